# Optimizing an MI355X kernel written in HIP

```python
import jax
import jax.numpy as jnp
from jax import lax
import numpy as np

D_MODEL = 2048
BATCH = 4
SEQ = 4096
DEPTH = 2

CHUNK = 64
N_EVEN = (DEPTH + 1) // 2
N_ODD = DEPTH // 2
NORM_EPS = 1e-6
CONV_WIDTH = 4

RG_WIDTH = D_MODEL // 2
RG_BLOCKS = 8
RG_BLOCK_DIM = RG_WIDTH // RG_BLOCKS
RG_C = 8.0

HG_HEADS = 8
HG_DK = 128
HG_DV = (D_MODEL // 2) // HG_HEADS
HG_QK_WIDTH = HG_HEADS * HG_DK
HG_V_WIDTH = HG_HEADS * HG_DV

AB_IN_SIZES = (RG_WIDTH, RG_WIDTH, HG_QK_WIDTH, HG_QK_WIDTH, HG_V_WIDTH, HG_V_WIDTH)
AB_IN_WIDTH = sum(AB_IN_SIZES)
AB_OUT_WIDTH = RG_WIDTH + HG_V_WIDTH

GDN_DK = 128
GDN_DV = 128
GDN_K_HEADS = D_MODEL // GDN_DK
GDN_V_HEADS = 2 * GDN_K_HEADS
GDN_QK_WIDTH = GDN_K_HEADS * GDN_DK
GDN_V_WIDTH = GDN_V_HEADS * GDN_DV
GDN_QKV_WIDTH = 2 * GDN_QK_WIDTH + GDN_V_WIDTH
C_IN_SIZES = (GDN_QKV_WIDTH, GDN_V_WIDTH, GDN_V_HEADS, GDN_V_HEADS)
C_IN_WIDTH = sum(C_IN_SIZES)

N_GROUPS = 8
EXPERTS_PER_GROUP = 8
N_EXPERTS = N_GROUPS * EXPERTS_PER_GROUP
TOP_K = 2
D_EXPERT = D_MODEL // 4
MOE_BLOCK = 128
ROUTER_BIAS_SCALE = 0.01

kernel_name = 'hybrid_rglru_hgrn2_gdn_hmoe'

F32 = jnp.float32


def _split(t, sizes):
    return jnp.split(t, np.cumsum(sizes)[:-1].tolist(), axis=-1)


def rms_norm(x, gain):
    x32 = x.astype(F32)
    y = x32 * lax.rsqrt(jnp.mean(x32 * x32, axis=-1, keepdims=True) + NORM_EPS)
    return (y * gain.astype(F32)).astype(x.dtype)


def l2_norm(x):
    return x * lax.rsqrt(jnp.sum(x * x, axis=-1, keepdims=True) + 1e-6)


def causal_depthwise_conv(x, w):
    S = x.shape[1]
    xp = jnp.pad(x, ((0, 0), (CONV_WIDTH - 1, 0), (0, 0)))
    w = w.astype(x.dtype)
    y = xp[:, 0:S, :] * w[0]
    for j in range(1, CONV_WIDTH):
        y = y + xp[:, j:j + S, :] * w[j]
    return y


def to_chunks(t):
    B, S, H, d = t.shape
    return t.reshape(B, S // CHUNK, CHUNK, H, d).transpose(1, 0, 3, 2, 4)


def from_chunks(t):
    nC, B, H, C, d = t.shape
    return t.transpose(1, 0, 3, 2, 4).reshape(B, nC * C, H, d)


def rg_lru(x, w_a, b_a, w_x, b_x, lam):
    B, S, W = x.shape
    x32 = x.astype(F32)
    xb = x32.reshape(B, S, RG_BLOCKS, RG_BLOCK_DIM)
    r = jax.nn.sigmoid(jnp.einsum('bshi,hij->bshj', xb, w_a.astype(F32)).reshape(B, S, W) + b_a.astype(F32))
    i = jax.nn.sigmoid(jnp.einsum('bshi,hij->bshj', xb, w_x.astype(F32)).reshape(B, S, W) + b_x.astype(F32))
    log_a = -RG_C * jax.nn.softplus(-lam.astype(F32)) * r
    a = jnp.exp(log_a)
    u = jnp.sqrt(-jnp.expm1(2.0 * log_a)) * (i * x32)

    def combine(left, right):
        a_l, u_l = left
        a_r, u_r = right
        return a_l * a_r, a_r * u_l + u_r

    _, h = lax.associative_scan(combine, (a, u), axis=1)
    return h


def hgrn2_chunkwise(q, f_logit, v, lb):
    B, S, H, DK = q.shape
    DV = v.shape[-1]
    q = jax.nn.silu(q.astype(F32))
    lb = lb.reshape(H, DK)
    f = lb + (1.0 - lb) * jax.nn.sigmoid(f_logit.astype(F32))
    k = 1.0 - f
    qc, kc, vc = to_chunks(q), to_chunks(k), to_chunks(v.astype(F32))
    bc = jnp.cumsum(to_chunks(jnp.log(f)), axis=3)
    pos = jnp.arange(CHUNK)
    causal = (pos[:, None] >= pos[None, :])[:, :, None]

    def step(state, inp):
        q_n, k_n, v_n, b_n = inp
        inter = jnp.einsum('bhtk,bhkv->bhtv', q_n * jnp.exp(b_n), state)
        diff = b_n[:, :, :, None, :] - b_n[:, :, None, :, :]
        decay = jnp.exp(jnp.where(causal, diff, -jnp.inf))
        scores = jnp.einsum('bhtk,bhsk,bhtsk->bhts', q_n, k_n, decay)
        intra = jnp.einsum('bhts,bhsv->bhtv', scores, v_n)
        b_last = b_n[:, :, -1:, :]
        state = (jnp.exp(b_last[:, :, 0, :])[..., None] * state
                 + jnp.einsum('bhsk,bhsv->bhkv', k_n * jnp.exp(b_last - b_n), v_n))
        return state, inter + intra

    _, o = lax.scan(step, jnp.zeros((B, H, DK, DV), F32), (qc, kc, vc, bc))
    return from_chunks(o)


def mixer_rglru_hgrn2(h, w_in, conv_w, conv_b, w_a, b_a, w_x, b_x, lam, lb, hg_gain, w_out):
    B, S, _ = h.shape
    x_rg, gate_rg, q_hg, f_hg, i_hg, g_hg = _split(h @ w_in, AB_IN_SIZES)
    x_rg = causal_depthwise_conv(x_rg, conv_w) + conv_b.astype(h.dtype)
    y_a = rg_lru(x_rg, w_a, b_a, w_x, b_x, lam) * jax.nn.gelu(gate_rg.astype(F32))
    o = hgrn2_chunkwise(q_hg.reshape(B, S, HG_HEADS, HG_DK),
                        f_hg.reshape(B, S, HG_HEADS, HG_DK),
                        i_hg.reshape(B, S, HG_HEADS, HG_DV), lb)
    o = rms_norm(o, hg_gain.reshape(HG_HEADS, HG_DV))
    y_b = o.reshape(B, S, HG_V_WIDTH) * jax.nn.silu(g_hg.astype(F32))
    y = jnp.concatenate([y_a, y_b], axis=-1).astype(h.dtype)
    return y @ w_out


def gated_delta_rule_chunkwise(q, k, v, g, beta):
    B, S, H, DK = q.shape
    DV = v.shape[-1]
    qc, kc, vc = to_chunks(q), to_chunks(k), to_chunks(v)
    gc = jnp.cumsum(to_chunks(g[..., None])[..., 0], axis=-1)
    bc = to_chunks(beta[..., None])[..., 0]
    pos = jnp.arange(CHUNK)
    incl = pos[:, None] >= pos[None, :]
    strict = pos[:, None] > pos[None, :]
    decay = jnp.exp(jnp.where(incl, gc[..., :, None] - gc[..., None, :], -jnp.inf))
    kk = jnp.einsum('nbhtd,nbhsd->nbhts', kc, kc)
    lower = jnp.where(strict, bc[..., :, None] * kk * decay, 0.0)
    eye = jnp.eye(CHUNK, dtype=F32)
    t_inv = lax.linalg.triangular_solve(lower + eye, jnp.broadcast_to(eye, lower.shape),
                                        left_side=True, lower=True, unit_diagonal=True)
    u = t_inv @ (vc * bc[..., None])
    w = t_inv @ (kc * (bc * jnp.exp(gc))[..., None])
    qk = jnp.einsum('nbhtd,nbhsd->nbhts', qc, kc) * decay
    q_dec = qc * jnp.exp(gc)[..., None]
    k_dec = kc * jnp.exp(gc[..., -1:] - gc)[..., None]
    g_last = jnp.exp(gc[..., -1])

    def step(state, inp):
        q_n, k_n, u_n, w_n, qk_n, gl_n = inp
        delta = u_n - w_n @ state
        out = q_n @ state + qk_n @ delta
        state = gl_n[..., None, None] * state + jnp.einsum('bhsk,bhsv->bhkv', k_n, delta)
        return state, out

    _, o = lax.scan(step, jnp.zeros((B, H, DK, DV), F32), (q_dec, k_dec, u, w, qk, g_last))
    return from_chunks(o)


def mixer_gated_deltanet(h, w_in, conv_w, a_log, dt_bias, out_gain, w_out):
    B, S, _ = h.shape
    qkv, z, b, a = _split(h @ w_in, C_IN_SIZES)
    qkv = jax.nn.silu(causal_depthwise_conv(qkv, conv_w)).astype(F32)
    q, k, v = _split(qkv, (GDN_QK_WIDTH, GDN_QK_WIDTH, GDN_V_WIDTH))
    rep = GDN_V_HEADS // GDN_K_HEADS
    q = jnp.repeat(l2_norm(q.reshape(B, S, GDN_K_HEADS, GDN_DK)), rep, axis=2) * (GDN_DK ** -0.5)
    k = jnp.repeat(l2_norm(k.reshape(B, S, GDN_K_HEADS, GDN_DK)), rep, axis=2)
    v = v.reshape(B, S, GDN_V_HEADS, GDN_DV)
    beta = jax.nn.sigmoid(b.astype(F32))
    g = -jnp.exp(a_log.astype(F32)) * jax.nn.softplus(a.astype(F32) + dt_bias.astype(F32))
    o = gated_delta_rule_chunkwise(q, k, v, g, beta)
    o = rms_norm(o, out_gain) * jax.nn.silu(z.astype(F32).reshape(B, S, GDN_V_HEADS, GDN_DV))
    return o.reshape(B, S, GDN_V_WIDTH).astype(h.dtype) @ w_out


def grouped_expert_ffn(xt, expert_id, w_gate, w_up, w_down):
    T, D = xt.shape
    K = expert_id.shape[1]
    M = T * K
    flat_e = expert_id.reshape(M)
    order = jnp.argsort(flat_e)
    sorted_e = flat_e[order]
    counts = jnp.bincount(flat_e, length=N_EXPERTS)
    padded = (counts + MOE_BLOCK - 1) // MOE_BLOCK * MOE_BLOCK
    pad_end = jnp.cumsum(padded)
    pad_start = pad_end - padded
    start = jnp.cumsum(counts) - counts
    dest = pad_start[sorted_e] + jnp.arange(M) - start[sorted_e]
    n_blocks = M // MOE_BLOCK + N_EXPERTS
    rows = jnp.zeros((n_blocks * MOE_BLOCK, D), xt.dtype).at[dest].set(xt[order // K])
    block_expert = jnp.minimum(
        jnp.searchsorted(pad_end, jnp.arange(n_blocks) * MOE_BLOCK, side='right'), N_EXPERTS - 1)

    def block_ffn(args):
        xb, e = args
        return (jax.nn.silu(xb @ w_gate[e]) * (xb @ w_up[e])) @ w_down[e]

    yb = lax.map(block_ffn, (rows.reshape(n_blocks, MOE_BLOCK, D), block_expert))
    y_sorted = yb.reshape(n_blocks * MOE_BLOCK, D)[dest]
    y = jnp.zeros((M, D), yb.dtype).at[order].set(y_sorted)
    return y.reshape(T, K, D)


def hierarchical_moe(h, w_grp, b_grp, w_exp, b_exp, w_gate, w_up, w_down):
    B, S, D = h.shape
    xt = h.reshape(B * S, D)
    T = xt.shape[0]
    grp_prob = jax.nn.softmax((xt @ w_grp).astype(F32) + b_grp.astype(F32), axis=-1)
    grp_p, grp_idx = lax.top_k(grp_prob, 1)
    exp_logits = ((xt @ w_exp).astype(F32) + b_exp.astype(F32)).reshape(T, N_GROUPS, EXPERTS_PER_GROUP)
    sel = jnp.broadcast_to(grp_idx[:, :, None], (T, 1, EXPERTS_PER_GROUP))
    in_grp = jnp.take_along_axis(exp_logits, sel, axis=1)[:, 0]
    top_logit, top_idx = lax.top_k(in_grp, TOP_K)
    gate = jax.nn.softmax(top_logit, axis=-1) * grp_p
    expert_id = grp_idx * EXPERTS_PER_GROUP + top_idx
    y = grouped_expert_ffn(xt, expert_id, w_gate, w_up, w_down)
    out = jnp.einsum('tk,tkd->td', gate.astype(y.dtype), y)
    return out.reshape(B, S, D)


def setup_inputs(seed: int = 0) -> dict:
    key = jax.random.key(seed)
    ks = jax.random.split(key, 32)

    def nrm(k, shape, scale):
        return jax.random.normal(k, shape, F32) * scale

    x = nrm(ks[0], (BATCH, SEQ, D_MODEL), 1.0)
    norm_mix = 1.0 + nrm(ks[1], (DEPTH, D_MODEL), 0.01)
    norm_ffn = 1.0 + nrm(ks[2], (DEPTH, D_MODEL), 0.01)
    norm_final = 1.0 + nrm(ks[3], (D_MODEL,), 0.01)
    ab_w_in = nrm(ks[4], (N_EVEN, D_MODEL, AB_IN_WIDTH), D_MODEL ** -0.5)
    ab_conv_w = nrm(ks[5], (N_EVEN, CONV_WIDTH, RG_WIDTH), CONV_WIDTH ** -0.5)
    ab_conv_b = nrm(ks[6], (N_EVEN, RG_WIDTH), 0.01)
    rg_wa = nrm(ks[7], (N_EVEN, RG_BLOCKS, RG_BLOCK_DIM, RG_BLOCK_DIM), RG_BLOCK_DIM ** -0.5)
    rg_ba = nrm(ks[8], (N_EVEN, RG_WIDTH), 0.01)
    rg_wx = nrm(ks[9], (N_EVEN, RG_BLOCKS, RG_BLOCK_DIM, RG_BLOCK_DIM), RG_BLOCK_DIM ** -0.5)
    rg_bx = nrm(ks[10], (N_EVEN, RG_WIDTH), 0.01)
    a_c = jax.random.uniform(ks[11], (N_EVEN, RG_WIDTH), F32, 0.9, 0.999)
    sig = a_c ** (1.0 / RG_C)
    rg_lambda = jnp.log(sig) - jnp.log1p(-sig)
    hg_lb_logits = nrm(ks[12], (N_EVEN + 1, HG_QK_WIDTH), 0.1).at[0].add(-2.0)
    hg_norm = 1.0 + nrm(ks[13], (N_EVEN, HG_V_WIDTH), 0.01)
    ab_w_out = nrm(ks[14], (N_EVEN, AB_OUT_WIDTH, D_MODEL), AB_OUT_WIDTH ** -0.5)
    c_w_in = nrm(ks[15], (N_ODD, D_MODEL, C_IN_WIDTH), D_MODEL ** -0.5)
    c_conv_w = nrm(ks[16], (N_ODD, CONV_WIDTH, GDN_QKV_WIDTH), CONV_WIDTH ** -0.5)
    c_a_log = jnp.log(jax.random.uniform(ks[17], (N_ODD, GDN_V_HEADS), F32, 1.0, 16.0))
    dt = jnp.exp(jax.random.uniform(ks[18], (N_ODD, GDN_V_HEADS), F32,
                                    float(np.log(1e-3)), float(np.log(1e-1))))
    c_dt_bias = dt + jnp.log(-jnp.expm1(-dt))
    c_norm = 1.0 + nrm(ks[19], (N_ODD, GDN_DV), 0.01)
    c_w_out = nrm(ks[20], (N_ODD, GDN_V_WIDTH, D_MODEL), GDN_V_WIDTH ** -0.5)
    moe_wg = nrm(ks[21], (DEPTH, D_MODEL, N_GROUPS), D_MODEL ** -0.5)
    moe_bg = nrm(ks[22], (DEPTH, N_GROUPS), ROUTER_BIAS_SCALE)
    moe_we = nrm(ks[23], (DEPTH, D_MODEL, N_EXPERTS), D_MODEL ** -0.5)
    moe_be = nrm(ks[24], (DEPTH, N_EXPERTS), ROUTER_BIAS_SCALE)
    moe_w_gate = nrm(ks[25], (DEPTH, N_EXPERTS, D_MODEL, D_EXPERT), D_MODEL ** -0.5)
    moe_w_up = nrm(ks[26], (DEPTH, N_EXPERTS, D_MODEL, D_EXPERT), D_MODEL ** -0.5)
    moe_w_down = nrm(ks[27], (DEPTH, N_EXPERTS, D_EXPERT, D_MODEL), D_EXPERT ** -0.5)
    return {'x': x, 'norm_mix': norm_mix, 'norm_ffn': norm_ffn, 'norm_final': norm_final,
            'ab_w_in': ab_w_in, 'ab_conv_w': ab_conv_w, 'ab_conv_b': ab_conv_b,
            'rg_wa': rg_wa, 'rg_ba': rg_ba, 'rg_wx': rg_wx, 'rg_bx': rg_bx, 'rg_lambda': rg_lambda,
            'hg_lb_logits': hg_lb_logits, 'hg_norm': hg_norm, 'ab_w_out': ab_w_out,
            'c_w_in': c_w_in, 'c_conv_w': c_conv_w, 'c_a_log': c_a_log, 'c_dt_bias': c_dt_bias,
            'c_norm': c_norm, 'c_w_out': c_w_out,
            'moe_wg': moe_wg, 'moe_bg': moe_bg, 'moe_we': moe_we, 'moe_be': moe_be,
            'moe_w_gate': moe_w_gate, 'moe_w_up': moe_w_up, 'moe_w_down': moe_w_down}


def reference(x, norm_mix, norm_ffn, norm_final, ab_w_in, ab_conv_w, ab_conv_b, rg_wa, rg_ba, rg_wx,
              rg_bx, rg_lambda, hg_lb_logits, hg_norm, ab_w_out, c_w_in, c_conv_w, c_a_log, c_dt_bias,
              c_norm, c_w_out, moe_wg, moe_bg, moe_we, moe_be, moe_w_gate, moe_w_up, moe_w_down):
    lb_all = jnp.cumsum(jax.nn.softmax(hg_lb_logits.astype(F32), axis=0), axis=0)
    for layer in range(DEPTH):
        j = layer // 2
        h = rms_norm(x, norm_mix[layer])
        if layer % 2 == 0:
            mix = mixer_rglru_hgrn2(h, ab_w_in[j], ab_conv_w[j], ab_conv_b[j], rg_wa[j], rg_ba[j],
                                    rg_wx[j], rg_bx[j], rg_lambda[j], lb_all[j], hg_norm[j], ab_w_out[j])
        else:
            mix = mixer_gated_deltanet(h, c_w_in[j], c_conv_w[j], c_a_log[j], c_dt_bias[j],
                                       c_norm[j], c_w_out[j])
        x = x + mix.astype(x.dtype)
        h = rms_norm(x, norm_ffn[layer])
        x = x + hierarchical_moe(h, moe_wg[layer], moe_bg[layer], moe_we[layer], moe_be[layer],
                                 moe_w_gate[layer], moe_w_up[layer], moe_w_down[layer]).astype(x.dtype)
    return rms_norm(x, norm_final)
```

```cpp
#include <hip/hip_runtime.h>
#include <stdint.h>
#include <stdio.h>
#include <string.h>

#ifndef EXTRA_PH
#define EXTRA_PH -1
#endif
#ifndef N_LAUNCH_MODE
#define N_LAUNCH_MODE 1
#endif

#define LAS __attribute__((address_space(3)))
typedef unsigned short bf16_t;
typedef short bf16x8 __attribute__((ext_vector_type(8)));
typedef float f32x4 __attribute__((ext_vector_type(4)));
typedef float f32x2 __attribute__((ext_vector_type(2)));
typedef unsigned u32x4 __attribute__((ext_vector_type(4)));
typedef unsigned u32x2 __attribute__((ext_vector_type(2)));

constexpr int T_ = 16384, D_ = 2048, S_ = 4096, NB_ = 4;
constexpr int N_IN0 = 6144, N_IN1 = 12352, N_IN1P = 12544;
constexpr int NEXP = 64, DEXP = 512, MPAD = 49152;
constexpr int NTHREADS = 512;
constexpr int LDS_MAIN = 131072;
constexpr int LDS_BYTES = 163840;
constexpr int LDS_XBW = LDS_BYTES - 16;

constexpr size_t al256(size_t x) { return (x + 255) & ~(size_t)255; }
constexpr size_t WS_CTL = 0;
constexpr size_t CTL_BYTES = 65536;
constexpr size_t CTL_CNT = 16384;
constexpr size_t WS_LB = WS_CTL + CTL_BYTES;
constexpr size_t WS_TINFO = WS_LB + 4096;
constexpr size_t WS_WIN0T = WS_TINFO + 4096;
constexpr size_t WS_WOUT0T = WS_WIN0T + (size_t)N_IN0 * D_ * 2;
constexpr size_t WS_WIN1T = WS_WOUT0T + (size_t)D_ * D_ * 2;
constexpr size_t WS_WOUT1T = WS_WIN1T + (size_t)N_IN1P * D_ * 2;
constexpr size_t WS_WGATES = WS_WOUT1T + (size_t)D_ * 4096 * 2;
constexpr size_t WS_WRT = WS_WGATES + (size_t)8 * 256 * 256 * 2;
constexpr size_t WS_WG = WS_WRT + (size_t)2 * 256 * D_ * 2;
constexpr size_t WS_WU = WS_WG + (size_t)NEXP * DEXP * D_ * 2;
constexpr size_t WS_WD = WS_WU + (size_t)NEXP * DEXP * D_ * 2;
constexpr size_t WS_X = WS_WD + (size_t)NEXP * DEXP * D_ * 2;
constexpr size_t WS_H = WS_X + (size_t)T_ * D_ * 4;
constexpr size_t WS_PROJ = WS_H + (size_t)T_ * D_ * 2;
constexpr size_t PROJ_BYTES = (size_t)T_ * N_IN1P * 2;
constexpr size_t WS_FLOG = WS_PROJ + (size_t)T_ * N_IN0 * 2;
constexpr size_t WS_XC = WS_FLOG + (size_t)T_ * 1024 * 4;
constexpr size_t WS_ACT = WS_PROJ;
constexpr size_t WS_YMOE = WS_ACT + (size_t)MPAD * DEXP * 2;
constexpr size_t WS_R1 = WS_PROJ + PROJ_BYTES;
constexpr size_t WS_A = WS_R1;
constexpr size_t WS_U = WS_R1 + (size_t)T_ * 1024 * 4;
constexpr size_t WS_QKVC = WS_R1;
constexpr size_t WS_Y = WS_R1 + (size_t)T_ * 8192 * 2;
constexpr size_t WS_O = WS_Y + (size_t)T_ * 4096 * 2;
constexpr size_t WS_TAIL = WS_O + (size_t)T_ * 4096 * 4;
constexpr size_t WS_BG = WS_TAIL + (size_t)T_ * 64 * 4;
constexpr size_t WS_LOGITS = WS_BG + (size_t)T_ * 64 * 4;
constexpr size_t WS_EID = WS_LOGITS + (size_t)T_ * 128 * 4;
constexpr size_t WS_SLOT = WS_EID + (size_t)T_ * 2 * 4;
constexpr size_t WS_GATE = WS_SLOT + (size_t)T_ * 2 * 4;
constexpr size_t WS_POSOF = WS_GATE + (size_t)T_ * 2 * 4;
constexpr size_t WS_ROWMAP = WS_POSOF + (size_t)T_ * 2 * 4;
constexpr size_t WS_H8 = WS_ROWMAP + (size_t)MPAD * 4;
constexpr size_t WS_END = WS_H8 + (size_t)T_ * D_;
static_assert(WS_YMOE + (size_t)MPAD * D_ * 2 <= WS_R1, "moe overlay");
static_assert(WS_XC + (size_t)T_ * 1024 * 2 <= WS_R1, "layer0 overlay");

struct Args {
    const float* in[28];
    float* out;
    unsigned char* ws;
    int ph_lo, ph_hi;
};

__device__ __forceinline__ int tidx_() { int t = (int)threadIdx.x; asm volatile("" : "+v"(t)); return t; }
#define TIDX tidx_()
typedef __bf16 bf16x2n __attribute__((ext_vector_type(2)));
__device__ __forceinline__ unsigned cvt_pk_bf16(float lo, float hi) { const f32x2 v = {lo, hi}; return __builtin_bit_cast(unsigned, __builtin_convertvector(v, bf16x2n)); }
__device__ __forceinline__ unsigned pk_fp8x4(float a, float b, float c, float d) { int v = __builtin_amdgcn_cvt_pk_fp8_f32(a, b, 0, false); v = __builtin_amdgcn_cvt_pk_fp8_f32(c, d, v, true); return (unsigned)v; }
constexpr float W8_SCALE = 64.0f, ACT8_SCALE = 8.0f;
__device__ __forceinline__ bf16_t f2bf(float x) { return (bf16_t)(cvt_pk_bf16(x, 0.f) & 0xffffu); }
__device__ __forceinline__ float bf_lo(unsigned w) { return __uint_as_float(w << 16); }
__device__ __forceinline__ float bf_hi(unsigned w) { return __uint_as_float(w & 0xffff0000u); }
__device__ __forceinline__ float bf1(bf16_t v) { return __uint_as_float(((unsigned)v) << 16); }
__device__ __forceinline__ float sigmoidf_(float x) { return __builtin_amdgcn_rcpf(1.0f + __expf(-x)); }
__device__ __forceinline__ float siluf_(float x) { return x * __builtin_amdgcn_rcpf(1.0f + __expf(-x)); }
__device__ __forceinline__ float softplusf_(float x) { return x > 20.f ? x : log1pf(__expf(x)); }
__device__ __forceinline__ float gelu_tanh(float x) { const float u = 0.7978845608028654f * (x + 0.044715f * x * x * x); return x * __builtin_amdgcn_rcpf(1.0f + __expf(-2.0f * u)); }
template <int CTRL> __device__ __forceinline__ float dpp_f(float v) { return __builtin_bit_cast(float, __builtin_amdgcn_update_dpp(0, __builtin_bit_cast(int, v), CTRL, 0xf, 0xf, false)); }
__device__ __forceinline__ float row16_sum(float s) { s += dpp_f<0x140>(s); s += dpp_f<0x141>(s); s += dpp_f<0xB1>(s); s += dpp_f<0x4E>(s); return s; }
__device__ __forceinline__ float wave_sum(float v) { v = row16_sum(v); v += __shfl_xor(v, 16); v += __shfl_xor(v, 32); return v; }

#define LDS_BARRIER() do { asm volatile("s_waitcnt lgkmcnt(0)" ::: "memory"); __builtin_amdgcn_s_barrier(); asm volatile("" ::: "memory"); } while (0)
#define XB_TMO      128
#define XB_XCNT(j)  (256  + 64 * (j))
#define XB_XSUB(j)  (1280 + 64 * (j))
#define XB_XGEN(j)  (2304 + 64 * (j))
#define XB_TOP      3328
#define XB_TOPGEN   3392
#define XCD_BAR_WORDS 3456
#define XB_SPIN_CAP (1u << 18)

__device__ __forceinline__ unsigned xb_ld(unsigned* p)              { return __hip_atomic_load(p, __ATOMIC_RELAXED, __HIP_MEMORY_SCOPE_AGENT); }
__device__ __forceinline__ unsigned xb_add(unsigned* p, unsigned v) { return __hip_atomic_fetch_add(p, v, __ATOMIC_RELAXED, __HIP_MEMORY_SCOPE_AGENT); }
__device__ __forceinline__ unsigned xb_xcc_id() { return (unsigned)__builtin_amdgcn_s_getreg((3 << 11) | 20) & 0xFu; }
#define XB_SPIN(cond, bar) do { unsigned _sp = 0; while (cond) { __builtin_amdgcn_s_sleep(1); \
    if ((++_sp & 255u) == 0u) { if (xb_ld(&(bar)[XB_TMO])) break; if (_sp > XB_SPIN_CAP) { atomicAdd(&(bar)[XB_TMO], 1u); break; } } } } while (0)

struct XcdBarrier { unsigned* bar; unsigned x; volatile LAS unsigned* st; };

__device__ __forceinline__ XcdBarrier xcd_barrier_post(unsigned* bar, volatile LAS unsigned* st) {
    XcdBarrier b; b.bar = bar; b.x = xb_xcc_id(); b.st = st;
    if (TIDX == 0) (void)xb_add(&bar[XB_XCNT(b.x)], 1u);
    return b;
}
__device__ __forceinline__ void xcd_barrier_complete(unsigned* bar, unsigned x, unsigned& nloc, unsigned& nx) {
    const unsigned G = gridDim.x * gridDim.y * gridDim.z;
    unsigned sum, cnt, mine, sp = 0u;
    for (;;) {
        sum = 0u; cnt = 0u; mine = 0u;
#pragma unroll
        for (unsigned j = 0; j < 16; ++j) { const unsigned c = xb_ld(&bar[XB_XCNT(j)]); sum += c; cnt += (c > 0u) ? 1u : 0u; mine = (j == x) ? c : mine; }
        if (sum == G) break;
        __builtin_amdgcn_s_sleep(1);
        if ((++sp & 255u) == 0u) { if (xb_ld(&bar[XB_TMO])) break; if (sp > XB_SPIN_CAP) { atomicAdd(&bar[XB_TMO], 1u); break; } }
    }
    nloc = mine > 0u ? mine : 1u; nx = cnt > 0u ? cnt : 1u;
}
__device__ __forceinline__ void xcd_barrier(const XcdBarrier& b) {
    asm volatile("s_waitcnt vmcnt(0)" ::: "memory");
    __syncthreads();
    if (TIDX == 0) {
        unsigned* bar = b.bar;
        __builtin_amdgcn_s_waitcnt(0);
        unsigned nloc = b.st[0], nx = b.st[1];
        if (nloc == 0u) { xcd_barrier_complete(bar, b.x, nloc, nx); b.st[0] = nloc; b.st[1] = nx; }
        const unsigned old = xb_add(&bar[XB_XSUB(b.x)], 1u);
        const unsigned gen = old / nloc;
        if (old + 1u == (gen + 1u) * nloc) {
            __builtin_amdgcn_fence(__ATOMIC_RELEASE, "agent");
            asm volatile("s_waitcnt vmcnt(0)" ::: "memory");
            const unsigned og = xb_add(&bar[XB_TOP], 1u);
            const unsigned tg = og / nx;
            if (og + 1u == (tg + 1u) * nx) xb_add(&bar[XB_TOPGEN], 1u);
            else XB_SPIN(xb_ld(&bar[XB_TOPGEN]) == tg, bar);
            __builtin_amdgcn_fence(__ATOMIC_ACQUIRE, "agent");
            xb_add(&bar[XB_XGEN(b.x)], 1u);
            asm volatile("s_waitcnt vmcnt(0)" ::: "memory");
        } else {
            XB_SPIN(xb_ld(&bar[XB_XGEN(b.x)]) == gen, bar);
            __builtin_amdgcn_fence(__ATOMIC_ACQUIRE, "agent");
            asm volatile("s_waitcnt vmcnt(0)" ::: "memory");
        }
    }
    __syncthreads();
}

constexpr int BM = 256, BK = 64, HALF = 128, HTB = HALF * BK * 2;
__device__ __forceinline__ int lds_byte(int r, int c) { const int st = (r >> 4) * 2 + (c >> 5), rr = r & 15, cc = c & 31, ob = rr * 64 + cc * 2; return st * 1024 + (ob ^ (((ob >> 9) & 1) << 5)); }
__device__ __forceinline__ void stage_rc(int b, int& R, int& C) { const int st = b / 1024, sb = b % 1024, swz = sb ^ (((sb >> 9) & 1) << 5); R = (st >> 1) * 16 + swz / 64; C = (st & 1) * 32 + (swz % 64) / 2; }
__device__ __forceinline__ int perm32(int rho) { const int n = rho >> 4, i = rho & 15; return 8 * (i >> 2) + 4 * n + (i & 3); }

__device__ __forceinline__ void stage_pos(int tid, int& R0, int& C0) { stage_rc(tid * 16, R0, C0); }
__device__ __forceinline__ int perm_row(int R) { return (R & ~31) + perm32(R & 31); }

#define BID ((int)blockIdx.x)
#define NBLK ((int)gridDim.x)
#define BID_ BID
#define NBLK_ NBLK
typedef f32x4 Acc[2][2][4][2];
struct UnitD { const char* gA; const char* gB; int t0, t1, t2; };

typedef int i32x8 __attribute__((ext_vector_type(8)));
typedef int i32x4 __attribute__((ext_vector_type(4)));
template <bool GATHER, bool FP8, class Src, class Epi>
__device__ __forceinline__ void gemm_stream(LAS unsigned char* lds, const Src& S, const int nt, const Epi& E) {
    const int tid = TIDX, wid = tid >> 6, lane = tid & 63, wr = wid >> 2, wc = wid & 3, fr = lane & 15, fq = lane >> 4;
    const unsigned ldsw = (unsigned)wid * 1024u;
    const int aoff = lds_byte(wr * 64 + fr, fq * 8), boff = lds_byte(wc * 32 + fr, fq * 8);
    const size_t kstep = (size_t)(BK * 2);
#define G_SA(b, h) (((b) * 2 + (h)) * HTB)
#define G_SB(b, h) ((4 + (b) * 2 + (h)) * HTB)
#define G_STAGE(bufoff, gbase, v) do { _Pragma("unroll") for (int _i = 0; _i < 2; ++_i) \
        __builtin_amdgcn_global_load_lds((const unsigned*)((gbase) + (v)[_i]), (LAS unsigned*)(lds + (bufoff) + ldsw + _i * 8192), 16, 0, 0); } while (0)
#define G_LD8(p) __builtin_shufflevector(*(const LAS i32x4*)(p), *(const LAS i32x4*)((p) + 1024), 0, 1, 2, 3, 4, 5, 6, 7)
#define G_LDA(dst, b, h) do { _Pragma("unroll") for (int m = 0; m < 4; ++m) dst[m] = G_LD8(lds + G_SA(b, h) + aoff + m * 2048); } while (0)
#define G_LDB(dst, b, h) do { _Pragma("unroll") for (int n = 0; n < 2; ++n) dst[n] = G_LD8(lds + G_SB(b, h) + boff + n * 2048); } while (0)
#define G_HALF(x, k) __builtin_bit_cast(bf16x8, __builtin_shufflevector((x), (x), 4 * (k), 4 * (k) + 1, 4 * (k) + 2, 4 * (k) + 3))
#define G_MMA(ai, bj, At, Bt) do { __builtin_amdgcn_s_setprio(1); _Pragma("unroll") for (int m = 0; m < 4; ++m) _Pragma("unroll") for (int n = 0; n < 2; ++n) { \
        if (FP8) asm volatile("v_mfma_f32_16x16x128_f8f6f4 %0, %1, %2, %0" : "+v"(acc[ai][bj][m][n]) : "v"(Bt[n]), "v"(At[m]));   \
        else { acc[ai][bj][m][n] = __builtin_amdgcn_mfma_f32_16x16x32_bf16(G_HALF(Bt[n], 0), G_HALF(At[m], 0), acc[ai][bj][m][n], 0, 0, 0); \
               acc[ai][bj][m][n] = __builtin_amdgcn_mfma_f32_16x16x32_bf16(G_HALF(Bt[n], 1), G_HALF(At[m], 1), acc[ai][bj][m][n], 0, 0, 0); } } \
        __builtin_amdgcn_s_setprio(0); } while (0)
#define G_WAIT_V(n) asm volatile("s_waitcnt vmcnt(" #n ")" ::: "memory")
#define G_WAIT_L(n) asm volatile("s_waitcnt lgkmcnt(" #n ")" ::: "memory")
#define G_BAR __builtin_amdgcn_s_barrier()
#define G_SCHED __builtin_amdgcn_sched_barrier(0)
    UnitD cur, nxt; int ui = 0;
    if (!S.next(0, cur)) return;
    unsigned va[2][2], vb[2][2], van[2][2];
    S.vb(vb); S.va(cur, va);
    Acc acc;
#pragma unroll
    for (int a = 0; a < 2; ++a)
#pragma unroll
        for (int b = 0; b < 2; ++b)
#pragma unroll
            for (int m = 0; m < 4; ++m)
#pragma unroll
                for (int n = 0; n < 2; ++n) acc[a][b][m][n] = (f32x4){0.f, 0.f, 0.f, 0.f};
    i32x8 At[4], B0[2], B1[2];
    const char* cA = cur.gA; const char* cB = cur.gB;
    G_WAIT_V(0);
    __syncthreads();
    G_STAGE(G_SB(0, 0), cB, vb[0]); G_STAGE(G_SA(0, 0), cA, va[0]); G_STAGE(G_SB(0, 1), cB, vb[1]); G_STAGE(G_SA(0, 1), cA, va[1]);
    if (wr == 1) G_BAR;
    G_WAIT_V(4); G_BAR;
    G_STAGE(G_SB(1, 0), cB + kstep, vb[0]); G_STAGE(G_SA(1, 0), cA + kstep, va[0]); G_STAGE(G_SB(1, 1), cB + kstep, vb[1]);
    G_WAIT_V(6); G_BAR;
    for (;;) {
        const bool has_next = S.next(ui + 1, nxt);
        const char* nA = has_next ? nxt.gA : cA; const char* nB = has_next ? nxt.gB : cB;
        if (GATHER) { if (has_next) S.va(nxt, van); else { van[0][0] = va[0][0]; van[0][1] = va[0][1]; van[1][0] = va[1][0]; van[1][1] = va[1][1]; } }
#pragma unroll 1
        for (int t = 0; t < nt; t += 2) {
            const bool last = (t == nt - 2);
            const char* a1 = cA + (size_t)(t + 1) * kstep;
            const char* a2 = last ? nA : cA + (size_t)(t + 2) * kstep; const char* b2 = last ? nB : cB + (size_t)(t + 2) * kstep;
            const char* a3 = a2 + kstep; const char* b3 = b2 + kstep;
            unsigned v2[2][2];
#pragma unroll
            for (int hh = 0; hh < 2; ++hh)
#pragma unroll
                for (int i = 0; i < 2; ++i) v2[hh][i] = (GATHER && last) ? van[hh][i] : va[hh][i];
            G_LDB(B0, 0, 0); G_SCHED; G_LDA(At, 0, 0); G_STAGE(G_SA(1, 1), a1, va[1]);
            G_WAIT_L(8); G_BAR; G_WAIT_L(0); G_MMA(0, 0, At, B0); G_BAR; G_SCHED;
            G_LDB(B1, 0, 1); G_STAGE(G_SB(0, 0), b2, vb[0]);
            G_BAR; G_WAIT_L(0); G_MMA(0, 1, At, B1); G_BAR;
            G_LDA(At, 0, 1); G_STAGE(G_SA(0, 0), a2, v2[0]);
            G_BAR; G_WAIT_L(0); G_MMA(1, 0, At, B0); G_BAR; G_SCHED;
            G_STAGE(G_SB(0, 1), b2, vb[1]);
            G_WAIT_V(6); G_BAR; G_MMA(1, 1, At, B1); G_BAR;
            G_LDB(B0, 1, 0); G_SCHED; G_LDA(At, 1, 0); G_STAGE(G_SA(0, 1), a2, v2[1]);
            G_WAIT_L(8); G_BAR; G_WAIT_L(0); G_MMA(0, 0, At, B0); G_BAR; G_SCHED;
            G_LDB(B1, 1, 1); G_STAGE(G_SB(1, 0), b3, vb[0]);
            G_BAR; G_WAIT_L(0); G_MMA(0, 1, At, B1); G_BAR;
            G_LDA(At, 1, 1); G_STAGE(G_SA(1, 0), a3, v2[0]);
            G_BAR; G_WAIT_L(0); G_MMA(1, 0, At, B0); G_BAR; G_SCHED;
            G_STAGE(G_SB(1, 1), b3, vb[1]);
            G_WAIT_V(6); G_BAR; G_MMA(1, 1, At, B1); G_BAR;
        }
        if (FP8) asm volatile("s_nop 15\n\ts_nop 15" ::: "memory");
        { int tz = TIDX; asm volatile("" : "+v"(tz));
          const int wid2 = tz >> 6, lane2 = tz & 63; E(acc, cur, wid2 >> 2, wid2 & 3, lane2 & 15, lane2 >> 4); }
        if (!has_next) break;
#pragma unroll
        for (int a = 0; a < 2; ++a)
#pragma unroll
            for (int b = 0; b < 2; ++b)
#pragma unroll
                for (int m = 0; m < 4; ++m)
#pragma unroll
                    for (int n = 0; n < 2; ++n) acc[a][b][m][n] = (f32x4){0.f, 0.f, 0.f, 0.f};
        cur = nxt; cA = nA; cB = nB; ++ui;
        if (GATHER) { va[0][0] = van[0][0]; va[0][1] = van[0][1]; va[1][0] = van[1][0]; va[1][1] = van[1][1]; }
    }
    G_WAIT_V(0);
    if (wr == 0) G_BAR;
    G_BAR;
#undef G_SA
#undef G_SB
#undef G_STAGE
#undef G_LDA
#undef G_LDB
#undef G_MMA
#undef G_LD8
#undef G_HALF
#undef G_WAIT_V
#undef G_WAIT_L
#undef G_BAR
#undef G_SCHED
}

__device__ __forceinline__ void offs_direct(unsigned (&v)[2][2], int ld, bool perm) {
    int R0, C0; stage_pos(TIDX, R0, C0);
#pragma unroll
    for (int i = 0; i < 2; ++i) { const int R = R0 + 64 * i, Rr = perm ? perm_row(R) : R;
        v[0][i] = (unsigned)(Rr * ld + C0) * 2u; v[1][i] = (unsigned)((Rr + HALF) * ld + C0) * 2u; }
}

struct SrcGrid {
    const char* A; const char* B; size_t astep, bstep; int nM, total, lda, ldb;
    __device__ __forceinline__ bool next(int i, UnitD& u) const { const int id = BID_ + i * NBLK_; if (id >= total) return false; u.t0 = id % nM; u.t1 = id / nM; u.t2 = 0;
        u.gA = A + (size_t)u.t0 * astep; u.gB = B + (size_t)u.t1 * bstep; return true; }
    __device__ __forceinline__ void va(const UnitD&, unsigned (&v)[2][2]) const { offs_direct(v, lda, false); }
    __device__ __forceinline__ void vb(unsigned (&v)[2][2]) const { offs_direct(v, ldb, true); }
};

__device__ __forceinline__ void store_bf16_tile(const Acc& acc, bf16_t* O, int ld, int wr, int wc, int fr, int fq, const float sc = 1.0f) {
#pragma unroll
    for (int ai = 0; ai < 2; ++ai)
#pragma unroll
        for (int m = 0; m < 4; ++m) { bf16_t* rowp = O + (size_t)(ai * HALF + wr * 64 + m * 16 + fr) * ld + wc * 32 + 8 * fq;
#pragma unroll
            for (int bj = 0; bj < 2; ++bj) { const f32x4 v0 = acc[ai][bj][m][0] * sc, v1 = acc[ai][bj][m][1] * sc;
                u32x4 w; w.x = cvt_pk_bf16(v0[0], v0[1]); w.y = cvt_pk_bf16(v0[2], v0[3]); w.z = cvt_pk_bf16(v1[0], v1[1]); w.w = cvt_pk_bf16(v1[2], v1[3]);
                *(u32x4*)(rowp + bj * HALF) = w; } }
}
__device__ __forceinline__ void store_f32_tile(const Acc& acc, float* O, const float* R, int ld, int ncol, int wr, int wc, int fr, int fq, const float sc = 1.0f) {
#pragma unroll
    for (int ai = 0; ai < 2; ++ai)
#pragma unroll
        for (int m = 0; m < 4; ++m) { const size_t ro = (size_t)(ai * HALF + wr * 64 + m * 16 + fr) * ld;
#pragma unroll
            for (int bj = 0; bj < 2; ++bj)
#pragma unroll
                for (int n = 0; n < 2; ++n) { const int c = bj * HALF + wc * 32 + 8 * fq + 4 * n; if (c >= ncol) continue;
                    f32x4 v = acc[ai][bj][m][n] * sc; if (R) v += *(const f32x4*)(R + ro + c); *(f32x4*)(O + ro + c) = v; } }
}
struct EpiProj {
    bf16_t* O; int ld; float* F; int fld, fp0, fp1, ncol; float sc;
    __device__ __forceinline__ void operator()(const Acc& acc, const UnitD& u, int wr, int wc, int fr, int fq) const {
        if (u.t1 >= fp0 && u.t1 < fp1) store_f32_tile(acc, F + (size_t)u.t0 * BM * fld + (u.t1 - fp0) * BM, nullptr, fld, ncol, wr, wc, fr, fq, sc);
        else store_bf16_tile(acc, O + (size_t)u.t0 * BM * ld + u.t1 * BM, ld, wr, wc, fr, fq, sc);
    }
};
struct EpiResid {
    bf16_t* O; const float* Rf; const bf16_t* Rb; float sc;
    __device__ __forceinline__ void operator()(const Acc& acc, const UnitD& u, int wr, int wc, int fr, int fq) const {
        const size_t o = (size_t)u.t0 * BM * D_ + u.t1 * BM;
#pragma unroll
        for (int ai = 0; ai < 2; ++ai)
#pragma unroll
            for (int m = 0; m < 4; ++m) { const size_t ro = o + (size_t)(ai * HALF + wr * 64 + m * 16 + fr) * D_ + wc * 32 + 8 * fq;
#pragma unroll
                for (int bj = 0; bj < 2; ++bj) { f32x4 v0 = acc[ai][bj][m][0] * sc, v1 = acc[ai][bj][m][1] * sc;
                    if (Rf) { v0 += *(const f32x4*)(Rf + ro + bj * HALF); v1 += *(const f32x4*)(Rf + ro + bj * HALF + 4); }
                    else { const u32x4 r = *(const u32x4*)(Rb + ro + bj * HALF); v0[0] += bf_lo(r.x); v0[1] += bf_hi(r.x); v0[2] += bf_lo(r.y); v0[3] += bf_hi(r.y); v1[0] += bf_lo(r.z); v1[1] += bf_hi(r.z); v1[2] += bf_lo(r.w); v1[3] += bf_hi(r.w); }
                    u32x4 w; w.x = cvt_pk_bf16(v0[0], v0[1]); w.y = cvt_pk_bf16(v0[2], v0[3]); w.z = cvt_pk_bf16(v1[0], v1[1]); w.w = cvt_pk_bf16(v1[2], v1[3]);
                    *(u32x4*)(O + ro + bj * HALF) = w; } }
    }
};
struct EpiLogits {
    float* O;
    __device__ __forceinline__ void operator()(const Acc& acc, const UnitD& u, int wr, int wc, int fr, int fq) const { store_f32_tile(acc, O + (size_t)u.t0 * BM * 128, nullptr, 128, 128, wr, wc, fr, fq); }
};
struct EpiSwiGLU {
    unsigned char* O;
    __device__ __forceinline__ void operator()(const Acc& acc, const UnitD& u, int wr, int wc, int fr, int fq) const {
        unsigned char* o = O + (size_t)u.t0 * BM * DEXP + u.t1 * 128;
#pragma unroll
        for (int ai = 0; ai < 2; ++ai)
#pragma unroll
            for (int m = 0; m < 4; ++m) { unsigned char* rowp = o + (size_t)(ai * HALF + wr * 64 + m * 16 + fr) * DEXP + wc * 32 + 8 * fq;
                float r[8];
#pragma unroll
                for (int n = 0; n < 2; ++n)
#pragma unroll
                    for (int j = 0; j < 4; ++j) r[n * 4 + j] = (ACT8_SCALE / W8_SCALE) * siluf_(acc[ai][0][m][n][j] * (1.0f / W8_SCALE)) * acc[ai][1][m][n][j];
                u32x2 w; w.x = pk_fp8x4(r[0], r[1], r[2], r[3]); w.y = pk_fp8x4(r[4], r[5], r[6], r[7]);
                *(u32x2*)rowp = w; }
    }
};
struct EpiDown {
    unsigned char* O;
    __device__ __forceinline__ void operator()(const Acc& acc, const UnitD& u, int wr, int wc, int fr, int fq) const {
        unsigned char* o = O + (size_t)u.t0 * BM * D_ + u.t1 * BM; const float sc = 1.0f / (W8_SCALE * ACT8_SCALE);
#pragma unroll
        for (int ai = 0; ai < 2; ++ai)
#pragma unroll
            for (int m = 0; m < 4; ++m) { unsigned char* rowp = o + (size_t)(ai * HALF + wr * 64 + m * 16 + fr) * D_ + wc * 32 + 8 * fq;
#pragma unroll
                for (int bj = 0; bj < 2; ++bj) { const f32x4 v0 = acc[ai][bj][m][0] * sc, v1 = acc[ai][bj][m][1] * sc;
                    u32x2 w; w.x = pk_fp8x4(v0[0], v0[1], v0[2], v0[3]); w.y = pk_fp8x4(v1[0], v1[1], v1[2], v1[3]); *(u32x2*)(rowp + bj * HALF) = w; } }
    }
};
__device__ __forceinline__ unsigned rg_idx(unsigned tok, int c) { return ((((tok >> 12) * 64u + (unsigned)(c >> 4)) * (unsigned)S_ + (tok & (unsigned)(S_ - 1))) << 4) + (unsigned)(c & 15); }
struct EpiRgGates {
    bf16_t* LAo; bf16_t* Uo; const bf16_t* xc;
    const float* ba; const float* bx; const float* lam;
    __device__ __forceinline__ void operator()(const Acc& acc, const UnitD& u, int wr, int wc, int fr, int fq) const {
#pragma unroll
        for (int n = 0; n < 2; ++n) { const int c = u.t1 * 128 + wc * 32 + 8 * fq + 4 * n;
            const f32x4 vba = *(const f32x4*)(ba + c), vbx = *(const f32x4*)(bx + c), vl = *(const f32x4*)(lam + c);
            f32x4 c8; for (int j = 0; j < 4; ++j) c8[j] = -8.0f * softplusf_(-vl[j]);
#pragma unroll
            for (int ai = 0; ai < 2; ++ai)
#pragma unroll
                for (int m = 0; m < 4; ++m) { const unsigned tok = (unsigned)(u.t0 * BM + ai * HALF + wr * 64 + m * 16 + fr);
                    const u32x2 xw = *(const u32x2*)(xc + (tok * 1024u + (unsigned)c)); const float xv[4] = {bf_lo(xw.x), bf_hi(xw.x), bf_lo(xw.y), bf_hi(xw.y)};
                    f32x4 lv, uv;
#pragma unroll
                    for (int j = 0; j < 4; ++j) { const float r = sigmoidf_(acc[ai][0][m][n][j] + vba[j]), ig = sigmoidf_(acc[ai][1][m][n][j] + vbx[j]);
                        const float la = c8[j] * r, av = __expf(la); lv[j] = la; uv[j] = __builtin_amdgcn_sqrtf(fmaxf(0.f, 1.0f - av * av)) * ig * xv[j]; }
                    const unsigned o = rg_idx(tok, c);
                    u32x2 w0; w0.x = cvt_pk_bf16(lv[0], lv[1]); w0.y = cvt_pk_bf16(lv[2], lv[3]); *(u32x2*)(LAo + o) = w0;
                    u32x2 w1; w1.x = cvt_pk_bf16(uv[0], uv[1]); w1.y = cvt_pk_bf16(uv[2], uv[3]); *(u32x2*)(Uo + o) = w1; } }
    }
};


__device__ __forceinline__ void transpose_job8(const float* src, unsigned char* dst, int K, int N, int ldd, size_t sb, size_t db, int nbatch, LAS unsigned char* lds) {
    LAS float* tile = (LAS float*)lds;
    const int tid = TIDX, tk = K / 128, tn = N / 64, per = tk * tn, total = per * nbatch;
    for (int t = BID; t < total; t += NBLK) {
        const int b = t / per, r = t % per, ik = r / tn, in = r % tn;
        const float* sp = src + (size_t)b * sb + (size_t)(ik * 128) * N + in * 64;
        unsigned char* d = dst + (size_t)b * db + (size_t)(in * 64) * ldd + ik * 128;
#pragma unroll
        for (int i = 0; i < 4; ++i) { const int idx = tid + i * 512, rr = idx >> 4, c4 = (idx & 15) * 4;
            const f32x4 v = *(const f32x4*)(sp + (size_t)rr * N + c4);
            tile[rr * 65 + c4 + 0] = v[0]; tile[rr * 65 + c4 + 1] = v[1]; tile[rr * 65 + c4 + 2] = v[2]; tile[rr * 65 + c4 + 3] = v[3]; }
        __syncthreads();
        { const int n = tid >> 3, kg = (tid & 7) * 16; float f[16];
#pragma unroll
          for (int j = 0; j < 16; ++j) f[j] = tile[(kg + j) * 65 + n] * W8_SCALE;
          u32x4 w; w.x = pk_fp8x4(f[0], f[1], f[2], f[3]); w.y = pk_fp8x4(f[4], f[5], f[6], f[7]); w.z = pk_fp8x4(f[8], f[9], f[10], f[11]); w.w = pk_fp8x4(f[12], f[13], f[14], f[15]);
          *(u32x4*)(d + (size_t)n * ldd + kg) = w; }
        __syncthreads();
    }
}
__device__ __forceinline__ void transpose_job(const float* src, bf16_t* dst, int K, int N, int ldd, size_t sb, size_t db, int dalt, int nbatch, LAS unsigned char* lds) {
    LAS float* tile = (LAS float*)lds;
    const int tid = TIDX, tk = K / 64, tn = N / 64, per = tk * tn, total = per * nbatch;
    for (int t = BID; t < total; t += NBLK) {
        const int b = t / per, r = t % per, ik = r / tn, in = r % tn;
        const float* s = src + (size_t)b * sb + (size_t)(ik * 64) * N + in * 64;
        bf16_t* d = dst + (size_t)b * db + (size_t)(b & 1) * dalt + (size_t)(in * 64) * ldd + ik * 64;
#pragma unroll
        for (int i = 0; i < 2; ++i) { const int idx = tid + i * 512, rr = idx >> 4, c4 = (idx & 15) * 4;
            const f32x4 v = *(const f32x4*)(s + (size_t)rr * N + c4);
            tile[rr * 65 + c4 + 0] = v[0]; tile[rr * 65 + c4 + 1] = v[1]; tile[rr * 65 + c4 + 2] = v[2]; tile[rr * 65 + c4 + 3] = v[3]; }
        __syncthreads();
        { const int n = tid >> 3, kg = (tid & 7) * 8; float f[8];
#pragma unroll
          for (int j = 0; j < 8; ++j) f[j] = tile[(kg + j) * 65 + n];
          u32x4 w; w.x = cvt_pk_bf16(f[0], f[1]); w.y = cvt_pk_bf16(f[2], f[3]); w.z = cvt_pk_bf16(f[4], f[5]); w.w = cvt_pk_bf16(f[6], f[7]);
          *(u32x4*)(d + (size_t)n * ldd + kg) = w; }
        __syncthreads();
    }
}

__device__ __forceinline__ void moe_weight_jobs(const Args& a, int layer, LAS unsigned char* lds) {
    const size_t lo = (size_t)layer * NEXP * D_ * DEXP;
    transpose_job8(a.in[25] + lo, a.ws + WS_WG, D_, DEXP, D_, (size_t)D_ * DEXP, (size_t)DEXP * D_, NEXP, lds);
    transpose_job8(a.in[26] + lo, a.ws + WS_WU, D_, DEXP, D_, (size_t)D_ * DEXP, (size_t)DEXP * D_, NEXP, lds);
    transpose_job8(a.in[27] + lo, a.ws + WS_WD, DEXP, D_, DEXP, (size_t)D_ * DEXP, (size_t)DEXP * D_, NEXP, lds);
}

__device__ __forceinline__ void phase_prologue(const Args& a, LAS unsigned char* lds) {
    const int gtid = BID * NTHREADS + TIDX, gsz = NBLK * NTHREADS;
    for (int i = gtid; i < 1024; i += gsz) { const float l0 = a.in[12][i], l1 = a.in[12][1024 + i], mx = fmaxf(l0, l1), e0 = __expf(l0 - mx), e1 = __expf(l1 - mx);
        ((float*)(a.ws + WS_LB))[i] = e0 / (e0 + e1); }
    for (int it = gtid; it < 2 * 256 * 256; it += gsz) { const int l = it >> 16, n = (it >> 8) & 255, k8 = (it & 255) * 8; float f[8];
#pragma unroll
        for (int j = 0; j < 8; ++j) { const int k = k8 + j; f[j] = n < 8 ? a.in[21][((size_t)l * D_ + k) * 8 + n] : (n < 72 ? a.in[23][((size_t)l * D_ + k) * 64 + (n - 8)] : 0.f); }
        u32x4 w; w.x = cvt_pk_bf16(f[0], f[1]); w.y = cvt_pk_bf16(f[2], f[3]); w.z = cvt_pk_bf16(f[4], f[5]); w.w = cvt_pk_bf16(f[6], f[7]);
        *(u32x4*)((bf16_t*)(a.ws + WS_WRT) + ((size_t)l * 256 + n) * D_ + k8) = w; }
    for (int it = gtid; it < 192 * 128; it += gsz) *(u32x4*)(a.ws + WS_WIN1T + (size_t)N_IN1 * D_ + (size_t)it * 16) = (u32x4){0u, 0u, 0u, 0u};
    transpose_job(a.in[4], (bf16_t*)(a.ws + WS_WIN0T), D_, N_IN0, D_, 0, 0, 0, 1, lds);
    transpose_job(a.in[14], (bf16_t*)(a.ws + WS_WOUT0T), D_, D_, D_, 0, 0, 0, 1, lds);
    transpose_job8(a.in[15], a.ws + WS_WIN1T, D_, N_IN1, D_, 0, 0, 1, lds);
    transpose_job8(a.in[20], a.ws + WS_WOUT1T, 4096, D_, 4096, 0, 0, 1, lds);
    transpose_job(a.in[7], (bf16_t*)(a.ws + WS_WGATES), 128, 128, 128, 128 * 128, 256 * 128, 0, 8, lds);
    transpose_job(a.in[9], (bf16_t*)(a.ws + WS_WGATES) + 128 * 128, 128, 128, 128, 128 * 128, 256 * 128, 0, 8, lds);
    moe_weight_jobs(a, 0, lds);
}

template <int MODE>
__device__ __forceinline__ void phase_norm(const Args& a, const float* src, const float* gain, int layer) {
    const int wid = TIDX >> 6, lane = TIDX & 63;
    bf16_t* xw = (bf16_t*)(a.ws + WS_X); bf16_t* hw = (bf16_t*)(a.ws + WS_H);
    const unsigned char* ym = a.ws + WS_YMOE; const int* posof = (const int*)(a.ws + WS_POSOF); const float* gate = (const float*)(a.ws + WS_GATE);
    for (int row = BID * 8 + wid; row < T_; row += NBLK * 8) {
        f32x4 v[8];
#pragma unroll
        for (int i = 0; i < 8; ++i) { if (src) v[i] = *(const f32x4*)(src + (size_t)row * D_ + (i * 64 + lane) * 4);
            else { const u32x2 r = *(const u32x2*)(xw + (size_t)row * D_ + (i * 64 + lane) * 4); v[i] = (f32x4){bf_lo(r.x), bf_hi(r.x), bf_lo(r.y), bf_hi(r.y)}; } }
        if (MODE >= 1) {
            const int p0 = posof[row * 2], p1 = posof[row * 2 + 1]; const float g0 = gate[row * 2], g1 = gate[row * 2 + 1];
#pragma unroll
            for (int i = 0; i < 8; ++i) { const int c = (i * 64 + lane) * 4;
                const int y0 = *(const int*)(ym + (size_t)p0 * D_ + c), y1 = *(const int*)(ym + (size_t)p1 * D_ + c);
                const f32x2 a0 = __builtin_amdgcn_cvt_pk_f32_fp8(y0, false), a1 = __builtin_amdgcn_cvt_pk_f32_fp8(y0, true), b0 = __builtin_amdgcn_cvt_pk_f32_fp8(y1, false), b1 = __builtin_amdgcn_cvt_pk_f32_fp8(y1, true);
                v[i][0] += g0 * a0[0] + g1 * b0[0]; v[i][1] += g0 * a0[1] + g1 * b0[1]; v[i][2] += g0 * a1[0] + g1 * b1[0]; v[i][3] += g0 * a1[1] + g1 * b1[1]; }
            if (MODE == 1) {
#pragma unroll
                for (int i = 0; i < 8; ++i) { u32x2 w; w.x = cvt_pk_bf16(v[i][0], v[i][1]); w.y = cvt_pk_bf16(v[i][2], v[i][3]); *(u32x2*)(xw + (size_t)row * D_ + (i * 64 + lane) * 4) = w; } }
        }
        float ss = 0.f;
#pragma unroll
        for (int i = 0; i < 8; ++i) ss += v[i][0] * v[i][0] + v[i][1] * v[i][1] + v[i][2] * v[i][2] + v[i][3] * v[i][3];
        ss = wave_sum(ss);
        const float rstd = rsqrtf(ss * (1.0f / D_) + 1e-6f);
#pragma unroll
        for (int i = 0; i < 8; ++i) { const int c = (i * 64 + lane) * 4; const f32x4 g = *(const f32x4*)(gain + c);
            const f32x4 o = v[i] * rstd * g;
            if (MODE == 2) *(f32x4*)(a.out + (size_t)row * D_ + c) = o;
            else { if (MODE != 1) { u32x2 w; w.x = cvt_pk_bf16(o[0], o[1]); w.y = cvt_pk_bf16(o[2], o[3]); *(u32x2*)(hw + (size_t)row * D_ + c) = w; }
                   if (layer >= 0) *(unsigned*)(a.ws + WS_H8 + (size_t)row * D_ + c) = pk_fp8x4(o[0], o[1], o[2], o[3]); } }
    }
    (void)layer;
}

__device__ __forceinline__ void phase_gemm_in0(const Args& a, LAS unsigned char* lds) {
    SrcGrid S{(const char*)(a.ws + WS_H), (const char*)(a.ws + WS_WIN0T), (size_t)BM * D_ * 2, (size_t)BM * D_ * 2, 64, 64 * 24, D_, D_};
    EpiProj E{(bf16_t*)(a.ws + WS_PROJ), N_IN0, (float*)(a.ws + WS_FLOG), 1024, 12, 16, 256, 1.0f};
    gemm_stream<false, false>(lds, S, D_ / BK, E);
}

__device__ __forceinline__ void phase_rg_conv(const Args& a) {
    const bf16_t* p0 = (const bf16_t*)(a.ws + WS_PROJ); bf16_t* xc = (bf16_t*)(a.ws + WS_XC);
    const float* cw = a.in[5]; const float* cb = a.in[6];
    for (int it = BID * NTHREADS + TIDX; it < 128 * (T_ / 16); it += NBLK * NTHREADS) { const int c = (it & 127) * 8; const size_t t0 = (size_t)(it >> 7) * 16;
        float w[4][8], bias[8];
#pragma unroll
        for (int k = 0; k < 4; ++k) { const f32x4 w0 = *(const f32x4*)(cw + k * 1024 + c), w1 = *(const f32x4*)(cw + k * 1024 + c + 4);
            w[k][0] = w0[0]; w[k][1] = w0[1]; w[k][2] = w0[2]; w[k][3] = w0[3]; w[k][4] = w1[0]; w[k][5] = w1[1]; w[k][6] = w1[2]; w[k][7] = w1[3]; }
        { const f32x4 b0 = *(const f32x4*)(cb + c), b1 = *(const f32x4*)(cb + c + 4); bias[0] = b0[0]; bias[1] = b0[1]; bias[2] = b0[2]; bias[3] = b0[3]; bias[4] = b1[0]; bias[5] = b1[1]; bias[6] = b1[2]; bias[7] = b1[3]; }
        u32x4 x0 = (u32x4){0u, 0u, 0u, 0u}, x1 = x0, x2 = x0;
        if ((t0 & (S_ - 1)) != 0) { x0 = *(const u32x4*)(p0 + (t0 - 3) * N_IN0 + c); x1 = *(const u32x4*)(p0 + (t0 - 2) * N_IN0 + c); x2 = *(const u32x4*)(p0 + (t0 - 1) * N_IN0 + c); }
#pragma unroll 4
        for (int r = 0; r < 16; ++r) { const u32x4 x3 = *(const u32x4*)(p0 + (t0 + r) * N_IN0 + c);
            float acc[8];
#define TAPS(j, f, m) (bias[j] + w[0][j] * f(x0.m) + w[1][j] * f(x1.m) + w[2][j] * f(x2.m) + w[3][j] * f(x3.m))
            acc[0] = TAPS(0, bf_lo, x); acc[1] = TAPS(1, bf_hi, x); acc[2] = TAPS(2, bf_lo, y); acc[3] = TAPS(3, bf_hi, y);
            acc[4] = TAPS(4, bf_lo, z); acc[5] = TAPS(5, bf_hi, z); acc[6] = TAPS(6, bf_lo, w); acc[7] = TAPS(7, bf_hi, w);
#undef TAPS
            u32x4 o; o.x = cvt_pk_bf16(acc[0], acc[1]); o.y = cvt_pk_bf16(acc[2], acc[3]); o.z = cvt_pk_bf16(acc[4], acc[5]); o.w = cvt_pk_bf16(acc[6], acc[7]);
            *(u32x4*)(xc + (t0 + r) * 1024 + c) = o;
            x0 = x1; x1 = x2; x2 = x3; } }
}

struct SrcRgGates {
    const char* xc; const char* w; int total;
    __device__ __forceinline__ bool next(int i, UnitD& u) const { const int id = BID + i * NBLK; if (id >= total) return false; u.t0 = id & 63; u.t1 = id >> 6; u.t2 = 0;
        u.gA = xc + ((size_t)u.t0 * BM * 1024 + u.t1 * 128) * 2; u.gB = w + (size_t)u.t1 * 256 * 128 * 2; return true; }
    __device__ __forceinline__ void va(const UnitD&, unsigned (&v)[2][2]) const { offs_direct(v, 1024, false); }
    __device__ __forceinline__ void vb(unsigned (&v)[2][2]) const { offs_direct(v, 128, true); }
};
__device__ __forceinline__ void phase_rg_gates(const Args& a, LAS unsigned char* lds) {
    SrcRgGates S{(const char*)(a.ws + WS_XC), (const char*)(a.ws + WS_WGATES), 64 * 8};
    EpiRgGates E{(bf16_t*)(a.ws + WS_A), (bf16_t*)(a.ws + WS_U), (const bf16_t*)(a.ws + WS_XC), a.in[8], a.in[10], a.in[11]};
    int nt = 2; asm volatile("" : "+s"(nt));
    gemm_stream<false, false>(lds, S, nt, E);
}

__device__ __forceinline__ void phase_rg_scan(const Args& a, LAS unsigned char* lds) {
    const bf16_t* LA = (const bf16_t*)(a.ws + WS_A); const bf16_t* U = (const bf16_t*)(a.ws + WS_U);
    const bf16_t* p0 = (const bf16_t*)(a.ws + WS_PROJ); bf16_t* Y = (bf16_t*)(a.ws + WS_Y);
    LAS float* sP = (LAS float*)lds; LAS float* sH = sP + 4096; LAS float* gP = sH + 4096; LAS float* gH = gP + 512; LAS float* gC = gH + 512;
    const int tid = TIDX, seg = tid >> 1, c8 = (tid & 1) * 8;
    for (int blk = BID; blk < NB_ * 64; blk += NBLK) { const int b = blk >> 6, c = (blk & 63) * 16 + c8;
        const size_t base = (((size_t)blk * S_ + seg * 16) << 4) + c8;
        float P[8], H[8];
#pragma unroll
        for (int j = 0; j < 8; ++j) { P[j] = 1.f; H[j] = 0.f; }
#pragma unroll 4
        for (int s = 0; s < 16; ++s) { const u32x4 lw = *(const u32x4*)(LA + base + (size_t)s * 16), uw = *(const u32x4*)(U + base + (size_t)s * 16);
            const float la[8] = {bf_lo(lw.x), bf_hi(lw.x), bf_lo(lw.y), bf_hi(lw.y), bf_lo(lw.z), bf_hi(lw.z), bf_lo(lw.w), bf_hi(lw.w)};
            const float uu[8] = {bf_lo(uw.x), bf_hi(uw.x), bf_lo(uw.y), bf_hi(uw.y), bf_lo(uw.z), bf_hi(uw.z), bf_lo(uw.w), bf_hi(uw.w)};
#pragma unroll
            for (int j = 0; j < 8; ++j) { const float av = __expf(la[j]); H[j] = av * H[j] + uu[j]; P[j] *= av; } }
        __syncthreads();
#pragma unroll
        for (int j = 0; j < 8; ++j) { sP[seg * 16 + c8 + j] = P[j]; sH[seg * 16 + c8 + j] = H[j]; }
        __syncthreads();
        { const int ch = tid & 15, grp = tid >> 4; float p = 1.f, h = 0.f;
#pragma unroll
          for (int q = 0; q < 8; ++q) { const int sgi = grp * 8 + q; h = sP[sgi * 16 + ch] * h + sH[sgi * 16 + ch]; p *= sP[sgi * 16 + ch]; }
          gP[grp * 16 + ch] = p; gH[grp * 16 + ch] = h; }
        __syncthreads();
        if (tid < 16) { float carry = 0.f; for (int g = 0; g < 32; ++g) { gC[g * 16 + tid] = carry; carry = gP[g * 16 + tid] * carry + gH[g * 16 + tid]; } }
        __syncthreads();
        { const int ch = tid & 15, grp = tid >> 4; float h = gC[grp * 16 + ch];
#pragma unroll
          for (int q = 0; q < 8; ++q) { const int sgi = grp * 8 + q; const float pin = sP[sgi * 16 + ch], hin = sH[sgi * 16 + ch]; sH[sgi * 16 + ch] = h; h = pin * h + hin; } }
        __syncthreads();
#pragma unroll
        for (int j = 0; j < 8; ++j) H[j] = sH[seg * 16 + c8 + j];
#pragma unroll 4
        for (int s = 0; s < 16; ++s) { const u32x4 lw = *(const u32x4*)(LA + base + (size_t)s * 16), uw = *(const u32x4*)(U + base + (size_t)s * 16);
            const size_t t = (size_t)b * S_ + seg * 16 + s; const u32x4 gw = *(const u32x4*)(p0 + t * N_IN0 + 1024 + c);
            const float la[8] = {bf_lo(lw.x), bf_hi(lw.x), bf_lo(lw.y), bf_hi(lw.y), bf_lo(lw.z), bf_hi(lw.z), bf_lo(lw.w), bf_hi(lw.w)};
            const float uu[8] = {bf_lo(uw.x), bf_hi(uw.x), bf_lo(uw.y), bf_hi(uw.y), bf_lo(uw.z), bf_hi(uw.z), bf_lo(uw.w), bf_hi(uw.w)};
            const float gg[8] = {bf_lo(gw.x), bf_hi(gw.x), bf_lo(gw.y), bf_hi(gw.y), bf_lo(gw.z), bf_hi(gw.z), bf_lo(gw.w), bf_hi(gw.w)};
            float y[8];
#pragma unroll
            for (int j = 0; j < 8; ++j) { H[j] = __expf(la[j]) * H[j] + uu[j]; y[j] = H[j] * gelu_tanh(gg[j]); }
            u32x4 o; o.x = cvt_pk_bf16(y[0], y[1]); o.y = cvt_pk_bf16(y[2], y[3]); o.z = cvt_pk_bf16(y[4], y[5]); o.w = cvt_pk_bf16(y[6], y[7]);
            *(u32x4*)(Y + t * D_ + c) = o; }
    }
}

typedef short s16x4 __attribute__((ext_vector_type(4)));
__device__ __forceinline__ f32x4 mfma32(bf16x8 a, bf16x8 b, f32x4 c) { return __builtin_amdgcn_mfma_f32_16x16x32_bf16(a, b, c, 0, 0, 0); }
__device__ __forceinline__ bf16x8 lds_frag(LAS const unsigned char* p) { return *(const LAS bf16x8*)p; }
__device__ __forceinline__ s16x4 lds_tr4(LAS const unsigned char* p) { return __builtin_amdgcn_ds_read_tr16_b64_v4i16((LAS s16x4*)p); }
__device__ __forceinline__ bf16x8 lds_tr8(LAS const unsigned char* p, int rowskip_bytes) {
    const s16x4 lo = lds_tr4(p), hi = lds_tr4(p + rowskip_bytes); return __builtin_shufflevector(lo, hi, 0, 1, 2, 3, 4, 5, 6, 7); }
__device__ __forceinline__ bf16x8 pack8(const f32x4& lo, const f32x4& hi) { u32x4 w; w.x = cvt_pk_bf16(lo[0], lo[1]); w.y = cvt_pk_bf16(lo[2], lo[3]); w.z = cvt_pk_bf16(hi[0], hi[1]); w.w = cvt_pk_bf16(hi[2], hi[3]); return __builtin_bit_cast(bf16x8, w); }
constexpr int RSB = 272;

constexpr size_t WS_HQ = WS_O;
constexpr size_t WS_HA = WS_HQ + (size_t)2048 * 64 * 128 * 2;
constexpr size_t WS_HG = WS_HA + (size_t)2048 * 8 * 512 * 2;
constexpr size_t WS_HS = WS_HG + (size_t)2048 * 128 * 128 * 2;
constexpr size_t WS_HD = WS_HS + (size_t)2048 * 128 * 128 * 2;
static_assert(WS_HD + (size_t)2048 * 128 * 4 <= WS_TAIL, "hgrn overlay");

__device__ __forceinline__ void phase_hg1(const Args& a, LAS unsigned char* lds) {
    const bf16_t* p0 = (const bf16_t*)(a.ws + WS_PROJ); const float* flog = (const float*)(a.ws + WS_FLOG); const float* lb = (const float*)(a.ws + WS_LB);
    bf16_t* QG = (bf16_t*)(a.ws + WS_HQ); bf16_t* AG = (bf16_t*)(a.ws + WS_HA); bf16_t* GG = (bf16_t*)(a.ws + WS_HG); float* DG = (float*)(a.ws + WS_HD);
    constexpr int SEG = 0, QT = 4096, KT = QT + 64 * RSB, KH = KT + 64 * RSB, VS = KH + 64 * RSB;
    const int tid = TIDX, wid = tid >> 6, lane = tid & 63, I = lane & 15, G = lane >> 4, k2 = 2 * lane, sg = wid;
    LAS float* seg = (LAS float*)(lds + SEG);
    u32x4 pvv[2]; f32x2 pz[8]; unsigned pqw[8];
#define HG1_LOAD(it_) do { const int bh_ = (it_) >> 6, ck_ = (it_) & 63, h_ = bh_ & 7; const size_t t0_ = (size_t)(bh_ >> 3) * S_ + ck_ * 64; \
        _Pragma("unroll") for (int i = 0; i < 2; ++i) { const int c = tid + i * 512, s_ = c >> 4, v8 = (c & 15) * 8; pvv[i] = *(const u32x4*)(p0 + (t0_ + s_) * N_IN0 + 4096 + h_ * 128 + v8); } \
        _Pragma("unroll") for (int i = 0; i < 8; ++i) { const size_t t_ = t0_ + sg * 8 + i; pz[i] = *(const f32x2*)(flog + t_ * 1024 + h_ * 128 + k2); pqw[i] = *(const unsigned*)(p0 + t_ * N_IN0 + 2048 + h_ * 128 + k2); } } while (0)
    if (BID < 2048) HG1_LOAD(BID);
    for (int item = BID; item < 2048; item += NBLK) { const int bh = item >> 6, h = bh & 7;
        LDS_BARRIER();
#pragma unroll
        for (int i = 0; i < 2; ++i) { const int c = tid + i * 512, s = c >> 4, v8 = (c & 15) * 8; *(LAS u32x4*)(lds + VS + s * RSB + v8 * 2) = pvv[i]; }
        const f32x2 l2 = *(const f32x2*)(lb + h * 128 + k2);
        float f[8][2], cb[8][2]; unsigned qw[8]; float c0 = 0.f, c1 = 0.f;
#pragma unroll
        for (int i = 0; i < 8; ++i) { const f32x2 z = pz[i]; qw[i] = pqw[i];
            f[i][0] = l2[0] + (1.0f - l2[0]) * sigmoidf_(z[0]); f[i][1] = l2[1] + (1.0f - l2[1]) * sigmoidf_(z[1]);
            c0 += __logf(f[i][0]); c1 += __logf(f[i][1]); cb[i][0] = c0; cb[i][1] = c1; }
        *(LAS f32x2*)(seg + sg * 128 + k2) = (f32x2){c0, c1};
        if (item + NBLK < 2048) HG1_LOAD(item + NBLK);
        LDS_BARRIER();
        float off0 = 0.f, off1 = 0.f, tot0 = 0.f, tot1 = 0.f;
#pragma unroll
        for (int s2 = 0; s2 < 8; ++s2) { const f32x2 v = *(const LAS f32x2*)(seg + s2 * 128 + k2); tot0 += v[0]; tot1 += v[1]; if (s2 < sg) { off0 += v[0]; off1 += v[1]; } }
        const float et0 = __expf(tot0), et1 = __expf(tot1);
#pragma unroll
        for (int i = 0; i < 8; ++i) { const int t = sg * 8 + i;
            const float e0 = __expf(cb[i][0] + off0), e1 = __expf(cb[i][1] + off1), r0 = __builtin_amdgcn_rcpf(e0), r1 = __builtin_amdgcn_rcpf(e1), km0 = 1.0f - f[i][0], km1 = 1.0f - f[i][1];
            const unsigned qt = cvt_pk_bf16(siluf_(bf_lo(qw[i])) * e0, siluf_(bf_hi(qw[i])) * e1);
            *(LAS unsigned*)(lds + QT + t * RSB + k2 * 2) = qt; *(unsigned*)(QG + ((size_t)item * 64 + t) * 128 + k2) = qt;
            *(LAS unsigned*)(lds + KT + t * RSB + k2 * 2) = cvt_pk_bf16(km0 * r0, km1 * r1);
            *(LAS unsigned*)(lds + KH + t * RSB + k2 * 2) = cvt_pk_bf16(km0 * r0 * et0, km1 * r1 * et1); }
        if (sg == 0) *(f32x2*)(DG + (size_t)item * 128 + k2) = (f32x2){et0, et1};
        LDS_BARRIER();
        { const int tt = wid & 3, sp = wid >> 2;
          bf16x8 qf[4];
#pragma unroll
          for (int ks = 0; ks < 4; ++ks) qf[ks] = lds_frag(lds + QT + (16 * tt + I) * RSB + (32 * ks + 8 * G) * 2);
          f32x4 acc[2];
#pragma unroll
          for (int hh = 0; hh < 2; ++hh) { const int st = 2 * sp + hh; acc[hh] = (f32x4){0.f, 0.f, 0.f, 0.f};
              if (st <= tt) {
#pragma unroll
                  for (int ks = 0; ks < 4; ++ks) acc[hh] = mfma32(lds_frag(lds + KT + (16 * st + I) * RSB + (32 * ks + 8 * G) * 2), qf[ks], acc[hh]);
#pragma unroll
                  for (int r = 0; r < 4; ++r) if (16 * st + 4 * G + r > 16 * tt + I) acc[hh][r] = 0.f; } }
          *(bf16x8*)(AG + (((size_t)item * 4 + tt) * 2 + sp) * 512 + lane * 8) = pack8(acc[0], acc[1]); }
        { const int kt = wid, q = I >> 2, p = I & 3;
          bf16x8 ka[2];
#pragma unroll
          for (int ks = 0; ks < 2; ++ks) ka[ks] = lds_tr8(lds + KH + (32 * ks + 8 * G + q) * RSB + (16 * kt + 4 * p) * 2, 4 * RSB);
#pragma unroll
          for (int vt = 0; vt < 8; ++vt) { f32x4 acc = (f32x4){0.f, 0.f, 0.f, 0.f};
#pragma unroll
              for (int ks = 0; ks < 2; ++ks) acc = mfma32(ka[ks], lds_tr8(lds + VS + (32 * ks + 8 * G + q) * RSB + (16 * vt + 4 * p) * 2, 4 * RSB), acc);
              u32x2 w; w.x = cvt_pk_bf16(acc[0], acc[1]); w.y = cvt_pk_bf16(acc[2], acc[3]);
              *(u32x2*)(GG + ((size_t)item * 128 + 16 * vt + I) * 128 + 16 * kt + 4 * G) = w; } }
    }
#undef HG1_LOAD
}

__device__ __forceinline__ void phase_hg2(const Args& a) {
    const bf16_t* GG = (const bf16_t*)(a.ws + WS_HG); const float* DG = (const float*)(a.ws + WS_HD); bf16_t* SG = (bf16_t*)(a.ws + WS_HS);
    for (int gid = BID * NTHREADS + TIDX; gid < 32 * 4096; gid += NBLK * NTHREADS) { const int bh = gid >> 12, e = gid & 4095, v = e >> 5, k4 = (e & 31) * 4;
        f32x4 S = (f32x4){0.f, 0.f, 0.f, 0.f};
        for (int n = 0; n < 64; ++n) { const size_t item = (size_t)bh * 64 + n, o = (item * 128 + v) * 128 + k4;
            u32x2 w; w.x = cvt_pk_bf16(S[0], S[1]); w.y = cvt_pk_bf16(S[2], S[3]); *(u32x2*)(SG + o) = w;
            const f32x4 d = *(const f32x4*)(DG + item * 128 + k4); const u32x2 g = *(const u32x2*)(GG + o);
            S[0] = d[0] * S[0] + bf_lo(g.x); S[1] = d[1] * S[1] + bf_hi(g.x); S[2] = d[2] * S[2] + bf_lo(g.y); S[3] = d[3] * S[3] + bf_hi(g.y); } }
}

__device__ __forceinline__ void phase_hg3(const Args& a, LAS unsigned char* lds) {
    const bf16_t* p0 = (const bf16_t*)(a.ws + WS_PROJ); const bf16_t* QG = (const bf16_t*)(a.ws + WS_HQ); const bf16_t* AG = (const bf16_t*)(a.ws + WS_HA); const bf16_t* SG = (const bf16_t*)(a.ws + WS_HS);
    bf16_t* Y = (bf16_t*)(a.ws + WS_Y); const float* gain = a.in[13];
    constexpr int ST = 0, QT = 128 * RSB, VS = QT + 64 * RSB, PART = VS + 64 * RSB;
    const int tid = TIDX, wid = tid >> 6, lane = tid & 63, I = lane & 15, G = lane >> 4, q = I >> 2, p = I & 3;
    LAS float* part = (LAS float*)(lds + PART);
    const int tt = wid & 3, vh = wid >> 2;
    u32x4 ps[4], pq2[2], pv2[2]; bf16x8 paf[2];
#define HG3_LOAD(it_) do { const int bh_ = (it_) >> 6, ck_ = (it_) & 63; const size_t t0_ = (size_t)(bh_ >> 3) * S_ + ck_ * 64; const int h_ = bh_ & 7; \
        _Pragma("unroll") for (int i = 0; i < 4; ++i) { const int c = tid + i * 512, v = c >> 4, k8 = (c & 15) * 8; ps[i] = *(const u32x4*)(SG + ((size_t)(it_) * 128 + v) * 128 + k8); } \
        _Pragma("unroll") for (int i = 0; i < 2; ++i) { const int c = tid + i * 512, s_ = c >> 4, c8 = (c & 15) * 8; pq2[i] = *(const u32x4*)(QG + ((size_t)(it_) * 64 + s_) * 128 + c8); pv2[i] = *(const u32x4*)(p0 + (t0_ + s_) * N_IN0 + 4096 + h_ * 128 + c8); } \
        _Pragma("unroll") for (int sp = 0; sp < 2; ++sp) paf[sp] = *(const bf16x8*)(AG + (((size_t)(it_) * 4 + tt) * 2 + sp) * 512 + lane * 8); } while (0)
    if (BID < 2048) HG3_LOAD(BID);
    for (int item = BID; item < 2048; item += NBLK) { const int bh = item >> 6, ck = item & 63, b = bh >> 3, h = bh & 7; const size_t t0 = (size_t)b * S_ + ck * 64;
        LDS_BARRIER();
#pragma unroll
        for (int i = 0; i < 4; ++i) { const int c = tid + i * 512, v = c >> 4, k8 = (c & 15) * 8; *(LAS u32x4*)(lds + ST + v * RSB + k8 * 2) = ps[i]; }
#pragma unroll
        for (int i = 0; i < 2; ++i) { const int c = tid + i * 512, s2 = c >> 4, c8 = (c & 15) * 8; *(LAS u32x4*)(lds + QT + s2 * RSB + c8 * 2) = pq2[i]; *(LAS u32x4*)(lds + VS + s2 * RSB + c8 * 2) = pv2[i]; }
        bf16x8 af[2]; af[0] = paf[0]; af[1] = paf[1];
        if (item + NBLK < 2048) HG3_LOAD(item + NBLK);
        u32x2 zwp[4];
#pragma unroll
        for (int vi = 0; vi < 4; ++vi) zwp[vi] = *(const u32x2*)(p0 + (t0 + 16 * tt + I) * N_IN0 + 5120 + h * 128 + 16 * (4 * vh + vi) + 4 * G);
        LDS_BARRIER();
        bf16x8 qf[4];
#pragma unroll
        for (int ks = 0; ks < 4; ++ks) qf[ks] = lds_frag(lds + QT + (16 * tt + I) * RSB + (32 * ks + 8 * G) * 2);
        f32x4 acc[4]; float ss = 0.f;
#pragma unroll
        for (int vi = 0; vi < 4; ++vi) { const int vt = 4 * vh + vi; acc[vi] = (f32x4){0.f, 0.f, 0.f, 0.f};
#pragma unroll
            for (int ks = 0; ks < 4; ++ks) acc[vi] = mfma32(lds_frag(lds + ST + (16 * vt + I) * RSB + (32 * ks + 8 * G) * 2), qf[ks], acc[vi]);
#pragma unroll
            for (int sp = 0; sp < 2; ++sp) acc[vi] = mfma32(lds_tr8(lds + VS + (32 * sp + 4 * G + q) * RSB + (16 * vt + 4 * p) * 2, 16 * RSB), af[sp], acc[vi]);
            ss += acc[vi][0] * acc[vi][0] + acc[vi][1] * acc[vi][1] + acc[vi][2] * acc[vi][2] + acc[vi][3] * acc[vi][3]; }
        ss += __shfl_xor(ss, 16); ss += __shfl_xor(ss, 32);
        if (G == 0) part[wid * 16 + I] = ss;
        LDS_BARRIER();
        const float rstd = rsqrtf((part[wid * 16 + I] + part[(wid ^ 4) * 16 + I]) * (1.0f / 128.0f) + 1e-6f);
        const size_t t = t0 + 16 * tt + I;
#pragma unroll
        for (int vi = 0; vi < 4; ++vi) { const int c = h * 128 + 16 * (4 * vh + vi) + 4 * G;
            const f32x4 gn = *(const f32x4*)(gain + c); const u32x2 zw = zwp[vi];
            const float o0 = acc[vi][0] * rstd * gn[0] * siluf_(bf_lo(zw.x)), o1 = acc[vi][1] * rstd * gn[1] * siluf_(bf_hi(zw.x)), o2 = acc[vi][2] * rstd * gn[2] * siluf_(bf_lo(zw.y)), o3 = acc[vi][3] * rstd * gn[3] * siluf_(bf_hi(zw.y));
            u32x2 w; w.x = cvt_pk_bf16(o0, o1); w.y = cvt_pk_bf16(o2, o3); *(u32x2*)(Y + t * D_ + 1024 + c) = w; }
    }
#undef HG3_LOAD
}

__device__ __forceinline__ void phase_gdn_norm(const Args& a) {
    const bf16_t* O = (const bf16_t*)(a.ws + WS_O); const bf16_t* pj = (const bf16_t*)(a.ws + WS_PROJ); unsigned char* Y = a.ws + WS_Y; const float* gain = a.in[19];
    const int lane = TIDX & 63, wid = TIDX >> 6, gc = (lane & 15) * 8;
    const f32x4 g0 = *(const f32x4*)(gain + gc), g1 = *(const f32x4*)(gain + gc + 4);
    for (int row = BID * 8 + wid; row < T_; row += NBLK * 8) {
#pragma unroll 4
        for (int i = 0; i < 8; ++i) { const int c = (i * 64 + lane) * 8;
            const u32x4 ow = *(const u32x4*)(O + (size_t)row * 4096 + c), zw = *(const u32x4*)(pj + (size_t)row * N_IN1P + 8192 + c);
            const float o[8] = {bf_lo(ow.x), bf_hi(ow.x), bf_lo(ow.y), bf_hi(ow.y), bf_lo(ow.z), bf_hi(ow.z), bf_lo(ow.w), bf_hi(ow.w)};
            const float z[8] = {bf_lo(zw.x), bf_hi(zw.x), bf_lo(zw.y), bf_hi(zw.y), bf_lo(zw.z), bf_hi(zw.z), bf_lo(zw.w), bf_hi(zw.w)};
            float ss = 0.f;
#pragma unroll
            for (int q = 0; q < 8; ++q) ss += o[q] * o[q];
            ss = row16_sum(ss);
            const float rstd = rsqrtf(ss * (1.0f / 128.0f) + 1e-6f);
            float y[8];
#pragma unroll
            for (int q = 0; q < 8; ++q) y[q] = o[q] * rstd * (q < 4 ? g0[q & 3] : g1[q & 3]) * siluf_(z[q]);
            u32x2 w; w.x = pk_fp8x4(y[0], y[1], y[2], y[3]); w.y = pk_fp8x4(y[4], y[5], y[6], y[7]);
            *(u32x2*)(Y + (size_t)row * 4096 + c) = w; }
    }
}

template <bool FP8>
__device__ __forceinline__ void phase_gemm_out(const Args& a, LAS unsigned char* lds, int K, const void* w, const float* xin) {
    const int eb = FP8 ? 1 : 2;
    SrcGrid S{(const char*)(a.ws + WS_Y), (const char*)w, (size_t)BM * K * eb, (size_t)BM * K * eb, 64, 64 * 8, K * eb / 2, K * eb / 2};
    EpiResid E{(bf16_t*)(a.ws + WS_X), xin, (const bf16_t*)(a.ws + WS_X), FP8 ? 1.0f / W8_SCALE : 1.0f};
    gemm_stream<false, FP8>(lds, S, K * eb / 128, E);
}

struct SrcRouter {
    const char* h; const char* w;
    __device__ __forceinline__ bool next(int i, UnitD& u) const { const int id = BID + i * NBLK; if (id >= 256) return false; u.t0 = id & 63; u.t1 = id >> 6; u.t2 = 0;
        u.gA = h + ((size_t)u.t0 * BM * D_ + u.t1 * 512) * 2; u.gB = w + (size_t)u.t1 * 512 * 2; return true; }
    __device__ __forceinline__ void va(const UnitD&, unsigned (&v)[2][2]) const { offs_direct(v, D_, false); }
    __device__ __forceinline__ void vb(unsigned (&v)[2][2]) const { offs_direct(v, D_, true); }
};
struct EpiLogitsQ {
    float* O;
    __device__ __forceinline__ void operator()(const Acc& acc, const UnitD& u, int wr, int wc, int fr, int fq) const { store_f32_tile(acc, O + ((size_t)u.t1 * T_ + (size_t)u.t0 * BM) * 128, nullptr, 128, 128, wr, wc, fr, fq); }
};
__device__ __forceinline__ void phase_gemm_router(const Args& a, LAS unsigned char* lds, int layer) {
    SrcRouter S{(const char*)(a.ws + WS_H), (const char*)(a.ws + WS_WRT) + (size_t)layer * 256 * D_ * 2};
    EpiLogitsQ E{(float*)(a.ws + WS_O)};
    gemm_stream<false, false>(lds, S, 512 / BK, E);
}

__device__ __forceinline__ void phase_route(const Args& a, int layer) {
    const float* lg = (const float*)(a.ws + WS_O); const float* bg = a.in[22] + layer * 8; const float* be = a.in[24] + layer * 64;
    int* cnt = (int*)(a.ws + WS_CTL + CTL_CNT) + layer * 64;
    int* eid = (int*)(a.ws + WS_EID); int* slot = (int*)(a.ws + WS_SLOT); float* gate = (float*)(a.ws + WS_GATE); int* rowmap = (int*)(a.ws + WS_ROWMAP);
    const int gtid = BID * NTHREADS + TIDX, gsz = NBLK * NTHREADS;
    for (int i = gtid; i < MPAD; i += gsz) rowmap[i] = 0;
    for (int t = gtid; t < T_; t += gsz) {
        f32x4 ga = (f32x4){0.f, 0.f, 0.f, 0.f}, gb = ga;
#pragma unroll
        for (int kq = 0; kq < 4; ++kq) { ga += *(const f32x4*)(lg + ((size_t)kq * T_ + t) * 128); gb += *(const f32x4*)(lg + ((size_t)kq * T_ + t) * 128 + 4); }
        const float gl[8] = {ga[0] + bg[0], ga[1] + bg[1], ga[2] + bg[2], ga[3] + bg[3], gb[0] + bg[4], gb[1] + bg[5], gb[2] + bg[6], gb[3] + bg[7]};
        float mx = -3.0e38f; int gi = 0;
#pragma unroll
        for (int j = 0; j < 8; ++j) if (gl[j] > mx) { mx = gl[j]; gi = j; }
        float se = 0.f;
#pragma unroll
        for (int j = 0; j < 8; ++j) se += __expf(gl[j] - mx);
        const float gp = 1.0f / se;
        f32x4 ea = *(const f32x4*)(be + gi * 8), eb = *(const f32x4*)(be + gi * 8 + 4);
#pragma unroll
        for (int kq = 0; kq < 4; ++kq) { ea += *(const f32x4*)(lg + ((size_t)kq * T_ + t) * 128 + 8 + gi * 8); eb += *(const f32x4*)(lg + ((size_t)kq * T_ + t) * 128 + 12 + gi * 8); }
        const float el[8] = {ea[0], ea[1], ea[2], ea[3], eb[0], eb[1], eb[2], eb[3]};
        float l1 = -3.0e38f, l2 = -3.0e38f; int i1 = 0, i2 = 0;
#pragma unroll
        for (int j = 0; j < 8; ++j) { const float v = el[j];
            if (v > l1) { l2 = l1; i2 = i1; l1 = v; i1 = j; } else if (v > l2) { l2 = v; i2 = j; } }
        const float e2 = __expf(l2 - l1), inv = 1.0f / (1.0f + e2);
        const int e0 = gi * 8 + i1, e1 = gi * 8 + i2;
        eid[t * 2] = e0; eid[t * 2 + 1] = e1; gate[t * 2] = inv * gp; gate[t * 2 + 1] = e2 * inv * gp;
        slot[t * 2] = atomicAdd(&cnt[e0], 1); slot[t * 2 + 1] = atomicAdd(&cnt[e1], 1); }
}

__device__ __forceinline__ void phase_rowmap(const Args& a, LAS unsigned char* lds, int layer) {
    const int* cnt = (const int*)(a.ws + WS_CTL + CTL_CNT) + layer * 64; LAS int* ps = (LAS int*)lds;
    int* tinfo = (int*)(a.ws + WS_TINFO) + layer * 512;
    const int* eid = (const int*)(a.ws + WS_EID); const int* slot = (const int*)(a.ws + WS_SLOT); int* posof = (int*)(a.ws + WS_POSOF); int* rowmap = (int*)(a.ws + WS_ROWMAP);
    __syncthreads();
    if (TIDX == 0) { int acc = 0; for (int e = 0; e < 64; ++e) { ps[e] = acc; acc += (cnt[e] + 255) & ~255; } ps[64] = acc; }
    __syncthreads();
    if (BID == 0) { if (TIDX <= 64) tinfo[TIDX] = ps[TIDX]; if (TIDX == 65) tinfo[65] = ps[64] >> 8;
        if (TIDX < 192) { const int p = TIDX * 256; int e = 0; for (int j = 0; j < 64; ++j) if (ps[j + 1] <= p) e = j + 1; tinfo[128 + TIDX] = e < 64 ? e : 63; } }
    for (int i = BID * NTHREADS + TIDX; i < T_ * 2; i += NBLK * NTHREADS) { const int p = ps[eid[i]] + slot[i]; posof[i] = p; rowmap[p] = i >> 1; }
    __syncthreads();
}

struct SrcMoeUp {
    const char* h; const char* wg; const int* tinfo; const int* rowmap; int total;
    __device__ __forceinline__ bool next(int i, UnitD& u) const { const int id = BID + i * NBLK; if (id >= total) return false; u.t0 = id >> 2; u.t1 = id & 3;
        u.t2 = __builtin_amdgcn_readfirstlane(tinfo[128 + u.t0]); u.gA = h; u.gB = wg + ((size_t)u.t2 * DEXP + u.t1 * 128) * D_; return true; }
    __device__ __forceinline__ void va(const UnitD& u, unsigned (&v)[2][2]) const { int R0, C0; stage_pos(TIDX, R0, C0);
#pragma unroll
        for (int hh = 0; hh < 2; ++hh)
#pragma unroll
            for (int i = 0; i < 2; ++i) v[hh][i] = (unsigned)(rowmap[u.t0 * 256 + hh * 128 + R0 + 64 * i] * D_ + C0 * 2); }
    __device__ __forceinline__ void vb(unsigned (&v)[2][2]) const { int R0, C0; stage_pos(TIDX, R0, C0);
#pragma unroll
        for (int i = 0; i < 2; ++i) { const int Rr = perm_row(R0 + 64 * i); v[0][i] = (unsigned)(Rr * D_ + C0 * 2); v[1][i] = (unsigned)(WS_WU - WS_WG) + (unsigned)(Rr * D_ + C0 * 2); } }
};
__device__ __forceinline__ void phase_moe_up(const Args& a, LAS unsigned char* lds, int layer) {
    const int* tinfo = (const int*)(a.ws + WS_TINFO) + layer * 512;
    const int ntm = __builtin_amdgcn_readfirstlane(tinfo[65]);
    SrcMoeUp S{(const char*)(a.ws + WS_H8), (const char*)(a.ws + WS_WG), tinfo, (const int*)(a.ws + WS_ROWMAP), ntm * 4};
    EpiSwiGLU E{a.ws + WS_ACT};
    gemm_stream<true, true>(lds, S, D_ / 128, E);
}

struct SrcMoeDown {
    const char* act; const char* wd; const int* tinfo; int total;
    __device__ __forceinline__ bool next(int i, UnitD& u) const { const int id = BID + i * NBLK; if (id >= total) return false; u.t0 = id >> 3; u.t1 = id & 7;
        u.t2 = __builtin_amdgcn_readfirstlane(tinfo[128 + u.t0]); u.gA = act + (size_t)u.t0 * BM * DEXP; u.gB = wd + ((size_t)u.t2 * D_ + u.t1 * BM) * DEXP; return true; }
    __device__ __forceinline__ void va(const UnitD&, unsigned (&v)[2][2]) const { offs_direct(v, DEXP / 2, false); }
    __device__ __forceinline__ void vb(unsigned (&v)[2][2]) const { offs_direct(v, DEXP / 2, true); }
};
__device__ __forceinline__ void phase_moe_down(const Args& a, LAS unsigned char* lds, int layer) {
    const int* tinfo = (const int*)(a.ws + WS_TINFO) + layer * 512; const int ntm = __builtin_amdgcn_readfirstlane(tinfo[65]);
    SrcMoeDown S{(const char*)(a.ws + WS_ACT), (const char*)(a.ws + WS_WD), tinfo, ntm * 8};
    EpiDown E{a.ws + WS_YMOE};
    gemm_stream<false, true>(lds, S, DEXP / 128, E);
}

struct SrcIn1Tail {
    const char* h; const char* w;
    __device__ __forceinline__ bool next(int i, UnitD& u) const { const int id = BID + i * NBLK; if (id >= 256) return false; u.t0 = id & 63; u.t1 = id >> 6; u.t2 = 0;
        u.gA = h + (size_t)u.t0 * BM * D_ + u.t1 * 512; u.gB = w + (size_t)48 * BM * D_ + u.t1 * 512; return true; }
    __device__ __forceinline__ void va(const UnitD&, unsigned (&v)[2][2]) const { offs_direct(v, D_ / 2, false); }
    __device__ __forceinline__ void vb(unsigned (&v)[2][2]) const { offs_direct(v, D_ / 2, true); }
};
struct EpiTailQ {
    float* O;
    __device__ __forceinline__ void operator()(const Acc& acc, const UnitD& u, int wr, int wc, int fr, int fq) const { store_f32_tile(acc, O + ((size_t)u.t1 * T_ + (size_t)u.t0 * BM) * 64, nullptr, 64, 64, wr, wc, fr, fq, 1.0f / W8_SCALE); }
};
__device__ __forceinline__ void phase_gemm_in1(const Args& a, LAS unsigned char* lds) {
    SrcGrid S{(const char*)(a.ws + WS_H8), (const char*)(a.ws + WS_WIN1T), (size_t)BM * D_, (size_t)BM * D_, 64, 64 * 48, D_ / 2, D_ / 2};
    EpiProj E{(bf16_t*)(a.ws + WS_PROJ), N_IN1P, nullptr, 64, 48, 48, 64, 1.0f / W8_SCALE};
    gemm_stream<false, true>(lds, S, D_ / 128, E);
}
__device__ __forceinline__ void phase_gemm_in1_tail(const Args& a, LAS unsigned char* lds) {
    SrcIn1Tail S{(const char*)(a.ws + WS_H8), (const char*)(a.ws + WS_WIN1T)};
    EpiTailQ E{(float*)(a.ws + WS_O)};
    int nt = 4; asm volatile("" : "+s"(nt));
    gemm_stream<false, true>(lds, S, nt, E);
}

__device__ __forceinline__ void phase_gdn_conv(const Args& a) {
    const bf16_t* p1 = (const bf16_t*)(a.ws + WS_PROJ); bf16_t* qc = (bf16_t*)(a.ws + WS_QKVC); const float* cw = a.in[16];
    const int gtid = BID * NTHREADS + TIDX, gsz = NBLK * NTHREADS;
    for (int it = gtid; it < 1024 * (T_ / 128); it += gsz) { const int c = (it & 1023) * 8, seg = it >> 10; const size_t t0 = (size_t)seg * 128;
        float w[4][8];
#pragma unroll
        for (int k = 0; k < 4; ++k) { const f32x4 w0 = *(const f32x4*)(cw + k * 8192 + c), w1 = *(const f32x4*)(cw + k * 8192 + c + 4);
            w[k][0] = w0[0]; w[k][1] = w0[1]; w[k][2] = w0[2]; w[k][3] = w0[3]; w[k][4] = w1[0]; w[k][5] = w1[1]; w[k][6] = w1[2]; w[k][7] = w1[3]; }
        u32x4 x0 = (u32x4){0u, 0u, 0u, 0u}, x1 = x0, x2 = x0;
        if ((t0 & (S_ - 1)) != 0) { x0 = *(const u32x4*)(p1 + (t0 - 3) * N_IN1P + c); x1 = *(const u32x4*)(p1 + (t0 - 2) * N_IN1P + c); x2 = *(const u32x4*)(p1 + (t0 - 1) * N_IN1P + c); }
        const float qsc = c < 2048 ? 0.08838834764831845f : 1.0f;
#pragma unroll 8
        for (int r = 0; r < 128; ++r) { const u32x4 x3 = *(const u32x4*)(p1 + (t0 + r) * N_IN1P + c);
            float acc[8];
#define TAPS(j, f, m) (w[0][j] * f(x0.m) + w[1][j] * f(x1.m) + w[2][j] * f(x2.m) + w[3][j] * f(x3.m))
            acc[0] = TAPS(0, bf_lo, x); acc[1] = TAPS(1, bf_hi, x); acc[2] = TAPS(2, bf_lo, y); acc[3] = TAPS(3, bf_hi, y);
            acc[4] = TAPS(4, bf_lo, z); acc[5] = TAPS(5, bf_hi, z); acc[6] = TAPS(6, bf_lo, w); acc[7] = TAPS(7, bf_hi, w);
#undef TAPS
            float ss = 0.f;
#pragma unroll
            for (int j = 0; j < 8; ++j) { acc[j] = siluf_(acc[j]); ss += acc[j] * acc[j]; }
            ss = row16_sum(ss);
            const float sc = c < 4096 ? rsqrtf(ss + 1e-6f) * qsc : 1.0f;
            u32x4 o; o.x = cvt_pk_bf16(acc[0] * sc, acc[1] * sc); o.y = cvt_pk_bf16(acc[2] * sc, acc[3] * sc); o.z = cvt_pk_bf16(acc[4] * sc, acc[5] * sc); o.w = cvt_pk_bf16(acc[6] * sc, acc[7] * sc);
            *(u32x4*)(qc + (t0 + r) * 8192 + c) = o;
            x0 = x1; x1 = x2; x2 = x3; } }
    const float* tail = (const float*)(a.ws + WS_O); float* bgo = (float*)(a.ws + WS_BG);
    for (int it = gtid; it < T_ * 32; it += gsz) { const int t = it >> 5, hv = it & 31; float tb = 0.f, ta = 0.f;
#pragma unroll
        for (int kq = 0; kq < 4; ++kq) { tb += tail[((size_t)kq * T_ + t) * 64 + hv]; ta += tail[((size_t)kq * T_ + t) * 64 + 32 + hv]; }
        bgo[t * 64 + hv] = sigmoidf_(tb);
        bgo[t * 64 + 32 + hv] = -__expf(a.in[17][hv]) * softplusf_(ta + a.in[18][hv]); }
}

struct MoeTile { const float* src; unsigned char* dst; int lds_, ldd; };
__device__ __forceinline__ MoeTile moe_tile(const Args& a, int g) {
    const int job = g >> 14, r = g & 16383, e = r >> 8, rr = r & 255; MoeTile t;
    typedef __attribute__((address_space(1))) const float* gcf; gcf s25 = (gcf)a.in[25], s26 = (gcf)a.in[26]; asm volatile("" : "+s"(s25), "+s"(s26));
    if (job < 2) { const int ik = rr >> 3, in = rr & 7; t.lds_ = DEXP; t.ldd = D_;
        t.src = (const float*)(job ? s26 : s25) + ((size_t)(NEXP + e) * D_ + ik * 64) * DEXP + in * 64; t.dst = a.ws + (job ? WS_WU : WS_WG) + ((size_t)e * DEXP + in * 64) * D_ + ik * 64; }
    else { const int ik = rr >> 5, in = rr & 31; t.lds_ = D_; t.ldd = DEXP;
        t.src = a.in[27] + ((size_t)(NEXP + e) * DEXP + ik * 64) * D_ + in * 64; t.dst = a.ws + WS_WD + ((size_t)e * D_ + in * 64) * DEXP + ik * 64; }
    return t;
}
__device__ __forceinline__ void moe_tile_load(const MoeTile& t, int tid, f32x4 (&v)[2]) {
#pragma unroll
    for (int i = 0; i < 2; ++i) { const int idx = tid + i * 512, rr = idx >> 4, c4 = (idx & 15) * 4; v[i] = *(const f32x4*)(t.src + (size_t)rr * t.lds_ + c4); }
}
__device__ __forceinline__ void moe_tile_store(const MoeTile& t, int tid, const f32x4 (&v)[2], LAS float* tile) {
#pragma unroll
    for (int i = 0; i < 2; ++i) { const int idx = tid + i * 512, rr = idx >> 4, c4 = (idx & 15) * 4;
        tile[rr * 65 + c4 + 0] = v[i][0]; tile[rr * 65 + c4 + 1] = v[i][1]; tile[rr * 65 + c4 + 2] = v[i][2]; tile[rr * 65 + c4 + 3] = v[i][3]; }
    LDS_BARRIER();
    { const int n = tid >> 3, kg = (tid & 7) * 8; float f[8];
#pragma unroll
      for (int jj = 0; jj < 8; ++jj) f[jj] = tile[(kg + jj) * 65 + n] * W8_SCALE;
      u32x2 w; w.x = pk_fp8x4(f[0], f[1], f[2], f[3]); w.y = pk_fp8x4(f[4], f[5], f[6], f[7]);
      *(u32x2*)(t.dst + (size_t)n * t.ldd + kg) = w; }
    LDS_BARRIER();
}
constexpr int MOE_TILES = 3 * NEXP * 256;

__device__ __forceinline__ f32x4 mfma16(s16x4 a, s16x4 b, f32x4 c) { return __builtin_amdgcn_mfma_f32_16x16x16bf16_1k(a, b, c, 0, 0, 0); }
__device__ __forceinline__ s16x4 pack4(const f32x4& v) { u32x2 w; w.x = cvt_pk_bf16(v[0], v[1]); w.y = cvt_pk_bf16(v[2], v[3]); return __builtin_bit_cast(s16x4, w); }
__device__ __forceinline__ void phase_gdn_chunk(const Args& a, LAS unsigned char* lds) {
    const bf16_t* qc = (const bf16_t*)(a.ws + WS_QKVC); const float* bgi = (const float*)(a.ws + WS_BG); bf16_t* O = (bf16_t*)(a.ws + WS_O);
    constexpr int VRS = 144, KTRS = 136;
    constexpr int KT = 0, QS = KT + 128 * KTRS, WSL = QS + 64 * RSB, QKS = WSL + 64 * RSB, EE = QKS + 2048, EDD = EE + 256, SET = EDD + 256;
    constexpr int STL = 2 * SET, KS = STL + 64 * RSB, VS = KS + 64 * RSB, X2 = VS + 64 * VRS, LS = X2 + 2048, X1 = LS + 4096, GAM = X1 + 2048, BET = GAM + 256, LEND = BET + 256;
    static_assert(LEND <= LDS_XBW, "gdn lds");
    const int wid = __builtin_amdgcn_readfirstlane(TIDX >> 6);
    const int NCK = S_ / 64;
    for (int blk = BID; blk < NB_ * 32 * 2; blk += NBLK) { const int b = blk >> 6, hv = (blk >> 1) & 31, vhalf = blk & 1, hk = hv >> 1;
        __syncthreads();
        if (wid < 4) {
            const int vt = wid;
            f32x4 Sacc[8];
#pragma unroll
            for (int n = 0; n < 8; ++n) Sacc[n] = (f32x4){0.f, 0.f, 0.f, 0.f};
            { const int lane = TIDX & 63;
              for (int i = lane; i < 16 * RSB / 16; i += 64) *(LAS u32x4*)(lds + STL + 16 * vt * RSB + i * 16) = (u32x4){0u, 0u, 0u, 0u}; }
            int lz = TIDX & 63; asm volatile("" : "+v"(lz));
            const int lane = lz, I = lane & 15, G = lane >> 4, q4 = I >> 2, p4 = I & 3;
            for (int it = 0; it <= NCK; ++it) {
                const int set = ((it - 1) & 1) * SET; const size_t t0 = (size_t)b * S_ + (size_t)(it - 1) * 64;
                f32x4 U[4];
                if (it >= 1) {
#pragma unroll
                    for (int sa = 0; sa < 4; ++sa) U[sa] = mfma16(*(const LAS s16x4*)(lds + X2 + ((sa * 16 + I) * 16 + 4 * G) * 2), lds_tr4(lds + VS + (16 * sa + 4 * G + q4) * VRS + (16 * vt + 4 * p4) * 2), (f32x4){0.f, 0.f, 0.f, 0.f});
                    asm volatile("" : "+v"(U[0]), "+v"(U[1]), "+v"(U[2]), "+v"(U[3]) :: "memory");
                }
#pragma unroll
                for (int sa = 0; sa < 4; ++sa) {
                    if (it >= 1) {
                        bf16x8 sf[4];
#pragma unroll
                        for (int ks = 0; ks < 4; ++ks) sf[ks] = lds_frag(lds + STL + (16 * vt + I) * RSB + (32 * ks + 8 * G) * 2);
                        s16x4 kt[8];
#pragma unroll
                        for (int dt = 0; dt < 8; ++dt) kt[dt] = *(const LAS s16x4*)(lds + set + KT + (16 * dt + I) * KTRS + (16 * sa + 4 * G) * 2);
                        f32x4 dl = U[sa], oq = (f32x4){0.f, 0.f, 0.f, 0.f};
#pragma unroll
                        for (int ks = 0; ks < 4; ++ks) { dl = mfma32(lds_frag(lds + set + WSL + (16 * sa + I) * RSB + (32 * ks + 8 * G) * 2), sf[ks], dl);
                            oq = mfma32(sf[ks], lds_frag(lds + set + QS + (16 * sa + I) * RSB + (32 * ks + 8 * G) * 2), oq); }
                        const s16x4 dfrag = pack4(dl);
                        const float et = *(const LAS float*)(lds + set + EE + (16 * sa + I) * 4);
                        oq = mfma16(dfrag, *(const LAS s16x4*)(lds + set + QKS + ((sa * 16 + I) * 16 + 4 * G) * 2), oq * et);
                        { u32x2 ow; ow.x = cvt_pk_bf16(oq[0], oq[1]); ow.y = cvt_pk_bf16(oq[2], oq[3]);
                          *(u32x2*)(O + (t0 + 16 * sa + I) * 4096 + hv * 128 + vhalf * 64 + 16 * vt + 4 * G) = ow; }
                        const f32x4 ed4 = *(const LAS f32x4*)(lds + set + EDD + (16 * sa + 4 * G) * 4); const float e15 = *(const LAS float*)(lds + set + EE + (16 * sa + 15) * 4);
                        const s16x4 dsc = pack4(dl * ed4);
#pragma unroll
                        for (int dt = 0; dt < 8; ++dt) {
                            Sacc[dt] = mfma16(kt[dt], dsc, Sacc[dt] * e15);
                            *(LAS s16x4*)(lds + STL + (16 * vt + I) * RSB + (16 * dt + 4 * G) * 2) = pack4(Sacc[dt]); }
                    }
                    LDS_BARRIER();
                }
            }
        } else {
            const int pw = wid - 4;
            u32x4 pq[4], pk[4], pv[2]; float pb = 0.f, pg = 0.f;
            { const int ptid = TIDX - 256; const size_t t0 = (size_t)b * S_;
#pragma unroll
              for (int i = 0; i < 4; ++i) { const int c = ptid + i * 256, s2 = c >> 4, c8 = (c & 15) * 8; pq[i] = *(const u32x4*)(qc + (t0 + s2) * 8192 + hk * 128 + c8); pk[i] = *(const u32x4*)(qc + (t0 + s2) * 8192 + 2048 + hk * 128 + c8); }
#pragma unroll
              for (int i = 0; i < 2; ++i) { const int c = ptid + i * 256, s2 = c >> 3, c8 = (c & 7) * 8; pv[i] = *(const u32x4*)(qc + (t0 + s2) * 8192 + 4096 + hv * 128 + vhalf * 64 + c8); }
              if (pw == 1) { pb = bgi[(t0 + ptid - 64) * 64 + hv]; pg = bgi[(t0 + ptid - 64) * 64 + 32 + hv]; } }
            int lz = TIDX & 63; asm volatile("" : "+v"(lz));
            const int lane = lz, ptid = pw * 64 + lane, I = lane & 15, G = lane >> 4, q4 = I >> 2, p4 = I & 3;
            for (int it = 0; it <= NCK; ++it) {
                const int set = (it & 1) * SET; const bool act = it < NCK;
                if (act) {
#pragma unroll
                    for (int i = 0; i < 4; ++i) { const int c = ptid + i * 256, s2 = c >> 4, c8 = (c & 15) * 8; *(LAS u32x4*)(lds + set + QS + s2 * RSB + c8 * 2) = pq[i]; *(LAS u32x4*)(lds + KS + s2 * RSB + c8 * 2) = pk[i]; }
                    if (pw == 1) { float x = pg;
                        x += __builtin_bit_cast(float, __builtin_amdgcn_update_dpp(0, __builtin_bit_cast(int, x), 0x111, 0xf, 0xf, true));
                        x += __builtin_bit_cast(float, __builtin_amdgcn_update_dpp(0, __builtin_bit_cast(int, x), 0x112, 0xf, 0xf, true));
                        x += __builtin_bit_cast(float, __builtin_amdgcn_update_dpp(0, __builtin_bit_cast(int, x), 0x114, 0xf, 0xf, true));
                        x += __builtin_bit_cast(float, __builtin_amdgcn_update_dpp(0, __builtin_bit_cast(int, x), 0x118, 0xf, 0xf, true));
                        const float g15 = __shfl(x, 15, 16);
                        *(LAS float*)(lds + GAM + lane * 4) = x; *(LAS float*)(lds + set + EE + lane * 4) = __expf(x); *(LAS float*)(lds + set + EDD + lane * 4) = __expf(g15 - x); *(LAS float*)(lds + BET + lane * 4) = pb; }
                }
                LDS_BARRIER();
                if (act) { const int sa = pw;
#pragma unroll
                    for (int i = 0; i < 2; ++i) { const int c = ptid + i * 256, s2 = c >> 3, c8 = (c & 7) * 8; *(LAS u32x4*)(lds + VS + s2 * VRS + c8 * 2) = pv[i]; }
                    if (it + 1 < NCK) { const size_t t1 = (size_t)b * S_ + (size_t)(it + 1) * 64;
#pragma unroll
                        for (int i = 0; i < 4; ++i) { const int c = ptid + i * 256, s2 = c >> 4, c8 = (c & 15) * 8; pq[i] = *(const u32x4*)(qc + (t1 + s2) * 8192 + hk * 128 + c8); pk[i] = *(const u32x4*)(qc + (t1 + s2) * 8192 + 2048 + hk * 128 + c8); }
#pragma unroll
                        for (int i = 0; i < 2; ++i) { const int c = ptid + i * 256, s2 = c >> 3, c8 = (c & 7) * 8; pv[i] = *(const u32x4*)(qc + (t1 + s2) * 8192 + 4096 + hv * 128 + vhalf * 64 + c8); }
                        if (pw == 1) { pb = bgi[(t1 + ptid - 64) * 64 + hv]; pg = bgi[(t1 + ptid - 64) * 64 + 32 + hv]; } }
#pragma unroll
                    for (int ty = 0; ty < 2; ++ty) { f32x4 acc = (f32x4){0.f, 0.f, 0.f, 0.f};
#pragma unroll
                        for (int ks = 0; ks < 4; ++ks) { const bf16x8 ka = lds_frag(lds + KS + (16 * sa + I) * RSB + (32 * ks + 8 * G) * 2);
                            const bf16x8 bo = ty ? lds_frag(lds + set + QS + (16 * sa + I) * RSB + (32 * ks + 8 * G) * 2) : ka; acc = mfma32(ka, bo, acc); }
                        const f32x4 gr = *(const LAS f32x4*)(lds + GAM + (16 * sa + 4 * G) * 4); const float gc = *(const LAS float*)(lds + GAM + (16 * sa + I) * 4);
                        if (ty == 0) { const f32x4 br = *(const LAS f32x4*)(lds + BET + (16 * sa + 4 * G) * 4);
#pragma unroll
                            for (int r = 0; r < 4; ++r) { const float val = br[r] * acc[r] * __expf(gr[r] - gc); *(LAS float*)(lds + LS + ((sa * 16 + 4 * G + r) * 16 + I) * 4) = (I < 4 * G + r) ? val : 0.f; } }
                        else { f32x4 o;
#pragma unroll
                            for (int r = 0; r < 4; ++r) { const float val = acc[r] * __expf(gc - gr[r]); o[r] = (4 * G + r <= I) ? val : 0.f; }
                            *(LAS s16x4*)(lds + set + QKS + ((sa * 16 + I) * 16 + 4 * G) * 2) = pack4(o); } } }
                LDS_BARRIER();
                if (act && pw == 0) { const int sa = G, c = I; float x[16];
#pragma unroll
                    for (int i = 0; i < 16; ++i) x[i] = 0.f;
#pragma unroll
                    for (int ib = 0; ib < 4; ++ib) {
                        f32x4 lv[4][4];
#pragma unroll
                        for (int r = 0; r < 4; ++r)
#pragma unroll
                            for (int jj = 0; jj <= ib; ++jj) lv[r][jj] = *(const LAS f32x4*)(lds + LS + ((sa * 16 + 4 * ib + r) * 16 + 4 * jj) * 4);
                        __builtin_amdgcn_sched_barrier(0);
#pragma unroll
                        for (int r = 0; r < 4; ++r) { const int i = 4 * ib + r; float s0 = (i == c) ? 1.0f : 0.0f, s1 = 0.f;
#pragma unroll
                            for (int jj = 0; jj <= ib; ++jj) { s0 -= lv[r][jj][0] * x[4 * jj] + lv[r][jj][1] * x[4 * jj + 1]; s1 -= lv[r][jj][2] * x[4 * jj + 2] + lv[r][jj][3] * x[4 * jj + 3]; }
                            x[i] = s0 + s1; }
                    }
                    const float bc = *(const LAS float*)(lds + BET + lane * 4), sc1 = -bc * *(const LAS float*)(lds + set + EE + lane * 4);
#pragma unroll
                    for (int i = 0; i < 16; ++i) { *(LAS bf16_t*)(lds + X1 + ((sa * 16 + i) * 16 + c) * 2) = f2bf(x[i] * sc1); *(LAS bf16_t*)(lds + X2 + ((sa * 16 + i) * 16 + c) * 2) = f2bf(x[i] * bc); } }
                LDS_BARRIER();
                if (act) { const int sa = pw;
                    const s16x4 xb = *(const LAS s16x4*)(lds + X1 + ((sa * 16 + I) * 16 + 4 * G) * 2); s16x4 kt[8]; f32x4 w[8];
#pragma unroll
                    for (int dt = 0; dt < 8; ++dt) kt[dt] = lds_tr4(lds + KS + (16 * sa + 4 * G + q4) * RSB + (16 * dt + 4 * p4) * 2);
#pragma unroll
                    for (int dt = 0; dt < 8; ++dt) { w[dt] = mfma16(kt[dt], xb, (f32x4){0.f, 0.f, 0.f, 0.f}); *(LAS s16x4*)(lds + set + KT + (16 * dt + I) * KTRS + (16 * sa + 4 * G) * 2) = kt[dt]; }
#pragma unroll
                    for (int dt = 0; dt < 8; ++dt) *(LAS s16x4*)(lds + set + WSL + (16 * sa + I) * RSB + (16 * dt + 4 * G) * 2) = pack4(w[dt]); }
                LDS_BARRIER();
            }
        }
    }
}

constexpr int N_PHASES = 30;
__global__ void __launch_bounds__(NTHREADS, 2) fwd(Args a0) {
    extern __shared__ __attribute__((aligned(16))) unsigned char smem_raw[];
    LAS unsigned char* lds = (LAS unsigned char*)smem_raw;
    volatile LAS unsigned* xbw = (volatile LAS unsigned*)(lds + LDS_XBW);
    if (TIDX == 0) { xbw[0] = 0u; xbw[1] = 0u; xbw[2] = 0u; xbw[3] = 0u; }
    __syncthreads();
    XcdBarrier bar = xcd_barrier_post((unsigned*)(a0.ws + WS_CTL), xbw);
#ifndef PHMASK
#define PHMASK 0xFFFFFFFFull
#endif
#ifndef DUPMASK
#define DUPMASK 0ull
#endif
#define PH(i, body) do { if (((PHMASK >> (i)) & 1ull) && a0.ph_lo <= (i) && (i) < a0.ph_hi) { __attribute__((address_space(1))) unsigned char* wsp_ = (__attribute__((address_space(1))) unsigned char*)a0.ws; asm volatile("" : "+s"(wsp_)); Args a = a0; a.ws = (unsigned char*)wsp_; const float* xin = a.in[0]; const float* xw = (const float*)(a.ws + WS_X); (void)xin; (void)xw; \
        if ((DUPMASK >> (i)) & 1ull) { body; xcd_barrier(bar); } body; if ((i) + 1 < a0.ph_hi) xcd_barrier(bar); } } while (0)
    PH(0, { phase_prologue(a, lds); __syncthreads(); phase_norm<0>(a, xin, a.in[1], -1); });
    PH(2, phase_gemm_in0(a, lds));
    PH(3, { phase_rg_conv(a); __syncthreads(); phase_hg1(a, lds); });
    PH(4, { phase_rg_gates(a, lds); __syncthreads(); phase_hg2(a); });
    PH(5, { phase_rg_scan(a, lds); __syncthreads(); phase_hg3(a, lds); });
    PH(9, phase_gemm_out<false>(a, lds, D_, a.ws + WS_WOUT0T, xin));
    PH(10, phase_norm<0>(a, nullptr, a.in[2], 0));
    PH(11, phase_gemm_router(a, lds, 0));
    PH(12, phase_route(a, 0));
    PH(13, phase_rowmap(a, lds, 0));
    PH(14, phase_moe_up(a, lds, 0));
    PH(15, phase_moe_down(a, lds, 0));
    PH(16, { phase_norm<1>(a, nullptr, a.in[1] + D_, 0); __syncthreads(); moe_weight_jobs(a, 1, lds); });
    PH(18, { phase_gemm_in1(a, lds); phase_gemm_in1_tail(a, lds); });
    PH(19, phase_gdn_conv(a));
    PH(20, phase_gdn_chunk(a, lds));
    PH(21, phase_gdn_norm(a));
    PH(22, phase_gemm_out<true>(a, lds, 4096, a.ws + WS_WOUT1T, nullptr));
    PH(23, phase_norm<0>(a, nullptr, a.in[2] + D_, 1));
    PH(24, phase_gemm_router(a, lds, 1));
    PH(25, phase_route(a, 1));
    PH(26, phase_rowmap(a, lds, 1));
    PH(27, phase_moe_up(a, lds, 1));
    PH(28, phase_moe_down(a, lds, 1));
    PH(29, phase_norm<2>(a, nullptr, a.in[3], 1));
#undef PH
}

extern "C" void kernel_launch(void* const* d_in, const int* in_sizes, int n_in, void* d_out, int out_size, void* d_ws, size_t ws_size, hipStream_t stream) {
    static int grid = 0;
    if (grid == 0) {
        if (n_in != 28 || ws_size < WS_END) { fprintf(stderr, "kernel_launch: need 28 inputs and %zu bytes of workspace, got %d / %zu\n", (size_t)WS_END, n_in, ws_size); grid = -1; return; }
        int dev = 0, cus = 0, per_cu = 0;
        if (hipGetDevice(&dev) != hipSuccess || hipDeviceGetAttribute(&cus, hipDeviceAttributeMultiprocessorCount, dev) != hipSuccess) { grid = -1; return; }
        if (hipFuncSetAttribute((const void*)fwd, hipFuncAttributeMaxDynamicSharedMemorySize, LDS_BYTES) != hipSuccess) { fprintf(stderr, "kernel_launch: hipFuncSetAttribute failed\n"); grid = -1; return; }
        if (hipOccupancyMaxActiveBlocksPerMultiprocessor(&per_cu, (const void*)fwd, NTHREADS, LDS_BYTES) != hipSuccess || per_cu < 1) { fprintf(stderr, "kernel_launch: occupancy query says %d\n", per_cu); }
        (void)hipGetLastError();
        grid = cus;
    }
    if (grid < 0) return;
    (void)in_sizes; (void)out_size;
    hipMemsetAsync((char*)d_ws + WS_CTL, 0, CTL_BYTES, stream);
    Args a; memset(&a, 0, sizeof(a));
    for (int i = 0; i < 28; ++i) a.in[i] = (const float*)d_in[i];
    a.out = (float*)d_out; a.ws = (unsigned char*)d_ws;
#if N_LAUNCH_MODE == 1
    a.ph_lo = 0; a.ph_hi = N_PHASES;
    hipLaunchKernelGGL(fwd, dim3(grid), dim3(NTHREADS), LDS_BYTES, stream, a);
#if EXTRA_PH >= 0
    a.ph_lo = EXTRA_PH; a.ph_hi = EXTRA_PH + 1;
    hipLaunchKernelGGL(fwd, dim3(grid), dim3(NTHREADS), LDS_BYTES, stream, a);
#endif
#else
    for (int p = 0; p < N_PHASES; ++p) { a.ph_lo = p; a.ph_hi = p + 1; hipLaunchKernelGGL(fwd, dim3(grid), dim3(NTHREADS), LDS_BYTES, stream, a); }
#endif
}
```

```cpp
#include <hip/hip_runtime.h>
#include <stdint.h>
#include <stdio.h>
#include <string.h>

#ifndef EXTRA_PH
#define EXTRA_PH -1
#endif
#ifndef N_LAUNCH_MODE
#define N_LAUNCH_MODE 1
#endif

#define LAS __attribute__((address_space(3)))
typedef unsigned short bf16_t;
typedef short bf16x8 __attribute__((ext_vector_type(8)));
typedef float f32x4 __attribute__((ext_vector_type(4)));
typedef float f32x2 __attribute__((ext_vector_type(2)));
typedef unsigned u32x4 __attribute__((ext_vector_type(4)));
typedef unsigned u32x2 __attribute__((ext_vector_type(2)));

constexpr int T_ = 16384, D_ = 2048, S_ = 4096, NB_ = 4;
constexpr int N_IN0 = 6144, N_IN1 = 12352, N_IN1P = 12544;
constexpr int NEXP = 64, DEXP = 512, MPAD = 49152;
constexpr int NTHREADS = 512;
constexpr int LDS_MAIN = 131072;
constexpr int LDS_BYTES = 163840;
constexpr int LDS_XBW = LDS_BYTES - 16;

constexpr size_t al256(size_t x) { return (x + 255) & ~(size_t)255; }
constexpr size_t WS_CTL = 0;
constexpr size_t CTL_BYTES = 65536;
constexpr size_t CTL_CNT = 16384;
constexpr size_t WS_LB = WS_CTL + CTL_BYTES;
constexpr size_t WS_TINFO = WS_LB + 4096;
constexpr size_t WS_WIN0T = WS_TINFO + 4096;
constexpr size_t WS_WOUT0T = WS_WIN0T + (size_t)N_IN0 * D_ * 2;
constexpr size_t WS_WIN1T = WS_WOUT0T + (size_t)D_ * D_ * 2;
constexpr size_t WS_WOUT1T = WS_WIN1T + (size_t)N_IN1P * D_ * 2;
constexpr size_t WS_WGATES = WS_WOUT1T + (size_t)D_ * 4096 * 2;
constexpr size_t WS_WRT = WS_WGATES + (size_t)8 * 256 * 256 * 2;
constexpr size_t WS_WG = WS_WRT + (size_t)2 * 256 * D_ * 2;
constexpr size_t WS_WU = WS_WG + (size_t)NEXP * DEXP * D_ * 2;
constexpr size_t WS_WD = WS_WU + (size_t)NEXP * DEXP * D_ * 2;
constexpr size_t WS_X = WS_WD + (size_t)NEXP * DEXP * D_ * 2;
constexpr size_t WS_H = WS_X + (size_t)T_ * D_ * 4;
constexpr size_t WS_PROJ = WS_H + (size_t)T_ * D_ * 2;
constexpr size_t PROJ_BYTES = (size_t)T_ * N_IN1P * 2;
constexpr size_t WS_FLOG = WS_PROJ + (size_t)T_ * N_IN0 * 2;
constexpr size_t WS_XC = WS_FLOG + (size_t)T_ * 1024 * 4;
constexpr size_t WS_ACT = WS_PROJ;
constexpr size_t WS_YMOE = WS_ACT + (size_t)MPAD * DEXP * 2;
constexpr size_t WS_R1 = WS_PROJ + PROJ_BYTES;
constexpr size_t WS_A = WS_R1;
constexpr size_t WS_U = WS_R1 + (size_t)T_ * 1024 * 4;
constexpr size_t WS_QKVC = WS_R1;
constexpr size_t WS_Y = WS_R1 + (size_t)T_ * 8192 * 2;
constexpr size_t WS_O = WS_Y + (size_t)T_ * 4096 * 2;
constexpr size_t WS_TAIL = WS_O + (size_t)T_ * 4096 * 4;
constexpr size_t WS_BG = WS_TAIL + (size_t)T_ * 64 * 4;
constexpr size_t WS_LOGITS = WS_BG + (size_t)T_ * 64 * 4;
constexpr size_t WS_EID = WS_LOGITS + (size_t)T_ * 128 * 4;
constexpr size_t WS_SLOT = WS_EID + (size_t)T_ * 2 * 4;
constexpr size_t WS_GATE = WS_SLOT + (size_t)T_ * 2 * 4;
constexpr size_t WS_POSOF = WS_GATE + (size_t)T_ * 2 * 4;
constexpr size_t WS_ROWMAP = WS_POSOF + (size_t)T_ * 2 * 4;
constexpr size_t WS_H8 = WS_ROWMAP + (size_t)MPAD * 4;
constexpr size_t WS_END = WS_H8 + (size_t)T_ * D_;
static_assert(WS_YMOE + (size_t)MPAD * D_ * 2 <= WS_R1, "moe overlay");
static_assert(WS_XC + (size_t)T_ * 1024 * 2 <= WS_R1, "layer0 overlay");

struct Args {
    const float* in[28];
    float* out;
    unsigned char* ws;
    int ph_lo, ph_hi;
};

__device__ __forceinline__ int tidx_() { int t = (int)threadIdx.x; asm volatile("" : "+v"(t)); return t; }
#define TIDX tidx_()
typedef __bf16 bf16x2n __attribute__((ext_vector_type(2)));
__device__ __forceinline__ unsigned cvt_pk_bf16(float lo, float hi) { const f32x2 v = {lo, hi}; return __builtin_bit_cast(unsigned, __builtin_convertvector(v, bf16x2n)); }
__device__ __forceinline__ unsigned pk_fp8x4(float a, float b, float c, float d) { int v = __builtin_amdgcn_cvt_pk_fp8_f32(a, b, 0, false); v = __builtin_amdgcn_cvt_pk_fp8_f32(c, d, v, true); return (unsigned)v; }
constexpr float W8_SCALE = 64.0f, ACT8_SCALE = 8.0f;
__device__ __forceinline__ bf16_t f2bf(float x) { return (bf16_t)(cvt_pk_bf16(x, 0.f) & 0xffffu); }
__device__ __forceinline__ float bf_lo(unsigned w) { return __uint_as_float(w << 16); }
__device__ __forceinline__ float bf_hi(unsigned w) { return __uint_as_float(w & 0xffff0000u); }
__device__ __forceinline__ float bf1(bf16_t v) { return __uint_as_float(((unsigned)v) << 16); }
__device__ __forceinline__ float sigmoidf_(float x) { return __builtin_amdgcn_rcpf(1.0f + __expf(-x)); }
__device__ __forceinline__ float siluf_(float x) { return x * __builtin_amdgcn_rcpf(1.0f + __expf(-x)); }
__device__ __forceinline__ float softplusf_(float x) { return x > 20.f ? x : log1pf(__expf(x)); }
__device__ __forceinline__ float gelu_tanh(float x) { const float u = 0.7978845608028654f * (x + 0.044715f * x * x * x); return x * __builtin_amdgcn_rcpf(1.0f + __expf(-2.0f * u)); }
template <int CTRL> __device__ __forceinline__ float dpp_f(float v) { return __builtin_bit_cast(float, __builtin_amdgcn_update_dpp(0, __builtin_bit_cast(int, v), CTRL, 0xf, 0xf, false)); }
__device__ __forceinline__ float row16_sum(float s) { s += dpp_f<0x140>(s); s += dpp_f<0x141>(s); s += dpp_f<0xB1>(s); s += dpp_f<0x4E>(s); return s; }
__device__ __forceinline__ float wave_sum(float v) { v = row16_sum(v); v += __shfl_xor(v, 16); v += __shfl_xor(v, 32); return v; }

#define LDS_BARRIER() do { asm volatile("s_waitcnt lgkmcnt(0)" ::: "memory"); __builtin_amdgcn_s_barrier(); asm volatile("" ::: "memory"); } while (0)
#define XB_TMO      128
#define XB_XCNT(j)  (256  + 64 * (j))
#define XB_XSUB(j)  (1280 + 64 * (j))
#define XB_XGEN(j)  (2304 + 64 * (j))
#define XB_TOP      3328
#define XB_TOPGEN   3392
#define XCD_BAR_WORDS 3456
#define XB_SPIN_CAP (1u << 18)

__device__ __forceinline__ unsigned xb_ld(unsigned* p)              { return __hip_atomic_load(p, __ATOMIC_RELAXED, __HIP_MEMORY_SCOPE_AGENT); }
__device__ __forceinline__ unsigned xb_add(unsigned* p, unsigned v) { return __hip_atomic_fetch_add(p, v, __ATOMIC_RELAXED, __HIP_MEMORY_SCOPE_AGENT); }
__device__ __forceinline__ unsigned xb_xcc_id() { return (unsigned)__builtin_amdgcn_s_getreg((3 << 11) | 20) & 0xFu; }
#define XB_SPIN(cond, bar) do { unsigned _sp = 0; while (cond) { __builtin_amdgcn_s_sleep(1); \
    if ((++_sp & 255u) == 0u) { if (xb_ld(&(bar)[XB_TMO])) break; if (_sp > XB_SPIN_CAP) { atomicAdd(&(bar)[XB_TMO], 1u); break; } } } } while (0)

struct XcdBarrier { unsigned* bar; unsigned x; volatile LAS unsigned* st; };

__device__ __forceinline__ XcdBarrier xcd_barrier_post(unsigned* bar, volatile LAS unsigned* st) {
    XcdBarrier b; b.bar = bar; b.x = xb_xcc_id(); b.st = st;
    if (TIDX == 0) (void)xb_add(&bar[XB_XCNT(b.x)], 1u);
    return b;
}
__device__ __forceinline__ void xcd_barrier_complete(unsigned* bar, unsigned x, unsigned& nloc, unsigned& nx) {
    const unsigned G = gridDim.x * gridDim.y * gridDim.z;
    unsigned sum, cnt, mine, sp = 0u;
    for (;;) {
        sum = 0u; cnt = 0u; mine = 0u;
#pragma unroll
        for (unsigned j = 0; j < 16; ++j) { const unsigned c = xb_ld(&bar[XB_XCNT(j)]); sum += c; cnt += (c > 0u) ? 1u : 0u; mine = (j == x) ? c : mine; }
        if (sum == G) break;
        __builtin_amdgcn_s_sleep(1);
        if ((++sp & 255u) == 0u) { if (xb_ld(&bar[XB_TMO])) break; if (sp > XB_SPIN_CAP) { atomicAdd(&bar[XB_TMO], 1u); break; } }
    }
    nloc = mine > 0u ? mine : 1u; nx = cnt > 0u ? cnt : 1u;
}
__device__ __forceinline__ void xcd_barrier(const XcdBarrier& b) {
    asm volatile("s_waitcnt vmcnt(0)" ::: "memory");
    __syncthreads();
    if (TIDX == 0) {
        unsigned* bar = b.bar;
        __builtin_amdgcn_s_waitcnt(0);
        unsigned nloc = b.st[0], nx = b.st[1];
        if (nloc == 0u) { xcd_barrier_complete(bar, b.x, nloc, nx); b.st[0] = nloc; b.st[1] = nx; }
        const unsigned old = xb_add(&bar[XB_XSUB(b.x)], 1u);
        const unsigned gen = old / nloc;
        if (old + 1u == (gen + 1u) * nloc) {
            __builtin_amdgcn_fence(__ATOMIC_RELEASE, "agent");
            asm volatile("s_waitcnt vmcnt(0)" ::: "memory");
            const unsigned og = xb_add(&bar[XB_TOP], 1u);
            const unsigned tg = og / nx;
            if (og + 1u == (tg + 1u) * nx) xb_add(&bar[XB_TOPGEN], 1u);
            else XB_SPIN(xb_ld(&bar[XB_TOPGEN]) == tg, bar);
            __builtin_amdgcn_fence(__ATOMIC_ACQUIRE, "agent");
            xb_add(&bar[XB_XGEN(b.x)], 1u);
            asm volatile("s_waitcnt vmcnt(0)" ::: "memory");
        } else {
            XB_SPIN(xb_ld(&bar[XB_XGEN(b.x)]) == gen, bar);
            __builtin_amdgcn_fence(__ATOMIC_ACQUIRE, "agent");
            asm volatile("s_waitcnt vmcnt(0)" ::: "memory");
        }
    }
    __syncthreads();
}

constexpr int BM = 256, BK = 64, HALF = 128, HTB = HALF * BK * 2;
__device__ __forceinline__ int lds_byte(int r, int c) { const int st = (r >> 4) * 2 + (c >> 5), rr = r & 15, cc = c & 31, ob = rr * 64 + cc * 2; return st * 1024 + (ob ^ (((ob >> 9) & 1) << 5)); }
__device__ __forceinline__ void stage_rc(int b, int& R, int& C) { const int st = b / 1024, sb = b % 1024, swz = sb ^ (((sb >> 9) & 1) << 5); R = (st >> 1) * 16 + swz / 64; C = (st & 1) * 32 + (swz % 64) / 2; }
__device__ __forceinline__ int perm32(int rho) { const int n = rho >> 4, i = rho & 15; return 8 * (i >> 2) + 4 * n + (i & 3); }

__device__ __forceinline__ void stage_pos(int tid, int& R0, int& C0) { stage_rc(tid * 16, R0, C0); }
__device__ __forceinline__ int perm_row(int R) { return (R & ~31) + perm32(R & 31); }

#define BID ((int)blockIdx.x)
#define NBLK ((int)gridDim.x)
#define BID_ BID
#define NBLK_ NBLK
typedef f32x4 Acc[2][2][4][2];
struct UnitD { const char* gA; const char* gB; int t0, t1, t2; };

typedef int i32x8 __attribute__((ext_vector_type(8)));
typedef int i32x4 __attribute__((ext_vector_type(4)));
template <bool GATHER, bool FP8, class Src, class Epi>
__device__ __forceinline__ void gemm_stream(LAS unsigned char* lds, const Src& S, const int nt, const Epi& E) {
    const int tid = TIDX, wid = tid >> 6, lane = tid & 63, wr = wid >> 2, wc = wid & 3, fr = lane & 15, fq = lane >> 4;
    const unsigned ldsw = (unsigned)wid * 1024u;
    const int aoff = lds_byte(wr * 64 + fr, fq * 8), boff = lds_byte(wc * 32 + fr, fq * 8);
    const size_t kstep = (size_t)(BK * 2);
#define G_SA(b, h) (((b) * 2 + (h)) * HTB)
#define G_SB(b, h) ((4 + (b) * 2 + (h)) * HTB)
#define G_STAGE(bufoff, gbase, v) do { _Pragma("unroll") for (int _i = 0; _i < 2; ++_i) \
        __builtin_amdgcn_global_load_lds((const unsigned*)((gbase) + (v)[_i]), (LAS unsigned*)(lds + (bufoff) + ldsw + _i * 8192), 16, 0, 0); } while (0)
#define G_LD8(p) __builtin_shufflevector(*(const LAS i32x4*)(p), *(const LAS i32x4*)((p) + 1024), 0, 1, 2, 3, 4, 5, 6, 7)
#define G_LDA(dst, b, h) do { _Pragma("unroll") for (int m = 0; m < 4; ++m) dst[m] = G_LD8(lds + G_SA(b, h) + aoff + m * 2048); } while (0)
#define G_LDB(dst, b, h) do { _Pragma("unroll") for (int n = 0; n < 2; ++n) dst[n] = G_LD8(lds + G_SB(b, h) + boff + n * 2048); } while (0)
#define G_HALF(x, k) __builtin_bit_cast(bf16x8, __builtin_shufflevector((x), (x), 4 * (k), 4 * (k) + 1, 4 * (k) + 2, 4 * (k) + 3))
#define G_MMA(ai, bj, At, Bt) do { __builtin_amdgcn_s_setprio(1); _Pragma("unroll") for (int m = 0; m < 4; ++m) _Pragma("unroll") for (int n = 0; n < 2; ++n) { \
        if (FP8) asm volatile("v_mfma_f32_16x16x128_f8f6f4 %0, %1, %2, %0" : "+v"(acc[ai][bj][m][n]) : "v"(Bt[n]), "v"(At[m]));   \
        else { acc[ai][bj][m][n] = __builtin_amdgcn_mfma_f32_16x16x32_bf16(G_HALF(Bt[n], 0), G_HALF(At[m], 0), acc[ai][bj][m][n], 0, 0, 0); \
               acc[ai][bj][m][n] = __builtin_amdgcn_mfma_f32_16x16x32_bf16(G_HALF(Bt[n], 1), G_HALF(At[m], 1), acc[ai][bj][m][n], 0, 0, 0); } } \
        __builtin_amdgcn_s_setprio(0); } while (0)
#define G_WAIT_V(n) asm volatile("s_waitcnt vmcnt(" #n ")" ::: "memory")
#define G_WAIT_L(n) asm volatile("s_waitcnt lgkmcnt(" #n ")" ::: "memory")
#define G_BAR __builtin_amdgcn_s_barrier()
#define G_SCHED __builtin_amdgcn_sched_barrier(0)
    UnitD cur, nxt; int ui = 0;
    if (!S.next(0, cur)) return;
    unsigned va[2][2], vb[2][2], van[2][2];
    S.vb(vb); S.va(cur, va);
    Acc acc;
#pragma unroll
    for (int a = 0; a < 2; ++a)
#pragma unroll
        for (int b = 0; b < 2; ++b)
#pragma unroll
            for (int m = 0; m < 4; ++m)
#pragma unroll
                for (int n = 0; n < 2; ++n) acc[a][b][m][n] = (f32x4){0.f, 0.f, 0.f, 0.f};
    i32x8 At[4], B0[2], B1[2];
    const char* cA = cur.gA; const char* cB = cur.gB;
    G_WAIT_V(0);
    __syncthreads();
    G_STAGE(G_SB(0, 0), cB, vb[0]); G_STAGE(G_SA(0, 0), cA, va[0]); G_STAGE(G_SB(0, 1), cB, vb[1]); G_STAGE(G_SA(0, 1), cA, va[1]);
    if (wr == 1) G_BAR;
    G_WAIT_V(4); G_BAR;
    G_STAGE(G_SB(1, 0), cB + kstep, vb[0]); G_STAGE(G_SA(1, 0), cA + kstep, va[0]); G_STAGE(G_SB(1, 1), cB + kstep, vb[1]);
    G_WAIT_V(6); G_BAR;
    for (;;) {
        const bool has_next = S.next(ui + 1, nxt);
        const char* nA = has_next ? nxt.gA : cA; const char* nB = has_next ? nxt.gB : cB;
        if (GATHER) { if (has_next) S.va(nxt, van); else { van[0][0] = va[0][0]; van[0][1] = va[0][1]; van[1][0] = va[1][0]; van[1][1] = va[1][1]; } }
#pragma unroll 1
        for (int t = 0; t < nt; t += 2) {
            const bool last = (t == nt - 2);
            const char* a1 = cA + (size_t)(t + 1) * kstep;
            const char* a2 = last ? nA : cA + (size_t)(t + 2) * kstep; const char* b2 = last ? nB : cB + (size_t)(t + 2) * kstep;
            const char* a3 = a2 + kstep; const char* b3 = b2 + kstep;
            unsigned v2[2][2];
#pragma unroll
            for (int hh = 0; hh < 2; ++hh)
#pragma unroll
                for (int i = 0; i < 2; ++i) v2[hh][i] = (GATHER && last) ? van[hh][i] : va[hh][i];
            G_LDB(B0, 0, 0); G_SCHED; G_LDA(At, 0, 0); G_STAGE(G_SA(1, 1), a1, va[1]);
            G_WAIT_L(8); G_BAR; G_WAIT_L(0); G_MMA(0, 0, At, B0); G_BAR; G_SCHED;
            G_LDB(B1, 0, 1); G_STAGE(G_SB(0, 0), b2, vb[0]);
            G_BAR; G_WAIT_L(0); G_MMA(0, 1, At, B1); G_BAR;
            G_LDA(At, 0, 1); G_STAGE(G_SA(0, 0), a2, v2[0]);
            G_BAR; G_WAIT_L(0); G_MMA(1, 0, At, B0); G_BAR; G_SCHED;
            G_STAGE(G_SB(0, 1), b2, vb[1]);
            G_WAIT_V(6); G_BAR; G_MMA(1, 1, At, B1); G_BAR;
            G_LDB(B0, 1, 0); G_SCHED; G_LDA(At, 1, 0); G_STAGE(G_SA(0, 1), a2, v2[1]);
            G_WAIT_L(8); G_BAR; G_WAIT_L(0); G_MMA(0, 0, At, B0); G_BAR; G_SCHED;
            G_LDB(B1, 1, 1); G_STAGE(G_SB(1, 0), b3, vb[0]);
            G_BAR; G_WAIT_L(0); G_MMA(0, 1, At, B1); G_BAR;
            G_LDA(At, 1, 1); G_STAGE(G_SA(1, 0), a3, v2[0]);
            G_BAR; G_WAIT_L(0); G_MMA(1, 0, At, B0); G_BAR; G_SCHED;
            G_STAGE(G_SB(1, 1), b3, vb[1]);
            G_WAIT_V(6); G_BAR; G_MMA(1, 1, At, B1); G_BAR;
        }
        if (FP8) asm volatile("s_nop 15\n\ts_nop 15" ::: "memory");
        { int tz = TIDX; asm volatile("" : "+v"(tz));
          const int wid2 = tz >> 6, lane2 = tz & 63; E(acc, cur, wid2 >> 2, wid2 & 3, lane2 & 15, lane2 >> 4); }
        if (!has_next) break;
#pragma unroll
        for (int a = 0; a < 2; ++a)
#pragma unroll
            for (int b = 0; b < 2; ++b)
#pragma unroll
                for (int m = 0; m < 4; ++m)
#pragma unroll
                    for (int n = 0; n < 2; ++n) acc[a][b][m][n] = (f32x4){0.f, 0.f, 0.f, 0.f};
        cur = nxt; cA = nA; cB = nB; ++ui;
        if (GATHER) { va[0][0] = van[0][0]; va[0][1] = van[0][1]; va[1][0] = van[1][0]; va[1][1] = van[1][1]; }
    }
    G_WAIT_V(0);
    if (wr == 0) G_BAR;
    G_BAR;
#undef G_SA
#undef G_SB
#undef G_STAGE
#undef G_LDA
#undef G_LDB
#undef G_MMA
#undef G_LD8
#undef G_HALF
#undef G_WAIT_V
#undef G_WAIT_L
#undef G_BAR
#undef G_SCHED
}

__device__ __forceinline__ void offs_direct(unsigned (&v)[2][2], int ld, bool perm) {
    int R0, C0; stage_pos(TIDX, R0, C0);
#pragma unroll
    for (int i = 0; i < 2; ++i) { const int R = R0 + 64 * i, Rr = perm ? perm_row(R) : R;
        v[0][i] = (unsigned)(Rr * ld + C0) * 2u; v[1][i] = (unsigned)((Rr + HALF) * ld + C0) * 2u; }
}

struct SrcGrid {
    const char* A; const char* B; size_t astep, bstep; int nM, total, lda, ldb;
    __device__ __forceinline__ bool next(int i, UnitD& u) const { const int id = BID_ + i * NBLK_; if (id >= total) return false; u.t0 = id % nM; u.t1 = id / nM; u.t2 = 0;
        u.gA = A + (size_t)u.t0 * astep; u.gB = B + (size_t)u.t1 * bstep; return true; }
    __device__ __forceinline__ void va(const UnitD&, unsigned (&v)[2][2]) const { offs_direct(v, lda, false); }
    __device__ __forceinline__ void vb(unsigned (&v)[2][2]) const { offs_direct(v, ldb, true); }
};

__device__ __forceinline__ void store_bf16_tile(const Acc& acc, bf16_t* O, int ld, int wr, int wc, int fr, int fq, const float sc = 1.0f) {
#pragma unroll
    for (int ai = 0; ai < 2; ++ai)
#pragma unroll
        for (int m = 0; m < 4; ++m) { bf16_t* rowp = O + (size_t)(ai * HALF + wr * 64 + m * 16 + fr) * ld + wc * 32 + 8 * fq;
#pragma unroll
            for (int bj = 0; bj < 2; ++bj) { const f32x4 v0 = acc[ai][bj][m][0] * sc, v1 = acc[ai][bj][m][1] * sc;
                u32x4 w; w.x = cvt_pk_bf16(v0[0], v0[1]); w.y = cvt_pk_bf16(v0[2], v0[3]); w.z = cvt_pk_bf16(v1[0], v1[1]); w.w = cvt_pk_bf16(v1[2], v1[3]);
                *(u32x4*)(rowp + bj * HALF) = w; } }
}
__device__ __forceinline__ void store_f32_tile(const Acc& acc, float* O, const float* R, int ld, int ncol, int wr, int wc, int fr, int fq, const float sc = 1.0f) {
#pragma unroll
    for (int ai = 0; ai < 2; ++ai)
#pragma unroll
        for (int m = 0; m < 4; ++m) { const size_t ro = (size_t)(ai * HALF + wr * 64 + m * 16 + fr) * ld;
#pragma unroll
            for (int bj = 0; bj < 2; ++bj)
#pragma unroll
                for (int n = 0; n < 2; ++n) { const int c = bj * HALF + wc * 32 + 8 * fq + 4 * n; if (c >= ncol) continue;
                    f32x4 v = acc[ai][bj][m][n] * sc; if (R) v += *(const f32x4*)(R + ro + c); *(f32x4*)(O + ro + c) = v; } }
}
struct EpiProj {
    bf16_t* O; int ld; float* F; int fld, fp0, fp1, ncol; float sc;
    __device__ __forceinline__ void operator()(const Acc& acc, const UnitD& u, int wr, int wc, int fr, int fq) const {
        if (u.t1 >= fp0 && u.t1 < fp1) store_f32_tile(acc, F + (size_t)u.t0 * BM * fld + (u.t1 - fp0) * BM, nullptr, fld, ncol, wr, wc, fr, fq, sc);
        else store_bf16_tile(acc, O + (size_t)u.t0 * BM * ld + u.t1 * BM, ld, wr, wc, fr, fq, sc);
    }
};
struct EpiResid {
    bf16_t* O; const float* Rf; const bf16_t* Rb; float sc;
    __device__ __forceinline__ void operator()(const Acc& acc, const UnitD& u, int wr, int wc, int fr, int fq) const {
        const size_t o = (size_t)u.t0 * BM * D_ + u.t1 * BM;
#pragma unroll
        for (int ai = 0; ai < 2; ++ai)
#pragma unroll
            for (int m = 0; m < 4; ++m) { const size_t ro = o + (size_t)(ai * HALF + wr * 64 + m * 16 + fr) * D_ + wc * 32 + 8 * fq;
#pragma unroll
                for (int bj = 0; bj < 2; ++bj) { f32x4 v0 = acc[ai][bj][m][0] * sc, v1 = acc[ai][bj][m][1] * sc;
                    if (Rf) { v0 += *(const f32x4*)(Rf + ro + bj * HALF); v1 += *(const f32x4*)(Rf + ro + bj * HALF + 4); }
                    else { const u32x4 r = *(const u32x4*)(Rb + ro + bj * HALF); v0[0] += bf_lo(r.x); v0[1] += bf_hi(r.x); v0[2] += bf_lo(r.y); v0[3] += bf_hi(r.y); v1[0] += bf_lo(r.z); v1[1] += bf_hi(r.z); v1[2] += bf_lo(r.w); v1[3] += bf_hi(r.w); }
                    u32x4 w; w.x = cvt_pk_bf16(v0[0], v0[1]); w.y = cvt_pk_bf16(v0[2], v0[3]); w.z = cvt_pk_bf16(v1[0], v1[1]); w.w = cvt_pk_bf16(v1[2], v1[3]);
                    *(u32x4*)(O + ro + bj * HALF) = w; } }
    }
};
struct EpiLogits {
    float* O;
    __device__ __forceinline__ void operator()(const Acc& acc, const UnitD& u, int wr, int wc, int fr, int fq) const { store_f32_tile(acc, O + (size_t)u.t0 * BM * 128, nullptr, 128, 128, wr, wc, fr, fq); }
};
struct EpiSwiGLU {
    unsigned char* O;
    __device__ __forceinline__ void operator()(const Acc& acc, const UnitD& u, int wr, int wc, int fr, int fq) const {
        unsigned char* o = O + (size_t)u.t0 * BM * DEXP + u.t1 * 128;
#pragma unroll
        for (int ai = 0; ai < 2; ++ai)
#pragma unroll
            for (int m = 0; m < 4; ++m) { unsigned char* rowp = o + (size_t)(ai * HALF + wr * 64 + m * 16 + fr) * DEXP + wc * 32 + 8 * fq;
                float r[8];
#pragma unroll
                for (int n = 0; n < 2; ++n)
#pragma unroll
                    for (int j = 0; j < 4; ++j) r[n * 4 + j] = (ACT8_SCALE / W8_SCALE) * siluf_(acc[ai][0][m][n][j] * (1.0f / W8_SCALE)) * acc[ai][1][m][n][j];
                u32x2 w; w.x = pk_fp8x4(r[0], r[1], r[2], r[3]); w.y = pk_fp8x4(r[4], r[5], r[6], r[7]);
                *(u32x2*)rowp = w; }
    }
};
struct EpiDown {
    unsigned char* O;
    __device__ __forceinline__ void operator()(const Acc& acc, const UnitD& u, int wr, int wc, int fr, int fq) const {
        unsigned char* o = O + (size_t)u.t0 * BM * D_ + u.t1 * BM; const float sc = 1.0f / (W8_SCALE * ACT8_SCALE);
#pragma unroll
        for (int ai = 0; ai < 2; ++ai)
#pragma unroll
            for (int m = 0; m < 4; ++m) { unsigned char* rowp = o + (size_t)(ai * HALF + wr * 64 + m * 16 + fr) * D_ + wc * 32 + 8 * fq;
#pragma unroll
                for (int bj = 0; bj < 2; ++bj) { const f32x4 v0 = acc[ai][bj][m][0] * sc, v1 = acc[ai][bj][m][1] * sc;
                    u32x2 w; w.x = pk_fp8x4(v0[0], v0[1], v0[2], v0[3]); w.y = pk_fp8x4(v1[0], v1[1], v1[2], v1[3]); *(u32x2*)(rowp + bj * HALF) = w; } }
    }
};
__device__ __forceinline__ unsigned rg_idx(unsigned tok, int c) { return ((((tok >> 12) * 64u + (unsigned)(c >> 4)) * (unsigned)S_ + (tok & (unsigned)(S_ - 1))) << 4) + (unsigned)(c & 15); }
struct EpiRgGates {
    bf16_t* LAo; bf16_t* Uo; const bf16_t* xc;
    const float* ba; const float* bx; const float* lam;
    __device__ __forceinline__ void operator()(const Acc& acc, const UnitD& u, int wr, int wc, int fr, int fq) const {
#pragma unroll
        for (int n = 0; n < 2; ++n) { const int c = u.t1 * 128 + wc * 32 + 8 * fq + 4 * n;
            const f32x4 vba = *(const f32x4*)(ba + c), vbx = *(const f32x4*)(bx + c), vl = *(const f32x4*)(lam + c);
            f32x4 c8; for (int j = 0; j < 4; ++j) c8[j] = -8.0f * softplusf_(-vl[j]);
#pragma unroll
            for (int ai = 0; ai < 2; ++ai)
#pragma unroll
                for (int m = 0; m < 4; ++m) { const unsigned tok = (unsigned)(u.t0 * BM + ai * HALF + wr * 64 + m * 16 + fr);
                    const u32x2 xw = *(const u32x2*)(xc + (tok * 1024u + (unsigned)c)); const float xv[4] = {bf_lo(xw.x), bf_hi(xw.x), bf_lo(xw.y), bf_hi(xw.y)};
                    f32x4 lv, uv;
#pragma unroll
                    for (int j = 0; j < 4; ++j) { const float r = sigmoidf_(acc[ai][0][m][n][j] + vba[j]), ig = sigmoidf_(acc[ai][1][m][n][j] + vbx[j]);
                        const float la = c8[j] * r, av = __expf(la); lv[j] = la; uv[j] = __builtin_amdgcn_sqrtf(fmaxf(0.f, 1.0f - av * av)) * ig * xv[j]; }
                    const unsigned o = rg_idx(tok, c);
                    u32x2 w0; w0.x = cvt_pk_bf16(lv[0], lv[1]); w0.y = cvt_pk_bf16(lv[2], lv[3]); *(u32x2*)(LAo + o) = w0;
                    u32x2 w1; w1.x = cvt_pk_bf16(uv[0], uv[1]); w1.y = cvt_pk_bf16(uv[2], uv[3]); *(u32x2*)(Uo + o) = w1; } }
    }
};


__device__ __forceinline__ void transpose_job8(const float* src, unsigned char* dst, int K, int N, int ldd, size_t sb, size_t db, int nbatch, LAS unsigned char* lds) {
    LAS float* tile = (LAS float*)lds;
    const int tid = TIDX, tk = K / 128, tn = N / 64, per = tk * tn, total = per * nbatch;
    for (int t = BID; t < total; t += NBLK) {
        const int b = t / per, r = t % per, ik = r / tn, in = r % tn;
        const float* sp = src + (size_t)b * sb + (size_t)(ik * 128) * N + in * 64;
        unsigned char* d = dst + (size_t)b * db + (size_t)(in * 64) * ldd + ik * 128;
#pragma unroll
        for (int i = 0; i < 4; ++i) { const int idx = tid + i * 512, rr = idx >> 4, c4 = (idx & 15) * 4;
            const f32x4 v = *(const f32x4*)(sp + (size_t)rr * N + c4);
            tile[rr * 65 + c4 + 0] = v[0]; tile[rr * 65 + c4 + 1] = v[1]; tile[rr * 65 + c4 + 2] = v[2]; tile[rr * 65 + c4 + 3] = v[3]; }
        __syncthreads();
        { const int n = tid >> 3, kg = (tid & 7) * 16; float f[16];
#pragma unroll
          for (int j = 0; j < 16; ++j) f[j] = tile[(kg + j) * 65 + n] * W8_SCALE;
          u32x4 w; w.x = pk_fp8x4(f[0], f[1], f[2], f[3]); w.y = pk_fp8x4(f[4], f[5], f[6], f[7]); w.z = pk_fp8x4(f[8], f[9], f[10], f[11]); w.w = pk_fp8x4(f[12], f[13], f[14], f[15]);
          *(u32x4*)(d + (size_t)n * ldd + kg) = w; }
        __syncthreads();
    }
}
__device__ __forceinline__ void transpose_job(const float* src, bf16_t* dst, int K, int N, int ldd, size_t sb, size_t db, int dalt, int nbatch, LAS unsigned char* lds) {
    LAS float* tile = (LAS float*)lds;
    const int tid = TIDX, tk = K / 64, tn = N / 64, per = tk * tn, total = per * nbatch;
    for (int t = BID; t < total; t += NBLK) {
        const int b = t / per, r = t % per, ik = r / tn, in = r % tn;
        const float* s = src + (size_t)b * sb + (size_t)(ik * 64) * N + in * 64;
        bf16_t* d = dst + (size_t)b * db + (size_t)(b & 1) * dalt + (size_t)(in * 64) * ldd + ik * 64;
#pragma unroll
        for (int i = 0; i < 2; ++i) { const int idx = tid + i * 512, rr = idx >> 4, c4 = (idx & 15) * 4;
            const f32x4 v = *(const f32x4*)(s + (size_t)rr * N + c4);
            tile[rr * 65 + c4 + 0] = v[0]; tile[rr * 65 + c4 + 1] = v[1]; tile[rr * 65 + c4 + 2] = v[2]; tile[rr * 65 + c4 + 3] = v[3]; }
        __syncthreads();
        { const int n = tid >> 3, kg = (tid & 7) * 8; float f[8];
#pragma unroll
          for (int j = 0; j < 8; ++j) f[j] = tile[(kg + j) * 65 + n];
          u32x4 w; w.x = cvt_pk_bf16(f[0], f[1]); w.y = cvt_pk_bf16(f[2], f[3]); w.z = cvt_pk_bf16(f[4], f[5]); w.w = cvt_pk_bf16(f[6], f[7]);
          *(u32x4*)(d + (size_t)n * ldd + kg) = w; }
        __syncthreads();
    }
}

__device__ __forceinline__ void moe_weight_jobs(const Args& a, int layer, LAS unsigned char* lds) {
    const size_t lo = (size_t)layer * NEXP * D_ * DEXP;
    transpose_job8(a.in[25] + lo, a.ws + WS_WG, D_, DEXP, D_, (size_t)D_ * DEXP, (size_t)DEXP * D_, NEXP, lds);
    transpose_job8(a.in[26] + lo, a.ws + WS_WU, D_, DEXP, D_, (size_t)D_ * DEXP, (size_t)DEXP * D_, NEXP, lds);
    transpose_job8(a.in[27] + lo, a.ws + WS_WD, DEXP, D_, DEXP, (size_t)D_ * DEXP, (size_t)DEXP * D_, NEXP, lds);
}

__device__ __forceinline__ void phase_prologue(const Args& a, LAS unsigned char* lds) {
    const int gtid = BID * NTHREADS + TIDX, gsz = NBLK * NTHREADS;
    for (int i = gtid; i < 1024; i += gsz) { const float l0 = a.in[12][i], l1 = a.in[12][1024 + i], mx = fmaxf(l0, l1), e0 = __expf(l0 - mx), e1 = __expf(l1 - mx);
        ((float*)(a.ws + WS_LB))[i] = e0 / (e0 + e1); }
    for (int it = gtid; it < 2 * 256 * 256; it += gsz) { const int l = it >> 16, n = (it >> 8) & 255, k8 = (it & 255) * 8; float f[8];
#pragma unroll
        for (int j = 0; j < 8; ++j) { const int k = k8 + j; f[j] = n < 8 ? a.in[21][((size_t)l * D_ + k) * 8 + n] : (n < 72 ? a.in[23][((size_t)l * D_ + k) * 64 + (n - 8)] : 0.f); }
        u32x4 w; w.x = cvt_pk_bf16(f[0], f[1]); w.y = cvt_pk_bf16(f[2], f[3]); w.z = cvt_pk_bf16(f[4], f[5]); w.w = cvt_pk_bf16(f[6], f[7]);
        *(u32x4*)((bf16_t*)(a.ws + WS_WRT) + ((size_t)l * 256 + n) * D_ + k8) = w; }
    for (int it = gtid; it < 192 * 128; it += gsz) *(u32x4*)(a.ws + WS_WIN1T + (size_t)N_IN1 * D_ + (size_t)it * 16) = (u32x4){0u, 0u, 0u, 0u};
    transpose_job(a.in[4], (bf16_t*)(a.ws + WS_WIN0T), D_, N_IN0, D_, 0, 0, 0, 1, lds);
    transpose_job(a.in[14], (bf16_t*)(a.ws + WS_WOUT0T), D_, D_, D_, 0, 0, 0, 1, lds);
    transpose_job8(a.in[15], a.ws + WS_WIN1T, D_, N_IN1, D_, 0, 0, 1, lds);
    transpose_job8(a.in[20], a.ws + WS_WOUT1T, 4096, D_, 4096, 0, 0, 1, lds);
    transpose_job(a.in[7], (bf16_t*)(a.ws + WS_WGATES), 128, 128, 128, 128 * 128, 256 * 128, 0, 8, lds);
    transpose_job(a.in[9], (bf16_t*)(a.ws + WS_WGATES) + 128 * 128, 128, 128, 128, 128 * 128, 256 * 128, 0, 8, lds);
    moe_weight_jobs(a, 0, lds);
}

template <int MODE>
__device__ __forceinline__ void phase_norm(const Args& a, const float* src, const float* gain, int layer) {
    const int wid = TIDX >> 6, lane = TIDX & 63;
    bf16_t* xw = (bf16_t*)(a.ws + WS_X); bf16_t* hw = (bf16_t*)(a.ws + WS_H);
    const unsigned char* ym = a.ws + WS_YMOE; const int* posof = (const int*)(a.ws + WS_POSOF); const float* gate = (const float*)(a.ws + WS_GATE);
    for (int row = BID * 8 + wid; row < T_; row += NBLK * 8) {
        f32x4 v[8];
#pragma unroll
        for (int i = 0; i < 8; ++i) { if (src) v[i] = *(const f32x4*)(src + (size_t)row * D_ + (i * 64 + lane) * 4);
            else { const u32x2 r = *(const u32x2*)(xw + (size_t)row * D_ + (i * 64 + lane) * 4); v[i] = (f32x4){bf_lo(r.x), bf_hi(r.x), bf_lo(r.y), bf_hi(r.y)}; } }
        if (MODE >= 1) {
            const int p0 = posof[row * 2], p1 = posof[row * 2 + 1]; const float g0 = gate[row * 2], g1 = gate[row * 2 + 1];
#pragma unroll
            for (int i = 0; i < 8; ++i) { const int c = (i * 64 + lane) * 4;
                const int y0 = *(const int*)(ym + (size_t)p0 * D_ + c), y1 = *(const int*)(ym + (size_t)p1 * D_ + c);
                const f32x2 a0 = __builtin_amdgcn_cvt_pk_f32_fp8(y0, false), a1 = __builtin_amdgcn_cvt_pk_f32_fp8(y0, true), b0 = __builtin_amdgcn_cvt_pk_f32_fp8(y1, false), b1 = __builtin_amdgcn_cvt_pk_f32_fp8(y1, true);
                v[i][0] += g0 * a0[0] + g1 * b0[0]; v[i][1] += g0 * a0[1] + g1 * b0[1]; v[i][2] += g0 * a1[0] + g1 * b1[0]; v[i][3] += g0 * a1[1] + g1 * b1[1]; }
            if (MODE == 1) {
#pragma unroll
                for (int i = 0; i < 8; ++i) { u32x2 w; w.x = cvt_pk_bf16(v[i][0], v[i][1]); w.y = cvt_pk_bf16(v[i][2], v[i][3]); *(u32x2*)(xw + (size_t)row * D_ + (i * 64 + lane) * 4) = w; } }
        }
        float ss = 0.f;
#pragma unroll
        for (int i = 0; i < 8; ++i) ss += v[i][0] * v[i][0] + v[i][1] * v[i][1] + v[i][2] * v[i][2] + v[i][3] * v[i][3];
        ss = wave_sum(ss);
        const float rstd = rsqrtf(ss * (1.0f / D_) + 1e-6f);
#pragma unroll
        for (int i = 0; i < 8; ++i) { const int c = (i * 64 + lane) * 4; const f32x4 g = *(const f32x4*)(gain + c);
            const f32x4 o = v[i] * rstd * g;
            if (MODE == 2) *(f32x4*)(a.out + (size_t)row * D_ + c) = o;
            else { if (MODE != 1) { u32x2 w; w.x = cvt_pk_bf16(o[0], o[1]); w.y = cvt_pk_bf16(o[2], o[3]); *(u32x2*)(hw + (size_t)row * D_ + c) = w; }
                   if (layer >= 0) *(unsigned*)(a.ws + WS_H8 + (size_t)row * D_ + c) = pk_fp8x4(o[0], o[1], o[2], o[3]); } }
    }
    (void)layer;
}

__device__ __forceinline__ void phase_gemm_in0(const Args& a, LAS unsigned char* lds) {
    SrcGrid S{(const char*)(a.ws + WS_H), (const char*)(a.ws + WS_WIN0T), (size_t)BM * D_ * 2, (size_t)BM * D_ * 2, 64, 64 * 24, D_, D_};
    EpiProj E{(bf16_t*)(a.ws + WS_PROJ), N_IN0, (float*)(a.ws + WS_FLOG), 1024, 12, 16, 256, 1.0f};
    gemm_stream<false, false>(lds, S, D_ / BK, E);
}

__device__ __forceinline__ void phase_rg_conv(const Args& a) {
    const bf16_t* p0 = (const bf16_t*)(a.ws + WS_PROJ); bf16_t* xc = (bf16_t*)(a.ws + WS_XC);
    const float* cw = a.in[5]; const float* cb = a.in[6];
    for (int it = BID * NTHREADS + TIDX; it < 128 * (T_ / 16); it += NBLK * NTHREADS) { const int c = (it & 127) * 8; const size_t t0 = (size_t)(it >> 7) * 16;
        float w[4][8], bias[8];
#pragma unroll
        for (int k = 0; k < 4; ++k) { const f32x4 w0 = *(const f32x4*)(cw + k * 1024 + c), w1 = *(const f32x4*)(cw + k * 1024 + c + 4);
            w[k][0] = w0[0]; w[k][1] = w0[1]; w[k][2] = w0[2]; w[k][3] = w0[3]; w[k][4] = w1[0]; w[k][5] = w1[1]; w[k][6] = w1[2]; w[k][7] = w1[3]; }
        { const f32x4 b0 = *(const f32x4*)(cb + c), b1 = *(const f32x4*)(cb + c + 4); bias[0] = b0[0]; bias[1] = b0[1]; bias[2] = b0[2]; bias[3] = b0[3]; bias[4] = b1[0]; bias[5] = b1[1]; bias[6] = b1[2]; bias[7] = b1[3]; }
        u32x4 x0 = (u32x4){0u, 0u, 0u, 0u}, x1 = x0, x2 = x0;
        if ((t0 & (S_ - 1)) != 0) { x0 = *(const u32x4*)(p0 + (t0 - 3) * N_IN0 + c); x1 = *(const u32x4*)(p0 + (t0 - 2) * N_IN0 + c); x2 = *(const u32x4*)(p0 + (t0 - 1) * N_IN0 + c); }
#pragma unroll 4
        for (int r = 0; r < 16; ++r) { const u32x4 x3 = *(const u32x4*)(p0 + (t0 + r) * N_IN0 + c);
            float acc[8];
#define TAPS(j, f, m) (bias[j] + w[0][j] * f(x0.m) + w[1][j] * f(x1.m) + w[2][j] * f(x2.m) + w[3][j] * f(x3.m))
            acc[0] = TAPS(0, bf_lo, x); acc[1] = TAPS(1, bf_hi, x); acc[2] = TAPS(2, bf_lo, y); acc[3] = TAPS(3, bf_hi, y);
            acc[4] = TAPS(4, bf_lo, z); acc[5] = TAPS(5, bf_hi, z); acc[6] = TAPS(6, bf_lo, w); acc[7] = TAPS(7, bf_hi, w);
#undef TAPS
            u32x4 o; o.x = cvt_pk_bf16(acc[0], acc[1]); o.y = cvt_pk_bf16(acc[2], acc[3]); o.z = cvt_pk_bf16(acc[4], acc[5]); o.w = cvt_pk_bf16(acc[6], acc[7]);
            *(u32x4*)(xc + (t0 + r) * 1024 + c) = o;
            x0 = x1; x1 = x2; x2 = x3; } }
}

struct SrcRgGates {
    const char* xc; const char* w; int total;
    __device__ __forceinline__ bool next(int i, UnitD& u) const { const int id = BID + i * NBLK; if (id >= total) return false; u.t0 = id & 63; u.t1 = id >> 6; u.t2 = 0;
        u.gA = xc + ((size_t)u.t0 * BM * 1024 + u.t1 * 128) * 2; u.gB = w + (size_t)u.t1 * 256 * 128 * 2; return true; }
    __device__ __forceinline__ void va(const UnitD&, unsigned (&v)[2][2]) const { offs_direct(v, 1024, false); }
    __device__ __forceinline__ void vb(unsigned (&v)[2][2]) const { offs_direct(v, 128, true); }
};
__device__ __forceinline__ void phase_rg_gates(const Args& a, LAS unsigned char* lds) {
    SrcRgGates S{(const char*)(a.ws + WS_XC), (const char*)(a.ws + WS_WGATES), 64 * 8};
    EpiRgGates E{(bf16_t*)(a.ws + WS_A), (bf16_t*)(a.ws + WS_U), (const bf16_t*)(a.ws + WS_XC), a.in[8], a.in[10], a.in[11]};
    int nt = 2; asm volatile("" : "+s"(nt));
    gemm_stream<false, false>(lds, S, nt, E);
}

__device__ __forceinline__ void phase_rg_scan(const Args& a, LAS unsigned char* lds) {
    const bf16_t* LA = (const bf16_t*)(a.ws + WS_A); const bf16_t* U = (const bf16_t*)(a.ws + WS_U);
    const bf16_t* p0 = (const bf16_t*)(a.ws + WS_PROJ); bf16_t* Y = (bf16_t*)(a.ws + WS_Y);
    LAS float* sP = (LAS float*)lds; LAS float* sH = sP + 4096; LAS float* gP = sH + 4096; LAS float* gH = gP + 512; LAS float* gC = gH + 512;
    const int tid = TIDX, seg = tid >> 1, c8 = (tid & 1) * 8;
    for (int blk = BID; blk < NB_ * 64; blk += NBLK) { const int b = blk >> 6, c = (blk & 63) * 16 + c8;
        const size_t base = (((size_t)blk * S_ + seg * 16) << 4) + c8;
        float P[8], H[8];
#pragma unroll
        for (int j = 0; j < 8; ++j) { P[j] = 1.f; H[j] = 0.f; }
#pragma unroll 4
        for (int s = 0; s < 16; ++s) { const u32x4 lw = *(const u32x4*)(LA + base + (size_t)s * 16), uw = *(const u32x4*)(U + base + (size_t)s * 16);
            const float la[8] = {bf_lo(lw.x), bf_hi(lw.x), bf_lo(lw.y), bf_hi(lw.y), bf_lo(lw.z), bf_hi(lw.z), bf_lo(lw.w), bf_hi(lw.w)};
            const float uu[8] = {bf_lo(uw.x), bf_hi(uw.x), bf_lo(uw.y), bf_hi(uw.y), bf_lo(uw.z), bf_hi(uw.z), bf_lo(uw.w), bf_hi(uw.w)};
#pragma unroll
            for (int j = 0; j < 8; ++j) { const float av = __expf(la[j]); H[j] = av * H[j] + uu[j]; P[j] *= av; } }
        __syncthreads();
#pragma unroll
        for (int j = 0; j < 8; ++j) { sP[seg * 16 + c8 + j] = P[j]; sH[seg * 16 + c8 + j] = H[j]; }
        __syncthreads();
        { const int ch = tid & 15, grp = tid >> 4; float p = 1.f, h = 0.f;
#pragma unroll
          for (int q = 0; q < 8; ++q) { const int sgi = grp * 8 + q; h = sP[sgi * 16 + ch] * h + sH[sgi * 16 + ch]; p *= sP[sgi * 16 + ch]; }
          gP[grp * 16 + ch] = p; gH[grp * 16 + ch] = h; }
        __syncthreads();
        if (tid < 16) { float carry = 0.f; for (int g = 0; g < 32; ++g) { gC[g * 16 + tid] = carry; carry = gP[g * 16 + tid] * carry + gH[g * 16 + tid]; } }
        __syncthreads();
        { const int ch = tid & 15, grp = tid >> 4; float h = gC[grp * 16 + ch];
#pragma unroll
          for (int q = 0; q < 8; ++q) { const int sgi = grp * 8 + q; const float pin = sP[sgi * 16 + ch], hin = sH[sgi * 16 + ch]; sH[sgi * 16 + ch] = h; h = pin * h + hin; } }
        __syncthreads();
#pragma unroll
        for (int j = 0; j < 8; ++j) H[j] = sH[seg * 16 + c8 + j];
#pragma unroll 4
        for (int s = 0; s < 16; ++s) { const u32x4 lw = *(const u32x4*)(LA + base + (size_t)s * 16), uw = *(const u32x4*)(U + base + (size_t)s * 16);
            const size_t t = (size_t)b * S_ + seg * 16 + s; const u32x4 gw = *(const u32x4*)(p0 + t * N_IN0 + 1024 + c);
            const float la[8] = {bf_lo(lw.x), bf_hi(lw.x), bf_lo(lw.y), bf_hi(lw.y), bf_lo(lw.z), bf_hi(lw.z), bf_lo(lw.w), bf_hi(lw.w)};
            const float uu[8] = {bf_lo(uw.x), bf_hi(uw.x), bf_lo(uw.y), bf_hi(uw.y), bf_lo(uw.z), bf_hi(uw.z), bf_lo(uw.w), bf_hi(uw.w)};
            const float gg[8] = {bf_lo(gw.x), bf_hi(gw.x), bf_lo(gw.y), bf_hi(gw.y), bf_lo(gw.z), bf_hi(gw.z), bf_lo(gw.w), bf_hi(gw.w)};
            float y[8];
#pragma unroll
            for (int j = 0; j < 8; ++j) { H[j] = __expf(la[j]) * H[j] + uu[j]; y[j] = H[j] * gelu_tanh(gg[j]); }
            u32x4 o; o.x = cvt_pk_bf16(y[0], y[1]); o.y = cvt_pk_bf16(y[2], y[3]); o.z = cvt_pk_bf16(y[4], y[5]); o.w = cvt_pk_bf16(y[6], y[7]);
            *(u32x4*)(Y + t * D_ + c) = o; }
    }
}

typedef short s16x4 __attribute__((ext_vector_type(4)));
__device__ __forceinline__ f32x4 mfma32(bf16x8 a, bf16x8 b, f32x4 c) { return __builtin_amdgcn_mfma_f32_16x16x32_bf16(a, b, c, 0, 0, 0); }
__device__ __forceinline__ bf16x8 lds_frag(LAS const unsigned char* p) { return *(const LAS bf16x8*)p; }
__device__ __forceinline__ s16x4 lds_tr4(LAS const unsigned char* p) { return __builtin_amdgcn_ds_read_tr16_b64_v4i16((LAS s16x4*)p); }
__device__ __forceinline__ bf16x8 lds_tr8(LAS const unsigned char* p, int rowskip_bytes) {
    const s16x4 lo = lds_tr4(p), hi = lds_tr4(p + rowskip_bytes); return __builtin_shufflevector(lo, hi, 0, 1, 2, 3, 4, 5, 6, 7); }
__device__ __forceinline__ bf16x8 pack8(const f32x4& lo, const f32x4& hi) { u32x4 w; w.x = cvt_pk_bf16(lo[0], lo[1]); w.y = cvt_pk_bf16(lo[2], lo[3]); w.z = cvt_pk_bf16(hi[0], hi[1]); w.w = cvt_pk_bf16(hi[2], hi[3]); return __builtin_bit_cast(bf16x8, w); }
constexpr int RSB = 272;

constexpr size_t WS_HQ = WS_O;
constexpr size_t WS_HA = WS_HQ + (size_t)2048 * 64 * 128 * 2;
constexpr size_t WS_HG = WS_HA + (size_t)2048 * 8 * 512 * 2;
constexpr size_t WS_HS = WS_HG + (size_t)2048 * 128 * 128 * 2;
constexpr size_t WS_HD = WS_HS + (size_t)2048 * 128 * 128 * 2;
static_assert(WS_HD + (size_t)2048 * 128 * 4 <= WS_TAIL, "hgrn overlay");

__device__ __forceinline__ void phase_hg1(const Args& a, LAS unsigned char* lds) {
    const bf16_t* p0 = (const bf16_t*)(a.ws + WS_PROJ); const float* flog = (const float*)(a.ws + WS_FLOG); const float* lb = (const float*)(a.ws + WS_LB);
    bf16_t* QG = (bf16_t*)(a.ws + WS_HQ); bf16_t* AG = (bf16_t*)(a.ws + WS_HA); bf16_t* GG = (bf16_t*)(a.ws + WS_HG); float* DG = (float*)(a.ws + WS_HD);
    constexpr int SEG = 0, QT = 4096, KT = QT + 64 * RSB, KH = KT + 64 * RSB, VS = KH + 64 * RSB;
    const int tid = TIDX, wid = tid >> 6, lane = tid & 63, I = lane & 15, G = lane >> 4, k2 = 2 * lane, sg = wid;
    LAS float* seg = (LAS float*)(lds + SEG);
    u32x4 pvv[2]; f32x2 pz[8]; unsigned pqw[8];
#define HG1_LOAD(it_) do { const int bh_ = (it_) >> 6, ck_ = (it_) & 63, h_ = bh_ & 7; const size_t t0_ = (size_t)(bh_ >> 3) * S_ + ck_ * 64; \
        _Pragma("unroll") for (int i = 0; i < 2; ++i) { const int c = tid + i * 512, s_ = c >> 4, v8 = (c & 15) * 8; pvv[i] = *(const u32x4*)(p0 + (t0_ + s_) * N_IN0 + 4096 + h_ * 128 + v8); } \
        _Pragma("unroll") for (int i = 0; i < 8; ++i) { const size_t t_ = t0_ + sg * 8 + i; pz[i] = *(const f32x2*)(flog + t_ * 1024 + h_ * 128 + k2); pqw[i] = *(const unsigned*)(p0 + t_ * N_IN0 + 2048 + h_ * 128 + k2); } } while (0)
    if (BID < 2048) HG1_LOAD(BID);
    for (int item = BID; item < 2048; item += NBLK) { const int bh = item >> 6, h = bh & 7;
        LDS_BARRIER();
#pragma unroll
        for (int i = 0; i < 2; ++i) { const int c = tid + i * 512, s = c >> 4, v8 = (c & 15) * 8; *(LAS u32x4*)(lds + VS + s * RSB + v8 * 2) = pvv[i]; }
        const f32x2 l2 = *(const f32x2*)(lb + h * 128 + k2);
        float f[8][2], cb[8][2]; unsigned qw[8]; float c0 = 0.f, c1 = 0.f;
#pragma unroll
        for (int i = 0; i < 8; ++i) { const f32x2 z = pz[i]; qw[i] = pqw[i];
            f[i][0] = l2[0] + (1.0f - l2[0]) * sigmoidf_(z[0]); f[i][1] = l2[1] + (1.0f - l2[1]) * sigmoidf_(z[1]);
            c0 += __logf(f[i][0]); c1 += __logf(f[i][1]); cb[i][0] = c0; cb[i][1] = c1; }
        *(LAS f32x2*)(seg + sg * 128 + k2) = (f32x2){c0, c1};
        if (item + NBLK < 2048) HG1_LOAD(item + NBLK);
        LDS_BARRIER();
        float off0 = 0.f, off1 = 0.f, tot0 = 0.f, tot1 = 0.f;
#pragma unroll
        for (int s2 = 0; s2 < 8; ++s2) { const f32x2 v = *(const LAS f32x2*)(seg + s2 * 128 + k2); tot0 += v[0]; tot1 += v[1]; if (s2 < sg) { off0 += v[0]; off1 += v[1]; } }
        const float et0 = __expf(tot0), et1 = __expf(tot1);
#pragma unroll
        for (int i = 0; i < 8; ++i) { const int t = sg * 8 + i;
            const float e0 = __expf(cb[i][0] + off0), e1 = __expf(cb[i][1] + off1), r0 = __builtin_amdgcn_rcpf(e0), r1 = __builtin_amdgcn_rcpf(e1), km0 = 1.0f - f[i][0], km1 = 1.0f - f[i][1];
            const unsigned qt = cvt_pk_bf16(siluf_(bf_lo(qw[i])) * e0, siluf_(bf_hi(qw[i])) * e1);
            *(LAS unsigned*)(lds + QT + t * RSB + k2 * 2) = qt; *(unsigned*)(QG + ((size_t)item * 64 + t) * 128 + k2) = qt;
            *(LAS unsigned*)(lds + KT + t * RSB + k2 * 2) = cvt_pk_bf16(km0 * r0, km1 * r1);
            *(LAS unsigned*)(lds + KH + t * RSB + k2 * 2) = cvt_pk_bf16(km0 * r0 * et0, km1 * r1 * et1); }
        if (sg == 0) *(f32x2*)(DG + (size_t)item * 128 + k2) = (f32x2){et0, et1};
        LDS_BARRIER();
        { const int tt = wid & 3, sp = wid >> 2;
          bf16x8 qf[4];
#pragma unroll
          for (int ks = 0; ks < 4; ++ks) qf[ks] = lds_frag(lds + QT + (16 * tt + I) * RSB + (32 * ks + 8 * G) * 2);
          f32x4 acc[2];
#pragma unroll
          for (int hh = 0; hh < 2; ++hh) { const int st = 2 * sp + hh; acc[hh] = (f32x4){0.f, 0.f, 0.f, 0.f};
              if (st <= tt) {
#pragma unroll
                  for (int ks = 0; ks < 4; ++ks) acc[hh] = mfma32(lds_frag(lds + KT + (16 * st + I) * RSB + (32 * ks + 8 * G) * 2), qf[ks], acc[hh]);
#pragma unroll
                  for (int r = 0; r < 4; ++r) if (16 * st + 4 * G + r > 16 * tt + I) acc[hh][r] = 0.f; } }
          *(bf16x8*)(AG + (((size_t)item * 4 + tt) * 2 + sp) * 512 + lane * 8) = pack8(acc[0], acc[1]); }
        { const int kt = wid, q = I >> 2, p = I & 3;
          bf16x8 ka[2];
#pragma unroll
          for (int ks = 0; ks < 2; ++ks) ka[ks] = lds_tr8(lds + KH + (32 * ks + 8 * G + q) * RSB + (16 * kt + 4 * p) * 2, 4 * RSB);
#pragma unroll
          for (int vt = 0; vt < 8; ++vt) { f32x4 acc = (f32x4){0.f, 0.f, 0.f, 0.f};
#pragma unroll
              for (int ks = 0; ks < 2; ++ks) acc = mfma32(ka[ks], lds_tr8(lds + VS + (32 * ks + 8 * G + q) * RSB + (16 * vt + 4 * p) * 2, 4 * RSB), acc);
              u32x2 w; w.x = cvt_pk_bf16(acc[0], acc[1]); w.y = cvt_pk_bf16(acc[2], acc[3]);
              *(u32x2*)(GG + ((size_t)item * 128 + 16 * vt + I) * 128 + 16 * kt + 4 * G) = w; } }
    }
#undef HG1_LOAD
}

__device__ __forceinline__ void phase_hg2(const Args& a) {
    const bf16_t* GG = (const bf16_t*)(a.ws + WS_HG); const float* DG = (const float*)(a.ws + WS_HD); bf16_t* SG = (bf16_t*)(a.ws + WS_HS);
    for (int gid = BID * NTHREADS + TIDX; gid < 32 * 4096; gid += NBLK * NTHREADS) { const int bh = gid >> 12, e = gid & 4095, v = e >> 5, k4 = (e & 31) * 4;
        f32x4 S = (f32x4){0.f, 0.f, 0.f, 0.f};
        for (int n = 0; n < 64; ++n) { const size_t item = (size_t)bh * 64 + n, o = (item * 128 + v) * 128 + k4;
            u32x2 w; w.x = cvt_pk_bf16(S[0], S[1]); w.y = cvt_pk_bf16(S[2], S[3]); *(u32x2*)(SG + o) = w;
            const f32x4 d = *(const f32x4*)(DG + item * 128 + k4); const u32x2 g = *(const u32x2*)(GG + o);
            S[0] = d[0] * S[0] + bf_lo(g.x); S[1] = d[1] * S[1] + bf_hi(g.x); S[2] = d[2] * S[2] + bf_lo(g.y); S[3] = d[3] * S[3] + bf_hi(g.y); } }
}

__device__ __forceinline__ void phase_hg3(const Args& a, LAS unsigned char* lds) {
    const bf16_t* p0 = (const bf16_t*)(a.ws + WS_PROJ); const bf16_t* QG = (const bf16_t*)(a.ws + WS_HQ); const bf16_t* AG = (const bf16_t*)(a.ws + WS_HA); const bf16_t* SG = (const bf16_t*)(a.ws + WS_HS);
    bf16_t* Y = (bf16_t*)(a.ws + WS_Y); const float* gain = a.in[13];
    constexpr int ST = 0, QT = 128 * RSB, VS = QT + 64 * RSB, PART = VS + 64 * RSB;
    const int tid = TIDX, wid = tid >> 6, lane = tid & 63, I = lane & 15, G = lane >> 4, q = I >> 2, p = I & 3;
    LAS float* part = (LAS float*)(lds + PART);
    const int tt = wid & 3, vh = wid >> 2;
    u32x4 ps[4], pq2[2], pv2[2]; bf16x8 paf[2];
#define HG3_LOAD(it_) do { const int bh_ = (it_) >> 6, ck_ = (it_) & 63; const size_t t0_ = (size_t)(bh_ >> 3) * S_ + ck_ * 64; const int h_ = bh_ & 7; \
        _Pragma("unroll") for (int i = 0; i < 4; ++i) { const int c = tid + i * 512, v = c >> 4, k8 = (c & 15) * 8; ps[i] = *(const u32x4*)(SG + ((size_t)(it_) * 128 + v) * 128 + k8); } \
        _Pragma("unroll") for (int i = 0; i < 2; ++i) { const int c = tid + i * 512, s_ = c >> 4, c8 = (c & 15) * 8; pq2[i] = *(const u32x4*)(QG + ((size_t)(it_) * 64 + s_) * 128 + c8); pv2[i] = *(const u32x4*)(p0 + (t0_ + s_) * N_IN0 + 4096 + h_ * 128 + c8); } \
        _Pragma("unroll") for (int sp = 0; sp < 2; ++sp) paf[sp] = *(const bf16x8*)(AG + (((size_t)(it_) * 4 + tt) * 2 + sp) * 512 + lane * 8); } while (0)
    if (BID < 2048) HG3_LOAD(BID);
    for (int item = BID; item < 2048; item += NBLK) { const int bh = item >> 6, ck = item & 63, b = bh >> 3, h = bh & 7; const size_t t0 = (size_t)b * S_ + ck * 64;
        LDS_BARRIER();
#pragma unroll
        for (int i = 0; i < 4; ++i) { const int c = tid + i * 512, v = c >> 4, k8 = (c & 15) * 8; *(LAS u32x4*)(lds + ST + v * RSB + k8 * 2) = ps[i]; }
#pragma unroll
        for (int i = 0; i < 2; ++i) { const int c = tid + i * 512, s2 = c >> 4, c8 = (c & 15) * 8; *(LAS u32x4*)(lds + QT + s2 * RSB + c8 * 2) = pq2[i]; *(LAS u32x4*)(lds + VS + s2 * RSB + c8 * 2) = pv2[i]; }
        bf16x8 af[2]; af[0] = paf[0]; af[1] = paf[1];
        if (item + NBLK < 2048) HG3_LOAD(item + NBLK);
        u32x2 zwp[4];
#pragma unroll
        for (int vi = 0; vi < 4; ++vi) zwp[vi] = *(const u32x2*)(p0 + (t0 + 16 * tt + I) * N_IN0 + 5120 + h * 128 + 16 * (4 * vh + vi) + 4 * G);
        LDS_BARRIER();
        bf16x8 qf[4];
#pragma unroll
        for (int ks = 0; ks < 4; ++ks) qf[ks] = lds_frag(lds + QT + (16 * tt + I) * RSB + (32 * ks + 8 * G) * 2);
        f32x4 acc[4]; float ss = 0.f;
#pragma unroll
        for (int vi = 0; vi < 4; ++vi) { const int vt = 4 * vh + vi; acc[vi] = (f32x4){0.f, 0.f, 0.f, 0.f};
#pragma unroll
            for (int ks = 0; ks < 4; ++ks) acc[vi] = mfma32(lds_frag(lds + ST + (16 * vt + I) * RSB + (32 * ks + 8 * G) * 2), qf[ks], acc[vi]);
#pragma unroll
            for (int sp = 0; sp < 2; ++sp) acc[vi] = mfma32(lds_tr8(lds + VS + (32 * sp + 4 * G + q) * RSB + (16 * vt + 4 * p) * 2, 16 * RSB), af[sp], acc[vi]);
            ss += acc[vi][0] * acc[vi][0] + acc[vi][1] * acc[vi][1] + acc[vi][2] * acc[vi][2] + acc[vi][3] * acc[vi][3]; }
        ss += __shfl_xor(ss, 16); ss += __shfl_xor(ss, 32);
        if (G == 0) part[wid * 16 + I] = ss;
        LDS_BARRIER();
        const float rstd = rsqrtf((part[wid * 16 + I] + part[(wid ^ 4) * 16 + I]) * (1.0f / 128.0f) + 1e-6f);
        const size_t t = t0 + 16 * tt + I;
#pragma unroll
        for (int vi = 0; vi < 4; ++vi) { const int c = h * 128 + 16 * (4 * vh + vi) + 4 * G;
            const f32x4 gn = *(const f32x4*)(gain + c); const u32x2 zw = zwp[vi];
            const float o0 = acc[vi][0] * rstd * gn[0] * siluf_(bf_lo(zw.x)), o1 = acc[vi][1] * rstd * gn[1] * siluf_(bf_hi(zw.x)), o2 = acc[vi][2] * rstd * gn[2] * siluf_(bf_lo(zw.y)), o3 = acc[vi][3] * rstd * gn[3] * siluf_(bf_hi(zw.y));
            u32x2 w; w.x = cvt_pk_bf16(o0, o1); w.y = cvt_pk_bf16(o2, o3); *(u32x2*)(Y + t * D_ + 1024 + c) = w; }
    }
#undef HG3_LOAD
}

__device__ __forceinline__ void phase_gdn_norm(const Args& a) {
    const bf16_t* O = (const bf16_t*)(a.ws + WS_O); const bf16_t* pj = (const bf16_t*)(a.ws + WS_PROJ); unsigned char* Y = a.ws + WS_Y; const float* gain = a.in[19];
    const int lane = TIDX & 63, wid = TIDX >> 6, gc = (lane & 15) * 8;
    const f32x4 g0 = *(const f32x4*)(gain + gc), g1 = *(const f32x4*)(gain + gc + 4);
    for (int row = BID * 8 + wid; row < T_; row += NBLK * 8) {
#pragma unroll 4
        for (int i = 0; i < 8; ++i) { const int c = (i * 64 + lane) * 8;
            const u32x4 ow = *(const u32x4*)(O + (size_t)row * 4096 + c), zw = *(const u32x4*)(pj + (size_t)row * N_IN1P + 8192 + c);
            const float o[8] = {bf_lo(ow.x), bf_hi(ow.x), bf_lo(ow.y), bf_hi(ow.y), bf_lo(ow.z), bf_hi(ow.z), bf_lo(ow.w), bf_hi(ow.w)};
            const float z[8] = {bf_lo(zw.x), bf_hi(zw.x), bf_lo(zw.y), bf_hi(zw.y), bf_lo(zw.z), bf_hi(zw.z), bf_lo(zw.w), bf_hi(zw.w)};
            float ss = 0.f;
#pragma unroll
            for (int q = 0; q < 8; ++q) ss += o[q] * o[q];
            ss = row16_sum(ss);
            const float rstd = rsqrtf(ss * (1.0f / 128.0f) + 1e-6f);
            float y[8];
#pragma unroll
            for (int q = 0; q < 8; ++q) y[q] = o[q] * rstd * (q < 4 ? g0[q & 3] : g1[q & 3]) * siluf_(z[q]);
            u32x2 w; w.x = pk_fp8x4(y[0], y[1], y[2], y[3]); w.y = pk_fp8x4(y[4], y[5], y[6], y[7]);
            *(u32x2*)(Y + (size_t)row * 4096 + c) = w; }
    }
}

template <bool FP8>
__device__ __forceinline__ void phase_gemm_out(const Args& a, LAS unsigned char* lds, int K, const void* w, const float* xin) {
    const int eb = FP8 ? 1 : 2;
    SrcGrid S{(const char*)(a.ws + WS_Y), (const char*)w, (size_t)BM * K * eb, (size_t)BM * K * eb, 64, 64 * 8, K * eb / 2, K * eb / 2};
    EpiResid E{(bf16_t*)(a.ws + WS_X), xin, (const bf16_t*)(a.ws + WS_X), FP8 ? 1.0f / W8_SCALE : 1.0f};
    gemm_stream<false, FP8>(lds, S, K * eb / 128, E);
}

struct SrcRouter {
    const char* h; const char* w;
    __device__ __forceinline__ bool next(int i, UnitD& u) const { const int id = BID + i * NBLK; if (id >= 256) return false; u.t0 = id & 63; u.t1 = id >> 6; u.t2 = 0;
        u.gA = h + ((size_t)u.t0 * BM * D_ + u.t1 * 512) * 2; u.gB = w + (size_t)u.t1 * 512 * 2; return true; }
    __device__ __forceinline__ void va(const UnitD&, unsigned (&v)[2][2]) const { offs_direct(v, D_, false); }
    __device__ __forceinline__ void vb(unsigned (&v)[2][2]) const { offs_direct(v, D_, true); }
};
struct EpiLogitsQ {
    float* O;
    __device__ __forceinline__ void operator()(const Acc& acc, const UnitD& u, int wr, int wc, int fr, int fq) const { store_f32_tile(acc, O + ((size_t)u.t1 * T_ + (size_t)u.t0 * BM) * 128, nullptr, 128, 128, wr, wc, fr, fq); }
};
__device__ __forceinline__ void phase_gemm_router(const Args& a, LAS unsigned char* lds, int layer) {
    SrcRouter S{(const char*)(a.ws + WS_H), (const char*)(a.ws + WS_WRT) + (size_t)layer * 256 * D_ * 2};
    EpiLogitsQ E{(float*)(a.ws + WS_O)};
    gemm_stream<false, false>(lds, S, 512 / BK, E);
}

__device__ __forceinline__ void phase_route(const Args& a, int layer) {
    const float* lg = (const float*)(a.ws + WS_O); const float* bg = a.in[22] + layer * 8; const float* be = a.in[24] + layer * 64;
    int* cnt = (int*)(a.ws + WS_CTL + CTL_CNT) + layer * 64;
    int* eid = (int*)(a.ws + WS_EID); int* slot = (int*)(a.ws + WS_SLOT); float* gate = (float*)(a.ws + WS_GATE); int* rowmap = (int*)(a.ws + WS_ROWMAP);
    const int gtid = BID * NTHREADS + TIDX, gsz = NBLK * NTHREADS;
    for (int i = gtid; i < MPAD; i += gsz) rowmap[i] = 0;
    for (int t = gtid; t < T_; t += gsz) {
        f32x4 ga = (f32x4){0.f, 0.f, 0.f, 0.f}, gb = ga;
#pragma unroll
        for (int kq = 0; kq < 4; ++kq) { ga += *(const f32x4*)(lg + ((size_t)kq * T_ + t) * 128); gb += *(const f32x4*)(lg + ((size_t)kq * T_ + t) * 128 + 4); }
        const float gl[8] = {ga[0] + bg[0], ga[1] + bg[1], ga[2] + bg[2], ga[3] + bg[3], gb[0] + bg[4], gb[1] + bg[5], gb[2] + bg[6], gb[3] + bg[7]};
        float mx = -3.0e38f; int gi = 0;
#pragma unroll
        for (int j = 0; j < 8; ++j) if (gl[j] > mx) { mx = gl[j]; gi = j; }
        float se = 0.f;
#pragma unroll
        for (int j = 0; j < 8; ++j) se += __expf(gl[j] - mx);
        const float gp = 1.0f / se;
        f32x4 ea = *(const f32x4*)(be + gi * 8), eb = *(const f32x4*)(be + gi * 8 + 4);
#pragma unroll
        for (int kq = 0; kq < 4; ++kq) { ea += *(const f32x4*)(lg + ((size_t)kq * T_ + t) * 128 + 8 + gi * 8); eb += *(const f32x4*)(lg + ((size_t)kq * T_ + t) * 128 + 12 + gi * 8); }
        const float el[8] = {ea[0], ea[1], ea[2], ea[3], eb[0], eb[1], eb[2], eb[3]};
        float l1 = -3.0e38f, l2 = -3.0e38f; int i1 = 0, i2 = 0;
#pragma unroll
        for (int j = 0; j < 8; ++j) { const float v = el[j];
            if (v > l1) { l2 = l1; i2 = i1; l1 = v; i1 = j; } else if (v > l2) { l2 = v; i2 = j; } }
        const float e2 = __expf(l2 - l1), inv = 1.0f / (1.0f + e2);
        const int e0 = gi * 8 + i1, e1 = gi * 8 + i2;
        eid[t * 2] = e0; eid[t * 2 + 1] = e1; gate[t * 2] = inv * gp; gate[t * 2 + 1] = e2 * inv * gp;
        slot[t * 2] = atomicAdd(&cnt[e0], 1); slot[t * 2 + 1] = atomicAdd(&cnt[e1], 1); }
}

__device__ __forceinline__ void phase_rowmap(const Args& a, LAS unsigned char* lds, int layer) {
    const int* cnt = (const int*)(a.ws + WS_CTL + CTL_CNT) + layer * 64; LAS int* ps = (LAS int*)lds;
    int* tinfo = (int*)(a.ws + WS_TINFO) + layer * 512;
    const int* eid = (const int*)(a.ws + WS_EID); const int* slot = (const int*)(a.ws + WS_SLOT); int* posof = (int*)(a.ws + WS_POSOF); int* rowmap = (int*)(a.ws + WS_ROWMAP);
    __syncthreads();
    if (TIDX == 0) { int acc = 0; for (int e = 0; e < 64; ++e) { ps[e] = acc; acc += (cnt[e] + 255) & ~255; } ps[64] = acc; }
    __syncthreads();
    if (BID == 0) { if (TIDX <= 64) tinfo[TIDX] = ps[TIDX]; if (TIDX == 65) tinfo[65] = ps[64] >> 8;
        if (TIDX < 192) { const int p = TIDX * 256; int e = 0; for (int j = 0; j < 64; ++j) if (ps[j + 1] <= p) e = j + 1; tinfo[128 + TIDX] = e < 64 ? e : 63; } }
    for (int i = BID * NTHREADS + TIDX; i < T_ * 2; i += NBLK * NTHREADS) { const int p = ps[eid[i]] + slot[i]; posof[i] = p; rowmap[p] = i >> 1; }
    __syncthreads();
}

struct SrcMoeUp {
    const char* h; const char* wg; const int* tinfo; const int* rowmap; int total;
    __device__ __forceinline__ bool next(int i, UnitD& u) const { const int id = BID + i * NBLK; if (id >= total) return false; u.t0 = id >> 2; u.t1 = id & 3;
        u.t2 = __builtin_amdgcn_readfirstlane(tinfo[128 + u.t0]); u.gA = h; u.gB = wg + ((size_t)u.t2 * DEXP + u.t1 * 128) * D_; return true; }
    __device__ __forceinline__ void va(const UnitD& u, unsigned (&v)[2][2]) const { int R0, C0; stage_pos(TIDX, R0, C0);
#pragma unroll
        for (int hh = 0; hh < 2; ++hh)
#pragma unroll
            for (int i = 0; i < 2; ++i) v[hh][i] = (unsigned)(rowmap[u.t0 * 256 + hh * 128 + R0 + 64 * i] * D_ + C0 * 2); }
    __device__ __forceinline__ void vb(unsigned (&v)[2][2]) const { int R0, C0; stage_pos(TIDX, R0, C0);
#pragma unroll
        for (int i = 0; i < 2; ++i) { const int Rr = perm_row(R0 + 64 * i); v[0][i] = (unsigned)(Rr * D_ + C0 * 2); v[1][i] = (unsigned)(WS_WU - WS_WG) + (unsigned)(Rr * D_ + C0 * 2); } }
};
__device__ __forceinline__ void phase_moe_up(const Args& a, LAS unsigned char* lds, int layer) {
    const int* tinfo = (const int*)(a.ws + WS_TINFO) + layer * 512;
    const int ntm = __builtin_amdgcn_readfirstlane(tinfo[65]);
    SrcMoeUp S{(const char*)(a.ws + WS_H8), (const char*)(a.ws + WS_WG), tinfo, (const int*)(a.ws + WS_ROWMAP), ntm * 4};
    EpiSwiGLU E{a.ws + WS_ACT};
    gemm_stream<true, true>(lds, S, D_ / 128, E);
}

struct SrcMoeDown {
    const char* act; const char* wd; const int* tinfo; int total;
    __device__ __forceinline__ bool next(int i, UnitD& u) const { const int id = BID + i * NBLK; if (id >= total) return false; u.t0 = id >> 3; u.t1 = id & 7;
        u.t2 = __builtin_amdgcn_readfirstlane(tinfo[128 + u.t0]); u.gA = act + (size_t)u.t0 * BM * DEXP; u.gB = wd + ((size_t)u.t2 * D_ + u.t1 * BM) * DEXP; return true; }
    __device__ __forceinline__ void va(const UnitD&, unsigned (&v)[2][2]) const { offs_direct(v, DEXP / 2, false); }
    __device__ __forceinline__ void vb(unsigned (&v)[2][2]) const { offs_direct(v, DEXP / 2, true); }
};
__device__ __forceinline__ void phase_moe_down(const Args& a, LAS unsigned char* lds, int layer) {
    const int* tinfo = (const int*)(a.ws + WS_TINFO) + layer * 512; const int ntm = __builtin_amdgcn_readfirstlane(tinfo[65]);
    SrcMoeDown S{(const char*)(a.ws + WS_ACT), (const char*)(a.ws + WS_WD), tinfo, ntm * 8};
    EpiDown E{a.ws + WS_YMOE};
    gemm_stream<false, true>(lds, S, DEXP / 128, E);
}

struct SrcIn1Tail {
    const char* h; const char* w;
    __device__ __forceinline__ bool next(int i, UnitD& u) const { const int id = BID + i * NBLK; if (id >= 256) return false; u.t0 = id & 63; u.t1 = id >> 6; u.t2 = 0;
        u.gA = h + (size_t)u.t0 * BM * D_ + u.t1 * 512; u.gB = w + (size_t)48 * BM * D_ + u.t1 * 512; return true; }
    __device__ __forceinline__ void va(const UnitD&, unsigned (&v)[2][2]) const { offs_direct(v, D_ / 2, false); }
    __device__ __forceinline__ void vb(unsigned (&v)[2][2]) const { offs_direct(v, D_ / 2, true); }
};
struct EpiTailQ {
    float* O;
    __device__ __forceinline__ void operator()(const Acc& acc, const UnitD& u, int wr, int wc, int fr, int fq) const { store_f32_tile(acc, O + ((size_t)u.t1 * T_ + (size_t)u.t0 * BM) * 64, nullptr, 64, 64, wr, wc, fr, fq, 1.0f / W8_SCALE); }
};
__device__ __forceinline__ void phase_gemm_in1(const Args& a, LAS unsigned char* lds) {
    SrcGrid S{(const char*)(a.ws + WS_H8), (const char*)(a.ws + WS_WIN1T), (size_t)BM * D_, (size_t)BM * D_, 64, 64 * 48, D_ / 2, D_ / 2};
    EpiProj E{(bf16_t*)(a.ws + WS_PROJ), N_IN1P, nullptr, 64, 48, 48, 64, 1.0f / W8_SCALE};
    gemm_stream<false, true>(lds, S, D_ / 128, E);
}
__device__ __forceinline__ void phase_gemm_in1_tail(const Args& a, LAS unsigned char* lds) {
    SrcIn1Tail S{(const char*)(a.ws + WS_H8), (const char*)(a.ws + WS_WIN1T)};
    EpiTailQ E{(float*)(a.ws + WS_O)};
    int nt = 4; asm volatile("" : "+s"(nt));
    gemm_stream<false, true>(lds, S, nt, E);
}

__device__ __forceinline__ void phase_gdn_conv(const Args& a) {
    const bf16_t* p1 = (const bf16_t*)(a.ws + WS_PROJ); bf16_t* qc = (bf16_t*)(a.ws + WS_QKVC); const float* cw = a.in[16];
    const int gtid = BID * NTHREADS + TIDX, gsz = NBLK * NTHREADS;
    for (int it = gtid; it < 1024 * (T_ / 128); it += gsz) { const int c = (it & 1023) * 8, seg = it >> 10; const size_t t0 = (size_t)seg * 128;
        float w[4][8];
#pragma unroll
        for (int k = 0; k < 4; ++k) { const f32x4 w0 = *(const f32x4*)(cw + k * 8192 + c), w1 = *(const f32x4*)(cw + k * 8192 + c + 4);
            w[k][0] = w0[0]; w[k][1] = w0[1]; w[k][2] = w0[2]; w[k][3] = w0[3]; w[k][4] = w1[0]; w[k][5] = w1[1]; w[k][6] = w1[2]; w[k][7] = w1[3]; }
        u32x4 x0 = (u32x4){0u, 0u, 0u, 0u}, x1 = x0, x2 = x0;
        if ((t0 & (S_ - 1)) != 0) { x0 = *(const u32x4*)(p1 + (t0 - 3) * N_IN1P + c); x1 = *(const u32x4*)(p1 + (t0 - 2) * N_IN1P + c); x2 = *(const u32x4*)(p1 + (t0 - 1) * N_IN1P + c); }
        const float qsc = c < 2048 ? 0.08838834764831845f : 1.0f;
#pragma unroll 8
        for (int r = 0; r < 128; ++r) { const u32x4 x3 = *(const u32x4*)(p1 + (t0 + r) * N_IN1P + c);
            float acc[8];
#define TAPS(j, f, m) (w[0][j] * f(x0.m) + w[1][j] * f(x1.m) + w[2][j] * f(x2.m) + w[3][j] * f(x3.m))
            acc[0] = TAPS(0, bf_lo, x); acc[1] = TAPS(1, bf_hi, x); acc[2] = TAPS(2, bf_lo, y); acc[3] = TAPS(3, bf_hi, y);
            acc[4] = TAPS(4, bf_lo, z); acc[5] = TAPS(5, bf_hi, z); acc[6] = TAPS(6, bf_lo, w); acc[7] = TAPS(7, bf_hi, w);
#undef TAPS
            float ss = 0.f;
#pragma unroll
            for (int j = 0; j < 8; ++j) { acc[j] = siluf_(acc[j]); ss += acc[j] * acc[j]; }
            ss = row16_sum(ss);
            const float sc = c < 4096 ? rsqrtf(ss + 1e-6f) * qsc : 1.0f;
            u32x4 o; o.x = cvt_pk_bf16(acc[0] * sc, acc[1] * sc); o.y = cvt_pk_bf16(acc[2] * sc, acc[3] * sc); o.z = cvt_pk_bf16(acc[4] * sc, acc[5] * sc); o.w = cvt_pk_bf16(acc[6] * sc, acc[7] * sc);
            *(u32x4*)(qc + (t0 + r) * 8192 + c) = o;
            x0 = x1; x1 = x2; x2 = x3; } }
    const float* tail = (const float*)(a.ws + WS_O); float* bgo = (float*)(a.ws + WS_BG);
    for (int it = gtid; it < T_ * 32; it += gsz) { const int t = it >> 5, hv = it & 31; float tb = 0.f, ta = 0.f;
#pragma unroll
        for (int kq = 0; kq < 4; ++kq) { tb += tail[((size_t)kq * T_ + t) * 64 + hv]; ta += tail[((size_t)kq * T_ + t) * 64 + 32 + hv]; }
        bgo[t * 64 + hv] = sigmoidf_(tb);
        bgo[t * 64 + 32 + hv] = -__expf(a.in[17][hv]) * softplusf_(ta + a.in[18][hv]); }
}

struct MoeTile { const float* src; unsigned char* dst; int lds_, ldd; };
__device__ __forceinline__ MoeTile moe_tile(const Args& a, int g) {
    const int job = g >> 14, r = g & 16383, e = r >> 8, rr = r & 255; MoeTile t;
    typedef __attribute__((address_space(1))) const float* gcf; gcf s25 = (gcf)a.in[25], s26 = (gcf)a.in[26]; asm volatile("" : "+s"(s25), "+s"(s26));
    if (job < 2) { const int ik = rr >> 3, in = rr & 7; t.lds_ = DEXP; t.ldd = D_;
        t.src = (const float*)(job ? s26 : s25) + ((size_t)(NEXP + e) * D_ + ik * 64) * DEXP + in * 64; t.dst = a.ws + (job ? WS_WU : WS_WG) + ((size_t)e * DEXP + in * 64) * D_ + ik * 64; }
    else { const int ik = rr >> 5, in = rr & 31; t.lds_ = D_; t.ldd = DEXP;
        t.src = a.in[27] + ((size_t)(NEXP + e) * DEXP + ik * 64) * D_ + in * 64; t.dst = a.ws + WS_WD + ((size_t)e * D_ + in * 64) * DEXP + ik * 64; }
    return t;
}
__device__ __forceinline__ void moe_tile_load(const MoeTile& t, int tid, f32x4 (&v)[2]) {
#pragma unroll
    for (int i = 0; i < 2; ++i) { const int idx = tid + i * 512, rr = idx >> 4, c4 = (idx & 15) * 4; v[i] = *(const f32x4*)(t.src + (size_t)rr * t.lds_ + c4); }
}
__device__ __forceinline__ void moe_tile_store(const MoeTile& t, int tid, const f32x4 (&v)[2], LAS float* tile) {
#pragma unroll
    for (int i = 0; i < 2; ++i) { const int idx = tid + i * 512, rr = idx >> 4, c4 = (idx & 15) * 4;
        tile[rr * 65 + c4 + 0] = v[i][0]; tile[rr * 65 + c4 + 1] = v[i][1]; tile[rr * 65 + c4 + 2] = v[i][2]; tile[rr * 65 + c4 + 3] = v[i][3]; }
    LDS_BARRIER();
    { const int n = tid >> 3, kg = (tid & 7) * 8; float f[8];
#pragma unroll
      for (int jj = 0; jj < 8; ++jj) f[jj] = tile[(kg + jj) * 65 + n] * W8_SCALE;
      u32x2 w; w.x = pk_fp8x4(f[0], f[1], f[2], f[3]); w.y = pk_fp8x4(f[4], f[5], f[6], f[7]);
      *(u32x2*)(t.dst + (size_t)n * t.ldd + kg) = w; }
    LDS_BARRIER();
}
constexpr int MOE_TILES = 3 * NEXP * 256;

__device__ __forceinline__ f32x4 mfma16(s16x4 a, s16x4 b, f32x4 c) { return __builtin_amdgcn_mfma_f32_16x16x16bf16_1k(a, b, c, 0, 0, 0); }
__device__ __forceinline__ bf16x8 lds_pfrag(LAS const unsigned char* p) { const s16x4 lo = *(const LAS s16x4*)p, hi = *(const LAS s16x4*)(p + 32); return __builtin_shufflevector(lo, hi, 0, 1, 2, 3, 4, 5, 6, 7); }
__device__ __forceinline__ s16x4 pack4(const f32x4& v) { u32x2 w; w.x = cvt_pk_bf16(v[0], v[1]); w.y = cvt_pk_bf16(v[2], v[3]); return __builtin_bit_cast(s16x4, w); }
__device__ __forceinline__ void phase_gdn_chunk(const Args& a, LAS unsigned char* lds) {
    const bf16_t* qc = (const bf16_t*)(a.ws + WS_QKVC); const float* bgi = (const float*)(a.ws + WS_BG); bf16_t* O = (bf16_t*)(a.ws + WS_O);
    constexpr int VRS = 144, KTRS = 136;
    constexpr int KT = 0, QS = KT + 128 * KTRS, WSL = QS + 64 * RSB, QKS = WSL + 64 * RSB, EE = QKS + 2048, EDD = EE + 256, SET = EDD + 256;
    constexpr int KS = 2 * SET, VS = KS + 64 * RSB, X2 = VS + 64 * VRS, LS = X2 + 2048, X1 = LS + 4096, GAM = X1 + 2048, BET = GAM + 256, LEND = BET + 256;
    static_assert(LEND <= LDS_XBW, "gdn lds");
    const int wid = __builtin_amdgcn_readfirstlane(TIDX >> 6);
    const int NCK = S_ / 64;
    for (int blk = BID; blk < NB_ * 32 * 2; blk += NBLK) { const int b = blk >> 6, hv = (blk >> 1) & 31, vhalf = blk & 1, hk = hv >> 1;
        __syncthreads();
        if (wid < 4) {
            const int vt = wid;
            f32x4 Sacc[8];
#pragma unroll
            for (int n = 0; n < 8; ++n) Sacc[n] = (f32x4){0.f, 0.f, 0.f, 0.f};
            int lz = TIDX & 63; asm volatile("" : "+v"(lz));
            const int lane = lz, I = lane & 15, G = lane >> 4, q4 = I >> 2, p4 = I & 3;
            for (int it = 0; it <= NCK; ++it) {
                const int set = ((it - 1) & 1) * SET; const size_t t0 = (size_t)b * S_ + (size_t)(it - 1) * 64;
                f32x4 U[4];
                if (it >= 1) {
#pragma unroll
                    for (int sa = 0; sa < 4; ++sa) U[sa] = mfma16(*(const LAS s16x4*)(lds + X2 + ((sa * 16 + I) * 16 + 4 * G) * 2), lds_tr4(lds + VS + (16 * sa + 4 * G + q4) * VRS + (16 * vt + 4 * p4) * 2), (f32x4){0.f, 0.f, 0.f, 0.f});
                    asm volatile("" : "+v"(U[0]), "+v"(U[1]), "+v"(U[2]), "+v"(U[3]) :: "memory");
                }
#pragma unroll
                for (int sa = 0; sa < 4; ++sa) {
                    if (it >= 1) {
                        bf16x8 sf[4];
#pragma unroll
                        for (int ks = 0; ks < 4; ++ks) sf[ks] = __builtin_shufflevector(pack4(Sacc[2 * ks]), pack4(Sacc[2 * ks + 1]), 0, 1, 2, 3, 4, 5, 6, 7);
                        s16x4 kt[8];
#pragma unroll
                        for (int dt = 0; dt < 8; ++dt) kt[dt] = *(const LAS s16x4*)(lds + set + KT + (16 * dt + I) * KTRS + (16 * sa + 4 * G) * 2);
                        f32x4 dl = U[sa], oq = (f32x4){0.f, 0.f, 0.f, 0.f};
#pragma unroll
                        for (int ks = 0; ks < 4; ++ks) { dl = mfma32(lds_pfrag(lds + set + WSL + (16 * sa + I) * RSB + (32 * ks + 4 * G) * 2), sf[ks], dl);
                            oq = mfma32(lds_pfrag(lds + set + QS + (16 * sa + I) * RSB + (32 * ks + 4 * G) * 2), sf[ks], oq); }
                        const s16x4 dfrag = pack4(dl);
                        const f32x4 e4 = *(const LAS f32x4*)(lds + set + EE + (16 * sa + 4 * G) * 4);
                        oq = mfma16(*(const LAS s16x4*)(lds + set + QKS + ((sa * 16 + I) * 16 + 4 * G) * 2), dfrag, oq * e4);
#pragma unroll
                        for (int r = 0; r < 4; ++r) O[(t0 + 16 * sa + 4 * G + r) * 4096 + hv * 128 + vhalf * 64 + 16 * vt + I] = f2bf(oq[r]);
                        const f32x4 ed4 = *(const LAS f32x4*)(lds + set + EDD + (16 * sa + 4 * G) * 4); const float e15 = *(const LAS float*)(lds + set + EE + (16 * sa + 15) * 4);
                        const s16x4 dsc = pack4(dl * ed4);
#pragma unroll
                        for (int dt = 0; dt < 8; ++dt) {
                            Sacc[dt] = mfma16(kt[dt], dsc, Sacc[dt] * e15); }
                    }
                    LDS_BARRIER();
                }
            }
        } else {
            const int pw = wid - 4;
            u32x4 pq[4], pk[4], pv[2]; float pb = 0.f, pg = 0.f;
            { const int ptid = TIDX - 256; const size_t t0 = (size_t)b * S_;
#pragma unroll
              for (int i = 0; i < 4; ++i) { const int c = ptid + i * 256, s2 = c >> 4, c8 = (c & 15) * 8; pq[i] = *(const u32x4*)(qc + (t0 + s2) * 8192 + hk * 128 + c8); pk[i] = *(const u32x4*)(qc + (t0 + s2) * 8192 + 2048 + hk * 128 + c8); }
#pragma unroll
              for (int i = 0; i < 2; ++i) { const int c = ptid + i * 256, s2 = c >> 3, c8 = (c & 7) * 8; pv[i] = *(const u32x4*)(qc + (t0 + s2) * 8192 + 4096 + hv * 128 + vhalf * 64 + c8); }
              if (pw == 1) { pb = bgi[(t0 + ptid - 64) * 64 + hv]; pg = bgi[(t0 + ptid - 64) * 64 + 32 + hv]; } }
            int lz = TIDX & 63; asm volatile("" : "+v"(lz));
            const int lane = lz, ptid = pw * 64 + lane, I = lane & 15, G = lane >> 4, q4 = I >> 2, p4 = I & 3;
            for (int it = 0; it <= NCK; ++it) {
                const int set = (it & 1) * SET; const bool act = it < NCK;
                if (act) {
#pragma unroll
                    for (int i = 0; i < 4; ++i) { const int c = ptid + i * 256, s2 = c >> 4, c8 = (c & 15) * 8; *(LAS u32x4*)(lds + set + QS + s2 * RSB + c8 * 2) = pq[i]; *(LAS u32x4*)(lds + KS + s2 * RSB + c8 * 2) = pk[i]; }
                    if (pw == 1) { float x = pg;
                        x += __builtin_bit_cast(float, __builtin_amdgcn_update_dpp(0, __builtin_bit_cast(int, x), 0x111, 0xf, 0xf, true));
                        x += __builtin_bit_cast(float, __builtin_amdgcn_update_dpp(0, __builtin_bit_cast(int, x), 0x112, 0xf, 0xf, true));
                        x += __builtin_bit_cast(float, __builtin_amdgcn_update_dpp(0, __builtin_bit_cast(int, x), 0x114, 0xf, 0xf, true));
                        x += __builtin_bit_cast(float, __builtin_amdgcn_update_dpp(0, __builtin_bit_cast(int, x), 0x118, 0xf, 0xf, true));
                        const float g15 = __shfl(x, 15, 16);
                        *(LAS float*)(lds + GAM + lane * 4) = x; *(LAS float*)(lds + set + EE + lane * 4) = __expf(x); *(LAS float*)(lds + set + EDD + lane * 4) = __expf(g15 - x); *(LAS float*)(lds + BET + lane * 4) = pb; }
                }
                LDS_BARRIER();
                if (act) { const int sa = pw;
#pragma unroll
                    for (int i = 0; i < 2; ++i) { const int c = ptid + i * 256, s2 = c >> 3, c8 = (c & 7) * 8; *(LAS u32x4*)(lds + VS + s2 * VRS + c8 * 2) = pv[i]; }
                    if (it + 1 < NCK) { const size_t t1 = (size_t)b * S_ + (size_t)(it + 1) * 64;
#pragma unroll
                        for (int i = 0; i < 4; ++i) { const int c = ptid + i * 256, s2 = c >> 4, c8 = (c & 15) * 8; pq[i] = *(const u32x4*)(qc + (t1 + s2) * 8192 + hk * 128 + c8); pk[i] = *(const u32x4*)(qc + (t1 + s2) * 8192 + 2048 + hk * 128 + c8); }
#pragma unroll
                        for (int i = 0; i < 2; ++i) { const int c = ptid + i * 256, s2 = c >> 3, c8 = (c & 7) * 8; pv[i] = *(const u32x4*)(qc + (t1 + s2) * 8192 + 4096 + hv * 128 + vhalf * 64 + c8); }
                        if (pw == 1) { pb = bgi[(t1 + ptid - 64) * 64 + hv]; pg = bgi[(t1 + ptid - 64) * 64 + 32 + hv]; } }
#pragma unroll
                    for (int ty = 0; ty < 2; ++ty) { f32x4 acc = (f32x4){0.f, 0.f, 0.f, 0.f};
#pragma unroll
                        for (int ks = 0; ks < 4; ++ks) { const bf16x8 ka = lds_frag(lds + KS + (16 * sa + I) * RSB + (32 * ks + 8 * G) * 2);
                            const bf16x8 bo = ty ? lds_frag(lds + set + QS + (16 * sa + I) * RSB + (32 * ks + 8 * G) * 2) : ka; acc = mfma32(ka, bo, acc); }
                        const f32x4 gr = *(const LAS f32x4*)(lds + GAM + (16 * sa + 4 * G) * 4); const float gc = *(const LAS float*)(lds + GAM + (16 * sa + I) * 4);
                        if (ty == 0) { const f32x4 br = *(const LAS f32x4*)(lds + BET + (16 * sa + 4 * G) * 4);
#pragma unroll
                            for (int r = 0; r < 4; ++r) { const float val = br[r] * acc[r] * __expf(gr[r] - gc); *(LAS float*)(lds + LS + ((sa * 16 + 4 * G + r) * 16 + I) * 4) = (I < 4 * G + r) ? val : 0.f; } }
                        else { f32x4 o;
#pragma unroll
                            for (int r = 0; r < 4; ++r) { const float val = acc[r] * __expf(gc - gr[r]); o[r] = (4 * G + r <= I) ? val : 0.f; }
                            *(LAS s16x4*)(lds + set + QKS + ((sa * 16 + I) * 16 + 4 * G) * 2) = pack4(o); } } }
                LDS_BARRIER();
                if (act && pw == 0) { const int sa = G, c = I; float x[16];
#pragma unroll
                    for (int i = 0; i < 16; ++i) x[i] = 0.f;
#pragma unroll
                    for (int ib = 0; ib < 4; ++ib) {
                        f32x4 lv[4][4];
#pragma unroll
                        for (int r = 0; r < 4; ++r)
#pragma unroll
                            for (int jj = 0; jj <= ib; ++jj) lv[r][jj] = *(const LAS f32x4*)(lds + LS + ((sa * 16 + 4 * ib + r) * 16 + 4 * jj) * 4);
                        __builtin_amdgcn_sched_barrier(0);
#pragma unroll
                        for (int r = 0; r < 4; ++r) { const int i = 4 * ib + r; float s0 = (i == c) ? 1.0f : 0.0f, s1 = 0.f;
#pragma unroll
                            for (int jj = 0; jj <= ib; ++jj) { s0 -= lv[r][jj][0] * x[4 * jj] + lv[r][jj][1] * x[4 * jj + 1]; s1 -= lv[r][jj][2] * x[4 * jj + 2] + lv[r][jj][3] * x[4 * jj + 3]; }
                            x[i] = s0 + s1; }
                    }
                    const float bc = *(const LAS float*)(lds + BET + lane * 4), sc1 = -bc * *(const LAS float*)(lds + set + EE + lane * 4);
#pragma unroll
                    for (int i = 0; i < 16; ++i) { *(LAS bf16_t*)(lds + X1 + ((sa * 16 + i) * 16 + c) * 2) = f2bf(x[i] * sc1); *(LAS bf16_t*)(lds + X2 + ((sa * 16 + i) * 16 + c) * 2) = f2bf(x[i] * bc); } }
                LDS_BARRIER();
                if (act) { const int sa = pw;
                    const s16x4 xb = *(const LAS s16x4*)(lds + X1 + ((sa * 16 + I) * 16 + 4 * G) * 2); s16x4 kt[8]; f32x4 w[8];
#pragma unroll
                    for (int dt = 0; dt < 8; ++dt) kt[dt] = lds_tr4(lds + KS + (16 * sa + 4 * G + q4) * RSB + (16 * dt + 4 * p4) * 2);
#pragma unroll
                    for (int dt = 0; dt < 8; ++dt) { w[dt] = mfma16(kt[dt], xb, (f32x4){0.f, 0.f, 0.f, 0.f}); *(LAS s16x4*)(lds + set + KT + (16 * dt + I) * KTRS + (16 * sa + 4 * G) * 2) = kt[dt]; }
#pragma unroll
                    for (int dt = 0; dt < 8; ++dt) *(LAS s16x4*)(lds + set + WSL + (16 * sa + I) * RSB + (16 * dt + 4 * G) * 2) = pack4(w[dt]); }
                LDS_BARRIER();
            }
        }
    }
}

constexpr int N_PHASES = 30;
__global__ void __launch_bounds__(NTHREADS, 2) fwd(Args a0) {
    extern __shared__ __attribute__((aligned(16))) unsigned char smem_raw[];
    LAS unsigned char* lds = (LAS unsigned char*)smem_raw;
    volatile LAS unsigned* xbw = (volatile LAS unsigned*)(lds + LDS_XBW);
    if (TIDX == 0) { xbw[0] = 0u; xbw[1] = 0u; xbw[2] = 0u; xbw[3] = 0u; }
    __syncthreads();
    XcdBarrier bar = xcd_barrier_post((unsigned*)(a0.ws + WS_CTL), xbw);
#ifndef PHMASK
#define PHMASK 0xFFFFFFFFull
#endif
#ifndef DUPMASK
#define DUPMASK 0ull
#endif
#define PH(i, body) do { if (((PHMASK >> (i)) & 1ull) && a0.ph_lo <= (i) && (i) < a0.ph_hi) { __attribute__((address_space(1))) unsigned char* wsp_ = (__attribute__((address_space(1))) unsigned char*)a0.ws; asm volatile("" : "+s"(wsp_)); Args a = a0; a.ws = (unsigned char*)wsp_; const float* xin = a.in[0]; const float* xw = (const float*)(a.ws + WS_X); (void)xin; (void)xw; \
        if ((DUPMASK >> (i)) & 1ull) { body; xcd_barrier(bar); } body; if ((i) + 1 < a0.ph_hi) xcd_barrier(bar); } } while (0)
    PH(0, { phase_prologue(a, lds); __syncthreads(); phase_norm<0>(a, xin, a.in[1], -1); });
    PH(2, phase_gemm_in0(a, lds));
    PH(3, { phase_rg_conv(a); __syncthreads(); phase_hg1(a, lds); });
    PH(4, { phase_rg_gates(a, lds); __syncthreads(); phase_hg2(a); });
    PH(5, { phase_rg_scan(a, lds); __syncthreads(); phase_hg3(a, lds); });
    PH(9, phase_gemm_out<false>(a, lds, D_, a.ws + WS_WOUT0T, xin));
    PH(10, phase_norm<0>(a, nullptr, a.in[2], 0));
    PH(11, phase_gemm_router(a, lds, 0));
    PH(12, phase_route(a, 0));
    PH(13, phase_rowmap(a, lds, 0));
    PH(14, phase_moe_up(a, lds, 0));
    PH(15, phase_moe_down(a, lds, 0));
    PH(16, { phase_norm<1>(a, nullptr, a.in[1] + D_, 0); __syncthreads(); moe_weight_jobs(a, 1, lds); });
    PH(18, { phase_gemm_in1(a, lds); phase_gemm_in1_tail(a, lds); });
    PH(19, phase_gdn_conv(a));
    PH(20, phase_gdn_chunk(a, lds));
    PH(21, phase_gdn_norm(a));
    PH(22, phase_gemm_out<true>(a, lds, 4096, a.ws + WS_WOUT1T, nullptr));
    PH(23, phase_norm<0>(a, nullptr, a.in[2] + D_, 1));
    PH(24, phase_gemm_router(a, lds, 1));
    PH(25, phase_route(a, 1));
    PH(26, phase_rowmap(a, lds, 1));
    PH(27, phase_moe_up(a, lds, 1));
    PH(28, phase_moe_down(a, lds, 1));
    PH(29, phase_norm<2>(a, nullptr, a.in[3], 1));
#undef PH
}

extern "C" void kernel_launch(void* const* d_in, const int* in_sizes, int n_in, void* d_out, int out_size, void* d_ws, size_t ws_size, hipStream_t stream) {
    static int grid = 0;
    if (grid == 0) {
        if (n_in != 28 || ws_size < WS_END) { fprintf(stderr, "kernel_launch: need 28 inputs and %zu bytes of workspace, got %d / %zu\n", (size_t)WS_END, n_in, ws_size); grid = -1; return; }
        int dev = 0, cus = 0, per_cu = 0;
        if (hipGetDevice(&dev) != hipSuccess || hipDeviceGetAttribute(&cus, hipDeviceAttributeMultiprocessorCount, dev) != hipSuccess) { grid = -1; return; }
        if (hipFuncSetAttribute((const void*)fwd, hipFuncAttributeMaxDynamicSharedMemorySize, LDS_BYTES) != hipSuccess) { fprintf(stderr, "kernel_launch: hipFuncSetAttribute failed\n"); grid = -1; return; }
        if (hipOccupancyMaxActiveBlocksPerMultiprocessor(&per_cu, (const void*)fwd, NTHREADS, LDS_BYTES) != hipSuccess || per_cu < 1) { fprintf(stderr, "kernel_launch: occupancy query says %d\n", per_cu); }
        (void)hipGetLastError();
        grid = cus;
    }
    if (grid < 0) return;
    (void)in_sizes; (void)out_size;
    hipMemsetAsync((char*)d_ws + WS_CTL, 0, CTL_BYTES, stream);
    Args a; memset(&a, 0, sizeof(a));
    for (int i = 0; i < 28; ++i) a.in[i] = (const float*)d_in[i];
    a.out = (float*)d_out; a.ws = (unsigned char*)d_ws;
#if N_LAUNCH_MODE == 1
    a.ph_lo = 0; a.ph_hi = N_PHASES;
    hipLaunchKernelGGL(fwd, dim3(grid), dim3(NTHREADS), LDS_BYTES, stream, a);
#if EXTRA_PH >= 0
    a.ph_lo = EXTRA_PH; a.ph_hi = EXTRA_PH + 1;
    hipLaunchKernelGGL(fwd, dim3(grid), dim3(NTHREADS), LDS_BYTES, stream, a);
#endif
#else
    for (int p = 0; p < N_PHASES; ++p) { a.ph_lo = p; a.ph_hi = p + 1; hipLaunchKernelGGL(fwd, dim3(grid), dim3(NTHREADS), LDS_BYTES, stream, a); }
#endif
}
```

```cpp
#include <hip/hip_runtime.h>
#include <stdint.h>
#include <stdio.h>
#include <string.h>

#ifndef EXTRA_PH
#define EXTRA_PH -1
#endif
#ifndef N_LAUNCH_MODE
#define N_LAUNCH_MODE 1
#endif

#define LAS __attribute__((address_space(3)))
typedef unsigned short bf16_t;
typedef short bf16x8 __attribute__((ext_vector_type(8)));
typedef float f32x4 __attribute__((ext_vector_type(4)));
typedef float f32x2 __attribute__((ext_vector_type(2)));
typedef unsigned u32x4 __attribute__((ext_vector_type(4)));
typedef unsigned u32x2 __attribute__((ext_vector_type(2)));

constexpr int T_ = 16384, D_ = 2048, S_ = 4096, NB_ = 4;
constexpr int N_IN0 = 6144, N_IN1 = 12352, N_IN1P = 12544;
constexpr int NEXP = 64, DEXP = 512, MPAD = 49152;
constexpr int NTHREADS = 512;
constexpr int LDS_MAIN = 131072;
constexpr int LDS_BYTES = 163840;
constexpr int LDS_XBW = LDS_BYTES - 16;

constexpr size_t al256(size_t x) { return (x + 255) & ~(size_t)255; }
constexpr size_t WS_CTL = 0;
constexpr size_t CTL_BYTES = 65536;
constexpr size_t CTL_CNT = 16384;
constexpr size_t WS_LB = WS_CTL + CTL_BYTES;
constexpr size_t WS_TINFO = WS_LB + 4096;
constexpr size_t WS_WIN0T = WS_TINFO + 4096;
constexpr size_t WS_WOUT0T = WS_WIN0T + (size_t)N_IN0 * D_ * 2;
constexpr size_t WS_WIN1T = WS_WOUT0T + (size_t)D_ * D_ * 2;
constexpr size_t WS_WOUT1T = WS_WIN1T + (size_t)N_IN1P * D_ * 2;
constexpr size_t WS_WGATES = WS_WOUT1T + (size_t)D_ * 4096 * 2;
constexpr size_t WS_WRT = WS_WGATES + (size_t)8 * 256 * 256 * 2;
constexpr size_t WS_WG = WS_WRT + (size_t)2 * 256 * D_ * 2;
constexpr size_t WS_WU = WS_WG + (size_t)NEXP * DEXP * D_ * 2;
constexpr size_t WS_WD = WS_WU + (size_t)NEXP * DEXP * D_ * 2;
constexpr size_t WS_X = WS_WD + (size_t)NEXP * DEXP * D_ * 2;
constexpr size_t WS_H = WS_X + (size_t)T_ * D_ * 4;
constexpr size_t WS_PROJ = WS_H + (size_t)T_ * D_ * 2;
constexpr size_t PROJ_BYTES = (size_t)T_ * N_IN1P * 2;
constexpr size_t WS_FLOG = WS_PROJ + (size_t)T_ * N_IN0 * 2;
constexpr size_t WS_XC = WS_FLOG + (size_t)T_ * 1024 * 4;
constexpr size_t WS_ACT = WS_PROJ;
constexpr size_t WS_YMOE = WS_ACT + (size_t)MPAD * DEXP * 2;
constexpr size_t WS_R1 = WS_PROJ + PROJ_BYTES;
constexpr size_t WS_A = WS_R1;
constexpr size_t WS_U = WS_R1 + (size_t)T_ * 1024 * 4;
constexpr size_t WS_QKVC = WS_R1;
constexpr size_t WS_Y = WS_R1 + (size_t)T_ * 8192 * 2;
constexpr size_t WS_O = WS_Y + (size_t)T_ * 4096 * 2;
constexpr size_t WS_TAIL = WS_O + (size_t)T_ * 4096 * 4;
constexpr size_t WS_BG = WS_TAIL + (size_t)T_ * 64 * 4;
constexpr size_t WS_LOGITS = WS_BG + (size_t)T_ * 64 * 4;
constexpr size_t WS_EID = WS_LOGITS + (size_t)T_ * 128 * 4;
constexpr size_t WS_SLOT = WS_EID + (size_t)T_ * 2 * 4;
constexpr size_t WS_GATE = WS_SLOT + (size_t)T_ * 2 * 4;
constexpr size_t WS_POSOF = WS_GATE + (size_t)T_ * 2 * 4;
constexpr size_t WS_ROWMAP = WS_POSOF + (size_t)T_ * 2 * 4;
constexpr size_t WS_H8 = WS_ROWMAP + (size_t)MPAD * 4;
constexpr size_t WS_END = WS_H8 + (size_t)T_ * D_;
static_assert(WS_YMOE + (size_t)MPAD * D_ * 2 <= WS_R1, "moe overlay");
static_assert(WS_XC + (size_t)T_ * 1024 * 2 <= WS_R1, "layer0 overlay");

struct Args {
    const float* in[28];
    float* out;
    unsigned char* ws;
    int ph_lo, ph_hi;
};

__device__ __forceinline__ int tidx_() { int t = (int)threadIdx.x; asm volatile("" : "+v"(t)); return t; }
#define TIDX tidx_()
typedef __bf16 bf16x2n __attribute__((ext_vector_type(2)));
__device__ __forceinline__ unsigned cvt_pk_bf16(float lo, float hi) { const f32x2 v = {lo, hi}; return __builtin_bit_cast(unsigned, __builtin_convertvector(v, bf16x2n)); }
__device__ __forceinline__ unsigned pk_fp8x4(float a, float b, float c, float d) { int v = __builtin_amdgcn_cvt_pk_fp8_f32(a, b, 0, false); v = __builtin_amdgcn_cvt_pk_fp8_f32(c, d, v, true); return (unsigned)v; }
constexpr float W8_SCALE = 64.0f, ACT8_SCALE = 8.0f;
__device__ __forceinline__ bf16_t f2bf(float x) { return (bf16_t)(cvt_pk_bf16(x, 0.f) & 0xffffu); }
__device__ __forceinline__ float bf_lo(unsigned w) { return __uint_as_float(w << 16); }
__device__ __forceinline__ float bf_hi(unsigned w) { return __uint_as_float(w & 0xffff0000u); }
__device__ __forceinline__ float bf1(bf16_t v) { return __uint_as_float(((unsigned)v) << 16); }
__device__ __forceinline__ float sigmoidf_(float x) { return __builtin_amdgcn_rcpf(1.0f + __expf(-x)); }
__device__ __forceinline__ float siluf_(float x) { return x * __builtin_amdgcn_rcpf(1.0f + __expf(-x)); }
__device__ __forceinline__ float softplusf_(float x) { return x > 20.f ? x : log1pf(__expf(x)); }
__device__ __forceinline__ float gelu_tanh(float x) { const float u = 0.7978845608028654f * (x + 0.044715f * x * x * x); return x * __builtin_amdgcn_rcpf(1.0f + __expf(-2.0f * u)); }
template <int CTRL> __device__ __forceinline__ float dpp_f(float v) { return __builtin_bit_cast(float, __builtin_amdgcn_update_dpp(0, __builtin_bit_cast(int, v), CTRL, 0xf, 0xf, false)); }
__device__ __forceinline__ float row16_sum(float s) { s += dpp_f<0x140>(s); s += dpp_f<0x141>(s); s += dpp_f<0xB1>(s); s += dpp_f<0x4E>(s); return s; }
__device__ __forceinline__ float wave_sum(float v) { v = row16_sum(v); v += __shfl_xor(v, 16); v += __shfl_xor(v, 32); return v; }

#define LDS_BARRIER() do { asm volatile("s_waitcnt lgkmcnt(0)" ::: "memory"); __builtin_amdgcn_s_barrier(); asm volatile("" ::: "memory"); } while (0)
#define XB_TMO      128
#define XB_XCNT(j)  (256  + 64 * (j))
#define XB_XSUB(j)  (1280 + 64 * (j))
#define XB_XGEN(j)  (2304 + 64 * (j))
#define XB_TOP      3328
#define XB_TOPGEN   3392
#define XCD_BAR_WORDS 3456
#define XB_SPIN_CAP (1u << 18)

__device__ __forceinline__ unsigned xb_ld(unsigned* p)              { return __hip_atomic_load(p, __ATOMIC_RELAXED, __HIP_MEMORY_SCOPE_AGENT); }
__device__ __forceinline__ unsigned xb_add(unsigned* p, unsigned v) { return __hip_atomic_fetch_add(p, v, __ATOMIC_RELAXED, __HIP_MEMORY_SCOPE_AGENT); }
__device__ __forceinline__ unsigned xb_xcc_id() { return (unsigned)__builtin_amdgcn_s_getreg((3 << 11) | 20) & 0xFu; }
#define XB_SPIN(cond, bar) do { unsigned _sp = 0; while (cond) { __builtin_amdgcn_s_sleep(1); \
    if ((++_sp & 255u) == 0u) { if (xb_ld(&(bar)[XB_TMO])) break; if (_sp > XB_SPIN_CAP) { atomicAdd(&(bar)[XB_TMO], 1u); break; } } } } while (0)

struct XcdBarrier { unsigned* bar; unsigned x; volatile LAS unsigned* st; };

__device__ __forceinline__ XcdBarrier xcd_barrier_post(unsigned* bar, volatile LAS unsigned* st) {
    XcdBarrier b; b.bar = bar; b.x = xb_xcc_id(); b.st = st;
    if (TIDX == 0) (void)xb_add(&bar[XB_XCNT(b.x)], 1u);
    return b;
}
__device__ __forceinline__ void xcd_barrier_complete(unsigned* bar, unsigned x, unsigned& nloc, unsigned& nx) {
    const unsigned G = gridDim.x * gridDim.y * gridDim.z;
    unsigned sum, cnt, mine, sp = 0u;
    for (;;) {
        sum = 0u; cnt = 0u; mine = 0u;
#pragma unroll
        for (unsigned j = 0; j < 16; ++j) { const unsigned c = xb_ld(&bar[XB_XCNT(j)]); sum += c; cnt += (c > 0u) ? 1u : 0u; mine = (j == x) ? c : mine; }
        if (sum == G) break;
        __builtin_amdgcn_s_sleep(1);
        if ((++sp & 255u) == 0u) { if (xb_ld(&bar[XB_TMO])) break; if (sp > XB_SPIN_CAP) { atomicAdd(&bar[XB_TMO], 1u); break; } }
    }
    nloc = mine > 0u ? mine : 1u; nx = cnt > 0u ? cnt : 1u;
}
__device__ __forceinline__ void xcd_barrier(const XcdBarrier& b) {
    asm volatile("s_waitcnt vmcnt(0)" ::: "memory");
    __syncthreads();
    if (TIDX == 0) {
        unsigned* bar = b.bar;
        __builtin_amdgcn_s_waitcnt(0);
        unsigned nloc = b.st[0], nx = b.st[1];
        if (nloc == 0u) { xcd_barrier_complete(bar, b.x, nloc, nx); b.st[0] = nloc; b.st[1] = nx; }
        const unsigned old = xb_add(&bar[XB_XSUB(b.x)], 1u);
        const unsigned gen = old / nloc;
        if (old + 1u == (gen + 1u) * nloc) {
            __builtin_amdgcn_fence(__ATOMIC_RELEASE, "agent");
            asm volatile("s_waitcnt vmcnt(0)" ::: "memory");
            const unsigned og = xb_add(&bar[XB_TOP], 1u);
            const unsigned tg = og / nx;
            if (og + 1u == (tg + 1u) * nx) xb_add(&bar[XB_TOPGEN], 1u);
            else XB_SPIN(xb_ld(&bar[XB_TOPGEN]) == tg, bar);
            __builtin_amdgcn_fence(__ATOMIC_ACQUIRE, "agent");
            xb_add(&bar[XB_XGEN(b.x)], 1u);
            asm volatile("s_waitcnt vmcnt(0)" ::: "memory");
        } else {
            XB_SPIN(xb_ld(&bar[XB_XGEN(b.x)]) == gen, bar);
            __builtin_amdgcn_fence(__ATOMIC_ACQUIRE, "agent");
            asm volatile("s_waitcnt vmcnt(0)" ::: "memory");
        }
    }
    __syncthreads();
}

constexpr int BM = 256, BK = 64, HALF = 128, HTB = HALF * BK * 2;
__device__ __forceinline__ int lds_byte(int r, int c) { const int st = (r >> 4) * 2 + (c >> 5), rr = r & 15, cc = c & 31, ob = rr * 64 + cc * 2; return st * 1024 + (ob ^ (((ob >> 9) & 1) << 5)); }
__device__ __forceinline__ void stage_rc(int b, int& R, int& C) { const int st = b / 1024, sb = b % 1024, swz = sb ^ (((sb >> 9) & 1) << 5); R = (st >> 1) * 16 + swz / 64; C = (st & 1) * 32 + (swz % 64) / 2; }
__device__ __forceinline__ int perm32(int rho) { const int n = rho >> 4, i = rho & 15; return 8 * (i >> 2) + 4 * n + (i & 3); }

__device__ __forceinline__ void stage_pos(int tid, int& R0, int& C0) { stage_rc(tid * 16, R0, C0); }
__device__ __forceinline__ int perm_row(int R) { return (R & ~31) + perm32(R & 31); }

#define BID ((int)blockIdx.x)
#define NBLK ((int)gridDim.x)
#define BID_ BID
#define NBLK_ NBLK
typedef f32x4 Acc[2][2][4][2];
struct UnitD { const char* gA; const char* gB; int t0, t1, t2; };

typedef int i32x8 __attribute__((ext_vector_type(8)));
typedef int i32x4 __attribute__((ext_vector_type(4)));
template <bool GATHER, bool FP8, class Src, class Epi>
__device__ __forceinline__ void gemm_stream(LAS unsigned char* lds, const Src& S, const int nt, const Epi& E) {
    const int tid = TIDX, wid = tid >> 6, lane = tid & 63, wr = wid >> 2, wc = wid & 3, fr = lane & 15, fq = lane >> 4;
    const unsigned ldsw = (unsigned)wid * 1024u;
    const int aoff = lds_byte(wr * 64 + fr, fq * 8), boff = lds_byte(wc * 32 + fr, fq * 8);
    const size_t kstep = (size_t)(BK * 2);
#define G_SA(b, h) (((b) * 2 + (h)) * HTB)
#define G_SB(b, h) ((4 + (b) * 2 + (h)) * HTB)
#define G_STAGE(bufoff, gbase, v) do { _Pragma("unroll") for (int _i = 0; _i < 2; ++_i) \
        __builtin_amdgcn_global_load_lds((const unsigned*)((gbase) + (v)[_i]), (LAS unsigned*)(lds + (bufoff) + ldsw + _i * 8192), 16, 0, 0); } while (0)
#define G_LD8(p) __builtin_shufflevector(*(const LAS i32x4*)(p), *(const LAS i32x4*)((p) + 1024), 0, 1, 2, 3, 4, 5, 6, 7)
#define G_LDA(dst, b, h) do { _Pragma("unroll") for (int m = 0; m < 4; ++m) dst[m] = G_LD8(lds + G_SA(b, h) + aoff + m * 2048); } while (0)
#define G_LDB(dst, b, h) do { _Pragma("unroll") for (int n = 0; n < 2; ++n) dst[n] = G_LD8(lds + G_SB(b, h) + boff + n * 2048); } while (0)
#define G_HALF(x, k) __builtin_bit_cast(bf16x8, __builtin_shufflevector((x), (x), 4 * (k), 4 * (k) + 1, 4 * (k) + 2, 4 * (k) + 3))
#define G_MMA(ai, bj, At, Bt) do { __builtin_amdgcn_s_setprio(1); _Pragma("unroll") for (int m = 0; m < 4; ++m) _Pragma("unroll") for (int n = 0; n < 2; ++n) { \
        if (FP8) asm volatile("v_mfma_f32_16x16x128_f8f6f4 %0, %1, %2, %0" : "+v"(acc[ai][bj][m][n]) : "v"(Bt[n]), "v"(At[m]));   \
        else { acc[ai][bj][m][n] = __builtin_amdgcn_mfma_f32_16x16x32_bf16(G_HALF(Bt[n], 0), G_HALF(At[m], 0), acc[ai][bj][m][n], 0, 0, 0); \
               acc[ai][bj][m][n] = __builtin_amdgcn_mfma_f32_16x16x32_bf16(G_HALF(Bt[n], 1), G_HALF(At[m], 1), acc[ai][bj][m][n], 0, 0, 0); } } \
        __builtin_amdgcn_s_setprio(0); } while (0)
#define G_WAIT_V(n) asm volatile("s_waitcnt vmcnt(" #n ")" ::: "memory")
#define G_WAIT_L(n) asm volatile("s_waitcnt lgkmcnt(" #n ")" ::: "memory")
#define G_BAR __builtin_amdgcn_s_barrier()
#define G_SCHED __builtin_amdgcn_sched_barrier(0)
    UnitD cur, nxt; int ui = 0;
    if (!S.next(0, cur)) return;
    unsigned va[2][2], vb[2][2], van[2][2];
    S.vb(vb); S.va(cur, va);
    Acc acc;
#pragma unroll
    for (int a = 0; a < 2; ++a)
#pragma unroll
        for (int b = 0; b < 2; ++b)
#pragma unroll
            for (int m = 0; m < 4; ++m)
#pragma unroll
                for (int n = 0; n < 2; ++n) acc[a][b][m][n] = (f32x4){0.f, 0.f, 0.f, 0.f};
    i32x8 At[4], B0[2], B1[2];
    const char* cA = cur.gA; const char* cB = cur.gB;
    G_WAIT_V(0);
    __syncthreads();
    G_STAGE(G_SB(0, 0), cB, vb[0]); G_STAGE(G_SA(0, 0), cA, va[0]); G_STAGE(G_SB(0, 1), cB, vb[1]); G_STAGE(G_SA(0, 1), cA, va[1]);
    if (wr == 1) G_BAR;
    G_WAIT_V(4); G_BAR;
    G_STAGE(G_SB(1, 0), cB + kstep, vb[0]); G_STAGE(G_SA(1, 0), cA + kstep, va[0]); G_STAGE(G_SB(1, 1), cB + kstep, vb[1]);
    G_WAIT_V(6); G_BAR;
    for (;;) {
        const bool has_next = S.next(ui + 1, nxt);
        const char* nA = has_next ? nxt.gA : cA; const char* nB = has_next ? nxt.gB : cB;
        if (GATHER) { if (has_next) S.va(nxt, van); else { van[0][0] = va[0][0]; van[0][1] = va[0][1]; van[1][0] = va[1][0]; van[1][1] = va[1][1]; } }
#pragma unroll 1
        for (int t = 0; t < nt; t += 2) {
            const bool last = (t == nt - 2);
            const char* a1 = cA + (size_t)(t + 1) * kstep;
            const char* a2 = last ? nA : cA + (size_t)(t + 2) * kstep; const char* b2 = last ? nB : cB + (size_t)(t + 2) * kstep;
            const char* a3 = a2 + kstep; const char* b3 = b2 + kstep;
            unsigned v2[2][2];
#pragma unroll
            for (int hh = 0; hh < 2; ++hh)
#pragma unroll
                for (int i = 0; i < 2; ++i) v2[hh][i] = (GATHER && last) ? van[hh][i] : va[hh][i];
            G_LDB(B0, 0, 0); G_SCHED; G_LDA(At, 0, 0); G_STAGE(G_SA(1, 1), a1, va[1]);
            G_WAIT_L(8); G_BAR; G_WAIT_L(0); G_MMA(0, 0, At, B0); G_BAR; G_SCHED;
            G_LDB(B1, 0, 1); G_STAGE(G_SB(0, 0), b2, vb[0]);
            G_BAR; G_WAIT_L(0); G_MMA(0, 1, At, B1); G_BAR;
            G_LDA(At, 0, 1); G_STAGE(G_SA(0, 0), a2, v2[0]);
            G_BAR; G_WAIT_L(0); G_MMA(1, 0, At, B0); G_BAR; G_SCHED;
            G_STAGE(G_SB(0, 1), b2, vb[1]);
            G_WAIT_V(6); G_BAR; G_MMA(1, 1, At, B1); G_BAR;
            G_LDB(B0, 1, 0); G_SCHED; G_LDA(At, 1, 0); G_STAGE(G_SA(0, 1), a2, v2[1]);
            G_WAIT_L(8); G_BAR; G_WAIT_L(0); G_MMA(0, 0, At, B0); G_BAR; G_SCHED;
            G_LDB(B1, 1, 1); G_STAGE(G_SB(1, 0), b3, vb[0]);
            G_BAR; G_WAIT_L(0); G_MMA(0, 1, At, B1); G_BAR;
            G_LDA(At, 1, 1); G_STAGE(G_SA(1, 0), a3, v2[0]);
            G_BAR; G_WAIT_L(0); G_MMA(1, 0, At, B0); G_BAR; G_SCHED;
            G_STAGE(G_SB(1, 1), b3, vb[1]);
            G_WAIT_V(6); G_BAR; G_MMA(1, 1, At, B1); G_BAR;
        }
        if (FP8) asm volatile("s_nop 15\n\ts_nop 15" ::: "memory");
        { int tz = TIDX; asm volatile("" : "+v"(tz));
          const int wid2 = tz >> 6, lane2 = tz & 63; E(acc, cur, wid2 >> 2, wid2 & 3, lane2 & 15, lane2 >> 4); }
        if (!has_next) break;
#pragma unroll
        for (int a = 0; a < 2; ++a)
#pragma unroll
            for (int b = 0; b < 2; ++b)
#pragma unroll
                for (int m = 0; m < 4; ++m)
#pragma unroll
                    for (int n = 0; n < 2; ++n) acc[a][b][m][n] = (f32x4){0.f, 0.f, 0.f, 0.f};
        cur = nxt; cA = nA; cB = nB; ++ui;
        if (GATHER) { va[0][0] = van[0][0]; va[0][1] = van[0][1]; va[1][0] = van[1][0]; va[1][1] = van[1][1]; }
    }
    G_WAIT_V(0);
    if (wr == 0) G_BAR;
    G_BAR;
#undef G_SA
#undef G_SB
#undef G_STAGE
#undef G_LDA
#undef G_LDB
#undef G_MMA
#undef G_LD8
#undef G_HALF
#undef G_WAIT_V
#undef G_WAIT_L
#undef G_BAR
#undef G_SCHED
}

__device__ __forceinline__ void offs_direct(unsigned (&v)[2][2], int ld, bool perm) {
    int R0, C0; stage_pos(TIDX, R0, C0);
#pragma unroll
    for (int i = 0; i < 2; ++i) { const int R = R0 + 64 * i, Rr = perm ? perm_row(R) : R;
        v[0][i] = (unsigned)(Rr * ld + C0) * 2u; v[1][i] = (unsigned)((Rr + HALF) * ld + C0) * 2u; }
}

struct SrcGrid {
    const char* A; const char* B; size_t astep, bstep; int nM, total, lda, ldb;
    __device__ __forceinline__ bool next(int i, UnitD& u) const { const int id = BID_ + i * NBLK_; if (id >= total) return false; u.t0 = id % nM; u.t1 = id / nM; u.t2 = 0;
        u.gA = A + (size_t)u.t0 * astep; u.gB = B + (size_t)u.t1 * bstep; return true; }
    __device__ __forceinline__ void va(const UnitD&, unsigned (&v)[2][2]) const { offs_direct(v, lda, false); }
    __device__ __forceinline__ void vb(unsigned (&v)[2][2]) const { offs_direct(v, ldb, true); }
};

__device__ __forceinline__ void store_bf16_tile(const Acc& acc, bf16_t* O, int ld, int wr, int wc, int fr, int fq, const float sc = 1.0f) {
#pragma unroll
    for (int ai = 0; ai < 2; ++ai)
#pragma unroll
        for (int m = 0; m < 4; ++m) { bf16_t* rowp = O + (size_t)(ai * HALF + wr * 64 + m * 16 + fr) * ld + wc * 32 + 8 * fq;
#pragma unroll
            for (int bj = 0; bj < 2; ++bj) { const f32x4 v0 = acc[ai][bj][m][0] * sc, v1 = acc[ai][bj][m][1] * sc;
                u32x4 w; w.x = cvt_pk_bf16(v0[0], v0[1]); w.y = cvt_pk_bf16(v0[2], v0[3]); w.z = cvt_pk_bf16(v1[0], v1[1]); w.w = cvt_pk_bf16(v1[2], v1[3]);
                *(u32x4*)(rowp + bj * HALF) = w; } }
}
__device__ __forceinline__ void store_f32_tile(const Acc& acc, float* O, const float* R, int ld, int ncol, int wr, int wc, int fr, int fq, const float sc = 1.0f) {
#pragma unroll
    for (int ai = 0; ai < 2; ++ai)
#pragma unroll
        for (int m = 0; m < 4; ++m) { const size_t ro = (size_t)(ai * HALF + wr * 64 + m * 16 + fr) * ld;
#pragma unroll
            for (int bj = 0; bj < 2; ++bj)
#pragma unroll
                for (int n = 0; n < 2; ++n) { const int c = bj * HALF + wc * 32 + 8 * fq + 4 * n; if (c >= ncol) continue;
                    f32x4 v = acc[ai][bj][m][n] * sc; if (R) v += *(const f32x4*)(R + ro + c); *(f32x4*)(O + ro + c) = v; } }
}
struct EpiProj {
    bf16_t* O; int ld; float* F; int fld, fp0, fp1, ncol; float sc;
    __device__ __forceinline__ void operator()(const Acc& acc, const UnitD& u, int wr, int wc, int fr, int fq) const {
        if (u.t1 >= fp0 && u.t1 < fp1) store_f32_tile(acc, F + (size_t)u.t0 * BM * fld + (u.t1 - fp0) * BM, nullptr, fld, ncol, wr, wc, fr, fq, sc);
        else store_bf16_tile(acc, O + (size_t)u.t0 * BM * ld + u.t1 * BM, ld, wr, wc, fr, fq, sc);
    }
};
struct EpiResid {
    bf16_t* O; const float* Rf; const bf16_t* Rb; float sc;
    __device__ __forceinline__ void operator()(const Acc& acc, const UnitD& u, int wr, int wc, int fr, int fq) const {
        const size_t o = (size_t)u.t0 * BM * D_ + u.t1 * BM;
#pragma unroll
        for (int ai = 0; ai < 2; ++ai)
#pragma unroll
            for (int m = 0; m < 4; ++m) { const size_t ro = o + (size_t)(ai * HALF + wr * 64 + m * 16 + fr) * D_ + wc * 32 + 8 * fq;
#pragma unroll
                for (int bj = 0; bj < 2; ++bj) { f32x4 v0 = acc[ai][bj][m][0] * sc, v1 = acc[ai][bj][m][1] * sc;
                    if (Rf) { v0 += *(const f32x4*)(Rf + ro + bj * HALF); v1 += *(const f32x4*)(Rf + ro + bj * HALF + 4); }
                    else { const u32x4 r = *(const u32x4*)(Rb + ro + bj * HALF); v0[0] += bf_lo(r.x); v0[1] += bf_hi(r.x); v0[2] += bf_lo(r.y); v0[3] += bf_hi(r.y); v1[0] += bf_lo(r.z); v1[1] += bf_hi(r.z); v1[2] += bf_lo(r.w); v1[3] += bf_hi(r.w); }
                    u32x4 w; w.x = cvt_pk_bf16(v0[0], v0[1]); w.y = cvt_pk_bf16(v0[2], v0[3]); w.z = cvt_pk_bf16(v1[0], v1[1]); w.w = cvt_pk_bf16(v1[2], v1[3]);
                    *(u32x4*)(O + ro + bj * HALF) = w; } }
    }
};
struct EpiLogits {
    float* O;
    __device__ __forceinline__ void operator()(const Acc& acc, const UnitD& u, int wr, int wc, int fr, int fq) const { store_f32_tile(acc, O + (size_t)u.t0 * BM * 128, nullptr, 128, 128, wr, wc, fr, fq); }
};
struct EpiSwiGLU {
    unsigned char* O;
    __device__ __forceinline__ void operator()(const Acc& acc, const UnitD& u, int wr, int wc, int fr, int fq) const {
        unsigned char* o = O + (size_t)u.t0 * BM * DEXP + u.t1 * 128;
#pragma unroll
        for (int ai = 0; ai < 2; ++ai)
#pragma unroll
            for (int m = 0; m < 4; ++m) { unsigned char* rowp = o + (size_t)(ai * HALF + wr * 64 + m * 16 + fr) * DEXP + wc * 32 + 8 * fq;
                float r[8];
#pragma unroll
                for (int n = 0; n < 2; ++n)
#pragma unroll
                    for (int j = 0; j < 4; ++j) r[n * 4 + j] = (ACT8_SCALE / W8_SCALE) * siluf_(acc[ai][0][m][n][j] * (1.0f / W8_SCALE)) * acc[ai][1][m][n][j];
                u32x2 w; w.x = pk_fp8x4(r[0], r[1], r[2], r[3]); w.y = pk_fp8x4(r[4], r[5], r[6], r[7]);
                *(u32x2*)rowp = w; }
    }
};
struct EpiDown {
    unsigned char* O;
    __device__ __forceinline__ void operator()(const Acc& acc, const UnitD& u, int wr, int wc, int fr, int fq) const {
        unsigned char* o = O + (size_t)u.t0 * BM * D_ + u.t1 * BM; const float sc = 1.0f / (W8_SCALE * ACT8_SCALE);
#pragma unroll
        for (int ai = 0; ai < 2; ++ai)
#pragma unroll
            for (int m = 0; m < 4; ++m) { unsigned char* rowp = o + (size_t)(ai * HALF + wr * 64 + m * 16 + fr) * D_ + wc * 32 + 8 * fq;
#pragma unroll
                for (int bj = 0; bj < 2; ++bj) { const f32x4 v0 = acc[ai][bj][m][0] * sc, v1 = acc[ai][bj][m][1] * sc;
                    u32x2 w; w.x = pk_fp8x4(v0[0], v0[1], v0[2], v0[3]); w.y = pk_fp8x4(v1[0], v1[1], v1[2], v1[3]); *(u32x2*)(rowp + bj * HALF) = w; } }
    }
};
__device__ __forceinline__ unsigned rg_idx(unsigned tok, int c) { return ((((tok >> 12) * 64u + (unsigned)(c >> 4)) * (unsigned)S_ + (tok & (unsigned)(S_ - 1))) << 4) + (unsigned)(c & 15); }
struct EpiRgGates {
    bf16_t* LAo; bf16_t* Uo; const bf16_t* xc;
    const float* ba; const float* bx; const float* lam;
    __device__ __forceinline__ void operator()(const Acc& acc, const UnitD& u, int wr, int wc, int fr, int fq) const {
#pragma unroll
        for (int n = 0; n < 2; ++n) { const int c = u.t1 * 128 + wc * 32 + 8 * fq + 4 * n;
            const f32x4 vba = *(const f32x4*)(ba + c), vbx = *(const f32x4*)(bx + c), vl = *(const f32x4*)(lam + c);
            f32x4 c8; for (int j = 0; j < 4; ++j) c8[j] = -8.0f * softplusf_(-vl[j]);
#pragma unroll
            for (int ai = 0; ai < 2; ++ai)
#pragma unroll
                for (int m = 0; m < 4; ++m) { const unsigned tok = (unsigned)(u.t0 * BM + ai * HALF + wr * 64 + m * 16 + fr);
                    const u32x2 xw = *(const u32x2*)(xc + (tok * 1024u + (unsigned)c)); const float xv[4] = {bf_lo(xw.x), bf_hi(xw.x), bf_lo(xw.y), bf_hi(xw.y)};
                    f32x4 lv, uv;
#pragma unroll
                    for (int j = 0; j < 4; ++j) { const float r = sigmoidf_(acc[ai][0][m][n][j] + vba[j]), ig = sigmoidf_(acc[ai][1][m][n][j] + vbx[j]);
                        const float la = c8[j] * r, av = __expf(la); lv[j] = la; uv[j] = __builtin_amdgcn_sqrtf(fmaxf(0.f, 1.0f - av * av)) * ig * xv[j]; }
                    const unsigned o = rg_idx(tok, c);
                    u32x2 w0; w0.x = cvt_pk_bf16(lv[0], lv[1]); w0.y = cvt_pk_bf16(lv[2], lv[3]); *(u32x2*)(LAo + o) = w0;
                    u32x2 w1; w1.x = cvt_pk_bf16(uv[0], uv[1]); w1.y = cvt_pk_bf16(uv[2], uv[3]); *(u32x2*)(Uo + o) = w1; } }
    }
};


__device__ __forceinline__ void transpose_job8(const float* src, unsigned char* dst, int K, int N, int ldd, size_t sb, size_t db, int nbatch, LAS unsigned char* lds) {
    const int tid = TIDX, tk = K / 128, tn = N / 64, per = tk * tn, total = per * nbatch;
    const int rr0 = tid >> 4, c4 = (tid & 15) * 4, n = tid >> 3, kg = (tid & 7) * 16;
    f32x4 va[4], vb[4];
#define T8_LD(v, t) { const int u_ = (t), ub_ = u_ / per, ur_ = u_ % per, uik_ = ur_ / tn, uin_ = ur_ % tn; const float* usp_ = src + (size_t)ub_ * sb + (size_t)(uik_ * 128 + rr0) * N + uin_ * 64 + c4; \
        _Pragma("unroll") for (int i = 0; i < 4; ++i) v[i] = *(const f32x4*)(usp_ + (size_t)(i * 32) * N); }
#define T8_ST(v, t, buf) { const int t_ = (t), b_ = t_ / per, r_ = t_ % per, ik_ = r_ / tn, in_ = r_ % tn; LAS float* tile = (LAS float*)(lds + (buf) * (128 * 65 * 4)); \
        _Pragma("unroll") for (int i = 0; i < 4; ++i) { const int rr = rr0 + i * 32; tile[rr * 65 + c4 + 0] = v[i][0]; tile[rr * 65 + c4 + 1] = v[i][1]; tile[rr * 65 + c4 + 2] = v[i][2]; tile[rr * 65 + c4 + 3] = v[i][3]; } \
        if (t_ + 2 * NBLK < total) T8_LD(v, t_ + 2 * NBLK) \
        LDS_BARRIER(); \
        float f[16]; \
        _Pragma("unroll") for (int j = 0; j < 16; ++j) f[j] = tile[(kg + j) * 65 + n] * W8_SCALE; \
        u32x4 w; w.x = pk_fp8x4(f[0], f[1], f[2], f[3]); w.y = pk_fp8x4(f[4], f[5], f[6], f[7]); w.z = pk_fp8x4(f[8], f[9], f[10], f[11]); w.w = pk_fp8x4(f[12], f[13], f[14], f[15]); \
        *(u32x4*)(dst + (size_t)b_ * db + (size_t)(in_ * 64 + n) * ldd + ik_ * 128 + kg) = w; }
    int t = BID;
    if (t < total) T8_LD(va, t)
    if (t + NBLK < total) T8_LD(vb, t + NBLK)
    for (; t < total; t += 2 * NBLK) {
        T8_ST(va, t, 0)
        if (t + NBLK < total) T8_ST(vb, t + NBLK, 1)
    }
#undef T8_LD
#undef T8_ST
    LDS_BARRIER();
}
__device__ __forceinline__ void transpose_job(const float* src, bf16_t* dst, int K, int N, int ldd, size_t sb, size_t db, int dalt, int nbatch, LAS unsigned char* lds) {
    const int tid = TIDX, tk = K / 64, tn = N / 64, per = tk * tn, total = per * nbatch;
    const int rr0 = tid >> 4, c4 = (tid & 15) * 4, n = tid >> 3, kg = (tid & 7) * 8;
    f32x4 va[2], vb[2];
#define T16_LD(v, t) { const int u_ = (t), ub_ = u_ / per, ur_ = u_ % per, uik_ = ur_ / tn, uin_ = ur_ % tn; const float* usp_ = src + (size_t)ub_ * sb + (size_t)(uik_ * 64 + rr0) * N + uin_ * 64 + c4; \
        _Pragma("unroll") for (int i = 0; i < 2; ++i) v[i] = *(const f32x4*)(usp_ + (size_t)(i * 32) * N); }
#define T16_ST(v, t, buf) { const int t_ = (t), b_ = t_ / per, r_ = t_ % per, ik_ = r_ / tn, in_ = r_ % tn; LAS float* tile = (LAS float*)(lds + (buf) * (64 * 65 * 4)); \
        _Pragma("unroll") for (int i = 0; i < 2; ++i) { const int rr = rr0 + i * 32; tile[rr * 65 + c4 + 0] = v[i][0]; tile[rr * 65 + c4 + 1] = v[i][1]; tile[rr * 65 + c4 + 2] = v[i][2]; tile[rr * 65 + c4 + 3] = v[i][3]; } \
        if (t_ + 2 * NBLK < total) T16_LD(v, t_ + 2 * NBLK) \
        LDS_BARRIER(); \
        float f[8]; \
        _Pragma("unroll") for (int j = 0; j < 8; ++j) f[j] = tile[(kg + j) * 65 + n]; \
        u32x4 w; w.x = cvt_pk_bf16(f[0], f[1]); w.y = cvt_pk_bf16(f[2], f[3]); w.z = cvt_pk_bf16(f[4], f[5]); w.w = cvt_pk_bf16(f[6], f[7]); \
        *(u32x4*)(dst + (size_t)b_ * db + (size_t)(b_ & 1) * dalt + (size_t)(in_ * 64 + n) * ldd + ik_ * 64 + kg) = w; }
    int t = BID;
    if (t < total) T16_LD(va, t)
    if (t + NBLK < total) T16_LD(vb, t + NBLK)
    for (; t < total; t += 2 * NBLK) {
        T16_ST(va, t, 0)
        if (t + NBLK < total) T16_ST(vb, t + NBLK, 1)
    }
#undef T16_LD
#undef T16_ST
    LDS_BARRIER();
}

__device__ __forceinline__ void moe_weight_jobs(const Args& a, int layer, LAS unsigned char* lds) {
    const size_t lo = (size_t)layer * NEXP * D_ * DEXP;
    transpose_job8(a.in[25] + lo, a.ws + WS_WG, D_, DEXP, D_, (size_t)D_ * DEXP, (size_t)DEXP * D_, NEXP, lds);
    transpose_job8(a.in[26] + lo, a.ws + WS_WU, D_, DEXP, D_, (size_t)D_ * DEXP, (size_t)DEXP * D_, NEXP, lds);
    transpose_job8(a.in[27] + lo, a.ws + WS_WD, DEXP, D_, DEXP, (size_t)D_ * DEXP, (size_t)DEXP * D_, NEXP, lds);
}

__device__ __forceinline__ void phase_prologue(const Args& a, LAS unsigned char* lds) {
    const int gtid = BID * NTHREADS + TIDX, gsz = NBLK * NTHREADS;
    for (int i = gtid; i < 1024; i += gsz) { const float l0 = a.in[12][i], l1 = a.in[12][1024 + i], mx = fmaxf(l0, l1), e0 = __expf(l0 - mx), e1 = __expf(l1 - mx);
        ((float*)(a.ws + WS_LB))[i] = e0 / (e0 + e1); }
    for (int it = gtid; it < 2 * 256 * 256; it += gsz) { const int l = it >> 16, n = (it >> 8) & 255, k8 = (it & 255) * 8; float f[8];
#pragma unroll
        for (int j = 0; j < 8; ++j) { const int k = k8 + j; f[j] = n < 8 ? a.in[21][((size_t)l * D_ + k) * 8 + n] : (n < 72 ? a.in[23][((size_t)l * D_ + k) * 64 + (n - 8)] : 0.f); }
        u32x4 w; w.x = cvt_pk_bf16(f[0], f[1]); w.y = cvt_pk_bf16(f[2], f[3]); w.z = cvt_pk_bf16(f[4], f[5]); w.w = cvt_pk_bf16(f[6], f[7]);
        *(u32x4*)((bf16_t*)(a.ws + WS_WRT) + ((size_t)l * 256 + n) * D_ + k8) = w; }
    for (int it = gtid; it < 192 * 128; it += gsz) *(u32x4*)(a.ws + WS_WIN1T + (size_t)N_IN1 * D_ + (size_t)it * 16) = (u32x4){0u, 0u, 0u, 0u};
    transpose_job(a.in[4], (bf16_t*)(a.ws + WS_WIN0T), D_, N_IN0, D_, 0, 0, 0, 1, lds);
    transpose_job(a.in[14], (bf16_t*)(a.ws + WS_WOUT0T), D_, D_, D_, 0, 0, 0, 1, lds);
    transpose_job8(a.in[15], a.ws + WS_WIN1T, D_, N_IN1, D_, 0, 0, 1, lds);
    transpose_job8(a.in[20], a.ws + WS_WOUT1T, 4096, D_, 4096, 0, 0, 1, lds);
    transpose_job(a.in[7], (bf16_t*)(a.ws + WS_WGATES), 128, 128, 128, 128 * 128, 256 * 128, 0, 8, lds);
    transpose_job(a.in[9], (bf16_t*)(a.ws + WS_WGATES) + 128 * 128, 128, 128, 128, 128 * 128, 256 * 128, 0, 8, lds);
    moe_weight_jobs(a, 0, lds);
}

template <int MODE>
__device__ __forceinline__ void phase_norm(const Args& a, const float* src, const float* gain, int layer) {
    const int wid = TIDX >> 6, lane = TIDX & 63;
    bf16_t* xw = (bf16_t*)(a.ws + WS_X); bf16_t* hw = (bf16_t*)(a.ws + WS_H);
    const unsigned char* ym = a.ws + WS_YMOE; const int* posof = (const int*)(a.ws + WS_POSOF); const float* gate = (const float*)(a.ws + WS_GATE);
    for (int row = BID * 8 + wid; row < T_; row += NBLK * 8) {
        f32x4 v[8];
#pragma unroll
        for (int i = 0; i < 8; ++i) { if (src) v[i] = *(const f32x4*)(src + (size_t)row * D_ + (i * 64 + lane) * 4);
            else { const u32x2 r = *(const u32x2*)(xw + (size_t)row * D_ + (i * 64 + lane) * 4); v[i] = (f32x4){bf_lo(r.x), bf_hi(r.x), bf_lo(r.y), bf_hi(r.y)}; } }
        if (MODE >= 1) {
            const int p0 = posof[row * 2], p1 = posof[row * 2 + 1]; const float g0 = gate[row * 2], g1 = gate[row * 2 + 1];
#pragma unroll
            for (int i = 0; i < 8; ++i) { const int c = (i * 64 + lane) * 4;
                const int y0 = *(const int*)(ym + (size_t)p0 * D_ + c), y1 = *(const int*)(ym + (size_t)p1 * D_ + c);
                const f32x2 a0 = __builtin_amdgcn_cvt_pk_f32_fp8(y0, false), a1 = __builtin_amdgcn_cvt_pk_f32_fp8(y0, true), b0 = __builtin_amdgcn_cvt_pk_f32_fp8(y1, false), b1 = __builtin_amdgcn_cvt_pk_f32_fp8(y1, true);
                v[i][0] += g0 * a0[0] + g1 * b0[0]; v[i][1] += g0 * a0[1] + g1 * b0[1]; v[i][2] += g0 * a1[0] + g1 * b1[0]; v[i][3] += g0 * a1[1] + g1 * b1[1]; }
            if (MODE == 1) {
#pragma unroll
                for (int i = 0; i < 8; ++i) { u32x2 w; w.x = cvt_pk_bf16(v[i][0], v[i][1]); w.y = cvt_pk_bf16(v[i][2], v[i][3]); *(u32x2*)(xw + (size_t)row * D_ + (i * 64 + lane) * 4) = w; } }
        }
        float ss = 0.f;
#pragma unroll
        for (int i = 0; i < 8; ++i) ss += v[i][0] * v[i][0] + v[i][1] * v[i][1] + v[i][2] * v[i][2] + v[i][3] * v[i][3];
        ss = wave_sum(ss);
        const float rstd = rsqrtf(ss * (1.0f / D_) + 1e-6f);
#pragma unroll
        for (int i = 0; i < 8; ++i) { const int c = (i * 64 + lane) * 4; const f32x4 g = *(const f32x4*)(gain + c);
            const f32x4 o = v[i] * rstd * g;
            if (MODE == 2) *(f32x4*)(a.out + (size_t)row * D_ + c) = o;
            else { if (MODE != 1) { u32x2 w; w.x = cvt_pk_bf16(o[0], o[1]); w.y = cvt_pk_bf16(o[2], o[3]); *(u32x2*)(hw + (size_t)row * D_ + c) = w; }
                   if (layer >= 0) *(unsigned*)(a.ws + WS_H8 + (size_t)row * D_ + c) = pk_fp8x4(o[0], o[1], o[2], o[3]); } }
    }
    (void)layer;
}

__device__ __forceinline__ void phase_gemm_in0(const Args& a, LAS unsigned char* lds) {
    SrcGrid S{(const char*)(a.ws + WS_H), (const char*)(a.ws + WS_WIN0T), (size_t)BM * D_ * 2, (size_t)BM * D_ * 2, 64, 64 * 24, D_, D_};
    EpiProj E{(bf16_t*)(a.ws + WS_PROJ), N_IN0, (float*)(a.ws + WS_FLOG), 1024, 12, 16, 256, 1.0f};
    gemm_stream<false, false>(lds, S, D_ / BK, E);
}

__device__ __forceinline__ void phase_rg_conv(const Args& a) {
    const bf16_t* p0 = (const bf16_t*)(a.ws + WS_PROJ); bf16_t* xc = (bf16_t*)(a.ws + WS_XC);
    const float* cw = a.in[5]; const float* cb = a.in[6];
    for (int it = BID * NTHREADS + TIDX; it < 128 * (T_ / 16); it += NBLK * NTHREADS) { const int c = (it & 127) * 8; const size_t t0 = (size_t)(it >> 7) * 16;
        float w[4][8], bias[8];
#pragma unroll
        for (int k = 0; k < 4; ++k) { const f32x4 w0 = *(const f32x4*)(cw + k * 1024 + c), w1 = *(const f32x4*)(cw + k * 1024 + c + 4);
            w[k][0] = w0[0]; w[k][1] = w0[1]; w[k][2] = w0[2]; w[k][3] = w0[3]; w[k][4] = w1[0]; w[k][5] = w1[1]; w[k][6] = w1[2]; w[k][7] = w1[3]; }
        { const f32x4 b0 = *(const f32x4*)(cb + c), b1 = *(const f32x4*)(cb + c + 4); bias[0] = b0[0]; bias[1] = b0[1]; bias[2] = b0[2]; bias[3] = b0[3]; bias[4] = b1[0]; bias[5] = b1[1]; bias[6] = b1[2]; bias[7] = b1[3]; }
        u32x4 x0 = (u32x4){0u, 0u, 0u, 0u}, x1 = x0, x2 = x0;
        if ((t0 & (S_ - 1)) != 0) { x0 = *(const u32x4*)(p0 + (t0 - 3) * N_IN0 + c); x1 = *(const u32x4*)(p0 + (t0 - 2) * N_IN0 + c); x2 = *(const u32x4*)(p0 + (t0 - 1) * N_IN0 + c); }
#pragma unroll 4
        for (int r = 0; r < 16; ++r) { const u32x4 x3 = *(const u32x4*)(p0 + (t0 + r) * N_IN0 + c);
            float acc[8];
#define TAPS(j, f, m) (bias[j] + w[0][j] * f(x0.m) + w[1][j] * f(x1.m) + w[2][j] * f(x2.m) + w[3][j] * f(x3.m))
            acc[0] = TAPS(0, bf_lo, x); acc[1] = TAPS(1, bf_hi, x); acc[2] = TAPS(2, bf_lo, y); acc[3] = TAPS(3, bf_hi, y);
            acc[4] = TAPS(4, bf_lo, z); acc[5] = TAPS(5, bf_hi, z); acc[6] = TAPS(6, bf_lo, w); acc[7] = TAPS(7, bf_hi, w);
#undef TAPS
            u32x4 o; o.x = cvt_pk_bf16(acc[0], acc[1]); o.y = cvt_pk_bf16(acc[2], acc[3]); o.z = cvt_pk_bf16(acc[4], acc[5]); o.w = cvt_pk_bf16(acc[6], acc[7]);
            *(u32x4*)(xc + (t0 + r) * 1024 + c) = o;
            x0 = x1; x1 = x2; x2 = x3; } }
}

struct SrcRgGates {
    const char* xc; const char* w; int total;
    __device__ __forceinline__ bool next(int i, UnitD& u) const { const int id = BID + i * NBLK; if (id >= total) return false; u.t0 = id & 63; u.t1 = id >> 6; u.t2 = 0;
        u.gA = xc + ((size_t)u.t0 * BM * 1024 + u.t1 * 128) * 2; u.gB = w + (size_t)u.t1 * 256 * 128 * 2; return true; }
    __device__ __forceinline__ void va(const UnitD&, unsigned (&v)[2][2]) const { offs_direct(v, 1024, false); }
    __device__ __forceinline__ void vb(unsigned (&v)[2][2]) const { offs_direct(v, 128, true); }
};
__device__ __forceinline__ void phase_rg_gates(const Args& a, LAS unsigned char* lds) {
    SrcRgGates S{(const char*)(a.ws + WS_XC), (const char*)(a.ws + WS_WGATES), 64 * 8};
    EpiRgGates E{(bf16_t*)(a.ws + WS_A), (bf16_t*)(a.ws + WS_U), (const bf16_t*)(a.ws + WS_XC), a.in[8], a.in[10], a.in[11]};
    int nt = 2; asm volatile("" : "+s"(nt));
    gemm_stream<false, false>(lds, S, nt, E);
}

__device__ __forceinline__ void phase_rg_scan(const Args& a, LAS unsigned char* lds) {
    const bf16_t* LA = (const bf16_t*)(a.ws + WS_A); const bf16_t* U = (const bf16_t*)(a.ws + WS_U);
    const bf16_t* p0 = (const bf16_t*)(a.ws + WS_PROJ); bf16_t* Y = (bf16_t*)(a.ws + WS_Y);
    LAS float* sP = (LAS float*)lds; LAS float* sH = sP + 4096; LAS float* gP = sH + 4096; LAS float* gH = gP + 512; LAS float* gC = gH + 512;
    const int tid = TIDX, seg = tid >> 1, c8 = (tid & 1) * 8;
    for (int blk = BID; blk < NB_ * 64; blk += NBLK) { const int b = blk >> 6, c = (blk & 63) * 16 + c8;
        const size_t base = (((size_t)blk * S_ + seg * 16) << 4) + c8;
        float P[8], H[8];
#pragma unroll
        for (int j = 0; j < 8; ++j) { P[j] = 1.f; H[j] = 0.f; }
#pragma unroll 4
        for (int s = 0; s < 16; ++s) { const u32x4 lw = *(const u32x4*)(LA + base + (size_t)s * 16), uw = *(const u32x4*)(U + base + (size_t)s * 16);
            const float la[8] = {bf_lo(lw.x), bf_hi(lw.x), bf_lo(lw.y), bf_hi(lw.y), bf_lo(lw.z), bf_hi(lw.z), bf_lo(lw.w), bf_hi(lw.w)};
            const float uu[8] = {bf_lo(uw.x), bf_hi(uw.x), bf_lo(uw.y), bf_hi(uw.y), bf_lo(uw.z), bf_hi(uw.z), bf_lo(uw.w), bf_hi(uw.w)};
#pragma unroll
            for (int j = 0; j < 8; ++j) { const float av = __expf(la[j]); H[j] = av * H[j] + uu[j]; P[j] *= av; } }
        __syncthreads();
#pragma unroll
        for (int j = 0; j < 8; ++j) { sP[seg * 16 + c8 + j] = P[j]; sH[seg * 16 + c8 + j] = H[j]; }
        __syncthreads();
        { const int ch = tid & 15, grp = tid >> 4; float p = 1.f, h = 0.f;
#pragma unroll
          for (int q = 0; q < 8; ++q) { const int sgi = grp * 8 + q; h = sP[sgi * 16 + ch] * h + sH[sgi * 16 + ch]; p *= sP[sgi * 16 + ch]; }
          gP[grp * 16 + ch] = p; gH[grp * 16 + ch] = h; }
        __syncthreads();
        if (tid < 16) { float carry = 0.f; for (int g = 0; g < 32; ++g) { gC[g * 16 + tid] = carry; carry = gP[g * 16 + tid] * carry + gH[g * 16 + tid]; } }
        __syncthreads();
        { const int ch = tid & 15, grp = tid >> 4; float h = gC[grp * 16 + ch];
#pragma unroll
          for (int q = 0; q < 8; ++q) { const int sgi = grp * 8 + q; const float pin = sP[sgi * 16 + ch], hin = sH[sgi * 16 + ch]; sH[sgi * 16 + ch] = h; h = pin * h + hin; } }
        __syncthreads();
#pragma unroll
        for (int j = 0; j < 8; ++j) H[j] = sH[seg * 16 + c8 + j];
#pragma unroll 4
        for (int s = 0; s < 16; ++s) { const u32x4 lw = *(const u32x4*)(LA + base + (size_t)s * 16), uw = *(const u32x4*)(U + base + (size_t)s * 16);
            const size_t t = (size_t)b * S_ + seg * 16 + s; const u32x4 gw = *(const u32x4*)(p0 + t * N_IN0 + 1024 + c);
            const float la[8] = {bf_lo(lw.x), bf_hi(lw.x), bf_lo(lw.y), bf_hi(lw.y), bf_lo(lw.z), bf_hi(lw.z), bf_lo(lw.w), bf_hi(lw.w)};
            const float uu[8] = {bf_lo(uw.x), bf_hi(uw.x), bf_lo(uw.y), bf_hi(uw.y), bf_lo(uw.z), bf_hi(uw.z), bf_lo(uw.w), bf_hi(uw.w)};
            const float gg[8] = {bf_lo(gw.x), bf_hi(gw.x), bf_lo(gw.y), bf_hi(gw.y), bf_lo(gw.z), bf_hi(gw.z), bf_lo(gw.w), bf_hi(gw.w)};
            float y[8];
#pragma unroll
            for (int j = 0; j < 8; ++j) { H[j] = __expf(la[j]) * H[j] + uu[j]; y[j] = H[j] * gelu_tanh(gg[j]); }
            u32x4 o; o.x = cvt_pk_bf16(y[0], y[1]); o.y = cvt_pk_bf16(y[2], y[3]); o.z = cvt_pk_bf16(y[4], y[5]); o.w = cvt_pk_bf16(y[6], y[7]);
            *(u32x4*)(Y + t * D_ + c) = o; }
    }
}

typedef short s16x4 __attribute__((ext_vector_type(4)));
__device__ __forceinline__ f32x4 mfma32(bf16x8 a, bf16x8 b, f32x4 c) { return __builtin_amdgcn_mfma_f32_16x16x32_bf16(a, b, c, 0, 0, 0); }
__device__ __forceinline__ bf16x8 lds_frag(LAS const unsigned char* p) { return *(const LAS bf16x8*)p; }
__device__ __forceinline__ s16x4 lds_tr4(LAS const unsigned char* p) { return __builtin_amdgcn_ds_read_tr16_b64_v4i16((LAS s16x4*)p); }
__device__ __forceinline__ bf16x8 lds_tr8(LAS const unsigned char* p, int rowskip_bytes) {
    const s16x4 lo = lds_tr4(p), hi = lds_tr4(p + rowskip_bytes); return __builtin_shufflevector(lo, hi, 0, 1, 2, 3, 4, 5, 6, 7); }
__device__ __forceinline__ bf16x8 pack8(const f32x4& lo, const f32x4& hi) { u32x4 w; w.x = cvt_pk_bf16(lo[0], lo[1]); w.y = cvt_pk_bf16(lo[2], lo[3]); w.z = cvt_pk_bf16(hi[0], hi[1]); w.w = cvt_pk_bf16(hi[2], hi[3]); return __builtin_bit_cast(bf16x8, w); }
constexpr int RSB = 272;

constexpr size_t WS_HQ = WS_O;
constexpr size_t WS_HA = WS_HQ + (size_t)2048 * 64 * 128 * 2;
constexpr size_t WS_HG = WS_HA + (size_t)2048 * 8 * 512 * 2;
constexpr size_t WS_HS = WS_HG + (size_t)2048 * 128 * 128 * 2;
constexpr size_t WS_HD = WS_HS + (size_t)2048 * 128 * 128 * 2;
static_assert(WS_HD + (size_t)2048 * 128 * 4 <= WS_TAIL, "hgrn overlay");

__device__ __forceinline__ void phase_hg1(const Args& a, LAS unsigned char* lds) {
    const bf16_t* p0 = (const bf16_t*)(a.ws + WS_PROJ); const float* flog = (const float*)(a.ws + WS_FLOG); const float* lb = (const float*)(a.ws + WS_LB);
    bf16_t* QG = (bf16_t*)(a.ws + WS_HQ); bf16_t* AG = (bf16_t*)(a.ws + WS_HA); bf16_t* GG = (bf16_t*)(a.ws + WS_HG); float* DG = (float*)(a.ws + WS_HD);
    constexpr int SEG = 0, QT = 4096, KT = QT + 64 * RSB, KH = KT + 64 * RSB, VS = KH + 64 * RSB;
    const int tid = TIDX, wid = tid >> 6, lane = tid & 63, I = lane & 15, G = lane >> 4, k2 = 2 * lane, sg = wid;
    LAS float* seg = (LAS float*)(lds + SEG);
    u32x4 pvv[2]; f32x2 pz[8]; unsigned pqw[8];
#define HG1_LOAD(it_) do { const int bh_ = (it_) >> 6, ck_ = (it_) & 63, h_ = bh_ & 7; const size_t t0_ = (size_t)(bh_ >> 3) * S_ + ck_ * 64; \
        _Pragma("unroll") for (int i = 0; i < 2; ++i) { const int c = tid + i * 512, s_ = c >> 4, v8 = (c & 15) * 8; pvv[i] = *(const u32x4*)(p0 + (t0_ + s_) * N_IN0 + 4096 + h_ * 128 + v8); } \
        _Pragma("unroll") for (int i = 0; i < 8; ++i) { const size_t t_ = t0_ + sg * 8 + i; pz[i] = *(const f32x2*)(flog + t_ * 1024 + h_ * 128 + k2); pqw[i] = *(const unsigned*)(p0 + t_ * N_IN0 + 2048 + h_ * 128 + k2); } } while (0)
    if (BID < 2048) HG1_LOAD(BID);
    for (int item = BID; item < 2048; item += NBLK) { const int bh = item >> 6, h = bh & 7;
        LDS_BARRIER();
#pragma unroll
        for (int i = 0; i < 2; ++i) { const int c = tid + i * 512, s = c >> 4, v8 = (c & 15) * 8; *(LAS u32x4*)(lds + VS + s * RSB + v8 * 2) = pvv[i]; }
        const f32x2 l2 = *(const f32x2*)(lb + h * 128 + k2);
        float f[8][2], cb[8][2]; unsigned qw[8]; float c0 = 0.f, c1 = 0.f;
#pragma unroll
        for (int i = 0; i < 8; ++i) { const f32x2 z = pz[i]; qw[i] = pqw[i];
            f[i][0] = l2[0] + (1.0f - l2[0]) * sigmoidf_(z[0]); f[i][1] = l2[1] + (1.0f - l2[1]) * sigmoidf_(z[1]);
            c0 += __logf(f[i][0]); c1 += __logf(f[i][1]); cb[i][0] = c0; cb[i][1] = c1; }
        *(LAS f32x2*)(seg + sg * 128 + k2) = (f32x2){c0, c1};
        if (item + NBLK < 2048) HG1_LOAD(item + NBLK);
        LDS_BARRIER();
        float off0 = 0.f, off1 = 0.f, tot0 = 0.f, tot1 = 0.f;
#pragma unroll
        for (int s2 = 0; s2 < 8; ++s2) { const f32x2 v = *(const LAS f32x2*)(seg + s2 * 128 + k2); tot0 += v[0]; tot1 += v[1]; if (s2 < sg) { off0 += v[0]; off1 += v[1]; } }
        const float et0 = __expf(tot0), et1 = __expf(tot1);
#pragma unroll
        for (int i = 0; i < 8; ++i) { const int t = sg * 8 + i;
            const float e0 = __expf(cb[i][0] + off0), e1 = __expf(cb[i][1] + off1), r0 = __builtin_amdgcn_rcpf(e0), r1 = __builtin_amdgcn_rcpf(e1), km0 = 1.0f - f[i][0], km1 = 1.0f - f[i][1];
            const unsigned qt = cvt_pk_bf16(siluf_(bf_lo(qw[i])) * e0, siluf_(bf_hi(qw[i])) * e1);
            *(LAS unsigned*)(lds + QT + t * RSB + k2 * 2) = qt; *(unsigned*)(QG + ((size_t)item * 64 + t) * 128 + k2) = qt;
            *(LAS unsigned*)(lds + KT + t * RSB + k2 * 2) = cvt_pk_bf16(km0 * r0, km1 * r1);
            *(LAS unsigned*)(lds + KH + t * RSB + k2 * 2) = cvt_pk_bf16(km0 * r0 * et0, km1 * r1 * et1); }
        if (sg == 0) *(f32x2*)(DG + (size_t)item * 128 + k2) = (f32x2){et0, et1};
        LDS_BARRIER();
        { const int tt = wid & 3, sp = wid >> 2;
          bf16x8 qf[4];
#pragma unroll
          for (int ks = 0; ks < 4; ++ks) qf[ks] = lds_frag(lds + QT + (16 * tt + I) * RSB + (32 * ks + 8 * G) * 2);
          f32x4 acc[2];
#pragma unroll
          for (int hh = 0; hh < 2; ++hh) { const int st = 2 * sp + hh; acc[hh] = (f32x4){0.f, 0.f, 0.f, 0.f};
              if (st <= tt) {
#pragma unroll
                  for (int ks = 0; ks < 4; ++ks) acc[hh] = mfma32(lds_frag(lds + KT + (16 * st + I) * RSB + (32 * ks + 8 * G) * 2), qf[ks], acc[hh]);
#pragma unroll
                  for (int r = 0; r < 4; ++r) if (16 * st + 4 * G + r > 16 * tt + I) acc[hh][r] = 0.f; } }
          *(bf16x8*)(AG + (((size_t)item * 4 + tt) * 2 + sp) * 512 + lane * 8) = pack8(acc[0], acc[1]); }
        { const int kt = wid, q = I >> 2, p = I & 3;
          bf16x8 ka[2];
#pragma unroll
          for (int ks = 0; ks < 2; ++ks) ka[ks] = lds_tr8(lds + KH + (32 * ks + 8 * G + q) * RSB + (16 * kt + 4 * p) * 2, 4 * RSB);
#pragma unroll
          for (int vt = 0; vt < 8; ++vt) { f32x4 acc = (f32x4){0.f, 0.f, 0.f, 0.f};
#pragma unroll
              for (int ks = 0; ks < 2; ++ks) acc = mfma32(ka[ks], lds_tr8(lds + VS + (32 * ks + 8 * G + q) * RSB + (16 * vt + 4 * p) * 2, 4 * RSB), acc);
              u32x2 w; w.x = cvt_pk_bf16(acc[0], acc[1]); w.y = cvt_pk_bf16(acc[2], acc[3]);
              *(u32x2*)(GG + ((size_t)item * 128 + 16 * vt + I) * 128 + 16 * kt + 4 * G) = w; } }
    }
#undef HG1_LOAD
}

__device__ __forceinline__ void phase_hg2(const Args& a) {
    const bf16_t* GG = (const bf16_t*)(a.ws + WS_HG); const float* DG = (const float*)(a.ws + WS_HD); bf16_t* SG = (bf16_t*)(a.ws + WS_HS);
    for (int gid = BID * NTHREADS + TIDX; gid < 32 * 4096; gid += NBLK * NTHREADS) { const int bh = gid >> 12, e = gid & 4095, v = e >> 5, k4 = (e & 31) * 4;
        f32x4 S = (f32x4){0.f, 0.f, 0.f, 0.f};
        for (int n = 0; n < 64; ++n) { const size_t item = (size_t)bh * 64 + n, o = (item * 128 + v) * 128 + k4;
            u32x2 w; w.x = cvt_pk_bf16(S[0], S[1]); w.y = cvt_pk_bf16(S[2], S[3]); *(u32x2*)(SG + o) = w;
            const f32x4 d = *(const f32x4*)(DG + item * 128 + k4); const u32x2 g = *(const u32x2*)(GG + o);
            S[0] = d[0] * S[0] + bf_lo(g.x); S[1] = d[1] * S[1] + bf_hi(g.x); S[2] = d[2] * S[2] + bf_lo(g.y); S[3] = d[3] * S[3] + bf_hi(g.y); } }
}

__device__ __forceinline__ void phase_hg3(const Args& a, LAS unsigned char* lds) {
    const bf16_t* p0 = (const bf16_t*)(a.ws + WS_PROJ); const bf16_t* QG = (const bf16_t*)(a.ws + WS_HQ); const bf16_t* AG = (const bf16_t*)(a.ws + WS_HA); const bf16_t* SG = (const bf16_t*)(a.ws + WS_HS);
    bf16_t* Y = (bf16_t*)(a.ws + WS_Y); const float* gain = a.in[13];
    constexpr int ST = 0, QT = 128 * RSB, VS = QT + 64 * RSB, PART = VS + 64 * RSB;
    const int tid = TIDX, wid = tid >> 6, lane = tid & 63, I = lane & 15, G = lane >> 4, q = I >> 2, p = I & 3;
    LAS float* part = (LAS float*)(lds + PART);
    const int tt = wid & 3, vh = wid >> 2;
    u32x4 ps[4], pq2[2], pv2[2]; bf16x8 paf[2];
#define HG3_LOAD(it_) do { const int bh_ = (it_) >> 6, ck_ = (it_) & 63; const size_t t0_ = (size_t)(bh_ >> 3) * S_ + ck_ * 64; const int h_ = bh_ & 7; \
        _Pragma("unroll") for (int i = 0; i < 4; ++i) { const int c = tid + i * 512, v = c >> 4, k8 = (c & 15) * 8; ps[i] = *(const u32x4*)(SG + ((size_t)(it_) * 128 + v) * 128 + k8); } \
        _Pragma("unroll") for (int i = 0; i < 2; ++i) { const int c = tid + i * 512, s_ = c >> 4, c8 = (c & 15) * 8; pq2[i] = *(const u32x4*)(QG + ((size_t)(it_) * 64 + s_) * 128 + c8); pv2[i] = *(const u32x4*)(p0 + (t0_ + s_) * N_IN0 + 4096 + h_ * 128 + c8); } \
        _Pragma("unroll") for (int sp = 0; sp < 2; ++sp) paf[sp] = *(const bf16x8*)(AG + (((size_t)(it_) * 4 + tt) * 2 + sp) * 512 + lane * 8); } while (0)
    if (BID < 2048) HG3_LOAD(BID);
    for (int item = BID; item < 2048; item += NBLK) { const int bh = item >> 6, ck = item & 63, b = bh >> 3, h = bh & 7; const size_t t0 = (size_t)b * S_ + ck * 64;
        LDS_BARRIER();
#pragma unroll
        for (int i = 0; i < 4; ++i) { const int c = tid + i * 512, v = c >> 4, k8 = (c & 15) * 8; *(LAS u32x4*)(lds + ST + v * RSB + k8 * 2) = ps[i]; }
#pragma unroll
        for (int i = 0; i < 2; ++i) { const int c = tid + i * 512, s2 = c >> 4, c8 = (c & 15) * 8; *(LAS u32x4*)(lds + QT + s2 * RSB + c8 * 2) = pq2[i]; *(LAS u32x4*)(lds + VS + s2 * RSB + c8 * 2) = pv2[i]; }
        bf16x8 af[2]; af[0] = paf[0]; af[1] = paf[1];
        if (item + NBLK < 2048) HG3_LOAD(item + NBLK);
        u32x2 zwp[4];
#pragma unroll
        for (int vi = 0; vi < 4; ++vi) zwp[vi] = *(const u32x2*)(p0 + (t0 + 16 * tt + I) * N_IN0 + 5120 + h * 128 + 16 * (4 * vh + vi) + 4 * G);
        LDS_BARRIER();
        bf16x8 qf[4];
#pragma unroll
        for (int ks = 0; ks < 4; ++ks) qf[ks] = lds_frag(lds + QT + (16 * tt + I) * RSB + (32 * ks + 8 * G) * 2);
        f32x4 acc[4]; float ss = 0.f;
#pragma unroll
        for (int vi = 0; vi < 4; ++vi) { const int vt = 4 * vh + vi; acc[vi] = (f32x4){0.f, 0.f, 0.f, 0.f};
#pragma unroll
            for (int ks = 0; ks < 4; ++ks) acc[vi] = mfma32(lds_frag(lds + ST + (16 * vt + I) * RSB + (32 * ks + 8 * G) * 2), qf[ks], acc[vi]);
#pragma unroll
            for (int sp = 0; sp < 2; ++sp) acc[vi] = mfma32(lds_tr8(lds + VS + (32 * sp + 4 * G + q) * RSB + (16 * vt + 4 * p) * 2, 16 * RSB), af[sp], acc[vi]);
            ss += acc[vi][0] * acc[vi][0] + acc[vi][1] * acc[vi][1] + acc[vi][2] * acc[vi][2] + acc[vi][3] * acc[vi][3]; }
        ss += __shfl_xor(ss, 16); ss += __shfl_xor(ss, 32);
        if (G == 0) part[wid * 16 + I] = ss;
        LDS_BARRIER();
        const float rstd = rsqrtf((part[wid * 16 + I] + part[(wid ^ 4) * 16 + I]) * (1.0f / 128.0f) + 1e-6f);
        const size_t t = t0 + 16 * tt + I;
#pragma unroll
        for (int vi = 0; vi < 4; ++vi) { const int c = h * 128 + 16 * (4 * vh + vi) + 4 * G;
            const f32x4 gn = *(const f32x4*)(gain + c); const u32x2 zw = zwp[vi];
            const float o0 = acc[vi][0] * rstd * gn[0] * siluf_(bf_lo(zw.x)), o1 = acc[vi][1] * rstd * gn[1] * siluf_(bf_hi(zw.x)), o2 = acc[vi][2] * rstd * gn[2] * siluf_(bf_lo(zw.y)), o3 = acc[vi][3] * rstd * gn[3] * siluf_(bf_hi(zw.y));
            u32x2 w; w.x = cvt_pk_bf16(o0, o1); w.y = cvt_pk_bf16(o2, o3); *(u32x2*)(Y + t * D_ + 1024 + c) = w; }
    }
#undef HG3_LOAD
}

__device__ __forceinline__ void phase_gdn_norm(const Args& a) {
    const bf16_t* O = (const bf16_t*)(a.ws + WS_O); const bf16_t* pj = (const bf16_t*)(a.ws + WS_PROJ); unsigned char* Y = a.ws + WS_Y; const float* gain = a.in[19];
    const int lane = TIDX & 63, wid = TIDX >> 6, gc = (lane & 15) * 8;
    const f32x4 g0 = *(const f32x4*)(gain + gc), g1 = *(const f32x4*)(gain + gc + 4);
    for (int row = BID * 8 + wid; row < T_; row += NBLK * 8) {
#pragma unroll 4
        for (int i = 0; i < 8; ++i) { const int c = (i * 64 + lane) * 8;
            const u32x4 ow = *(const u32x4*)(O + (size_t)row * 4096 + c), zw = *(const u32x4*)(pj + (size_t)row * N_IN1P + 8192 + c);
            const float o[8] = {bf_lo(ow.x), bf_hi(ow.x), bf_lo(ow.y), bf_hi(ow.y), bf_lo(ow.z), bf_hi(ow.z), bf_lo(ow.w), bf_hi(ow.w)};
            const float z[8] = {bf_lo(zw.x), bf_hi(zw.x), bf_lo(zw.y), bf_hi(zw.y), bf_lo(zw.z), bf_hi(zw.z), bf_lo(zw.w), bf_hi(zw.w)};
            float ss = 0.f;
#pragma unroll
            for (int q = 0; q < 8; ++q) ss += o[q] * o[q];
            ss = row16_sum(ss);
            const float rstd = rsqrtf(ss * (1.0f / 128.0f) + 1e-6f);
            float y[8];
#pragma unroll
            for (int q = 0; q < 8; ++q) y[q] = o[q] * rstd * (q < 4 ? g0[q & 3] : g1[q & 3]) * siluf_(z[q]);
            u32x2 w; w.x = pk_fp8x4(y[0], y[1], y[2], y[3]); w.y = pk_fp8x4(y[4], y[5], y[6], y[7]);
            *(u32x2*)(Y + (size_t)row * 4096 + c) = w; }
    }
}

template <bool FP8>
__device__ __forceinline__ void phase_gemm_out(const Args& a, LAS unsigned char* lds, int K, const void* w, const float* xin) {
    const int eb = FP8 ? 1 : 2;
    SrcGrid S{(const char*)(a.ws + WS_Y), (const char*)w, (size_t)BM * K * eb, (size_t)BM * K * eb, 64, 64 * 8, K * eb / 2, K * eb / 2};
    EpiResid E{(bf16_t*)(a.ws + WS_X), xin, (const bf16_t*)(a.ws + WS_X), FP8 ? 1.0f / W8_SCALE : 1.0f};
    gemm_stream<false, FP8>(lds, S, K * eb / 128, E);
}

struct SrcRouter {
    const char* h; const char* w;
    __device__ __forceinline__ bool next(int i, UnitD& u) const { const int id = BID + i * NBLK; if (id >= 256) return false; u.t0 = id & 63; u.t1 = id >> 6; u.t2 = 0;
        u.gA = h + ((size_t)u.t0 * BM * D_ + u.t1 * 512) * 2; u.gB = w + (size_t)u.t1 * 512 * 2; return true; }
    __device__ __forceinline__ void va(const UnitD&, unsigned (&v)[2][2]) const { offs_direct(v, D_, false); }
    __device__ __forceinline__ void vb(unsigned (&v)[2][2]) const { offs_direct(v, D_, true); }
};
struct EpiLogitsQ {
    float* O;
    __device__ __forceinline__ void operator()(const Acc& acc, const UnitD& u, int wr, int wc, int fr, int fq) const { store_f32_tile(acc, O + ((size_t)u.t1 * T_ + (size_t)u.t0 * BM) * 128, nullptr, 128, 128, wr, wc, fr, fq); }
};
__device__ __forceinline__ void phase_gemm_router(const Args& a, LAS unsigned char* lds, int layer) {
    SrcRouter S{(const char*)(a.ws + WS_H), (const char*)(a.ws + WS_WRT) + (size_t)layer * 256 * D_ * 2};
    EpiLogitsQ E{(float*)(a.ws + WS_O)};
    gemm_stream<false, false>(lds, S, 512 / BK, E);
}

__device__ __forceinline__ void phase_route(const Args& a, int layer) {
    const float* lg = (const float*)(a.ws + WS_O); const float* bg = a.in[22] + layer * 8; const float* be = a.in[24] + layer * 64;
    int* cnt = (int*)(a.ws + WS_CTL + CTL_CNT) + layer * 64;
    int* eid = (int*)(a.ws + WS_EID); int* slot = (int*)(a.ws + WS_SLOT); float* gate = (float*)(a.ws + WS_GATE); int* rowmap = (int*)(a.ws + WS_ROWMAP);
    const int gtid = BID * NTHREADS + TIDX, gsz = NBLK * NTHREADS;
    for (int i = gtid; i < MPAD; i += gsz) rowmap[i] = 0;
    for (int t = gtid; t < T_; t += gsz) {
        f32x4 ga = (f32x4){0.f, 0.f, 0.f, 0.f}, gb = ga;
#pragma unroll
        for (int kq = 0; kq < 4; ++kq) { ga += *(const f32x4*)(lg + ((size_t)kq * T_ + t) * 128); gb += *(const f32x4*)(lg + ((size_t)kq * T_ + t) * 128 + 4); }
        const float gl[8] = {ga[0] + bg[0], ga[1] + bg[1], ga[2] + bg[2], ga[3] + bg[3], gb[0] + bg[4], gb[1] + bg[5], gb[2] + bg[6], gb[3] + bg[7]};
        float mx = -3.0e38f; int gi = 0;
#pragma unroll
        for (int j = 0; j < 8; ++j) if (gl[j] > mx) { mx = gl[j]; gi = j; }
        float se = 0.f;
#pragma unroll
        for (int j = 0; j < 8; ++j) se += __expf(gl[j] - mx);
        const float gp = 1.0f / se;
        f32x4 ea = *(const f32x4*)(be + gi * 8), eb = *(const f32x4*)(be + gi * 8 + 4);
#pragma unroll
        for (int kq = 0; kq < 4; ++kq) { ea += *(const f32x4*)(lg + ((size_t)kq * T_ + t) * 128 + 8 + gi * 8); eb += *(const f32x4*)(lg + ((size_t)kq * T_ + t) * 128 + 12 + gi * 8); }
        const float el[8] = {ea[0], ea[1], ea[2], ea[3], eb[0], eb[1], eb[2], eb[3]};
        float l1 = -3.0e38f, l2 = -3.0e38f; int i1 = 0, i2 = 0;
#pragma unroll
        for (int j = 0; j < 8; ++j) { const float v = el[j];
            if (v > l1) { l2 = l1; i2 = i1; l1 = v; i1 = j; } else if (v > l2) { l2 = v; i2 = j; } }
        const float e2 = __expf(l2 - l1), inv = 1.0f / (1.0f + e2);
        const int e0 = gi * 8 + i1, e1 = gi * 8 + i2;
        eid[t * 2] = e0; eid[t * 2 + 1] = e1; gate[t * 2] = inv * gp; gate[t * 2 + 1] = e2 * inv * gp;
        slot[t * 2] = atomicAdd(&cnt[e0], 1); slot[t * 2 + 1] = atomicAdd(&cnt[e1], 1); }
}

__device__ __forceinline__ void phase_rowmap(const Args& a, LAS unsigned char* lds, int layer) {
    const int* cnt = (const int*)(a.ws + WS_CTL + CTL_CNT) + layer * 64; LAS int* ps = (LAS int*)lds;
    int* tinfo = (int*)(a.ws + WS_TINFO) + layer * 512;
    const int* eid = (const int*)(a.ws + WS_EID); const int* slot = (const int*)(a.ws + WS_SLOT); int* posof = (int*)(a.ws + WS_POSOF); int* rowmap = (int*)(a.ws + WS_ROWMAP);
    __syncthreads();
    if (TIDX == 0) { int acc = 0; for (int e = 0; e < 64; ++e) { ps[e] = acc; acc += (cnt[e] + 255) & ~255; } ps[64] = acc; }
    __syncthreads();
    if (BID == 0) { if (TIDX <= 64) tinfo[TIDX] = ps[TIDX]; if (TIDX == 65) tinfo[65] = ps[64] >> 8;
        if (TIDX < 192) { const int p = TIDX * 256; int e = 0; for (int j = 0; j < 64; ++j) if (ps[j + 1] <= p) e = j + 1; tinfo[128 + TIDX] = e < 64 ? e : 63; } }
    for (int i = BID * NTHREADS + TIDX; i < T_ * 2; i += NBLK * NTHREADS) { const int p = ps[eid[i]] + slot[i]; posof[i] = p; rowmap[p] = i >> 1; }
    __syncthreads();
}

struct SrcMoeUp {
    const char* h; const char* wg; const int* tinfo; const int* rowmap; int total;
    __device__ __forceinline__ bool next(int i, UnitD& u) const { const int id = BID + i * NBLK; if (id >= total) return false; u.t0 = id >> 2; u.t1 = id & 3;
        u.t2 = __builtin_amdgcn_readfirstlane(tinfo[128 + u.t0]); u.gA = h; u.gB = wg + ((size_t)u.t2 * DEXP + u.t1 * 128) * D_; return true; }
    __device__ __forceinline__ void va(const UnitD& u, unsigned (&v)[2][2]) const { int R0, C0; stage_pos(TIDX, R0, C0);
#pragma unroll
        for (int hh = 0; hh < 2; ++hh)
#pragma unroll
            for (int i = 0; i < 2; ++i) v[hh][i] = (unsigned)(rowmap[u.t0 * 256 + hh * 128 + R0 + 64 * i] * D_ + C0 * 2); }
    __device__ __forceinline__ void vb(unsigned (&v)[2][2]) const { int R0, C0; stage_pos(TIDX, R0, C0);
#pragma unroll
        for (int i = 0; i < 2; ++i) { const int Rr = perm_row(R0 + 64 * i); v[0][i] = (unsigned)(Rr * D_ + C0 * 2); v[1][i] = (unsigned)(WS_WU - WS_WG) + (unsigned)(Rr * D_ + C0 * 2); } }
};
__device__ __forceinline__ void phase_moe_up(const Args& a, LAS unsigned char* lds, int layer) {
    const int* tinfo = (const int*)(a.ws + WS_TINFO) + layer * 512;
    const int ntm = __builtin_amdgcn_readfirstlane(tinfo[65]);
    SrcMoeUp S{(const char*)(a.ws + WS_H8), (const char*)(a.ws + WS_WG), tinfo, (const int*)(a.ws + WS_ROWMAP), ntm * 4};
    EpiSwiGLU E{a.ws + WS_ACT};
    gemm_stream<true, true>(lds, S, D_ / 128, E);
}

struct SrcMoeDown {
    const char* act; const char* wd; const int* tinfo; int total;
    __device__ __forceinline__ bool next(int i, UnitD& u) const { const int id = BID + i * NBLK; if (id >= total) return false; u.t0 = id >> 3; u.t1 = id & 7;
        u.t2 = __builtin_amdgcn_readfirstlane(tinfo[128 + u.t0]); u.gA = act + (size_t)u.t0 * BM * DEXP; u.gB = wd + ((size_t)u.t2 * D_ + u.t1 * BM) * DEXP; return true; }
    __device__ __forceinline__ void va(const UnitD&, unsigned (&v)[2][2]) const { offs_direct(v, DEXP / 2, false); }
    __device__ __forceinline__ void vb(unsigned (&v)[2][2]) const { offs_direct(v, DEXP / 2, true); }
};
__device__ __forceinline__ void phase_moe_down(const Args& a, LAS unsigned char* lds, int layer) {
    const int* tinfo = (const int*)(a.ws + WS_TINFO) + layer * 512; const int ntm = __builtin_amdgcn_readfirstlane(tinfo[65]);
    SrcMoeDown S{(const char*)(a.ws + WS_ACT), (const char*)(a.ws + WS_WD), tinfo, ntm * 8};
    EpiDown E{a.ws + WS_YMOE};
    gemm_stream<false, true>(lds, S, DEXP / 128, E);
}

struct SrcIn1Tail {
    const char* h; const char* w;
    __device__ __forceinline__ bool next(int i, UnitD& u) const { const int id = BID + i * NBLK; if (id >= 256) return false; u.t0 = id & 63; u.t1 = id >> 6; u.t2 = 0;
        u.gA = h + (size_t)u.t0 * BM * D_ + u.t1 * 512; u.gB = w + (size_t)48 * BM * D_ + u.t1 * 512; return true; }
    __device__ __forceinline__ void va(const UnitD&, unsigned (&v)[2][2]) const { offs_direct(v, D_ / 2, false); }
    __device__ __forceinline__ void vb(unsigned (&v)[2][2]) const { offs_direct(v, D_ / 2, true); }
};
struct EpiTailQ {
    float* O;
    __device__ __forceinline__ void operator()(const Acc& acc, const UnitD& u, int wr, int wc, int fr, int fq) const { store_f32_tile(acc, O + ((size_t)u.t1 * T_ + (size_t)u.t0 * BM) * 64, nullptr, 64, 64, wr, wc, fr, fq, 1.0f / W8_SCALE); }
};
__device__ __forceinline__ void phase_gemm_in1(const Args& a, LAS unsigned char* lds) {
    SrcGrid S{(const char*)(a.ws + WS_H8), (const char*)(a.ws + WS_WIN1T), (size_t)BM * D_, (size_t)BM * D_, 64, 64 * 48, D_ / 2, D_ / 2};
    EpiProj E{(bf16_t*)(a.ws + WS_PROJ), N_IN1P, nullptr, 64, 48, 48, 64, 1.0f / W8_SCALE};
    gemm_stream<false, true>(lds, S, D_ / 128, E);
}
__device__ __forceinline__ void phase_gemm_in1_tail(const Args& a, LAS unsigned char* lds) {
    SrcIn1Tail S{(const char*)(a.ws + WS_H8), (const char*)(a.ws + WS_WIN1T)};
    EpiTailQ E{(float*)(a.ws + WS_O)};
    int nt = 4; asm volatile("" : "+s"(nt));
    gemm_stream<false, true>(lds, S, nt, E);
}

__device__ __forceinline__ void phase_gdn_conv(const Args& a) {
    const bf16_t* p1 = (const bf16_t*)(a.ws + WS_PROJ); bf16_t* qc = (bf16_t*)(a.ws + WS_QKVC); const float* cw = a.in[16];
    const int gtid = BID * NTHREADS + TIDX, gsz = NBLK * NTHREADS;
    for (int it = gtid; it < 1024 * (T_ / 128); it += gsz) { const int c = (it & 1023) * 8, seg = it >> 10; const size_t t0 = (size_t)seg * 128;
        float w[4][8];
#pragma unroll
        for (int k = 0; k < 4; ++k) { const f32x4 w0 = *(const f32x4*)(cw + k * 8192 + c), w1 = *(const f32x4*)(cw + k * 8192 + c + 4);
            w[k][0] = w0[0]; w[k][1] = w0[1]; w[k][2] = w0[2]; w[k][3] = w0[3]; w[k][4] = w1[0]; w[k][5] = w1[1]; w[k][6] = w1[2]; w[k][7] = w1[3]; }
        u32x4 x0 = (u32x4){0u, 0u, 0u, 0u}, x1 = x0, x2 = x0;
        if ((t0 & (S_ - 1)) != 0) { x0 = *(const u32x4*)(p1 + (t0 - 3) * N_IN1P + c); x1 = *(const u32x4*)(p1 + (t0 - 2) * N_IN1P + c); x2 = *(const u32x4*)(p1 + (t0 - 1) * N_IN1P + c); }
        const float qsc = c < 2048 ? 0.08838834764831845f : 1.0f;
#pragma unroll 8
        for (int r = 0; r < 128; ++r) { const u32x4 x3 = *(const u32x4*)(p1 + (t0 + r) * N_IN1P + c);
            float acc[8];
#define TAPS(j, f, m) (w[0][j] * f(x0.m) + w[1][j] * f(x1.m) + w[2][j] * f(x2.m) + w[3][j] * f(x3.m))
            acc[0] = TAPS(0, bf_lo, x); acc[1] = TAPS(1, bf_hi, x); acc[2] = TAPS(2, bf_lo, y); acc[3] = TAPS(3, bf_hi, y);
            acc[4] = TAPS(4, bf_lo, z); acc[5] = TAPS(5, bf_hi, z); acc[6] = TAPS(6, bf_lo, w); acc[7] = TAPS(7, bf_hi, w);
#undef TAPS
            float ss = 0.f;
#pragma unroll
            for (int j = 0; j < 8; ++j) { acc[j] = siluf_(acc[j]); ss += acc[j] * acc[j]; }
            ss = row16_sum(ss);
            const float sc = c < 4096 ? rsqrtf(ss + 1e-6f) * qsc : 1.0f;
            u32x4 o; o.x = cvt_pk_bf16(acc[0] * sc, acc[1] * sc); o.y = cvt_pk_bf16(acc[2] * sc, acc[3] * sc); o.z = cvt_pk_bf16(acc[4] * sc, acc[5] * sc); o.w = cvt_pk_bf16(acc[6] * sc, acc[7] * sc);
            *(u32x4*)(qc + (t0 + r) * 8192 + c) = o;
            x0 = x1; x1 = x2; x2 = x3; } }
    const float* tail = (const float*)(a.ws + WS_O); float* bgo = (float*)(a.ws + WS_BG);
    for (int it = gtid; it < T_ * 32; it += gsz) { const int t = it >> 5, hv = it & 31; float tb = 0.f, ta = 0.f;
#pragma unroll
        for (int kq = 0; kq < 4; ++kq) { tb += tail[((size_t)kq * T_ + t) * 64 + hv]; ta += tail[((size_t)kq * T_ + t) * 64 + 32 + hv]; }
        bgo[t * 64 + hv] = sigmoidf_(tb);
        bgo[t * 64 + 32 + hv] = -__expf(a.in[17][hv]) * softplusf_(ta + a.in[18][hv]); }
}

struct MoeTile { const float* src; unsigned char* dst; int lds_, ldd; };
__device__ __forceinline__ MoeTile moe_tile(const Args& a, int g) {
    const int job = g >> 14, r = g & 16383, e = r >> 8, rr = r & 255; MoeTile t;
    typedef __attribute__((address_space(1))) const float* gcf; gcf s25 = (gcf)a.in[25], s26 = (gcf)a.in[26]; asm volatile("" : "+s"(s25), "+s"(s26));
    if (job < 2) { const int ik = rr >> 3, in = rr & 7; t.lds_ = DEXP; t.ldd = D_;
        t.src = (const float*)(job ? s26 : s25) + ((size_t)(NEXP + e) * D_ + ik * 64) * DEXP + in * 64; t.dst = a.ws + (job ? WS_WU : WS_WG) + ((size_t)e * DEXP + in * 64) * D_ + ik * 64; }
    else { const int ik = rr >> 5, in = rr & 31; t.lds_ = D_; t.ldd = DEXP;
        t.src = a.in[27] + ((size_t)(NEXP + e) * DEXP + ik * 64) * D_ + in * 64; t.dst = a.ws + WS_WD + ((size_t)e * D_ + in * 64) * DEXP + ik * 64; }
    return t;
}
__device__ __forceinline__ void moe_tile_load(const MoeTile& t, int tid, f32x4 (&v)[2]) {
#pragma unroll
    for (int i = 0; i < 2; ++i) { const int idx = tid + i * 512, rr = idx >> 4, c4 = (idx & 15) * 4; v[i] = *(const f32x4*)(t.src + (size_t)rr * t.lds_ + c4); }
}
__device__ __forceinline__ void moe_tile_store(const MoeTile& t, int tid, const f32x4 (&v)[2], LAS float* tile) {
#pragma unroll
    for (int i = 0; i < 2; ++i) { const int idx = tid + i * 512, rr = idx >> 4, c4 = (idx & 15) * 4;
        tile[rr * 65 + c4 + 0] = v[i][0]; tile[rr * 65 + c4 + 1] = v[i][1]; tile[rr * 65 + c4 + 2] = v[i][2]; tile[rr * 65 + c4 + 3] = v[i][3]; }
    LDS_BARRIER();
    { const int n = tid >> 3, kg = (tid & 7) * 8; float f[8];
#pragma unroll
      for (int jj = 0; jj < 8; ++jj) f[jj] = tile[(kg + jj) * 65 + n] * W8_SCALE;
      u32x2 w; w.x = pk_fp8x4(f[0], f[1], f[2], f[3]); w.y = pk_fp8x4(f[4], f[5], f[6], f[7]);
      *(u32x2*)(t.dst + (size_t)n * t.ldd + kg) = w; }
    LDS_BARRIER();
}
constexpr int MOE_TILES = 3 * NEXP * 256;

__device__ __forceinline__ f32x4 mfma16(s16x4 a, s16x4 b, f32x4 c) { return __builtin_amdgcn_mfma_f32_16x16x16bf16_1k(a, b, c, 0, 0, 0); }
__device__ __forceinline__ s16x4 pack4(const f32x4& v) { u32x2 w; w.x = cvt_pk_bf16(v[0], v[1]); w.y = cvt_pk_bf16(v[2], v[3]); return __builtin_bit_cast(s16x4, w); }
__device__ __forceinline__ void phase_gdn_chunk(const Args& a, LAS unsigned char* lds) {
    const bf16_t* qc = (const bf16_t*)(a.ws + WS_QKVC); const float* bgi = (const float*)(a.ws + WS_BG); bf16_t* O = (bf16_t*)(a.ws + WS_O);
    constexpr int VRS = 144, KTRS = 136;
    constexpr int KT = 0, QS = KT + 128 * KTRS, WSL = QS + 64 * RSB, QKS = WSL + 64 * RSB, EE = QKS + 2048, EDD = EE + 256, SET = EDD + 256;
    constexpr int STL = 2 * SET, KS = STL + 64 * RSB, VS = KS + 64 * RSB, X2 = VS + 64 * VRS, LS = X2 + 2048, X1 = LS + 4096, GAM = X1 + 2048, BET = GAM + 256, LEND = BET + 256;
    static_assert(LEND <= LDS_XBW, "gdn lds");
    const int wid = __builtin_amdgcn_readfirstlane(TIDX >> 6);
    const int NCK = S_ / 64;
    for (int blk = BID; blk < NB_ * 32 * 2; blk += NBLK) {
        const int grp = (blk & 7) * 8 + (blk >> 5), mem = (blk >> 3) & 3, b = grp >> 4, hk = grp & 15, hv = 2 * hk + (mem >> 1), vhalf = mem & 1;
        __syncthreads();
        if (wid < 4) {
            const int vt = wid;
            f32x4 Sacc[8];
#pragma unroll
            for (int n = 0; n < 8; ++n) Sacc[n] = (f32x4){0.f, 0.f, 0.f, 0.f};
            { const int lane = TIDX & 63;
              for (int i = lane; i < 16 * RSB / 16; i += 64) *(LAS u32x4*)(lds + STL + 16 * vt * RSB + i * 16) = (u32x4){0u, 0u, 0u, 0u}; }
            int lz = TIDX & 63; asm volatile("" : "+v"(lz));
            const int lane = lz, I = lane & 15, G = lane >> 4, q4 = I >> 2, p4 = I & 3;
            for (int it = 0; it <= NCK; ++it) {
                const int set = ((it - 1) & 1) * SET; const size_t t0 = (size_t)b * S_ + (size_t)(it - 1) * 64;
                f32x4 U[4];
                if (it >= 1) {
#pragma unroll
                    for (int sa = 0; sa < 4; ++sa) U[sa] = mfma16(*(const LAS s16x4*)(lds + X2 + ((sa * 16 + I) * 16 + 4 * G) * 2), lds_tr4(lds + VS + (16 * sa + 4 * G + q4) * VRS + (16 * vt + 4 * p4) * 2), (f32x4){0.f, 0.f, 0.f, 0.f});
                    asm volatile("" : "+v"(U[0]), "+v"(U[1]), "+v"(U[2]), "+v"(U[3]) :: "memory");
                }
#pragma unroll
                for (int sa = 0; sa < 4; ++sa) {
                    if (it >= 1) {
                        bf16x8 sf[4];
#pragma unroll
                        for (int ks = 0; ks < 4; ++ks) sf[ks] = lds_frag(lds + STL + (16 * vt + I) * RSB + (32 * ks + 8 * G) * 2);
                        s16x4 kt[8];
#pragma unroll
                        for (int dt = 0; dt < 8; ++dt) kt[dt] = *(const LAS s16x4*)(lds + set + KT + (16 * dt + I) * KTRS + (16 * sa + 4 * G) * 2);
                        f32x4 dl = U[sa], oq = (f32x4){0.f, 0.f, 0.f, 0.f};
#pragma unroll
                        for (int ks = 0; ks < 4; ++ks) { dl = mfma32(lds_frag(lds + set + WSL + (16 * sa + I) * RSB + (32 * ks + 8 * G) * 2), sf[ks], dl);
                            oq = mfma32(lds_frag(lds + set + QS + (16 * sa + I) * RSB + (32 * ks + 8 * G) * 2), sf[ks], oq); }
                        const s16x4 dfrag = pack4(dl);
                        const f32x4 e4 = *(const LAS f32x4*)(lds + set + EE + (16 * sa + 4 * G) * 4);
                        oq = mfma16(*(const LAS s16x4*)(lds + set + QKS + ((sa * 16 + I) * 16 + 4 * G) * 2), dfrag, oq * e4);
#pragma unroll
                        for (int r = 0; r < 4; ++r) O[(t0 + 16 * sa + 4 * G + r) * 4096 + hv * 128 + vhalf * 64 + 16 * vt + I] = f2bf(oq[r]);
                        const f32x4 ed4 = *(const LAS f32x4*)(lds + set + EDD + (16 * sa + 4 * G) * 4); const float e15 = *(const LAS float*)(lds + set + EE + (16 * sa + 15) * 4);
                        const s16x4 dsc = pack4(dl * ed4);
#pragma unroll
                        for (int dt = 0; dt < 8; ++dt) {
                            Sacc[dt] = mfma16(kt[dt], dsc, Sacc[dt] * e15);
                            *(LAS s16x4*)(lds + STL + (16 * vt + I) * RSB + (16 * dt + 4 * G) * 2) = pack4(Sacc[dt]); }
                    }
                    LDS_BARRIER();
                }
            }
        } else {
            const int pw = wid - 4;
            u32x4 pq[4], pk[4], pv[2]; float pb = 0.f, pg = 0.f;
            { const int ptid = TIDX - 256; const size_t t0 = (size_t)b * S_;
#pragma unroll
              for (int i = 0; i < 4; ++i) { const int c = ptid + i * 256, s2 = c >> 4, c8 = (c & 15) * 8; pq[i] = *(const u32x4*)(qc + (t0 + s2) * 8192 + hk * 128 + c8); pk[i] = *(const u32x4*)(qc + (t0 + s2) * 8192 + 2048 + hk * 128 + c8); }
#pragma unroll
              for (int i = 0; i < 2; ++i) { const int c = ptid + i * 256, s2 = c >> 3, c8 = (c & 7) * 8; pv[i] = *(const u32x4*)(qc + (t0 + s2) * 8192 + 4096 + hv * 128 + vhalf * 64 + c8); }
              if (pw == 1) { pb = bgi[(t0 + ptid - 64) * 64 + hv]; pg = bgi[(t0 + ptid - 64) * 64 + 32 + hv]; } }
            int lz = TIDX & 63; asm volatile("" : "+v"(lz));
            const int lane = lz, ptid = pw * 64 + lane, I = lane & 15, G = lane >> 4, q4 = I >> 2, p4 = I & 3;
            for (int it = 0; it <= NCK; ++it) {
                const int set = (it & 1) * SET; const bool act = it < NCK;
                if (act) {
#pragma unroll
                    for (int i = 0; i < 4; ++i) { const int c = ptid + i * 256, s2 = c >> 4, c8 = (c & 15) * 8; *(LAS u32x4*)(lds + set + QS + s2 * RSB + c8 * 2) = pq[i]; *(LAS u32x4*)(lds + KS + s2 * RSB + c8 * 2) = pk[i]; }
                    if (pw == 1) { float x = pg;
                        x += __builtin_bit_cast(float, __builtin_amdgcn_update_dpp(0, __builtin_bit_cast(int, x), 0x111, 0xf, 0xf, true));
                        x += __builtin_bit_cast(float, __builtin_amdgcn_update_dpp(0, __builtin_bit_cast(int, x), 0x112, 0xf, 0xf, true));
                        x += __builtin_bit_cast(float, __builtin_amdgcn_update_dpp(0, __builtin_bit_cast(int, x), 0x114, 0xf, 0xf, true));
                        x += __builtin_bit_cast(float, __builtin_amdgcn_update_dpp(0, __builtin_bit_cast(int, x), 0x118, 0xf, 0xf, true));
                        const float g15 = __shfl(x, 15, 16);
                        *(LAS float*)(lds + GAM + lane * 4) = x; *(LAS float*)(lds + set + EE + lane * 4) = __expf(x); *(LAS float*)(lds + set + EDD + lane * 4) = __expf(g15 - x); *(LAS float*)(lds + BET + lane * 4) = pb; }
                }
                LDS_BARRIER();
                if (act) { const int sa = pw;
#pragma unroll
                    for (int i = 0; i < 2; ++i) { const int c = ptid + i * 256, s2 = c >> 3, c8 = (c & 7) * 8; *(LAS u32x4*)(lds + VS + s2 * VRS + c8 * 2) = pv[i]; }
                    if (it + 1 < NCK) { const size_t t1 = (size_t)b * S_ + (size_t)(it + 1) * 64;
#pragma unroll
                        for (int i = 0; i < 4; ++i) { const int c = ptid + i * 256, s2 = c >> 4, c8 = (c & 15) * 8; pq[i] = *(const u32x4*)(qc + (t1 + s2) * 8192 + hk * 128 + c8); pk[i] = *(const u32x4*)(qc + (t1 + s2) * 8192 + 2048 + hk * 128 + c8); }
#pragma unroll
                        for (int i = 0; i < 2; ++i) { const int c = ptid + i * 256, s2 = c >> 3, c8 = (c & 7) * 8; pv[i] = *(const u32x4*)(qc + (t1 + s2) * 8192 + 4096 + hv * 128 + vhalf * 64 + c8); }
                        if (pw == 1) { pb = bgi[(t1 + ptid - 64) * 64 + hv]; pg = bgi[(t1 + ptid - 64) * 64 + 32 + hv]; } }
#pragma unroll
                    for (int ty = 0; ty < 2; ++ty) { f32x4 acc = (f32x4){0.f, 0.f, 0.f, 0.f};
#pragma unroll
                        for (int ks = 0; ks < 4; ++ks) { const bf16x8 ka = lds_frag(lds + KS + (16 * sa + I) * RSB + (32 * ks + 8 * G) * 2);
                            const bf16x8 bo = ty ? lds_frag(lds + set + QS + (16 * sa + I) * RSB + (32 * ks + 8 * G) * 2) : ka; acc = mfma32(ka, bo, acc); }
                        const f32x4 gr = *(const LAS f32x4*)(lds + GAM + (16 * sa + 4 * G) * 4); const float gc = *(const LAS float*)(lds + GAM + (16 * sa + I) * 4);
                        if (ty == 0) { const f32x4 br = *(const LAS f32x4*)(lds + BET + (16 * sa + 4 * G) * 4);
#pragma unroll
                            for (int r = 0; r < 4; ++r) { const float val = br[r] * acc[r] * __expf(gr[r] - gc); *(LAS float*)(lds + LS + ((sa * 16 + 4 * G + r) * 16 + I) * 4) = (I < 4 * G + r) ? val : 0.f; } }
                        else { f32x4 o;
#pragma unroll
                            for (int r = 0; r < 4; ++r) { const float val = acc[r] * __expf(gc - gr[r]); o[r] = (4 * G + r <= I) ? val : 0.f; }
                            *(LAS s16x4*)(lds + set + QKS + ((sa * 16 + I) * 16 + 4 * G) * 2) = pack4(o); } } }
                LDS_BARRIER();
                if (act && pw == 0) { const int sa = G, c = I; float x[16];
#pragma unroll
                    for (int i = 0; i < 16; ++i) x[i] = 0.f;
#pragma unroll
                    for (int ib = 0; ib < 4; ++ib) {
                        f32x4 lv[4][4];
#pragma unroll
                        for (int r = 0; r < 4; ++r)
#pragma unroll
                            for (int jj = 0; jj <= ib; ++jj) lv[r][jj] = *(const LAS f32x4*)(lds + LS + ((sa * 16 + 4 * ib + r) * 16 + 4 * jj) * 4);
                        __builtin_amdgcn_sched_barrier(0);
#pragma unroll
                        for (int r = 0; r < 4; ++r) { const int i = 4 * ib + r; float s0 = (i == c) ? 1.0f : 0.0f, s1 = 0.f;
#pragma unroll
                            for (int jj = 0; jj <= ib; ++jj) { s0 -= lv[r][jj][0] * x[4 * jj] + lv[r][jj][1] * x[4 * jj + 1]; s1 -= lv[r][jj][2] * x[4 * jj + 2] + lv[r][jj][3] * x[4 * jj + 3]; }
                            x[i] = s0 + s1; }
                    }
                    const float bc = *(const LAS float*)(lds + BET + lane * 4), sc1 = -bc * *(const LAS float*)(lds + set + EE + lane * 4);
#pragma unroll
                    for (int i = 0; i < 16; ++i) { *(LAS bf16_t*)(lds + X1 + ((sa * 16 + i) * 16 + c) * 2) = f2bf(x[i] * sc1); *(LAS bf16_t*)(lds + X2 + ((sa * 16 + i) * 16 + c) * 2) = f2bf(x[i] * bc); } }
                LDS_BARRIER();
                if (act) { const int sa = pw;
                    const s16x4 xb = *(const LAS s16x4*)(lds + X1 + ((sa * 16 + I) * 16 + 4 * G) * 2); s16x4 kt[8]; f32x4 w[8];
#pragma unroll
                    for (int dt = 0; dt < 8; ++dt) kt[dt] = lds_tr4(lds + KS + (16 * sa + 4 * G + q4) * RSB + (16 * dt + 4 * p4) * 2);
#pragma unroll
                    for (int dt = 0; dt < 8; ++dt) { w[dt] = mfma16(kt[dt], xb, (f32x4){0.f, 0.f, 0.f, 0.f}); *(LAS s16x4*)(lds + set + KT + (16 * dt + I) * KTRS + (16 * sa + 4 * G) * 2) = kt[dt]; }
#pragma unroll
                    for (int dt = 0; dt < 8; ++dt) *(LAS s16x4*)(lds + set + WSL + (16 * sa + I) * RSB + (16 * dt + 4 * G) * 2) = pack4(w[dt]); }
                LDS_BARRIER();
            }
        }
    }
}

constexpr int N_PHASES = 30;
__global__ void __launch_bounds__(NTHREADS, 2) fwd(Args a0) {
    extern __shared__ __attribute__((aligned(16))) unsigned char smem_raw[];
    LAS unsigned char* lds = (LAS unsigned char*)smem_raw;
    volatile LAS unsigned* xbw = (volatile LAS unsigned*)(lds + LDS_XBW);
    if (TIDX == 0) { xbw[0] = 0u; xbw[1] = 0u; xbw[2] = 0u; xbw[3] = 0u; }
    __syncthreads();
    XcdBarrier bar = xcd_barrier_post((unsigned*)(a0.ws + WS_CTL), xbw);
#ifndef PHMASK
#define PHMASK 0xFFFFFFFFull
#endif
#ifndef DUPMASK
#define DUPMASK 0ull
#endif
#define PH(i, body) do { if (((PHMASK >> (i)) & 1ull) && a0.ph_lo <= (i) && (i) < a0.ph_hi) { __attribute__((address_space(1))) unsigned char* wsp_ = (__attribute__((address_space(1))) unsigned char*)a0.ws; asm volatile("" : "+s"(wsp_)); Args a = a0; a.ws = (unsigned char*)wsp_; const float* xin = a.in[0]; const float* xw = (const float*)(a.ws + WS_X); (void)xin; (void)xw; \
        if ((DUPMASK >> (i)) & 1ull) { body; xcd_barrier(bar); } body; if ((i) + 1 < a0.ph_hi) xcd_barrier(bar); } } while (0)
    PH(0, { phase_prologue(a, lds); __syncthreads(); phase_norm<0>(a, xin, a.in[1], -1); });
    PH(2, phase_gemm_in0(a, lds));
    PH(3, { phase_rg_conv(a); __syncthreads(); phase_hg1(a, lds); });
    PH(4, { phase_rg_gates(a, lds); __syncthreads(); phase_hg2(a); });
    PH(5, { phase_rg_scan(a, lds); __syncthreads(); phase_hg3(a, lds); });
    PH(9, phase_gemm_out<false>(a, lds, D_, a.ws + WS_WOUT0T, xin));
    PH(10, phase_norm<0>(a, nullptr, a.in[2], 0));
    PH(11, phase_gemm_router(a, lds, 0));
    PH(12, phase_route(a, 0));
    PH(13, phase_rowmap(a, lds, 0));
    PH(14, phase_moe_up(a, lds, 0));
    PH(15, phase_moe_down(a, lds, 0));
    PH(16, { phase_norm<1>(a, nullptr, a.in[1] + D_, 0); __syncthreads(); moe_weight_jobs(a, 1, lds); });
    PH(18, { phase_gemm_in1(a, lds); phase_gemm_in1_tail(a, lds); });
    PH(19, phase_gdn_conv(a));
    PH(20, phase_gdn_chunk(a, lds));
    PH(21, phase_gdn_norm(a));
    PH(22, phase_gemm_out<true>(a, lds, 4096, a.ws + WS_WOUT1T, nullptr));
    PH(23, phase_norm<0>(a, nullptr, a.in[2] + D_, 1));
    PH(24, phase_gemm_router(a, lds, 1));
    PH(25, phase_route(a, 1));
    PH(26, phase_rowmap(a, lds, 1));
    PH(27, phase_moe_up(a, lds, 1));
    PH(28, phase_moe_down(a, lds, 1));
    PH(29, phase_norm<2>(a, nullptr, a.in[3], 1));
#undef PH
}

extern "C" void kernel_launch(void* const* d_in, const int* in_sizes, int n_in, void* d_out, int out_size, void* d_ws, size_t ws_size, hipStream_t stream) {
    static int grid = 0;
    if (grid == 0) {
        if (n_in != 28 || ws_size < WS_END) { fprintf(stderr, "kernel_launch: need 28 inputs and %zu bytes of workspace, got %d / %zu\n", (size_t)WS_END, n_in, ws_size); grid = -1; return; }
        int dev = 0, cus = 0, per_cu = 0;
        if (hipGetDevice(&dev) != hipSuccess || hipDeviceGetAttribute(&cus, hipDeviceAttributeMultiprocessorCount, dev) != hipSuccess) { grid = -1; return; }
        if (hipFuncSetAttribute((const void*)fwd, hipFuncAttributeMaxDynamicSharedMemorySize, LDS_BYTES) != hipSuccess) { fprintf(stderr, "kernel_launch: hipFuncSetAttribute failed\n"); grid = -1; return; }
        if (hipOccupancyMaxActiveBlocksPerMultiprocessor(&per_cu, (const void*)fwd, NTHREADS, LDS_BYTES) != hipSuccess || per_cu < 1) { fprintf(stderr, "kernel_launch: occupancy query says %d\n", per_cu); }
        (void)hipGetLastError();
        grid = cus;
    }
    if (grid < 0) return;
    (void)in_sizes; (void)out_size;
    hipMemsetAsync((char*)d_ws + WS_CTL, 0, CTL_BYTES, stream);
    Args a; memset(&a, 0, sizeof(a));
    for (int i = 0; i < 28; ++i) a.in[i] = (const float*)d_in[i];
    a.out = (float*)d_out; a.ws = (unsigned char*)d_ws;
#if N_LAUNCH_MODE == 1
    a.ph_lo = 0; a.ph_hi = N_PHASES;
    hipLaunchKernelGGL(fwd, dim3(grid), dim3(NTHREADS), LDS_BYTES, stream, a);
#if EXTRA_PH >= 0
    a.ph_lo = EXTRA_PH; a.ph_hi = EXTRA_PH + 1;
    hipLaunchKernelGGL(fwd, dim3(grid), dim3(NTHREADS), LDS_BYTES, stream, a);
#endif
#else
    for (int p = 0; p < N_PHASES; ++p) { a.ph_lo = p; a.ph_hi = p + 1; hipLaunchKernelGGL(fwd, dim3(grid), dim3(NTHREADS), LDS_BYTES, stream, a); }
#endif
}
```

```cpp
#include <hip/hip_runtime.h>
#include <stdint.h>
#include <stdio.h>
#include <string.h>

#ifndef EXTRA_PH
#define EXTRA_PH -1
#endif
#ifndef N_LAUNCH_MODE
#define N_LAUNCH_MODE 1
#endif

#define LAS __attribute__((address_space(3)))
typedef unsigned short bf16_t;
typedef short bf16x8 __attribute__((ext_vector_type(8)));
typedef float f32x4 __attribute__((ext_vector_type(4)));
typedef float f32x2 __attribute__((ext_vector_type(2)));
typedef unsigned u32x4 __attribute__((ext_vector_type(4)));
typedef unsigned u32x2 __attribute__((ext_vector_type(2)));

constexpr int T_ = 16384, D_ = 2048, S_ = 4096, NB_ = 4;
constexpr int N_IN0 = 6144, N_IN1 = 12352, N_IN1P = 12544;
constexpr int NEXP = 64, DEXP = 512, MPAD = 49152;
constexpr int NTHREADS = 512;
constexpr int LDS_MAIN = 131072;
constexpr int LDS_BYTES = 163840;
constexpr int LDS_XBW = LDS_BYTES - 16;

constexpr size_t al256(size_t x) { return (x + 255) & ~(size_t)255; }
constexpr size_t WS_CTL = 0;
constexpr size_t CTL_BYTES = 65536;
constexpr size_t CTL_CNT = 16384;
constexpr size_t WS_LB = WS_CTL + CTL_BYTES;
constexpr size_t WS_TINFO = WS_LB + 4096;
constexpr size_t WS_WIN0T = WS_TINFO + 4096;
constexpr size_t WS_WOUT0T = WS_WIN0T + (size_t)N_IN0 * D_ * 2;
constexpr size_t WS_WIN1T = WS_WOUT0T + (size_t)D_ * D_ * 2;
constexpr size_t WS_WOUT1T = WS_WIN1T + (size_t)N_IN1P * D_ * 2;
constexpr size_t WS_WGATES = WS_WOUT1T + (size_t)D_ * 4096 * 2;
constexpr size_t WS_WRT = WS_WGATES + (size_t)8 * 256 * 256 * 2;
constexpr size_t WS_WG = WS_WRT + (size_t)2 * 256 * D_ * 2;
constexpr size_t WS_WU = WS_WG + (size_t)NEXP * DEXP * D_ * 2;
constexpr size_t WS_WD = WS_WU + (size_t)NEXP * DEXP * D_ * 2;
constexpr size_t WS_X = WS_WD + (size_t)NEXP * DEXP * D_ * 2;
constexpr size_t WS_H = WS_X + (size_t)T_ * D_ * 4;
constexpr size_t WS_PROJ = WS_H + (size_t)T_ * D_ * 2;
constexpr size_t PROJ_BYTES = (size_t)T_ * N_IN1P * 2;
constexpr size_t WS_FLOG = WS_PROJ + (size_t)T_ * N_IN0 * 2;
constexpr size_t WS_XC = WS_FLOG + (size_t)T_ * 1024 * 4;
constexpr size_t WS_ACT = WS_PROJ;
constexpr size_t WS_YMOE = WS_ACT + (size_t)MPAD * DEXP * 2;
constexpr size_t WS_R1 = WS_PROJ + PROJ_BYTES;
constexpr size_t WS_A = WS_R1;
constexpr size_t WS_U = WS_R1 + (size_t)T_ * 1024 * 4;
constexpr size_t WS_QKVC = WS_R1;
constexpr size_t WS_Y = WS_R1 + (size_t)T_ * 8192 * 2;
constexpr size_t WS_O = WS_Y + (size_t)T_ * 4096 * 2;
constexpr size_t WS_TAIL = WS_O + (size_t)T_ * 4096 * 4;
constexpr size_t WS_BG = WS_TAIL + (size_t)T_ * 64 * 4;
constexpr size_t WS_LOGITS = WS_BG + (size_t)T_ * 64 * 4;
constexpr size_t WS_EID = WS_LOGITS + (size_t)T_ * 128 * 4;
constexpr size_t WS_SLOT = WS_EID + (size_t)T_ * 2 * 4;
constexpr size_t WS_GATE = WS_SLOT + (size_t)T_ * 2 * 4;
constexpr size_t WS_POSOF = WS_GATE + (size_t)T_ * 2 * 4;
constexpr size_t WS_ROWMAP = WS_POSOF + (size_t)T_ * 2 * 4;
constexpr size_t WS_H8 = WS_ROWMAP + (size_t)MPAD * 4;
constexpr size_t WS_END = WS_H8 + (size_t)T_ * D_;
static_assert(WS_YMOE + (size_t)MPAD * D_ * 2 <= WS_R1, "moe overlay");
static_assert(WS_XC + (size_t)T_ * 1024 * 2 <= WS_R1, "layer0 overlay");

struct Args {
    const float* in[28];
    float* out;
    unsigned char* ws;
    int ph_lo, ph_hi;
};

__device__ __forceinline__ int tidx_() { int t = (int)threadIdx.x; asm volatile("" : "+v"(t)); return t; }
#define TIDX tidx_()
typedef __bf16 bf16x2n __attribute__((ext_vector_type(2)));
__device__ __forceinline__ unsigned cvt_pk_bf16(float lo, float hi) { const f32x2 v = {lo, hi}; return __builtin_bit_cast(unsigned, __builtin_convertvector(v, bf16x2n)); }
__device__ __forceinline__ unsigned pk_fp8x4(float a, float b, float c, float d) { int v = __builtin_amdgcn_cvt_pk_fp8_f32(a, b, 0, false); v = __builtin_amdgcn_cvt_pk_fp8_f32(c, d, v, true); return (unsigned)v; }
constexpr float W8_SCALE = 64.0f, ACT8_SCALE = 8.0f;
__device__ __forceinline__ bf16_t f2bf(float x) { return (bf16_t)(cvt_pk_bf16(x, 0.f) & 0xffffu); }
__device__ __forceinline__ float bf_lo(unsigned w) { return __uint_as_float(w << 16); }
__device__ __forceinline__ float bf_hi(unsigned w) { return __uint_as_float(w & 0xffff0000u); }
__device__ __forceinline__ float bf1(bf16_t v) { return __uint_as_float(((unsigned)v) << 16); }
__device__ __forceinline__ float sigmoidf_(float x) { return __builtin_amdgcn_rcpf(1.0f + __expf(-x)); }
__device__ __forceinline__ float siluf_(float x) { return x * __builtin_amdgcn_rcpf(1.0f + __expf(-x)); }
__device__ __forceinline__ float softplusf_(float x) { return x > 20.f ? x : log1pf(__expf(x)); }
__device__ __forceinline__ float gelu_tanh(float x) { const float u = 0.7978845608028654f * (x + 0.044715f * x * x * x); return x * __builtin_amdgcn_rcpf(1.0f + __expf(-2.0f * u)); }
template <int CTRL> __device__ __forceinline__ float dpp_f(float v) { return __builtin_bit_cast(float, __builtin_amdgcn_update_dpp(0, __builtin_bit_cast(int, v), CTRL, 0xf, 0xf, false)); }
__device__ __forceinline__ float row16_sum(float s) { s += dpp_f<0x140>(s); s += dpp_f<0x141>(s); s += dpp_f<0xB1>(s); s += dpp_f<0x4E>(s); return s; }
__device__ __forceinline__ float wave_sum(float v) { v = row16_sum(v); v += __shfl_xor(v, 16); v += __shfl_xor(v, 32); return v; }

#define LDS_BARRIER() do { asm volatile("s_waitcnt lgkmcnt(0)" ::: "memory"); __builtin_amdgcn_s_barrier(); asm volatile("" ::: "memory"); } while (0)
#define XB_TMO      128
#define XB_XCNT(j)  (256  + 64 * (j))
#define XB_XSUB(j)  (1280 + 64 * (j))
#define XB_XGEN(j)  (2304 + 64 * (j))
#define XB_TOP      3328
#define XB_TOPGEN   3392
#define XCD_BAR_WORDS 3456
#define XB_SPIN_CAP (1u << 18)

__device__ __forceinline__ unsigned xb_ld(unsigned* p)              { return __hip_atomic_load(p, __ATOMIC_RELAXED, __HIP_MEMORY_SCOPE_AGENT); }
__device__ __forceinline__ unsigned xb_add(unsigned* p, unsigned v) { return __hip_atomic_fetch_add(p, v, __ATOMIC_RELAXED, __HIP_MEMORY_SCOPE_AGENT); }
__device__ __forceinline__ unsigned xb_xcc_id() { return (unsigned)__builtin_amdgcn_s_getreg((3 << 11) | 20) & 0xFu; }
#define XB_SPIN(cond, bar) do { unsigned _sp = 0; while (cond) { __builtin_amdgcn_s_sleep(1); \
    if ((++_sp & 255u) == 0u) { if (xb_ld(&(bar)[XB_TMO])) break; if (_sp > XB_SPIN_CAP) { atomicAdd(&(bar)[XB_TMO], 1u); break; } } } } while (0)

struct XcdBarrier { unsigned* bar; unsigned x; volatile LAS unsigned* st; };

__device__ __forceinline__ XcdBarrier xcd_barrier_post(unsigned* bar, volatile LAS unsigned* st) {
    XcdBarrier b; b.bar = bar; b.x = xb_xcc_id(); b.st = st;
    if (TIDX == 0) (void)xb_add(&bar[XB_XCNT(b.x)], 1u);
    return b;
}
__device__ __forceinline__ void xcd_barrier_complete(unsigned* bar, unsigned x, unsigned& nloc, unsigned& nx) {
    const unsigned G = gridDim.x * gridDim.y * gridDim.z;
    unsigned sum, cnt, mine, sp = 0u;
    for (;;) {
        sum = 0u; cnt = 0u; mine = 0u;
#pragma unroll
        for (unsigned j = 0; j < 16; ++j) { const unsigned c = xb_ld(&bar[XB_XCNT(j)]); sum += c; cnt += (c > 0u) ? 1u : 0u; mine = (j == x) ? c : mine; }
        if (sum == G) break;
        __builtin_amdgcn_s_sleep(1);
        if ((++sp & 255u) == 0u) { if (xb_ld(&bar[XB_TMO])) break; if (sp > XB_SPIN_CAP) { atomicAdd(&bar[XB_TMO], 1u); break; } }
    }
    nloc = mine > 0u ? mine : 1u; nx = cnt > 0u ? cnt : 1u;
}
__device__ __forceinline__ void xcd_barrier(const XcdBarrier& b) {
    asm volatile("s_waitcnt vmcnt(0)" ::: "memory");
    __syncthreads();
    if (TIDX == 0) {
        unsigned* bar = b.bar;
        __builtin_amdgcn_s_waitcnt(0);
        unsigned nloc = b.st[0], nx = b.st[1];
        if (nloc == 0u) { xcd_barrier_complete(bar, b.x, nloc, nx); b.st[0] = nloc; b.st[1] = nx; }
        const unsigned old = xb_add(&bar[XB_XSUB(b.x)], 1u);
        const unsigned gen = old / nloc;
        if (old + 1u == (gen + 1u) * nloc) {
            __builtin_amdgcn_fence(__ATOMIC_RELEASE, "agent");
            asm volatile("s_waitcnt vmcnt(0)" ::: "memory");
            const unsigned og = xb_add(&bar[XB_TOP], 1u);
            const unsigned tg = og / nx;
            if (og + 1u == (tg + 1u) * nx) xb_add(&bar[XB_TOPGEN], 1u);
            else XB_SPIN(xb_ld(&bar[XB_TOPGEN]) == tg, bar);
            __builtin_amdgcn_fence(__ATOMIC_ACQUIRE, "agent");
            xb_add(&bar[XB_XGEN(b.x)], 1u);
            asm volatile("s_waitcnt vmcnt(0)" ::: "memory");
        } else {
            XB_SPIN(xb_ld(&bar[XB_XGEN(b.x)]) == gen, bar);
            __builtin_amdgcn_fence(__ATOMIC_ACQUIRE, "agent");
            asm volatile("s_waitcnt vmcnt(0)" ::: "memory");
        }
    }
    __syncthreads();
}

constexpr int BM = 256, BK = 64, HALF = 128, HTB = HALF * BK * 2;
__device__ __forceinline__ int lds_byte(int r, int c) { const int st = (r >> 4) * 2 + (c >> 5), rr = r & 15, cc = c & 31, ob = rr * 64 + cc * 2; return st * 1024 + (ob ^ (((ob >> 9) & 1) << 5)); }
__device__ __forceinline__ void stage_rc(int b, int& R, int& C) { const int st = b / 1024, sb = b % 1024, swz = sb ^ (((sb >> 9) & 1) << 5); R = (st >> 1) * 16 + swz / 64; C = (st & 1) * 32 + (swz % 64) / 2; }
__device__ __forceinline__ int perm32(int rho) { const int n = rho >> 4, i = rho & 15; return 8 * (i >> 2) + 4 * n + (i & 3); }

__device__ __forceinline__ void stage_pos(int tid, int& R0, int& C0) { stage_rc(tid * 16, R0, C0); }
__device__ __forceinline__ int perm_row(int R) { return (R & ~31) + perm32(R & 31); }

#define BID ((int)blockIdx.x)
#define NBLK ((int)gridDim.x)
#define BID_ BID
#define NBLK_ NBLK
typedef f32x4 Acc[2][2][4][2];
struct UnitD { const char* gA; const char* gB; int t0, t1, t2; };

typedef int i32x8 __attribute__((ext_vector_type(8)));
typedef int i32x4 __attribute__((ext_vector_type(4)));
template <bool GATHER, bool FP8, class Src, class Epi>
__device__ __forceinline__ void gemm_stream(LAS unsigned char* lds, const Src& S, const int nt, const Epi& E) {
    const int tid = TIDX, wid = tid >> 6, lane = tid & 63, wr = wid >> 2, wc = wid & 3, fr = lane & 15, fq = lane >> 4;
    const unsigned ldsw = (unsigned)wid * 1024u;
    const int aoff = lds_byte(wr * 64 + fr, fq * 8), boff = lds_byte(wc * 32 + fr, fq * 8);
    const size_t kstep = (size_t)(BK * 2);
#define G_SA(b, h) (((b) * 2 + (h)) * HTB)
#define G_SB(b, h) ((4 + (b) * 2 + (h)) * HTB)
#define G_STAGE(bufoff, gbase, v) do { _Pragma("unroll") for (int _i = 0; _i < 2; ++_i) \
        __builtin_amdgcn_global_load_lds((const unsigned*)((gbase) + (v)[_i]), (LAS unsigned*)(lds + (bufoff) + ldsw + _i * 8192), 16, 0, 0); } while (0)
#define G_LD8(p) __builtin_shufflevector(*(const LAS i32x4*)(p), *(const LAS i32x4*)((p) + 1024), 0, 1, 2, 3, 4, 5, 6, 7)
#define G_LDA(dst, b, h) do { _Pragma("unroll") for (int m = 0; m < 4; ++m) dst[m] = G_LD8(lds + G_SA(b, h) + aoff + m * 2048); } while (0)
#define G_LDB(dst, b, h) do { _Pragma("unroll") for (int n = 0; n < 2; ++n) dst[n] = G_LD8(lds + G_SB(b, h) + boff + n * 2048); } while (0)
#define G_HALF(x, k) __builtin_bit_cast(bf16x8, __builtin_shufflevector((x), (x), 4 * (k), 4 * (k) + 1, 4 * (k) + 2, 4 * (k) + 3))
#define G_MMA(ai, bj, At, Bt) do { __builtin_amdgcn_s_setprio(1); _Pragma("unroll") for (int m = 0; m < 4; ++m) _Pragma("unroll") for (int n = 0; n < 2; ++n) { \
        if (FP8) asm volatile("v_mfma_f32_16x16x128_f8f6f4 %0, %1, %2, %0" : "+v"(acc[ai][bj][m][n]) : "v"(Bt[n]), "v"(At[m]));   \
        else { acc[ai][bj][m][n] = __builtin_amdgcn_mfma_f32_16x16x32_bf16(G_HALF(Bt[n], 0), G_HALF(At[m], 0), acc[ai][bj][m][n], 0, 0, 0); \
               acc[ai][bj][m][n] = __builtin_amdgcn_mfma_f32_16x16x32_bf16(G_HALF(Bt[n], 1), G_HALF(At[m], 1), acc[ai][bj][m][n], 0, 0, 0); } } \
        __builtin_amdgcn_s_setprio(0); } while (0)
#define G_WAIT_V(n) asm volatile("s_waitcnt vmcnt(" #n ")" ::: "memory")
#define G_WAIT_L(n) asm volatile("s_waitcnt lgkmcnt(" #n ")" ::: "memory")
#define G_BAR __builtin_amdgcn_s_barrier()
#define G_SCHED __builtin_amdgcn_sched_barrier(0)
    UnitD cur, nxt; int ui = 0;
    if (!S.next(0, cur)) return;
    unsigned va[2][2], vb[2][2], van[2][2];
    S.vb(vb); S.va(cur, va);
    Acc acc;
#pragma unroll
    for (int a = 0; a < 2; ++a)
#pragma unroll
        for (int b = 0; b < 2; ++b)
#pragma unroll
            for (int m = 0; m < 4; ++m)
#pragma unroll
                for (int n = 0; n < 2; ++n) acc[a][b][m][n] = (f32x4){0.f, 0.f, 0.f, 0.f};
    i32x8 At[4], B0[2], B1[2];
    const char* cA = cur.gA; const char* cB = cur.gB;
    G_WAIT_V(0);
    __syncthreads();
    G_STAGE(G_SB(0, 0), cB, vb[0]); G_STAGE(G_SA(0, 0), cA, va[0]); G_STAGE(G_SB(0, 1), cB, vb[1]); G_STAGE(G_SA(0, 1), cA, va[1]);
    if (wr == 1) G_BAR;
    G_WAIT_V(4); G_BAR;
    G_STAGE(G_SB(1, 0), cB + kstep, vb[0]); G_STAGE(G_SA(1, 0), cA + kstep, va[0]); G_STAGE(G_SB(1, 1), cB + kstep, vb[1]);
    G_WAIT_V(6); G_BAR;
    for (;;) {
        const bool has_next = S.next(ui + 1, nxt);
        const char* nA = has_next ? nxt.gA : cA; const char* nB = has_next ? nxt.gB : cB;
        if (GATHER) { if (has_next) S.va(nxt, van); else { van[0][0] = va[0][0]; van[0][1] = va[0][1]; van[1][0] = va[1][0]; van[1][1] = va[1][1]; } }
#pragma unroll 1
        for (int t = 0; t < nt; t += 2) {
            const bool last = (t == nt - 2);
            const char* a1 = cA + (size_t)(t + 1) * kstep;
            const char* a2 = last ? nA : cA + (size_t)(t + 2) * kstep; const char* b2 = last ? nB : cB + (size_t)(t + 2) * kstep;
            const char* a3 = a2 + kstep; const char* b3 = b2 + kstep;
            unsigned v2[2][2];
#pragma unroll
            for (int hh = 0; hh < 2; ++hh)
#pragma unroll
                for (int i = 0; i < 2; ++i) v2[hh][i] = (GATHER && last) ? van[hh][i] : va[hh][i];
            G_LDB(B0, 0, 0); G_SCHED; G_LDA(At, 0, 0); G_STAGE(G_SA(1, 1), a1, va[1]);
            G_WAIT_L(8); G_BAR; G_WAIT_L(0); G_MMA(0, 0, At, B0); G_BAR; G_SCHED;
            G_LDB(B1, 0, 1); G_STAGE(G_SB(0, 0), b2, vb[0]);
            G_BAR; G_WAIT_L(0); G_MMA(0, 1, At, B1); G_BAR;
            G_LDA(At, 0, 1); G_STAGE(G_SA(0, 0), a2, v2[0]);
            G_BAR; G_WAIT_L(0); G_MMA(1, 0, At, B0); G_BAR; G_SCHED;
            G_STAGE(G_SB(0, 1), b2, vb[1]);
            G_WAIT_V(6); G_BAR; G_MMA(1, 1, At, B1); G_BAR;
            G_LDB(B0, 1, 0); G_SCHED; G_LDA(At, 1, 0); G_STAGE(G_SA(0, 1), a2, v2[1]);
            G_WAIT_L(8); G_BAR; G_WAIT_L(0); G_MMA(0, 0, At, B0); G_BAR; G_SCHED;
            G_LDB(B1, 1, 1); G_STAGE(G_SB(1, 0), b3, vb[0]);
            G_BAR; G_WAIT_L(0); G_MMA(0, 1, At, B1); G_BAR;
            G_LDA(At, 1, 1); G_STAGE(G_SA(1, 0), a3, v2[0]);
            G_BAR; G_WAIT_L(0); G_MMA(1, 0, At, B0); G_BAR; G_SCHED;
            G_STAGE(G_SB(1, 1), b3, vb[1]);
            G_WAIT_V(6); G_BAR; G_MMA(1, 1, At, B1); G_BAR;
        }
        if (FP8) asm volatile("s_nop 15\n\ts_nop 15" ::: "memory");
        { int tz = TIDX; asm volatile("" : "+v"(tz));
          const int wid2 = tz >> 6, lane2 = tz & 63; E(acc, cur, wid2 >> 2, wid2 & 3, lane2 & 15, lane2 >> 4); }
        if (!has_next) break;
#pragma unroll
        for (int a = 0; a < 2; ++a)
#pragma unroll
            for (int b = 0; b < 2; ++b)
#pragma unroll
                for (int m = 0; m < 4; ++m)
#pragma unroll
                    for (int n = 0; n < 2; ++n) acc[a][b][m][n] = (f32x4){0.f, 0.f, 0.f, 0.f};
        cur = nxt; cA = nA; cB = nB; ++ui;
        if (GATHER) { va[0][0] = van[0][0]; va[0][1] = van[0][1]; va[1][0] = van[1][0]; va[1][1] = van[1][1]; }
    }
    G_WAIT_V(0);
    if (wr == 0) G_BAR;
    G_BAR;
#undef G_SA
#undef G_SB
#undef G_STAGE
#undef G_LDA
#undef G_LDB
#undef G_MMA
#undef G_LD8
#undef G_HALF
#undef G_WAIT_V
#undef G_WAIT_L
#undef G_BAR
#undef G_SCHED
}

__device__ __forceinline__ void offs_direct(unsigned (&v)[2][2], int ld, bool perm) {
    int R0, C0; stage_pos(TIDX, R0, C0);
#pragma unroll
    for (int i = 0; i < 2; ++i) { const int R = R0 + 64 * i, Rr = perm ? perm_row(R) : R;
        v[0][i] = (unsigned)(Rr * ld + C0) * 2u; v[1][i] = (unsigned)((Rr + HALF) * ld + C0) * 2u; }
}

struct SrcGrid {
    const char* A; const char* B; size_t astep, bstep; int nM, total, lda, ldb;
    __device__ __forceinline__ bool next(int i, UnitD& u) const { const int id = BID_ + i * NBLK_; if (id >= total) return false; u.t0 = id % nM; u.t1 = id / nM; u.t2 = 0;
        u.gA = A + (size_t)u.t0 * astep; u.gB = B + (size_t)u.t1 * bstep; return true; }
    __device__ __forceinline__ void va(const UnitD&, unsigned (&v)[2][2]) const { offs_direct(v, lda, false); }
    __device__ __forceinline__ void vb(unsigned (&v)[2][2]) const { offs_direct(v, ldb, true); }
};

__device__ __forceinline__ void store_bf16_tile(const Acc& acc, bf16_t* O, int ld, int wr, int wc, int fr, int fq, const float sc = 1.0f) {
#pragma unroll
    for (int ai = 0; ai < 2; ++ai)
#pragma unroll
        for (int m = 0; m < 4; ++m) { bf16_t* rowp = O + (size_t)(ai * HALF + wr * 64 + m * 16 + fr) * ld + wc * 32 + 8 * fq;
#pragma unroll
            for (int bj = 0; bj < 2; ++bj) { const f32x4 v0 = acc[ai][bj][m][0] * sc, v1 = acc[ai][bj][m][1] * sc;
                u32x4 w; w.x = cvt_pk_bf16(v0[0], v0[1]); w.y = cvt_pk_bf16(v0[2], v0[3]); w.z = cvt_pk_bf16(v1[0], v1[1]); w.w = cvt_pk_bf16(v1[2], v1[3]);
                *(u32x4*)(rowp + bj * HALF) = w; } }
}
__device__ __forceinline__ void store_f32_tile(const Acc& acc, float* O, const float* R, int ld, int ncol, int wr, int wc, int fr, int fq, const float sc = 1.0f) {
#pragma unroll
    for (int ai = 0; ai < 2; ++ai)
#pragma unroll
        for (int m = 0; m < 4; ++m) { const size_t ro = (size_t)(ai * HALF + wr * 64 + m * 16 + fr) * ld;
#pragma unroll
            for (int bj = 0; bj < 2; ++bj)
#pragma unroll
                for (int n = 0; n < 2; ++n) { const int c = bj * HALF + wc * 32 + 8 * fq + 4 * n; if (c >= ncol) continue;
                    f32x4 v = acc[ai][bj][m][n] * sc; if (R) v += *(const f32x4*)(R + ro + c); *(f32x4*)(O + ro + c) = v; } }
}
struct EpiProj {
    bf16_t* O; int ld; float* F; int fld, fp0, fp1, ncol; float sc;
    __device__ __forceinline__ void operator()(const Acc& acc, const UnitD& u, int wr, int wc, int fr, int fq) const {
        if (u.t1 >= fp0 && u.t1 < fp1) store_f32_tile(acc, F + (size_t)u.t0 * BM * fld + (u.t1 - fp0) * BM, nullptr, fld, ncol, wr, wc, fr, fq, sc);
        else store_bf16_tile(acc, O + (size_t)u.t0 * BM * ld + u.t1 * BM, ld, wr, wc, fr, fq, sc);
    }
};
struct EpiResid {
    bf16_t* O; const float* Rf; const bf16_t* Rb; float sc;
    __device__ __forceinline__ void operator()(const Acc& acc, const UnitD& u, int wr, int wc, int fr, int fq) const {
        const size_t o = (size_t)u.t0 * BM * D_ + u.t1 * BM;
#pragma unroll
        for (int ai = 0; ai < 2; ++ai)
#pragma unroll
            for (int m = 0; m < 4; ++m) { const size_t ro = o + (size_t)(ai * HALF + wr * 64 + m * 16 + fr) * D_ + wc * 32 + 8 * fq;
#pragma unroll
                for (int bj = 0; bj < 2; ++bj) { f32x4 v0 = acc[ai][bj][m][0] * sc, v1 = acc[ai][bj][m][1] * sc;
                    if (Rf) { v0 += *(const f32x4*)(Rf + ro + bj * HALF); v1 += *(const f32x4*)(Rf + ro + bj * HALF + 4); }
                    else { const u32x4 r = *(const u32x4*)(Rb + ro + bj * HALF); v0[0] += bf_lo(r.x); v0[1] += bf_hi(r.x); v0[2] += bf_lo(r.y); v0[3] += bf_hi(r.y); v1[0] += bf_lo(r.z); v1[1] += bf_hi(r.z); v1[2] += bf_lo(r.w); v1[3] += bf_hi(r.w); }
                    u32x4 w; w.x = cvt_pk_bf16(v0[0], v0[1]); w.y = cvt_pk_bf16(v0[2], v0[3]); w.z = cvt_pk_bf16(v1[0], v1[1]); w.w = cvt_pk_bf16(v1[2], v1[3]);
                    *(u32x4*)(O + ro + bj * HALF) = w; } }
    }
};
struct EpiLogits {
    float* O;
    __device__ __forceinline__ void operator()(const Acc& acc, const UnitD& u, int wr, int wc, int fr, int fq) const { store_f32_tile(acc, O + (size_t)u.t0 * BM * 128, nullptr, 128, 128, wr, wc, fr, fq); }
};
struct EpiSwiGLU {
    unsigned char* O;
    __device__ __forceinline__ void operator()(const Acc& acc, const UnitD& u, int wr, int wc, int fr, int fq) const {
        unsigned char* o = O + (size_t)u.t0 * BM * DEXP + u.t1 * 128;
#pragma unroll
        for (int ai = 0; ai < 2; ++ai)
#pragma unroll
            for (int m = 0; m < 4; ++m) { unsigned char* rowp = o + (size_t)(ai * HALF + wr * 64 + m * 16 + fr) * DEXP + wc * 32 + 8 * fq;
                float r[8];
#pragma unroll
                for (int n = 0; n < 2; ++n)
#pragma unroll
                    for (int j = 0; j < 4; ++j) r[n * 4 + j] = (ACT8_SCALE / W8_SCALE) * siluf_(acc[ai][0][m][n][j] * (1.0f / W8_SCALE)) * acc[ai][1][m][n][j];
                u32x2 w; w.x = pk_fp8x4(r[0], r[1], r[2], r[3]); w.y = pk_fp8x4(r[4], r[5], r[6], r[7]);
                *(u32x2*)rowp = w; }
    }
};
struct EpiDown {
    unsigned char* O;
    __device__ __forceinline__ void operator()(const Acc& acc, const UnitD& u, int wr, int wc, int fr, int fq) const {
        unsigned char* o = O + (size_t)u.t0 * BM * D_ + u.t1 * BM; const float sc = 1.0f / (W8_SCALE * ACT8_SCALE);
#pragma unroll
        for (int ai = 0; ai < 2; ++ai)
#pragma unroll
            for (int m = 0; m < 4; ++m) { unsigned char* rowp = o + (size_t)(ai * HALF + wr * 64 + m * 16 + fr) * D_ + wc * 32 + 8 * fq;
#pragma unroll
                for (int bj = 0; bj < 2; ++bj) { const f32x4 v0 = acc[ai][bj][m][0] * sc, v1 = acc[ai][bj][m][1] * sc;
                    u32x2 w; w.x = pk_fp8x4(v0[0], v0[1], v0[2], v0[3]); w.y = pk_fp8x4(v1[0], v1[1], v1[2], v1[3]); *(u32x2*)(rowp + bj * HALF) = w; } }
    }
};
__device__ __forceinline__ unsigned rg_idx(unsigned tok, int c) { return ((((tok >> 12) * 64u + (unsigned)(c >> 4)) * (unsigned)S_ + (tok & (unsigned)(S_ - 1))) << 4) + (unsigned)(c & 15); }
struct EpiRgGates {
    bf16_t* LAo; bf16_t* Uo; const bf16_t* xc;
    const float* ba; const float* bx; const float* lam;
    __device__ __forceinline__ void operator()(const Acc& acc, const UnitD& u, int wr, int wc, int fr, int fq) const {
#pragma unroll
        for (int n = 0; n < 2; ++n) { const int c = u.t1 * 128 + wc * 32 + 8 * fq + 4 * n;
            const f32x4 vba = *(const f32x4*)(ba + c), vbx = *(const f32x4*)(bx + c), vl = *(const f32x4*)(lam + c);
            f32x4 c8; for (int j = 0; j < 4; ++j) c8[j] = -8.0f * softplusf_(-vl[j]);
#pragma unroll
            for (int ai = 0; ai < 2; ++ai)
#pragma unroll
                for (int m = 0; m < 4; ++m) { const unsigned tok = (unsigned)(u.t0 * BM + ai * HALF + wr * 64 + m * 16 + fr);
                    const u32x2 xw = *(const u32x2*)(xc + (tok * 1024u + (unsigned)c)); const float xv[4] = {bf_lo(xw.x), bf_hi(xw.x), bf_lo(xw.y), bf_hi(xw.y)};
                    f32x4 lv, uv;
#pragma unroll
                    for (int j = 0; j < 4; ++j) { const float r = sigmoidf_(acc[ai][0][m][n][j] + vba[j]), ig = sigmoidf_(acc[ai][1][m][n][j] + vbx[j]);
                        const float la = c8[j] * r, av = __expf(la); lv[j] = la; uv[j] = __builtin_amdgcn_sqrtf(fmaxf(0.f, 1.0f - av * av)) * ig * xv[j]; }
                    const unsigned o = rg_idx(tok, c);
                    u32x2 w0; w0.x = cvt_pk_bf16(lv[0], lv[1]); w0.y = cvt_pk_bf16(lv[2], lv[3]); *(u32x2*)(LAo + o) = w0;
                    u32x2 w1; w1.x = cvt_pk_bf16(uv[0], uv[1]); w1.y = cvt_pk_bf16(uv[2], uv[3]); *(u32x2*)(Uo + o) = w1; } }
    }
};


__device__ __forceinline__ void transpose_job8(const float* src, unsigned char* dst, int K, int N, int ldd, size_t sb, size_t db, int nbatch, LAS unsigned char* lds) {
    const int tid = TIDX, tk = K / 128, tn = N / 64, per = tk * tn, total = per * nbatch;
    const int rr0 = tid >> 4, c4 = (tid & 15) * 4, n = tid >> 3, kg = (tid & 7) * 16;
    f32x4 va[4], vb[4];
#define T8_LD(v, t) { const int u_ = (t), ub_ = u_ / per, ur_ = u_ % per, uik_ = ur_ / tn, uin_ = ur_ % tn; const float* usp_ = src + (size_t)ub_ * sb + (size_t)(uik_ * 128 + rr0) * N + uin_ * 64 + c4; \
        _Pragma("unroll") for (int i = 0; i < 4; ++i) v[i] = *(const f32x4*)(usp_ + (size_t)(i * 32) * N); }
#define T8_ST(v, t, buf) { const int t_ = (t), b_ = t_ / per, r_ = t_ % per, ik_ = r_ / tn, in_ = r_ % tn; LAS float* tile = (LAS float*)(lds + (buf) * (128 * 65 * 4)); \
        _Pragma("unroll") for (int i = 0; i < 4; ++i) { const int rr = rr0 + i * 32; tile[rr * 65 + c4 + 0] = v[i][0]; tile[rr * 65 + c4 + 1] = v[i][1]; tile[rr * 65 + c4 + 2] = v[i][2]; tile[rr * 65 + c4 + 3] = v[i][3]; } \
        if (t_ + 2 * NBLK < total) T8_LD(v, t_ + 2 * NBLK) \
        LDS_BARRIER(); \
        float f[16]; \
        _Pragma("unroll") for (int j = 0; j < 16; ++j) f[j] = tile[(kg + j) * 65 + n] * W8_SCALE; \
        u32x4 w; w.x = pk_fp8x4(f[0], f[1], f[2], f[3]); w.y = pk_fp8x4(f[4], f[5], f[6], f[7]); w.z = pk_fp8x4(f[8], f[9], f[10], f[11]); w.w = pk_fp8x4(f[12], f[13], f[14], f[15]); \
        *(u32x4*)(dst + (size_t)b_ * db + (size_t)(in_ * 64 + n) * ldd + ik_ * 128 + kg) = w; }
    int t = BID;
    if (t < total) T8_LD(va, t)
    if (t + NBLK < total) T8_LD(vb, t + NBLK)
    for (; t < total; t += 2 * NBLK) {
        T8_ST(va, t, 0)
        if (t + NBLK < total) T8_ST(vb, t + NBLK, 1)
    }
#undef T8_LD
#undef T8_ST
    LDS_BARRIER();
}
__device__ __forceinline__ void transpose_job(const float* src, bf16_t* dst, int K, int N, int ldd, size_t sb, size_t db, int dalt, int nbatch, LAS unsigned char* lds) {
    const int tid = TIDX, tk = K / 64, tn = N / 64, per = tk * tn, total = per * nbatch;
    const int rr0 = tid >> 4, c4 = (tid & 15) * 4, n = tid >> 3, kg = (tid & 7) * 8;
    f32x4 va[2], vb[2];
#define T16_LD(v, t) { const int u_ = (t), ub_ = u_ / per, ur_ = u_ % per, uik_ = ur_ / tn, uin_ = ur_ % tn; const float* usp_ = src + (size_t)ub_ * sb + (size_t)(uik_ * 64 + rr0) * N + uin_ * 64 + c4; \
        _Pragma("unroll") for (int i = 0; i < 2; ++i) v[i] = *(const f32x4*)(usp_ + (size_t)(i * 32) * N); }
#define T16_ST(v, t, buf) { const int t_ = (t), b_ = t_ / per, r_ = t_ % per, ik_ = r_ / tn, in_ = r_ % tn; LAS float* tile = (LAS float*)(lds + (buf) * (64 * 65 * 4)); \
        _Pragma("unroll") for (int i = 0; i < 2; ++i) { const int rr = rr0 + i * 32; tile[rr * 65 + c4 + 0] = v[i][0]; tile[rr * 65 + c4 + 1] = v[i][1]; tile[rr * 65 + c4 + 2] = v[i][2]; tile[rr * 65 + c4 + 3] = v[i][3]; } \
        if (t_ + 2 * NBLK < total) T16_LD(v, t_ + 2 * NBLK) \
        LDS_BARRIER(); \
        float f[8]; \
        _Pragma("unroll") for (int j = 0; j < 8; ++j) f[j] = tile[(kg + j) * 65 + n]; \
        u32x4 w; w.x = cvt_pk_bf16(f[0], f[1]); w.y = cvt_pk_bf16(f[2], f[3]); w.z = cvt_pk_bf16(f[4], f[5]); w.w = cvt_pk_bf16(f[6], f[7]); \
        *(u32x4*)(dst + (size_t)b_ * db + (size_t)(b_ & 1) * dalt + (size_t)(in_ * 64 + n) * ldd + ik_ * 64 + kg) = w; }
    int t = BID;
    if (t < total) T16_LD(va, t)
    if (t + NBLK < total) T16_LD(vb, t + NBLK)
    for (; t < total; t += 2 * NBLK) {
        T16_ST(va, t, 0)
        if (t + NBLK < total) T16_ST(vb, t + NBLK, 1)
    }
#undef T16_LD
#undef T16_ST
    LDS_BARRIER();
}

__device__ __forceinline__ void moe_weight_jobs(const Args& a, int layer, LAS unsigned char* lds) {
    const size_t lo = (size_t)layer * NEXP * D_ * DEXP;
    transpose_job8(a.in[25] + lo, a.ws + WS_WG, D_, DEXP, D_, (size_t)D_ * DEXP, (size_t)DEXP * D_, NEXP, lds);
    transpose_job8(a.in[26] + lo, a.ws + WS_WU, D_, DEXP, D_, (size_t)D_ * DEXP, (size_t)DEXP * D_, NEXP, lds);
    transpose_job8(a.in[27] + lo, a.ws + WS_WD, DEXP, D_, DEXP, (size_t)D_ * DEXP, (size_t)DEXP * D_, NEXP, lds);
}

__device__ __forceinline__ void phase_prologue(const Args& a, LAS unsigned char* lds) {
    const int gtid = BID * NTHREADS + TIDX, gsz = NBLK * NTHREADS;
    for (int i = gtid; i < 1024; i += gsz) { const float l0 = a.in[12][i], l1 = a.in[12][1024 + i], mx = fmaxf(l0, l1), e0 = __expf(l0 - mx), e1 = __expf(l1 - mx);
        ((float*)(a.ws + WS_LB))[i] = e0 / (e0 + e1); }
    for (int it = gtid; it < 2 * 256 * 256; it += gsz) { const int l = it >> 16, n = (it >> 8) & 255, k8 = (it & 255) * 8; float f[8];
#pragma unroll
        for (int j = 0; j < 8; ++j) { const int k = k8 + j; f[j] = n < 8 ? a.in[21][((size_t)l * D_ + k) * 8 + n] : (n < 72 ? a.in[23][((size_t)l * D_ + k) * 64 + (n - 8)] : 0.f); }
        u32x4 w; w.x = cvt_pk_bf16(f[0], f[1]); w.y = cvt_pk_bf16(f[2], f[3]); w.z = cvt_pk_bf16(f[4], f[5]); w.w = cvt_pk_bf16(f[6], f[7]);
        *(u32x4*)((bf16_t*)(a.ws + WS_WRT) + ((size_t)l * 256 + n) * D_ + k8) = w; }
    for (int it = gtid; it < 192 * 128; it += gsz) *(u32x4*)(a.ws + WS_WIN1T + (size_t)N_IN1 * D_ + (size_t)it * 16) = (u32x4){0u, 0u, 0u, 0u};
    transpose_job(a.in[4], (bf16_t*)(a.ws + WS_WIN0T), D_, N_IN0, D_, 0, 0, 0, 1, lds);
    transpose_job(a.in[14], (bf16_t*)(a.ws + WS_WOUT0T), D_, D_, D_, 0, 0, 0, 1, lds);
    transpose_job8(a.in[15], a.ws + WS_WIN1T, D_, N_IN1, D_, 0, 0, 1, lds);
    transpose_job8(a.in[20], a.ws + WS_WOUT1T, 4096, D_, 4096, 0, 0, 1, lds);
    transpose_job(a.in[7], (bf16_t*)(a.ws + WS_WGATES), 128, 128, 128, 128 * 128, 256 * 128, 0, 8, lds);
    transpose_job(a.in[9], (bf16_t*)(a.ws + WS_WGATES) + 128 * 128, 128, 128, 128, 128 * 128, 256 * 128, 0, 8, lds);
    moe_weight_jobs(a, 0, lds);
}

template <int MODE>
__device__ __forceinline__ void phase_norm(const Args& a, const float* src, const float* gain, int layer) {
    const int wid = TIDX >> 6, lane = TIDX & 63;
    bf16_t* xw = (bf16_t*)(a.ws + WS_X); bf16_t* hw = (bf16_t*)(a.ws + WS_H);
    const unsigned char* ym = a.ws + WS_YMOE; const int* posof = (const int*)(a.ws + WS_POSOF); const float* gate = (const float*)(a.ws + WS_GATE);
    for (int row = BID * 8 + wid; row < T_; row += NBLK * 8) {
        f32x4 v[8];
#pragma unroll
        for (int i = 0; i < 8; ++i) { if (src) v[i] = *(const f32x4*)(src + (size_t)row * D_ + (i * 64 + lane) * 4);
            else { const u32x2 r = *(const u32x2*)(xw + (size_t)row * D_ + (i * 64 + lane) * 4); v[i] = (f32x4){bf_lo(r.x), bf_hi(r.x), bf_lo(r.y), bf_hi(r.y)}; } }
        if (MODE >= 1) {
            const int p0 = posof[row * 2], p1 = posof[row * 2 + 1]; const float g0 = gate[row * 2], g1 = gate[row * 2 + 1];
#pragma unroll
            for (int i = 0; i < 8; ++i) { const int c = (i * 64 + lane) * 4;
                const int y0 = *(const int*)(ym + (size_t)p0 * D_ + c), y1 = *(const int*)(ym + (size_t)p1 * D_ + c);
                const f32x2 a0 = __builtin_amdgcn_cvt_pk_f32_fp8(y0, false), a1 = __builtin_amdgcn_cvt_pk_f32_fp8(y0, true), b0 = __builtin_amdgcn_cvt_pk_f32_fp8(y1, false), b1 = __builtin_amdgcn_cvt_pk_f32_fp8(y1, true);
                v[i][0] += g0 * a0[0] + g1 * b0[0]; v[i][1] += g0 * a0[1] + g1 * b0[1]; v[i][2] += g0 * a1[0] + g1 * b1[0]; v[i][3] += g0 * a1[1] + g1 * b1[1]; }
            if (MODE == 1) {
#pragma unroll
                for (int i = 0; i < 8; ++i) { u32x2 w; w.x = cvt_pk_bf16(v[i][0], v[i][1]); w.y = cvt_pk_bf16(v[i][2], v[i][3]); *(u32x2*)(xw + (size_t)row * D_ + (i * 64 + lane) * 4) = w; } }
        }
        float ss = 0.f;
#pragma unroll
        for (int i = 0; i < 8; ++i) ss += v[i][0] * v[i][0] + v[i][1] * v[i][1] + v[i][2] * v[i][2] + v[i][3] * v[i][3];
        ss = wave_sum(ss);
        const float rstd = rsqrtf(ss * (1.0f / D_) + 1e-6f);
#pragma unroll
        for (int i = 0; i < 8; ++i) { const int c = (i * 64 + lane) * 4; const f32x4 g = *(const f32x4*)(gain + c);
            const f32x4 o = v[i] * rstd * g;
            if (MODE == 2) *(f32x4*)(a.out + (size_t)row * D_ + c) = o;
            else { if (MODE != 1) { u32x2 w; w.x = cvt_pk_bf16(o[0], o[1]); w.y = cvt_pk_bf16(o[2], o[3]); *(u32x2*)(hw + (size_t)row * D_ + c) = w; }
                   if (layer >= 0) *(unsigned*)(a.ws + WS_H8 + (size_t)row * D_ + c) = pk_fp8x4(o[0], o[1], o[2], o[3]); } }
    }
    (void)layer;
}

__device__ __forceinline__ void phase_gemm_in0(const Args& a, LAS unsigned char* lds) {
    SrcGrid S{(const char*)(a.ws + WS_H), (const char*)(a.ws + WS_WIN0T), (size_t)BM * D_ * 2, (size_t)BM * D_ * 2, 64, 64 * 24, D_, D_};
    EpiProj E{(bf16_t*)(a.ws + WS_PROJ), N_IN0, (float*)(a.ws + WS_FLOG), 1024, 12, 16, 256, 1.0f};
    gemm_stream<false, false>(lds, S, D_ / BK, E);
}

__device__ __forceinline__ void phase_rg_conv(const Args& a) {
    const bf16_t* p0 = (const bf16_t*)(a.ws + WS_PROJ); bf16_t* xc = (bf16_t*)(a.ws + WS_XC);
    const float* cw = a.in[5]; const float* cb = a.in[6];
    for (int it = BID * NTHREADS + TIDX; it < 128 * (T_ / 16); it += NBLK * NTHREADS) { const int c = (it & 127) * 8; const size_t t0 = (size_t)(it >> 7) * 16;
        float w[4][8], bias[8];
#pragma unroll
        for (int k = 0; k < 4; ++k) { const f32x4 w0 = *(const f32x4*)(cw + k * 1024 + c), w1 = *(const f32x4*)(cw + k * 1024 + c + 4);
            w[k][0] = w0[0]; w[k][1] = w0[1]; w[k][2] = w0[2]; w[k][3] = w0[3]; w[k][4] = w1[0]; w[k][5] = w1[1]; w[k][6] = w1[2]; w[k][7] = w1[3]; }
        { const f32x4 b0 = *(const f32x4*)(cb + c), b1 = *(const f32x4*)(cb + c + 4); bias[0] = b0[0]; bias[1] = b0[1]; bias[2] = b0[2]; bias[3] = b0[3]; bias[4] = b1[0]; bias[5] = b1[1]; bias[6] = b1[2]; bias[7] = b1[3]; }
        u32x4 x0 = (u32x4){0u, 0u, 0u, 0u}, x1 = x0, x2 = x0;
        if ((t0 & (S_ - 1)) != 0) { x0 = *(const u32x4*)(p0 + (t0 - 3) * N_IN0 + c); x1 = *(const u32x4*)(p0 + (t0 - 2) * N_IN0 + c); x2 = *(const u32x4*)(p0 + (t0 - 1) * N_IN0 + c); }
#pragma unroll 4
        for (int r = 0; r < 16; ++r) { const u32x4 x3 = *(const u32x4*)(p0 + (t0 + r) * N_IN0 + c);
            float acc[8];
#define TAPS(j, f, m) (bias[j] + w[0][j] * f(x0.m) + w[1][j] * f(x1.m) + w[2][j] * f(x2.m) + w[3][j] * f(x3.m))
            acc[0] = TAPS(0, bf_lo, x); acc[1] = TAPS(1, bf_hi, x); acc[2] = TAPS(2, bf_lo, y); acc[3] = TAPS(3, bf_hi, y);
            acc[4] = TAPS(4, bf_lo, z); acc[5] = TAPS(5, bf_hi, z); acc[6] = TAPS(6, bf_lo, w); acc[7] = TAPS(7, bf_hi, w);
#undef TAPS
            u32x4 o; o.x = cvt_pk_bf16(acc[0], acc[1]); o.y = cvt_pk_bf16(acc[2], acc[3]); o.z = cvt_pk_bf16(acc[4], acc[5]); o.w = cvt_pk_bf16(acc[6], acc[7]);
            *(u32x4*)(xc + (t0 + r) * 1024 + c) = o;
            x0 = x1; x1 = x2; x2 = x3; } }
}

struct SrcRgGates {
    const char* xc; const char* w; int total;
    __device__ __forceinline__ bool next(int i, UnitD& u) const { const int id = BID + i * NBLK; if (id >= total) return false; u.t0 = id & 63; u.t1 = id >> 6; u.t2 = 0;
        u.gA = xc + ((size_t)u.t0 * BM * 1024 + u.t1 * 128) * 2; u.gB = w + (size_t)u.t1 * 256 * 128 * 2; return true; }
    __device__ __forceinline__ void va(const UnitD&, unsigned (&v)[2][2]) const { offs_direct(v, 1024, false); }
    __device__ __forceinline__ void vb(unsigned (&v)[2][2]) const { offs_direct(v, 128, true); }
};
__device__ __forceinline__ void phase_rg_gates(const Args& a, LAS unsigned char* lds) {
    SrcRgGates S{(const char*)(a.ws + WS_XC), (const char*)(a.ws + WS_WGATES), 64 * 8};
    EpiRgGates E{(bf16_t*)(a.ws + WS_A), (bf16_t*)(a.ws + WS_U), (const bf16_t*)(a.ws + WS_XC), a.in[8], a.in[10], a.in[11]};
    int nt = 2; asm volatile("" : "+s"(nt));
    gemm_stream<false, false>(lds, S, nt, E);
}

__device__ __forceinline__ void phase_rg_scan(const Args& a, LAS unsigned char* lds) {
    const bf16_t* LA = (const bf16_t*)(a.ws + WS_A); const bf16_t* U = (const bf16_t*)(a.ws + WS_U);
    const bf16_t* p0 = (const bf16_t*)(a.ws + WS_PROJ); bf16_t* Y = (bf16_t*)(a.ws + WS_Y);
    LAS float* sP = (LAS float*)lds; LAS float* sH = sP + 4096; LAS float* gP = sH + 4096; LAS float* gH = gP + 512; LAS float* gC = gH + 512;
    const int tid = TIDX, seg = tid >> 1, c8 = (tid & 1) * 8;
    for (int blk = BID; blk < NB_ * 64; blk += NBLK) { const int b = blk >> 6, c = (blk & 63) * 16 + c8;
        const size_t base = (((size_t)blk * S_ + seg * 16) << 4) + c8;
        float P[8], H[8];
#pragma unroll
        for (int j = 0; j < 8; ++j) { P[j] = 1.f; H[j] = 0.f; }
#pragma unroll 4
        for (int s = 0; s < 16; ++s) { const u32x4 lw = *(const u32x4*)(LA + base + (size_t)s * 16), uw = *(const u32x4*)(U + base + (size_t)s * 16);
            const float la[8] = {bf_lo(lw.x), bf_hi(lw.x), bf_lo(lw.y), bf_hi(lw.y), bf_lo(lw.z), bf_hi(lw.z), bf_lo(lw.w), bf_hi(lw.w)};
            const float uu[8] = {bf_lo(uw.x), bf_hi(uw.x), bf_lo(uw.y), bf_hi(uw.y), bf_lo(uw.z), bf_hi(uw.z), bf_lo(uw.w), bf_hi(uw.w)};
#pragma unroll
            for (int j = 0; j < 8; ++j) { const float av = __expf(la[j]); H[j] = av * H[j] + uu[j]; P[j] *= av; } }
        __syncthreads();
#pragma unroll
        for (int j = 0; j < 8; ++j) { sP[seg * 16 + c8 + j] = P[j]; sH[seg * 16 + c8 + j] = H[j]; }
        __syncthreads();
        { const int ch = tid & 15, grp = tid >> 4; float p = 1.f, h = 0.f;
#pragma unroll
          for (int q = 0; q < 8; ++q) { const int sgi = grp * 8 + q; h = sP[sgi * 16 + ch] * h + sH[sgi * 16 + ch]; p *= sP[sgi * 16 + ch]; }
          gP[grp * 16 + ch] = p; gH[grp * 16 + ch] = h; }
        __syncthreads();
        if (tid < 16) { float carry = 0.f; for (int g = 0; g < 32; ++g) { gC[g * 16 + tid] = carry; carry = gP[g * 16 + tid] * carry + gH[g * 16 + tid]; } }
        __syncthreads();
        { const int ch = tid & 15, grp = tid >> 4; float h = gC[grp * 16 + ch];
#pragma unroll
          for (int q = 0; q < 8; ++q) { const int sgi = grp * 8 + q; const float pin = sP[sgi * 16 + ch], hin = sH[sgi * 16 + ch]; sH[sgi * 16 + ch] = h; h = pin * h + hin; } }
        __syncthreads();
#pragma unroll
        for (int j = 0; j < 8; ++j) H[j] = sH[seg * 16 + c8 + j];
#pragma unroll 4
        for (int s = 0; s < 16; ++s) { const u32x4 lw = *(const u32x4*)(LA + base + (size_t)s * 16), uw = *(const u32x4*)(U + base + (size_t)s * 16);
            const size_t t = (size_t)b * S_ + seg * 16 + s; const u32x4 gw = *(const u32x4*)(p0 + t * N_IN0 + 1024 + c);
            const float la[8] = {bf_lo(lw.x), bf_hi(lw.x), bf_lo(lw.y), bf_hi(lw.y), bf_lo(lw.z), bf_hi(lw.z), bf_lo(lw.w), bf_hi(lw.w)};
            const float uu[8] = {bf_lo(uw.x), bf_hi(uw.x), bf_lo(uw.y), bf_hi(uw.y), bf_lo(uw.z), bf_hi(uw.z), bf_lo(uw.w), bf_hi(uw.w)};
            const float gg[8] = {bf_lo(gw.x), bf_hi(gw.x), bf_lo(gw.y), bf_hi(gw.y), bf_lo(gw.z), bf_hi(gw.z), bf_lo(gw.w), bf_hi(gw.w)};
            float y[8];
#pragma unroll
            for (int j = 0; j < 8; ++j) { H[j] = __expf(la[j]) * H[j] + uu[j]; y[j] = H[j] * gelu_tanh(gg[j]); }
            u32x4 o; o.x = cvt_pk_bf16(y[0], y[1]); o.y = cvt_pk_bf16(y[2], y[3]); o.z = cvt_pk_bf16(y[4], y[5]); o.w = cvt_pk_bf16(y[6], y[7]);
            *(u32x4*)(Y + t * D_ + c) = o; }
    }
}

typedef short s16x4 __attribute__((ext_vector_type(4)));
__device__ __forceinline__ f32x4 mfma32(bf16x8 a, bf16x8 b, f32x4 c) { return __builtin_amdgcn_mfma_f32_16x16x32_bf16(a, b, c, 0, 0, 0); }
__device__ __forceinline__ bf16x8 lds_frag(LAS const unsigned char* p) { return *(const LAS bf16x8*)p; }
__device__ __forceinline__ s16x4 lds_tr4(LAS const unsigned char* p) { return __builtin_amdgcn_ds_read_tr16_b64_v4i16((LAS s16x4*)p); }
__device__ __forceinline__ bf16x8 lds_tr8(LAS const unsigned char* p, int rowskip_bytes) {
    const s16x4 lo = lds_tr4(p), hi = lds_tr4(p + rowskip_bytes); return __builtin_shufflevector(lo, hi, 0, 1, 2, 3, 4, 5, 6, 7); }
__device__ __forceinline__ bf16x8 pack8(const f32x4& lo, const f32x4& hi) { u32x4 w; w.x = cvt_pk_bf16(lo[0], lo[1]); w.y = cvt_pk_bf16(lo[2], lo[3]); w.z = cvt_pk_bf16(hi[0], hi[1]); w.w = cvt_pk_bf16(hi[2], hi[3]); return __builtin_bit_cast(bf16x8, w); }
constexpr int RSB = 272;

constexpr size_t WS_HQ = WS_O;
constexpr size_t WS_HA = WS_HQ + (size_t)2048 * 64 * 128 * 2;
constexpr size_t WS_HG = WS_HA + (size_t)2048 * 8 * 512 * 2;
constexpr size_t WS_HS = WS_HG + (size_t)2048 * 128 * 128 * 2;
constexpr size_t WS_HD = WS_HS + (size_t)2048 * 128 * 128 * 2;
static_assert(WS_HD + (size_t)2048 * 128 * 4 <= WS_TAIL, "hgrn overlay");

__device__ __forceinline__ void phase_hg1(const Args& a, LAS unsigned char* lds) {
    const bf16_t* p0 = (const bf16_t*)(a.ws + WS_PROJ); const float* flog = (const float*)(a.ws + WS_FLOG); const float* lb = (const float*)(a.ws + WS_LB);
    bf16_t* QG = (bf16_t*)(a.ws + WS_HQ); bf16_t* AG = (bf16_t*)(a.ws + WS_HA); bf16_t* GG = (bf16_t*)(a.ws + WS_HG); float* DG = (float*)(a.ws + WS_HD);
    constexpr int SEG = 0, QT = 4096, KT = QT + 64 * RSB, KH = KT + 64 * RSB, VS = KH + 64 * RSB;
    const int tid = TIDX, wid = tid >> 6, lane = tid & 63, I = lane & 15, G = lane >> 4, k2 = 2 * lane, sg = wid;
    LAS float* seg = (LAS float*)(lds + SEG);
    u32x4 pvv[2]; f32x2 pz[8]; unsigned pqw[8];
#define HG1_LOAD(it_) do { const int bh_ = (it_) >> 6, ck_ = (it_) & 63, h_ = bh_ & 7; const size_t t0_ = (size_t)(bh_ >> 3) * S_ + ck_ * 64; \
        _Pragma("unroll") for (int i = 0; i < 2; ++i) { const int c = tid + i * 512, s_ = c >> 4, v8 = (c & 15) * 8; pvv[i] = *(const u32x4*)(p0 + (t0_ + s_) * N_IN0 + 4096 + h_ * 128 + v8); } \
        _Pragma("unroll") for (int i = 0; i < 8; ++i) { const size_t t_ = t0_ + sg * 8 + i; pz[i] = *(const f32x2*)(flog + t_ * 1024 + h_ * 128 + k2); pqw[i] = *(const unsigned*)(p0 + t_ * N_IN0 + 2048 + h_ * 128 + k2); } } while (0)
    if (BID < 2048) HG1_LOAD(BID);
    for (int item = BID; item < 2048; item += NBLK) { const int bh = item >> 6, h = bh & 7;
        LDS_BARRIER();
#pragma unroll
        for (int i = 0; i < 2; ++i) { const int c = tid + i * 512, s = c >> 4, v8 = (c & 15) * 8; *(LAS u32x4*)(lds + VS + s * RSB + v8 * 2) = pvv[i]; }
        const f32x2 l2 = *(const f32x2*)(lb + h * 128 + k2);
        float f[8][2], cb[8][2]; unsigned qw[8]; float c0 = 0.f, c1 = 0.f;
#pragma unroll
        for (int i = 0; i < 8; ++i) { const f32x2 z = pz[i]; qw[i] = pqw[i];
            f[i][0] = l2[0] + (1.0f - l2[0]) * sigmoidf_(z[0]); f[i][1] = l2[1] + (1.0f - l2[1]) * sigmoidf_(z[1]);
            c0 += __logf(f[i][0]); c1 += __logf(f[i][1]); cb[i][0] = c0; cb[i][1] = c1; }
        *(LAS f32x2*)(seg + sg * 128 + k2) = (f32x2){c0, c1};
        if (item + NBLK < 2048) HG1_LOAD(item + NBLK);
        LDS_BARRIER();
        float off0 = 0.f, off1 = 0.f, tot0 = 0.f, tot1 = 0.f;
#pragma unroll
        for (int s2 = 0; s2 < 8; ++s2) { const f32x2 v = *(const LAS f32x2*)(seg + s2 * 128 + k2); tot0 += v[0]; tot1 += v[1]; if (s2 < sg) { off0 += v[0]; off1 += v[1]; } }
        const float et0 = __expf(tot0), et1 = __expf(tot1);
#pragma unroll
        for (int i = 0; i < 8; ++i) { const int t = sg * 8 + i;
            const float e0 = __expf(cb[i][0] + off0), e1 = __expf(cb[i][1] + off1), r0 = __builtin_amdgcn_rcpf(e0), r1 = __builtin_amdgcn_rcpf(e1), km0 = 1.0f - f[i][0], km1 = 1.0f - f[i][1];
            const unsigned qt = cvt_pk_bf16(siluf_(bf_lo(qw[i])) * e0, siluf_(bf_hi(qw[i])) * e1);
            *(LAS unsigned*)(lds + QT + t * RSB + k2 * 2) = qt; *(unsigned*)(QG + ((size_t)item * 64 + t) * 128 + k2) = qt;
            *(LAS unsigned*)(lds + KT + t * RSB + k2 * 2) = cvt_pk_bf16(km0 * r0, km1 * r1);
            *(LAS unsigned*)(lds + KH + t * RSB + k2 * 2) = cvt_pk_bf16(km0 * r0 * et0, km1 * r1 * et1); }
        if (sg == 0) *(f32x2*)(DG + (size_t)item * 128 + k2) = (f32x2){et0, et1};
        LDS_BARRIER();
        { const int tt = wid & 3, sp = wid >> 2;
          bf16x8 qf[4];
#pragma unroll
          for (int ks = 0; ks < 4; ++ks) qf[ks] = lds_frag(lds + QT + (16 * tt + I) * RSB + (32 * ks + 8 * G) * 2);
          f32x4 acc[2];
#pragma unroll
          for (int hh = 0; hh < 2; ++hh) { const int st = 2 * sp + hh; acc[hh] = (f32x4){0.f, 0.f, 0.f, 0.f};
              if (st <= tt) {
#pragma unroll
                  for (int ks = 0; ks < 4; ++ks) acc[hh] = mfma32(lds_frag(lds + KT + (16 * st + I) * RSB + (32 * ks + 8 * G) * 2), qf[ks], acc[hh]);
#pragma unroll
                  for (int r = 0; r < 4; ++r) if (16 * st + 4 * G + r > 16 * tt + I) acc[hh][r] = 0.f; } }
          *(bf16x8*)(AG + (((size_t)item * 4 + tt) * 2 + sp) * 512 + lane * 8) = pack8(acc[0], acc[1]); }
        { const int kt = wid, q = I >> 2, p = I & 3;
          bf16x8 ka[2];
#pragma unroll
          for (int ks = 0; ks < 2; ++ks) ka[ks] = lds_tr8(lds + KH + (32 * ks + 8 * G + q) * RSB + (16 * kt + 4 * p) * 2, 4 * RSB);
#pragma unroll
          for (int vt = 0; vt < 8; ++vt) { f32x4 acc = (f32x4){0.f, 0.f, 0.f, 0.f};
#pragma unroll
              for (int ks = 0; ks < 2; ++ks) acc = mfma32(ka[ks], lds_tr8(lds + VS + (32 * ks + 8 * G + q) * RSB + (16 * vt + 4 * p) * 2, 4 * RSB), acc);
              u32x2 w; w.x = cvt_pk_bf16(acc[0], acc[1]); w.y = cvt_pk_bf16(acc[2], acc[3]);
              *(u32x2*)(GG + ((size_t)item * 128 + 16 * vt + I) * 128 + 16 * kt + 4 * G) = w; } }
    }
#undef HG1_LOAD
}

__device__ __forceinline__ void phase_hg2(const Args& a) {
    const bf16_t* GG = (const bf16_t*)(a.ws + WS_HG); const float* DG = (const float*)(a.ws + WS_HD); bf16_t* SG = (bf16_t*)(a.ws + WS_HS);
    for (int gid = BID * NTHREADS + TIDX; gid < 32 * 4096; gid += NBLK * NTHREADS) { const int bh = gid >> 12, e = gid & 4095, v = e >> 5, k4 = (e & 31) * 4;
        f32x4 S = (f32x4){0.f, 0.f, 0.f, 0.f};
        for (int n = 0; n < 64; ++n) { const size_t item = (size_t)bh * 64 + n, o = (item * 128 + v) * 128 + k4;
            u32x2 w; w.x = cvt_pk_bf16(S[0], S[1]); w.y = cvt_pk_bf16(S[2], S[3]); *(u32x2*)(SG + o) = w;
            const f32x4 d = *(const f32x4*)(DG + item * 128 + k4); const u32x2 g = *(const u32x2*)(GG + o);
            S[0] = d[0] * S[0] + bf_lo(g.x); S[1] = d[1] * S[1] + bf_hi(g.x); S[2] = d[2] * S[2] + bf_lo(g.y); S[3] = d[3] * S[3] + bf_hi(g.y); } }
}

__device__ __forceinline__ void phase_hg3(const Args& a, LAS unsigned char* lds) {
    const bf16_t* p0 = (const bf16_t*)(a.ws + WS_PROJ); const bf16_t* QG = (const bf16_t*)(a.ws + WS_HQ); const bf16_t* AG = (const bf16_t*)(a.ws + WS_HA); const bf16_t* SG = (const bf16_t*)(a.ws + WS_HS);
    bf16_t* Y = (bf16_t*)(a.ws + WS_Y); const float* gain = a.in[13];
    constexpr int ST = 0, QT = 128 * RSB, VS = QT + 64 * RSB, PART = VS + 64 * RSB;
    const int tid = TIDX, wid = tid >> 6, lane = tid & 63, I = lane & 15, G = lane >> 4, q = I >> 2, p = I & 3;
    LAS float* part = (LAS float*)(lds + PART);
    const int tt = wid & 3, vh = wid >> 2;
    u32x4 ps[4], pq2[2], pv2[2]; bf16x8 paf[2];
#define HG3_LOAD(it_) do { const int bh_ = (it_) >> 6, ck_ = (it_) & 63; const size_t t0_ = (size_t)(bh_ >> 3) * S_ + ck_ * 64; const int h_ = bh_ & 7; \
        _Pragma("unroll") for (int i = 0; i < 4; ++i) { const int c = tid + i * 512, v = c >> 4, k8 = (c & 15) * 8; ps[i] = *(const u32x4*)(SG + ((size_t)(it_) * 128 + v) * 128 + k8); } \
        _Pragma("unroll") for (int i = 0; i < 2; ++i) { const int c = tid + i * 512, s_ = c >> 4, c8 = (c & 15) * 8; pq2[i] = *(const u32x4*)(QG + ((size_t)(it_) * 64 + s_) * 128 + c8); pv2[i] = *(const u32x4*)(p0 + (t0_ + s_) * N_IN0 + 4096 + h_ * 128 + c8); } \
        _Pragma("unroll") for (int sp = 0; sp < 2; ++sp) paf[sp] = *(const bf16x8*)(AG + (((size_t)(it_) * 4 + tt) * 2 + sp) * 512 + lane * 8); } while (0)
    if (BID < 2048) HG3_LOAD(BID);
    for (int item = BID; item < 2048; item += NBLK) { const int bh = item >> 6, ck = item & 63, b = bh >> 3, h = bh & 7; const size_t t0 = (size_t)b * S_ + ck * 64;
        LDS_BARRIER();
#pragma unroll
        for (int i = 0; i < 4; ++i) { const int c = tid + i * 512, v = c >> 4, k8 = (c & 15) * 8; *(LAS u32x4*)(lds + ST + v * RSB + k8 * 2) = ps[i]; }
#pragma unroll
        for (int i = 0; i < 2; ++i) { const int c = tid + i * 512, s2 = c >> 4, c8 = (c & 15) * 8; *(LAS u32x4*)(lds + QT + s2 * RSB + c8 * 2) = pq2[i]; *(LAS u32x4*)(lds + VS + s2 * RSB + c8 * 2) = pv2[i]; }
        bf16x8 af[2]; af[0] = paf[0]; af[1] = paf[1];
        if (item + NBLK < 2048) HG3_LOAD(item + NBLK);
        u32x2 zwp[4];
#pragma unroll
        for (int vi = 0; vi < 4; ++vi) zwp[vi] = *(const u32x2*)(p0 + (t0 + 16 * tt + I) * N_IN0 + 5120 + h * 128 + 16 * (4 * vh + vi) + 4 * G);
        LDS_BARRIER();
        bf16x8 qf[4];
#pragma unroll
        for (int ks = 0; ks < 4; ++ks) qf[ks] = lds_frag(lds + QT + (16 * tt + I) * RSB + (32 * ks + 8 * G) * 2);
        f32x4 acc[4]; float ss = 0.f;
#pragma unroll
        for (int vi = 0; vi < 4; ++vi) { const int vt = 4 * vh + vi; acc[vi] = (f32x4){0.f, 0.f, 0.f, 0.f};
#pragma unroll
            for (int ks = 0; ks < 4; ++ks) acc[vi] = mfma32(lds_frag(lds + ST + (16 * vt + I) * RSB + (32 * ks + 8 * G) * 2), qf[ks], acc[vi]);
#pragma unroll
            for (int sp = 0; sp < 2; ++sp) acc[vi] = mfma32(lds_tr8(lds + VS + (32 * sp + 4 * G + q) * RSB + (16 * vt + 4 * p) * 2, 16 * RSB), af[sp], acc[vi]);
            ss += acc[vi][0] * acc[vi][0] + acc[vi][1] * acc[vi][1] + acc[vi][2] * acc[vi][2] + acc[vi][3] * acc[vi][3]; }
        ss += __shfl_xor(ss, 16); ss += __shfl_xor(ss, 32);
        if (G == 0) part[wid * 16 + I] = ss;
        LDS_BARRIER();
        const float rstd = rsqrtf((part[wid * 16 + I] + part[(wid ^ 4) * 16 + I]) * (1.0f / 128.0f) + 1e-6f);
        const size_t t = t0 + 16 * tt + I;
#pragma unroll
        for (int vi = 0; vi < 4; ++vi) { const int c = h * 128 + 16 * (4 * vh + vi) + 4 * G;
            const f32x4 gn = *(const f32x4*)(gain + c); const u32x2 zw = zwp[vi];
            const float o0 = acc[vi][0] * rstd * gn[0] * siluf_(bf_lo(zw.x)), o1 = acc[vi][1] * rstd * gn[1] * siluf_(bf_hi(zw.x)), o2 = acc[vi][2] * rstd * gn[2] * siluf_(bf_lo(zw.y)), o3 = acc[vi][3] * rstd * gn[3] * siluf_(bf_hi(zw.y));
            u32x2 w; w.x = cvt_pk_bf16(o0, o1); w.y = cvt_pk_bf16(o2, o3); *(u32x2*)(Y + t * D_ + 1024 + c) = w; }
    }
#undef HG3_LOAD
}

__device__ __forceinline__ void phase_gdn_norm(const Args& a) {
    const bf16_t* O = (const bf16_t*)(a.ws + WS_O); const bf16_t* pj = (const bf16_t*)(a.ws + WS_PROJ); unsigned char* Y = a.ws + WS_Y; const float* gain = a.in[19];
    const int lane = TIDX & 63, wid = TIDX >> 6, gc = (lane & 15) * 8;
    const f32x4 g0 = *(const f32x4*)(gain + gc), g1 = *(const f32x4*)(gain + gc + 4);
    for (int row = BID * 8 + wid; row < T_; row += NBLK * 8) {
#pragma unroll 4
        for (int i = 0; i < 8; ++i) { const int c = (i * 64 + lane) * 8;
            const u32x4 ow = *(const u32x4*)(O + (size_t)row * 4096 + c), zw = *(const u32x4*)(pj + (size_t)row * N_IN1P + 8192 + c);
            const float o[8] = {bf_lo(ow.x), bf_hi(ow.x), bf_lo(ow.y), bf_hi(ow.y), bf_lo(ow.z), bf_hi(ow.z), bf_lo(ow.w), bf_hi(ow.w)};
            const float z[8] = {bf_lo(zw.x), bf_hi(zw.x), bf_lo(zw.y), bf_hi(zw.y), bf_lo(zw.z), bf_hi(zw.z), bf_lo(zw.w), bf_hi(zw.w)};
            float ss = 0.f;
#pragma unroll
            for (int q = 0; q < 8; ++q) ss += o[q] * o[q];
            ss = row16_sum(ss);
            const float rstd = rsqrtf(ss * (1.0f / 128.0f) + 1e-6f);
            float y[8];
#pragma unroll
            for (int q = 0; q < 8; ++q) y[q] = o[q] * rstd * (q < 4 ? g0[q & 3] : g1[q & 3]) * siluf_(z[q]);
            u32x2 w; w.x = pk_fp8x4(y[0], y[1], y[2], y[3]); w.y = pk_fp8x4(y[4], y[5], y[6], y[7]);
            *(u32x2*)(Y + (size_t)row * 4096 + c) = w; }
    }
}

template <bool FP8>
__device__ __forceinline__ void phase_gemm_out(const Args& a, LAS unsigned char* lds, int K, const void* w, const float* xin) {
    const int eb = FP8 ? 1 : 2;
    SrcGrid S{(const char*)(a.ws + WS_Y), (const char*)w, (size_t)BM * K * eb, (size_t)BM * K * eb, 64, 64 * 8, K * eb / 2, K * eb / 2};
    EpiResid E{(bf16_t*)(a.ws + WS_X), xin, (const bf16_t*)(a.ws + WS_X), FP8 ? 1.0f / W8_SCALE : 1.0f};
    gemm_stream<false, FP8>(lds, S, K * eb / 128, E);
}

struct SrcRouter {
    const char* h; const char* w;
    __device__ __forceinline__ bool next(int i, UnitD& u) const { const int id = BID + i * NBLK; if (id >= 256) return false; u.t0 = id & 63; u.t1 = id >> 6; u.t2 = 0;
        u.gA = h + ((size_t)u.t0 * BM * D_ + u.t1 * 512) * 2; u.gB = w + (size_t)u.t1 * 512 * 2; return true; }
    __device__ __forceinline__ void va(const UnitD&, unsigned (&v)[2][2]) const { offs_direct(v, D_, false); }
    __device__ __forceinline__ void vb(unsigned (&v)[2][2]) const { offs_direct(v, D_, true); }
};
struct EpiLogitsQ {
    float* O;
    __device__ __forceinline__ void operator()(const Acc& acc, const UnitD& u, int wr, int wc, int fr, int fq) const { store_f32_tile(acc, O + ((size_t)u.t1 * T_ + (size_t)u.t0 * BM) * 128, nullptr, 128, 128, wr, wc, fr, fq); }
};
__device__ __forceinline__ void phase_gemm_router(const Args& a, LAS unsigned char* lds, int layer) {
    SrcRouter S{(const char*)(a.ws + WS_H), (const char*)(a.ws + WS_WRT) + (size_t)layer * 256 * D_ * 2};
    EpiLogitsQ E{(float*)(a.ws + WS_O)};
    gemm_stream<false, false>(lds, S, 512 / BK, E);
}

__device__ __forceinline__ void phase_route(const Args& a, int layer) {
    const float* lg = (const float*)(a.ws + WS_O); const float* bg = a.in[22] + layer * 8; const float* be = a.in[24] + layer * 64;
    int* cnt = (int*)(a.ws + WS_CTL + CTL_CNT) + layer * 64;
    int* eid = (int*)(a.ws + WS_EID); int* slot = (int*)(a.ws + WS_SLOT); float* gate = (float*)(a.ws + WS_GATE); int* rowmap = (int*)(a.ws + WS_ROWMAP);
    const int gtid = BID * NTHREADS + TIDX, gsz = NBLK * NTHREADS;
    for (int i = gtid; i < MPAD; i += gsz) rowmap[i] = 0;
    for (int t = gtid; t < T_; t += gsz) {
        f32x4 ga = (f32x4){0.f, 0.f, 0.f, 0.f}, gb = ga;
#pragma unroll
        for (int kq = 0; kq < 4; ++kq) { ga += *(const f32x4*)(lg + ((size_t)kq * T_ + t) * 128); gb += *(const f32x4*)(lg + ((size_t)kq * T_ + t) * 128 + 4); }
        const float gl[8] = {ga[0] + bg[0], ga[1] + bg[1], ga[2] + bg[2], ga[3] + bg[3], gb[0] + bg[4], gb[1] + bg[5], gb[2] + bg[6], gb[3] + bg[7]};
        float mx = -3.0e38f; int gi = 0;
#pragma unroll
        for (int j = 0; j < 8; ++j) if (gl[j] > mx) { mx = gl[j]; gi = j; }
        float se = 0.f;
#pragma unroll
        for (int j = 0; j < 8; ++j) se += __expf(gl[j] - mx);
        const float gp = 1.0f / se;
        f32x4 ea = *(const f32x4*)(be + gi * 8), eb = *(const f32x4*)(be + gi * 8 + 4);
#pragma unroll
        for (int kq = 0; kq < 4; ++kq) { ea += *(const f32x4*)(lg + ((size_t)kq * T_ + t) * 128 + 8 + gi * 8); eb += *(const f32x4*)(lg + ((size_t)kq * T_ + t) * 128 + 12 + gi * 8); }
        const float el[8] = {ea[0], ea[1], ea[2], ea[3], eb[0], eb[1], eb[2], eb[3]};
        float l1 = -3.0e38f, l2 = -3.0e38f; int i1 = 0, i2 = 0;
#pragma unroll
        for (int j = 0; j < 8; ++j) { const float v = el[j];
            if (v > l1) { l2 = l1; i2 = i1; l1 = v; i1 = j; } else if (v > l2) { l2 = v; i2 = j; } }
        const float e2 = __expf(l2 - l1), inv = 1.0f / (1.0f + e2);
        const int e0 = gi * 8 + i1, e1 = gi * 8 + i2;
        eid[t * 2] = e0; eid[t * 2 + 1] = e1; gate[t * 2] = inv * gp; gate[t * 2 + 1] = e2 * inv * gp;
        slot[t * 2] = atomicAdd(&cnt[e0], 1); slot[t * 2 + 1] = atomicAdd(&cnt[e1], 1); }
}

__device__ __forceinline__ void phase_rowmap(const Args& a, LAS unsigned char* lds, int layer) {
    const int* cnt = (const int*)(a.ws + WS_CTL + CTL_CNT) + layer * 64; LAS int* ps = (LAS int*)lds;
    int* tinfo = (int*)(a.ws + WS_TINFO) + layer * 512;
    const int* eid = (const int*)(a.ws + WS_EID); const int* slot = (const int*)(a.ws + WS_SLOT); int* posof = (int*)(a.ws + WS_POSOF); int* rowmap = (int*)(a.ws + WS_ROWMAP);
    __syncthreads();
    if (TIDX == 0) { int acc = 0; for (int e = 0; e < 64; ++e) { ps[e] = acc; acc += (cnt[e] + 255) & ~255; } ps[64] = acc; }
    __syncthreads();
    if (BID == 0) { if (TIDX <= 64) tinfo[TIDX] = ps[TIDX]; if (TIDX == 65) tinfo[65] = ps[64] >> 8;
        if (TIDX < 192) { const int p = TIDX * 256; int e = 0; for (int j = 0; j < 64; ++j) if (ps[j + 1] <= p) e = j + 1; tinfo[128 + TIDX] = e < 64 ? e : 63; } }
    for (int i = BID * NTHREADS + TIDX; i < T_ * 2; i += NBLK * NTHREADS) { const int p = ps[eid[i]] + slot[i]; posof[i] = p; rowmap[p] = i >> 1; }
    __syncthreads();
}

struct SrcMoeUp {
    const char* h; const char* wg; const int* tinfo; const int* rowmap; int total;
    __device__ __forceinline__ bool next(int i, UnitD& u) const { const int id = BID + i * NBLK; if (id >= total) return false; u.t0 = id >> 2; u.t1 = id & 3;
        u.t2 = __builtin_amdgcn_readfirstlane(tinfo[128 + u.t0]); u.gA = h; u.gB = wg + ((size_t)u.t2 * DEXP + u.t1 * 128) * D_; return true; }
    __device__ __forceinline__ void va(const UnitD& u, unsigned (&v)[2][2]) const { int R0, C0; stage_pos(TIDX, R0, C0);
#pragma unroll
        for (int hh = 0; hh < 2; ++hh)
#pragma unroll
            for (int i = 0; i < 2; ++i) v[hh][i] = (unsigned)(rowmap[u.t0 * 256 + hh * 128 + R0 + 64 * i] * D_ + C0 * 2); }
    __device__ __forceinline__ void vb(unsigned (&v)[2][2]) const { int R0, C0; stage_pos(TIDX, R0, C0);
#pragma unroll
        for (int i = 0; i < 2; ++i) { const int Rr = perm_row(R0 + 64 * i); v[0][i] = (unsigned)(Rr * D_ + C0 * 2); v[1][i] = (unsigned)(WS_WU - WS_WG) + (unsigned)(Rr * D_ + C0 * 2); } }
};
__device__ __forceinline__ void phase_moe_up(const Args& a, LAS unsigned char* lds, int layer) {
    const int* tinfo = (const int*)(a.ws + WS_TINFO) + layer * 512;
    const int ntm = __builtin_amdgcn_readfirstlane(tinfo[65]);
    SrcMoeUp S{(const char*)(a.ws + WS_H8), (const char*)(a.ws + WS_WG), tinfo, (const int*)(a.ws + WS_ROWMAP), ntm * 4};
    EpiSwiGLU E{a.ws + WS_ACT};
    gemm_stream<true, true>(lds, S, D_ / 128, E);
}

struct SrcMoeDown {
    const char* act; const char* wd; const int* tinfo; int total;
    __device__ __forceinline__ bool next(int i, UnitD& u) const { const int id = BID + i * NBLK; if (id >= total) return false; u.t0 = id >> 3; u.t1 = id & 7;
        u.t2 = __builtin_amdgcn_readfirstlane(tinfo[128 + u.t0]); u.gA = act + (size_t)u.t0 * BM * DEXP; u.gB = wd + ((size_t)u.t2 * D_ + u.t1 * BM) * DEXP; return true; }
    __device__ __forceinline__ void va(const UnitD&, unsigned (&v)[2][2]) const { offs_direct(v, DEXP / 2, false); }
    __device__ __forceinline__ void vb(unsigned (&v)[2][2]) const { offs_direct(v, DEXP / 2, true); }
};
__device__ __forceinline__ void phase_moe_down(const Args& a, LAS unsigned char* lds, int layer) {
    const int* tinfo = (const int*)(a.ws + WS_TINFO) + layer * 512; const int ntm = __builtin_amdgcn_readfirstlane(tinfo[65]);
    SrcMoeDown S{(const char*)(a.ws + WS_ACT), (const char*)(a.ws + WS_WD), tinfo, ntm * 8};
    EpiDown E{a.ws + WS_YMOE};
    gemm_stream<false, true>(lds, S, DEXP / 128, E);
}

struct SrcIn1Tail {
    const char* h; const char* w;
    __device__ __forceinline__ bool next(int i, UnitD& u) const { const int id = BID + i * NBLK; if (id >= 256) return false; u.t0 = id & 63; u.t1 = id >> 6; u.t2 = 0;
        u.gA = h + (size_t)u.t0 * BM * D_ + u.t1 * 512; u.gB = w + (size_t)48 * BM * D_ + u.t1 * 512; return true; }
    __device__ __forceinline__ void va(const UnitD&, unsigned (&v)[2][2]) const { offs_direct(v, D_ / 2, false); }
    __device__ __forceinline__ void vb(unsigned (&v)[2][2]) const { offs_direct(v, D_ / 2, true); }
};
struct EpiTailQ {
    float* O;
    __device__ __forceinline__ void operator()(const Acc& acc, const UnitD& u, int wr, int wc, int fr, int fq) const { store_f32_tile(acc, O + ((size_t)u.t1 * T_ + (size_t)u.t0 * BM) * 64, nullptr, 64, 64, wr, wc, fr, fq, 1.0f / W8_SCALE); }
};
__device__ __forceinline__ void phase_gemm_in1(const Args& a, LAS unsigned char* lds) {
    SrcGrid S{(const char*)(a.ws + WS_H8), (const char*)(a.ws + WS_WIN1T), (size_t)BM * D_, (size_t)BM * D_, 64, 64 * 48, D_ / 2, D_ / 2};
    EpiProj E{(bf16_t*)(a.ws + WS_PROJ), N_IN1P, nullptr, 64, 48, 48, 64, 1.0f / W8_SCALE};
    gemm_stream<false, true>(lds, S, D_ / 128, E);
}
__device__ __forceinline__ void phase_gemm_in1_tail(const Args& a, LAS unsigned char* lds) {
    SrcIn1Tail S{(const char*)(a.ws + WS_H8), (const char*)(a.ws + WS_WIN1T)};
    EpiTailQ E{(float*)(a.ws + WS_O)};
    int nt = 4; asm volatile("" : "+s"(nt));
    gemm_stream<false, true>(lds, S, nt, E);
}

__device__ __forceinline__ void phase_gdn_conv(const Args& a) {
    const bf16_t* p1 = (const bf16_t*)(a.ws + WS_PROJ); bf16_t* qc = (bf16_t*)(a.ws + WS_QKVC); const float* cw = a.in[16];
    const int gtid = BID * NTHREADS + TIDX, gsz = NBLK * NTHREADS;
    for (int it = gtid; it < 1024 * (T_ / 128); it += gsz) { const int c = (it & 1023) * 8, seg = it >> 10; const size_t t0 = (size_t)seg * 128;
        float w[4][8];
#pragma unroll
        for (int k = 0; k < 4; ++k) { const f32x4 w0 = *(const f32x4*)(cw + k * 8192 + c), w1 = *(const f32x4*)(cw + k * 8192 + c + 4);
            w[k][0] = w0[0]; w[k][1] = w0[1]; w[k][2] = w0[2]; w[k][3] = w0[3]; w[k][4] = w1[0]; w[k][5] = w1[1]; w[k][6] = w1[2]; w[k][7] = w1[3]; }
        u32x4 x0 = (u32x4){0u, 0u, 0u, 0u}, x1 = x0, x2 = x0;
        if ((t0 & (S_ - 1)) != 0) { x0 = *(const u32x4*)(p1 + (t0 - 3) * N_IN1P + c); x1 = *(const u32x4*)(p1 + (t0 - 2) * N_IN1P + c); x2 = *(const u32x4*)(p1 + (t0 - 1) * N_IN1P + c); }
        const float qsc = c < 2048 ? 0.08838834764831845f : 1.0f;
        u32x4 xa[8];
#pragma unroll
        for (int j = 0; j < 8; ++j) xa[j] = *(const u32x4*)(p1 + (t0 + j) * N_IN1P + c);
#pragma unroll 1
        for (int r0 = 0; r0 < 128; r0 += 8) { u32x4 xb[8];
#pragma unroll
            for (int j = 0; j < 8; ++j) xb[j] = xa[j];
            if (r0 + 8 < 128) {
#pragma unroll
                for (int j = 0; j < 8; ++j) xb[j] = *(const u32x4*)(p1 + (t0 + r0 + 8 + j) * N_IN1P + c); }
#pragma unroll
          for (int j8 = 0; j8 < 8; ++j8) { const u32x4 x3 = xa[j8]; const int r = r0 + j8;
            float acc[8];
#define TAPS(j, f, m) (w[0][j] * f(x0.m) + w[1][j] * f(x1.m) + w[2][j] * f(x2.m) + w[3][j] * f(x3.m))
            acc[0] = TAPS(0, bf_lo, x); acc[1] = TAPS(1, bf_hi, x); acc[2] = TAPS(2, bf_lo, y); acc[3] = TAPS(3, bf_hi, y);
            acc[4] = TAPS(4, bf_lo, z); acc[5] = TAPS(5, bf_hi, z); acc[6] = TAPS(6, bf_lo, w); acc[7] = TAPS(7, bf_hi, w);
#undef TAPS
            float ss = 0.f;
#pragma unroll
            for (int j = 0; j < 8; ++j) { acc[j] = siluf_(acc[j]); ss += acc[j] * acc[j]; }
            ss = row16_sum(ss);
            const float sc = c < 4096 ? rsqrtf(ss + 1e-6f) * qsc : 1.0f;
            u32x4 o; o.x = cvt_pk_bf16(acc[0] * sc, acc[1] * sc); o.y = cvt_pk_bf16(acc[2] * sc, acc[3] * sc); o.z = cvt_pk_bf16(acc[4] * sc, acc[5] * sc); o.w = cvt_pk_bf16(acc[6] * sc, acc[7] * sc);
            *(u32x4*)(qc + (t0 + r) * 8192 + c) = o;
            x0 = x1; x1 = x2; x2 = x3; }
#pragma unroll
            for (int j = 0; j < 8; ++j) xa[j] = xb[j]; } }
    const float* tail = (const float*)(a.ws + WS_O); float* bgo = (float*)(a.ws + WS_BG);
    for (int it = gtid; it < T_ * 32; it += gsz) { const int t = it >> 5, hv = it & 31; float tb = 0.f, ta = 0.f;
#pragma unroll
        for (int kq = 0; kq < 4; ++kq) { tb += tail[((size_t)kq * T_ + t) * 64 + hv]; ta += tail[((size_t)kq * T_ + t) * 64 + 32 + hv]; }
        bgo[t * 64 + hv] = sigmoidf_(tb);
        bgo[t * 64 + 32 + hv] = -__expf(a.in[17][hv]) * softplusf_(ta + a.in[18][hv]); }
}

struct MoeTile { const float* src; unsigned char* dst; int lds_, ldd; };
__device__ __forceinline__ MoeTile moe_tile(const Args& a, int g) {
    const int job = g >> 14, r = g & 16383, e = r >> 8, rr = r & 255; MoeTile t;
    typedef __attribute__((address_space(1))) const float* gcf; gcf s25 = (gcf)a.in[25], s26 = (gcf)a.in[26]; asm volatile("" : "+s"(s25), "+s"(s26));
    if (job < 2) { const int ik = rr >> 3, in = rr & 7; t.lds_ = DEXP; t.ldd = D_;
        t.src = (const float*)(job ? s26 : s25) + ((size_t)(NEXP + e) * D_ + ik * 64) * DEXP + in * 64; t.dst = a.ws + (job ? WS_WU : WS_WG) + ((size_t)e * DEXP + in * 64) * D_ + ik * 64; }
    else { const int ik = rr >> 5, in = rr & 31; t.lds_ = D_; t.ldd = DEXP;
        t.src = a.in[27] + ((size_t)(NEXP + e) * DEXP + ik * 64) * D_ + in * 64; t.dst = a.ws + WS_WD + ((size_t)e * D_ + in * 64) * DEXP + ik * 64; }
    return t;
}
__device__ __forceinline__ void moe_tile_load(const MoeTile& t, int tid, f32x4 (&v)[2]) {
#pragma unroll
    for (int i = 0; i < 2; ++i) { const int idx = tid + i * 512, rr = idx >> 4, c4 = (idx & 15) * 4; v[i] = *(const f32x4*)(t.src + (size_t)rr * t.lds_ + c4); }
}
__device__ __forceinline__ void moe_tile_store(const MoeTile& t, int tid, const f32x4 (&v)[2], LAS float* tile) {
#pragma unroll
    for (int i = 0; i < 2; ++i) { const int idx = tid + i * 512, rr = idx >> 4, c4 = (idx & 15) * 4;
        tile[rr * 65 + c4 + 0] = v[i][0]; tile[rr * 65 + c4 + 1] = v[i][1]; tile[rr * 65 + c4 + 2] = v[i][2]; tile[rr * 65 + c4 + 3] = v[i][3]; }
    LDS_BARRIER();
    { const int n = tid >> 3, kg = (tid & 7) * 8; float f[8];
#pragma unroll
      for (int jj = 0; jj < 8; ++jj) f[jj] = tile[(kg + jj) * 65 + n] * W8_SCALE;
      u32x2 w; w.x = pk_fp8x4(f[0], f[1], f[2], f[3]); w.y = pk_fp8x4(f[4], f[5], f[6], f[7]);
      *(u32x2*)(t.dst + (size_t)n * t.ldd + kg) = w; }
    LDS_BARRIER();
}
constexpr int MOE_TILES = 3 * NEXP * 256;

__device__ __forceinline__ f32x4 mfma16(s16x4 a, s16x4 b, f32x4 c) { return __builtin_amdgcn_mfma_f32_16x16x16bf16_1k(a, b, c, 0, 0, 0); }
__device__ __forceinline__ s16x4 pack4(const f32x4& v) { u32x2 w; w.x = cvt_pk_bf16(v[0], v[1]); w.y = cvt_pk_bf16(v[2], v[3]); return __builtin_bit_cast(s16x4, w); }
__device__ __forceinline__ void phase_gdn_chunk(const Args& a, LAS unsigned char* lds) {
    const bf16_t* qc = (const bf16_t*)(a.ws + WS_QKVC); const float* bgi = (const float*)(a.ws + WS_BG); bf16_t* O = (bf16_t*)(a.ws + WS_O);
    constexpr int VRS = 144, KTRS = 136;
    constexpr int KT = 0, QS = KT + 128 * KTRS, WSL = QS + 64 * RSB, QKS = WSL + 64 * RSB, EE = QKS + 2048, EDD = EE + 256, SET = EDD + 256;
    constexpr int STL = 2 * SET, KS = STL + 64 * RSB, VS = KS + 64 * RSB, X2 = VS + 64 * VRS, LS = X2 + 2048, X1 = LS + 4096, GAM = X1 + 2048, BET = GAM + 256, LEND = BET + 256;
    static_assert(LEND <= LDS_XBW, "gdn lds");
    const int wid = __builtin_amdgcn_readfirstlane(TIDX >> 6);
    const int NCK = S_ / 64;
    for (int blk = BID; blk < NB_ * 32 * 2; blk += NBLK) {
        const int grp = (blk & 7) * 8 + (blk >> 5), mem = (blk >> 3) & 3, b = grp >> 4, hk = grp & 15, hv = 2 * hk + (mem >> 1), vhalf = mem & 1;
        __syncthreads();
        if (wid < 4) {
            const int vt = wid;
            f32x4 Sacc[8];
#pragma unroll
            for (int n = 0; n < 8; ++n) Sacc[n] = (f32x4){0.f, 0.f, 0.f, 0.f};
            { const int lane = TIDX & 63;
              for (int i = lane; i < 16 * RSB / 16; i += 64) *(LAS u32x4*)(lds + STL + 16 * vt * RSB + i * 16) = (u32x4){0u, 0u, 0u, 0u}; }
            int lz = TIDX & 63; asm volatile("" : "+v"(lz));
            const int lane = lz, I = lane & 15, G = lane >> 4, q4 = I >> 2, p4 = I & 3;
            for (int it = 0; it <= NCK; ++it) {
                const int set = ((it - 1) & 1) * SET; const size_t t0 = (size_t)b * S_ + (size_t)(it - 1) * 64;
                f32x4 U[4];
                if (it >= 1) {
#pragma unroll
                    for (int sa = 0; sa < 4; ++sa) U[sa] = mfma16(*(const LAS s16x4*)(lds + X2 + ((sa * 16 + I) * 16 + 4 * G) * 2), lds_tr4(lds + VS + (16 * sa + 4 * G + q4) * VRS + (16 * vt + 4 * p4) * 2), (f32x4){0.f, 0.f, 0.f, 0.f});
                    asm volatile("" : "+v"(U[0]), "+v"(U[1]), "+v"(U[2]), "+v"(U[3]) :: "memory");
                }
#pragma unroll
                for (int sa = 0; sa < 4; ++sa) {
                    if (it >= 1) {
                        bf16x8 sf[4];
#pragma unroll
                        for (int ks = 0; ks < 4; ++ks) sf[ks] = lds_frag(lds + STL + (16 * vt + I) * RSB + (32 * ks + 8 * G) * 2);
                        s16x4 kt[8];
#pragma unroll
                        for (int dt = 0; dt < 8; ++dt) kt[dt] = *(const LAS s16x4*)(lds + set + KT + (16 * dt + I) * KTRS + (16 * sa + 4 * G) * 2);
                        f32x4 dl = U[sa], oq = (f32x4){0.f, 0.f, 0.f, 0.f};
#pragma unroll
                        for (int ks = 0; ks < 4; ++ks) { dl = mfma32(lds_frag(lds + set + WSL + (16 * sa + I) * RSB + (32 * ks + 8 * G) * 2), sf[ks], dl);
                            oq = mfma32(lds_frag(lds + set + QS + (16 * sa + I) * RSB + (32 * ks + 8 * G) * 2), sf[ks], oq); }
                        const s16x4 dfrag = pack4(dl);
                        const f32x4 e4 = *(const LAS f32x4*)(lds + set + EE + (16 * sa + 4 * G) * 4);
                        oq = mfma16(*(const LAS s16x4*)(lds + set + QKS + ((sa * 16 + I) * 16 + 4 * G) * 2), dfrag, oq * e4);
#pragma unroll
                        for (int r = 0; r < 4; ++r) O[(t0 + 16 * sa + 4 * G + r) * 4096 + hv * 128 + vhalf * 64 + 16 * vt + I] = f2bf(oq[r]);
                        const f32x4 ed4 = *(const LAS f32x4*)(lds + set + EDD + (16 * sa + 4 * G) * 4); const float e15 = *(const LAS float*)(lds + set + EE + (16 * sa + 15) * 4);
                        const s16x4 dsc = pack4(dl * ed4);
#pragma unroll
                        for (int dt = 0; dt < 8; ++dt) {
                            Sacc[dt] = mfma16(kt[dt], dsc, Sacc[dt] * e15);
                            *(LAS s16x4*)(lds + STL + (16 * vt + I) * RSB + (16 * dt + 4 * G) * 2) = pack4(Sacc[dt]); }
                    }
                    LDS_BARRIER();
                }
            }
        } else {
            const int pw = wid - 4;
            u32x4 pq[4], pk[4], pv[2]; float pb = 0.f, pg = 0.f;
            { const int ptid = TIDX - 256; const size_t t0 = (size_t)b * S_;
#pragma unroll
              for (int i = 0; i < 4; ++i) { const int c = ptid + i * 256, s2 = c >> 4, c8 = (c & 15) * 8; pq[i] = *(const u32x4*)(qc + (t0 + s2) * 8192 + hk * 128 + c8); pk[i] = *(const u32x4*)(qc + (t0 + s2) * 8192 + 2048 + hk * 128 + c8); }
#pragma unroll
              for (int i = 0; i < 2; ++i) { const int c = ptid + i * 256, s2 = c >> 3, c8 = (c & 7) * 8; pv[i] = *(const u32x4*)(qc + (t0 + s2) * 8192 + 4096 + hv * 128 + vhalf * 64 + c8); }
              if (pw == 1) { pb = bgi[(t0 + ptid - 64) * 64 + hv]; pg = bgi[(t0 + ptid - 64) * 64 + 32 + hv]; } }
            int lz = TIDX & 63; asm volatile("" : "+v"(lz));
            const int lane = lz, ptid = pw * 64 + lane, I = lane & 15, G = lane >> 4, q4 = I >> 2, p4 = I & 3;
            for (int it = 0; it <= NCK; ++it) {
                const int set = (it & 1) * SET; const bool act = it < NCK;
                if (act) {
#pragma unroll
                    for (int i = 0; i < 4; ++i) { const int c = ptid + i * 256, s2 = c >> 4, c8 = (c & 15) * 8; *(LAS u32x4*)(lds + set + QS + s2 * RSB + c8 * 2) = pq[i]; *(LAS u32x4*)(lds + KS + s2 * RSB + c8 * 2) = pk[i]; }
                    if (pw == 1) { float x = pg;
                        x += __builtin_bit_cast(float, __builtin_amdgcn_update_dpp(0, __builtin_bit_cast(int, x), 0x111, 0xf, 0xf, true));
                        x += __builtin_bit_cast(float, __builtin_amdgcn_update_dpp(0, __builtin_bit_cast(int, x), 0x112, 0xf, 0xf, true));
                        x += __builtin_bit_cast(float, __builtin_amdgcn_update_dpp(0, __builtin_bit_cast(int, x), 0x114, 0xf, 0xf, true));
                        x += __builtin_bit_cast(float, __builtin_amdgcn_update_dpp(0, __builtin_bit_cast(int, x), 0x118, 0xf, 0xf, true));
                        const float g15 = __shfl(x, 15, 16);
                        *(LAS float*)(lds + GAM + lane * 4) = x; *(LAS float*)(lds + set + EE + lane * 4) = __expf(x); *(LAS float*)(lds + set + EDD + lane * 4) = __expf(g15 - x); *(LAS float*)(lds + BET + lane * 4) = pb; }
                }
                LDS_BARRIER();
                if (act) { const int sa = pw;
#pragma unroll
                    for (int i = 0; i < 2; ++i) { const int c = ptid + i * 256, s2 = c >> 3, c8 = (c & 7) * 8; *(LAS u32x4*)(lds + VS + s2 * VRS + c8 * 2) = pv[i]; }
                    if (it + 1 < NCK) { const size_t t1 = (size_t)b * S_ + (size_t)(it + 1) * 64;
#pragma unroll
                        for (int i = 0; i < 4; ++i) { const int c = ptid + i * 256, s2 = c >> 4, c8 = (c & 15) * 8; pq[i] = *(const u32x4*)(qc + (t1 + s2) * 8192 + hk * 128 + c8); pk[i] = *(const u32x4*)(qc + (t1 + s2) * 8192 + 2048 + hk * 128 + c8); }
#pragma unroll
                        for (int i = 0; i < 2; ++i) { const int c = ptid + i * 256, s2 = c >> 3, c8 = (c & 7) * 8; pv[i] = *(const u32x4*)(qc + (t1 + s2) * 8192 + 4096 + hv * 128 + vhalf * 64 + c8); }
                        if (pw == 1) { pb = bgi[(t1 + ptid - 64) * 64 + hv]; pg = bgi[(t1 + ptid - 64) * 64 + 32 + hv]; } }
#pragma unroll
                    for (int ty = 0; ty < 2; ++ty) { f32x4 acc = (f32x4){0.f, 0.f, 0.f, 0.f};
#pragma unroll
                        for (int ks = 0; ks < 4; ++ks) { const bf16x8 ka = lds_frag(lds + KS + (16 * sa + I) * RSB + (32 * ks + 8 * G) * 2);
                            const bf16x8 bo = ty ? lds_frag(lds + set + QS + (16 * sa + I) * RSB + (32 * ks + 8 * G) * 2) : ka; acc = mfma32(ka, bo, acc); }
                        const f32x4 gr = *(const LAS f32x4*)(lds + GAM + (16 * sa + 4 * G) * 4); const float gc = *(const LAS float*)(lds + GAM + (16 * sa + I) * 4);
                        if (ty == 0) { const f32x4 br = *(const LAS f32x4*)(lds + BET + (16 * sa + 4 * G) * 4);
#pragma unroll
                            for (int r = 0; r < 4; ++r) { const float val = br[r] * acc[r] * __expf(gr[r] - gc); *(LAS float*)(lds + LS + ((sa * 16 + 4 * G + r) * 16 + I) * 4) = (I < 4 * G + r) ? val : 0.f; } }
                        else { f32x4 o;
#pragma unroll
                            for (int r = 0; r < 4; ++r) { const float val = acc[r] * __expf(gc - gr[r]); o[r] = (4 * G + r <= I) ? val : 0.f; }
                            *(LAS s16x4*)(lds + set + QKS + ((sa * 16 + I) * 16 + 4 * G) * 2) = pack4(o); } } }
                LDS_BARRIER();
                if (act && pw == 0) { const int sa = G, c = I; float x[16];
#pragma unroll
                    for (int i = 0; i < 16; ++i) x[i] = 0.f;
#pragma unroll
                    for (int ib = 0; ib < 4; ++ib) {
                        f32x4 lv[4][4];
#pragma unroll
                        for (int r = 0; r < 4; ++r)
#pragma unroll
                            for (int jj = 0; jj <= ib; ++jj) lv[r][jj] = *(const LAS f32x4*)(lds + LS + ((sa * 16 + 4 * ib + r) * 16 + 4 * jj) * 4);
                        __builtin_amdgcn_sched_barrier(0);
#pragma unroll
                        for (int r = 0; r < 4; ++r) { const int i = 4 * ib + r; float s0 = (i == c) ? 1.0f : 0.0f, s1 = 0.f;
#pragma unroll
                            for (int jj = 0; jj <= ib; ++jj) { s0 -= lv[r][jj][0] * x[4 * jj] + lv[r][jj][1] * x[4 * jj + 1]; s1 -= lv[r][jj][2] * x[4 * jj + 2] + lv[r][jj][3] * x[4 * jj + 3]; }
                            x[i] = s0 + s1; }
                    }
                    const float bc = *(const LAS float*)(lds + BET + lane * 4), sc1 = -bc * *(const LAS float*)(lds + set + EE + lane * 4);
#pragma unroll
                    for (int i = 0; i < 16; ++i) { *(LAS bf16_t*)(lds + X1 + ((sa * 16 + i) * 16 + c) * 2) = f2bf(x[i] * sc1); *(LAS bf16_t*)(lds + X2 + ((sa * 16 + i) * 16 + c) * 2) = f2bf(x[i] * bc); } }
                LDS_BARRIER();
                if (act) { const int sa = pw;
                    const s16x4 xb = *(const LAS s16x4*)(lds + X1 + ((sa * 16 + I) * 16 + 4 * G) * 2); s16x4 kt[8]; f32x4 w[8];
#pragma unroll
                    for (int dt = 0; dt < 8; ++dt) kt[dt] = lds_tr4(lds + KS + (16 * sa + 4 * G + q4) * RSB + (16 * dt + 4 * p4) * 2);
#pragma unroll
                    for (int dt = 0; dt < 8; ++dt) { w[dt] = mfma16(kt[dt], xb, (f32x4){0.f, 0.f, 0.f, 0.f}); *(LAS s16x4*)(lds + set + KT + (16 * dt + I) * KTRS + (16 * sa + 4 * G) * 2) = kt[dt]; }
#pragma unroll
                    for (int dt = 0; dt < 8; ++dt) *(LAS s16x4*)(lds + set + WSL + (16 * sa + I) * RSB + (16 * dt + 4 * G) * 2) = pack4(w[dt]); }
                LDS_BARRIER();
            }
        }
    }
}

constexpr int N_PHASES = 30;
__global__ void __launch_bounds__(NTHREADS, 2) fwd(Args a0) {
    extern __shared__ __attribute__((aligned(16))) unsigned char smem_raw[];
    LAS unsigned char* lds = (LAS unsigned char*)smem_raw;
    volatile LAS unsigned* xbw = (volatile LAS unsigned*)(lds + LDS_XBW);
    if (TIDX == 0) { xbw[0] = 0u; xbw[1] = 0u; xbw[2] = 0u; xbw[3] = 0u; }
    __syncthreads();
    XcdBarrier bar = xcd_barrier_post((unsigned*)(a0.ws + WS_CTL), xbw);
#ifndef PHMASK
#define PHMASK 0xFFFFFFFFull
#endif
#ifndef DUPMASK
#define DUPMASK 0ull
#endif
#define PH(i, body) do { if (((PHMASK >> (i)) & 1ull) && a0.ph_lo <= (i) && (i) < a0.ph_hi) { __attribute__((address_space(1))) unsigned char* wsp_ = (__attribute__((address_space(1))) unsigned char*)a0.ws; asm volatile("" : "+s"(wsp_)); Args a = a0; a.ws = (unsigned char*)wsp_; const float* xin = a.in[0]; const float* xw = (const float*)(a.ws + WS_X); (void)xin; (void)xw; \
        if ((DUPMASK >> (i)) & 1ull) { body; xcd_barrier(bar); } body; if ((i) + 1 < a0.ph_hi) xcd_barrier(bar); } } while (0)
    PH(0, { phase_prologue(a, lds); __syncthreads(); phase_norm<0>(a, xin, a.in[1], -1); });
    PH(2, phase_gemm_in0(a, lds));
    PH(3, { phase_rg_conv(a); __syncthreads(); phase_hg1(a, lds); });
    PH(4, { phase_rg_gates(a, lds); __syncthreads(); phase_hg2(a); });
    PH(5, { phase_rg_scan(a, lds); __syncthreads(); phase_hg3(a, lds); });
    PH(9, phase_gemm_out<false>(a, lds, D_, a.ws + WS_WOUT0T, xin));
    PH(10, phase_norm<0>(a, nullptr, a.in[2], 0));
    PH(11, phase_gemm_router(a, lds, 0));
    PH(12, phase_route(a, 0));
    PH(13, phase_rowmap(a, lds, 0));
    PH(14, phase_moe_up(a, lds, 0));
    PH(15, phase_moe_down(a, lds, 0));
    PH(16, { phase_norm<1>(a, nullptr, a.in[1] + D_, 0); __syncthreads(); moe_weight_jobs(a, 1, lds); });
    PH(18, { phase_gemm_in1(a, lds); phase_gemm_in1_tail(a, lds); });
    PH(19, phase_gdn_conv(a));
    PH(20, phase_gdn_chunk(a, lds));
    PH(21, phase_gdn_norm(a));
    PH(22, phase_gemm_out<true>(a, lds, 4096, a.ws + WS_WOUT1T, nullptr));
    PH(23, phase_norm<0>(a, nullptr, a.in[2] + D_, 1));
    PH(24, phase_gemm_router(a, lds, 1));
    PH(25, phase_route(a, 1));
    PH(26, phase_rowmap(a, lds, 1));
    PH(27, phase_moe_up(a, lds, 1));
    PH(28, phase_moe_down(a, lds, 1));
    PH(29, phase_norm<2>(a, nullptr, a.in[3], 1));
#undef PH
}

extern "C" void kernel_launch(void* const* d_in, const int* in_sizes, int n_in, void* d_out, int out_size, void* d_ws, size_t ws_size, hipStream_t stream) {
    static int grid = 0;
    if (grid == 0) {
        if (n_in != 28 || ws_size < WS_END) { fprintf(stderr, "kernel_launch: need 28 inputs and %zu bytes of workspace, got %d / %zu\n", (size_t)WS_END, n_in, ws_size); grid = -1; return; }
        int dev = 0, cus = 0, per_cu = 0;
        if (hipGetDevice(&dev) != hipSuccess || hipDeviceGetAttribute(&cus, hipDeviceAttributeMultiprocessorCount, dev) != hipSuccess) { grid = -1; return; }
        if (hipFuncSetAttribute((const void*)fwd, hipFuncAttributeMaxDynamicSharedMemorySize, LDS_BYTES) != hipSuccess) { fprintf(stderr, "kernel_launch: hipFuncSetAttribute failed\n"); grid = -1; return; }
        if (hipOccupancyMaxActiveBlocksPerMultiprocessor(&per_cu, (const void*)fwd, NTHREADS, LDS_BYTES) != hipSuccess || per_cu < 1) { fprintf(stderr, "kernel_launch: occupancy query says %d\n", per_cu); }
        (void)hipGetLastError();
        grid = cus;
    }
    if (grid < 0) return;
    (void)in_sizes; (void)out_size;
    hipMemsetAsync((char*)d_ws + WS_CTL, 0, CTL_BYTES, stream);
    Args a; memset(&a, 0, sizeof(a));
    for (int i = 0; i < 28; ++i) a.in[i] = (const float*)d_in[i];
    a.out = (float*)d_out; a.ws = (unsigned char*)d_ws;
#if N_LAUNCH_MODE == 1
    a.ph_lo = 0; a.ph_hi = N_PHASES;
    hipLaunchKernelGGL(fwd, dim3(grid), dim3(NTHREADS), LDS_BYTES, stream, a);
#if EXTRA_PH >= 0
    a.ph_lo = EXTRA_PH; a.ph_hi = EXTRA_PH + 1;
    hipLaunchKernelGGL(fwd, dim3(grid), dim3(NTHREADS), LDS_BYTES, stream, a);
#endif
#else
    for (int p = 0; p < N_PHASES; ++p) { a.ph_lo = p; a.ph_hi = p + 1; hipLaunchKernelGGL(fwd, dim3(grid), dim3(NTHREADS), LDS_BYTES, stream, a); }
#endif
}
```

```cpp
#include <hip/hip_runtime.h>
#include <stdint.h>
#include <stdio.h>
#include <string.h>

#ifndef EXTRA_PH
#define EXTRA_PH -1
#endif
#ifndef N_LAUNCH_MODE
#define N_LAUNCH_MODE 1
#endif

#define LAS __attribute__((address_space(3)))
typedef unsigned short bf16_t;
typedef short bf16x8 __attribute__((ext_vector_type(8)));
typedef float f32x4 __attribute__((ext_vector_type(4)));
typedef float f32x2 __attribute__((ext_vector_type(2)));
typedef unsigned u32x4 __attribute__((ext_vector_type(4)));
typedef unsigned u32x2 __attribute__((ext_vector_type(2)));

constexpr int T_ = 16384, D_ = 2048, S_ = 4096, NB_ = 4;
constexpr int N_IN0 = 6144, N_IN1 = 12352, N_IN1P = 12544;
constexpr int NEXP = 64, DEXP = 512, MPAD = 49152;
constexpr int NTHREADS = 512;
constexpr int LDS_MAIN = 131072;
constexpr int LDS_BYTES = 163840;
constexpr int LDS_XBW = LDS_BYTES - 16;

constexpr size_t al256(size_t x) { return (x + 255) & ~(size_t)255; }
constexpr size_t WS_CTL = 0;
constexpr size_t CTL_BYTES = 65536;
constexpr size_t CTL_CNT = 16384;
constexpr size_t WS_LB = WS_CTL + CTL_BYTES;
constexpr size_t WS_TINFO = WS_LB + 4096;
constexpr size_t WS_WIN0T = WS_TINFO + 4096;
constexpr size_t WS_WOUT0T = WS_WIN0T + (size_t)N_IN0 * D_ * 2;
constexpr size_t WS_WIN1T = WS_WOUT0T + (size_t)D_ * D_ * 2;
constexpr size_t WS_WOUT1T = WS_WIN1T + (size_t)N_IN1P * D_ * 2;
constexpr size_t WS_WGATES = WS_WOUT1T + (size_t)D_ * 4096 * 2;
constexpr size_t WS_WRT = WS_WGATES + (size_t)8 * 256 * 256 * 2;
constexpr size_t WS_WG = WS_WRT + (size_t)2 * 256 * D_ * 2;
constexpr size_t WS_WU = WS_WG + (size_t)NEXP * DEXP * D_ * 2;
constexpr size_t WS_WD = WS_WU + (size_t)NEXP * DEXP * D_ * 2;
constexpr size_t WS_X = WS_WD + (size_t)NEXP * DEXP * D_ * 2;
constexpr size_t WS_H = WS_X + (size_t)T_ * D_ * 4;
constexpr size_t WS_PROJ = WS_H + (size_t)T_ * D_ * 2;
constexpr size_t PROJ_BYTES = (size_t)T_ * N_IN1P * 2;
constexpr size_t WS_FLOG = WS_PROJ + (size_t)T_ * N_IN0 * 2;
constexpr size_t WS_XC = WS_FLOG + (size_t)T_ * 1024 * 4;
constexpr size_t WS_ACT = WS_PROJ;
constexpr size_t WS_YMOE = WS_ACT + (size_t)MPAD * DEXP * 2;
constexpr size_t WS_R1 = WS_PROJ + PROJ_BYTES;
constexpr size_t WS_A = WS_R1;
constexpr size_t WS_U = WS_R1 + (size_t)T_ * 1024 * 4;
constexpr size_t WS_QKVC = WS_R1;
constexpr size_t WS_Y = WS_R1 + (size_t)T_ * 8192 * 2;
constexpr size_t WS_O = WS_Y + (size_t)T_ * 4096 * 2;
constexpr size_t WS_TAIL = WS_O + (size_t)T_ * 4096 * 4;
constexpr size_t WS_BG = WS_TAIL + (size_t)T_ * 64 * 4;
constexpr size_t WS_LOGITS = WS_BG + (size_t)T_ * 64 * 4;
constexpr size_t WS_EID = WS_LOGITS + (size_t)T_ * 128 * 4;
constexpr size_t WS_SLOT = WS_EID + (size_t)T_ * 2 * 4;
constexpr size_t WS_GATE = WS_SLOT + (size_t)T_ * 2 * 4;
constexpr size_t WS_POSOF = WS_GATE + (size_t)T_ * 2 * 4;
constexpr size_t WS_ROWMAP = WS_POSOF + (size_t)T_ * 2 * 4;
constexpr size_t WS_H8 = WS_ROWMAP + (size_t)MPAD * 4;
constexpr size_t WS_END = WS_H8 + (size_t)T_ * D_;
static_assert(WS_YMOE + (size_t)MPAD * D_ * 2 <= WS_R1, "moe overlay");
static_assert(WS_XC + (size_t)T_ * 1024 * 2 <= WS_R1, "layer0 overlay");

struct Args {
    const float* in[28];
    float* out;
    unsigned char* ws;
    int ph_lo, ph_hi;
};

__device__ __forceinline__ int tidx_() { int t = (int)threadIdx.x; asm volatile("" : "+v"(t)); return t; }
#define TIDX tidx_()
typedef __bf16 bf16x2n __attribute__((ext_vector_type(2)));
__device__ __forceinline__ unsigned cvt_pk_bf16(float lo, float hi) { const f32x2 v = {lo, hi}; return __builtin_bit_cast(unsigned, __builtin_convertvector(v, bf16x2n)); }
__device__ __forceinline__ unsigned pk_fp8x4(float a, float b, float c, float d) { int v = __builtin_amdgcn_cvt_pk_fp8_f32(a, b, 0, false); v = __builtin_amdgcn_cvt_pk_fp8_f32(c, d, v, true); return (unsigned)v; }
constexpr float W8_SCALE = 64.0f, ACT8_SCALE = 8.0f;
__device__ __forceinline__ bf16_t f2bf(float x) { return (bf16_t)(cvt_pk_bf16(x, 0.f) & 0xffffu); }
__device__ __forceinline__ float bf_lo(unsigned w) { return __uint_as_float(w << 16); }
__device__ __forceinline__ float bf_hi(unsigned w) { return __uint_as_float(w & 0xffff0000u); }
__device__ __forceinline__ float bf1(bf16_t v) { return __uint_as_float(((unsigned)v) << 16); }
__device__ __forceinline__ float sigmoidf_(float x) { return __builtin_amdgcn_rcpf(1.0f + __expf(-x)); }
__device__ __forceinline__ float siluf_(float x) { return x * __builtin_amdgcn_rcpf(1.0f + __expf(-x)); }
__device__ __forceinline__ float softplusf_(float x) { return x > 20.f ? x : log1pf(__expf(x)); }
__device__ __forceinline__ float gelu_tanh(float x) { const float u = 0.7978845608028654f * (x + 0.044715f * x * x * x); return x * __builtin_amdgcn_rcpf(1.0f + __expf(-2.0f * u)); }
template <int CTRL> __device__ __forceinline__ float dpp_f(float v) { return __builtin_bit_cast(float, __builtin_amdgcn_update_dpp(0, __builtin_bit_cast(int, v), CTRL, 0xf, 0xf, false)); }
__device__ __forceinline__ float row16_sum(float s) { s += dpp_f<0x140>(s); s += dpp_f<0x141>(s); s += dpp_f<0xB1>(s); s += dpp_f<0x4E>(s); return s; }
__device__ __forceinline__ float wave_sum(float v) { v = row16_sum(v); v += __shfl_xor(v, 16); v += __shfl_xor(v, 32); return v; }

#define LDS_BARRIER() do { asm volatile("s_waitcnt lgkmcnt(0)" ::: "memory"); __builtin_amdgcn_s_barrier(); asm volatile("" ::: "memory"); } while (0)
#define XB_TMO      128
#define XB_XCNT(j)  (256  + 64 * (j))
#define XB_XSUB(j)  (1280 + 64 * (j))
#define XB_XGEN(j)  (2304 + 64 * (j))
#define XB_TOP      3328
#define XB_TOPGEN   3392
#define XCD_BAR_WORDS 3456
#define XB_SPIN_CAP (1u << 18)

__device__ __forceinline__ unsigned xb_ld(unsigned* p)              { return __hip_atomic_load(p, __ATOMIC_RELAXED, __HIP_MEMORY_SCOPE_AGENT); }
__device__ __forceinline__ unsigned xb_add(unsigned* p, unsigned v) { return __hip_atomic_fetch_add(p, v, __ATOMIC_RELAXED, __HIP_MEMORY_SCOPE_AGENT); }
__device__ __forceinline__ unsigned xb_xcc_id() { return (unsigned)__builtin_amdgcn_s_getreg((3 << 11) | 20) & 0xFu; }
#define XB_SPIN(cond, bar) do { unsigned _sp = 0; while (cond) { __builtin_amdgcn_s_sleep(1); \
    if ((++_sp & 255u) == 0u) { if (xb_ld(&(bar)[XB_TMO])) break; if (_sp > XB_SPIN_CAP) { atomicAdd(&(bar)[XB_TMO], 1u); break; } } } } while (0)

struct XcdBarrier { unsigned* bar; unsigned x; volatile LAS unsigned* st; };

__device__ __forceinline__ XcdBarrier xcd_barrier_post(unsigned* bar, volatile LAS unsigned* st) {
    XcdBarrier b; b.bar = bar; b.x = xb_xcc_id(); b.st = st;
    if (TIDX == 0) (void)xb_add(&bar[XB_XCNT(b.x)], 1u);
    return b;
}
__device__ __forceinline__ void xcd_barrier_complete(unsigned* bar, unsigned x, unsigned& nloc, unsigned& nx) {
    const unsigned G = gridDim.x * gridDim.y * gridDim.z;
    unsigned sum, cnt, mine, sp = 0u;
    for (;;) {
        sum = 0u; cnt = 0u; mine = 0u;
#pragma unroll
        for (unsigned j = 0; j < 16; ++j) { const unsigned c = xb_ld(&bar[XB_XCNT(j)]); sum += c; cnt += (c > 0u) ? 1u : 0u; mine = (j == x) ? c : mine; }
        if (sum == G) break;
        __builtin_amdgcn_s_sleep(1);
        if ((++sp & 255u) == 0u) { if (xb_ld(&bar[XB_TMO])) break; if (sp > XB_SPIN_CAP) { atomicAdd(&bar[XB_TMO], 1u); break; } }
    }
    nloc = mine > 0u ? mine : 1u; nx = cnt > 0u ? cnt : 1u;
}
__device__ __forceinline__ void xcd_barrier(const XcdBarrier& b) {
    asm volatile("s_waitcnt vmcnt(0)" ::: "memory");
    __syncthreads();
    if (TIDX == 0) {
        unsigned* bar = b.bar;
        __builtin_amdgcn_s_waitcnt(0);
        unsigned nloc = b.st[0], nx = b.st[1];
        if (nloc == 0u) { xcd_barrier_complete(bar, b.x, nloc, nx); b.st[0] = nloc; b.st[1] = nx; }
        const unsigned old = xb_add(&bar[XB_XSUB(b.x)], 1u);
        const unsigned gen = old / nloc;
        if (old + 1u == (gen + 1u) * nloc) {
            __builtin_amdgcn_fence(__ATOMIC_RELEASE, "agent");
            asm volatile("s_waitcnt vmcnt(0)" ::: "memory");
            const unsigned og = xb_add(&bar[XB_TOP], 1u);
            const unsigned tg = og / nx;
            if (og + 1u == (tg + 1u) * nx) xb_add(&bar[XB_TOPGEN], 1u);
            else XB_SPIN(xb_ld(&bar[XB_TOPGEN]) == tg, bar);
            __builtin_amdgcn_fence(__ATOMIC_ACQUIRE, "agent");
            xb_add(&bar[XB_XGEN(b.x)], 1u);
            asm volatile("s_waitcnt vmcnt(0)" ::: "memory");
        } else {
            XB_SPIN(xb_ld(&bar[XB_XGEN(b.x)]) == gen, bar);
            __builtin_amdgcn_fence(__ATOMIC_ACQUIRE, "agent");
            asm volatile("s_waitcnt vmcnt(0)" ::: "memory");
        }
    }
    __syncthreads();
}

constexpr int BM = 256, BK = 64, HALF = 128, HTB = HALF * BK * 2;
__device__ __forceinline__ int lds_byte(int r, int c) { const int st = (r >> 4) * 2 + (c >> 5), rr = r & 15, cc = c & 31, ob = rr * 64 + cc * 2; return st * 1024 + (ob ^ (((ob >> 9) & 1) << 5)); }
__device__ __forceinline__ void stage_rc(int b, int& R, int& C) { const int st = b / 1024, sb = b % 1024, swz = sb ^ (((sb >> 9) & 1) << 5); R = (st >> 1) * 16 + swz / 64; C = (st & 1) * 32 + (swz % 64) / 2; }
__device__ __forceinline__ int perm32(int rho) { const int n = rho >> 4, i = rho & 15; return 8 * (i >> 2) + 4 * n + (i & 3); }

__device__ __forceinline__ void stage_pos(int tid, int& R0, int& C0) { stage_rc(tid * 16, R0, C0); }
__device__ __forceinline__ int perm_row(int R) { return (R & ~31) + perm32(R & 31); }

#define BID ((int)blockIdx.x)
#define NBLK ((int)gridDim.x)
#define BID_ BID
#define NBLK_ NBLK
typedef f32x4 Acc[2][2][4][2];
struct UnitD { const char* gA; const char* gB; int t0, t1, t2; };

typedef int i32x8 __attribute__((ext_vector_type(8)));
typedef int i32x4 __attribute__((ext_vector_type(4)));
template <bool GATHER, bool FP8, class Src, class Epi>
__device__ __forceinline__ void gemm_stream(LAS unsigned char* lds, const Src& S, const int nt, const Epi& E) {
    const int tid = TIDX, wid = tid >> 6, lane = tid & 63, wr = wid >> 2, wc = wid & 3, fr = lane & 15, fq = lane >> 4;
    const unsigned ldsw = (unsigned)wid * 1024u;
    const int aoff = lds_byte(wr * 64 + fr, fq * 8), boff = lds_byte(wc * 32 + fr, fq * 8);
    const size_t kstep = (size_t)(BK * 2);
#define G_SA(b, h) (((b) * 2 + (h)) * HTB)
#define G_SB(b, h) ((4 + (b) * 2 + (h)) * HTB)
#define G_STAGE(bufoff, gbase, v) do { _Pragma("unroll") for (int _i = 0; _i < 2; ++_i) \
        __builtin_amdgcn_global_load_lds((const unsigned*)((gbase) + (v)[_i]), (LAS unsigned*)(lds + (bufoff) + ldsw + _i * 8192), 16, 0, 0); } while (0)
#define G_LD8(p) __builtin_shufflevector(*(const LAS i32x4*)(p), *(const LAS i32x4*)((p) + 1024), 0, 1, 2, 3, 4, 5, 6, 7)
#define G_LDA(dst, b, h) do { _Pragma("unroll") for (int m = 0; m < 4; ++m) dst[m] = G_LD8(lds + G_SA(b, h) + aoff + m * 2048); } while (0)
#define G_LDB(dst, b, h) do { _Pragma("unroll") for (int n = 0; n < 2; ++n) dst[n] = G_LD8(lds + G_SB(b, h) + boff + n * 2048); } while (0)
#define G_HALF(x, k) __builtin_bit_cast(bf16x8, __builtin_shufflevector((x), (x), 4 * (k), 4 * (k) + 1, 4 * (k) + 2, 4 * (k) + 3))
#define G_MMA(ai, bj, At, Bt) do { __builtin_amdgcn_s_setprio(1); _Pragma("unroll") for (int m = 0; m < 4; ++m) _Pragma("unroll") for (int n = 0; n < 2; ++n) { \
        if (FP8) asm volatile("v_mfma_f32_16x16x128_f8f6f4 %0, %1, %2, %0" : "+v"(acc[ai][bj][m][n]) : "v"(Bt[n]), "v"(At[m]));   \
        else { acc[ai][bj][m][n] = __builtin_amdgcn_mfma_f32_16x16x32_bf16(G_HALF(Bt[n], 0), G_HALF(At[m], 0), acc[ai][bj][m][n], 0, 0, 0); \
               acc[ai][bj][m][n] = __builtin_amdgcn_mfma_f32_16x16x32_bf16(G_HALF(Bt[n], 1), G_HALF(At[m], 1), acc[ai][bj][m][n], 0, 0, 0); } } \
        __builtin_amdgcn_s_setprio(0); } while (0)
#define G_WAIT_V(n) asm volatile("s_waitcnt vmcnt(" #n ")" ::: "memory")
#define G_WAIT_L(n) asm volatile("s_waitcnt lgkmcnt(" #n ")" ::: "memory")
#define G_BAR __builtin_amdgcn_s_barrier()
#define G_SCHED __builtin_amdgcn_sched_barrier(0)
    UnitD cur, nxt; int ui = 0;
    if (!S.next(0, cur)) return;
    unsigned va[2][2], vb[2][2], van[2][2];
    S.vb(vb); S.va(cur, va);
    Acc acc;
#pragma unroll
    for (int a = 0; a < 2; ++a)
#pragma unroll
        for (int b = 0; b < 2; ++b)
#pragma unroll
            for (int m = 0; m < 4; ++m)
#pragma unroll
                for (int n = 0; n < 2; ++n) acc[a][b][m][n] = (f32x4){0.f, 0.f, 0.f, 0.f};
    i32x8 At[4], B0[2], B1[2];
    const char* cA = cur.gA; const char* cB = cur.gB;
    G_WAIT_V(0);
    __syncthreads();
    G_STAGE(G_SB(0, 0), cB, vb[0]); G_STAGE(G_SA(0, 0), cA, va[0]); G_STAGE(G_SB(0, 1), cB, vb[1]); G_STAGE(G_SA(0, 1), cA, va[1]);
    if (wr == 1) G_BAR;
    G_WAIT_V(4); G_BAR;
    G_STAGE(G_SB(1, 0), cB + kstep, vb[0]); G_STAGE(G_SA(1, 0), cA + kstep, va[0]); G_STAGE(G_SB(1, 1), cB + kstep, vb[1]);
    G_WAIT_V(6); G_BAR;
    for (;;) {
        const bool has_next = S.next(ui + 1, nxt);
        const char* nA = has_next ? nxt.gA : cA; const char* nB = has_next ? nxt.gB : cB;
        if (GATHER) { if (has_next) S.va(nxt, van); else { van[0][0] = va[0][0]; van[0][1] = va[0][1]; van[1][0] = va[1][0]; van[1][1] = va[1][1]; } }
#pragma unroll 1
        for (int t = 0; t < nt; t += 2) {
            const bool last = (t == nt - 2);
            const char* a1 = cA + (size_t)(t + 1) * kstep;
            const char* a2 = last ? nA : cA + (size_t)(t + 2) * kstep; const char* b2 = last ? nB : cB + (size_t)(t + 2) * kstep;
            const char* a3 = a2 + kstep; const char* b3 = b2 + kstep;
            unsigned v2[2][2];
#pragma unroll
            for (int hh = 0; hh < 2; ++hh)
#pragma unroll
                for (int i = 0; i < 2; ++i) v2[hh][i] = (GATHER && last) ? van[hh][i] : va[hh][i];
            G_LDB(B0, 0, 0); G_SCHED; G_LDA(At, 0, 0); G_STAGE(G_SA(1, 1), a1, va[1]);
            G_WAIT_L(8); G_BAR; G_WAIT_L(0); G_MMA(0, 0, At, B0); G_BAR; G_SCHED;
            G_LDB(B1, 0, 1); G_STAGE(G_SB(0, 0), b2, vb[0]);
            G_BAR; G_WAIT_L(0); G_MMA(0, 1, At, B1); G_BAR;
            G_LDA(At, 0, 1); G_STAGE(G_SA(0, 0), a2, v2[0]);
            G_BAR; G_WAIT_L(0); G_MMA(1, 0, At, B0); G_BAR; G_SCHED;
            G_STAGE(G_SB(0, 1), b2, vb[1]);
            G_WAIT_V(6); G_BAR; G_MMA(1, 1, At, B1); G_BAR;
            G_LDB(B0, 1, 0); G_SCHED; G_LDA(At, 1, 0); G_STAGE(G_SA(0, 1), a2, v2[1]);
            G_WAIT_L(8); G_BAR; G_WAIT_L(0); G_MMA(0, 0, At, B0); G_BAR; G_SCHED;
            G_LDB(B1, 1, 1); G_STAGE(G_SB(1, 0), b3, vb[0]);
            G_BAR; G_WAIT_L(0); G_MMA(0, 1, At, B1); G_BAR;
            G_LDA(At, 1, 1); G_STAGE(G_SA(1, 0), a3, v2[0]);
            G_BAR; G_WAIT_L(0); G_MMA(1, 0, At, B0); G_BAR; G_SCHED;
            G_STAGE(G_SB(1, 1), b3, vb[1]);
            G_WAIT_V(6); G_BAR; G_MMA(1, 1, At, B1); G_BAR;
        }
        if (FP8) asm volatile("s_nop 15\n\ts_nop 15" ::: "memory");
        { int tz = TIDX; asm volatile("" : "+v"(tz));
          const int wid2 = tz >> 6, lane2 = tz & 63; E(acc, cur, wid2 >> 2, wid2 & 3, lane2 & 15, lane2 >> 4); }
        if (!has_next) break;
#pragma unroll
        for (int a = 0; a < 2; ++a)
#pragma unroll
            for (int b = 0; b < 2; ++b)
#pragma unroll
                for (int m = 0; m < 4; ++m)
#pragma unroll
                    for (int n = 0; n < 2; ++n) acc[a][b][m][n] = (f32x4){0.f, 0.f, 0.f, 0.f};
        cur = nxt; cA = nA; cB = nB; ++ui;
        if (GATHER) { va[0][0] = van[0][0]; va[0][1] = van[0][1]; va[1][0] = van[1][0]; va[1][1] = van[1][1]; }
    }
    G_WAIT_V(0);
    if (wr == 0) G_BAR;
    G_BAR;
#undef G_SA
#undef G_SB
#undef G_STAGE
#undef G_LDA
#undef G_LDB
#undef G_MMA
#undef G_LD8
#undef G_HALF
#undef G_WAIT_V
#undef G_WAIT_L
#undef G_BAR
#undef G_SCHED
}

__device__ __forceinline__ void offs_direct(unsigned (&v)[2][2], int ld, bool perm) {
    int R0, C0; stage_pos(TIDX, R0, C0);
#pragma unroll
    for (int i = 0; i < 2; ++i) { const int R = R0 + 64 * i, Rr = perm ? perm_row(R) : R;
        v[0][i] = (unsigned)(Rr * ld + C0) * 2u; v[1][i] = (unsigned)((Rr + HALF) * ld + C0) * 2u; }
}

struct SrcGrid {
    const char* A; const char* B; size_t astep, bstep; int nM, total, lda, ldb;
    __device__ __forceinline__ bool next(int i, UnitD& u) const { const int id = BID_ + i * NBLK_; if (id >= total) return false; u.t0 = id % nM; u.t1 = id / nM; u.t2 = 0;
        u.gA = A + (size_t)u.t0 * astep; u.gB = B + (size_t)u.t1 * bstep; return true; }
    __device__ __forceinline__ void va(const UnitD&, unsigned (&v)[2][2]) const { offs_direct(v, lda, false); }
    __device__ __forceinline__ void vb(unsigned (&v)[2][2]) const { offs_direct(v, ldb, true); }
};

__device__ __forceinline__ void store_bf16_tile(const Acc& acc, bf16_t* O, int ld, int wr, int wc, int fr, int fq, const float sc = 1.0f) {
#pragma unroll
    for (int ai = 0; ai < 2; ++ai)
#pragma unroll
        for (int m = 0; m < 4; ++m) { bf16_t* rowp = O + (size_t)(ai * HALF + wr * 64 + m * 16 + fr) * ld + wc * 32 + 8 * fq;
#pragma unroll
            for (int bj = 0; bj < 2; ++bj) { const f32x4 v0 = acc[ai][bj][m][0] * sc, v1 = acc[ai][bj][m][1] * sc;
                u32x4 w; w.x = cvt_pk_bf16(v0[0], v0[1]); w.y = cvt_pk_bf16(v0[2], v0[3]); w.z = cvt_pk_bf16(v1[0], v1[1]); w.w = cvt_pk_bf16(v1[2], v1[3]);
                *(u32x4*)(rowp + bj * HALF) = w; } }
}
__device__ __forceinline__ void store_f32_tile(const Acc& acc, float* O, const float* R, int ld, int ncol, int wr, int wc, int fr, int fq, const float sc = 1.0f) {
#pragma unroll
    for (int ai = 0; ai < 2; ++ai)
#pragma unroll
        for (int m = 0; m < 4; ++m) { const size_t ro = (size_t)(ai * HALF + wr * 64 + m * 16 + fr) * ld;
#pragma unroll
            for (int bj = 0; bj < 2; ++bj)
#pragma unroll
                for (int n = 0; n < 2; ++n) { const int c = bj * HALF + wc * 32 + 8 * fq + 4 * n; if (c >= ncol) continue;
                    f32x4 v = acc[ai][bj][m][n] * sc; if (R) v += *(const f32x4*)(R + ro + c); *(f32x4*)(O + ro + c) = v; } }
}
struct EpiProj {
    bf16_t* O; int ld; float* F; int fld, fp0, fp1, ncol; float sc;
    __device__ __forceinline__ void operator()(const Acc& acc, const UnitD& u, int wr, int wc, int fr, int fq) const {
        if (u.t1 >= fp0 && u.t1 < fp1) store_f32_tile(acc, F + (size_t)u.t0 * BM * fld + (u.t1 - fp0) * BM, nullptr, fld, ncol, wr, wc, fr, fq, sc);
        else store_bf16_tile(acc, O + (size_t)u.t0 * BM * ld + u.t1 * BM, ld, wr, wc, fr, fq, sc);
    }
};
struct EpiResid {
    bf16_t* O; const float* Rf; const bf16_t* Rb; float sc;
    __device__ __forceinline__ void operator()(const Acc& acc, const UnitD& u, int wr, int wc, int fr, int fq) const {
        const size_t o = (size_t)u.t0 * BM * D_ + u.t1 * BM;
#pragma unroll
        for (int ai = 0; ai < 2; ++ai)
#pragma unroll
            for (int m = 0; m < 4; ++m) { const size_t ro = o + (size_t)(ai * HALF + wr * 64 + m * 16 + fr) * D_ + wc * 32 + 8 * fq;
#pragma unroll
                for (int bj = 0; bj < 2; ++bj) { f32x4 v0 = acc[ai][bj][m][0] * sc, v1 = acc[ai][bj][m][1] * sc;
                    if (Rf) { v0 += *(const f32x4*)(Rf + ro + bj * HALF); v1 += *(const f32x4*)(Rf + ro + bj * HALF + 4); }
                    else { const u32x4 r = *(const u32x4*)(Rb + ro + bj * HALF); v0[0] += bf_lo(r.x); v0[1] += bf_hi(r.x); v0[2] += bf_lo(r.y); v0[3] += bf_hi(r.y); v1[0] += bf_lo(r.z); v1[1] += bf_hi(r.z); v1[2] += bf_lo(r.w); v1[3] += bf_hi(r.w); }
                    u32x4 w; w.x = cvt_pk_bf16(v0[0], v0[1]); w.y = cvt_pk_bf16(v0[2], v0[3]); w.z = cvt_pk_bf16(v1[0], v1[1]); w.w = cvt_pk_bf16(v1[2], v1[3]);
                    *(u32x4*)(O + ro + bj * HALF) = w; } }
    }
};
struct EpiLogits {
    float* O;
    __device__ __forceinline__ void operator()(const Acc& acc, const UnitD& u, int wr, int wc, int fr, int fq) const { store_f32_tile(acc, O + (size_t)u.t0 * BM * 128, nullptr, 128, 128, wr, wc, fr, fq); }
};
struct EpiSwiGLU {
    unsigned char* O;
    __device__ __forceinline__ void operator()(const Acc& acc, const UnitD& u, int wr, int wc, int fr, int fq) const {
        unsigned char* o = O + (size_t)u.t0 * BM * DEXP + u.t1 * 128;
#pragma unroll
        for (int ai = 0; ai < 2; ++ai)
#pragma unroll
            for (int m = 0; m < 4; ++m) { unsigned char* rowp = o + (size_t)(ai * HALF + wr * 64 + m * 16 + fr) * DEXP + wc * 32 + 8 * fq;
                float r[8];
#pragma unroll
                for (int n = 0; n < 2; ++n)
#pragma unroll
                    for (int j = 0; j < 4; ++j) r[n * 4 + j] = (ACT8_SCALE / W8_SCALE) * siluf_(acc[ai][0][m][n][j] * (1.0f / W8_SCALE)) * acc[ai][1][m][n][j];
                u32x2 w; w.x = pk_fp8x4(r[0], r[1], r[2], r[3]); w.y = pk_fp8x4(r[4], r[5], r[6], r[7]);
                *(u32x2*)rowp = w; }
    }
};
struct EpiDown {
    unsigned char* O;
    __device__ __forceinline__ void operator()(const Acc& acc, const UnitD& u, int wr, int wc, int fr, int fq) const {
        unsigned char* o = O + (size_t)u.t0 * BM * D_ + u.t1 * BM; const float sc = 1.0f / (W8_SCALE * ACT8_SCALE);
#pragma unroll
        for (int ai = 0; ai < 2; ++ai)
#pragma unroll
            for (int m = 0; m < 4; ++m) { unsigned char* rowp = o + (size_t)(ai * HALF + wr * 64 + m * 16 + fr) * D_ + wc * 32 + 8 * fq;
#pragma unroll
                for (int bj = 0; bj < 2; ++bj) { const f32x4 v0 = acc[ai][bj][m][0] * sc, v1 = acc[ai][bj][m][1] * sc;
                    u32x2 w; w.x = pk_fp8x4(v0[0], v0[1], v0[2], v0[3]); w.y = pk_fp8x4(v1[0], v1[1], v1[2], v1[3]); *(u32x2*)(rowp + bj * HALF) = w; } }
    }
};
__device__ __forceinline__ unsigned rg_idx(unsigned tok, int c) { return ((((tok >> 12) * 64u + (unsigned)(c >> 4)) * (unsigned)S_ + (tok & (unsigned)(S_ - 1))) << 4) + (unsigned)(c & 15); }
struct EpiRgGates {
    bf16_t* LAo; bf16_t* Uo; const bf16_t* xc;
    const float* ba; const float* bx; const float* lam;
    __device__ __forceinline__ void operator()(const Acc& acc, const UnitD& u, int wr, int wc, int fr, int fq) const {
#pragma unroll
        for (int n = 0; n < 2; ++n) { const int c = u.t1 * 128 + wc * 32 + 8 * fq + 4 * n;
            const f32x4 vba = *(const f32x4*)(ba + c), vbx = *(const f32x4*)(bx + c), vl = *(const f32x4*)(lam + c);
            f32x4 c8; for (int j = 0; j < 4; ++j) c8[j] = -8.0f * softplusf_(-vl[j]);
#pragma unroll
            for (int ai = 0; ai < 2; ++ai)
#pragma unroll
                for (int m = 0; m < 4; ++m) { const unsigned tok = (unsigned)(u.t0 * BM + ai * HALF + wr * 64 + m * 16 + fr);
                    const u32x2 xw = *(const u32x2*)(xc + (tok * 1024u + (unsigned)c)); const float xv[4] = {bf_lo(xw.x), bf_hi(xw.x), bf_lo(xw.y), bf_hi(xw.y)};
                    f32x4 lv, uv;
#pragma unroll
                    for (int j = 0; j < 4; ++j) { const float r = sigmoidf_(acc[ai][0][m][n][j] + vba[j]), ig = sigmoidf_(acc[ai][1][m][n][j] + vbx[j]);
                        const float la = c8[j] * r, av = __expf(la); lv[j] = la; uv[j] = __builtin_amdgcn_sqrtf(fmaxf(0.f, 1.0f - av * av)) * ig * xv[j]; }
                    const unsigned o = rg_idx(tok, c);
                    u32x2 w0; w0.x = cvt_pk_bf16(lv[0], lv[1]); w0.y = cvt_pk_bf16(lv[2], lv[3]); *(u32x2*)(LAo + o) = w0;
                    u32x2 w1; w1.x = cvt_pk_bf16(uv[0], uv[1]); w1.y = cvt_pk_bf16(uv[2], uv[3]); *(u32x2*)(Uo + o) = w1; } }
    }
};


__device__ __forceinline__ void transpose_job8(const float* src, unsigned char* dst, int K, int N, int ldd, size_t sb, size_t db, int nbatch, LAS unsigned char* lds) {
    const int tid = TIDX, tk = K / 128, tn = N / 64, per = tk * tn, total = per * nbatch;
    const int rr0 = tid >> 4, c4 = (tid & 15) * 4, n = tid >> 3, kg = (tid & 7) * 16;
    f32x4 va[4], vb[4];
#define T8_LD(v, t) { const int u_ = (t), ub_ = u_ / per, ur_ = u_ % per, uik_ = ur_ / tn, uin_ = ur_ % tn; const float* usp_ = src + (size_t)ub_ * sb + (size_t)(uik_ * 128 + rr0) * N + uin_ * 64 + c4; \
        _Pragma("unroll") for (int i = 0; i < 4; ++i) v[i] = *(const f32x4*)(usp_ + (size_t)(i * 32) * N); }
#define T8_ST(v, t, buf) { const int t_ = (t), b_ = t_ / per, r_ = t_ % per, ik_ = r_ / tn, in_ = r_ % tn; LAS float* tile = (LAS float*)(lds + (buf) * (128 * 65 * 4)); \
        _Pragma("unroll") for (int i = 0; i < 4; ++i) { const int rr = rr0 + i * 32; tile[rr * 65 + c4 + 0] = v[i][0]; tile[rr * 65 + c4 + 1] = v[i][1]; tile[rr * 65 + c4 + 2] = v[i][2]; tile[rr * 65 + c4 + 3] = v[i][3]; } \
        if (t_ + 2 * NBLK < total) T8_LD(v, t_ + 2 * NBLK) \
        LDS_BARRIER(); \
        float f[16]; \
        _Pragma("unroll") for (int j = 0; j < 16; ++j) f[j] = tile[(kg + j) * 65 + n] * W8_SCALE; \
        u32x4 w; w.x = pk_fp8x4(f[0], f[1], f[2], f[3]); w.y = pk_fp8x4(f[4], f[5], f[6], f[7]); w.z = pk_fp8x4(f[8], f[9], f[10], f[11]); w.w = pk_fp8x4(f[12], f[13], f[14], f[15]); \
        *(u32x4*)(dst + (size_t)b_ * db + (size_t)(in_ * 64 + n) * ldd + ik_ * 128 + kg) = w; }
    int t = BID;
    if (t < total) T8_LD(va, t)
    if (t + NBLK < total) T8_LD(vb, t + NBLK)
    for (; t < total; t += 2 * NBLK) {
        T8_ST(va, t, 0)
        if (t + NBLK < total) T8_ST(vb, t + NBLK, 1)
    }
#undef T8_LD
#undef T8_ST
    LDS_BARRIER();
}
__device__ __forceinline__ void transpose_job(const float* src, bf16_t* dst, int K, int N, int ldd, size_t sb, size_t db, int dalt, int nbatch, LAS unsigned char* lds) {
    const int tid = TIDX, tk = K / 64, tn = N / 64, per = tk * tn, total = per * nbatch;
    const int rr0 = tid >> 4, c4 = (tid & 15) * 4, n = tid >> 3, kg = (tid & 7) * 8;
    f32x4 va[2], vb[2];
#define T16_LD(v, t) { const int u_ = (t), ub_ = u_ / per, ur_ = u_ % per, uik_ = ur_ / tn, uin_ = ur_ % tn; const float* usp_ = src + (size_t)ub_ * sb + (size_t)(uik_ * 64 + rr0) * N + uin_ * 64 + c4; \
        _Pragma("unroll") for (int i = 0; i < 2; ++i) v[i] = *(const f32x4*)(usp_ + (size_t)(i * 32) * N); }
#define T16_ST(v, t, buf) { const int t_ = (t), b_ = t_ / per, r_ = t_ % per, ik_ = r_ / tn, in_ = r_ % tn; LAS float* tile = (LAS float*)(lds + (buf) * (64 * 65 * 4)); \
        _Pragma("unroll") for (int i = 0; i < 2; ++i) { const int rr = rr0 + i * 32; tile[rr * 65 + c4 + 0] = v[i][0]; tile[rr * 65 + c4 + 1] = v[i][1]; tile[rr * 65 + c4 + 2] = v[i][2]; tile[rr * 65 + c4 + 3] = v[i][3]; } \
        if (t_ + 2 * NBLK < total) T16_LD(v, t_ + 2 * NBLK) \
        LDS_BARRIER(); \
        float f[8]; \
        _Pragma("unroll") for (int j = 0; j < 8; ++j) f[j] = tile[(kg + j) * 65 + n]; \
        u32x4 w; w.x = cvt_pk_bf16(f[0], f[1]); w.y = cvt_pk_bf16(f[2], f[3]); w.z = cvt_pk_bf16(f[4], f[5]); w.w = cvt_pk_bf16(f[6], f[7]); \
        *(u32x4*)(dst + (size_t)b_ * db + (size_t)(b_ & 1) * dalt + (size_t)(in_ * 64 + n) * ldd + ik_ * 64 + kg) = w; }
    int t = BID;
    if (t < total) T16_LD(va, t)
    if (t + NBLK < total) T16_LD(vb, t + NBLK)
    for (; t < total; t += 2 * NBLK) {
        T16_ST(va, t, 0)
        if (t + NBLK < total) T16_ST(vb, t + NBLK, 1)
    }
#undef T16_LD
#undef T16_ST
    LDS_BARRIER();
}

__device__ __forceinline__ void moe_weight_jobs(const Args& a, int layer, LAS unsigned char* lds) {
    const size_t lo = (size_t)layer * NEXP * D_ * DEXP;
    transpose_job8(a.in[25] + lo, a.ws + WS_WG, D_, DEXP, D_, (size_t)D_ * DEXP, (size_t)DEXP * D_, NEXP, lds);
    transpose_job8(a.in[26] + lo, a.ws + WS_WU, D_, DEXP, D_, (size_t)D_ * DEXP, (size_t)DEXP * D_, NEXP, lds);
    transpose_job8(a.in[27] + lo, a.ws + WS_WD, DEXP, D_, DEXP, (size_t)D_ * DEXP, (size_t)DEXP * D_, NEXP, lds);
}

__device__ __forceinline__ void phase_prologue(const Args& a, LAS unsigned char* lds) {
    const int gtid = BID * NTHREADS + TIDX, gsz = NBLK * NTHREADS;
    for (int i = gtid; i < 1024; i += gsz) { const float l0 = a.in[12][i], l1 = a.in[12][1024 + i], mx = fmaxf(l0, l1), e0 = __expf(l0 - mx), e1 = __expf(l1 - mx);
        ((float*)(a.ws + WS_LB))[i] = e0 / (e0 + e1); }
    for (int it = gtid; it < 2 * 256 * 256; it += gsz) { const int l = it >> 16, n = (it >> 8) & 255, k8 = (it & 255) * 8; float f[8];
#pragma unroll
        for (int j = 0; j < 8; ++j) { const int k = k8 + j; f[j] = n < 8 ? a.in[21][((size_t)l * D_ + k) * 8 + n] : (n < 72 ? a.in[23][((size_t)l * D_ + k) * 64 + (n - 8)] : 0.f); }
        u32x4 w; w.x = cvt_pk_bf16(f[0], f[1]); w.y = cvt_pk_bf16(f[2], f[3]); w.z = cvt_pk_bf16(f[4], f[5]); w.w = cvt_pk_bf16(f[6], f[7]);
        *(u32x4*)((bf16_t*)(a.ws + WS_WRT) + ((size_t)l * 256 + n) * D_ + k8) = w; }
    for (int it = gtid; it < 192 * 128; it += gsz) *(u32x4*)(a.ws + WS_WIN1T + (size_t)N_IN1 * D_ + (size_t)it * 16) = (u32x4){0u, 0u, 0u, 0u};
    transpose_job(a.in[4], (bf16_t*)(a.ws + WS_WIN0T), D_, N_IN0, D_, 0, 0, 0, 1, lds);
    transpose_job(a.in[14], (bf16_t*)(a.ws + WS_WOUT0T), D_, D_, D_, 0, 0, 0, 1, lds);
    transpose_job8(a.in[15], a.ws + WS_WIN1T, D_, N_IN1, D_, 0, 0, 1, lds);
    transpose_job8(a.in[20], a.ws + WS_WOUT1T, 4096, D_, 4096, 0, 0, 1, lds);
    transpose_job(a.in[7], (bf16_t*)(a.ws + WS_WGATES), 128, 128, 128, 128 * 128, 256 * 128, 0, 8, lds);
    transpose_job(a.in[9], (bf16_t*)(a.ws + WS_WGATES) + 128 * 128, 128, 128, 128, 128 * 128, 256 * 128, 0, 8, lds);
    moe_weight_jobs(a, 0, lds);
}

#define NORM_PH(M, F) phase_norm<M, F>
template <int MODE, bool F32>
__device__ __forceinline__ void phase_norm(const Args& a, const float* src, const float* gain, int layer) {
    const int wid = TIDX >> 6, lane = TIDX & 63;
    bf16_t* xw = (bf16_t*)(a.ws + WS_X); bf16_t* hw = (bf16_t*)(a.ws + WS_H);
    const unsigned char* ym = a.ws + WS_YMOE; const int* posof = (const int*)(a.ws + WS_POSOF); const float* gate = (const float*)(a.ws + WS_GATE);
    const int stride = NBLK * 16;
    f32x4 rf[2][8]; u32x2 rb[2][8]; int pp[2][2] = {{0, 0}, {0, 0}}; float pg[2][2] = {{0.f, 0.f}, {0.f, 0.f}};
#define NORM_LD(r) { _Pragma("unroll") for (int u = 0; u < 2; ++u) { _Pragma("unroll") for (int i = 0; i < 8; ++i) { \
            if (F32) rf[u][i] = *(const f32x4*)(src + (size_t)((r) + u) * D_ + (i * 64 + lane) * 4); else rb[u][i] = *(const u32x2*)(xw + (size_t)((r) + u) * D_ + (i * 64 + lane) * 4); } \
            if (MODE >= 1) { pp[u][0] = posof[((r) + u) * 2]; pp[u][1] = posof[((r) + u) * 2 + 1]; pg[u][0] = gate[((r) + u) * 2]; pg[u][1] = gate[((r) + u) * 2 + 1]; } } }
    int row = (BID * 8 + wid) * 2;
    if (row < T_) NORM_LD(row)
    for (; row < T_; row += stride) {
        f32x4 v[2][8]; int p[2][2]; float g[2][2];
#pragma unroll
        for (int u = 0; u < 2; ++u) { p[u][0] = pp[u][0]; p[u][1] = pp[u][1]; g[u][0] = pg[u][0]; g[u][1] = pg[u][1];
#pragma unroll
            for (int i = 0; i < 8; ++i) v[u][i] = F32 ? rf[u][i] : (f32x4){bf_lo(rb[u][i].x), bf_hi(rb[u][i].x), bf_lo(rb[u][i].y), bf_hi(rb[u][i].y)}; }
        if (row + stride < T_) NORM_LD(row + stride)
        if (MODE >= 1) {
            int y[2][8][2];
#pragma unroll
            for (int u = 0; u < 2; ++u) {
#pragma unroll
                for (int i = 0; i < 8; ++i) { const int c = (i * 64 + lane) * 4; y[u][i][0] = *(const int*)(ym + (size_t)p[u][0] * D_ + c); y[u][i][1] = *(const int*)(ym + (size_t)p[u][1] * D_ + c); } }
#pragma unroll
            for (int u = 0; u < 2; ++u) { const float g0 = g[u][0], g1 = g[u][1];
#pragma unroll
                for (int i = 0; i < 8; ++i) { const int y0 = y[u][i][0], y1 = y[u][i][1];
                    const f32x2 a0 = __builtin_amdgcn_cvt_pk_f32_fp8(y0, false), a1 = __builtin_amdgcn_cvt_pk_f32_fp8(y0, true), b0 = __builtin_amdgcn_cvt_pk_f32_fp8(y1, false), b1 = __builtin_amdgcn_cvt_pk_f32_fp8(y1, true);
                    v[u][i][0] += g0 * a0[0] + g1 * b0[0]; v[u][i][1] += g0 * a0[1] + g1 * b0[1]; v[u][i][2] += g0 * a1[0] + g1 * b1[0]; v[u][i][3] += g0 * a1[1] + g1 * b1[1]; }
                if (MODE == 1) {
#pragma unroll
                    for (int i = 0; i < 8; ++i) { u32x2 w; w.x = cvt_pk_bf16(v[u][i][0], v[u][i][1]); w.y = cvt_pk_bf16(v[u][i][2], v[u][i][3]); *(u32x2*)(xw + (size_t)(row + u) * D_ + (i * 64 + lane) * 4) = w; } } }
        }
#pragma unroll
        for (int u = 0; u < 2; ++u) {
            float ss = 0.f;
#pragma unroll
            for (int i = 0; i < 8; ++i) ss += v[u][i][0] * v[u][i][0] + v[u][i][1] * v[u][i][1] + v[u][i][2] * v[u][i][2] + v[u][i][3] * v[u][i][3];
            ss = wave_sum(ss);
            const float rstd = rsqrtf(ss * (1.0f / D_) + 1e-6f);
#pragma unroll
            for (int i = 0; i < 8; ++i) { const int c = (i * 64 + lane) * 4; const f32x4 gn = *(const f32x4*)(gain + c);
                const f32x4 o = v[u][i] * rstd * gn;
                if (MODE == 2) *(f32x4*)(a.out + (size_t)(row + u) * D_ + c) = o;
                else { if (MODE != 1) { u32x2 w; w.x = cvt_pk_bf16(o[0], o[1]); w.y = cvt_pk_bf16(o[2], o[3]); *(u32x2*)(hw + (size_t)(row + u) * D_ + c) = w; }
                       if (layer >= 0) *(unsigned*)(a.ws + WS_H8 + (size_t)(row + u) * D_ + c) = pk_fp8x4(o[0], o[1], o[2], o[3]); } } }
    }
#undef NORM_LD
    (void)layer;
}

__device__ __forceinline__ void phase_gemm_in0(const Args& a, LAS unsigned char* lds) {
    SrcGrid S{(const char*)(a.ws + WS_H), (const char*)(a.ws + WS_WIN0T), (size_t)BM * D_ * 2, (size_t)BM * D_ * 2, 64, 64 * 24, D_, D_};
    EpiProj E{(bf16_t*)(a.ws + WS_PROJ), N_IN0, (float*)(a.ws + WS_FLOG), 1024, 12, 16, 256, 1.0f};
    gemm_stream<false, false>(lds, S, D_ / BK, E);
}

__device__ __forceinline__ void phase_rg_conv(const Args& a) {
    const bf16_t* p0 = (const bf16_t*)(a.ws + WS_PROJ); bf16_t* xc = (bf16_t*)(a.ws + WS_XC);
    const float* cw = a.in[5]; const float* cb = a.in[6];
    for (int it = BID * NTHREADS + TIDX; it < 128 * (T_ / 16); it += NBLK * NTHREADS) { const int c = (it & 127) * 8; const size_t t0 = (size_t)(it >> 7) * 16;
        float w[4][8], bias[8];
#pragma unroll
        for (int k = 0; k < 4; ++k) { const f32x4 w0 = *(const f32x4*)(cw + k * 1024 + c), w1 = *(const f32x4*)(cw + k * 1024 + c + 4);
            w[k][0] = w0[0]; w[k][1] = w0[1]; w[k][2] = w0[2]; w[k][3] = w0[3]; w[k][4] = w1[0]; w[k][5] = w1[1]; w[k][6] = w1[2]; w[k][7] = w1[3]; }
        { const f32x4 b0 = *(const f32x4*)(cb + c), b1 = *(const f32x4*)(cb + c + 4); bias[0] = b0[0]; bias[1] = b0[1]; bias[2] = b0[2]; bias[3] = b0[3]; bias[4] = b1[0]; bias[5] = b1[1]; bias[6] = b1[2]; bias[7] = b1[3]; }
        u32x4 x0 = (u32x4){0u, 0u, 0u, 0u}, x1 = x0, x2 = x0;
        if ((t0 & (S_ - 1)) != 0) { x0 = *(const u32x4*)(p0 + (t0 - 3) * N_IN0 + c); x1 = *(const u32x4*)(p0 + (t0 - 2) * N_IN0 + c); x2 = *(const u32x4*)(p0 + (t0 - 1) * N_IN0 + c); }
#pragma unroll 4
        for (int r = 0; r < 16; ++r) { const u32x4 x3 = *(const u32x4*)(p0 + (t0 + r) * N_IN0 + c);
            float acc[8];
#define TAPS(j, f, m) (bias[j] + w[0][j] * f(x0.m) + w[1][j] * f(x1.m) + w[2][j] * f(x2.m) + w[3][j] * f(x3.m))
            acc[0] = TAPS(0, bf_lo, x); acc[1] = TAPS(1, bf_hi, x); acc[2] = TAPS(2, bf_lo, y); acc[3] = TAPS(3, bf_hi, y);
            acc[4] = TAPS(4, bf_lo, z); acc[5] = TAPS(5, bf_hi, z); acc[6] = TAPS(6, bf_lo, w); acc[7] = TAPS(7, bf_hi, w);
#undef TAPS
            u32x4 o; o.x = cvt_pk_bf16(acc[0], acc[1]); o.y = cvt_pk_bf16(acc[2], acc[3]); o.z = cvt_pk_bf16(acc[4], acc[5]); o.w = cvt_pk_bf16(acc[6], acc[7]);
            *(u32x4*)(xc + (t0 + r) * 1024 + c) = o;
            x0 = x1; x1 = x2; x2 = x3; } }
}

struct SrcRgGates {
    const char* xc; const char* w; int total;
    __device__ __forceinline__ bool next(int i, UnitD& u) const { const int id = BID + i * NBLK; if (id >= total) return false; u.t0 = id & 63; u.t1 = id >> 6; u.t2 = 0;
        u.gA = xc + ((size_t)u.t0 * BM * 1024 + u.t1 * 128) * 2; u.gB = w + (size_t)u.t1 * 256 * 128 * 2; return true; }
    __device__ __forceinline__ void va(const UnitD&, unsigned (&v)[2][2]) const { offs_direct(v, 1024, false); }
    __device__ __forceinline__ void vb(unsigned (&v)[2][2]) const { offs_direct(v, 128, true); }
};
__device__ __forceinline__ void phase_rg_gates(const Args& a, LAS unsigned char* lds) {
    SrcRgGates S{(const char*)(a.ws + WS_XC), (const char*)(a.ws + WS_WGATES), 64 * 8};
    EpiRgGates E{(bf16_t*)(a.ws + WS_A), (bf16_t*)(a.ws + WS_U), (const bf16_t*)(a.ws + WS_XC), a.in[8], a.in[10], a.in[11]};
    int nt = 2; asm volatile("" : "+s"(nt));
    gemm_stream<false, false>(lds, S, nt, E);
}

__device__ __forceinline__ void phase_rg_scan(const Args& a, LAS unsigned char* lds) {
    const bf16_t* LA = (const bf16_t*)(a.ws + WS_A); const bf16_t* U = (const bf16_t*)(a.ws + WS_U);
    const bf16_t* p0 = (const bf16_t*)(a.ws + WS_PROJ); bf16_t* Y = (bf16_t*)(a.ws + WS_Y);
    LAS float* sP = (LAS float*)lds; LAS float* sH = sP + 4096; LAS float* gP = sH + 4096; LAS float* gH = gP + 512; LAS float* gC = gH + 512;
    const int tid = TIDX, seg = tid >> 1, c8 = (tid & 1) * 8;
    for (int blk = BID; blk < NB_ * 64; blk += NBLK) { const int b = blk >> 6, c = (blk & 63) * 16 + c8;
        const size_t base = (((size_t)blk * S_ + seg * 16) << 4) + c8;
        float P[8], H[8];
#pragma unroll
        for (int j = 0; j < 8; ++j) { P[j] = 1.f; H[j] = 0.f; }
#pragma unroll 4
        for (int s = 0; s < 16; ++s) { const u32x4 lw = *(const u32x4*)(LA + base + (size_t)s * 16), uw = *(const u32x4*)(U + base + (size_t)s * 16);
            const float la[8] = {bf_lo(lw.x), bf_hi(lw.x), bf_lo(lw.y), bf_hi(lw.y), bf_lo(lw.z), bf_hi(lw.z), bf_lo(lw.w), bf_hi(lw.w)};
            const float uu[8] = {bf_lo(uw.x), bf_hi(uw.x), bf_lo(uw.y), bf_hi(uw.y), bf_lo(uw.z), bf_hi(uw.z), bf_lo(uw.w), bf_hi(uw.w)};
#pragma unroll
            for (int j = 0; j < 8; ++j) { const float av = __expf(la[j]); H[j] = av * H[j] + uu[j]; P[j] *= av; } }
        __syncthreads();
#pragma unroll
        for (int j = 0; j < 8; ++j) { sP[seg * 16 + c8 + j] = P[j]; sH[seg * 16 + c8 + j] = H[j]; }
        __syncthreads();
        { const int ch = tid & 15, grp = tid >> 4; float p = 1.f, h = 0.f;
#pragma unroll
          for (int q = 0; q < 8; ++q) { const int sgi = grp * 8 + q; h = sP[sgi * 16 + ch] * h + sH[sgi * 16 + ch]; p *= sP[sgi * 16 + ch]; }
          gP[grp * 16 + ch] = p; gH[grp * 16 + ch] = h; }
        __syncthreads();
        if (tid < 16) { float carry = 0.f; for (int g = 0; g < 32; ++g) { gC[g * 16 + tid] = carry; carry = gP[g * 16 + tid] * carry + gH[g * 16 + tid]; } }
        __syncthreads();
        { const int ch = tid & 15, grp = tid >> 4; float h = gC[grp * 16 + ch];
#pragma unroll
          for (int q = 0; q < 8; ++q) { const int sgi = grp * 8 + q; const float pin = sP[sgi * 16 + ch], hin = sH[sgi * 16 + ch]; sH[sgi * 16 + ch] = h; h = pin * h + hin; } }
        __syncthreads();
#pragma unroll
        for (int j = 0; j < 8; ++j) H[j] = sH[seg * 16 + c8 + j];
#pragma unroll 4
        for (int s = 0; s < 16; ++s) { const u32x4 lw = *(const u32x4*)(LA + base + (size_t)s * 16), uw = *(const u32x4*)(U + base + (size_t)s * 16);
            const size_t t = (size_t)b * S_ + seg * 16 + s; const u32x4 gw = *(const u32x4*)(p0 + t * N_IN0 + 1024 + c);
            const float la[8] = {bf_lo(lw.x), bf_hi(lw.x), bf_lo(lw.y), bf_hi(lw.y), bf_lo(lw.z), bf_hi(lw.z), bf_lo(lw.w), bf_hi(lw.w)};
            const float uu[8] = {bf_lo(uw.x), bf_hi(uw.x), bf_lo(uw.y), bf_hi(uw.y), bf_lo(uw.z), bf_hi(uw.z), bf_lo(uw.w), bf_hi(uw.w)};
            const float gg[8] = {bf_lo(gw.x), bf_hi(gw.x), bf_lo(gw.y), bf_hi(gw.y), bf_lo(gw.z), bf_hi(gw.z), bf_lo(gw.w), bf_hi(gw.w)};
            float y[8];
#pragma unroll
            for (int j = 0; j < 8; ++j) { H[j] = __expf(la[j]) * H[j] + uu[j]; y[j] = H[j] * gelu_tanh(gg[j]); }
            u32x4 o; o.x = cvt_pk_bf16(y[0], y[1]); o.y = cvt_pk_bf16(y[2], y[3]); o.z = cvt_pk_bf16(y[4], y[5]); o.w = cvt_pk_bf16(y[6], y[7]);
            *(u32x4*)(Y + t * D_ + c) = o; }
    }
}

typedef short s16x4 __attribute__((ext_vector_type(4)));
__device__ __forceinline__ f32x4 mfma32(bf16x8 a, bf16x8 b, f32x4 c) { return __builtin_amdgcn_mfma_f32_16x16x32_bf16(a, b, c, 0, 0, 0); }
__device__ __forceinline__ bf16x8 lds_frag(LAS const unsigned char* p) { return *(const LAS bf16x8*)p; }
__device__ __forceinline__ s16x4 lds_tr4(LAS const unsigned char* p) { return __builtin_amdgcn_ds_read_tr16_b64_v4i16((LAS s16x4*)p); }
__device__ __forceinline__ bf16x8 lds_tr8(LAS const unsigned char* p, int rowskip_bytes) {
    const s16x4 lo = lds_tr4(p), hi = lds_tr4(p + rowskip_bytes); return __builtin_shufflevector(lo, hi, 0, 1, 2, 3, 4, 5, 6, 7); }
__device__ __forceinline__ bf16x8 pack8(const f32x4& lo, const f32x4& hi) { u32x4 w; w.x = cvt_pk_bf16(lo[0], lo[1]); w.y = cvt_pk_bf16(lo[2], lo[3]); w.z = cvt_pk_bf16(hi[0], hi[1]); w.w = cvt_pk_bf16(hi[2], hi[3]); return __builtin_bit_cast(bf16x8, w); }
constexpr int RSB = 272;

constexpr size_t WS_HQ = WS_O;
constexpr size_t WS_HA = WS_HQ + (size_t)2048 * 64 * 128 * 2;
constexpr size_t WS_HG = WS_HA + (size_t)2048 * 8 * 512 * 2;
constexpr size_t WS_HS = WS_HG + (size_t)2048 * 128 * 128 * 2;
constexpr size_t WS_HD = WS_HS + (size_t)2048 * 128 * 128 * 2;
static_assert(WS_HD + (size_t)2048 * 128 * 4 <= WS_TAIL, "hgrn overlay");

__device__ __forceinline__ void phase_hg1(const Args& a, LAS unsigned char* lds) {
    const bf16_t* p0 = (const bf16_t*)(a.ws + WS_PROJ); const float* flog = (const float*)(a.ws + WS_FLOG); const float* lb = (const float*)(a.ws + WS_LB);
    bf16_t* QG = (bf16_t*)(a.ws + WS_HQ); bf16_t* AG = (bf16_t*)(a.ws + WS_HA); bf16_t* GG = (bf16_t*)(a.ws + WS_HG); float* DG = (float*)(a.ws + WS_HD);
    constexpr int SEG = 0, QT = 4096, KT = QT + 64 * RSB, KH = KT + 64 * RSB, VS = KH + 64 * RSB;
    const int tid = TIDX, wid = tid >> 6, lane = tid & 63, I = lane & 15, G = lane >> 4, k2 = 2 * lane, sg = wid;
    LAS float* seg = (LAS float*)(lds + SEG);
    u32x4 pvv[2]; f32x2 pz[8]; unsigned pqw[8];
#define HG1_LOAD(it_) do { const int bh_ = (it_) >> 6, ck_ = (it_) & 63, h_ = bh_ & 7; const size_t t0_ = (size_t)(bh_ >> 3) * S_ + ck_ * 64; \
        _Pragma("unroll") for (int i = 0; i < 2; ++i) { const int c = tid + i * 512, s_ = c >> 4, v8 = (c & 15) * 8; pvv[i] = *(const u32x4*)(p0 + (t0_ + s_) * N_IN0 + 4096 + h_ * 128 + v8); } \
        _Pragma("unroll") for (int i = 0; i < 8; ++i) { const size_t t_ = t0_ + sg * 8 + i; pz[i] = *(const f32x2*)(flog + t_ * 1024 + h_ * 128 + k2); pqw[i] = *(const unsigned*)(p0 + t_ * N_IN0 + 2048 + h_ * 128 + k2); } } while (0)
    if (BID < 2048) HG1_LOAD(BID);
    for (int item = BID; item < 2048; item += NBLK) { const int bh = item >> 6, h = bh & 7;
        LDS_BARRIER();
#pragma unroll
        for (int i = 0; i < 2; ++i) { const int c = tid + i * 512, s = c >> 4, v8 = (c & 15) * 8; *(LAS u32x4*)(lds + VS + s * RSB + v8 * 2) = pvv[i]; }
        const f32x2 l2 = *(const f32x2*)(lb + h * 128 + k2);
        float f[8][2], cb[8][2]; unsigned qw[8]; float c0 = 0.f, c1 = 0.f;
#pragma unroll
        for (int i = 0; i < 8; ++i) { const f32x2 z = pz[i]; qw[i] = pqw[i];
            f[i][0] = l2[0] + (1.0f - l2[0]) * sigmoidf_(z[0]); f[i][1] = l2[1] + (1.0f - l2[1]) * sigmoidf_(z[1]);
            c0 += __logf(f[i][0]); c1 += __logf(f[i][1]); cb[i][0] = c0; cb[i][1] = c1; }
        *(LAS f32x2*)(seg + sg * 128 + k2) = (f32x2){c0, c1};
        if (item + NBLK < 2048) HG1_LOAD(item + NBLK);
        LDS_BARRIER();
        float off0 = 0.f, off1 = 0.f, tot0 = 0.f, tot1 = 0.f;
#pragma unroll
        for (int s2 = 0; s2 < 8; ++s2) { const f32x2 v = *(const LAS f32x2*)(seg + s2 * 128 + k2); tot0 += v[0]; tot1 += v[1]; if (s2 < sg) { off0 += v[0]; off1 += v[1]; } }
        const float et0 = __expf(tot0), et1 = __expf(tot1);
#pragma unroll
        for (int i = 0; i < 8; ++i) { const int t = sg * 8 + i;
            const float e0 = __expf(cb[i][0] + off0), e1 = __expf(cb[i][1] + off1), r0 = __builtin_amdgcn_rcpf(e0), r1 = __builtin_amdgcn_rcpf(e1), km0 = 1.0f - f[i][0], km1 = 1.0f - f[i][1];
            const unsigned qt = cvt_pk_bf16(siluf_(bf_lo(qw[i])) * e0, siluf_(bf_hi(qw[i])) * e1);
            *(LAS unsigned*)(lds + QT + t * RSB + k2 * 2) = qt; *(unsigned*)(QG + ((size_t)item * 64 + t) * 128 + k2) = qt;
            *(LAS unsigned*)(lds + KT + t * RSB + k2 * 2) = cvt_pk_bf16(km0 * r0, km1 * r1);
            *(LAS unsigned*)(lds + KH + t * RSB + k2 * 2) = cvt_pk_bf16(km0 * r0 * et0, km1 * r1 * et1); }
        if (sg == 0) *(f32x2*)(DG + (size_t)item * 128 + k2) = (f32x2){et0, et1};
        LDS_BARRIER();
        { const int tt = wid & 3, sp = wid >> 2;
          bf16x8 qf[4];
#pragma unroll
          for (int ks = 0; ks < 4; ++ks) qf[ks] = lds_frag(lds + QT + (16 * tt + I) * RSB + (32 * ks + 8 * G) * 2);
          f32x4 acc[2];
#pragma unroll
          for (int hh = 0; hh < 2; ++hh) { const int st = 2 * sp + hh; acc[hh] = (f32x4){0.f, 0.f, 0.f, 0.f};
              if (st <= tt) {
#pragma unroll
                  for (int ks = 0; ks < 4; ++ks) acc[hh] = mfma32(lds_frag(lds + KT + (16 * st + I) * RSB + (32 * ks + 8 * G) * 2), qf[ks], acc[hh]);
#pragma unroll
                  for (int r = 0; r < 4; ++r) if (16 * st + 4 * G + r > 16 * tt + I) acc[hh][r] = 0.f; } }
          *(bf16x8*)(AG + (((size_t)item * 4 + tt) * 2 + sp) * 512 + lane * 8) = pack8(acc[0], acc[1]); }
        { const int kt = wid, q = I >> 2, p = I & 3;
          bf16x8 ka[2];
#pragma unroll
          for (int ks = 0; ks < 2; ++ks) ka[ks] = lds_tr8(lds + KH + (32 * ks + 8 * G + q) * RSB + (16 * kt + 4 * p) * 2, 4 * RSB);
#pragma unroll
          for (int vt = 0; vt < 8; ++vt) { f32x4 acc = (f32x4){0.f, 0.f, 0.f, 0.f};
#pragma unroll
              for (int ks = 0; ks < 2; ++ks) acc = mfma32(ka[ks], lds_tr8(lds + VS + (32 * ks + 8 * G + q) * RSB + (16 * vt + 4 * p) * 2, 4 * RSB), acc);
              u32x2 w; w.x = cvt_pk_bf16(acc[0], acc[1]); w.y = cvt_pk_bf16(acc[2], acc[3]);
              *(u32x2*)(GG + ((size_t)item * 128 + 16 * vt + I) * 128 + 16 * kt + 4 * G) = w; } }
    }
#undef HG1_LOAD
}

__device__ __forceinline__ void phase_hg2(const Args& a) {
    const bf16_t* GG = (const bf16_t*)(a.ws + WS_HG); const float* DG = (const float*)(a.ws + WS_HD); bf16_t* SG = (bf16_t*)(a.ws + WS_HS);
    for (int gid = BID * NTHREADS + TIDX; gid < 32 * 4096; gid += NBLK * NTHREADS) { const int bh = gid >> 12, e = gid & 4095, v = e >> 5, k4 = (e & 31) * 4;
        f32x4 S = (f32x4){0.f, 0.f, 0.f, 0.f};
        for (int n = 0; n < 64; ++n) { const size_t item = (size_t)bh * 64 + n, o = (item * 128 + v) * 128 + k4;
            u32x2 w; w.x = cvt_pk_bf16(S[0], S[1]); w.y = cvt_pk_bf16(S[2], S[3]); *(u32x2*)(SG + o) = w;
            const f32x4 d = *(const f32x4*)(DG + item * 128 + k4); const u32x2 g = *(const u32x2*)(GG + o);
            S[0] = d[0] * S[0] + bf_lo(g.x); S[1] = d[1] * S[1] + bf_hi(g.x); S[2] = d[2] * S[2] + bf_lo(g.y); S[3] = d[3] * S[3] + bf_hi(g.y); } }
}

__device__ __forceinline__ void phase_hg3(const Args& a, LAS unsigned char* lds) {
    const bf16_t* p0 = (const bf16_t*)(a.ws + WS_PROJ); const bf16_t* QG = (const bf16_t*)(a.ws + WS_HQ); const bf16_t* AG = (const bf16_t*)(a.ws + WS_HA); const bf16_t* SG = (const bf16_t*)(a.ws + WS_HS);
    bf16_t* Y = (bf16_t*)(a.ws + WS_Y); const float* gain = a.in[13];
    constexpr int ST = 0, QT = 128 * RSB, VS = QT + 64 * RSB, PART = VS + 64 * RSB;
    const int tid = TIDX, wid = tid >> 6, lane = tid & 63, I = lane & 15, G = lane >> 4, q = I >> 2, p = I & 3;
    LAS float* part = (LAS float*)(lds + PART);
    const int tt = wid & 3, vh = wid >> 2;
    u32x4 ps[4], pq2[2], pv2[2]; bf16x8 paf[2];
#define HG3_LOAD(it_) do { const int bh_ = (it_) >> 6, ck_ = (it_) & 63; const size_t t0_ = (size_t)(bh_ >> 3) * S_ + ck_ * 64; const int h_ = bh_ & 7; \
        _Pragma("unroll") for (int i = 0; i < 4; ++i) { const int c = tid + i * 512, v = c >> 4, k8 = (c & 15) * 8; ps[i] = *(const u32x4*)(SG + ((size_t)(it_) * 128 + v) * 128 + k8); } \
        _Pragma("unroll") for (int i = 0; i < 2; ++i) { const int c = tid + i * 512, s_ = c >> 4, c8 = (c & 15) * 8; pq2[i] = *(const u32x4*)(QG + ((size_t)(it_) * 64 + s_) * 128 + c8); pv2[i] = *(const u32x4*)(p0 + (t0_ + s_) * N_IN0 + 4096 + h_ * 128 + c8); } \
        _Pragma("unroll") for (int sp = 0; sp < 2; ++sp) paf[sp] = *(const bf16x8*)(AG + (((size_t)(it_) * 4 + tt) * 2 + sp) * 512 + lane * 8); } while (0)
    if (BID < 2048) HG3_LOAD(BID);
    for (int item = BID; item < 2048; item += NBLK) { const int bh = item >> 6, ck = item & 63, b = bh >> 3, h = bh & 7; const size_t t0 = (size_t)b * S_ + ck * 64;
        LDS_BARRIER();
#pragma unroll
        for (int i = 0; i < 4; ++i) { const int c = tid + i * 512, v = c >> 4, k8 = (c & 15) * 8; *(LAS u32x4*)(lds + ST + v * RSB + k8 * 2) = ps[i]; }
#pragma unroll
        for (int i = 0; i < 2; ++i) { const int c = tid + i * 512, s2 = c >> 4, c8 = (c & 15) * 8; *(LAS u32x4*)(lds + QT + s2 * RSB + c8 * 2) = pq2[i]; *(LAS u32x4*)(lds + VS + s2 * RSB + c8 * 2) = pv2[i]; }
        bf16x8 af[2]; af[0] = paf[0]; af[1] = paf[1];
        if (item + NBLK < 2048) HG3_LOAD(item + NBLK);
        u32x2 zwp[4];
#pragma unroll
        for (int vi = 0; vi < 4; ++vi) zwp[vi] = *(const u32x2*)(p0 + (t0 + 16 * tt + I) * N_IN0 + 5120 + h * 128 + 16 * (4 * vh + vi) + 4 * G);
        LDS_BARRIER();
        bf16x8 qf[4];
#pragma unroll
        for (int ks = 0; ks < 4; ++ks) qf[ks] = lds_frag(lds + QT + (16 * tt + I) * RSB + (32 * ks + 8 * G) * 2);
        f32x4 acc[4]; float ss = 0.f;
#pragma unroll
        for (int vi = 0; vi < 4; ++vi) { const int vt = 4 * vh + vi; acc[vi] = (f32x4){0.f, 0.f, 0.f, 0.f};
#pragma unroll
            for (int ks = 0; ks < 4; ++ks) acc[vi] = mfma32(lds_frag(lds + ST + (16 * vt + I) * RSB + (32 * ks + 8 * G) * 2), qf[ks], acc[vi]);
#pragma unroll
            for (int sp = 0; sp < 2; ++sp) acc[vi] = mfma32(lds_tr8(lds + VS + (32 * sp + 4 * G + q) * RSB + (16 * vt + 4 * p) * 2, 16 * RSB), af[sp], acc[vi]);
            ss += acc[vi][0] * acc[vi][0] + acc[vi][1] * acc[vi][1] + acc[vi][2] * acc[vi][2] + acc[vi][3] * acc[vi][3]; }
        ss += __shfl_xor(ss, 16); ss += __shfl_xor(ss, 32);
        if (G == 0) part[wid * 16 + I] = ss;
        LDS_BARRIER();
        const float rstd = rsqrtf((part[wid * 16 + I] + part[(wid ^ 4) * 16 + I]) * (1.0f / 128.0f) + 1e-6f);
        const size_t t = t0 + 16 * tt + I;
#pragma unroll
        for (int vi = 0; vi < 4; ++vi) { const int c = h * 128 + 16 * (4 * vh + vi) + 4 * G;
            const f32x4 gn = *(const f32x4*)(gain + c); const u32x2 zw = zwp[vi];
            const float o0 = acc[vi][0] * rstd * gn[0] * siluf_(bf_lo(zw.x)), o1 = acc[vi][1] * rstd * gn[1] * siluf_(bf_hi(zw.x)), o2 = acc[vi][2] * rstd * gn[2] * siluf_(bf_lo(zw.y)), o3 = acc[vi][3] * rstd * gn[3] * siluf_(bf_hi(zw.y));
            u32x2 w; w.x = cvt_pk_bf16(o0, o1); w.y = cvt_pk_bf16(o2, o3); *(u32x2*)(Y + t * D_ + 1024 + c) = w; }
    }
#undef HG3_LOAD
}

__device__ __forceinline__ void phase_gdn_norm(const Args& a) {
    const bf16_t* O = (const bf16_t*)(a.ws + WS_O); const bf16_t* pj = (const bf16_t*)(a.ws + WS_PROJ); unsigned char* Y = a.ws + WS_Y; const float* gain = a.in[19];
    const int lane = TIDX & 63, wid = TIDX >> 6, gc = (lane & 15) * 8;
    const f32x4 g0 = *(const f32x4*)(gain + gc), g1 = *(const f32x4*)(gain + gc + 4);
    for (int row = BID * 8 + wid; row < T_; row += NBLK * 8) {
#pragma unroll 4
        for (int i = 0; i < 8; ++i) { const int c = (i * 64 + lane) * 8;
            const u32x4 ow = *(const u32x4*)(O + (size_t)row * 4096 + c), zw = *(const u32x4*)(pj + (size_t)row * N_IN1P + 8192 + c);
            const float o[8] = {bf_lo(ow.x), bf_hi(ow.x), bf_lo(ow.y), bf_hi(ow.y), bf_lo(ow.z), bf_hi(ow.z), bf_lo(ow.w), bf_hi(ow.w)};
            const float z[8] = {bf_lo(zw.x), bf_hi(zw.x), bf_lo(zw.y), bf_hi(zw.y), bf_lo(zw.z), bf_hi(zw.z), bf_lo(zw.w), bf_hi(zw.w)};
            float ss = 0.f;
#pragma unroll
            for (int q = 0; q < 8; ++q) ss += o[q] * o[q];
            ss = row16_sum(ss);
            const float rstd = rsqrtf(ss * (1.0f / 128.0f) + 1e-6f);
            float y[8];
#pragma unroll
            for (int q = 0; q < 8; ++q) y[q] = o[q] * rstd * (q < 4 ? g0[q & 3] : g1[q & 3]) * siluf_(z[q]);
            u32x2 w; w.x = pk_fp8x4(y[0], y[1], y[2], y[3]); w.y = pk_fp8x4(y[4], y[5], y[6], y[7]);
            *(u32x2*)(Y + (size_t)row * 4096 + c) = w; }
    }
}

template <bool FP8>
__device__ __forceinline__ void phase_gemm_out(const Args& a, LAS unsigned char* lds, int K, const void* w, const float* xin) {
    const int eb = FP8 ? 1 : 2;
    SrcGrid S{(const char*)(a.ws + WS_Y), (const char*)w, (size_t)BM * K * eb, (size_t)BM * K * eb, 64, 64 * 8, K * eb / 2, K * eb / 2};
    EpiResid E{(bf16_t*)(a.ws + WS_X), xin, (const bf16_t*)(a.ws + WS_X), FP8 ? 1.0f / W8_SCALE : 1.0f};
    gemm_stream<false, FP8>(lds, S, K * eb / 128, E);
}

struct SrcRouter {
    const char* h; const char* w;
    __device__ __forceinline__ bool next(int i, UnitD& u) const { const int id = BID + i * NBLK; if (id >= 256) return false; u.t0 = id & 63; u.t1 = id >> 6; u.t2 = 0;
        u.gA = h + ((size_t)u.t0 * BM * D_ + u.t1 * 512) * 2; u.gB = w + (size_t)u.t1 * 512 * 2; return true; }
    __device__ __forceinline__ void va(const UnitD&, unsigned (&v)[2][2]) const { offs_direct(v, D_, false); }
    __device__ __forceinline__ void vb(unsigned (&v)[2][2]) const { offs_direct(v, D_, true); }
};
struct EpiLogitsQ {
    float* O;
    __device__ __forceinline__ void operator()(const Acc& acc, const UnitD& u, int wr, int wc, int fr, int fq) const { store_f32_tile(acc, O + ((size_t)u.t1 * T_ + (size_t)u.t0 * BM) * 128, nullptr, 128, 128, wr, wc, fr, fq); }
};
__device__ __forceinline__ void phase_gemm_router(const Args& a, LAS unsigned char* lds, int layer) {
    SrcRouter S{(const char*)(a.ws + WS_H), (const char*)(a.ws + WS_WRT) + (size_t)layer * 256 * D_ * 2};
    EpiLogitsQ E{(float*)(a.ws + WS_O)};
    gemm_stream<false, false>(lds, S, 512 / BK, E);
}

__device__ __forceinline__ void phase_route(const Args& a, int layer) {
    const float* lg = (const float*)(a.ws + WS_O); const float* bg = a.in[22] + layer * 8; const float* be = a.in[24] + layer * 64;
    int* cnt = (int*)(a.ws + WS_CTL + CTL_CNT) + layer * 64;
    int* eid = (int*)(a.ws + WS_EID); int* slot = (int*)(a.ws + WS_SLOT); float* gate = (float*)(a.ws + WS_GATE); int* rowmap = (int*)(a.ws + WS_ROWMAP);
    const int gtid = BID * NTHREADS + TIDX, gsz = NBLK * NTHREADS;
    for (int i = gtid; i < MPAD; i += gsz) rowmap[i] = 0;
    for (int t = gtid; t < T_; t += gsz) {
        f32x4 ga = (f32x4){0.f, 0.f, 0.f, 0.f}, gb = ga;
#pragma unroll
        for (int kq = 0; kq < 4; ++kq) { ga += *(const f32x4*)(lg + ((size_t)kq * T_ + t) * 128); gb += *(const f32x4*)(lg + ((size_t)kq * T_ + t) * 128 + 4); }
        const float gl[8] = {ga[0] + bg[0], ga[1] + bg[1], ga[2] + bg[2], ga[3] + bg[3], gb[0] + bg[4], gb[1] + bg[5], gb[2] + bg[6], gb[3] + bg[7]};
        float mx = -3.0e38f; int gi = 0;
#pragma unroll
        for (int j = 0; j < 8; ++j) if (gl[j] > mx) { mx = gl[j]; gi = j; }
        float se = 0.f;
#pragma unroll
        for (int j = 0; j < 8; ++j) se += __expf(gl[j] - mx);
        const float gp = 1.0f / se;
        f32x4 ea = *(const f32x4*)(be + gi * 8), eb = *(const f32x4*)(be + gi * 8 + 4);
#pragma unroll
        for (int kq = 0; kq < 4; ++kq) { ea += *(const f32x4*)(lg + ((size_t)kq * T_ + t) * 128 + 8 + gi * 8); eb += *(const f32x4*)(lg + ((size_t)kq * T_ + t) * 128 + 12 + gi * 8); }
        const float el[8] = {ea[0], ea[1], ea[2], ea[3], eb[0], eb[1], eb[2], eb[3]};
        float l1 = -3.0e38f, l2 = -3.0e38f; int i1 = 0, i2 = 0;
#pragma unroll
        for (int j = 0; j < 8; ++j) { const float v = el[j];
            if (v > l1) { l2 = l1; i2 = i1; l1 = v; i1 = j; } else if (v > l2) { l2 = v; i2 = j; } }
        const float e2 = __expf(l2 - l1), inv = 1.0f / (1.0f + e2);
        const int e0 = gi * 8 + i1, e1 = gi * 8 + i2;
        eid[t * 2] = e0; eid[t * 2 + 1] = e1; gate[t * 2] = inv * gp; gate[t * 2 + 1] = e2 * inv * gp;
        slot[t * 2] = atomicAdd(&cnt[e0], 1); slot[t * 2 + 1] = atomicAdd(&cnt[e1], 1); }
}

__device__ __forceinline__ void phase_rowmap(const Args& a, LAS unsigned char* lds, int layer) {
    const int* cnt = (const int*)(a.ws + WS_CTL + CTL_CNT) + layer * 64; LAS int* ps = (LAS int*)lds;
    int* tinfo = (int*)(a.ws + WS_TINFO) + layer * 512;
    const int* eid = (const int*)(a.ws + WS_EID); const int* slot = (const int*)(a.ws + WS_SLOT); int* posof = (int*)(a.ws + WS_POSOF); int* rowmap = (int*)(a.ws + WS_ROWMAP);
    __syncthreads();
    if (TIDX == 0) { int acc = 0; for (int e = 0; e < 64; ++e) { ps[e] = acc; acc += (cnt[e] + 255) & ~255; } ps[64] = acc; }
    __syncthreads();
    if (BID == 0) { if (TIDX <= 64) tinfo[TIDX] = ps[TIDX]; if (TIDX == 65) tinfo[65] = ps[64] >> 8;
        if (TIDX < 192) { const int p = TIDX * 256; int e = 0; for (int j = 0; j < 64; ++j) if (ps[j + 1] <= p) e = j + 1; tinfo[128 + TIDX] = e < 64 ? e : 63; } }
    for (int i = BID * NTHREADS + TIDX; i < T_ * 2; i += NBLK * NTHREADS) { const int p = ps[eid[i]] + slot[i]; posof[i] = p; rowmap[p] = i >> 1; }
    __syncthreads();
}

struct SrcMoeUp {
    const char* h; const char* wg; const int* tinfo; const int* rowmap; int total;
    __device__ __forceinline__ bool next(int i, UnitD& u) const { const int id = BID + i * NBLK; if (id >= total) return false; u.t0 = id >> 2; u.t1 = id & 3;
        u.t2 = __builtin_amdgcn_readfirstlane(tinfo[128 + u.t0]); u.gA = h; u.gB = wg + ((size_t)u.t2 * DEXP + u.t1 * 128) * D_; return true; }
    __device__ __forceinline__ void va(const UnitD& u, unsigned (&v)[2][2]) const { int R0, C0; stage_pos(TIDX, R0, C0);
#pragma unroll
        for (int hh = 0; hh < 2; ++hh)
#pragma unroll
            for (int i = 0; i < 2; ++i) v[hh][i] = (unsigned)(rowmap[u.t0 * 256 + hh * 128 + R0 + 64 * i] * D_ + C0 * 2); }
    __device__ __forceinline__ void vb(unsigned (&v)[2][2]) const { int R0, C0; stage_pos(TIDX, R0, C0);
#pragma unroll
        for (int i = 0; i < 2; ++i) { const int Rr = perm_row(R0 + 64 * i); v[0][i] = (unsigned)(Rr * D_ + C0 * 2); v[1][i] = (unsigned)(WS_WU - WS_WG) + (unsigned)(Rr * D_ + C0 * 2); } }
};
__device__ __forceinline__ void phase_moe_up(const Args& a, LAS unsigned char* lds, int layer) {
    const int* tinfo = (const int*)(a.ws + WS_TINFO) + layer * 512;
    const int ntm = __builtin_amdgcn_readfirstlane(tinfo[65]);
    SrcMoeUp S{(const char*)(a.ws + WS_H8), (const char*)(a.ws + WS_WG), tinfo, (const int*)(a.ws + WS_ROWMAP), ntm * 4};
    EpiSwiGLU E{a.ws + WS_ACT};
    gemm_stream<true, true>(lds, S, D_ / 128, E);
}

struct SrcMoeDown {
    const char* act; const char* wd; const int* tinfo; int total;
    __device__ __forceinline__ bool next(int i, UnitD& u) const { const int id = BID + i * NBLK; if (id >= total) return false; u.t0 = id >> 3; u.t1 = id & 7;
        u.t2 = __builtin_amdgcn_readfirstlane(tinfo[128 + u.t0]); u.gA = act + (size_t)u.t0 * BM * DEXP; u.gB = wd + ((size_t)u.t2 * D_ + u.t1 * BM) * DEXP; return true; }
    __device__ __forceinline__ void va(const UnitD&, unsigned (&v)[2][2]) const { offs_direct(v, DEXP / 2, false); }
    __device__ __forceinline__ void vb(unsigned (&v)[2][2]) const { offs_direct(v, DEXP / 2, true); }
};
__device__ __forceinline__ void phase_moe_down(const Args& a, LAS unsigned char* lds, int layer) {
    const int* tinfo = (const int*)(a.ws + WS_TINFO) + layer * 512; const int ntm = __builtin_amdgcn_readfirstlane(tinfo[65]);
    SrcMoeDown S{(const char*)(a.ws + WS_ACT), (const char*)(a.ws + WS_WD), tinfo, ntm * 8};
    EpiDown E{a.ws + WS_YMOE};
    gemm_stream<false, true>(lds, S, DEXP / 128, E);
}

struct SrcIn1Tail {
    const char* h; const char* w;
    __device__ __forceinline__ bool next(int i, UnitD& u) const { const int id = BID + i * NBLK; if (id >= 256) return false; u.t0 = id & 63; u.t1 = id >> 6; u.t2 = 0;
        u.gA = h + (size_t)u.t0 * BM * D_ + u.t1 * 512; u.gB = w + (size_t)48 * BM * D_ + u.t1 * 512; return true; }
    __device__ __forceinline__ void va(const UnitD&, unsigned (&v)[2][2]) const { offs_direct(v, D_ / 2, false); }
    __device__ __forceinline__ void vb(unsigned (&v)[2][2]) const { offs_direct(v, D_ / 2, true); }
};
struct EpiTailQ {
    float* O;
    __device__ __forceinline__ void operator()(const Acc& acc, const UnitD& u, int wr, int wc, int fr, int fq) const { store_f32_tile(acc, O + ((size_t)u.t1 * T_ + (size_t)u.t0 * BM) * 64, nullptr, 64, 64, wr, wc, fr, fq, 1.0f / W8_SCALE); }
};
__device__ __forceinline__ void phase_gemm_in1(const Args& a, LAS unsigned char* lds) {
    SrcGrid S{(const char*)(a.ws + WS_H8), (const char*)(a.ws + WS_WIN1T), (size_t)BM * D_, (size_t)BM * D_, 64, 64 * 48, D_ / 2, D_ / 2};
    EpiProj E{(bf16_t*)(a.ws + WS_PROJ), N_IN1P, nullptr, 64, 48, 48, 64, 1.0f / W8_SCALE};
    gemm_stream<false, true>(lds, S, D_ / 128, E);
}
__device__ __forceinline__ void phase_gemm_in1_tail(const Args& a, LAS unsigned char* lds) {
    SrcIn1Tail S{(const char*)(a.ws + WS_H8), (const char*)(a.ws + WS_WIN1T)};
    EpiTailQ E{(float*)(a.ws + WS_O)};
    int nt = 4; asm volatile("" : "+s"(nt));
    gemm_stream<false, true>(lds, S, nt, E);
}

__device__ __forceinline__ void phase_gdn_conv(const Args& a) {
    const bf16_t* p1 = (const bf16_t*)(a.ws + WS_PROJ); bf16_t* qc = (bf16_t*)(a.ws + WS_QKVC); const float* cw = a.in[16];
    const int gtid = BID * NTHREADS + TIDX, gsz = NBLK * NTHREADS;
    for (int it = gtid; it < 1024 * (T_ / 128); it += gsz) { const int c = (it & 1023) * 8, seg = it >> 10; const size_t t0 = (size_t)seg * 128;
        float w[4][8];
#pragma unroll
        for (int k = 0; k < 4; ++k) { const f32x4 w0 = *(const f32x4*)(cw + k * 8192 + c), w1 = *(const f32x4*)(cw + k * 8192 + c + 4);
            w[k][0] = w0[0]; w[k][1] = w0[1]; w[k][2] = w0[2]; w[k][3] = w0[3]; w[k][4] = w1[0]; w[k][5] = w1[1]; w[k][6] = w1[2]; w[k][7] = w1[3]; }
        u32x4 x0 = (u32x4){0u, 0u, 0u, 0u}, x1 = x0, x2 = x0;
        if ((t0 & (S_ - 1)) != 0) { x0 = *(const u32x4*)(p1 + (t0 - 3) * N_IN1P + c); x1 = *(const u32x4*)(p1 + (t0 - 2) * N_IN1P + c); x2 = *(const u32x4*)(p1 + (t0 - 1) * N_IN1P + c); }
        const float qsc = c < 2048 ? 0.08838834764831845f : 1.0f;
        u32x4 xa[8];
#pragma unroll
        for (int j = 0; j < 8; ++j) xa[j] = *(const u32x4*)(p1 + (t0 + j) * N_IN1P + c);
#pragma unroll 1
        for (int r0 = 0; r0 < 128; r0 += 8) { u32x4 xb[8];
#pragma unroll
            for (int j = 0; j < 8; ++j) xb[j] = xa[j];
            if (r0 + 8 < 128) {
#pragma unroll
                for (int j = 0; j < 8; ++j) xb[j] = *(const u32x4*)(p1 + (t0 + r0 + 8 + j) * N_IN1P + c); }
#pragma unroll
          for (int j8 = 0; j8 < 8; ++j8) { const u32x4 x3 = xa[j8]; const int r = r0 + j8;
            float acc[8];
#define TAPS(j, f, m) (w[0][j] * f(x0.m) + w[1][j] * f(x1.m) + w[2][j] * f(x2.m) + w[3][j] * f(x3.m))
            acc[0] = TAPS(0, bf_lo, x); acc[1] = TAPS(1, bf_hi, x); acc[2] = TAPS(2, bf_lo, y); acc[3] = TAPS(3, bf_hi, y);
            acc[4] = TAPS(4, bf_lo, z); acc[5] = TAPS(5, bf_hi, z); acc[6] = TAPS(6, bf_lo, w); acc[7] = TAPS(7, bf_hi, w);
#undef TAPS
            float ss = 0.f;
#pragma unroll
            for (int j = 0; j < 8; ++j) { acc[j] = siluf_(acc[j]); ss += acc[j] * acc[j]; }
            ss = row16_sum(ss);
            const float sc = c < 4096 ? rsqrtf(ss + 1e-6f) * qsc : 1.0f;
            u32x4 o; o.x = cvt_pk_bf16(acc[0] * sc, acc[1] * sc); o.y = cvt_pk_bf16(acc[2] * sc, acc[3] * sc); o.z = cvt_pk_bf16(acc[4] * sc, acc[5] * sc); o.w = cvt_pk_bf16(acc[6] * sc, acc[7] * sc);
            *(u32x4*)(qc + (t0 + r) * 8192 + c) = o;
            x0 = x1; x1 = x2; x2 = x3; }
#pragma unroll
            for (int j = 0; j < 8; ++j) xa[j] = xb[j]; } }
    const float* tail = (const float*)(a.ws + WS_O); float* bgo = (float*)(a.ws + WS_BG);
    for (int it = gtid; it < T_ * 32; it += gsz) { const int t = it >> 5, hv = it & 31; float tb = 0.f, ta = 0.f;
#pragma unroll
        for (int kq = 0; kq < 4; ++kq) { tb += tail[((size_t)kq * T_ + t) * 64 + hv]; ta += tail[((size_t)kq * T_ + t) * 64 + 32 + hv]; }
        bgo[t * 64 + hv] = sigmoidf_(tb);
        bgo[t * 64 + 32 + hv] = -__expf(a.in[17][hv]) * softplusf_(ta + a.in[18][hv]); }
}

struct MoeTile { const float* src; unsigned char* dst; int lds_, ldd; };
__device__ __forceinline__ MoeTile moe_tile(const Args& a, int g) {
    const int job = g >> 14, r = g & 16383, e = r >> 8, rr = r & 255; MoeTile t;
    typedef __attribute__((address_space(1))) const float* gcf; gcf s25 = (gcf)a.in[25], s26 = (gcf)a.in[26]; asm volatile("" : "+s"(s25), "+s"(s26));
    if (job < 2) { const int ik = rr >> 3, in = rr & 7; t.lds_ = DEXP; t.ldd = D_;
        t.src = (const float*)(job ? s26 : s25) + ((size_t)(NEXP + e) * D_ + ik * 64) * DEXP + in * 64; t.dst = a.ws + (job ? WS_WU : WS_WG) + ((size_t)e * DEXP + in * 64) * D_ + ik * 64; }
    else { const int ik = rr >> 5, in = rr & 31; t.lds_ = D_; t.ldd = DEXP;
        t.src = a.in[27] + ((size_t)(NEXP + e) * DEXP + ik * 64) * D_ + in * 64; t.dst = a.ws + WS_WD + ((size_t)e * D_ + in * 64) * DEXP + ik * 64; }
    return t;
}
__device__ __forceinline__ void moe_tile_load(const MoeTile& t, int tid, f32x4 (&v)[2]) {
#pragma unroll
    for (int i = 0; i < 2; ++i) { const int idx = tid + i * 512, rr = idx >> 4, c4 = (idx & 15) * 4; v[i] = *(const f32x4*)(t.src + (size_t)rr * t.lds_ + c4); }
}
__device__ __forceinline__ void moe_tile_store(const MoeTile& t, int tid, const f32x4 (&v)[2], LAS float* tile) {
#pragma unroll
    for (int i = 0; i < 2; ++i) { const int idx = tid + i * 512, rr = idx >> 4, c4 = (idx & 15) * 4;
        tile[rr * 65 + c4 + 0] = v[i][0]; tile[rr * 65 + c4 + 1] = v[i][1]; tile[rr * 65 + c4 + 2] = v[i][2]; tile[rr * 65 + c4 + 3] = v[i][3]; }
    LDS_BARRIER();
    { const int n = tid >> 3, kg = (tid & 7) * 8; float f[8];
#pragma unroll
      for (int jj = 0; jj < 8; ++jj) f[jj] = tile[(kg + jj) * 65 + n] * W8_SCALE;
      u32x2 w; w.x = pk_fp8x4(f[0], f[1], f[2], f[3]); w.y = pk_fp8x4(f[4], f[5], f[6], f[7]);
      *(u32x2*)(t.dst + (size_t)n * t.ldd + kg) = w; }
    LDS_BARRIER();
}
constexpr int MOE_TILES = 3 * NEXP * 256;

__device__ __forceinline__ f32x4 mfma16(s16x4 a, s16x4 b, f32x4 c) { return __builtin_amdgcn_mfma_f32_16x16x16bf16_1k(a, b, c, 0, 0, 0); }
__device__ __forceinline__ s16x4 pack4(const f32x4& v) { u32x2 w; w.x = cvt_pk_bf16(v[0], v[1]); w.y = cvt_pk_bf16(v[2], v[3]); return __builtin_bit_cast(s16x4, w); }
__device__ __forceinline__ void phase_gdn_chunk(const Args& a, LAS unsigned char* lds) {
    const bf16_t* qc = (const bf16_t*)(a.ws + WS_QKVC); const float* bgi = (const float*)(a.ws + WS_BG); bf16_t* O = (bf16_t*)(a.ws + WS_O);
    constexpr int VRS = 144, KTRS = 136;
    constexpr int KT = 0, QS = KT + 128 * KTRS, WSL = QS + 64 * RSB, QKS = WSL + 64 * RSB, EE = QKS + 2048, EDD = EE + 256, SET = EDD + 256;
    constexpr int STL = 2 * SET, KS = STL + 64 * RSB, VS = KS + 64 * RSB, X2 = VS + 64 * VRS, LS = X2 + 2048, X1 = LS + 4096, GAM = X1 + 2048, BET = GAM + 256, LEND = BET + 256;
    static_assert(LEND <= LDS_XBW, "gdn lds");
    const int wid = __builtin_amdgcn_readfirstlane(TIDX >> 6);
    const int NCK = S_ / 64;
    for (int blk = BID; blk < NB_ * 32 * 2; blk += NBLK) {
        const int grp = (blk & 7) * 8 + (blk >> 5), mem = (blk >> 3) & 3, b = grp >> 4, hk = grp & 15, hv = 2 * hk + (mem >> 1), vhalf = mem & 1;
        __syncthreads();
        if (wid < 4) {
            const int vt = wid;
            f32x4 Sacc[8];
#pragma unroll
            for (int n = 0; n < 8; ++n) Sacc[n] = (f32x4){0.f, 0.f, 0.f, 0.f};
            { const int lane = TIDX & 63;
              for (int i = lane; i < 16 * RSB / 16; i += 64) *(LAS u32x4*)(lds + STL + 16 * vt * RSB + i * 16) = (u32x4){0u, 0u, 0u, 0u}; }
            int lz = TIDX & 63; asm volatile("" : "+v"(lz));
            const int lane = lz, I = lane & 15, G = lane >> 4, q4 = I >> 2, p4 = I & 3;
            for (int it = 0; it <= NCK; ++it) {
                const int set = ((it - 1) & 1) * SET; const size_t t0 = (size_t)b * S_ + (size_t)(it - 1) * 64;
                f32x4 U[4];
                if (it >= 1) {
#pragma unroll
                    for (int sa = 0; sa < 4; ++sa) U[sa] = mfma16(*(const LAS s16x4*)(lds + X2 + ((sa * 16 + I) * 16 + 4 * G) * 2), lds_tr4(lds + VS + (16 * sa + 4 * G + q4) * VRS + (16 * vt + 4 * p4) * 2), (f32x4){0.f, 0.f, 0.f, 0.f});
                    asm volatile("" : "+v"(U[0]), "+v"(U[1]), "+v"(U[2]), "+v"(U[3]) :: "memory");
                }
#pragma unroll
                for (int sa = 0; sa < 4; ++sa) {
                    if (it >= 1) {
                        bf16x8 sf[4];
#pragma unroll
                        for (int ks = 0; ks < 4; ++ks) sf[ks] = lds_frag(lds + STL + (16 * vt + I) * RSB + (32 * ks + 8 * G) * 2);
                        s16x4 kt[8];
#pragma unroll
                        for (int dt = 0; dt < 8; ++dt) kt[dt] = *(const LAS s16x4*)(lds + set + KT + (16 * dt + I) * KTRS + (16 * sa + 4 * G) * 2);
                        f32x4 dl = U[sa], oq = (f32x4){0.f, 0.f, 0.f, 0.f};
#pragma unroll
                        for (int ks = 0; ks < 4; ++ks) { dl = mfma32(lds_frag(lds + set + WSL + (16 * sa + I) * RSB + (32 * ks + 8 * G) * 2), sf[ks], dl);
                            oq = mfma32(lds_frag(lds + set + QS + (16 * sa + I) * RSB + (32 * ks + 8 * G) * 2), sf[ks], oq); }
                        const s16x4 dfrag = pack4(dl);
                        const f32x4 e4 = *(const LAS f32x4*)(lds + set + EE + (16 * sa + 4 * G) * 4);
                        oq = mfma16(*(const LAS s16x4*)(lds + set + QKS + ((sa * 16 + I) * 16 + 4 * G) * 2), dfrag, oq * e4);
#pragma unroll
                        for (int r = 0; r < 4; ++r) O[(t0 + 16 * sa + 4 * G + r) * 4096 + hv * 128 + vhalf * 64 + 16 * vt + I] = f2bf(oq[r]);
                        const f32x4 ed4 = *(const LAS f32x4*)(lds + set + EDD + (16 * sa + 4 * G) * 4); const float e15 = *(const LAS float*)(lds + set + EE + (16 * sa + 15) * 4);
                        const s16x4 dsc = pack4(dl * ed4);
#pragma unroll
                        for (int dt = 0; dt < 8; ++dt) {
                            Sacc[dt] = mfma16(kt[dt], dsc, Sacc[dt] * e15);
                            *(LAS s16x4*)(lds + STL + (16 * vt + I) * RSB + (16 * dt + 4 * G) * 2) = pack4(Sacc[dt]); }
                    }
                    LDS_BARRIER();
                }
            }
        } else {
            const int pw = wid - 4;
            u32x4 pq[4], pk[4], pv[2]; float pb = 0.f, pg = 0.f;
            { const int ptid = TIDX - 256; const size_t t0 = (size_t)b * S_;
#pragma unroll
              for (int i = 0; i < 4; ++i) { const int c = ptid + i * 256, s2 = c >> 4, c8 = (c & 15) * 8; pq[i] = *(const u32x4*)(qc + (t0 + s2) * 8192 + hk * 128 + c8); pk[i] = *(const u32x4*)(qc + (t0 + s2) * 8192 + 2048 + hk * 128 + c8); }
#pragma unroll
              for (int i = 0; i < 2; ++i) { const int c = ptid + i * 256, s2 = c >> 3, c8 = (c & 7) * 8; pv[i] = *(const u32x4*)(qc + (t0 + s2) * 8192 + 4096 + hv * 128 + vhalf * 64 + c8); }
              if (pw == 1) { pb = bgi[(t0 + ptid - 64) * 64 + hv]; pg = bgi[(t0 + ptid - 64) * 64 + 32 + hv]; } }
            int lz = TIDX & 63; asm volatile("" : "+v"(lz));
            const int lane = lz, ptid = pw * 64 + lane, I = lane & 15, G = lane >> 4, q4 = I >> 2, p4 = I & 3;
            for (int it = 0; it <= NCK; ++it) {
                const int set = (it & 1) * SET; const bool act = it < NCK;
                if (act) {
#pragma unroll
                    for (int i = 0; i < 4; ++i) { const int c = ptid + i * 256, s2 = c >> 4, c8 = (c & 15) * 8; *(LAS u32x4*)(lds + set + QS + s2 * RSB + c8 * 2) = pq[i]; *(LAS u32x4*)(lds + KS + s2 * RSB + c8 * 2) = pk[i]; }
                    if (pw == 1) { float x = pg;
                        x += __builtin_bit_cast(float, __builtin_amdgcn_update_dpp(0, __builtin_bit_cast(int, x), 0x111, 0xf, 0xf, true));
                        x += __builtin_bit_cast(float, __builtin_amdgcn_update_dpp(0, __builtin_bit_cast(int, x), 0x112, 0xf, 0xf, true));
                        x += __builtin_bit_cast(float, __builtin_amdgcn_update_dpp(0, __builtin_bit_cast(int, x), 0x114, 0xf, 0xf, true));
                        x += __builtin_bit_cast(float, __builtin_amdgcn_update_dpp(0, __builtin_bit_cast(int, x), 0x118, 0xf, 0xf, true));
                        const float g15 = __shfl(x, 15, 16);
                        *(LAS float*)(lds + GAM + lane * 4) = x; *(LAS float*)(lds + set + EE + lane * 4) = __expf(x); *(LAS float*)(lds + set + EDD + lane * 4) = __expf(g15 - x); *(LAS float*)(lds + BET + lane * 4) = pb; }
                }
                LDS_BARRIER();
                if (act) { const int sa = pw;
#pragma unroll
                    for (int i = 0; i < 2; ++i) { const int c = ptid + i * 256, s2 = c >> 3, c8 = (c & 7) * 8; *(LAS u32x4*)(lds + VS + s2 * VRS + c8 * 2) = pv[i]; }
                    if (it + 1 < NCK) { const size_t t1 = (size_t)b * S_ + (size_t)(it + 1) * 64;
#pragma unroll
                        for (int i = 0; i < 4; ++i) { const int c = ptid + i * 256, s2 = c >> 4, c8 = (c & 15) * 8; pq[i] = *(const u32x4*)(qc + (t1 + s2) * 8192 + hk * 128 + c8); pk[i] = *(const u32x4*)(qc + (t1 + s2) * 8192 + 2048 + hk * 128 + c8); }
#pragma unroll
                        for (int i = 0; i < 2; ++i) { const int c = ptid + i * 256, s2 = c >> 3, c8 = (c & 7) * 8; pv[i] = *(const u32x4*)(qc + (t1 + s2) * 8192 + 4096 + hv * 128 + vhalf * 64 + c8); }
                        if (pw == 1) { pb = bgi[(t1 + ptid - 64) * 64 + hv]; pg = bgi[(t1 + ptid - 64) * 64 + 32 + hv]; } }
#pragma unroll
                    for (int ty = 0; ty < 2; ++ty) { f32x4 acc = (f32x4){0.f, 0.f, 0.f, 0.f};
#pragma unroll
                        for (int ks = 0; ks < 4; ++ks) { const bf16x8 ka = lds_frag(lds + KS + (16 * sa + I) * RSB + (32 * ks + 8 * G) * 2);
                            const bf16x8 bo = ty ? lds_frag(lds + set + QS + (16 * sa + I) * RSB + (32 * ks + 8 * G) * 2) : ka; acc = mfma32(ka, bo, acc); }
                        const f32x4 gr = *(const LAS f32x4*)(lds + GAM + (16 * sa + 4 * G) * 4); const float gc = *(const LAS float*)(lds + GAM + (16 * sa + I) * 4);
                        if (ty == 0) { const f32x4 br = *(const LAS f32x4*)(lds + BET + (16 * sa + 4 * G) * 4);
#pragma unroll
                            for (int r = 0; r < 4; ++r) { const float val = br[r] * acc[r] * __expf(gr[r] - gc); *(LAS float*)(lds + LS + ((sa * 16 + 4 * G + r) * 16 + I) * 4) = (I < 4 * G + r) ? val : 0.f; } }
                        else { f32x4 o;
#pragma unroll
                            for (int r = 0; r < 4; ++r) { const float val = acc[r] * __expf(gc - gr[r]); o[r] = (4 * G + r <= I) ? val : 0.f; }
                            *(LAS s16x4*)(lds + set + QKS + ((sa * 16 + I) * 16 + 4 * G) * 2) = pack4(o); } } }
                LDS_BARRIER();
                if (act && pw == 0) { const int sa = G, c = I; float x[16];
#pragma unroll
                    for (int i = 0; i < 16; ++i) x[i] = 0.f;
#pragma unroll
                    for (int ib = 0; ib < 4; ++ib) {
                        f32x4 lv[4][4];
#pragma unroll
                        for (int r = 0; r < 4; ++r)
#pragma unroll
                            for (int jj = 0; jj <= ib; ++jj) lv[r][jj] = *(const LAS f32x4*)(lds + LS + ((sa * 16 + 4 * ib + r) * 16 + 4 * jj) * 4);
                        __builtin_amdgcn_sched_barrier(0);
#pragma unroll
                        for (int r = 0; r < 4; ++r) { const int i = 4 * ib + r; float s0 = (i == c) ? 1.0f : 0.0f, s1 = 0.f;
#pragma unroll
                            for (int jj = 0; jj <= ib; ++jj) { s0 -= lv[r][jj][0] * x[4 * jj] + lv[r][jj][1] * x[4 * jj + 1]; s1 -= lv[r][jj][2] * x[4 * jj + 2] + lv[r][jj][3] * x[4 * jj + 3]; }
                            x[i] = s0 + s1; }
                    }
                    const float bc = *(const LAS float*)(lds + BET + lane * 4), sc1 = -bc * *(const LAS float*)(lds + set + EE + lane * 4);
#pragma unroll
                    for (int i = 0; i < 16; ++i) { *(LAS bf16_t*)(lds + X1 + ((sa * 16 + i) * 16 + c) * 2) = f2bf(x[i] * sc1); *(LAS bf16_t*)(lds + X2 + ((sa * 16 + i) * 16 + c) * 2) = f2bf(x[i] * bc); } }
                LDS_BARRIER();
                if (act) { const int sa = pw;
                    const s16x4 xb = *(const LAS s16x4*)(lds + X1 + ((sa * 16 + I) * 16 + 4 * G) * 2); s16x4 kt[8]; f32x4 w[8];
#pragma unroll
                    for (int dt = 0; dt < 8; ++dt) kt[dt] = lds_tr4(lds + KS + (16 * sa + 4 * G + q4) * RSB + (16 * dt + 4 * p4) * 2);
#pragma unroll
                    for (int dt = 0; dt < 8; ++dt) { w[dt] = mfma16(kt[dt], xb, (f32x4){0.f, 0.f, 0.f, 0.f}); *(LAS s16x4*)(lds + set + KT + (16 * dt + I) * KTRS + (16 * sa + 4 * G) * 2) = kt[dt]; }
#pragma unroll
                    for (int dt = 0; dt < 8; ++dt) *(LAS s16x4*)(lds + set + WSL + (16 * sa + I) * RSB + (16 * dt + 4 * G) * 2) = pack4(w[dt]); }
                LDS_BARRIER();
            }
        }
    }
}

constexpr int N_PHASES = 30;
__global__ void __launch_bounds__(NTHREADS, 2) fwd(Args a0) {
    extern __shared__ __attribute__((aligned(16))) unsigned char smem_raw[];
    LAS unsigned char* lds = (LAS unsigned char*)smem_raw;
    volatile LAS unsigned* xbw = (volatile LAS unsigned*)(lds + LDS_XBW);
    if (TIDX == 0) { xbw[0] = 0u; xbw[1] = 0u; xbw[2] = 0u; xbw[3] = 0u; }
    __syncthreads();
    XcdBarrier bar = xcd_barrier_post((unsigned*)(a0.ws + WS_CTL), xbw);
#ifndef PHMASK
#define PHMASK 0xFFFFFFFFull
#endif
#ifndef DUPMASK
#define DUPMASK 0ull
#endif
#define PH(i, body) do { if (((PHMASK >> (i)) & 1ull) && a0.ph_lo <= (i) && (i) < a0.ph_hi) { __attribute__((address_space(1))) unsigned char* wsp_ = (__attribute__((address_space(1))) unsigned char*)a0.ws; asm volatile("" : "+s"(wsp_)); Args a = a0; a.ws = (unsigned char*)wsp_; const float* xin = a.in[0]; const float* xw = (const float*)(a.ws + WS_X); (void)xin; (void)xw; \
        if ((DUPMASK >> (i)) & 1ull) { body; xcd_barrier(bar); } body; if ((i) + 1 < a0.ph_hi) xcd_barrier(bar); } } while (0)
    PH(0, { phase_prologue(a, lds); __syncthreads(); NORM_PH(0, true)(a, xin, a.in[1], -1); });
    PH(2, phase_gemm_in0(a, lds));
    PH(3, { phase_rg_conv(a); __syncthreads(); phase_hg1(a, lds); });
    PH(4, { phase_rg_gates(a, lds); __syncthreads(); phase_hg2(a); });
    PH(5, { phase_rg_scan(a, lds); __syncthreads(); phase_hg3(a, lds); });
    PH(9, phase_gemm_out<false>(a, lds, D_, a.ws + WS_WOUT0T, xin));
    PH(10, NORM_PH(0, false)(a, nullptr, a.in[2], 0));
    PH(11, phase_gemm_router(a, lds, 0));
    PH(12, phase_route(a, 0));
    PH(13, phase_rowmap(a, lds, 0));
    PH(14, phase_moe_up(a, lds, 0));
    PH(15, phase_moe_down(a, lds, 0));
    PH(16, { NORM_PH(1, false)(a, nullptr, a.in[1] + D_, 0); __syncthreads(); moe_weight_jobs(a, 1, lds); });
    PH(18, { phase_gemm_in1(a, lds); phase_gemm_in1_tail(a, lds); });
    PH(19, phase_gdn_conv(a));
    PH(20, phase_gdn_chunk(a, lds));
    PH(21, phase_gdn_norm(a));
    PH(22, phase_gemm_out<true>(a, lds, 4096, a.ws + WS_WOUT1T, nullptr));
    PH(23, NORM_PH(0, false)(a, nullptr, a.in[2] + D_, 1));
    PH(24, phase_gemm_router(a, lds, 1));
    PH(25, phase_route(a, 1));
    PH(26, phase_rowmap(a, lds, 1));
    PH(27, phase_moe_up(a, lds, 1));
    PH(28, phase_moe_down(a, lds, 1));
    PH(29, NORM_PH(2, false)(a, nullptr, a.in[3], 1));
#undef PH
}

extern "C" void kernel_launch(void* const* d_in, const int* in_sizes, int n_in, void* d_out, int out_size, void* d_ws, size_t ws_size, hipStream_t stream) {
    static int grid = 0;
    if (grid == 0) {
        if (n_in != 28 || ws_size < WS_END) { fprintf(stderr, "kernel_launch: need 28 inputs and %zu bytes of workspace, got %d / %zu\n", (size_t)WS_END, n_in, ws_size); grid = -1; return; }
        int dev = 0, cus = 0, per_cu = 0;
        if (hipGetDevice(&dev) != hipSuccess || hipDeviceGetAttribute(&cus, hipDeviceAttributeMultiprocessorCount, dev) != hipSuccess) { grid = -1; return; }
        if (hipFuncSetAttribute((const void*)fwd, hipFuncAttributeMaxDynamicSharedMemorySize, LDS_BYTES) != hipSuccess) { fprintf(stderr, "kernel_launch: hipFuncSetAttribute failed\n"); grid = -1; return; }
        if (hipOccupancyMaxActiveBlocksPerMultiprocessor(&per_cu, (const void*)fwd, NTHREADS, LDS_BYTES) != hipSuccess || per_cu < 1) { fprintf(stderr, "kernel_launch: occupancy query says %d\n", per_cu); }
        (void)hipGetLastError();
        grid = cus;
    }
    if (grid < 0) return;
    (void)in_sizes; (void)out_size;
    hipMemsetAsync((char*)d_ws + WS_CTL, 0, CTL_BYTES, stream);
    Args a; memset(&a, 0, sizeof(a));
    for (int i = 0; i < 28; ++i) a.in[i] = (const float*)d_in[i];
    a.out = (float*)d_out; a.ws = (unsigned char*)d_ws;
#if N_LAUNCH_MODE == 1
    a.ph_lo = 0; a.ph_hi = N_PHASES;
    hipLaunchKernelGGL(fwd, dim3(grid), dim3(NTHREADS), LDS_BYTES, stream, a);
#if EXTRA_PH >= 0
    a.ph_lo = EXTRA_PH; a.ph_hi = EXTRA_PH + 1;
    hipLaunchKernelGGL(fwd, dim3(grid), dim3(NTHREADS), LDS_BYTES, stream, a);
#endif
#else
    for (int p = 0; p < N_PHASES; ++p) { a.ph_lo = p; a.ph_hi = p + 1; hipLaunchKernelGGL(fwd, dim3(grid), dim3(NTHREADS), LDS_BYTES, stream, a); }
#endif
}
```

```cpp
#include <hip/hip_runtime.h>
#include <stdint.h>
#include <stdio.h>
#include <string.h>

#ifndef EXTRA_PH
#define EXTRA_PH -1
#endif
#ifndef N_LAUNCH_MODE
#define N_LAUNCH_MODE 1
#endif

#define LAS __attribute__((address_space(3)))
typedef unsigned short bf16_t;
typedef short bf16x8 __attribute__((ext_vector_type(8)));
typedef float f32x4 __attribute__((ext_vector_type(4)));
typedef float f32x2 __attribute__((ext_vector_type(2)));
typedef unsigned u32x4 __attribute__((ext_vector_type(4)));
typedef unsigned u32x2 __attribute__((ext_vector_type(2)));

constexpr int T_ = 16384, D_ = 2048, S_ = 4096, NB_ = 4;
constexpr int N_IN0 = 6144, N_IN1 = 12352, N_IN1P = 12544;
constexpr int NEXP = 64, DEXP = 512, MPAD = 49152;
constexpr int NTHREADS = 512;
constexpr int LDS_MAIN = 131072;
constexpr int LDS_BYTES = 163840;
constexpr int LDS_XBW = LDS_BYTES - 16;

constexpr size_t al256(size_t x) { return (x + 255) & ~(size_t)255; }
constexpr size_t WS_CTL = 0;
constexpr size_t CTL_BYTES = 65536;
constexpr size_t CTL_CNT = 16384;
constexpr size_t WS_LB = WS_CTL + CTL_BYTES;
constexpr size_t WS_TINFO = WS_LB + 4096;
constexpr size_t WS_WIN0T = WS_TINFO + 4096;
constexpr size_t WS_WOUT0T = WS_WIN0T + (size_t)N_IN0 * D_ * 2;
constexpr size_t WS_WIN1T = WS_WOUT0T + (size_t)D_ * D_ * 2;
constexpr size_t WS_WOUT1T = WS_WIN1T + (size_t)N_IN1P * D_ * 2;
constexpr size_t WS_WGATES = WS_WOUT1T + (size_t)D_ * 4096 * 2;
constexpr size_t WS_WRT = WS_WGATES + (size_t)8 * 256 * 256 * 2;
constexpr size_t WS_WG = WS_WRT + (size_t)2 * 256 * D_ * 2;
constexpr size_t WS_WU = WS_WG + (size_t)NEXP * DEXP * D_ * 2;
constexpr size_t WS_WD = WS_WU + (size_t)NEXP * DEXP * D_ * 2;
constexpr size_t WS_X = WS_WD + (size_t)NEXP * DEXP * D_ * 2;
constexpr size_t WS_H = WS_X + (size_t)T_ * D_ * 4;
constexpr size_t WS_PROJ = WS_H + (size_t)T_ * D_ * 2;
constexpr size_t PROJ_BYTES = (size_t)T_ * N_IN1P * 2;
constexpr size_t WS_FLOG = WS_PROJ + (size_t)T_ * N_IN0 * 2;
constexpr size_t WS_XC = WS_FLOG + (size_t)T_ * 1024 * 4;
constexpr size_t WS_ACT = WS_PROJ;
constexpr size_t WS_YMOE = WS_ACT + (size_t)MPAD * DEXP * 2;
constexpr size_t WS_R1 = WS_PROJ + PROJ_BYTES;
constexpr size_t WS_A = WS_R1;
constexpr size_t WS_U = WS_R1 + (size_t)T_ * 1024 * 4;
constexpr size_t WS_QKVC = WS_R1;
constexpr size_t WS_Y = WS_R1 + (size_t)T_ * 8192 * 2;
constexpr size_t WS_O = WS_Y + (size_t)T_ * 4096 * 2;
constexpr size_t WS_TAIL = WS_O + (size_t)T_ * 4096 * 4;
constexpr size_t WS_BG = WS_TAIL + (size_t)T_ * 64 * 4;
constexpr size_t WS_LOGITS = WS_BG + (size_t)T_ * 64 * 4;
constexpr size_t WS_EID = WS_LOGITS + (size_t)T_ * 128 * 4;
constexpr size_t WS_SLOT = WS_EID + (size_t)T_ * 2 * 4;
constexpr size_t WS_GATE = WS_SLOT + (size_t)T_ * 2 * 4;
constexpr size_t WS_POSOF = WS_GATE + (size_t)T_ * 2 * 4;
constexpr size_t WS_ROWMAP = WS_POSOF + (size_t)T_ * 2 * 4;
constexpr size_t WS_H8 = WS_ROWMAP + (size_t)MPAD * 4;
constexpr size_t WS_END = WS_H8 + (size_t)T_ * D_;
static_assert(WS_YMOE + (size_t)MPAD * D_ * 2 <= WS_R1, "moe overlay");
static_assert(WS_XC + (size_t)T_ * 1024 * 2 <= WS_R1, "layer0 overlay");

struct Args {
    const float* in[28];
    float* out;
    unsigned char* ws;
    int ph_lo, ph_hi;
};

__device__ __forceinline__ int tidx_() { int t = (int)threadIdx.x; asm volatile("" : "+v"(t)); return t; }
#define TIDX tidx_()
typedef __bf16 bf16x2n __attribute__((ext_vector_type(2)));
__device__ __forceinline__ unsigned cvt_pk_bf16(float lo, float hi) { const f32x2 v = {lo, hi}; return __builtin_bit_cast(unsigned, __builtin_convertvector(v, bf16x2n)); }
__device__ __forceinline__ unsigned pk_fp8x4(float a, float b, float c, float d) { int v = __builtin_amdgcn_cvt_pk_fp8_f32(a, b, 0, false); v = __builtin_amdgcn_cvt_pk_fp8_f32(c, d, v, true); return (unsigned)v; }
constexpr float W8_SCALE = 64.0f, ACT8_SCALE = 8.0f;
__device__ __forceinline__ bf16_t f2bf(float x) { return (bf16_t)(cvt_pk_bf16(x, 0.f) & 0xffffu); }
__device__ __forceinline__ float bf_lo(unsigned w) { return __uint_as_float(w << 16); }
__device__ __forceinline__ float bf_hi(unsigned w) { return __uint_as_float(w & 0xffff0000u); }
__device__ __forceinline__ float bf1(bf16_t v) { return __uint_as_float(((unsigned)v) << 16); }
__device__ __forceinline__ float sigmoidf_(float x) { return __builtin_amdgcn_rcpf(1.0f + __expf(-x)); }
__device__ __forceinline__ float siluf_(float x) { return x * __builtin_amdgcn_rcpf(1.0f + __expf(-x)); }
__device__ __forceinline__ float softplusf_(float x) { return x > 20.f ? x : log1pf(__expf(x)); }
__device__ __forceinline__ float gelu_tanh(float x) { const float u = 0.7978845608028654f * (x + 0.044715f * x * x * x); return x * __builtin_amdgcn_rcpf(1.0f + __expf(-2.0f * u)); }
template <int CTRL> __device__ __forceinline__ float dpp_f(float v) { return __builtin_bit_cast(float, __builtin_amdgcn_update_dpp(0, __builtin_bit_cast(int, v), CTRL, 0xf, 0xf, false)); }
__device__ __forceinline__ float row16_sum(float s) { s += dpp_f<0x140>(s); s += dpp_f<0x141>(s); s += dpp_f<0xB1>(s); s += dpp_f<0x4E>(s); return s; }
__device__ __forceinline__ float wave_sum(float v) { v = row16_sum(v); v += __shfl_xor(v, 16); v += __shfl_xor(v, 32); return v; }

#define LDS_BARRIER() do { asm volatile("s_waitcnt lgkmcnt(0)" ::: "memory"); __builtin_amdgcn_s_barrier(); asm volatile("" ::: "memory"); } while (0)
#define XB_TMO      128
#define XB_XCNT(j)  (256  + 64 * (j))
#define XB_XSUB(j)  (1280 + 64 * (j))
#define XB_XGEN(j)  (2304 + 64 * (j))
#define XB_TOP      3328
#define XB_TOPGEN   3392
#define XCD_BAR_WORDS 3456
#define XB_SPIN_CAP (1u << 18)

__device__ __forceinline__ unsigned xb_ld(unsigned* p)              { return __hip_atomic_load(p, __ATOMIC_RELAXED, __HIP_MEMORY_SCOPE_AGENT); }
__device__ __forceinline__ unsigned xb_add(unsigned* p, unsigned v) { return __hip_atomic_fetch_add(p, v, __ATOMIC_RELAXED, __HIP_MEMORY_SCOPE_AGENT); }
__device__ __forceinline__ unsigned xb_xcc_id() { return (unsigned)__builtin_amdgcn_s_getreg((3 << 11) | 20) & 0xFu; }
#define XB_SPIN(cond, bar) do { unsigned _sp = 0; while (cond) { __builtin_amdgcn_s_sleep(1); \
    if ((++_sp & 255u) == 0u) { if (xb_ld(&(bar)[XB_TMO])) break; if (_sp > XB_SPIN_CAP) { atomicAdd(&(bar)[XB_TMO], 1u); break; } } } } while (0)

struct XcdBarrier { unsigned* bar; unsigned x; volatile LAS unsigned* st; };

__device__ __forceinline__ XcdBarrier xcd_barrier_post(unsigned* bar, volatile LAS unsigned* st) {
    XcdBarrier b; b.bar = bar; b.x = xb_xcc_id(); b.st = st;
    if (TIDX == 0) (void)xb_add(&bar[XB_XCNT(b.x)], 1u);
    return b;
}
__device__ __forceinline__ void xcd_barrier_complete(unsigned* bar, unsigned x, unsigned& nloc, unsigned& nx) {
    const unsigned G = gridDim.x * gridDim.y * gridDim.z;
    unsigned sum, cnt, mine, sp = 0u;
    for (;;) {
        sum = 0u; cnt = 0u; mine = 0u;
#pragma unroll
        for (unsigned j = 0; j < 16; ++j) { const unsigned c = xb_ld(&bar[XB_XCNT(j)]); sum += c; cnt += (c > 0u) ? 1u : 0u; mine = (j == x) ? c : mine; }
        if (sum == G) break;
        __builtin_amdgcn_s_sleep(1);
        if ((++sp & 255u) == 0u) { if (xb_ld(&bar[XB_TMO])) break; if (sp > XB_SPIN_CAP) { atomicAdd(&bar[XB_TMO], 1u); break; } }
    }
    nloc = mine > 0u ? mine : 1u; nx = cnt > 0u ? cnt : 1u;
}
__device__ __forceinline__ void xcd_barrier(const XcdBarrier& b) {
    asm volatile("s_waitcnt vmcnt(0)" ::: "memory");
    __syncthreads();
    if (TIDX == 0) {
        unsigned* bar = b.bar;
        __builtin_amdgcn_s_waitcnt(0);
        unsigned nloc = b.st[0], nx = b.st[1];
        if (nloc == 0u) { xcd_barrier_complete(bar, b.x, nloc, nx); b.st[0] = nloc; b.st[1] = nx; }
        const unsigned old = xb_add(&bar[XB_XSUB(b.x)], 1u);
        const unsigned gen = old / nloc;
        if (old + 1u == (gen + 1u) * nloc) {
            __builtin_amdgcn_fence(__ATOMIC_RELEASE, "agent");
            asm volatile("s_waitcnt vmcnt(0)" ::: "memory");
            const unsigned og = xb_add(&bar[XB_TOP], 1u);
            const unsigned tg = og / nx;
            if (og + 1u == (tg + 1u) * nx) xb_add(&bar[XB_TOPGEN], 1u);
            else XB_SPIN(xb_ld(&bar[XB_TOPGEN]) == tg, bar);
            __builtin_amdgcn_fence(__ATOMIC_ACQUIRE, "agent");
            xb_add(&bar[XB_XGEN(b.x)], 1u);
            asm volatile("s_waitcnt vmcnt(0)" ::: "memory");
        } else {
            XB_SPIN(xb_ld(&bar[XB_XGEN(b.x)]) == gen, bar);
            __builtin_amdgcn_fence(__ATOMIC_ACQUIRE, "agent");
            asm volatile("s_waitcnt vmcnt(0)" ::: "memory");
        }
    }
    __syncthreads();
}

constexpr int BM = 256, BK = 64, HALF = 128, HTB = HALF * BK * 2;
__device__ __forceinline__ int lds_byte(int r, int c) { const int st = (r >> 4) * 2 + (c >> 5), rr = r & 15, cc = c & 31, ob = rr * 64 + cc * 2; return st * 1024 + (ob ^ (((ob >> 9) & 1) << 5)); }
__device__ __forceinline__ void stage_rc(int b, int& R, int& C) { const int st = b / 1024, sb = b % 1024, swz = sb ^ (((sb >> 9) & 1) << 5); R = (st >> 1) * 16 + swz / 64; C = (st & 1) * 32 + (swz % 64) / 2; }
__device__ __forceinline__ int perm32(int rho) { const int n = rho >> 4, i = rho & 15; return 8 * (i >> 2) + 4 * n + (i & 3); }

__device__ __forceinline__ void stage_pos(int tid, int& R0, int& C0) { stage_rc(tid * 16, R0, C0); }
__device__ __forceinline__ int perm_row(int R) { return (R & ~31) + perm32(R & 31); }

#define BID ((int)blockIdx.x)
#define NBLK ((int)gridDim.x)
#define BID_ BID
#define NBLK_ NBLK
typedef f32x4 Acc[2][2][4][2];
struct UnitD { const char* gA; const char* gB; int t0, t1, t2; };

typedef int i32x8 __attribute__((ext_vector_type(8)));
typedef int i32x4 __attribute__((ext_vector_type(4)));
template <bool GATHER, bool FP8, class Src, class Epi>
__device__ __forceinline__ void gemm_stream(LAS unsigned char* lds, const Src& S, const int nt, const Epi& E) {
    const int tid = TIDX, wid = tid >> 6, lane = tid & 63, wr = wid >> 2, wc = wid & 3, fr = lane & 15, fq = lane >> 4;
    const unsigned ldsw = (unsigned)wid * 1024u;
    const int aoff = lds_byte(wr * 64 + fr, fq * 8), boff = lds_byte(wc * 32 + fr, fq * 8);
    const size_t kstep = (size_t)(BK * 2);
#define G_SA(b, h) (((b) * 2 + (h)) * HTB)
#define G_SB(b, h) ((4 + (b) * 2 + (h)) * HTB)
#define G_STAGE(bufoff, gbase, v) do { _Pragma("unroll") for (int _i = 0; _i < 2; ++_i) \
        __builtin_amdgcn_global_load_lds((const unsigned*)((gbase) + (v)[_i]), (LAS unsigned*)(lds + (bufoff) + ldsw + _i * 8192), 16, 0, 0); } while (0)
#define G_LD8(p) __builtin_shufflevector(*(const LAS i32x4*)(p), *(const LAS i32x4*)((p) + 1024), 0, 1, 2, 3, 4, 5, 6, 7)
#define G_LDA(dst, b, h) do { _Pragma("unroll") for (int m = 0; m < 4; ++m) dst[m] = G_LD8(lds + G_SA(b, h) + aoff + m * 2048); } while (0)
#define G_LDB(dst, b, h) do { _Pragma("unroll") for (int n = 0; n < 2; ++n) dst[n] = G_LD8(lds + G_SB(b, h) + boff + n * 2048); } while (0)
#define G_HALF(x, k) __builtin_bit_cast(bf16x8, __builtin_shufflevector((x), (x), 4 * (k), 4 * (k) + 1, 4 * (k) + 2, 4 * (k) + 3))
#define G_MMA(ai, bj, At, Bt) do { __builtin_amdgcn_s_setprio(1); _Pragma("unroll") for (int m = 0; m < 4; ++m) _Pragma("unroll") for (int n = 0; n < 2; ++n) { \
        if (FP8) asm volatile("v_mfma_f32_16x16x128_f8f6f4 %0, %1, %2, %0" : "+v"(acc[ai][bj][m][n]) : "v"(Bt[n]), "v"(At[m]));   \
        else { acc[ai][bj][m][n] = __builtin_amdgcn_mfma_f32_16x16x32_bf16(G_HALF(Bt[n], 0), G_HALF(At[m], 0), acc[ai][bj][m][n], 0, 0, 0); \
               acc[ai][bj][m][n] = __builtin_amdgcn_mfma_f32_16x16x32_bf16(G_HALF(Bt[n], 1), G_HALF(At[m], 1), acc[ai][bj][m][n], 0, 0, 0); } } \
        __builtin_amdgcn_s_setprio(0); } while (0)
#define G_WAIT_V(n) asm volatile("s_waitcnt vmcnt(" #n ")" ::: "memory")
#define G_WAIT_L(n) asm volatile("s_waitcnt lgkmcnt(" #n ")" ::: "memory")
#define G_BAR __builtin_amdgcn_s_barrier()
#define G_SCHED __builtin_amdgcn_sched_barrier(0)
    UnitD cur, nxt; int ui = 0;
    if (!S.next(0, cur)) return;
    unsigned va[2][2], vb[2][2], van[2][2];
    S.vb(vb); S.va(cur, va);
    Acc acc;
#pragma unroll
    for (int a = 0; a < 2; ++a)
#pragma unroll
        for (int b = 0; b < 2; ++b)
#pragma unroll
            for (int m = 0; m < 4; ++m)
#pragma unroll
                for (int n = 0; n < 2; ++n) acc[a][b][m][n] = (f32x4){0.f, 0.f, 0.f, 0.f};
    i32x8 At[4], B0[2], B1[2];
    const char* cA = cur.gA; const char* cB = cur.gB;
    G_WAIT_V(0);
    __syncthreads();
    G_STAGE(G_SB(0, 0), cB, vb[0]); G_STAGE(G_SA(0, 0), cA, va[0]); G_STAGE(G_SB(0, 1), cB, vb[1]); G_STAGE(G_SA(0, 1), cA, va[1]);
    if (wr == 1) G_BAR;
    G_WAIT_V(4); G_BAR;
    G_STAGE(G_SB(1, 0), cB + kstep, vb[0]); G_STAGE(G_SA(1, 0), cA + kstep, va[0]); G_STAGE(G_SB(1, 1), cB + kstep, vb[1]);
    G_WAIT_V(6); G_BAR;
    for (;;) {
        const bool has_next = S.next(ui + 1, nxt);
        const char* nA = has_next ? nxt.gA : cA; const char* nB = has_next ? nxt.gB : cB;
        if (GATHER) { if (has_next) S.va(nxt, van); else { van[0][0] = va[0][0]; van[0][1] = va[0][1]; van[1][0] = va[1][0]; van[1][1] = va[1][1]; } }
#pragma unroll 1
        for (int t = 0; t < nt; t += 2) {
            const bool last = (t == nt - 2);
            const char* a1 = cA + (size_t)(t + 1) * kstep;
            const char* a2 = last ? nA : cA + (size_t)(t + 2) * kstep; const char* b2 = last ? nB : cB + (size_t)(t + 2) * kstep;
            const char* a3 = a2 + kstep; const char* b3 = b2 + kstep;
            unsigned v2[2][2];
#pragma unroll
            for (int hh = 0; hh < 2; ++hh)
#pragma unroll
                for (int i = 0; i < 2; ++i) v2[hh][i] = (GATHER && last) ? van[hh][i] : va[hh][i];
            G_LDB(B0, 0, 0); G_SCHED; G_LDA(At, 0, 0); G_STAGE(G_SA(1, 1), a1, va[1]);
            G_WAIT_L(8); G_BAR; G_WAIT_L(0); G_MMA(0, 0, At, B0); G_BAR; G_SCHED;
            G_LDB(B1, 0, 1); G_STAGE(G_SB(0, 0), b2, vb[0]);
            G_BAR; G_WAIT_L(0); G_MMA(0, 1, At, B1); G_BAR;
            G_LDA(At, 0, 1); G_STAGE(G_SA(0, 0), a2, v2[0]);
            G_BAR; G_WAIT_L(0); G_MMA(1, 0, At, B0); G_BAR; G_SCHED;
            G_STAGE(G_SB(0, 1), b2, vb[1]);
            G_WAIT_V(6); G_BAR; G_MMA(1, 1, At, B1); G_BAR;
            G_LDB(B0, 1, 0); G_SCHED; G_LDA(At, 1, 0); G_STAGE(G_SA(0, 1), a2, v2[1]);
            G_WAIT_L(8); G_BAR; G_WAIT_L(0); G_MMA(0, 0, At, B0); G_BAR; G_SCHED;
            G_LDB(B1, 1, 1); G_STAGE(G_SB(1, 0), b3, vb[0]);
            G_BAR; G_WAIT_L(0); G_MMA(0, 1, At, B1); G_BAR;
            G_LDA(At, 1, 1); G_STAGE(G_SA(1, 0), a3, v2[0]);
            G_BAR; G_WAIT_L(0); G_MMA(1, 0, At, B0); G_BAR; G_SCHED;
            G_STAGE(G_SB(1, 1), b3, vb[1]);
            G_WAIT_V(6); G_BAR; G_MMA(1, 1, At, B1); G_BAR;
        }
        if (FP8) asm volatile("s_nop 15\n\ts_nop 15" ::: "memory");
        { int tz = TIDX; asm volatile("" : "+v"(tz));
          const int wid2 = tz >> 6, lane2 = tz & 63; E(acc, cur, wid2 >> 2, wid2 & 3, lane2 & 15, lane2 >> 4); }
        if (!has_next) break;
#pragma unroll
        for (int a = 0; a < 2; ++a)
#pragma unroll
            for (int b = 0; b < 2; ++b)
#pragma unroll
                for (int m = 0; m < 4; ++m)
#pragma unroll
                    for (int n = 0; n < 2; ++n) acc[a][b][m][n] = (f32x4){0.f, 0.f, 0.f, 0.f};
        cur = nxt; cA = nA; cB = nB; ++ui;
        if (GATHER) { va[0][0] = van[0][0]; va[0][1] = van[0][1]; va[1][0] = van[1][0]; va[1][1] = van[1][1]; }
    }
    G_WAIT_V(0);
    if (wr == 0) G_BAR;
    G_BAR;
#undef G_SA
#undef G_SB
#undef G_STAGE
#undef G_LDA
#undef G_LDB
#undef G_MMA
#undef G_LD8
#undef G_HALF
#undef G_WAIT_V
#undef G_WAIT_L
#undef G_BAR
#undef G_SCHED
}

__device__ __forceinline__ void offs_direct(unsigned (&v)[2][2], int ld, bool perm) {
    int R0, C0; stage_pos(TIDX, R0, C0);
#pragma unroll
    for (int i = 0; i < 2; ++i) { const int R = R0 + 64 * i, Rr = perm ? perm_row(R) : R;
        v[0][i] = (unsigned)(Rr * ld + C0) * 2u; v[1][i] = (unsigned)((Rr + HALF) * ld + C0) * 2u; }
}

struct SrcGrid {
    const char* A; const char* B; size_t astep, bstep; int nM, total, lda, ldb;
    __device__ __forceinline__ bool next(int i, UnitD& u) const { const int id = BID_ + i * NBLK_; if (id >= total) return false; u.t0 = id % nM; u.t1 = id / nM; u.t2 = 0;
        u.gA = A + (size_t)u.t0 * astep; u.gB = B + (size_t)u.t1 * bstep; return true; }
    __device__ __forceinline__ void va(const UnitD&, unsigned (&v)[2][2]) const { offs_direct(v, lda, false); }
    __device__ __forceinline__ void vb(unsigned (&v)[2][2]) const { offs_direct(v, ldb, true); }
};

__device__ __forceinline__ void store_bf16_tile(const Acc& acc, bf16_t* O, int ld, int wr, int wc, int fr, int fq, const float sc = 1.0f) {
#pragma unroll
    for (int ai = 0; ai < 2; ++ai)
#pragma unroll
        for (int m = 0; m < 4; ++m) { bf16_t* rowp = O + (size_t)(ai * HALF + wr * 64 + m * 16 + fr) * ld + wc * 32 + 8 * fq;
#pragma unroll
            for (int bj = 0; bj < 2; ++bj) { const f32x4 v0 = acc[ai][bj][m][0] * sc, v1 = acc[ai][bj][m][1] * sc;
                u32x4 w; w.x = cvt_pk_bf16(v0[0], v0[1]); w.y = cvt_pk_bf16(v0[2], v0[3]); w.z = cvt_pk_bf16(v1[0], v1[1]); w.w = cvt_pk_bf16(v1[2], v1[3]);
                *(u32x4*)(rowp + bj * HALF) = w; } }
}
__device__ __forceinline__ void store_f32_tile(const Acc& acc, float* O, const float* R, int ld, int ncol, int wr, int wc, int fr, int fq, const float sc = 1.0f) {
#pragma unroll
    for (int ai = 0; ai < 2; ++ai)
#pragma unroll
        for (int m = 0; m < 4; ++m) { const size_t ro = (size_t)(ai * HALF + wr * 64 + m * 16 + fr) * ld;
#pragma unroll
            for (int bj = 0; bj < 2; ++bj)
#pragma unroll
                for (int n = 0; n < 2; ++n) { const int c = bj * HALF + wc * 32 + 8 * fq + 4 * n; if (c >= ncol) continue;
                    f32x4 v = acc[ai][bj][m][n] * sc; if (R) v += *(const f32x4*)(R + ro + c); *(f32x4*)(O + ro + c) = v; } }
}
struct EpiProj {
    bf16_t* O; int ld; float* F; int fld, fp0, fp1, ncol; float sc;
    __device__ __forceinline__ void operator()(const Acc& acc, const UnitD& u, int wr, int wc, int fr, int fq) const {
        if (u.t1 >= fp0 && u.t1 < fp1) store_f32_tile(acc, F + (size_t)u.t0 * BM * fld + (u.t1 - fp0) * BM, nullptr, fld, ncol, wr, wc, fr, fq, sc);
        else store_bf16_tile(acc, O + (size_t)u.t0 * BM * ld + u.t1 * BM, ld, wr, wc, fr, fq, sc);
    }
};
struct EpiResid {
    bf16_t* O; const float* Rf; const bf16_t* Rb; float sc;
    __device__ __forceinline__ void operator()(const Acc& acc, const UnitD& u, int wr, int wc, int fr, int fq) const {
        const size_t o = (size_t)u.t0 * BM * D_ + u.t1 * BM;
#pragma unroll
        for (int ai = 0; ai < 2; ++ai)
#pragma unroll
            for (int m = 0; m < 4; ++m) { const size_t ro = o + (size_t)(ai * HALF + wr * 64 + m * 16 + fr) * D_ + wc * 32 + 8 * fq;
#pragma unroll
                for (int bj = 0; bj < 2; ++bj) { f32x4 v0 = acc[ai][bj][m][0] * sc, v1 = acc[ai][bj][m][1] * sc;
                    if (Rf) { v0 += *(const f32x4*)(Rf + ro + bj * HALF); v1 += *(const f32x4*)(Rf + ro + bj * HALF + 4); }
                    else { const u32x4 r = *(const u32x4*)(Rb + ro + bj * HALF); v0[0] += bf_lo(r.x); v0[1] += bf_hi(r.x); v0[2] += bf_lo(r.y); v0[3] += bf_hi(r.y); v1[0] += bf_lo(r.z); v1[1] += bf_hi(r.z); v1[2] += bf_lo(r.w); v1[3] += bf_hi(r.w); }
                    u32x4 w; w.x = cvt_pk_bf16(v0[0], v0[1]); w.y = cvt_pk_bf16(v0[2], v0[3]); w.z = cvt_pk_bf16(v1[0], v1[1]); w.w = cvt_pk_bf16(v1[2], v1[3]);
                    *(u32x4*)(O + ro + bj * HALF) = w; } }
    }
};
struct EpiLogits {
    float* O;
    __device__ __forceinline__ void operator()(const Acc& acc, const UnitD& u, int wr, int wc, int fr, int fq) const { store_f32_tile(acc, O + (size_t)u.t0 * BM * 128, nullptr, 128, 128, wr, wc, fr, fq); }
};
struct EpiSwiGLU {
    unsigned char* O;
    __device__ __forceinline__ void operator()(const Acc& acc, const UnitD& u, int wr, int wc, int fr, int fq) const {
        unsigned char* o = O + (size_t)u.t0 * BM * DEXP + u.t1 * 128;
#pragma unroll
        for (int ai = 0; ai < 2; ++ai)
#pragma unroll
            for (int m = 0; m < 4; ++m) { unsigned char* rowp = o + (size_t)(ai * HALF + wr * 64 + m * 16 + fr) * DEXP + wc * 32 + 8 * fq;
                float r[8];
#pragma unroll
                for (int n = 0; n < 2; ++n)
#pragma unroll
                    for (int j = 0; j < 4; ++j) r[n * 4 + j] = (ACT8_SCALE / W8_SCALE) * siluf_(acc[ai][0][m][n][j] * (1.0f / W8_SCALE)) * acc[ai][1][m][n][j];
                u32x2 w; w.x = pk_fp8x4(r[0], r[1], r[2], r[3]); w.y = pk_fp8x4(r[4], r[5], r[6], r[7]);
                *(u32x2*)rowp = w; }
    }
};
struct EpiDown {
    unsigned char* O;
    __device__ __forceinline__ void operator()(const Acc& acc, const UnitD& u, int wr, int wc, int fr, int fq) const {
        unsigned char* o = O + (size_t)u.t0 * BM * D_ + u.t1 * BM; const float sc = 1.0f / (W8_SCALE * ACT8_SCALE);
#pragma unroll
        for (int ai = 0; ai < 2; ++ai)
#pragma unroll
            for (int m = 0; m < 4; ++m) { unsigned char* rowp = o + (size_t)(ai * HALF + wr * 64 + m * 16 + fr) * D_ + wc * 32 + 8 * fq;
#pragma unroll
                for (int bj = 0; bj < 2; ++bj) { const f32x4 v0 = acc[ai][bj][m][0] * sc, v1 = acc[ai][bj][m][1] * sc;
                    u32x2 w; w.x = pk_fp8x4(v0[0], v0[1], v0[2], v0[3]); w.y = pk_fp8x4(v1[0], v1[1], v1[2], v1[3]); *(u32x2*)(rowp + bj * HALF) = w; } }
    }
};
__device__ __forceinline__ unsigned rg_idx(unsigned tok, int c) { return ((((tok >> 12) * 64u + (unsigned)(c >> 4)) * (unsigned)S_ + (tok & (unsigned)(S_ - 1))) << 4) + (unsigned)(c & 15); }
struct EpiRgGates {
    bf16_t* LAo; bf16_t* Uo; const bf16_t* xc;
    const float* ba; const float* bx; const float* lam;
    __device__ __forceinline__ void operator()(const Acc& acc, const UnitD& u, int wr, int wc, int fr, int fq) const {
#pragma unroll
        for (int n = 0; n < 2; ++n) { const int c = u.t1 * 128 + wc * 32 + 8 * fq + 4 * n;
            const f32x4 vba = *(const f32x4*)(ba + c), vbx = *(const f32x4*)(bx + c), vl = *(const f32x4*)(lam + c);
            f32x4 c8; for (int j = 0; j < 4; ++j) c8[j] = -8.0f * softplusf_(-vl[j]);
#pragma unroll
            for (int ai = 0; ai < 2; ++ai)
#pragma unroll
                for (int m = 0; m < 4; ++m) { const unsigned tok = (unsigned)(u.t0 * BM + ai * HALF + wr * 64 + m * 16 + fr);
                    const u32x2 xw = *(const u32x2*)(xc + (tok * 1024u + (unsigned)c)); const float xv[4] = {bf_lo(xw.x), bf_hi(xw.x), bf_lo(xw.y), bf_hi(xw.y)};
                    f32x4 lv, uv;
#pragma unroll
                    for (int j = 0; j < 4; ++j) { const float r = sigmoidf_(acc[ai][0][m][n][j] + vba[j]), ig = sigmoidf_(acc[ai][1][m][n][j] + vbx[j]);
                        const float la = c8[j] * r, av = __expf(la); lv[j] = la; uv[j] = __builtin_amdgcn_sqrtf(fmaxf(0.f, 1.0f - av * av)) * ig * xv[j]; }
                    const unsigned o = rg_idx(tok, c);
                    u32x2 w0; w0.x = cvt_pk_bf16(lv[0], lv[1]); w0.y = cvt_pk_bf16(lv[2], lv[3]); *(u32x2*)(LAo + o) = w0;
                    u32x2 w1; w1.x = cvt_pk_bf16(uv[0], uv[1]); w1.y = cvt_pk_bf16(uv[2], uv[3]); *(u32x2*)(Uo + o) = w1; } }
    }
};


__device__ __forceinline__ void transpose_job8(const float* src, unsigned char* dst, int K, int N, int ldd, size_t sb, size_t db, int nbatch, LAS unsigned char* lds) {
    const int tid = TIDX, tk = K / 128, tn = N / 64, per = tk * tn, total = per * nbatch;
    const int rr0 = tid >> 4, c4 = (tid & 15) * 4, n = tid >> 3, kg = (tid & 7) * 16;
    f32x4 va[4], vb[4];
#define T8_LD(v, t) { const int u_ = (t), ub_ = u_ / per, ur_ = u_ % per, uik_ = ur_ / tn, uin_ = ur_ % tn; const float* usp_ = src + (size_t)ub_ * sb + (size_t)(uik_ * 128 + rr0) * N + uin_ * 64 + c4; \
        _Pragma("unroll") for (int i = 0; i < 4; ++i) v[i] = *(const f32x4*)(usp_ + (size_t)(i * 32) * N); }
#define T8_ST(v, t, buf) { const int t_ = (t), b_ = t_ / per, r_ = t_ % per, ik_ = r_ / tn, in_ = r_ % tn; LAS float* tile = (LAS float*)(lds + (buf) * (128 * 65 * 4)); \
        _Pragma("unroll") for (int i = 0; i < 4; ++i) { const int rr = rr0 + i * 32; tile[rr * 65 + c4 + 0] = v[i][0]; tile[rr * 65 + c4 + 1] = v[i][1]; tile[rr * 65 + c4 + 2] = v[i][2]; tile[rr * 65 + c4 + 3] = v[i][3]; } \
        if (t_ + 2 * NBLK < total) T8_LD(v, t_ + 2 * NBLK) \
        LDS_BARRIER(); \
        float f[16]; \
        _Pragma("unroll") for (int j = 0; j < 16; ++j) f[j] = tile[(kg + j) * 65 + n] * W8_SCALE; \
        u32x4 w; w.x = pk_fp8x4(f[0], f[1], f[2], f[3]); w.y = pk_fp8x4(f[4], f[5], f[6], f[7]); w.z = pk_fp8x4(f[8], f[9], f[10], f[11]); w.w = pk_fp8x4(f[12], f[13], f[14], f[15]); \
        *(u32x4*)(dst + (size_t)b_ * db + (size_t)(in_ * 64 + n) * ldd + ik_ * 128 + kg) = w; }
    int t = BID;
    if (t < total) T8_LD(va, t)
    if (t + NBLK < total) T8_LD(vb, t + NBLK)
    for (; t < total; t += 2 * NBLK) {
        T8_ST(va, t, 0)
        if (t + NBLK < total) T8_ST(vb, t + NBLK, 1)
    }
#undef T8_LD
#undef T8_ST
    LDS_BARRIER();
}
__device__ __forceinline__ void transpose_job(const float* src, bf16_t* dst, int K, int N, int ldd, size_t sb, size_t db, int dalt, int nbatch, LAS unsigned char* lds) {
    const int tid = TIDX, tk = K / 64, tn = N / 64, per = tk * tn, total = per * nbatch;
    const int rr0 = tid >> 4, c4 = (tid & 15) * 4, n = tid >> 3, kg = (tid & 7) * 8;
    f32x4 va[2], vb[2];
#define T16_LD(v, t) { const int u_ = (t), ub_ = u_ / per, ur_ = u_ % per, uik_ = ur_ / tn, uin_ = ur_ % tn; const float* usp_ = src + (size_t)ub_ * sb + (size_t)(uik_ * 64 + rr0) * N + uin_ * 64 + c4; \
        _Pragma("unroll") for (int i = 0; i < 2; ++i) v[i] = *(const f32x4*)(usp_ + (size_t)(i * 32) * N); }
#define T16_ST(v, t, buf) { const int t_ = (t), b_ = t_ / per, r_ = t_ % per, ik_ = r_ / tn, in_ = r_ % tn; LAS float* tile = (LAS float*)(lds + (buf) * (64 * 65 * 4)); \
        _Pragma("unroll") for (int i = 0; i < 2; ++i) { const int rr = rr0 + i * 32; tile[rr * 65 + c4 + 0] = v[i][0]; tile[rr * 65 + c4 + 1] = v[i][1]; tile[rr * 65 + c4 + 2] = v[i][2]; tile[rr * 65 + c4 + 3] = v[i][3]; } \
        if (t_ + 2 * NBLK < total) T16_LD(v, t_ + 2 * NBLK) \
        LDS_BARRIER(); \
        float f[8]; \
        _Pragma("unroll") for (int j = 0; j < 8; ++j) f[j] = tile[(kg + j) * 65 + n]; \
        u32x4 w; w.x = cvt_pk_bf16(f[0], f[1]); w.y = cvt_pk_bf16(f[2], f[3]); w.z = cvt_pk_bf16(f[4], f[5]); w.w = cvt_pk_bf16(f[6], f[7]); \
        *(u32x4*)(dst + (size_t)b_ * db + (size_t)(b_ & 1) * dalt + (size_t)(in_ * 64 + n) * ldd + ik_ * 64 + kg) = w; }
    int t = BID;
    if (t < total) T16_LD(va, t)
    if (t + NBLK < total) T16_LD(vb, t + NBLK)
    for (; t < total; t += 2 * NBLK) {
        T16_ST(va, t, 0)
        if (t + NBLK < total) T16_ST(vb, t + NBLK, 1)
    }
#undef T16_LD
#undef T16_ST
    LDS_BARRIER();
}

__device__ __forceinline__ void moe_weight_jobs(const Args& a, int layer, LAS unsigned char* lds) {
    const size_t lo = (size_t)layer * NEXP * D_ * DEXP;
    transpose_job8(a.in[25] + lo, a.ws + WS_WG, D_, DEXP, D_, (size_t)D_ * DEXP, (size_t)DEXP * D_, NEXP, lds);
    transpose_job8(a.in[26] + lo, a.ws + WS_WU, D_, DEXP, D_, (size_t)D_ * DEXP, (size_t)DEXP * D_, NEXP, lds);
    transpose_job8(a.in[27] + lo, a.ws + WS_WD, DEXP, D_, DEXP, (size_t)D_ * DEXP, (size_t)DEXP * D_, NEXP, lds);
}

__device__ __forceinline__ void phase_prologue(const Args& a, LAS unsigned char* lds) {
    const int gtid = BID * NTHREADS + TIDX, gsz = NBLK * NTHREADS;
    for (int i = gtid; i < 1024; i += gsz) { const float l0 = a.in[12][i], l1 = a.in[12][1024 + i], mx = fmaxf(l0, l1), e0 = __expf(l0 - mx), e1 = __expf(l1 - mx);
        ((float*)(a.ws + WS_LB))[i] = e0 / (e0 + e1); }
    for (int it = gtid; it < 2 * 256 * 256; it += gsz) { const int l = it >> 16, n = (it >> 8) & 255, k8 = (it & 255) * 8; float f[8];
#pragma unroll
        for (int j = 0; j < 8; ++j) { const int k = k8 + j; f[j] = n < 8 ? a.in[21][((size_t)l * D_ + k) * 8 + n] : (n < 72 ? a.in[23][((size_t)l * D_ + k) * 64 + (n - 8)] : 0.f); }
        u32x4 w; w.x = cvt_pk_bf16(f[0], f[1]); w.y = cvt_pk_bf16(f[2], f[3]); w.z = cvt_pk_bf16(f[4], f[5]); w.w = cvt_pk_bf16(f[6], f[7]);
        *(u32x4*)((bf16_t*)(a.ws + WS_WRT) + ((size_t)l * 256 + n) * D_ + k8) = w; }
    for (int it = gtid; it < 192 * 128; it += gsz) *(u32x4*)(a.ws + WS_WIN1T + (size_t)N_IN1 * D_ + (size_t)it * 16) = (u32x4){0u, 0u, 0u, 0u};
    transpose_job(a.in[4], (bf16_t*)(a.ws + WS_WIN0T), D_, N_IN0, D_, 0, 0, 0, 1, lds);
    transpose_job(a.in[14], (bf16_t*)(a.ws + WS_WOUT0T), D_, D_, D_, 0, 0, 0, 1, lds);
    transpose_job8(a.in[15], a.ws + WS_WIN1T, D_, N_IN1, D_, 0, 0, 1, lds);
    transpose_job8(a.in[20], a.ws + WS_WOUT1T, 4096, D_, 4096, 0, 0, 1, lds);
    transpose_job(a.in[7], (bf16_t*)(a.ws + WS_WGATES), 128, 128, 128, 128 * 128, 256 * 128, 0, 8, lds);
    transpose_job(a.in[9], (bf16_t*)(a.ws + WS_WGATES) + 128 * 128, 128, 128, 128, 128 * 128, 256 * 128, 0, 8, lds);
    moe_weight_jobs(a, 0, lds);
}

#define NORM_PH(M, F) phase_norm<M, F>
template <int MODE, bool F32>
__device__ __forceinline__ void phase_norm(const Args& a, const float* src, const float* gain, int layer) {
    const int wid = TIDX >> 6, lane = TIDX & 63;
    bf16_t* xw = (bf16_t*)(a.ws + WS_X); bf16_t* hw = (bf16_t*)(a.ws + WS_H);
    const unsigned char* ym = a.ws + WS_YMOE; const int* posof = (const int*)(a.ws + WS_POSOF); const float* gate = (const float*)(a.ws + WS_GATE);
    const int stride = NBLK * 16;
    f32x4 rf[2][8]; u32x2 rb[2][8]; int pp[2][2] = {{0, 0}, {0, 0}}; float pg[2][2] = {{0.f, 0.f}, {0.f, 0.f}};
#define NORM_LD(r) { _Pragma("unroll") for (int u = 0; u < 2; ++u) { _Pragma("unroll") for (int i = 0; i < 8; ++i) { \
            if (F32) rf[u][i] = *(const f32x4*)(src + (size_t)((r) + u) * D_ + (i * 64 + lane) * 4); else rb[u][i] = *(const u32x2*)(xw + (size_t)((r) + u) * D_ + (i * 64 + lane) * 4); } \
            if (MODE >= 1) { pp[u][0] = posof[((r) + u) * 2]; pp[u][1] = posof[((r) + u) * 2 + 1]; pg[u][0] = gate[((r) + u) * 2]; pg[u][1] = gate[((r) + u) * 2 + 1]; } } }
    int row = (BID * 8 + wid) * 2;
    if (row < T_) NORM_LD(row)
    for (; row < T_; row += stride) {
        f32x4 v[2][8]; int p[2][2]; float g[2][2];
#pragma unroll
        for (int u = 0; u < 2; ++u) { p[u][0] = pp[u][0]; p[u][1] = pp[u][1]; g[u][0] = pg[u][0]; g[u][1] = pg[u][1];
#pragma unroll
            for (int i = 0; i < 8; ++i) v[u][i] = F32 ? rf[u][i] : (f32x4){bf_lo(rb[u][i].x), bf_hi(rb[u][i].x), bf_lo(rb[u][i].y), bf_hi(rb[u][i].y)}; }
        if (row + stride < T_) NORM_LD(row + stride)
        if (MODE >= 1) {
            int y[2][8][2];
#pragma unroll
            for (int u = 0; u < 2; ++u) {
#pragma unroll
                for (int i = 0; i < 8; ++i) { const int c = (i * 64 + lane) * 4; y[u][i][0] = *(const int*)(ym + (size_t)p[u][0] * D_ + c); y[u][i][1] = *(const int*)(ym + (size_t)p[u][1] * D_ + c); } }
#pragma unroll
            for (int u = 0; u < 2; ++u) { const float g0 = g[u][0], g1 = g[u][1];
#pragma unroll
                for (int i = 0; i < 8; ++i) { const int y0 = y[u][i][0], y1 = y[u][i][1];
                    const f32x2 a0 = __builtin_amdgcn_cvt_pk_f32_fp8(y0, false), a1 = __builtin_amdgcn_cvt_pk_f32_fp8(y0, true), b0 = __builtin_amdgcn_cvt_pk_f32_fp8(y1, false), b1 = __builtin_amdgcn_cvt_pk_f32_fp8(y1, true);
                    v[u][i][0] += g0 * a0[0] + g1 * b0[0]; v[u][i][1] += g0 * a0[1] + g1 * b0[1]; v[u][i][2] += g0 * a1[0] + g1 * b1[0]; v[u][i][3] += g0 * a1[1] + g1 * b1[1]; }
                if (MODE == 1) {
#pragma unroll
                    for (int i = 0; i < 8; ++i) { u32x2 w; w.x = cvt_pk_bf16(v[u][i][0], v[u][i][1]); w.y = cvt_pk_bf16(v[u][i][2], v[u][i][3]); *(u32x2*)(xw + (size_t)(row + u) * D_ + (i * 64 + lane) * 4) = w; } } }
        }
#pragma unroll
        for (int u = 0; u < 2; ++u) {
            float ss = 0.f;
#pragma unroll
            for (int i = 0; i < 8; ++i) ss += v[u][i][0] * v[u][i][0] + v[u][i][1] * v[u][i][1] + v[u][i][2] * v[u][i][2] + v[u][i][3] * v[u][i][3];
            ss = wave_sum(ss);
            const float rstd = rsqrtf(ss * (1.0f / D_) + 1e-6f);
#pragma unroll
            for (int i = 0; i < 8; ++i) { const int c = (i * 64 + lane) * 4; const f32x4 gn = *(const f32x4*)(gain + c);
                const f32x4 o = v[u][i] * rstd * gn;
                if (MODE == 2) *(f32x4*)(a.out + (size_t)(row + u) * D_ + c) = o;
                else { if (MODE != 1) { u32x2 w; w.x = cvt_pk_bf16(o[0], o[1]); w.y = cvt_pk_bf16(o[2], o[3]); *(u32x2*)(hw + (size_t)(row + u) * D_ + c) = w; }
                       if (layer >= 0) *(unsigned*)(a.ws + WS_H8 + (size_t)(row + u) * D_ + c) = pk_fp8x4(o[0], o[1], o[2], o[3]); } } }
    }
#undef NORM_LD
    (void)layer;
}

__device__ __forceinline__ void phase_gemm_in0(const Args& a, LAS unsigned char* lds) {
    SrcGrid S{(const char*)(a.ws + WS_H), (const char*)(a.ws + WS_WIN0T), (size_t)BM * D_ * 2, (size_t)BM * D_ * 2, 64, 64 * 24, D_, D_};
    EpiProj E{(bf16_t*)(a.ws + WS_PROJ), N_IN0, (float*)(a.ws + WS_FLOG), 1024, 12, 16, 256, 1.0f};
    gemm_stream<false, false>(lds, S, D_ / BK, E);
}

__device__ __forceinline__ void phase_rg_conv(const Args& a) {
    const bf16_t* p0 = (const bf16_t*)(a.ws + WS_PROJ); bf16_t* xc = (bf16_t*)(a.ws + WS_XC);
    const float* cw = a.in[5]; const float* cb = a.in[6];
    for (int it = BID * NTHREADS + TIDX; it < 128 * (T_ / 16); it += NBLK * NTHREADS) { const int c = (it & 127) * 8; const size_t t0 = (size_t)(it >> 7) * 16;
        float w[4][8], bias[8];
#pragma unroll
        for (int k = 0; k < 4; ++k) { const f32x4 w0 = *(const f32x4*)(cw + k * 1024 + c), w1 = *(const f32x4*)(cw + k * 1024 + c + 4);
            w[k][0] = w0[0]; w[k][1] = w0[1]; w[k][2] = w0[2]; w[k][3] = w0[3]; w[k][4] = w1[0]; w[k][5] = w1[1]; w[k][6] = w1[2]; w[k][7] = w1[3]; }
        { const f32x4 b0 = *(const f32x4*)(cb + c), b1 = *(const f32x4*)(cb + c + 4); bias[0] = b0[0]; bias[1] = b0[1]; bias[2] = b0[2]; bias[3] = b0[3]; bias[4] = b1[0]; bias[5] = b1[1]; bias[6] = b1[2]; bias[7] = b1[3]; }
        u32x4 x0 = (u32x4){0u, 0u, 0u, 0u}, x1 = x0, x2 = x0;
        if ((t0 & (S_ - 1)) != 0) { x0 = *(const u32x4*)(p0 + (t0 - 3) * N_IN0 + c); x1 = *(const u32x4*)(p0 + (t0 - 2) * N_IN0 + c); x2 = *(const u32x4*)(p0 + (t0 - 1) * N_IN0 + c); }
#pragma unroll 4
        for (int r = 0; r < 16; ++r) { const u32x4 x3 = *(const u32x4*)(p0 + (t0 + r) * N_IN0 + c);
            float acc[8];
#define TAPS(j, f, m) (bias[j] + w[0][j] * f(x0.m) + w[1][j] * f(x1.m) + w[2][j] * f(x2.m) + w[3][j] * f(x3.m))
            acc[0] = TAPS(0, bf_lo, x); acc[1] = TAPS(1, bf_hi, x); acc[2] = TAPS(2, bf_lo, y); acc[3] = TAPS(3, bf_hi, y);
            acc[4] = TAPS(4, bf_lo, z); acc[5] = TAPS(5, bf_hi, z); acc[6] = TAPS(6, bf_lo, w); acc[7] = TAPS(7, bf_hi, w);
#undef TAPS
            u32x4 o; o.x = cvt_pk_bf16(acc[0], acc[1]); o.y = cvt_pk_bf16(acc[2], acc[3]); o.z = cvt_pk_bf16(acc[4], acc[5]); o.w = cvt_pk_bf16(acc[6], acc[7]);
            *(u32x4*)(xc + (t0 + r) * 1024 + c) = o;
            x0 = x1; x1 = x2; x2 = x3; } }
}

struct SrcRgGates {
    const char* xc; const char* w; int total;
    __device__ __forceinline__ bool next(int i, UnitD& u) const { const int id = BID + i * NBLK; if (id >= total) return false; u.t0 = id & 63; u.t1 = id >> 6; u.t2 = 0;
        u.gA = xc + ((size_t)u.t0 * BM * 1024 + u.t1 * 128) * 2; u.gB = w + (size_t)u.t1 * 256 * 128 * 2; return true; }
    __device__ __forceinline__ void va(const UnitD&, unsigned (&v)[2][2]) const { offs_direct(v, 1024, false); }
    __device__ __forceinline__ void vb(unsigned (&v)[2][2]) const { offs_direct(v, 128, true); }
};
__device__ __forceinline__ void phase_rg_gates(const Args& a, LAS unsigned char* lds) {
    SrcRgGates S{(const char*)(a.ws + WS_XC), (const char*)(a.ws + WS_WGATES), 64 * 8};
    EpiRgGates E{(bf16_t*)(a.ws + WS_A), (bf16_t*)(a.ws + WS_U), (const bf16_t*)(a.ws + WS_XC), a.in[8], a.in[10], a.in[11]};
    int nt = 2; asm volatile("" : "+s"(nt));
    gemm_stream<false, false>(lds, S, nt, E);
}

__device__ __forceinline__ void phase_rg_scan(const Args& a, LAS unsigned char* lds) {
    const bf16_t* LA = (const bf16_t*)(a.ws + WS_A); const bf16_t* U = (const bf16_t*)(a.ws + WS_U);
    const bf16_t* p0 = (const bf16_t*)(a.ws + WS_PROJ); bf16_t* Y = (bf16_t*)(a.ws + WS_Y);
    LAS float* sP = (LAS float*)lds; LAS float* sH = sP + 4096; LAS float* gP = sH + 4096; LAS float* gH = gP + 512; LAS float* gC = gH + 512;
    const int tid = TIDX, seg = tid >> 1, c8 = (tid & 1) * 8;
    for (int blk = BID; blk < NB_ * 64; blk += NBLK) { const int b = blk >> 6, c = (blk & 63) * 16 + c8;
        const size_t base = (((size_t)blk * S_ + seg * 16) << 4) + c8;
        float P[8], H[8];
#pragma unroll
        for (int j = 0; j < 8; ++j) { P[j] = 1.f; H[j] = 0.f; }
#pragma unroll 4
        for (int s = 0; s < 16; ++s) { const u32x4 lw = *(const u32x4*)(LA + base + (size_t)s * 16), uw = *(const u32x4*)(U + base + (size_t)s * 16);
            const float la[8] = {bf_lo(lw.x), bf_hi(lw.x), bf_lo(lw.y), bf_hi(lw.y), bf_lo(lw.z), bf_hi(lw.z), bf_lo(lw.w), bf_hi(lw.w)};
            const float uu[8] = {bf_lo(uw.x), bf_hi(uw.x), bf_lo(uw.y), bf_hi(uw.y), bf_lo(uw.z), bf_hi(uw.z), bf_lo(uw.w), bf_hi(uw.w)};
#pragma unroll
            for (int j = 0; j < 8; ++j) { const float av = __expf(la[j]); H[j] = av * H[j] + uu[j]; P[j] *= av; } }
        __syncthreads();
#pragma unroll
        for (int j = 0; j < 8; ++j) { sP[seg * 16 + c8 + j] = P[j]; sH[seg * 16 + c8 + j] = H[j]; }
        __syncthreads();
        { const int ch = tid & 15, grp = tid >> 4; float p = 1.f, h = 0.f;
#pragma unroll
          for (int q = 0; q < 8; ++q) { const int sgi = grp * 8 + q; h = sP[sgi * 16 + ch] * h + sH[sgi * 16 + ch]; p *= sP[sgi * 16 + ch]; }
          gP[grp * 16 + ch] = p; gH[grp * 16 + ch] = h; }
        __syncthreads();
        if (tid < 16) { float carry = 0.f; for (int g = 0; g < 32; ++g) { gC[g * 16 + tid] = carry; carry = gP[g * 16 + tid] * carry + gH[g * 16 + tid]; } }
        __syncthreads();
        { const int ch = tid & 15, grp = tid >> 4; float h = gC[grp * 16 + ch];
#pragma unroll
          for (int q = 0; q < 8; ++q) { const int sgi = grp * 8 + q; const float pin = sP[sgi * 16 + ch], hin = sH[sgi * 16 + ch]; sH[sgi * 16 + ch] = h; h = pin * h + hin; } }
        __syncthreads();
#pragma unroll
        for (int j = 0; j < 8; ++j) H[j] = sH[seg * 16 + c8 + j];
#pragma unroll 4
        for (int s = 0; s < 16; ++s) { const u32x4 lw = *(const u32x4*)(LA + base + (size_t)s * 16), uw = *(const u32x4*)(U + base + (size_t)s * 16);
            const size_t t = (size_t)b * S_ + seg * 16 + s; const u32x4 gw = *(const u32x4*)(p0 + t * N_IN0 + 1024 + c);
            const float la[8] = {bf_lo(lw.x), bf_hi(lw.x), bf_lo(lw.y), bf_hi(lw.y), bf_lo(lw.z), bf_hi(lw.z), bf_lo(lw.w), bf_hi(lw.w)};
            const float uu[8] = {bf_lo(uw.x), bf_hi(uw.x), bf_lo(uw.y), bf_hi(uw.y), bf_lo(uw.z), bf_hi(uw.z), bf_lo(uw.w), bf_hi(uw.w)};
            const float gg[8] = {bf_lo(gw.x), bf_hi(gw.x), bf_lo(gw.y), bf_hi(gw.y), bf_lo(gw.z), bf_hi(gw.z), bf_lo(gw.w), bf_hi(gw.w)};
            float y[8];
#pragma unroll
            for (int j = 0; j < 8; ++j) { H[j] = __expf(la[j]) * H[j] + uu[j]; y[j] = H[j] * gelu_tanh(gg[j]); }
            u32x4 o; o.x = cvt_pk_bf16(y[0], y[1]); o.y = cvt_pk_bf16(y[2], y[3]); o.z = cvt_pk_bf16(y[4], y[5]); o.w = cvt_pk_bf16(y[6], y[7]);
            *(u32x4*)(Y + t * D_ + c) = o; }
    }
}

typedef short s16x4 __attribute__((ext_vector_type(4)));
__device__ __forceinline__ f32x4 mfma32(bf16x8 a, bf16x8 b, f32x4 c) { return __builtin_amdgcn_mfma_f32_16x16x32_bf16(a, b, c, 0, 0, 0); }
__device__ __forceinline__ bf16x8 lds_frag(LAS const unsigned char* p) { return *(const LAS bf16x8*)p; }
__device__ __forceinline__ s16x4 lds_tr4(LAS const unsigned char* p) { return __builtin_amdgcn_ds_read_tr16_b64_v4i16((LAS s16x4*)p); }
__device__ __forceinline__ bf16x8 lds_tr8(LAS const unsigned char* p, int rowskip_bytes) {
    const s16x4 lo = lds_tr4(p), hi = lds_tr4(p + rowskip_bytes); return __builtin_shufflevector(lo, hi, 0, 1, 2, 3, 4, 5, 6, 7); }
__device__ __forceinline__ bf16x8 pack8(const f32x4& lo, const f32x4& hi) { u32x4 w; w.x = cvt_pk_bf16(lo[0], lo[1]); w.y = cvt_pk_bf16(lo[2], lo[3]); w.z = cvt_pk_bf16(hi[0], hi[1]); w.w = cvt_pk_bf16(hi[2], hi[3]); return __builtin_bit_cast(bf16x8, w); }
constexpr int RSB = 272;

constexpr size_t WS_HQ = WS_O;
constexpr size_t WS_HA = WS_HQ + (size_t)2048 * 64 * 128 * 2;
constexpr size_t WS_HG = WS_HA + (size_t)2048 * 8 * 512 * 2;
constexpr size_t WS_HS = WS_HG + (size_t)2048 * 128 * 128 * 2;
constexpr size_t WS_HD = WS_HS + (size_t)2048 * 128 * 128 * 2;
static_assert(WS_HD + (size_t)2048 * 128 * 4 <= WS_TAIL, "hgrn overlay");

__device__ __forceinline__ void phase_hg1(const Args& a, LAS unsigned char* lds) {
    const bf16_t* p0 = (const bf16_t*)(a.ws + WS_PROJ); const float* flog = (const float*)(a.ws + WS_FLOG); const float* lb = (const float*)(a.ws + WS_LB);
    bf16_t* QG = (bf16_t*)(a.ws + WS_HQ); bf16_t* AG = (bf16_t*)(a.ws + WS_HA); bf16_t* GG = (bf16_t*)(a.ws + WS_HG); float* DG = (float*)(a.ws + WS_HD);
    constexpr int SEG = 0, QT = 4096, KT = QT + 64 * RSB, KH = KT + 64 * RSB, VS = KH + 64 * RSB;
    const int tid = TIDX, wid = tid >> 6, lane = tid & 63, I = lane & 15, G = lane >> 4, k2 = 2 * lane, sg = wid;
    LAS float* seg = (LAS float*)(lds + SEG);
    u32x4 pvv[2]; f32x2 pz[8]; unsigned pqw[8];
#define HG1_LOAD(it_) do { const int bh_ = (it_) >> 6, ck_ = (it_) & 63, h_ = bh_ & 7; const size_t t0_ = (size_t)(bh_ >> 3) * S_ + ck_ * 64; \
        _Pragma("unroll") for (int i = 0; i < 2; ++i) { const int c = tid + i * 512, s_ = c >> 4, v8 = (c & 15) * 8; pvv[i] = *(const u32x4*)(p0 + (t0_ + s_) * N_IN0 + 4096 + h_ * 128 + v8); } \
        _Pragma("unroll") for (int i = 0; i < 8; ++i) { const size_t t_ = t0_ + sg * 8 + i; pz[i] = *(const f32x2*)(flog + t_ * 1024 + h_ * 128 + k2); pqw[i] = *(const unsigned*)(p0 + t_ * N_IN0 + 2048 + h_ * 128 + k2); } } while (0)
    if (BID < 2048) HG1_LOAD(BID);
    for (int item = BID; item < 2048; item += NBLK) { const int bh = item >> 6, h = bh & 7;
        LDS_BARRIER();
#pragma unroll
        for (int i = 0; i < 2; ++i) { const int c = tid + i * 512, s = c >> 4, v8 = (c & 15) * 8; *(LAS u32x4*)(lds + VS + s * RSB + v8 * 2) = pvv[i]; }
        const f32x2 l2 = *(const f32x2*)(lb + h * 128 + k2);
        float f[8][2], cb[8][2]; unsigned qw[8]; float c0 = 0.f, c1 = 0.f;
#pragma unroll
        for (int i = 0; i < 8; ++i) { const f32x2 z = pz[i]; qw[i] = pqw[i];
            f[i][0] = l2[0] + (1.0f - l2[0]) * sigmoidf_(z[0]); f[i][1] = l2[1] + (1.0f - l2[1]) * sigmoidf_(z[1]);
            c0 += __logf(f[i][0]); c1 += __logf(f[i][1]); cb[i][0] = c0; cb[i][1] = c1; }
        *(LAS f32x2*)(seg + sg * 128 + k2) = (f32x2){c0, c1};
        if (item + NBLK < 2048) HG1_LOAD(item + NBLK);
        LDS_BARRIER();
        float off0 = 0.f, off1 = 0.f, tot0 = 0.f, tot1 = 0.f;
#pragma unroll
        for (int s2 = 0; s2 < 8; ++s2) { const f32x2 v = *(const LAS f32x2*)(seg + s2 * 128 + k2); tot0 += v[0]; tot1 += v[1]; if (s2 < sg) { off0 += v[0]; off1 += v[1]; } }
        const float et0 = __expf(tot0), et1 = __expf(tot1);
#pragma unroll
        for (int i = 0; i < 8; ++i) { const int t = sg * 8 + i;
            const float e0 = __expf(cb[i][0] + off0), e1 = __expf(cb[i][1] + off1), r0 = __builtin_amdgcn_rcpf(e0), r1 = __builtin_amdgcn_rcpf(e1), km0 = 1.0f - f[i][0], km1 = 1.0f - f[i][1];
            const unsigned qt = cvt_pk_bf16(siluf_(bf_lo(qw[i])) * e0, siluf_(bf_hi(qw[i])) * e1);
            *(LAS unsigned*)(lds + QT + t * RSB + k2 * 2) = qt; *(unsigned*)(QG + ((size_t)item * 64 + t) * 128 + k2) = qt;
            *(LAS unsigned*)(lds + KT + t * RSB + k2 * 2) = cvt_pk_bf16(km0 * r0, km1 * r1);
            *(LAS unsigned*)(lds + KH + t * RSB + k2 * 2) = cvt_pk_bf16(km0 * r0 * et0, km1 * r1 * et1); }
        if (sg == 0) *(f32x2*)(DG + (size_t)item * 128 + k2) = (f32x2){et0, et1};
        LDS_BARRIER();
        { const int tt = wid & 3, sp = wid >> 2;
          bf16x8 qf[4];
#pragma unroll
          for (int ks = 0; ks < 4; ++ks) qf[ks] = lds_frag(lds + QT + (16 * tt + I) * RSB + (32 * ks + 8 * G) * 2);
          f32x4 acc[2];
#pragma unroll
          for (int hh = 0; hh < 2; ++hh) { const int st = 2 * sp + hh; acc[hh] = (f32x4){0.f, 0.f, 0.f, 0.f};
              if (st <= tt) {
#pragma unroll
                  for (int ks = 0; ks < 4; ++ks) acc[hh] = mfma32(lds_frag(lds + KT + (16 * st + I) * RSB + (32 * ks + 8 * G) * 2), qf[ks], acc[hh]);
#pragma unroll
                  for (int r = 0; r < 4; ++r) if (16 * st + 4 * G + r > 16 * tt + I) acc[hh][r] = 0.f; } }
          *(bf16x8*)(AG + (((size_t)item * 4 + tt) * 2 + sp) * 512 + lane * 8) = pack8(acc[0], acc[1]); }
        { const int kt = wid, q = I >> 2, p = I & 3;
          bf16x8 ka[2];
#pragma unroll
          for (int ks = 0; ks < 2; ++ks) ka[ks] = lds_tr8(lds + KH + (32 * ks + 8 * G + q) * RSB + (16 * kt + 4 * p) * 2, 4 * RSB);
#pragma unroll
          for (int vt = 0; vt < 8; ++vt) { f32x4 acc = (f32x4){0.f, 0.f, 0.f, 0.f};
#pragma unroll
              for (int ks = 0; ks < 2; ++ks) acc = mfma32(ka[ks], lds_tr8(lds + VS + (32 * ks + 8 * G + q) * RSB + (16 * vt + 4 * p) * 2, 4 * RSB), acc);
              u32x2 w; w.x = cvt_pk_bf16(acc[0], acc[1]); w.y = cvt_pk_bf16(acc[2], acc[3]);
              *(u32x2*)(GG + ((size_t)item * 128 + 16 * vt + I) * 128 + 16 * kt + 4 * G) = w; } }
    }
#undef HG1_LOAD
}

__device__ __forceinline__ void phase_hg2(const Args& a) {
    const bf16_t* GG = (const bf16_t*)(a.ws + WS_HG); const float* DG = (const float*)(a.ws + WS_HD); bf16_t* SG = (bf16_t*)(a.ws + WS_HS);
    for (int gid = BID * NTHREADS + TIDX; gid < 32 * 4096; gid += NBLK * NTHREADS) { const int bh = gid >> 12, e = gid & 4095, v = e >> 5, k4 = (e & 31) * 4;
        f32x4 S = (f32x4){0.f, 0.f, 0.f, 0.f};
        const size_t o0 = (((size_t)bh * 64) * 128 + v) * 128 + k4; const float* dg = DG + (size_t)bh * 64 * 128 + k4;
        f32x4 da[8]; u32x2 ga[8];
#pragma unroll
        for (int j = 0; j < 8; ++j) { da[j] = *(const f32x4*)(dg + j * 128); ga[j] = *(const u32x2*)(GG + o0 + (size_t)j * 16384); }
#pragma unroll 1
        for (int n0 = 0; n0 < 64; n0 += 8) { f32x4 db[8]; u32x2 gb[8];
#pragma unroll
            for (int j = 0; j < 8; ++j) { db[j] = da[j]; gb[j] = ga[j]; }
            if (n0 + 8 < 64) {
#pragma unroll
                for (int j = 0; j < 8; ++j) { db[j] = *(const f32x4*)(dg + (n0 + 8 + j) * 128); gb[j] = *(const u32x2*)(GG + o0 + (size_t)(n0 + 8 + j) * 16384); } }
#pragma unroll
            for (int j = 0; j < 8; ++j) { u32x2 w; w.x = cvt_pk_bf16(S[0], S[1]); w.y = cvt_pk_bf16(S[2], S[3]); *(u32x2*)(SG + o0 + (size_t)(n0 + j) * 16384) = w;
                const f32x4 d = da[j]; const u32x2 g = ga[j];
                S[0] = d[0] * S[0] + bf_lo(g.x); S[1] = d[1] * S[1] + bf_hi(g.x); S[2] = d[2] * S[2] + bf_lo(g.y); S[3] = d[3] * S[3] + bf_hi(g.y); }
#pragma unroll
            for (int j = 0; j < 8; ++j) { da[j] = db[j]; ga[j] = gb[j]; } } }
}

__device__ __forceinline__ void phase_hg3(const Args& a, LAS unsigned char* lds) {
    const bf16_t* p0 = (const bf16_t*)(a.ws + WS_PROJ); const bf16_t* QG = (const bf16_t*)(a.ws + WS_HQ); const bf16_t* AG = (const bf16_t*)(a.ws + WS_HA); const bf16_t* SG = (const bf16_t*)(a.ws + WS_HS);
    bf16_t* Y = (bf16_t*)(a.ws + WS_Y); const float* gain = a.in[13];
    constexpr int ST = 0, QT = 128 * RSB, VS = QT + 64 * RSB, PART = VS + 64 * RSB;
    const int tid = TIDX, wid = tid >> 6, lane = tid & 63, I = lane & 15, G = lane >> 4, q = I >> 2, p = I & 3;
    LAS float* part = (LAS float*)(lds + PART);
    const int tt = wid & 3, vh = wid >> 2;
    u32x4 ps[4], pq2[2], pv2[2]; bf16x8 paf[2];
#define HG3_LOAD(it_) do { const int bh_ = (it_) >> 6, ck_ = (it_) & 63; const size_t t0_ = (size_t)(bh_ >> 3) * S_ + ck_ * 64; const int h_ = bh_ & 7; \
        _Pragma("unroll") for (int i = 0; i < 4; ++i) { const int c = tid + i * 512, v = c >> 4, k8 = (c & 15) * 8; ps[i] = *(const u32x4*)(SG + ((size_t)(it_) * 128 + v) * 128 + k8); } \
        _Pragma("unroll") for (int i = 0; i < 2; ++i) { const int c = tid + i * 512, s_ = c >> 4, c8 = (c & 15) * 8; pq2[i] = *(const u32x4*)(QG + ((size_t)(it_) * 64 + s_) * 128 + c8); pv2[i] = *(const u32x4*)(p0 + (t0_ + s_) * N_IN0 + 4096 + h_ * 128 + c8); } \
        _Pragma("unroll") for (int sp = 0; sp < 2; ++sp) paf[sp] = *(const bf16x8*)(AG + (((size_t)(it_) * 4 + tt) * 2 + sp) * 512 + lane * 8); } while (0)
    if (BID < 2048) HG3_LOAD(BID);
    for (int item = BID; item < 2048; item += NBLK) { const int bh = item >> 6, ck = item & 63, b = bh >> 3, h = bh & 7; const size_t t0 = (size_t)b * S_ + ck * 64;
        LDS_BARRIER();
#pragma unroll
        for (int i = 0; i < 4; ++i) { const int c = tid + i * 512, v = c >> 4, k8 = (c & 15) * 8; *(LAS u32x4*)(lds + ST + v * RSB + k8 * 2) = ps[i]; }
#pragma unroll
        for (int i = 0; i < 2; ++i) { const int c = tid + i * 512, s2 = c >> 4, c8 = (c & 15) * 8; *(LAS u32x4*)(lds + QT + s2 * RSB + c8 * 2) = pq2[i]; *(LAS u32x4*)(lds + VS + s2 * RSB + c8 * 2) = pv2[i]; }
        bf16x8 af[2]; af[0] = paf[0]; af[1] = paf[1];
        if (item + NBLK < 2048) HG3_LOAD(item + NBLK);
        u32x2 zwp[4];
#pragma unroll
        for (int vi = 0; vi < 4; ++vi) zwp[vi] = *(const u32x2*)(p0 + (t0 + 16 * tt + I) * N_IN0 + 5120 + h * 128 + 16 * (4 * vh + vi) + 4 * G);
        LDS_BARRIER();
        bf16x8 qf[4];
#pragma unroll
        for (int ks = 0; ks < 4; ++ks) qf[ks] = lds_frag(lds + QT + (16 * tt + I) * RSB + (32 * ks + 8 * G) * 2);
        f32x4 acc[4]; float ss = 0.f;
#pragma unroll
        for (int vi = 0; vi < 4; ++vi) { const int vt = 4 * vh + vi; acc[vi] = (f32x4){0.f, 0.f, 0.f, 0.f};
#pragma unroll
            for (int ks = 0; ks < 4; ++ks) acc[vi] = mfma32(lds_frag(lds + ST + (16 * vt + I) * RSB + (32 * ks + 8 * G) * 2), qf[ks], acc[vi]);
#pragma unroll
            for (int sp = 0; sp < 2; ++sp) acc[vi] = mfma32(lds_tr8(lds + VS + (32 * sp + 4 * G + q) * RSB + (16 * vt + 4 * p) * 2, 16 * RSB), af[sp], acc[vi]);
            ss += acc[vi][0] * acc[vi][0] + acc[vi][1] * acc[vi][1] + acc[vi][2] * acc[vi][2] + acc[vi][3] * acc[vi][3]; }
        ss += __shfl_xor(ss, 16); ss += __shfl_xor(ss, 32);
        if (G == 0) part[wid * 16 + I] = ss;
        LDS_BARRIER();
        const float rstd = rsqrtf((part[wid * 16 + I] + part[(wid ^ 4) * 16 + I]) * (1.0f / 128.0f) + 1e-6f);
        const size_t t = t0 + 16 * tt + I;
#pragma unroll
        for (int vi = 0; vi < 4; ++vi) { const int c = h * 128 + 16 * (4 * vh + vi) + 4 * G;
            const f32x4 gn = *(const f32x4*)(gain + c); const u32x2 zw = zwp[vi];
            const float o0 = acc[vi][0] * rstd * gn[0] * siluf_(bf_lo(zw.x)), o1 = acc[vi][1] * rstd * gn[1] * siluf_(bf_hi(zw.x)), o2 = acc[vi][2] * rstd * gn[2] * siluf_(bf_lo(zw.y)), o3 = acc[vi][3] * rstd * gn[3] * siluf_(bf_hi(zw.y));
            u32x2 w; w.x = cvt_pk_bf16(o0, o1); w.y = cvt_pk_bf16(o2, o3); *(u32x2*)(Y + t * D_ + 1024 + c) = w; }
    }
#undef HG3_LOAD
}

__device__ __forceinline__ void phase_gdn_norm(const Args& a) {
    const bf16_t* O = (const bf16_t*)(a.ws + WS_O); const bf16_t* pj = (const bf16_t*)(a.ws + WS_PROJ); unsigned char* Y = a.ws + WS_Y; const float* gain = a.in[19];
    const int lane = TIDX & 63, wid = TIDX >> 6, gc = (lane & 15) * 8;
    const f32x4 g0 = *(const f32x4*)(gain + gc), g1 = *(const f32x4*)(gain + gc + 4);
    u32x4 oa[8], za[8];
    int row = BID * 8 + wid; const int stride = NBLK * 8;
#define GN_LD(ov, zv, r) { _Pragma("unroll") for (int i = 0; i < 8; ++i) { const int c = (i * 64 + lane) * 8; ov[i] = *(const u32x4*)(O + (size_t)(r) * 4096 + c); zv[i] = *(const u32x4*)(pj + (size_t)(r) * N_IN1P + 8192 + c); } }
    if (row < T_) GN_LD(oa, za, row)
    for (; row < T_; row += stride) { u32x4 ob[8], zb[8];
#pragma unroll
        for (int i = 0; i < 8; ++i) { ob[i] = oa[i]; zb[i] = za[i]; }
        if (row + stride < T_) GN_LD(ob, zb, row + stride)
#pragma unroll
        for (int i = 0; i < 8; ++i) { const int c = (i * 64 + lane) * 8;
            const u32x4 ow = oa[i], zw = za[i];
            const float o[8] = {bf_lo(ow.x), bf_hi(ow.x), bf_lo(ow.y), bf_hi(ow.y), bf_lo(ow.z), bf_hi(ow.z), bf_lo(ow.w), bf_hi(ow.w)};
            const float z[8] = {bf_lo(zw.x), bf_hi(zw.x), bf_lo(zw.y), bf_hi(zw.y), bf_lo(zw.z), bf_hi(zw.z), bf_lo(zw.w), bf_hi(zw.w)};
            float ss = 0.f;
#pragma unroll
            for (int q = 0; q < 8; ++q) ss += o[q] * o[q];
            ss = row16_sum(ss);
            const float rstd = rsqrtf(ss * (1.0f / 128.0f) + 1e-6f);
            float y[8];
#pragma unroll
            for (int q = 0; q < 8; ++q) y[q] = o[q] * rstd * (q < 4 ? g0[q & 3] : g1[q & 3]) * siluf_(z[q]);
            u32x2 w; w.x = pk_fp8x4(y[0], y[1], y[2], y[3]); w.y = pk_fp8x4(y[4], y[5], y[6], y[7]);
            *(u32x2*)(Y + (size_t)row * 4096 + c) = w; }
#pragma unroll
        for (int i = 0; i < 8; ++i) { oa[i] = ob[i]; za[i] = zb[i]; }
    }
#undef GN_LD
}

template <bool FP8>
__device__ __forceinline__ void phase_gemm_out(const Args& a, LAS unsigned char* lds, int K, const void* w, const float* xin) {
    const int eb = FP8 ? 1 : 2;
    SrcGrid S{(const char*)(a.ws + WS_Y), (const char*)w, (size_t)BM * K * eb, (size_t)BM * K * eb, 64, 64 * 8, K * eb / 2, K * eb / 2};
    EpiResid E{(bf16_t*)(a.ws + WS_X), xin, (const bf16_t*)(a.ws + WS_X), FP8 ? 1.0f / W8_SCALE : 1.0f};
    gemm_stream<false, FP8>(lds, S, K * eb / 128, E);
}

struct SrcRouter {
    const char* h; const char* w;
    __device__ __forceinline__ bool next(int i, UnitD& u) const { const int id = BID + i * NBLK; if (id >= 256) return false; u.t0 = id & 63; u.t1 = id >> 6; u.t2 = 0;
        u.gA = h + ((size_t)u.t0 * BM * D_ + u.t1 * 512) * 2; u.gB = w + (size_t)u.t1 * 512 * 2; return true; }
    __device__ __forceinline__ void va(const UnitD&, unsigned (&v)[2][2]) const { offs_direct(v, D_, false); }
    __device__ __forceinline__ void vb(unsigned (&v)[2][2]) const { offs_direct(v, D_, true); }
};
struct EpiLogitsQ {
    float* O;
    __device__ __forceinline__ void operator()(const Acc& acc, const UnitD& u, int wr, int wc, int fr, int fq) const { store_f32_tile(acc, O + ((size_t)u.t1 * T_ + (size_t)u.t0 * BM) * 128, nullptr, 128, 128, wr, wc, fr, fq); }
};
__device__ __forceinline__ void phase_gemm_router(const Args& a, LAS unsigned char* lds, int layer) {
    SrcRouter S{(const char*)(a.ws + WS_H), (const char*)(a.ws + WS_WRT) + (size_t)layer * 256 * D_ * 2};
    EpiLogitsQ E{(float*)(a.ws + WS_O)};
    gemm_stream<false, false>(lds, S, 512 / BK, E);
}

__device__ __forceinline__ void phase_route(const Args& a, int layer) {
    const float* lg = (const float*)(a.ws + WS_O); const float* bg = a.in[22] + layer * 8; const float* be = a.in[24] + layer * 64;
    int* cnt = (int*)(a.ws + WS_CTL + CTL_CNT) + layer * 64;
    int* eid = (int*)(a.ws + WS_EID); int* slot = (int*)(a.ws + WS_SLOT); float* gate = (float*)(a.ws + WS_GATE); int* rowmap = (int*)(a.ws + WS_ROWMAP);
    const int gtid = BID * NTHREADS + TIDX, gsz = NBLK * NTHREADS;
    for (int i = gtid; i < MPAD; i += gsz) rowmap[i] = 0;
    for (int t = gtid; t < T_; t += gsz) {
        f32x4 ga = (f32x4){0.f, 0.f, 0.f, 0.f}, gb = ga;
#pragma unroll
        for (int kq = 0; kq < 4; ++kq) { ga += *(const f32x4*)(lg + ((size_t)kq * T_ + t) * 128); gb += *(const f32x4*)(lg + ((size_t)kq * T_ + t) * 128 + 4); }
        const float gl[8] = {ga[0] + bg[0], ga[1] + bg[1], ga[2] + bg[2], ga[3] + bg[3], gb[0] + bg[4], gb[1] + bg[5], gb[2] + bg[6], gb[3] + bg[7]};
        float mx = -3.0e38f; int gi = 0;
#pragma unroll
        for (int j = 0; j < 8; ++j) if (gl[j] > mx) { mx = gl[j]; gi = j; }
        float se = 0.f;
#pragma unroll
        for (int j = 0; j < 8; ++j) se += __expf(gl[j] - mx);
        const float gp = 1.0f / se;
        f32x4 ea = *(const f32x4*)(be + gi * 8), eb = *(const f32x4*)(be + gi * 8 + 4);
#pragma unroll
        for (int kq = 0; kq < 4; ++kq) { ea += *(const f32x4*)(lg + ((size_t)kq * T_ + t) * 128 + 8 + gi * 8); eb += *(const f32x4*)(lg + ((size_t)kq * T_ + t) * 128 + 12 + gi * 8); }
        const float el[8] = {ea[0], ea[1], ea[2], ea[3], eb[0], eb[1], eb[2], eb[3]};
        float l1 = -3.0e38f, l2 = -3.0e38f; int i1 = 0, i2 = 0;
#pragma unroll
        for (int j = 0; j < 8; ++j) { const float v = el[j];
            if (v > l1) { l2 = l1; i2 = i1; l1 = v; i1 = j; } else if (v > l2) { l2 = v; i2 = j; } }
        const float e2 = __expf(l2 - l1), inv = 1.0f / (1.0f + e2);
        const int e0 = gi * 8 + i1, e1 = gi * 8 + i2;
        eid[t * 2] = e0; eid[t * 2 + 1] = e1; gate[t * 2] = inv * gp; gate[t * 2 + 1] = e2 * inv * gp;
        slot[t * 2] = atomicAdd(&cnt[e0], 1); slot[t * 2 + 1] = atomicAdd(&cnt[e1], 1); }
}

__device__ __forceinline__ void phase_rowmap(const Args& a, LAS unsigned char* lds, int layer) {
    const int* cnt = (const int*)(a.ws + WS_CTL + CTL_CNT) + layer * 64; LAS int* ps = (LAS int*)lds;
    int* tinfo = (int*)(a.ws + WS_TINFO) + layer * 512;
    const int* eid = (const int*)(a.ws + WS_EID); const int* slot = (const int*)(a.ws + WS_SLOT); int* posof = (int*)(a.ws + WS_POSOF); int* rowmap = (int*)(a.ws + WS_ROWMAP);
    __syncthreads();
    if (TIDX == 0) { int acc = 0; for (int e = 0; e < 64; ++e) { ps[e] = acc; acc += (cnt[e] + 255) & ~255; } ps[64] = acc; }
    __syncthreads();
    if (BID == 0) { if (TIDX <= 64) tinfo[TIDX] = ps[TIDX]; if (TIDX == 65) tinfo[65] = ps[64] >> 8;
        if (TIDX < 192) { const int p = TIDX * 256; int e = 0; for (int j = 0; j < 64; ++j) if (ps[j + 1] <= p) e = j + 1; tinfo[128 + TIDX] = e < 64 ? e : 63; } }
    for (int i = BID * NTHREADS + TIDX; i < T_ * 2; i += NBLK * NTHREADS) { const int p = ps[eid[i]] + slot[i]; posof[i] = p; rowmap[p] = i >> 1; }
    __syncthreads();
}

struct SrcMoeUp {
    const char* h; const char* wg; const int* tinfo; const int* rowmap; int total;
    __device__ __forceinline__ bool next(int i, UnitD& u) const { const int id = BID + i * NBLK; if (id >= total) return false; u.t0 = id >> 2; u.t1 = id & 3;
        u.t2 = __builtin_amdgcn_readfirstlane(tinfo[128 + u.t0]); u.gA = h; u.gB = wg + ((size_t)u.t2 * DEXP + u.t1 * 128) * D_; return true; }
    __device__ __forceinline__ void va(const UnitD& u, unsigned (&v)[2][2]) const { int R0, C0; stage_pos(TIDX, R0, C0);
#pragma unroll
        for (int hh = 0; hh < 2; ++hh)
#pragma unroll
            for (int i = 0; i < 2; ++i) v[hh][i] = (unsigned)(rowmap[u.t0 * 256 + hh * 128 + R0 + 64 * i] * D_ + C0 * 2); }
    __device__ __forceinline__ void vb(unsigned (&v)[2][2]) const { int R0, C0; stage_pos(TIDX, R0, C0);
#pragma unroll
        for (int i = 0; i < 2; ++i) { const int Rr = perm_row(R0 + 64 * i); v[0][i] = (unsigned)(Rr * D_ + C0 * 2); v[1][i] = (unsigned)(WS_WU - WS_WG) + (unsigned)(Rr * D_ + C0 * 2); } }
};
__device__ __forceinline__ void phase_moe_up(const Args& a, LAS unsigned char* lds, int layer) {
    const int* tinfo = (const int*)(a.ws + WS_TINFO) + layer * 512;
    const int ntm = __builtin_amdgcn_readfirstlane(tinfo[65]);
    SrcMoeUp S{(const char*)(a.ws + WS_H8), (const char*)(a.ws + WS_WG), tinfo, (const int*)(a.ws + WS_ROWMAP), ntm * 4};
    EpiSwiGLU E{a.ws + WS_ACT};
    gemm_stream<true, true>(lds, S, D_ / 128, E);
}

struct SrcMoeDown {
    const char* act; const char* wd; const int* tinfo; int total;
    __device__ __forceinline__ bool next(int i, UnitD& u) const { const int id = BID + i * NBLK; if (id >= total) return false; u.t0 = id >> 3; u.t1 = id & 7;
        u.t2 = __builtin_amdgcn_readfirstlane(tinfo[128 + u.t0]); u.gA = act + (size_t)u.t0 * BM * DEXP; u.gB = wd + ((size_t)u.t2 * D_ + u.t1 * BM) * DEXP; return true; }
    __device__ __forceinline__ void va(const UnitD&, unsigned (&v)[2][2]) const { offs_direct(v, DEXP / 2, false); }
    __device__ __forceinline__ void vb(unsigned (&v)[2][2]) const { offs_direct(v, DEXP / 2, true); }
};
__device__ __forceinline__ void phase_moe_down(const Args& a, LAS unsigned char* lds, int layer) {
    const int* tinfo = (const int*)(a.ws + WS_TINFO) + layer * 512; const int ntm = __builtin_amdgcn_readfirstlane(tinfo[65]);
    SrcMoeDown S{(const char*)(a.ws + WS_ACT), (const char*)(a.ws + WS_WD), tinfo, ntm * 8};
    EpiDown E{a.ws + WS_YMOE};
    gemm_stream<false, true>(lds, S, DEXP / 128, E);
}

struct SrcIn1Tail {
    const char* h; const char* w;
    __device__ __forceinline__ bool next(int i, UnitD& u) const { const int id = BID + i * NBLK; if (id >= 256) return false; u.t0 = id & 63; u.t1 = id >> 6; u.t2 = 0;
        u.gA = h + (size_t)u.t0 * BM * D_ + u.t1 * 512; u.gB = w + (size_t)48 * BM * D_ + u.t1 * 512; return true; }
    __device__ __forceinline__ void va(const UnitD&, unsigned (&v)[2][2]) const { offs_direct(v, D_ / 2, false); }
    __device__ __forceinline__ void vb(unsigned (&v)[2][2]) const { offs_direct(v, D_ / 2, true); }
};
struct EpiTailQ {
    float* O;
    __device__ __forceinline__ void operator()(const Acc& acc, const UnitD& u, int wr, int wc, int fr, int fq) const { store_f32_tile(acc, O + ((size_t)u.t1 * T_ + (size_t)u.t0 * BM) * 64, nullptr, 64, 64, wr, wc, fr, fq, 1.0f / W8_SCALE); }
};
__device__ __forceinline__ void phase_gemm_in1(const Args& a, LAS unsigned char* lds) {
    SrcGrid S{(const char*)(a.ws + WS_H8), (const char*)(a.ws + WS_WIN1T), (size_t)BM * D_, (size_t)BM * D_, 64, 64 * 48, D_ / 2, D_ / 2};
    EpiProj E{(bf16_t*)(a.ws + WS_PROJ), N_IN1P, nullptr, 64, 48, 48, 64, 1.0f / W8_SCALE};
    gemm_stream<false, true>(lds, S, D_ / 128, E);
}
__device__ __forceinline__ void phase_gemm_in1_tail(const Args& a, LAS unsigned char* lds) {
    SrcIn1Tail S{(const char*)(a.ws + WS_H8), (const char*)(a.ws + WS_WIN1T)};
    EpiTailQ E{(float*)(a.ws + WS_O)};
    int nt = 4; asm volatile("" : "+s"(nt));
    gemm_stream<false, true>(lds, S, nt, E);
}

__device__ __forceinline__ void phase_gdn_conv(const Args& a) {
    const bf16_t* p1 = (const bf16_t*)(a.ws + WS_PROJ); bf16_t* qc = (bf16_t*)(a.ws + WS_QKVC); const float* cw = a.in[16];
    const int gtid = BID * NTHREADS + TIDX, gsz = NBLK * NTHREADS;
    for (int it = gtid; it < 1024 * (T_ / 128); it += gsz) { const int c = (it & 1023) * 8, seg = it >> 10; const size_t t0 = (size_t)seg * 128;
        float w[4][8];
#pragma unroll
        for (int k = 0; k < 4; ++k) { const f32x4 w0 = *(const f32x4*)(cw + k * 8192 + c), w1 = *(const f32x4*)(cw + k * 8192 + c + 4);
            w[k][0] = w0[0]; w[k][1] = w0[1]; w[k][2] = w0[2]; w[k][3] = w0[3]; w[k][4] = w1[0]; w[k][5] = w1[1]; w[k][6] = w1[2]; w[k][7] = w1[3]; }
        u32x4 x0 = (u32x4){0u, 0u, 0u, 0u}, x1 = x0, x2 = x0;
        if ((t0 & (S_ - 1)) != 0) { x0 = *(const u32x4*)(p1 + (t0 - 3) * N_IN1P + c); x1 = *(const u32x4*)(p1 + (t0 - 2) * N_IN1P + c); x2 = *(const u32x4*)(p1 + (t0 - 1) * N_IN1P + c); }
        const float qsc = c < 2048 ? 0.08838834764831845f : 1.0f;
        u32x4 xa[8];
#pragma unroll
        for (int j = 0; j < 8; ++j) xa[j] = *(const u32x4*)(p1 + (t0 + j) * N_IN1P + c);
#pragma unroll 1
        for (int r0 = 0; r0 < 128; r0 += 8) { u32x4 xb[8];
#pragma unroll
            for (int j = 0; j < 8; ++j) xb[j] = xa[j];
            if (r0 + 8 < 128) {
#pragma unroll
                for (int j = 0; j < 8; ++j) xb[j] = *(const u32x4*)(p1 + (t0 + r0 + 8 + j) * N_IN1P + c); }
#pragma unroll
          for (int j8 = 0; j8 < 8; ++j8) { const u32x4 x3 = xa[j8]; const int r = r0 + j8;
            float acc[8];
#define TAPS(j, f, m) (w[0][j] * f(x0.m) + w[1][j] * f(x1.m) + w[2][j] * f(x2.m) + w[3][j] * f(x3.m))
            acc[0] = TAPS(0, bf_lo, x); acc[1] = TAPS(1, bf_hi, x); acc[2] = TAPS(2, bf_lo, y); acc[3] = TAPS(3, bf_hi, y);
            acc[4] = TAPS(4, bf_lo, z); acc[5] = TAPS(5, bf_hi, z); acc[6] = TAPS(6, bf_lo, w); acc[7] = TAPS(7, bf_hi, w);
#undef TAPS
            float ss = 0.f;
#pragma unroll
            for (int j = 0; j < 8; ++j) { acc[j] = siluf_(acc[j]); ss += acc[j] * acc[j]; }
            ss = row16_sum(ss);
            const float sc = c < 4096 ? rsqrtf(ss + 1e-6f) * qsc : 1.0f;
            u32x4 o; o.x = cvt_pk_bf16(acc[0] * sc, acc[1] * sc); o.y = cvt_pk_bf16(acc[2] * sc, acc[3] * sc); o.z = cvt_pk_bf16(acc[4] * sc, acc[5] * sc); o.w = cvt_pk_bf16(acc[6] * sc, acc[7] * sc);
            *(u32x4*)(qc + (t0 + r) * 8192 + c) = o;
            x0 = x1; x1 = x2; x2 = x3; }
#pragma unroll
            for (int j = 0; j < 8; ++j) xa[j] = xb[j]; } }
    const float* tail = (const float*)(a.ws + WS_O); float* bgo = (float*)(a.ws + WS_BG);
    for (int it = gtid; it < T_ * 32; it += gsz) { const int t = it >> 5, hv = it & 31; float tb = 0.f, ta = 0.f;
#pragma unroll
        for (int kq = 0; kq < 4; ++kq) { tb += tail[((size_t)kq * T_ + t) * 64 + hv]; ta += tail[((size_t)kq * T_ + t) * 64 + 32 + hv]; }
        bgo[t * 64 + hv] = sigmoidf_(tb);
        bgo[t * 64 + 32 + hv] = -__expf(a.in[17][hv]) * softplusf_(ta + a.in[18][hv]); }
}

struct MoeTile { const float* src; unsigned char* dst; int lds_, ldd; };
__device__ __forceinline__ MoeTile moe_tile(const Args& a, int g) {
    const int job = g >> 14, r = g & 16383, e = r >> 8, rr = r & 255; MoeTile t;
    typedef __attribute__((address_space(1))) const float* gcf; gcf s25 = (gcf)a.in[25], s26 = (gcf)a.in[26]; asm volatile("" : "+s"(s25), "+s"(s26));
    if (job < 2) { const int ik = rr >> 3, in = rr & 7; t.lds_ = DEXP; t.ldd = D_;
        t.src = (const float*)(job ? s26 : s25) + ((size_t)(NEXP + e) * D_ + ik * 64) * DEXP + in * 64; t.dst = a.ws + (job ? WS_WU : WS_WG) + ((size_t)e * DEXP + in * 64) * D_ + ik * 64; }
    else { const int ik = rr >> 5, in = rr & 31; t.lds_ = D_; t.ldd = DEXP;
        t.src = a.in[27] + ((size_t)(NEXP + e) * DEXP + ik * 64) * D_ + in * 64; t.dst = a.ws + WS_WD + ((size_t)e * D_ + in * 64) * DEXP + ik * 64; }
    return t;
}
__device__ __forceinline__ void moe_tile_load(const MoeTile& t, int tid, f32x4 (&v)[2]) {
#pragma unroll
    for (int i = 0; i < 2; ++i) { const int idx = tid + i * 512, rr = idx >> 4, c4 = (idx & 15) * 4; v[i] = *(const f32x4*)(t.src + (size_t)rr * t.lds_ + c4); }
}
__device__ __forceinline__ void moe_tile_store(const MoeTile& t, int tid, const f32x4 (&v)[2], LAS float* tile) {
#pragma unroll
    for (int i = 0; i < 2; ++i) { const int idx = tid + i * 512, rr = idx >> 4, c4 = (idx & 15) * 4;
        tile[rr * 65 + c4 + 0] = v[i][0]; tile[rr * 65 + c4 + 1] = v[i][1]; tile[rr * 65 + c4 + 2] = v[i][2]; tile[rr * 65 + c4 + 3] = v[i][3]; }
    LDS_BARRIER();
    { const int n = tid >> 3, kg = (tid & 7) * 8; float f[8];
#pragma unroll
      for (int jj = 0; jj < 8; ++jj) f[jj] = tile[(kg + jj) * 65 + n] * W8_SCALE;
      u32x2 w; w.x = pk_fp8x4(f[0], f[1], f[2], f[3]); w.y = pk_fp8x4(f[4], f[5], f[6], f[7]);
      *(u32x2*)(t.dst + (size_t)n * t.ldd + kg) = w; }
    LDS_BARRIER();
}
constexpr int MOE_TILES = 3 * NEXP * 256;

__device__ __forceinline__ f32x4 mfma16(s16x4 a, s16x4 b, f32x4 c) { return __builtin_amdgcn_mfma_f32_16x16x16bf16_1k(a, b, c, 0, 0, 0); }
__device__ __forceinline__ s16x4 pack4(const f32x4& v) { u32x2 w; w.x = cvt_pk_bf16(v[0], v[1]); w.y = cvt_pk_bf16(v[2], v[3]); return __builtin_bit_cast(s16x4, w); }
__device__ __forceinline__ void phase_gdn_chunk(const Args& a, LAS unsigned char* lds) {
    const bf16_t* qc = (const bf16_t*)(a.ws + WS_QKVC); const float* bgi = (const float*)(a.ws + WS_BG); bf16_t* O = (bf16_t*)(a.ws + WS_O);
    constexpr int VRS = 144, KTRS = 136;
    constexpr int KT = 0, QS = KT + 128 * KTRS, WSL = QS + 64 * RSB, QKS = WSL + 64 * RSB, EE = QKS + 2048, EDD = EE + 256, SET = EDD + 256;
    constexpr int STL = 2 * SET, KS = STL + 64 * RSB, VS = KS + 64 * RSB, X2 = VS + 64 * VRS, LS = X2 + 2048, X1 = LS + 4096, GAM = X1 + 2048, BET = GAM + 256, LEND = BET + 256;
    static_assert(LEND <= LDS_XBW, "gdn lds");
    const int wid = __builtin_amdgcn_readfirstlane(TIDX >> 6);
    const int NCK = S_ / 64;
    for (int blk = BID; blk < NB_ * 32 * 2; blk += NBLK) {
        const int grp = (blk & 7) * 8 + (blk >> 5), mem = (blk >> 3) & 3, b = grp >> 4, hk = grp & 15, hv = 2 * hk + (mem >> 1), vhalf = mem & 1;
        __syncthreads();
        if (wid < 4) {
            const int vt = wid;
            f32x4 Sacc[8];
#pragma unroll
            for (int n = 0; n < 8; ++n) Sacc[n] = (f32x4){0.f, 0.f, 0.f, 0.f};
            { const int lane = TIDX & 63;
              for (int i = lane; i < 16 * RSB / 16; i += 64) *(LAS u32x4*)(lds + STL + 16 * vt * RSB + i * 16) = (u32x4){0u, 0u, 0u, 0u}; }
            int lz = TIDX & 63; asm volatile("" : "+v"(lz));
            const int lane = lz, I = lane & 15, G = lane >> 4, q4 = I >> 2, p4 = I & 3;
            for (int it = 0; it <= NCK; ++it) {
                const int set = ((it - 1) & 1) * SET; const size_t t0 = (size_t)b * S_ + (size_t)(it - 1) * 64;
                f32x4 U[4];
                if (it >= 1) {
#pragma unroll
                    for (int sa = 0; sa < 4; ++sa) U[sa] = mfma16(*(const LAS s16x4*)(lds + X2 + ((sa * 16 + I) * 16 + 4 * G) * 2), lds_tr4(lds + VS + (16 * sa + 4 * G + q4) * VRS + (16 * vt + 4 * p4) * 2), (f32x4){0.f, 0.f, 0.f, 0.f});
                    asm volatile("" : "+v"(U[0]), "+v"(U[1]), "+v"(U[2]), "+v"(U[3]) :: "memory");
                }
#pragma unroll
                for (int sa = 0; sa < 4; ++sa) {
                    if (it >= 1) {
                        bf16x8 sf[4];
#pragma unroll
                        for (int ks = 0; ks < 4; ++ks) sf[ks] = lds_frag(lds + STL + (16 * vt + I) * RSB + (32 * ks + 8 * G) * 2);
                        s16x4 kt[8];
#pragma unroll
                        for (int dt = 0; dt < 8; ++dt) kt[dt] = *(const LAS s16x4*)(lds + set + KT + (16 * dt + I) * KTRS + (16 * sa + 4 * G) * 2);
                        f32x4 dl = U[sa], oq = (f32x4){0.f, 0.f, 0.f, 0.f};
#pragma unroll
                        for (int ks = 0; ks < 4; ++ks) { dl = mfma32(lds_frag(lds + set + WSL + (16 * sa + I) * RSB + (32 * ks + 8 * G) * 2), sf[ks], dl);
                            oq = mfma32(lds_frag(lds + set + QS + (16 * sa + I) * RSB + (32 * ks + 8 * G) * 2), sf[ks], oq); }
                        const s16x4 dfrag = pack4(dl);
                        const f32x4 e4 = *(const LAS f32x4*)(lds + set + EE + (16 * sa + 4 * G) * 4);
                        oq = mfma16(*(const LAS s16x4*)(lds + set + QKS + ((sa * 16 + I) * 16 + 4 * G) * 2), dfrag, oq * e4);
#pragma unroll
                        for (int r = 0; r < 4; ++r) O[(t0 + 16 * sa + 4 * G + r) * 4096 + hv * 128 + vhalf * 64 + 16 * vt + I] = f2bf(oq[r]);
                        const f32x4 ed4 = *(const LAS f32x4*)(lds + set + EDD + (16 * sa + 4 * G) * 4); const float e15 = *(const LAS float*)(lds + set + EE + (16 * sa + 15) * 4);
                        const s16x4 dsc = pack4(dl * ed4);
#pragma unroll
                        for (int dt = 0; dt < 8; ++dt) {
                            Sacc[dt] = mfma16(kt[dt], dsc, Sacc[dt] * e15);
                            *(LAS s16x4*)(lds + STL + (16 * vt + I) * RSB + (16 * dt + 4 * G) * 2) = pack4(Sacc[dt]); }
                    }
                    LDS_BARRIER();
                }
            }
        } else {
            const int pw = wid - 4;
            u32x4 pq[4], pk[4], pv[2]; float pb = 0.f, pg = 0.f;
            { const int ptid = TIDX - 256; const size_t t0 = (size_t)b * S_;
#pragma unroll
              for (int i = 0; i < 4; ++i) { const int c = ptid + i * 256, s2 = c >> 4, c8 = (c & 15) * 8; pq[i] = *(const u32x4*)(qc + (t0 + s2) * 8192 + hk * 128 + c8); pk[i] = *(const u32x4*)(qc + (t0 + s2) * 8192 + 2048 + hk * 128 + c8); }
#pragma unroll
              for (int i = 0; i < 2; ++i) { const int c = ptid + i * 256, s2 = c >> 3, c8 = (c & 7) * 8; pv[i] = *(const u32x4*)(qc + (t0 + s2) * 8192 + 4096 + hv * 128 + vhalf * 64 + c8); }
              if (pw == 1) { pb = bgi[(t0 + ptid - 64) * 64 + hv]; pg = bgi[(t0 + ptid - 64) * 64 + 32 + hv]; } }
            int lz = TIDX & 63; asm volatile("" : "+v"(lz));
            const int lane = lz, ptid = pw * 64 + lane, I = lane & 15, G = lane >> 4, q4 = I >> 2, p4 = I & 3;
            for (int it = 0; it <= NCK; ++it) {
                const int set = (it & 1) * SET; const bool act = it < NCK;
                if (act) {
#pragma unroll
                    for (int i = 0; i < 4; ++i) { const int c = ptid + i * 256, s2 = c >> 4, c8 = (c & 15) * 8; *(LAS u32x4*)(lds + set + QS + s2 * RSB + c8 * 2) = pq[i]; *(LAS u32x4*)(lds + KS + s2 * RSB + c8 * 2) = pk[i]; }
                    if (pw == 1) { float x = pg;
                        x += __builtin_bit_cast(float, __builtin_amdgcn_update_dpp(0, __builtin_bit_cast(int, x), 0x111, 0xf, 0xf, true));
                        x += __builtin_bit_cast(float, __builtin_amdgcn_update_dpp(0, __builtin_bit_cast(int, x), 0x112, 0xf, 0xf, true));
                        x += __builtin_bit_cast(float, __builtin_amdgcn_update_dpp(0, __builtin_bit_cast(int, x), 0x114, 0xf, 0xf, true));
                        x += __builtin_bit_cast(float, __builtin_amdgcn_update_dpp(0, __builtin_bit_cast(int, x), 0x118, 0xf, 0xf, true));
                        const float g15 = __shfl(x, 15, 16);
                        *(LAS float*)(lds + GAM + lane * 4) = x; *(LAS float*)(lds + set + EE + lane * 4) = __expf(x); *(LAS float*)(lds + set + EDD + lane * 4) = __expf(g15 - x); *(LAS float*)(lds + BET + lane * 4) = pb; }
                }
                LDS_BARRIER();
                if (act) { const int sa = pw;
#pragma unroll
                    for (int i = 0; i < 2; ++i) { const int c = ptid + i * 256, s2 = c >> 3, c8 = (c & 7) * 8; *(LAS u32x4*)(lds + VS + s2 * VRS + c8 * 2) = pv[i]; }
                    if (it + 1 < NCK) { const size_t t1 = (size_t)b * S_ + (size_t)(it + 1) * 64;
#pragma unroll
                        for (int i = 0; i < 4; ++i) { const int c = ptid + i * 256, s2 = c >> 4, c8 = (c & 15) * 8; pq[i] = *(const u32x4*)(qc + (t1 + s2) * 8192 + hk * 128 + c8); pk[i] = *(const u32x4*)(qc + (t1 + s2) * 8192 + 2048 + hk * 128 + c8); }
#pragma unroll
                        for (int i = 0; i < 2; ++i) { const int c = ptid + i * 256, s2 = c >> 3, c8 = (c & 7) * 8; pv[i] = *(const u32x4*)(qc + (t1 + s2) * 8192 + 4096 + hv * 128 + vhalf * 64 + c8); }
                        if (pw == 1) { pb = bgi[(t1 + ptid - 64) * 64 + hv]; pg = bgi[(t1 + ptid - 64) * 64 + 32 + hv]; } }
#pragma unroll
                    for (int ty = 0; ty < 2; ++ty) { f32x4 acc = (f32x4){0.f, 0.f, 0.f, 0.f};
#pragma unroll
                        for (int ks = 0; ks < 4; ++ks) { const bf16x8 ka = lds_frag(lds + KS + (16 * sa + I) * RSB + (32 * ks + 8 * G) * 2);
                            const bf16x8 bo = ty ? lds_frag(lds + set + QS + (16 * sa + I) * RSB + (32 * ks + 8 * G) * 2) : ka; acc = mfma32(ka, bo, acc); }
                        const f32x4 gr = *(const LAS f32x4*)(lds + GAM + (16 * sa + 4 * G) * 4); const float gc = *(const LAS float*)(lds + GAM + (16 * sa + I) * 4);
                        if (ty == 0) { const f32x4 br = *(const LAS f32x4*)(lds + BET + (16 * sa + 4 * G) * 4);
#pragma unroll
                            for (int r = 0; r < 4; ++r) { const float val = br[r] * acc[r] * __expf(gr[r] - gc); *(LAS float*)(lds + LS + ((sa * 16 + 4 * G + r) * 16 + I) * 4) = (I < 4 * G + r) ? val : 0.f; } }
                        else { f32x4 o;
#pragma unroll
                            for (int r = 0; r < 4; ++r) { const float val = acc[r] * __expf(gc - gr[r]); o[r] = (4 * G + r <= I) ? val : 0.f; }
                            *(LAS s16x4*)(lds + set + QKS + ((sa * 16 + I) * 16 + 4 * G) * 2) = pack4(o); } } }
                LDS_BARRIER();
                if (act && pw == 0) { const int sa = G, c = I; float x[16];
#pragma unroll
                    for (int i = 0; i < 16; ++i) x[i] = 0.f;
#pragma unroll
                    for (int ib = 0; ib < 4; ++ib) {
                        f32x4 lv[4][4];
#pragma unroll
                        for (int r = 0; r < 4; ++r)
#pragma unroll
                            for (int jj = 0; jj <= ib; ++jj) lv[r][jj] = *(const LAS f32x4*)(lds + LS + ((sa * 16 + 4 * ib + r) * 16 + 4 * jj) * 4);
                        __builtin_amdgcn_sched_barrier(0);
#pragma unroll
                        for (int r = 0; r < 4; ++r) { const int i = 4 * ib + r; float s0 = (i == c) ? 1.0f : 0.0f, s1 = 0.f;
#pragma unroll
                            for (int jj = 0; jj <= ib; ++jj) { s0 -= lv[r][jj][0] * x[4 * jj] + lv[r][jj][1] * x[4 * jj + 1]; s1 -= lv[r][jj][2] * x[4 * jj + 2] + lv[r][jj][3] * x[4 * jj + 3]; }
                            x[i] = s0 + s1; }
                    }
                    const float bc = *(const LAS float*)(lds + BET + lane * 4), sc1 = -bc * *(const LAS float*)(lds + set + EE + lane * 4);
#pragma unroll
                    for (int i = 0; i < 16; ++i) { *(LAS bf16_t*)(lds + X1 + ((sa * 16 + i) * 16 + c) * 2) = f2bf(x[i] * sc1); *(LAS bf16_t*)(lds + X2 + ((sa * 16 + i) * 16 + c) * 2) = f2bf(x[i] * bc); } }
                LDS_BARRIER();
                if (act) { const int sa = pw;
                    const s16x4 xb = *(const LAS s16x4*)(lds + X1 + ((sa * 16 + I) * 16 + 4 * G) * 2); s16x4 kt[8]; f32x4 w[8];
#pragma unroll
                    for (int dt = 0; dt < 8; ++dt) kt[dt] = lds_tr4(lds + KS + (16 * sa + 4 * G + q4) * RSB + (16 * dt + 4 * p4) * 2);
#pragma unroll
                    for (int dt = 0; dt < 8; ++dt) { w[dt] = mfma16(kt[dt], xb, (f32x4){0.f, 0.f, 0.f, 0.f}); *(LAS s16x4*)(lds + set + KT + (16 * dt + I) * KTRS + (16 * sa + 4 * G) * 2) = kt[dt]; }
#pragma unroll
                    for (int dt = 0; dt < 8; ++dt) *(LAS s16x4*)(lds + set + WSL + (16 * sa + I) * RSB + (16 * dt + 4 * G) * 2) = pack4(w[dt]); }
                LDS_BARRIER();
            }
        }
    }
}

constexpr int N_PHASES = 30;
__global__ void __launch_bounds__(NTHREADS, 2) fwd(Args a0) {
    extern __shared__ __attribute__((aligned(16))) unsigned char smem_raw[];
    LAS unsigned char* lds = (LAS unsigned char*)smem_raw;
    volatile LAS unsigned* xbw = (volatile LAS unsigned*)(lds + LDS_XBW);
    if (TIDX == 0) { xbw[0] = 0u; xbw[1] = 0u; xbw[2] = 0u; xbw[3] = 0u; }
    __syncthreads();
    XcdBarrier bar = xcd_barrier_post((unsigned*)(a0.ws + WS_CTL), xbw);
#ifndef PHMASK
#define PHMASK 0xFFFFFFFFull
#endif
#ifndef DUPMASK
#define DUPMASK 0ull
#endif
#define PH(i, body) do { if (((PHMASK >> (i)) & 1ull) && a0.ph_lo <= (i) && (i) < a0.ph_hi) { __attribute__((address_space(1))) unsigned char* wsp_ = (__attribute__((address_space(1))) unsigned char*)a0.ws; asm volatile("" : "+s"(wsp_)); Args a = a0; a.ws = (unsigned char*)wsp_; const float* xin = a.in[0]; const float* xw = (const float*)(a.ws + WS_X); (void)xin; (void)xw; \
        if ((DUPMASK >> (i)) & 1ull) { body; xcd_barrier(bar); } body; if ((i) + 1 < a0.ph_hi) xcd_barrier(bar); } } while (0)
    PH(0, { phase_prologue(a, lds); __syncthreads(); NORM_PH(0, true)(a, xin, a.in[1], -1); });
    PH(2, phase_gemm_in0(a, lds));
    PH(3, { phase_rg_conv(a); __syncthreads(); phase_hg1(a, lds); });
    PH(4, { phase_rg_gates(a, lds); __syncthreads(); phase_hg2(a); });
    PH(5, { phase_rg_scan(a, lds); __syncthreads(); phase_hg3(a, lds); });
    PH(9, phase_gemm_out<false>(a, lds, D_, a.ws + WS_WOUT0T, xin));
    PH(10, NORM_PH(0, false)(a, nullptr, a.in[2], 0));
    PH(11, phase_gemm_router(a, lds, 0));
    PH(12, phase_route(a, 0));
    PH(13, phase_rowmap(a, lds, 0));
    PH(14, phase_moe_up(a, lds, 0));
    PH(15, phase_moe_down(a, lds, 0));
    PH(16, { NORM_PH(1, false)(a, nullptr, a.in[1] + D_, 0); __syncthreads(); moe_weight_jobs(a, 1, lds); });
    PH(18, { phase_gemm_in1(a, lds); phase_gemm_in1_tail(a, lds); });
    PH(19, phase_gdn_conv(a));
    PH(20, phase_gdn_chunk(a, lds));
    PH(21, phase_gdn_norm(a));
    PH(22, phase_gemm_out<true>(a, lds, 4096, a.ws + WS_WOUT1T, nullptr));
    PH(23, NORM_PH(0, false)(a, nullptr, a.in[2] + D_, 1));
    PH(24, phase_gemm_router(a, lds, 1));
    PH(25, phase_route(a, 1));
    PH(26, phase_rowmap(a, lds, 1));
    PH(27, phase_moe_up(a, lds, 1));
    PH(28, phase_moe_down(a, lds, 1));
    PH(29, NORM_PH(2, false)(a, nullptr, a.in[3], 1));
#undef PH
}

extern "C" void kernel_launch(void* const* d_in, const int* in_sizes, int n_in, void* d_out, int out_size, void* d_ws, size_t ws_size, hipStream_t stream) {
    static int grid = 0;
    if (grid == 0) {
        if (n_in != 28 || ws_size < WS_END) { fprintf(stderr, "kernel_launch: need 28 inputs and %zu bytes of workspace, got %d / %zu\n", (size_t)WS_END, n_in, ws_size); grid = -1; return; }
        int dev = 0, cus = 0, per_cu = 0;
        if (hipGetDevice(&dev) != hipSuccess || hipDeviceGetAttribute(&cus, hipDeviceAttributeMultiprocessorCount, dev) != hipSuccess) { grid = -1; return; }
        if (hipFuncSetAttribute((const void*)fwd, hipFuncAttributeMaxDynamicSharedMemorySize, LDS_BYTES) != hipSuccess) { fprintf(stderr, "kernel_launch: hipFuncSetAttribute failed\n"); grid = -1; return; }
        if (hipOccupancyMaxActiveBlocksPerMultiprocessor(&per_cu, (const void*)fwd, NTHREADS, LDS_BYTES) != hipSuccess || per_cu < 1) { fprintf(stderr, "kernel_launch: occupancy query says %d\n", per_cu); }
        (void)hipGetLastError();
        grid = cus;
    }
    if (grid < 0) return;
    (void)in_sizes; (void)out_size;
    hipMemsetAsync((char*)d_ws + WS_CTL, 0, CTL_BYTES, stream);
    Args a; memset(&a, 0, sizeof(a));
    for (int i = 0; i < 28; ++i) a.in[i] = (const float*)d_in[i];
    a.out = (float*)d_out; a.ws = (unsigned char*)d_ws;
#if N_LAUNCH_MODE == 1
    a.ph_lo = 0; a.ph_hi = N_PHASES;
    hipLaunchKernelGGL(fwd, dim3(grid), dim3(NTHREADS), LDS_BYTES, stream, a);
#if EXTRA_PH >= 0
    a.ph_lo = EXTRA_PH; a.ph_hi = EXTRA_PH + 1;
    hipLaunchKernelGGL(fwd, dim3(grid), dim3(NTHREADS), LDS_BYTES, stream, a);
#endif
#else
    for (int p = 0; p < N_PHASES; ++p) { a.ph_lo = p; a.ph_hi = p + 1; hipLaunchKernelGGL(fwd, dim3(grid), dim3(NTHREADS), LDS_BYTES, stream, a); }
#endif
}
```

```cpp
#include <hip/hip_runtime.h>
#include <stdint.h>
#include <stdio.h>
#include <string.h>

#ifndef EXTRA_PH
#define EXTRA_PH -1
#endif
#ifndef N_LAUNCH_MODE
#define N_LAUNCH_MODE 1
#endif

#define LAS __attribute__((address_space(3)))
typedef unsigned short bf16_t;
typedef short bf16x8 __attribute__((ext_vector_type(8)));
typedef float f32x4 __attribute__((ext_vector_type(4)));
typedef float f32x2 __attribute__((ext_vector_type(2)));
typedef unsigned u32x4 __attribute__((ext_vector_type(4)));
typedef unsigned u32x2 __attribute__((ext_vector_type(2)));

constexpr int T_ = 16384, D_ = 2048, S_ = 4096, NB_ = 4;
constexpr int N_IN0 = 6144, N_IN1 = 12352, N_IN1P = 12544;
constexpr int NEXP = 64, DEXP = 512, MPAD = 49152;
constexpr int NTHREADS = 512;
constexpr int LDS_MAIN = 131072;
constexpr int LDS_BYTES = 163840;
constexpr int LDS_XBW = LDS_BYTES - 16;

constexpr size_t al256(size_t x) { return (x + 255) & ~(size_t)255; }
constexpr size_t WS_CTL = 0;
constexpr size_t CTL_BYTES = 65536;
constexpr size_t CTL_CNT = 16384;
constexpr size_t WS_LB = WS_CTL + CTL_BYTES;
constexpr size_t WS_TINFO = WS_LB + 4096;
constexpr size_t WS_WIN0T = WS_TINFO + 4096;
constexpr size_t WS_WOUT0T = WS_WIN0T + (size_t)N_IN0 * D_ * 2;
constexpr size_t WS_WIN1T = WS_WOUT0T + (size_t)D_ * D_ * 2;
constexpr size_t WS_WOUT1T = WS_WIN1T + (size_t)N_IN1P * D_ * 2;
constexpr size_t WS_WGATES = WS_WOUT1T + (size_t)D_ * 4096 * 2;
constexpr size_t WS_WRT = WS_WGATES + (size_t)8 * 256 * 256 * 2;
constexpr size_t WS_WG = WS_WRT + (size_t)2 * 256 * D_ * 2;
constexpr size_t WS_WU = WS_WG + (size_t)NEXP * DEXP * D_ * 2;
constexpr size_t WS_WD = WS_WU + (size_t)NEXP * DEXP * D_ * 2;
constexpr size_t WS_X = WS_WD + (size_t)NEXP * DEXP * D_ * 2;
constexpr size_t WS_H = WS_X + (size_t)T_ * D_ * 4;
constexpr size_t WS_PROJ = WS_H + (size_t)T_ * D_ * 2;
constexpr size_t PROJ_BYTES = (size_t)T_ * N_IN1P * 2;
constexpr size_t WS_FLOG = WS_PROJ + (size_t)T_ * N_IN0 * 2;
constexpr size_t WS_XC = WS_FLOG + (size_t)T_ * 1024 * 4;
constexpr size_t WS_ACT = WS_PROJ;
constexpr size_t WS_YMOE = WS_ACT + (size_t)MPAD * DEXP * 2;
constexpr size_t WS_R1 = WS_PROJ + PROJ_BYTES;
constexpr size_t WS_A = WS_R1;
constexpr size_t WS_U = WS_R1 + (size_t)T_ * 1024 * 4;
constexpr size_t WS_QKVC = WS_R1;
constexpr size_t WS_Y = WS_R1 + (size_t)T_ * 8192 * 2;
constexpr size_t WS_O = WS_Y + (size_t)T_ * 4096 * 2;
constexpr size_t WS_TAIL = WS_O + (size_t)T_ * 4096 * 4;
constexpr size_t WS_BG = WS_TAIL + (size_t)T_ * 64 * 4;
constexpr size_t WS_LOGITS = WS_BG + (size_t)T_ * 64 * 4;
constexpr size_t WS_EID = WS_LOGITS + (size_t)T_ * 128 * 4;
constexpr size_t WS_SLOT = WS_EID + (size_t)T_ * 2 * 4;
constexpr size_t WS_GATE = WS_SLOT + (size_t)T_ * 2 * 4;
constexpr size_t WS_POSOF = WS_GATE + (size_t)T_ * 2 * 4;
constexpr size_t WS_ROWMAP = WS_POSOF + (size_t)T_ * 2 * 4;
constexpr size_t WS_H8 = WS_ROWMAP + (size_t)MPAD * 4;
constexpr size_t WS_END = WS_H8 + (size_t)T_ * D_;
static_assert(WS_YMOE + (size_t)MPAD * D_ * 2 <= WS_R1, "moe overlay");
static_assert(WS_XC + (size_t)T_ * 1024 * 2 <= WS_R1, "layer0 overlay");

struct Args {
    const float* in[28];
    float* out;
    unsigned char* ws;
    int ph_lo, ph_hi;
};

__device__ __forceinline__ int tidx_() { int t = (int)threadIdx.x; asm volatile("" : "+v"(t)); return t; }
#define TIDX tidx_()
typedef __bf16 bf16x2n __attribute__((ext_vector_type(2)));
__device__ __forceinline__ unsigned cvt_pk_bf16(float lo, float hi) { const f32x2 v = {lo, hi}; return __builtin_bit_cast(unsigned, __builtin_convertvector(v, bf16x2n)); }
__device__ __forceinline__ unsigned pk_fp8x4(float a, float b, float c, float d) { int v = __builtin_amdgcn_cvt_pk_fp8_f32(a, b, 0, false); v = __builtin_amdgcn_cvt_pk_fp8_f32(c, d, v, true); return (unsigned)v; }
constexpr float W8_SCALE = 64.0f, ACT8_SCALE = 8.0f;
__device__ __forceinline__ bf16_t f2bf(float x) { return (bf16_t)(cvt_pk_bf16(x, 0.f) & 0xffffu); }
__device__ __forceinline__ float bf_lo(unsigned w) { return __uint_as_float(w << 16); }
__device__ __forceinline__ float bf_hi(unsigned w) { return __uint_as_float(w & 0xffff0000u); }
__device__ __forceinline__ float bf1(bf16_t v) { return __uint_as_float(((unsigned)v) << 16); }
__device__ __forceinline__ float sigmoidf_(float x) { return __builtin_amdgcn_rcpf(1.0f + __expf(-x)); }
__device__ __forceinline__ float siluf_(float x) { return x * __builtin_amdgcn_rcpf(1.0f + __expf(-x)); }
__device__ __forceinline__ float softplusf_(float x) { return x > 20.f ? x : log1pf(__expf(x)); }
__device__ __forceinline__ float gelu_tanh(float x) { const float u = 0.7978845608028654f * (x + 0.044715f * x * x * x); return x * __builtin_amdgcn_rcpf(1.0f + __expf(-2.0f * u)); }
template <int CTRL> __device__ __forceinline__ float dpp_f(float v) { return __builtin_bit_cast(float, __builtin_amdgcn_update_dpp(0, __builtin_bit_cast(int, v), CTRL, 0xf, 0xf, false)); }
__device__ __forceinline__ float row16_sum(float s) { s += dpp_f<0x140>(s); s += dpp_f<0x141>(s); s += dpp_f<0xB1>(s); s += dpp_f<0x4E>(s); return s; }
__device__ __forceinline__ float wave_sum(float v) { v = row16_sum(v); v += __shfl_xor(v, 16); v += __shfl_xor(v, 32); return v; }

#define LDS_BARRIER() do { asm volatile("s_waitcnt lgkmcnt(0)" ::: "memory"); __builtin_amdgcn_s_barrier(); asm volatile("" ::: "memory"); } while (0)
#define XB_TMO      128
#define XB_XCNT(j)  (256  + 64 * (j))
#define XB_XSUB(j)  (1280 + 64 * (j))
#define XB_XGEN(j)  (2304 + 64 * (j))
#define XB_TOP      3328
#define XB_TOPGEN   3392
#define XCD_BAR_WORDS 3456
#define XB_SPIN_CAP (1u << 18)

__device__ __forceinline__ unsigned xb_ld(unsigned* p)              { return __hip_atomic_load(p, __ATOMIC_RELAXED, __HIP_MEMORY_SCOPE_AGENT); }
__device__ __forceinline__ unsigned xb_add(unsigned* p, unsigned v) { return __hip_atomic_fetch_add(p, v, __ATOMIC_RELAXED, __HIP_MEMORY_SCOPE_AGENT); }
__device__ __forceinline__ unsigned xb_xcc_id() { return (unsigned)__builtin_amdgcn_s_getreg((3 << 11) | 20) & 0xFu; }
#define XB_SPIN(cond, bar) do { unsigned _sp = 0; while (cond) { __builtin_amdgcn_s_sleep(1); \
    if ((++_sp & 255u) == 0u) { if (xb_ld(&(bar)[XB_TMO])) break; if (_sp > XB_SPIN_CAP) { atomicAdd(&(bar)[XB_TMO], 1u); break; } } } } while (0)

struct XcdBarrier { unsigned* bar; unsigned x; volatile LAS unsigned* st; };

__device__ __forceinline__ XcdBarrier xcd_barrier_post(unsigned* bar, volatile LAS unsigned* st) {
    XcdBarrier b; b.bar = bar; b.x = xb_xcc_id(); b.st = st;
    if (TIDX == 0) (void)xb_add(&bar[XB_XCNT(b.x)], 1u);
    return b;
}
__device__ __forceinline__ void xcd_barrier_complete(unsigned* bar, unsigned x, unsigned& nloc, unsigned& nx) {
    const unsigned G = gridDim.x * gridDim.y * gridDim.z;
    unsigned sum, cnt, mine, sp = 0u;
    for (;;) {
        sum = 0u; cnt = 0u; mine = 0u;
#pragma unroll
        for (unsigned j = 0; j < 16; ++j) { const unsigned c = xb_ld(&bar[XB_XCNT(j)]); sum += c; cnt += (c > 0u) ? 1u : 0u; mine = (j == x) ? c : mine; }
        if (sum == G) break;
        __builtin_amdgcn_s_sleep(1);
        if ((++sp & 255u) == 0u) { if (xb_ld(&bar[XB_TMO])) break; if (sp > XB_SPIN_CAP) { atomicAdd(&bar[XB_TMO], 1u); break; } }
    }
    nloc = mine > 0u ? mine : 1u; nx = cnt > 0u ? cnt : 1u;
}
__device__ __forceinline__ void xcd_barrier(const XcdBarrier& b) {
    asm volatile("s_waitcnt vmcnt(0)" ::: "memory");
    __syncthreads();
    if (TIDX == 0) {
        unsigned* bar = b.bar;
        __builtin_amdgcn_s_waitcnt(0);
        unsigned nloc = b.st[0], nx = b.st[1];
        if (nloc == 0u) { xcd_barrier_complete(bar, b.x, nloc, nx); b.st[0] = nloc; b.st[1] = nx; }
        const unsigned old = xb_add(&bar[XB_XSUB(b.x)], 1u);
        const unsigned gen = old / nloc;
        if (old + 1u == (gen + 1u) * nloc) {
            __builtin_amdgcn_fence(__ATOMIC_RELEASE, "agent");
            asm volatile("s_waitcnt vmcnt(0)" ::: "memory");
            const unsigned og = xb_add(&bar[XB_TOP], 1u);
            const unsigned tg = og / nx;
            if (og + 1u == (tg + 1u) * nx) xb_add(&bar[XB_TOPGEN], 1u);
            else XB_SPIN(xb_ld(&bar[XB_TOPGEN]) == tg, bar);
            __builtin_amdgcn_fence(__ATOMIC_ACQUIRE, "agent");
            xb_add(&bar[XB_XGEN(b.x)], 1u);
            asm volatile("s_waitcnt vmcnt(0)" ::: "memory");
        } else {
            XB_SPIN(xb_ld(&bar[XB_XGEN(b.x)]) == gen, bar);
            __builtin_amdgcn_fence(__ATOMIC_ACQUIRE, "agent");
            asm volatile("s_waitcnt vmcnt(0)" ::: "memory");
        }
    }
    __syncthreads();
}

constexpr int BM = 256, BK = 64, HALF = 128, HTB = HALF * BK * 2;
__device__ __forceinline__ int lds_byte(int r, int c) { const int st = (r >> 4) * 2 + (c >> 5), rr = r & 15, cc = c & 31, ob = rr * 64 + cc * 2; return st * 1024 + (ob ^ (((ob >> 9) & 1) << 5)); }
__device__ __forceinline__ void stage_rc(int b, int& R, int& C) { const int st = b / 1024, sb = b % 1024, swz = sb ^ (((sb >> 9) & 1) << 5); R = (st >> 1) * 16 + swz / 64; C = (st & 1) * 32 + (swz % 64) / 2; }
__device__ __forceinline__ int perm32(int rho) { const int n = rho >> 4, i = rho & 15; return 8 * (i >> 2) + 4 * n + (i & 3); }

__device__ __forceinline__ void stage_pos(int tid, int& R0, int& C0) { stage_rc(tid * 16, R0, C0); }
__device__ __forceinline__ int perm_row(int R) { return (R & ~31) + perm32(R & 31); }

#define BID ((int)blockIdx.x)
#define NBLK ((int)gridDim.x)
#define BID_ BID
#define NBLK_ NBLK
typedef f32x4 Acc[2][2][4][2];
struct UnitD { const char* gA; const char* gB; int t0, t1, t2; };

typedef int i32x8 __attribute__((ext_vector_type(8)));
typedef int i32x4 __attribute__((ext_vector_type(4)));
template <bool GATHER, bool FP8, class Src, class Epi>
__device__ __forceinline__ void gemm_stream(LAS unsigned char* lds, const Src& S, const int nt, const Epi& E) {
    const int tid = TIDX, wid = tid >> 6, lane = tid & 63, wr = wid >> 2, wc = wid & 3, fr = lane & 15, fq = lane >> 4;
    const unsigned ldsw = (unsigned)wid * 1024u;
    const int aoff = lds_byte(wr * 64 + fr, fq * 8), boff = lds_byte(wc * 32 + fr, fq * 8);
    const size_t kstep = (size_t)(BK * 2);
#define G_SA(b, h) (((b) * 2 + (h)) * HTB)
#define G_SB(b, h) ((4 + (b) * 2 + (h)) * HTB)
#define G_STAGE(bufoff, gbase, v) do { _Pragma("unroll") for (int _i = 0; _i < 2; ++_i) \
        __builtin_amdgcn_global_load_lds((const unsigned*)((gbase) + (v)[_i]), (LAS unsigned*)(lds + (bufoff) + ldsw + _i * 8192), 16, 0, 0); } while (0)
#define G_LD8(p) __builtin_shufflevector(*(const LAS i32x4*)(p), *(const LAS i32x4*)((p) + 1024), 0, 1, 2, 3, 4, 5, 6, 7)
#define G_LDA(dst, b, h) do { _Pragma("unroll") for (int m = 0; m < 4; ++m) dst[m] = G_LD8(lds + G_SA(b, h) + aoff + m * 2048); } while (0)
#define G_LDB(dst, b, h) do { _Pragma("unroll") for (int n = 0; n < 2; ++n) dst[n] = G_LD8(lds + G_SB(b, h) + boff + n * 2048); } while (0)
#define G_HALF(x, k) __builtin_bit_cast(bf16x8, __builtin_shufflevector((x), (x), 4 * (k), 4 * (k) + 1, 4 * (k) + 2, 4 * (k) + 3))
#define G_MMA(ai, bj, At, Bt) do { __builtin_amdgcn_s_setprio(1); _Pragma("unroll") for (int m = 0; m < 4; ++m) _Pragma("unroll") for (int n = 0; n < 2; ++n) { \
        if (FP8) asm volatile("v_mfma_f32_16x16x128_f8f6f4 %0, %1, %2, %0" : "+v"(acc[ai][bj][m][n]) : "v"(Bt[n]), "v"(At[m]));   \
        else { acc[ai][bj][m][n] = __builtin_amdgcn_mfma_f32_16x16x32_bf16(G_HALF(Bt[n], 0), G_HALF(At[m], 0), acc[ai][bj][m][n], 0, 0, 0); \
               acc[ai][bj][m][n] = __builtin_amdgcn_mfma_f32_16x16x32_bf16(G_HALF(Bt[n], 1), G_HALF(At[m], 1), acc[ai][bj][m][n], 0, 0, 0); } } \
        __builtin_amdgcn_s_setprio(0); } while (0)
#define G_WAIT_V(n) asm volatile("s_waitcnt vmcnt(" #n ")" ::: "memory")
#define G_WAIT_L(n) asm volatile("s_waitcnt lgkmcnt(" #n ")" ::: "memory")
#define G_BAR __builtin_amdgcn_s_barrier()
#define G_SCHED __builtin_amdgcn_sched_barrier(0)
    UnitD cur, nxt; int ui = 0;
    if (!S.next(0, cur)) return;
    unsigned va[2][2], vb[2][2], van[2][2];
    S.vb(vb); S.va(cur, va);
    Acc acc;
#pragma unroll
    for (int a = 0; a < 2; ++a)
#pragma unroll
        for (int b = 0; b < 2; ++b)
#pragma unroll
            for (int m = 0; m < 4; ++m)
#pragma unroll
                for (int n = 0; n < 2; ++n) acc[a][b][m][n] = (f32x4){0.f, 0.f, 0.f, 0.f};
    i32x8 At[4], B0[2], B1[2];
    const char* cA = cur.gA; const char* cB = cur.gB;
    G_WAIT_V(0);
    __syncthreads();
    G_STAGE(G_SB(0, 0), cB, vb[0]); G_STAGE(G_SA(0, 0), cA, va[0]); G_STAGE(G_SB(0, 1), cB, vb[1]); G_STAGE(G_SA(0, 1), cA, va[1]);
    if (wr == 1) G_BAR;
    G_WAIT_V(4); G_BAR;
    G_STAGE(G_SB(1, 0), cB + kstep, vb[0]); G_STAGE(G_SA(1, 0), cA + kstep, va[0]); G_STAGE(G_SB(1, 1), cB + kstep, vb[1]);
    G_WAIT_V(6); G_BAR;
    for (;;) {
        const bool has_next = S.next(ui + 1, nxt);
        const char* nA = has_next ? nxt.gA : cA; const char* nB = has_next ? nxt.gB : cB;
        if (GATHER) { if (has_next) S.va(nxt, van); else { van[0][0] = va[0][0]; van[0][1] = va[0][1]; van[1][0] = va[1][0]; van[1][1] = va[1][1]; } }
#pragma unroll 1
        for (int t = 0; t < nt; t += 2) {
            const bool last = (t == nt - 2);
            const char* a1 = cA + (size_t)(t + 1) * kstep;
            const char* a2 = last ? nA : cA + (size_t)(t + 2) * kstep; const char* b2 = last ? nB : cB + (size_t)(t + 2) * kstep;
            const char* a3 = a2 + kstep; const char* b3 = b2 + kstep;
            unsigned v2[2][2];
#pragma unroll
            for (int hh = 0; hh < 2; ++hh)
#pragma unroll
                for (int i = 0; i < 2; ++i) v2[hh][i] = (GATHER && last) ? van[hh][i] : va[hh][i];
            G_LDB(B0, 0, 0); G_SCHED; G_LDA(At, 0, 0); G_STAGE(G_SA(1, 1), a1, va[1]);
            G_WAIT_L(8); G_BAR; G_WAIT_L(0); G_MMA(0, 0, At, B0); G_BAR; G_SCHED;
            G_LDB(B1, 0, 1); G_STAGE(G_SB(0, 0), b2, vb[0]);
            G_BAR; G_WAIT_L(0); G_MMA(0, 1, At, B1); G_BAR;
            G_LDA(At, 0, 1); G_STAGE(G_SA(0, 0), a2, v2[0]);
            G_BAR; G_WAIT_L(0); G_MMA(1, 0, At, B0); G_BAR; G_SCHED;
            G_STAGE(G_SB(0, 1), b2, vb[1]);
            G_WAIT_V(6); G_BAR; G_MMA(1, 1, At, B1); G_BAR;
            G_LDB(B0, 1, 0); G_SCHED; G_LDA(At, 1, 0); G_STAGE(G_SA(0, 1), a2, v2[1]);
            G_WAIT_L(8); G_BAR; G_WAIT_L(0); G_MMA(0, 0, At, B0); G_BAR; G_SCHED;
            G_LDB(B1, 1, 1); G_STAGE(G_SB(1, 0), b3, vb[0]);
            G_BAR; G_WAIT_L(0); G_MMA(0, 1, At, B1); G_BAR;
            G_LDA(At, 1, 1); G_STAGE(G_SA(1, 0), a3, v2[0]);
            G_BAR; G_WAIT_L(0); G_MMA(1, 0, At, B0); G_BAR; G_SCHED;
            G_STAGE(G_SB(1, 1), b3, vb[1]);
            G_WAIT_V(6); G_BAR; G_MMA(1, 1, At, B1); G_BAR;
        }
        if (FP8) asm volatile("s_nop 15\n\ts_nop 15" ::: "memory");
        { int tz = TIDX; asm volatile("" : "+v"(tz));
          const int wid2 = tz >> 6, lane2 = tz & 63; E(acc, cur, wid2 >> 2, wid2 & 3, lane2 & 15, lane2 >> 4); }
        if (!has_next) break;
#pragma unroll
        for (int a = 0; a < 2; ++a)
#pragma unroll
            for (int b = 0; b < 2; ++b)
#pragma unroll
                for (int m = 0; m < 4; ++m)
#pragma unroll
                    for (int n = 0; n < 2; ++n) acc[a][b][m][n] = (f32x4){0.f, 0.f, 0.f, 0.f};
        cur = nxt; cA = nA; cB = nB; ++ui;
        if (GATHER) { va[0][0] = van[0][0]; va[0][1] = van[0][1]; va[1][0] = van[1][0]; va[1][1] = van[1][1]; }
    }
    G_WAIT_V(0);
    if (wr == 0) G_BAR;
    G_BAR;
#undef G_SA
#undef G_SB
#undef G_STAGE
#undef G_LDA
#undef G_LDB
#undef G_MMA
#undef G_LD8
#undef G_HALF
#undef G_WAIT_V
#undef G_WAIT_L
#undef G_BAR
#undef G_SCHED
}

__device__ __forceinline__ void offs_direct(unsigned (&v)[2][2], int ld, bool perm) {
    int R0, C0; stage_pos(TIDX, R0, C0);
#pragma unroll
    for (int i = 0; i < 2; ++i) { const int R = R0 + 64 * i, Rr = perm ? perm_row(R) : R;
        v[0][i] = (unsigned)(Rr * ld + C0) * 2u; v[1][i] = (unsigned)((Rr + HALF) * ld + C0) * 2u; }
}

struct SrcGrid {
    const char* A; const char* B; size_t astep, bstep; int nM, total, lda, ldb;
    __device__ __forceinline__ bool next(int i, UnitD& u) const { const int id = BID_ + i * NBLK_; if (id >= total) return false; u.t0 = id % nM; u.t1 = id / nM; u.t2 = 0;
        u.gA = A + (size_t)u.t0 * astep; u.gB = B + (size_t)u.t1 * bstep; return true; }
    __device__ __forceinline__ void va(const UnitD&, unsigned (&v)[2][2]) const { offs_direct(v, lda, false); }
    __device__ __forceinline__ void vb(unsigned (&v)[2][2]) const { offs_direct(v, ldb, true); }
};

__device__ __forceinline__ void store_bf16_tile(const Acc& acc, bf16_t* O, int ld, int wr, int wc, int fr, int fq, const float sc = 1.0f) {
#pragma unroll
    for (int ai = 0; ai < 2; ++ai)
#pragma unroll
        for (int m = 0; m < 4; ++m) { bf16_t* rowp = O + (size_t)(ai * HALF + wr * 64 + m * 16 + fr) * ld + wc * 32 + 8 * fq;
#pragma unroll
            for (int bj = 0; bj < 2; ++bj) { const f32x4 v0 = acc[ai][bj][m][0] * sc, v1 = acc[ai][bj][m][1] * sc;
                u32x4 w; w.x = cvt_pk_bf16(v0[0], v0[1]); w.y = cvt_pk_bf16(v0[2], v0[3]); w.z = cvt_pk_bf16(v1[0], v1[1]); w.w = cvt_pk_bf16(v1[2], v1[3]);
                *(u32x4*)(rowp + bj * HALF) = w; } }
}
__device__ __forceinline__ void store_f32_tile(const Acc& acc, float* O, const float* R, int ld, int ncol, int wr, int wc, int fr, int fq, const float sc = 1.0f) {
#pragma unroll
    for (int ai = 0; ai < 2; ++ai)
#pragma unroll
        for (int m = 0; m < 4; ++m) { const size_t ro = (size_t)(ai * HALF + wr * 64 + m * 16 + fr) * ld;
#pragma unroll
            for (int bj = 0; bj < 2; ++bj)
#pragma unroll
                for (int n = 0; n < 2; ++n) { const int c = bj * HALF + wc * 32 + 8 * fq + 4 * n; if (c >= ncol) continue;
                    f32x4 v = acc[ai][bj][m][n] * sc; if (R) v += *(const f32x4*)(R + ro + c); *(f32x4*)(O + ro + c) = v; } }
}
struct EpiProj {
    bf16_t* O; int ld; float* F; int fld, fp0, fp1, ncol; float sc;
    __device__ __forceinline__ void operator()(const Acc& acc, const UnitD& u, int wr, int wc, int fr, int fq) const {
        if (u.t1 >= fp0 && u.t1 < fp1) store_f32_tile(acc, F + (size_t)u.t0 * BM * fld + (u.t1 - fp0) * BM, nullptr, fld, ncol, wr, wc, fr, fq, sc);
        else store_bf16_tile(acc, O + (size_t)u.t0 * BM * ld + u.t1 * BM, ld, wr, wc, fr, fq, sc);
    }
};
struct EpiResid {
    bf16_t* O; const float* Rf; const bf16_t* Rb; float sc;
    __device__ __forceinline__ void operator()(const Acc& acc, const UnitD& u, int wr, int wc, int fr, int fq) const {
        const size_t o = (size_t)u.t0 * BM * D_ + u.t1 * BM;
#pragma unroll
        for (int ai = 0; ai < 2; ++ai)
#pragma unroll
            for (int m = 0; m < 4; ++m) { const size_t ro = o + (size_t)(ai * HALF + wr * 64 + m * 16 + fr) * D_ + wc * 32 + 8 * fq;
#pragma unroll
                for (int bj = 0; bj < 2; ++bj) { f32x4 v0 = acc[ai][bj][m][0] * sc, v1 = acc[ai][bj][m][1] * sc;
                    if (Rf) { v0 += *(const f32x4*)(Rf + ro + bj * HALF); v1 += *(const f32x4*)(Rf + ro + bj * HALF + 4); }
                    else { const u32x4 r = *(const u32x4*)(Rb + ro + bj * HALF); v0[0] += bf_lo(r.x); v0[1] += bf_hi(r.x); v0[2] += bf_lo(r.y); v0[3] += bf_hi(r.y); v1[0] += bf_lo(r.z); v1[1] += bf_hi(r.z); v1[2] += bf_lo(r.w); v1[3] += bf_hi(r.w); }
                    u32x4 w; w.x = cvt_pk_bf16(v0[0], v0[1]); w.y = cvt_pk_bf16(v0[2], v0[3]); w.z = cvt_pk_bf16(v1[0], v1[1]); w.w = cvt_pk_bf16(v1[2], v1[3]);
                    *(u32x4*)(O + ro + bj * HALF) = w; } }
    }
};
struct EpiLogits {
    float* O;
    __device__ __forceinline__ void operator()(const Acc& acc, const UnitD& u, int wr, int wc, int fr, int fq) const { store_f32_tile(acc, O + (size_t)u.t0 * BM * 128, nullptr, 128, 128, wr, wc, fr, fq); }
};
struct EpiSwiGLU {
    unsigned char* O;
    __device__ __forceinline__ void operator()(const Acc& acc, const UnitD& u, int wr, int wc, int fr, int fq) const {
        unsigned char* o = O + (size_t)u.t0 * BM * DEXP + u.t1 * 128;
#pragma unroll
        for (int ai = 0; ai < 2; ++ai)
#pragma unroll
            for (int m = 0; m < 4; ++m) { unsigned char* rowp = o + (size_t)(ai * HALF + wr * 64 + m * 16 + fr) * DEXP + wc * 32 + 8 * fq;
                float r[8];
#pragma unroll
                for (int n = 0; n < 2; ++n)
#pragma unroll
                    for (int j = 0; j < 4; ++j) r[n * 4 + j] = (ACT8_SCALE / W8_SCALE) * siluf_(acc[ai][0][m][n][j] * (1.0f / W8_SCALE)) * acc[ai][1][m][n][j];
                u32x2 w; w.x = pk_fp8x4(r[0], r[1], r[2], r[3]); w.y = pk_fp8x4(r[4], r[5], r[6], r[7]);
                *(u32x2*)rowp = w; }
    }
};
struct EpiDown {
    unsigned char* O;
    __device__ __forceinline__ void operator()(const Acc& acc, const UnitD& u, int wr, int wc, int fr, int fq) const {
        unsigned char* o = O + (size_t)u.t0 * BM * D_ + u.t1 * BM; const float sc = 1.0f / (W8_SCALE * ACT8_SCALE);
#pragma unroll
        for (int ai = 0; ai < 2; ++ai)
#pragma unroll
            for (int m = 0; m < 4; ++m) { unsigned char* rowp = o + (size_t)(ai * HALF + wr * 64 + m * 16 + fr) * D_ + wc * 32 + 8 * fq;
#pragma unroll
                for (int bj = 0; bj < 2; ++bj) { const f32x4 v0 = acc[ai][bj][m][0] * sc, v1 = acc[ai][bj][m][1] * sc;
                    u32x2 w; w.x = pk_fp8x4(v0[0], v0[1], v0[2], v0[3]); w.y = pk_fp8x4(v1[0], v1[1], v1[2], v1[3]); *(u32x2*)(rowp + bj * HALF) = w; } }
    }
};
__device__ __forceinline__ unsigned rg_idx(unsigned tok, int c) { return ((((tok >> 12) * 64u + (unsigned)(c >> 4)) * (unsigned)S_ + (tok & (unsigned)(S_ - 1))) << 4) + (unsigned)(c & 15); }
struct EpiRgGates {
    bf16_t* LAo; bf16_t* Uo; const bf16_t* xc;
    const float* ba; const float* bx; const float* lam;
    __device__ __forceinline__ void operator()(const Acc& acc, const UnitD& u, int wr, int wc, int fr, int fq) const {
#pragma unroll
        for (int n = 0; n < 2; ++n) { const int c = u.t1 * 128 + wc * 32 + 8 * fq + 4 * n;
            const f32x4 vba = *(const f32x4*)(ba + c), vbx = *(const f32x4*)(bx + c), vl = *(const f32x4*)(lam + c);
            f32x4 c8; for (int j = 0; j < 4; ++j) c8[j] = -8.0f * softplusf_(-vl[j]);
#pragma unroll
            for (int ai = 0; ai < 2; ++ai)
#pragma unroll
                for (int m = 0; m < 4; ++m) { const unsigned tok = (unsigned)(u.t0 * BM + ai * HALF + wr * 64 + m * 16 + fr);
                    const u32x2 xw = *(const u32x2*)(xc + (tok * 1024u + (unsigned)c)); const float xv[4] = {bf_lo(xw.x), bf_hi(xw.x), bf_lo(xw.y), bf_hi(xw.y)};
                    f32x4 lv, uv;
#pragma unroll
                    for (int j = 0; j < 4; ++j) { const float r = sigmoidf_(acc[ai][0][m][n][j] + vba[j]), ig = sigmoidf_(acc[ai][1][m][n][j] + vbx[j]);
                        const float la = c8[j] * r, av = __expf(la); lv[j] = la; uv[j] = __builtin_amdgcn_sqrtf(fmaxf(0.f, 1.0f - av * av)) * ig * xv[j]; }
                    const unsigned o = rg_idx(tok, c);
                    u32x2 w0; w0.x = cvt_pk_bf16(lv[0], lv[1]); w0.y = cvt_pk_bf16(lv[2], lv[3]); *(u32x2*)(LAo + o) = w0;
                    u32x2 w1; w1.x = cvt_pk_bf16(uv[0], uv[1]); w1.y = cvt_pk_bf16(uv[2], uv[3]); *(u32x2*)(Uo + o) = w1; } }
    }
};


__device__ __forceinline__ void transpose_job8(const float* src, unsigned char* dst, int K, int N, int ldd, size_t sb, size_t db, int nbatch, LAS unsigned char* lds) {
    const int tid = TIDX, tk = K / 128, tn = N / 64, per = tk * tn, total = per * nbatch;
    const int rr0 = tid >> 4, c4 = (tid & 15) * 4, n = tid >> 3, kg = (tid & 7) * 16;
    f32x4 va[4], vb[4];
#define T8_LD(v, t) { const int u_ = (t), ub_ = u_ / per, ur_ = u_ % per, uik_ = ur_ / tn, uin_ = ur_ % tn; const float* usp_ = src + (size_t)ub_ * sb + (size_t)(uik_ * 128 + rr0) * N + uin_ * 64 + c4; \
        _Pragma("unroll") for (int i = 0; i < 4; ++i) v[i] = *(const f32x4*)(usp_ + (size_t)(i * 32) * N); }
#define T8_ST(v, t, buf) { const int t_ = (t), b_ = t_ / per, r_ = t_ % per, ik_ = r_ / tn, in_ = r_ % tn; LAS float* tile = (LAS float*)(lds + (buf) * (128 * 65 * 4)); \
        _Pragma("unroll") for (int i = 0; i < 4; ++i) { const int rr = rr0 + i * 32; tile[rr * 65 + c4 + 0] = v[i][0]; tile[rr * 65 + c4 + 1] = v[i][1]; tile[rr * 65 + c4 + 2] = v[i][2]; tile[rr * 65 + c4 + 3] = v[i][3]; } \
        if (t_ + 2 * NBLK < total) T8_LD(v, t_ + 2 * NBLK) \
        LDS_BARRIER(); \
        float f[16]; \
        _Pragma("unroll") for (int j = 0; j < 16; ++j) f[j] = tile[(kg + j) * 65 + n] * W8_SCALE; \
        u32x4 w; w.x = pk_fp8x4(f[0], f[1], f[2], f[3]); w.y = pk_fp8x4(f[4], f[5], f[6], f[7]); w.z = pk_fp8x4(f[8], f[9], f[10], f[11]); w.w = pk_fp8x4(f[12], f[13], f[14], f[15]); \
        *(u32x4*)(dst + (size_t)b_ * db + (size_t)(in_ * 64 + n) * ldd + ik_ * 128 + kg) = w; }
    int t = BID;
    if (t < total) T8_LD(va, t)
    if (t + NBLK < total) T8_LD(vb, t + NBLK)
    for (; t < total; t += 2 * NBLK) {
        T8_ST(va, t, 0)
        if (t + NBLK < total) T8_ST(vb, t + NBLK, 1)
    }
#undef T8_LD
#undef T8_ST
    LDS_BARRIER();
}
__device__ __forceinline__ void transpose_job(const float* src, bf16_t* dst, int K, int N, int ldd, size_t sb, size_t db, int dalt, int nbatch, LAS unsigned char* lds) {
    const int tid = TIDX, tk = K / 64, tn = N / 64, per = tk * tn, total = per * nbatch;
    const int rr0 = tid >> 4, c4 = (tid & 15) * 4, n = tid >> 3, kg = (tid & 7) * 8;
    f32x4 va[2], vb[2];
#define T16_LD(v, t) { const int u_ = (t), ub_ = u_ / per, ur_ = u_ % per, uik_ = ur_ / tn, uin_ = ur_ % tn; const float* usp_ = src + (size_t)ub_ * sb + (size_t)(uik_ * 64 + rr0) * N + uin_ * 64 + c4; \
        _Pragma("unroll") for (int i = 0; i < 2; ++i) v[i] = *(const f32x4*)(usp_ + (size_t)(i * 32) * N); }
#define T16_ST(v, t, buf) { const int t_ = (t), b_ = t_ / per, r_ = t_ % per, ik_ = r_ / tn, in_ = r_ % tn; LAS float* tile = (LAS float*)(lds + (buf) * (64 * 65 * 4)); \
        _Pragma("unroll") for (int i = 0; i < 2; ++i) { const int rr = rr0 + i * 32; tile[rr * 65 + c4 + 0] = v[i][0]; tile[rr * 65 + c4 + 1] = v[i][1]; tile[rr * 65 + c4 + 2] = v[i][2]; tile[rr * 65 + c4 + 3] = v[i][3]; } \
        if (t_ + 2 * NBLK < total) T16_LD(v, t_ + 2 * NBLK) \
        LDS_BARRIER(); \
        float f[8]; \
        _Pragma("unroll") for (int j = 0; j < 8; ++j) f[j] = tile[(kg + j) * 65 + n]; \
        u32x4 w; w.x = cvt_pk_bf16(f[0], f[1]); w.y = cvt_pk_bf16(f[2], f[3]); w.z = cvt_pk_bf16(f[4], f[5]); w.w = cvt_pk_bf16(f[6], f[7]); \
        *(u32x4*)(dst + (size_t)b_ * db + (size_t)(b_ & 1) * dalt + (size_t)(in_ * 64 + n) * ldd + ik_ * 64 + kg) = w; }
    int t = BID;
    if (t < total) T16_LD(va, t)
    if (t + NBLK < total) T16_LD(vb, t + NBLK)
    for (; t < total; t += 2 * NBLK) {
        T16_ST(va, t, 0)
        if (t + NBLK < total) T16_ST(vb, t + NBLK, 1)
    }
#undef T16_LD
#undef T16_ST
    LDS_BARRIER();
}

__device__ __forceinline__ void moe_weight_jobs(const Args& a, int layer, LAS unsigned char* lds) {
    const size_t lo = (size_t)layer * NEXP * D_ * DEXP;
    transpose_job8(a.in[25] + lo, a.ws + WS_WG, D_, DEXP, D_, (size_t)D_ * DEXP, (size_t)DEXP * D_, NEXP, lds);
    transpose_job8(a.in[26] + lo, a.ws + WS_WU, D_, DEXP, D_, (size_t)D_ * DEXP, (size_t)DEXP * D_, NEXP, lds);
    transpose_job8(a.in[27] + lo, a.ws + WS_WD, DEXP, D_, DEXP, (size_t)D_ * DEXP, (size_t)DEXP * D_, NEXP, lds);
}

__device__ __forceinline__ void phase_prologue(const Args& a, LAS unsigned char* lds) {
    const int gtid = BID * NTHREADS + TIDX, gsz = NBLK * NTHREADS;
    for (int i = gtid; i < 1024; i += gsz) { const float l0 = a.in[12][i], l1 = a.in[12][1024 + i], mx = fmaxf(l0, l1), e0 = __expf(l0 - mx), e1 = __expf(l1 - mx);
        ((float*)(a.ws + WS_LB))[i] = e0 / (e0 + e1); }
    for (int it = gtid; it < 2 * 256 * 256; it += gsz) { const int l = it >> 16, n = (it >> 8) & 255, k8 = (it & 255) * 8; float f[8];
#pragma unroll
        for (int j = 0; j < 8; ++j) { const int k = k8 + j; f[j] = n < 8 ? a.in[21][((size_t)l * D_ + k) * 8 + n] : (n < 72 ? a.in[23][((size_t)l * D_ + k) * 64 + (n - 8)] : 0.f); }
        u32x4 w; w.x = cvt_pk_bf16(f[0], f[1]); w.y = cvt_pk_bf16(f[2], f[3]); w.z = cvt_pk_bf16(f[4], f[5]); w.w = cvt_pk_bf16(f[6], f[7]);
        *(u32x4*)((bf16_t*)(a.ws + WS_WRT) + ((size_t)l * 256 + n) * D_ + k8) = w; }
    for (int it = gtid; it < 192 * 128; it += gsz) *(u32x4*)(a.ws + WS_WIN1T + (size_t)N_IN1 * D_ + (size_t)it * 16) = (u32x4){0u, 0u, 0u, 0u};
    transpose_job(a.in[4], (bf16_t*)(a.ws + WS_WIN0T), D_, N_IN0, D_, 0, 0, 0, 1, lds);
    transpose_job(a.in[14], (bf16_t*)(a.ws + WS_WOUT0T), D_, D_, D_, 0, 0, 0, 1, lds);
    transpose_job8(a.in[15], a.ws + WS_WIN1T, D_, N_IN1, D_, 0, 0, 1, lds);
    transpose_job8(a.in[20], a.ws + WS_WOUT1T, 4096, D_, 4096, 0, 0, 1, lds);
    transpose_job(a.in[7], (bf16_t*)(a.ws + WS_WGATES), 128, 128, 128, 128 * 128, 256 * 128, 0, 8, lds);
    transpose_job(a.in[9], (bf16_t*)(a.ws + WS_WGATES) + 128 * 128, 128, 128, 128, 128 * 128, 256 * 128, 0, 8, lds);
    moe_weight_jobs(a, 0, lds);
}

#define NORM_PH(M, F) phase_norm<M, F>
template <int MODE, bool F32>
__device__ __forceinline__ void phase_norm(const Args& a, const float* src, const float* gain, int layer) {
    const int wid = TIDX >> 6, lane = TIDX & 63;
    bf16_t* xw = (bf16_t*)(a.ws + WS_X); bf16_t* hw = (bf16_t*)(a.ws + WS_H);
    const unsigned char* ym = a.ws + WS_YMOE; const int* posof = (const int*)(a.ws + WS_POSOF); const float* gate = (const float*)(a.ws + WS_GATE);
    const int stride = NBLK * 16;
    f32x4 rf[2][8]; u32x2 rb[2][8]; int pp[2][2] = {{0, 0}, {0, 0}}; float pg[2][2] = {{0.f, 0.f}, {0.f, 0.f}};
#define NORM_LD(r) { _Pragma("unroll") for (int u = 0; u < 2; ++u) { _Pragma("unroll") for (int i = 0; i < 8; ++i) { \
            if (F32) rf[u][i] = *(const f32x4*)(src + (size_t)((r) + u) * D_ + (i * 64 + lane) * 4); else rb[u][i] = *(const u32x2*)(xw + (size_t)((r) + u) * D_ + (i * 64 + lane) * 4); } \
            if (MODE >= 1) { pp[u][0] = posof[((r) + u) * 2]; pp[u][1] = posof[((r) + u) * 2 + 1]; pg[u][0] = gate[((r) + u) * 2]; pg[u][1] = gate[((r) + u) * 2 + 1]; } } }
    int row = (BID * 8 + wid) * 2;
    if (row < T_) NORM_LD(row)
    for (; row < T_; row += stride) {
        f32x4 v[2][8]; int p[2][2]; float g[2][2];
#pragma unroll
        for (int u = 0; u < 2; ++u) { p[u][0] = pp[u][0]; p[u][1] = pp[u][1]; g[u][0] = pg[u][0]; g[u][1] = pg[u][1];
#pragma unroll
            for (int i = 0; i < 8; ++i) v[u][i] = F32 ? rf[u][i] : (f32x4){bf_lo(rb[u][i].x), bf_hi(rb[u][i].x), bf_lo(rb[u][i].y), bf_hi(rb[u][i].y)}; }
        if (row + stride < T_) NORM_LD(row + stride)
        if (MODE >= 1) {
            int y[2][8][2];
#pragma unroll
            for (int u = 0; u < 2; ++u) {
#pragma unroll
                for (int i = 0; i < 8; ++i) { const int c = (i * 64 + lane) * 4; y[u][i][0] = *(const int*)(ym + (size_t)p[u][0] * D_ + c); y[u][i][1] = *(const int*)(ym + (size_t)p[u][1] * D_ + c); } }
#pragma unroll
            for (int u = 0; u < 2; ++u) { const float g0 = g[u][0], g1 = g[u][1];
#pragma unroll
                for (int i = 0; i < 8; ++i) { const int y0 = y[u][i][0], y1 = y[u][i][1];
                    const f32x2 a0 = __builtin_amdgcn_cvt_pk_f32_fp8(y0, false), a1 = __builtin_amdgcn_cvt_pk_f32_fp8(y0, true), b0 = __builtin_amdgcn_cvt_pk_f32_fp8(y1, false), b1 = __builtin_amdgcn_cvt_pk_f32_fp8(y1, true);
                    v[u][i][0] += g0 * a0[0] + g1 * b0[0]; v[u][i][1] += g0 * a0[1] + g1 * b0[1]; v[u][i][2] += g0 * a1[0] + g1 * b1[0]; v[u][i][3] += g0 * a1[1] + g1 * b1[1]; }
                if (MODE == 1) {
#pragma unroll
                    for (int i = 0; i < 8; ++i) { u32x2 w; w.x = cvt_pk_bf16(v[u][i][0], v[u][i][1]); w.y = cvt_pk_bf16(v[u][i][2], v[u][i][3]); *(u32x2*)(xw + (size_t)(row + u) * D_ + (i * 64 + lane) * 4) = w; } } }
        }
#pragma unroll
        for (int u = 0; u < 2; ++u) {
            float ss = 0.f;
#pragma unroll
            for (int i = 0; i < 8; ++i) ss += v[u][i][0] * v[u][i][0] + v[u][i][1] * v[u][i][1] + v[u][i][2] * v[u][i][2] + v[u][i][3] * v[u][i][3];
            ss = wave_sum(ss);
            const float rstd = rsqrtf(ss * (1.0f / D_) + 1e-6f);
#pragma unroll
            for (int i = 0; i < 8; ++i) { const int c = (i * 64 + lane) * 4; const f32x4 gn = *(const f32x4*)(gain + c);
                const f32x4 o = v[u][i] * rstd * gn;
                if (MODE == 2) *(f32x4*)(a.out + (size_t)(row + u) * D_ + c) = o;
                else { if (MODE != 1) { u32x2 w; w.x = cvt_pk_bf16(o[0], o[1]); w.y = cvt_pk_bf16(o[2], o[3]); *(u32x2*)(hw + (size_t)(row + u) * D_ + c) = w; }
                       if (layer >= 0) *(unsigned*)(a.ws + WS_H8 + (size_t)(row + u) * D_ + c) = pk_fp8x4(o[0], o[1], o[2], o[3]); } } }
    }
#undef NORM_LD
    (void)layer;
}

__device__ __forceinline__ void phase_gemm_in0(const Args& a, LAS unsigned char* lds) {
    SrcGrid S{(const char*)(a.ws + WS_H), (const char*)(a.ws + WS_WIN0T), (size_t)BM * D_ * 2, (size_t)BM * D_ * 2, 64, 64 * 24, D_, D_};
    EpiProj E{(bf16_t*)(a.ws + WS_PROJ), N_IN0, (float*)(a.ws + WS_FLOG), 1024, 12, 16, 256, 1.0f};
    gemm_stream<false, false>(lds, S, D_ / BK, E);
}

__device__ __forceinline__ void phase_rg_conv(const Args& a) {
    const bf16_t* p0 = (const bf16_t*)(a.ws + WS_PROJ); bf16_t* xc = (bf16_t*)(a.ws + WS_XC);
    const float* cw = a.in[5]; const float* cb = a.in[6];
    for (int it = BID * NTHREADS + TIDX; it < 128 * (T_ / 16); it += NBLK * NTHREADS) { const int c = (it & 127) * 8; const size_t t0 = (size_t)(it >> 7) * 16;
        float w[4][8], bias[8];
#pragma unroll
        for (int k = 0; k < 4; ++k) { const f32x4 w0 = *(const f32x4*)(cw + k * 1024 + c), w1 = *(const f32x4*)(cw + k * 1024 + c + 4);
            w[k][0] = w0[0]; w[k][1] = w0[1]; w[k][2] = w0[2]; w[k][3] = w0[3]; w[k][4] = w1[0]; w[k][5] = w1[1]; w[k][6] = w1[2]; w[k][7] = w1[3]; }
        { const f32x4 b0 = *(const f32x4*)(cb + c), b1 = *(const f32x4*)(cb + c + 4); bias[0] = b0[0]; bias[1] = b0[1]; bias[2] = b0[2]; bias[3] = b0[3]; bias[4] = b1[0]; bias[5] = b1[1]; bias[6] = b1[2]; bias[7] = b1[3]; }
        u32x4 x0 = (u32x4){0u, 0u, 0u, 0u}, x1 = x0, x2 = x0;
        if ((t0 & (S_ - 1)) != 0) { x0 = *(const u32x4*)(p0 + (t0 - 3) * N_IN0 + c); x1 = *(const u32x4*)(p0 + (t0 - 2) * N_IN0 + c); x2 = *(const u32x4*)(p0 + (t0 - 1) * N_IN0 + c); }
        u32x4 xr[16];
#pragma unroll
        for (int r = 0; r < 16; ++r) xr[r] = *(const u32x4*)(p0 + (t0 + r) * N_IN0 + c);
#pragma unroll
        for (int r = 0; r < 16; ++r) { const u32x4 x3 = xr[r];
            float acc[8];
#define TAPS(j, f, m) (bias[j] + w[0][j] * f(x0.m) + w[1][j] * f(x1.m) + w[2][j] * f(x2.m) + w[3][j] * f(x3.m))
            acc[0] = TAPS(0, bf_lo, x); acc[1] = TAPS(1, bf_hi, x); acc[2] = TAPS(2, bf_lo, y); acc[3] = TAPS(3, bf_hi, y);
            acc[4] = TAPS(4, bf_lo, z); acc[5] = TAPS(5, bf_hi, z); acc[6] = TAPS(6, bf_lo, w); acc[7] = TAPS(7, bf_hi, w);
#undef TAPS
            u32x4 o; o.x = cvt_pk_bf16(acc[0], acc[1]); o.y = cvt_pk_bf16(acc[2], acc[3]); o.z = cvt_pk_bf16(acc[4], acc[5]); o.w = cvt_pk_bf16(acc[6], acc[7]);
            *(u32x4*)(xc + (t0 + r) * 1024 + c) = o;
            x0 = x1; x1 = x2; x2 = x3; } }
}

struct SrcRgGates {
    const char* xc; const char* w; int total;
    __device__ __forceinline__ bool next(int i, UnitD& u) const { const int id = BID + i * NBLK; if (id >= total) return false; u.t0 = id & 63; u.t1 = id >> 6; u.t2 = 0;
        u.gA = xc + ((size_t)u.t0 * BM * 1024 + u.t1 * 128) * 2; u.gB = w + (size_t)u.t1 * 256 * 128 * 2; return true; }
    __device__ __forceinline__ void va(const UnitD&, unsigned (&v)[2][2]) const { offs_direct(v, 1024, false); }
    __device__ __forceinline__ void vb(unsigned (&v)[2][2]) const { offs_direct(v, 128, true); }
};
__device__ __forceinline__ void phase_rg_gates(const Args& a, LAS unsigned char* lds) {
    SrcRgGates S{(const char*)(a.ws + WS_XC), (const char*)(a.ws + WS_WGATES), 64 * 8};
    EpiRgGates E{(bf16_t*)(a.ws + WS_A), (bf16_t*)(a.ws + WS_U), (const bf16_t*)(a.ws + WS_XC), a.in[8], a.in[10], a.in[11]};
    int nt = 2; asm volatile("" : "+s"(nt));
    gemm_stream<false, false>(lds, S, nt, E);
}

__device__ __forceinline__ void phase_rg_scan(const Args& a, LAS unsigned char* lds) {
    const bf16_t* LA = (const bf16_t*)(a.ws + WS_A); const bf16_t* U = (const bf16_t*)(a.ws + WS_U);
    const bf16_t* p0 = (const bf16_t*)(a.ws + WS_PROJ); bf16_t* Y = (bf16_t*)(a.ws + WS_Y);
    LAS float* sP = (LAS float*)lds; LAS float* sH = sP + 4096; LAS float* gP = sH + 4096; LAS float* gH = gP + 512; LAS float* gC = gH + 512;
    const int tid = TIDX, seg = tid >> 1, c8 = (tid & 1) * 8;
    for (int blk = BID; blk < NB_ * 64; blk += NBLK) { const int b = blk >> 6, c = (blk & 63) * 16 + c8;
        const size_t base = (((size_t)blk * S_ + seg * 16) << 4) + c8;
        float P[8], H[8];
#pragma unroll
        for (int j = 0; j < 8; ++j) { P[j] = 1.f; H[j] = 0.f; }
#pragma unroll 4
        for (int s = 0; s < 16; ++s) { const u32x4 lw = *(const u32x4*)(LA + base + (size_t)s * 16), uw = *(const u32x4*)(U + base + (size_t)s * 16);
            const float la[8] = {bf_lo(lw.x), bf_hi(lw.x), bf_lo(lw.y), bf_hi(lw.y), bf_lo(lw.z), bf_hi(lw.z), bf_lo(lw.w), bf_hi(lw.w)};
            const float uu[8] = {bf_lo(uw.x), bf_hi(uw.x), bf_lo(uw.y), bf_hi(uw.y), bf_lo(uw.z), bf_hi(uw.z), bf_lo(uw.w), bf_hi(uw.w)};
#pragma unroll
            for (int j = 0; j < 8; ++j) { const float av = __expf(la[j]); H[j] = av * H[j] + uu[j]; P[j] *= av; } }
        __syncthreads();
#pragma unroll
        for (int j = 0; j < 8; ++j) { sP[seg * 16 + c8 + j] = P[j]; sH[seg * 16 + c8 + j] = H[j]; }
        __syncthreads();
        { const int ch = tid & 15, grp = tid >> 4; float p = 1.f, h = 0.f;
#pragma unroll
          for (int q = 0; q < 8; ++q) { const int sgi = grp * 8 + q; h = sP[sgi * 16 + ch] * h + sH[sgi * 16 + ch]; p *= sP[sgi * 16 + ch]; }
          gP[grp * 16 + ch] = p; gH[grp * 16 + ch] = h; }
        __syncthreads();
        if (tid < 16) { float carry = 0.f; for (int g = 0; g < 32; ++g) { gC[g * 16 + tid] = carry; carry = gP[g * 16 + tid] * carry + gH[g * 16 + tid]; } }
        __syncthreads();
        { const int ch = tid & 15, grp = tid >> 4; float h = gC[grp * 16 + ch];
#pragma unroll
          for (int q = 0; q < 8; ++q) { const int sgi = grp * 8 + q; const float pin = sP[sgi * 16 + ch], hin = sH[sgi * 16 + ch]; sH[sgi * 16 + ch] = h; h = pin * h + hin; } }
        __syncthreads();
#pragma unroll
        for (int j = 0; j < 8; ++j) H[j] = sH[seg * 16 + c8 + j];
        {
            u32x4 l_a[4], u_a[4], g_a[4];
#define RS_LD(Lv, Uv, Gv, s0) { _Pragma("unroll") for (int j = 0; j < 4; ++j) { const int s_ = (s0) + j; Lv[j] = *(const u32x4*)(LA + base + (size_t)s_ * 16); Uv[j] = *(const u32x4*)(U + base + (size_t)s_ * 16); \
                Gv[j] = *(const u32x4*)(p0 + ((size_t)b * S_ + seg * 16 + s_) * N_IN0 + 1024 + c); } }
            RS_LD(l_a, u_a, g_a, 0)
#pragma unroll
            for (int s0 = 0; s0 < 16; s0 += 4) { u32x4 l_b[4], u_b[4], g_b[4];
#pragma unroll
                for (int j = 0; j < 4; ++j) { l_b[j] = l_a[j]; u_b[j] = u_a[j]; g_b[j] = g_a[j]; }
                if (s0 + 4 < 16) RS_LD(l_b, u_b, g_b, s0 + 4)
#pragma unroll
                for (int j = 0; j < 4; ++j) { const u32x4 lw = l_a[j], uw = u_a[j], gw = g_a[j]; const size_t t = (size_t)b * S_ + seg * 16 + s0 + j;
                    const float la[8] = {bf_lo(lw.x), bf_hi(lw.x), bf_lo(lw.y), bf_hi(lw.y), bf_lo(lw.z), bf_hi(lw.z), bf_lo(lw.w), bf_hi(lw.w)};
                    const float uu[8] = {bf_lo(uw.x), bf_hi(uw.x), bf_lo(uw.y), bf_hi(uw.y), bf_lo(uw.z), bf_hi(uw.z), bf_lo(uw.w), bf_hi(uw.w)};
                    const float gg[8] = {bf_lo(gw.x), bf_hi(gw.x), bf_lo(gw.y), bf_hi(gw.y), bf_lo(gw.z), bf_hi(gw.z), bf_lo(gw.w), bf_hi(gw.w)};
                    float y[8];
#pragma unroll
                    for (int q = 0; q < 8; ++q) { H[q] = __expf(la[q]) * H[q] + uu[q]; y[q] = H[q] * gelu_tanh(gg[q]); }
                    u32x4 o; o.x = cvt_pk_bf16(y[0], y[1]); o.y = cvt_pk_bf16(y[2], y[3]); o.z = cvt_pk_bf16(y[4], y[5]); o.w = cvt_pk_bf16(y[6], y[7]);
                    *(u32x4*)(Y + t * D_ + c) = o; }
#pragma unroll
                for (int j = 0; j < 4; ++j) { l_a[j] = l_b[j]; u_a[j] = u_b[j]; g_a[j] = g_b[j]; } }
#undef RS_LD
        }
    }
}

typedef short s16x4 __attribute__((ext_vector_type(4)));
__device__ __forceinline__ f32x4 mfma32(bf16x8 a, bf16x8 b, f32x4 c) { return __builtin_amdgcn_mfma_f32_16x16x32_bf16(a, b, c, 0, 0, 0); }
__device__ __forceinline__ bf16x8 lds_frag(LAS const unsigned char* p) { return *(const LAS bf16x8*)p; }
__device__ __forceinline__ s16x4 lds_tr4(LAS const unsigned char* p) { return __builtin_amdgcn_ds_read_tr16_b64_v4i16((LAS s16x4*)p); }
__device__ __forceinline__ bf16x8 lds_tr8(LAS const unsigned char* p, int rowskip_bytes) {
    const s16x4 lo = lds_tr4(p), hi = lds_tr4(p + rowskip_bytes); return __builtin_shufflevector(lo, hi, 0, 1, 2, 3, 4, 5, 6, 7); }
__device__ __forceinline__ bf16x8 pack8(const f32x4& lo, const f32x4& hi) { u32x4 w; w.x = cvt_pk_bf16(lo[0], lo[1]); w.y = cvt_pk_bf16(lo[2], lo[3]); w.z = cvt_pk_bf16(hi[0], hi[1]); w.w = cvt_pk_bf16(hi[2], hi[3]); return __builtin_bit_cast(bf16x8, w); }
constexpr int RSB = 272;

constexpr size_t WS_HQ = WS_O;
constexpr size_t WS_HA = WS_HQ + (size_t)2048 * 64 * 128 * 2;
constexpr size_t WS_HG = WS_HA + (size_t)2048 * 8 * 512 * 2;
constexpr size_t WS_HS = WS_HG + (size_t)2048 * 128 * 128 * 2;
constexpr size_t WS_HD = WS_HS + (size_t)2048 * 128 * 128 * 2;
static_assert(WS_HD + (size_t)2048 * 128 * 4 <= WS_TAIL, "hgrn overlay");

__device__ __forceinline__ void phase_hg1(const Args& a, LAS unsigned char* lds) {
    const bf16_t* p0 = (const bf16_t*)(a.ws + WS_PROJ); const float* flog = (const float*)(a.ws + WS_FLOG); const float* lb = (const float*)(a.ws + WS_LB);
    bf16_t* QG = (bf16_t*)(a.ws + WS_HQ); bf16_t* AG = (bf16_t*)(a.ws + WS_HA); bf16_t* GG = (bf16_t*)(a.ws + WS_HG); float* DG = (float*)(a.ws + WS_HD);
    constexpr int SEG = 0, QT = 4096, KT = QT + 64 * RSB, KH = KT + 64 * RSB, VS = KH + 64 * RSB;
    const int tid = TIDX, wid = tid >> 6, lane = tid & 63, I = lane & 15, G = lane >> 4, k2 = 2 * lane, sg = wid;
    LAS float* seg = (LAS float*)(lds + SEG);
    u32x4 pvv[2]; f32x2 pz[8]; unsigned pqw[8];
#define HG1_LOAD(it_) do { const int bh_ = (it_) >> 6, ck_ = (it_) & 63, h_ = bh_ & 7; const size_t t0_ = (size_t)(bh_ >> 3) * S_ + ck_ * 64; \
        _Pragma("unroll") for (int i = 0; i < 2; ++i) { const int c = tid + i * 512, s_ = c >> 4, v8 = (c & 15) * 8; pvv[i] = *(const u32x4*)(p0 + (t0_ + s_) * N_IN0 + 4096 + h_ * 128 + v8); } \
        _Pragma("unroll") for (int i = 0; i < 8; ++i) { const size_t t_ = t0_ + sg * 8 + i; pz[i] = *(const f32x2*)(flog + t_ * 1024 + h_ * 128 + k2); pqw[i] = *(const unsigned*)(p0 + t_ * N_IN0 + 2048 + h_ * 128 + k2); } } while (0)
    if (BID < 2048) HG1_LOAD(BID);
    for (int item = BID; item < 2048; item += NBLK) { const int bh = item >> 6, h = bh & 7;
        LDS_BARRIER();
#pragma unroll
        for (int i = 0; i < 2; ++i) { const int c = tid + i * 512, s = c >> 4, v8 = (c & 15) * 8; *(LAS u32x4*)(lds + VS + s * RSB + v8 * 2) = pvv[i]; }
        const f32x2 l2 = *(const f32x2*)(lb + h * 128 + k2);
        float f[8][2], cb[8][2]; unsigned qw[8]; float c0 = 0.f, c1 = 0.f;
#pragma unroll
        for (int i = 0; i < 8; ++i) { const f32x2 z = pz[i]; qw[i] = pqw[i];
            f[i][0] = l2[0] + (1.0f - l2[0]) * sigmoidf_(z[0]); f[i][1] = l2[1] + (1.0f - l2[1]) * sigmoidf_(z[1]);
            c0 += __logf(f[i][0]); c1 += __logf(f[i][1]); cb[i][0] = c0; cb[i][1] = c1; }
        *(LAS f32x2*)(seg + sg * 128 + k2) = (f32x2){c0, c1};
        if (item + NBLK < 2048) HG1_LOAD(item + NBLK);
        LDS_BARRIER();
        float off0 = 0.f, off1 = 0.f, tot0 = 0.f, tot1 = 0.f;
#pragma unroll
        for (int s2 = 0; s2 < 8; ++s2) { const f32x2 v = *(const LAS f32x2*)(seg + s2 * 128 + k2); tot0 += v[0]; tot1 += v[1]; if (s2 < sg) { off0 += v[0]; off1 += v[1]; } }
        const float et0 = __expf(tot0), et1 = __expf(tot1);
#pragma unroll
        for (int i = 0; i < 8; ++i) { const int t = sg * 8 + i;
            const float e0 = __expf(cb[i][0] + off0), e1 = __expf(cb[i][1] + off1), r0 = __builtin_amdgcn_rcpf(e0), r1 = __builtin_amdgcn_rcpf(e1), km0 = 1.0f - f[i][0], km1 = 1.0f - f[i][1];
            const unsigned qt = cvt_pk_bf16(siluf_(bf_lo(qw[i])) * e0, siluf_(bf_hi(qw[i])) * e1);
            *(LAS unsigned*)(lds + QT + t * RSB + k2 * 2) = qt; *(unsigned*)(QG + ((size_t)item * 64 + t) * 128 + k2) = qt;
            *(LAS unsigned*)(lds + KT + t * RSB + k2 * 2) = cvt_pk_bf16(km0 * r0, km1 * r1);
            *(LAS unsigned*)(lds + KH + t * RSB + k2 * 2) = cvt_pk_bf16(km0 * r0 * et0, km1 * r1 * et1); }
        if (sg == 0) *(f32x2*)(DG + (size_t)item * 128 + k2) = (f32x2){et0, et1};
        LDS_BARRIER();
        { const int tt = wid & 3, sp = wid >> 2;
          bf16x8 qf[4];
#pragma unroll
          for (int ks = 0; ks < 4; ++ks) qf[ks] = lds_frag(lds + QT + (16 * tt + I) * RSB + (32 * ks + 8 * G) * 2);
          f32x4 acc[2];
#pragma unroll
          for (int hh = 0; hh < 2; ++hh) { const int st = 2 * sp + hh; acc[hh] = (f32x4){0.f, 0.f, 0.f, 0.f};
              if (st <= tt) {
#pragma unroll
                  for (int ks = 0; ks < 4; ++ks) acc[hh] = mfma32(lds_frag(lds + KT + (16 * st + I) * RSB + (32 * ks + 8 * G) * 2), qf[ks], acc[hh]);
#pragma unroll
                  for (int r = 0; r < 4; ++r) if (16 * st + 4 * G + r > 16 * tt + I) acc[hh][r] = 0.f; } }
          *(bf16x8*)(AG + (((size_t)item * 4 + tt) * 2 + sp) * 512 + lane * 8) = pack8(acc[0], acc[1]); }
        { const int kt = wid, q = I >> 2, p = I & 3;
          bf16x8 ka[2];
#pragma unroll
          for (int ks = 0; ks < 2; ++ks) ka[ks] = lds_tr8(lds + KH + (32 * ks + 8 * G + q) * RSB + (16 * kt + 4 * p) * 2, 4 * RSB);
#pragma unroll
          for (int vt = 0; vt < 8; ++vt) { f32x4 acc = (f32x4){0.f, 0.f, 0.f, 0.f};
#pragma unroll
              for (int ks = 0; ks < 2; ++ks) acc = mfma32(ka[ks], lds_tr8(lds + VS + (32 * ks + 8 * G + q) * RSB + (16 * vt + 4 * p) * 2, 4 * RSB), acc);
              u32x2 w; w.x = cvt_pk_bf16(acc[0], acc[1]); w.y = cvt_pk_bf16(acc[2], acc[3]);
              *(u32x2*)(GG + ((size_t)item * 128 + 16 * vt + I) * 128 + 16 * kt + 4 * G) = w; } }
    }
#undef HG1_LOAD
}

__device__ __forceinline__ void phase_hg2(const Args& a) {
    const bf16_t* GG = (const bf16_t*)(a.ws + WS_HG); const float* DG = (const float*)(a.ws + WS_HD); bf16_t* SG = (bf16_t*)(a.ws + WS_HS);
    for (int gid = BID * NTHREADS + TIDX; gid < 32 * 4096; gid += NBLK * NTHREADS) { const int bh = gid >> 12, e = gid & 4095, v = e >> 5, k4 = (e & 31) * 4;
        f32x4 S = (f32x4){0.f, 0.f, 0.f, 0.f};
        const size_t o0 = (((size_t)bh * 64) * 128 + v) * 128 + k4; const float* dg = DG + (size_t)bh * 64 * 128 + k4;
        f32x4 da[8]; u32x2 ga[8];
#pragma unroll
        for (int j = 0; j < 8; ++j) { da[j] = *(const f32x4*)(dg + j * 128); ga[j] = *(const u32x2*)(GG + o0 + (size_t)j * 16384); }
#pragma unroll 1
        for (int n0 = 0; n0 < 64; n0 += 8) { f32x4 db[8]; u32x2 gb[8];
#pragma unroll
            for (int j = 0; j < 8; ++j) { db[j] = da[j]; gb[j] = ga[j]; }
            if (n0 + 8 < 64) {
#pragma unroll
                for (int j = 0; j < 8; ++j) { db[j] = *(const f32x4*)(dg + (n0 + 8 + j) * 128); gb[j] = *(const u32x2*)(GG + o0 + (size_t)(n0 + 8 + j) * 16384); } }
#pragma unroll
            for (int j = 0; j < 8; ++j) { u32x2 w; w.x = cvt_pk_bf16(S[0], S[1]); w.y = cvt_pk_bf16(S[2], S[3]); *(u32x2*)(SG + o0 + (size_t)(n0 + j) * 16384) = w;
                const f32x4 d = da[j]; const u32x2 g = ga[j];
                S[0] = d[0] * S[0] + bf_lo(g.x); S[1] = d[1] * S[1] + bf_hi(g.x); S[2] = d[2] * S[2] + bf_lo(g.y); S[3] = d[3] * S[3] + bf_hi(g.y); }
#pragma unroll
            for (int j = 0; j < 8; ++j) { da[j] = db[j]; ga[j] = gb[j]; } } }
}

__device__ __forceinline__ void phase_hg3(const Args& a, LAS unsigned char* lds) {
    const bf16_t* p0 = (const bf16_t*)(a.ws + WS_PROJ); const bf16_t* QG = (const bf16_t*)(a.ws + WS_HQ); const bf16_t* AG = (const bf16_t*)(a.ws + WS_HA); const bf16_t* SG = (const bf16_t*)(a.ws + WS_HS);
    bf16_t* Y = (bf16_t*)(a.ws + WS_Y); const float* gain = a.in[13];
    constexpr int ST = 0, QT = 128 * RSB, VS = QT + 64 * RSB, PART = VS + 64 * RSB;
    const int tid = TIDX, wid = tid >> 6, lane = tid & 63, I = lane & 15, G = lane >> 4, q = I >> 2, p = I & 3;
    LAS float* part = (LAS float*)(lds + PART);
    const int tt = wid & 3, vh = wid >> 2;
    u32x4 ps[4], pq2[2], pv2[2]; bf16x8 paf[2];
#define HG3_LOAD(it_) do { const int bh_ = (it_) >> 6, ck_ = (it_) & 63; const size_t t0_ = (size_t)(bh_ >> 3) * S_ + ck_ * 64; const int h_ = bh_ & 7; \
        _Pragma("unroll") for (int i = 0; i < 4; ++i) { const int c = tid + i * 512, v = c >> 4, k8 = (c & 15) * 8; ps[i] = *(const u32x4*)(SG + ((size_t)(it_) * 128 + v) * 128 + k8); } \
        _Pragma("unroll") for (int i = 0; i < 2; ++i) { const int c = tid + i * 512, s_ = c >> 4, c8 = (c & 15) * 8; pq2[i] = *(const u32x4*)(QG + ((size_t)(it_) * 64 + s_) * 128 + c8); pv2[i] = *(const u32x4*)(p0 + (t0_ + s_) * N_IN0 + 4096 + h_ * 128 + c8); } \
        _Pragma("unroll") for (int sp = 0; sp < 2; ++sp) paf[sp] = *(const bf16x8*)(AG + (((size_t)(it_) * 4 + tt) * 2 + sp) * 512 + lane * 8); } while (0)
    if (BID < 2048) HG3_LOAD(BID);
    for (int item = BID; item < 2048; item += NBLK) { const int bh = item >> 6, ck = item & 63, b = bh >> 3, h = bh & 7; const size_t t0 = (size_t)b * S_ + ck * 64;
        LDS_BARRIER();
#pragma unroll
        for (int i = 0; i < 4; ++i) { const int c = tid + i * 512, v = c >> 4, k8 = (c & 15) * 8; *(LAS u32x4*)(lds + ST + v * RSB + k8 * 2) = ps[i]; }
#pragma unroll
        for (int i = 0; i < 2; ++i) { const int c = tid + i * 512, s2 = c >> 4, c8 = (c & 15) * 8; *(LAS u32x4*)(lds + QT + s2 * RSB + c8 * 2) = pq2[i]; *(LAS u32x4*)(lds + VS + s2 * RSB + c8 * 2) = pv2[i]; }
        bf16x8 af[2]; af[0] = paf[0]; af[1] = paf[1];
        if (item + NBLK < 2048) HG3_LOAD(item + NBLK);
        u32x2 zwp[4];
#pragma unroll
        for (int vi = 0; vi < 4; ++vi) zwp[vi] = *(const u32x2*)(p0 + (t0 + 16 * tt + I) * N_IN0 + 5120 + h * 128 + 16 * (4 * vh + vi) + 4 * G);
        LDS_BARRIER();
        bf16x8 qf[4];
#pragma unroll
        for (int ks = 0; ks < 4; ++ks) qf[ks] = lds_frag(lds + QT + (16 * tt + I) * RSB + (32 * ks + 8 * G) * 2);
        f32x4 acc[4]; float ss = 0.f;
#pragma unroll
        for (int vi = 0; vi < 4; ++vi) { const int vt = 4 * vh + vi; acc[vi] = (f32x4){0.f, 0.f, 0.f, 0.f};
#pragma unroll
            for (int ks = 0; ks < 4; ++ks) acc[vi] = mfma32(lds_frag(lds + ST + (16 * vt + I) * RSB + (32 * ks + 8 * G) * 2), qf[ks], acc[vi]);
#pragma unroll
            for (int sp = 0; sp < 2; ++sp) acc[vi] = mfma32(lds_tr8(lds + VS + (32 * sp + 4 * G + q) * RSB + (16 * vt + 4 * p) * 2, 16 * RSB), af[sp], acc[vi]);
            ss += acc[vi][0] * acc[vi][0] + acc[vi][1] * acc[vi][1] + acc[vi][2] * acc[vi][2] + acc[vi][3] * acc[vi][3]; }
        ss += __shfl_xor(ss, 16); ss += __shfl_xor(ss, 32);
        if (G == 0) part[wid * 16 + I] = ss;
        LDS_BARRIER();
        const float rstd = rsqrtf((part[wid * 16 + I] + part[(wid ^ 4) * 16 + I]) * (1.0f / 128.0f) + 1e-6f);
        const size_t t = t0 + 16 * tt + I;
#pragma unroll
        for (int vi = 0; vi < 4; ++vi) { const int c = h * 128 + 16 * (4 * vh + vi) + 4 * G;
            const f32x4 gn = *(const f32x4*)(gain + c); const u32x2 zw = zwp[vi];
            const float o0 = acc[vi][0] * rstd * gn[0] * siluf_(bf_lo(zw.x)), o1 = acc[vi][1] * rstd * gn[1] * siluf_(bf_hi(zw.x)), o2 = acc[vi][2] * rstd * gn[2] * siluf_(bf_lo(zw.y)), o3 = acc[vi][3] * rstd * gn[3] * siluf_(bf_hi(zw.y));
            u32x2 w; w.x = cvt_pk_bf16(o0, o1); w.y = cvt_pk_bf16(o2, o3); *(u32x2*)(Y + t * D_ + 1024 + c) = w; }
    }
#undef HG3_LOAD
}

__device__ __forceinline__ void phase_gdn_norm(const Args& a) {
    const bf16_t* O = (const bf16_t*)(a.ws + WS_O); const bf16_t* pj = (const bf16_t*)(a.ws + WS_PROJ); unsigned char* Y = a.ws + WS_Y; const float* gain = a.in[19];
    const int lane = TIDX & 63, wid = TIDX >> 6, gc = (lane & 15) * 8;
    const f32x4 g0 = *(const f32x4*)(gain + gc), g1 = *(const f32x4*)(gain + gc + 4);
    u32x4 oa[8], za[8];
    int row = BID * 8 + wid; const int stride = NBLK * 8;
#define GN_LD(ov, zv, r) { _Pragma("unroll") for (int i = 0; i < 8; ++i) { const int c = (i * 64 + lane) * 8; ov[i] = *(const u32x4*)(O + (size_t)(r) * 4096 + c); zv[i] = *(const u32x4*)(pj + (size_t)(r) * N_IN1P + 8192 + c); } }
    if (row < T_) GN_LD(oa, za, row)
    for (; row < T_; row += stride) { u32x4 ob[8], zb[8];
#pragma unroll
        for (int i = 0; i < 8; ++i) { ob[i] = oa[i]; zb[i] = za[i]; }
        if (row + stride < T_) GN_LD(ob, zb, row + stride)
#pragma unroll
        for (int i = 0; i < 8; ++i) { const int c = (i * 64 + lane) * 8;
            const u32x4 ow = oa[i], zw = za[i];
            const float o[8] = {bf_lo(ow.x), bf_hi(ow.x), bf_lo(ow.y), bf_hi(ow.y), bf_lo(ow.z), bf_hi(ow.z), bf_lo(ow.w), bf_hi(ow.w)};
            const float z[8] = {bf_lo(zw.x), bf_hi(zw.x), bf_lo(zw.y), bf_hi(zw.y), bf_lo(zw.z), bf_hi(zw.z), bf_lo(zw.w), bf_hi(zw.w)};
            float ss = 0.f;
#pragma unroll
            for (int q = 0; q < 8; ++q) ss += o[q] * o[q];
            ss = row16_sum(ss);
            const float rstd = rsqrtf(ss * (1.0f / 128.0f) + 1e-6f);
            float y[8];
#pragma unroll
            for (int q = 0; q < 8; ++q) y[q] = o[q] * rstd * (q < 4 ? g0[q & 3] : g1[q & 3]) * siluf_(z[q]);
            u32x2 w; w.x = pk_fp8x4(y[0], y[1], y[2], y[3]); w.y = pk_fp8x4(y[4], y[5], y[6], y[7]);
            *(u32x2*)(Y + (size_t)row * 4096 + c) = w; }
#pragma unroll
        for (int i = 0; i < 8; ++i) { oa[i] = ob[i]; za[i] = zb[i]; }
    }
#undef GN_LD
}

template <bool FP8>
__device__ __forceinline__ void phase_gemm_out(const Args& a, LAS unsigned char* lds, int K, const void* w, const float* xin) {
    const int eb = FP8 ? 1 : 2;
    SrcGrid S{(const char*)(a.ws + WS_Y), (const char*)w, (size_t)BM * K * eb, (size_t)BM * K * eb, 64, 64 * 8, K * eb / 2, K * eb / 2};
    EpiResid E{(bf16_t*)(a.ws + WS_X), xin, (const bf16_t*)(a.ws + WS_X), FP8 ? 1.0f / W8_SCALE : 1.0f};
    gemm_stream<false, FP8>(lds, S, K * eb / 128, E);
}

struct SrcRouter {
    const char* h; const char* w;
    __device__ __forceinline__ bool next(int i, UnitD& u) const { const int id = BID + i * NBLK; if (id >= 256) return false; u.t0 = id & 63; u.t1 = id >> 6; u.t2 = 0;
        u.gA = h + ((size_t)u.t0 * BM * D_ + u.t1 * 512) * 2; u.gB = w + (size_t)u.t1 * 512 * 2; return true; }
    __device__ __forceinline__ void va(const UnitD&, unsigned (&v)[2][2]) const { offs_direct(v, D_, false); }
    __device__ __forceinline__ void vb(unsigned (&v)[2][2]) const { offs_direct(v, D_, true); }
};
struct EpiLogitsQ {
    float* O;
    __device__ __forceinline__ void operator()(const Acc& acc, const UnitD& u, int wr, int wc, int fr, int fq) const { store_f32_tile(acc, O + ((size_t)u.t1 * T_ + (size_t)u.t0 * BM) * 128, nullptr, 128, 128, wr, wc, fr, fq); }
};
__device__ __forceinline__ void phase_gemm_router(const Args& a, LAS unsigned char* lds, int layer) {
    SrcRouter S{(const char*)(a.ws + WS_H), (const char*)(a.ws + WS_WRT) + (size_t)layer * 256 * D_ * 2};
    EpiLogitsQ E{(float*)(a.ws + WS_O)};
    gemm_stream<false, false>(lds, S, 512 / BK, E);
}

__device__ __forceinline__ void phase_route(const Args& a, int layer) {
    const float* lg = (const float*)(a.ws + WS_O); const float* bg = a.in[22] + layer * 8; const float* be = a.in[24] + layer * 64;
    int* cnt = (int*)(a.ws + WS_CTL + CTL_CNT) + layer * 64;
    int* eid = (int*)(a.ws + WS_EID); int* slot = (int*)(a.ws + WS_SLOT); float* gate = (float*)(a.ws + WS_GATE); int* rowmap = (int*)(a.ws + WS_ROWMAP);
    const int gtid = BID * NTHREADS + TIDX, gsz = NBLK * NTHREADS;
    for (int i = gtid; i < MPAD; i += gsz) rowmap[i] = 0;
    for (int t = gtid; t < T_; t += gsz) {
        f32x4 ga = (f32x4){0.f, 0.f, 0.f, 0.f}, gb = ga;
#pragma unroll
        for (int kq = 0; kq < 4; ++kq) { ga += *(const f32x4*)(lg + ((size_t)kq * T_ + t) * 128); gb += *(const f32x4*)(lg + ((size_t)kq * T_ + t) * 128 + 4); }
        const float gl[8] = {ga[0] + bg[0], ga[1] + bg[1], ga[2] + bg[2], ga[3] + bg[3], gb[0] + bg[4], gb[1] + bg[5], gb[2] + bg[6], gb[3] + bg[7]};
        float mx = -3.0e38f; int gi = 0;
#pragma unroll
        for (int j = 0; j < 8; ++j) if (gl[j] > mx) { mx = gl[j]; gi = j; }
        float se = 0.f;
#pragma unroll
        for (int j = 0; j < 8; ++j) se += __expf(gl[j] - mx);
        const float gp = 1.0f / se;
        f32x4 ea = *(const f32x4*)(be + gi * 8), eb = *(const f32x4*)(be + gi * 8 + 4);
#pragma unroll
        for (int kq = 0; kq < 4; ++kq) { ea += *(const f32x4*)(lg + ((size_t)kq * T_ + t) * 128 + 8 + gi * 8); eb += *(const f32x4*)(lg + ((size_t)kq * T_ + t) * 128 + 12 + gi * 8); }
        const float el[8] = {ea[0], ea[1], ea[2], ea[3], eb[0], eb[1], eb[2], eb[3]};
        float l1 = -3.0e38f, l2 = -3.0e38f; int i1 = 0, i2 = 0;
#pragma unroll
        for (int j = 0; j < 8; ++j) { const float v = el[j];
            if (v > l1) { l2 = l1; i2 = i1; l1 = v; i1 = j; } else if (v > l2) { l2 = v; i2 = j; } }
        const float e2 = __expf(l2 - l1), inv = 1.0f / (1.0f + e2);
        const int e0 = gi * 8 + i1, e1 = gi * 8 + i2;
        eid[t * 2] = e0; eid[t * 2 + 1] = e1; gate[t * 2] = inv * gp; gate[t * 2 + 1] = e2 * inv * gp;
        slot[t * 2] = atomicAdd(&cnt[e0], 1); slot[t * 2 + 1] = atomicAdd(&cnt[e1], 1); }
}

__device__ __forceinline__ void phase_rowmap(const Args& a, LAS unsigned char* lds, int layer) {
    const int* cnt = (const int*)(a.ws + WS_CTL + CTL_CNT) + layer * 64; LAS int* ps = (LAS int*)lds;
    int* tinfo = (int*)(a.ws + WS_TINFO) + layer * 512;
    const int* eid = (const int*)(a.ws + WS_EID); const int* slot = (const int*)(a.ws + WS_SLOT); int* posof = (int*)(a.ws + WS_POSOF); int* rowmap = (int*)(a.ws + WS_ROWMAP);
    __syncthreads();
    if (TIDX == 0) { int acc = 0; for (int e = 0; e < 64; ++e) { ps[e] = acc; acc += (cnt[e] + 255) & ~255; } ps[64] = acc; }
    __syncthreads();
    if (BID == 0) { if (TIDX <= 64) tinfo[TIDX] = ps[TIDX]; if (TIDX == 65) tinfo[65] = ps[64] >> 8;
        if (TIDX < 192) { const int p = TIDX * 256; int e = 0; for (int j = 0; j < 64; ++j) if (ps[j + 1] <= p) e = j + 1; tinfo[128 + TIDX] = e < 64 ? e : 63; } }
    for (int i = BID * NTHREADS + TIDX; i < T_ * 2; i += NBLK * NTHREADS) { const int p = ps[eid[i]] + slot[i]; posof[i] = p; rowmap[p] = i >> 1; }
    __syncthreads();
}

struct SrcMoeUp {
    const char* h; const char* wg; const int* tinfo; const int* rowmap; int total;
    __device__ __forceinline__ bool next(int i, UnitD& u) const { const int id = BID + i * NBLK; if (id >= total) return false; u.t0 = id >> 2; u.t1 = id & 3;
        u.t2 = __builtin_amdgcn_readfirstlane(tinfo[128 + u.t0]); u.gA = h; u.gB = wg + ((size_t)u.t2 * DEXP + u.t1 * 128) * D_; return true; }
    __device__ __forceinline__ void va(const UnitD& u, unsigned (&v)[2][2]) const { int R0, C0; stage_pos(TIDX, R0, C0);
#pragma unroll
        for (int hh = 0; hh < 2; ++hh)
#pragma unroll
            for (int i = 0; i < 2; ++i) v[hh][i] = (unsigned)(rowmap[u.t0 * 256 + hh * 128 + R0 + 64 * i] * D_ + C0 * 2); }
    __device__ __forceinline__ void vb(unsigned (&v)[2][2]) const { int R0, C0; stage_pos(TIDX, R0, C0);
#pragma unroll
        for (int i = 0; i < 2; ++i) { const int Rr = perm_row(R0 + 64 * i); v[0][i] = (unsigned)(Rr * D_ + C0 * 2); v[1][i] = (unsigned)(WS_WU - WS_WG) + (unsigned)(Rr * D_ + C0 * 2); } }
};
__device__ __forceinline__ void phase_moe_up(const Args& a, LAS unsigned char* lds, int layer) {
    const int* tinfo = (const int*)(a.ws + WS_TINFO) + layer * 512;
    const int ntm = __builtin_amdgcn_readfirstlane(tinfo[65]);
    SrcMoeUp S{(const char*)(a.ws + WS_H8), (const char*)(a.ws + WS_WG), tinfo, (const int*)(a.ws + WS_ROWMAP), ntm * 4};
    EpiSwiGLU E{a.ws + WS_ACT};
    gemm_stream<true, true>(lds, S, D_ / 128, E);
}

struct SrcMoeDown {
    const char* act; const char* wd; const int* tinfo; int total;
    __device__ __forceinline__ bool next(int i, UnitD& u) const { const int id = BID + i * NBLK; if (id >= total) return false; u.t0 = id >> 3; u.t1 = id & 7;
        u.t2 = __builtin_amdgcn_readfirstlane(tinfo[128 + u.t0]); u.gA = act + (size_t)u.t0 * BM * DEXP; u.gB = wd + ((size_t)u.t2 * D_ + u.t1 * BM) * DEXP; return true; }
    __device__ __forceinline__ void va(const UnitD&, unsigned (&v)[2][2]) const { offs_direct(v, DEXP / 2, false); }
    __device__ __forceinline__ void vb(unsigned (&v)[2][2]) const { offs_direct(v, DEXP / 2, true); }
};
__device__ __forceinline__ void phase_moe_down(const Args& a, LAS unsigned char* lds, int layer) {
    const int* tinfo = (const int*)(a.ws + WS_TINFO) + layer * 512; const int ntm = __builtin_amdgcn_readfirstlane(tinfo[65]);
    SrcMoeDown S{(const char*)(a.ws + WS_ACT), (const char*)(a.ws + WS_WD), tinfo, ntm * 8};
    EpiDown E{a.ws + WS_YMOE};
    gemm_stream<false, true>(lds, S, DEXP / 128, E);
}

struct SrcIn1Tail {
    const char* h; const char* w;
    __device__ __forceinline__ bool next(int i, UnitD& u) const { const int id = BID + i * NBLK; if (id >= 256) return false; u.t0 = id & 63; u.t1 = id >> 6; u.t2 = 0;
        u.gA = h + (size_t)u.t0 * BM * D_ + u.t1 * 512; u.gB = w + (size_t)48 * BM * D_ + u.t1 * 512; return true; }
    __device__ __forceinline__ void va(const UnitD&, unsigned (&v)[2][2]) const { offs_direct(v, D_ / 2, false); }
    __device__ __forceinline__ void vb(unsigned (&v)[2][2]) const { offs_direct(v, D_ / 2, true); }
};
struct EpiTailQ {
    float* O;
    __device__ __forceinline__ void operator()(const Acc& acc, const UnitD& u, int wr, int wc, int fr, int fq) const { store_f32_tile(acc, O + ((size_t)u.t1 * T_ + (size_t)u.t0 * BM) * 64, nullptr, 64, 64, wr, wc, fr, fq, 1.0f / W8_SCALE); }
};
__device__ __forceinline__ void phase_gemm_in1(const Args& a, LAS unsigned char* lds) {
    SrcGrid S{(const char*)(a.ws + WS_H8), (const char*)(a.ws + WS_WIN1T), (size_t)BM * D_, (size_t)BM * D_, 64, 64 * 48, D_ / 2, D_ / 2};
    EpiProj E{(bf16_t*)(a.ws + WS_PROJ), N_IN1P, nullptr, 64, 48, 48, 64, 1.0f / W8_SCALE};
    gemm_stream<false, true>(lds, S, D_ / 128, E);
}
__device__ __forceinline__ void phase_gemm_in1_tail(const Args& a, LAS unsigned char* lds) {
    SrcIn1Tail S{(const char*)(a.ws + WS_H8), (const char*)(a.ws + WS_WIN1T)};
    EpiTailQ E{(float*)(a.ws + WS_O)};
    int nt = 4; asm volatile("" : "+s"(nt));
    gemm_stream<false, true>(lds, S, nt, E);
}

__device__ __forceinline__ void phase_gdn_conv(const Args& a) {
    const bf16_t* p1 = (const bf16_t*)(a.ws + WS_PROJ); bf16_t* qc = (bf16_t*)(a.ws + WS_QKVC); const float* cw = a.in[16];
    const int gtid = BID * NTHREADS + TIDX, gsz = NBLK * NTHREADS;
    for (int it = gtid; it < 1024 * (T_ / 128); it += gsz) { const int c = (it & 1023) * 8, seg = it >> 10; const size_t t0 = (size_t)seg * 128;
        float w[4][8];
#pragma unroll
        for (int k = 0; k < 4; ++k) { const f32x4 w0 = *(const f32x4*)(cw + k * 8192 + c), w1 = *(const f32x4*)(cw + k * 8192 + c + 4);
            w[k][0] = w0[0]; w[k][1] = w0[1]; w[k][2] = w0[2]; w[k][3] = w0[3]; w[k][4] = w1[0]; w[k][5] = w1[1]; w[k][6] = w1[2]; w[k][7] = w1[3]; }
        u32x4 x0 = (u32x4){0u, 0u, 0u, 0u}, x1 = x0, x2 = x0;
        if ((t0 & (S_ - 1)) != 0) { x0 = *(const u32x4*)(p1 + (t0 - 3) * N_IN1P + c); x1 = *(const u32x4*)(p1 + (t0 - 2) * N_IN1P + c); x2 = *(const u32x4*)(p1 + (t0 - 1) * N_IN1P + c); }
        const float qsc = c < 2048 ? 0.08838834764831845f : 1.0f;
        u32x4 xa[8];
#pragma unroll
        for (int j = 0; j < 8; ++j) xa[j] = *(const u32x4*)(p1 + (t0 + j) * N_IN1P + c);
#pragma unroll 1
        for (int r0 = 0; r0 < 128; r0 += 8) { u32x4 xb[8];
#pragma unroll
            for (int j = 0; j < 8; ++j) xb[j] = xa[j];
            if (r0 + 8 < 128) {
#pragma unroll
                for (int j = 0; j < 8; ++j) xb[j] = *(const u32x4*)(p1 + (t0 + r0 + 8 + j) * N_IN1P + c); }
#pragma unroll
          for (int j8 = 0; j8 < 8; ++j8) { const u32x4 x3 = xa[j8]; const int r = r0 + j8;
            float acc[8];
#define TAPS(j, f, m) (w[0][j] * f(x0.m) + w[1][j] * f(x1.m) + w[2][j] * f(x2.m) + w[3][j] * f(x3.m))
            acc[0] = TAPS(0, bf_lo, x); acc[1] = TAPS(1, bf_hi, x); acc[2] = TAPS(2, bf_lo, y); acc[3] = TAPS(3, bf_hi, y);
            acc[4] = TAPS(4, bf_lo, z); acc[5] = TAPS(5, bf_hi, z); acc[6] = TAPS(6, bf_lo, w); acc[7] = TAPS(7, bf_hi, w);
#undef TAPS
            float ss = 0.f;
#pragma unroll
            for (int j = 0; j < 8; ++j) { acc[j] = siluf_(acc[j]); ss += acc[j] * acc[j]; }
            ss = row16_sum(ss);
            const float sc = c < 4096 ? rsqrtf(ss + 1e-6f) * qsc : 1.0f;
            u32x4 o; o.x = cvt_pk_bf16(acc[0] * sc, acc[1] * sc); o.y = cvt_pk_bf16(acc[2] * sc, acc[3] * sc); o.z = cvt_pk_bf16(acc[4] * sc, acc[5] * sc); o.w = cvt_pk_bf16(acc[6] * sc, acc[7] * sc);
            *(u32x4*)(qc + (t0 + r) * 8192 + c) = o;
            x0 = x1; x1 = x2; x2 = x3; }
#pragma unroll
            for (int j = 0; j < 8; ++j) xa[j] = xb[j]; } }
    const float* tail = (const float*)(a.ws + WS_O); float* bgo = (float*)(a.ws + WS_BG);
    for (int it = gtid; it < T_ * 32; it += gsz) { const int t = it >> 5, hv = it & 31; float tb = 0.f, ta = 0.f;
#pragma unroll
        for (int kq = 0; kq < 4; ++kq) { tb += tail[((size_t)kq * T_ + t) * 64 + hv]; ta += tail[((size_t)kq * T_ + t) * 64 + 32 + hv]; }
        bgo[t * 64 + hv] = sigmoidf_(tb);
        bgo[t * 64 + 32 + hv] = -__expf(a.in[17][hv]) * softplusf_(ta + a.in[18][hv]); }
}

struct MoeTile { const float* src; unsigned char* dst; int lds_, ldd; };
__device__ __forceinline__ MoeTile moe_tile(const Args& a, int g) {
    const int job = g >> 14, r = g & 16383, e = r >> 8, rr = r & 255; MoeTile t;
    typedef __attribute__((address_space(1))) const float* gcf; gcf s25 = (gcf)a.in[25], s26 = (gcf)a.in[26]; asm volatile("" : "+s"(s25), "+s"(s26));
    if (job < 2) { const int ik = rr >> 3, in = rr & 7; t.lds_ = DEXP; t.ldd = D_;
        t.src = (const float*)(job ? s26 : s25) + ((size_t)(NEXP + e) * D_ + ik * 64) * DEXP + in * 64; t.dst = a.ws + (job ? WS_WU : WS_WG) + ((size_t)e * DEXP + in * 64) * D_ + ik * 64; }
    else { const int ik = rr >> 5, in = rr & 31; t.lds_ = D_; t.ldd = DEXP;
        t.src = a.in[27] + ((size_t)(NEXP + e) * DEXP + ik * 64) * D_ + in * 64; t.dst = a.ws + WS_WD + ((size_t)e * D_ + in * 64) * DEXP + ik * 64; }
    return t;
}
__device__ __forceinline__ void moe_tile_load(const MoeTile& t, int tid, f32x4 (&v)[2]) {
#pragma unroll
    for (int i = 0; i < 2; ++i) { const int idx = tid + i * 512, rr = idx >> 4, c4 = (idx & 15) * 4; v[i] = *(const f32x4*)(t.src + (size_t)rr * t.lds_ + c4); }
}
__device__ __forceinline__ void moe_tile_store(const MoeTile& t, int tid, const f32x4 (&v)[2], LAS float* tile) {
#pragma unroll
    for (int i = 0; i < 2; ++i) { const int idx = tid + i * 512, rr = idx >> 4, c4 = (idx & 15) * 4;
        tile[rr * 65 + c4 + 0] = v[i][0]; tile[rr * 65 + c4 + 1] = v[i][1]; tile[rr * 65 + c4 + 2] = v[i][2]; tile[rr * 65 + c4 + 3] = v[i][3]; }
    LDS_BARRIER();
    { const int n = tid >> 3, kg = (tid & 7) * 8; float f[8];
#pragma unroll
      for (int jj = 0; jj < 8; ++jj) f[jj] = tile[(kg + jj) * 65 + n] * W8_SCALE;
      u32x2 w; w.x = pk_fp8x4(f[0], f[1], f[2], f[3]); w.y = pk_fp8x4(f[4], f[5], f[6], f[7]);
      *(u32x2*)(t.dst + (size_t)n * t.ldd + kg) = w; }
    LDS_BARRIER();
}
constexpr int MOE_TILES = 3 * NEXP * 256;

__device__ __forceinline__ f32x4 mfma16(s16x4 a, s16x4 b, f32x4 c) { return __builtin_amdgcn_mfma_f32_16x16x16bf16_1k(a, b, c, 0, 0, 0); }
__device__ __forceinline__ s16x4 pack4(const f32x4& v) { u32x2 w; w.x = cvt_pk_bf16(v[0], v[1]); w.y = cvt_pk_bf16(v[2], v[3]); return __builtin_bit_cast(s16x4, w); }
__device__ __forceinline__ void phase_gdn_chunk(const Args& a, LAS unsigned char* lds) {
    const bf16_t* qc = (const bf16_t*)(a.ws + WS_QKVC); const float* bgi = (const float*)(a.ws + WS_BG); bf16_t* O = (bf16_t*)(a.ws + WS_O);
    constexpr int VRS = 144, KTRS = 136;
    constexpr int KT = 0, QS = KT + 128 * KTRS, WSL = QS + 64 * RSB, QKS = WSL + 64 * RSB, EE = QKS + 2048, EDD = EE + 256, SET = EDD + 256;
    constexpr int STL = 2 * SET, KS = STL + 64 * RSB, VS = KS + 64 * RSB, X2 = VS + 64 * VRS, LS = X2 + 2048, X1 = LS + 4096, GAM = X1 + 2048, BET = GAM + 256, LEND = BET + 256;
    static_assert(LEND <= LDS_XBW, "gdn lds");
    const int wid = __builtin_amdgcn_readfirstlane(TIDX >> 6);
    const int NCK = S_ / 64;
    for (int blk = BID; blk < NB_ * 32 * 2; blk += NBLK) {
        const int grp = (blk & 7) * 8 + (blk >> 5), mem = (blk >> 3) & 3, b = grp >> 4, hk = grp & 15, hv = 2 * hk + (mem >> 1), vhalf = mem & 1;
        __syncthreads();
        if (wid < 4) {
            const int vt = wid;
            f32x4 Sacc[8];
#pragma unroll
            for (int n = 0; n < 8; ++n) Sacc[n] = (f32x4){0.f, 0.f, 0.f, 0.f};
            { const int lane = TIDX & 63;
              for (int i = lane; i < 16 * RSB / 16; i += 64) *(LAS u32x4*)(lds + STL + 16 * vt * RSB + i * 16) = (u32x4){0u, 0u, 0u, 0u}; }
            int lz = TIDX & 63; asm volatile("" : "+v"(lz));
            const int lane = lz, I = lane & 15, G = lane >> 4, q4 = I >> 2, p4 = I & 3;
            for (int it = 0; it <= NCK; ++it) {
                const int set = ((it - 1) & 1) * SET; const size_t t0 = (size_t)b * S_ + (size_t)(it - 1) * 64;
                f32x4 U[4];
                if (it >= 1) {
#pragma unroll
                    for (int sa = 0; sa < 4; ++sa) U[sa] = mfma16(*(const LAS s16x4*)(lds + X2 + ((sa * 16 + I) * 16 + 4 * G) * 2), lds_tr4(lds + VS + (16 * sa + 4 * G + q4) * VRS + (16 * vt + 4 * p4) * 2), (f32x4){0.f, 0.f, 0.f, 0.f});
                    asm volatile("" : "+v"(U[0]), "+v"(U[1]), "+v"(U[2]), "+v"(U[3]) :: "memory");
                }
#pragma unroll
                for (int sa = 0; sa < 4; ++sa) {
                    if (it >= 1) {
                        bf16x8 sf[4];
#pragma unroll
                        for (int ks = 0; ks < 4; ++ks) sf[ks] = lds_frag(lds + STL + (16 * vt + I) * RSB + (32 * ks + 8 * G) * 2);
                        s16x4 kt[8];
#pragma unroll
                        for (int dt = 0; dt < 8; ++dt) kt[dt] = *(const LAS s16x4*)(lds + set + KT + (16 * dt + I) * KTRS + (16 * sa + 4 * G) * 2);
                        f32x4 dl = U[sa], oq = (f32x4){0.f, 0.f, 0.f, 0.f};
#pragma unroll
                        for (int ks = 0; ks < 4; ++ks) { dl = mfma32(lds_frag(lds + set + WSL + (16 * sa + I) * RSB + (32 * ks + 8 * G) * 2), sf[ks], dl);
                            oq = mfma32(lds_frag(lds + set + QS + (16 * sa + I) * RSB + (32 * ks + 8 * G) * 2), sf[ks], oq); }
                        const s16x4 dfrag = pack4(dl);
                        const f32x4 e4 = *(const LAS f32x4*)(lds + set + EE + (16 * sa + 4 * G) * 4);
                        oq = mfma16(*(const LAS s16x4*)(lds + set + QKS + ((sa * 16 + I) * 16 + 4 * G) * 2), dfrag, oq * e4);
#pragma unroll
                        for (int r = 0; r < 4; ++r) O[(t0 + 16 * sa + 4 * G + r) * 4096 + hv * 128 + vhalf * 64 + 16 * vt + I] = f2bf(oq[r]);
                        const f32x4 ed4 = *(const LAS f32x4*)(lds + set + EDD + (16 * sa + 4 * G) * 4); const float e15 = *(const LAS float*)(lds + set + EE + (16 * sa + 15) * 4);
                        const s16x4 dsc = pack4(dl * ed4);
#pragma unroll
                        for (int dt = 0; dt < 8; ++dt) {
                            Sacc[dt] = mfma16(kt[dt], dsc, Sacc[dt] * e15);
                            *(LAS s16x4*)(lds + STL + (16 * vt + I) * RSB + (16 * dt + 4 * G) * 2) = pack4(Sacc[dt]); }
                    }
                    LDS_BARRIER();
                }
            }
        } else {
            const int pw = wid - 4;
            u32x4 pq[4], pk[4], pv[2]; float pb = 0.f, pg = 0.f;
            { const int ptid = TIDX - 256; const size_t t0 = (size_t)b * S_;
#pragma unroll
              for (int i = 0; i < 4; ++i) { const int c = ptid + i * 256, s2 = c >> 4, c8 = (c & 15) * 8; pq[i] = *(const u32x4*)(qc + (t0 + s2) * 8192 + hk * 128 + c8); pk[i] = *(const u32x4*)(qc + (t0 + s2) * 8192 + 2048 + hk * 128 + c8); }
#pragma unroll
              for (int i = 0; i < 2; ++i) { const int c = ptid + i * 256, s2 = c >> 3, c8 = (c & 7) * 8; pv[i] = *(const u32x4*)(qc + (t0 + s2) * 8192 + 4096 + hv * 128 + vhalf * 64 + c8); }
              if (pw == 1) { pb = bgi[(t0 + ptid - 64) * 64 + hv]; pg = bgi[(t0 + ptid - 64) * 64 + 32 + hv]; } }
            int lz = TIDX & 63; asm volatile("" : "+v"(lz));
            const int lane = lz, ptid = pw * 64 + lane, I = lane & 15, G = lane >> 4, q4 = I >> 2, p4 = I & 3;
            for (int it = 0; it <= NCK; ++it) {
                const int set = (it & 1) * SET; const bool act = it < NCK;
                if (act) {
#pragma unroll
                    for (int i = 0; i < 4; ++i) { const int c = ptid + i * 256, s2 = c >> 4, c8 = (c & 15) * 8; *(LAS u32x4*)(lds + set + QS + s2 * RSB + c8 * 2) = pq[i]; *(LAS u32x4*)(lds + KS + s2 * RSB + c8 * 2) = pk[i]; }
                    if (pw == 1) { float x = pg;
                        x += __builtin_bit_cast(float, __builtin_amdgcn_update_dpp(0, __builtin_bit_cast(int, x), 0x111, 0xf, 0xf, true));
                        x += __builtin_bit_cast(float, __builtin_amdgcn_update_dpp(0, __builtin_bit_cast(int, x), 0x112, 0xf, 0xf, true));
                        x += __builtin_bit_cast(float, __builtin_amdgcn_update_dpp(0, __builtin_bit_cast(int, x), 0x114, 0xf, 0xf, true));
                        x += __builtin_bit_cast(float, __builtin_amdgcn_update_dpp(0, __builtin_bit_cast(int, x), 0x118, 0xf, 0xf, true));
                        const float g15 = __shfl(x, 15, 16);
                        *(LAS float*)(lds + GAM + lane * 4) = x; *(LAS float*)(lds + set + EE + lane * 4) = __expf(x); *(LAS float*)(lds + set + EDD + lane * 4) = __expf(g15 - x); *(LAS float*)(lds + BET + lane * 4) = pb; }
                }
                LDS_BARRIER();
                if (act) { const int sa = pw;
#pragma unroll
                    for (int i = 0; i < 2; ++i) { const int c = ptid + i * 256, s2 = c >> 3, c8 = (c & 7) * 8; *(LAS u32x4*)(lds + VS + s2 * VRS + c8 * 2) = pv[i]; }
                    if (it + 1 < NCK) { const size_t t1 = (size_t)b * S_ + (size_t)(it + 1) * 64;
#pragma unroll
                        for (int i = 0; i < 4; ++i) { const int c = ptid + i * 256, s2 = c >> 4, c8 = (c & 15) * 8; pq[i] = *(const u32x4*)(qc + (t1 + s2) * 8192 + hk * 128 + c8); pk[i] = *(const u32x4*)(qc + (t1 + s2) * 8192 + 2048 + hk * 128 + c8); }
#pragma unroll
                        for (int i = 0; i < 2; ++i) { const int c = ptid + i * 256, s2 = c >> 3, c8 = (c & 7) * 8; pv[i] = *(const u32x4*)(qc + (t1 + s2) * 8192 + 4096 + hv * 128 + vhalf * 64 + c8); }
                        if (pw == 1) { pb = bgi[(t1 + ptid - 64) * 64 + hv]; pg = bgi[(t1 + ptid - 64) * 64 + 32 + hv]; } }
#pragma unroll
                    for (int ty = 0; ty < 2; ++ty) { f32x4 acc = (f32x4){0.f, 0.f, 0.f, 0.f};
#pragma unroll
                        for (int ks = 0; ks < 4; ++ks) { const bf16x8 ka = lds_frag(lds + KS + (16 * sa + I) * RSB + (32 * ks + 8 * G) * 2);
                            const bf16x8 bo = ty ? lds_frag(lds + set + QS + (16 * sa + I) * RSB + (32 * ks + 8 * G) * 2) : ka; acc = mfma32(ka, bo, acc); }
                        const f32x4 gr = *(const LAS f32x4*)(lds + GAM + (16 * sa + 4 * G) * 4); const float gc = *(const LAS float*)(lds + GAM + (16 * sa + I) * 4);
                        if (ty == 0) { const f32x4 br = *(const LAS f32x4*)(lds + BET + (16 * sa + 4 * G) * 4);
#pragma unroll
                            for (int r = 0; r < 4; ++r) { const float val = br[r] * acc[r] * __expf(gr[r] - gc); *(LAS float*)(lds + LS + ((sa * 16 + 4 * G + r) * 16 + I) * 4) = (I < 4 * G + r) ? val : 0.f; } }
                        else { f32x4 o;
#pragma unroll
                            for (int r = 0; r < 4; ++r) { const float val = acc[r] * __expf(gc - gr[r]); o[r] = (4 * G + r <= I) ? val : 0.f; }
                            *(LAS s16x4*)(lds + set + QKS + ((sa * 16 + I) * 16 + 4 * G) * 2) = pack4(o); } } }
                LDS_BARRIER();
                if (act && pw == 0) { const int sa = G, c = I; float x[16];
#pragma unroll
                    for (int i = 0; i < 16; ++i) x[i] = 0.f;
#pragma unroll
                    for (int ib = 0; ib < 4; ++ib) {
                        f32x4 lv[4][4];
#pragma unroll
                        for (int r = 0; r < 4; ++r)
#pragma unroll
                            for (int jj = 0; jj <= ib; ++jj) lv[r][jj] = *(const LAS f32x4*)(lds + LS + ((sa * 16 + 4 * ib + r) * 16 + 4 * jj) * 4);
                        __builtin_amdgcn_sched_barrier(0);
#pragma unroll
                        for (int r = 0; r < 4; ++r) { const int i = 4 * ib + r; float s0 = (i == c) ? 1.0f : 0.0f, s1 = 0.f;
#pragma unroll
                            for (int jj = 0; jj <= ib; ++jj) { s0 -= lv[r][jj][0] * x[4 * jj] + lv[r][jj][1] * x[4 * jj + 1]; s1 -= lv[r][jj][2] * x[4 * jj + 2] + lv[r][jj][3] * x[4 * jj + 3]; }
                            x[i] = s0 + s1; }
                    }
                    const float bc = *(const LAS float*)(lds + BET + lane * 4), sc1 = -bc * *(const LAS float*)(lds + set + EE + lane * 4);
#pragma unroll
                    for (int i = 0; i < 16; ++i) { *(LAS bf16_t*)(lds + X1 + ((sa * 16 + i) * 16 + c) * 2) = f2bf(x[i] * sc1); *(LAS bf16_t*)(lds + X2 + ((sa * 16 + i) * 16 + c) * 2) = f2bf(x[i] * bc); } }
                LDS_BARRIER();
                if (act) { const int sa = pw;
                    const s16x4 xb = *(const LAS s16x4*)(lds + X1 + ((sa * 16 + I) * 16 + 4 * G) * 2); s16x4 kt[8]; f32x4 w[8];
#pragma unroll
                    for (int dt = 0; dt < 8; ++dt) kt[dt] = lds_tr4(lds + KS + (16 * sa + 4 * G + q4) * RSB + (16 * dt + 4 * p4) * 2);
#pragma unroll
                    for (int dt = 0; dt < 8; ++dt) { w[dt] = mfma16(kt[dt], xb, (f32x4){0.f, 0.f, 0.f, 0.f}); *(LAS s16x4*)(lds + set + KT + (16 * dt + I) * KTRS + (16 * sa + 4 * G) * 2) = kt[dt]; }
#pragma unroll
                    for (int dt = 0; dt < 8; ++dt) *(LAS s16x4*)(lds + set + WSL + (16 * sa + I) * RSB + (16 * dt + 4 * G) * 2) = pack4(w[dt]); }
                LDS_BARRIER();
            }
        }
    }
}

constexpr int N_PHASES = 30;
__global__ void __launch_bounds__(NTHREADS, 2) fwd(Args a0) {
    extern __shared__ __attribute__((aligned(16))) unsigned char smem_raw[];
    LAS unsigned char* lds = (LAS unsigned char*)smem_raw;
    volatile LAS unsigned* xbw = (volatile LAS unsigned*)(lds + LDS_XBW);
    if (TIDX == 0) { xbw[0] = 0u; xbw[1] = 0u; xbw[2] = 0u; xbw[3] = 0u; }
    __syncthreads();
    XcdBarrier bar = xcd_barrier_post((unsigned*)(a0.ws + WS_CTL), xbw);
#ifndef PHMASK
#define PHMASK 0xFFFFFFFFull
#endif
#ifndef DUPMASK
#define DUPMASK 0ull
#endif
#define PH(i, body) do { if (((PHMASK >> (i)) & 1ull) && a0.ph_lo <= (i) && (i) < a0.ph_hi) { __attribute__((address_space(1))) unsigned char* wsp_ = (__attribute__((address_space(1))) unsigned char*)a0.ws; asm volatile("" : "+s"(wsp_)); Args a = a0; a.ws = (unsigned char*)wsp_; const float* xin = a.in[0]; const float* xw = (const float*)(a.ws + WS_X); (void)xin; (void)xw; \
        if ((DUPMASK >> (i)) & 1ull) { body; xcd_barrier(bar); } body; if ((i) + 1 < a0.ph_hi) xcd_barrier(bar); } } while (0)
    PH(0, { phase_prologue(a, lds); __syncthreads(); NORM_PH(0, true)(a, xin, a.in[1], -1); });
    PH(2, phase_gemm_in0(a, lds));
    PH(3, { phase_rg_conv(a); __syncthreads(); phase_hg1(a, lds); });
    PH(4, { phase_rg_gates(a, lds); __syncthreads(); phase_hg2(a); });
    PH(5, { phase_rg_scan(a, lds); __syncthreads(); phase_hg3(a, lds); });
    PH(9, phase_gemm_out<false>(a, lds, D_, a.ws + WS_WOUT0T, xin));
    PH(10, NORM_PH(0, false)(a, nullptr, a.in[2], 0));
    PH(11, phase_gemm_router(a, lds, 0));
    PH(12, phase_route(a, 0));
    PH(13, phase_rowmap(a, lds, 0));
    PH(14, phase_moe_up(a, lds, 0));
    PH(15, phase_moe_down(a, lds, 0));
    PH(16, { NORM_PH(1, false)(a, nullptr, a.in[1] + D_, 0); __syncthreads(); moe_weight_jobs(a, 1, lds); });
    PH(18, { phase_gemm_in1(a, lds); phase_gemm_in1_tail(a, lds); });
    PH(19, phase_gdn_conv(a));
    PH(20, phase_gdn_chunk(a, lds));
    PH(21, phase_gdn_norm(a));
    PH(22, phase_gemm_out<true>(a, lds, 4096, a.ws + WS_WOUT1T, nullptr));
    PH(23, NORM_PH(0, false)(a, nullptr, a.in[2] + D_, 1));
    PH(24, phase_gemm_router(a, lds, 1));
    PH(25, phase_route(a, 1));
    PH(26, phase_rowmap(a, lds, 1));
    PH(27, phase_moe_up(a, lds, 1));
    PH(28, phase_moe_down(a, lds, 1));
    PH(29, NORM_PH(2, false)(a, nullptr, a.in[3], 1));
#undef PH
}

extern "C" void kernel_launch(void* const* d_in, const int* in_sizes, int n_in, void* d_out, int out_size, void* d_ws, size_t ws_size, hipStream_t stream) {
    static int grid = 0;
    if (grid == 0) {
        if (n_in != 28 || ws_size < WS_END) { fprintf(stderr, "kernel_launch: need 28 inputs and %zu bytes of workspace, got %d / %zu\n", (size_t)WS_END, n_in, ws_size); grid = -1; return; }
        int dev = 0, cus = 0, per_cu = 0;
        if (hipGetDevice(&dev) != hipSuccess || hipDeviceGetAttribute(&cus, hipDeviceAttributeMultiprocessorCount, dev) != hipSuccess) { grid = -1; return; }
        if (hipFuncSetAttribute((const void*)fwd, hipFuncAttributeMaxDynamicSharedMemorySize, LDS_BYTES) != hipSuccess) { fprintf(stderr, "kernel_launch: hipFuncSetAttribute failed\n"); grid = -1; return; }
        if (hipOccupancyMaxActiveBlocksPerMultiprocessor(&per_cu, (const void*)fwd, NTHREADS, LDS_BYTES) != hipSuccess || per_cu < 1) { fprintf(stderr, "kernel_launch: occupancy query says %d\n", per_cu); }
        (void)hipGetLastError();
        grid = cus;
    }
    if (grid < 0) return;
    (void)in_sizes; (void)out_size;
    hipMemsetAsync((char*)d_ws + WS_CTL, 0, CTL_BYTES, stream);
    Args a; memset(&a, 0, sizeof(a));
    for (int i = 0; i < 28; ++i) a.in[i] = (const float*)d_in[i];
    a.out = (float*)d_out; a.ws = (unsigned char*)d_ws;
#if N_LAUNCH_MODE == 1
    a.ph_lo = 0; a.ph_hi = N_PHASES;
    hipLaunchKernelGGL(fwd, dim3(grid), dim3(NTHREADS), LDS_BYTES, stream, a);
#if EXTRA_PH >= 0
    a.ph_lo = EXTRA_PH; a.ph_hi = EXTRA_PH + 1;
    hipLaunchKernelGGL(fwd, dim3(grid), dim3(NTHREADS), LDS_BYTES, stream, a);
#endif
#else
    for (int p = 0; p < N_PHASES; ++p) { a.ph_lo = p; a.ph_hi = p + 1; hipLaunchKernelGGL(fwd, dim3(grid), dim3(NTHREADS), LDS_BYTES, stream, a); }
#endif
}
```

```cpp
#include <hip/hip_runtime.h>
#include <stdint.h>
#include <stdio.h>
#include <string.h>

#ifndef EXTRA_PH
#define EXTRA_PH -1
#endif
#ifndef N_LAUNCH_MODE
#define N_LAUNCH_MODE 1
#endif

#define LAS __attribute__((address_space(3)))
typedef unsigned short bf16_t;
typedef short bf16x8 __attribute__((ext_vector_type(8)));
typedef float f32x4 __attribute__((ext_vector_type(4)));
typedef float f32x2 __attribute__((ext_vector_type(2)));
typedef unsigned u32x4 __attribute__((ext_vector_type(4)));
typedef unsigned u32x2 __attribute__((ext_vector_type(2)));

constexpr int T_ = 16384, D_ = 2048, S_ = 4096, NB_ = 4;
constexpr int N_IN0 = 6144, N_IN1 = 12352, N_IN1P = 12544;
constexpr int NEXP = 64, DEXP = 512, MPAD = 49152;
constexpr int NTHREADS = 512;
constexpr int LDS_MAIN = 131072;
constexpr int LDS_BYTES = 163840;
constexpr int LDS_XBW = LDS_BYTES - 16;

constexpr size_t al256(size_t x) { return (x + 255) & ~(size_t)255; }
constexpr size_t WS_CTL = 0;
constexpr size_t CTL_BYTES = 65536;
constexpr size_t CTL_CNT = 16384;
constexpr size_t WS_LB = WS_CTL + CTL_BYTES;
constexpr size_t WS_TINFO = WS_LB + 4096;
constexpr size_t WS_WIN0T = WS_TINFO + 4096;
constexpr size_t WS_WOUT0T = WS_WIN0T + (size_t)N_IN0 * D_ * 2;
constexpr size_t WS_WIN1T = WS_WOUT0T + (size_t)D_ * D_ * 2;
constexpr size_t WS_WOUT1T = WS_WIN1T + (size_t)N_IN1P * D_ * 2;
constexpr size_t WS_WGATES = WS_WOUT1T + (size_t)D_ * 4096 * 2;
constexpr size_t WS_WRT = WS_WGATES + (size_t)8 * 256 * 256 * 2;
constexpr size_t WS_WG = WS_WRT + (size_t)2 * 256 * D_ * 2;
constexpr size_t WS_WU = WS_WG + (size_t)NEXP * DEXP * D_ * 2;
constexpr size_t WS_WD = WS_WU + (size_t)NEXP * DEXP * D_ * 2;
constexpr size_t WS_X = WS_WD + (size_t)NEXP * DEXP * D_ * 2;
constexpr size_t WS_H = WS_X + (size_t)T_ * D_ * 4;
constexpr size_t WS_PROJ = WS_H + (size_t)T_ * D_ * 2;
constexpr size_t PROJ_BYTES = (size_t)T_ * N_IN1P * 2;
constexpr size_t WS_FLOG = WS_PROJ + (size_t)T_ * N_IN0 * 2;
constexpr size_t WS_XC = WS_FLOG + (size_t)T_ * 1024 * 4;
constexpr size_t WS_ACT = WS_PROJ;
constexpr size_t WS_YMOE = WS_ACT + (size_t)MPAD * DEXP * 2;
constexpr size_t WS_R1 = WS_PROJ + PROJ_BYTES;
constexpr size_t WS_A = WS_R1;
constexpr size_t WS_U = WS_R1 + (size_t)T_ * 1024 * 4;
constexpr size_t WS_QKVC = WS_R1;
constexpr size_t WS_Y = WS_R1 + (size_t)T_ * 8192 * 2;
constexpr size_t WS_O = WS_Y + (size_t)T_ * 4096 * 2;
constexpr size_t WS_TAIL = WS_O + (size_t)T_ * 4096 * 4;
constexpr size_t WS_BG = WS_TAIL + (size_t)T_ * 64 * 4;
constexpr size_t WS_LOGITS = WS_BG + (size_t)T_ * 64 * 4;
constexpr size_t WS_EID = WS_LOGITS + (size_t)T_ * 128 * 4;
constexpr size_t WS_SLOT = WS_EID + (size_t)T_ * 2 * 4;
constexpr size_t WS_GATE = WS_SLOT + (size_t)T_ * 2 * 4;
constexpr size_t WS_POSOF = WS_GATE + (size_t)T_ * 2 * 4;
constexpr size_t WS_ROWMAP = WS_POSOF + (size_t)T_ * 2 * 4;
constexpr size_t WS_H8 = WS_ROWMAP + (size_t)MPAD * 4;
constexpr size_t WS_END = WS_H8 + (size_t)T_ * D_;
static_assert(WS_YMOE + (size_t)MPAD * D_ * 2 <= WS_R1, "moe overlay");
static_assert(WS_XC + (size_t)T_ * 1024 * 2 <= WS_R1, "layer0 overlay");

struct Args {
    const float* in[28];
    float* out;
    unsigned char* ws;
    int ph_lo, ph_hi;
};

__device__ __forceinline__ int tidx_() { int t = (int)threadIdx.x; asm volatile("" : "+v"(t)); return t; }
#define TIDX tidx_()
typedef __bf16 bf16x2n __attribute__((ext_vector_type(2)));
__device__ __forceinline__ unsigned cvt_pk_bf16(float lo, float hi) { const f32x2 v = {lo, hi}; return __builtin_bit_cast(unsigned, __builtin_convertvector(v, bf16x2n)); }
__device__ __forceinline__ unsigned pk_fp8x4(float a, float b, float c, float d) { int v = __builtin_amdgcn_cvt_pk_fp8_f32(a, b, 0, false); v = __builtin_amdgcn_cvt_pk_fp8_f32(c, d, v, true); return (unsigned)v; }
constexpr float W8_SCALE = 64.0f, ACT8_SCALE = 8.0f;
__device__ __forceinline__ bf16_t f2bf(float x) { return (bf16_t)(cvt_pk_bf16(x, 0.f) & 0xffffu); }
__device__ __forceinline__ float bf_lo(unsigned w) { return __uint_as_float(w << 16); }
__device__ __forceinline__ float bf_hi(unsigned w) { return __uint_as_float(w & 0xffff0000u); }
__device__ __forceinline__ float bf1(bf16_t v) { return __uint_as_float(((unsigned)v) << 16); }
__device__ __forceinline__ float sigmoidf_(float x) { return __builtin_amdgcn_rcpf(1.0f + __expf(-x)); }
__device__ __forceinline__ float siluf_(float x) { return x * __builtin_amdgcn_rcpf(1.0f + __expf(-x)); }
__device__ __forceinline__ float softplusf_(float x) { return x > 20.f ? x : log1pf(__expf(x)); }
__device__ __forceinline__ float gelu_tanh(float x) { const float u = 0.7978845608028654f * (x + 0.044715f * x * x * x); return x * __builtin_amdgcn_rcpf(1.0f + __expf(-2.0f * u)); }
template <int CTRL> __device__ __forceinline__ float dpp_f(float v) { return __builtin_bit_cast(float, __builtin_amdgcn_update_dpp(0, __builtin_bit_cast(int, v), CTRL, 0xf, 0xf, false)); }
__device__ __forceinline__ float row16_sum(float s) { s += dpp_f<0x140>(s); s += dpp_f<0x141>(s); s += dpp_f<0xB1>(s); s += dpp_f<0x4E>(s); return s; }
__device__ __forceinline__ float wave_sum(float v) { v = row16_sum(v); v += __shfl_xor(v, 16); v += __shfl_xor(v, 32); return v; }

#define LDS_BARRIER() do { asm volatile("s_waitcnt lgkmcnt(0)" ::: "memory"); __builtin_amdgcn_s_barrier(); asm volatile("" ::: "memory"); } while (0)
#define XB_TMO      128
#define XB_XCNT(j)  (256  + 64 * (j))
#define XB_XSUB(j)  (1280 + 64 * (j))
#define XB_XGEN(j)  (2304 + 64 * (j))
#define XB_TOP      3328
#define XB_TOPGEN   3392
#define XCD_BAR_WORDS 3456
#define XB_SPIN_CAP (1u << 18)

__device__ __forceinline__ unsigned xb_ld(unsigned* p)              { return __hip_atomic_load(p, __ATOMIC_RELAXED, __HIP_MEMORY_SCOPE_AGENT); }
__device__ __forceinline__ unsigned xb_add(unsigned* p, unsigned v) { return __hip_atomic_fetch_add(p, v, __ATOMIC_RELAXED, __HIP_MEMORY_SCOPE_AGENT); }
__device__ __forceinline__ unsigned xb_xcc_id() { return (unsigned)__builtin_amdgcn_s_getreg((3 << 11) | 20) & 0xFu; }
#define XB_SPIN(cond, bar) do { unsigned _sp = 0; while (cond) { __builtin_amdgcn_s_sleep(1); \
    if ((++_sp & 255u) == 0u) { if (xb_ld(&(bar)[XB_TMO])) break; if (_sp > XB_SPIN_CAP) { atomicAdd(&(bar)[XB_TMO], 1u); break; } } } } while (0)

struct XcdBarrier { unsigned* bar; unsigned x; volatile LAS unsigned* st; };

__device__ __forceinline__ XcdBarrier xcd_barrier_post(unsigned* bar, volatile LAS unsigned* st) {
    XcdBarrier b; b.bar = bar; b.x = xb_xcc_id(); b.st = st;
    if (TIDX == 0) (void)xb_add(&bar[XB_XCNT(b.x)], 1u);
    return b;
}
__device__ __forceinline__ void xcd_barrier_complete(unsigned* bar, unsigned x, unsigned& nloc, unsigned& nx) {
    const unsigned G = gridDim.x * gridDim.y * gridDim.z;
    unsigned sum, cnt, mine, sp = 0u;
    for (;;) {
        sum = 0u; cnt = 0u; mine = 0u;
#pragma unroll
        for (unsigned j = 0; j < 16; ++j) { const unsigned c = xb_ld(&bar[XB_XCNT(j)]); sum += c; cnt += (c > 0u) ? 1u : 0u; mine = (j == x) ? c : mine; }
        if (sum == G) break;
        __builtin_amdgcn_s_sleep(1);
        if ((++sp & 255u) == 0u) { if (xb_ld(&bar[XB_TMO])) break; if (sp > XB_SPIN_CAP) { atomicAdd(&bar[XB_TMO], 1u); break; } }
    }
    nloc = mine > 0u ? mine : 1u; nx = cnt > 0u ? cnt : 1u;
}
__device__ __forceinline__ void xcd_barrier(const XcdBarrier& b) {
    asm volatile("s_waitcnt vmcnt(0)" ::: "memory");
    __syncthreads();
    if (TIDX == 0) {
        unsigned* bar = b.bar;
        __builtin_amdgcn_s_waitcnt(0);
        unsigned nloc = b.st[0], nx = b.st[1];
        if (nloc == 0u) { xcd_barrier_complete(bar, b.x, nloc, nx); b.st[0] = nloc; b.st[1] = nx; }
        const unsigned old = xb_add(&bar[XB_XSUB(b.x)], 1u);
        const unsigned gen = old / nloc;
        if (old + 1u == (gen + 1u) * nloc) {
            __builtin_amdgcn_fence(__ATOMIC_RELEASE, "agent");
            asm volatile("s_waitcnt vmcnt(0)" ::: "memory");
            const unsigned og = xb_add(&bar[XB_TOP], 1u);
            const unsigned tg = og / nx;
            if (og + 1u == (tg + 1u) * nx) xb_add(&bar[XB_TOPGEN], 1u);
            else XB_SPIN(xb_ld(&bar[XB_TOPGEN]) == tg, bar);
            __builtin_amdgcn_fence(__ATOMIC_ACQUIRE, "agent");
            xb_add(&bar[XB_XGEN(b.x)], 1u);
            asm volatile("s_waitcnt vmcnt(0)" ::: "memory");
        } else {
            XB_SPIN(xb_ld(&bar[XB_XGEN(b.x)]) == gen, bar);
            __builtin_amdgcn_fence(__ATOMIC_ACQUIRE, "agent");
            asm volatile("s_waitcnt vmcnt(0)" ::: "memory");
        }
    }
    __syncthreads();
}

constexpr int BM = 256, BK = 64, HALF = 128, HTB = HALF * BK * 2;
__device__ __forceinline__ int lds_byte(int r, int c) { const int st = (r >> 4) * 2 + (c >> 5), rr = r & 15, cc = c & 31, ob = rr * 64 + cc * 2; return st * 1024 + (ob ^ (((ob >> 9) & 1) << 5)); }
__device__ __forceinline__ void stage_rc(int b, int& R, int& C) { const int st = b / 1024, sb = b % 1024, swz = sb ^ (((sb >> 9) & 1) << 5); R = (st >> 1) * 16 + swz / 64; C = (st & 1) * 32 + (swz % 64) / 2; }
__device__ __forceinline__ int perm32(int rho) { const int n = rho >> 4, i = rho & 15; return 8 * (i >> 2) + 4 * n + (i & 3); }

__device__ __forceinline__ void stage_pos(int tid, int& R0, int& C0) { stage_rc(tid * 16, R0, C0); }
__device__ __forceinline__ int perm_row(int R) { return (R & ~31) + perm32(R & 31); }

#define BID ((int)blockIdx.x)
#define NBLK ((int)gridDim.x)
#define BID_ BID
#define NBLK_ NBLK
typedef f32x4 Acc[2][2][4][2];
struct UnitD { const char* gA; const char* gB; int t0, t1, t2; };

typedef int i32x8 __attribute__((ext_vector_type(8)));
typedef int i32x4 __attribute__((ext_vector_type(4)));
template <bool GATHER, bool FP8, class Src, class Epi>
__device__ __forceinline__ void gemm_stream(LAS unsigned char* lds, const Src& S, const int nt, const Epi& E) {
    const int tid = TIDX, wid = tid >> 6, lane = tid & 63, wr = wid >> 2, wc = wid & 3, fr = lane & 15, fq = lane >> 4;
    const unsigned ldsw = (unsigned)wid * 1024u;
    const int aoff = lds_byte(wr * 64 + fr, fq * 8), boff = lds_byte(wc * 32 + fr, fq * 8);
    const size_t kstep = (size_t)(BK * 2);
#define G_SA(b, h) (((b) * 2 + (h)) * HTB)
#define G_SB(b, h) ((4 + (b) * 2 + (h)) * HTB)
#define G_STAGE(bufoff, gbase, v) do { _Pragma("unroll") for (int _i = 0; _i < 2; ++_i) \
        __builtin_amdgcn_global_load_lds((const unsigned*)((gbase) + (v)[_i]), (LAS unsigned*)(lds + (bufoff) + ldsw + _i * 8192), 16, 0, 0); } while (0)
#define G_LD8(p) __builtin_shufflevector(*(const LAS i32x4*)(p), *(const LAS i32x4*)((p) + 1024), 0, 1, 2, 3, 4, 5, 6, 7)
#define G_LDA(dst, b, h) do { _Pragma("unroll") for (int m = 0; m < 4; ++m) dst[m] = G_LD8(lds + G_SA(b, h) + aoff + m * 2048); } while (0)
#define G_LDB(dst, b, h) do { _Pragma("unroll") for (int n = 0; n < 2; ++n) dst[n] = G_LD8(lds + G_SB(b, h) + boff + n * 2048); } while (0)
#define G_HALF(x, k) __builtin_bit_cast(bf16x8, __builtin_shufflevector((x), (x), 4 * (k), 4 * (k) + 1, 4 * (k) + 2, 4 * (k) + 3))
#define G_MMA(ai, bj, At, Bt) do { __builtin_amdgcn_s_setprio(1); _Pragma("unroll") for (int m = 0; m < 4; ++m) _Pragma("unroll") for (int n = 0; n < 2; ++n) { \
        if (FP8) asm volatile("v_mfma_f32_16x16x128_f8f6f4 %0, %1, %2, %0" : "+v"(acc[ai][bj][m][n]) : "v"(Bt[n]), "v"(At[m]));   \
        else { acc[ai][bj][m][n] = __builtin_amdgcn_mfma_f32_16x16x32_bf16(G_HALF(Bt[n], 0), G_HALF(At[m], 0), acc[ai][bj][m][n], 0, 0, 0); \
               acc[ai][bj][m][n] = __builtin_amdgcn_mfma_f32_16x16x32_bf16(G_HALF(Bt[n], 1), G_HALF(At[m], 1), acc[ai][bj][m][n], 0, 0, 0); } } \
        __builtin_amdgcn_s_setprio(0); } while (0)
#define G_WAIT_V(n) asm volatile("s_waitcnt vmcnt(" #n ")" ::: "memory")
#define G_WAIT_L(n) asm volatile("s_waitcnt lgkmcnt(" #n ")" ::: "memory")
#define G_BAR __builtin_amdgcn_s_barrier()
#define G_SCHED __builtin_amdgcn_sched_barrier(0)
    UnitD cur, nxt; int ui = 0;
    if (!S.next(0, cur)) return;
    unsigned va[2][2], vb[2][2], van[2][2];
    S.vb(vb); S.va(cur, va);
    Acc acc;
#pragma unroll
    for (int a = 0; a < 2; ++a)
#pragma unroll
        for (int b = 0; b < 2; ++b)
#pragma unroll
            for (int m = 0; m < 4; ++m)
#pragma unroll
                for (int n = 0; n < 2; ++n) acc[a][b][m][n] = (f32x4){0.f, 0.f, 0.f, 0.f};
    i32x8 At[4], B0[2], B1[2];
    const char* cA = cur.gA; const char* cB = cur.gB;
    G_WAIT_V(0);
    __syncthreads();
    G_STAGE(G_SB(0, 0), cB, vb[0]); G_STAGE(G_SA(0, 0), cA, va[0]); G_STAGE(G_SB(0, 1), cB, vb[1]); G_STAGE(G_SA(0, 1), cA, va[1]);
    if (wr == 1) G_BAR;
    G_WAIT_V(4); G_BAR;
    G_STAGE(G_SB(1, 0), cB + kstep, vb[0]); G_STAGE(G_SA(1, 0), cA + kstep, va[0]); G_STAGE(G_SB(1, 1), cB + kstep, vb[1]);
    G_WAIT_V(6); G_BAR;
    for (;;) {
        const bool has_next = S.next(ui + 1, nxt);
        const char* nA = has_next ? nxt.gA : cA; const char* nB = has_next ? nxt.gB : cB;
        if (GATHER) { if (has_next) S.va(nxt, van); else { van[0][0] = va[0][0]; van[0][1] = va[0][1]; van[1][0] = va[1][0]; van[1][1] = va[1][1]; } }
#pragma unroll 1
        for (int t = 0; t < nt; t += 2) {
            const bool last = (t == nt - 2);
            const char* a1 = cA + (size_t)(t + 1) * kstep;
            const char* a2 = last ? nA : cA + (size_t)(t + 2) * kstep; const char* b2 = last ? nB : cB + (size_t)(t + 2) * kstep;
            const char* a3 = a2 + kstep; const char* b3 = b2 + kstep;
            unsigned v2[2][2];
#pragma unroll
            for (int hh = 0; hh < 2; ++hh)
#pragma unroll
                for (int i = 0; i < 2; ++i) v2[hh][i] = (GATHER && last) ? van[hh][i] : va[hh][i];
            G_LDB(B0, 0, 0); G_SCHED; G_LDA(At, 0, 0); G_STAGE(G_SA(1, 1), a1, va[1]);
            G_WAIT_L(8); G_BAR; G_WAIT_L(0); G_MMA(0, 0, At, B0); G_BAR; G_SCHED;
            G_LDB(B1, 0, 1); G_STAGE(G_SB(0, 0), b2, vb[0]);
            G_BAR; G_WAIT_L(0); G_MMA(0, 1, At, B1); G_BAR;
            G_LDA(At, 0, 1); G_STAGE(G_SA(0, 0), a2, v2[0]);
            G_BAR; G_WAIT_L(0); G_MMA(1, 0, At, B0); G_BAR; G_SCHED;
            G_STAGE(G_SB(0, 1), b2, vb[1]);
            G_WAIT_V(6); G_BAR; G_MMA(1, 1, At, B1); G_BAR;
            G_LDB(B0, 1, 0); G_SCHED; G_LDA(At, 1, 0); G_STAGE(G_SA(0, 1), a2, v2[1]);
            G_WAIT_L(8); G_BAR; G_WAIT_L(0); G_MMA(0, 0, At, B0); G_BAR; G_SCHED;
            G_LDB(B1, 1, 1); G_STAGE(G_SB(1, 0), b3, vb[0]);
            G_BAR; G_WAIT_L(0); G_MMA(0, 1, At, B1); G_BAR;
            G_LDA(At, 1, 1); G_STAGE(G_SA(1, 0), a3, v2[0]);
            G_BAR; G_WAIT_L(0); G_MMA(1, 0, At, B0); G_BAR; G_SCHED;
            G_STAGE(G_SB(1, 1), b3, vb[1]);
            G_WAIT_V(6); G_BAR; G_MMA(1, 1, At, B1); G_BAR;
        }
        if (FP8) asm volatile("s_nop 15\n\ts_nop 15" ::: "memory");
        { int tz = TIDX; asm volatile("" : "+v"(tz));
          const int wid2 = tz >> 6, lane2 = tz & 63; E(acc, cur, wid2 >> 2, wid2 & 3, lane2 & 15, lane2 >> 4); }
        if (!has_next) break;
#pragma unroll
        for (int a = 0; a < 2; ++a)
#pragma unroll
            for (int b = 0; b < 2; ++b)
#pragma unroll
                for (int m = 0; m < 4; ++m)
#pragma unroll
                    for (int n = 0; n < 2; ++n) acc[a][b][m][n] = (f32x4){0.f, 0.f, 0.f, 0.f};
        cur = nxt; cA = nA; cB = nB; ++ui;
        if (GATHER) { va[0][0] = van[0][0]; va[0][1] = van[0][1]; va[1][0] = van[1][0]; va[1][1] = van[1][1]; }
    }
    G_WAIT_V(0);
    if (wr == 0) G_BAR;
    G_BAR;
#undef G_SA
#undef G_SB
#undef G_STAGE
#undef G_LDA
#undef G_LDB
#undef G_MMA
#undef G_LD8
#undef G_HALF
#undef G_WAIT_V
#undef G_WAIT_L
#undef G_BAR
#undef G_SCHED
}

__device__ __forceinline__ void offs_direct(unsigned (&v)[2][2], int ld, bool perm) {
    int R0, C0; stage_pos(TIDX, R0, C0);
#pragma unroll
    for (int i = 0; i < 2; ++i) { const int R = R0 + 64 * i, Rr = perm ? perm_row(R) : R;
        v[0][i] = (unsigned)(Rr * ld + C0) * 2u; v[1][i] = (unsigned)((Rr + HALF) * ld + C0) * 2u; }
}

struct SrcGrid {
    const char* A; const char* B; size_t astep, bstep; int nM, total, lda, ldb;
    __device__ __forceinline__ bool next(int i, UnitD& u) const { const int id = BID_ + i * NBLK_; if (id >= total) return false; u.t0 = id % nM; u.t1 = id / nM; u.t2 = 0;
        u.gA = A + (size_t)u.t0 * astep; u.gB = B + (size_t)u.t1 * bstep; return true; }
    __device__ __forceinline__ void va(const UnitD&, unsigned (&v)[2][2]) const { offs_direct(v, lda, false); }
    __device__ __forceinline__ void vb(unsigned (&v)[2][2]) const { offs_direct(v, ldb, true); }
};

__device__ __forceinline__ void store_bf16_tile(const Acc& acc, bf16_t* O, int ld, int wr, int wc, int fr, int fq, const float sc = 1.0f) {
#pragma unroll
    for (int ai = 0; ai < 2; ++ai)
#pragma unroll
        for (int m = 0; m < 4; ++m) { bf16_t* rowp = O + (size_t)(ai * HALF + wr * 64 + m * 16 + fr) * ld + wc * 32 + 8 * fq;
#pragma unroll
            for (int bj = 0; bj < 2; ++bj) { const f32x4 v0 = acc[ai][bj][m][0] * sc, v1 = acc[ai][bj][m][1] * sc;
                u32x4 w; w.x = cvt_pk_bf16(v0[0], v0[1]); w.y = cvt_pk_bf16(v0[2], v0[3]); w.z = cvt_pk_bf16(v1[0], v1[1]); w.w = cvt_pk_bf16(v1[2], v1[3]);
                *(u32x4*)(rowp + bj * HALF) = w; } }
}
__device__ __forceinline__ void store_f32_tile(const Acc& acc, float* O, const float* R, int ld, int ncol, int wr, int wc, int fr, int fq, const float sc = 1.0f) {
#pragma unroll
    for (int ai = 0; ai < 2; ++ai)
#pragma unroll
        for (int m = 0; m < 4; ++m) { const size_t ro = (size_t)(ai * HALF + wr * 64 + m * 16 + fr) * ld;
#pragma unroll
            for (int bj = 0; bj < 2; ++bj)
#pragma unroll
                for (int n = 0; n < 2; ++n) { const int c = bj * HALF + wc * 32 + 8 * fq + 4 * n; if (c >= ncol) continue;
                    f32x4 v = acc[ai][bj][m][n] * sc; if (R) v += *(const f32x4*)(R + ro + c); *(f32x4*)(O + ro + c) = v; } }
}
struct EpiProj {
    bf16_t* O; int ld; float* F; int fld, fp0, fp1, ncol; float sc;
    __device__ __forceinline__ void operator()(const Acc& acc, const UnitD& u, int wr, int wc, int fr, int fq) const {
        if (u.t1 >= fp0 && u.t1 < fp1) store_f32_tile(acc, F + (size_t)u.t0 * BM * fld + (u.t1 - fp0) * BM, nullptr, fld, ncol, wr, wc, fr, fq, sc);
        else store_bf16_tile(acc, O + (size_t)u.t0 * BM * ld + u.t1 * BM, ld, wr, wc, fr, fq, sc);
    }
};
struct EpiResid {
    bf16_t* O; const float* Rf; const bf16_t* Rb; float sc;
    __device__ __forceinline__ void operator()(const Acc& acc, const UnitD& u, int wr, int wc, int fr, int fq) const {
        const size_t o = (size_t)u.t0 * BM * D_ + u.t1 * BM;
        if (Rf) {
#pragma unroll
            for (int am = 0; am < 4; ++am) { const int ai = am >> 1; f32x4 r0[2][2], r1[2][2];
#pragma unroll
                for (int mm = 0; mm < 2; ++mm) { const int m = (am & 1) * 2 + mm; const size_t ro = o + (size_t)(ai * HALF + wr * 64 + m * 16 + fr) * D_ + wc * 32 + 8 * fq;
#pragma unroll
                    for (int bj = 0; bj < 2; ++bj) { r0[mm][bj] = *(const f32x4*)(Rf + ro + bj * HALF); r1[mm][bj] = *(const f32x4*)(Rf + ro + bj * HALF + 4); } }
#pragma unroll
                for (int mm = 0; mm < 2; ++mm) { const int m = (am & 1) * 2 + mm; const size_t ro = o + (size_t)(ai * HALF + wr * 64 + m * 16 + fr) * D_ + wc * 32 + 8 * fq;
#pragma unroll
                    for (int bj = 0; bj < 2; ++bj) { const f32x4 v0 = acc[ai][bj][m][0] * sc + r0[mm][bj], v1 = acc[ai][bj][m][1] * sc + r1[mm][bj];
                        u32x4 w; w.x = cvt_pk_bf16(v0[0], v0[1]); w.y = cvt_pk_bf16(v0[2], v0[3]); w.z = cvt_pk_bf16(v1[0], v1[1]); w.w = cvt_pk_bf16(v1[2], v1[3]);
                        *(u32x4*)(O + ro + bj * HALF) = w; } } }
        } else {
#pragma unroll
            for (int ai = 0; ai < 2; ++ai) { u32x4 rr[4][2];
#pragma unroll
                for (int m = 0; m < 4; ++m) { const size_t ro = o + (size_t)(ai * HALF + wr * 64 + m * 16 + fr) * D_ + wc * 32 + 8 * fq;
#pragma unroll
                    for (int bj = 0; bj < 2; ++bj) rr[m][bj] = *(const u32x4*)(Rb + ro + bj * HALF); }
#pragma unroll
                for (int m = 0; m < 4; ++m) { const size_t ro = o + (size_t)(ai * HALF + wr * 64 + m * 16 + fr) * D_ + wc * 32 + 8 * fq;
#pragma unroll
                    for (int bj = 0; bj < 2; ++bj) { f32x4 v0 = acc[ai][bj][m][0] * sc, v1 = acc[ai][bj][m][1] * sc; const u32x4 r = rr[m][bj];
                        v0[0] += bf_lo(r.x); v0[1] += bf_hi(r.x); v0[2] += bf_lo(r.y); v0[3] += bf_hi(r.y); v1[0] += bf_lo(r.z); v1[1] += bf_hi(r.z); v1[2] += bf_lo(r.w); v1[3] += bf_hi(r.w);
                        u32x4 w; w.x = cvt_pk_bf16(v0[0], v0[1]); w.y = cvt_pk_bf16(v0[2], v0[3]); w.z = cvt_pk_bf16(v1[0], v1[1]); w.w = cvt_pk_bf16(v1[2], v1[3]);
                        *(u32x4*)(O + ro + bj * HALF) = w; } } }
        }
    }
};
struct EpiLogits {
    float* O;
    __device__ __forceinline__ void operator()(const Acc& acc, const UnitD& u, int wr, int wc, int fr, int fq) const { store_f32_tile(acc, O + (size_t)u.t0 * BM * 128, nullptr, 128, 128, wr, wc, fr, fq); }
};
struct EpiSwiGLU {
    unsigned char* O;
    __device__ __forceinline__ void operator()(const Acc& acc, const UnitD& u, int wr, int wc, int fr, int fq) const {
        unsigned char* o = O + (size_t)u.t0 * BM * DEXP + u.t1 * 128;
#pragma unroll
        for (int ai = 0; ai < 2; ++ai)
#pragma unroll
            for (int m = 0; m < 4; ++m) { unsigned char* rowp = o + (size_t)(ai * HALF + wr * 64 + m * 16 + fr) * DEXP + wc * 32 + 8 * fq;
                float r[8];
#pragma unroll
                for (int n = 0; n < 2; ++n)
#pragma unroll
                    for (int j = 0; j < 4; ++j) r[n * 4 + j] = (ACT8_SCALE / W8_SCALE) * siluf_(acc[ai][0][m][n][j] * (1.0f / W8_SCALE)) * acc[ai][1][m][n][j];
                u32x2 w; w.x = pk_fp8x4(r[0], r[1], r[2], r[3]); w.y = pk_fp8x4(r[4], r[5], r[6], r[7]);
                *(u32x2*)rowp = w; }
    }
};
struct EpiDown {
    unsigned char* O;
    __device__ __forceinline__ void operator()(const Acc& acc, const UnitD& u, int wr, int wc, int fr, int fq) const {
        unsigned char* o = O + (size_t)u.t0 * BM * D_ + u.t1 * BM; const float sc = 1.0f / (W8_SCALE * ACT8_SCALE);
#pragma unroll
        for (int ai = 0; ai < 2; ++ai)
#pragma unroll
            for (int m = 0; m < 4; ++m) { unsigned char* rowp = o + (size_t)(ai * HALF + wr * 64 + m * 16 + fr) * D_ + wc * 32 + 8 * fq;
#pragma unroll
                for (int bj = 0; bj < 2; ++bj) { const f32x4 v0 = acc[ai][bj][m][0] * sc, v1 = acc[ai][bj][m][1] * sc;
                    u32x2 w; w.x = pk_fp8x4(v0[0], v0[1], v0[2], v0[3]); w.y = pk_fp8x4(v1[0], v1[1], v1[2], v1[3]); *(u32x2*)(rowp + bj * HALF) = w; } }
    }
};
__device__ __forceinline__ unsigned rg_idx(unsigned tok, int c) { return ((((tok >> 12) * 64u + (unsigned)(c >> 4)) * (unsigned)S_ + (tok & (unsigned)(S_ - 1))) << 4) + (unsigned)(c & 15); }
struct EpiRgGates {
    bf16_t* LAo; bf16_t* Uo; const bf16_t* xc;
    const float* ba; const float* bx; const float* lam;
    __device__ __forceinline__ void operator()(const Acc& acc, const UnitD& u, int wr, int wc, int fr, int fq) const {
#pragma unroll
        for (int n = 0; n < 2; ++n) { const int c = u.t1 * 128 + wc * 32 + 8 * fq + 4 * n;
            u32x2 xq[2][4];
#pragma unroll
            for (int ai = 0; ai < 2; ++ai)
#pragma unroll
                for (int m = 0; m < 4; ++m) xq[ai][m] = *(const u32x2*)(xc + ((unsigned)(u.t0 * BM + ai * HALF + wr * 64 + m * 16 + fr) * 1024u + (unsigned)c));
            const f32x4 vba = *(const f32x4*)(ba + c), vbx = *(const f32x4*)(bx + c), vl = *(const f32x4*)(lam + c);
            f32x4 c8; for (int j = 0; j < 4; ++j) c8[j] = -8.0f * softplusf_(-vl[j]);
#pragma unroll
            for (int ai = 0; ai < 2; ++ai)
#pragma unroll
                for (int m = 0; m < 4; ++m) { const unsigned tok = (unsigned)(u.t0 * BM + ai * HALF + wr * 64 + m * 16 + fr);
                    const u32x2 xw = xq[ai][m]; const float xv[4] = {bf_lo(xw.x), bf_hi(xw.x), bf_lo(xw.y), bf_hi(xw.y)};
                    f32x4 lv, uv;
#pragma unroll
                    for (int j = 0; j < 4; ++j) { const float r = sigmoidf_(acc[ai][0][m][n][j] + vba[j]), ig = sigmoidf_(acc[ai][1][m][n][j] + vbx[j]);
                        const float la = c8[j] * r, av = __expf(la); lv[j] = la; uv[j] = __builtin_amdgcn_sqrtf(fmaxf(0.f, 1.0f - av * av)) * ig * xv[j]; }
                    const unsigned o = rg_idx(tok, c);
                    u32x2 w0; w0.x = cvt_pk_bf16(lv[0], lv[1]); w0.y = cvt_pk_bf16(lv[2], lv[3]); *(u32x2*)(LAo + o) = w0;
                    u32x2 w1; w1.x = cvt_pk_bf16(uv[0], uv[1]); w1.y = cvt_pk_bf16(uv[2], uv[3]); *(u32x2*)(Uo + o) = w1; } }
    }
};


__device__ __forceinline__ void transpose_job8(const float* src, unsigned char* dst, int K, int N, int ldd, size_t sb, size_t db, int nbatch, LAS unsigned char* lds) {
    const int tid = TIDX, tk = K / 128, tn = N / 64, per = tk * tn, total = per * nbatch;
    const int rr0 = tid >> 4, c4 = (tid & 15) * 4, n = tid >> 3, kg = (tid & 7) * 16;
    f32x4 va[4], vb[4];
#define T8_LD(v, t) { const int u_ = (t), ub_ = u_ / per, ur_ = u_ % per, uik_ = ur_ / tn, uin_ = ur_ % tn; const float* usp_ = src + (size_t)ub_ * sb + (size_t)(uik_ * 128 + rr0) * N + uin_ * 64 + c4; \
        _Pragma("unroll") for (int i = 0; i < 4; ++i) v[i] = *(const f32x4*)(usp_ + (size_t)(i * 32) * N); }
#define T8_ST(v, t, buf) { const int t_ = (t), b_ = t_ / per, r_ = t_ % per, ik_ = r_ / tn, in_ = r_ % tn; LAS float* tile = (LAS float*)(lds + (buf) * (128 * 65 * 4)); \
        _Pragma("unroll") for (int i = 0; i < 4; ++i) { const int rr = rr0 + i * 32; tile[rr * 65 + c4 + 0] = v[i][0]; tile[rr * 65 + c4 + 1] = v[i][1]; tile[rr * 65 + c4 + 2] = v[i][2]; tile[rr * 65 + c4 + 3] = v[i][3]; } \
        if (t_ + 2 * NBLK < total) T8_LD(v, t_ + 2 * NBLK) \
        LDS_BARRIER(); \
        float f[16]; \
        _Pragma("unroll") for (int j = 0; j < 16; ++j) f[j] = tile[(kg + j) * 65 + n] * W8_SCALE; \
        u32x4 w; w.x = pk_fp8x4(f[0], f[1], f[2], f[3]); w.y = pk_fp8x4(f[4], f[5], f[6], f[7]); w.z = pk_fp8x4(f[8], f[9], f[10], f[11]); w.w = pk_fp8x4(f[12], f[13], f[14], f[15]); \
        *(u32x4*)(dst + (size_t)b_ * db + (size_t)(in_ * 64 + n) * ldd + ik_ * 128 + kg) = w; }
    int t = BID;
    if (t < total) T8_LD(va, t)
    if (t + NBLK < total) T8_LD(vb, t + NBLK)
    for (; t < total; t += 2 * NBLK) {
        T8_ST(va, t, 0)
        if (t + NBLK < total) T8_ST(vb, t + NBLK, 1)
    }
#undef T8_LD
#undef T8_ST
    LDS_BARRIER();
}
__device__ __forceinline__ void transpose_job(const float* src, bf16_t* dst, int K, int N, int ldd, size_t sb, size_t db, int dalt, int nbatch, LAS unsigned char* lds) {
    const int tid = TIDX, tk = K / 64, tn = N / 64, per = tk * tn, total = per * nbatch;
    const int rr0 = tid >> 4, c4 = (tid & 15) * 4, n = tid >> 3, kg = (tid & 7) * 8;
    f32x4 va[2], vb[2];
#define T16_LD(v, t) { const int u_ = (t), ub_ = u_ / per, ur_ = u_ % per, uik_ = ur_ / tn, uin_ = ur_ % tn; const float* usp_ = src + (size_t)ub_ * sb + (size_t)(uik_ * 64 + rr0) * N + uin_ * 64 + c4; \
        _Pragma("unroll") for (int i = 0; i < 2; ++i) v[i] = *(const f32x4*)(usp_ + (size_t)(i * 32) * N); }
#define T16_ST(v, t, buf) { const int t_ = (t), b_ = t_ / per, r_ = t_ % per, ik_ = r_ / tn, in_ = r_ % tn; LAS float* tile = (LAS float*)(lds + (buf) * (64 * 65 * 4)); \
        _Pragma("unroll") for (int i = 0; i < 2; ++i) { const int rr = rr0 + i * 32; tile[rr * 65 + c4 + 0] = v[i][0]; tile[rr * 65 + c4 + 1] = v[i][1]; tile[rr * 65 + c4 + 2] = v[i][2]; tile[rr * 65 + c4 + 3] = v[i][3]; } \
        if (t_ + 2 * NBLK < total) T16_LD(v, t_ + 2 * NBLK) \
        LDS_BARRIER(); \
        float f[8]; \
        _Pragma("unroll") for (int j = 0; j < 8; ++j) f[j] = tile[(kg + j) * 65 + n]; \
        u32x4 w; w.x = cvt_pk_bf16(f[0], f[1]); w.y = cvt_pk_bf16(f[2], f[3]); w.z = cvt_pk_bf16(f[4], f[5]); w.w = cvt_pk_bf16(f[6], f[7]); \
        *(u32x4*)(dst + (size_t)b_ * db + (size_t)(b_ & 1) * dalt + (size_t)(in_ * 64 + n) * ldd + ik_ * 64 + kg) = w; }
    int t = BID;
    if (t < total) T16_LD(va, t)
    if (t + NBLK < total) T16_LD(vb, t + NBLK)
    for (; t < total; t += 2 * NBLK) {
        T16_ST(va, t, 0)
        if (t + NBLK < total) T16_ST(vb, t + NBLK, 1)
    }
#undef T16_LD
#undef T16_ST
    LDS_BARRIER();
}

__device__ __forceinline__ void moe_weight_jobs(const Args& a, int layer, LAS unsigned char* lds) {
    const size_t lo = (size_t)layer * NEXP * D_ * DEXP;
    transpose_job8(a.in[25] + lo, a.ws + WS_WG, D_, DEXP, D_, (size_t)D_ * DEXP, (size_t)DEXP * D_, NEXP, lds);
    transpose_job8(a.in[26] + lo, a.ws + WS_WU, D_, DEXP, D_, (size_t)D_ * DEXP, (size_t)DEXP * D_, NEXP, lds);
    transpose_job8(a.in[27] + lo, a.ws + WS_WD, DEXP, D_, DEXP, (size_t)D_ * DEXP, (size_t)DEXP * D_, NEXP, lds);
}

__device__ __forceinline__ void phase_prologue(const Args& a, LAS unsigned char* lds) {
    const int gtid = BID * NTHREADS + TIDX, gsz = NBLK * NTHREADS;
    for (int i = gtid; i < 1024; i += gsz) { const float l0 = a.in[12][i], l1 = a.in[12][1024 + i], mx = fmaxf(l0, l1), e0 = __expf(l0 - mx), e1 = __expf(l1 - mx);
        ((float*)(a.ws + WS_LB))[i] = e0 / (e0 + e1); }
    for (int it = gtid; it < 2 * 256 * 256; it += gsz) { const int l = it >> 16, n = (it >> 8) & 255, k8 = (it & 255) * 8; float f[8];
#pragma unroll
        for (int j = 0; j < 8; ++j) { const int k = k8 + j; f[j] = n < 8 ? a.in[21][((size_t)l * D_ + k) * 8 + n] : (n < 72 ? a.in[23][((size_t)l * D_ + k) * 64 + (n - 8)] : 0.f); }
        u32x4 w; w.x = cvt_pk_bf16(f[0], f[1]); w.y = cvt_pk_bf16(f[2], f[3]); w.z = cvt_pk_bf16(f[4], f[5]); w.w = cvt_pk_bf16(f[6], f[7]);
        *(u32x4*)((bf16_t*)(a.ws + WS_WRT) + ((size_t)l * 256 + n) * D_ + k8) = w; }
    for (int it = gtid; it < 192 * 128; it += gsz) *(u32x4*)(a.ws + WS_WIN1T + (size_t)N_IN1 * D_ + (size_t)it * 16) = (u32x4){0u, 0u, 0u, 0u};
    transpose_job(a.in[4], (bf16_t*)(a.ws + WS_WIN0T), D_, N_IN0, D_, 0, 0, 0, 1, lds);
    transpose_job(a.in[14], (bf16_t*)(a.ws + WS_WOUT0T), D_, D_, D_, 0, 0, 0, 1, lds);
    transpose_job8(a.in[15], a.ws + WS_WIN1T, D_, N_IN1, D_, 0, 0, 1, lds);
    transpose_job8(a.in[20], a.ws + WS_WOUT1T, 4096, D_, 4096, 0, 0, 1, lds);
    transpose_job(a.in[7], (bf16_t*)(a.ws + WS_WGATES), 128, 128, 128, 128 * 128, 256 * 128, 0, 8, lds);
    transpose_job(a.in[9], (bf16_t*)(a.ws + WS_WGATES) + 128 * 128, 128, 128, 128, 128 * 128, 256 * 128, 0, 8, lds);
    moe_weight_jobs(a, 0, lds);
}

#define NORM_PH(M, F) phase_norm<M, F>
template <int MODE, bool F32>
__device__ __forceinline__ void phase_norm(const Args& a, const float* src, const float* gain, int layer) {
    const int wid = TIDX >> 6, lane = TIDX & 63;
    bf16_t* xw = (bf16_t*)(a.ws + WS_X); bf16_t* hw = (bf16_t*)(a.ws + WS_H);
    const unsigned char* ym = a.ws + WS_YMOE; const int* posof = (const int*)(a.ws + WS_POSOF); const float* gate = (const float*)(a.ws + WS_GATE);
    const int stride = NBLK * 16;
    f32x4 rf[2][8]; u32x2 rb[2][8]; int pp[2][2] = {{0, 0}, {0, 0}}; float pg[2][2] = {{0.f, 0.f}, {0.f, 0.f}};
#define NORM_LD(r) { _Pragma("unroll") for (int u = 0; u < 2; ++u) { _Pragma("unroll") for (int i = 0; i < 8; ++i) { \
            if (F32) rf[u][i] = *(const f32x4*)(src + (size_t)((r) + u) * D_ + (i * 64 + lane) * 4); else rb[u][i] = *(const u32x2*)(xw + (size_t)((r) + u) * D_ + (i * 64 + lane) * 4); } \
            if (MODE >= 1) { pp[u][0] = posof[((r) + u) * 2]; pp[u][1] = posof[((r) + u) * 2 + 1]; pg[u][0] = gate[((r) + u) * 2]; pg[u][1] = gate[((r) + u) * 2 + 1]; } } }
    int row = (BID * 8 + wid) * 2;
    if (row < T_) NORM_LD(row)
    for (; row < T_; row += stride) {
        f32x4 v[2][8]; int p[2][2]; float g[2][2];
#pragma unroll
        for (int u = 0; u < 2; ++u) { p[u][0] = pp[u][0]; p[u][1] = pp[u][1]; g[u][0] = pg[u][0]; g[u][1] = pg[u][1];
#pragma unroll
            for (int i = 0; i < 8; ++i) v[u][i] = F32 ? rf[u][i] : (f32x4){bf_lo(rb[u][i].x), bf_hi(rb[u][i].x), bf_lo(rb[u][i].y), bf_hi(rb[u][i].y)}; }
        if (row + stride < T_) NORM_LD(row + stride)
        if (MODE >= 1) {
            int y[2][8][2];
#pragma unroll
            for (int u = 0; u < 2; ++u) {
#pragma unroll
                for (int i = 0; i < 8; ++i) { const int c = (i * 64 + lane) * 4; y[u][i][0] = *(const int*)(ym + (size_t)p[u][0] * D_ + c); y[u][i][1] = *(const int*)(ym + (size_t)p[u][1] * D_ + c); } }
#pragma unroll
            for (int u = 0; u < 2; ++u) { const float g0 = g[u][0], g1 = g[u][1];
#pragma unroll
                for (int i = 0; i < 8; ++i) { const int y0 = y[u][i][0], y1 = y[u][i][1];
                    const f32x2 a0 = __builtin_amdgcn_cvt_pk_f32_fp8(y0, false), a1 = __builtin_amdgcn_cvt_pk_f32_fp8(y0, true), b0 = __builtin_amdgcn_cvt_pk_f32_fp8(y1, false), b1 = __builtin_amdgcn_cvt_pk_f32_fp8(y1, true);
                    v[u][i][0] += g0 * a0[0] + g1 * b0[0]; v[u][i][1] += g0 * a0[1] + g1 * b0[1]; v[u][i][2] += g0 * a1[0] + g1 * b1[0]; v[u][i][3] += g0 * a1[1] + g1 * b1[1]; }
                if (MODE == 1) {
#pragma unroll
                    for (int i = 0; i < 8; ++i) { u32x2 w; w.x = cvt_pk_bf16(v[u][i][0], v[u][i][1]); w.y = cvt_pk_bf16(v[u][i][2], v[u][i][3]); *(u32x2*)(xw + (size_t)(row + u) * D_ + (i * 64 + lane) * 4) = w; } } }
        }
#pragma unroll
        for (int u = 0; u < 2; ++u) {
            float ss = 0.f;
#pragma unroll
            for (int i = 0; i < 8; ++i) ss += v[u][i][0] * v[u][i][0] + v[u][i][1] * v[u][i][1] + v[u][i][2] * v[u][i][2] + v[u][i][3] * v[u][i][3];
            ss = wave_sum(ss);
            const float rstd = rsqrtf(ss * (1.0f / D_) + 1e-6f);
#pragma unroll
            for (int i = 0; i < 8; ++i) { const int c = (i * 64 + lane) * 4; const f32x4 gn = *(const f32x4*)(gain + c);
                const f32x4 o = v[u][i] * rstd * gn;
                if (MODE == 2) *(f32x4*)(a.out + (size_t)(row + u) * D_ + c) = o;
                else { if (MODE != 1) { u32x2 w; w.x = cvt_pk_bf16(o[0], o[1]); w.y = cvt_pk_bf16(o[2], o[3]); *(u32x2*)(hw + (size_t)(row + u) * D_ + c) = w; }
                       if (layer >= 0) *(unsigned*)(a.ws + WS_H8 + (size_t)(row + u) * D_ + c) = pk_fp8x4(o[0], o[1], o[2], o[3]); } } }
    }
#undef NORM_LD
    (void)layer;
}

__device__ __forceinline__ void phase_gemm_in0(const Args& a, LAS unsigned char* lds) {
    SrcGrid S{(const char*)(a.ws + WS_H), (const char*)(a.ws + WS_WIN0T), (size_t)BM * D_ * 2, (size_t)BM * D_ * 2, 64, 64 * 24, D_, D_};
    EpiProj E{(bf16_t*)(a.ws + WS_PROJ), N_IN0, (float*)(a.ws + WS_FLOG), 1024, 12, 16, 256, 1.0f};
    gemm_stream<false, false>(lds, S, D_ / BK, E);
}

__device__ __forceinline__ void phase_rg_conv(const Args& a) {
    const bf16_t* p0 = (const bf16_t*)(a.ws + WS_PROJ); bf16_t* xc = (bf16_t*)(a.ws + WS_XC);
    const float* cw = a.in[5]; const float* cb = a.in[6];
    for (int it = BID * NTHREADS + TIDX; it < 128 * (T_ / 16); it += NBLK * NTHREADS) { const int c = (it & 127) * 8; const size_t t0 = (size_t)(it >> 7) * 16;
        float w[4][8], bias[8];
#pragma unroll
        for (int k = 0; k < 4; ++k) { const f32x4 w0 = *(const f32x4*)(cw + k * 1024 + c), w1 = *(const f32x4*)(cw + k * 1024 + c + 4);
            w[k][0] = w0[0]; w[k][1] = w0[1]; w[k][2] = w0[2]; w[k][3] = w0[3]; w[k][4] = w1[0]; w[k][5] = w1[1]; w[k][6] = w1[2]; w[k][7] = w1[3]; }
        { const f32x4 b0 = *(const f32x4*)(cb + c), b1 = *(const f32x4*)(cb + c + 4); bias[0] = b0[0]; bias[1] = b0[1]; bias[2] = b0[2]; bias[3] = b0[3]; bias[4] = b1[0]; bias[5] = b1[1]; bias[6] = b1[2]; bias[7] = b1[3]; }
        u32x4 x0 = (u32x4){0u, 0u, 0u, 0u}, x1 = x0, x2 = x0;
        if ((t0 & (S_ - 1)) != 0) { x0 = *(const u32x4*)(p0 + (t0 - 3) * N_IN0 + c); x1 = *(const u32x4*)(p0 + (t0 - 2) * N_IN0 + c); x2 = *(const u32x4*)(p0 + (t0 - 1) * N_IN0 + c); }
        u32x4 xr[16];
#pragma unroll
        for (int r = 0; r < 16; ++r) xr[r] = *(const u32x4*)(p0 + (t0 + r) * N_IN0 + c);
#pragma unroll
        for (int r = 0; r < 16; ++r) { const u32x4 x3 = xr[r];
            float acc[8];
#define TAPS(j, f, m) (bias[j] + w[0][j] * f(x0.m) + w[1][j] * f(x1.m) + w[2][j] * f(x2.m) + w[3][j] * f(x3.m))
            acc[0] = TAPS(0, bf_lo, x); acc[1] = TAPS(1, bf_hi, x); acc[2] = TAPS(2, bf_lo, y); acc[3] = TAPS(3, bf_hi, y);
            acc[4] = TAPS(4, bf_lo, z); acc[5] = TAPS(5, bf_hi, z); acc[6] = TAPS(6, bf_lo, w); acc[7] = TAPS(7, bf_hi, w);
#undef TAPS
            u32x4 o; o.x = cvt_pk_bf16(acc[0], acc[1]); o.y = cvt_pk_bf16(acc[2], acc[3]); o.z = cvt_pk_bf16(acc[4], acc[5]); o.w = cvt_pk_bf16(acc[6], acc[7]);
            *(u32x4*)(xc + (t0 + r) * 1024 + c) = o;
            x0 = x1; x1 = x2; x2 = x3; } }
}

struct SrcRgGates {
    const char* xc; const char* w; int total;
    __device__ __forceinline__ bool next(int i, UnitD& u) const { const int id = BID + i * NBLK; if (id >= total) return false; u.t0 = id & 63; u.t1 = id >> 6; u.t2 = 0;
        u.gA = xc + ((size_t)u.t0 * BM * 1024 + u.t1 * 128) * 2; u.gB = w + (size_t)u.t1 * 256 * 128 * 2; return true; }
    __device__ __forceinline__ void va(const UnitD&, unsigned (&v)[2][2]) const { offs_direct(v, 1024, false); }
    __device__ __forceinline__ void vb(unsigned (&v)[2][2]) const { offs_direct(v, 128, true); }
};
__device__ __forceinline__ void phase_rg_gates(const Args& a, LAS unsigned char* lds) {
    SrcRgGates S{(const char*)(a.ws + WS_XC), (const char*)(a.ws + WS_WGATES), 64 * 8};
    EpiRgGates E{(bf16_t*)(a.ws + WS_A), (bf16_t*)(a.ws + WS_U), (const bf16_t*)(a.ws + WS_XC), a.in[8], a.in[10], a.in[11]};
    int nt = 2; asm volatile("" : "+s"(nt));
    gemm_stream<false, false>(lds, S, nt, E);
}

__device__ __forceinline__ void phase_rg_scan(const Args& a, LAS unsigned char* lds) {
    const bf16_t* LA = (const bf16_t*)(a.ws + WS_A); const bf16_t* U = (const bf16_t*)(a.ws + WS_U);
    const bf16_t* p0 = (const bf16_t*)(a.ws + WS_PROJ); bf16_t* Y = (bf16_t*)(a.ws + WS_Y);
    LAS float* sP = (LAS float*)lds; LAS float* sH = sP + 4096; LAS float* gP = sH + 4096; LAS float* gH = gP + 512; LAS float* gC = gH + 512;
    const int tid = TIDX, seg = tid >> 1, c8 = (tid & 1) * 8;
    for (int blk = BID; blk < NB_ * 64; blk += NBLK) { const int b = blk >> 6, c = (blk & 63) * 16 + c8;
        const size_t base = (((size_t)blk * S_ + seg * 16) << 4) + c8;
        float P[8], H[8];
#pragma unroll
        for (int j = 0; j < 8; ++j) { P[j] = 1.f; H[j] = 0.f; }
#pragma unroll 4
        for (int s = 0; s < 16; ++s) { const u32x4 lw = *(const u32x4*)(LA + base + (size_t)s * 16), uw = *(const u32x4*)(U + base + (size_t)s * 16);
            const float la[8] = {bf_lo(lw.x), bf_hi(lw.x), bf_lo(lw.y), bf_hi(lw.y), bf_lo(lw.z), bf_hi(lw.z), bf_lo(lw.w), bf_hi(lw.w)};
            const float uu[8] = {bf_lo(uw.x), bf_hi(uw.x), bf_lo(uw.y), bf_hi(uw.y), bf_lo(uw.z), bf_hi(uw.z), bf_lo(uw.w), bf_hi(uw.w)};
#pragma unroll
            for (int j = 0; j < 8; ++j) { const float av = __expf(la[j]); H[j] = av * H[j] + uu[j]; P[j] *= av; } }
        __syncthreads();
#pragma unroll
        for (int j = 0; j < 8; ++j) { sP[seg * 16 + c8 + j] = P[j]; sH[seg * 16 + c8 + j] = H[j]; }
        __syncthreads();
        { const int ch = tid & 15, grp = tid >> 4; float p = 1.f, h = 0.f;
#pragma unroll
          for (int q = 0; q < 8; ++q) { const int sgi = grp * 8 + q; h = sP[sgi * 16 + ch] * h + sH[sgi * 16 + ch]; p *= sP[sgi * 16 + ch]; }
          gP[grp * 16 + ch] = p; gH[grp * 16 + ch] = h; }
        __syncthreads();
        if (tid < 16) { float carry = 0.f; for (int g = 0; g < 32; ++g) { gC[g * 16 + tid] = carry; carry = gP[g * 16 + tid] * carry + gH[g * 16 + tid]; } }
        __syncthreads();
        { const int ch = tid & 15, grp = tid >> 4; float h = gC[grp * 16 + ch];
#pragma unroll
          for (int q = 0; q < 8; ++q) { const int sgi = grp * 8 + q; const float pin = sP[sgi * 16 + ch], hin = sH[sgi * 16 + ch]; sH[sgi * 16 + ch] = h; h = pin * h + hin; } }
        __syncthreads();
#pragma unroll
        for (int j = 0; j < 8; ++j) H[j] = sH[seg * 16 + c8 + j];
        {
            u32x4 l_a[4], u_a[4], g_a[4];
#define RS_LD(Lv, Uv, Gv, s0) { _Pragma("unroll") for (int j = 0; j < 4; ++j) { const int s_ = (s0) + j; Lv[j] = *(const u32x4*)(LA + base + (size_t)s_ * 16); Uv[j] = *(const u32x4*)(U + base + (size_t)s_ * 16); \
                Gv[j] = *(const u32x4*)(p0 + ((size_t)b * S_ + seg * 16 + s_) * N_IN0 + 1024 + c); } }
            RS_LD(l_a, u_a, g_a, 0)
#pragma unroll
            for (int s0 = 0; s0 < 16; s0 += 4) { u32x4 l_b[4], u_b[4], g_b[4];
#pragma unroll
                for (int j = 0; j < 4; ++j) { l_b[j] = l_a[j]; u_b[j] = u_a[j]; g_b[j] = g_a[j]; }
                if (s0 + 4 < 16) RS_LD(l_b, u_b, g_b, s0 + 4)
#pragma unroll
                for (int j = 0; j < 4; ++j) { const u32x4 lw = l_a[j], uw = u_a[j], gw = g_a[j]; const size_t t = (size_t)b * S_ + seg * 16 + s0 + j;
                    const float la[8] = {bf_lo(lw.x), bf_hi(lw.x), bf_lo(lw.y), bf_hi(lw.y), bf_lo(lw.z), bf_hi(lw.z), bf_lo(lw.w), bf_hi(lw.w)};
                    const float uu[8] = {bf_lo(uw.x), bf_hi(uw.x), bf_lo(uw.y), bf_hi(uw.y), bf_lo(uw.z), bf_hi(uw.z), bf_lo(uw.w), bf_hi(uw.w)};
                    const float gg[8] = {bf_lo(gw.x), bf_hi(gw.x), bf_lo(gw.y), bf_hi(gw.y), bf_lo(gw.z), bf_hi(gw.z), bf_lo(gw.w), bf_hi(gw.w)};
                    float y[8];
#pragma unroll
                    for (int q = 0; q < 8; ++q) { H[q] = __expf(la[q]) * H[q] + uu[q]; y[q] = H[q] * gelu_tanh(gg[q]); }
                    u32x4 o; o.x = cvt_pk_bf16(y[0], y[1]); o.y = cvt_pk_bf16(y[2], y[3]); o.z = cvt_pk_bf16(y[4], y[5]); o.w = cvt_pk_bf16(y[6], y[7]);
                    *(u32x4*)(Y + t * D_ + c) = o; }
#pragma unroll
                for (int j = 0; j < 4; ++j) { l_a[j] = l_b[j]; u_a[j] = u_b[j]; g_a[j] = g_b[j]; } }
#undef RS_LD
        }
    }
}

typedef short s16x4 __attribute__((ext_vector_type(4)));
__device__ __forceinline__ f32x4 mfma32(bf16x8 a, bf16x8 b, f32x4 c) { return __builtin_amdgcn_mfma_f32_16x16x32_bf16(a, b, c, 0, 0, 0); }
__device__ __forceinline__ bf16x8 lds_frag(LAS const unsigned char* p) { return *(const LAS bf16x8*)p; }
__device__ __forceinline__ s16x4 lds_tr4(LAS const unsigned char* p) { return __builtin_amdgcn_ds_read_tr16_b64_v4i16((LAS s16x4*)p); }
__device__ __forceinline__ bf16x8 lds_tr8(LAS const unsigned char* p, int rowskip_bytes) {
    const s16x4 lo = lds_tr4(p), hi = lds_tr4(p + rowskip_bytes); return __builtin_shufflevector(lo, hi, 0, 1, 2, 3, 4, 5, 6, 7); }
__device__ __forceinline__ bf16x8 pack8(const f32x4& lo, const f32x4& hi) { u32x4 w; w.x = cvt_pk_bf16(lo[0], lo[1]); w.y = cvt_pk_bf16(lo[2], lo[3]); w.z = cvt_pk_bf16(hi[0], hi[1]); w.w = cvt_pk_bf16(hi[2], hi[3]); return __builtin_bit_cast(bf16x8, w); }
constexpr int RSB = 272;

constexpr size_t WS_HQ = WS_O;
constexpr size_t WS_HA = WS_HQ + (size_t)2048 * 64 * 128 * 2;
constexpr size_t WS_HG = WS_HA + (size_t)2048 * 8 * 512 * 2;
constexpr size_t WS_HS = WS_HG + (size_t)2048 * 128 * 128 * 2;
constexpr size_t WS_HD = WS_HS + (size_t)2048 * 128 * 128 * 2;
static_assert(WS_HD + (size_t)2048 * 128 * 4 <= WS_TAIL, "hgrn overlay");

__device__ __forceinline__ void phase_hg1(const Args& a, LAS unsigned char* lds) {
    const bf16_t* p0 = (const bf16_t*)(a.ws + WS_PROJ); const float* flog = (const float*)(a.ws + WS_FLOG); const float* lb = (const float*)(a.ws + WS_LB);
    bf16_t* QG = (bf16_t*)(a.ws + WS_HQ); bf16_t* AG = (bf16_t*)(a.ws + WS_HA); bf16_t* GG = (bf16_t*)(a.ws + WS_HG); float* DG = (float*)(a.ws + WS_HD);
    constexpr int SEG = 0, QT = 4096, KT = QT + 64 * RSB, KH = KT + 64 * RSB, VS = KH + 64 * RSB;
    const int tid = TIDX, wid = tid >> 6, lane = tid & 63, I = lane & 15, G = lane >> 4, k2 = 2 * lane, sg = wid;
    LAS float* seg = (LAS float*)(lds + SEG);
    u32x4 pvv[2]; f32x2 pz[8]; unsigned pqw[8];
#define HG1_LOAD(it_) do { const int bh_ = (it_) >> 6, ck_ = (it_) & 63, h_ = bh_ & 7; const size_t t0_ = (size_t)(bh_ >> 3) * S_ + ck_ * 64; \
        _Pragma("unroll") for (int i = 0; i < 2; ++i) { const int c = tid + i * 512, s_ = c >> 4, v8 = (c & 15) * 8; pvv[i] = *(const u32x4*)(p0 + (t0_ + s_) * N_IN0 + 4096 + h_ * 128 + v8); } \
        _Pragma("unroll") for (int i = 0; i < 8; ++i) { const size_t t_ = t0_ + sg * 8 + i; pz[i] = *(const f32x2*)(flog + t_ * 1024 + h_ * 128 + k2); pqw[i] = *(const unsigned*)(p0 + t_ * N_IN0 + 2048 + h_ * 128 + k2); } } while (0)
    if (BID < 2048) HG1_LOAD(BID);
    for (int item = BID; item < 2048; item += NBLK) { const int bh = item >> 6, h = bh & 7;
        LDS_BARRIER();
#pragma unroll
        for (int i = 0; i < 2; ++i) { const int c = tid + i * 512, s = c >> 4, v8 = (c & 15) * 8; *(LAS u32x4*)(lds + VS + s * RSB + v8 * 2) = pvv[i]; }
        const f32x2 l2 = *(const f32x2*)(lb + h * 128 + k2);
        float f[8][2], cb[8][2]; unsigned qw[8]; float c0 = 0.f, c1 = 0.f;
#pragma unroll
        for (int i = 0; i < 8; ++i) { const f32x2 z = pz[i]; qw[i] = pqw[i];
            f[i][0] = l2[0] + (1.0f - l2[0]) * sigmoidf_(z[0]); f[i][1] = l2[1] + (1.0f - l2[1]) * sigmoidf_(z[1]);
            c0 += __logf(f[i][0]); c1 += __logf(f[i][1]); cb[i][0] = c0; cb[i][1] = c1; }
        *(LAS f32x2*)(seg + sg * 128 + k2) = (f32x2){c0, c1};
        if (item + NBLK < 2048) HG1_LOAD(item + NBLK);
        LDS_BARRIER();
        float off0 = 0.f, off1 = 0.f, tot0 = 0.f, tot1 = 0.f;
#pragma unroll
        for (int s2 = 0; s2 < 8; ++s2) { const f32x2 v = *(const LAS f32x2*)(seg + s2 * 128 + k2); tot0 += v[0]; tot1 += v[1]; if (s2 < sg) { off0 += v[0]; off1 += v[1]; } }
        const float et0 = __expf(tot0), et1 = __expf(tot1);
#pragma unroll
        for (int i = 0; i < 8; ++i) { const int t = sg * 8 + i;
            const float e0 = __expf(cb[i][0] + off0), e1 = __expf(cb[i][1] + off1), r0 = __builtin_amdgcn_rcpf(e0), r1 = __builtin_amdgcn_rcpf(e1), km0 = 1.0f - f[i][0], km1 = 1.0f - f[i][1];
            const unsigned qt = cvt_pk_bf16(siluf_(bf_lo(qw[i])) * e0, siluf_(bf_hi(qw[i])) * e1);
            *(LAS unsigned*)(lds + QT + t * RSB + k2 * 2) = qt; *(unsigned*)(QG + ((size_t)item * 64 + t) * 128 + k2) = qt;
            *(LAS unsigned*)(lds + KT + t * RSB + k2 * 2) = cvt_pk_bf16(km0 * r0, km1 * r1);
            *(LAS unsigned*)(lds + KH + t * RSB + k2 * 2) = cvt_pk_bf16(km0 * r0 * et0, km1 * r1 * et1); }
        if (sg == 0) *(f32x2*)(DG + (size_t)item * 128 + k2) = (f32x2){et0, et1};
        LDS_BARRIER();
        { const int tt = wid & 3, sp = wid >> 2;
          bf16x8 qf[4];
#pragma unroll
          for (int ks = 0; ks < 4; ++ks) qf[ks] = lds_frag(lds + QT + (16 * tt + I) * RSB + (32 * ks + 8 * G) * 2);
          f32x4 acc[2];
#pragma unroll
          for (int hh = 0; hh < 2; ++hh) { const int st = 2 * sp + hh; acc[hh] = (f32x4){0.f, 0.f, 0.f, 0.f};
              if (st <= tt) {
#pragma unroll
                  for (int ks = 0; ks < 4; ++ks) acc[hh] = mfma32(lds_frag(lds + KT + (16 * st + I) * RSB + (32 * ks + 8 * G) * 2), qf[ks], acc[hh]);
#pragma unroll
                  for (int r = 0; r < 4; ++r) if (16 * st + 4 * G + r > 16 * tt + I) acc[hh][r] = 0.f; } }
          *(bf16x8*)(AG + (((size_t)item * 4 + tt) * 2 + sp) * 512 + lane * 8) = pack8(acc[0], acc[1]); }
        { const int kt = wid, q = I >> 2, p = I & 3;
          bf16x8 ka[2];
#pragma unroll
          for (int ks = 0; ks < 2; ++ks) ka[ks] = lds_tr8(lds + KH + (32 * ks + 8 * G + q) * RSB + (16 * kt + 4 * p) * 2, 4 * RSB);
#pragma unroll
          for (int vt = 0; vt < 8; ++vt) { f32x4 acc = (f32x4){0.f, 0.f, 0.f, 0.f};
#pragma unroll
              for (int ks = 0; ks < 2; ++ks) acc = mfma32(ka[ks], lds_tr8(lds + VS + (32 * ks + 8 * G + q) * RSB + (16 * vt + 4 * p) * 2, 4 * RSB), acc);
              u32x2 w; w.x = cvt_pk_bf16(acc[0], acc[1]); w.y = cvt_pk_bf16(acc[2], acc[3]);
              *(u32x2*)(GG + ((size_t)item * 128 + 16 * vt + I) * 128 + 16 * kt + 4 * G) = w; } }
    }
#undef HG1_LOAD
}

__device__ __forceinline__ void phase_hg2(const Args& a) {
    const bf16_t* GG = (const bf16_t*)(a.ws + WS_HG); const float* DG = (const float*)(a.ws + WS_HD); bf16_t* SG = (bf16_t*)(a.ws + WS_HS);
    for (int gid = BID * NTHREADS + TIDX; gid < 32 * 4096; gid += NBLK * NTHREADS) { const int bh = gid >> 12, e = gid & 4095, v = e >> 5, k4 = (e & 31) * 4;
        f32x4 S = (f32x4){0.f, 0.f, 0.f, 0.f};
        const size_t o0 = (((size_t)bh * 64) * 128 + v) * 128 + k4; const float* dg = DG + (size_t)bh * 64 * 128 + k4;
        f32x4 da[8]; u32x2 ga[8];
#pragma unroll
        for (int j = 0; j < 8; ++j) { da[j] = *(const f32x4*)(dg + j * 128); ga[j] = *(const u32x2*)(GG + o0 + (size_t)j * 16384); }
#pragma unroll 1
        for (int n0 = 0; n0 < 64; n0 += 8) { f32x4 db[8]; u32x2 gb[8];
#pragma unroll
            for (int j = 0; j < 8; ++j) { db[j] = da[j]; gb[j] = ga[j]; }
            if (n0 + 8 < 64) {
#pragma unroll
                for (int j = 0; j < 8; ++j) { db[j] = *(const f32x4*)(dg + (n0 + 8 + j) * 128); gb[j] = *(const u32x2*)(GG + o0 + (size_t)(n0 + 8 + j) * 16384); } }
#pragma unroll
            for (int j = 0; j < 8; ++j) { u32x2 w; w.x = cvt_pk_bf16(S[0], S[1]); w.y = cvt_pk_bf16(S[2], S[3]); *(u32x2*)(SG + o0 + (size_t)(n0 + j) * 16384) = w;
                const f32x4 d = da[j]; const u32x2 g = ga[j];
                S[0] = d[0] * S[0] + bf_lo(g.x); S[1] = d[1] * S[1] + bf_hi(g.x); S[2] = d[2] * S[2] + bf_lo(g.y); S[3] = d[3] * S[3] + bf_hi(g.y); }
#pragma unroll
            for (int j = 0; j < 8; ++j) { da[j] = db[j]; ga[j] = gb[j]; } } }
}

__device__ __forceinline__ void phase_hg3(const Args& a, LAS unsigned char* lds) {
    const bf16_t* p0 = (const bf16_t*)(a.ws + WS_PROJ); const bf16_t* QG = (const bf16_t*)(a.ws + WS_HQ); const bf16_t* AG = (const bf16_t*)(a.ws + WS_HA); const bf16_t* SG = (const bf16_t*)(a.ws + WS_HS);
    bf16_t* Y = (bf16_t*)(a.ws + WS_Y); const float* gain = a.in[13];
    constexpr int ST = 0, QT = 128 * RSB, VS = QT + 64 * RSB, PART = VS + 64 * RSB;
    const int tid = TIDX, wid = tid >> 6, lane = tid & 63, I = lane & 15, G = lane >> 4, q = I >> 2, p = I & 3;
    LAS float* part = (LAS float*)(lds + PART);
    const int tt = wid & 3, vh = wid >> 2;
    u32x4 ps[4], pq2[2], pv2[2]; bf16x8 paf[2];
#define HG3_LOAD(it_) do { const int bh_ = (it_) >> 6, ck_ = (it_) & 63; const size_t t0_ = (size_t)(bh_ >> 3) * S_ + ck_ * 64; const int h_ = bh_ & 7; \
        _Pragma("unroll") for (int i = 0; i < 4; ++i) { const int c = tid + i * 512, v = c >> 4, k8 = (c & 15) * 8; ps[i] = *(const u32x4*)(SG + ((size_t)(it_) * 128 + v) * 128 + k8); } \
        _Pragma("unroll") for (int i = 0; i < 2; ++i) { const int c = tid + i * 512, s_ = c >> 4, c8 = (c & 15) * 8; pq2[i] = *(const u32x4*)(QG + ((size_t)(it_) * 64 + s_) * 128 + c8); pv2[i] = *(const u32x4*)(p0 + (t0_ + s_) * N_IN0 + 4096 + h_ * 128 + c8); } \
        _Pragma("unroll") for (int sp = 0; sp < 2; ++sp) paf[sp] = *(const bf16x8*)(AG + (((size_t)(it_) * 4 + tt) * 2 + sp) * 512 + lane * 8); } while (0)
    if (BID < 2048) HG3_LOAD(BID);
    for (int item = BID; item < 2048; item += NBLK) { const int bh = item >> 6, ck = item & 63, b = bh >> 3, h = bh & 7; const size_t t0 = (size_t)b * S_ + ck * 64;
        LDS_BARRIER();
#pragma unroll
        for (int i = 0; i < 4; ++i) { const int c = tid + i * 512, v = c >> 4, k8 = (c & 15) * 8; *(LAS u32x4*)(lds + ST + v * RSB + k8 * 2) = ps[i]; }
#pragma unroll
        for (int i = 0; i < 2; ++i) { const int c = tid + i * 512, s2 = c >> 4, c8 = (c & 15) * 8; *(LAS u32x4*)(lds + QT + s2 * RSB + c8 * 2) = pq2[i]; *(LAS u32x4*)(lds + VS + s2 * RSB + c8 * 2) = pv2[i]; }
        bf16x8 af[2]; af[0] = paf[0]; af[1] = paf[1];
        if (item + NBLK < 2048) HG3_LOAD(item + NBLK);
        u32x2 zwp[4];
#pragma unroll
        for (int vi = 0; vi < 4; ++vi) zwp[vi] = *(const u32x2*)(p0 + (t0 + 16 * tt + I) * N_IN0 + 5120 + h * 128 + 16 * (4 * vh + vi) + 4 * G);
        LDS_BARRIER();
        bf16x8 qf[4];
#pragma unroll
        for (int ks = 0; ks < 4; ++ks) qf[ks] = lds_frag(lds + QT + (16 * tt + I) * RSB + (32 * ks + 8 * G) * 2);
        f32x4 acc[4]; float ss = 0.f;
#pragma unroll
        for (int vi = 0; vi < 4; ++vi) { const int vt = 4 * vh + vi; acc[vi] = (f32x4){0.f, 0.f, 0.f, 0.f};
#pragma unroll
            for (int ks = 0; ks < 4; ++ks) acc[vi] = mfma32(lds_frag(lds + ST + (16 * vt + I) * RSB + (32 * ks + 8 * G) * 2), qf[ks], acc[vi]);
#pragma unroll
            for (int sp = 0; sp < 2; ++sp) acc[vi] = mfma32(lds_tr8(lds + VS + (32 * sp + 4 * G + q) * RSB + (16 * vt + 4 * p) * 2, 16 * RSB), af[sp], acc[vi]);
            ss += acc[vi][0] * acc[vi][0] + acc[vi][1] * acc[vi][1] + acc[vi][2] * acc[vi][2] + acc[vi][3] * acc[vi][3]; }
        ss += __shfl_xor(ss, 16); ss += __shfl_xor(ss, 32);
        if (G == 0) part[wid * 16 + I] = ss;
        LDS_BARRIER();
        const float rstd = rsqrtf((part[wid * 16 + I] + part[(wid ^ 4) * 16 + I]) * (1.0f / 128.0f) + 1e-6f);
        const size_t t = t0 + 16 * tt + I;
#pragma unroll
        for (int vi = 0; vi < 4; ++vi) { const int c = h * 128 + 16 * (4 * vh + vi) + 4 * G;
            const f32x4 gn = *(const f32x4*)(gain + c); const u32x2 zw = zwp[vi];
            const float o0 = acc[vi][0] * rstd * gn[0] * siluf_(bf_lo(zw.x)), o1 = acc[vi][1] * rstd * gn[1] * siluf_(bf_hi(zw.x)), o2 = acc[vi][2] * rstd * gn[2] * siluf_(bf_lo(zw.y)), o3 = acc[vi][3] * rstd * gn[3] * siluf_(bf_hi(zw.y));
            u32x2 w; w.x = cvt_pk_bf16(o0, o1); w.y = cvt_pk_bf16(o2, o3); *(u32x2*)(Y + t * D_ + 1024 + c) = w; }
    }
#undef HG3_LOAD
}

__device__ __forceinline__ void phase_gdn_norm(const Args& a) {
    const bf16_t* O = (const bf16_t*)(a.ws + WS_O); const bf16_t* pj = (const bf16_t*)(a.ws + WS_PROJ); unsigned char* Y = a.ws + WS_Y; const float* gain = a.in[19];
    const int lane = TIDX & 63, wid = TIDX >> 6, gc = (lane & 15) * 8;
    const f32x4 g0 = *(const f32x4*)(gain + gc), g1 = *(const f32x4*)(gain + gc + 4);
    u32x4 oa[8], za[8];
    int row = BID * 8 + wid; const int stride = NBLK * 8;
#define GN_LD(ov, zv, r) { _Pragma("unroll") for (int i = 0; i < 8; ++i) { const int c = (i * 64 + lane) * 8; ov[i] = *(const u32x4*)(O + (size_t)(r) * 4096 + c); zv[i] = *(const u32x4*)(pj + (size_t)(r) * N_IN1P + 8192 + c); } }
    if (row < T_) GN_LD(oa, za, row)
    for (; row < T_; row += stride) { u32x4 ob[8], zb[8];
#pragma unroll
        for (int i = 0; i < 8; ++i) { ob[i] = oa[i]; zb[i] = za[i]; }
        if (row + stride < T_) GN_LD(ob, zb, row + stride)
#pragma unroll
        for (int i = 0; i < 8; ++i) { const int c = (i * 64 + lane) * 8;
            const u32x4 ow = oa[i], zw = za[i];
            const float o[8] = {bf_lo(ow.x), bf_hi(ow.x), bf_lo(ow.y), bf_hi(ow.y), bf_lo(ow.z), bf_hi(ow.z), bf_lo(ow.w), bf_hi(ow.w)};
            const float z[8] = {bf_lo(zw.x), bf_hi(zw.x), bf_lo(zw.y), bf_hi(zw.y), bf_lo(zw.z), bf_hi(zw.z), bf_lo(zw.w), bf_hi(zw.w)};
            float ss = 0.f;
#pragma unroll
            for (int q = 0; q < 8; ++q) ss += o[q] * o[q];
            ss = row16_sum(ss);
            const float rstd = rsqrtf(ss * (1.0f / 128.0f) + 1e-6f);
            float y[8];
#pragma unroll
            for (int q = 0; q < 8; ++q) y[q] = o[q] * rstd * (q < 4 ? g0[q & 3] : g1[q & 3]) * siluf_(z[q]);
            u32x2 w; w.x = pk_fp8x4(y[0], y[1], y[2], y[3]); w.y = pk_fp8x4(y[4], y[5], y[6], y[7]);
            *(u32x2*)(Y + (size_t)row * 4096 + c) = w; }
#pragma unroll
        for (int i = 0; i < 8; ++i) { oa[i] = ob[i]; za[i] = zb[i]; }
    }
#undef GN_LD
}

template <bool FP8>
__device__ __forceinline__ void phase_gemm_out(const Args& a, LAS unsigned char* lds, int K, const void* w, const float* xin) {
    const int eb = FP8 ? 1 : 2;
    SrcGrid S{(const char*)(a.ws + WS_Y), (const char*)w, (size_t)BM * K * eb, (size_t)BM * K * eb, 64, 64 * 8, K * eb / 2, K * eb / 2};
    EpiResid E{(bf16_t*)(a.ws + WS_X), xin, (const bf16_t*)(a.ws + WS_X), FP8 ? 1.0f / W8_SCALE : 1.0f};
    gemm_stream<false, FP8>(lds, S, K * eb / 128, E);
}

struct SrcRouter {
    const char* h; const char* w;
    __device__ __forceinline__ bool next(int i, UnitD& u) const { const int id = BID + i * NBLK; if (id >= 256) return false; u.t0 = id & 63; u.t1 = id >> 6; u.t2 = 0;
        u.gA = h + ((size_t)u.t0 * BM * D_ + u.t1 * 512) * 2; u.gB = w + (size_t)u.t1 * 512 * 2; return true; }
    __device__ __forceinline__ void va(const UnitD&, unsigned (&v)[2][2]) const { offs_direct(v, D_, false); }
    __device__ __forceinline__ void vb(unsigned (&v)[2][2]) const { offs_direct(v, D_, true); }
};
struct EpiLogitsQ {
    float* O;
    __device__ __forceinline__ void operator()(const Acc& acc, const UnitD& u, int wr, int wc, int fr, int fq) const { store_f32_tile(acc, O + ((size_t)u.t1 * T_ + (size_t)u.t0 * BM) * 128, nullptr, 128, 128, wr, wc, fr, fq); }
};
__device__ __forceinline__ void phase_gemm_router(const Args& a, LAS unsigned char* lds, int layer) {
    SrcRouter S{(const char*)(a.ws + WS_H), (const char*)(a.ws + WS_WRT) + (size_t)layer * 256 * D_ * 2};
    EpiLogitsQ E{(float*)(a.ws + WS_O)};
    gemm_stream<false, false>(lds, S, 512 / BK, E);
}

__device__ __forceinline__ void phase_route(const Args& a, int layer) {
    const float* lg = (const float*)(a.ws + WS_O); const float* bg = a.in[22] + layer * 8; const float* be = a.in[24] + layer * 64;
    int* cnt = (int*)(a.ws + WS_CTL + CTL_CNT) + layer * 64;
    int* eid = (int*)(a.ws + WS_EID); int* slot = (int*)(a.ws + WS_SLOT); float* gate = (float*)(a.ws + WS_GATE); int* rowmap = (int*)(a.ws + WS_ROWMAP);
    const int gtid = BID * NTHREADS + TIDX, gsz = NBLK * NTHREADS;
    for (int i = gtid; i < MPAD; i += gsz) rowmap[i] = 0;
    for (int t = gtid; t < T_; t += gsz) {
        f32x4 ga = (f32x4){0.f, 0.f, 0.f, 0.f}, gb = ga;
#pragma unroll
        for (int kq = 0; kq < 4; ++kq) { ga += *(const f32x4*)(lg + ((size_t)kq * T_ + t) * 128); gb += *(const f32x4*)(lg + ((size_t)kq * T_ + t) * 128 + 4); }
        const float gl[8] = {ga[0] + bg[0], ga[1] + bg[1], ga[2] + bg[2], ga[3] + bg[3], gb[0] + bg[4], gb[1] + bg[5], gb[2] + bg[6], gb[3] + bg[7]};
        float mx = -3.0e38f; int gi = 0;
#pragma unroll
        for (int j = 0; j < 8; ++j) if (gl[j] > mx) { mx = gl[j]; gi = j; }
        float se = 0.f;
#pragma unroll
        for (int j = 0; j < 8; ++j) se += __expf(gl[j] - mx);
        const float gp = 1.0f / se;
        f32x4 ea = *(const f32x4*)(be + gi * 8), eb = *(const f32x4*)(be + gi * 8 + 4);
#pragma unroll
        for (int kq = 0; kq < 4; ++kq) { ea += *(const f32x4*)(lg + ((size_t)kq * T_ + t) * 128 + 8 + gi * 8); eb += *(const f32x4*)(lg + ((size_t)kq * T_ + t) * 128 + 12 + gi * 8); }
        const float el[8] = {ea[0], ea[1], ea[2], ea[3], eb[0], eb[1], eb[2], eb[3]};
        float l1 = -3.0e38f, l2 = -3.0e38f; int i1 = 0, i2 = 0;
#pragma unroll
        for (int j = 0; j < 8; ++j) { const float v = el[j];
            if (v > l1) { l2 = l1; i2 = i1; l1 = v; i1 = j; } else if (v > l2) { l2 = v; i2 = j; } }
        const float e2 = __expf(l2 - l1), inv = 1.0f / (1.0f + e2);
        const int e0 = gi * 8 + i1, e1 = gi * 8 + i2;
        eid[t * 2] = e0; eid[t * 2 + 1] = e1; gate[t * 2] = inv * gp; gate[t * 2 + 1] = e2 * inv * gp;
        slot[t * 2] = atomicAdd(&cnt[e0], 1); slot[t * 2 + 1] = atomicAdd(&cnt[e1], 1); }
}

__device__ __forceinline__ void phase_rowmap(const Args& a, LAS unsigned char* lds, int layer) {
    const int* cnt = (const int*)(a.ws + WS_CTL + CTL_CNT) + layer * 64; LAS int* ps = (LAS int*)lds;
    int* tinfo = (int*)(a.ws + WS_TINFO) + layer * 512;
    const int* eid = (const int*)(a.ws + WS_EID); const int* slot = (const int*)(a.ws + WS_SLOT); int* posof = (int*)(a.ws + WS_POSOF); int* rowmap = (int*)(a.ws + WS_ROWMAP);
    __syncthreads();
    if (TIDX == 0) { int acc = 0; for (int e = 0; e < 64; ++e) { ps[e] = acc; acc += (cnt[e] + 255) & ~255; } ps[64] = acc; }
    __syncthreads();
    if (BID == 0) { if (TIDX <= 64) tinfo[TIDX] = ps[TIDX]; if (TIDX == 65) tinfo[65] = ps[64] >> 8;
        if (TIDX < 192) { const int p = TIDX * 256; int e = 0; for (int j = 0; j < 64; ++j) if (ps[j + 1] <= p) e = j + 1; tinfo[128 + TIDX] = e < 64 ? e : 63; } }
    for (int i = BID * NTHREADS + TIDX; i < T_ * 2; i += NBLK * NTHREADS) { const int p = ps[eid[i]] + slot[i]; posof[i] = p; rowmap[p] = i >> 1; }
    __syncthreads();
}

struct SrcMoeUp {
    const char* h; const char* wg; const int* tinfo; const int* rowmap; int total;
    __device__ __forceinline__ bool next(int i, UnitD& u) const { const int id = BID + i * NBLK; if (id >= total) return false; u.t0 = id >> 2; u.t1 = id & 3;
        u.t2 = __builtin_amdgcn_readfirstlane(tinfo[128 + u.t0]); u.gA = h; u.gB = wg + ((size_t)u.t2 * DEXP + u.t1 * 128) * D_; return true; }
    __device__ __forceinline__ void va(const UnitD& u, unsigned (&v)[2][2]) const { int R0, C0; stage_pos(TIDX, R0, C0);
#pragma unroll
        for (int hh = 0; hh < 2; ++hh)
#pragma unroll
            for (int i = 0; i < 2; ++i) v[hh][i] = (unsigned)(rowmap[u.t0 * 256 + hh * 128 + R0 + 64 * i] * D_ + C0 * 2); }
    __device__ __forceinline__ void vb(unsigned (&v)[2][2]) const { int R0, C0; stage_pos(TIDX, R0, C0);
#pragma unroll
        for (int i = 0; i < 2; ++i) { const int Rr = perm_row(R0 + 64 * i); v[0][i] = (unsigned)(Rr * D_ + C0 * 2); v[1][i] = (unsigned)(WS_WU - WS_WG) + (unsigned)(Rr * D_ + C0 * 2); } }
};
__device__ __forceinline__ void phase_moe_up(const Args& a, LAS unsigned char* lds, int layer) {
    const int* tinfo = (const int*)(a.ws + WS_TINFO) + layer * 512;
    const int ntm = __builtin_amdgcn_readfirstlane(tinfo[65]);
    SrcMoeUp S{(const char*)(a.ws + WS_H8), (const char*)(a.ws + WS_WG), tinfo, (const int*)(a.ws + WS_ROWMAP), ntm * 4};
    EpiSwiGLU E{a.ws + WS_ACT};
    gemm_stream<true, true>(lds, S, D_ / 128, E);
}

struct SrcMoeDown {
    const char* act; const char* wd; const int* tinfo; int total;
    __device__ __forceinline__ bool next(int i, UnitD& u) const { const int id = BID + i * NBLK; if (id >= total) return false; u.t0 = id >> 3; u.t1 = id & 7;
        u.t2 = __builtin_amdgcn_readfirstlane(tinfo[128 + u.t0]); u.gA = act + (size_t)u.t0 * BM * DEXP; u.gB = wd + ((size_t)u.t2 * D_ + u.t1 * BM) * DEXP; return true; }
    __device__ __forceinline__ void va(const UnitD&, unsigned (&v)[2][2]) const { offs_direct(v, DEXP / 2, false); }
    __device__ __forceinline__ void vb(unsigned (&v)[2][2]) const { offs_direct(v, DEXP / 2, true); }
};
__device__ __forceinline__ void phase_moe_down(const Args& a, LAS unsigned char* lds, int layer) {
    const int* tinfo = (const int*)(a.ws + WS_TINFO) + layer * 512; const int ntm = __builtin_amdgcn_readfirstlane(tinfo[65]);
    SrcMoeDown S{(const char*)(a.ws + WS_ACT), (const char*)(a.ws + WS_WD), tinfo, ntm * 8};
    EpiDown E{a.ws + WS_YMOE};
    gemm_stream<false, true>(lds, S, DEXP / 128, E);
}

struct SrcIn1Tail {
    const char* h; const char* w;
    __device__ __forceinline__ bool next(int i, UnitD& u) const { const int id = BID + i * NBLK; if (id >= 256) return false; u.t0 = id & 63; u.t1 = id >> 6; u.t2 = 0;
        u.gA = h + (size_t)u.t0 * BM * D_ + u.t1 * 512; u.gB = w + (size_t)48 * BM * D_ + u.t1 * 512; return true; }
    __device__ __forceinline__ void va(const UnitD&, unsigned (&v)[2][2]) const { offs_direct(v, D_ / 2, false); }
    __device__ __forceinline__ void vb(unsigned (&v)[2][2]) const { offs_direct(v, D_ / 2, true); }
};
struct EpiTailQ {
    float* O;
    __device__ __forceinline__ void operator()(const Acc& acc, const UnitD& u, int wr, int wc, int fr, int fq) const { store_f32_tile(acc, O + ((size_t)u.t1 * T_ + (size_t)u.t0 * BM) * 64, nullptr, 64, 64, wr, wc, fr, fq, 1.0f / W8_SCALE); }
};
__device__ __forceinline__ void phase_gemm_in1(const Args& a, LAS unsigned char* lds) {
    SrcGrid S{(const char*)(a.ws + WS_H8), (const char*)(a.ws + WS_WIN1T), (size_t)BM * D_, (size_t)BM * D_, 64, 64 * 48, D_ / 2, D_ / 2};
    EpiProj E{(bf16_t*)(a.ws + WS_PROJ), N_IN1P, nullptr, 64, 48, 48, 64, 1.0f / W8_SCALE};
    gemm_stream<false, true>(lds, S, D_ / 128, E);
}
__device__ __forceinline__ void phase_gemm_in1_tail(const Args& a, LAS unsigned char* lds) {
    SrcIn1Tail S{(const char*)(a.ws + WS_H8), (const char*)(a.ws + WS_WIN1T)};
    EpiTailQ E{(float*)(a.ws + WS_O)};
    int nt = 4; asm volatile("" : "+s"(nt));
    gemm_stream<false, true>(lds, S, nt, E);
}

__device__ __forceinline__ void phase_gdn_conv(const Args& a) {
    const bf16_t* p1 = (const bf16_t*)(a.ws + WS_PROJ); bf16_t* qc = (bf16_t*)(a.ws + WS_QKVC); const float* cw = a.in[16];
    const int gtid = BID * NTHREADS + TIDX, gsz = NBLK * NTHREADS;
    for (int it = gtid; it < 1024 * (T_ / 128); it += gsz) { const int c = (it & 1023) * 8, seg = it >> 10; const size_t t0 = (size_t)seg * 128;
        float w[4][8];
#pragma unroll
        for (int k = 0; k < 4; ++k) { const f32x4 w0 = *(const f32x4*)(cw + k * 8192 + c), w1 = *(const f32x4*)(cw + k * 8192 + c + 4);
            w[k][0] = w0[0]; w[k][1] = w0[1]; w[k][2] = w0[2]; w[k][3] = w0[3]; w[k][4] = w1[0]; w[k][5] = w1[1]; w[k][6] = w1[2]; w[k][7] = w1[3]; }
        u32x4 x0 = (u32x4){0u, 0u, 0u, 0u}, x1 = x0, x2 = x0;
        if ((t0 & (S_ - 1)) != 0) { x0 = *(const u32x4*)(p1 + (t0 - 3) * N_IN1P + c); x1 = *(const u32x4*)(p1 + (t0 - 2) * N_IN1P + c); x2 = *(const u32x4*)(p1 + (t0 - 1) * N_IN1P + c); }
        const float qsc = c < 2048 ? 0.08838834764831845f : 1.0f;
        u32x4 xa[8];
#pragma unroll
        for (int j = 0; j < 8; ++j) xa[j] = *(const u32x4*)(p1 + (t0 + j) * N_IN1P + c);
#pragma unroll 1
        for (int r0 = 0; r0 < 128; r0 += 8) { u32x4 xb[8];
#pragma unroll
            for (int j = 0; j < 8; ++j) xb[j] = xa[j];
            if (r0 + 8 < 128) {
#pragma unroll
                for (int j = 0; j < 8; ++j) xb[j] = *(const u32x4*)(p1 + (t0 + r0 + 8 + j) * N_IN1P + c); }
#pragma unroll
          for (int j8 = 0; j8 < 8; ++j8) { const u32x4 x3 = xa[j8]; const int r = r0 + j8;
            float acc[8];
#define TAPS(j, f, m) (w[0][j] * f(x0.m) + w[1][j] * f(x1.m) + w[2][j] * f(x2.m) + w[3][j] * f(x3.m))
            acc[0] = TAPS(0, bf_lo, x); acc[1] = TAPS(1, bf_hi, x); acc[2] = TAPS(2, bf_lo, y); acc[3] = TAPS(3, bf_hi, y);
            acc[4] = TAPS(4, bf_lo, z); acc[5] = TAPS(5, bf_hi, z); acc[6] = TAPS(6, bf_lo, w); acc[7] = TAPS(7, bf_hi, w);
#undef TAPS
            float ss = 0.f;
#pragma unroll
            for (int j = 0; j < 8; ++j) { acc[j] = siluf_(acc[j]); ss += acc[j] * acc[j]; }
            ss = row16_sum(ss);
            const float sc = c < 4096 ? rsqrtf(ss + 1e-6f) * qsc : 1.0f;
            u32x4 o; o.x = cvt_pk_bf16(acc[0] * sc, acc[1] * sc); o.y = cvt_pk_bf16(acc[2] * sc, acc[3] * sc); o.z = cvt_pk_bf16(acc[4] * sc, acc[5] * sc); o.w = cvt_pk_bf16(acc[6] * sc, acc[7] * sc);
            *(u32x4*)(qc + (t0 + r) * 8192 + c) = o;
            x0 = x1; x1 = x2; x2 = x3; }
#pragma unroll
            for (int j = 0; j < 8; ++j) xa[j] = xb[j]; } }
    const float* tail = (const float*)(a.ws + WS_O); float* bgo = (float*)(a.ws + WS_BG);
    for (int it = gtid; it < T_ * 32; it += gsz) { const int t = it >> 5, hv = it & 31; float tb = 0.f, ta = 0.f;
#pragma unroll
        for (int kq = 0; kq < 4; ++kq) { tb += tail[((size_t)kq * T_ + t) * 64 + hv]; ta += tail[((size_t)kq * T_ + t) * 64 + 32 + hv]; }
        bgo[t * 64 + hv] = sigmoidf_(tb);
        bgo[t * 64 + 32 + hv] = -__expf(a.in[17][hv]) * softplusf_(ta + a.in[18][hv]); }
}

struct MoeTile { const float* src; unsigned char* dst; int lds_, ldd; };
__device__ __forceinline__ MoeTile moe_tile(const Args& a, int g) {
    const int job = g >> 14, r = g & 16383, e = r >> 8, rr = r & 255; MoeTile t;
    typedef __attribute__((address_space(1))) const float* gcf; gcf s25 = (gcf)a.in[25], s26 = (gcf)a.in[26]; asm volatile("" : "+s"(s25), "+s"(s26));
    if (job < 2) { const int ik = rr >> 3, in = rr & 7; t.lds_ = DEXP; t.ldd = D_;
        t.src = (const float*)(job ? s26 : s25) + ((size_t)(NEXP + e) * D_ + ik * 64) * DEXP + in * 64; t.dst = a.ws + (job ? WS_WU : WS_WG) + ((size_t)e * DEXP + in * 64) * D_ + ik * 64; }
    else { const int ik = rr >> 5, in = rr & 31; t.lds_ = D_; t.ldd = DEXP;
        t.src = a.in[27] + ((size_t)(NEXP + e) * DEXP + ik * 64) * D_ + in * 64; t.dst = a.ws + WS_WD + ((size_t)e * D_ + in * 64) * DEXP + ik * 64; }
    return t;
}
__device__ __forceinline__ void moe_tile_load(const MoeTile& t, int tid, f32x4 (&v)[2]) {
#pragma unroll
    for (int i = 0; i < 2; ++i) { const int idx = tid + i * 512, rr = idx >> 4, c4 = (idx & 15) * 4; v[i] = *(const f32x4*)(t.src + (size_t)rr * t.lds_ + c4); }
}
__device__ __forceinline__ void moe_tile_store(const MoeTile& t, int tid, const f32x4 (&v)[2], LAS float* tile) {
#pragma unroll
    for (int i = 0; i < 2; ++i) { const int idx = tid + i * 512, rr = idx >> 4, c4 = (idx & 15) * 4;
        tile[rr * 65 + c4 + 0] = v[i][0]; tile[rr * 65 + c4 + 1] = v[i][1]; tile[rr * 65 + c4 + 2] = v[i][2]; tile[rr * 65 + c4 + 3] = v[i][3]; }
    LDS_BARRIER();
    { const int n = tid >> 3, kg = (tid & 7) * 8; float f[8];
#pragma unroll
      for (int jj = 0; jj < 8; ++jj) f[jj] = tile[(kg + jj) * 65 + n] * W8_SCALE;
      u32x2 w; w.x = pk_fp8x4(f[0], f[1], f[2], f[3]); w.y = pk_fp8x4(f[4], f[5], f[6], f[7]);
      *(u32x2*)(t.dst + (size_t)n * t.ldd + kg) = w; }
    LDS_BARRIER();
}
constexpr int MOE_TILES = 3 * NEXP * 256;

__device__ __forceinline__ f32x4 mfma16(s16x4 a, s16x4 b, f32x4 c) { return __builtin_amdgcn_mfma_f32_16x16x16bf16_1k(a, b, c, 0, 0, 0); }
__device__ __forceinline__ s16x4 pack4(const f32x4& v) { u32x2 w; w.x = cvt_pk_bf16(v[0], v[1]); w.y = cvt_pk_bf16(v[2], v[3]); return __builtin_bit_cast(s16x4, w); }
__device__ __forceinline__ void phase_gdn_chunk(const Args& a, LAS unsigned char* lds) {
    const bf16_t* qc = (const bf16_t*)(a.ws + WS_QKVC); const float* bgi = (const float*)(a.ws + WS_BG); bf16_t* O = (bf16_t*)(a.ws + WS_O);
    constexpr int VRS = 144, KTRS = 136;
    constexpr int KT = 0, QS = KT + 128 * KTRS, WSL = QS + 64 * RSB, QKS = WSL + 64 * RSB, EE = QKS + 2048, EDD = EE + 256, SET = EDD + 256;
    constexpr int STL = 2 * SET, KS = STL + 64 * RSB, VS = KS + 64 * RSB, X2 = VS + 64 * VRS, LS = X2 + 2048, X1 = LS + 4096, GAM = X1 + 2048, BET = GAM + 256, LEND = BET + 256;
    static_assert(LEND <= LDS_XBW, "gdn lds");
    const int wid = __builtin_amdgcn_readfirstlane(TIDX >> 6);
    const int NCK = S_ / 64;
    for (int blk = BID; blk < NB_ * 32 * 2; blk += NBLK) {
        const int grp = (blk & 7) * 8 + (blk >> 5), mem = (blk >> 3) & 3, b = grp >> 4, hk = grp & 15, hv = 2 * hk + (mem >> 1), vhalf = mem & 1;
        __syncthreads();
        if (wid < 4) {
            const int vt = wid;
            f32x4 Sacc[8];
#pragma unroll
            for (int n = 0; n < 8; ++n) Sacc[n] = (f32x4){0.f, 0.f, 0.f, 0.f};
            { const int lane = TIDX & 63;
              for (int i = lane; i < 16 * RSB / 16; i += 64) *(LAS u32x4*)(lds + STL + 16 * vt * RSB + i * 16) = (u32x4){0u, 0u, 0u, 0u}; }
            int lz = TIDX & 63; asm volatile("" : "+v"(lz));
            const int lane = lz, I = lane & 15, G = lane >> 4, q4 = I >> 2, p4 = I & 3;
            for (int it = 0; it <= NCK; ++it) {
                const int set = ((it - 1) & 1) * SET; const size_t t0 = (size_t)b * S_ + (size_t)(it - 1) * 64;
                f32x4 U[4];
                if (it >= 1) {
#pragma unroll
                    for (int sa = 0; sa < 4; ++sa) U[sa] = mfma16(*(const LAS s16x4*)(lds + X2 + ((sa * 16 + I) * 16 + 4 * G) * 2), lds_tr4(lds + VS + (16 * sa + 4 * G + q4) * VRS + (16 * vt + 4 * p4) * 2), (f32x4){0.f, 0.f, 0.f, 0.f});
                    asm volatile("" : "+v"(U[0]), "+v"(U[1]), "+v"(U[2]), "+v"(U[3]) :: "memory");
                }
#pragma unroll
                for (int sa = 0; sa < 4; ++sa) {
                    if (it >= 1) {
                        bf16x8 sf[4];
#pragma unroll
                        for (int ks = 0; ks < 4; ++ks) sf[ks] = lds_frag(lds + STL + (16 * vt + I) * RSB + (32 * ks + 8 * G) * 2);
                        s16x4 kt[8];
#pragma unroll
                        for (int dt = 0; dt < 8; ++dt) kt[dt] = *(const LAS s16x4*)(lds + set + KT + (16 * dt + I) * KTRS + (16 * sa + 4 * G) * 2);
                        f32x4 dl = U[sa], oq = (f32x4){0.f, 0.f, 0.f, 0.f};
#pragma unroll
                        for (int ks = 0; ks < 4; ++ks) { dl = mfma32(lds_frag(lds + set + WSL + (16 * sa + I) * RSB + (32 * ks + 8 * G) * 2), sf[ks], dl);
                            oq = mfma32(lds_frag(lds + set + QS + (16 * sa + I) * RSB + (32 * ks + 8 * G) * 2), sf[ks], oq); }
                        const s16x4 dfrag = pack4(dl);
                        const f32x4 e4 = *(const LAS f32x4*)(lds + set + EE + (16 * sa + 4 * G) * 4);
                        oq = mfma16(*(const LAS s16x4*)(lds + set + QKS + ((sa * 16 + I) * 16 + 4 * G) * 2), dfrag, oq * e4);
#pragma unroll
                        for (int r = 0; r < 4; ++r) O[(t0 + 16 * sa + 4 * G + r) * 4096 + hv * 128 + vhalf * 64 + 16 * vt + I] = f2bf(oq[r]);
                        const f32x4 ed4 = *(const LAS f32x4*)(lds + set + EDD + (16 * sa + 4 * G) * 4); const float e15 = *(const LAS float*)(lds + set + EE + (16 * sa + 15) * 4);
                        const s16x4 dsc = pack4(dl * ed4);
#pragma unroll
                        for (int dt = 0; dt < 8; ++dt) {
                            Sacc[dt] = mfma16(kt[dt], dsc, Sacc[dt] * e15);
                            *(LAS s16x4*)(lds + STL + (16 * vt + I) * RSB + (16 * dt + 4 * G) * 2) = pack4(Sacc[dt]); }
                    }
                    LDS_BARRIER();
                }
            }
        } else {
            const int pw = wid - 4;
            u32x4 pq[4], pk[4], pv[2]; float pb = 0.f, pg = 0.f;
            { const int ptid = TIDX - 256; const size_t t0 = (size_t)b * S_;
#pragma unroll
              for (int i = 0; i < 4; ++i) { const int c = ptid + i * 256, s2 = c >> 4, c8 = (c & 15) * 8; pq[i] = *(const u32x4*)(qc + (t0 + s2) * 8192 + hk * 128 + c8); pk[i] = *(const u32x4*)(qc + (t0 + s2) * 8192 + 2048 + hk * 128 + c8); }
#pragma unroll
              for (int i = 0; i < 2; ++i) { const int c = ptid + i * 256, s2 = c >> 3, c8 = (c & 7) * 8; pv[i] = *(const u32x4*)(qc + (t0 + s2) * 8192 + 4096 + hv * 128 + vhalf * 64 + c8); }
              if (pw == 1) { pb = bgi[(t0 + ptid - 64) * 64 + hv]; pg = bgi[(t0 + ptid - 64) * 64 + 32 + hv]; } }
            int lz = TIDX & 63; asm volatile("" : "+v"(lz));
            const int lane = lz, ptid = pw * 64 + lane, I = lane & 15, G = lane >> 4, q4 = I >> 2, p4 = I & 3;
            for (int it = 0; it <= NCK; ++it) {
                const int set = (it & 1) * SET; const bool act = it < NCK;
                if (act) {
#pragma unroll
                    for (int i = 0; i < 4; ++i) { const int c = ptid + i * 256, s2 = c >> 4, c8 = (c & 15) * 8; *(LAS u32x4*)(lds + set + QS + s2 * RSB + c8 * 2) = pq[i]; *(LAS u32x4*)(lds + KS + s2 * RSB + c8 * 2) = pk[i]; }
                    if (pw == 1) { float x = pg;
                        x += __builtin_bit_cast(float, __builtin_amdgcn_update_dpp(0, __builtin_bit_cast(int, x), 0x111, 0xf, 0xf, true));
                        x += __builtin_bit_cast(float, __builtin_amdgcn_update_dpp(0, __builtin_bit_cast(int, x), 0x112, 0xf, 0xf, true));
                        x += __builtin_bit_cast(float, __builtin_amdgcn_update_dpp(0, __builtin_bit_cast(int, x), 0x114, 0xf, 0xf, true));
                        x += __builtin_bit_cast(float, __builtin_amdgcn_update_dpp(0, __builtin_bit_cast(int, x), 0x118, 0xf, 0xf, true));
                        const float g15 = __shfl(x, 15, 16);
                        *(LAS float*)(lds + GAM + lane * 4) = x; *(LAS float*)(lds + set + EE + lane * 4) = __expf(x); *(LAS float*)(lds + set + EDD + lane * 4) = __expf(g15 - x); *(LAS float*)(lds + BET + lane * 4) = pb; }
                }
                LDS_BARRIER();
                if (act) { const int sa = pw;
#pragma unroll
                    for (int i = 0; i < 2; ++i) { const int c = ptid + i * 256, s2 = c >> 3, c8 = (c & 7) * 8; *(LAS u32x4*)(lds + VS + s2 * VRS + c8 * 2) = pv[i]; }
                    if (it + 1 < NCK) { const size_t t1 = (size_t)b * S_ + (size_t)(it + 1) * 64;
#pragma unroll
                        for (int i = 0; i < 4; ++i) { const int c = ptid + i * 256, s2 = c >> 4, c8 = (c & 15) * 8; pq[i] = *(const u32x4*)(qc + (t1 + s2) * 8192 + hk * 128 + c8); pk[i] = *(const u32x4*)(qc + (t1 + s2) * 8192 + 2048 + hk * 128 + c8); }
#pragma unroll
                        for (int i = 0; i < 2; ++i) { const int c = ptid + i * 256, s2 = c >> 3, c8 = (c & 7) * 8; pv[i] = *(const u32x4*)(qc + (t1 + s2) * 8192 + 4096 + hv * 128 + vhalf * 64 + c8); }
                        if (pw == 1) { pb = bgi[(t1 + ptid - 64) * 64 + hv]; pg = bgi[(t1 + ptid - 64) * 64 + 32 + hv]; } }
#pragma unroll
                    for (int ty = 0; ty < 2; ++ty) { f32x4 acc = (f32x4){0.f, 0.f, 0.f, 0.f};
#pragma unroll
                        for (int ks = 0; ks < 4; ++ks) { const bf16x8 ka = lds_frag(lds + KS + (16 * sa + I) * RSB + (32 * ks + 8 * G) * 2);
                            const bf16x8 bo = ty ? lds_frag(lds + set + QS + (16 * sa + I) * RSB + (32 * ks + 8 * G) * 2) : ka; acc = mfma32(ka, bo, acc); }
                        const f32x4 gr = *(const LAS f32x4*)(lds + GAM + (16 * sa + 4 * G) * 4); const float gc = *(const LAS float*)(lds + GAM + (16 * sa + I) * 4);
                        if (ty == 0) { const f32x4 br = *(const LAS f32x4*)(lds + BET + (16 * sa + 4 * G) * 4);
#pragma unroll
                            for (int r = 0; r < 4; ++r) { const float val = br[r] * acc[r] * __expf(gr[r] - gc); *(LAS float*)(lds + LS + ((sa * 16 + 4 * G + r) * 16 + I) * 4) = (I < 4 * G + r) ? val : 0.f; } }
                        else { f32x4 o;
#pragma unroll
                            for (int r = 0; r < 4; ++r) { const float val = acc[r] * __expf(gc - gr[r]); o[r] = (4 * G + r <= I) ? val : 0.f; }
                            *(LAS s16x4*)(lds + set + QKS + ((sa * 16 + I) * 16 + 4 * G) * 2) = pack4(o); } } }
                LDS_BARRIER();
                if (act && pw == 0) { const int sa = G, c = I; float x[16];
#pragma unroll
                    for (int i = 0; i < 16; ++i) x[i] = 0.f;
#pragma unroll
                    for (int ib = 0; ib < 4; ++ib) {
                        f32x4 lv[4][4];
#pragma unroll
                        for (int r = 0; r < 4; ++r)
#pragma unroll
                            for (int jj = 0; jj <= ib; ++jj) lv[r][jj] = *(const LAS f32x4*)(lds + LS + ((sa * 16 + 4 * ib + r) * 16 + 4 * jj) * 4);
                        __builtin_amdgcn_sched_barrier(0);
#pragma unroll
                        for (int r = 0; r < 4; ++r) { const int i = 4 * ib + r; float s0 = (i == c) ? 1.0f : 0.0f, s1 = 0.f;
#pragma unroll
                            for (int jj = 0; jj <= ib; ++jj) { s0 -= lv[r][jj][0] * x[4 * jj] + lv[r][jj][1] * x[4 * jj + 1]; s1 -= lv[r][jj][2] * x[4 * jj + 2] + lv[r][jj][3] * x[4 * jj + 3]; }
                            x[i] = s0 + s1; }
                    }
                    const float bc = *(const LAS float*)(lds + BET + lane * 4), sc1 = -bc * *(const LAS float*)(lds + set + EE + lane * 4);
#pragma unroll
                    for (int i = 0; i < 16; ++i) { *(LAS bf16_t*)(lds + X1 + ((sa * 16 + i) * 16 + c) * 2) = f2bf(x[i] * sc1); *(LAS bf16_t*)(lds + X2 + ((sa * 16 + i) * 16 + c) * 2) = f2bf(x[i] * bc); } }
                LDS_BARRIER();
                if (act) { const int sa = pw;
                    const s16x4 xb = *(const LAS s16x4*)(lds + X1 + ((sa * 16 + I) * 16 + 4 * G) * 2); s16x4 kt[8]; f32x4 w[8];
#pragma unroll
                    for (int dt = 0; dt < 8; ++dt) kt[dt] = lds_tr4(lds + KS + (16 * sa + 4 * G + q4) * RSB + (16 * dt + 4 * p4) * 2);
#pragma unroll
                    for (int dt = 0; dt < 8; ++dt) { w[dt] = mfma16(kt[dt], xb, (f32x4){0.f, 0.f, 0.f, 0.f}); *(LAS s16x4*)(lds + set + KT + (16 * dt + I) * KTRS + (16 * sa + 4 * G) * 2) = kt[dt]; }
#pragma unroll
                    for (int dt = 0; dt < 8; ++dt) *(LAS s16x4*)(lds + set + WSL + (16 * sa + I) * RSB + (16 * dt + 4 * G) * 2) = pack4(w[dt]); }
                LDS_BARRIER();
            }
        }
    }
}

constexpr int N_PHASES = 30;
__global__ void __launch_bounds__(NTHREADS, 2) fwd(Args a0) {
    extern __shared__ __attribute__((aligned(16))) unsigned char smem_raw[];
    LAS unsigned char* lds = (LAS unsigned char*)smem_raw;
    volatile LAS unsigned* xbw = (volatile LAS unsigned*)(lds + LDS_XBW);
    if (TIDX == 0) { xbw[0] = 0u; xbw[1] = 0u; xbw[2] = 0u; xbw[3] = 0u; }
    __syncthreads();
    XcdBarrier bar = xcd_barrier_post((unsigned*)(a0.ws + WS_CTL), xbw);
#ifndef PHMASK
#define PHMASK 0xFFFFFFFFull
#endif
#ifndef DUPMASK
#define DUPMASK 0ull
#endif
#define PH(i, body) do { if (((PHMASK >> (i)) & 1ull) && a0.ph_lo <= (i) && (i) < a0.ph_hi) { __attribute__((address_space(1))) unsigned char* wsp_ = (__attribute__((address_space(1))) unsigned char*)a0.ws; asm volatile("" : "+s"(wsp_)); Args a = a0; a.ws = (unsigned char*)wsp_; const float* xin = a.in[0]; const float* xw = (const float*)(a.ws + WS_X); (void)xin; (void)xw; \
        if ((DUPMASK >> (i)) & 1ull) { body; xcd_barrier(bar); } body; if ((i) + 1 < a0.ph_hi) xcd_barrier(bar); } } while (0)
    PH(0, { phase_prologue(a, lds); __syncthreads(); NORM_PH(0, true)(a, xin, a.in[1], -1); });
    PH(2, phase_gemm_in0(a, lds));
    PH(3, { phase_rg_conv(a); __syncthreads(); phase_hg1(a, lds); });
    PH(4, { phase_rg_gates(a, lds); __syncthreads(); phase_hg2(a); });
    PH(5, { phase_rg_scan(a, lds); __syncthreads(); phase_hg3(a, lds); });
    PH(9, phase_gemm_out<false>(a, lds, D_, a.ws + WS_WOUT0T, xin));
    PH(10, NORM_PH(0, false)(a, nullptr, a.in[2], 0));
    PH(11, phase_gemm_router(a, lds, 0));
    PH(12, phase_route(a, 0));
    PH(13, phase_rowmap(a, lds, 0));
    PH(14, phase_moe_up(a, lds, 0));
    PH(15, phase_moe_down(a, lds, 0));
    PH(16, { NORM_PH(1, false)(a, nullptr, a.in[1] + D_, 0); __syncthreads(); moe_weight_jobs(a, 1, lds); });
    PH(18, { phase_gemm_in1(a, lds); phase_gemm_in1_tail(a, lds); });
    PH(19, phase_gdn_conv(a));
    PH(20, phase_gdn_chunk(a, lds));
    PH(21, phase_gdn_norm(a));
    PH(22, phase_gemm_out<true>(a, lds, 4096, a.ws + WS_WOUT1T, nullptr));
    PH(23, NORM_PH(0, false)(a, nullptr, a.in[2] + D_, 1));
    PH(24, phase_gemm_router(a, lds, 1));
    PH(25, phase_route(a, 1));
    PH(26, phase_rowmap(a, lds, 1));
    PH(27, phase_moe_up(a, lds, 1));
    PH(28, phase_moe_down(a, lds, 1));
    PH(29, NORM_PH(2, false)(a, nullptr, a.in[3], 1));
#undef PH
}

extern "C" void kernel_launch(void* const* d_in, const int* in_sizes, int n_in, void* d_out, int out_size, void* d_ws, size_t ws_size, hipStream_t stream) {
    static int grid = 0;
    if (grid == 0) {
        if (n_in != 28 || ws_size < WS_END) { fprintf(stderr, "kernel_launch: need 28 inputs and %zu bytes of workspace, got %d / %zu\n", (size_t)WS_END, n_in, ws_size); grid = -1; return; }
        int dev = 0, cus = 0, per_cu = 0;
        if (hipGetDevice(&dev) != hipSuccess || hipDeviceGetAttribute(&cus, hipDeviceAttributeMultiprocessorCount, dev) != hipSuccess) { grid = -1; return; }
        if (hipFuncSetAttribute((const void*)fwd, hipFuncAttributeMaxDynamicSharedMemorySize, LDS_BYTES) != hipSuccess) { fprintf(stderr, "kernel_launch: hipFuncSetAttribute failed\n"); grid = -1; return; }
        if (hipOccupancyMaxActiveBlocksPerMultiprocessor(&per_cu, (const void*)fwd, NTHREADS, LDS_BYTES) != hipSuccess || per_cu < 1) { fprintf(stderr, "kernel_launch: occupancy query says %d\n", per_cu); }
        (void)hipGetLastError();
        grid = cus;
    }
    if (grid < 0) return;
    (void)in_sizes; (void)out_size;
    hipMemsetAsync((char*)d_ws + WS_CTL, 0, CTL_BYTES, stream);
    Args a; memset(&a, 0, sizeof(a));
    for (int i = 0; i < 28; ++i) a.in[i] = (const float*)d_in[i];
    a.out = (float*)d_out; a.ws = (unsigned char*)d_ws;
#if N_LAUNCH_MODE == 1
    a.ph_lo = 0; a.ph_hi = N_PHASES;
    hipLaunchKernelGGL(fwd, dim3(grid), dim3(NTHREADS), LDS_BYTES, stream, a);
#if EXTRA_PH >= 0
    a.ph_lo = EXTRA_PH; a.ph_hi = EXTRA_PH + 1;
    hipLaunchKernelGGL(fwd, dim3(grid), dim3(NTHREADS), LDS_BYTES, stream, a);
#endif
#else
    for (int p = 0; p < N_PHASES; ++p) { a.ph_lo = p; a.ph_hi = p + 1; hipLaunchKernelGGL(fwd, dim3(grid), dim3(NTHREADS), LDS_BYTES, stream, a); }
#endif
}
```

```cpp
#include <hip/hip_runtime.h>
#include <stdint.h>
#include <stdio.h>
#include <string.h>

#ifndef EXTRA_PH
#define EXTRA_PH -1
#endif
#ifndef N_LAUNCH_MODE
#define N_LAUNCH_MODE 1
#endif

#define LAS __attribute__((address_space(3)))
typedef unsigned short bf16_t;
typedef short bf16x8 __attribute__((ext_vector_type(8)));
typedef float f32x4 __attribute__((ext_vector_type(4)));
typedef float f32x2 __attribute__((ext_vector_type(2)));
typedef unsigned u32x4 __attribute__((ext_vector_type(4)));
typedef unsigned u32x2 __attribute__((ext_vector_type(2)));

constexpr int T_ = 16384, D_ = 2048, S_ = 4096, NB_ = 4;
constexpr int N_IN0 = 6144, N_IN1 = 12352, N_IN1P = 12544;
constexpr int NEXP = 64, DEXP = 512, MPAD = 49152;
constexpr int NTHREADS = 512;
constexpr int LDS_MAIN = 131072;
constexpr int LDS_BYTES = 163840;
constexpr int LDS_XBW = LDS_BYTES - 16;

constexpr size_t al256(size_t x) { return (x + 255) & ~(size_t)255; }
constexpr size_t WS_CTL = 0;
constexpr size_t CTL_BYTES = 65536;
constexpr size_t CTL_CNT = 16384;
constexpr size_t WS_LB = WS_CTL + CTL_BYTES;
constexpr size_t WS_TINFO = WS_LB + 4096;
constexpr size_t WS_WIN0T = WS_TINFO + 4096;
constexpr size_t WS_WOUT0T = WS_WIN0T + (size_t)N_IN0 * D_ * 2;
constexpr size_t WS_WIN1T = WS_WOUT0T + (size_t)D_ * D_ * 2;
constexpr size_t WS_WOUT1T = WS_WIN1T + (size_t)N_IN1P * D_ * 2;
constexpr size_t WS_WGATES = WS_WOUT1T + (size_t)D_ * 4096 * 2;
constexpr size_t WS_WRT = WS_WGATES + (size_t)8 * 256 * 256 * 2;
constexpr size_t WS_WG = WS_WRT + (size_t)2 * 256 * D_ * 2;
constexpr size_t WS_WU = WS_WG + (size_t)NEXP * DEXP * D_ * 2;
constexpr size_t WS_WD = WS_WU + (size_t)NEXP * DEXP * D_ * 2;
constexpr size_t WS_X = WS_WD + (size_t)NEXP * DEXP * D_ * 2;
constexpr size_t WS_H = WS_X + (size_t)T_ * D_ * 4;
constexpr size_t WS_PROJ = WS_H + (size_t)T_ * D_ * 2;
constexpr size_t PROJ_BYTES = (size_t)T_ * N_IN1P * 2;
constexpr size_t WS_FLOG = WS_PROJ + (size_t)T_ * N_IN0 * 2;
constexpr size_t WS_XC = WS_FLOG + (size_t)T_ * 1024 * 4;
constexpr size_t WS_ACT = WS_PROJ;
constexpr size_t WS_YMOE = WS_ACT + (size_t)MPAD * DEXP * 2;
constexpr size_t WS_R1 = WS_PROJ + PROJ_BYTES;
constexpr size_t WS_A = WS_R1;
constexpr size_t WS_U = WS_R1 + (size_t)T_ * 1024 * 4;
constexpr size_t WS_QKVC = WS_R1;
constexpr size_t WS_Y = WS_R1 + (size_t)T_ * 8192 * 2;
constexpr size_t WS_O = WS_Y + (size_t)T_ * 4096 * 2;
constexpr size_t WS_TAIL = WS_O + (size_t)T_ * 4096 * 4;
constexpr size_t WS_BG = WS_TAIL + (size_t)T_ * 64 * 4;
constexpr size_t WS_LOGITS = WS_BG + (size_t)T_ * 64 * 4;
constexpr size_t WS_EID = WS_LOGITS + (size_t)T_ * 128 * 4;
constexpr size_t WS_SLOT = WS_EID + (size_t)T_ * 2 * 4;
constexpr size_t WS_GATE = WS_SLOT + (size_t)T_ * 2 * 4;
constexpr size_t WS_POSOF = WS_GATE + (size_t)T_ * 2 * 4;
constexpr size_t WS_ROWMAP = WS_POSOF + (size_t)T_ * 2 * 4;
constexpr size_t WS_H8 = WS_ROWMAP + (size_t)MPAD * 4;
constexpr size_t WS_END = WS_H8 + (size_t)T_ * D_;
static_assert(WS_YMOE + (size_t)MPAD * D_ * 2 <= WS_R1, "moe overlay");
static_assert(WS_XC + (size_t)T_ * 1024 * 2 <= WS_R1, "layer0 overlay");

struct Args {
    const float* in[28];
    float* out;
    unsigned char* ws;
    int ph_lo, ph_hi;
};

__device__ __forceinline__ int tidx_() { int t = (int)threadIdx.x; asm volatile("" : "+v"(t)); return t; }
#define TIDX tidx_()
typedef __bf16 bf16x2n __attribute__((ext_vector_type(2)));
__device__ __forceinline__ unsigned cvt_pk_bf16(float lo, float hi) { const f32x2 v = {lo, hi}; return __builtin_bit_cast(unsigned, __builtin_convertvector(v, bf16x2n)); }
__device__ __forceinline__ unsigned pk_fp8x4(float a, float b, float c, float d) { int v = __builtin_amdgcn_cvt_pk_fp8_f32(a, b, 0, false); v = __builtin_amdgcn_cvt_pk_fp8_f32(c, d, v, true); return (unsigned)v; }
constexpr float W8_SCALE = 64.0f, ACT8_SCALE = 8.0f;
__device__ __forceinline__ bf16_t f2bf(float x) { return (bf16_t)(cvt_pk_bf16(x, 0.f) & 0xffffu); }
__device__ __forceinline__ float bf_lo(unsigned w) { return __uint_as_float(w << 16); }
__device__ __forceinline__ float bf_hi(unsigned w) { return __uint_as_float(w & 0xffff0000u); }
__device__ __forceinline__ float bf1(bf16_t v) { return __uint_as_float(((unsigned)v) << 16); }
__device__ __forceinline__ float sigmoidf_(float x) { return __builtin_amdgcn_rcpf(1.0f + __expf(-x)); }
__device__ __forceinline__ float siluf_(float x) { return x * __builtin_amdgcn_rcpf(1.0f + __expf(-x)); }
__device__ __forceinline__ float softplusf_(float x) { return x > 20.f ? x : log1pf(__expf(x)); }
__device__ __forceinline__ float gelu_tanh(float x) { const float u = 0.7978845608028654f * (x + 0.044715f * x * x * x); return x * __builtin_amdgcn_rcpf(1.0f + __expf(-2.0f * u)); }
template <int CTRL> __device__ __forceinline__ float dpp_f(float v) { return __builtin_bit_cast(float, __builtin_amdgcn_update_dpp(0, __builtin_bit_cast(int, v), CTRL, 0xf, 0xf, false)); }
__device__ __forceinline__ float row16_sum(float s) { s += dpp_f<0x140>(s); s += dpp_f<0x141>(s); s += dpp_f<0xB1>(s); s += dpp_f<0x4E>(s); return s; }
__device__ __forceinline__ float wave_sum(float v) { v = row16_sum(v); v += __shfl_xor(v, 16); v += __shfl_xor(v, 32); return v; }

#define LDS_BARRIER() do { asm volatile("s_waitcnt lgkmcnt(0)" ::: "memory"); __builtin_amdgcn_s_barrier(); asm volatile("" ::: "memory"); } while (0)
#define XB_TMO      128
#define XB_XCNT(j)  (256  + 64 * (j))
#define XB_XSUB(j)  (1280 + 64 * (j))
#define XB_XGEN(j)  (2304 + 64 * (j))
#define XB_TOP      3328
#define XB_TOPGEN   3392
#define XCD_BAR_WORDS 3456
#define XB_SPIN_CAP (1u << 18)

__device__ __forceinline__ unsigned xb_ld(unsigned* p)              { return __hip_atomic_load(p, __ATOMIC_RELAXED, __HIP_MEMORY_SCOPE_AGENT); }
__device__ __forceinline__ unsigned xb_add(unsigned* p, unsigned v) { return __hip_atomic_fetch_add(p, v, __ATOMIC_RELAXED, __HIP_MEMORY_SCOPE_AGENT); }
__device__ __forceinline__ unsigned xb_xcc_id() { return (unsigned)__builtin_amdgcn_s_getreg((3 << 11) | 20) & 0xFu; }
#define XB_SPIN(cond, bar) do { unsigned _sp = 0; while (cond) { __builtin_amdgcn_s_sleep(1); \
    if ((++_sp & 255u) == 0u) { if (xb_ld(&(bar)[XB_TMO])) break; if (_sp > XB_SPIN_CAP) { atomicAdd(&(bar)[XB_TMO], 1u); break; } } } } while (0)

struct XcdBarrier { unsigned* bar; unsigned x; volatile LAS unsigned* st; };

__device__ __forceinline__ XcdBarrier xcd_barrier_post(unsigned* bar, volatile LAS unsigned* st) {
    XcdBarrier b; b.bar = bar; b.x = xb_xcc_id(); b.st = st;
    if (TIDX == 0) (void)xb_add(&bar[XB_XCNT(b.x)], 1u);
    return b;
}
__device__ __forceinline__ void xcd_barrier_complete(unsigned* bar, unsigned x, unsigned& nloc, unsigned& nx) {
    const unsigned G = gridDim.x * gridDim.y * gridDim.z;
    unsigned sum, cnt, mine, sp = 0u;
    for (;;) {
        sum = 0u; cnt = 0u; mine = 0u;
#pragma unroll
        for (unsigned j = 0; j < 16; ++j) { const unsigned c = xb_ld(&bar[XB_XCNT(j)]); sum += c; cnt += (c > 0u) ? 1u : 0u; mine = (j == x) ? c : mine; }
        if (sum == G) break;
        __builtin_amdgcn_s_sleep(1);
        if ((++sp & 255u) == 0u) { if (xb_ld(&bar[XB_TMO])) break; if (sp > XB_SPIN_CAP) { atomicAdd(&bar[XB_TMO], 1u); break; } }
    }
    nloc = mine > 0u ? mine : 1u; nx = cnt > 0u ? cnt : 1u;
}
__device__ __forceinline__ void xcd_barrier(const XcdBarrier& b) {
    asm volatile("s_waitcnt vmcnt(0)" ::: "memory");
    __syncthreads();
    if (TIDX == 0) {
        unsigned* bar = b.bar;
        __builtin_amdgcn_s_waitcnt(0);
        unsigned nloc = b.st[0], nx = b.st[1];
        if (nloc == 0u) { xcd_barrier_complete(bar, b.x, nloc, nx); b.st[0] = nloc; b.st[1] = nx; }
        const unsigned old = xb_add(&bar[XB_XSUB(b.x)], 1u);
        const unsigned gen = old / nloc;
        if (old + 1u == (gen + 1u) * nloc) {
            __builtin_amdgcn_fence(__ATOMIC_RELEASE, "agent");
            asm volatile("s_waitcnt vmcnt(0)" ::: "memory");
            const unsigned og = xb_add(&bar[XB_TOP], 1u);
            const unsigned tg = og / nx;
            if (og + 1u == (tg + 1u) * nx) xb_add(&bar[XB_TOPGEN], 1u);
            else XB_SPIN(xb_ld(&bar[XB_TOPGEN]) == tg, bar);
            __builtin_amdgcn_fence(__ATOMIC_ACQUIRE, "agent");
            xb_add(&bar[XB_XGEN(b.x)], 1u);
            asm volatile("s_waitcnt vmcnt(0)" ::: "memory");
        } else {
            XB_SPIN(xb_ld(&bar[XB_XGEN(b.x)]) == gen, bar);
            __builtin_amdgcn_fence(__ATOMIC_ACQUIRE, "agent");
            asm volatile("s_waitcnt vmcnt(0)" ::: "memory");
        }
    }
    __syncthreads();
}

constexpr int BM = 256, BK = 64, HALF = 128, HTB = HALF * BK * 2;
__device__ __forceinline__ int lds_byte(int r, int c) { const int st = (r >> 4) * 2 + (c >> 5), rr = r & 15, cc = c & 31, ob = rr * 64 + cc * 2; return st * 1024 + (ob ^ (((ob >> 9) & 1) << 5)); }
__device__ __forceinline__ void stage_rc(int b, int& R, int& C) { const int st = b / 1024, sb = b % 1024, swz = sb ^ (((sb >> 9) & 1) << 5); R = (st >> 1) * 16 + swz / 64; C = (st & 1) * 32 + (swz % 64) / 2; }
__device__ __forceinline__ int perm32(int rho) { const int n = rho >> 4, i = rho & 15; return 8 * (i >> 2) + 4 * n + (i & 3); }

__device__ __forceinline__ void stage_pos(int tid, int& R0, int& C0) { stage_rc(tid * 16, R0, C0); }
__device__ __forceinline__ int perm_row(int R) { return (R & ~31) + perm32(R & 31); }

#define BID ((int)blockIdx.x)
#define NBLK ((int)gridDim.x)
#define BID_ BID
#define NBLK_ NBLK
typedef f32x4 Acc[2][2][4][2];
struct UnitD { const char* gA; const char* gB; int t0, t1, t2; };

typedef int i32x8 __attribute__((ext_vector_type(8)));
typedef int i32x4 __attribute__((ext_vector_type(4)));
template <bool GATHER, bool FP8, class Src, class Epi>
__device__ __forceinline__ void gemm_stream(LAS unsigned char* lds, const Src& S, const int nt, const Epi& E) {
    const int tid = TIDX, wid = tid >> 6, lane = tid & 63, wr = wid >> 2, wc = wid & 3, fr = lane & 15, fq = lane >> 4;
    const unsigned ldsw = (unsigned)wid * 1024u;
    const int aoff = lds_byte(wr * 64 + fr, fq * 8), boff = lds_byte(wc * 32 + fr, fq * 8);
    const size_t kstep = (size_t)(BK * 2);
#define G_SA(b, h) (((b) * 2 + (h)) * HTB)
#define G_SB(b, h) ((4 + (b) * 2 + (h)) * HTB)
#define G_STAGE(bufoff, gbase, v) do { _Pragma("unroll") for (int _i = 0; _i < 2; ++_i) \
        __builtin_amdgcn_global_load_lds((const unsigned*)((gbase) + (v)[_i]), (LAS unsigned*)(lds + (bufoff) + ldsw + _i * 8192), 16, 0, 0); } while (0)
#define G_LD8(p) __builtin_shufflevector(*(const LAS i32x4*)(p), *(const LAS i32x4*)((p) + 1024), 0, 1, 2, 3, 4, 5, 6, 7)
#define G_LDA(dst, b, h) do { _Pragma("unroll") for (int m = 0; m < 4; ++m) dst[m] = G_LD8(lds + G_SA(b, h) + aoff + m * 2048); } while (0)
#define G_LDB(dst, b, h) do { _Pragma("unroll") for (int n = 0; n < 2; ++n) dst[n] = G_LD8(lds + G_SB(b, h) + boff + n * 2048); } while (0)
#define G_HALF(x, k) __builtin_bit_cast(bf16x8, __builtin_shufflevector((x), (x), 4 * (k), 4 * (k) + 1, 4 * (k) + 2, 4 * (k) + 3))
#define G_MMA(ai, bj, At, Bt) do { __builtin_amdgcn_s_setprio(1); _Pragma("unroll") for (int m = 0; m < 4; ++m) _Pragma("unroll") for (int n = 0; n < 2; ++n) { \
        if (FP8) asm volatile("v_mfma_f32_16x16x128_f8f6f4 %0, %1, %2, %0" : "+v"(acc[ai][bj][m][n]) : "v"(Bt[n]), "v"(At[m]));   \
        else { acc[ai][bj][m][n] = __builtin_amdgcn_mfma_f32_16x16x32_bf16(G_HALF(Bt[n], 0), G_HALF(At[m], 0), acc[ai][bj][m][n], 0, 0, 0); \
               acc[ai][bj][m][n] = __builtin_amdgcn_mfma_f32_16x16x32_bf16(G_HALF(Bt[n], 1), G_HALF(At[m], 1), acc[ai][bj][m][n], 0, 0, 0); } } \
        __builtin_amdgcn_s_setprio(0); } while (0)
#define G_WAIT_V(n) asm volatile("s_waitcnt vmcnt(" #n ")" ::: "memory")
#define G_WAIT_L(n) asm volatile("s_waitcnt lgkmcnt(" #n ")" ::: "memory")
#define G_BAR __builtin_amdgcn_s_barrier()
#define G_SCHED __builtin_amdgcn_sched_barrier(0)
    UnitD cur, nxt; int ui = 0;
    if (!S.next(0, cur)) return;
    unsigned va[2][2], vb[2][2], van[2][2];
    S.vb(vb); S.va(cur, va);
    Acc acc;
#pragma unroll
    for (int a = 0; a < 2; ++a)
#pragma unroll
        for (int b = 0; b < 2; ++b)
#pragma unroll
            for (int m = 0; m < 4; ++m)
#pragma unroll
                for (int n = 0; n < 2; ++n) acc[a][b][m][n] = (f32x4){0.f, 0.f, 0.f, 0.f};
    i32x8 At[4], B0[2], B1[2];
    const char* cA = cur.gA; const char* cB = cur.gB;
    G_WAIT_V(0);
    __syncthreads();
    G_STAGE(G_SB(0, 0), cB, vb[0]); G_STAGE(G_SA(0, 0), cA, va[0]); G_STAGE(G_SB(0, 1), cB, vb[1]); G_STAGE(G_SA(0, 1), cA, va[1]);
    if (wr == 1) G_BAR;
    G_WAIT_V(4); G_BAR;
    G_STAGE(G_SB(1, 0), cB + kstep, vb[0]); G_STAGE(G_SA(1, 0), cA + kstep, va[0]); G_STAGE(G_SB(1, 1), cB + kstep, vb[1]);
    G_WAIT_V(6); G_BAR;
    for (;;) {
        const bool has_next = S.next(ui + 1, nxt);
        const char* nA = has_next ? nxt.gA : cA; const char* nB = has_next ? nxt.gB : cB;
        if (GATHER) { if (has_next) S.va(nxt, van); else { van[0][0] = va[0][0]; van[0][1] = va[0][1]; van[1][0] = va[1][0]; van[1][1] = va[1][1]; } }
#pragma unroll 1
        for (int t = 0; t < nt; t += 2) {
            const bool last = (t == nt - 2);
            const char* a1 = cA + (size_t)(t + 1) * kstep;
            const char* a2 = last ? nA : cA + (size_t)(t + 2) * kstep; const char* b2 = last ? nB : cB + (size_t)(t + 2) * kstep;
            const char* a3 = a2 + kstep; const char* b3 = b2 + kstep;
            unsigned v2[2][2];
#pragma unroll
            for (int hh = 0; hh < 2; ++hh)
#pragma unroll
                for (int i = 0; i < 2; ++i) v2[hh][i] = (GATHER && last) ? van[hh][i] : va[hh][i];
            G_LDB(B0, 0, 0); G_SCHED; G_LDA(At, 0, 0); G_STAGE(G_SA(1, 1), a1, va[1]);
            G_WAIT_L(8); G_BAR; G_WAIT_L(0); G_MMA(0, 0, At, B0); G_BAR; G_SCHED;
            G_LDB(B1, 0, 1); G_STAGE(G_SB(0, 0), b2, vb[0]);
            G_BAR; G_WAIT_L(0); G_MMA(0, 1, At, B1); G_BAR;
            G_LDA(At, 0, 1); G_STAGE(G_SA(0, 0), a2, v2[0]);
            G_BAR; G_WAIT_L(0); G_MMA(1, 0, At, B0); G_BAR; G_SCHED;
            G_STAGE(G_SB(0, 1), b2, vb[1]);
            G_WAIT_V(6); G_BAR; G_MMA(1, 1, At, B1); G_BAR;
            G_LDB(B0, 1, 0); G_SCHED; G_LDA(At, 1, 0); G_STAGE(G_SA(0, 1), a2, v2[1]);
            G_WAIT_L(8); G_BAR; G_WAIT_L(0); G_MMA(0, 0, At, B0); G_BAR; G_SCHED;
            G_LDB(B1, 1, 1); G_STAGE(G_SB(1, 0), b3, vb[0]);
            G_BAR; G_WAIT_L(0); G_MMA(0, 1, At, B1); G_BAR;
            G_LDA(At, 1, 1); G_STAGE(G_SA(1, 0), a3, v2[0]);
            G_BAR; G_WAIT_L(0); G_MMA(1, 0, At, B0); G_BAR; G_SCHED;
            G_STAGE(G_SB(1, 1), b3, vb[1]);
            G_WAIT_V(6); G_BAR; G_MMA(1, 1, At, B1); G_BAR;
        }
        if (FP8) asm volatile("s_nop 15\n\ts_nop 15" ::: "memory");
        { int tz = TIDX; asm volatile("" : "+v"(tz));
          const int wid2 = tz >> 6, lane2 = tz & 63; E(acc, cur, wid2 >> 2, wid2 & 3, lane2 & 15, lane2 >> 4); }
        if (!has_next) break;
#pragma unroll
        for (int a = 0; a < 2; ++a)
#pragma unroll
            for (int b = 0; b < 2; ++b)
#pragma unroll
                for (int m = 0; m < 4; ++m)
#pragma unroll
                    for (int n = 0; n < 2; ++n) acc[a][b][m][n] = (f32x4){0.f, 0.f, 0.f, 0.f};
        cur = nxt; cA = nA; cB = nB; ++ui;
        if (GATHER) { va[0][0] = van[0][0]; va[0][1] = van[0][1]; va[1][0] = van[1][0]; va[1][1] = van[1][1]; }
    }
    G_WAIT_V(0);
    if (wr == 0) G_BAR;
    G_BAR;
#undef G_SA
#undef G_SB
#undef G_STAGE
#undef G_LDA
#undef G_LDB
#undef G_MMA
#undef G_LD8
#undef G_HALF
#undef G_WAIT_V
#undef G_WAIT_L
#undef G_BAR
#undef G_SCHED
}

__device__ __forceinline__ void offs_direct(unsigned (&v)[2][2], int ld, bool perm) {
    int R0, C0; stage_pos(TIDX, R0, C0);
#pragma unroll
    for (int i = 0; i < 2; ++i) { const int R = R0 + 64 * i, Rr = perm ? perm_row(R) : R;
        v[0][i] = (unsigned)(Rr * ld + C0) * 2u; v[1][i] = (unsigned)((Rr + HALF) * ld + C0) * 2u; }
}

struct SrcGrid {
    const char* A; const char* B; size_t astep, bstep; int nM, total, lda, ldb;
    __device__ __forceinline__ bool next(int i, UnitD& u) const { const int id = BID_ + i * NBLK_; if (id >= total) return false; u.t0 = id % nM; u.t1 = id / nM; u.t2 = 0;
        u.gA = A + (size_t)u.t0 * astep; u.gB = B + (size_t)u.t1 * bstep; return true; }
    __device__ __forceinline__ void va(const UnitD&, unsigned (&v)[2][2]) const { offs_direct(v, lda, false); }
    __device__ __forceinline__ void vb(unsigned (&v)[2][2]) const { offs_direct(v, ldb, true); }
};

__device__ __forceinline__ void store_bf16_tile(const Acc& acc, bf16_t* O, int ld, int wr, int wc, int fr, int fq, const float sc = 1.0f) {
#pragma unroll
    for (int ai = 0; ai < 2; ++ai)
#pragma unroll
        for (int m = 0; m < 4; ++m) { bf16_t* rowp = O + (size_t)(ai * HALF + wr * 64 + m * 16 + fr) * ld + wc * 32 + 8 * fq;
#pragma unroll
            for (int bj = 0; bj < 2; ++bj) { const f32x4 v0 = acc[ai][bj][m][0] * sc, v1 = acc[ai][bj][m][1] * sc;
                u32x4 w; w.x = cvt_pk_bf16(v0[0], v0[1]); w.y = cvt_pk_bf16(v0[2], v0[3]); w.z = cvt_pk_bf16(v1[0], v1[1]); w.w = cvt_pk_bf16(v1[2], v1[3]);
                *(u32x4*)(rowp + bj * HALF) = w; } }
}
__device__ __forceinline__ void store_f32_tile(const Acc& acc, float* O, const float* R, int ld, int ncol, int wr, int wc, int fr, int fq, const float sc = 1.0f) {
#pragma unroll
    for (int ai = 0; ai < 2; ++ai)
#pragma unroll
        for (int m = 0; m < 4; ++m) { const size_t ro = (size_t)(ai * HALF + wr * 64 + m * 16 + fr) * ld;
#pragma unroll
            for (int bj = 0; bj < 2; ++bj)
#pragma unroll
                for (int n = 0; n < 2; ++n) { const int c = bj * HALF + wc * 32 + 8 * fq + 4 * n; if (c >= ncol) continue;
                    f32x4 v = acc[ai][bj][m][n] * sc; if (R) v += *(const f32x4*)(R + ro + c); *(f32x4*)(O + ro + c) = v; } }
}
struct EpiProj {
    bf16_t* O; int ld; float* F; int fld, fp0, fp1, ncol; float sc;
    __device__ __forceinline__ void operator()(const Acc& acc, const UnitD& u, int wr, int wc, int fr, int fq) const {
        if (u.t1 >= fp0 && u.t1 < fp1) store_f32_tile(acc, F + (size_t)u.t0 * BM * fld + (u.t1 - fp0) * BM, nullptr, fld, ncol, wr, wc, fr, fq, sc);
        else store_bf16_tile(acc, O + (size_t)u.t0 * BM * ld + u.t1 * BM, ld, wr, wc, fr, fq, sc);
    }
};
struct EpiResid {
    bf16_t* O; const float* Rf; const bf16_t* Rb; float sc;
    __device__ __forceinline__ void operator()(const Acc& acc, const UnitD& u, int wr, int wc, int fr, int fq) const {
        const size_t o = (size_t)u.t0 * BM * D_ + u.t1 * BM;
        if (Rf) {
#pragma unroll
            for (int am = 0; am < 4; ++am) { const int ai = am >> 1; f32x4 r0[2][2], r1[2][2];
#pragma unroll
                for (int mm = 0; mm < 2; ++mm) { const int m = (am & 1) * 2 + mm; const size_t ro = o + (size_t)(ai * HALF + wr * 64 + m * 16 + fr) * D_ + wc * 32 + 8 * fq;
#pragma unroll
                    for (int bj = 0; bj < 2; ++bj) { r0[mm][bj] = *(const f32x4*)(Rf + ro + bj * HALF); r1[mm][bj] = *(const f32x4*)(Rf + ro + bj * HALF + 4); } }
#pragma unroll
                for (int mm = 0; mm < 2; ++mm) { const int m = (am & 1) * 2 + mm; const size_t ro = o + (size_t)(ai * HALF + wr * 64 + m * 16 + fr) * D_ + wc * 32 + 8 * fq;
#pragma unroll
                    for (int bj = 0; bj < 2; ++bj) { const f32x4 v0 = acc[ai][bj][m][0] * sc + r0[mm][bj], v1 = acc[ai][bj][m][1] * sc + r1[mm][bj];
                        u32x4 w; w.x = cvt_pk_bf16(v0[0], v0[1]); w.y = cvt_pk_bf16(v0[2], v0[3]); w.z = cvt_pk_bf16(v1[0], v1[1]); w.w = cvt_pk_bf16(v1[2], v1[3]);
                        *(u32x4*)(O + ro + bj * HALF) = w; } } }
        } else {
#pragma unroll
            for (int ai = 0; ai < 2; ++ai) { u32x4 rr[4][2];
#pragma unroll
                for (int m = 0; m < 4; ++m) { const size_t ro = o + (size_t)(ai * HALF + wr * 64 + m * 16 + fr) * D_ + wc * 32 + 8 * fq;
#pragma unroll
                    for (int bj = 0; bj < 2; ++bj) rr[m][bj] = *(const u32x4*)(Rb + ro + bj * HALF); }
#pragma unroll
                for (int m = 0; m < 4; ++m) { const size_t ro = o + (size_t)(ai * HALF + wr * 64 + m * 16 + fr) * D_ + wc * 32 + 8 * fq;
#pragma unroll
                    for (int bj = 0; bj < 2; ++bj) { f32x4 v0 = acc[ai][bj][m][0] * sc, v1 = acc[ai][bj][m][1] * sc; const u32x4 r = rr[m][bj];
                        v0[0] += bf_lo(r.x); v0[1] += bf_hi(r.x); v0[2] += bf_lo(r.y); v0[3] += bf_hi(r.y); v1[0] += bf_lo(r.z); v1[1] += bf_hi(r.z); v1[2] += bf_lo(r.w); v1[3] += bf_hi(r.w);
                        u32x4 w; w.x = cvt_pk_bf16(v0[0], v0[1]); w.y = cvt_pk_bf16(v0[2], v0[3]); w.z = cvt_pk_bf16(v1[0], v1[1]); w.w = cvt_pk_bf16(v1[2], v1[3]);
                        *(u32x4*)(O + ro + bj * HALF) = w; } } }
        }
    }
};
struct EpiLogits {
    float* O;
    __device__ __forceinline__ void operator()(const Acc& acc, const UnitD& u, int wr, int wc, int fr, int fq) const { store_f32_tile(acc, O + (size_t)u.t0 * BM * 128, nullptr, 128, 128, wr, wc, fr, fq); }
};
struct EpiSwiGLU {
    unsigned char* O;
    __device__ __forceinline__ void operator()(const Acc& acc, const UnitD& u, int wr, int wc, int fr, int fq) const {
        unsigned char* o = O + (size_t)u.t0 * BM * DEXP + u.t1 * 128;
#pragma unroll
        for (int ai = 0; ai < 2; ++ai)
#pragma unroll
            for (int m = 0; m < 4; ++m) { unsigned char* rowp = o + (size_t)(ai * HALF + wr * 64 + m * 16 + fr) * DEXP + wc * 32 + 8 * fq;
                float r[8];
#pragma unroll
                for (int n = 0; n < 2; ++n)
#pragma unroll
                    for (int j = 0; j < 4; ++j) r[n * 4 + j] = (ACT8_SCALE / W8_SCALE) * siluf_(acc[ai][0][m][n][j] * (1.0f / W8_SCALE)) * acc[ai][1][m][n][j];
                u32x2 w; w.x = pk_fp8x4(r[0], r[1], r[2], r[3]); w.y = pk_fp8x4(r[4], r[5], r[6], r[7]);
                *(u32x2*)rowp = w; }
    }
};
struct EpiDown {
    unsigned char* O;
    __device__ __forceinline__ void operator()(const Acc& acc, const UnitD& u, int wr, int wc, int fr, int fq) const {
        unsigned char* o = O + (size_t)u.t0 * BM * D_ + u.t1 * BM; const float sc = 1.0f / (W8_SCALE * ACT8_SCALE);
#pragma unroll
        for (int ai = 0; ai < 2; ++ai)
#pragma unroll
            for (int m = 0; m < 4; ++m) { unsigned char* rowp = o + (size_t)(ai * HALF + wr * 64 + m * 16 + fr) * D_ + wc * 32 + 8 * fq;
#pragma unroll
                for (int bj = 0; bj < 2; ++bj) { const f32x4 v0 = acc[ai][bj][m][0] * sc, v1 = acc[ai][bj][m][1] * sc;
                    u32x2 w; w.x = pk_fp8x4(v0[0], v0[1], v0[2], v0[3]); w.y = pk_fp8x4(v1[0], v1[1], v1[2], v1[3]); *(u32x2*)(rowp + bj * HALF) = w; } }
    }
};
__device__ __forceinline__ unsigned rg_idx(unsigned tok, int c) { return ((((tok >> 12) * 64u + (unsigned)(c >> 4)) * (unsigned)S_ + (tok & (unsigned)(S_ - 1))) << 4) + (unsigned)(c & 15); }
struct EpiRgGates {
    bf16_t* LAo; bf16_t* Uo; const bf16_t* xc;
    const float* ba; const float* bx; const float* lam;
    __device__ __forceinline__ void operator()(const Acc& acc, const UnitD& u, int wr, int wc, int fr, int fq) const {
#pragma unroll
        for (int n = 0; n < 2; ++n) { const int c = u.t1 * 128 + wc * 32 + 8 * fq + 4 * n;
            u32x2 xq[2][4];
#pragma unroll
            for (int ai = 0; ai < 2; ++ai)
#pragma unroll
                for (int m = 0; m < 4; ++m) xq[ai][m] = *(const u32x2*)(xc + ((unsigned)(u.t0 * BM + ai * HALF + wr * 64 + m * 16 + fr) * 1024u + (unsigned)c));
            const f32x4 vba = *(const f32x4*)(ba + c), vbx = *(const f32x4*)(bx + c), vl = *(const f32x4*)(lam + c);
            f32x4 c8; for (int j = 0; j < 4; ++j) c8[j] = -8.0f * softplusf_(-vl[j]);
#pragma unroll
            for (int ai = 0; ai < 2; ++ai)
#pragma unroll
                for (int m = 0; m < 4; ++m) { const unsigned tok = (unsigned)(u.t0 * BM + ai * HALF + wr * 64 + m * 16 + fr);
                    const u32x2 xw = xq[ai][m]; const float xv[4] = {bf_lo(xw.x), bf_hi(xw.x), bf_lo(xw.y), bf_hi(xw.y)};
                    f32x4 lv, uv;
#pragma unroll
                    for (int j = 0; j < 4; ++j) { const float r = sigmoidf_(acc[ai][0][m][n][j] + vba[j]), ig = sigmoidf_(acc[ai][1][m][n][j] + vbx[j]);
                        const float la = c8[j] * r, av = __expf(la); lv[j] = la; uv[j] = __builtin_amdgcn_sqrtf(fmaxf(0.f, 1.0f - av * av)) * ig * xv[j]; }
                    const unsigned o = rg_idx(tok, c);
                    u32x2 w0; w0.x = cvt_pk_bf16(lv[0], lv[1]); w0.y = cvt_pk_bf16(lv[2], lv[3]); *(u32x2*)(LAo + o) = w0;
                    u32x2 w1; w1.x = cvt_pk_bf16(uv[0], uv[1]); w1.y = cvt_pk_bf16(uv[2], uv[3]); *(u32x2*)(Uo + o) = w1; } }
    }
};


__device__ __forceinline__ void transpose_job8(const float* src, unsigned char* dst, int K, int N, int ldd, size_t sb, size_t db, int nbatch, LAS unsigned char* lds) {
    const int tid = TIDX, tk = K / 128, tn = N / 64, per = tk * tn, total = per * nbatch;
    const int rr0 = tid >> 4, c4 = (tid & 15) * 4, n = tid >> 3, kg = (tid & 7) * 16;
    f32x4 va[4], vb[4];
#define T8_LD(v, t) { const int u_ = (t), ub_ = u_ / per, ur_ = u_ % per, uik_ = ur_ / tn, uin_ = ur_ % tn; const float* usp_ = src + (size_t)ub_ * sb + (size_t)(uik_ * 128 + rr0) * N + uin_ * 64 + c4; \
        _Pragma("unroll") for (int i = 0; i < 4; ++i) v[i] = *(const f32x4*)(usp_ + (size_t)(i * 32) * N); }
#define T8_ST(v, t, buf) { const int t_ = (t), b_ = t_ / per, r_ = t_ % per, ik_ = r_ / tn, in_ = r_ % tn; LAS float* tile = (LAS float*)(lds + (buf) * (128 * 65 * 4)); \
        _Pragma("unroll") for (int i = 0; i < 4; ++i) { const int rr = rr0 + i * 32; tile[rr * 65 + c4 + 0] = v[i][0]; tile[rr * 65 + c4 + 1] = v[i][1]; tile[rr * 65 + c4 + 2] = v[i][2]; tile[rr * 65 + c4 + 3] = v[i][3]; } \
        if (t_ + 2 * NBLK < total) T8_LD(v, t_ + 2 * NBLK) \
        LDS_BARRIER(); \
        float f[16]; \
        _Pragma("unroll") for (int j = 0; j < 16; ++j) f[j] = tile[(kg + j) * 65 + n] * W8_SCALE; \
        u32x4 w; w.x = pk_fp8x4(f[0], f[1], f[2], f[3]); w.y = pk_fp8x4(f[4], f[5], f[6], f[7]); w.z = pk_fp8x4(f[8], f[9], f[10], f[11]); w.w = pk_fp8x4(f[12], f[13], f[14], f[15]); \
        *(u32x4*)(dst + (size_t)b_ * db + (size_t)(in_ * 64 + n) * ldd + ik_ * 128 + kg) = w; }
    int t = BID;
    if (t < total) T8_LD(va, t)
    if (t + NBLK < total) T8_LD(vb, t + NBLK)
    for (; t < total; t += 2 * NBLK) {
        T8_ST(va, t, 0)
        if (t + NBLK < total) T8_ST(vb, t + NBLK, 1)
    }
#undef T8_LD
#undef T8_ST
    LDS_BARRIER();
}
__device__ __forceinline__ void transpose_job(const float* src, bf16_t* dst, int K, int N, int ldd, size_t sb, size_t db, int dalt, int nbatch, LAS unsigned char* lds) {
    const int tid = TIDX, tk = K / 64, tn = N / 64, per = tk * tn, total = per * nbatch;
    const int rr0 = tid >> 4, c4 = (tid & 15) * 4, n = tid >> 3, kg = (tid & 7) * 8;
    f32x4 va[2], vb[2];
#define T16_LD(v, t) { const int u_ = (t), ub_ = u_ / per, ur_ = u_ % per, uik_ = ur_ / tn, uin_ = ur_ % tn; const float* usp_ = src + (size_t)ub_ * sb + (size_t)(uik_ * 64 + rr0) * N + uin_ * 64 + c4; \
        _Pragma("unroll") for (int i = 0; i < 2; ++i) v[i] = *(const f32x4*)(usp_ + (size_t)(i * 32) * N); }
#define T16_ST(v, t, buf) { const int t_ = (t), b_ = t_ / per, r_ = t_ % per, ik_ = r_ / tn, in_ = r_ % tn; LAS float* tile = (LAS float*)(lds + (buf) * (64 * 65 * 4)); \
        _Pragma("unroll") for (int i = 0; i < 2; ++i) { const int rr = rr0 + i * 32; tile[rr * 65 + c4 + 0] = v[i][0]; tile[rr * 65 + c4 + 1] = v[i][1]; tile[rr * 65 + c4 + 2] = v[i][2]; tile[rr * 65 + c4 + 3] = v[i][3]; } \
        if (t_ + 2 * NBLK < total) T16_LD(v, t_ + 2 * NBLK) \
        LDS_BARRIER(); \
        float f[8]; \
        _Pragma("unroll") for (int j = 0; j < 8; ++j) f[j] = tile[(kg + j) * 65 + n]; \
        u32x4 w; w.x = cvt_pk_bf16(f[0], f[1]); w.y = cvt_pk_bf16(f[2], f[3]); w.z = cvt_pk_bf16(f[4], f[5]); w.w = cvt_pk_bf16(f[6], f[7]); \
        *(u32x4*)(dst + (size_t)b_ * db + (size_t)(b_ & 1) * dalt + (size_t)(in_ * 64 + n) * ldd + ik_ * 64 + kg) = w; }
    int t = BID;
    if (t < total) T16_LD(va, t)
    if (t + NBLK < total) T16_LD(vb, t + NBLK)
    for (; t < total; t += 2 * NBLK) {
        T16_ST(va, t, 0)
        if (t + NBLK < total) T16_ST(vb, t + NBLK, 1)
    }
#undef T16_LD
#undef T16_ST
    LDS_BARRIER();
}

__device__ __forceinline__ void moe_weight_jobs(const Args& a, int layer, LAS unsigned char* lds) {
    const size_t lo = (size_t)layer * NEXP * D_ * DEXP;
    transpose_job8(a.in[25] + lo, a.ws + WS_WG, D_, DEXP, D_, (size_t)D_ * DEXP, (size_t)DEXP * D_, NEXP, lds);
    transpose_job8(a.in[26] + lo, a.ws + WS_WU, D_, DEXP, D_, (size_t)D_ * DEXP, (size_t)DEXP * D_, NEXP, lds);
    transpose_job8(a.in[27] + lo, a.ws + WS_WD, DEXP, D_, DEXP, (size_t)D_ * DEXP, (size_t)DEXP * D_, NEXP, lds);
}

__device__ __forceinline__ void phase_prologue(const Args& a, LAS unsigned char* lds) {
    const int gtid = BID * NTHREADS + TIDX, gsz = NBLK * NTHREADS;
    for (int i = gtid; i < 1024; i += gsz) { const float l0 = a.in[12][i], l1 = a.in[12][1024 + i], mx = fmaxf(l0, l1), e0 = __expf(l0 - mx), e1 = __expf(l1 - mx);
        ((float*)(a.ws + WS_LB))[i] = e0 / (e0 + e1); }
    for (int it = gtid; it < 2 * 256 * 256; it += gsz) { const int l = it >> 16, n = (it >> 8) & 255, k8 = (it & 255) * 8; float f[8];
#pragma unroll
        for (int j = 0; j < 8; ++j) { const int k = k8 + j; f[j] = n < 8 ? a.in[21][((size_t)l * D_ + k) * 8 + n] : (n < 72 ? a.in[23][((size_t)l * D_ + k) * 64 + (n - 8)] : 0.f); }
        u32x4 w; w.x = cvt_pk_bf16(f[0], f[1]); w.y = cvt_pk_bf16(f[2], f[3]); w.z = cvt_pk_bf16(f[4], f[5]); w.w = cvt_pk_bf16(f[6], f[7]);
        *(u32x4*)((bf16_t*)(a.ws + WS_WRT) + ((size_t)l * 256 + n) * D_ + k8) = w; }
    for (int it = gtid; it < 192 * 128; it += gsz) *(u32x4*)(a.ws + WS_WIN1T + (size_t)N_IN1 * D_ + (size_t)it * 16) = (u32x4){0u, 0u, 0u, 0u};
    transpose_job(a.in[4], (bf16_t*)(a.ws + WS_WIN0T), D_, N_IN0, D_, 0, 0, 0, 1, lds);
    transpose_job(a.in[14], (bf16_t*)(a.ws + WS_WOUT0T), D_, D_, D_, 0, 0, 0, 1, lds);
    transpose_job8(a.in[15], a.ws + WS_WIN1T, D_, N_IN1, D_, 0, 0, 1, lds);
    transpose_job8(a.in[20], a.ws + WS_WOUT1T, 4096, D_, 4096, 0, 0, 1, lds);
    transpose_job(a.in[7], (bf16_t*)(a.ws + WS_WGATES), 128, 128, 128, 128 * 128, 256 * 128, 0, 8, lds);
    transpose_job(a.in[9], (bf16_t*)(a.ws + WS_WGATES) + 128 * 128, 128, 128, 128, 128 * 128, 256 * 128, 0, 8, lds);
    moe_weight_jobs(a, 0, lds);
}

#define NORM_PH(M, F) phase_norm<M, F>
template <int MODE, bool F32>
__device__ __forceinline__ void phase_norm(const Args& a, const float* src, const float* gain, int layer) {
    const int wid = TIDX >> 6, lane = TIDX & 63;
    bf16_t* xw = (bf16_t*)(a.ws + WS_X); bf16_t* hw = (bf16_t*)(a.ws + WS_H);
    const unsigned char* ym = a.ws + WS_YMOE; const int* posof = (const int*)(a.ws + WS_POSOF); const float* gate = (const float*)(a.ws + WS_GATE);
    const int stride = NBLK * 16;
    f32x4 rf[2][8]; u32x2 rb[2][8]; int pp[2][2] = {{0, 0}, {0, 0}}; float pg[2][2] = {{0.f, 0.f}, {0.f, 0.f}};
#define NORM_LD(r) { _Pragma("unroll") for (int u = 0; u < 2; ++u) { _Pragma("unroll") for (int i = 0; i < 8; ++i) { \
            if (F32) rf[u][i] = *(const f32x4*)(src + (size_t)((r) + u) * D_ + (i * 64 + lane) * 4); else rb[u][i] = *(const u32x2*)(xw + (size_t)((r) + u) * D_ + (i * 64 + lane) * 4); } \
            if (MODE >= 1) { pp[u][0] = posof[((r) + u) * 2]; pp[u][1] = posof[((r) + u) * 2 + 1]; pg[u][0] = gate[((r) + u) * 2]; pg[u][1] = gate[((r) + u) * 2 + 1]; } } }
    int row = (BID * 8 + wid) * 2;
    if (row < T_) NORM_LD(row)
    for (; row < T_; row += stride) {
        f32x4 v[2][8]; int p[2][2]; float g[2][2];
#pragma unroll
        for (int u = 0; u < 2; ++u) { p[u][0] = pp[u][0]; p[u][1] = pp[u][1]; g[u][0] = pg[u][0]; g[u][1] = pg[u][1];
#pragma unroll
            for (int i = 0; i < 8; ++i) v[u][i] = F32 ? rf[u][i] : (f32x4){bf_lo(rb[u][i].x), bf_hi(rb[u][i].x), bf_lo(rb[u][i].y), bf_hi(rb[u][i].y)}; }
        if (row + stride < T_) NORM_LD(row + stride)
        if (MODE >= 1) {
            int y[2][8][2];
#pragma unroll
            for (int u = 0; u < 2; ++u) {
#pragma unroll
                for (int i = 0; i < 8; ++i) { const int c = (i * 64 + lane) * 4; y[u][i][0] = *(const int*)(ym + (size_t)p[u][0] * D_ + c); y[u][i][1] = *(const int*)(ym + (size_t)p[u][1] * D_ + c); } }
#pragma unroll
            for (int u = 0; u < 2; ++u) { const float g0 = g[u][0], g1 = g[u][1];
#pragma unroll
                for (int i = 0; i < 8; ++i) { const int y0 = y[u][i][0], y1 = y[u][i][1];
                    const f32x2 a0 = __builtin_amdgcn_cvt_pk_f32_fp8(y0, false), a1 = __builtin_amdgcn_cvt_pk_f32_fp8(y0, true), b0 = __builtin_amdgcn_cvt_pk_f32_fp8(y1, false), b1 = __builtin_amdgcn_cvt_pk_f32_fp8(y1, true);
                    v[u][i][0] += g0 * a0[0] + g1 * b0[0]; v[u][i][1] += g0 * a0[1] + g1 * b0[1]; v[u][i][2] += g0 * a1[0] + g1 * b1[0]; v[u][i][3] += g0 * a1[1] + g1 * b1[1]; }
                if (MODE == 1) {
#pragma unroll
                    for (int i = 0; i < 8; ++i) { u32x2 w; w.x = cvt_pk_bf16(v[u][i][0], v[u][i][1]); w.y = cvt_pk_bf16(v[u][i][2], v[u][i][3]); *(u32x2*)(xw + (size_t)(row + u) * D_ + (i * 64 + lane) * 4) = w; } } }
        }
#pragma unroll
        for (int u = 0; u < 2; ++u) {
            float ss = 0.f;
#pragma unroll
            for (int i = 0; i < 8; ++i) ss += v[u][i][0] * v[u][i][0] + v[u][i][1] * v[u][i][1] + v[u][i][2] * v[u][i][2] + v[u][i][3] * v[u][i][3];
            ss = wave_sum(ss);
            const float rstd = rsqrtf(ss * (1.0f / D_) + 1e-6f);
#pragma unroll
            for (int i = 0; i < 8; ++i) { const int c = (i * 64 + lane) * 4; const f32x4 gn = *(const f32x4*)(gain + c);
                const f32x4 o = v[u][i] * rstd * gn;
                if (MODE == 2) *(f32x4*)(a.out + (size_t)(row + u) * D_ + c) = o;
                else { if (MODE != 1) { u32x2 w; w.x = cvt_pk_bf16(o[0], o[1]); w.y = cvt_pk_bf16(o[2], o[3]); *(u32x2*)(hw + (size_t)(row + u) * D_ + c) = w; }
                       if (layer >= 0) *(unsigned*)(a.ws + WS_H8 + (size_t)(row + u) * D_ + c) = pk_fp8x4(o[0], o[1], o[2], o[3]); } } }
    }
#undef NORM_LD
    (void)layer;
}

__device__ __forceinline__ void phase_gemm_in0(const Args& a, LAS unsigned char* lds) {
    SrcGrid S{(const char*)(a.ws + WS_H), (const char*)(a.ws + WS_WIN0T), (size_t)BM * D_ * 2, (size_t)BM * D_ * 2, 64, 64 * 24, D_, D_};
    EpiProj E{(bf16_t*)(a.ws + WS_PROJ), N_IN0, (float*)(a.ws + WS_FLOG), 1024, 12, 16, 256, 1.0f};
    gemm_stream<false, false>(lds, S, D_ / BK, E);
}

__device__ __forceinline__ void phase_rg_conv(const Args& a) {
    const bf16_t* p0 = (const bf16_t*)(a.ws + WS_PROJ); bf16_t* xc = (bf16_t*)(a.ws + WS_XC);
    const float* cw = a.in[5]; const float* cb = a.in[6];
    for (int it = BID * NTHREADS + TIDX; it < 128 * (T_ / 16); it += NBLK * NTHREADS) { const int c = (it & 127) * 8; const size_t t0 = (size_t)(it >> 7) * 16;
        float w[4][8], bias[8];
#pragma unroll
        for (int k = 0; k < 4; ++k) { const f32x4 w0 = *(const f32x4*)(cw + k * 1024 + c), w1 = *(const f32x4*)(cw + k * 1024 + c + 4);
            w[k][0] = w0[0]; w[k][1] = w0[1]; w[k][2] = w0[2]; w[k][3] = w0[3]; w[k][4] = w1[0]; w[k][5] = w1[1]; w[k][6] = w1[2]; w[k][7] = w1[3]; }
        { const f32x4 b0 = *(const f32x4*)(cb + c), b1 = *(const f32x4*)(cb + c + 4); bias[0] = b0[0]; bias[1] = b0[1]; bias[2] = b0[2]; bias[3] = b0[3]; bias[4] = b1[0]; bias[5] = b1[1]; bias[6] = b1[2]; bias[7] = b1[3]; }
        u32x4 x0 = (u32x4){0u, 0u, 0u, 0u}, x1 = x0, x2 = x0;
        if ((t0 & (S_ - 1)) != 0) { x0 = *(const u32x4*)(p0 + (t0 - 3) * N_IN0 + c); x1 = *(const u32x4*)(p0 + (t0 - 2) * N_IN0 + c); x2 = *(const u32x4*)(p0 + (t0 - 1) * N_IN0 + c); }
        u32x4 xr[16];
#pragma unroll
        for (int r = 0; r < 16; ++r) xr[r] = *(const u32x4*)(p0 + (t0 + r) * N_IN0 + c);
#pragma unroll
        for (int r = 0; r < 16; ++r) { const u32x4 x3 = xr[r];
            float acc[8];
#define TAPS(j, f, m) (bias[j] + w[0][j] * f(x0.m) + w[1][j] * f(x1.m) + w[2][j] * f(x2.m) + w[3][j] * f(x3.m))
            acc[0] = TAPS(0, bf_lo, x); acc[1] = TAPS(1, bf_hi, x); acc[2] = TAPS(2, bf_lo, y); acc[3] = TAPS(3, bf_hi, y);
            acc[4] = TAPS(4, bf_lo, z); acc[5] = TAPS(5, bf_hi, z); acc[6] = TAPS(6, bf_lo, w); acc[7] = TAPS(7, bf_hi, w);
#undef TAPS
            u32x4 o; o.x = cvt_pk_bf16(acc[0], acc[1]); o.y = cvt_pk_bf16(acc[2], acc[3]); o.z = cvt_pk_bf16(acc[4], acc[5]); o.w = cvt_pk_bf16(acc[6], acc[7]);
            *(u32x4*)(xc + (t0 + r) * 1024 + c) = o;
            x0 = x1; x1 = x2; x2 = x3; } }
}

struct SrcRgGates {
    const char* xc; const char* w; int total;
    __device__ __forceinline__ bool next(int i, UnitD& u) const { const int id = BID + i * NBLK; if (id >= total) return false; u.t0 = id & 63; u.t1 = id >> 6; u.t2 = 0;
        u.gA = xc + ((size_t)u.t0 * BM * 1024 + u.t1 * 128) * 2; u.gB = w + (size_t)u.t1 * 256 * 128 * 2; return true; }
    __device__ __forceinline__ void va(const UnitD&, unsigned (&v)[2][2]) const { offs_direct(v, 1024, false); }
    __device__ __forceinline__ void vb(unsigned (&v)[2][2]) const { offs_direct(v, 128, true); }
};
__device__ __forceinline__ void phase_rg_gates(const Args& a, LAS unsigned char* lds) {
    SrcRgGates S{(const char*)(a.ws + WS_XC), (const char*)(a.ws + WS_WGATES), 64 * 8};
    EpiRgGates E{(bf16_t*)(a.ws + WS_A), (bf16_t*)(a.ws + WS_U), (const bf16_t*)(a.ws + WS_XC), a.in[8], a.in[10], a.in[11]};
    int nt = 2; asm volatile("" : "+s"(nt));
    gemm_stream<false, false>(lds, S, nt, E);
}

__device__ __forceinline__ void phase_rg_scan(const Args& a, LAS unsigned char* lds) {
    const bf16_t* LA = (const bf16_t*)(a.ws + WS_A); const bf16_t* U = (const bf16_t*)(a.ws + WS_U);
    const bf16_t* p0 = (const bf16_t*)(a.ws + WS_PROJ); bf16_t* Y = (bf16_t*)(a.ws + WS_Y);
    LAS float* sP = (LAS float*)lds; LAS float* sH = sP + 4096; LAS float* gP = sH + 4096; LAS float* gH = gP + 512; LAS float* gC = gH + 512;
    const int tid = TIDX, seg = tid >> 1, c8 = (tid & 1) * 8;
    for (int blk = BID; blk < NB_ * 64; blk += NBLK) { const int b = blk >> 6, c = (blk & 63) * 16 + c8;
        const size_t base = (((size_t)blk * S_ + seg * 16) << 4) + c8;
        float P[8], H[8];
#pragma unroll
        for (int j = 0; j < 8; ++j) { P[j] = 1.f; H[j] = 0.f; }
#pragma unroll 4
        for (int s = 0; s < 16; ++s) { const u32x4 lw = *(const u32x4*)(LA + base + (size_t)s * 16), uw = *(const u32x4*)(U + base + (size_t)s * 16);
            const float la[8] = {bf_lo(lw.x), bf_hi(lw.x), bf_lo(lw.y), bf_hi(lw.y), bf_lo(lw.z), bf_hi(lw.z), bf_lo(lw.w), bf_hi(lw.w)};
            const float uu[8] = {bf_lo(uw.x), bf_hi(uw.x), bf_lo(uw.y), bf_hi(uw.y), bf_lo(uw.z), bf_hi(uw.z), bf_lo(uw.w), bf_hi(uw.w)};
#pragma unroll
            for (int j = 0; j < 8; ++j) { const float av = __expf(la[j]); H[j] = av * H[j] + uu[j]; P[j] *= av; } }
        __syncthreads();
#pragma unroll
        for (int j = 0; j < 8; ++j) { sP[seg * 16 + c8 + j] = P[j]; sH[seg * 16 + c8 + j] = H[j]; }
        __syncthreads();
        { const int ch = tid & 15, grp = tid >> 4; float p = 1.f, h = 0.f;
#pragma unroll
          for (int q = 0; q < 8; ++q) { const int sgi = grp * 8 + q; h = sP[sgi * 16 + ch] * h + sH[sgi * 16 + ch]; p *= sP[sgi * 16 + ch]; }
          gP[grp * 16 + ch] = p; gH[grp * 16 + ch] = h; }
        __syncthreads();
        if (tid < 16) { float carry = 0.f; for (int g = 0; g < 32; ++g) { gC[g * 16 + tid] = carry; carry = gP[g * 16 + tid] * carry + gH[g * 16 + tid]; } }
        __syncthreads();
        { const int ch = tid & 15, grp = tid >> 4; float h = gC[grp * 16 + ch];
#pragma unroll
          for (int q = 0; q < 8; ++q) { const int sgi = grp * 8 + q; const float pin = sP[sgi * 16 + ch], hin = sH[sgi * 16 + ch]; sH[sgi * 16 + ch] = h; h = pin * h + hin; } }
        __syncthreads();
#pragma unroll
        for (int j = 0; j < 8; ++j) H[j] = sH[seg * 16 + c8 + j];
        {
            u32x4 l_a[4], u_a[4], g_a[4];
#define RS_LD(Lv, Uv, Gv, s0) { _Pragma("unroll") for (int j = 0; j < 4; ++j) { const int s_ = (s0) + j; Lv[j] = *(const u32x4*)(LA + base + (size_t)s_ * 16); Uv[j] = *(const u32x4*)(U + base + (size_t)s_ * 16); \
                Gv[j] = *(const u32x4*)(p0 + ((size_t)b * S_ + seg * 16 + s_) * N_IN0 + 1024 + c); } }
            RS_LD(l_a, u_a, g_a, 0)
#pragma unroll
            for (int s0 = 0; s0 < 16; s0 += 4) { u32x4 l_b[4], u_b[4], g_b[4];
#pragma unroll
                for (int j = 0; j < 4; ++j) { l_b[j] = l_a[j]; u_b[j] = u_a[j]; g_b[j] = g_a[j]; }
                if (s0 + 4 < 16) RS_LD(l_b, u_b, g_b, s0 + 4)
#pragma unroll
                for (int j = 0; j < 4; ++j) { const u32x4 lw = l_a[j], uw = u_a[j], gw = g_a[j]; const size_t t = (size_t)b * S_ + seg * 16 + s0 + j;
                    const float la[8] = {bf_lo(lw.x), bf_hi(lw.x), bf_lo(lw.y), bf_hi(lw.y), bf_lo(lw.z), bf_hi(lw.z), bf_lo(lw.w), bf_hi(lw.w)};
                    const float uu[8] = {bf_lo(uw.x), bf_hi(uw.x), bf_lo(uw.y), bf_hi(uw.y), bf_lo(uw.z), bf_hi(uw.z), bf_lo(uw.w), bf_hi(uw.w)};
                    const float gg[8] = {bf_lo(gw.x), bf_hi(gw.x), bf_lo(gw.y), bf_hi(gw.y), bf_lo(gw.z), bf_hi(gw.z), bf_lo(gw.w), bf_hi(gw.w)};
                    float y[8];
#pragma unroll
                    for (int q = 0; q < 8; ++q) { H[q] = __expf(la[q]) * H[q] + uu[q]; y[q] = H[q] * gelu_tanh(gg[q]); }
                    u32x4 o; o.x = cvt_pk_bf16(y[0], y[1]); o.y = cvt_pk_bf16(y[2], y[3]); o.z = cvt_pk_bf16(y[4], y[5]); o.w = cvt_pk_bf16(y[6], y[7]);
                    *(u32x4*)(Y + t * D_ + c) = o; }
#pragma unroll
                for (int j = 0; j < 4; ++j) { l_a[j] = l_b[j]; u_a[j] = u_b[j]; g_a[j] = g_b[j]; } }
#undef RS_LD
        }
    }
}

typedef short s16x4 __attribute__((ext_vector_type(4)));
__device__ __forceinline__ f32x4 mfma32(bf16x8 a, bf16x8 b, f32x4 c) { return __builtin_amdgcn_mfma_f32_16x16x32_bf16(a, b, c, 0, 0, 0); }
__device__ __forceinline__ bf16x8 lds_frag(LAS const unsigned char* p) { return *(const LAS bf16x8*)p; }
__device__ __forceinline__ s16x4 lds_tr4(LAS const unsigned char* p) { return __builtin_amdgcn_ds_read_tr16_b64_v4i16((LAS s16x4*)p); }
__device__ __forceinline__ bf16x8 lds_tr8(LAS const unsigned char* p, int rowskip_bytes) {
    const s16x4 lo = lds_tr4(p), hi = lds_tr4(p + rowskip_bytes); return __builtin_shufflevector(lo, hi, 0, 1, 2, 3, 4, 5, 6, 7); }
__device__ __forceinline__ bf16x8 pack8(const f32x4& lo, const f32x4& hi) { u32x4 w; w.x = cvt_pk_bf16(lo[0], lo[1]); w.y = cvt_pk_bf16(lo[2], lo[3]); w.z = cvt_pk_bf16(hi[0], hi[1]); w.w = cvt_pk_bf16(hi[2], hi[3]); return __builtin_bit_cast(bf16x8, w); }
constexpr int RSB = 272;

constexpr size_t WS_HQ = WS_O;
constexpr size_t WS_HA = WS_HQ + (size_t)2048 * 64 * 128 * 2;
constexpr size_t WS_HG = WS_HA + (size_t)2048 * 8 * 512 * 2;
constexpr size_t WS_HS = WS_HG + (size_t)2048 * 128 * 128 * 2;
constexpr size_t WS_HD = WS_HS + (size_t)2048 * 128 * 128 * 2;
static_assert(WS_HD + (size_t)2048 * 128 * 4 <= WS_TAIL, "hgrn overlay");

__device__ __forceinline__ void phase_hg1(const Args& a, LAS unsigned char* lds) {
    const bf16_t* p0 = (const bf16_t*)(a.ws + WS_PROJ); const float* flog = (const float*)(a.ws + WS_FLOG); const float* lb = (const float*)(a.ws + WS_LB);
    bf16_t* QG = (bf16_t*)(a.ws + WS_HQ); bf16_t* AG = (bf16_t*)(a.ws + WS_HA); bf16_t* GG = (bf16_t*)(a.ws + WS_HG); float* DG = (float*)(a.ws + WS_HD);
    constexpr int SEG = 0, QT = 4096, KT = QT + 64 * RSB, KH = KT + 64 * RSB, VS = KH + 64 * RSB;
    const int tid = TIDX, wid = tid >> 6, lane = tid & 63, I = lane & 15, G = lane >> 4, k2 = 2 * lane, sg = wid;
    LAS float* seg = (LAS float*)(lds + SEG);
    u32x4 pvv[2]; f32x2 pz[8]; unsigned pqw[8];
#define HG1_LOAD(it_) do { const int bh_ = (it_) >> 6, ck_ = (it_) & 63, h_ = bh_ & 7; const size_t t0_ = (size_t)(bh_ >> 3) * S_ + ck_ * 64; \
        _Pragma("unroll") for (int i = 0; i < 2; ++i) { const int c = tid + i * 512, s_ = c >> 4, v8 = (c & 15) * 8; pvv[i] = *(const u32x4*)(p0 + (t0_ + s_) * N_IN0 + 4096 + h_ * 128 + v8); } \
        _Pragma("unroll") for (int i = 0; i < 8; ++i) { const size_t t_ = t0_ + sg * 8 + i; pz[i] = *(const f32x2*)(flog + t_ * 1024 + h_ * 128 + k2); pqw[i] = *(const unsigned*)(p0 + t_ * N_IN0 + 2048 + h_ * 128 + k2); } } while (0)
    if (BID < 2048) HG1_LOAD(BID);
    for (int item = BID; item < 2048; item += NBLK) { const int bh = item >> 6, h = bh & 7;
        LDS_BARRIER();
#pragma unroll
        for (int i = 0; i < 2; ++i) { const int c = tid + i * 512, s = c >> 4, v8 = (c & 15) * 8; *(LAS u32x4*)(lds + VS + s * RSB + v8 * 2) = pvv[i]; }
        const f32x2 l2 = *(const f32x2*)(lb + h * 128 + k2);
        float f[8][2], cb[8][2]; unsigned qw[8]; float c0 = 0.f, c1 = 0.f;
#pragma unroll
        for (int i = 0; i < 8; ++i) { const f32x2 z = pz[i]; qw[i] = pqw[i];
            f[i][0] = l2[0] + (1.0f - l2[0]) * sigmoidf_(z[0]); f[i][1] = l2[1] + (1.0f - l2[1]) * sigmoidf_(z[1]);
            c0 += __logf(f[i][0]); c1 += __logf(f[i][1]); cb[i][0] = c0; cb[i][1] = c1; }
        *(LAS f32x2*)(seg + sg * 128 + k2) = (f32x2){c0, c1};
        if (item + NBLK < 2048) HG1_LOAD(item + NBLK);
        LDS_BARRIER();
        float off0 = 0.f, off1 = 0.f, tot0 = 0.f, tot1 = 0.f;
#pragma unroll
        for (int s2 = 0; s2 < 8; ++s2) { const f32x2 v = *(const LAS f32x2*)(seg + s2 * 128 + k2); tot0 += v[0]; tot1 += v[1]; if (s2 < sg) { off0 += v[0]; off1 += v[1]; } }
        const float et0 = __expf(tot0), et1 = __expf(tot1);
#pragma unroll
        for (int i = 0; i < 8; ++i) { const int t = sg * 8 + i;
            const float e0 = __expf(cb[i][0] + off0), e1 = __expf(cb[i][1] + off1), r0 = __builtin_amdgcn_rcpf(e0), r1 = __builtin_amdgcn_rcpf(e1), km0 = 1.0f - f[i][0], km1 = 1.0f - f[i][1];
            const unsigned qt = cvt_pk_bf16(siluf_(bf_lo(qw[i])) * e0, siluf_(bf_hi(qw[i])) * e1);
            *(LAS unsigned*)(lds + QT + t * RSB + k2 * 2) = qt; *(unsigned*)(QG + ((size_t)item * 64 + t) * 128 + k2) = qt;
            *(LAS unsigned*)(lds + KT + t * RSB + k2 * 2) = cvt_pk_bf16(km0 * r0, km1 * r1);
            *(LAS unsigned*)(lds + KH + t * RSB + k2 * 2) = cvt_pk_bf16(km0 * r0 * et0, km1 * r1 * et1); }
        if (sg == 0) *(f32x2*)(DG + (size_t)item * 128 + k2) = (f32x2){et0, et1};
        LDS_BARRIER();
        { const int tt = wid & 3, sp = wid >> 2;
          bf16x8 qf[4];
#pragma unroll
          for (int ks = 0; ks < 4; ++ks) qf[ks] = lds_frag(lds + QT + (16 * tt + I) * RSB + (32 * ks + 8 * G) * 2);
          f32x4 acc[2];
#pragma unroll
          for (int hh = 0; hh < 2; ++hh) { const int st = 2 * sp + hh; acc[hh] = (f32x4){0.f, 0.f, 0.f, 0.f};
              if (st <= tt) {
#pragma unroll
                  for (int ks = 0; ks < 4; ++ks) acc[hh] = mfma32(lds_frag(lds + KT + (16 * st + I) * RSB + (32 * ks + 8 * G) * 2), qf[ks], acc[hh]);
#pragma unroll
                  for (int r = 0; r < 4; ++r) if (16 * st + 4 * G + r > 16 * tt + I) acc[hh][r] = 0.f; } }
          *(bf16x8*)(AG + (((size_t)item * 4 + tt) * 2 + sp) * 512 + lane * 8) = pack8(acc[0], acc[1]); }
        { const int kt = wid, q = I >> 2, p = I & 3;
          bf16x8 ka[2];
#pragma unroll
          for (int ks = 0; ks < 2; ++ks) ka[ks] = lds_tr8(lds + KH + (32 * ks + 8 * G + q) * RSB + (16 * kt + 4 * p) * 2, 4 * RSB);
#pragma unroll
          for (int vt = 0; vt < 8; ++vt) { f32x4 acc = (f32x4){0.f, 0.f, 0.f, 0.f};
#pragma unroll
              for (int ks = 0; ks < 2; ++ks) acc = mfma32(ka[ks], lds_tr8(lds + VS + (32 * ks + 8 * G + q) * RSB + (16 * vt + 4 * p) * 2, 4 * RSB), acc);
              u32x2 w; w.x = cvt_pk_bf16(acc[0], acc[1]); w.y = cvt_pk_bf16(acc[2], acc[3]);
              *(u32x2*)(GG + ((size_t)item * 128 + 16 * vt + I) * 128 + 16 * kt + 4 * G) = w; } }
    }
#undef HG1_LOAD
}

__device__ __forceinline__ void phase_hg2(const Args& a) {
    const bf16_t* GG = (const bf16_t*)(a.ws + WS_HG); const float* DG = (const float*)(a.ws + WS_HD); bf16_t* SG = (bf16_t*)(a.ws + WS_HS);
    for (int gid = BID * NTHREADS + TIDX; gid < 32 * 4096; gid += NBLK * NTHREADS) { const int bh = gid >> 12, e = gid & 4095, v = e >> 5, k4 = (e & 31) * 4;
        f32x4 S = (f32x4){0.f, 0.f, 0.f, 0.f};
        const size_t o0 = (((size_t)bh * 64) * 128 + v) * 128 + k4; const float* dg = DG + (size_t)bh * 64 * 128 + k4;
        f32x4 da[8]; u32x2 ga[8];
#pragma unroll
        for (int j = 0; j < 8; ++j) { da[j] = *(const f32x4*)(dg + j * 128); ga[j] = *(const u32x2*)(GG + o0 + (size_t)j * 16384); }
#pragma unroll 1
        for (int n0 = 0; n0 < 64; n0 += 8) { f32x4 db[8]; u32x2 gb[8];
#pragma unroll
            for (int j = 0; j < 8; ++j) { db[j] = da[j]; gb[j] = ga[j]; }
            if (n0 + 8 < 64) {
#pragma unroll
                for (int j = 0; j < 8; ++j) { db[j] = *(const f32x4*)(dg + (n0 + 8 + j) * 128); gb[j] = *(const u32x2*)(GG + o0 + (size_t)(n0 + 8 + j) * 16384); } }
#pragma unroll
            for (int j = 0; j < 8; ++j) { u32x2 w; w.x = cvt_pk_bf16(S[0], S[1]); w.y = cvt_pk_bf16(S[2], S[3]); *(u32x2*)(SG + o0 + (size_t)(n0 + j) * 16384) = w;
                const f32x4 d = da[j]; const u32x2 g = ga[j];
                S[0] = d[0] * S[0] + bf_lo(g.x); S[1] = d[1] * S[1] + bf_hi(g.x); S[2] = d[2] * S[2] + bf_lo(g.y); S[3] = d[3] * S[3] + bf_hi(g.y); }
#pragma unroll
            for (int j = 0; j < 8; ++j) { da[j] = db[j]; ga[j] = gb[j]; } } }
}

__device__ __forceinline__ void phase_hg3(const Args& a, LAS unsigned char* lds) {
    const bf16_t* p0 = (const bf16_t*)(a.ws + WS_PROJ); const bf16_t* QG = (const bf16_t*)(a.ws + WS_HQ); const bf16_t* AG = (const bf16_t*)(a.ws + WS_HA); const bf16_t* SG = (const bf16_t*)(a.ws + WS_HS);
    bf16_t* Y = (bf16_t*)(a.ws + WS_Y); const float* gain = a.in[13];
    constexpr int ST = 0, QT = 128 * RSB, VS = QT + 64 * RSB, PART = VS + 64 * RSB;
    const int tid = TIDX, wid = tid >> 6, lane = tid & 63, I = lane & 15, G = lane >> 4, q = I >> 2, p = I & 3;
    LAS float* part = (LAS float*)(lds + PART);
    const int tt = wid & 3, vh = wid >> 2;
    u32x4 ps[4], pq2[2], pv2[2]; bf16x8 paf[2];
#define HG3_LOAD(it_) do { const int bh_ = (it_) >> 6, ck_ = (it_) & 63; const size_t t0_ = (size_t)(bh_ >> 3) * S_ + ck_ * 64; const int h_ = bh_ & 7; \
        _Pragma("unroll") for (int i = 0; i < 4; ++i) { const int c = tid + i * 512, v = c >> 4, k8 = (c & 15) * 8; ps[i] = *(const u32x4*)(SG + ((size_t)(it_) * 128 + v) * 128 + k8); } \
        _Pragma("unroll") for (int i = 0; i < 2; ++i) { const int c = tid + i * 512, s_ = c >> 4, c8 = (c & 15) * 8; pq2[i] = *(const u32x4*)(QG + ((size_t)(it_) * 64 + s_) * 128 + c8); pv2[i] = *(const u32x4*)(p0 + (t0_ + s_) * N_IN0 + 4096 + h_ * 128 + c8); } \
        _Pragma("unroll") for (int sp = 0; sp < 2; ++sp) paf[sp] = *(const bf16x8*)(AG + (((size_t)(it_) * 4 + tt) * 2 + sp) * 512 + lane * 8); } while (0)
    if (BID < 2048) HG3_LOAD(BID);
    for (int item = BID; item < 2048; item += NBLK) { const int bh = item >> 6, ck = item & 63, b = bh >> 3, h = bh & 7; const size_t t0 = (size_t)b * S_ + ck * 64;
        LDS_BARRIER();
#pragma unroll
        for (int i = 0; i < 4; ++i) { const int c = tid + i * 512, v = c >> 4, k8 = (c & 15) * 8; *(LAS u32x4*)(lds + ST + v * RSB + k8 * 2) = ps[i]; }
#pragma unroll
        for (int i = 0; i < 2; ++i) { const int c = tid + i * 512, s2 = c >> 4, c8 = (c & 15) * 8; *(LAS u32x4*)(lds + QT + s2 * RSB + c8 * 2) = pq2[i]; *(LAS u32x4*)(lds + VS + s2 * RSB + c8 * 2) = pv2[i]; }
        bf16x8 af[2]; af[0] = paf[0]; af[1] = paf[1];
        if (item + NBLK < 2048) HG3_LOAD(item + NBLK);
        u32x2 zwp[4];
#pragma unroll
        for (int vi = 0; vi < 4; ++vi) zwp[vi] = *(const u32x2*)(p0 + (t0 + 16 * tt + I) * N_IN0 + 5120 + h * 128 + 16 * (4 * vh + vi) + 4 * G);
        LDS_BARRIER();
        bf16x8 qf[4];
#pragma unroll
        for (int ks = 0; ks < 4; ++ks) qf[ks] = lds_frag(lds + QT + (16 * tt + I) * RSB + (32 * ks + 8 * G) * 2);
        f32x4 acc[4]; float ss = 0.f;
#pragma unroll
        for (int vi = 0; vi < 4; ++vi) { const int vt = 4 * vh + vi; acc[vi] = (f32x4){0.f, 0.f, 0.f, 0.f};
#pragma unroll
            for (int ks = 0; ks < 4; ++ks) acc[vi] = mfma32(lds_frag(lds + ST + (16 * vt + I) * RSB + (32 * ks + 8 * G) * 2), qf[ks], acc[vi]);
#pragma unroll
            for (int sp = 0; sp < 2; ++sp) acc[vi] = mfma32(lds_tr8(lds + VS + (32 * sp + 4 * G + q) * RSB + (16 * vt + 4 * p) * 2, 16 * RSB), af[sp], acc[vi]);
            ss += acc[vi][0] * acc[vi][0] + acc[vi][1] * acc[vi][1] + acc[vi][2] * acc[vi][2] + acc[vi][3] * acc[vi][3]; }
        ss += __shfl_xor(ss, 16); ss += __shfl_xor(ss, 32);
        if (G == 0) part[wid * 16 + I] = ss;
        LDS_BARRIER();
        const float rstd = rsqrtf((part[wid * 16 + I] + part[(wid ^ 4) * 16 + I]) * (1.0f / 128.0f) + 1e-6f);
        const size_t t = t0 + 16 * tt + I;
#pragma unroll
        for (int vi = 0; vi < 4; ++vi) { const int c = h * 128 + 16 * (4 * vh + vi) + 4 * G;
            const f32x4 gn = *(const f32x4*)(gain + c); const u32x2 zw = zwp[vi];
            const float o0 = acc[vi][0] * rstd * gn[0] * siluf_(bf_lo(zw.x)), o1 = acc[vi][1] * rstd * gn[1] * siluf_(bf_hi(zw.x)), o2 = acc[vi][2] * rstd * gn[2] * siluf_(bf_lo(zw.y)), o3 = acc[vi][3] * rstd * gn[3] * siluf_(bf_hi(zw.y));
            u32x2 w; w.x = cvt_pk_bf16(o0, o1); w.y = cvt_pk_bf16(o2, o3); *(u32x2*)(Y + t * D_ + 1024 + c) = w; }
    }
#undef HG3_LOAD
}

__device__ __forceinline__ void phase_gdn_norm(const Args& a) {
    const bf16_t* O = (const bf16_t*)(a.ws + WS_O); const bf16_t* pj = (const bf16_t*)(a.ws + WS_PROJ); unsigned char* Y = a.ws + WS_Y; const float* gain = a.in[19];
    const int lane = TIDX & 63, wid = TIDX >> 6, gc = (lane & 15) * 8;
    const f32x4 g0 = *(const f32x4*)(gain + gc), g1 = *(const f32x4*)(gain + gc + 4);
    u32x4 oa[8], za[8];
    int row = BID * 8 + wid; const int stride = NBLK * 8;
#define GN_LD(ov, zv, r) { _Pragma("unroll") for (int i = 0; i < 8; ++i) { const int c = (i * 64 + lane) * 8; ov[i] = *(const u32x4*)(O + (size_t)(r) * 4096 + c); zv[i] = *(const u32x4*)(pj + (size_t)(r) * N_IN1P + 8192 + c); } }
    if (row < T_) GN_LD(oa, za, row)
    for (; row < T_; row += stride) { u32x4 ob[8], zb[8];
#pragma unroll
        for (int i = 0; i < 8; ++i) { ob[i] = oa[i]; zb[i] = za[i]; }
        if (row + stride < T_) GN_LD(ob, zb, row + stride)
#pragma unroll
        for (int i = 0; i < 8; ++i) { const int c = (i * 64 + lane) * 8;
            const u32x4 ow = oa[i], zw = za[i];
            const float o[8] = {bf_lo(ow.x), bf_hi(ow.x), bf_lo(ow.y), bf_hi(ow.y), bf_lo(ow.z), bf_hi(ow.z), bf_lo(ow.w), bf_hi(ow.w)};
            const float z[8] = {bf_lo(zw.x), bf_hi(zw.x), bf_lo(zw.y), bf_hi(zw.y), bf_lo(zw.z), bf_hi(zw.z), bf_lo(zw.w), bf_hi(zw.w)};
            float ss = 0.f;
#pragma unroll
            for (int q = 0; q < 8; ++q) ss += o[q] * o[q];
            ss = row16_sum(ss);
            const float rstd = rsqrtf(ss * (1.0f / 128.0f) + 1e-6f);
            float y[8];
#pragma unroll
            for (int q = 0; q < 8; ++q) y[q] = o[q] * rstd * (q < 4 ? g0[q & 3] : g1[q & 3]) * siluf_(z[q]);
            u32x2 w; w.x = pk_fp8x4(y[0], y[1], y[2], y[3]); w.y = pk_fp8x4(y[4], y[5], y[6], y[7]);
            *(u32x2*)(Y + (size_t)row * 4096 + c) = w; }
#pragma unroll
        for (int i = 0; i < 8; ++i) { oa[i] = ob[i]; za[i] = zb[i]; }
    }
#undef GN_LD
}

template <bool FP8>
__device__ __forceinline__ void phase_gemm_out(const Args& a, LAS unsigned char* lds, int K, const void* w, const float* xin) {
    const int eb = FP8 ? 1 : 2;
    SrcGrid S{(const char*)(a.ws + WS_Y), (const char*)w, (size_t)BM * K * eb, (size_t)BM * K * eb, 64, 64 * 8, K * eb / 2, K * eb / 2};
    EpiResid E{(bf16_t*)(a.ws + WS_X), xin, (const bf16_t*)(a.ws + WS_X), FP8 ? 1.0f / W8_SCALE : 1.0f};
    gemm_stream<false, FP8>(lds, S, K * eb / 128, E);
}

struct SrcRouter {
    const char* h; const char* w;
    __device__ __forceinline__ bool next(int i, UnitD& u) const { const int id = BID + i * NBLK; if (id >= 256) return false; u.t0 = id & 63; u.t1 = id >> 6; u.t2 = 0;
        u.gA = h + ((size_t)u.t0 * BM * D_ + u.t1 * 512) * 2; u.gB = w + (size_t)u.t1 * 512 * 2; return true; }
    __device__ __forceinline__ void va(const UnitD&, unsigned (&v)[2][2]) const { offs_direct(v, D_, false); }
    __device__ __forceinline__ void vb(unsigned (&v)[2][2]) const { offs_direct(v, D_, true); }
};
struct EpiLogitsQ {
    float* O;
    __device__ __forceinline__ void operator()(const Acc& acc, const UnitD& u, int wr, int wc, int fr, int fq) const { store_f32_tile(acc, O + ((size_t)u.t1 * T_ + (size_t)u.t0 * BM) * 128, nullptr, 128, 128, wr, wc, fr, fq); }
};
__device__ __forceinline__ void phase_gemm_router(const Args& a, LAS unsigned char* lds, int layer) {
    SrcRouter S{(const char*)(a.ws + WS_H), (const char*)(a.ws + WS_WRT) + (size_t)layer * 256 * D_ * 2};
    EpiLogitsQ E{(float*)(a.ws + WS_O)};
    gemm_stream<false, false>(lds, S, 512 / BK, E);
}

__device__ __forceinline__ void phase_route(const Args& a, int layer) {
    const float* lg = (const float*)(a.ws + WS_O); const float* bg = a.in[22] + layer * 8; const float* be = a.in[24] + layer * 64;
    int* cnt = (int*)(a.ws + WS_CTL + CTL_CNT) + layer * 64;
    int* eid = (int*)(a.ws + WS_EID); int* slot = (int*)(a.ws + WS_SLOT); float* gate = (float*)(a.ws + WS_GATE); int* rowmap = (int*)(a.ws + WS_ROWMAP);
    const int gtid = BID * NTHREADS + TIDX, gsz = NBLK * NTHREADS;
    for (int i = gtid; i < MPAD; i += gsz) rowmap[i] = 0;
    for (int t = gtid; t < T_; t += gsz) {
        f32x4 ga = (f32x4){0.f, 0.f, 0.f, 0.f}, gb = ga;
#pragma unroll
        for (int kq = 0; kq < 4; ++kq) { ga += *(const f32x4*)(lg + ((size_t)kq * T_ + t) * 128); gb += *(const f32x4*)(lg + ((size_t)kq * T_ + t) * 128 + 4); }
        const float gl[8] = {ga[0] + bg[0], ga[1] + bg[1], ga[2] + bg[2], ga[3] + bg[3], gb[0] + bg[4], gb[1] + bg[5], gb[2] + bg[6], gb[3] + bg[7]};
        float mx = -3.0e38f; int gi = 0;
#pragma unroll
        for (int j = 0; j < 8; ++j) if (gl[j] > mx) { mx = gl[j]; gi = j; }
        float se = 0.f;
#pragma unroll
        for (int j = 0; j < 8; ++j) se += __expf(gl[j] - mx);
        const float gp = 1.0f / se;
        f32x4 ea = *(const f32x4*)(be + gi * 8), eb = *(const f32x4*)(be + gi * 8 + 4);
#pragma unroll
        for (int kq = 0; kq < 4; ++kq) { ea += *(const f32x4*)(lg + ((size_t)kq * T_ + t) * 128 + 8 + gi * 8); eb += *(const f32x4*)(lg + ((size_t)kq * T_ + t) * 128 + 12 + gi * 8); }
        const float el[8] = {ea[0], ea[1], ea[2], ea[3], eb[0], eb[1], eb[2], eb[3]};
        float l1 = -3.0e38f, l2 = -3.0e38f; int i1 = 0, i2 = 0;
#pragma unroll
        for (int j = 0; j < 8; ++j) { const float v = el[j];
            if (v > l1) { l2 = l1; i2 = i1; l1 = v; i1 = j; } else if (v > l2) { l2 = v; i2 = j; } }
        const float e2 = __expf(l2 - l1), inv = 1.0f / (1.0f + e2);
        const int e0 = gi * 8 + i1, e1 = gi * 8 + i2;
        eid[t * 2] = e0; eid[t * 2 + 1] = e1; gate[t * 2] = inv * gp; gate[t * 2 + 1] = e2 * inv * gp;
        slot[t * 2] = atomicAdd(&cnt[e0], 1); slot[t * 2 + 1] = atomicAdd(&cnt[e1], 1); }
}

__device__ __forceinline__ void phase_rowmap(const Args& a, LAS unsigned char* lds, int layer) {
    const int* cnt = (const int*)(a.ws + WS_CTL + CTL_CNT) + layer * 64; LAS int* ps = (LAS int*)lds;
    int* tinfo = (int*)(a.ws + WS_TINFO) + layer * 512;
    const int* eid = (const int*)(a.ws + WS_EID); const int* slot = (const int*)(a.ws + WS_SLOT); int* posof = (int*)(a.ws + WS_POSOF); int* rowmap = (int*)(a.ws + WS_ROWMAP);
    __syncthreads();
    if (TIDX == 0) { int acc = 0; for (int e = 0; e < 64; ++e) { ps[e] = acc; acc += (cnt[e] + 255) & ~255; } ps[64] = acc; }
    __syncthreads();
    if (BID == 0) { if (TIDX <= 64) tinfo[TIDX] = ps[TIDX]; if (TIDX == 65) tinfo[65] = ps[64] >> 8;
        if (TIDX < 192) { const int p = TIDX * 256; int e = 0; for (int j = 0; j < 64; ++j) if (ps[j + 1] <= p) e = j + 1; tinfo[128 + TIDX] = e < 64 ? e : 63; } }
    for (int i = BID * NTHREADS + TIDX; i < T_ * 2; i += NBLK * NTHREADS) { const int p = ps[eid[i]] + slot[i]; posof[i] = p; rowmap[p] = i >> 1; }
    __syncthreads();
}

struct SrcMoeUp {
    const char* h; const char* wg; const int* tinfo; const int* rowmap; int total;
    __device__ __forceinline__ bool next(int i, UnitD& u) const { const int id = BID + i * NBLK; if (id >= total) return false; u.t0 = id >> 2; u.t1 = id & 3;
        u.t2 = __builtin_amdgcn_readfirstlane(tinfo[128 + u.t0]); u.gA = h; u.gB = wg + ((size_t)u.t2 * DEXP + u.t1 * 128) * D_; return true; }
    __device__ __forceinline__ void va(const UnitD& u, unsigned (&v)[2][2]) const { int R0, C0; stage_pos(TIDX, R0, C0);
#pragma unroll
        for (int hh = 0; hh < 2; ++hh)
#pragma unroll
            for (int i = 0; i < 2; ++i) v[hh][i] = (unsigned)(rowmap[u.t0 * 256 + hh * 128 + R0 + 64 * i] * D_ + C0 * 2); }
    __device__ __forceinline__ void vb(unsigned (&v)[2][2]) const { int R0, C0; stage_pos(TIDX, R0, C0);
#pragma unroll
        for (int i = 0; i < 2; ++i) { const int Rr = perm_row(R0 + 64 * i); v[0][i] = (unsigned)(Rr * D_ + C0 * 2); v[1][i] = (unsigned)(WS_WU - WS_WG) + (unsigned)(Rr * D_ + C0 * 2); } }
};
__device__ __forceinline__ void phase_moe_up(const Args& a, LAS unsigned char* lds, int layer) {
    const int* tinfo = (const int*)(a.ws + WS_TINFO) + layer * 512;
    const int ntm = __builtin_amdgcn_readfirstlane(tinfo[65]);
    SrcMoeUp S{(const char*)(a.ws + WS_H8), (const char*)(a.ws + WS_WG), tinfo, (const int*)(a.ws + WS_ROWMAP), ntm * 4};
    EpiSwiGLU E{a.ws + WS_ACT};
    gemm_stream<true, true>(lds, S, D_ / 128, E);
}

struct SrcMoeDown {
    const char* act; const char* wd; const int* tinfo; int total;
    __device__ __forceinline__ bool next(int i, UnitD& u) const { const int id = BID + i * NBLK; if (id >= total) return false; u.t0 = id >> 3; u.t1 = id & 7;
        u.t2 = __builtin_amdgcn_readfirstlane(tinfo[128 + u.t0]); u.gA = act + (size_t)u.t0 * BM * DEXP; u.gB = wd + ((size_t)u.t2 * D_ + u.t1 * BM) * DEXP; return true; }
    __device__ __forceinline__ void va(const UnitD&, unsigned (&v)[2][2]) const { offs_direct(v, DEXP / 2, false); }
    __device__ __forceinline__ void vb(unsigned (&v)[2][2]) const { offs_direct(v, DEXP / 2, true); }
};
__device__ __forceinline__ void phase_moe_down(const Args& a, LAS unsigned char* lds, int layer) {
    const int* tinfo = (const int*)(a.ws + WS_TINFO) + layer * 512; const int ntm = __builtin_amdgcn_readfirstlane(tinfo[65]);
    SrcMoeDown S{(const char*)(a.ws + WS_ACT), (const char*)(a.ws + WS_WD), tinfo, ntm * 8};
    EpiDown E{a.ws + WS_YMOE};
    gemm_stream<false, true>(lds, S, DEXP / 128, E);
}

struct SrcIn1Tail {
    const char* h; const char* w;
    __device__ __forceinline__ bool next(int i, UnitD& u) const { const int id = BID + i * NBLK; if (id >= 256) return false; u.t0 = id & 63; u.t1 = id >> 6; u.t2 = 0;
        u.gA = h + (size_t)u.t0 * BM * D_ + u.t1 * 512; u.gB = w + (size_t)48 * BM * D_ + u.t1 * 512; return true; }
    __device__ __forceinline__ void va(const UnitD&, unsigned (&v)[2][2]) const { offs_direct(v, D_ / 2, false); }
    __device__ __forceinline__ void vb(unsigned (&v)[2][2]) const { offs_direct(v, D_ / 2, true); }
};
struct EpiTailQ {
    float* O;
    __device__ __forceinline__ void operator()(const Acc& acc, const UnitD& u, int wr, int wc, int fr, int fq) const { store_f32_tile(acc, O + ((size_t)u.t1 * T_ + (size_t)u.t0 * BM) * 64, nullptr, 64, 64, wr, wc, fr, fq, 1.0f / W8_SCALE); }
};
__device__ __forceinline__ void phase_gemm_in1(const Args& a, LAS unsigned char* lds) {
    SrcGrid S{(const char*)(a.ws + WS_H8), (const char*)(a.ws + WS_WIN1T), (size_t)BM * D_, (size_t)BM * D_, 64, 64 * 48, D_ / 2, D_ / 2};
    EpiProj E{(bf16_t*)(a.ws + WS_PROJ), N_IN1P, nullptr, 64, 48, 48, 64, 1.0f / W8_SCALE};
    gemm_stream<false, true>(lds, S, D_ / 128, E);
}
__device__ __forceinline__ void phase_gemm_in1_tail(const Args& a, LAS unsigned char* lds) {
    SrcIn1Tail S{(const char*)(a.ws + WS_H8), (const char*)(a.ws + WS_WIN1T)};
    EpiTailQ E{(float*)(a.ws + WS_O)};
    int nt = 4; asm volatile("" : "+s"(nt));
    gemm_stream<false, true>(lds, S, nt, E);
}

__device__ __forceinline__ void phase_gdn_conv(const Args& a) {
    const bf16_t* p1 = (const bf16_t*)(a.ws + WS_PROJ); bf16_t* qc = (bf16_t*)(a.ws + WS_QKVC); const float* cw = a.in[16];
    const int gtid = BID * NTHREADS + TIDX, gsz = NBLK * NTHREADS;
    for (int it = gtid; it < 1024 * (T_ / 128); it += gsz) { const int c = (it & 1023) * 8, seg = it >> 10; const size_t t0 = (size_t)seg * 128;
        float w[4][8];
#pragma unroll
        for (int k = 0; k < 4; ++k) { const f32x4 w0 = *(const f32x4*)(cw + k * 8192 + c), w1 = *(const f32x4*)(cw + k * 8192 + c + 4);
            w[k][0] = w0[0]; w[k][1] = w0[1]; w[k][2] = w0[2]; w[k][3] = w0[3]; w[k][4] = w1[0]; w[k][5] = w1[1]; w[k][6] = w1[2]; w[k][7] = w1[3]; }
        u32x4 x0 = (u32x4){0u, 0u, 0u, 0u}, x1 = x0, x2 = x0;
        if ((t0 & (S_ - 1)) != 0) { x0 = *(const u32x4*)(p1 + (t0 - 3) * N_IN1P + c); x1 = *(const u32x4*)(p1 + (t0 - 2) * N_IN1P + c); x2 = *(const u32x4*)(p1 + (t0 - 1) * N_IN1P + c); }
        const float qsc = c < 2048 ? 0.08838834764831845f : 1.0f;
        u32x4 xa[8];
#pragma unroll
        for (int j = 0; j < 8; ++j) xa[j] = *(const u32x4*)(p1 + (t0 + j) * N_IN1P + c);
#pragma unroll 1
        for (int r0 = 0; r0 < 128; r0 += 8) { u32x4 xb[8];
#pragma unroll
            for (int j = 0; j < 8; ++j) xb[j] = xa[j];
            if (r0 + 8 < 128) {
#pragma unroll
                for (int j = 0; j < 8; ++j) xb[j] = *(const u32x4*)(p1 + (t0 + r0 + 8 + j) * N_IN1P + c); }
#pragma unroll
          for (int j8 = 0; j8 < 8; ++j8) { const u32x4 x3 = xa[j8]; const int r = r0 + j8;
            float acc[8];
#define TAPS(j, f, m) (w[0][j] * f(x0.m) + w[1][j] * f(x1.m) + w[2][j] * f(x2.m) + w[3][j] * f(x3.m))
            acc[0] = TAPS(0, bf_lo, x); acc[1] = TAPS(1, bf_hi, x); acc[2] = TAPS(2, bf_lo, y); acc[3] = TAPS(3, bf_hi, y);
            acc[4] = TAPS(4, bf_lo, z); acc[5] = TAPS(5, bf_hi, z); acc[6] = TAPS(6, bf_lo, w); acc[7] = TAPS(7, bf_hi, w);
#undef TAPS
            float ss = 0.f;
#pragma unroll
            for (int j = 0; j < 8; ++j) { acc[j] = siluf_(acc[j]); ss += acc[j] * acc[j]; }
            ss = row16_sum(ss);
            const float sc = c < 4096 ? rsqrtf(ss + 1e-6f) * qsc : 1.0f;
            u32x4 o; o.x = cvt_pk_bf16(acc[0] * sc, acc[1] * sc); o.y = cvt_pk_bf16(acc[2] * sc, acc[3] * sc); o.z = cvt_pk_bf16(acc[4] * sc, acc[5] * sc); o.w = cvt_pk_bf16(acc[6] * sc, acc[7] * sc);
            *(u32x4*)(qc + (t0 + r) * 8192 + c) = o;
            x0 = x1; x1 = x2; x2 = x3; }
#pragma unroll
            for (int j = 0; j < 8; ++j) xa[j] = xb[j]; } }
    const float* tail = (const float*)(a.ws + WS_O); float* bgo = (float*)(a.ws + WS_BG);
    for (int it = gtid; it < T_ * 32; it += gsz) { const int t = it >> 5, hv = it & 31; float tb = 0.f, ta = 0.f;
#pragma unroll
        for (int kq = 0; kq < 4; ++kq) { tb += tail[((size_t)kq * T_ + t) * 64 + hv]; ta += tail[((size_t)kq * T_ + t) * 64 + 32 + hv]; }
        bgo[t * 64 + hv] = sigmoidf_(tb);
        bgo[t * 64 + 32 + hv] = -__expf(a.in[17][hv]) * softplusf_(ta + a.in[18][hv]); }
}

struct MoeTile { const float* src; unsigned char* dst; int lds_, ldd; };
__device__ __forceinline__ MoeTile moe_tile(const Args& a, int g) {
    const int job = g >> 14, r = g & 16383, e = r >> 8, rr = r & 255; MoeTile t;
    typedef __attribute__((address_space(1))) const float* gcf; gcf s25 = (gcf)a.in[25], s26 = (gcf)a.in[26]; asm volatile("" : "+s"(s25), "+s"(s26));
    if (job < 2) { const int ik = rr >> 3, in = rr & 7; t.lds_ = DEXP; t.ldd = D_;
        t.src = (const float*)(job ? s26 : s25) + ((size_t)(NEXP + e) * D_ + ik * 64) * DEXP + in * 64; t.dst = a.ws + (job ? WS_WU : WS_WG) + ((size_t)e * DEXP + in * 64) * D_ + ik * 64; }
    else { const int ik = rr >> 5, in = rr & 31; t.lds_ = D_; t.ldd = DEXP;
        t.src = a.in[27] + ((size_t)(NEXP + e) * DEXP + ik * 64) * D_ + in * 64; t.dst = a.ws + WS_WD + ((size_t)e * D_ + in * 64) * DEXP + ik * 64; }
    return t;
}
__device__ __forceinline__ void moe_tile_load(const MoeTile& t, int tid, f32x4 (&v)[2]) {
#pragma unroll
    for (int i = 0; i < 2; ++i) { const int idx = tid + i * 512, rr = idx >> 4, c4 = (idx & 15) * 4; v[i] = *(const f32x4*)(t.src + (size_t)rr * t.lds_ + c4); }
}
__device__ __forceinline__ void moe_tile_store(const MoeTile& t, int tid, const f32x4 (&v)[2], LAS float* tile) {
#pragma unroll
    for (int i = 0; i < 2; ++i) { const int idx = tid + i * 512, rr = idx >> 4, c4 = (idx & 15) * 4;
        tile[rr * 65 + c4 + 0] = v[i][0]; tile[rr * 65 + c4 + 1] = v[i][1]; tile[rr * 65 + c4 + 2] = v[i][2]; tile[rr * 65 + c4 + 3] = v[i][3]; }
    LDS_BARRIER();
    { const int n = tid >> 3, kg = (tid & 7) * 8; float f[8];
#pragma unroll
      for (int jj = 0; jj < 8; ++jj) f[jj] = tile[(kg + jj) * 65 + n] * W8_SCALE;
      u32x2 w; w.x = pk_fp8x4(f[0], f[1], f[2], f[3]); w.y = pk_fp8x4(f[4], f[5], f[6], f[7]);
      *(u32x2*)(t.dst + (size_t)n * t.ldd + kg) = w; }
    LDS_BARRIER();
}
constexpr int MOE_TILES = 3 * NEXP * 256;

__device__ __forceinline__ f32x4 mfma16(s16x4 a, s16x4 b, f32x4 c) { return __builtin_amdgcn_mfma_f32_16x16x16bf16_1k(a, b, c, 0, 0, 0); }
__device__ __forceinline__ s16x4 pack4(const f32x4& v) { u32x2 w; w.x = cvt_pk_bf16(v[0], v[1]); w.y = cvt_pk_bf16(v[2], v[3]); return __builtin_bit_cast(s16x4, w); }
__device__ __forceinline__ void phase_gdn_chunk(const Args& a, LAS unsigned char* lds) {
    const bf16_t* qc = (const bf16_t*)(a.ws + WS_QKVC); const float* bgi = (const float*)(a.ws + WS_BG); bf16_t* O = (bf16_t*)(a.ws + WS_O);
    constexpr int VRS = 144, KTRS = 136;
    constexpr int KT = 0, QS = KT + 128 * KTRS, WSL = QS + 64 * RSB, QKS = WSL + 64 * RSB, EE = QKS + 2048, EDD = EE + 256, SET = EDD + 256;
    constexpr int STL = 2 * SET, KS = STL + 64 * RSB, VS = KS + 64 * RSB, X2 = VS + 64 * VRS, LS = X2 + 2048, X1 = LS + 4096, GAM = X1 + 2048, BET = GAM + 256, LEND = BET + 256;
    static_assert(LEND <= LDS_XBW, "gdn lds");
    const int wid = __builtin_amdgcn_readfirstlane(TIDX >> 6);
    const int NCK = S_ / 64;
    for (int blk = BID; blk < NB_ * 32 * 2; blk += NBLK) {
        const int grp = (blk & 7) * 8 + (blk >> 5), mem = (blk >> 3) & 3, b = grp >> 4, hk = grp & 15, hv = 2 * hk + (mem >> 1), vhalf = mem & 1;
        __syncthreads();
        if (wid < 4) {
            const int vt = wid;
            f32x4 Sacc[8];
#pragma unroll
            for (int n = 0; n < 8; ++n) Sacc[n] = (f32x4){0.f, 0.f, 0.f, 0.f};
            { const int lane = TIDX & 63;
              for (int i = lane; i < 16 * RSB / 16; i += 64) *(LAS u32x4*)(lds + STL + 16 * vt * RSB + i * 16) = (u32x4){0u, 0u, 0u, 0u}; }
            int lz = TIDX & 63; asm volatile("" : "+v"(lz));
            const int lane = lz, I = lane & 15, G = lane >> 4, q4 = I >> 2, p4 = I & 3;
            for (int it = 0; it <= NCK; ++it) {
                const int set = ((it - 1) & 1) * SET; const size_t t0 = (size_t)b * S_ + (size_t)(it - 1) * 64;
                f32x4 U[4];
                if (it >= 1) {
#pragma unroll
                    for (int sa = 0; sa < 4; ++sa) U[sa] = mfma16(*(const LAS s16x4*)(lds + X2 + ((sa * 16 + I) * 16 + 4 * G) * 2), lds_tr4(lds + VS + (16 * sa + 4 * G + q4) * VRS + (16 * vt + 4 * p4) * 2), (f32x4){0.f, 0.f, 0.f, 0.f});
                    asm volatile("" : "+v"(U[0]), "+v"(U[1]), "+v"(U[2]), "+v"(U[3]) :: "memory");
                }
                LDS_BARRIER();
#pragma unroll
                for (int sa = 0; sa < 4; ++sa) {
                    if (it >= 1) {
                        bf16x8 sf[4];
#pragma unroll
                        for (int ks = 0; ks < 4; ++ks) sf[ks] = lds_frag(lds + STL + (16 * vt + I) * RSB + (32 * ks + 8 * G) * 2);
                        s16x4 kt[8];
#pragma unroll
                        for (int dt = 0; dt < 8; ++dt) kt[dt] = *(const LAS s16x4*)(lds + set + KT + (16 * dt + I) * KTRS + (16 * sa + 4 * G) * 2);
                        f32x4 dl = U[sa], oq = (f32x4){0.f, 0.f, 0.f, 0.f};
#pragma unroll
                        for (int ks = 0; ks < 4; ++ks) { dl = mfma32(lds_frag(lds + set + WSL + (16 * sa + I) * RSB + (32 * ks + 8 * G) * 2), sf[ks], dl);
                            oq = mfma32(lds_frag(lds + set + QS + (16 * sa + I) * RSB + (32 * ks + 8 * G) * 2), sf[ks], oq); }
                        const s16x4 dfrag = pack4(dl);
                        const f32x4 e4 = *(const LAS f32x4*)(lds + set + EE + (16 * sa + 4 * G) * 4);
                        oq = mfma16(*(const LAS s16x4*)(lds + set + QKS + ((sa * 16 + I) * 16 + 4 * G) * 2), dfrag, oq * e4);
#pragma unroll
                        for (int r = 0; r < 4; ++r) O[(t0 + 16 * sa + 4 * G + r) * 4096 + hv * 128 + vhalf * 64 + 16 * vt + I] = f2bf(oq[r]);
                        const f32x4 ed4 = *(const LAS f32x4*)(lds + set + EDD + (16 * sa + 4 * G) * 4); const float e15 = *(const LAS float*)(lds + set + EE + (16 * sa + 15) * 4);
                        const s16x4 dsc = pack4(dl * ed4);
#pragma unroll
                        for (int dt = 0; dt < 8; ++dt) {
                            Sacc[dt] = mfma16(kt[dt], dsc, Sacc[dt] * e15);
                            *(LAS s16x4*)(lds + STL + (16 * vt + I) * RSB + (16 * dt + 4 * G) * 2) = pack4(Sacc[dt]); }
                    }
                    if (sa != 1) LDS_BARRIER(); else asm volatile("s_waitcnt lgkmcnt(0)" ::: "memory");
                }
            }
        } else {
            const int pw = wid - 4;
            u32x4 pq[4], pk[4], pv[2]; float pb = 0.f, pg = 0.f;
            { const int ptid = TIDX - 256; const size_t t0 = (size_t)b * S_;
#pragma unroll
              for (int i = 0; i < 4; ++i) { const int c = ptid + i * 256, s2 = c >> 4, c8 = (c & 15) * 8; pq[i] = *(const u32x4*)(qc + (t0 + s2) * 8192 + hk * 128 + c8); pk[i] = *(const u32x4*)(qc + (t0 + s2) * 8192 + 2048 + hk * 128 + c8); }
#pragma unroll
              for (int i = 0; i < 2; ++i) { const int c = ptid + i * 256, s2 = c >> 3, c8 = (c & 7) * 8; pv[i] = *(const u32x4*)(qc + (t0 + s2) * 8192 + 4096 + hv * 128 + vhalf * 64 + c8); }
              if (pw == 1) { pb = bgi[(t0 + ptid - 64) * 64 + hv]; pg = bgi[(t0 + ptid - 64) * 64 + 32 + hv]; } }
            int lz = TIDX & 63; asm volatile("" : "+v"(lz));
            const int lane = lz, ptid = pw * 64 + lane, I = lane & 15, G = lane >> 4, q4 = I >> 2, p4 = I & 3;
            for (int it = 0; it <= NCK; ++it) {
                const int set = (it & 1) * SET; const bool act = it < NCK;
                if (act) {
#pragma unroll
                    for (int i = 0; i < 4; ++i) { const int c = ptid + i * 256, s2 = c >> 4, c8 = (c & 15) * 8; *(LAS u32x4*)(lds + set + QS + s2 * RSB + c8 * 2) = pq[i]; *(LAS u32x4*)(lds + KS + s2 * RSB + c8 * 2) = pk[i]; }
                    if (pw == 1) { float x = pg;
                        x += __builtin_bit_cast(float, __builtin_amdgcn_update_dpp(0, __builtin_bit_cast(int, x), 0x111, 0xf, 0xf, true));
                        x += __builtin_bit_cast(float, __builtin_amdgcn_update_dpp(0, __builtin_bit_cast(int, x), 0x112, 0xf, 0xf, true));
                        x += __builtin_bit_cast(float, __builtin_amdgcn_update_dpp(0, __builtin_bit_cast(int, x), 0x114, 0xf, 0xf, true));
                        x += __builtin_bit_cast(float, __builtin_amdgcn_update_dpp(0, __builtin_bit_cast(int, x), 0x118, 0xf, 0xf, true));
                        const float g15 = __shfl(x, 15, 16);
                        *(LAS float*)(lds + GAM + lane * 4) = x; *(LAS float*)(lds + set + EE + lane * 4) = __expf(x); *(LAS float*)(lds + set + EDD + lane * 4) = __expf(g15 - x); *(LAS float*)(lds + BET + lane * 4) = pb; }
                }
                LDS_BARRIER();
                if (act) { const int sa = pw;
#pragma unroll
                    for (int i = 0; i < 2; ++i) { const int c = ptid + i * 256, s2 = c >> 3, c8 = (c & 7) * 8; *(LAS u32x4*)(lds + VS + s2 * VRS + c8 * 2) = pv[i]; }
                    if (it + 1 < NCK) { const size_t t1 = (size_t)b * S_ + (size_t)(it + 1) * 64;
#pragma unroll
                        for (int i = 0; i < 4; ++i) { const int c = ptid + i * 256, s2 = c >> 4, c8 = (c & 15) * 8; pq[i] = *(const u32x4*)(qc + (t1 + s2) * 8192 + hk * 128 + c8); pk[i] = *(const u32x4*)(qc + (t1 + s2) * 8192 + 2048 + hk * 128 + c8); }
#pragma unroll
                        for (int i = 0; i < 2; ++i) { const int c = ptid + i * 256, s2 = c >> 3, c8 = (c & 7) * 8; pv[i] = *(const u32x4*)(qc + (t1 + s2) * 8192 + 4096 + hv * 128 + vhalf * 64 + c8); }
                        if (pw == 1) { pb = bgi[(t1 + ptid - 64) * 64 + hv]; pg = bgi[(t1 + ptid - 64) * 64 + 32 + hv]; } }
#pragma unroll
                    for (int ty = 0; ty < 2; ++ty) { f32x4 acc = (f32x4){0.f, 0.f, 0.f, 0.f};
#pragma unroll
                        for (int ks = 0; ks < 4; ++ks) { const bf16x8 ka = lds_frag(lds + KS + (16 * sa + I) * RSB + (32 * ks + 8 * G) * 2);
                            const bf16x8 bo = ty ? lds_frag(lds + set + QS + (16 * sa + I) * RSB + (32 * ks + 8 * G) * 2) : ka; acc = mfma32(ka, bo, acc); }
                        const f32x4 gr = *(const LAS f32x4*)(lds + GAM + (16 * sa + 4 * G) * 4); const float gc = *(const LAS float*)(lds + GAM + (16 * sa + I) * 4);
                        if (ty == 0) { const f32x4 br = *(const LAS f32x4*)(lds + BET + (16 * sa + 4 * G) * 4);
#pragma unroll
                            for (int r = 0; r < 4; ++r) { const float val = br[r] * acc[r] * __expf(gr[r] - gc); *(LAS float*)(lds + LS + ((sa * 16 + 4 * G + r) * 16 + I) * 4) = (I < 4 * G + r) ? val : 0.f; } }
                        else { f32x4 o;
#pragma unroll
                            for (int r = 0; r < 4; ++r) { const float val = acc[r] * __expf(gc - gr[r]); o[r] = (4 * G + r <= I) ? val : 0.f; }
                            *(LAS s16x4*)(lds + set + QKS + ((sa * 16 + I) * 16 + 4 * G) * 2) = pack4(o); } } }
                LDS_BARRIER();
                if (act && pw == 0) { const int sa = G, c = I; float x[16];
#pragma unroll
                    for (int i = 0; i < 16; ++i) x[i] = 0.f;
#pragma unroll
                    for (int ib = 0; ib < 4; ++ib) {
                        f32x4 lv[4][4];
#pragma unroll
                        for (int r = 0; r < 4; ++r)
#pragma unroll
                            for (int jj = 0; jj <= ib; ++jj) lv[r][jj] = *(const LAS f32x4*)(lds + LS + ((sa * 16 + 4 * ib + r) * 16 + 4 * jj) * 4);
                        __builtin_amdgcn_sched_barrier(0);
#pragma unroll
                        for (int r = 0; r < 4; ++r) { const int i = 4 * ib + r; float s0 = (i == c) ? 1.0f : 0.0f, s1 = 0.f;
#pragma unroll
                            for (int jj = 0; jj <= ib; ++jj) { s0 -= lv[r][jj][0] * x[4 * jj] + lv[r][jj][1] * x[4 * jj + 1]; s1 -= lv[r][jj][2] * x[4 * jj + 2] + lv[r][jj][3] * x[4 * jj + 3]; }
                            x[i] = s0 + s1; }
                    }
                    const float bc = *(const LAS float*)(lds + BET + lane * 4), sc1 = -bc * *(const LAS float*)(lds + set + EE + lane * 4);
#pragma unroll
                    for (int i = 0; i < 16; ++i) { *(LAS bf16_t*)(lds + X1 + ((sa * 16 + i) * 16 + c) * 2) = f2bf(x[i] * sc1); *(LAS bf16_t*)(lds + X2 + ((sa * 16 + i) * 16 + c) * 2) = f2bf(x[i] * bc); } }
                LDS_BARRIER();
                if (act) { const int sa = pw;
                    const s16x4 xb = *(const LAS s16x4*)(lds + X1 + ((sa * 16 + I) * 16 + 4 * G) * 2); s16x4 kt[8]; f32x4 w[8];
#pragma unroll
                    for (int dt = 0; dt < 8; ++dt) kt[dt] = lds_tr4(lds + KS + (16 * sa + 4 * G + q4) * RSB + (16 * dt + 4 * p4) * 2);
#pragma unroll
                    for (int dt = 0; dt < 8; ++dt) { w[dt] = mfma16(kt[dt], xb, (f32x4){0.f, 0.f, 0.f, 0.f}); *(LAS s16x4*)(lds + set + KT + (16 * dt + I) * KTRS + (16 * sa + 4 * G) * 2) = kt[dt]; }
#pragma unroll
                    for (int dt = 0; dt < 8; ++dt) *(LAS s16x4*)(lds + set + WSL + (16 * sa + I) * RSB + (16 * dt + 4 * G) * 2) = pack4(w[dt]); }
                LDS_BARRIER();
            }
        }
    }
}

constexpr int N_PHASES = 30;
__global__ void __launch_bounds__(NTHREADS, 2) fwd(Args a0) {
    extern __shared__ __attribute__((aligned(16))) unsigned char smem_raw[];
    LAS unsigned char* lds = (LAS unsigned char*)smem_raw;
    volatile LAS unsigned* xbw = (volatile LAS unsigned*)(lds + LDS_XBW);
    if (TIDX == 0) { xbw[0] = 0u; xbw[1] = 0u; xbw[2] = 0u; xbw[3] = 0u; }
    __syncthreads();
    XcdBarrier bar = xcd_barrier_post((unsigned*)(a0.ws + WS_CTL), xbw);
#ifndef PHMASK
#define PHMASK 0xFFFFFFFFull
#endif
#ifndef DUPMASK
#define DUPMASK 0ull
#endif
#define PH(i, body) do { if (((PHMASK >> (i)) & 1ull) && a0.ph_lo <= (i) && (i) < a0.ph_hi) { __attribute__((address_space(1))) unsigned char* wsp_ = (__attribute__((address_space(1))) unsigned char*)a0.ws; asm volatile("" : "+s"(wsp_)); Args a = a0; a.ws = (unsigned char*)wsp_; const float* xin = a.in[0]; const float* xw = (const float*)(a.ws + WS_X); (void)xin; (void)xw; \
        if ((DUPMASK >> (i)) & 1ull) { body; xcd_barrier(bar); } body; if ((i) + 1 < a0.ph_hi) xcd_barrier(bar); } } while (0)
    PH(0, { phase_prologue(a, lds); __syncthreads(); NORM_PH(0, true)(a, xin, a.in[1], -1); });
    PH(2, phase_gemm_in0(a, lds));
    PH(3, { phase_rg_conv(a); __syncthreads(); phase_hg1(a, lds); });
    PH(4, { phase_rg_gates(a, lds); __syncthreads(); phase_hg2(a); });
    PH(5, { phase_rg_scan(a, lds); __syncthreads(); phase_hg3(a, lds); });
    PH(9, phase_gemm_out<false>(a, lds, D_, a.ws + WS_WOUT0T, xin));
    PH(10, NORM_PH(0, false)(a, nullptr, a.in[2], 0));
    PH(11, phase_gemm_router(a, lds, 0));
    PH(12, phase_route(a, 0));
    PH(13, phase_rowmap(a, lds, 0));
    PH(14, phase_moe_up(a, lds, 0));
    PH(15, phase_moe_down(a, lds, 0));
    PH(16, { NORM_PH(1, false)(a, nullptr, a.in[1] + D_, 0); __syncthreads(); moe_weight_jobs(a, 1, lds); });
    PH(18, { phase_gemm_in1(a, lds); phase_gemm_in1_tail(a, lds); });
    PH(19, phase_gdn_conv(a));
    PH(20, phase_gdn_chunk(a, lds));
    PH(21, phase_gdn_norm(a));
    PH(22, phase_gemm_out<true>(a, lds, 4096, a.ws + WS_WOUT1T, nullptr));
    PH(23, NORM_PH(0, false)(a, nullptr, a.in[2] + D_, 1));
    PH(24, phase_gemm_router(a, lds, 1));
    PH(25, phase_route(a, 1));
    PH(26, phase_rowmap(a, lds, 1));
    PH(27, phase_moe_up(a, lds, 1));
    PH(28, phase_moe_down(a, lds, 1));
    PH(29, NORM_PH(2, false)(a, nullptr, a.in[3], 1));
#undef PH
}

extern "C" void kernel_launch(void* const* d_in, const int* in_sizes, int n_in, void* d_out, int out_size, void* d_ws, size_t ws_size, hipStream_t stream) {
    static int grid = 0;
    if (grid == 0) {
        if (n_in != 28 || ws_size < WS_END) { fprintf(stderr, "kernel_launch: need 28 inputs and %zu bytes of workspace, got %d / %zu\n", (size_t)WS_END, n_in, ws_size); grid = -1; return; }
        int dev = 0, cus = 0, per_cu = 0;
        if (hipGetDevice(&dev) != hipSuccess || hipDeviceGetAttribute(&cus, hipDeviceAttributeMultiprocessorCount, dev) != hipSuccess) { grid = -1; return; }
        if (hipFuncSetAttribute((const void*)fwd, hipFuncAttributeMaxDynamicSharedMemorySize, LDS_BYTES) != hipSuccess) { fprintf(stderr, "kernel_launch: hipFuncSetAttribute failed\n"); grid = -1; return; }
        if (hipOccupancyMaxActiveBlocksPerMultiprocessor(&per_cu, (const void*)fwd, NTHREADS, LDS_BYTES) != hipSuccess || per_cu < 1) { fprintf(stderr, "kernel_launch: occupancy query says %d\n", per_cu); }
        (void)hipGetLastError();
        grid = cus;
    }
    if (grid < 0) return;
    (void)in_sizes; (void)out_size;
    hipMemsetAsync((char*)d_ws + WS_CTL, 0, CTL_BYTES, stream);
    Args a; memset(&a, 0, sizeof(a));
    for (int i = 0; i < 28; ++i) a.in[i] = (const float*)d_in[i];
    a.out = (float*)d_out; a.ws = (unsigned char*)d_ws;
#if N_LAUNCH_MODE == 1
    a.ph_lo = 0; a.ph_hi = N_PHASES;
    hipLaunchKernelGGL(fwd, dim3(grid), dim3(NTHREADS), LDS_BYTES, stream, a);
#if EXTRA_PH >= 0
    a.ph_lo = EXTRA_PH; a.ph_hi = EXTRA_PH + 1;
    hipLaunchKernelGGL(fwd, dim3(grid), dim3(NTHREADS), LDS_BYTES, stream, a);
#endif
#else
    for (int p = 0; p < N_PHASES; ++p) { a.ph_lo = p; a.ph_hi = p + 1; hipLaunchKernelGGL(fwd, dim3(grid), dim3(NTHREADS), LDS_BYTES, stream, a); }
#endif
}
```

```cpp
#include <hip/hip_runtime.h>
#include <stdint.h>
#include <stdio.h>
#include <string.h>

#ifndef EXTRA_PH
#define EXTRA_PH -1
#endif
#ifndef N_LAUNCH_MODE
#define N_LAUNCH_MODE 1
#endif

#define LAS __attribute__((address_space(3)))
typedef unsigned short bf16_t;
typedef short bf16x8 __attribute__((ext_vector_type(8)));
typedef float f32x4 __attribute__((ext_vector_type(4)));
typedef float f32x2 __attribute__((ext_vector_type(2)));
typedef unsigned u32x4 __attribute__((ext_vector_type(4)));
typedef unsigned u32x2 __attribute__((ext_vector_type(2)));

constexpr int T_ = 16384, D_ = 2048, S_ = 4096, NB_ = 4;
constexpr int N_IN0 = 6144, N_IN1 = 12352, N_IN1P = 12544;
constexpr int NEXP = 64, DEXP = 512, MPAD = 49152;
constexpr int NTHREADS = 512;
constexpr int LDS_MAIN = 131072;
constexpr int LDS_BYTES = 163840;
constexpr int LDS_XBW = LDS_BYTES - 16;

constexpr size_t al256(size_t x) { return (x + 255) & ~(size_t)255; }
constexpr size_t WS_CTL = 0;
constexpr size_t CTL_BYTES = 65536;
constexpr size_t CTL_CNT = 16384;
constexpr size_t WS_LB = WS_CTL + CTL_BYTES;
constexpr size_t WS_TINFO = WS_LB + 4096;
constexpr size_t WS_WIN0T = WS_TINFO + 4096;
constexpr size_t WS_WOUT0T = WS_WIN0T + (size_t)N_IN0 * D_ * 2;
constexpr size_t WS_WIN1T = WS_WOUT0T + (size_t)D_ * D_ * 2;
constexpr size_t WS_WOUT1T = WS_WIN1T + (size_t)N_IN1P * D_ * 2;
constexpr size_t WS_WGATES = WS_WOUT1T + (size_t)D_ * 4096 * 2;
constexpr size_t WS_WRT = WS_WGATES + (size_t)8 * 256 * 256 * 2;
constexpr size_t WS_WG = WS_WRT + (size_t)2 * 256 * D_ * 2;
constexpr size_t WS_WU = WS_WG + (size_t)NEXP * DEXP * D_ * 2;
constexpr size_t WS_WD = WS_WU + (size_t)NEXP * DEXP * D_ * 2;
constexpr size_t WS_X = WS_WD + (size_t)NEXP * DEXP * D_ * 2;
constexpr size_t WS_H = WS_X + (size_t)T_ * D_ * 4;
constexpr size_t WS_PROJ = WS_H + (size_t)T_ * D_ * 2;
constexpr size_t PROJ_BYTES = (size_t)T_ * N_IN1P * 2;
constexpr size_t WS_FLOG = WS_PROJ + (size_t)T_ * N_IN0 * 2;
constexpr size_t WS_XC = WS_FLOG + (size_t)T_ * 1024 * 4;
constexpr size_t WS_ACT = WS_PROJ;
constexpr size_t WS_YMOE = WS_ACT + (size_t)MPAD * DEXP * 2;
constexpr size_t WS_R1 = WS_PROJ + PROJ_BYTES;
constexpr size_t WS_A = WS_R1;
constexpr size_t WS_U = WS_R1 + (size_t)T_ * 1024 * 4;
constexpr size_t WS_QKVC = WS_R1;
constexpr size_t WS_Y = WS_R1 + (size_t)T_ * 8192 * 2;
constexpr size_t WS_O = WS_Y + (size_t)T_ * 4096 * 2;
constexpr size_t WS_TAIL = WS_O + (size_t)T_ * 4096 * 4;
constexpr size_t WS_BG = WS_TAIL + (size_t)T_ * 64 * 4;
constexpr size_t WS_LOGITS = WS_BG + (size_t)T_ * 64 * 4;
constexpr size_t WS_EID = WS_LOGITS + (size_t)T_ * 128 * 4;
constexpr size_t WS_SLOT = WS_EID + (size_t)T_ * 2 * 4;
constexpr size_t WS_GATE = WS_SLOT + (size_t)T_ * 2 * 4;
constexpr size_t WS_POSOF = WS_GATE + (size_t)T_ * 2 * 4;
constexpr size_t WS_ROWMAP = WS_POSOF + (size_t)T_ * 2 * 4;
constexpr size_t WS_H8 = WS_ROWMAP + (size_t)MPAD * 4;
constexpr size_t WS_END = WS_H8 + (size_t)T_ * D_;
static_assert(WS_YMOE + (size_t)MPAD * D_ * 2 <= WS_R1, "moe overlay");
static_assert(WS_XC + (size_t)T_ * 1024 * 2 <= WS_R1, "layer0 overlay");

struct Args {
    const float* in[28];
    float* out;
    unsigned char* ws;
    int ph_lo, ph_hi;
};

__device__ __forceinline__ int tidx_() { int t = (int)threadIdx.x; asm volatile("" : "+v"(t)); return t; }
#define TIDX tidx_()
typedef __bf16 bf16x2n __attribute__((ext_vector_type(2)));
__device__ __forceinline__ unsigned cvt_pk_bf16(float lo, float hi) { const f32x2 v = {lo, hi}; return __builtin_bit_cast(unsigned, __builtin_convertvector(v, bf16x2n)); }
__device__ __forceinline__ unsigned pk_fp8x4(float a, float b, float c, float d) { int v = __builtin_amdgcn_cvt_pk_fp8_f32(a, b, 0, false); v = __builtin_amdgcn_cvt_pk_fp8_f32(c, d, v, true); return (unsigned)v; }
constexpr float W8_SCALE = 64.0f, ACT8_SCALE = 8.0f;
__device__ __forceinline__ bf16_t f2bf(float x) { return (bf16_t)(cvt_pk_bf16(x, 0.f) & 0xffffu); }
__device__ __forceinline__ float bf_lo(unsigned w) { return __uint_as_float(w << 16); }
__device__ __forceinline__ float bf_hi(unsigned w) { return __uint_as_float(w & 0xffff0000u); }
__device__ __forceinline__ float bf1(bf16_t v) { return __uint_as_float(((unsigned)v) << 16); }
__device__ __forceinline__ float sigmoidf_(float x) { return __builtin_amdgcn_rcpf(1.0f + __expf(-x)); }
__device__ __forceinline__ float siluf_(float x) { return x * __builtin_amdgcn_rcpf(1.0f + __expf(-x)); }
__device__ __forceinline__ float softplusf_(float x) { return x > 20.f ? x : log1pf(__expf(x)); }
__device__ __forceinline__ float gelu_tanh(float x) { const float u = 0.7978845608028654f * (x + 0.044715f * x * x * x); return x * __builtin_amdgcn_rcpf(1.0f + __expf(-2.0f * u)); }
template <int CTRL> __device__ __forceinline__ float dpp_f(float v) { return __builtin_bit_cast(float, __builtin_amdgcn_update_dpp(0, __builtin_bit_cast(int, v), CTRL, 0xf, 0xf, false)); }
__device__ __forceinline__ float row16_sum(float s) { s += dpp_f<0x140>(s); s += dpp_f<0x141>(s); s += dpp_f<0xB1>(s); s += dpp_f<0x4E>(s); return s; }
__device__ __forceinline__ float wave_sum(float v) { v = row16_sum(v); v += __shfl_xor(v, 16); v += __shfl_xor(v, 32); return v; }

#define LDS_BARRIER() do { asm volatile("s_waitcnt lgkmcnt(0)" ::: "memory"); __builtin_amdgcn_s_barrier(); asm volatile("" ::: "memory"); } while (0)
#define XB_TMO      128
#define XB_XCNT(j)  (256  + 64 * (j))
#define XB_XSUB(j)  (1280 + 64 * (j))
#define XB_XGEN(j)  (2304 + 64 * (j))
#define XB_TOP      3328
#define XB_TOPGEN   3392
#define XCD_BAR_WORDS 3456
#define XB_SPIN_CAP (1u << 18)

__device__ __forceinline__ unsigned xb_ld(unsigned* p)              { return __hip_atomic_load(p, __ATOMIC_RELAXED, __HIP_MEMORY_SCOPE_AGENT); }
__device__ __forceinline__ unsigned xb_add(unsigned* p, unsigned v) { return __hip_atomic_fetch_add(p, v, __ATOMIC_RELAXED, __HIP_MEMORY_SCOPE_AGENT); }
__device__ __forceinline__ unsigned xb_xcc_id() { return (unsigned)__builtin_amdgcn_s_getreg((3 << 11) | 20) & 0xFu; }
#define XB_SPIN(cond, bar) do { unsigned _sp = 0; while (cond) { __builtin_amdgcn_s_sleep(1); \
    if ((++_sp & 255u) == 0u) { if (xb_ld(&(bar)[XB_TMO])) break; if (_sp > XB_SPIN_CAP) { atomicAdd(&(bar)[XB_TMO], 1u); break; } } } } while (0)

struct XcdBarrier { unsigned* bar; unsigned x; volatile LAS unsigned* st; };

__device__ __forceinline__ XcdBarrier xcd_barrier_post(unsigned* bar, volatile LAS unsigned* st) {
    XcdBarrier b; b.bar = bar; b.x = xb_xcc_id(); b.st = st;
    if (TIDX == 0) (void)xb_add(&bar[XB_XCNT(b.x)], 1u);
    return b;
}
__device__ __forceinline__ void xcd_barrier_complete(unsigned* bar, unsigned x, unsigned& nloc, unsigned& nx) {
    const unsigned G = gridDim.x * gridDim.y * gridDim.z;
    unsigned sum, cnt, mine, sp = 0u;
    for (;;) {
        sum = 0u; cnt = 0u; mine = 0u;
#pragma unroll
        for (unsigned j = 0; j < 16; ++j) { const unsigned c = xb_ld(&bar[XB_XCNT(j)]); sum += c; cnt += (c > 0u) ? 1u : 0u; mine = (j == x) ? c : mine; }
        if (sum == G) break;
        __builtin_amdgcn_s_sleep(1);
        if ((++sp & 255u) == 0u) { if (xb_ld(&bar[XB_TMO])) break; if (sp > XB_SPIN_CAP) { atomicAdd(&bar[XB_TMO], 1u); break; } }
    }
    nloc = mine > 0u ? mine : 1u; nx = cnt > 0u ? cnt : 1u;
}
__device__ __forceinline__ void xcd_barrier(const XcdBarrier& b) {
    asm volatile("s_waitcnt vmcnt(0)" ::: "memory");
    __syncthreads();
    if (TIDX == 0) {
        unsigned* bar = b.bar;
        __builtin_amdgcn_s_waitcnt(0);
        unsigned nloc = b.st[0], nx = b.st[1];
        if (nloc == 0u) { xcd_barrier_complete(bar, b.x, nloc, nx); b.st[0] = nloc; b.st[1] = nx; }
        const unsigned old = xb_add(&bar[XB_XSUB(b.x)], 1u);
        const unsigned gen = old / nloc;
        if (old + 1u == (gen + 1u) * nloc) {
            __builtin_amdgcn_fence(__ATOMIC_RELEASE, "agent");
            asm volatile("s_waitcnt vmcnt(0)" ::: "memory");
            const unsigned og = xb_add(&bar[XB_TOP], 1u);
            const unsigned tg = og / nx;
            if (og + 1u == (tg + 1u) * nx) xb_add(&bar[XB_TOPGEN], 1u);
            else XB_SPIN(xb_ld(&bar[XB_TOPGEN]) == tg, bar);
            __builtin_amdgcn_fence(__ATOMIC_ACQUIRE, "agent");
            xb_add(&bar[XB_XGEN(b.x)], 1u);
            asm volatile("s_waitcnt vmcnt(0)" ::: "memory");
        } else {
            XB_SPIN(xb_ld(&bar[XB_XGEN(b.x)]) == gen, bar);
            __builtin_amdgcn_fence(__ATOMIC_ACQUIRE, "agent");
            asm volatile("s_waitcnt vmcnt(0)" ::: "memory");
        }
    }
    __syncthreads();
}

constexpr int BM = 256, BK = 64, HALF = 128, HTB = HALF * BK * 2;
__device__ __forceinline__ int lds_byte(int r, int c) { const int st = (r >> 4) * 2 + (c >> 5), rr = r & 15, cc = c & 31, ob = rr * 64 + cc * 2; return st * 1024 + (ob ^ (((ob >> 9) & 1) << 5)); }
__device__ __forceinline__ void stage_rc(int b, int& R, int& C) { const int st = b / 1024, sb = b % 1024, swz = sb ^ (((sb >> 9) & 1) << 5); R = (st >> 1) * 16 + swz / 64; C = (st & 1) * 32 + (swz % 64) / 2; }
__device__ __forceinline__ int perm32(int rho) { const int n = rho >> 4, i = rho & 15; return 8 * (i >> 2) + 4 * n + (i & 3); }

__device__ __forceinline__ void stage_pos(int tid, int& R0, int& C0) { stage_rc(tid * 16, R0, C0); }
__device__ __forceinline__ int perm_row(int R) { return (R & ~31) + perm32(R & 31); }

#define BID ((int)blockIdx.x)
#define NBLK ((int)gridDim.x)
#define BID_ BID
#define NBLK_ NBLK
typedef f32x4 Acc[2][2][4][2];
struct UnitD { const char* gA; const char* gB; int t0, t1, t2; };

typedef int i32x8 __attribute__((ext_vector_type(8)));
typedef int i32x4 __attribute__((ext_vector_type(4)));
template <bool GATHER, bool FP8, class Src, class Epi>
__device__ __forceinline__ void gemm_stream(LAS unsigned char* lds, const Src& S, const int nt, const Epi& E) {
    const int tid = TIDX, wid = tid >> 6, lane = tid & 63, wr = wid >> 2, wc = wid & 3, fr = lane & 15, fq = lane >> 4;
    const unsigned ldsw = (unsigned)wid * 1024u;
    const int aoff = lds_byte(wr * 64 + fr, fq * 8), boff = lds_byte(wc * 32 + fr, fq * 8);
    const size_t kstep = (size_t)(BK * 2);
#define G_SA(b, h) (((b) * 2 + (h)) * HTB)
#define G_SB(b, h) ((4 + (b) * 2 + (h)) * HTB)
#define G_STAGE(bufoff, gbase, v) do { _Pragma("unroll") for (int _i = 0; _i < 2; ++_i) \
        __builtin_amdgcn_global_load_lds((const unsigned*)((gbase) + (v)[_i]), (LAS unsigned*)(lds + (bufoff) + ldsw + _i * 8192), 16, 0, 0); } while (0)
#define G_LD8(p) __builtin_shufflevector(*(const LAS i32x4*)(p), *(const LAS i32x4*)((p) + 1024), 0, 1, 2, 3, 4, 5, 6, 7)
#define G_LDA(dst, b, h) do { _Pragma("unroll") for (int m = 0; m < 4; ++m) dst[m] = G_LD8(lds + G_SA(b, h) + aoff + m * 2048); } while (0)
#define G_LDB(dst, b, h) do { _Pragma("unroll") for (int n = 0; n < 2; ++n) dst[n] = G_LD8(lds + G_SB(b, h) + boff + n * 2048); } while (0)
#define G_HALF(x, k) __builtin_bit_cast(bf16x8, __builtin_shufflevector((x), (x), 4 * (k), 4 * (k) + 1, 4 * (k) + 2, 4 * (k) + 3))
#define G_MMA(ai, bj, At, Bt) do { __builtin_amdgcn_s_setprio(1); _Pragma("unroll") for (int m = 0; m < 4; ++m) _Pragma("unroll") for (int n = 0; n < 2; ++n) { \
        if (FP8) asm volatile("v_mfma_f32_16x16x128_f8f6f4 %0, %1, %2, %0" : "+v"(acc[ai][bj][m][n]) : "v"(Bt[n]), "v"(At[m]));   \
        else { acc[ai][bj][m][n] = __builtin_amdgcn_mfma_f32_16x16x32_bf16(G_HALF(Bt[n], 0), G_HALF(At[m], 0), acc[ai][bj][m][n], 0, 0, 0); \
               acc[ai][bj][m][n] = __builtin_amdgcn_mfma_f32_16x16x32_bf16(G_HALF(Bt[n], 1), G_HALF(At[m], 1), acc[ai][bj][m][n], 0, 0, 0); } } \
        __builtin_amdgcn_s_setprio(0); } while (0)
#define G_WAIT_V(n) asm volatile("s_waitcnt vmcnt(" #n ")" ::: "memory")
#define G_WAIT_L(n) asm volatile("s_waitcnt lgkmcnt(" #n ")" ::: "memory")
#define G_BAR __builtin_amdgcn_s_barrier()
#define G_SCHED __builtin_amdgcn_sched_barrier(0)
    UnitD cur, nxt; int ui = 0;
    if (!S.next(0, cur)) return;
    unsigned va[2][2], vb[2][2], van[2][2];
    S.vb(vb); S.va(cur, va);
    Acc acc;
#pragma unroll
    for (int a = 0; a < 2; ++a)
#pragma unroll
        for (int b = 0; b < 2; ++b)
#pragma unroll
            for (int m = 0; m < 4; ++m)
#pragma unroll
                for (int n = 0; n < 2; ++n) acc[a][b][m][n] = (f32x4){0.f, 0.f, 0.f, 0.f};
    i32x8 At[4], B0[2], B1[2];
    const char* cA = cur.gA; const char* cB = cur.gB;
    G_WAIT_V(0);
    __syncthreads();
    G_STAGE(G_SB(0, 0), cB, vb[0]); G_STAGE(G_SA(0, 0), cA, va[0]); G_STAGE(G_SB(0, 1), cB, vb[1]); G_STAGE(G_SA(0, 1), cA, va[1]);
    if (wr == 1) G_BAR;
    G_WAIT_V(4); G_BAR;
    G_STAGE(G_SB(1, 0), cB + kstep, vb[0]); G_STAGE(G_SA(1, 0), cA + kstep, va[0]); G_STAGE(G_SB(1, 1), cB + kstep, vb[1]);
    G_WAIT_V(6); G_BAR;
    for (;;) {
        const bool has_next = S.next(ui + 1, nxt);
        const char* nA = has_next ? nxt.gA : cA; const char* nB = has_next ? nxt.gB : cB;
        if (GATHER) { if (has_next) S.va(nxt, van); else { van[0][0] = va[0][0]; van[0][1] = va[0][1]; van[1][0] = va[1][0]; van[1][1] = va[1][1]; } }
#pragma unroll 1
        for (int t = 0; t < nt; t += 2) {
            const bool last = (t == nt - 2);
            const char* a1 = cA + (size_t)(t + 1) * kstep;
            const char* a2 = last ? nA : cA + (size_t)(t + 2) * kstep; const char* b2 = last ? nB : cB + (size_t)(t + 2) * kstep;
            const char* a3 = a2 + kstep; const char* b3 = b2 + kstep;
            unsigned v2[2][2];
#pragma unroll
            for (int hh = 0; hh < 2; ++hh)
#pragma unroll
                for (int i = 0; i < 2; ++i) v2[hh][i] = (GATHER && last) ? van[hh][i] : va[hh][i];
            G_LDB(B0, 0, 0); G_SCHED; G_LDA(At, 0, 0); G_STAGE(G_SA(1, 1), a1, va[1]);
            G_WAIT_L(8); G_BAR; G_WAIT_L(0); G_MMA(0, 0, At, B0); G_BAR; G_SCHED;
            G_LDB(B1, 0, 1); G_STAGE(G_SB(0, 0), b2, vb[0]);
            G_BAR; G_WAIT_L(0); G_MMA(0, 1, At, B1); G_BAR;
            G_LDA(At, 0, 1); G_STAGE(G_SA(0, 0), a2, v2[0]);
            G_BAR; G_WAIT_L(0); G_MMA(1, 0, At, B0); G_BAR; G_SCHED;
            G_STAGE(G_SB(0, 1), b2, vb[1]);
            G_WAIT_V(6); G_BAR; G_MMA(1, 1, At, B1); G_BAR;
            G_LDB(B0, 1, 0); G_SCHED; G_LDA(At, 1, 0); G_STAGE(G_SA(0, 1), a2, v2[1]);
            G_WAIT_L(8); G_BAR; G_WAIT_L(0); G_MMA(0, 0, At, B0); G_BAR; G_SCHED;
            G_LDB(B1, 1, 1); G_STAGE(G_SB(1, 0), b3, vb[0]);
            G_BAR; G_WAIT_L(0); G_MMA(0, 1, At, B1); G_BAR;
            G_LDA(At, 1, 1); G_STAGE(G_SA(1, 0), a3, v2[0]);
            G_BAR; G_WAIT_L(0); G_MMA(1, 0, At, B0); G_BAR; G_SCHED;
            G_STAGE(G_SB(1, 1), b3, vb[1]);
            G_WAIT_V(6); G_BAR; G_MMA(1, 1, At, B1); G_BAR;
        }
        if (FP8) asm volatile("s_nop 15\n\ts_nop 15" ::: "memory");
        { int tz = TIDX; asm volatile("" : "+v"(tz));
          const int wid2 = tz >> 6, lane2 = tz & 63; E(acc, cur, wid2 >> 2, wid2 & 3, lane2 & 15, lane2 >> 4); }
        if (!has_next) break;
#pragma unroll
        for (int a = 0; a < 2; ++a)
#pragma unroll
            for (int b = 0; b < 2; ++b)
#pragma unroll
                for (int m = 0; m < 4; ++m)
#pragma unroll
                    for (int n = 0; n < 2; ++n) acc[a][b][m][n] = (f32x4){0.f, 0.f, 0.f, 0.f};
        cur = nxt; cA = nA; cB = nB; ++ui;
        if (GATHER) { va[0][0] = van[0][0]; va[0][1] = van[0][1]; va[1][0] = van[1][0]; va[1][1] = van[1][1]; }
    }
    G_WAIT_V(0);
    if (wr == 0) G_BAR;
    G_BAR;
#undef G_SA
#undef G_SB
#undef G_STAGE
#undef G_LDA
#undef G_LDB
#undef G_MMA
#undef G_LD8
#undef G_HALF
#undef G_WAIT_V
#undef G_WAIT_L
#undef G_BAR
#undef G_SCHED
}

__device__ __forceinline__ void offs_direct(unsigned (&v)[2][2], int ld, bool perm) {
    int R0, C0; stage_pos(TIDX, R0, C0);
#pragma unroll
    for (int i = 0; i < 2; ++i) { const int R = R0 + 64 * i, Rr = perm ? perm_row(R) : R;
        v[0][i] = (unsigned)(Rr * ld + C0) * 2u; v[1][i] = (unsigned)((Rr + HALF) * ld + C0) * 2u; }
}

struct SrcGrid {
    const char* A; const char* B; size_t astep, bstep; int nM, total, lda, ldb;
    __device__ __forceinline__ bool next(int i, UnitD& u) const { const int id = BID_ + i * NBLK_; if (id >= total) return false; u.t0 = id % nM; u.t1 = id / nM; u.t2 = 0;
        u.gA = A + (size_t)u.t0 * astep; u.gB = B + (size_t)u.t1 * bstep; return true; }
    __device__ __forceinline__ void va(const UnitD&, unsigned (&v)[2][2]) const { offs_direct(v, lda, false); }
    __device__ __forceinline__ void vb(unsigned (&v)[2][2]) const { offs_direct(v, ldb, true); }
};

__device__ __forceinline__ void store_bf16_tile(const Acc& acc, bf16_t* O, int ld, int wr, int wc, int fr, int fq, const float sc = 1.0f) {
#pragma unroll
    for (int ai = 0; ai < 2; ++ai)
#pragma unroll
        for (int m = 0; m < 4; ++m) { bf16_t* rowp = O + (size_t)(ai * HALF + wr * 64 + m * 16 + fr) * ld + wc * 32 + 8 * fq;
#pragma unroll
            for (int bj = 0; bj < 2; ++bj) { const f32x4 v0 = acc[ai][bj][m][0] * sc, v1 = acc[ai][bj][m][1] * sc;
                u32x4 w; w.x = cvt_pk_bf16(v0[0], v0[1]); w.y = cvt_pk_bf16(v0[2], v0[3]); w.z = cvt_pk_bf16(v1[0], v1[1]); w.w = cvt_pk_bf16(v1[2], v1[3]);
                *(u32x4*)(rowp + bj * HALF) = w; } }
}
__device__ __forceinline__ void store_f32_tile(const Acc& acc, float* O, const float* R, int ld, int ncol, int wr, int wc, int fr, int fq, const float sc = 1.0f) {
#pragma unroll
    for (int ai = 0; ai < 2; ++ai)
#pragma unroll
        for (int m = 0; m < 4; ++m) { const size_t ro = (size_t)(ai * HALF + wr * 64 + m * 16 + fr) * ld;
#pragma unroll
            for (int bj = 0; bj < 2; ++bj)
#pragma unroll
                for (int n = 0; n < 2; ++n) { const int c = bj * HALF + wc * 32 + 8 * fq + 4 * n; if (c >= ncol) continue;
                    f32x4 v = acc[ai][bj][m][n] * sc; if (R) v += *(const f32x4*)(R + ro + c); *(f32x4*)(O + ro + c) = v; } }
}
struct EpiProj {
    bf16_t* O; int ld; float* F; int fld, fp0, fp1, ncol; float sc;
    __device__ __forceinline__ void operator()(const Acc& acc, const UnitD& u, int wr, int wc, int fr, int fq) const {
        if (u.t1 >= fp0 && u.t1 < fp1) store_f32_tile(acc, F + (size_t)u.t0 * BM * fld + (u.t1 - fp0) * BM, nullptr, fld, ncol, wr, wc, fr, fq, sc);
        else store_bf16_tile(acc, O + (size_t)u.t0 * BM * ld + u.t1 * BM, ld, wr, wc, fr, fq, sc);
    }
};
struct EpiResid {
    bf16_t* O; const float* Rf; const bf16_t* Rb; float sc;
    __device__ __forceinline__ void operator()(const Acc& acc, const UnitD& u, int wr, int wc, int fr, int fq) const {
        const size_t o = (size_t)u.t0 * BM * D_ + u.t1 * BM;
        if (Rf) {
#pragma unroll
            for (int am = 0; am < 4; ++am) { const int ai = am >> 1; f32x4 r0[2][2], r1[2][2];
#pragma unroll
                for (int mm = 0; mm < 2; ++mm) { const int m = (am & 1) * 2 + mm; const size_t ro = o + (size_t)(ai * HALF + wr * 64 + m * 16 + fr) * D_ + wc * 32 + 8 * fq;
#pragma unroll
                    for (int bj = 0; bj < 2; ++bj) { r0[mm][bj] = *(const f32x4*)(Rf + ro + bj * HALF); r1[mm][bj] = *(const f32x4*)(Rf + ro + bj * HALF + 4); } }
#pragma unroll
                for (int mm = 0; mm < 2; ++mm) { const int m = (am & 1) * 2 + mm; const size_t ro = o + (size_t)(ai * HALF + wr * 64 + m * 16 + fr) * D_ + wc * 32 + 8 * fq;
#pragma unroll
                    for (int bj = 0; bj < 2; ++bj) { const f32x4 v0 = acc[ai][bj][m][0] * sc + r0[mm][bj], v1 = acc[ai][bj][m][1] * sc + r1[mm][bj];
                        u32x4 w; w.x = cvt_pk_bf16(v0[0], v0[1]); w.y = cvt_pk_bf16(v0[2], v0[3]); w.z = cvt_pk_bf16(v1[0], v1[1]); w.w = cvt_pk_bf16(v1[2], v1[3]);
                        *(u32x4*)(O + ro + bj * HALF) = w; } } }
        } else {
#pragma unroll
            for (int ai = 0; ai < 2; ++ai) { u32x4 rr[4][2];
#pragma unroll
                for (int m = 0; m < 4; ++m) { const size_t ro = o + (size_t)(ai * HALF + wr * 64 + m * 16 + fr) * D_ + wc * 32 + 8 * fq;
#pragma unroll
                    for (int bj = 0; bj < 2; ++bj) rr[m][bj] = *(const u32x4*)(Rb + ro + bj * HALF); }
#pragma unroll
                for (int m = 0; m < 4; ++m) { const size_t ro = o + (size_t)(ai * HALF + wr * 64 + m * 16 + fr) * D_ + wc * 32 + 8 * fq;
#pragma unroll
                    for (int bj = 0; bj < 2; ++bj) { f32x4 v0 = acc[ai][bj][m][0] * sc, v1 = acc[ai][bj][m][1] * sc; const u32x4 r = rr[m][bj];
                        v0[0] += bf_lo(r.x); v0[1] += bf_hi(r.x); v0[2] += bf_lo(r.y); v0[3] += bf_hi(r.y); v1[0] += bf_lo(r.z); v1[1] += bf_hi(r.z); v1[2] += bf_lo(r.w); v1[3] += bf_hi(r.w);
                        u32x4 w; w.x = cvt_pk_bf16(v0[0], v0[1]); w.y = cvt_pk_bf16(v0[2], v0[3]); w.z = cvt_pk_bf16(v1[0], v1[1]); w.w = cvt_pk_bf16(v1[2], v1[3]);
                        *(u32x4*)(O + ro + bj * HALF) = w; } } }
        }
    }
};
struct EpiLogits {
    float* O;
    __device__ __forceinline__ void operator()(const Acc& acc, const UnitD& u, int wr, int wc, int fr, int fq) const { store_f32_tile(acc, O + (size_t)u.t0 * BM * 128, nullptr, 128, 128, wr, wc, fr, fq); }
};
struct EpiSwiGLU {
    unsigned char* O;
    __device__ __forceinline__ void operator()(const Acc& acc, const UnitD& u, int wr, int wc, int fr, int fq) const {
        unsigned char* o = O + (size_t)u.t0 * BM * DEXP + u.t1 * 128;
#pragma unroll
        for (int ai = 0; ai < 2; ++ai)
#pragma unroll
            for (int m = 0; m < 4; ++m) { unsigned char* rowp = o + (size_t)(ai * HALF + wr * 64 + m * 16 + fr) * DEXP + wc * 32 + 8 * fq;
                float r[8];
#pragma unroll
                for (int n = 0; n < 2; ++n)
#pragma unroll
                    for (int j = 0; j < 4; ++j) r[n * 4 + j] = (ACT8_SCALE / W8_SCALE) * siluf_(acc[ai][0][m][n][j] * (1.0f / W8_SCALE)) * acc[ai][1][m][n][j];
                u32x2 w; w.x = pk_fp8x4(r[0], r[1], r[2], r[3]); w.y = pk_fp8x4(r[4], r[5], r[6], r[7]);
                *(u32x2*)rowp = w; }
    }
};
struct EpiDown {
    unsigned char* O;
    __device__ __forceinline__ void operator()(const Acc& acc, const UnitD& u, int wr, int wc, int fr, int fq) const {
        unsigned char* o = O + (size_t)u.t0 * BM * D_ + u.t1 * BM; const float sc = 1.0f / (W8_SCALE * ACT8_SCALE);
#pragma unroll
        for (int ai = 0; ai < 2; ++ai)
#pragma unroll
            for (int m = 0; m < 4; ++m) { unsigned char* rowp = o + (size_t)(ai * HALF + wr * 64 + m * 16 + fr) * D_ + wc * 32 + 8 * fq;
#pragma unroll
                for (int bj = 0; bj < 2; ++bj) { const f32x4 v0 = acc[ai][bj][m][0] * sc, v1 = acc[ai][bj][m][1] * sc;
                    u32x2 w; w.x = pk_fp8x4(v0[0], v0[1], v0[2], v0[3]); w.y = pk_fp8x4(v1[0], v1[1], v1[2], v1[3]); *(u32x2*)(rowp + bj * HALF) = w; } }
    }
};
__device__ __forceinline__ unsigned rg_idx(unsigned tok, int c) { return ((((tok >> 12) * 64u + (unsigned)(c >> 4)) * (unsigned)S_ + (tok & (unsigned)(S_ - 1))) << 4) + (unsigned)(c & 15); }
struct EpiRgGates {
    bf16_t* LAo; bf16_t* Uo; const bf16_t* xc;
    const float* ba; const float* bx; const float* lam;
    __device__ __forceinline__ void operator()(const Acc& acc, const UnitD& u, int wr, int wc, int fr, int fq) const {
#pragma unroll
        for (int n = 0; n < 2; ++n) { const int c = u.t1 * 128 + wc * 32 + 8 * fq + 4 * n;
            u32x2 xq[2][4];
#pragma unroll
            for (int ai = 0; ai < 2; ++ai)
#pragma unroll
                for (int m = 0; m < 4; ++m) xq[ai][m] = *(const u32x2*)(xc + ((unsigned)(u.t0 * BM + ai * HALF + wr * 64 + m * 16 + fr) * 1024u + (unsigned)c));
            const f32x4 vba = *(const f32x4*)(ba + c), vbx = *(const f32x4*)(bx + c), vl = *(const f32x4*)(lam + c);
            f32x4 c8; for (int j = 0; j < 4; ++j) c8[j] = -8.0f * softplusf_(-vl[j]);
#pragma unroll
            for (int ai = 0; ai < 2; ++ai)
#pragma unroll
                for (int m = 0; m < 4; ++m) { const unsigned tok = (unsigned)(u.t0 * BM + ai * HALF + wr * 64 + m * 16 + fr);
                    const u32x2 xw = xq[ai][m]; const float xv[4] = {bf_lo(xw.x), bf_hi(xw.x), bf_lo(xw.y), bf_hi(xw.y)};
                    f32x4 lv, uv;
#pragma unroll
                    for (int j = 0; j < 4; ++j) { const float r = sigmoidf_(acc[ai][0][m][n][j] + vba[j]), ig = sigmoidf_(acc[ai][1][m][n][j] + vbx[j]);
                        const float la = c8[j] * r, av = __expf(la); lv[j] = la; uv[j] = __builtin_amdgcn_sqrtf(fmaxf(0.f, 1.0f - av * av)) * ig * xv[j]; }
                    const unsigned o = rg_idx(tok, c);
                    u32x2 w0; w0.x = cvt_pk_bf16(lv[0], lv[1]); w0.y = cvt_pk_bf16(lv[2], lv[3]); *(u32x2*)(LAo + o) = w0;
                    u32x2 w1; w1.x = cvt_pk_bf16(uv[0], uv[1]); w1.y = cvt_pk_bf16(uv[2], uv[3]); *(u32x2*)(Uo + o) = w1; } }
    }
};


__device__ __forceinline__ void transpose_job8(const float* src, unsigned char* dst, int K, int N, int ldd, size_t sb, size_t db, int nbatch, LAS unsigned char* lds) {
    const int tid = TIDX, tk = K / 128, tn = N / 64, per = tk * tn, total = per * nbatch;
    const int rr0 = tid >> 4, c4 = (tid & 15) * 4, n = tid >> 3, kg = (tid & 7) * 16;
    f32x4 va[4], vb[4];
#define T8_LD(v, t) { const int u_ = (t), ub_ = u_ / per, ur_ = u_ % per, uik_ = ur_ / tn, uin_ = ur_ % tn; const float* usp_ = src + (size_t)ub_ * sb + (size_t)(uik_ * 128 + rr0) * N + uin_ * 64 + c4; \
        _Pragma("unroll") for (int i = 0; i < 4; ++i) v[i] = *(const f32x4*)(usp_ + (size_t)(i * 32) * N); }
#define T8_ST(v, t, buf) { const int t_ = (t), b_ = t_ / per, r_ = t_ % per, ik_ = r_ / tn, in_ = r_ % tn; LAS float* tile = (LAS float*)(lds + (buf) * (128 * 65 * 4)); \
        _Pragma("unroll") for (int i = 0; i < 4; ++i) { const int rr = rr0 + i * 32; tile[rr * 65 + c4 + 0] = v[i][0]; tile[rr * 65 + c4 + 1] = v[i][1]; tile[rr * 65 + c4 + 2] = v[i][2]; tile[rr * 65 + c4 + 3] = v[i][3]; } \
        if (t_ + 2 * NBLK < total) T8_LD(v, t_ + 2 * NBLK) \
        LDS_BARRIER(); \
        float f[16]; \
        _Pragma("unroll") for (int j = 0; j < 16; ++j) f[j] = tile[(kg + j) * 65 + n] * W8_SCALE; \
        u32x4 w; w.x = pk_fp8x4(f[0], f[1], f[2], f[3]); w.y = pk_fp8x4(f[4], f[5], f[6], f[7]); w.z = pk_fp8x4(f[8], f[9], f[10], f[11]); w.w = pk_fp8x4(f[12], f[13], f[14], f[15]); \
        *(u32x4*)(dst + (size_t)b_ * db + (size_t)(in_ * 64 + n) * ldd + ik_ * 128 + kg) = w; }
    int t = BID;
    if (t < total) T8_LD(va, t)
    if (t + NBLK < total) T8_LD(vb, t + NBLK)
    for (; t < total; t += 2 * NBLK) {
        T8_ST(va, t, 0)
        if (t + NBLK < total) T8_ST(vb, t + NBLK, 1)
    }
#undef T8_LD
#undef T8_ST
    LDS_BARRIER();
}
__device__ __forceinline__ void transpose_job(const float* src, bf16_t* dst, int K, int N, int ldd, size_t sb, size_t db, int dalt, int nbatch, LAS unsigned char* lds) {
    const int tid = TIDX, tk = K / 64, tn = N / 64, per = tk * tn, total = per * nbatch;
    const int rr0 = tid >> 4, c4 = (tid & 15) * 4, n = tid >> 3, kg = (tid & 7) * 8;
    f32x4 va[2], vb[2];
#define T16_LD(v, t) { const int u_ = (t), ub_ = u_ / per, ur_ = u_ % per, uik_ = ur_ / tn, uin_ = ur_ % tn; const float* usp_ = src + (size_t)ub_ * sb + (size_t)(uik_ * 64 + rr0) * N + uin_ * 64 + c4; \
        _Pragma("unroll") for (int i = 0; i < 2; ++i) v[i] = *(const f32x4*)(usp_ + (size_t)(i * 32) * N); }
#define T16_ST(v, t, buf) { const int t_ = (t), b_ = t_ / per, r_ = t_ % per, ik_ = r_ / tn, in_ = r_ % tn; LAS float* tile = (LAS float*)(lds + (buf) * (64 * 65 * 4)); \
        _Pragma("unroll") for (int i = 0; i < 2; ++i) { const int rr = rr0 + i * 32; tile[rr * 65 + c4 + 0] = v[i][0]; tile[rr * 65 + c4 + 1] = v[i][1]; tile[rr * 65 + c4 + 2] = v[i][2]; tile[rr * 65 + c4 + 3] = v[i][3]; } \
        if (t_ + 2 * NBLK < total) T16_LD(v, t_ + 2 * NBLK) \
        LDS_BARRIER(); \
        float f[8]; \
        _Pragma("unroll") for (int j = 0; j < 8; ++j) f[j] = tile[(kg + j) * 65 + n]; \
        u32x4 w; w.x = cvt_pk_bf16(f[0], f[1]); w.y = cvt_pk_bf16(f[2], f[3]); w.z = cvt_pk_bf16(f[4], f[5]); w.w = cvt_pk_bf16(f[6], f[7]); \
        *(u32x4*)(dst + (size_t)b_ * db + (size_t)(b_ & 1) * dalt + (size_t)(in_ * 64 + n) * ldd + ik_ * 64 + kg) = w; }
    int t = BID;
    if (t < total) T16_LD(va, t)
    if (t + NBLK < total) T16_LD(vb, t + NBLK)
    for (; t < total; t += 2 * NBLK) {
        T16_ST(va, t, 0)
        if (t + NBLK < total) T16_ST(vb, t + NBLK, 1)
    }
#undef T16_LD
#undef T16_ST
    LDS_BARRIER();
}

__device__ __forceinline__ void moe_weight_jobs(const Args& a, int layer, LAS unsigned char* lds) {
    const size_t lo = (size_t)layer * NEXP * D_ * DEXP;
    transpose_job8(a.in[25] + lo, a.ws + WS_WG, D_, DEXP, D_, (size_t)D_ * DEXP, (size_t)DEXP * D_, NEXP, lds);
    transpose_job8(a.in[26] + lo, a.ws + WS_WU, D_, DEXP, D_, (size_t)D_ * DEXP, (size_t)DEXP * D_, NEXP, lds);
    transpose_job8(a.in[27] + lo, a.ws + WS_WD, DEXP, D_, DEXP, (size_t)D_ * DEXP, (size_t)DEXP * D_, NEXP, lds);
}

__device__ __forceinline__ void phase_prologue(const Args& a, LAS unsigned char* lds) {
    const int gtid = BID * NTHREADS + TIDX, gsz = NBLK * NTHREADS;
    for (int i = gtid; i < 1024; i += gsz) { const float l0 = a.in[12][i], l1 = a.in[12][1024 + i], mx = fmaxf(l0, l1), e0 = __expf(l0 - mx), e1 = __expf(l1 - mx);
        ((float*)(a.ws + WS_LB))[i] = e0 / (e0 + e1); }
    for (int it = gtid; it < 2 * 256 * 256; it += gsz) { const int l = it >> 16, n = (it >> 8) & 255, k8 = (it & 255) * 8; float f[8];
#pragma unroll
        for (int j = 0; j < 8; ++j) { const int k = k8 + j; f[j] = n < 8 ? a.in[21][((size_t)l * D_ + k) * 8 + n] : (n < 72 ? a.in[23][((size_t)l * D_ + k) * 64 + (n - 8)] : 0.f); }
        u32x4 w; w.x = cvt_pk_bf16(f[0], f[1]); w.y = cvt_pk_bf16(f[2], f[3]); w.z = cvt_pk_bf16(f[4], f[5]); w.w = cvt_pk_bf16(f[6], f[7]);
        *(u32x4*)((bf16_t*)(a.ws + WS_WRT) + ((size_t)l * 256 + n) * D_ + k8) = w; }
    for (int it = gtid; it < 192 * 128; it += gsz) *(u32x4*)(a.ws + WS_WIN1T + (size_t)N_IN1 * D_ + (size_t)it * 16) = (u32x4){0u, 0u, 0u, 0u};
    transpose_job(a.in[4], (bf16_t*)(a.ws + WS_WIN0T), D_, N_IN0, D_, 0, 0, 0, 1, lds);
    transpose_job(a.in[14], (bf16_t*)(a.ws + WS_WOUT0T), D_, D_, D_, 0, 0, 0, 1, lds);
    transpose_job8(a.in[15], a.ws + WS_WIN1T, D_, N_IN1, D_, 0, 0, 1, lds);
    transpose_job8(a.in[20], a.ws + WS_WOUT1T, 4096, D_, 4096, 0, 0, 1, lds);
    transpose_job(a.in[7], (bf16_t*)(a.ws + WS_WGATES), 128, 128, 128, 128 * 128, 256 * 128, 0, 8, lds);
    transpose_job(a.in[9], (bf16_t*)(a.ws + WS_WGATES) + 128 * 128, 128, 128, 128, 128 * 128, 256 * 128, 0, 8, lds);
    moe_weight_jobs(a, 0, lds);
}

#define NORM_PH(M, F) phase_norm<M, F>
template <int MODE, bool F32>
__device__ __forceinline__ void phase_norm(const Args& a, const float* src, const float* gain, int layer) {
    const int wid = TIDX >> 6, lane = TIDX & 63;
    bf16_t* xw = (bf16_t*)(a.ws + WS_X); bf16_t* hw = (bf16_t*)(a.ws + WS_H);
    const unsigned char* ym = a.ws + WS_YMOE; const int* posof = (const int*)(a.ws + WS_POSOF); const float* gate = (const float*)(a.ws + WS_GATE);
    const int stride = NBLK * 16;
    f32x4 rf[2][8]; u32x2 rb[2][8]; int pp[2][2] = {{0, 0}, {0, 0}}; float pg[2][2] = {{0.f, 0.f}, {0.f, 0.f}};
#define NORM_LD(r) { _Pragma("unroll") for (int u = 0; u < 2; ++u) { _Pragma("unroll") for (int i = 0; i < 8; ++i) { \
            if (F32) rf[u][i] = *(const f32x4*)(src + (size_t)((r) + u) * D_ + (i * 64 + lane) * 4); else rb[u][i] = *(const u32x2*)(xw + (size_t)((r) + u) * D_ + (i * 64 + lane) * 4); } \
            if (MODE >= 1) { pp[u][0] = posof[((r) + u) * 2]; pp[u][1] = posof[((r) + u) * 2 + 1]; pg[u][0] = gate[((r) + u) * 2]; pg[u][1] = gate[((r) + u) * 2 + 1]; } } }
    int row = (BID * 8 + wid) * 2;
    if (row < T_) NORM_LD(row)
    for (; row < T_; row += stride) {
        f32x4 v[2][8]; int p[2][2]; float g[2][2];
#pragma unroll
        for (int u = 0; u < 2; ++u) { p[u][0] = pp[u][0]; p[u][1] = pp[u][1]; g[u][0] = pg[u][0]; g[u][1] = pg[u][1];
#pragma unroll
            for (int i = 0; i < 8; ++i) v[u][i] = F32 ? rf[u][i] : (f32x4){bf_lo(rb[u][i].x), bf_hi(rb[u][i].x), bf_lo(rb[u][i].y), bf_hi(rb[u][i].y)}; }
        if (row + stride < T_) NORM_LD(row + stride)
        if (MODE >= 1) {
            int y[2][8][2];
#pragma unroll
            for (int u = 0; u < 2; ++u) {
#pragma unroll
                for (int i = 0; i < 8; ++i) { const int c = (i * 64 + lane) * 4; y[u][i][0] = *(const int*)(ym + (size_t)p[u][0] * D_ + c); y[u][i][1] = *(const int*)(ym + (size_t)p[u][1] * D_ + c); } }
#pragma unroll
            for (int u = 0; u < 2; ++u) { const float g0 = g[u][0], g1 = g[u][1];
#pragma unroll
                for (int i = 0; i < 8; ++i) { const int y0 = y[u][i][0], y1 = y[u][i][1];
                    const f32x2 a0 = __builtin_amdgcn_cvt_pk_f32_fp8(y0, false), a1 = __builtin_amdgcn_cvt_pk_f32_fp8(y0, true), b0 = __builtin_amdgcn_cvt_pk_f32_fp8(y1, false), b1 = __builtin_amdgcn_cvt_pk_f32_fp8(y1, true);
                    v[u][i][0] += g0 * a0[0] + g1 * b0[0]; v[u][i][1] += g0 * a0[1] + g1 * b0[1]; v[u][i][2] += g0 * a1[0] + g1 * b1[0]; v[u][i][3] += g0 * a1[1] + g1 * b1[1]; }
                if (MODE == 1) {
#pragma unroll
                    for (int i = 0; i < 8; ++i) { u32x2 w; w.x = cvt_pk_bf16(v[u][i][0], v[u][i][1]); w.y = cvt_pk_bf16(v[u][i][2], v[u][i][3]); *(u32x2*)(xw + (size_t)(row + u) * D_ + (i * 64 + lane) * 4) = w; } } }
        }
#pragma unroll
        for (int u = 0; u < 2; ++u) {
            float ss = 0.f;
#pragma unroll
            for (int i = 0; i < 8; ++i) ss += v[u][i][0] * v[u][i][0] + v[u][i][1] * v[u][i][1] + v[u][i][2] * v[u][i][2] + v[u][i][3] * v[u][i][3];
            ss = wave_sum(ss);
            const float rstd = rsqrtf(ss * (1.0f / D_) + 1e-6f);
#pragma unroll
            for (int i = 0; i < 8; ++i) { const int c = (i * 64 + lane) * 4; const f32x4 gn = *(const f32x4*)(gain + c);
                const f32x4 o = v[u][i] * rstd * gn;
                if (MODE == 2) *(f32x4*)(a.out + (size_t)(row + u) * D_ + c) = o;
                else { if (MODE != 1) { u32x2 w; w.x = cvt_pk_bf16(o[0], o[1]); w.y = cvt_pk_bf16(o[2], o[3]); *(u32x2*)(hw + (size_t)(row + u) * D_ + c) = w; }
                       if (layer >= 0) *(unsigned*)(a.ws + WS_H8 + (size_t)(row + u) * D_ + c) = pk_fp8x4(o[0], o[1], o[2], o[3]); } } }
    }
#undef NORM_LD
    (void)layer;
}

__device__ __forceinline__ void phase_gemm_in0(const Args& a, LAS unsigned char* lds) {
    SrcGrid S{(const char*)(a.ws + WS_H), (const char*)(a.ws + WS_WIN0T), (size_t)BM * D_ * 2, (size_t)BM * D_ * 2, 64, 64 * 24, D_, D_};
    EpiProj E{(bf16_t*)(a.ws + WS_PROJ), N_IN0, (float*)(a.ws + WS_FLOG), 1024, 12, 16, 256, 1.0f};
    gemm_stream<false, false>(lds, S, D_ / BK, E);
}

__device__ __forceinline__ void phase_rg_conv(const Args& a) {
    const bf16_t* p0 = (const bf16_t*)(a.ws + WS_PROJ); bf16_t* xc = (bf16_t*)(a.ws + WS_XC);
    const float* cw = a.in[5]; const float* cb = a.in[6];
    for (int it = BID * NTHREADS + TIDX; it < 128 * (T_ / 16); it += NBLK * NTHREADS) { const int c = (it & 127) * 8; const size_t t0 = (size_t)(it >> 7) * 16;
        float w[4][8], bias[8];
#pragma unroll
        for (int k = 0; k < 4; ++k) { const f32x4 w0 = *(const f32x4*)(cw + k * 1024 + c), w1 = *(const f32x4*)(cw + k * 1024 + c + 4);
            w[k][0] = w0[0]; w[k][1] = w0[1]; w[k][2] = w0[2]; w[k][3] = w0[3]; w[k][4] = w1[0]; w[k][5] = w1[1]; w[k][6] = w1[2]; w[k][7] = w1[3]; }
        { const f32x4 b0 = *(const f32x4*)(cb + c), b1 = *(const f32x4*)(cb + c + 4); bias[0] = b0[0]; bias[1] = b0[1]; bias[2] = b0[2]; bias[3] = b0[3]; bias[4] = b1[0]; bias[5] = b1[1]; bias[6] = b1[2]; bias[7] = b1[3]; }
        u32x4 x0 = (u32x4){0u, 0u, 0u, 0u}, x1 = x0, x2 = x0;
        if ((t0 & (S_ - 1)) != 0) { x0 = *(const u32x4*)(p0 + (t0 - 3) * N_IN0 + c); x1 = *(const u32x4*)(p0 + (t0 - 2) * N_IN0 + c); x2 = *(const u32x4*)(p0 + (t0 - 1) * N_IN0 + c); }
        u32x4 xr[16];
#pragma unroll
        for (int r = 0; r < 16; ++r) xr[r] = *(const u32x4*)(p0 + (t0 + r) * N_IN0 + c);
#pragma unroll
        for (int r = 0; r < 16; ++r) { const u32x4 x3 = xr[r];
            float acc[8];
#define TAPS(j, f, m) (bias[j] + w[0][j] * f(x0.m) + w[1][j] * f(x1.m) + w[2][j] * f(x2.m) + w[3][j] * f(x3.m))
            acc[0] = TAPS(0, bf_lo, x); acc[1] = TAPS(1, bf_hi, x); acc[2] = TAPS(2, bf_lo, y); acc[3] = TAPS(3, bf_hi, y);
            acc[4] = TAPS(4, bf_lo, z); acc[5] = TAPS(5, bf_hi, z); acc[6] = TAPS(6, bf_lo, w); acc[7] = TAPS(7, bf_hi, w);
#undef TAPS
            u32x4 o; o.x = cvt_pk_bf16(acc[0], acc[1]); o.y = cvt_pk_bf16(acc[2], acc[3]); o.z = cvt_pk_bf16(acc[4], acc[5]); o.w = cvt_pk_bf16(acc[6], acc[7]);
            *(u32x4*)(xc + (t0 + r) * 1024 + c) = o;
            x0 = x1; x1 = x2; x2 = x3; } }
}

struct SrcRgGates {
    const char* xc; const char* w; int total;
    __device__ __forceinline__ bool next(int i, UnitD& u) const { const int id = BID + i * NBLK; if (id >= total) return false; u.t0 = id & 63; u.t1 = id >> 6; u.t2 = 0;
        u.gA = xc + ((size_t)u.t0 * BM * 1024 + u.t1 * 128) * 2; u.gB = w + (size_t)u.t1 * 256 * 128 * 2; return true; }
    __device__ __forceinline__ void va(const UnitD&, unsigned (&v)[2][2]) const { offs_direct(v, 1024, false); }
    __device__ __forceinline__ void vb(unsigned (&v)[2][2]) const { offs_direct(v, 128, true); }
};
__device__ __forceinline__ void phase_rg_gates(const Args& a, LAS unsigned char* lds) {
    SrcRgGates S{(const char*)(a.ws + WS_XC), (const char*)(a.ws + WS_WGATES), 64 * 8};
    EpiRgGates E{(bf16_t*)(a.ws + WS_A), (bf16_t*)(a.ws + WS_U), (const bf16_t*)(a.ws + WS_XC), a.in[8], a.in[10], a.in[11]};
    int nt = 2; asm volatile("" : "+s"(nt));
    gemm_stream<false, false>(lds, S, nt, E);
}

__device__ __forceinline__ void phase_rg_scan(const Args& a, LAS unsigned char* lds) {
    const bf16_t* LA = (const bf16_t*)(a.ws + WS_A); const bf16_t* U = (const bf16_t*)(a.ws + WS_U);
    const bf16_t* p0 = (const bf16_t*)(a.ws + WS_PROJ); bf16_t* Y = (bf16_t*)(a.ws + WS_Y);
    LAS float* sP = (LAS float*)lds; LAS float* sH = sP + 4096; LAS float* gP = sH + 4096; LAS float* gH = gP + 512; LAS float* gC = gH + 512;
    const int tid = TIDX, seg = tid >> 1, c8 = (tid & 1) * 8;
    for (int blk = BID; blk < NB_ * 64; blk += NBLK) { const int b = blk >> 6, c = (blk & 63) * 16 + c8;
        const size_t base = (((size_t)blk * S_ + seg * 16) << 4) + c8;
        float P[8], H[8];
#pragma unroll
        for (int j = 0; j < 8; ++j) { P[j] = 1.f; H[j] = 0.f; }
#pragma unroll 4
        for (int s = 0; s < 16; ++s) { const u32x4 lw = *(const u32x4*)(LA + base + (size_t)s * 16), uw = *(const u32x4*)(U + base + (size_t)s * 16);
            const float la[8] = {bf_lo(lw.x), bf_hi(lw.x), bf_lo(lw.y), bf_hi(lw.y), bf_lo(lw.z), bf_hi(lw.z), bf_lo(lw.w), bf_hi(lw.w)};
            const float uu[8] = {bf_lo(uw.x), bf_hi(uw.x), bf_lo(uw.y), bf_hi(uw.y), bf_lo(uw.z), bf_hi(uw.z), bf_lo(uw.w), bf_hi(uw.w)};
#pragma unroll
            for (int j = 0; j < 8; ++j) { const float av = __expf(la[j]); H[j] = av * H[j] + uu[j]; P[j] *= av; } }
        __syncthreads();
#pragma unroll
        for (int j = 0; j < 8; ++j) { sP[seg * 16 + c8 + j] = P[j]; sH[seg * 16 + c8 + j] = H[j]; }
        __syncthreads();
        { const int ch = tid & 15, grp = tid >> 4; float p = 1.f, h = 0.f;
#pragma unroll
          for (int q = 0; q < 8; ++q) { const int sgi = grp * 8 + q; h = sP[sgi * 16 + ch] * h + sH[sgi * 16 + ch]; p *= sP[sgi * 16 + ch]; }
          gP[grp * 16 + ch] = p; gH[grp * 16 + ch] = h; }
        __syncthreads();
        if (tid < 16) { float carry = 0.f; for (int g = 0; g < 32; ++g) { gC[g * 16 + tid] = carry; carry = gP[g * 16 + tid] * carry + gH[g * 16 + tid]; } }
        __syncthreads();
        { const int ch = tid & 15, grp = tid >> 4; float h = gC[grp * 16 + ch];
#pragma unroll
          for (int q = 0; q < 8; ++q) { const int sgi = grp * 8 + q; const float pin = sP[sgi * 16 + ch], hin = sH[sgi * 16 + ch]; sH[sgi * 16 + ch] = h; h = pin * h + hin; } }
        __syncthreads();
#pragma unroll
        for (int j = 0; j < 8; ++j) H[j] = sH[seg * 16 + c8 + j];
        {
            u32x4 l_a[4], u_a[4], g_a[4];
#define RS_LD(Lv, Uv, Gv, s0) { _Pragma("unroll") for (int j = 0; j < 4; ++j) { const int s_ = (s0) + j; Lv[j] = *(const u32x4*)(LA + base + (size_t)s_ * 16); Uv[j] = *(const u32x4*)(U + base + (size_t)s_ * 16); \
                Gv[j] = *(const u32x4*)(p0 + ((size_t)b * S_ + seg * 16 + s_) * N_IN0 + 1024 + c); } }
            RS_LD(l_a, u_a, g_a, 0)
#pragma unroll
            for (int s0 = 0; s0 < 16; s0 += 4) { u32x4 l_b[4], u_b[4], g_b[4];
#pragma unroll
                for (int j = 0; j < 4; ++j) { l_b[j] = l_a[j]; u_b[j] = u_a[j]; g_b[j] = g_a[j]; }
                if (s0 + 4 < 16) RS_LD(l_b, u_b, g_b, s0 + 4)
#pragma unroll
                for (int j = 0; j < 4; ++j) { const u32x4 lw = l_a[j], uw = u_a[j], gw = g_a[j]; const size_t t = (size_t)b * S_ + seg * 16 + s0 + j;
                    const float la[8] = {bf_lo(lw.x), bf_hi(lw.x), bf_lo(lw.y), bf_hi(lw.y), bf_lo(lw.z), bf_hi(lw.z), bf_lo(lw.w), bf_hi(lw.w)};
                    const float uu[8] = {bf_lo(uw.x), bf_hi(uw.x), bf_lo(uw.y), bf_hi(uw.y), bf_lo(uw.z), bf_hi(uw.z), bf_lo(uw.w), bf_hi(uw.w)};
                    const float gg[8] = {bf_lo(gw.x), bf_hi(gw.x), bf_lo(gw.y), bf_hi(gw.y), bf_lo(gw.z), bf_hi(gw.z), bf_lo(gw.w), bf_hi(gw.w)};
                    float y[8];
#pragma unroll
                    for (int q = 0; q < 8; ++q) { H[q] = __expf(la[q]) * H[q] + uu[q]; y[q] = H[q] * gelu_tanh(gg[q]); }
                    u32x4 o; o.x = cvt_pk_bf16(y[0], y[1]); o.y = cvt_pk_bf16(y[2], y[3]); o.z = cvt_pk_bf16(y[4], y[5]); o.w = cvt_pk_bf16(y[6], y[7]);
                    *(u32x4*)(Y + t * D_ + c) = o; }
#pragma unroll
                for (int j = 0; j < 4; ++j) { l_a[j] = l_b[j]; u_a[j] = u_b[j]; g_a[j] = g_b[j]; } }
#undef RS_LD
        }
    }
}

typedef short s16x4 __attribute__((ext_vector_type(4)));
__device__ __forceinline__ f32x4 mfma32(bf16x8 a, bf16x8 b, f32x4 c) { return __builtin_amdgcn_mfma_f32_16x16x32_bf16(a, b, c, 0, 0, 0); }
__device__ __forceinline__ bf16x8 lds_frag(LAS const unsigned char* p) { return *(const LAS bf16x8*)p; }
__device__ __forceinline__ s16x4 lds_tr4(LAS const unsigned char* p) { return __builtin_amdgcn_ds_read_tr16_b64_v4i16((LAS s16x4*)p); }
__device__ __forceinline__ bf16x8 lds_tr8(LAS const unsigned char* p, int rowskip_bytes) {
    const s16x4 lo = lds_tr4(p), hi = lds_tr4(p + rowskip_bytes); return __builtin_shufflevector(lo, hi, 0, 1, 2, 3, 4, 5, 6, 7); }
__device__ __forceinline__ bf16x8 pack8(const f32x4& lo, const f32x4& hi) { u32x4 w; w.x = cvt_pk_bf16(lo[0], lo[1]); w.y = cvt_pk_bf16(lo[2], lo[3]); w.z = cvt_pk_bf16(hi[0], hi[1]); w.w = cvt_pk_bf16(hi[2], hi[3]); return __builtin_bit_cast(bf16x8, w); }
constexpr int RSB = 272;

constexpr size_t WS_HQ = WS_O;
constexpr size_t WS_HA = WS_HQ + (size_t)2048 * 64 * 128 * 2;
constexpr size_t WS_HG = WS_HA + (size_t)2048 * 8 * 512 * 2;
constexpr size_t WS_HS = WS_HG + (size_t)2048 * 128 * 128 * 2;
constexpr size_t WS_HD = WS_HS + (size_t)2048 * 128 * 128 * 2;
static_assert(WS_HD + (size_t)2048 * 128 * 4 <= WS_TAIL, "hgrn overlay");

__device__ __forceinline__ void phase_hg1(const Args& a, LAS unsigned char* lds) {
    const bf16_t* p0 = (const bf16_t*)(a.ws + WS_PROJ); const float* flog = (const float*)(a.ws + WS_FLOG); const float* lb = (const float*)(a.ws + WS_LB);
    bf16_t* QG = (bf16_t*)(a.ws + WS_HQ); bf16_t* AG = (bf16_t*)(a.ws + WS_HA); bf16_t* GG = (bf16_t*)(a.ws + WS_HG); float* DG = (float*)(a.ws + WS_HD);
    constexpr int SEG = 0, QT = 4096, KT = QT + 64 * RSB, KH = KT + 64 * RSB, VS = KH + 64 * RSB;
    const int tid = TIDX, wid = tid >> 6, lane = tid & 63, I = lane & 15, G = lane >> 4, k2 = 2 * lane, sg = wid;
    LAS float* seg = (LAS float*)(lds + SEG);
    u32x4 pvv[2]; f32x2 pz[8]; unsigned pqw[8];
#define HG1_LOAD(it_) do { const int bh_ = (it_) >> 6, ck_ = (it_) & 63, h_ = bh_ & 7; const size_t t0_ = (size_t)(bh_ >> 3) * S_ + ck_ * 64; \
        _Pragma("unroll") for (int i = 0; i < 2; ++i) { const int c = tid + i * 512, s_ = c >> 4, v8 = (c & 15) * 8; pvv[i] = *(const u32x4*)(p0 + (t0_ + s_) * N_IN0 + 4096 + h_ * 128 + v8); } \
        _Pragma("unroll") for (int i = 0; i < 8; ++i) { const size_t t_ = t0_ + sg * 8 + i; pz[i] = *(const f32x2*)(flog + t_ * 1024 + h_ * 128 + k2); pqw[i] = *(const unsigned*)(p0 + t_ * N_IN0 + 2048 + h_ * 128 + k2); } } while (0)
    if (BID < 2048) HG1_LOAD(BID);
    for (int item = BID; item < 2048; item += NBLK) { const int bh = item >> 6, h = bh & 7;
        LDS_BARRIER();
#pragma unroll
        for (int i = 0; i < 2; ++i) { const int c = tid + i * 512, s = c >> 4, v8 = (c & 15) * 8; *(LAS u32x4*)(lds + VS + s * RSB + v8 * 2) = pvv[i]; }
        const f32x2 l2 = *(const f32x2*)(lb + h * 128 + k2);
        float f[8][2], cb[8][2]; unsigned qw[8]; float c0 = 0.f, c1 = 0.f;
#pragma unroll
        for (int i = 0; i < 8; ++i) { const f32x2 z = pz[i]; qw[i] = pqw[i];
            f[i][0] = l2[0] + (1.0f - l2[0]) * sigmoidf_(z[0]); f[i][1] = l2[1] + (1.0f - l2[1]) * sigmoidf_(z[1]);
            c0 += __logf(f[i][0]); c1 += __logf(f[i][1]); cb[i][0] = c0; cb[i][1] = c1; }
        *(LAS f32x2*)(seg + sg * 128 + k2) = (f32x2){c0, c1};
        if (item + NBLK < 2048) HG1_LOAD(item + NBLK);
        LDS_BARRIER();
        float off0 = 0.f, off1 = 0.f, tot0 = 0.f, tot1 = 0.f;
#pragma unroll
        for (int s2 = 0; s2 < 8; ++s2) { const f32x2 v = *(const LAS f32x2*)(seg + s2 * 128 + k2); tot0 += v[0]; tot1 += v[1]; if (s2 < sg) { off0 += v[0]; off1 += v[1]; } }
        const float et0 = __expf(tot0), et1 = __expf(tot1);
#pragma unroll
        for (int i = 0; i < 8; ++i) { const int t = sg * 8 + i;
            const float e0 = __expf(cb[i][0] + off0), e1 = __expf(cb[i][1] + off1), r0 = __builtin_amdgcn_rcpf(e0), r1 = __builtin_amdgcn_rcpf(e1), km0 = 1.0f - f[i][0], km1 = 1.0f - f[i][1];
            const unsigned qt = cvt_pk_bf16(siluf_(bf_lo(qw[i])) * e0, siluf_(bf_hi(qw[i])) * e1);
            *(LAS unsigned*)(lds + QT + t * RSB + k2 * 2) = qt; *(unsigned*)(QG + ((size_t)item * 64 + t) * 128 + k2) = qt;
            *(LAS unsigned*)(lds + KT + t * RSB + k2 * 2) = cvt_pk_bf16(km0 * r0, km1 * r1);
            *(LAS unsigned*)(lds + KH + t * RSB + k2 * 2) = cvt_pk_bf16(km0 * r0 * et0, km1 * r1 * et1); }
        if (sg == 0) *(f32x2*)(DG + (size_t)item * 128 + k2) = (f32x2){et0, et1};
        LDS_BARRIER();
        { const int tt = wid & 3, sp = wid >> 2;
          bf16x8 qf[4];
#pragma unroll
          for (int ks = 0; ks < 4; ++ks) qf[ks] = lds_frag(lds + QT + (16 * tt + I) * RSB + (32 * ks + 8 * G) * 2);
          f32x4 acc[2];
#pragma unroll
          for (int hh = 0; hh < 2; ++hh) { const int st = 2 * sp + hh; acc[hh] = (f32x4){0.f, 0.f, 0.f, 0.f};
              if (st <= tt) {
#pragma unroll
                  for (int ks = 0; ks < 4; ++ks) acc[hh] = mfma32(lds_frag(lds + KT + (16 * st + I) * RSB + (32 * ks + 8 * G) * 2), qf[ks], acc[hh]);
#pragma unroll
                  for (int r = 0; r < 4; ++r) if (16 * st + 4 * G + r > 16 * tt + I) acc[hh][r] = 0.f; } }
          *(bf16x8*)(AG + (((size_t)item * 4 + tt) * 2 + sp) * 512 + lane * 8) = pack8(acc[0], acc[1]); }
        { const int kt = wid, q = I >> 2, p = I & 3;
          bf16x8 ka[2];
#pragma unroll
          for (int ks = 0; ks < 2; ++ks) ka[ks] = lds_tr8(lds + KH + (32 * ks + 8 * G + q) * RSB + (16 * kt + 4 * p) * 2, 4 * RSB);
#pragma unroll
          for (int vt = 0; vt < 8; ++vt) { f32x4 acc = (f32x4){0.f, 0.f, 0.f, 0.f};
#pragma unroll
              for (int ks = 0; ks < 2; ++ks) acc = mfma32(ka[ks], lds_tr8(lds + VS + (32 * ks + 8 * G + q) * RSB + (16 * vt + 4 * p) * 2, 4 * RSB), acc);
              u32x2 w; w.x = cvt_pk_bf16(acc[0], acc[1]); w.y = cvt_pk_bf16(acc[2], acc[3]);
              *(u32x2*)(GG + ((size_t)item * 128 + 16 * vt + I) * 128 + 16 * kt + 4 * G) = w; } }
    }
#undef HG1_LOAD
}

__device__ __forceinline__ void phase_hg2(const Args& a) {
    const bf16_t* GG = (const bf16_t*)(a.ws + WS_HG); const float* DG = (const float*)(a.ws + WS_HD); bf16_t* SG = (bf16_t*)(a.ws + WS_HS);
    for (int gid = BID * NTHREADS + TIDX; gid < 32 * 4096; gid += NBLK * NTHREADS) { const int bh = gid >> 12, e = gid & 4095, v = e >> 5, k4 = (e & 31) * 4;
        f32x4 S = (f32x4){0.f, 0.f, 0.f, 0.f};
        const size_t o0 = (((size_t)bh * 64) * 128 + v) * 128 + k4; const float* dg = DG + (size_t)bh * 64 * 128 + k4;
        f32x4 da[8]; u32x2 ga[8];
#pragma unroll
        for (int j = 0; j < 8; ++j) { da[j] = *(const f32x4*)(dg + j * 128); ga[j] = *(const u32x2*)(GG + o0 + (size_t)j * 16384); }
#pragma unroll 1
        for (int n0 = 0; n0 < 64; n0 += 8) { f32x4 db[8]; u32x2 gb[8];
#pragma unroll
            for (int j = 0; j < 8; ++j) { db[j] = da[j]; gb[j] = ga[j]; }
            if (n0 + 8 < 64) {
#pragma unroll
                for (int j = 0; j < 8; ++j) { db[j] = *(const f32x4*)(dg + (n0 + 8 + j) * 128); gb[j] = *(const u32x2*)(GG + o0 + (size_t)(n0 + 8 + j) * 16384); } }
#pragma unroll
            for (int j = 0; j < 8; ++j) { u32x2 w; w.x = cvt_pk_bf16(S[0], S[1]); w.y = cvt_pk_bf16(S[2], S[3]); *(u32x2*)(SG + o0 + (size_t)(n0 + j) * 16384) = w;
                const f32x4 d = da[j]; const u32x2 g = ga[j];
                S[0] = d[0] * S[0] + bf_lo(g.x); S[1] = d[1] * S[1] + bf_hi(g.x); S[2] = d[2] * S[2] + bf_lo(g.y); S[3] = d[3] * S[3] + bf_hi(g.y); }
#pragma unroll
            for (int j = 0; j < 8; ++j) { da[j] = db[j]; ga[j] = gb[j]; } } }
}

__device__ __forceinline__ void phase_hg3(const Args& a, LAS unsigned char* lds) {
    const bf16_t* p0 = (const bf16_t*)(a.ws + WS_PROJ); const bf16_t* QG = (const bf16_t*)(a.ws + WS_HQ); const bf16_t* AG = (const bf16_t*)(a.ws + WS_HA); const bf16_t* SG = (const bf16_t*)(a.ws + WS_HS);
    bf16_t* Y = (bf16_t*)(a.ws + WS_Y); const float* gain = a.in[13];
    constexpr int ST = 0, QT = 128 * RSB, VS = QT + 64 * RSB, PART = VS + 64 * RSB;
    const int tid = TIDX, wid = tid >> 6, lane = tid & 63, I = lane & 15, G = lane >> 4, q = I >> 2, p = I & 3;
    LAS float* part = (LAS float*)(lds + PART);
    const int tt = wid & 3, vh = wid >> 2;
    u32x4 ps[4], pq2[2], pv2[2]; bf16x8 paf[2];
#define HG3_LOAD(it_) do { const int bh_ = (it_) >> 6, ck_ = (it_) & 63; const size_t t0_ = (size_t)(bh_ >> 3) * S_ + ck_ * 64; const int h_ = bh_ & 7; \
        _Pragma("unroll") for (int i = 0; i < 4; ++i) { const int c = tid + i * 512, v = c >> 4, k8 = (c & 15) * 8; ps[i] = *(const u32x4*)(SG + ((size_t)(it_) * 128 + v) * 128 + k8); } \
        _Pragma("unroll") for (int i = 0; i < 2; ++i) { const int c = tid + i * 512, s_ = c >> 4, c8 = (c & 15) * 8; pq2[i] = *(const u32x4*)(QG + ((size_t)(it_) * 64 + s_) * 128 + c8); pv2[i] = *(const u32x4*)(p0 + (t0_ + s_) * N_IN0 + 4096 + h_ * 128 + c8); } \
        _Pragma("unroll") for (int sp = 0; sp < 2; ++sp) paf[sp] = *(const bf16x8*)(AG + (((size_t)(it_) * 4 + tt) * 2 + sp) * 512 + lane * 8); } while (0)
    if (BID < 2048) HG3_LOAD(BID);
    for (int item = BID; item < 2048; item += NBLK) { const int bh = item >> 6, ck = item & 63, b = bh >> 3, h = bh & 7; const size_t t0 = (size_t)b * S_ + ck * 64;
        LDS_BARRIER();
#pragma unroll
        for (int i = 0; i < 4; ++i) { const int c = tid + i * 512, v = c >> 4, k8 = (c & 15) * 8; *(LAS u32x4*)(lds + ST + v * RSB + k8 * 2) = ps[i]; }
#pragma unroll
        for (int i = 0; i < 2; ++i) { const int c = tid + i * 512, s2 = c >> 4, c8 = (c & 15) * 8; *(LAS u32x4*)(lds + QT + s2 * RSB + c8 * 2) = pq2[i]; *(LAS u32x4*)(lds + VS + s2 * RSB + c8 * 2) = pv2[i]; }
        bf16x8 af[2]; af[0] = paf[0]; af[1] = paf[1];
        if (item + NBLK < 2048) HG3_LOAD(item + NBLK);
        u32x2 zwp[4];
#pragma unroll
        for (int vi = 0; vi < 4; ++vi) zwp[vi] = *(const u32x2*)(p0 + (t0 + 16 * tt + I) * N_IN0 + 5120 + h * 128 + 16 * (4 * vh + vi) + 4 * G);
        LDS_BARRIER();
        bf16x8 qf[4];
#pragma unroll
        for (int ks = 0; ks < 4; ++ks) qf[ks] = lds_frag(lds + QT + (16 * tt + I) * RSB + (32 * ks + 8 * G) * 2);
        f32x4 acc[4]; float ss = 0.f;
#pragma unroll
        for (int vi = 0; vi < 4; ++vi) { const int vt = 4 * vh + vi; acc[vi] = (f32x4){0.f, 0.f, 0.f, 0.f};
#pragma unroll
            for (int ks = 0; ks < 4; ++ks) acc[vi] = mfma32(lds_frag(lds + ST + (16 * vt + I) * RSB + (32 * ks + 8 * G) * 2), qf[ks], acc[vi]);
#pragma unroll
            for (int sp = 0; sp < 2; ++sp) acc[vi] = mfma32(lds_tr8(lds + VS + (32 * sp + 4 * G + q) * RSB + (16 * vt + 4 * p) * 2, 16 * RSB), af[sp], acc[vi]);
            ss += acc[vi][0] * acc[vi][0] + acc[vi][1] * acc[vi][1] + acc[vi][2] * acc[vi][2] + acc[vi][3] * acc[vi][3]; }
        ss += __shfl_xor(ss, 16); ss += __shfl_xor(ss, 32);
        if (G == 0) part[wid * 16 + I] = ss;
        LDS_BARRIER();
        const float rstd = rsqrtf((part[wid * 16 + I] + part[(wid ^ 4) * 16 + I]) * (1.0f / 128.0f) + 1e-6f);
        const size_t t = t0 + 16 * tt + I;
#pragma unroll
        for (int vi = 0; vi < 4; ++vi) { const int c = h * 128 + 16 * (4 * vh + vi) + 4 * G;
            const f32x4 gn = *(const f32x4*)(gain + c); const u32x2 zw = zwp[vi];
            const float o0 = acc[vi][0] * rstd * gn[0] * siluf_(bf_lo(zw.x)), o1 = acc[vi][1] * rstd * gn[1] * siluf_(bf_hi(zw.x)), o2 = acc[vi][2] * rstd * gn[2] * siluf_(bf_lo(zw.y)), o3 = acc[vi][3] * rstd * gn[3] * siluf_(bf_hi(zw.y));
            u32x2 w; w.x = cvt_pk_bf16(o0, o1); w.y = cvt_pk_bf16(o2, o3); *(u32x2*)(Y + t * D_ + 1024 + c) = w; }
    }
#undef HG3_LOAD
}

__device__ __forceinline__ void phase_gdn_norm(const Args& a) {
    const bf16_t* O = (const bf16_t*)(a.ws + WS_O); const bf16_t* pj = (const bf16_t*)(a.ws + WS_PROJ); unsigned char* Y = a.ws + WS_Y; const float* gain = a.in[19];
    const int lane = TIDX & 63, wid = TIDX >> 6, gc = (lane & 15) * 8;
    const f32x4 g0 = *(const f32x4*)(gain + gc), g1 = *(const f32x4*)(gain + gc + 4);
    u32x4 oa[8], za[8];
    int row = BID * 8 + wid; const int stride = NBLK * 8;
#define GN_LD(ov, zv, r) { _Pragma("unroll") for (int i = 0; i < 8; ++i) { const int c = (i * 64 + lane) * 8; ov[i] = *(const u32x4*)(O + (size_t)(r) * 4096 + c); zv[i] = *(const u32x4*)(pj + (size_t)(r) * N_IN1P + 8192 + c); } }
    if (row < T_) GN_LD(oa, za, row)
    for (; row < T_; row += stride) { u32x4 ob[8], zb[8];
#pragma unroll
        for (int i = 0; i < 8; ++i) { ob[i] = oa[i]; zb[i] = za[i]; }
        if (row + stride < T_) GN_LD(ob, zb, row + stride)
#pragma unroll
        for (int i = 0; i < 8; ++i) { const int c = (i * 64 + lane) * 8;
            const u32x4 ow = oa[i], zw = za[i];
            const float o[8] = {bf_lo(ow.x), bf_hi(ow.x), bf_lo(ow.y), bf_hi(ow.y), bf_lo(ow.z), bf_hi(ow.z), bf_lo(ow.w), bf_hi(ow.w)};
            const float z[8] = {bf_lo(zw.x), bf_hi(zw.x), bf_lo(zw.y), bf_hi(zw.y), bf_lo(zw.z), bf_hi(zw.z), bf_lo(zw.w), bf_hi(zw.w)};
            float ss = 0.f;
#pragma unroll
            for (int q = 0; q < 8; ++q) ss += o[q] * o[q];
            ss = row16_sum(ss);
            const float rstd = rsqrtf(ss * (1.0f / 128.0f) + 1e-6f);
            float y[8];
#pragma unroll
            for (int q = 0; q < 8; ++q) y[q] = o[q] * rstd * (q < 4 ? g0[q & 3] : g1[q & 3]) * siluf_(z[q]);
            u32x2 w; w.x = pk_fp8x4(y[0], y[1], y[2], y[3]); w.y = pk_fp8x4(y[4], y[5], y[6], y[7]);
            *(u32x2*)(Y + (size_t)row * 4096 + c) = w; }
#pragma unroll
        for (int i = 0; i < 8; ++i) { oa[i] = ob[i]; za[i] = zb[i]; }
    }
#undef GN_LD
}

template <bool FP8>
__device__ __forceinline__ void phase_gemm_out(const Args& a, LAS unsigned char* lds, int K, const void* w, const float* xin) {
    const int eb = FP8 ? 1 : 2;
    SrcGrid S{(const char*)(a.ws + WS_Y), (const char*)w, (size_t)BM * K * eb, (size_t)BM * K * eb, 64, 64 * 8, K * eb / 2, K * eb / 2};
    EpiResid E{(bf16_t*)(a.ws + WS_X), xin, (const bf16_t*)(a.ws + WS_X), FP8 ? 1.0f / W8_SCALE : 1.0f};
    gemm_stream<false, FP8>(lds, S, K * eb / 128, E);
}

struct SrcRouter {
    const char* h; const char* w;
    __device__ __forceinline__ bool next(int i, UnitD& u) const { const int id = BID + i * NBLK; if (id >= 256) return false; u.t0 = id & 63; u.t1 = id >> 6; u.t2 = 0;
        u.gA = h + ((size_t)u.t0 * BM * D_ + u.t1 * 512) * 2; u.gB = w + (size_t)u.t1 * 512 * 2; return true; }
    __device__ __forceinline__ void va(const UnitD&, unsigned (&v)[2][2]) const { offs_direct(v, D_, false); }
    __device__ __forceinline__ void vb(unsigned (&v)[2][2]) const { offs_direct(v, D_, true); }
};
struct EpiLogitsQ {
    float* O;
    __device__ __forceinline__ void operator()(const Acc& acc, const UnitD& u, int wr, int wc, int fr, int fq) const { store_f32_tile(acc, O + ((size_t)u.t1 * T_ + (size_t)u.t0 * BM) * 128, nullptr, 128, 128, wr, wc, fr, fq); }
};
__device__ __forceinline__ void phase_gemm_router(const Args& a, LAS unsigned char* lds, int layer) {
    SrcRouter S{(const char*)(a.ws + WS_H), (const char*)(a.ws + WS_WRT) + (size_t)layer * 256 * D_ * 2};
    EpiLogitsQ E{(float*)(a.ws + WS_O)};
    gemm_stream<false, false>(lds, S, 512 / BK, E);
}

__device__ __forceinline__ void phase_route(const Args& a, int layer) {
    const float* lg = (const float*)(a.ws + WS_O); const float* bg = a.in[22] + layer * 8; const float* be = a.in[24] + layer * 64;
    int* cnt = (int*)(a.ws + WS_CTL + CTL_CNT) + layer * 64;
    int* eid = (int*)(a.ws + WS_EID); int* slot = (int*)(a.ws + WS_SLOT); float* gate = (float*)(a.ws + WS_GATE); int* rowmap = (int*)(a.ws + WS_ROWMAP);
    const int gtid = BID * NTHREADS + TIDX, gsz = NBLK * NTHREADS;
    for (int i = gtid; i < MPAD; i += gsz) rowmap[i] = 0;
    for (int t = gtid; t < T_; t += gsz) {
        f32x4 ga = (f32x4){0.f, 0.f, 0.f, 0.f}, gb = ga;
#pragma unroll
        for (int kq = 0; kq < 4; ++kq) { ga += *(const f32x4*)(lg + ((size_t)kq * T_ + t) * 128); gb += *(const f32x4*)(lg + ((size_t)kq * T_ + t) * 128 + 4); }
        const float gl[8] = {ga[0] + bg[0], ga[1] + bg[1], ga[2] + bg[2], ga[3] + bg[3], gb[0] + bg[4], gb[1] + bg[5], gb[2] + bg[6], gb[3] + bg[7]};
        float mx = -3.0e38f; int gi = 0;
#pragma unroll
        for (int j = 0; j < 8; ++j) if (gl[j] > mx) { mx = gl[j]; gi = j; }
        float se = 0.f;
#pragma unroll
        for (int j = 0; j < 8; ++j) se += __expf(gl[j] - mx);
        const float gp = 1.0f / se;
        f32x4 ea = *(const f32x4*)(be + gi * 8), eb = *(const f32x4*)(be + gi * 8 + 4);
#pragma unroll
        for (int kq = 0; kq < 4; ++kq) { ea += *(const f32x4*)(lg + ((size_t)kq * T_ + t) * 128 + 8 + gi * 8); eb += *(const f32x4*)(lg + ((size_t)kq * T_ + t) * 128 + 12 + gi * 8); }
        const float el[8] = {ea[0], ea[1], ea[2], ea[3], eb[0], eb[1], eb[2], eb[3]};
        float l1 = -3.0e38f, l2 = -3.0e38f; int i1 = 0, i2 = 0;
#pragma unroll
        for (int j = 0; j < 8; ++j) { const float v = el[j];
            if (v > l1) { l2 = l1; i2 = i1; l1 = v; i1 = j; } else if (v > l2) { l2 = v; i2 = j; } }
        const float e2 = __expf(l2 - l1), inv = 1.0f / (1.0f + e2);
        const int e0 = gi * 8 + i1, e1 = gi * 8 + i2;
        eid[t * 2] = e0; eid[t * 2 + 1] = e1; gate[t * 2] = inv * gp; gate[t * 2 + 1] = e2 * inv * gp;
        slot[t * 2] = atomicAdd(&cnt[e0], 1); slot[t * 2 + 1] = atomicAdd(&cnt[e1], 1); }
}

__device__ __forceinline__ void phase_rowmap(const Args& a, LAS unsigned char* lds, int layer) {
    const int* cnt = (const int*)(a.ws + WS_CTL + CTL_CNT) + layer * 64; LAS int* ps = (LAS int*)lds;
    int* tinfo = (int*)(a.ws + WS_TINFO) + layer * 512;
    const int* eid = (const int*)(a.ws + WS_EID); const int* slot = (const int*)(a.ws + WS_SLOT); int* posof = (int*)(a.ws + WS_POSOF); int* rowmap = (int*)(a.ws + WS_ROWMAP);
    __syncthreads();
    if (TIDX == 0) { int acc = 0; for (int e = 0; e < 64; ++e) { ps[e] = acc; acc += (cnt[e] + 255) & ~255; } ps[64] = acc; }
    __syncthreads();
    if (BID == 0) { if (TIDX <= 64) tinfo[TIDX] = ps[TIDX]; if (TIDX == 65) tinfo[65] = ps[64] >> 8;
        if (TIDX < 192) { const int p = TIDX * 256; int e = 0; for (int j = 0; j < 64; ++j) if (ps[j + 1] <= p) e = j + 1; tinfo[128 + TIDX] = e < 64 ? e : 63; } }
    for (int i = BID * NTHREADS + TIDX; i < T_ * 2; i += NBLK * NTHREADS) { const int p = ps[eid[i]] + slot[i]; posof[i] = p; rowmap[p] = i >> 1; }
    __syncthreads();
}

struct SrcMoeUp {
    const char* h; const char* wg; const int* tinfo; const int* rowmap; int total;
    __device__ __forceinline__ bool next(int i, UnitD& u) const { const int id = BID + i * NBLK; if (id >= total) return false; u.t0 = id >> 2; u.t1 = id & 3;
        u.t2 = __builtin_amdgcn_readfirstlane(tinfo[128 + u.t0]); u.gA = h; u.gB = wg + ((size_t)u.t2 * DEXP + u.t1 * 128) * D_; return true; }
    __device__ __forceinline__ void va(const UnitD& u, unsigned (&v)[2][2]) const { int R0, C0; stage_pos(TIDX, R0, C0);
#pragma unroll
        for (int hh = 0; hh < 2; ++hh)
#pragma unroll
            for (int i = 0; i < 2; ++i) v[hh][i] = (unsigned)(rowmap[u.t0 * 256 + hh * 128 + R0 + 64 * i] * D_ + C0 * 2); }
    __device__ __forceinline__ void vb(unsigned (&v)[2][2]) const { int R0, C0; stage_pos(TIDX, R0, C0);
#pragma unroll
        for (int i = 0; i < 2; ++i) { const int Rr = perm_row(R0 + 64 * i); v[0][i] = (unsigned)(Rr * D_ + C0 * 2); v[1][i] = (unsigned)(WS_WU - WS_WG) + (unsigned)(Rr * D_ + C0 * 2); } }
};
__device__ __forceinline__ void phase_moe_up(const Args& a, LAS unsigned char* lds, int layer) {
    const int* tinfo = (const int*)(a.ws + WS_TINFO) + layer * 512;
    const int ntm = __builtin_amdgcn_readfirstlane(tinfo[65]);
    SrcMoeUp S{(const char*)(a.ws + WS_H8), (const char*)(a.ws + WS_WG), tinfo, (const int*)(a.ws + WS_ROWMAP), ntm * 4};
    EpiSwiGLU E{a.ws + WS_ACT};
    gemm_stream<true, true>(lds, S, D_ / 128, E);
}

struct SrcMoeDown {
    const char* act; const char* wd; const int* tinfo; int total;
    __device__ __forceinline__ bool next(int i, UnitD& u) const { const int id = BID + i * NBLK; if (id >= total) return false; u.t0 = id >> 3; u.t1 = id & 7;
        u.t2 = __builtin_amdgcn_readfirstlane(tinfo[128 + u.t0]); u.gA = act + (size_t)u.t0 * BM * DEXP; u.gB = wd + ((size_t)u.t2 * D_ + u.t1 * BM) * DEXP; return true; }
    __device__ __forceinline__ void va(const UnitD&, unsigned (&v)[2][2]) const { offs_direct(v, DEXP / 2, false); }
    __device__ __forceinline__ void vb(unsigned (&v)[2][2]) const { offs_direct(v, DEXP / 2, true); }
};
__device__ __forceinline__ void phase_moe_down(const Args& a, LAS unsigned char* lds, int layer) {
    const int* tinfo = (const int*)(a.ws + WS_TINFO) + layer * 512; const int ntm = __builtin_amdgcn_readfirstlane(tinfo[65]);
    SrcMoeDown S{(const char*)(a.ws + WS_ACT), (const char*)(a.ws + WS_WD), tinfo, ntm * 8};
    EpiDown E{a.ws + WS_YMOE};
    gemm_stream<false, true>(lds, S, DEXP / 128, E);
}

struct SrcIn1Tail {
    const char* h; const char* w;
    __device__ __forceinline__ bool next(int i, UnitD& u) const { const int id = BID + i * NBLK; if (id >= 256) return false; u.t0 = id & 63; u.t1 = id >> 6; u.t2 = 0;
        u.gA = h + (size_t)u.t0 * BM * D_ + u.t1 * 512; u.gB = w + (size_t)48 * BM * D_ + u.t1 * 512; return true; }
    __device__ __forceinline__ void va(const UnitD&, unsigned (&v)[2][2]) const { offs_direct(v, D_ / 2, false); }
    __device__ __forceinline__ void vb(unsigned (&v)[2][2]) const { offs_direct(v, D_ / 2, true); }
};
struct EpiTailQ {
    float* O;
    __device__ __forceinline__ void operator()(const Acc& acc, const UnitD& u, int wr, int wc, int fr, int fq) const { store_f32_tile(acc, O + ((size_t)u.t1 * T_ + (size_t)u.t0 * BM) * 64, nullptr, 64, 64, wr, wc, fr, fq, 1.0f / W8_SCALE); }
};
__device__ __forceinline__ void phase_gemm_in1(const Args& a, LAS unsigned char* lds) {
    SrcGrid S{(const char*)(a.ws + WS_H8), (const char*)(a.ws + WS_WIN1T), (size_t)BM * D_, (size_t)BM * D_, 64, 64 * 48, D_ / 2, D_ / 2};
    EpiProj E{(bf16_t*)(a.ws + WS_PROJ), N_IN1P, nullptr, 64, 48, 48, 64, 1.0f / W8_SCALE};
    gemm_stream<false, true>(lds, S, D_ / 128, E);
}
__device__ __forceinline__ void phase_gemm_in1_tail(const Args& a, LAS unsigned char* lds) {
    SrcIn1Tail S{(const char*)(a.ws + WS_H8), (const char*)(a.ws + WS_WIN1T)};
    EpiTailQ E{(float*)(a.ws + WS_O)};
    int nt = 4; asm volatile("" : "+s"(nt));
    gemm_stream<false, true>(lds, S, nt, E);
}

__device__ __forceinline__ void phase_gdn_conv(const Args& a) {
    const bf16_t* p1 = (const bf16_t*)(a.ws + WS_PROJ); bf16_t* qc = (bf16_t*)(a.ws + WS_QKVC); const float* cw = a.in[16];
    const int gtid = BID * NTHREADS + TIDX, gsz = NBLK * NTHREADS;
    for (int it = gtid; it < 1024 * (T_ / 128); it += gsz) { const int c = (it & 1023) * 8, seg = it >> 10; const size_t t0 = (size_t)seg * 128;
        float w[4][8];
#pragma unroll
        for (int k = 0; k < 4; ++k) { const f32x4 w0 = *(const f32x4*)(cw + k * 8192 + c), w1 = *(const f32x4*)(cw + k * 8192 + c + 4);
            w[k][0] = w0[0]; w[k][1] = w0[1]; w[k][2] = w0[2]; w[k][3] = w0[3]; w[k][4] = w1[0]; w[k][5] = w1[1]; w[k][6] = w1[2]; w[k][7] = w1[3]; }
        u32x4 x0 = (u32x4){0u, 0u, 0u, 0u}, x1 = x0, x2 = x0;
        if ((t0 & (S_ - 1)) != 0) { x0 = *(const u32x4*)(p1 + (t0 - 3) * N_IN1P + c); x1 = *(const u32x4*)(p1 + (t0 - 2) * N_IN1P + c); x2 = *(const u32x4*)(p1 + (t0 - 1) * N_IN1P + c); }
        const float qsc = c < 2048 ? 0.08838834764831845f : 1.0f;
        u32x4 xa[8];
#pragma unroll
        for (int j = 0; j < 8; ++j) xa[j] = *(const u32x4*)(p1 + (t0 + j) * N_IN1P + c);
#pragma unroll 1
        for (int r0 = 0; r0 < 128; r0 += 8) { u32x4 xb[8];
#pragma unroll
            for (int j = 0; j < 8; ++j) xb[j] = xa[j];
            if (r0 + 8 < 128) {
#pragma unroll
                for (int j = 0; j < 8; ++j) xb[j] = *(const u32x4*)(p1 + (t0 + r0 + 8 + j) * N_IN1P + c); }
#pragma unroll
          for (int j8 = 0; j8 < 8; ++j8) { const u32x4 x3 = xa[j8]; const int r = r0 + j8;
            float acc[8];
#define TAPS(j, f, m) (w[0][j] * f(x0.m) + w[1][j] * f(x1.m) + w[2][j] * f(x2.m) + w[3][j] * f(x3.m))
            acc[0] = TAPS(0, bf_lo, x); acc[1] = TAPS(1, bf_hi, x); acc[2] = TAPS(2, bf_lo, y); acc[3] = TAPS(3, bf_hi, y);
            acc[4] = TAPS(4, bf_lo, z); acc[5] = TAPS(5, bf_hi, z); acc[6] = TAPS(6, bf_lo, w); acc[7] = TAPS(7, bf_hi, w);
#undef TAPS
            float ss = 0.f;
#pragma unroll
            for (int j = 0; j < 8; ++j) { acc[j] = siluf_(acc[j]); ss += acc[j] * acc[j]; }
            ss = row16_sum(ss);
            const float sc = c < 4096 ? rsqrtf(ss + 1e-6f) * qsc : 1.0f;
            u32x4 o; o.x = cvt_pk_bf16(acc[0] * sc, acc[1] * sc); o.y = cvt_pk_bf16(acc[2] * sc, acc[3] * sc); o.z = cvt_pk_bf16(acc[4] * sc, acc[5] * sc); o.w = cvt_pk_bf16(acc[6] * sc, acc[7] * sc);
            *(u32x4*)(qc + (t0 + r) * 8192 + c) = o;
            x0 = x1; x1 = x2; x2 = x3; }
#pragma unroll
            for (int j = 0; j < 8; ++j) xa[j] = xb[j]; } }
    const float* tail = (const float*)(a.ws + WS_O); float* bgo = (float*)(a.ws + WS_BG);
    for (int it = gtid; it < T_ * 32; it += gsz) { const int t = it >> 5, hv = it & 31; float tb = 0.f, ta = 0.f;
#pragma unroll
        for (int kq = 0; kq < 4; ++kq) { tb += tail[((size_t)kq * T_ + t) * 64 + hv]; ta += tail[((size_t)kq * T_ + t) * 64 + 32 + hv]; }
        bgo[t * 64 + hv] = sigmoidf_(tb);
        bgo[t * 64 + 32 + hv] = -__expf(a.in[17][hv]) * softplusf_(ta + a.in[18][hv]); }
}

struct MoeTile { const float* src; unsigned char* dst; int lds_, ldd; };
__device__ __forceinline__ MoeTile moe_tile(const Args& a, int g) {
    const int job = g >> 14, r = g & 16383, e = r >> 8, rr = r & 255; MoeTile t;
    typedef __attribute__((address_space(1))) const float* gcf; gcf s25 = (gcf)a.in[25], s26 = (gcf)a.in[26]; asm volatile("" : "+s"(s25), "+s"(s26));
    if (job < 2) { const int ik = rr >> 3, in = rr & 7; t.lds_ = DEXP; t.ldd = D_;
        t.src = (const float*)(job ? s26 : s25) + ((size_t)(NEXP + e) * D_ + ik * 64) * DEXP + in * 64; t.dst = a.ws + (job ? WS_WU : WS_WG) + ((size_t)e * DEXP + in * 64) * D_ + ik * 64; }
    else { const int ik = rr >> 5, in = rr & 31; t.lds_ = D_; t.ldd = DEXP;
        t.src = a.in[27] + ((size_t)(NEXP + e) * DEXP + ik * 64) * D_ + in * 64; t.dst = a.ws + WS_WD + ((size_t)e * D_ + in * 64) * DEXP + ik * 64; }
    return t;
}
__device__ __forceinline__ void moe_tile_load(const MoeTile& t, int tid, f32x4 (&v)[2]) {
#pragma unroll
    for (int i = 0; i < 2; ++i) { const int idx = tid + i * 512, rr = idx >> 4, c4 = (idx & 15) * 4; v[i] = *(const f32x4*)(t.src + (size_t)rr * t.lds_ + c4); }
}
__device__ __forceinline__ void moe_tile_store(const MoeTile& t, int tid, const f32x4 (&v)[2], LAS float* tile) {
#pragma unroll
    for (int i = 0; i < 2; ++i) { const int idx = tid + i * 512, rr = idx >> 4, c4 = (idx & 15) * 4;
        tile[rr * 65 + c4 + 0] = v[i][0]; tile[rr * 65 + c4 + 1] = v[i][1]; tile[rr * 65 + c4 + 2] = v[i][2]; tile[rr * 65 + c4 + 3] = v[i][3]; }
    LDS_BARRIER();
    { const int n = tid >> 3, kg = (tid & 7) * 8; float f[8];
#pragma unroll
      for (int jj = 0; jj < 8; ++jj) f[jj] = tile[(kg + jj) * 65 + n] * W8_SCALE;
      u32x2 w; w.x = pk_fp8x4(f[0], f[1], f[2], f[3]); w.y = pk_fp8x4(f[4], f[5], f[6], f[7]);
      *(u32x2*)(t.dst + (size_t)n * t.ldd + kg) = w; }
    LDS_BARRIER();
}
constexpr int MOE_TILES = 3 * NEXP * 256;

__device__ __forceinline__ f32x4 mfma16(s16x4 a, s16x4 b, f32x4 c) { return __builtin_amdgcn_mfma_f32_16x16x16bf16_1k(a, b, c, 0, 0, 0); }
__device__ __forceinline__ s16x4 pack4(const f32x4& v) { u32x2 w; w.x = cvt_pk_bf16(v[0], v[1]); w.y = cvt_pk_bf16(v[2], v[3]); return __builtin_bit_cast(s16x4, w); }
__device__ __forceinline__ void phase_gdn_chunk(const Args& a, LAS unsigned char* lds) {
    const bf16_t* qc = (const bf16_t*)(a.ws + WS_QKVC); const float* bgi = (const float*)(a.ws + WS_BG); bf16_t* O = (bf16_t*)(a.ws + WS_O);
    constexpr int VRS = 144, KTRS = 136;
    constexpr int KT = 0, QS = KT + 128 * KTRS, WSL = QS + 64 * RSB, QKS = WSL + 64 * RSB, EE = QKS + 2048, EDD = EE + 256, SET = EDD + 256;
    constexpr int STL = 2 * SET, KS = STL + 64 * RSB, VS = KS + 64 * RSB, X2 = VS + 64 * VRS, LS = X2 + 2048, X1 = LS + 4096, GAM = X1 + 2048, BET = GAM + 256, LEND = BET + 256;
    static_assert(LEND <= LDS_XBW, "gdn lds");
    const int wid = __builtin_amdgcn_readfirstlane(TIDX >> 6);
    const int NCK = S_ / 64;
    for (int blk = BID; blk < NB_ * 32 * 2; blk += NBLK) {
        const int grp = (blk & 7) * 8 + (blk >> 5), mem = (blk >> 3) & 3, b = grp >> 4, hk = grp & 15, hv = 2 * hk + (mem >> 1), vhalf = mem & 1;
        __syncthreads();
        if (wid < 4) {
            const int vt = wid;
            f32x4 Sacc[8];
#pragma unroll
            for (int n = 0; n < 8; ++n) Sacc[n] = (f32x4){0.f, 0.f, 0.f, 0.f};
            { const int lane = TIDX & 63;
              for (int i = lane; i < 16 * RSB / 16; i += 64) *(LAS u32x4*)(lds + STL + 16 * vt * RSB + i * 16) = (u32x4){0u, 0u, 0u, 0u}; }
            int lz = TIDX & 63; asm volatile("" : "+v"(lz));
            const int lane = lz, I = lane & 15, G = lane >> 4, q4 = I >> 2, p4 = I & 3;
            for (int it = 0; it <= NCK; ++it) {
                const int set = ((it - 1) & 1) * SET; const size_t t0 = (size_t)b * S_ + (size_t)(it - 1) * 64;
                f32x4 U[4];
                if (it >= 1) {
#pragma unroll
                    for (int sa = 0; sa < 4; ++sa) U[sa] = mfma16(*(const LAS s16x4*)(lds + X2 + ((sa * 16 + I) * 16 + 4 * G) * 2), lds_tr4(lds + VS + (16 * sa + 4 * G + q4) * VRS + (16 * vt + 4 * p4) * 2), (f32x4){0.f, 0.f, 0.f, 0.f});
                    asm volatile("" : "+v"(U[0]), "+v"(U[1]), "+v"(U[2]), "+v"(U[3]) :: "memory");
                }
                LDS_BARRIER();
#pragma unroll
                for (int sa = 0; sa < 4; ++sa) {
                    if (it >= 1) {
                        bf16x8 sf[4];
#pragma unroll
                        for (int ks = 0; ks < 4; ++ks) sf[ks] = lds_frag(lds + STL + (16 * vt + I) * RSB + (32 * ks + 8 * G) * 2);
                        s16x4 kt[8];
#pragma unroll
                        for (int dt = 0; dt < 8; ++dt) kt[dt] = *(const LAS s16x4*)(lds + set + KT + (16 * dt + I) * KTRS + (16 * sa + 4 * G) * 2);
                        f32x4 dl = U[sa], oq = (f32x4){0.f, 0.f, 0.f, 0.f};
#pragma unroll
                        for (int ks = 0; ks < 4; ++ks) { dl = mfma32(lds_frag(lds + set + WSL + (16 * sa + I) * RSB + (32 * ks + 8 * G) * 2), sf[ks], dl);
                            oq = mfma32(lds_frag(lds + set + QS + (16 * sa + I) * RSB + (32 * ks + 8 * G) * 2), sf[ks], oq); }
                        const s16x4 dfrag = pack4(dl);
                        const f32x4 e4 = *(const LAS f32x4*)(lds + set + EE + (16 * sa + 4 * G) * 4);
                        oq = mfma16(*(const LAS s16x4*)(lds + set + QKS + ((sa * 16 + I) * 16 + 4 * G) * 2), dfrag, oq * e4);
#pragma unroll
                        for (int r = 0; r < 4; ++r) O[(t0 + 16 * sa + 4 * G + r) * 4096 + hv * 128 + vhalf * 64 + 16 * vt + I] = f2bf(oq[r]);
                        const f32x4 ed4 = *(const LAS f32x4*)(lds + set + EDD + (16 * sa + 4 * G) * 4); const float e15 = *(const LAS float*)(lds + set + EE + (16 * sa + 15) * 4);
                        const s16x4 dsc = pack4(dl * ed4);
#pragma unroll
                        for (int dt = 0; dt < 8; ++dt) {
                            Sacc[dt] = mfma16(kt[dt], dsc, Sacc[dt] * e15);
                            *(LAS s16x4*)(lds + STL + (16 * vt + I) * RSB + (16 * dt + 4 * G) * 2) = pack4(Sacc[dt]); }
                    }
                    if (sa & 1) LDS_BARRIER();
                }
            }
        } else {
            const int pw = wid - 4;
            u32x4 pq[4], pk[4], pv[2]; float pb = 0.f, pg = 0.f;
            { const int ptid = TIDX - 256; const size_t t0 = (size_t)b * S_;
#pragma unroll
              for (int i = 0; i < 4; ++i) { const int c = ptid + i * 256, s2 = c >> 4, c8 = (c & 15) * 8; pq[i] = *(const u32x4*)(qc + (t0 + s2) * 8192 + hk * 128 + c8); pk[i] = *(const u32x4*)(qc + (t0 + s2) * 8192 + 2048 + hk * 128 + c8); }
#pragma unroll
              for (int i = 0; i < 2; ++i) { const int c = ptid + i * 256, s2 = c >> 3, c8 = (c & 7) * 8; pv[i] = *(const u32x4*)(qc + (t0 + s2) * 8192 + 4096 + hv * 128 + vhalf * 64 + c8); }
              if (pw == 1) { pb = bgi[(t0 + ptid - 64) * 64 + hv]; pg = bgi[(t0 + ptid - 64) * 64 + 32 + hv]; } }
            int lz = TIDX & 63; asm volatile("" : "+v"(lz));
            const int lane = lz, ptid = pw * 64 + lane, I = lane & 15, G = lane >> 4, q4 = I >> 2, p4 = I & 3;
            for (int it = 0; it <= NCK; ++it) {
                const int set = (it & 1) * SET; const bool act = it < NCK;
                if (act) {
#pragma unroll
                    for (int i = 0; i < 4; ++i) { const int c = ptid + i * 256, s2 = c >> 4, c8 = (c & 15) * 8; *(LAS u32x4*)(lds + set + QS + s2 * RSB + c8 * 2) = pq[i]; *(LAS u32x4*)(lds + KS + s2 * RSB + c8 * 2) = pk[i]; }
                    if (pw == 1) { float x = pg;
                        x += __builtin_bit_cast(float, __builtin_amdgcn_update_dpp(0, __builtin_bit_cast(int, x), 0x111, 0xf, 0xf, true));
                        x += __builtin_bit_cast(float, __builtin_amdgcn_update_dpp(0, __builtin_bit_cast(int, x), 0x112, 0xf, 0xf, true));
                        x += __builtin_bit_cast(float, __builtin_amdgcn_update_dpp(0, __builtin_bit_cast(int, x), 0x114, 0xf, 0xf, true));
                        x += __builtin_bit_cast(float, __builtin_amdgcn_update_dpp(0, __builtin_bit_cast(int, x), 0x118, 0xf, 0xf, true));
                        const float g15 = __shfl(x, 15, 16);
                        *(LAS float*)(lds + GAM + lane * 4) = x; *(LAS float*)(lds + set + EE + lane * 4) = __expf(x); *(LAS float*)(lds + set + EDD + lane * 4) = __expf(g15 - x); *(LAS float*)(lds + BET + lane * 4) = pb; }
                }
                LDS_BARRIER();
                if (act) { const int sa = pw;
#pragma unroll
                    for (int i = 0; i < 2; ++i) { const int c = ptid + i * 256, s2 = c >> 3, c8 = (c & 7) * 8; *(LAS u32x4*)(lds + VS + s2 * VRS + c8 * 2) = pv[i]; }
                    if (it + 1 < NCK) { const size_t t1 = (size_t)b * S_ + (size_t)(it + 1) * 64;
#pragma unroll
                        for (int i = 0; i < 4; ++i) { const int c = ptid + i * 256, s2 = c >> 4, c8 = (c & 15) * 8; pq[i] = *(const u32x4*)(qc + (t1 + s2) * 8192 + hk * 128 + c8); pk[i] = *(const u32x4*)(qc + (t1 + s2) * 8192 + 2048 + hk * 128 + c8); }
#pragma unroll
                        for (int i = 0; i < 2; ++i) { const int c = ptid + i * 256, s2 = c >> 3, c8 = (c & 7) * 8; pv[i] = *(const u32x4*)(qc + (t1 + s2) * 8192 + 4096 + hv * 128 + vhalf * 64 + c8); }
                        if (pw == 1) { pb = bgi[(t1 + ptid - 64) * 64 + hv]; pg = bgi[(t1 + ptid - 64) * 64 + 32 + hv]; } }
#pragma unroll
                    for (int ty = 0; ty < 2; ++ty) { f32x4 acc = (f32x4){0.f, 0.f, 0.f, 0.f};
#pragma unroll
                        for (int ks = 0; ks < 4; ++ks) { const bf16x8 ka = lds_frag(lds + KS + (16 * sa + I) * RSB + (32 * ks + 8 * G) * 2);
                            const bf16x8 bo = ty ? lds_frag(lds + set + QS + (16 * sa + I) * RSB + (32 * ks + 8 * G) * 2) : ka; acc = mfma32(ka, bo, acc); }
                        const f32x4 gr = *(const LAS f32x4*)(lds + GAM + (16 * sa + 4 * G) * 4); const float gc = *(const LAS float*)(lds + GAM + (16 * sa + I) * 4);
                        if (ty == 0) { const f32x4 br = *(const LAS f32x4*)(lds + BET + (16 * sa + 4 * G) * 4);
#pragma unroll
                            for (int r = 0; r < 4; ++r) { const float val = br[r] * acc[r] * __expf(gr[r] - gc); *(LAS float*)(lds + LS + ((sa * 16 + 4 * G + r) * 16 + I) * 4) = (I < 4 * G + r) ? val : 0.f; } }
                        else { f32x4 o;
#pragma unroll
                            for (int r = 0; r < 4; ++r) { const float val = acc[r] * __expf(gc - gr[r]); o[r] = (4 * G + r <= I) ? val : 0.f; }
                            *(LAS s16x4*)(lds + set + QKS + ((sa * 16 + I) * 16 + 4 * G) * 2) = pack4(o); } } }
                LDS_BARRIER();
                if (act) { const int sa = pw, c = lane >> 2, q = lane & 3;
                    f32x4 lv[16];
#pragma unroll
                    for (int i = 0; i < 16; ++i) lv[i] = *(const LAS f32x4*)(lds + LS + ((sa * 16 + i) * 16 + 4 * q) * 4);
                    float xo[4] = {0.f, 0.f, 0.f, 0.f}, xw[4] = {0.f, 0.f, 0.f, 0.f};
#pragma unroll
                    for (int i = 0; i < 16; ++i) {
                        float p = lv[i][0] * xo[0] + lv[i][1] * xo[1] + lv[i][2] * xo[2] + lv[i][3] * xo[3];
                        p += dpp_f<0xB1>(p); p += dpp_f<0x4E>(p);
                        const float xi = ((i == c) ? 1.0f : 0.0f) - p;
                        xo[i & 3] = (q == (i >> 2)) ? xi : xo[i & 3];
                        xw[i >> 2] = (q == (i & 3)) ? xi : xw[i >> 2]; }
                    const float bc = *(const LAS float*)(lds + BET + (sa * 16 + c) * 4), sc1 = -bc * *(const LAS float*)(lds + set + EE + (sa * 16 + c) * 4);
#pragma unroll
                    for (int k = 0; k < 4; ++k) { const int i = 4 * k + q; *(LAS bf16_t*)(lds + X1 + ((sa * 16 + i) * 16 + c) * 2) = f2bf(xw[k] * sc1); *(LAS bf16_t*)(lds + X2 + ((sa * 16 + i) * 16 + c) * 2) = f2bf(xw[k] * bc); } }
                asm volatile("" ::: "memory");
                if (act) { const int sa = pw;
                    const s16x4 xb = *(const LAS s16x4*)(lds + X1 + ((sa * 16 + I) * 16 + 4 * G) * 2); s16x4 kt[8]; f32x4 w[8];
#pragma unroll
                    for (int dt = 0; dt < 8; ++dt) kt[dt] = lds_tr4(lds + KS + (16 * sa + 4 * G + q4) * RSB + (16 * dt + 4 * p4) * 2);
#pragma unroll
                    for (int dt = 0; dt < 8; ++dt) { w[dt] = mfma16(kt[dt], xb, (f32x4){0.f, 0.f, 0.f, 0.f}); *(LAS s16x4*)(lds + set + KT + (16 * dt + I) * KTRS + (16 * sa + 4 * G) * 2) = kt[dt]; }
#pragma unroll
                    for (int dt = 0; dt < 8; ++dt) *(LAS s16x4*)(lds + set + WSL + (16 * sa + I) * RSB + (16 * dt + 4 * G) * 2) = pack4(w[dt]); }
                LDS_BARRIER();
            }
        }
    }
}

constexpr int N_PHASES = 30;
__global__ void __launch_bounds__(NTHREADS, 2) fwd(Args a0) {
    extern __shared__ __attribute__((aligned(16))) unsigned char smem_raw[];
    LAS unsigned char* lds = (LAS unsigned char*)smem_raw;
    volatile LAS unsigned* xbw = (volatile LAS unsigned*)(lds + LDS_XBW);
    if (TIDX == 0) { xbw[0] = 0u; xbw[1] = 0u; xbw[2] = 0u; xbw[3] = 0u; }
    __syncthreads();
    XcdBarrier bar = xcd_barrier_post((unsigned*)(a0.ws + WS_CTL), xbw);
#ifndef PHMASK
#define PHMASK 0xFFFFFFFFull
#endif
#ifndef DUPMASK
#define DUPMASK 0ull
#endif
#define PH(i, body) do { if (((PHMASK >> (i)) & 1ull) && a0.ph_lo <= (i) && (i) < a0.ph_hi) { __attribute__((address_space(1))) unsigned char* wsp_ = (__attribute__((address_space(1))) unsigned char*)a0.ws; asm volatile("" : "+s"(wsp_)); Args a = a0; a.ws = (unsigned char*)wsp_; const float* xin = a.in[0]; const float* xw = (const float*)(a.ws + WS_X); (void)xin; (void)xw; \
        if ((DUPMASK >> (i)) & 1ull) { body; xcd_barrier(bar); } body; if ((i) + 1 < a0.ph_hi) xcd_barrier(bar); } } while (0)
    PH(0, { phase_prologue(a, lds); __syncthreads(); NORM_PH(0, true)(a, xin, a.in[1], -1); });
    PH(2, phase_gemm_in0(a, lds));
    PH(3, { phase_rg_conv(a); __syncthreads(); phase_hg1(a, lds); });
    PH(4, { phase_rg_gates(a, lds); __syncthreads(); phase_hg2(a); });
    PH(5, { phase_rg_scan(a, lds); __syncthreads(); phase_hg3(a, lds); });
    PH(9, phase_gemm_out<false>(a, lds, D_, a.ws + WS_WOUT0T, xin));
    PH(10, NORM_PH(0, false)(a, nullptr, a.in[2], 0));
    PH(11, phase_gemm_router(a, lds, 0));
    PH(12, phase_route(a, 0));
    PH(13, phase_rowmap(a, lds, 0));
    PH(14, phase_moe_up(a, lds, 0));
    PH(15, phase_moe_down(a, lds, 0));
    PH(16, { NORM_PH(1, false)(a, nullptr, a.in[1] + D_, 0); __syncthreads(); moe_weight_jobs(a, 1, lds); });
    PH(18, { phase_gemm_in1(a, lds); phase_gemm_in1_tail(a, lds); });
    PH(19, phase_gdn_conv(a));
    PH(20, phase_gdn_chunk(a, lds));
    PH(21, phase_gdn_norm(a));
    PH(22, phase_gemm_out<true>(a, lds, 4096, a.ws + WS_WOUT1T, nullptr));
    PH(23, NORM_PH(0, false)(a, nullptr, a.in[2] + D_, 1));
    PH(24, phase_gemm_router(a, lds, 1));
    PH(25, phase_route(a, 1));
    PH(26, phase_rowmap(a, lds, 1));
    PH(27, phase_moe_up(a, lds, 1));
    PH(28, phase_moe_down(a, lds, 1));
    PH(29, NORM_PH(2, false)(a, nullptr, a.in[3], 1));
#undef PH
}

extern "C" void kernel_launch(void* const* d_in, const int* in_sizes, int n_in, void* d_out, int out_size, void* d_ws, size_t ws_size, hipStream_t stream) {
    static int grid = 0;
    if (grid == 0) {
        if (n_in != 28 || ws_size < WS_END) { fprintf(stderr, "kernel_launch: need 28 inputs and %zu bytes of workspace, got %d / %zu\n", (size_t)WS_END, n_in, ws_size); grid = -1; return; }
        int dev = 0, cus = 0, per_cu = 0;
        if (hipGetDevice(&dev) != hipSuccess || hipDeviceGetAttribute(&cus, hipDeviceAttributeMultiprocessorCount, dev) != hipSuccess) { grid = -1; return; }
        if (hipFuncSetAttribute((const void*)fwd, hipFuncAttributeMaxDynamicSharedMemorySize, LDS_BYTES) != hipSuccess) { fprintf(stderr, "kernel_launch: hipFuncSetAttribute failed\n"); grid = -1; return; }
        if (hipOccupancyMaxActiveBlocksPerMultiprocessor(&per_cu, (const void*)fwd, NTHREADS, LDS_BYTES) != hipSuccess || per_cu < 1) { fprintf(stderr, "kernel_launch: occupancy query says %d\n", per_cu); }
        (void)hipGetLastError();
        grid = cus;
    }
    if (grid < 0) return;
    (void)in_sizes; (void)out_size;
    hipMemsetAsync((char*)d_ws + WS_CTL, 0, CTL_BYTES, stream);
    Args a; memset(&a, 0, sizeof(a));
    for (int i = 0; i < 28; ++i) a.in[i] = (const float*)d_in[i];
    a.out = (float*)d_out; a.ws = (unsigned char*)d_ws;
#if N_LAUNCH_MODE == 1
    a.ph_lo = 0; a.ph_hi = N_PHASES;
    hipLaunchKernelGGL(fwd, dim3(grid), dim3(NTHREADS), LDS_BYTES, stream, a);
#if EXTRA_PH >= 0
    a.ph_lo = EXTRA_PH; a.ph_hi = EXTRA_PH + 1;
    hipLaunchKernelGGL(fwd, dim3(grid), dim3(NTHREADS), LDS_BYTES, stream, a);
#endif
#else
    for (int p = 0; p < N_PHASES; ++p) { a.ph_lo = p; a.ph_hi = p + 1; hipLaunchKernelGGL(fwd, dim3(grid), dim3(NTHREADS), LDS_BYTES, stream, a); }
#endif
}
```

```cpp
#include <hip/hip_runtime.h>
#include <stdint.h>
#include <stdio.h>
#include <string.h>

#ifndef EXTRA_PH
#define EXTRA_PH -1
#endif
#ifndef N_LAUNCH_MODE
#define N_LAUNCH_MODE 1
#endif

#define LAS __attribute__((address_space(3)))
typedef unsigned short bf16_t;
typedef short bf16x8 __attribute__((ext_vector_type(8)));
typedef float f32x4 __attribute__((ext_vector_type(4)));
typedef float f32x2 __attribute__((ext_vector_type(2)));
typedef unsigned u32x4 __attribute__((ext_vector_type(4)));
typedef unsigned u32x2 __attribute__((ext_vector_type(2)));

constexpr int T_ = 16384, D_ = 2048, S_ = 4096, NB_ = 4;
constexpr int N_IN0 = 6144, N_IN1 = 12352, N_IN1P = 12544;
constexpr int NEXP = 64, DEXP = 512, MPAD = 49152;
constexpr int NTHREADS = 512;
constexpr int LDS_MAIN = 131072;
constexpr int LDS_BYTES = 163840;
constexpr int LDS_XBW = LDS_BYTES - 16;

constexpr size_t al256(size_t x) { return (x + 255) & ~(size_t)255; }
constexpr size_t WS_CTL = 0;
constexpr size_t CTL_BYTES = 65536;
constexpr size_t CTL_CNT = 16384;
constexpr size_t WS_LB = WS_CTL + CTL_BYTES;
constexpr size_t WS_TINFO = WS_LB + 4096;
constexpr size_t WS_WIN0T = WS_TINFO + 4096;
constexpr size_t WS_WOUT0T = WS_WIN0T + (size_t)N_IN0 * D_ * 2;
constexpr size_t WS_WIN1T = WS_WOUT0T + (size_t)D_ * D_ * 2;
constexpr size_t WS_WOUT1T = WS_WIN1T + (size_t)N_IN1P * D_ * 2;
constexpr size_t WS_WGATES = WS_WOUT1T + (size_t)D_ * 4096 * 2;
constexpr size_t WS_WRT = WS_WGATES + (size_t)8 * 256 * 256 * 2;
constexpr size_t WS_WG = WS_WRT + (size_t)2 * 256 * D_ * 2;
constexpr size_t WS_WU = WS_WG + (size_t)NEXP * DEXP * D_ * 2;
constexpr size_t WS_WD = WS_WU + (size_t)NEXP * DEXP * D_ * 2;
constexpr size_t WS_X = WS_WD + (size_t)NEXP * DEXP * D_ * 2;
constexpr size_t WS_H = WS_X + (size_t)T_ * D_ * 4;
constexpr size_t WS_PROJ = WS_H + (size_t)T_ * D_ * 2;
constexpr size_t PROJ_BYTES = (size_t)T_ * N_IN1P * 2;
constexpr size_t WS_FLOG = WS_PROJ + (size_t)T_ * N_IN0 * 2;
constexpr size_t WS_XC = WS_FLOG + (size_t)T_ * 1024 * 4;
constexpr size_t WS_ACT = WS_PROJ;
constexpr size_t WS_YMOE = WS_ACT + (size_t)MPAD * DEXP * 2;
constexpr size_t WS_R1 = WS_PROJ + PROJ_BYTES;
constexpr size_t WS_A = WS_R1;
constexpr size_t WS_U = WS_R1 + (size_t)T_ * 1024 * 4;
constexpr size_t WS_QKVC = WS_R1;
constexpr size_t WS_Y = WS_R1 + (size_t)T_ * 8192 * 2;
constexpr size_t WS_O = WS_Y + (size_t)T_ * 4096 * 2;
constexpr size_t WS_TAIL = WS_O + (size_t)T_ * 4096 * 4;
constexpr size_t WS_BG = WS_TAIL + (size_t)T_ * 64 * 4;
constexpr size_t WS_LOGITS = WS_BG + (size_t)T_ * 64 * 4;
constexpr size_t WS_EID = WS_LOGITS + (size_t)T_ * 128 * 4;
constexpr size_t WS_SLOT = WS_EID + (size_t)T_ * 2 * 4;
constexpr size_t WS_GATE = WS_SLOT + (size_t)T_ * 2 * 4;
constexpr size_t WS_POSOF = WS_GATE + (size_t)T_ * 2 * 4;
constexpr size_t WS_ROWMAP = WS_POSOF + (size_t)T_ * 2 * 4;
constexpr size_t WS_H8 = WS_ROWMAP + (size_t)MPAD * 4;
constexpr size_t WS_END = WS_H8 + (size_t)T_ * D_;
static_assert(WS_YMOE + (size_t)MPAD * D_ * 2 <= WS_R1, "moe overlay");
static_assert(WS_XC + (size_t)T_ * 1024 * 2 <= WS_R1, "layer0 overlay");

struct Args {
    const float* in[28];
    float* out;
    unsigned char* ws;
    int ph_lo, ph_hi;
};

__device__ __forceinline__ int tidx_() { int t = (int)threadIdx.x; asm volatile("" : "+v"(t)); return t; }
#define TIDX tidx_()
typedef __bf16 bf16x2n __attribute__((ext_vector_type(2)));
__device__ __forceinline__ unsigned cvt_pk_bf16(float lo, float hi) { const f32x2 v = {lo, hi}; return __builtin_bit_cast(unsigned, __builtin_convertvector(v, bf16x2n)); }
__device__ __forceinline__ unsigned pk_fp8x4(float a, float b, float c, float d) { int v = __builtin_amdgcn_cvt_pk_fp8_f32(a, b, 0, false); v = __builtin_amdgcn_cvt_pk_fp8_f32(c, d, v, true); return (unsigned)v; }
constexpr float W8_SCALE = 64.0f, ACT8_SCALE = 8.0f;
__device__ __forceinline__ bf16_t f2bf(float x) { return (bf16_t)(cvt_pk_bf16(x, 0.f) & 0xffffu); }
__device__ __forceinline__ float bf_lo(unsigned w) { return __uint_as_float(w << 16); }
__device__ __forceinline__ float bf_hi(unsigned w) { return __uint_as_float(w & 0xffff0000u); }
__device__ __forceinline__ float bf1(bf16_t v) { return __uint_as_float(((unsigned)v) << 16); }
__device__ __forceinline__ float sigmoidf_(float x) { return __builtin_amdgcn_rcpf(1.0f + __expf(-x)); }
__device__ __forceinline__ float siluf_(float x) { return x * __builtin_amdgcn_rcpf(1.0f + __expf(-x)); }
__device__ __forceinline__ float softplusf_(float x) { return x > 20.f ? x : log1pf(__expf(x)); }
__device__ __forceinline__ float gelu_tanh(float x) { const float u = 0.7978845608028654f * (x + 0.044715f * x * x * x); return x * __builtin_amdgcn_rcpf(1.0f + __expf(-2.0f * u)); }
template <int CTRL> __device__ __forceinline__ float dpp_f(float v) { return __builtin_bit_cast(float, __builtin_amdgcn_update_dpp(0, __builtin_bit_cast(int, v), CTRL, 0xf, 0xf, false)); }
__device__ __forceinline__ float row16_sum(float s) { s += dpp_f<0x140>(s); s += dpp_f<0x141>(s); s += dpp_f<0xB1>(s); s += dpp_f<0x4E>(s); return s; }
__device__ __forceinline__ float wave_sum(float v) { v = row16_sum(v); v += __shfl_xor(v, 16); v += __shfl_xor(v, 32); return v; }

#define LDS_BARRIER() do { asm volatile("s_waitcnt lgkmcnt(0)" ::: "memory"); __builtin_amdgcn_s_barrier(); asm volatile("" ::: "memory"); } while (0)
#define XB_TMO      128
#define XB_XCNT(j)  (256  + 64 * (j))
#define XB_XSUB(j)  (1280 + 64 * (j))
#define XB_XGEN(j)  (2304 + 64 * (j))
#define XB_TOP      3328
#define XB_TOPGEN   3392
#define XCD_BAR_WORDS 3456
#define XB_SPIN_CAP (1u << 18)

__device__ __forceinline__ unsigned xb_ld(unsigned* p)              { return __hip_atomic_load(p, __ATOMIC_RELAXED, __HIP_MEMORY_SCOPE_AGENT); }
__device__ __forceinline__ unsigned xb_add(unsigned* p, unsigned v) { return __hip_atomic_fetch_add(p, v, __ATOMIC_RELAXED, __HIP_MEMORY_SCOPE_AGENT); }
__device__ __forceinline__ unsigned xb_xcc_id() { return (unsigned)__builtin_amdgcn_s_getreg((3 << 11) | 20) & 0xFu; }
#define XB_SPIN(cond, bar) do { unsigned _sp = 0; while (cond) { __builtin_amdgcn_s_sleep(1); \
    if ((++_sp & 255u) == 0u) { if (xb_ld(&(bar)[XB_TMO])) break; if (_sp > XB_SPIN_CAP) { atomicAdd(&(bar)[XB_TMO], 1u); break; } } } } while (0)

struct XcdBarrier { unsigned* bar; unsigned x; volatile LAS unsigned* st; };

__device__ __forceinline__ XcdBarrier xcd_barrier_post(unsigned* bar, volatile LAS unsigned* st) {
    XcdBarrier b; b.bar = bar; b.x = xb_xcc_id(); b.st = st;
    if (TIDX == 0) (void)xb_add(&bar[XB_XCNT(b.x)], 1u);
    return b;
}
__device__ __forceinline__ void xcd_barrier_complete(unsigned* bar, unsigned x, unsigned& nloc, unsigned& nx) {
    const unsigned G = gridDim.x * gridDim.y * gridDim.z;
    unsigned sum, cnt, mine, sp = 0u;
    for (;;) {
        sum = 0u; cnt = 0u; mine = 0u;
#pragma unroll
        for (unsigned j = 0; j < 16; ++j) { const unsigned c = xb_ld(&bar[XB_XCNT(j)]); sum += c; cnt += (c > 0u) ? 1u : 0u; mine = (j == x) ? c : mine; }
        if (sum == G) break;
        __builtin_amdgcn_s_sleep(1);
        if ((++sp & 255u) == 0u) { if (xb_ld(&bar[XB_TMO])) break; if (sp > XB_SPIN_CAP) { atomicAdd(&bar[XB_TMO], 1u); break; } }
    }
    nloc = mine > 0u ? mine : 1u; nx = cnt > 0u ? cnt : 1u;
}
__device__ __forceinline__ void xcd_barrier(const XcdBarrier& b) {
    asm volatile("s_waitcnt vmcnt(0)" ::: "memory");
    __syncthreads();
    if (TIDX == 0) {
        unsigned* bar = b.bar;
        __builtin_amdgcn_s_waitcnt(0);
        unsigned nloc = b.st[0], nx = b.st[1];
        if (nloc == 0u) { xcd_barrier_complete(bar, b.x, nloc, nx); b.st[0] = nloc; b.st[1] = nx; }
        const unsigned old = xb_add(&bar[XB_XSUB(b.x)], 1u);
        const unsigned gen = old / nloc;
        if (old + 1u == (gen + 1u) * nloc) {
            __builtin_amdgcn_fence(__ATOMIC_RELEASE, "agent");
            asm volatile("s_waitcnt vmcnt(0)" ::: "memory");
            const unsigned og = xb_add(&bar[XB_TOP], 1u);
            const unsigned tg = og / nx;
            if (og + 1u == (tg + 1u) * nx) xb_add(&bar[XB_TOPGEN], 1u);
            else XB_SPIN(xb_ld(&bar[XB_TOPGEN]) == tg, bar);
            __builtin_amdgcn_fence(__ATOMIC_ACQUIRE, "agent");
            xb_add(&bar[XB_XGEN(b.x)], 1u);
            asm volatile("s_waitcnt vmcnt(0)" ::: "memory");
        } else {
            XB_SPIN(xb_ld(&bar[XB_XGEN(b.x)]) == gen, bar);
            __builtin_amdgcn_fence(__ATOMIC_ACQUIRE, "agent");
            asm volatile("s_waitcnt vmcnt(0)" ::: "memory");
        }
    }
    __syncthreads();
}

constexpr int BM = 256, BK = 64, HALF = 128, HTB = HALF * BK * 2;
__device__ __forceinline__ int lds_byte(int r, int c) { const int st = (r >> 4) * 2 + (c >> 5), rr = r & 15, cc = c & 31, ob = rr * 64 + cc * 2; return st * 1024 + (ob ^ (((ob >> 9) & 1) << 5)); }
__device__ __forceinline__ void stage_rc(int b, int& R, int& C) { const int st = b / 1024, sb = b % 1024, swz = sb ^ (((sb >> 9) & 1) << 5); R = (st >> 1) * 16 + swz / 64; C = (st & 1) * 32 + (swz % 64) / 2; }
__device__ __forceinline__ int perm32(int rho) { const int n = rho >> 4, i = rho & 15; return 8 * (i >> 2) + 4 * n + (i & 3); }

__device__ __forceinline__ void stage_pos(int tid, int& R0, int& C0) { stage_rc(tid * 16, R0, C0); }
__device__ __forceinline__ int perm_row(int R) { return (R & ~31) + perm32(R & 31); }

#define BID ((int)blockIdx.x)
#define NBLK ((int)gridDim.x)
#define BID_ BID
#define NBLK_ NBLK
typedef f32x4 Acc[2][2][4][2];
struct UnitD { const char* gA; const char* gB; int t0, t1, t2; };

typedef int i32x8 __attribute__((ext_vector_type(8)));
typedef int i32x4 __attribute__((ext_vector_type(4)));
template <bool GATHER, bool FP8, class Src, class Epi>
__device__ __forceinline__ void gemm_stream(LAS unsigned char* lds, const Src& S, const int nt, const Epi& E) {
    const int tid = TIDX, wid = tid >> 6, lane = tid & 63, wr = wid >> 2, wc = wid & 3, fr = lane & 15, fq = lane >> 4;
    const unsigned ldsw = (unsigned)wid * 1024u;
    const int aoff = lds_byte(wr * 64 + fr, fq * 8), boff = lds_byte(wc * 32 + fr, fq * 8);
    const size_t kstep = (size_t)(BK * 2);
#define G_SA(b, h) (((b) * 2 + (h)) * HTB)
#define G_SB(b, h) ((4 + (b) * 2 + (h)) * HTB)
#define G_STAGE(bufoff, gbase, v) do { _Pragma("unroll") for (int _i = 0; _i < 2; ++_i) \
        __builtin_amdgcn_global_load_lds((const unsigned*)((gbase) + (v)[_i]), (LAS unsigned*)(lds + (bufoff) + ldsw + _i * 8192), 16, 0, 0); } while (0)
#define G_LD8(p) __builtin_shufflevector(*(const LAS i32x4*)(p), *(const LAS i32x4*)((p) + 1024), 0, 1, 2, 3, 4, 5, 6, 7)
#define G_LDA(dst, b, h) do { _Pragma("unroll") for (int m = 0; m < 4; ++m) dst[m] = G_LD8(lds + G_SA(b, h) + aoff + m * 2048); } while (0)
#define G_LDB(dst, b, h) do { _Pragma("unroll") for (int n = 0; n < 2; ++n) dst[n] = G_LD8(lds + G_SB(b, h) + boff + n * 2048); } while (0)
#define G_HALF(x, k) __builtin_bit_cast(bf16x8, __builtin_shufflevector((x), (x), 4 * (k), 4 * (k) + 1, 4 * (k) + 2, 4 * (k) + 3))
#define G_MMA(ai, bj, At, Bt) do { __builtin_amdgcn_s_setprio(1); _Pragma("unroll") for (int m = 0; m < 4; ++m) _Pragma("unroll") for (int n = 0; n < 2; ++n) { \
        if (FP8) asm volatile("v_mfma_f32_16x16x128_f8f6f4 %0, %1, %2, %0" : "+v"(acc[ai][bj][m][n]) : "v"(Bt[n]), "v"(At[m]));   \
        else { acc[ai][bj][m][n] = __builtin_amdgcn_mfma_f32_16x16x32_bf16(G_HALF(Bt[n], 0), G_HALF(At[m], 0), acc[ai][bj][m][n], 0, 0, 0); \
               acc[ai][bj][m][n] = __builtin_amdgcn_mfma_f32_16x16x32_bf16(G_HALF(Bt[n], 1), G_HALF(At[m], 1), acc[ai][bj][m][n], 0, 0, 0); } } \
        __builtin_amdgcn_s_setprio(0); } while (0)
#define G_WAIT_V(n) asm volatile("s_waitcnt vmcnt(" #n ")" ::: "memory")
#define G_WAIT_L(n) asm volatile("s_waitcnt lgkmcnt(" #n ")" ::: "memory")
#define G_BAR __builtin_amdgcn_s_barrier()
#define G_SCHED __builtin_amdgcn_sched_barrier(0)
    UnitD cur, nxt; int ui = 0;
    if (!S.next(0, cur)) return;
    unsigned va[2][2], vb[2][2], van[2][2];
    S.vb(vb); S.va(cur, va);
    Acc acc;
#pragma unroll
    for (int a = 0; a < 2; ++a)
#pragma unroll
        for (int b = 0; b < 2; ++b)
#pragma unroll
            for (int m = 0; m < 4; ++m)
#pragma unroll
                for (int n = 0; n < 2; ++n) acc[a][b][m][n] = (f32x4){0.f, 0.f, 0.f, 0.f};
    i32x8 At[4], B0[2], B1[2];
    const char* cA = cur.gA; const char* cB = cur.gB;
    G_WAIT_V(0);
    __syncthreads();
    G_STAGE(G_SB(0, 0), cB, vb[0]); G_STAGE(G_SA(0, 0), cA, va[0]); G_STAGE(G_SB(0, 1), cB, vb[1]); G_STAGE(G_SA(0, 1), cA, va[1]);
    if (wr == 1) G_BAR;
    G_WAIT_V(4); G_BAR;
    G_STAGE(G_SB(1, 0), cB + kstep, vb[0]); G_STAGE(G_SA(1, 0), cA + kstep, va[0]); G_STAGE(G_SB(1, 1), cB + kstep, vb[1]);
    G_WAIT_V(6); G_BAR;
    for (;;) {
        const bool has_next = S.next(ui + 1, nxt);
        const char* nA = has_next ? nxt.gA : cA; const char* nB = has_next ? nxt.gB : cB;
        if (GATHER) { if (has_next) S.va(nxt, van); else { van[0][0] = va[0][0]; van[0][1] = va[0][1]; van[1][0] = va[1][0]; van[1][1] = va[1][1]; } }
#pragma unroll 1
        for (int t = 0; t < nt; t += 2) {
            const bool last = (t == nt - 2);
            const char* a1 = cA + (size_t)(t + 1) * kstep;
            const char* a2 = last ? nA : cA + (size_t)(t + 2) * kstep; const char* b2 = last ? nB : cB + (size_t)(t + 2) * kstep;
            const char* a3 = a2 + kstep; const char* b3 = b2 + kstep;
            unsigned v2[2][2];
#pragma unroll
            for (int hh = 0; hh < 2; ++hh)
#pragma unroll
                for (int i = 0; i < 2; ++i) v2[hh][i] = (GATHER && last) ? van[hh][i] : va[hh][i];
            G_LDB(B0, 0, 0); G_SCHED; G_LDA(At, 0, 0); G_STAGE(G_SA(1, 1), a1, va[1]);
            G_WAIT_L(8); G_BAR; G_WAIT_L(0); G_MMA(0, 0, At, B0); G_BAR; G_SCHED;
            G_LDB(B1, 0, 1); G_STAGE(G_SB(0, 0), b2, vb[0]);
            G_BAR; G_WAIT_L(0); G_MMA(0, 1, At, B1); G_BAR;
            G_LDA(At, 0, 1); G_STAGE(G_SA(0, 0), a2, v2[0]);
            G_BAR; G_WAIT_L(0); G_MMA(1, 0, At, B0); G_BAR; G_SCHED;
            G_STAGE(G_SB(0, 1), b2, vb[1]);
            G_WAIT_V(6); G_BAR; G_MMA(1, 1, At, B1); G_BAR;
            G_LDB(B0, 1, 0); G_SCHED; G_LDA(At, 1, 0); G_STAGE(G_SA(0, 1), a2, v2[1]);
            G_WAIT_L(8); G_BAR; G_WAIT_L(0); G_MMA(0, 0, At, B0); G_BAR; G_SCHED;
            G_LDB(B1, 1, 1); G_STAGE(G_SB(1, 0), b3, vb[0]);
            G_BAR; G_WAIT_L(0); G_MMA(0, 1, At, B1); G_BAR;
            G_LDA(At, 1, 1); G_STAGE(G_SA(1, 0), a3, v2[0]);
            G_BAR; G_WAIT_L(0); G_MMA(1, 0, At, B0); G_BAR; G_SCHED;
            G_STAGE(G_SB(1, 1), b3, vb[1]);
            G_WAIT_V(6); G_BAR; G_MMA(1, 1, At, B1); G_BAR;
        }
        if (FP8) asm volatile("s_nop 15\n\ts_nop 15" ::: "memory");
        { int tz = TIDX; asm volatile("" : "+v"(tz));
          const int wid2 = tz >> 6, lane2 = tz & 63; E(acc, cur, wid2 >> 2, wid2 & 3, lane2 & 15, lane2 >> 4); }
        if (!has_next) break;
#pragma unroll
        for (int a = 0; a < 2; ++a)
#pragma unroll
            for (int b = 0; b < 2; ++b)
#pragma unroll
                for (int m = 0; m < 4; ++m)
#pragma unroll
                    for (int n = 0; n < 2; ++n) acc[a][b][m][n] = (f32x4){0.f, 0.f, 0.f, 0.f};
        cur = nxt; cA = nA; cB = nB; ++ui;
        if (GATHER) { va[0][0] = van[0][0]; va[0][1] = van[0][1]; va[1][0] = van[1][0]; va[1][1] = van[1][1]; }
    }
    G_WAIT_V(0);
    if (wr == 0) G_BAR;
    G_BAR;
#undef G_SA
#undef G_SB
#undef G_STAGE
#undef G_LDA
#undef G_LDB
#undef G_MMA
#undef G_LD8
#undef G_HALF
#undef G_WAIT_V
#undef G_WAIT_L
#undef G_BAR
#undef G_SCHED
}

__device__ __forceinline__ void offs_direct(unsigned (&v)[2][2], int ld, bool perm) {
    int R0, C0; stage_pos(TIDX, R0, C0);
#pragma unroll
    for (int i = 0; i < 2; ++i) { const int R = R0 + 64 * i, Rr = perm ? perm_row(R) : R;
        v[0][i] = (unsigned)(Rr * ld + C0) * 2u; v[1][i] = (unsigned)((Rr + HALF) * ld + C0) * 2u; }
}

struct SrcGrid {
    const char* A; const char* B; size_t astep, bstep; int nM, total, lda, ldb;
    __device__ __forceinline__ bool next(int i, UnitD& u) const { const int id = BID_ + i * NBLK_; if (id >= total) return false; u.t0 = id % nM; u.t1 = id / nM; u.t2 = 0;
        u.gA = A + (size_t)u.t0 * astep; u.gB = B + (size_t)u.t1 * bstep; return true; }
    __device__ __forceinline__ void va(const UnitD&, unsigned (&v)[2][2]) const { offs_direct(v, lda, false); }
    __device__ __forceinline__ void vb(unsigned (&v)[2][2]) const { offs_direct(v, ldb, true); }
};

__device__ __forceinline__ void store_bf16_tile(const Acc& acc, bf16_t* O, int ld, int wr, int wc, int fr, int fq, const float sc = 1.0f) {
#pragma unroll
    for (int ai = 0; ai < 2; ++ai)
#pragma unroll
        for (int m = 0; m < 4; ++m) { bf16_t* rowp = O + (size_t)(ai * HALF + wr * 64 + m * 16 + fr) * ld + wc * 32 + 8 * fq;
#pragma unroll
            for (int bj = 0; bj < 2; ++bj) { const f32x4 v0 = acc[ai][bj][m][0] * sc, v1 = acc[ai][bj][m][1] * sc;
                u32x4 w; w.x = cvt_pk_bf16(v0[0], v0[1]); w.y = cvt_pk_bf16(v0[2], v0[3]); w.z = cvt_pk_bf16(v1[0], v1[1]); w.w = cvt_pk_bf16(v1[2], v1[3]);
                *(u32x4*)(rowp + bj * HALF) = w; } }
}
__device__ __forceinline__ void store_f32_tile(const Acc& acc, float* O, const float* R, int ld, int ncol, int wr, int wc, int fr, int fq, const float sc = 1.0f) {
#pragma unroll
    for (int ai = 0; ai < 2; ++ai)
#pragma unroll
        for (int m = 0; m < 4; ++m) { const size_t ro = (size_t)(ai * HALF + wr * 64 + m * 16 + fr) * ld;
#pragma unroll
            for (int bj = 0; bj < 2; ++bj)
#pragma unroll
                for (int n = 0; n < 2; ++n) { const int c = bj * HALF + wc * 32 + 8 * fq + 4 * n; if (c >= ncol) continue;
                    f32x4 v = acc[ai][bj][m][n] * sc; if (R) v += *(const f32x4*)(R + ro + c); *(f32x4*)(O + ro + c) = v; } }
}
struct EpiProj {
    bf16_t* O; int ld; float* F; int fld, fp0, fp1, ncol; float sc;
    __device__ __forceinline__ void operator()(const Acc& acc, const UnitD& u, int wr, int wc, int fr, int fq) const {
        if (u.t1 >= fp0 && u.t1 < fp1) store_f32_tile(acc, F + (size_t)u.t0 * BM * fld + (u.t1 - fp0) * BM, nullptr, fld, ncol, wr, wc, fr, fq, sc);
        else store_bf16_tile(acc, O + (size_t)u.t0 * BM * ld + u.t1 * BM, ld, wr, wc, fr, fq, sc);
    }
};
struct EpiResid {
    bf16_t* O; const float* Rf; const bf16_t* Rb; float sc;
    __device__ __forceinline__ void operator()(const Acc& acc, const UnitD& u, int wr, int wc, int fr, int fq) const {
        const size_t o = (size_t)u.t0 * BM * D_ + u.t1 * BM;
        if (Rf) {
#pragma unroll
            for (int am = 0; am < 4; ++am) { const int ai = am >> 1; f32x4 r0[2][2], r1[2][2];
#pragma unroll
                for (int mm = 0; mm < 2; ++mm) { const int m = (am & 1) * 2 + mm; const size_t ro = o + (size_t)(ai * HALF + wr * 64 + m * 16 + fr) * D_ + wc * 32 + 8 * fq;
#pragma unroll
                    for (int bj = 0; bj < 2; ++bj) { r0[mm][bj] = *(const f32x4*)(Rf + ro + bj * HALF); r1[mm][bj] = *(const f32x4*)(Rf + ro + bj * HALF + 4); } }
#pragma unroll
                for (int mm = 0; mm < 2; ++mm) { const int m = (am & 1) * 2 + mm; const size_t ro = o + (size_t)(ai * HALF + wr * 64 + m * 16 + fr) * D_ + wc * 32 + 8 * fq;
#pragma unroll
                    for (int bj = 0; bj < 2; ++bj) { const f32x4 v0 = acc[ai][bj][m][0] * sc + r0[mm][bj], v1 = acc[ai][bj][m][1] * sc + r1[mm][bj];
                        u32x4 w; w.x = cvt_pk_bf16(v0[0], v0[1]); w.y = cvt_pk_bf16(v0[2], v0[3]); w.z = cvt_pk_bf16(v1[0], v1[1]); w.w = cvt_pk_bf16(v1[2], v1[3]);
                        *(u32x4*)(O + ro + bj * HALF) = w; } } }
        } else {
#pragma unroll
            for (int ai = 0; ai < 2; ++ai) { u32x4 rr[4][2];
#pragma unroll
                for (int m = 0; m < 4; ++m) { const size_t ro = o + (size_t)(ai * HALF + wr * 64 + m * 16 + fr) * D_ + wc * 32 + 8 * fq;
#pragma unroll
                    for (int bj = 0; bj < 2; ++bj) rr[m][bj] = *(const u32x4*)(Rb + ro + bj * HALF); }
#pragma unroll
                for (int m = 0; m < 4; ++m) { const size_t ro = o + (size_t)(ai * HALF + wr * 64 + m * 16 + fr) * D_ + wc * 32 + 8 * fq;
#pragma unroll
                    for (int bj = 0; bj < 2; ++bj) { f32x4 v0 = acc[ai][bj][m][0] * sc, v1 = acc[ai][bj][m][1] * sc; const u32x4 r = rr[m][bj];
                        v0[0] += bf_lo(r.x); v0[1] += bf_hi(r.x); v0[2] += bf_lo(r.y); v0[3] += bf_hi(r.y); v1[0] += bf_lo(r.z); v1[1] += bf_hi(r.z); v1[2] += bf_lo(r.w); v1[3] += bf_hi(r.w);
                        u32x4 w; w.x = cvt_pk_bf16(v0[0], v0[1]); w.y = cvt_pk_bf16(v0[2], v0[3]); w.z = cvt_pk_bf16(v1[0], v1[1]); w.w = cvt_pk_bf16(v1[2], v1[3]);
                        *(u32x4*)(O + ro + bj * HALF) = w; } } }
        }
    }
};
struct EpiLogits {
    float* O;
    __device__ __forceinline__ void operator()(const Acc& acc, const UnitD& u, int wr, int wc, int fr, int fq) const { store_f32_tile(acc, O + (size_t)u.t0 * BM * 128, nullptr, 128, 128, wr, wc, fr, fq); }
};
struct EpiSwiGLU {
    unsigned char* O;
    __device__ __forceinline__ void operator()(const Acc& acc, const UnitD& u, int wr, int wc, int fr, int fq) const {
        unsigned char* o = O + (size_t)u.t0 * BM * DEXP + u.t1 * 128;
#pragma unroll
        for (int ai = 0; ai < 2; ++ai)
#pragma unroll
            for (int m = 0; m < 4; ++m) { unsigned char* rowp = o + (size_t)(ai * HALF + wr * 64 + m * 16 + fr) * DEXP + wc * 32 + 8 * fq;
                float r[8];
#pragma unroll
                for (int n = 0; n < 2; ++n)
#pragma unroll
                    for (int j = 0; j < 4; ++j) r[n * 4 + j] = (ACT8_SCALE / W8_SCALE) * siluf_(acc[ai][0][m][n][j] * (1.0f / W8_SCALE)) * acc[ai][1][m][n][j];
                u32x2 w; w.x = pk_fp8x4(r[0], r[1], r[2], r[3]); w.y = pk_fp8x4(r[4], r[5], r[6], r[7]);
                *(u32x2*)rowp = w; }
    }
};
struct EpiDown {
    unsigned char* O;
    __device__ __forceinline__ void operator()(const Acc& acc, const UnitD& u, int wr, int wc, int fr, int fq) const {
        unsigned char* o = O + (size_t)u.t0 * BM * D_ + u.t1 * BM; const float sc = 1.0f / (W8_SCALE * ACT8_SCALE);
#pragma unroll
        for (int ai = 0; ai < 2; ++ai)
#pragma unroll
            for (int m = 0; m < 4; ++m) { unsigned char* rowp = o + (size_t)(ai * HALF + wr * 64 + m * 16 + fr) * D_ + wc * 32 + 8 * fq;
#pragma unroll
                for (int bj = 0; bj < 2; ++bj) { const f32x4 v0 = acc[ai][bj][m][0] * sc, v1 = acc[ai][bj][m][1] * sc;
                    u32x2 w; w.x = pk_fp8x4(v0[0], v0[1], v0[2], v0[3]); w.y = pk_fp8x4(v1[0], v1[1], v1[2], v1[3]); *(u32x2*)(rowp + bj * HALF) = w; } }
    }
};
__device__ __forceinline__ unsigned rg_idx(unsigned tok, int c) { return ((((tok >> 12) * 64u + (unsigned)(c >> 4)) * (unsigned)S_ + (tok & (unsigned)(S_ - 1))) << 4) + (unsigned)(c & 15); }
struct EpiRgGates {
    bf16_t* LAo; bf16_t* Uo; const bf16_t* xc;
    const float* ba; const float* bx; const float* lam;
    __device__ __forceinline__ void operator()(const Acc& acc, const UnitD& u, int wr, int wc, int fr, int fq) const {
#pragma unroll
        for (int n = 0; n < 2; ++n) { const int c = u.t1 * 128 + wc * 32 + 8 * fq + 4 * n;
            u32x2 xq[2][4];
#pragma unroll
            for (int ai = 0; ai < 2; ++ai)
#pragma unroll
                for (int m = 0; m < 4; ++m) xq[ai][m] = *(const u32x2*)(xc + ((unsigned)(u.t0 * BM + ai * HALF + wr * 64 + m * 16 + fr) * 1024u + (unsigned)c));
            const f32x4 vba = *(const f32x4*)(ba + c), vbx = *(const f32x4*)(bx + c), vl = *(const f32x4*)(lam + c);
            f32x4 c8; for (int j = 0; j < 4; ++j) c8[j] = -8.0f * softplusf_(-vl[j]);
#pragma unroll
            for (int ai = 0; ai < 2; ++ai)
#pragma unroll
                for (int m = 0; m < 4; ++m) { const unsigned tok = (unsigned)(u.t0 * BM + ai * HALF + wr * 64 + m * 16 + fr);
                    const u32x2 xw = xq[ai][m]; const float xv[4] = {bf_lo(xw.x), bf_hi(xw.x), bf_lo(xw.y), bf_hi(xw.y)};
                    f32x4 lv, uv;
#pragma unroll
                    for (int j = 0; j < 4; ++j) { const float r = sigmoidf_(acc[ai][0][m][n][j] + vba[j]), ig = sigmoidf_(acc[ai][1][m][n][j] + vbx[j]);
                        const float la = c8[j] * r, av = __expf(la); lv[j] = la; uv[j] = __builtin_amdgcn_sqrtf(fmaxf(0.f, 1.0f - av * av)) * ig * xv[j]; }
                    const unsigned o = rg_idx(tok, c);
                    u32x2 w0; w0.x = cvt_pk_bf16(lv[0], lv[1]); w0.y = cvt_pk_bf16(lv[2], lv[3]); *(u32x2*)(LAo + o) = w0;
                    u32x2 w1; w1.x = cvt_pk_bf16(uv[0], uv[1]); w1.y = cvt_pk_bf16(uv[2], uv[3]); *(u32x2*)(Uo + o) = w1; } }
    }
};


__device__ __forceinline__ void transpose_job8(const float* src, unsigned char* dst, int K, int N, int ldd, size_t sb, size_t db, int nbatch, LAS unsigned char* lds) {
    const int tid = TIDX, tk = K / 128, tn = N / 64, per = tk * tn, total = per * nbatch;
    const int rr0 = tid >> 4, c4 = (tid & 15) * 4, n = tid >> 3, kg = (tid & 7) * 16;
    f32x4 va[4], vb[4];
#define T8_LD(v, t) { const int u_ = (t), ub_ = u_ / per, ur_ = u_ % per, uik_ = ur_ / tn, uin_ = ur_ % tn; const float* usp_ = src + (size_t)ub_ * sb + (size_t)(uik_ * 128 + rr0) * N + uin_ * 64 + c4; \
        _Pragma("unroll") for (int i = 0; i < 4; ++i) v[i] = *(const f32x4*)(usp_ + (size_t)(i * 32) * N); }
#define T8_ST(v, t, buf) { const int t_ = (t), b_ = t_ / per, r_ = t_ % per, ik_ = r_ / tn, in_ = r_ % tn; LAS float* tile = (LAS float*)(lds + (buf) * (128 * 65 * 4)); \
        _Pragma("unroll") for (int i = 0; i < 4; ++i) { const int rr = rr0 + i * 32; tile[rr * 65 + c4 + 0] = v[i][0]; tile[rr * 65 + c4 + 1] = v[i][1]; tile[rr * 65 + c4 + 2] = v[i][2]; tile[rr * 65 + c4 + 3] = v[i][3]; } \
        if (t_ + 2 * NBLK < total) T8_LD(v, t_ + 2 * NBLK) \
        LDS_BARRIER(); \
        float f[16]; \
        _Pragma("unroll") for (int j = 0; j < 16; ++j) f[j] = tile[(kg + j) * 65 + n] * W8_SCALE; \
        u32x4 w; w.x = pk_fp8x4(f[0], f[1], f[2], f[3]); w.y = pk_fp8x4(f[4], f[5], f[6], f[7]); w.z = pk_fp8x4(f[8], f[9], f[10], f[11]); w.w = pk_fp8x4(f[12], f[13], f[14], f[15]); \
        *(u32x4*)(dst + (size_t)b_ * db + (size_t)(in_ * 64 + n) * ldd + ik_ * 128 + kg) = w; }
    int t = BID;
    if (t < total) T8_LD(va, t)
    if (t + NBLK < total) T8_LD(vb, t + NBLK)
    for (; t < total; t += 2 * NBLK) {
        T8_ST(va, t, 0)
        if (t + NBLK < total) T8_ST(vb, t + NBLK, 1)
    }
#undef T8_LD
#undef T8_ST
    LDS_BARRIER();
}
__device__ __forceinline__ void transpose_job(const float* src, bf16_t* dst, int K, int N, int ldd, size_t sb, size_t db, int dalt, int nbatch, LAS unsigned char* lds) {
    const int tid = TIDX, tk = K / 64, tn = N / 64, per = tk * tn, total = per * nbatch;
    const int rr0 = tid >> 4, c4 = (tid & 15) * 4, n = tid >> 3, kg = (tid & 7) * 8;
    f32x4 va[2], vb[2];
#define T16_LD(v, t) { const int u_ = (t), ub_ = u_ / per, ur_ = u_ % per, uik_ = ur_ / tn, uin_ = ur_ % tn; const float* usp_ = src + (size_t)ub_ * sb + (size_t)(uik_ * 64 + rr0) * N + uin_ * 64 + c4; \
        _Pragma("unroll") for (int i = 0; i < 2; ++i) v[i] = *(const f32x4*)(usp_ + (size_t)(i * 32) * N); }
#define T16_ST(v, t, buf) { const int t_ = (t), b_ = t_ / per, r_ = t_ % per, ik_ = r_ / tn, in_ = r_ % tn; LAS float* tile = (LAS float*)(lds + (buf) * (64 * 65 * 4)); \
        _Pragma("unroll") for (int i = 0; i < 2; ++i) { const int rr = rr0 + i * 32; tile[rr * 65 + c4 + 0] = v[i][0]; tile[rr * 65 + c4 + 1] = v[i][1]; tile[rr * 65 + c4 + 2] = v[i][2]; tile[rr * 65 + c4 + 3] = v[i][3]; } \
        if (t_ + 2 * NBLK < total) T16_LD(v, t_ + 2 * NBLK) \
        LDS_BARRIER(); \
        float f[8]; \
        _Pragma("unroll") for (int j = 0; j < 8; ++j) f[j] = tile[(kg + j) * 65 + n]; \
        u32x4 w; w.x = cvt_pk_bf16(f[0], f[1]); w.y = cvt_pk_bf16(f[2], f[3]); w.z = cvt_pk_bf16(f[4], f[5]); w.w = cvt_pk_bf16(f[6], f[7]); \
        *(u32x4*)(dst + (size_t)b_ * db + (size_t)(b_ & 1) * dalt + (size_t)(in_ * 64 + n) * ldd + ik_ * 64 + kg) = w; }
    int t = BID;
    if (t < total) T16_LD(va, t)
    if (t + NBLK < total) T16_LD(vb, t + NBLK)
    for (; t < total; t += 2 * NBLK) {
        T16_ST(va, t, 0)
        if (t + NBLK < total) T16_ST(vb, t + NBLK, 1)
    }
#undef T16_LD
#undef T16_ST
    LDS_BARRIER();
}

__device__ __forceinline__ void moe_weight_jobs(const Args& a, int layer, LAS unsigned char* lds) {
    const size_t lo = (size_t)layer * NEXP * D_ * DEXP;
    transpose_job8(a.in[25] + lo, a.ws + WS_WG, D_, DEXP, D_, (size_t)D_ * DEXP, (size_t)DEXP * D_, NEXP, lds);
    transpose_job8(a.in[26] + lo, a.ws + WS_WU, D_, DEXP, D_, (size_t)D_ * DEXP, (size_t)DEXP * D_, NEXP, lds);
    transpose_job8(a.in[27] + lo, a.ws + WS_WD, DEXP, D_, DEXP, (size_t)D_ * DEXP, (size_t)DEXP * D_, NEXP, lds);
}

__device__ __forceinline__ void phase_prologue(const Args& a, LAS unsigned char* lds) {
    const int gtid = BID * NTHREADS + TIDX, gsz = NBLK * NTHREADS;
    for (int i = gtid; i < 1024; i += gsz) { const float l0 = a.in[12][i], l1 = a.in[12][1024 + i], mx = fmaxf(l0, l1), e0 = __expf(l0 - mx), e1 = __expf(l1 - mx);
        ((float*)(a.ws + WS_LB))[i] = e0 / (e0 + e1); }
    for (int it = gtid; it < 2 * 256 * 256; it += gsz) { const int l = it >> 16, n = (it >> 8) & 255, k8 = (it & 255) * 8; float f[8];
#pragma unroll
        for (int j = 0; j < 8; ++j) { const int k = k8 + j; f[j] = n < 8 ? a.in[21][((size_t)l * D_ + k) * 8 + n] : (n < 72 ? a.in[23][((size_t)l * D_ + k) * 64 + (n - 8)] : 0.f); }
        u32x4 w; w.x = cvt_pk_bf16(f[0], f[1]); w.y = cvt_pk_bf16(f[2], f[3]); w.z = cvt_pk_bf16(f[4], f[5]); w.w = cvt_pk_bf16(f[6], f[7]);
        *(u32x4*)((bf16_t*)(a.ws + WS_WRT) + ((size_t)l * 256 + n) * D_ + k8) = w; }
    for (int it = gtid; it < 192 * 128; it += gsz) *(u32x4*)(a.ws + WS_WIN1T + (size_t)N_IN1 * D_ + (size_t)it * 16) = (u32x4){0u, 0u, 0u, 0u};
    transpose_job(a.in[4], (bf16_t*)(a.ws + WS_WIN0T), D_, N_IN0, D_, 0, 0, 0, 1, lds);
    transpose_job(a.in[14], (bf16_t*)(a.ws + WS_WOUT0T), D_, D_, D_, 0, 0, 0, 1, lds);
    transpose_job8(a.in[15], a.ws + WS_WIN1T, D_, N_IN1, D_, 0, 0, 1, lds);
    transpose_job8(a.in[20], a.ws + WS_WOUT1T, 4096, D_, 4096, 0, 0, 1, lds);
    transpose_job(a.in[7], (bf16_t*)(a.ws + WS_WGATES), 128, 128, 128, 128 * 128, 256 * 128, 0, 8, lds);
    transpose_job(a.in[9], (bf16_t*)(a.ws + WS_WGATES) + 128 * 128, 128, 128, 128, 128 * 128, 256 * 128, 0, 8, lds);
    moe_weight_jobs(a, 0, lds);
}

#define NORM_PH(M, F) phase_norm<M, F>
template <int MODE, bool F32>
__device__ __forceinline__ void phase_norm(const Args& a, const float* src, const float* gain, int layer) {
    const int wid = TIDX >> 6, lane = TIDX & 63;
    bf16_t* xw = (bf16_t*)(a.ws + WS_X); bf16_t* hw = (bf16_t*)(a.ws + WS_H);
    const unsigned char* ym = a.ws + WS_YMOE; const int* posof = (const int*)(a.ws + WS_POSOF); const float* gate = (const float*)(a.ws + WS_GATE);
    const int stride = NBLK * 16;
    f32x4 rf[2][8]; u32x2 rb[2][8]; int pp[2][2] = {{0, 0}, {0, 0}}; float pg[2][2] = {{0.f, 0.f}, {0.f, 0.f}};
#define NORM_LD(r) { _Pragma("unroll") for (int u = 0; u < 2; ++u) { _Pragma("unroll") for (int i = 0; i < 8; ++i) { \
            if (F32) rf[u][i] = *(const f32x4*)(src + (size_t)((r) + u) * D_ + (i * 64 + lane) * 4); else rb[u][i] = *(const u32x2*)(xw + (size_t)((r) + u) * D_ + (i * 64 + lane) * 4); } \
            if (MODE >= 1) { pp[u][0] = posof[((r) + u) * 2]; pp[u][1] = posof[((r) + u) * 2 + 1]; pg[u][0] = gate[((r) + u) * 2]; pg[u][1] = gate[((r) + u) * 2 + 1]; } } }
    int row = (BID * 8 + wid) * 2;
    if (row < T_) NORM_LD(row)
    for (; row < T_; row += stride) {
        f32x4 v[2][8]; int p[2][2]; float g[2][2];
#pragma unroll
        for (int u = 0; u < 2; ++u) { p[u][0] = pp[u][0]; p[u][1] = pp[u][1]; g[u][0] = pg[u][0]; g[u][1] = pg[u][1];
#pragma unroll
            for (int i = 0; i < 8; ++i) v[u][i] = F32 ? rf[u][i] : (f32x4){bf_lo(rb[u][i].x), bf_hi(rb[u][i].x), bf_lo(rb[u][i].y), bf_hi(rb[u][i].y)}; }
        if (row + stride < T_) NORM_LD(row + stride)
        if (MODE >= 1) {
            int y[2][8][2];
#pragma unroll
            for (int u = 0; u < 2; ++u) {
#pragma unroll
                for (int i = 0; i < 8; ++i) { const int c = (i * 64 + lane) * 4; y[u][i][0] = *(const int*)(ym + (size_t)p[u][0] * D_ + c); y[u][i][1] = *(const int*)(ym + (size_t)p[u][1] * D_ + c); } }
#pragma unroll
            for (int u = 0; u < 2; ++u) { const float g0 = g[u][0], g1 = g[u][1];
#pragma unroll
                for (int i = 0; i < 8; ++i) { const int y0 = y[u][i][0], y1 = y[u][i][1];
                    const f32x2 a0 = __builtin_amdgcn_cvt_pk_f32_fp8(y0, false), a1 = __builtin_amdgcn_cvt_pk_f32_fp8(y0, true), b0 = __builtin_amdgcn_cvt_pk_f32_fp8(y1, false), b1 = __builtin_amdgcn_cvt_pk_f32_fp8(y1, true);
                    v[u][i][0] += g0 * a0[0] + g1 * b0[0]; v[u][i][1] += g0 * a0[1] + g1 * b0[1]; v[u][i][2] += g0 * a1[0] + g1 * b1[0]; v[u][i][3] += g0 * a1[1] + g1 * b1[1]; }
                if (MODE == 1) {
#pragma unroll
                    for (int i = 0; i < 8; ++i) { u32x2 w; w.x = cvt_pk_bf16(v[u][i][0], v[u][i][1]); w.y = cvt_pk_bf16(v[u][i][2], v[u][i][3]); *(u32x2*)(xw + (size_t)(row + u) * D_ + (i * 64 + lane) * 4) = w; } } }
        }
#pragma unroll
        for (int u = 0; u < 2; ++u) {
            float ss = 0.f;
#pragma unroll
            for (int i = 0; i < 8; ++i) ss += v[u][i][0] * v[u][i][0] + v[u][i][1] * v[u][i][1] + v[u][i][2] * v[u][i][2] + v[u][i][3] * v[u][i][3];
            ss = wave_sum(ss);
            const float rstd = rsqrtf(ss * (1.0f / D_) + 1e-6f);
#pragma unroll
            for (int i = 0; i < 8; ++i) { const int c = (i * 64 + lane) * 4; const f32x4 gn = *(const f32x4*)(gain + c);
                const f32x4 o = v[u][i] * rstd * gn;
                if (MODE == 2) *(f32x4*)(a.out + (size_t)(row + u) * D_ + c) = o;
                else { if (MODE != 1) { u32x2 w; w.x = cvt_pk_bf16(o[0], o[1]); w.y = cvt_pk_bf16(o[2], o[3]); *(u32x2*)(hw + (size_t)(row + u) * D_ + c) = w; }
                       if (layer >= 0) *(unsigned*)(a.ws + WS_H8 + (size_t)(row + u) * D_ + c) = pk_fp8x4(o[0], o[1], o[2], o[3]); } } }
    }
#undef NORM_LD
    (void)layer;
}

__device__ __forceinline__ void phase_gemm_in0(const Args& a, LAS unsigned char* lds) {
    SrcGrid S{(const char*)(a.ws + WS_H), (const char*)(a.ws + WS_WIN0T), (size_t)BM * D_ * 2, (size_t)BM * D_ * 2, 64, 64 * 24, D_, D_};
    EpiProj E{(bf16_t*)(a.ws + WS_PROJ), N_IN0, (float*)(a.ws + WS_FLOG), 1024, 12, 16, 256, 1.0f};
    gemm_stream<false, false>(lds, S, D_ / BK, E);
}

__device__ __forceinline__ void phase_rg_conv(const Args& a) {
    const bf16_t* p0 = (const bf16_t*)(a.ws + WS_PROJ); bf16_t* xc = (bf16_t*)(a.ws + WS_XC);
    const float* cw = a.in[5]; const float* cb = a.in[6];
    for (int it = BID * NTHREADS + TIDX; it < 128 * (T_ / 16); it += NBLK * NTHREADS) { const int c = (it & 127) * 8; const size_t t0 = (size_t)(it >> 7) * 16;
        float w[4][8], bias[8];
#pragma unroll
        for (int k = 0; k < 4; ++k) { const f32x4 w0 = *(const f32x4*)(cw + k * 1024 + c), w1 = *(const f32x4*)(cw + k * 1024 + c + 4);
            w[k][0] = w0[0]; w[k][1] = w0[1]; w[k][2] = w0[2]; w[k][3] = w0[3]; w[k][4] = w1[0]; w[k][5] = w1[1]; w[k][6] = w1[2]; w[k][7] = w1[3]; }
        { const f32x4 b0 = *(const f32x4*)(cb + c), b1 = *(const f32x4*)(cb + c + 4); bias[0] = b0[0]; bias[1] = b0[1]; bias[2] = b0[2]; bias[3] = b0[3]; bias[4] = b1[0]; bias[5] = b1[1]; bias[6] = b1[2]; bias[7] = b1[3]; }
        u32x4 x0 = (u32x4){0u, 0u, 0u, 0u}, x1 = x0, x2 = x0;
        if ((t0 & (S_ - 1)) != 0) { x0 = *(const u32x4*)(p0 + (t0 - 3) * N_IN0 + c); x1 = *(const u32x4*)(p0 + (t0 - 2) * N_IN0 + c); x2 = *(const u32x4*)(p0 + (t0 - 1) * N_IN0 + c); }
        u32x4 xr[16];
#pragma unroll
        for (int r = 0; r < 16; ++r) xr[r] = *(const u32x4*)(p0 + (t0 + r) * N_IN0 + c);
#pragma unroll
        for (int r = 0; r < 16; ++r) { const u32x4 x3 = xr[r];
            float acc[8];
#define TAPS(j, f, m) (bias[j] + w[0][j] * f(x0.m) + w[1][j] * f(x1.m) + w[2][j] * f(x2.m) + w[3][j] * f(x3.m))
            acc[0] = TAPS(0, bf_lo, x); acc[1] = TAPS(1, bf_hi, x); acc[2] = TAPS(2, bf_lo, y); acc[3] = TAPS(3, bf_hi, y);
            acc[4] = TAPS(4, bf_lo, z); acc[5] = TAPS(5, bf_hi, z); acc[6] = TAPS(6, bf_lo, w); acc[7] = TAPS(7, bf_hi, w);
#undef TAPS
            u32x4 o; o.x = cvt_pk_bf16(acc[0], acc[1]); o.y = cvt_pk_bf16(acc[2], acc[3]); o.z = cvt_pk_bf16(acc[4], acc[5]); o.w = cvt_pk_bf16(acc[6], acc[7]);
            *(u32x4*)(xc + (t0 + r) * 1024 + c) = o;
            x0 = x1; x1 = x2; x2 = x3; } }
}

struct SrcRgGates {
    const char* xc; const char* w; int total;
    __device__ __forceinline__ bool next(int i, UnitD& u) const { const int id = BID + i * NBLK; if (id >= total) return false; u.t0 = id & 63; u.t1 = id >> 6; u.t2 = 0;
        u.gA = xc + ((size_t)u.t0 * BM * 1024 + u.t1 * 128) * 2; u.gB = w + (size_t)u.t1 * 256 * 128 * 2; return true; }
    __device__ __forceinline__ void va(const UnitD&, unsigned (&v)[2][2]) const { offs_direct(v, 1024, false); }
    __device__ __forceinline__ void vb(unsigned (&v)[2][2]) const { offs_direct(v, 128, true); }
};
__device__ __forceinline__ void phase_rg_gates(const Args& a, LAS unsigned char* lds) {
    SrcRgGates S{(const char*)(a.ws + WS_XC), (const char*)(a.ws + WS_WGATES), 64 * 8};
    EpiRgGates E{(bf16_t*)(a.ws + WS_A), (bf16_t*)(a.ws + WS_U), (const bf16_t*)(a.ws + WS_XC), a.in[8], a.in[10], a.in[11]};
    int nt = 2; asm volatile("" : "+s"(nt));
    gemm_stream<false, false>(lds, S, nt, E);
}

__device__ __forceinline__ void phase_rg_scan(const Args& a, LAS unsigned char* lds) {
    const bf16_t* LA = (const bf16_t*)(a.ws + WS_A); const bf16_t* U = (const bf16_t*)(a.ws + WS_U);
    const bf16_t* p0 = (const bf16_t*)(a.ws + WS_PROJ); bf16_t* Y = (bf16_t*)(a.ws + WS_Y);
    LAS float* sP = (LAS float*)lds; LAS float* sH = sP + 4096; LAS float* gP = sH + 4096; LAS float* gH = gP + 512; LAS float* gC = gH + 512;
    const int tid = TIDX, seg = tid >> 1, c8 = (tid & 1) * 8;
    for (int blk = BID; blk < NB_ * 64; blk += NBLK) { const int b = blk >> 6, c = (blk & 63) * 16 + c8;
        const size_t base = (((size_t)blk * S_ + seg * 16) << 4) + c8;
        float P[8], H[8];
#pragma unroll
        for (int j = 0; j < 8; ++j) { P[j] = 1.f; H[j] = 0.f; }
#pragma unroll 4
        for (int s = 0; s < 16; ++s) { const u32x4 lw = *(const u32x4*)(LA + base + (size_t)s * 16), uw = *(const u32x4*)(U + base + (size_t)s * 16);
            const float la[8] = {bf_lo(lw.x), bf_hi(lw.x), bf_lo(lw.y), bf_hi(lw.y), bf_lo(lw.z), bf_hi(lw.z), bf_lo(lw.w), bf_hi(lw.w)};
            const float uu[8] = {bf_lo(uw.x), bf_hi(uw.x), bf_lo(uw.y), bf_hi(uw.y), bf_lo(uw.z), bf_hi(uw.z), bf_lo(uw.w), bf_hi(uw.w)};
#pragma unroll
            for (int j = 0; j < 8; ++j) { const float av = __expf(la[j]); H[j] = av * H[j] + uu[j]; P[j] *= av; } }
        __syncthreads();
#pragma unroll
        for (int j = 0; j < 8; ++j) { sP[seg * 16 + c8 + j] = P[j]; sH[seg * 16 + c8 + j] = H[j]; }
        __syncthreads();
        { const int ch = tid & 15, grp = tid >> 4; float p = 1.f, h = 0.f;
#pragma unroll
          for (int q = 0; q < 8; ++q) { const int sgi = grp * 8 + q; h = sP[sgi * 16 + ch] * h + sH[sgi * 16 + ch]; p *= sP[sgi * 16 + ch]; }
          gP[grp * 16 + ch] = p; gH[grp * 16 + ch] = h; }
        __syncthreads();
        if (tid < 16) { float carry = 0.f; for (int g = 0; g < 32; ++g) { gC[g * 16 + tid] = carry; carry = gP[g * 16 + tid] * carry + gH[g * 16 + tid]; } }
        __syncthreads();
        { const int ch = tid & 15, grp = tid >> 4; float h = gC[grp * 16 + ch];
#pragma unroll
          for (int q = 0; q < 8; ++q) { const int sgi = grp * 8 + q; const float pin = sP[sgi * 16 + ch], hin = sH[sgi * 16 + ch]; sH[sgi * 16 + ch] = h; h = pin * h + hin; } }
        __syncthreads();
#pragma unroll
        for (int j = 0; j < 8; ++j) H[j] = sH[seg * 16 + c8 + j];
        {
            u32x4 l_a[4], u_a[4], g_a[4];
#define RS_LD(Lv, Uv, Gv, s0) { _Pragma("unroll") for (int j = 0; j < 4; ++j) { const int s_ = (s0) + j; Lv[j] = *(const u32x4*)(LA + base + (size_t)s_ * 16); Uv[j] = *(const u32x4*)(U + base + (size_t)s_ * 16); \
                Gv[j] = *(const u32x4*)(p0 + ((size_t)b * S_ + seg * 16 + s_) * N_IN0 + 1024 + c); } }
            RS_LD(l_a, u_a, g_a, 0)
#pragma unroll
            for (int s0 = 0; s0 < 16; s0 += 4) { u32x4 l_b[4], u_b[4], g_b[4];
#pragma unroll
                for (int j = 0; j < 4; ++j) { l_b[j] = l_a[j]; u_b[j] = u_a[j]; g_b[j] = g_a[j]; }
                if (s0 + 4 < 16) RS_LD(l_b, u_b, g_b, s0 + 4)
#pragma unroll
                for (int j = 0; j < 4; ++j) { const u32x4 lw = l_a[j], uw = u_a[j], gw = g_a[j]; const size_t t = (size_t)b * S_ + seg * 16 + s0 + j;
                    const float la[8] = {bf_lo(lw.x), bf_hi(lw.x), bf_lo(lw.y), bf_hi(lw.y), bf_lo(lw.z), bf_hi(lw.z), bf_lo(lw.w), bf_hi(lw.w)};
                    const float uu[8] = {bf_lo(uw.x), bf_hi(uw.x), bf_lo(uw.y), bf_hi(uw.y), bf_lo(uw.z), bf_hi(uw.z), bf_lo(uw.w), bf_hi(uw.w)};
                    const float gg[8] = {bf_lo(gw.x), bf_hi(gw.x), bf_lo(gw.y), bf_hi(gw.y), bf_lo(gw.z), bf_hi(gw.z), bf_lo(gw.w), bf_hi(gw.w)};
                    float y[8];
#pragma unroll
                    for (int q = 0; q < 8; ++q) { H[q] = __expf(la[q]) * H[q] + uu[q]; y[q] = H[q] * gelu_tanh(gg[q]); }
                    u32x4 o; o.x = cvt_pk_bf16(y[0], y[1]); o.y = cvt_pk_bf16(y[2], y[3]); o.z = cvt_pk_bf16(y[4], y[5]); o.w = cvt_pk_bf16(y[6], y[7]);
                    *(u32x4*)(Y + t * D_ + c) = o; }
#pragma unroll
                for (int j = 0; j < 4; ++j) { l_a[j] = l_b[j]; u_a[j] = u_b[j]; g_a[j] = g_b[j]; } }
#undef RS_LD
        }
    }
}

typedef short s16x4 __attribute__((ext_vector_type(4)));
__device__ __forceinline__ f32x4 mfma32(bf16x8 a, bf16x8 b, f32x4 c) { return __builtin_amdgcn_mfma_f32_16x16x32_bf16(a, b, c, 0, 0, 0); }
__device__ __forceinline__ bf16x8 lds_frag(LAS const unsigned char* p) { return *(const LAS bf16x8*)p; }
__device__ __forceinline__ s16x4 lds_tr4(LAS const unsigned char* p) { return __builtin_amdgcn_ds_read_tr16_b64_v4i16((LAS s16x4*)p); }
__device__ __forceinline__ bf16x8 lds_tr8(LAS const unsigned char* p, int rowskip_bytes) {
    const s16x4 lo = lds_tr4(p), hi = lds_tr4(p + rowskip_bytes); return __builtin_shufflevector(lo, hi, 0, 1, 2, 3, 4, 5, 6, 7); }
__device__ __forceinline__ bf16x8 pack8(const f32x4& lo, const f32x4& hi) { u32x4 w; w.x = cvt_pk_bf16(lo[0], lo[1]); w.y = cvt_pk_bf16(lo[2], lo[3]); w.z = cvt_pk_bf16(hi[0], hi[1]); w.w = cvt_pk_bf16(hi[2], hi[3]); return __builtin_bit_cast(bf16x8, w); }
constexpr int RSB = 272;

constexpr size_t WS_HQ = WS_O;
constexpr size_t WS_HA = WS_HQ + (size_t)2048 * 64 * 128 * 2;
constexpr size_t WS_HG = WS_HA + (size_t)2048 * 8 * 512 * 2;
constexpr size_t WS_HS = WS_HG + (size_t)2048 * 128 * 128 * 2;
constexpr size_t WS_HD = WS_HS + (size_t)2048 * 128 * 128 * 2;
static_assert(WS_HD + (size_t)2048 * 128 * 4 <= WS_TAIL, "hgrn overlay");

__device__ __forceinline__ void phase_hg1(const Args& a, LAS unsigned char* lds) {
    const bf16_t* p0 = (const bf16_t*)(a.ws + WS_PROJ); const float* flog = (const float*)(a.ws + WS_FLOG); const float* lb = (const float*)(a.ws + WS_LB);
    bf16_t* QG = (bf16_t*)(a.ws + WS_HQ); bf16_t* AG = (bf16_t*)(a.ws + WS_HA); bf16_t* GG = (bf16_t*)(a.ws + WS_HG); float* DG = (float*)(a.ws + WS_HD);
    constexpr int SEG = 0, QT = 4096, KT = QT + 64 * RSB, KH = KT + 64 * RSB, VS = KH + 64 * RSB;
    const int tid = TIDX, wid = tid >> 6, lane = tid & 63, I = lane & 15, G = lane >> 4, k2 = 2 * lane, sg = wid;
    LAS float* seg = (LAS float*)(lds + SEG);
    u32x4 pvv[2]; f32x2 pz[8]; unsigned pqw[8];
#define HG1_LOAD(it_) do { const int bh_ = (it_) >> 6, ck_ = (it_) & 63, h_ = bh_ & 7; const size_t t0_ = (size_t)(bh_ >> 3) * S_ + ck_ * 64; \
        _Pragma("unroll") for (int i = 0; i < 2; ++i) { const int c = tid + i * 512, s_ = c >> 4, v8 = (c & 15) * 8; pvv[i] = *(const u32x4*)(p0 + (t0_ + s_) * N_IN0 + 4096 + h_ * 128 + v8); } \
        _Pragma("unroll") for (int i = 0; i < 8; ++i) { const size_t t_ = t0_ + sg * 8 + i; pz[i] = *(const f32x2*)(flog + t_ * 1024 + h_ * 128 + k2); pqw[i] = *(const unsigned*)(p0 + t_ * N_IN0 + 2048 + h_ * 128 + k2); } } while (0)
    if (BID < 2048) HG1_LOAD(BID);
    for (int item = BID; item < 2048; item += NBLK) { const int bh = item >> 6, h = bh & 7;
        LDS_BARRIER();
#pragma unroll
        for (int i = 0; i < 2; ++i) { const int c = tid + i * 512, s = c >> 4, v8 = (c & 15) * 8; *(LAS u32x4*)(lds + VS + s * RSB + v8 * 2) = pvv[i]; }
        const f32x2 l2 = *(const f32x2*)(lb + h * 128 + k2);
        float f[8][2], cb[8][2]; unsigned qw[8]; float c0 = 0.f, c1 = 0.f;
#pragma unroll
        for (int i = 0; i < 8; ++i) { const f32x2 z = pz[i]; qw[i] = pqw[i];
            f[i][0] = l2[0] + (1.0f - l2[0]) * sigmoidf_(z[0]); f[i][1] = l2[1] + (1.0f - l2[1]) * sigmoidf_(z[1]);
            c0 += __logf(f[i][0]); c1 += __logf(f[i][1]); cb[i][0] = c0; cb[i][1] = c1; }
        *(LAS f32x2*)(seg + sg * 128 + k2) = (f32x2){c0, c1};
        if (item + NBLK < 2048) HG1_LOAD(item + NBLK);
        LDS_BARRIER();
        float off0 = 0.f, off1 = 0.f, tot0 = 0.f, tot1 = 0.f;
#pragma unroll
        for (int s2 = 0; s2 < 8; ++s2) { const f32x2 v = *(const LAS f32x2*)(seg + s2 * 128 + k2); tot0 += v[0]; tot1 += v[1]; if (s2 < sg) { off0 += v[0]; off1 += v[1]; } }
        const float et0 = __expf(tot0), et1 = __expf(tot1);
#pragma unroll
        for (int i = 0; i < 8; ++i) { const int t = sg * 8 + i;
            const float e0 = __expf(cb[i][0] + off0), e1 = __expf(cb[i][1] + off1), r0 = __builtin_amdgcn_rcpf(e0), r1 = __builtin_amdgcn_rcpf(e1), km0 = 1.0f - f[i][0], km1 = 1.0f - f[i][1];
            const unsigned qt = cvt_pk_bf16(siluf_(bf_lo(qw[i])) * e0, siluf_(bf_hi(qw[i])) * e1);
            *(LAS unsigned*)(lds + QT + t * RSB + k2 * 2) = qt; *(unsigned*)(QG + ((size_t)item * 64 + t) * 128 + k2) = qt;
            *(LAS unsigned*)(lds + KT + t * RSB + k2 * 2) = cvt_pk_bf16(km0 * r0, km1 * r1);
            *(LAS unsigned*)(lds + KH + t * RSB + k2 * 2) = cvt_pk_bf16(km0 * r0 * et0, km1 * r1 * et1); }
        if (sg == 0) *(f32x2*)(DG + (size_t)item * 128 + k2) = (f32x2){et0, et1};
        LDS_BARRIER();
        { const int tt = wid & 3, sp = wid >> 2;
          bf16x8 qf[4];
#pragma unroll
          for (int ks = 0; ks < 4; ++ks) qf[ks] = lds_frag(lds + QT + (16 * tt + I) * RSB + (32 * ks + 8 * G) * 2);
          f32x4 acc[2];
#pragma unroll
          for (int hh = 0; hh < 2; ++hh) { const int st = 2 * sp + hh; acc[hh] = (f32x4){0.f, 0.f, 0.f, 0.f};
              if (st <= tt) {
#pragma unroll
                  for (int ks = 0; ks < 4; ++ks) acc[hh] = mfma32(lds_frag(lds + KT + (16 * st + I) * RSB + (32 * ks + 8 * G) * 2), qf[ks], acc[hh]);
#pragma unroll
                  for (int r = 0; r < 4; ++r) if (16 * st + 4 * G + r > 16 * tt + I) acc[hh][r] = 0.f; } }
          *(bf16x8*)(AG + (((size_t)item * 4 + tt) * 2 + sp) * 512 + lane * 8) = pack8(acc[0], acc[1]); }
        { const int kt = wid, q = I >> 2, p = I & 3;
          bf16x8 ka[2];
#pragma unroll
          for (int ks = 0; ks < 2; ++ks) ka[ks] = lds_tr8(lds + KH + (32 * ks + 8 * G + q) * RSB + (16 * kt + 4 * p) * 2, 4 * RSB);
#pragma unroll
          for (int vt = 0; vt < 8; ++vt) { f32x4 acc = (f32x4){0.f, 0.f, 0.f, 0.f};
#pragma unroll
              for (int ks = 0; ks < 2; ++ks) acc = mfma32(ka[ks], lds_tr8(lds + VS + (32 * ks + 8 * G + q) * RSB + (16 * vt + 4 * p) * 2, 4 * RSB), acc);
              u32x2 w; w.x = cvt_pk_bf16(acc[0], acc[1]); w.y = cvt_pk_bf16(acc[2], acc[3]);
              *(u32x2*)(GG + ((size_t)item * 128 + 16 * vt + I) * 128 + 16 * kt + 4 * G) = w; } }
    }
#undef HG1_LOAD
}

__device__ __forceinline__ void phase_hg2(const Args& a) {
    const bf16_t* GG = (const bf16_t*)(a.ws + WS_HG); const float* DG = (const float*)(a.ws + WS_HD); bf16_t* SG = (bf16_t*)(a.ws + WS_HS);
    for (int gid = BID * NTHREADS + TIDX; gid < 32 * 4096; gid += NBLK * NTHREADS) { const int bh = gid >> 12, e = gid & 4095, v = e >> 5, k4 = (e & 31) * 4;
        f32x4 S = (f32x4){0.f, 0.f, 0.f, 0.f};
        const size_t o0 = (((size_t)bh * 64) * 128 + v) * 128 + k4; const float* dg = DG + (size_t)bh * 64 * 128 + k4;
        f32x4 da[8]; u32x2 ga[8];
#pragma unroll
        for (int j = 0; j < 8; ++j) { da[j] = *(const f32x4*)(dg + j * 128); ga[j] = *(const u32x2*)(GG + o0 + (size_t)j * 16384); }
#pragma unroll 1
        for (int n0 = 0; n0 < 64; n0 += 8) { f32x4 db[8]; u32x2 gb[8];
#pragma unroll
            for (int j = 0; j < 8; ++j) { db[j] = da[j]; gb[j] = ga[j]; }
            if (n0 + 8 < 64) {
#pragma unroll
                for (int j = 0; j < 8; ++j) { db[j] = *(const f32x4*)(dg + (n0 + 8 + j) * 128); gb[j] = *(const u32x2*)(GG + o0 + (size_t)(n0 + 8 + j) * 16384); } }
#pragma unroll
            for (int j = 0; j < 8; ++j) { u32x2 w; w.x = cvt_pk_bf16(S[0], S[1]); w.y = cvt_pk_bf16(S[2], S[3]); *(u32x2*)(SG + o0 + (size_t)(n0 + j) * 16384) = w;
                const f32x4 d = da[j]; const u32x2 g = ga[j];
                S[0] = d[0] * S[0] + bf_lo(g.x); S[1] = d[1] * S[1] + bf_hi(g.x); S[2] = d[2] * S[2] + bf_lo(g.y); S[3] = d[3] * S[3] + bf_hi(g.y); }
#pragma unroll
            for (int j = 0; j < 8; ++j) { da[j] = db[j]; ga[j] = gb[j]; } } }
}

__device__ __forceinline__ void phase_hg3(const Args& a, LAS unsigned char* lds) {
    const bf16_t* p0 = (const bf16_t*)(a.ws + WS_PROJ); const bf16_t* QG = (const bf16_t*)(a.ws + WS_HQ); const bf16_t* AG = (const bf16_t*)(a.ws + WS_HA); const bf16_t* SG = (const bf16_t*)(a.ws + WS_HS);
    bf16_t* Y = (bf16_t*)(a.ws + WS_Y); const float* gain = a.in[13];
    constexpr int ST = 0, QT = 128 * RSB, VS = QT + 64 * RSB, PART = VS + 64 * RSB;
    const int tid = TIDX, wid = tid >> 6, lane = tid & 63, I = lane & 15, G = lane >> 4, q = I >> 2, p = I & 3;
    LAS float* part = (LAS float*)(lds + PART);
    const int tt = wid & 3, vh = wid >> 2;
    u32x4 ps[4], pq2[2], pv2[2]; bf16x8 paf[2];
#define HG3_LOAD(it_) do { const int bh_ = (it_) >> 6, ck_ = (it_) & 63; const size_t t0_ = (size_t)(bh_ >> 3) * S_ + ck_ * 64; const int h_ = bh_ & 7; \
        _Pragma("unroll") for (int i = 0; i < 4; ++i) { const int c = tid + i * 512, v = c >> 4, k8 = (c & 15) * 8; ps[i] = *(const u32x4*)(SG + ((size_t)(it_) * 128 + v) * 128 + k8); } \
        _Pragma("unroll") for (int i = 0; i < 2; ++i) { const int c = tid + i * 512, s_ = c >> 4, c8 = (c & 15) * 8; pq2[i] = *(const u32x4*)(QG + ((size_t)(it_) * 64 + s_) * 128 + c8); pv2[i] = *(const u32x4*)(p0 + (t0_ + s_) * N_IN0 + 4096 + h_ * 128 + c8); } \
        _Pragma("unroll") for (int sp = 0; sp < 2; ++sp) paf[sp] = *(const bf16x8*)(AG + (((size_t)(it_) * 4 + tt) * 2 + sp) * 512 + lane * 8); } while (0)
    if (BID < 2048) HG3_LOAD(BID);
    for (int item = BID; item < 2048; item += NBLK) { const int bh = item >> 6, ck = item & 63, b = bh >> 3, h = bh & 7; const size_t t0 = (size_t)b * S_ + ck * 64;
        LDS_BARRIER();
#pragma unroll
        for (int i = 0; i < 4; ++i) { const int c = tid + i * 512, v = c >> 4, k8 = (c & 15) * 8; *(LAS u32x4*)(lds + ST + v * RSB + k8 * 2) = ps[i]; }
#pragma unroll
        for (int i = 0; i < 2; ++i) { const int c = tid + i * 512, s2 = c >> 4, c8 = (c & 15) * 8; *(LAS u32x4*)(lds + QT + s2 * RSB + c8 * 2) = pq2[i]; *(LAS u32x4*)(lds + VS + s2 * RSB + c8 * 2) = pv2[i]; }
        bf16x8 af[2]; af[0] = paf[0]; af[1] = paf[1];
        if (item + NBLK < 2048) HG3_LOAD(item + NBLK);
        u32x2 zwp[4];
#pragma unroll
        for (int vi = 0; vi < 4; ++vi) zwp[vi] = *(const u32x2*)(p0 + (t0 + 16 * tt + I) * N_IN0 + 5120 + h * 128 + 16 * (4 * vh + vi) + 4 * G);
        LDS_BARRIER();
        bf16x8 qf[4];
#pragma unroll
        for (int ks = 0; ks < 4; ++ks) qf[ks] = lds_frag(lds + QT + (16 * tt + I) * RSB + (32 * ks + 8 * G) * 2);
        f32x4 acc[4]; float ss = 0.f;
#pragma unroll
        for (int vi = 0; vi < 4; ++vi) { const int vt = 4 * vh + vi; acc[vi] = (f32x4){0.f, 0.f, 0.f, 0.f};
#pragma unroll
            for (int ks = 0; ks < 4; ++ks) acc[vi] = mfma32(lds_frag(lds + ST + (16 * vt + I) * RSB + (32 * ks + 8 * G) * 2), qf[ks], acc[vi]);
#pragma unroll
            for (int sp = 0; sp < 2; ++sp) acc[vi] = mfma32(lds_tr8(lds + VS + (32 * sp + 4 * G + q) * RSB + (16 * vt + 4 * p) * 2, 16 * RSB), af[sp], acc[vi]);
            ss += acc[vi][0] * acc[vi][0] + acc[vi][1] * acc[vi][1] + acc[vi][2] * acc[vi][2] + acc[vi][3] * acc[vi][3]; }
        ss += __shfl_xor(ss, 16); ss += __shfl_xor(ss, 32);
        if (G == 0) part[wid * 16 + I] = ss;
        LDS_BARRIER();
        const float rstd = rsqrtf((part[wid * 16 + I] + part[(wid ^ 4) * 16 + I]) * (1.0f / 128.0f) + 1e-6f);
        const size_t t = t0 + 16 * tt + I;
#pragma unroll
        for (int vi = 0; vi < 4; ++vi) { const int c = h * 128 + 16 * (4 * vh + vi) + 4 * G;
            const f32x4 gn = *(const f32x4*)(gain + c); const u32x2 zw = zwp[vi];
            const float o0 = acc[vi][0] * rstd * gn[0] * siluf_(bf_lo(zw.x)), o1 = acc[vi][1] * rstd * gn[1] * siluf_(bf_hi(zw.x)), o2 = acc[vi][2] * rstd * gn[2] * siluf_(bf_lo(zw.y)), o3 = acc[vi][3] * rstd * gn[3] * siluf_(bf_hi(zw.y));
            u32x2 w; w.x = cvt_pk_bf16(o0, o1); w.y = cvt_pk_bf16(o2, o3); *(u32x2*)(Y + t * D_ + 1024 + c) = w; }
    }
#undef HG3_LOAD
}

__device__ __forceinline__ void phase_gdn_norm(const Args& a) {
    const bf16_t* O = (const bf16_t*)(a.ws + WS_O); const bf16_t* pj = (const bf16_t*)(a.ws + WS_PROJ); unsigned char* Y = a.ws + WS_Y; const float* gain = a.in[19];
    const int lane = TIDX & 63, wid = TIDX >> 6, gc = (lane & 15) * 8;
    const f32x4 g0 = *(const f32x4*)(gain + gc), g1 = *(const f32x4*)(gain + gc + 4);
    u32x4 oa[8], za[8];
    int row = BID * 8 + wid; const int stride = NBLK * 8;
#define GN_LD(ov, zv, r) { _Pragma("unroll") for (int i = 0; i < 8; ++i) { const int c = (i * 64 + lane) * 8; ov[i] = *(const u32x4*)(O + (size_t)(r) * 4096 + c); zv[i] = *(const u32x4*)(pj + (size_t)(r) * N_IN1P + 8192 + c); } }
    if (row < T_) GN_LD(oa, za, row)
    for (; row < T_; row += stride) { u32x4 ob[8], zb[8];
#pragma unroll
        for (int i = 0; i < 8; ++i) { ob[i] = oa[i]; zb[i] = za[i]; }
        if (row + stride < T_) GN_LD(ob, zb, row + stride)
#pragma unroll
        for (int i = 0; i < 8; ++i) { const int c = (i * 64 + lane) * 8;
            const u32x4 ow = oa[i], zw = za[i];
            const float o[8] = {bf_lo(ow.x), bf_hi(ow.x), bf_lo(ow.y), bf_hi(ow.y), bf_lo(ow.z), bf_hi(ow.z), bf_lo(ow.w), bf_hi(ow.w)};
            const float z[8] = {bf_lo(zw.x), bf_hi(zw.x), bf_lo(zw.y), bf_hi(zw.y), bf_lo(zw.z), bf_hi(zw.z), bf_lo(zw.w), bf_hi(zw.w)};
            float ss = 0.f;
#pragma unroll
            for (int q = 0; q < 8; ++q) ss += o[q] * o[q];
            ss = row16_sum(ss);
            const float rstd = rsqrtf(ss * (1.0f / 128.0f) + 1e-6f);
            float y[8];
#pragma unroll
            for (int q = 0; q < 8; ++q) y[q] = o[q] * rstd * (q < 4 ? g0[q & 3] : g1[q & 3]) * siluf_(z[q]);
            u32x2 w; w.x = pk_fp8x4(y[0], y[1], y[2], y[3]); w.y = pk_fp8x4(y[4], y[5], y[6], y[7]);
            *(u32x2*)(Y + (size_t)row * 4096 + c) = w; }
#pragma unroll
        for (int i = 0; i < 8; ++i) { oa[i] = ob[i]; za[i] = zb[i]; }
    }
#undef GN_LD
}

template <bool FP8>
__device__ __forceinline__ void phase_gemm_out(const Args& a, LAS unsigned char* lds, int K, const void* w, const float* xin) {
    const int eb = FP8 ? 1 : 2;
    SrcGrid S{(const char*)(a.ws + WS_Y), (const char*)w, (size_t)BM * K * eb, (size_t)BM * K * eb, 64, 64 * 8, K * eb / 2, K * eb / 2};
    EpiResid E{(bf16_t*)(a.ws + WS_X), xin, (const bf16_t*)(a.ws + WS_X), FP8 ? 1.0f / W8_SCALE : 1.0f};
    gemm_stream<false, FP8>(lds, S, K * eb / 128, E);
}

struct SrcRouter {
    const char* h; const char* w;
    __device__ __forceinline__ bool next(int i, UnitD& u) const { const int id = BID + i * NBLK; if (id >= 256) return false; u.t0 = id & 63; u.t1 = id >> 6; u.t2 = 0;
        u.gA = h + ((size_t)u.t0 * BM * D_ + u.t1 * 512) * 2; u.gB = w + (size_t)u.t1 * 512 * 2; return true; }
    __device__ __forceinline__ void va(const UnitD&, unsigned (&v)[2][2]) const { offs_direct(v, D_, false); }
    __device__ __forceinline__ void vb(unsigned (&v)[2][2]) const { offs_direct(v, D_, true); }
};
struct EpiLogitsQ {
    float* O;
    __device__ __forceinline__ void operator()(const Acc& acc, const UnitD& u, int wr, int wc, int fr, int fq) const { store_f32_tile(acc, O + ((size_t)u.t1 * T_ + (size_t)u.t0 * BM) * 128, nullptr, 128, 128, wr, wc, fr, fq); }
};
__device__ __forceinline__ void phase_gemm_router(const Args& a, LAS unsigned char* lds, int layer) {
    SrcRouter S{(const char*)(a.ws + WS_H), (const char*)(a.ws + WS_WRT) + (size_t)layer * 256 * D_ * 2};
    EpiLogitsQ E{(float*)(a.ws + WS_O)};
    gemm_stream<false, false>(lds, S, 512 / BK, E);
}

__device__ __forceinline__ void phase_route(const Args& a, int layer) {
    const float* lg = (const float*)(a.ws + WS_O); const float* bg = a.in[22] + layer * 8; const float* be = a.in[24] + layer * 64;
    int* cnt = (int*)(a.ws + WS_CTL + CTL_CNT) + layer * 64;
    int* eid = (int*)(a.ws + WS_EID); int* slot = (int*)(a.ws + WS_SLOT); float* gate = (float*)(a.ws + WS_GATE); int* rowmap = (int*)(a.ws + WS_ROWMAP);
    const int gtid = BID * NTHREADS + TIDX, gsz = NBLK * NTHREADS;
    for (int i = gtid; i < MPAD; i += gsz) rowmap[i] = 0;
    for (int t = gtid; t < T_; t += gsz) {
        f32x4 ga = (f32x4){0.f, 0.f, 0.f, 0.f}, gb = ga;
#pragma unroll
        for (int kq = 0; kq < 4; ++kq) { ga += *(const f32x4*)(lg + ((size_t)kq * T_ + t) * 128); gb += *(const f32x4*)(lg + ((size_t)kq * T_ + t) * 128 + 4); }
        const float gl[8] = {ga[0] + bg[0], ga[1] + bg[1], ga[2] + bg[2], ga[3] + bg[3], gb[0] + bg[4], gb[1] + bg[5], gb[2] + bg[6], gb[3] + bg[7]};
        float mx = -3.0e38f; int gi = 0;
#pragma unroll
        for (int j = 0; j < 8; ++j) if (gl[j] > mx) { mx = gl[j]; gi = j; }
        float se = 0.f;
#pragma unroll
        for (int j = 0; j < 8; ++j) se += __expf(gl[j] - mx);
        const float gp = 1.0f / se;
        f32x4 ea = *(const f32x4*)(be + gi * 8), eb = *(const f32x4*)(be + gi * 8 + 4);
#pragma unroll
        for (int kq = 0; kq < 4; ++kq) { ea += *(const f32x4*)(lg + ((size_t)kq * T_ + t) * 128 + 8 + gi * 8); eb += *(const f32x4*)(lg + ((size_t)kq * T_ + t) * 128 + 12 + gi * 8); }
        const float el[8] = {ea[0], ea[1], ea[2], ea[3], eb[0], eb[1], eb[2], eb[3]};
        float l1 = -3.0e38f, l2 = -3.0e38f; int i1 = 0, i2 = 0;
#pragma unroll
        for (int j = 0; j < 8; ++j) { const float v = el[j];
            if (v > l1) { l2 = l1; i2 = i1; l1 = v; i1 = j; } else if (v > l2) { l2 = v; i2 = j; } }
        const float e2 = __expf(l2 - l1), inv = 1.0f / (1.0f + e2);
        const int e0 = gi * 8 + i1, e1 = gi * 8 + i2;
        eid[t * 2] = e0; eid[t * 2 + 1] = e1; gate[t * 2] = inv * gp; gate[t * 2 + 1] = e2 * inv * gp;
        slot[t * 2] = atomicAdd(&cnt[e0], 1); slot[t * 2 + 1] = atomicAdd(&cnt[e1], 1); }
}

__device__ __forceinline__ void phase_rowmap(const Args& a, LAS unsigned char* lds, int layer) {
    const int* cnt = (const int*)(a.ws + WS_CTL + CTL_CNT) + layer * 64; LAS int* ps = (LAS int*)lds;
    int* tinfo = (int*)(a.ws + WS_TINFO) + layer * 512;
    const int* eid = (const int*)(a.ws + WS_EID); const int* slot = (const int*)(a.ws + WS_SLOT); int* posof = (int*)(a.ws + WS_POSOF); int* rowmap = (int*)(a.ws + WS_ROWMAP);
    __syncthreads();
    if (TIDX == 0) { int acc = 0; for (int e = 0; e < 64; ++e) { ps[e] = acc; acc += (cnt[e] + 255) & ~255; } ps[64] = acc; }
    __syncthreads();
    if (BID == 0) { if (TIDX <= 64) tinfo[TIDX] = ps[TIDX]; if (TIDX == 65) tinfo[65] = ps[64] >> 8;
        if (TIDX < 192) { const int p = TIDX * 256; int e = 0; for (int j = 0; j < 64; ++j) if (ps[j + 1] <= p) e = j + 1; tinfo[128 + TIDX] = e < 64 ? e : 63; } }
    for (int i = BID * NTHREADS + TIDX; i < T_ * 2; i += NBLK * NTHREADS) { const int p = ps[eid[i]] + slot[i]; posof[i] = p; rowmap[p] = i >> 1; }
    __syncthreads();
}

struct SrcMoeUp {
    const char* h; const char* wg; const int* tinfo; const int* rowmap; int total;
    __device__ __forceinline__ bool next(int i, UnitD& u) const { const int id = BID + i * NBLK; if (id >= total) return false; u.t0 = id >> 2; u.t1 = id & 3;
        u.t2 = __builtin_amdgcn_readfirstlane(tinfo[128 + u.t0]); u.gA = h; u.gB = wg + ((size_t)u.t2 * DEXP + u.t1 * 128) * D_; return true; }
    __device__ __forceinline__ void va(const UnitD& u, unsigned (&v)[2][2]) const { int R0, C0; stage_pos(TIDX, R0, C0);
#pragma unroll
        for (int hh = 0; hh < 2; ++hh)
#pragma unroll
            for (int i = 0; i < 2; ++i) v[hh][i] = (unsigned)(rowmap[u.t0 * 256 + hh * 128 + R0 + 64 * i] * D_ + C0 * 2); }
    __device__ __forceinline__ void vb(unsigned (&v)[2][2]) const { int R0, C0; stage_pos(TIDX, R0, C0);
#pragma unroll
        for (int i = 0; i < 2; ++i) { const int Rr = perm_row(R0 + 64 * i); v[0][i] = (unsigned)(Rr * D_ + C0 * 2); v[1][i] = (unsigned)(WS_WU - WS_WG) + (unsigned)(Rr * D_ + C0 * 2); } }
};
__device__ __forceinline__ void phase_moe_up(const Args& a, LAS unsigned char* lds, int layer) {
    const int* tinfo = (const int*)(a.ws + WS_TINFO) + layer * 512;
    const int ntm = __builtin_amdgcn_readfirstlane(tinfo[65]);
    SrcMoeUp S{(const char*)(a.ws + WS_H8), (const char*)(a.ws + WS_WG), tinfo, (const int*)(a.ws + WS_ROWMAP), ntm * 4};
    EpiSwiGLU E{a.ws + WS_ACT};
    gemm_stream<true, true>(lds, S, D_ / 128, E);
}

struct SrcMoeDown {
    const char* act; const char* wd; const int* tinfo; int total;
    __device__ __forceinline__ bool next(int i, UnitD& u) const { const int id = BID + i * NBLK; if (id >= total) return false; u.t0 = id >> 3; u.t1 = id & 7;
        u.t2 = __builtin_amdgcn_readfirstlane(tinfo[128 + u.t0]); u.gA = act + (size_t)u.t0 * BM * DEXP; u.gB = wd + ((size_t)u.t2 * D_ + u.t1 * BM) * DEXP; return true; }
    __device__ __forceinline__ void va(const UnitD&, unsigned (&v)[2][2]) const { offs_direct(v, DEXP / 2, false); }
    __device__ __forceinline__ void vb(unsigned (&v)[2][2]) const { offs_direct(v, DEXP / 2, true); }
};
__device__ __forceinline__ void phase_moe_down(const Args& a, LAS unsigned char* lds, int layer) {
    const int* tinfo = (const int*)(a.ws + WS_TINFO) + layer * 512; const int ntm = __builtin_amdgcn_readfirstlane(tinfo[65]);
    SrcMoeDown S{(const char*)(a.ws + WS_ACT), (const char*)(a.ws + WS_WD), tinfo, ntm * 8};
    EpiDown E{a.ws + WS_YMOE};
    gemm_stream<false, true>(lds, S, DEXP / 128, E);
}

struct SrcIn1Tail {
    const char* h; const char* w;
    __device__ __forceinline__ bool next(int i, UnitD& u) const { const int id = BID + i * NBLK; if (id >= 256) return false; u.t0 = id & 63; u.t1 = id >> 6; u.t2 = 0;
        u.gA = h + (size_t)u.t0 * BM * D_ + u.t1 * 512; u.gB = w + (size_t)48 * BM * D_ + u.t1 * 512; return true; }
    __device__ __forceinline__ void va(const UnitD&, unsigned (&v)[2][2]) const { offs_direct(v, D_ / 2, false); }
    __device__ __forceinline__ void vb(unsigned (&v)[2][2]) const { offs_direct(v, D_ / 2, true); }
};
struct EpiTailQ {
    float* O;
    __device__ __forceinline__ void operator()(const Acc& acc, const UnitD& u, int wr, int wc, int fr, int fq) const { store_f32_tile(acc, O + ((size_t)u.t1 * T_ + (size_t)u.t0 * BM) * 64, nullptr, 64, 64, wr, wc, fr, fq, 1.0f / W8_SCALE); }
};
__device__ __forceinline__ void phase_gemm_in1(const Args& a, LAS unsigned char* lds) {
    SrcGrid S{(const char*)(a.ws + WS_H8), (const char*)(a.ws + WS_WIN1T), (size_t)BM * D_, (size_t)BM * D_, 64, 64 * 48, D_ / 2, D_ / 2};
    EpiProj E{(bf16_t*)(a.ws + WS_PROJ), N_IN1P, nullptr, 64, 48, 48, 64, 1.0f / W8_SCALE};
    gemm_stream<false, true>(lds, S, D_ / 128, E);
}
__device__ __forceinline__ void phase_gemm_in1_tail(const Args& a, LAS unsigned char* lds) {
    SrcIn1Tail S{(const char*)(a.ws + WS_H8), (const char*)(a.ws + WS_WIN1T)};
    EpiTailQ E{(float*)(a.ws + WS_O)};
    int nt = 4; asm volatile("" : "+s"(nt));
    gemm_stream<false, true>(lds, S, nt, E);
}

__device__ __forceinline__ void phase_gdn_conv(const Args& a) {
    const bf16_t* p1 = (const bf16_t*)(a.ws + WS_PROJ); bf16_t* qc = (bf16_t*)(a.ws + WS_QKVC); const float* cw = a.in[16];
    const int gtid = BID * NTHREADS + TIDX, gsz = NBLK * NTHREADS;
    for (int it = gtid; it < 1024 * (T_ / 128); it += gsz) { const int c = (it & 1023) * 8, seg = it >> 10; const size_t t0 = (size_t)seg * 128;
        float w[4][8];
#pragma unroll
        for (int k = 0; k < 4; ++k) { const f32x4 w0 = *(const f32x4*)(cw + k * 8192 + c), w1 = *(const f32x4*)(cw + k * 8192 + c + 4);
            w[k][0] = w0[0]; w[k][1] = w0[1]; w[k][2] = w0[2]; w[k][3] = w0[3]; w[k][4] = w1[0]; w[k][5] = w1[1]; w[k][6] = w1[2]; w[k][7] = w1[3]; }
        u32x4 x0 = (u32x4){0u, 0u, 0u, 0u}, x1 = x0, x2 = x0;
        if ((t0 & (S_ - 1)) != 0) { x0 = *(const u32x4*)(p1 + (t0 - 3) * N_IN1P + c); x1 = *(const u32x4*)(p1 + (t0 - 2) * N_IN1P + c); x2 = *(const u32x4*)(p1 + (t0 - 1) * N_IN1P + c); }
        const float qsc = c < 2048 ? 0.08838834764831845f : 1.0f;
        u32x4 xa[8];
#pragma unroll
        for (int j = 0; j < 8; ++j) xa[j] = *(const u32x4*)(p1 + (t0 + j) * N_IN1P + c);
#pragma unroll 1
        for (int r0 = 0; r0 < 128; r0 += 8) { u32x4 xb[8];
#pragma unroll
            for (int j = 0; j < 8; ++j) xb[j] = xa[j];
            if (r0 + 8 < 128) {
#pragma unroll
                for (int j = 0; j < 8; ++j) xb[j] = *(const u32x4*)(p1 + (t0 + r0 + 8 + j) * N_IN1P + c); }
#pragma unroll
          for (int j8 = 0; j8 < 8; ++j8) { const u32x4 x3 = xa[j8]; const int r = r0 + j8;
            float acc[8];
#define TAPS(j, f, m) (w[0][j] * f(x0.m) + w[1][j] * f(x1.m) + w[2][j] * f(x2.m) + w[3][j] * f(x3.m))
            acc[0] = TAPS(0, bf_lo, x); acc[1] = TAPS(1, bf_hi, x); acc[2] = TAPS(2, bf_lo, y); acc[3] = TAPS(3, bf_hi, y);
            acc[4] = TAPS(4, bf_lo, z); acc[5] = TAPS(5, bf_hi, z); acc[6] = TAPS(6, bf_lo, w); acc[7] = TAPS(7, bf_hi, w);
#undef TAPS
            float ss = 0.f;
#pragma unroll
            for (int j = 0; j < 8; ++j) { acc[j] = siluf_(acc[j]); ss += acc[j] * acc[j]; }
            ss = row16_sum(ss);
            const float sc = c < 4096 ? rsqrtf(ss + 1e-6f) * qsc : 1.0f;
            u32x4 o; o.x = cvt_pk_bf16(acc[0] * sc, acc[1] * sc); o.y = cvt_pk_bf16(acc[2] * sc, acc[3] * sc); o.z = cvt_pk_bf16(acc[4] * sc, acc[5] * sc); o.w = cvt_pk_bf16(acc[6] * sc, acc[7] * sc);
            *(u32x4*)(qc + (t0 + r) * 8192 + c) = o;
            x0 = x1; x1 = x2; x2 = x3; }
#pragma unroll
            for (int j = 0; j < 8; ++j) xa[j] = xb[j]; } }
    const float* tail = (const float*)(a.ws + WS_O); float* bgo = (float*)(a.ws + WS_BG);
    for (int it = gtid; it < T_ * 32; it += gsz) { const int t = it >> 5, hv = it & 31; float tb = 0.f, ta = 0.f;
#pragma unroll
        for (int kq = 0; kq < 4; ++kq) { tb += tail[((size_t)kq * T_ + t) * 64 + hv]; ta += tail[((size_t)kq * T_ + t) * 64 + 32 + hv]; }
        bgo[t * 64 + hv] = sigmoidf_(tb);
        bgo[t * 64 + 32 + hv] = -__expf(a.in[17][hv]) * softplusf_(ta + a.in[18][hv]); }
}

struct MoeTile { const float* src; unsigned char* dst; int lds_, ldd; };
__device__ __forceinline__ MoeTile moe_tile(const Args& a, int g) {
    const int job = g >> 14, r = g & 16383, e = r >> 8, rr = r & 255; MoeTile t;
    typedef __attribute__((address_space(1))) const float* gcf; gcf s25 = (gcf)a.in[25], s26 = (gcf)a.in[26]; asm volatile("" : "+s"(s25), "+s"(s26));
    if (job < 2) { const int ik = rr >> 3, in = rr & 7; t.lds_ = DEXP; t.ldd = D_;
        t.src = (const float*)(job ? s26 : s25) + ((size_t)(NEXP + e) * D_ + ik * 64) * DEXP + in * 64; t.dst = a.ws + (job ? WS_WU : WS_WG) + ((size_t)e * DEXP + in * 64) * D_ + ik * 64; }
    else { const int ik = rr >> 5, in = rr & 31; t.lds_ = D_; t.ldd = DEXP;
        t.src = a.in[27] + ((size_t)(NEXP + e) * DEXP + ik * 64) * D_ + in * 64; t.dst = a.ws + WS_WD + ((size_t)e * D_ + in * 64) * DEXP + ik * 64; }
    return t;
}
__device__ __forceinline__ void moe_tile_load(const MoeTile& t, int tid, f32x4 (&v)[2]) {
#pragma unroll
    for (int i = 0; i < 2; ++i) { const int idx = tid + i * 512, rr = idx >> 4, c4 = (idx & 15) * 4; v[i] = *(const f32x4*)(t.src + (size_t)rr * t.lds_ + c4); }
}
__device__ __forceinline__ void moe_tile_store(const MoeTile& t, int tid, const f32x4 (&v)[2], LAS float* tile) {
#pragma unroll
    for (int i = 0; i < 2; ++i) { const int idx = tid + i * 512, rr = idx >> 4, c4 = (idx & 15) * 4;
        tile[rr * 65 + c4 + 0] = v[i][0]; tile[rr * 65 + c4 + 1] = v[i][1]; tile[rr * 65 + c4 + 2] = v[i][2]; tile[rr * 65 + c4 + 3] = v[i][3]; }
    LDS_BARRIER();
    { const int n = tid >> 3, kg = (tid & 7) * 8; float f[8];
#pragma unroll
      for (int jj = 0; jj < 8; ++jj) f[jj] = tile[(kg + jj) * 65 + n] * W8_SCALE;
      u32x2 w; w.x = pk_fp8x4(f[0], f[1], f[2], f[3]); w.y = pk_fp8x4(f[4], f[5], f[6], f[7]);
      *(u32x2*)(t.dst + (size_t)n * t.ldd + kg) = w; }
    LDS_BARRIER();
}
constexpr int MOE_TILES = 3 * NEXP * 256;

__device__ __forceinline__ f32x4 mfma16(s16x4 a, s16x4 b, f32x4 c) { return __builtin_amdgcn_mfma_f32_16x16x16bf16_1k(a, b, c, 0, 0, 0); }
__device__ __forceinline__ s16x4 pack4(const f32x4& v) { u32x2 w; w.x = cvt_pk_bf16(v[0], v[1]); w.y = cvt_pk_bf16(v[2], v[3]); return __builtin_bit_cast(s16x4, w); }
__device__ __forceinline__ void phase_gdn_chunk(const Args& a, LAS unsigned char* lds) {
    const bf16_t* qc = (const bf16_t*)(a.ws + WS_QKVC); const float* bgi = (const float*)(a.ws + WS_BG); bf16_t* O = (bf16_t*)(a.ws + WS_O);
    constexpr int VRS = 144, KTRS = 136;
    constexpr int KT = 0, QS = KT + 128 * KTRS, WSL = QS + 64 * RSB, QKS = WSL + 64 * RSB, EE = QKS + 2048, EDD = EE + 256, SET = EDD + 256;
    constexpr int STL = 2 * SET, KS = STL + 64 * RSB, VS = KS + 64 * RSB, X2 = VS + 64 * VRS, LS = X2 + 2048, X1 = LS + 4096, GAM = X1 + 2048, BET = GAM + 256, LEND = BET + 256;
    static_assert(LEND <= LDS_XBW, "gdn lds");
    const int wid = __builtin_amdgcn_readfirstlane(TIDX >> 6);
    const int NCK = S_ / 64;
    for (int blk = BID; blk < NB_ * 32 * 2; blk += NBLK) {
        const int grp = (blk & 7) * 8 + (blk >> 5), mem = (blk >> 3) & 3, b = grp >> 4, hk = grp & 15, hv = 2 * hk + (mem >> 1), vhalf = mem & 1;
        __syncthreads();
        if (wid < 4) {
            const int vt = wid;
            f32x4 Sacc[8];
#pragma unroll
            for (int n = 0; n < 8; ++n) Sacc[n] = (f32x4){0.f, 0.f, 0.f, 0.f};
            { const int lane = TIDX & 63;
              for (int i = lane; i < 16 * RSB / 16; i += 64) *(LAS u32x4*)(lds + STL + 16 * vt * RSB + i * 16) = (u32x4){0u, 0u, 0u, 0u}; }
            int lz = TIDX & 63; asm volatile("" : "+v"(lz));
            const int lane = lz, I = lane & 15, G = lane >> 4, q4 = I >> 2, p4 = I & 3;
            for (int it = 0; it <= NCK; ++it) {
                const int set = ((it - 1) & 1) * SET; const size_t t0 = (size_t)b * S_ + (size_t)(it - 1) * 64;
                f32x4 U[4];
                if (it >= 1) {
#pragma unroll
                    for (int sa = 0; sa < 4; ++sa) U[sa] = mfma16(*(const LAS s16x4*)(lds + X2 + ((sa * 16 + I) * 16 + 4 * G) * 2), lds_tr4(lds + VS + (16 * sa + 4 * G + q4) * VRS + (16 * vt + 4 * p4) * 2), (f32x4){0.f, 0.f, 0.f, 0.f});
                    asm volatile("" : "+v"(U[0]), "+v"(U[1]), "+v"(U[2]), "+v"(U[3]) :: "memory");
                }
                LDS_BARRIER();
#pragma unroll
                for (int sa = 0; sa < 4; ++sa) {
                    if (it >= 1) {
                        bf16x8 sf[4];
#pragma unroll
                        for (int ks = 0; ks < 4; ++ks) sf[ks] = lds_frag(lds + STL + (16 * vt + I) * RSB + (32 * ks + 8 * G) * 2);
                        s16x4 kt[8];
#pragma unroll
                        for (int dt = 0; dt < 8; ++dt) kt[dt] = *(const LAS s16x4*)(lds + set + KT + (16 * dt + I) * KTRS + (16 * sa + 4 * G) * 2);
                        f32x4 dl = U[sa], oq = (f32x4){0.f, 0.f, 0.f, 0.f};
#pragma unroll
                        for (int ks = 0; ks < 4; ++ks) { dl = mfma32(lds_frag(lds + set + WSL + (16 * sa + I) * RSB + (32 * ks + 8 * G) * 2), sf[ks], dl);
                            oq = mfma32(lds_frag(lds + set + QS + (16 * sa + I) * RSB + (32 * ks + 8 * G) * 2), sf[ks], oq); }
                        const s16x4 dfrag = pack4(dl);
                        const f32x4 e4 = *(const LAS f32x4*)(lds + set + EE + (16 * sa + 4 * G) * 4);
                        oq = mfma16(*(const LAS s16x4*)(lds + set + QKS + ((sa * 16 + I) * 16 + 4 * G) * 2), dfrag, oq * e4);
#pragma unroll
                        for (int r = 0; r < 4; ++r) O[(t0 + 16 * sa + 4 * G + r) * 4096 + hv * 128 + vhalf * 64 + 16 * vt + I] = f2bf(oq[r]);
                        const f32x4 ed4 = *(const LAS f32x4*)(lds + set + EDD + (16 * sa + 4 * G) * 4); const float e15 = *(const LAS float*)(lds + set + EE + (16 * sa + 15) * 4);
                        const s16x4 dsc = pack4(dl * ed4);
#pragma unroll
                        for (int dt = 0; dt < 8; ++dt) {
                            Sacc[dt] = mfma16(kt[dt], dsc, Sacc[dt] * e15);
                            *(LAS s16x4*)(lds + STL + (16 * vt + I) * RSB + (16 * dt + 4 * G) * 2) = pack4(Sacc[dt]); }
                    }
                    if (sa & 1) LDS_BARRIER();
                }
            }
        } else {
            const int pw = wid - 4;
            u32x4 pq[4], pk[4], pv[2]; float pb = 0.f, pg = 0.f;
            { const int ptid = TIDX - 256; const size_t t0 = (size_t)b * S_;
#pragma unroll
              for (int i = 0; i < 4; ++i) { const int c = ptid + i * 256, s2 = c >> 4, c8 = (c & 15) * 8; pq[i] = *(const u32x4*)(qc + (t0 + s2) * 8192 + hk * 128 + c8); pk[i] = *(const u32x4*)(qc + (t0 + s2) * 8192 + 2048 + hk * 128 + c8); }
#pragma unroll
              for (int i = 0; i < 2; ++i) { const int c = ptid + i * 256, s2 = c >> 3, c8 = (c & 7) * 8; pv[i] = *(const u32x4*)(qc + (t0 + s2) * 8192 + 4096 + hv * 128 + vhalf * 64 + c8); }
              if (pw == 1) { pb = bgi[(t0 + ptid - 64) * 64 + hv]; pg = bgi[(t0 + ptid - 64) * 64 + 32 + hv]; } }
            int lz = TIDX & 63; asm volatile("" : "+v"(lz));
            const int lane = lz, ptid = pw * 64 + lane, I = lane & 15, G = lane >> 4, q4 = I >> 2, p4 = I & 3;
            for (int it = 0; it <= NCK; ++it) {
                const int set = (it & 1) * SET; const bool act = it < NCK;
                if (act) {
#pragma unroll
                    for (int i = 0; i < 4; ++i) { const int c = ptid + i * 256, s2 = c >> 4, c8 = (c & 15) * 8; *(LAS u32x4*)(lds + set + QS + s2 * RSB + c8 * 2) = pq[i]; *(LAS u32x4*)(lds + KS + s2 * RSB + c8 * 2) = pk[i]; }
                    if (pw == 1) { float x = pg;
                        x += __builtin_bit_cast(float, __builtin_amdgcn_update_dpp(0, __builtin_bit_cast(int, x), 0x111, 0xf, 0xf, true));
                        x += __builtin_bit_cast(float, __builtin_amdgcn_update_dpp(0, __builtin_bit_cast(int, x), 0x112, 0xf, 0xf, true));
                        x += __builtin_bit_cast(float, __builtin_amdgcn_update_dpp(0, __builtin_bit_cast(int, x), 0x114, 0xf, 0xf, true));
                        x += __builtin_bit_cast(float, __builtin_amdgcn_update_dpp(0, __builtin_bit_cast(int, x), 0x118, 0xf, 0xf, true));
                        const float g15 = __shfl(x, 15, 16);
                        *(LAS float*)(lds + GAM + lane * 4) = x; *(LAS float*)(lds + set + EE + lane * 4) = __expf(x); *(LAS float*)(lds + set + EDD + lane * 4) = __expf(g15 - x); *(LAS float*)(lds + BET + lane * 4) = pb; }
                    if (it + 1 < NCK) { const size_t t1 = (size_t)b * S_ + (size_t)(it + 1) * 64;
#pragma unroll
                        for (int i = 0; i < 4; ++i) { const int c = ptid + i * 256, s2 = c >> 4, c8 = (c & 15) * 8; pq[i] = *(const u32x4*)(qc + (t1 + s2) * 8192 + hk * 128 + c8); pk[i] = *(const u32x4*)(qc + (t1 + s2) * 8192 + 2048 + hk * 128 + c8); }
                        if (pw == 1) { pb = bgi[(t1 + ptid - 64) * 64 + hv]; pg = bgi[(t1 + ptid - 64) * 64 + 32 + hv]; } }
                }
                LDS_BARRIER();
                if (act) { const int sa = pw;
#pragma unroll
                    for (int i = 0; i < 2; ++i) { const int c = ptid + i * 256, s2 = c >> 3, c8 = (c & 7) * 8; *(LAS u32x4*)(lds + VS + s2 * VRS + c8 * 2) = pv[i]; }
                    if (it + 1 < NCK) { const size_t t1 = (size_t)b * S_ + (size_t)(it + 1) * 64;
#pragma unroll
                        for (int i = 0; i < 2; ++i) { const int c = ptid + i * 256, s2 = c >> 3, c8 = (c & 7) * 8; pv[i] = *(const u32x4*)(qc + (t1 + s2) * 8192 + 4096 + hv * 128 + vhalf * 64 + c8); } }
#pragma unroll
                    for (int ty = 0; ty < 2; ++ty) { f32x4 acc = (f32x4){0.f, 0.f, 0.f, 0.f};
#pragma unroll
                        for (int ks = 0; ks < 4; ++ks) { const bf16x8 ka = lds_frag(lds + KS + (16 * sa + I) * RSB + (32 * ks + 8 * G) * 2);
                            const bf16x8 bo = ty ? lds_frag(lds + set + QS + (16 * sa + I) * RSB + (32 * ks + 8 * G) * 2) : ka; acc = mfma32(ka, bo, acc); }
                        const f32x4 gr = *(const LAS f32x4*)(lds + GAM + (16 * sa + 4 * G) * 4); const float gc = *(const LAS float*)(lds + GAM + (16 * sa + I) * 4);
                        if (ty == 0) { const f32x4 br = *(const LAS f32x4*)(lds + BET + (16 * sa + 4 * G) * 4);
#pragma unroll
                            for (int r = 0; r < 4; ++r) { const float val = br[r] * acc[r] * __expf(gr[r] - gc); *(LAS float*)(lds + LS + ((sa * 16 + 4 * G + r) * 16 + I) * 4) = (I < 4 * G + r) ? val : 0.f; } }
                        else { f32x4 o;
#pragma unroll
                            for (int r = 0; r < 4; ++r) { const float val = acc[r] * __expf(gc - gr[r]); o[r] = (4 * G + r <= I) ? val : 0.f; }
                            *(LAS s16x4*)(lds + set + QKS + ((sa * 16 + I) * 16 + 4 * G) * 2) = pack4(o); } } }
                LDS_BARRIER();
                if (act) { const int sa = pw, c = lane >> 2, q = lane & 3;
                    f32x4 lv[16];
#pragma unroll
                    for (int i = 0; i < 16; ++i) lv[i] = *(const LAS f32x4*)(lds + LS + ((sa * 16 + i) * 16 + 4 * q) * 4);
                    float xo[4] = {0.f, 0.f, 0.f, 0.f}, xw[4] = {0.f, 0.f, 0.f, 0.f};
#pragma unroll
                    for (int i = 0; i < 16; ++i) {
                        float p = lv[i][0] * xo[0] + lv[i][1] * xo[1] + lv[i][2] * xo[2] + lv[i][3] * xo[3];
                        p += dpp_f<0xB1>(p); p += dpp_f<0x4E>(p);
                        const float xi = ((i == c) ? 1.0f : 0.0f) - p;
                        xo[i & 3] = (q == (i >> 2)) ? xi : xo[i & 3];
                        xw[i >> 2] = (q == (i & 3)) ? xi : xw[i >> 2]; }
                    const float bc = *(const LAS float*)(lds + BET + (sa * 16 + c) * 4), sc1 = -bc * *(const LAS float*)(lds + set + EE + (sa * 16 + c) * 4);
#pragma unroll
                    for (int k = 0; k < 4; ++k) { const int i = 4 * k + q; *(LAS bf16_t*)(lds + X1 + ((sa * 16 + i) * 16 + c) * 2) = f2bf(xw[k] * sc1); *(LAS bf16_t*)(lds + X2 + ((sa * 16 + i) * 16 + c) * 2) = f2bf(xw[k] * bc); } }
                asm volatile("" ::: "memory");
                if (act) { const int sa = pw;
                    const s16x4 xb = *(const LAS s16x4*)(lds + X1 + ((sa * 16 + I) * 16 + 4 * G) * 2); s16x4 kt[8]; f32x4 w[8];
#pragma unroll
                    for (int dt = 0; dt < 8; ++dt) kt[dt] = lds_tr4(lds + KS + (16 * sa + 4 * G + q4) * RSB + (16 * dt + 4 * p4) * 2);
#pragma unroll
                    for (int dt = 0; dt < 8; ++dt) { w[dt] = mfma16(kt[dt], xb, (f32x4){0.f, 0.f, 0.f, 0.f}); *(LAS s16x4*)(lds + set + KT + (16 * dt + I) * KTRS + (16 * sa + 4 * G) * 2) = kt[dt]; }
#pragma unroll
                    for (int dt = 0; dt < 8; ++dt) *(LAS s16x4*)(lds + set + WSL + (16 * sa + I) * RSB + (16 * dt + 4 * G) * 2) = pack4(w[dt]); }
                LDS_BARRIER();
            }
        }
    }
}

constexpr int N_PHASES = 30;
__global__ void __launch_bounds__(NTHREADS, 2) fwd(Args a0) {
    extern __shared__ __attribute__((aligned(16))) unsigned char smem_raw[];
    LAS unsigned char* lds = (LAS unsigned char*)smem_raw;
    volatile LAS unsigned* xbw = (volatile LAS unsigned*)(lds + LDS_XBW);
    if (TIDX == 0) { xbw[0] = 0u; xbw[1] = 0u; xbw[2] = 0u; xbw[3] = 0u; }
    __syncthreads();
    XcdBarrier bar = xcd_barrier_post((unsigned*)(a0.ws + WS_CTL), xbw);
#ifndef PHMASK
#define PHMASK 0xFFFFFFFFull
#endif
#ifndef DUPMASK
#define DUPMASK 0ull
#endif
#define PH(i, body) do { if (((PHMASK >> (i)) & 1ull) && a0.ph_lo <= (i) && (i) < a0.ph_hi) { __attribute__((address_space(1))) unsigned char* wsp_ = (__attribute__((address_space(1))) unsigned char*)a0.ws; asm volatile("" : "+s"(wsp_)); Args a = a0; a.ws = (unsigned char*)wsp_; const float* xin = a.in[0]; const float* xw = (const float*)(a.ws + WS_X); (void)xin; (void)xw; \
        if ((DUPMASK >> (i)) & 1ull) { body; xcd_barrier(bar); } body; if ((i) + 1 < a0.ph_hi) xcd_barrier(bar); } } while (0)
    PH(0, { phase_prologue(a, lds); __syncthreads(); NORM_PH(0, true)(a, xin, a.in[1], -1); });
    PH(2, phase_gemm_in0(a, lds));
    PH(3, { phase_rg_conv(a); __syncthreads(); phase_hg1(a, lds); });
    PH(4, { phase_rg_gates(a, lds); __syncthreads(); phase_hg2(a); });
    PH(5, { phase_rg_scan(a, lds); __syncthreads(); phase_hg3(a, lds); });
    PH(9, phase_gemm_out<false>(a, lds, D_, a.ws + WS_WOUT0T, xin));
    PH(10, NORM_PH(0, false)(a, nullptr, a.in[2], 0));
    PH(11, phase_gemm_router(a, lds, 0));
    PH(12, phase_route(a, 0));
    PH(13, phase_rowmap(a, lds, 0));
    PH(14, phase_moe_up(a, lds, 0));
    PH(15, phase_moe_down(a, lds, 0));
    PH(16, { NORM_PH(1, false)(a, nullptr, a.in[1] + D_, 0); __syncthreads(); moe_weight_jobs(a, 1, lds); });
    PH(18, { phase_gemm_in1(a, lds); phase_gemm_in1_tail(a, lds); });
    PH(19, phase_gdn_conv(a));
    PH(20, phase_gdn_chunk(a, lds));
    PH(21, phase_gdn_norm(a));
    PH(22, phase_gemm_out<true>(a, lds, 4096, a.ws + WS_WOUT1T, nullptr));
    PH(23, NORM_PH(0, false)(a, nullptr, a.in[2] + D_, 1));
    PH(24, phase_gemm_router(a, lds, 1));
    PH(25, phase_route(a, 1));
    PH(26, phase_rowmap(a, lds, 1));
    PH(27, phase_moe_up(a, lds, 1));
    PH(28, phase_moe_down(a, lds, 1));
    PH(29, NORM_PH(2, false)(a, nullptr, a.in[3], 1));
#undef PH
}

extern "C" void kernel_launch(void* const* d_in, const int* in_sizes, int n_in, void* d_out, int out_size, void* d_ws, size_t ws_size, hipStream_t stream) {
    static int grid = 0;
    if (grid == 0) {
        if (n_in != 28 || ws_size < WS_END) { fprintf(stderr, "kernel_launch: need 28 inputs and %zu bytes of workspace, got %d / %zu\n", (size_t)WS_END, n_in, ws_size); grid = -1; return; }
        int dev = 0, cus = 0, per_cu = 0;
        if (hipGetDevice(&dev) != hipSuccess || hipDeviceGetAttribute(&cus, hipDeviceAttributeMultiprocessorCount, dev) != hipSuccess) { grid = -1; return; }
        if (hipFuncSetAttribute((const void*)fwd, hipFuncAttributeMaxDynamicSharedMemorySize, LDS_BYTES) != hipSuccess) { fprintf(stderr, "kernel_launch: hipFuncSetAttribute failed\n"); grid = -1; return; }
        if (hipOccupancyMaxActiveBlocksPerMultiprocessor(&per_cu, (const void*)fwd, NTHREADS, LDS_BYTES) != hipSuccess || per_cu < 1) { fprintf(stderr, "kernel_launch: occupancy query says %d\n", per_cu); }
        (void)hipGetLastError();
        grid = cus;
    }
    if (grid < 0) return;
    (void)in_sizes; (void)out_size;
    hipMemsetAsync((char*)d_ws + WS_CTL, 0, CTL_BYTES, stream);
    Args a; memset(&a, 0, sizeof(a));
    for (int i = 0; i < 28; ++i) a.in[i] = (const float*)d_in[i];
    a.out = (float*)d_out; a.ws = (unsigned char*)d_ws;
#if N_LAUNCH_MODE == 1
    a.ph_lo = 0; a.ph_hi = N_PHASES;
    hipLaunchKernelGGL(fwd, dim3(grid), dim3(NTHREADS), LDS_BYTES, stream, a);
#if EXTRA_PH >= 0
    a.ph_lo = EXTRA_PH; a.ph_hi = EXTRA_PH + 1;
    hipLaunchKernelGGL(fwd, dim3(grid), dim3(NTHREADS), LDS_BYTES, stream, a);
#endif
#else
    for (int p = 0; p < N_PHASES; ++p) { a.ph_lo = p; a.ph_hi = p + 1; hipLaunchKernelGGL(fwd, dim3(grid), dim3(NTHREADS), LDS_BYTES, stream, a); }
#endif
}
```

```cpp
#include <hip/hip_runtime.h>
#include <stdint.h>
#include <stdio.h>
#include <string.h>

#ifndef EXTRA_PH
#define EXTRA_PH -1
#endif
#ifndef N_LAUNCH_MODE
#define N_LAUNCH_MODE 1
#endif

#define LAS __attribute__((address_space(3)))
typedef unsigned short bf16_t;
typedef short bf16x8 __attribute__((ext_vector_type(8)));
typedef float f32x4 __attribute__((ext_vector_type(4)));
typedef float f32x2 __attribute__((ext_vector_type(2)));
typedef unsigned u32x4 __attribute__((ext_vector_type(4)));
typedef unsigned u32x2 __attribute__((ext_vector_type(2)));

constexpr int T_ = 16384, D_ = 2048, S_ = 4096, NB_ = 4;
constexpr int N_IN0 = 6144, N_IN1 = 12352, N_IN1P = 12544;
constexpr int NEXP = 64, DEXP = 512, MPAD = 49152;
constexpr int NTHREADS = 512;
constexpr int LDS_MAIN = 131072;
constexpr int LDS_BYTES = 163840;
constexpr int LDS_XBW = LDS_BYTES - 16;

constexpr size_t al256(size_t x) { return (x + 255) & ~(size_t)255; }
constexpr size_t WS_CTL = 0;
constexpr size_t CTL_BYTES = 65536;
constexpr size_t CTL_CNT = 16384;
constexpr size_t WS_LB = WS_CTL + CTL_BYTES;
constexpr size_t WS_TINFO = WS_LB + 4096;
constexpr size_t WS_WIN0T = WS_TINFO + 4096;
constexpr size_t WS_WOUT0T = WS_WIN0T + (size_t)N_IN0 * D_ * 2;
constexpr size_t WS_WIN1T = WS_WOUT0T + (size_t)D_ * D_ * 2;
constexpr size_t WS_WOUT1T = WS_WIN1T + (size_t)N_IN1P * D_ * 2;
constexpr size_t WS_WGATES = WS_WOUT1T + (size_t)D_ * 4096 * 2;
constexpr size_t WS_WRT = WS_WGATES + (size_t)8 * 256 * 256 * 2;
constexpr size_t WS_WG = WS_WRT + (size_t)2 * 256 * D_ * 2;
constexpr size_t WS_WU = WS_WG + (size_t)NEXP * DEXP * D_ * 2;
constexpr size_t WS_WD = WS_WU + (size_t)NEXP * DEXP * D_ * 2;
constexpr size_t WS_X = WS_WD + (size_t)NEXP * DEXP * D_ * 2;
constexpr size_t WS_H = WS_X + (size_t)T_ * D_ * 4;
constexpr size_t WS_PROJ = WS_H + (size_t)T_ * D_ * 2;
constexpr size_t PROJ_BYTES = (size_t)T_ * N_IN1P * 2;
constexpr size_t WS_FLOG = WS_PROJ + (size_t)T_ * N_IN0 * 2;
constexpr size_t WS_XC = WS_FLOG + (size_t)T_ * 1024 * 4;
constexpr size_t WS_ACT = WS_PROJ;
constexpr size_t WS_YMOE = WS_ACT + (size_t)MPAD * DEXP * 2;
constexpr size_t WS_R1 = WS_PROJ + PROJ_BYTES;
constexpr size_t WS_A = WS_R1;
constexpr size_t WS_U = WS_R1 + (size_t)T_ * 1024 * 4;
constexpr size_t WS_QKVC = WS_R1;
constexpr size_t WS_Y = WS_R1 + (size_t)T_ * 8192 * 2;
constexpr size_t WS_O = WS_Y + (size_t)T_ * 4096 * 2;
constexpr size_t WS_TAIL = WS_O + (size_t)T_ * 4096 * 4;
constexpr size_t WS_BG = WS_TAIL + (size_t)T_ * 64 * 4;
constexpr size_t WS_LOGITS = WS_BG + (size_t)T_ * 64 * 4;
constexpr size_t WS_EID = WS_LOGITS + (size_t)T_ * 128 * 4;
constexpr size_t WS_SLOT = WS_EID + (size_t)T_ * 2 * 4;
constexpr size_t WS_GATE = WS_SLOT + (size_t)T_ * 2 * 4;
constexpr size_t WS_POSOF = WS_GATE + (size_t)T_ * 2 * 4;
constexpr size_t WS_ROWMAP = WS_POSOF + (size_t)T_ * 2 * 4;
constexpr size_t WS_H8 = WS_ROWMAP + (size_t)MPAD * 4;
constexpr size_t WS_END = WS_H8 + (size_t)T_ * D_;
static_assert(WS_YMOE + (size_t)MPAD * D_ * 2 <= WS_R1, "moe overlay");
static_assert(WS_XC + (size_t)T_ * 1024 * 2 <= WS_R1, "layer0 overlay");

struct Args {
    const float* in[28];
    float* out;
    unsigned char* ws;
    int ph_lo, ph_hi;
};

__device__ __forceinline__ int tidx_() { int t = (int)threadIdx.x; asm volatile("" : "+v"(t)); return t; }
#define TIDX tidx_()
typedef __bf16 bf16x2n __attribute__((ext_vector_type(2)));
__device__ __forceinline__ unsigned cvt_pk_bf16(float lo, float hi) { const f32x2 v = {lo, hi}; return __builtin_bit_cast(unsigned, __builtin_convertvector(v, bf16x2n)); }
__device__ __forceinline__ unsigned pk_fp8x4(float a, float b, float c, float d) { int v = __builtin_amdgcn_cvt_pk_fp8_f32(a, b, 0, false); v = __builtin_amdgcn_cvt_pk_fp8_f32(c, d, v, true); return (unsigned)v; }
constexpr float W8_SCALE = 64.0f, ACT8_SCALE = 8.0f;
__device__ __forceinline__ bf16_t f2bf(float x) { return (bf16_t)(cvt_pk_bf16(x, 0.f) & 0xffffu); }
__device__ __forceinline__ float bf_lo(unsigned w) { return __uint_as_float(w << 16); }
__device__ __forceinline__ float bf_hi(unsigned w) { return __uint_as_float(w & 0xffff0000u); }
__device__ __forceinline__ float bf1(bf16_t v) { return __uint_as_float(((unsigned)v) << 16); }
__device__ __forceinline__ float sigmoidf_(float x) { return __builtin_amdgcn_rcpf(1.0f + __expf(-x)); }
__device__ __forceinline__ float siluf_(float x) { return x * __builtin_amdgcn_rcpf(1.0f + __expf(-x)); }
__device__ __forceinline__ float softplusf_(float x) { return x > 20.f ? x : log1pf(__expf(x)); }
__device__ __forceinline__ float gelu_tanh(float x) { const float u = 0.7978845608028654f * (x + 0.044715f * x * x * x); return x * __builtin_amdgcn_rcpf(1.0f + __expf(-2.0f * u)); }
template <int CTRL> __device__ __forceinline__ float dpp_f(float v) { return __builtin_bit_cast(float, __builtin_amdgcn_update_dpp(0, __builtin_bit_cast(int, v), CTRL, 0xf, 0xf, false)); }
__device__ __forceinline__ float row16_sum(float s) { s += dpp_f<0x140>(s); s += dpp_f<0x141>(s); s += dpp_f<0xB1>(s); s += dpp_f<0x4E>(s); return s; }
__device__ __forceinline__ float wave_sum(float v) { v = row16_sum(v); v += __shfl_xor(v, 16); v += __shfl_xor(v, 32); return v; }

#define LDS_BARRIER() do { asm volatile("s_waitcnt lgkmcnt(0)" ::: "memory"); __builtin_amdgcn_s_barrier(); asm volatile("" ::: "memory"); } while (0)
#define XB_TMO      128
#define XB_XCNT(j)  (256  + 64 * (j))
#define XB_XSUB(j)  (1280 + 64 * (j))
#define XB_XGEN(j)  (2304 + 64 * (j))
#define XB_TOP      3328
#define XB_TOPGEN   3392
#define XCD_BAR_WORDS 3456
#define XB_SPIN_CAP (1u << 18)

__device__ __forceinline__ unsigned xb_ld(unsigned* p)              { return __hip_atomic_load(p, __ATOMIC_RELAXED, __HIP_MEMORY_SCOPE_AGENT); }
__device__ __forceinline__ unsigned xb_add(unsigned* p, unsigned v) { return __hip_atomic_fetch_add(p, v, __ATOMIC_RELAXED, __HIP_MEMORY_SCOPE_AGENT); }
__device__ __forceinline__ unsigned xb_xcc_id() { return (unsigned)__builtin_amdgcn_s_getreg((3 << 11) | 20) & 0xFu; }
#define XB_SPIN(cond, bar) do { unsigned _sp = 0; while (cond) { __builtin_amdgcn_s_sleep(1); \
    if ((++_sp & 255u) == 0u) { if (xb_ld(&(bar)[XB_TMO])) break; if (_sp > XB_SPIN_CAP) { atomicAdd(&(bar)[XB_TMO], 1u); break; } } } } while (0)

struct XcdBarrier { unsigned* bar; unsigned x; volatile LAS unsigned* st; };

__device__ __forceinline__ XcdBarrier xcd_barrier_post(unsigned* bar, volatile LAS unsigned* st) {
    XcdBarrier b; b.bar = bar; b.x = xb_xcc_id(); b.st = st;
    if (TIDX == 0) (void)xb_add(&bar[XB_XCNT(b.x)], 1u);
    return b;
}
__device__ __forceinline__ void xcd_barrier_complete(unsigned* bar, unsigned x, unsigned& nloc, unsigned& nx) {
    const unsigned G = gridDim.x * gridDim.y * gridDim.z;
    unsigned sum, cnt, mine, sp = 0u;
    for (;;) {
        sum = 0u; cnt = 0u; mine = 0u;
#pragma unroll
        for (unsigned j = 0; j < 16; ++j) { const unsigned c = xb_ld(&bar[XB_XCNT(j)]); sum += c; cnt += (c > 0u) ? 1u : 0u; mine = (j == x) ? c : mine; }
        if (sum == G) break;
        __builtin_amdgcn_s_sleep(1);
        if ((++sp & 255u) == 0u) { if (xb_ld(&bar[XB_TMO])) break; if (sp > XB_SPIN_CAP) { atomicAdd(&bar[XB_TMO], 1u); break; } }
    }
    nloc = mine > 0u ? mine : 1u; nx = cnt > 0u ? cnt : 1u;
}
__device__ __forceinline__ void xcd_barrier(const XcdBarrier& b) {
    asm volatile("s_waitcnt vmcnt(0)" ::: "memory");
    __syncthreads();
    if (TIDX == 0) {
        unsigned* bar = b.bar;
        __builtin_amdgcn_s_waitcnt(0);
        unsigned nloc = b.st[0], nx = b.st[1];
        if (nloc == 0u) { xcd_barrier_complete(bar, b.x, nloc, nx); b.st[0] = nloc; b.st[1] = nx; }
        const unsigned old = xb_add(&bar[XB_XSUB(b.x)], 1u);
        const unsigned gen = old / nloc;
        if (old + 1u == (gen + 1u) * nloc) {
            __builtin_amdgcn_fence(__ATOMIC_RELEASE, "agent");
            asm volatile("s_waitcnt vmcnt(0)" ::: "memory");
            const unsigned og = xb_add(&bar[XB_TOP], 1u);
            const unsigned tg = og / nx;
            if (og + 1u == (tg + 1u) * nx) xb_add(&bar[XB_TOPGEN], 1u);
            else XB_SPIN(xb_ld(&bar[XB_TOPGEN]) == tg, bar);
            __builtin_amdgcn_fence(__ATOMIC_ACQUIRE, "agent");
            xb_add(&bar[XB_XGEN(b.x)], 1u);
            asm volatile("s_waitcnt vmcnt(0)" ::: "memory");
        } else {
            XB_SPIN(xb_ld(&bar[XB_XGEN(b.x)]) == gen, bar);
            __builtin_amdgcn_fence(__ATOMIC_ACQUIRE, "agent");
            asm volatile("s_waitcnt vmcnt(0)" ::: "memory");
        }
    }
    __syncthreads();
}

constexpr int BM = 256, BK = 64, HALF = 128, HTB = HALF * BK * 2;
__device__ __forceinline__ int lds_byte(int r, int c) { const int st = (r >> 4) * 2 + (c >> 5), rr = r & 15, cc = c & 31, ob = rr * 64 + cc * 2; return st * 1024 + (ob ^ (((ob >> 9) & 1) << 5)); }
__device__ __forceinline__ void stage_rc(int b, int& R, int& C) { const int st = b / 1024, sb = b % 1024, swz = sb ^ (((sb >> 9) & 1) << 5); R = (st >> 1) * 16 + swz / 64; C = (st & 1) * 32 + (swz % 64) / 2; }
__device__ __forceinline__ int perm32(int rho) { const int n = rho >> 4, i = rho & 15; return 8 * (i >> 2) + 4 * n + (i & 3); }

__device__ __forceinline__ void stage_pos(int tid, int& R0, int& C0) { stage_rc(tid * 16, R0, C0); }
__device__ __forceinline__ int perm_row(int R) { return (R & ~31) + perm32(R & 31); }

#define BID ((int)blockIdx.x)
#define NBLK ((int)gridDim.x)
#define BID_ BID
#define NBLK_ NBLK
typedef f32x4 Acc[2][2][4][2];
struct UnitD { const char* gA; const char* gB; int t0, t1, t2; };

typedef int i32x8 __attribute__((ext_vector_type(8)));
typedef int i32x4 __attribute__((ext_vector_type(4)));
template <bool GATHER, bool FP8, class Src, class Epi>
__device__ __forceinline__ void gemm_stream(LAS unsigned char* lds, const Src& S, const int nt, const Epi& E) {
    const int tid = TIDX, wid = tid >> 6, lane = tid & 63, wr = wid >> 2, wc = wid & 3, fr = lane & 15, fq = lane >> 4;
    const unsigned ldsw = (unsigned)wid * 1024u;
    const int aoff = lds_byte(wr * 64 + fr, fq * 8), boff = lds_byte(wc * 32 + fr, fq * 8);
    const size_t kstep = (size_t)(BK * 2);
#define G_SA(b, h) (((b) * 2 + (h)) * HTB)
#define G_SB(b, h) ((4 + (b) * 2 + (h)) * HTB)
#define G_STAGE(bufoff, gbase, v) do { _Pragma("unroll") for (int _i = 0; _i < 2; ++_i) \
        __builtin_amdgcn_global_load_lds((const unsigned*)((gbase) + (v)[_i]), (LAS unsigned*)(lds + (bufoff) + ldsw + _i * 8192), 16, 0, 0); } while (0)
#define G_LD8(p) __builtin_shufflevector(*(const LAS i32x4*)(p), *(const LAS i32x4*)((p) + 1024), 0, 1, 2, 3, 4, 5, 6, 7)
#define G_LDA(dst, b, h) do { _Pragma("unroll") for (int m = 0; m < 4; ++m) dst[m] = G_LD8(lds + G_SA(b, h) + aoff + m * 2048); } while (0)
#define G_LDB(dst, b, h) do { _Pragma("unroll") for (int n = 0; n < 2; ++n) dst[n] = G_LD8(lds + G_SB(b, h) + boff + n * 2048); } while (0)
#define G_HALF(x, k) __builtin_bit_cast(bf16x8, __builtin_shufflevector((x), (x), 4 * (k), 4 * (k) + 1, 4 * (k) + 2, 4 * (k) + 3))
#define G_MMA(ai, bj, At, Bt) do { __builtin_amdgcn_s_setprio(1); _Pragma("unroll") for (int m = 0; m < 4; ++m) _Pragma("unroll") for (int n = 0; n < 2; ++n) { \
        if (FP8) asm volatile("v_mfma_f32_16x16x128_f8f6f4 %0, %1, %2, %0" : "+v"(acc[ai][bj][m][n]) : "v"(Bt[n]), "v"(At[m]));   \
        else { acc[ai][bj][m][n] = __builtin_amdgcn_mfma_f32_16x16x32_bf16(G_HALF(Bt[n], 0), G_HALF(At[m], 0), acc[ai][bj][m][n], 0, 0, 0); \
               acc[ai][bj][m][n] = __builtin_amdgcn_mfma_f32_16x16x32_bf16(G_HALF(Bt[n], 1), G_HALF(At[m], 1), acc[ai][bj][m][n], 0, 0, 0); } } \
        __builtin_amdgcn_s_setprio(0); } while (0)
#define G_WAIT_V(n) asm volatile("s_waitcnt vmcnt(" #n ")" ::: "memory")
#define G_WAIT_L(n) asm volatile("s_waitcnt lgkmcnt(" #n ")" ::: "memory")
#define G_BAR __builtin_amdgcn_s_barrier()
#define G_SCHED __builtin_amdgcn_sched_barrier(0)
    UnitD cur, nxt; int ui = 0;
    if (!S.next(0, cur)) return;
    unsigned va[2][2], vb[2][2], van[2][2];
    S.vb(vb); S.va(cur, va);
    Acc acc;
#pragma unroll
    for (int a = 0; a < 2; ++a)
#pragma unroll
        for (int b = 0; b < 2; ++b)
#pragma unroll
            for (int m = 0; m < 4; ++m)
#pragma unroll
                for (int n = 0; n < 2; ++n) acc[a][b][m][n] = (f32x4){0.f, 0.f, 0.f, 0.f};
    i32x8 At[4], B0[2], B1[2];
    const char* cA = cur.gA; const char* cB = cur.gB;
    G_WAIT_V(0);
    __syncthreads();
    G_STAGE(G_SB(0, 0), cB, vb[0]); G_STAGE(G_SA(0, 0), cA, va[0]); G_STAGE(G_SB(0, 1), cB, vb[1]); G_STAGE(G_SA(0, 1), cA, va[1]);
    if (wr == 1) G_BAR;
    G_WAIT_V(4); G_BAR;
    G_STAGE(G_SB(1, 0), cB + kstep, vb[0]); G_STAGE(G_SA(1, 0), cA + kstep, va[0]); G_STAGE(G_SB(1, 1), cB + kstep, vb[1]);
    G_WAIT_V(6); G_BAR;
    for (;;) {
        const bool has_next = S.next(ui + 1, nxt);
        const char* nA = has_next ? nxt.gA : cA; const char* nB = has_next ? nxt.gB : cB;
        if (GATHER) { if (has_next) S.va(nxt, van); else { van[0][0] = va[0][0]; van[0][1] = va[0][1]; van[1][0] = va[1][0]; van[1][1] = va[1][1]; } }
#pragma unroll 1
        for (int t = 0; t < nt; t += 2) {
            const bool last = (t == nt - 2);
            const char* a1 = cA + (size_t)(t + 1) * kstep;
            const char* a2 = last ? nA : cA + (size_t)(t + 2) * kstep; const char* b2 = last ? nB : cB + (size_t)(t + 2) * kstep;
            const char* a3 = a2 + kstep; const char* b3 = b2 + kstep;
            unsigned v2[2][2];
#pragma unroll
            for (int hh = 0; hh < 2; ++hh)
#pragma unroll
                for (int i = 0; i < 2; ++i) v2[hh][i] = (GATHER && last) ? van[hh][i] : va[hh][i];
            G_LDB(B0, 0, 0); G_SCHED; G_LDA(At, 0, 0); G_STAGE(G_SA(1, 1), a1, va[1]);
            G_WAIT_L(8); G_BAR; G_WAIT_L(0); G_MMA(0, 0, At, B0); G_BAR; G_SCHED;
            G_LDB(B1, 0, 1); G_STAGE(G_SB(0, 0), b2, vb[0]);
            G_BAR; G_WAIT_L(0); G_MMA(0, 1, At, B1); G_BAR;
            G_LDA(At, 0, 1); G_STAGE(G_SA(0, 0), a2, v2[0]);
            G_BAR; G_WAIT_L(0); G_MMA(1, 0, At, B0); G_BAR; G_SCHED;
            G_STAGE(G_SB(0, 1), b2, vb[1]);
            G_WAIT_V(6); G_BAR; G_MMA(1, 1, At, B1); G_BAR;
            G_LDB(B0, 1, 0); G_SCHED; G_LDA(At, 1, 0); G_STAGE(G_SA(0, 1), a2, v2[1]);
            G_WAIT_L(8); G_BAR; G_WAIT_L(0); G_MMA(0, 0, At, B0); G_BAR; G_SCHED;
            G_LDB(B1, 1, 1); G_STAGE(G_SB(1, 0), b3, vb[0]);
            G_BAR; G_WAIT_L(0); G_MMA(0, 1, At, B1); G_BAR;
            G_LDA(At, 1, 1); G_STAGE(G_SA(1, 0), a3, v2[0]);
            G_BAR; G_WAIT_L(0); G_MMA(1, 0, At, B0); G_BAR; G_SCHED;
            G_STAGE(G_SB(1, 1), b3, vb[1]);
            G_WAIT_V(6); G_BAR; G_MMA(1, 1, At, B1); G_BAR;
        }
        if (FP8) asm volatile("s_nop 15\n\ts_nop 15" ::: "memory");
        { int tz = TIDX; asm volatile("" : "+v"(tz));
          const int wid2 = tz >> 6, lane2 = tz & 63; E(acc, cur, wid2 >> 2, wid2 & 3, lane2 & 15, lane2 >> 4); }
        if (!has_next) break;
#pragma unroll
        for (int a = 0; a < 2; ++a)
#pragma unroll
            for (int b = 0; b < 2; ++b)
#pragma unroll
                for (int m = 0; m < 4; ++m)
#pragma unroll
                    for (int n = 0; n < 2; ++n) acc[a][b][m][n] = (f32x4){0.f, 0.f, 0.f, 0.f};
        cur = nxt; cA = nA; cB = nB; ++ui;
        if (GATHER) { va[0][0] = van[0][0]; va[0][1] = van[0][1]; va[1][0] = van[1][0]; va[1][1] = van[1][1]; }
    }
    G_WAIT_V(0);
    if (wr == 0) G_BAR;
    G_BAR;
#undef G_SA
#undef G_SB
#undef G_STAGE
#undef G_LDA
#undef G_LDB
#undef G_MMA
#undef G_LD8
#undef G_HALF
#undef G_WAIT_V
#undef G_WAIT_L
#undef G_BAR
#undef G_SCHED
}

__device__ __forceinline__ void offs_direct(unsigned (&v)[2][2], int ld, bool perm) {
    int R0, C0; stage_pos(TIDX, R0, C0);
#pragma unroll
    for (int i = 0; i < 2; ++i) { const int R = R0 + 64 * i, Rr = perm ? perm_row(R) : R;
        v[0][i] = (unsigned)(Rr * ld + C0) * 2u; v[1][i] = (unsigned)((Rr + HALF) * ld + C0) * 2u; }
}

struct SrcGrid {
    const char* A; const char* B; size_t astep, bstep; int nM, total, lda, ldb;
    __device__ __forceinline__ bool next(int i, UnitD& u) const { const int id = BID_ + i * NBLK_; if (id >= total) return false; u.t0 = id % nM; u.t1 = id / nM; u.t2 = 0;
        u.gA = A + (size_t)u.t0 * astep; u.gB = B + (size_t)u.t1 * bstep; return true; }
    __device__ __forceinline__ void va(const UnitD&, unsigned (&v)[2][2]) const { offs_direct(v, lda, false); }
    __device__ __forceinline__ void vb(unsigned (&v)[2][2]) const { offs_direct(v, ldb, true); }
};

__device__ __forceinline__ void store_bf16_tile(const Acc& acc, bf16_t* O, int ld, int wr, int wc, int fr, int fq, const float sc = 1.0f) {
#pragma unroll
    for (int ai = 0; ai < 2; ++ai)
#pragma unroll
        for (int m = 0; m < 4; ++m) { bf16_t* rowp = O + (size_t)(ai * HALF + wr * 64 + m * 16 + fr) * ld + wc * 32 + 8 * fq;
#pragma unroll
            for (int bj = 0; bj < 2; ++bj) { const f32x4 v0 = acc[ai][bj][m][0] * sc, v1 = acc[ai][bj][m][1] * sc;
                u32x4 w; w.x = cvt_pk_bf16(v0[0], v0[1]); w.y = cvt_pk_bf16(v0[2], v0[3]); w.z = cvt_pk_bf16(v1[0], v1[1]); w.w = cvt_pk_bf16(v1[2], v1[3]);
                *(u32x4*)(rowp + bj * HALF) = w; } }
}
__device__ __forceinline__ void store_f32_tile(const Acc& acc, float* O, const float* R, int ld, int ncol, int wr, int wc, int fr, int fq, const float sc = 1.0f) {
#pragma unroll
    for (int ai = 0; ai < 2; ++ai)
#pragma unroll
        for (int m = 0; m < 4; ++m) { const size_t ro = (size_t)(ai * HALF + wr * 64 + m * 16 + fr) * ld;
#pragma unroll
            for (int bj = 0; bj < 2; ++bj)
#pragma unroll
                for (int n = 0; n < 2; ++n) { const int c = bj * HALF + wc * 32 + 8 * fq + 4 * n; if (c >= ncol) continue;
                    f32x4 v = acc[ai][bj][m][n] * sc; if (R) v += *(const f32x4*)(R + ro + c); *(f32x4*)(O + ro + c) = v; } }
}
struct EpiProj {
    bf16_t* O; int ld; float* F; int fld, fp0, fp1, ncol; float sc;
    __device__ __forceinline__ void operator()(const Acc& acc, const UnitD& u, int wr, int wc, int fr, int fq) const {
        if (u.t1 >= fp0 && u.t1 < fp1) store_f32_tile(acc, F + (size_t)u.t0 * BM * fld + (u.t1 - fp0) * BM, nullptr, fld, ncol, wr, wc, fr, fq, sc);
        else store_bf16_tile(acc, O + (size_t)u.t0 * BM * ld + u.t1 * BM, ld, wr, wc, fr, fq, sc);
    }
};
struct EpiResid {
    bf16_t* O; const float* Rf; const bf16_t* Rb; float sc;
    __device__ __forceinline__ void operator()(const Acc& acc, const UnitD& u, int wr, int wc, int fr, int fq) const {
        const size_t o = (size_t)u.t0 * BM * D_ + u.t1 * BM;
        if (Rf) {
#pragma unroll
            for (int am = 0; am < 4; ++am) { const int ai = am >> 1; f32x4 r0[2][2], r1[2][2];
#pragma unroll
                for (int mm = 0; mm < 2; ++mm) { const int m = (am & 1) * 2 + mm; const size_t ro = o + (size_t)(ai * HALF + wr * 64 + m * 16 + fr) * D_ + wc * 32 + 8 * fq;
#pragma unroll
                    for (int bj = 0; bj < 2; ++bj) { r0[mm][bj] = *(const f32x4*)(Rf + ro + bj * HALF); r1[mm][bj] = *(const f32x4*)(Rf + ro + bj * HALF + 4); } }
#pragma unroll
                for (int mm = 0; mm < 2; ++mm) { const int m = (am & 1) * 2 + mm; const size_t ro = o + (size_t)(ai * HALF + wr * 64 + m * 16 + fr) * D_ + wc * 32 + 8 * fq;
#pragma unroll
                    for (int bj = 0; bj < 2; ++bj) { const f32x4 v0 = acc[ai][bj][m][0] * sc + r0[mm][bj], v1 = acc[ai][bj][m][1] * sc + r1[mm][bj];
                        u32x4 w; w.x = cvt_pk_bf16(v0[0], v0[1]); w.y = cvt_pk_bf16(v0[2], v0[3]); w.z = cvt_pk_bf16(v1[0], v1[1]); w.w = cvt_pk_bf16(v1[2], v1[3]);
                        *(u32x4*)(O + ro + bj * HALF) = w; } } }
        } else {
#pragma unroll
            for (int ai = 0; ai < 2; ++ai) { u32x4 rr[4][2];
#pragma unroll
                for (int m = 0; m < 4; ++m) { const size_t ro = o + (size_t)(ai * HALF + wr * 64 + m * 16 + fr) * D_ + wc * 32 + 8 * fq;
#pragma unroll
                    for (int bj = 0; bj < 2; ++bj) rr[m][bj] = *(const u32x4*)(Rb + ro + bj * HALF); }
#pragma unroll
                for (int m = 0; m < 4; ++m) { const size_t ro = o + (size_t)(ai * HALF + wr * 64 + m * 16 + fr) * D_ + wc * 32 + 8 * fq;
#pragma unroll
                    for (int bj = 0; bj < 2; ++bj) { f32x4 v0 = acc[ai][bj][m][0] * sc, v1 = acc[ai][bj][m][1] * sc; const u32x4 r = rr[m][bj];
                        v0[0] += bf_lo(r.x); v0[1] += bf_hi(r.x); v0[2] += bf_lo(r.y); v0[3] += bf_hi(r.y); v1[0] += bf_lo(r.z); v1[1] += bf_hi(r.z); v1[2] += bf_lo(r.w); v1[3] += bf_hi(r.w);
                        u32x4 w; w.x = cvt_pk_bf16(v0[0], v0[1]); w.y = cvt_pk_bf16(v0[2], v0[3]); w.z = cvt_pk_bf16(v1[0], v1[1]); w.w = cvt_pk_bf16(v1[2], v1[3]);
                        *(u32x4*)(O + ro + bj * HALF) = w; } } }
        }
    }
};
struct EpiLogits {
    float* O;
    __device__ __forceinline__ void operator()(const Acc& acc, const UnitD& u, int wr, int wc, int fr, int fq) const { store_f32_tile(acc, O + (size_t)u.t0 * BM * 128, nullptr, 128, 128, wr, wc, fr, fq); }
};
struct EpiSwiGLU {
    unsigned char* O;
    __device__ __forceinline__ void operator()(const Acc& acc, const UnitD& u, int wr, int wc, int fr, int fq) const {
        unsigned char* o = O + (size_t)u.t0 * BM * DEXP + u.t1 * 128;
#pragma unroll
        for (int ai = 0; ai < 2; ++ai)
#pragma unroll
            for (int m = 0; m < 4; ++m) { unsigned char* rowp = o + (size_t)(ai * HALF + wr * 64 + m * 16 + fr) * DEXP + wc * 32 + 8 * fq;
                float r[8];
#pragma unroll
                for (int n = 0; n < 2; ++n)
#pragma unroll
                    for (int j = 0; j < 4; ++j) r[n * 4 + j] = (ACT8_SCALE / W8_SCALE) * siluf_(acc[ai][0][m][n][j] * (1.0f / W8_SCALE)) * acc[ai][1][m][n][j];
                u32x2 w; w.x = pk_fp8x4(r[0], r[1], r[2], r[3]); w.y = pk_fp8x4(r[4], r[5], r[6], r[7]);
                *(u32x2*)rowp = w; }
    }
};
struct EpiDown {
    unsigned char* O;
    __device__ __forceinline__ void operator()(const Acc& acc, const UnitD& u, int wr, int wc, int fr, int fq) const {
        unsigned char* o = O + (size_t)u.t0 * BM * D_ + u.t1 * BM; const float sc = 1.0f / (W8_SCALE * ACT8_SCALE);
#pragma unroll
        for (int ai = 0; ai < 2; ++ai)
#pragma unroll
            for (int m = 0; m < 4; ++m) { unsigned char* rowp = o + (size_t)(ai * HALF + wr * 64 + m * 16 + fr) * D_ + wc * 32 + 8 * fq;
#pragma unroll
                for (int bj = 0; bj < 2; ++bj) { const f32x4 v0 = acc[ai][bj][m][0] * sc, v1 = acc[ai][bj][m][1] * sc;
                    u32x2 w; w.x = pk_fp8x4(v0[0], v0[1], v0[2], v0[3]); w.y = pk_fp8x4(v1[0], v1[1], v1[2], v1[3]); *(u32x2*)(rowp + bj * HALF) = w; } }
    }
};
__device__ __forceinline__ unsigned rg_idx(unsigned tok, int c) { return ((((tok >> 12) * 64u + (unsigned)(c >> 4)) * (unsigned)S_ + (tok & (unsigned)(S_ - 1))) << 4) + (unsigned)(c & 15); }
struct EpiRgGates {
    bf16_t* LAo; bf16_t* Uo; const bf16_t* xc;
    const float* ba; const float* bx; const float* lam;
    __device__ __forceinline__ void operator()(const Acc& acc, const UnitD& u, int wr, int wc, int fr, int fq) const {
#pragma unroll
        for (int n = 0; n < 2; ++n) { const int c = u.t1 * 128 + wc * 32 + 8 * fq + 4 * n;
            u32x2 xq[2][4];
#pragma unroll
            for (int ai = 0; ai < 2; ++ai)
#pragma unroll
                for (int m = 0; m < 4; ++m) xq[ai][m] = *(const u32x2*)(xc + ((unsigned)(u.t0 * BM + ai * HALF + wr * 64 + m * 16 + fr) * 1024u + (unsigned)c));
            const f32x4 vba = *(const f32x4*)(ba + c), vbx = *(const f32x4*)(bx + c), vl = *(const f32x4*)(lam + c);
            f32x4 c8; for (int j = 0; j < 4; ++j) c8[j] = -8.0f * softplusf_(-vl[j]);
#pragma unroll
            for (int ai = 0; ai < 2; ++ai)
#pragma unroll
                for (int m = 0; m < 4; ++m) { const unsigned tok = (unsigned)(u.t0 * BM + ai * HALF + wr * 64 + m * 16 + fr);
                    const u32x2 xw = xq[ai][m]; const float xv[4] = {bf_lo(xw.x), bf_hi(xw.x), bf_lo(xw.y), bf_hi(xw.y)};
                    f32x4 lv, uv;
#pragma unroll
                    for (int j = 0; j < 4; ++j) { const float r = sigmoidf_(acc[ai][0][m][n][j] + vba[j]), ig = sigmoidf_(acc[ai][1][m][n][j] + vbx[j]);
                        const float la = c8[j] * r, av = __expf(la); lv[j] = la; uv[j] = __builtin_amdgcn_sqrtf(fmaxf(0.f, 1.0f - av * av)) * ig * xv[j]; }
                    const unsigned o = rg_idx(tok, c);
                    u32x2 w0; w0.x = cvt_pk_bf16(lv[0], lv[1]); w0.y = cvt_pk_bf16(lv[2], lv[3]); *(u32x2*)(LAo + o) = w0;
                    u32x2 w1; w1.x = cvt_pk_bf16(uv[0], uv[1]); w1.y = cvt_pk_bf16(uv[2], uv[3]); *(u32x2*)(Uo + o) = w1; } }
    }
};


__device__ __forceinline__ void transpose_job8(const float* src, unsigned char* dst, int K, int N, int ldd, size_t sb, size_t db, int nbatch, LAS unsigned char* lds) {
    const int tid = TIDX, tk = K / 128, tn = N / 64, per = tk * tn, total = per * nbatch;
    const int rr0 = tid >> 4, c4 = (tid & 15) * 4, n = tid >> 3, kg = (tid & 7) * 16;
    f32x4 va[4], vb[4];
#define T8_LD(v, t) { const int u_ = (t), ub_ = u_ / per, ur_ = u_ % per, uik_ = ur_ / tn, uin_ = ur_ % tn; const float* usp_ = src + (size_t)ub_ * sb + (size_t)(uik_ * 128 + rr0) * N + uin_ * 64 + c4; \
        _Pragma("unroll") for (int i = 0; i < 4; ++i) v[i] = *(const f32x4*)(usp_ + (size_t)(i * 32) * N); }
#define T8_ST(v, t, buf) { const int t_ = (t), b_ = t_ / per, r_ = t_ % per, ik_ = r_ / tn, in_ = r_ % tn; LAS float* tile = (LAS float*)(lds + (buf) * (128 * 65 * 4)); \
        _Pragma("unroll") for (int i = 0; i < 4; ++i) { const int rr = rr0 + i * 32; tile[rr * 65 + c4 + 0] = v[i][0]; tile[rr * 65 + c4 + 1] = v[i][1]; tile[rr * 65 + c4 + 2] = v[i][2]; tile[rr * 65 + c4 + 3] = v[i][3]; } \
        if (t_ + 2 * NBLK < total) T8_LD(v, t_ + 2 * NBLK) \
        LDS_BARRIER(); \
        float f[16]; \
        _Pragma("unroll") for (int j = 0; j < 16; ++j) f[j] = tile[(kg + j) * 65 + n] * W8_SCALE; \
        u32x4 w; w.x = pk_fp8x4(f[0], f[1], f[2], f[3]); w.y = pk_fp8x4(f[4], f[5], f[6], f[7]); w.z = pk_fp8x4(f[8], f[9], f[10], f[11]); w.w = pk_fp8x4(f[12], f[13], f[14], f[15]); \
        *(u32x4*)(dst + (size_t)b_ * db + (size_t)(in_ * 64 + n) * ldd + ik_ * 128 + kg) = w; }
    int t = BID;
    if (t < total) T8_LD(va, t)
    if (t + NBLK < total) T8_LD(vb, t + NBLK)
    for (; t < total; t += 2 * NBLK) {
        T8_ST(va, t, 0)
        if (t + NBLK < total) T8_ST(vb, t + NBLK, 1)
    }
#undef T8_LD
#undef T8_ST
    LDS_BARRIER();
}
__device__ __forceinline__ void transpose_job(const float* src, bf16_t* dst, int K, int N, int ldd, size_t sb, size_t db, int dalt, int nbatch, LAS unsigned char* lds) {
    const int tid = TIDX, tk = K / 64, tn = N / 64, per = tk * tn, total = per * nbatch;
    const int rr0 = tid >> 4, c4 = (tid & 15) * 4, n = tid >> 3, kg = (tid & 7) * 8;
    f32x4 va[2], vb[2];
#define T16_LD(v, t) { const int u_ = (t), ub_ = u_ / per, ur_ = u_ % per, uik_ = ur_ / tn, uin_ = ur_ % tn; const float* usp_ = src + (size_t)ub_ * sb + (size_t)(uik_ * 64 + rr0) * N + uin_ * 64 + c4; \
        _Pragma("unroll") for (int i = 0; i < 2; ++i) v[i] = *(const f32x4*)(usp_ + (size_t)(i * 32) * N); }
#define T16_ST(v, t, buf) { const int t_ = (t), b_ = t_ / per, r_ = t_ % per, ik_ = r_ / tn, in_ = r_ % tn; LAS float* tile = (LAS float*)(lds + (buf) * (64 * 65 * 4)); \
        _Pragma("unroll") for (int i = 0; i < 2; ++i) { const int rr = rr0 + i * 32; tile[rr * 65 + c4 + 0] = v[i][0]; tile[rr * 65 + c4 + 1] = v[i][1]; tile[rr * 65 + c4 + 2] = v[i][2]; tile[rr * 65 + c4 + 3] = v[i][3]; } \
        if (t_ + 2 * NBLK < total) T16_LD(v, t_ + 2 * NBLK) \
        LDS_BARRIER(); \
        float f[8]; \
        _Pragma("unroll") for (int j = 0; j < 8; ++j) f[j] = tile[(kg + j) * 65 + n]; \
        u32x4 w; w.x = cvt_pk_bf16(f[0], f[1]); w.y = cvt_pk_bf16(f[2], f[3]); w.z = cvt_pk_bf16(f[4], f[5]); w.w = cvt_pk_bf16(f[6], f[7]); \
        *(u32x4*)(dst + (size_t)b_ * db + (size_t)(b_ & 1) * dalt + (size_t)(in_ * 64 + n) * ldd + ik_ * 64 + kg) = w; }
    int t = BID;
    if (t < total) T16_LD(va, t)
    if (t + NBLK < total) T16_LD(vb, t + NBLK)
    for (; t < total; t += 2 * NBLK) {
        T16_ST(va, t, 0)
        if (t + NBLK < total) T16_ST(vb, t + NBLK, 1)
    }
#undef T16_LD
#undef T16_ST
    LDS_BARRIER();
}

__device__ __forceinline__ void moe_weight_jobs(const Args& a, int layer, LAS unsigned char* lds) {
    const size_t lo = (size_t)layer * NEXP * D_ * DEXP;
    transpose_job8(a.in[25] + lo, a.ws + WS_WG, D_, DEXP, D_, (size_t)D_ * DEXP, (size_t)DEXP * D_, NEXP, lds);
    transpose_job8(a.in[26] + lo, a.ws + WS_WU, D_, DEXP, D_, (size_t)D_ * DEXP, (size_t)DEXP * D_, NEXP, lds);
    transpose_job8(a.in[27] + lo, a.ws + WS_WD, DEXP, D_, DEXP, (size_t)D_ * DEXP, (size_t)DEXP * D_, NEXP, lds);
}

__device__ __forceinline__ void phase_prologue(const Args& a, LAS unsigned char* lds) {
    const int gtid = BID * NTHREADS + TIDX, gsz = NBLK * NTHREADS;
    for (int i = gtid; i < 1024; i += gsz) { const float l0 = a.in[12][i], l1 = a.in[12][1024 + i], mx = fmaxf(l0, l1), e0 = __expf(l0 - mx), e1 = __expf(l1 - mx);
        ((float*)(a.ws + WS_LB))[i] = e0 / (e0 + e1); }
    for (int it = gtid; it < 2 * 256 * 256; it += gsz) { const int l = it >> 16, n = (it >> 8) & 255, k8 = (it & 255) * 8; float f[8];
#pragma unroll
        for (int j = 0; j < 8; ++j) { const int k = k8 + j; f[j] = n < 8 ? a.in[21][((size_t)l * D_ + k) * 8 + n] : (n < 72 ? a.in[23][((size_t)l * D_ + k) * 64 + (n - 8)] : 0.f); }
        u32x4 w; w.x = cvt_pk_bf16(f[0], f[1]); w.y = cvt_pk_bf16(f[2], f[3]); w.z = cvt_pk_bf16(f[4], f[5]); w.w = cvt_pk_bf16(f[6], f[7]);
        *(u32x4*)((bf16_t*)(a.ws + WS_WRT) + ((size_t)l * 256 + n) * D_ + k8) = w; }
    for (int it = gtid; it < 192 * 128; it += gsz) *(u32x4*)(a.ws + WS_WIN1T + (size_t)N_IN1 * D_ + (size_t)it * 16) = (u32x4){0u, 0u, 0u, 0u};
    transpose_job(a.in[4], (bf16_t*)(a.ws + WS_WIN0T), D_, N_IN0, D_, 0, 0, 0, 1, lds);
    transpose_job(a.in[14], (bf16_t*)(a.ws + WS_WOUT0T), D_, D_, D_, 0, 0, 0, 1, lds);
    transpose_job8(a.in[15], a.ws + WS_WIN1T, D_, N_IN1, D_, 0, 0, 1, lds);
    transpose_job8(a.in[20], a.ws + WS_WOUT1T, 4096, D_, 4096, 0, 0, 1, lds);
    transpose_job(a.in[7], (bf16_t*)(a.ws + WS_WGATES), 128, 128, 128, 128 * 128, 256 * 128, 0, 8, lds);
    transpose_job(a.in[9], (bf16_t*)(a.ws + WS_WGATES) + 128 * 128, 128, 128, 128, 128 * 128, 256 * 128, 0, 8, lds);
    moe_weight_jobs(a, 0, lds);
}

#define NORM_PH(M, F) phase_norm<M, F>
template <int MODE, bool F32>
__device__ __forceinline__ void phase_norm(const Args& a, const float* src, const float* gain, int layer) {
    const int wid = TIDX >> 6, lane = TIDX & 63;
    bf16_t* xw = (bf16_t*)(a.ws + WS_X); bf16_t* hw = (bf16_t*)(a.ws + WS_H);
    const unsigned char* ym = a.ws + WS_YMOE; const int* posof = (const int*)(a.ws + WS_POSOF); const float* gate = (const float*)(a.ws + WS_GATE);
    const int stride = NBLK * 16;
    f32x4 rf[2][8]; u32x2 rb[2][8]; int pp[2][2] = {{0, 0}, {0, 0}}; float pg[2][2] = {{0.f, 0.f}, {0.f, 0.f}};
#define NORM_LD(r) { _Pragma("unroll") for (int u = 0; u < 2; ++u) { _Pragma("unroll") for (int i = 0; i < 8; ++i) { \
            if (F32) rf[u][i] = *(const f32x4*)(src + (size_t)((r) + u) * D_ + (i * 64 + lane) * 4); else rb[u][i] = *(const u32x2*)(xw + (size_t)((r) + u) * D_ + (i * 64 + lane) * 4); } \
            if (MODE >= 1) { pp[u][0] = posof[((r) + u) * 2]; pp[u][1] = posof[((r) + u) * 2 + 1]; pg[u][0] = gate[((r) + u) * 2]; pg[u][1] = gate[((r) + u) * 2 + 1]; } } }
    int row = (BID * 8 + wid) * 2;
    if (row < T_) NORM_LD(row)
    for (; row < T_; row += stride) {
        f32x4 v[2][8]; int p[2][2]; float g[2][2];
#pragma unroll
        for (int u = 0; u < 2; ++u) { p[u][0] = pp[u][0]; p[u][1] = pp[u][1]; g[u][0] = pg[u][0]; g[u][1] = pg[u][1];
#pragma unroll
            for (int i = 0; i < 8; ++i) v[u][i] = F32 ? rf[u][i] : (f32x4){bf_lo(rb[u][i].x), bf_hi(rb[u][i].x), bf_lo(rb[u][i].y), bf_hi(rb[u][i].y)}; }
        if (row + stride < T_) NORM_LD(row + stride)
        if (MODE >= 1) {
            int y[2][8][2];
#pragma unroll
            for (int u = 0; u < 2; ++u) {
#pragma unroll
                for (int i = 0; i < 8; ++i) { const int c = (i * 64 + lane) * 4; y[u][i][0] = *(const int*)(ym + (size_t)p[u][0] * D_ + c); y[u][i][1] = *(const int*)(ym + (size_t)p[u][1] * D_ + c); } }
#pragma unroll
            for (int u = 0; u < 2; ++u) { const float g0 = g[u][0], g1 = g[u][1];
#pragma unroll
                for (int i = 0; i < 8; ++i) { const int y0 = y[u][i][0], y1 = y[u][i][1];
                    const f32x2 a0 = __builtin_amdgcn_cvt_pk_f32_fp8(y0, false), a1 = __builtin_amdgcn_cvt_pk_f32_fp8(y0, true), b0 = __builtin_amdgcn_cvt_pk_f32_fp8(y1, false), b1 = __builtin_amdgcn_cvt_pk_f32_fp8(y1, true);
                    v[u][i][0] += g0 * a0[0] + g1 * b0[0]; v[u][i][1] += g0 * a0[1] + g1 * b0[1]; v[u][i][2] += g0 * a1[0] + g1 * b1[0]; v[u][i][3] += g0 * a1[1] + g1 * b1[1]; }
                if (MODE == 1) {
#pragma unroll
                    for (int i = 0; i < 8; ++i) { u32x2 w; w.x = cvt_pk_bf16(v[u][i][0], v[u][i][1]); w.y = cvt_pk_bf16(v[u][i][2], v[u][i][3]); *(u32x2*)(xw + (size_t)(row + u) * D_ + (i * 64 + lane) * 4) = w; } } }
        }
#pragma unroll
        for (int u = 0; u < 2; ++u) {
            float ss = 0.f;
#pragma unroll
            for (int i = 0; i < 8; ++i) ss += v[u][i][0] * v[u][i][0] + v[u][i][1] * v[u][i][1] + v[u][i][2] * v[u][i][2] + v[u][i][3] * v[u][i][3];
            ss = wave_sum(ss);
            const float rstd = rsqrtf(ss * (1.0f / D_) + 1e-6f);
#pragma unroll
            for (int i = 0; i < 8; ++i) { const int c = (i * 64 + lane) * 4; const f32x4 gn = *(const f32x4*)(gain + c);
                const f32x4 o = v[u][i] * rstd * gn;
                if (MODE == 2) *(f32x4*)(a.out + (size_t)(row + u) * D_ + c) = o;
                else { if (MODE != 1) { u32x2 w; w.x = cvt_pk_bf16(o[0], o[1]); w.y = cvt_pk_bf16(o[2], o[3]); *(u32x2*)(hw + (size_t)(row + u) * D_ + c) = w; }
                       if (layer >= 0) *(unsigned*)(a.ws + WS_H8 + (size_t)(row + u) * D_ + c) = pk_fp8x4(o[0], o[1], o[2], o[3]); } } }
    }
#undef NORM_LD
    (void)layer;
}

__device__ __forceinline__ void phase_gemm_in0(const Args& a, LAS unsigned char* lds) {
    SrcGrid S{(const char*)(a.ws + WS_H), (const char*)(a.ws + WS_WIN0T), (size_t)BM * D_ * 2, (size_t)BM * D_ * 2, 64, 64 * 24, D_, D_};
    EpiProj E{(bf16_t*)(a.ws + WS_PROJ), N_IN0, (float*)(a.ws + WS_FLOG), 1024, 12, 16, 256, 1.0f};
    gemm_stream<false, false>(lds, S, D_ / BK, E);
}

__device__ __forceinline__ void phase_rg_conv(const Args& a) {
    const bf16_t* p0 = (const bf16_t*)(a.ws + WS_PROJ); bf16_t* xc = (bf16_t*)(a.ws + WS_XC);
    const float* cw = a.in[5]; const float* cb = a.in[6];
    for (int it = BID * NTHREADS + TIDX; it < 128 * (T_ / 16); it += NBLK * NTHREADS) { const int c = (it & 127) * 8; const size_t t0 = (size_t)(it >> 7) * 16;
        float w[4][8], bias[8];
#pragma unroll
        for (int k = 0; k < 4; ++k) { const f32x4 w0 = *(const f32x4*)(cw + k * 1024 + c), w1 = *(const f32x4*)(cw + k * 1024 + c + 4);
            w[k][0] = w0[0]; w[k][1] = w0[1]; w[k][2] = w0[2]; w[k][3] = w0[3]; w[k][4] = w1[0]; w[k][5] = w1[1]; w[k][6] = w1[2]; w[k][7] = w1[3]; }
        { const f32x4 b0 = *(const f32x4*)(cb + c), b1 = *(const f32x4*)(cb + c + 4); bias[0] = b0[0]; bias[1] = b0[1]; bias[2] = b0[2]; bias[3] = b0[3]; bias[4] = b1[0]; bias[5] = b1[1]; bias[6] = b1[2]; bias[7] = b1[3]; }
        u32x4 x0 = (u32x4){0u, 0u, 0u, 0u}, x1 = x0, x2 = x0;
        if ((t0 & (S_ - 1)) != 0) { x0 = *(const u32x4*)(p0 + (t0 - 3) * N_IN0 + c); x1 = *(const u32x4*)(p0 + (t0 - 2) * N_IN0 + c); x2 = *(const u32x4*)(p0 + (t0 - 1) * N_IN0 + c); }
        u32x4 xr[16];
#pragma unroll
        for (int r = 0; r < 16; ++r) xr[r] = *(const u32x4*)(p0 + (t0 + r) * N_IN0 + c);
#pragma unroll
        for (int r = 0; r < 16; ++r) { const u32x4 x3 = xr[r];
            float acc[8];
#define TAPS(j, f, m) (bias[j] + w[0][j] * f(x0.m) + w[1][j] * f(x1.m) + w[2][j] * f(x2.m) + w[3][j] * f(x3.m))
            acc[0] = TAPS(0, bf_lo, x); acc[1] = TAPS(1, bf_hi, x); acc[2] = TAPS(2, bf_lo, y); acc[3] = TAPS(3, bf_hi, y);
            acc[4] = TAPS(4, bf_lo, z); acc[5] = TAPS(5, bf_hi, z); acc[6] = TAPS(6, bf_lo, w); acc[7] = TAPS(7, bf_hi, w);
#undef TAPS
            u32x4 o; o.x = cvt_pk_bf16(acc[0], acc[1]); o.y = cvt_pk_bf16(acc[2], acc[3]); o.z = cvt_pk_bf16(acc[4], acc[5]); o.w = cvt_pk_bf16(acc[6], acc[7]);
            *(u32x4*)(xc + (t0 + r) * 1024 + c) = o;
            x0 = x1; x1 = x2; x2 = x3; } }
}

struct SrcRgGates {
    const char* xc; const char* w; int total;
    __device__ __forceinline__ bool next(int i, UnitD& u) const { const int id = BID + i * NBLK; if (id >= total) return false; u.t0 = id & 63; u.t1 = id >> 6; u.t2 = 0;
        u.gA = xc + ((size_t)u.t0 * BM * 1024 + u.t1 * 128) * 2; u.gB = w + (size_t)u.t1 * 256 * 128 * 2; return true; }
    __device__ __forceinline__ void va(const UnitD&, unsigned (&v)[2][2]) const { offs_direct(v, 1024, false); }
    __device__ __forceinline__ void vb(unsigned (&v)[2][2]) const { offs_direct(v, 128, true); }
};
__device__ __forceinline__ void phase_rg_gates(const Args& a, LAS unsigned char* lds) {
    SrcRgGates S{(const char*)(a.ws + WS_XC), (const char*)(a.ws + WS_WGATES), 64 * 8};
    EpiRgGates E{(bf16_t*)(a.ws + WS_A), (bf16_t*)(a.ws + WS_U), (const bf16_t*)(a.ws + WS_XC), a.in[8], a.in[10], a.in[11]};
    int nt = 2; asm volatile("" : "+s"(nt));
    gemm_stream<false, false>(lds, S, nt, E);
}

__device__ __forceinline__ void phase_rg_scan(const Args& a, LAS unsigned char* lds) {
    const bf16_t* LA = (const bf16_t*)(a.ws + WS_A); const bf16_t* U = (const bf16_t*)(a.ws + WS_U);
    const bf16_t* p0 = (const bf16_t*)(a.ws + WS_PROJ); bf16_t* Y = (bf16_t*)(a.ws + WS_Y);
    LAS float* sP = (LAS float*)lds; LAS float* sH = sP + 4096; LAS float* gP = sH + 4096; LAS float* gH = gP + 512; LAS float* gC = gH + 512;
    const int tid = TIDX, seg = tid >> 1, c8 = (tid & 1) * 8;
    for (int blk = BID; blk < NB_ * 64; blk += NBLK) { const int b = blk >> 6, c = (blk & 63) * 16 + c8;
        const size_t base = (((size_t)blk * S_ + seg * 16) << 4) + c8;
        float P[8], H[8];
#pragma unroll
        for (int j = 0; j < 8; ++j) { P[j] = 1.f; H[j] = 0.f; }
#pragma unroll 4
        for (int s = 0; s < 16; ++s) { const u32x4 lw = *(const u32x4*)(LA + base + (size_t)s * 16), uw = *(const u32x4*)(U + base + (size_t)s * 16);
            const float la[8] = {bf_lo(lw.x), bf_hi(lw.x), bf_lo(lw.y), bf_hi(lw.y), bf_lo(lw.z), bf_hi(lw.z), bf_lo(lw.w), bf_hi(lw.w)};
            const float uu[8] = {bf_lo(uw.x), bf_hi(uw.x), bf_lo(uw.y), bf_hi(uw.y), bf_lo(uw.z), bf_hi(uw.z), bf_lo(uw.w), bf_hi(uw.w)};
#pragma unroll
            for (int j = 0; j < 8; ++j) { const float av = __expf(la[j]); H[j] = av * H[j] + uu[j]; P[j] *= av; } }
        __syncthreads();
#pragma unroll
        for (int j = 0; j < 8; ++j) { sP[seg * 16 + c8 + j] = P[j]; sH[seg * 16 + c8 + j] = H[j]; }
        __syncthreads();
        { const int ch = tid & 15, grp = tid >> 4; float p = 1.f, h = 0.f;
#pragma unroll
          for (int q = 0; q < 8; ++q) { const int sgi = grp * 8 + q; h = sP[sgi * 16 + ch] * h + sH[sgi * 16 + ch]; p *= sP[sgi * 16 + ch]; }
          gP[grp * 16 + ch] = p; gH[grp * 16 + ch] = h; }
        __syncthreads();
        if (tid < 16) { float carry = 0.f; for (int g = 0; g < 32; ++g) { gC[g * 16 + tid] = carry; carry = gP[g * 16 + tid] * carry + gH[g * 16 + tid]; } }
        __syncthreads();
        { const int ch = tid & 15, grp = tid >> 4; float h = gC[grp * 16 + ch];
#pragma unroll
          for (int q = 0; q < 8; ++q) { const int sgi = grp * 8 + q; const float pin = sP[sgi * 16 + ch], hin = sH[sgi * 16 + ch]; sH[sgi * 16 + ch] = h; h = pin * h + hin; } }
        __syncthreads();
#pragma unroll
        for (int j = 0; j < 8; ++j) H[j] = sH[seg * 16 + c8 + j];
        {
            u32x4 l_a[4], u_a[4], g_a[4];
#define RS_LD(Lv, Uv, Gv, s0) { _Pragma("unroll") for (int j = 0; j < 4; ++j) { const int s_ = (s0) + j; Lv[j] = *(const u32x4*)(LA + base + (size_t)s_ * 16); Uv[j] = *(const u32x4*)(U + base + (size_t)s_ * 16); \
                Gv[j] = *(const u32x4*)(p0 + ((size_t)b * S_ + seg * 16 + s_) * N_IN0 + 1024 + c); } }
            RS_LD(l_a, u_a, g_a, 0)
#pragma unroll
            for (int s0 = 0; s0 < 16; s0 += 4) { u32x4 l_b[4], u_b[4], g_b[4];
#pragma unroll
                for (int j = 0; j < 4; ++j) { l_b[j] = l_a[j]; u_b[j] = u_a[j]; g_b[j] = g_a[j]; }
                if (s0 + 4 < 16) RS_LD(l_b, u_b, g_b, s0 + 4)
#pragma unroll
                for (int j = 0; j < 4; ++j) { const u32x4 lw = l_a[j], uw = u_a[j], gw = g_a[j]; const size_t t = (size_t)b * S_ + seg * 16 + s0 + j;
                    const float la[8] = {bf_lo(lw.x), bf_hi(lw.x), bf_lo(lw.y), bf_hi(lw.y), bf_lo(lw.z), bf_hi(lw.z), bf_lo(lw.w), bf_hi(lw.w)};
                    const float uu[8] = {bf_lo(uw.x), bf_hi(uw.x), bf_lo(uw.y), bf_hi(uw.y), bf_lo(uw.z), bf_hi(uw.z), bf_lo(uw.w), bf_hi(uw.w)};
                    const float gg[8] = {bf_lo(gw.x), bf_hi(gw.x), bf_lo(gw.y), bf_hi(gw.y), bf_lo(gw.z), bf_hi(gw.z), bf_lo(gw.w), bf_hi(gw.w)};
                    float y[8];
#pragma unroll
                    for (int q = 0; q < 8; ++q) { H[q] = __expf(la[q]) * H[q] + uu[q]; y[q] = H[q] * gelu_tanh(gg[q]); }
                    u32x4 o; o.x = cvt_pk_bf16(y[0], y[1]); o.y = cvt_pk_bf16(y[2], y[3]); o.z = cvt_pk_bf16(y[4], y[5]); o.w = cvt_pk_bf16(y[6], y[7]);
                    *(u32x4*)(Y + t * D_ + c) = o; }
#pragma unroll
                for (int j = 0; j < 4; ++j) { l_a[j] = l_b[j]; u_a[j] = u_b[j]; g_a[j] = g_b[j]; } }
#undef RS_LD
        }
    }
}

typedef short s16x4 __attribute__((ext_vector_type(4)));
__device__ __forceinline__ f32x4 mfma32(bf16x8 a, bf16x8 b, f32x4 c) { return __builtin_amdgcn_mfma_f32_16x16x32_bf16(a, b, c, 0, 0, 0); }
__device__ __forceinline__ bf16x8 lds_frag(LAS const unsigned char* p) { return *(const LAS bf16x8*)p; }
__device__ __forceinline__ s16x4 lds_tr4(LAS const unsigned char* p) { return __builtin_amdgcn_ds_read_tr16_b64_v4i16((LAS s16x4*)p); }
__device__ __forceinline__ bf16x8 lds_tr8(LAS const unsigned char* p, int rowskip_bytes) {
    const s16x4 lo = lds_tr4(p), hi = lds_tr4(p + rowskip_bytes); return __builtin_shufflevector(lo, hi, 0, 1, 2, 3, 4, 5, 6, 7); }
__device__ __forceinline__ bf16x8 pack8(const f32x4& lo, const f32x4& hi) { u32x4 w; w.x = cvt_pk_bf16(lo[0], lo[1]); w.y = cvt_pk_bf16(lo[2], lo[3]); w.z = cvt_pk_bf16(hi[0], hi[1]); w.w = cvt_pk_bf16(hi[2], hi[3]); return __builtin_bit_cast(bf16x8, w); }
constexpr int RSB = 272;

constexpr size_t WS_HQ = WS_O;
constexpr size_t WS_HA = WS_HQ + (size_t)2048 * 64 * 128 * 2;
constexpr size_t WS_HG = WS_HA + (size_t)2048 * 8 * 512 * 2;
constexpr size_t WS_HS = WS_HG + (size_t)2048 * 128 * 128 * 2;
constexpr size_t WS_HD = WS_HS + (size_t)2048 * 128 * 128 * 2;
static_assert(WS_HD + (size_t)2048 * 128 * 4 <= WS_TAIL, "hgrn overlay");

__device__ __forceinline__ void phase_hg1(const Args& a, LAS unsigned char* lds) {
    const bf16_t* p0 = (const bf16_t*)(a.ws + WS_PROJ); const float* flog = (const float*)(a.ws + WS_FLOG); const float* lb = (const float*)(a.ws + WS_LB);
    bf16_t* QG = (bf16_t*)(a.ws + WS_HQ); bf16_t* AG = (bf16_t*)(a.ws + WS_HA); bf16_t* GG = (bf16_t*)(a.ws + WS_HG); float* DG = (float*)(a.ws + WS_HD);
    constexpr int SEG = 0, QT = 4096, KT = QT + 64 * RSB, KH = KT + 64 * RSB, VS = KH + 64 * RSB;
    const int tid = TIDX, wid = tid >> 6, lane = tid & 63, I = lane & 15, G = lane >> 4, k2 = 2 * lane, sg = wid;
    LAS float* seg = (LAS float*)(lds + SEG);
    u32x4 pvv[2]; f32x2 pz[8]; unsigned pqw[8];
#define HG1_LOAD(it_) do { const int bh_ = (it_) >> 6, ck_ = (it_) & 63, h_ = bh_ & 7; const size_t t0_ = (size_t)(bh_ >> 3) * S_ + ck_ * 64; \
        _Pragma("unroll") for (int i = 0; i < 2; ++i) { const int c = tid + i * 512, s_ = c >> 4, v8 = (c & 15) * 8; pvv[i] = *(const u32x4*)(p0 + (t0_ + s_) * N_IN0 + 4096 + h_ * 128 + v8); } \
        _Pragma("unroll") for (int i = 0; i < 8; ++i) { const size_t t_ = t0_ + sg * 8 + i; pz[i] = *(const f32x2*)(flog + t_ * 1024 + h_ * 128 + k2); pqw[i] = *(const unsigned*)(p0 + t_ * N_IN0 + 2048 + h_ * 128 + k2); } } while (0)
    if (BID < 2048) HG1_LOAD(BID);
    for (int item = BID; item < 2048; item += NBLK) { const int bh = item >> 6, h = bh & 7;
        LDS_BARRIER();
#pragma unroll
        for (int i = 0; i < 2; ++i) { const int c = tid + i * 512, s = c >> 4, v8 = (c & 15) * 8; *(LAS u32x4*)(lds + VS + s * RSB + v8 * 2) = pvv[i]; }
        const f32x2 l2 = *(const f32x2*)(lb + h * 128 + k2);
        float f[8][2], cb[8][2]; unsigned qw[8]; float c0 = 0.f, c1 = 0.f;
#pragma unroll
        for (int i = 0; i < 8; ++i) { const f32x2 z = pz[i]; qw[i] = pqw[i];
            f[i][0] = l2[0] + (1.0f - l2[0]) * sigmoidf_(z[0]); f[i][1] = l2[1] + (1.0f - l2[1]) * sigmoidf_(z[1]);
            c0 += __logf(f[i][0]); c1 += __logf(f[i][1]); cb[i][0] = c0; cb[i][1] = c1; }
        *(LAS f32x2*)(seg + sg * 128 + k2) = (f32x2){c0, c1};
        if (item + NBLK < 2048) HG1_LOAD(item + NBLK);
        LDS_BARRIER();
        float off0 = 0.f, off1 = 0.f, tot0 = 0.f, tot1 = 0.f;
#pragma unroll
        for (int s2 = 0; s2 < 8; ++s2) { const f32x2 v = *(const LAS f32x2*)(seg + s2 * 128 + k2); tot0 += v[0]; tot1 += v[1]; if (s2 < sg) { off0 += v[0]; off1 += v[1]; } }
        const float et0 = __expf(tot0), et1 = __expf(tot1);
#pragma unroll
        for (int i = 0; i < 8; ++i) { const int t = sg * 8 + i;
            const float e0 = __expf(cb[i][0] + off0), e1 = __expf(cb[i][1] + off1), r0 = __builtin_amdgcn_rcpf(e0), r1 = __builtin_amdgcn_rcpf(e1), km0 = 1.0f - f[i][0], km1 = 1.0f - f[i][1];
            const unsigned qt = cvt_pk_bf16(siluf_(bf_lo(qw[i])) * e0, siluf_(bf_hi(qw[i])) * e1);
            *(LAS unsigned*)(lds + QT + t * RSB + k2 * 2) = qt; *(unsigned*)(QG + ((size_t)item * 64 + t) * 128 + k2) = qt;
            *(LAS unsigned*)(lds + KT + t * RSB + k2 * 2) = cvt_pk_bf16(km0 * r0, km1 * r1);
            *(LAS unsigned*)(lds + KH + t * RSB + k2 * 2) = cvt_pk_bf16(km0 * r0 * et0, km1 * r1 * et1); }
        if (sg == 0) *(f32x2*)(DG + (size_t)item * 128 + k2) = (f32x2){et0, et1};
        LDS_BARRIER();
        { const int tt = wid & 3, sp = wid >> 2;
          bf16x8 qf[4];
#pragma unroll
          for (int ks = 0; ks < 4; ++ks) qf[ks] = lds_frag(lds + QT + (16 * tt + I) * RSB + (32 * ks + 8 * G) * 2);
          f32x4 acc[2];
#pragma unroll
          for (int hh = 0; hh < 2; ++hh) { const int st = 2 * sp + hh; acc[hh] = (f32x4){0.f, 0.f, 0.f, 0.f};
              if (st <= tt) {
#pragma unroll
                  for (int ks = 0; ks < 4; ++ks) acc[hh] = mfma32(lds_frag(lds + KT + (16 * st + I) * RSB + (32 * ks + 8 * G) * 2), qf[ks], acc[hh]);
#pragma unroll
                  for (int r = 0; r < 4; ++r) if (16 * st + 4 * G + r > 16 * tt + I) acc[hh][r] = 0.f; } }
          *(bf16x8*)(AG + (((size_t)item * 4 + tt) * 2 + sp) * 512 + lane * 8) = pack8(acc[0], acc[1]); }
        { const int kt = wid, q = I >> 2, p = I & 3;
          bf16x8 ka[2];
#pragma unroll
          for (int ks = 0; ks < 2; ++ks) ka[ks] = lds_tr8(lds + KH + (32 * ks + 8 * G + q) * RSB + (16 * kt + 4 * p) * 2, 4 * RSB);
#pragma unroll
          for (int vt = 0; vt < 8; ++vt) { f32x4 acc = (f32x4){0.f, 0.f, 0.f, 0.f};
#pragma unroll
              for (int ks = 0; ks < 2; ++ks) acc = mfma32(ka[ks], lds_tr8(lds + VS + (32 * ks + 8 * G + q) * RSB + (16 * vt + 4 * p) * 2, 4 * RSB), acc);
              u32x2 w; w.x = cvt_pk_bf16(acc[0], acc[1]); w.y = cvt_pk_bf16(acc[2], acc[3]);
              *(u32x2*)(GG + ((size_t)item * 128 + 16 * vt + I) * 128 + 16 * kt + 4 * G) = w; } }
    }
#undef HG1_LOAD
}

__device__ __forceinline__ void phase_hg2(const Args& a) {
    const bf16_t* GG = (const bf16_t*)(a.ws + WS_HG); const float* DG = (const float*)(a.ws + WS_HD); bf16_t* SG = (bf16_t*)(a.ws + WS_HS);
    for (int gid = BID * NTHREADS + TIDX; gid < 32 * 4096; gid += NBLK * NTHREADS) { const int bh = gid >> 12, e = gid & 4095, v = e >> 5, k4 = (e & 31) * 4;
        f32x4 S = (f32x4){0.f, 0.f, 0.f, 0.f};
        const size_t o0 = (((size_t)bh * 64) * 128 + v) * 128 + k4; const float* dg = DG + (size_t)bh * 64 * 128 + k4;
        f32x4 da[8]; u32x2 ga[8];
#pragma unroll
        for (int j = 0; j < 8; ++j) { da[j] = *(const f32x4*)(dg + j * 128); ga[j] = *(const u32x2*)(GG + o0 + (size_t)j * 16384); }
#pragma unroll 1
        for (int n0 = 0; n0 < 64; n0 += 8) { f32x4 db[8]; u32x2 gb[8];
#pragma unroll
            for (int j = 0; j < 8; ++j) { db[j] = da[j]; gb[j] = ga[j]; }
            if (n0 + 8 < 64) {
#pragma unroll
                for (int j = 0; j < 8; ++j) { db[j] = *(const f32x4*)(dg + (n0 + 8 + j) * 128); gb[j] = *(const u32x2*)(GG + o0 + (size_t)(n0 + 8 + j) * 16384); } }
#pragma unroll
            for (int j = 0; j < 8; ++j) { u32x2 w; w.x = cvt_pk_bf16(S[0], S[1]); w.y = cvt_pk_bf16(S[2], S[3]); *(u32x2*)(SG + o0 + (size_t)(n0 + j) * 16384) = w;
                const f32x4 d = da[j]; const u32x2 g = ga[j];
                S[0] = d[0] * S[0] + bf_lo(g.x); S[1] = d[1] * S[1] + bf_hi(g.x); S[2] = d[2] * S[2] + bf_lo(g.y); S[3] = d[3] * S[3] + bf_hi(g.y); }
#pragma unroll
            for (int j = 0; j < 8; ++j) { da[j] = db[j]; ga[j] = gb[j]; } } }
}

__device__ __forceinline__ void phase_hg3(const Args& a, LAS unsigned char* lds) {
    const bf16_t* p0 = (const bf16_t*)(a.ws + WS_PROJ); const bf16_t* QG = (const bf16_t*)(a.ws + WS_HQ); const bf16_t* AG = (const bf16_t*)(a.ws + WS_HA); const bf16_t* SG = (const bf16_t*)(a.ws + WS_HS);
    bf16_t* Y = (bf16_t*)(a.ws + WS_Y); const float* gain = a.in[13];
    constexpr int ST = 0, QT = 128 * RSB, VS = QT + 64 * RSB, PART = VS + 64 * RSB;
    const int tid = TIDX, wid = tid >> 6, lane = tid & 63, I = lane & 15, G = lane >> 4, q = I >> 2, p = I & 3;
    LAS float* part = (LAS float*)(lds + PART);
    const int tt = wid & 3, vh = wid >> 2;
    u32x4 ps[4], pq2[2], pv2[2]; bf16x8 paf[2];
#define HG3_LOAD(it_) do { const int bh_ = (it_) >> 6, ck_ = (it_) & 63; const size_t t0_ = (size_t)(bh_ >> 3) * S_ + ck_ * 64; const int h_ = bh_ & 7; \
        _Pragma("unroll") for (int i = 0; i < 4; ++i) { const int c = tid + i * 512, v = c >> 4, k8 = (c & 15) * 8; ps[i] = *(const u32x4*)(SG + ((size_t)(it_) * 128 + v) * 128 + k8); } \
        _Pragma("unroll") for (int i = 0; i < 2; ++i) { const int c = tid + i * 512, s_ = c >> 4, c8 = (c & 15) * 8; pq2[i] = *(const u32x4*)(QG + ((size_t)(it_) * 64 + s_) * 128 + c8); pv2[i] = *(const u32x4*)(p0 + (t0_ + s_) * N_IN0 + 4096 + h_ * 128 + c8); } \
        _Pragma("unroll") for (int sp = 0; sp < 2; ++sp) paf[sp] = *(const bf16x8*)(AG + (((size_t)(it_) * 4 + tt) * 2 + sp) * 512 + lane * 8); } while (0)
    if (BID < 2048) HG3_LOAD(BID);
    for (int item = BID; item < 2048; item += NBLK) { const int bh = item >> 6, ck = item & 63, b = bh >> 3, h = bh & 7; const size_t t0 = (size_t)b * S_ + ck * 64;
        LDS_BARRIER();
#pragma unroll
        for (int i = 0; i < 4; ++i) { const int c = tid + i * 512, v = c >> 4, k8 = (c & 15) * 8; *(LAS u32x4*)(lds + ST + v * RSB + k8 * 2) = ps[i]; }
#pragma unroll
        for (int i = 0; i < 2; ++i) { const int c = tid + i * 512, s2 = c >> 4, c8 = (c & 15) * 8; *(LAS u32x4*)(lds + QT + s2 * RSB + c8 * 2) = pq2[i]; *(LAS u32x4*)(lds + VS + s2 * RSB + c8 * 2) = pv2[i]; }
        bf16x8 af[2]; af[0] = paf[0]; af[1] = paf[1];
        if (item + NBLK < 2048) HG3_LOAD(item + NBLK);
        u32x2 zwp[4];
#pragma unroll
        for (int vi = 0; vi < 4; ++vi) zwp[vi] = *(const u32x2*)(p0 + (t0 + 16 * tt + I) * N_IN0 + 5120 + h * 128 + 16 * (4 * vh + vi) + 4 * G);
        LDS_BARRIER();
        bf16x8 qf[4];
#pragma unroll
        for (int ks = 0; ks < 4; ++ks) qf[ks] = lds_frag(lds + QT + (16 * tt + I) * RSB + (32 * ks + 8 * G) * 2);
        f32x4 acc[4]; float ss = 0.f;
#pragma unroll
        for (int vi = 0; vi < 4; ++vi) { const int vt = 4 * vh + vi; acc[vi] = (f32x4){0.f, 0.f, 0.f, 0.f};
#pragma unroll
            for (int ks = 0; ks < 4; ++ks) acc[vi] = mfma32(lds_frag(lds + ST + (16 * vt + I) * RSB + (32 * ks + 8 * G) * 2), qf[ks], acc[vi]);
#pragma unroll
            for (int sp = 0; sp < 2; ++sp) acc[vi] = mfma32(lds_tr8(lds + VS + (32 * sp + 4 * G + q) * RSB + (16 * vt + 4 * p) * 2, 16 * RSB), af[sp], acc[vi]);
            ss += acc[vi][0] * acc[vi][0] + acc[vi][1] * acc[vi][1] + acc[vi][2] * acc[vi][2] + acc[vi][3] * acc[vi][3]; }
        ss += __shfl_xor(ss, 16); ss += __shfl_xor(ss, 32);
        if (G == 0) part[wid * 16 + I] = ss;
        LDS_BARRIER();
        const float rstd = rsqrtf((part[wid * 16 + I] + part[(wid ^ 4) * 16 + I]) * (1.0f / 128.0f) + 1e-6f);
        const size_t t = t0 + 16 * tt + I;
#pragma unroll
        for (int vi = 0; vi < 4; ++vi) { const int c = h * 128 + 16 * (4 * vh + vi) + 4 * G;
            const f32x4 gn = *(const f32x4*)(gain + c); const u32x2 zw = zwp[vi];
            const float o0 = acc[vi][0] * rstd * gn[0] * siluf_(bf_lo(zw.x)), o1 = acc[vi][1] * rstd * gn[1] * siluf_(bf_hi(zw.x)), o2 = acc[vi][2] * rstd * gn[2] * siluf_(bf_lo(zw.y)), o3 = acc[vi][3] * rstd * gn[3] * siluf_(bf_hi(zw.y));
            u32x2 w; w.x = cvt_pk_bf16(o0, o1); w.y = cvt_pk_bf16(o2, o3); *(u32x2*)(Y + t * D_ + 1024 + c) = w; }
    }
#undef HG3_LOAD
}

__device__ __forceinline__ void phase_gdn_norm(const Args& a) {
    const bf16_t* O = (const bf16_t*)(a.ws + WS_O); const bf16_t* pj = (const bf16_t*)(a.ws + WS_PROJ); unsigned char* Y = a.ws + WS_Y; const float* gain = a.in[19];
    const int lane = TIDX & 63, wid = TIDX >> 6, gc = (lane & 15) * 8;
    const f32x4 g0 = *(const f32x4*)(gain + gc), g1 = *(const f32x4*)(gain + gc + 4);
    u32x4 oa[8], za[8];
    int row = BID * 8 + wid; const int stride = NBLK * 8;
#define GN_LD(ov, zv, r) { _Pragma("unroll") for (int i = 0; i < 8; ++i) { const int c = (i * 64 + lane) * 8; ov[i] = *(const u32x4*)(O + (size_t)(r) * 4096 + c); zv[i] = *(const u32x4*)(pj + (size_t)(r) * N_IN1P + 8192 + c); } }
    if (row < T_) GN_LD(oa, za, row)
    for (; row < T_; row += stride) { u32x4 ob[8], zb[8];
#pragma unroll
        for (int i = 0; i < 8; ++i) { ob[i] = oa[i]; zb[i] = za[i]; }
        if (row + stride < T_) GN_LD(ob, zb, row + stride)
#pragma unroll
        for (int i = 0; i < 8; ++i) { const int c = (i * 64 + lane) * 8;
            const u32x4 ow = oa[i], zw = za[i];
            const float o[8] = {bf_lo(ow.x), bf_hi(ow.x), bf_lo(ow.y), bf_hi(ow.y), bf_lo(ow.z), bf_hi(ow.z), bf_lo(ow.w), bf_hi(ow.w)};
            const float z[8] = {bf_lo(zw.x), bf_hi(zw.x), bf_lo(zw.y), bf_hi(zw.y), bf_lo(zw.z), bf_hi(zw.z), bf_lo(zw.w), bf_hi(zw.w)};
            float ss = 0.f;
#pragma unroll
            for (int q = 0; q < 8; ++q) ss += o[q] * o[q];
            ss = row16_sum(ss);
            const float rstd = rsqrtf(ss * (1.0f / 128.0f) + 1e-6f);
            float y[8];
#pragma unroll
            for (int q = 0; q < 8; ++q) y[q] = o[q] * rstd * (q < 4 ? g0[q & 3] : g1[q & 3]) * siluf_(z[q]);
            u32x2 w; w.x = pk_fp8x4(y[0], y[1], y[2], y[3]); w.y = pk_fp8x4(y[4], y[5], y[6], y[7]);
            *(u32x2*)(Y + (size_t)row * 4096 + c) = w; }
#pragma unroll
        for (int i = 0; i < 8; ++i) { oa[i] = ob[i]; za[i] = zb[i]; }
    }
#undef GN_LD
}

template <bool FP8>
__device__ __forceinline__ void phase_gemm_out(const Args& a, LAS unsigned char* lds, int K, const void* w, const float* xin) {
    const int eb = FP8 ? 1 : 2;
    SrcGrid S{(const char*)(a.ws + WS_Y), (const char*)w, (size_t)BM * K * eb, (size_t)BM * K * eb, 64, 64 * 8, K * eb / 2, K * eb / 2};
    EpiResid E{(bf16_t*)(a.ws + WS_X), xin, (const bf16_t*)(a.ws + WS_X), FP8 ? 1.0f / W8_SCALE : 1.0f};
    gemm_stream<false, FP8>(lds, S, K * eb / 128, E);
}

struct SrcRouter {
    const char* h; const char* w;
    __device__ __forceinline__ bool next(int i, UnitD& u) const { const int id = BID + i * NBLK; if (id >= 256) return false; u.t0 = id & 63; u.t1 = id >> 6; u.t2 = 0;
        u.gA = h + ((size_t)u.t0 * BM * D_ + u.t1 * 512) * 2; u.gB = w + (size_t)u.t1 * 512 * 2; return true; }
    __device__ __forceinline__ void va(const UnitD&, unsigned (&v)[2][2]) const { offs_direct(v, D_, false); }
    __device__ __forceinline__ void vb(unsigned (&v)[2][2]) const { offs_direct(v, D_, true); }
};
struct EpiLogitsQ {
    float* O;
    __device__ __forceinline__ void operator()(const Acc& acc, const UnitD& u, int wr, int wc, int fr, int fq) const { store_f32_tile(acc, O + ((size_t)u.t1 * T_ + (size_t)u.t0 * BM) * 128, nullptr, 128, 128, wr, wc, fr, fq); }
};
__device__ __forceinline__ void phase_gemm_router(const Args& a, LAS unsigned char* lds, int layer) {
    SrcRouter S{(const char*)(a.ws + WS_H), (const char*)(a.ws + WS_WRT) + (size_t)layer * 256 * D_ * 2};
    EpiLogitsQ E{(float*)(a.ws + WS_O)};
    gemm_stream<false, false>(lds, S, 512 / BK, E);
}

__device__ __forceinline__ void phase_route(const Args& a, int layer) {
    const float* lg = (const float*)(a.ws + WS_O); const float* bg = a.in[22] + layer * 8; const float* be = a.in[24] + layer * 64;
    int* cnt = (int*)(a.ws + WS_CTL + CTL_CNT) + layer * 64;
    int* eid = (int*)(a.ws + WS_EID); int* slot = (int*)(a.ws + WS_SLOT); float* gate = (float*)(a.ws + WS_GATE); int* rowmap = (int*)(a.ws + WS_ROWMAP);
    const int gtid = BID * NTHREADS + TIDX, gsz = NBLK * NTHREADS;
    for (int i = gtid; i < MPAD; i += gsz) rowmap[i] = 0;
    for (int t = gtid; t < T_; t += gsz) {
        f32x4 ga = (f32x4){0.f, 0.f, 0.f, 0.f}, gb = ga;
#pragma unroll
        for (int kq = 0; kq < 4; ++kq) { ga += *(const f32x4*)(lg + ((size_t)kq * T_ + t) * 128); gb += *(const f32x4*)(lg + ((size_t)kq * T_ + t) * 128 + 4); }
        const float gl[8] = {ga[0] + bg[0], ga[1] + bg[1], ga[2] + bg[2], ga[3] + bg[3], gb[0] + bg[4], gb[1] + bg[5], gb[2] + bg[6], gb[3] + bg[7]};
        float mx = -3.0e38f; int gi = 0;
#pragma unroll
        for (int j = 0; j < 8; ++j) if (gl[j] > mx) { mx = gl[j]; gi = j; }
        float se = 0.f;
#pragma unroll
        for (int j = 0; j < 8; ++j) se += __expf(gl[j] - mx);
        const float gp = 1.0f / se;
        f32x4 ea = *(const f32x4*)(be + gi * 8), eb = *(const f32x4*)(be + gi * 8 + 4);
#pragma unroll
        for (int kq = 0; kq < 4; ++kq) { ea += *(const f32x4*)(lg + ((size_t)kq * T_ + t) * 128 + 8 + gi * 8); eb += *(const f32x4*)(lg + ((size_t)kq * T_ + t) * 128 + 12 + gi * 8); }
        const float el[8] = {ea[0], ea[1], ea[2], ea[3], eb[0], eb[1], eb[2], eb[3]};
        float l1 = -3.0e38f, l2 = -3.0e38f; int i1 = 0, i2 = 0;
#pragma unroll
        for (int j = 0; j < 8; ++j) { const float v = el[j];
            if (v > l1) { l2 = l1; i2 = i1; l1 = v; i1 = j; } else if (v > l2) { l2 = v; i2 = j; } }
        const float e2 = __expf(l2 - l1), inv = 1.0f / (1.0f + e2);
        const int e0 = gi * 8 + i1, e1 = gi * 8 + i2;
        eid[t * 2] = e0; eid[t * 2 + 1] = e1; gate[t * 2] = inv * gp; gate[t * 2 + 1] = e2 * inv * gp;
        slot[t * 2] = atomicAdd(&cnt[e0], 1); slot[t * 2 + 1] = atomicAdd(&cnt[e1], 1); }
}

__device__ __forceinline__ void phase_rowmap(const Args& a, LAS unsigned char* lds, int layer) {
    const int* cnt = (const int*)(a.ws + WS_CTL + CTL_CNT) + layer * 64; LAS int* ps = (LAS int*)lds;
    int* tinfo = (int*)(a.ws + WS_TINFO) + layer * 512;
    const int* eid = (const int*)(a.ws + WS_EID); const int* slot = (const int*)(a.ws + WS_SLOT); int* posof = (int*)(a.ws + WS_POSOF); int* rowmap = (int*)(a.ws + WS_ROWMAP);
    __syncthreads();
    if (TIDX == 0) { int acc = 0; for (int e = 0; e < 64; ++e) { ps[e] = acc; acc += (cnt[e] + 255) & ~255; } ps[64] = acc; }
    __syncthreads();
    if (BID == 0) { if (TIDX <= 64) tinfo[TIDX] = ps[TIDX]; if (TIDX == 65) tinfo[65] = ps[64] >> 8;
        if (TIDX < 192) { const int p = TIDX * 256; int e = 0; for (int j = 0; j < 64; ++j) if (ps[j + 1] <= p) e = j + 1; tinfo[128 + TIDX] = e < 64 ? e : 63; } }
    for (int i = BID * NTHREADS + TIDX; i < T_ * 2; i += NBLK * NTHREADS) { const int p = ps[eid[i]] + slot[i]; posof[i] = p; rowmap[p] = i >> 1; }
    __syncthreads();
}

struct SrcMoeUp {
    const char* h; const char* wg; const int* tinfo; const int* rowmap; int total;
    __device__ __forceinline__ bool next(int i, UnitD& u) const { const int id = BID + i * NBLK; if (id >= total) return false; u.t0 = id >> 2; u.t1 = id & 3;
        u.t2 = __builtin_amdgcn_readfirstlane(tinfo[128 + u.t0]); u.gA = h; u.gB = wg + ((size_t)u.t2 * DEXP + u.t1 * 128) * D_; return true; }
    __device__ __forceinline__ void va(const UnitD& u, unsigned (&v)[2][2]) const { int R0, C0; stage_pos(TIDX, R0, C0);
#pragma unroll
        for (int hh = 0; hh < 2; ++hh)
#pragma unroll
            for (int i = 0; i < 2; ++i) v[hh][i] = (unsigned)(rowmap[u.t0 * 256 + hh * 128 + R0 + 64 * i] * D_ + C0 * 2); }
    __device__ __forceinline__ void vb(unsigned (&v)[2][2]) const { int R0, C0; stage_pos(TIDX, R0, C0);
#pragma unroll
        for (int i = 0; i < 2; ++i) { const int Rr = perm_row(R0 + 64 * i); v[0][i] = (unsigned)(Rr * D_ + C0 * 2); v[1][i] = (unsigned)(WS_WU - WS_WG) + (unsigned)(Rr * D_ + C0 * 2); } }
};
__device__ __forceinline__ void phase_moe_up(const Args& a, LAS unsigned char* lds, int layer) {
    const int* tinfo = (const int*)(a.ws + WS_TINFO) + layer * 512;
    const int ntm = __builtin_amdgcn_readfirstlane(tinfo[65]);
    SrcMoeUp S{(const char*)(a.ws + WS_H8), (const char*)(a.ws + WS_WG), tinfo, (const int*)(a.ws + WS_ROWMAP), ntm * 4};
    EpiSwiGLU E{a.ws + WS_ACT};
    gemm_stream<true, true>(lds, S, D_ / 128, E);
}

struct SrcMoeDown {
    const char* act; const char* wd; const int* tinfo; int total;
    __device__ __forceinline__ bool next(int i, UnitD& u) const { const int id = BID + i * NBLK; if (id >= total) return false; u.t0 = id >> 3; u.t1 = id & 7;
        u.t2 = __builtin_amdgcn_readfirstlane(tinfo[128 + u.t0]); u.gA = act + (size_t)u.t0 * BM * DEXP; u.gB = wd + ((size_t)u.t2 * D_ + u.t1 * BM) * DEXP; return true; }
    __device__ __forceinline__ void va(const UnitD&, unsigned (&v)[2][2]) const { offs_direct(v, DEXP / 2, false); }
    __device__ __forceinline__ void vb(unsigned (&v)[2][2]) const { offs_direct(v, DEXP / 2, true); }
};
__device__ __forceinline__ void phase_moe_down(const Args& a, LAS unsigned char* lds, int layer) {
    const int* tinfo = (const int*)(a.ws + WS_TINFO) + layer * 512; const int ntm = __builtin_amdgcn_readfirstlane(tinfo[65]);
    SrcMoeDown S{(const char*)(a.ws + WS_ACT), (const char*)(a.ws + WS_WD), tinfo, ntm * 8};
    EpiDown E{a.ws + WS_YMOE};
    gemm_stream<false, true>(lds, S, DEXP / 128, E);
}

struct SrcIn1Tail {
    const char* h; const char* w;
    __device__ __forceinline__ bool next(int i, UnitD& u) const { const int id = BID + i * NBLK; if (id >= 256) return false; u.t0 = id & 63; u.t1 = id >> 6; u.t2 = 0;
        u.gA = h + (size_t)u.t0 * BM * D_ + u.t1 * 512; u.gB = w + (size_t)48 * BM * D_ + u.t1 * 512; return true; }
    __device__ __forceinline__ void va(const UnitD&, unsigned (&v)[2][2]) const { offs_direct(v, D_ / 2, false); }
    __device__ __forceinline__ void vb(unsigned (&v)[2][2]) const { offs_direct(v, D_ / 2, true); }
};
struct EpiTailQ {
    float* O;
    __device__ __forceinline__ void operator()(const Acc& acc, const UnitD& u, int wr, int wc, int fr, int fq) const { store_f32_tile(acc, O + ((size_t)u.t1 * T_ + (size_t)u.t0 * BM) * 64, nullptr, 64, 64, wr, wc, fr, fq, 1.0f / W8_SCALE); }
};
__device__ __forceinline__ void phase_gemm_in1(const Args& a, LAS unsigned char* lds) {
    SrcGrid S{(const char*)(a.ws + WS_H8), (const char*)(a.ws + WS_WIN1T), (size_t)BM * D_, (size_t)BM * D_, 64, 64 * 48, D_ / 2, D_ / 2};
    EpiProj E{(bf16_t*)(a.ws + WS_PROJ), N_IN1P, nullptr, 64, 48, 48, 64, 1.0f / W8_SCALE};
    gemm_stream<false, true>(lds, S, D_ / 128, E);
}
__device__ __forceinline__ void phase_gemm_in1_tail(const Args& a, LAS unsigned char* lds) {
    SrcIn1Tail S{(const char*)(a.ws + WS_H8), (const char*)(a.ws + WS_WIN1T)};
    EpiTailQ E{(float*)(a.ws + WS_O)};
    int nt = 4; asm volatile("" : "+s"(nt));
    gemm_stream<false, true>(lds, S, nt, E);
}

__device__ __forceinline__ void phase_gdn_conv(const Args& a) {
    const bf16_t* p1 = (const bf16_t*)(a.ws + WS_PROJ); bf16_t* qc = (bf16_t*)(a.ws + WS_QKVC); const float* cw = a.in[16];
    const int gtid = BID * NTHREADS + TIDX, gsz = NBLK * NTHREADS;
    for (int it = gtid; it < 1024 * (T_ / 128); it += gsz) { const int c = (it & 1023) * 8, seg = it >> 10; const size_t t0 = (size_t)seg * 128;
        float w[4][8];
#pragma unroll
        for (int k = 0; k < 4; ++k) { const f32x4 w0 = *(const f32x4*)(cw + k * 8192 + c), w1 = *(const f32x4*)(cw + k * 8192 + c + 4);
            w[k][0] = w0[0]; w[k][1] = w0[1]; w[k][2] = w0[2]; w[k][3] = w0[3]; w[k][4] = w1[0]; w[k][5] = w1[1]; w[k][6] = w1[2]; w[k][7] = w1[3]; }
        u32x4 x0 = (u32x4){0u, 0u, 0u, 0u}, x1 = x0, x2 = x0;
        if ((t0 & (S_ - 1)) != 0) { x0 = *(const u32x4*)(p1 + (t0 - 3) * N_IN1P + c); x1 = *(const u32x4*)(p1 + (t0 - 2) * N_IN1P + c); x2 = *(const u32x4*)(p1 + (t0 - 1) * N_IN1P + c); }
        const float qsc = c < 2048 ? 0.08838834764831845f : 1.0f;
        u32x4 xa[8];
#pragma unroll
        for (int j = 0; j < 8; ++j) xa[j] = *(const u32x4*)(p1 + (t0 + j) * N_IN1P + c);
#pragma unroll 1
        for (int r0 = 0; r0 < 128; r0 += 8) { u32x4 xb[8];
#pragma unroll
            for (int j = 0; j < 8; ++j) xb[j] = xa[j];
            if (r0 + 8 < 128) {
#pragma unroll
                for (int j = 0; j < 8; ++j) xb[j] = *(const u32x4*)(p1 + (t0 + r0 + 8 + j) * N_IN1P + c); }
#pragma unroll
          for (int j8 = 0; j8 < 8; ++j8) { const u32x4 x3 = xa[j8]; const int r = r0 + j8;
            float acc[8];
#define TAPS(j, f, m) (w[0][j] * f(x0.m) + w[1][j] * f(x1.m) + w[2][j] * f(x2.m) + w[3][j] * f(x3.m))
            acc[0] = TAPS(0, bf_lo, x); acc[1] = TAPS(1, bf_hi, x); acc[2] = TAPS(2, bf_lo, y); acc[3] = TAPS(3, bf_hi, y);
            acc[4] = TAPS(4, bf_lo, z); acc[5] = TAPS(5, bf_hi, z); acc[6] = TAPS(6, bf_lo, w); acc[7] = TAPS(7, bf_hi, w);
#undef TAPS
            float ss = 0.f;
#pragma unroll
            for (int j = 0; j < 8; ++j) { acc[j] = siluf_(acc[j]); ss += acc[j] * acc[j]; }
            ss = row16_sum(ss);
            const float sc = c < 4096 ? rsqrtf(ss + 1e-6f) * qsc : 1.0f;
            u32x4 o; o.x = cvt_pk_bf16(acc[0] * sc, acc[1] * sc); o.y = cvt_pk_bf16(acc[2] * sc, acc[3] * sc); o.z = cvt_pk_bf16(acc[4] * sc, acc[5] * sc); o.w = cvt_pk_bf16(acc[6] * sc, acc[7] * sc);
            *(u32x4*)(qc + (t0 + r) * 8192 + c) = o;
            x0 = x1; x1 = x2; x2 = x3; }
#pragma unroll
            for (int j = 0; j < 8; ++j) xa[j] = xb[j]; } }
    const float* tail = (const float*)(a.ws + WS_O); float* bgo = (float*)(a.ws + WS_BG);
    for (int it = gtid; it < T_ * 32; it += gsz) { const int t = it >> 5, hv = it & 31; float tb = 0.f, ta = 0.f;
#pragma unroll
        for (int kq = 0; kq < 4; ++kq) { tb += tail[((size_t)kq * T_ + t) * 64 + hv]; ta += tail[((size_t)kq * T_ + t) * 64 + 32 + hv]; }
        bgo[t * 64 + hv] = sigmoidf_(tb);
        bgo[t * 64 + 32 + hv] = -__expf(a.in[17][hv]) * softplusf_(ta + a.in[18][hv]); }
}

struct MoeTile { const float* src; unsigned char* dst; int lds_, ldd; };
__device__ __forceinline__ MoeTile moe_tile(const Args& a, int g) {
    const int job = g >> 14, r = g & 16383, e = r >> 8, rr = r & 255; MoeTile t;
    typedef __attribute__((address_space(1))) const float* gcf; gcf s25 = (gcf)a.in[25], s26 = (gcf)a.in[26]; asm volatile("" : "+s"(s25), "+s"(s26));
    if (job < 2) { const int ik = rr >> 3, in = rr & 7; t.lds_ = DEXP; t.ldd = D_;
        t.src = (const float*)(job ? s26 : s25) + ((size_t)(NEXP + e) * D_ + ik * 64) * DEXP + in * 64; t.dst = a.ws + (job ? WS_WU : WS_WG) + ((size_t)e * DEXP + in * 64) * D_ + ik * 64; }
    else { const int ik = rr >> 5, in = rr & 31; t.lds_ = D_; t.ldd = DEXP;
        t.src = a.in[27] + ((size_t)(NEXP + e) * DEXP + ik * 64) * D_ + in * 64; t.dst = a.ws + WS_WD + ((size_t)e * D_ + in * 64) * DEXP + ik * 64; }
    return t;
}
__device__ __forceinline__ void moe_tile_load(const MoeTile& t, int tid, f32x4 (&v)[2]) {
#pragma unroll
    for (int i = 0; i < 2; ++i) { const int idx = tid + i * 512, rr = idx >> 4, c4 = (idx & 15) * 4; v[i] = *(const f32x4*)(t.src + (size_t)rr * t.lds_ + c4); }
}
__device__ __forceinline__ void moe_tile_store(const MoeTile& t, int tid, const f32x4 (&v)[2], LAS float* tile) {
#pragma unroll
    for (int i = 0; i < 2; ++i) { const int idx = tid + i * 512, rr = idx >> 4, c4 = (idx & 15) * 4;
        tile[rr * 65 + c4 + 0] = v[i][0]; tile[rr * 65 + c4 + 1] = v[i][1]; tile[rr * 65 + c4 + 2] = v[i][2]; tile[rr * 65 + c4 + 3] = v[i][3]; }
    LDS_BARRIER();
    { const int n = tid >> 3, kg = (tid & 7) * 8; float f[8];
#pragma unroll
      for (int jj = 0; jj < 8; ++jj) f[jj] = tile[(kg + jj) * 65 + n] * W8_SCALE;
      u32x2 w; w.x = pk_fp8x4(f[0], f[1], f[2], f[3]); w.y = pk_fp8x4(f[4], f[5], f[6], f[7]);
      *(u32x2*)(t.dst + (size_t)n * t.ldd + kg) = w; }
    LDS_BARRIER();
}
constexpr int MOE_TILES = 3 * NEXP * 256;

__device__ __forceinline__ f32x4 mfma16(s16x4 a, s16x4 b, f32x4 c) { return __builtin_amdgcn_mfma_f32_16x16x16bf16_1k(a, b, c, 0, 0, 0); }
__device__ __forceinline__ s16x4 pack4(const f32x4& v) { u32x2 w; w.x = cvt_pk_bf16(v[0], v[1]); w.y = cvt_pk_bf16(v[2], v[3]); return __builtin_bit_cast(s16x4, w); }
__device__ __forceinline__ void phase_gdn_chunk(const Args& a, LAS unsigned char* lds) {
    const bf16_t* qc = (const bf16_t*)(a.ws + WS_QKVC); const float* bgi = (const float*)(a.ws + WS_BG); bf16_t* O = (bf16_t*)(a.ws + WS_O);
    constexpr int VRS = 144, KTRS = 136;
    constexpr int KT = 0, QS = KT + 128 * KTRS, WSL = QS + 64 * RSB, QKS = WSL + 64 * RSB, EE = QKS + 2048, EDD = EE + 256, SET = EDD + 256;
    constexpr int STL = 2 * SET, KS = STL + 64 * RSB, VS = KS + 64 * RSB, X2 = VS + 64 * VRS, LS = X2 + 2048, X1 = LS + 4096, GAM = X1 + 2048, BET = GAM + 256, LEND = BET + 256;
    static_assert(LEND <= LDS_XBW, "gdn lds");
    const int wid = __builtin_amdgcn_readfirstlane(TIDX >> 6);
    const int NCK = S_ / 64;
    for (int blk = BID; blk < NB_ * 32 * 2; blk += NBLK) {
        const int grp = (blk & 7) * 8 + (blk >> 5), mem = (blk >> 3) & 3, b = grp >> 4, hk = grp & 15, hv = 2 * hk + (mem >> 1), vhalf = mem & 1;
        __syncthreads();
        if (wid < 4) {
            const int vt = wid;
            f32x4 Sacc[8];
#pragma unroll
            for (int n = 0; n < 8; ++n) Sacc[n] = (f32x4){0.f, 0.f, 0.f, 0.f};
            { const int lane = TIDX & 63;
              for (int i = lane; i < 16 * RSB / 16; i += 64) *(LAS u32x4*)(lds + STL + 16 * vt * RSB + i * 16) = (u32x4){0u, 0u, 0u, 0u}; }
            int lz = TIDX & 63; asm volatile("" : "+v"(lz));
            const int lane = lz, I = lane & 15, G = lane >> 4, q4 = I >> 2, p4 = I & 3;
            for (int it = 0; it <= NCK; ++it) {
                const int set = ((it - 1) & 1) * SET; const size_t t0 = (size_t)b * S_ + (size_t)(it - 1) * 64;
                f32x4 U[4];
                if (it >= 1) {
#pragma unroll
                    for (int sa = 0; sa < 4; ++sa) U[sa] = mfma16(*(const LAS s16x4*)(lds + X2 + ((sa * 16 + I) * 16 + 4 * G) * 2), lds_tr4(lds + VS + (16 * sa + 4 * G + q4) * VRS + (16 * vt + 4 * p4) * 2), (f32x4){0.f, 0.f, 0.f, 0.f});
                    asm volatile("" : "+v"(U[0]), "+v"(U[1]), "+v"(U[2]), "+v"(U[3]) :: "memory");
                }
                LDS_BARRIER();
#pragma unroll
                for (int sa = 0; sa < 4; ++sa) {
                    if (it >= 1) {
                        bf16x8 sf[4];
#pragma unroll
                        for (int ks = 0; ks < 4; ++ks) sf[ks] = lds_frag(lds + STL + (16 * vt + I) * RSB + (32 * ks + 8 * G) * 2);
                        s16x4 kt[8];
#pragma unroll
                        for (int dt = 0; dt < 8; ++dt) kt[dt] = *(const LAS s16x4*)(lds + set + KT + (16 * dt + I) * KTRS + (16 * sa + 4 * G) * 2);
                        f32x4 dl = U[sa], oq = (f32x4){0.f, 0.f, 0.f, 0.f}, dl2 = oq, oq2 = oq;
#pragma unroll
                        for (int ks = 0; ks < 2; ++ks) { dl = mfma32(lds_frag(lds + set + WSL + (16 * sa + I) * RSB + (32 * ks + 8 * G) * 2), sf[ks], dl);
                            dl2 = mfma32(lds_frag(lds + set + WSL + (16 * sa + I) * RSB + (32 * (ks + 2) + 8 * G) * 2), sf[ks + 2], dl2);
                            oq = mfma32(lds_frag(lds + set + QS + (16 * sa + I) * RSB + (32 * ks + 8 * G) * 2), sf[ks], oq);
                            oq2 = mfma32(lds_frag(lds + set + QS + (16 * sa + I) * RSB + (32 * (ks + 2) + 8 * G) * 2), sf[ks + 2], oq2); }
                        dl += dl2; oq += oq2;
                        const s16x4 dfrag = pack4(dl);
                        const f32x4 e4 = *(const LAS f32x4*)(lds + set + EE + (16 * sa + 4 * G) * 4);
                        oq = mfma16(*(const LAS s16x4*)(lds + set + QKS + ((sa * 16 + I) * 16 + 4 * G) * 2), dfrag, oq * e4);
#pragma unroll
                        for (int r = 0; r < 4; ++r) O[(t0 + 16 * sa + 4 * G + r) * 4096 + hv * 128 + vhalf * 64 + 16 * vt + I] = f2bf(oq[r]);
                        const f32x4 ed4 = *(const LAS f32x4*)(lds + set + EDD + (16 * sa + 4 * G) * 4); const float e15 = *(const LAS float*)(lds + set + EE + (16 * sa + 15) * 4);
                        const s16x4 dsc = pack4(dl * ed4);
#pragma unroll
                        for (int dt = 0; dt < 8; ++dt) {
                            Sacc[dt] = mfma16(kt[dt], dsc, Sacc[dt] * e15);
                            *(LAS s16x4*)(lds + STL + (16 * vt + I) * RSB + (16 * dt + 4 * G) * 2) = pack4(Sacc[dt]); }
                    }
                    if (sa & 1) LDS_BARRIER();
                }
            }
        } else {
            const int pw = wid - 4;
            u32x4 pq[4], pk[4], pv[2]; float pb = 0.f, pg = 0.f;
            { const int ptid = TIDX - 256; const size_t t0 = (size_t)b * S_;
#pragma unroll
              for (int i = 0; i < 4; ++i) { const int c = ptid + i * 256, s2 = c >> 4, c8 = (c & 15) * 8; pq[i] = *(const u32x4*)(qc + (t0 + s2) * 8192 + hk * 128 + c8); pk[i] = *(const u32x4*)(qc + (t0 + s2) * 8192 + 2048 + hk * 128 + c8); }
#pragma unroll
              for (int i = 0; i < 2; ++i) { const int c = ptid + i * 256, s2 = c >> 3, c8 = (c & 7) * 8; pv[i] = *(const u32x4*)(qc + (t0 + s2) * 8192 + 4096 + hv * 128 + vhalf * 64 + c8); }
              if (pw == 1) { pb = bgi[(t0 + ptid - 64) * 64 + hv]; pg = bgi[(t0 + ptid - 64) * 64 + 32 + hv]; } }
            int lz = TIDX & 63; asm volatile("" : "+v"(lz));
            const int lane = lz, ptid = pw * 64 + lane, I = lane & 15, G = lane >> 4, q4 = I >> 2, p4 = I & 3;
            for (int it = 0; it <= NCK; ++it) {
                const int set = (it & 1) * SET; const bool act = it < NCK;
                if (act) {
#pragma unroll
                    for (int i = 0; i < 4; ++i) { const int c = ptid + i * 256, s2 = c >> 4, c8 = (c & 15) * 8; *(LAS u32x4*)(lds + set + QS + s2 * RSB + c8 * 2) = pq[i]; *(LAS u32x4*)(lds + KS + s2 * RSB + c8 * 2) = pk[i]; }
                    if (pw == 1) { float x = pg;
                        x += __builtin_bit_cast(float, __builtin_amdgcn_update_dpp(0, __builtin_bit_cast(int, x), 0x111, 0xf, 0xf, true));
                        x += __builtin_bit_cast(float, __builtin_amdgcn_update_dpp(0, __builtin_bit_cast(int, x), 0x112, 0xf, 0xf, true));
                        x += __builtin_bit_cast(float, __builtin_amdgcn_update_dpp(0, __builtin_bit_cast(int, x), 0x114, 0xf, 0xf, true));
                        x += __builtin_bit_cast(float, __builtin_amdgcn_update_dpp(0, __builtin_bit_cast(int, x), 0x118, 0xf, 0xf, true));
                        const float g15 = __shfl(x, 15, 16);
                        *(LAS float*)(lds + GAM + lane * 4) = x; *(LAS float*)(lds + set + EE + lane * 4) = __expf(x); *(LAS float*)(lds + set + EDD + lane * 4) = __expf(g15 - x); *(LAS float*)(lds + BET + lane * 4) = pb; }
                    if (it + 1 < NCK) { const size_t t1 = (size_t)b * S_ + (size_t)(it + 1) * 64;
#pragma unroll
                        for (int i = 0; i < 4; ++i) { const int c = ptid + i * 256, s2 = c >> 4, c8 = (c & 15) * 8; pq[i] = *(const u32x4*)(qc + (t1 + s2) * 8192 + hk * 128 + c8); pk[i] = *(const u32x4*)(qc + (t1 + s2) * 8192 + 2048 + hk * 128 + c8); }
                        if (pw == 1) { pb = bgi[(t1 + ptid - 64) * 64 + hv]; pg = bgi[(t1 + ptid - 64) * 64 + 32 + hv]; } }
                }
                LDS_BARRIER();
                if (act) { const int sa = pw;
#pragma unroll
                    for (int i = 0; i < 2; ++i) { const int c = ptid + i * 256, s2 = c >> 3, c8 = (c & 7) * 8; *(LAS u32x4*)(lds + VS + s2 * VRS + c8 * 2) = pv[i]; }
                    if (it + 1 < NCK) { const size_t t1 = (size_t)b * S_ + (size_t)(it + 1) * 64;
#pragma unroll
                        for (int i = 0; i < 2; ++i) { const int c = ptid + i * 256, s2 = c >> 3, c8 = (c & 7) * 8; pv[i] = *(const u32x4*)(qc + (t1 + s2) * 8192 + 4096 + hv * 128 + vhalf * 64 + c8); } }
#pragma unroll
                    for (int ty = 0; ty < 2; ++ty) { f32x4 acc = (f32x4){0.f, 0.f, 0.f, 0.f};
#pragma unroll
                        for (int ks = 0; ks < 4; ++ks) { const bf16x8 ka = lds_frag(lds + KS + (16 * sa + I) * RSB + (32 * ks + 8 * G) * 2);
                            const bf16x8 bo = ty ? lds_frag(lds + set + QS + (16 * sa + I) * RSB + (32 * ks + 8 * G) * 2) : ka; acc = mfma32(ka, bo, acc); }
                        const f32x4 gr = *(const LAS f32x4*)(lds + GAM + (16 * sa + 4 * G) * 4); const float gc = *(const LAS float*)(lds + GAM + (16 * sa + I) * 4);
                        if (ty == 0) { const f32x4 br = *(const LAS f32x4*)(lds + BET + (16 * sa + 4 * G) * 4);
#pragma unroll
                            for (int r = 0; r < 4; ++r) { const float val = br[r] * acc[r] * __expf(gr[r] - gc); *(LAS float*)(lds + LS + ((sa * 16 + 4 * G + r) * 16 + I) * 4) = (I < 4 * G + r) ? val : 0.f; } }
                        else { f32x4 o;
#pragma unroll
                            for (int r = 0; r < 4; ++r) { const float val = acc[r] * __expf(gc - gr[r]); o[r] = (4 * G + r <= I) ? val : 0.f; }
                            *(LAS s16x4*)(lds + set + QKS + ((sa * 16 + I) * 16 + 4 * G) * 2) = pack4(o); } } }
                LDS_BARRIER();
                if (act) { const int sa = pw, c = lane >> 2, q = lane & 3;
                    f32x4 lv[16];
#pragma unroll
                    for (int i = 0; i < 16; ++i) lv[i] = *(const LAS f32x4*)(lds + LS + ((sa * 16 + i) * 16 + 4 * q) * 4);
                    float xo[4] = {0.f, 0.f, 0.f, 0.f}, xw[4] = {0.f, 0.f, 0.f, 0.f};
#pragma unroll
                    for (int i = 0; i < 16; ++i) {
                        float p = lv[i][0] * xo[0] + lv[i][1] * xo[1] + lv[i][2] * xo[2] + lv[i][3] * xo[3];
                        p += dpp_f<0xB1>(p); p += dpp_f<0x4E>(p);
                        const float xi = ((i == c) ? 1.0f : 0.0f) - p;
                        xo[i & 3] = (q == (i >> 2)) ? xi : xo[i & 3];
                        xw[i >> 2] = (q == (i & 3)) ? xi : xw[i >> 2]; }
                    const float bc = *(const LAS float*)(lds + BET + (sa * 16 + c) * 4), sc1 = -bc * *(const LAS float*)(lds + set + EE + (sa * 16 + c) * 4);
#pragma unroll
                    for (int k = 0; k < 4; ++k) { const int i = 4 * k + q; *(LAS bf16_t*)(lds + X1 + ((sa * 16 + i) * 16 + c) * 2) = f2bf(xw[k] * sc1); *(LAS bf16_t*)(lds + X2 + ((sa * 16 + i) * 16 + c) * 2) = f2bf(xw[k] * bc); } }
                asm volatile("" ::: "memory");
                if (act) { const int sa = pw;
                    const s16x4 xb = *(const LAS s16x4*)(lds + X1 + ((sa * 16 + I) * 16 + 4 * G) * 2); s16x4 kt[8]; f32x4 w[8];
#pragma unroll
                    for (int dt = 0; dt < 8; ++dt) kt[dt] = lds_tr4(lds + KS + (16 * sa + 4 * G + q4) * RSB + (16 * dt + 4 * p4) * 2);
#pragma unroll
                    for (int dt = 0; dt < 8; ++dt) { w[dt] = mfma16(kt[dt], xb, (f32x4){0.f, 0.f, 0.f, 0.f}); *(LAS s16x4*)(lds + set + KT + (16 * dt + I) * KTRS + (16 * sa + 4 * G) * 2) = kt[dt]; }
#pragma unroll
                    for (int dt = 0; dt < 8; ++dt) *(LAS s16x4*)(lds + set + WSL + (16 * sa + I) * RSB + (16 * dt + 4 * G) * 2) = pack4(w[dt]); }
                LDS_BARRIER();
            }
        }
    }
}

constexpr int N_PHASES = 30;
__global__ void __launch_bounds__(NTHREADS, 2) fwd(Args a0) {
    extern __shared__ __attribute__((aligned(16))) unsigned char smem_raw[];
    LAS unsigned char* lds = (LAS unsigned char*)smem_raw;
    volatile LAS unsigned* xbw = (volatile LAS unsigned*)(lds + LDS_XBW);
    if (TIDX == 0) { xbw[0] = 0u; xbw[1] = 0u; xbw[2] = 0u; xbw[3] = 0u; }
    __syncthreads();
    XcdBarrier bar = xcd_barrier_post((unsigned*)(a0.ws + WS_CTL), xbw);
#ifndef PHMASK
#define PHMASK 0xFFFFFFFFull
#endif
#ifndef DUPMASK
#define DUPMASK 0ull
#endif
#define PH(i, body) do { if (((PHMASK >> (i)) & 1ull) && a0.ph_lo <= (i) && (i) < a0.ph_hi) { __attribute__((address_space(1))) unsigned char* wsp_ = (__attribute__((address_space(1))) unsigned char*)a0.ws; asm volatile("" : "+s"(wsp_)); Args a = a0; a.ws = (unsigned char*)wsp_; const float* xin = a.in[0]; const float* xw = (const float*)(a.ws + WS_X); (void)xin; (void)xw; \
        if ((DUPMASK >> (i)) & 1ull) { body; xcd_barrier(bar); } body; if ((i) + 1 < a0.ph_hi) xcd_barrier(bar); } } while (0)
    PH(0, { phase_prologue(a, lds); __syncthreads(); NORM_PH(0, true)(a, xin, a.in[1], -1); });
    PH(2, phase_gemm_in0(a, lds));
    PH(3, { phase_rg_conv(a); __syncthreads(); phase_hg1(a, lds); });
    PH(4, { phase_rg_gates(a, lds); __syncthreads(); phase_hg2(a); });
    PH(5, { phase_rg_scan(a, lds); __syncthreads(); phase_hg3(a, lds); });
    PH(9, phase_gemm_out<false>(a, lds, D_, a.ws + WS_WOUT0T, xin));
    PH(10, NORM_PH(0, false)(a, nullptr, a.in[2], 0));
    PH(11, phase_gemm_router(a, lds, 0));
    PH(12, phase_route(a, 0));
    PH(13, phase_rowmap(a, lds, 0));
    PH(14, phase_moe_up(a, lds, 0));
    PH(15, phase_moe_down(a, lds, 0));
    PH(16, { NORM_PH(1, false)(a, nullptr, a.in[1] + D_, 0); __syncthreads(); moe_weight_jobs(a, 1, lds); });
    PH(18, { phase_gemm_in1(a, lds); phase_gemm_in1_tail(a, lds); });
    PH(19, phase_gdn_conv(a));
    PH(20, phase_gdn_chunk(a, lds));
    PH(21, phase_gdn_norm(a));
    PH(22, phase_gemm_out<true>(a, lds, 4096, a.ws + WS_WOUT1T, nullptr));
    PH(23, NORM_PH(0, false)(a, nullptr, a.in[2] + D_, 1));
    PH(24, phase_gemm_router(a, lds, 1));
    PH(25, phase_route(a, 1));
    PH(26, phase_rowmap(a, lds, 1));
    PH(27, phase_moe_up(a, lds, 1));
    PH(28, phase_moe_down(a, lds, 1));
    PH(29, NORM_PH(2, false)(a, nullptr, a.in[3], 1));
#undef PH
}

extern "C" void kernel_launch(void* const* d_in, const int* in_sizes, int n_in, void* d_out, int out_size, void* d_ws, size_t ws_size, hipStream_t stream) {
    static int grid = 0;
    if (grid == 0) {
        if (n_in != 28 || ws_size < WS_END) { fprintf(stderr, "kernel_launch: need 28 inputs and %zu bytes of workspace, got %d / %zu\n", (size_t)WS_END, n_in, ws_size); grid = -1; return; }
        int dev = 0, cus = 0, per_cu = 0;
        if (hipGetDevice(&dev) != hipSuccess || hipDeviceGetAttribute(&cus, hipDeviceAttributeMultiprocessorCount, dev) != hipSuccess) { grid = -1; return; }
        if (hipFuncSetAttribute((const void*)fwd, hipFuncAttributeMaxDynamicSharedMemorySize, LDS_BYTES) != hipSuccess) { fprintf(stderr, "kernel_launch: hipFuncSetAttribute failed\n"); grid = -1; return; }
        if (hipOccupancyMaxActiveBlocksPerMultiprocessor(&per_cu, (const void*)fwd, NTHREADS, LDS_BYTES) != hipSuccess || per_cu < 1) { fprintf(stderr, "kernel_launch: occupancy query says %d\n", per_cu); }
        (void)hipGetLastError();
        grid = cus;
    }
    if (grid < 0) return;
    (void)in_sizes; (void)out_size;
    hipMemsetAsync((char*)d_ws + WS_CTL, 0, CTL_BYTES, stream);
    Args a; memset(&a, 0, sizeof(a));
    for (int i = 0; i < 28; ++i) a.in[i] = (const float*)d_in[i];
    a.out = (float*)d_out; a.ws = (unsigned char*)d_ws;
#if N_LAUNCH_MODE == 1
    a.ph_lo = 0; a.ph_hi = N_PHASES;
    hipLaunchKernelGGL(fwd, dim3(grid), dim3(NTHREADS), LDS_BYTES, stream, a);
#if EXTRA_PH >= 0
    a.ph_lo = EXTRA_PH; a.ph_hi = EXTRA_PH + 1;
    hipLaunchKernelGGL(fwd, dim3(grid), dim3(NTHREADS), LDS_BYTES, stream, a);
#endif
#else
    for (int p = 0; p < N_PHASES; ++p) { a.ph_lo = p; a.ph_hi = p + 1; hipLaunchKernelGGL(fwd, dim3(grid), dim3(NTHREADS), LDS_BYTES, stream, a); }
#endif
}
```

```cpp
#include <hip/hip_runtime.h>
#include <stdint.h>
#include <stdio.h>
#include <string.h>

#ifndef EXTRA_PH
#define EXTRA_PH -1
#endif
#ifndef N_LAUNCH_MODE
#define N_LAUNCH_MODE 1
#endif

#define LAS __attribute__((address_space(3)))
typedef unsigned short bf16_t;
typedef short bf16x8 __attribute__((ext_vector_type(8)));
typedef float f32x4 __attribute__((ext_vector_type(4)));
typedef float f32x2 __attribute__((ext_vector_type(2)));
typedef unsigned u32x4 __attribute__((ext_vector_type(4)));
typedef unsigned u32x2 __attribute__((ext_vector_type(2)));

constexpr int T_ = 16384, D_ = 2048, S_ = 4096, NB_ = 4;
constexpr int N_IN0 = 6144, N_IN1 = 12352, N_IN1P = 12544;
constexpr int NEXP = 64, DEXP = 512, MPAD = 49152;
constexpr int NTHREADS = 512;
constexpr int LDS_MAIN = 131072;
constexpr int LDS_BYTES = 163840;
constexpr int LDS_XBW = LDS_BYTES - 16;

constexpr size_t al256(size_t x) { return (x + 255) & ~(size_t)255; }
constexpr size_t WS_CTL = 0;
constexpr size_t CTL_BYTES = 65536;
constexpr size_t CTL_CNT = 16384;
constexpr size_t WS_LB = WS_CTL + CTL_BYTES;
constexpr size_t WS_TINFO = WS_LB + 4096;
constexpr size_t WS_WIN0T = WS_TINFO + 4096;
constexpr size_t WS_WOUT0T = WS_WIN0T + (size_t)N_IN0 * D_ * 2;
constexpr size_t WS_WIN1T = WS_WOUT0T + (size_t)D_ * D_ * 2;
constexpr size_t WS_WOUT1T = WS_WIN1T + (size_t)N_IN1P * D_ * 2;
constexpr size_t WS_WGATES = WS_WOUT1T + (size_t)D_ * 4096 * 2;
constexpr size_t WS_WRT = WS_WGATES + (size_t)8 * 256 * 256 * 2;
constexpr size_t WS_WG = WS_WRT + (size_t)2 * 256 * D_ * 2;
constexpr size_t WS_WU = WS_WG + (size_t)NEXP * DEXP * D_ * 2;
constexpr size_t WS_WD = WS_WU + (size_t)NEXP * DEXP * D_ * 2;
constexpr size_t WS_X = WS_WD + (size_t)NEXP * DEXP * D_ * 2;
constexpr size_t WS_H = WS_X + (size_t)T_ * D_ * 4;
constexpr size_t WS_PROJ = WS_H + (size_t)T_ * D_ * 2;
constexpr size_t PROJ_BYTES = (size_t)T_ * N_IN1P * 2;
constexpr size_t WS_FLOG = WS_PROJ + (size_t)T_ * N_IN0 * 2;
constexpr size_t WS_XC = WS_FLOG + (size_t)T_ * 1024 * 4;
constexpr size_t WS_ACT = WS_PROJ;
constexpr size_t WS_YMOE = WS_ACT + (size_t)MPAD * DEXP * 2;
constexpr size_t WS_R1 = WS_PROJ + PROJ_BYTES;
constexpr size_t WS_A = WS_R1;
constexpr size_t WS_U = WS_R1 + (size_t)T_ * 1024 * 4;
constexpr size_t WS_QKVC = WS_R1;
constexpr size_t WS_Y = WS_R1 + (size_t)T_ * 8192 * 2;
constexpr size_t WS_O = WS_Y + (size_t)T_ * 4096 * 2;
constexpr size_t WS_TAIL = WS_O + (size_t)T_ * 4096 * 4;
constexpr size_t WS_BG = WS_TAIL + (size_t)T_ * 64 * 4;
constexpr size_t WS_LOGITS = WS_BG + (size_t)T_ * 64 * 4;
constexpr size_t WS_EID = WS_LOGITS + (size_t)T_ * 128 * 4;
constexpr size_t WS_SLOT = WS_EID + (size_t)T_ * 2 * 4;
constexpr size_t WS_GATE = WS_SLOT + (size_t)T_ * 2 * 4;
constexpr size_t WS_POSOF = WS_GATE + (size_t)T_ * 2 * 4;
constexpr size_t WS_ROWMAP = WS_POSOF + (size_t)T_ * 2 * 4;
constexpr size_t WS_H8 = WS_ROWMAP + (size_t)MPAD * 4;
constexpr size_t WS_RSP = WS_H8 + (size_t)T_ * D_;
constexpr size_t WS_RSTD = WS_RSP + (size_t)T_ * 32 * 4;
constexpr size_t WS_END = WS_RSTD + (size_t)T_ * 4;
static_assert(WS_YMOE + (size_t)MPAD * D_ * 2 <= WS_R1, "moe overlay");
static_assert(WS_XC + (size_t)T_ * 1024 * 2 <= WS_R1, "layer0 overlay");

struct Args {
    const float* in[28];
    float* out;
    unsigned char* ws;
    int ph_lo, ph_hi;
};

__device__ __forceinline__ int tidx_() { int t = (int)threadIdx.x; asm volatile("" : "+v"(t)); return t; }
#define TIDX tidx_()
typedef __bf16 bf16x2n __attribute__((ext_vector_type(2)));
__device__ __forceinline__ unsigned cvt_pk_bf16(float lo, float hi) { const f32x2 v = {lo, hi}; return __builtin_bit_cast(unsigned, __builtin_convertvector(v, bf16x2n)); }
__device__ __forceinline__ unsigned pk_fp8x4(float a, float b, float c, float d) { int v = __builtin_amdgcn_cvt_pk_fp8_f32(a, b, 0, false); v = __builtin_amdgcn_cvt_pk_fp8_f32(c, d, v, true); return (unsigned)v; }
constexpr float W8_SCALE = 64.0f, ACT8_SCALE = 8.0f;
__device__ __forceinline__ bf16_t f2bf(float x) { return (bf16_t)(cvt_pk_bf16(x, 0.f) & 0xffffu); }
__device__ __forceinline__ float bf_lo(unsigned w) { return __uint_as_float(w << 16); }
__device__ __forceinline__ float bf_hi(unsigned w) { return __uint_as_float(w & 0xffff0000u); }
__device__ __forceinline__ float bf1(bf16_t v) { return __uint_as_float(((unsigned)v) << 16); }
__device__ __forceinline__ float sigmoidf_(float x) { return __builtin_amdgcn_rcpf(1.0f + __expf(-x)); }
__device__ __forceinline__ float siluf_(float x) { return x * __builtin_amdgcn_rcpf(1.0f + __expf(-x)); }
__device__ __forceinline__ float softplusf_(float x) { return x > 20.f ? x : log1pf(__expf(x)); }
__device__ __forceinline__ float gelu_tanh(float x) { const float u = 0.7978845608028654f * (x + 0.044715f * x * x * x); return x * __builtin_amdgcn_rcpf(1.0f + __expf(-2.0f * u)); }
template <int CTRL> __device__ __forceinline__ float dpp_f(float v) { return __builtin_bit_cast(float, __builtin_amdgcn_update_dpp(0, __builtin_bit_cast(int, v), CTRL, 0xf, 0xf, false)); }
__device__ __forceinline__ float row16_sum(float s) { s += dpp_f<0x140>(s); s += dpp_f<0x141>(s); s += dpp_f<0xB1>(s); s += dpp_f<0x4E>(s); return s; }
__device__ __forceinline__ float wave_sum(float v) { v = row16_sum(v); v += __shfl_xor(v, 16); v += __shfl_xor(v, 32); return v; }

#define LDS_BARRIER() do { asm volatile("s_waitcnt lgkmcnt(0)" ::: "memory"); __builtin_amdgcn_s_barrier(); asm volatile("" ::: "memory"); } while (0)
#define XB_TMO      128
#define XB_XCNT(j)  (256  + 64 * (j))
#define XB_XSUB(j)  (1280 + 64 * (j))
#define XB_XGEN(j)  (2304 + 64 * (j))
#define XB_TOP      3328
#define XB_TOPGEN   3392
#define XCD_BAR_WORDS 3456
#define XB_SPIN_CAP (1u << 18)

__device__ __forceinline__ unsigned xb_ld(unsigned* p)              { return __hip_atomic_load(p, __ATOMIC_RELAXED, __HIP_MEMORY_SCOPE_AGENT); }
__device__ __forceinline__ unsigned xb_add(unsigned* p, unsigned v) { return __hip_atomic_fetch_add(p, v, __ATOMIC_RELAXED, __HIP_MEMORY_SCOPE_AGENT); }
__device__ __forceinline__ unsigned xb_xcc_id() { return (unsigned)__builtin_amdgcn_s_getreg((3 << 11) | 20) & 0xFu; }
#define XB_SPIN(cond, bar) do { unsigned _sp = 0; while (cond) { __builtin_amdgcn_s_sleep(1); \
    if ((++_sp & 255u) == 0u) { if (xb_ld(&(bar)[XB_TMO])) break; if (_sp > XB_SPIN_CAP) { atomicAdd(&(bar)[XB_TMO], 1u); break; } } } } while (0)

struct XcdBarrier { unsigned* bar; unsigned x; volatile LAS unsigned* st; };

__device__ __forceinline__ XcdBarrier xcd_barrier_post(unsigned* bar, volatile LAS unsigned* st) {
    XcdBarrier b; b.bar = bar; b.x = xb_xcc_id(); b.st = st;
    if (TIDX == 0) (void)xb_add(&bar[XB_XCNT(b.x)], 1u);
    return b;
}
__device__ __forceinline__ void xcd_barrier_complete(unsigned* bar, unsigned x, unsigned& nloc, unsigned& nx) {
    const unsigned G = gridDim.x * gridDim.y * gridDim.z;
    unsigned sum, cnt, mine, sp = 0u;
    for (;;) {
        sum = 0u; cnt = 0u; mine = 0u;
#pragma unroll
        for (unsigned j = 0; j < 16; ++j) { const unsigned c = xb_ld(&bar[XB_XCNT(j)]); sum += c; cnt += (c > 0u) ? 1u : 0u; mine = (j == x) ? c : mine; }
        if (sum == G) break;
        __builtin_amdgcn_s_sleep(1);
        if ((++sp & 255u) == 0u) { if (xb_ld(&bar[XB_TMO])) break; if (sp > XB_SPIN_CAP) { atomicAdd(&bar[XB_TMO], 1u); break; } }
    }
    nloc = mine > 0u ? mine : 1u; nx = cnt > 0u ? cnt : 1u;
}
__device__ __forceinline__ void xcd_barrier(const XcdBarrier& b) {
    asm volatile("s_waitcnt vmcnt(0)" ::: "memory");
    __syncthreads();
    if (TIDX == 0) {
        unsigned* bar = b.bar;
        __builtin_amdgcn_s_waitcnt(0);
        unsigned nloc = b.st[0], nx = b.st[1];
        if (nloc == 0u) { xcd_barrier_complete(bar, b.x, nloc, nx); b.st[0] = nloc; b.st[1] = nx; }
        const unsigned old = xb_add(&bar[XB_XSUB(b.x)], 1u);
        const unsigned gen = old / nloc;
        if (old + 1u == (gen + 1u) * nloc) {
            __builtin_amdgcn_fence(__ATOMIC_RELEASE, "agent");
            asm volatile("s_waitcnt vmcnt(0)" ::: "memory");
            const unsigned og = xb_add(&bar[XB_TOP], 1u);
            const unsigned tg = og / nx;
            if (og + 1u == (tg + 1u) * nx) xb_add(&bar[XB_TOPGEN], 1u);
            else XB_SPIN(xb_ld(&bar[XB_TOPGEN]) == tg, bar);
            __builtin_amdgcn_fence(__ATOMIC_ACQUIRE, "agent");
            xb_add(&bar[XB_XGEN(b.x)], 1u);
            asm volatile("s_waitcnt vmcnt(0)" ::: "memory");
        } else {
            XB_SPIN(xb_ld(&bar[XB_XGEN(b.x)]) == gen, bar);
            __builtin_amdgcn_fence(__ATOMIC_ACQUIRE, "agent");
            asm volatile("s_waitcnt vmcnt(0)" ::: "memory");
        }
    }
    __syncthreads();
}

constexpr int BM = 256, BK = 64, HALF = 128, HTB = HALF * BK * 2;
__device__ __forceinline__ int lds_byte(int r, int c) { const int st = (r >> 4) * 2 + (c >> 5), rr = r & 15, cc = c & 31, ob = rr * 64 + cc * 2; return st * 1024 + (ob ^ (((ob >> 9) & 1) << 5)); }
__device__ __forceinline__ void stage_rc(int b, int& R, int& C) { const int st = b / 1024, sb = b % 1024, swz = sb ^ (((sb >> 9) & 1) << 5); R = (st >> 1) * 16 + swz / 64; C = (st & 1) * 32 + (swz % 64) / 2; }
__device__ __forceinline__ int perm32(int rho) { const int n = rho >> 4, i = rho & 15; return 8 * (i >> 2) + 4 * n + (i & 3); }

__device__ __forceinline__ void stage_pos(int tid, int& R0, int& C0) { stage_rc(tid * 16, R0, C0); }
__device__ __forceinline__ int perm_row(int R) { return (R & ~31) + perm32(R & 31); }

#define BID ((int)blockIdx.x)
#define NBLK ((int)gridDim.x)
#define BID_ BID
#define NBLK_ NBLK
typedef f32x4 Acc[2][2][4][2];
struct UnitD { const char* gA; const char* gB; int t0, t1, t2; };

typedef int i32x8 __attribute__((ext_vector_type(8)));
typedef int i32x4 __attribute__((ext_vector_type(4)));
template <bool GATHER, bool FP8, class Src, class Epi>
__device__ __forceinline__ void gemm_stream(LAS unsigned char* lds, const Src& S, const int nt, const Epi& E) {
    const int tid = TIDX, wid = tid >> 6, lane = tid & 63, wr = wid >> 2, wc = wid & 3, fr = lane & 15, fq = lane >> 4;
    const unsigned ldsw = (unsigned)wid * 1024u;
    const int aoff = lds_byte(wr * 64 + fr, fq * 8), boff = lds_byte(wc * 32 + fr, fq * 8);
    const size_t kstep = (size_t)(BK * 2);
#define G_SA(b, h) (((b) * 2 + (h)) * HTB)
#define G_SB(b, h) ((4 + (b) * 2 + (h)) * HTB)
#define G_STAGE(bufoff, gbase, v) do { _Pragma("unroll") for (int _i = 0; _i < 2; ++_i) \
        __builtin_amdgcn_global_load_lds((const unsigned*)((gbase) + (v)[_i]), (LAS unsigned*)(lds + (bufoff) + ldsw + _i * 8192), 16, 0, 0); } while (0)
#define G_LD8(p) __builtin_shufflevector(*(const LAS i32x4*)(p), *(const LAS i32x4*)((p) + 1024), 0, 1, 2, 3, 4, 5, 6, 7)
#define G_LDA(dst, b, h) do { _Pragma("unroll") for (int m = 0; m < 4; ++m) dst[m] = G_LD8(lds + G_SA(b, h) + aoff + m * 2048); } while (0)
#define G_LDB(dst, b, h) do { _Pragma("unroll") for (int n = 0; n < 2; ++n) dst[n] = G_LD8(lds + G_SB(b, h) + boff + n * 2048); } while (0)
#define G_HALF(x, k) __builtin_bit_cast(bf16x8, __builtin_shufflevector((x), (x), 4 * (k), 4 * (k) + 1, 4 * (k) + 2, 4 * (k) + 3))
#define G_MMA(ai, bj, At, Bt) do { __builtin_amdgcn_s_setprio(1); _Pragma("unroll") for (int m = 0; m < 4; ++m) _Pragma("unroll") for (int n = 0; n < 2; ++n) { \
        if (FP8) asm volatile("v_mfma_f32_16x16x128_f8f6f4 %0, %1, %2, %0" : "+v"(acc[ai][bj][m][n]) : "v"(Bt[n]), "v"(At[m]));   \
        else { acc[ai][bj][m][n] = __builtin_amdgcn_mfma_f32_16x16x32_bf16(G_HALF(Bt[n], 0), G_HALF(At[m], 0), acc[ai][bj][m][n], 0, 0, 0); \
               acc[ai][bj][m][n] = __builtin_amdgcn_mfma_f32_16x16x32_bf16(G_HALF(Bt[n], 1), G_HALF(At[m], 1), acc[ai][bj][m][n], 0, 0, 0); } } \
        __builtin_amdgcn_s_setprio(0); } while (0)
#define G_WAIT_V(n) asm volatile("s_waitcnt vmcnt(" #n ")" ::: "memory")
#define G_WAIT_L(n) asm volatile("s_waitcnt lgkmcnt(" #n ")" ::: "memory")
#define G_BAR __builtin_amdgcn_s_barrier()
#define G_SCHED __builtin_amdgcn_sched_barrier(0)
    UnitD cur, nxt; int ui = 0;
    if (!S.next(0, cur)) return;
    unsigned va[2][2], vb[2][2], van[2][2];
    S.vb(vb); S.va(cur, va);
    Acc acc;
#pragma unroll
    for (int a = 0; a < 2; ++a)
#pragma unroll
        for (int b = 0; b < 2; ++b)
#pragma unroll
            for (int m = 0; m < 4; ++m)
#pragma unroll
                for (int n = 0; n < 2; ++n) acc[a][b][m][n] = (f32x4){0.f, 0.f, 0.f, 0.f};
    i32x8 At[4], B0[2], B1[2];
    const char* cA = cur.gA; const char* cB = cur.gB;
    G_WAIT_V(0);
    __syncthreads();
    G_STAGE(G_SB(0, 0), cB, vb[0]); G_STAGE(G_SA(0, 0), cA, va[0]); G_STAGE(G_SB(0, 1), cB, vb[1]); G_STAGE(G_SA(0, 1), cA, va[1]);
    if (wr == 1) G_BAR;
    G_WAIT_V(4); G_BAR;
    G_STAGE(G_SB(1, 0), cB + kstep, vb[0]); G_STAGE(G_SA(1, 0), cA + kstep, va[0]); G_STAGE(G_SB(1, 1), cB + kstep, vb[1]);
    G_WAIT_V(6); G_BAR;
    for (;;) {
        const bool has_next = S.next(ui + 1, nxt);
        const char* nA = has_next ? nxt.gA : cA; const char* nB = has_next ? nxt.gB : cB;
        if (GATHER) { if (has_next) S.va(nxt, van); else { van[0][0] = va[0][0]; van[0][1] = va[0][1]; van[1][0] = va[1][0]; van[1][1] = va[1][1]; } }
#pragma unroll 1
        for (int t = 0; t < nt; t += 2) {
            const bool last = (t == nt - 2);
            const char* a1 = cA + (size_t)(t + 1) * kstep;
            const char* a2 = last ? nA : cA + (size_t)(t + 2) * kstep; const char* b2 = last ? nB : cB + (size_t)(t + 2) * kstep;
            const char* a3 = a2 + kstep; const char* b3 = b2 + kstep;
            unsigned v2[2][2];
#pragma unroll
            for (int hh = 0; hh < 2; ++hh)
#pragma unroll
                for (int i = 0; i < 2; ++i) v2[hh][i] = (GATHER && last) ? van[hh][i] : va[hh][i];
            G_LDB(B0, 0, 0); G_SCHED; G_LDA(At, 0, 0); G_STAGE(G_SA(1, 1), a1, va[1]);
            G_WAIT_L(8); G_BAR; G_WAIT_L(0); G_MMA(0, 0, At, B0); G_BAR; G_SCHED;
            G_LDB(B1, 0, 1); G_STAGE(G_SB(0, 0), b2, vb[0]);
            G_BAR; G_WAIT_L(0); G_MMA(0, 1, At, B1); G_BAR;
            G_LDA(At, 0, 1); G_STAGE(G_SA(0, 0), a2, v2[0]);
            G_BAR; G_WAIT_L(0); G_MMA(1, 0, At, B0); G_BAR; G_SCHED;
            G_STAGE(G_SB(0, 1), b2, vb[1]);
            G_WAIT_V(6); G_BAR; G_MMA(1, 1, At, B1); G_BAR;
            G_LDB(B0, 1, 0); G_SCHED; G_LDA(At, 1, 0); G_STAGE(G_SA(0, 1), a2, v2[1]);
            G_WAIT_L(8); G_BAR; G_WAIT_L(0); G_MMA(0, 0, At, B0); G_BAR; G_SCHED;
            G_LDB(B1, 1, 1); G_STAGE(G_SB(1, 0), b3, vb[0]);
            G_BAR; G_WAIT_L(0); G_MMA(0, 1, At, B1); G_BAR;
            G_LDA(At, 1, 1); G_STAGE(G_SA(1, 0), a3, v2[0]);
            G_BAR; G_WAIT_L(0); G_MMA(1, 0, At, B0); G_BAR; G_SCHED;
            G_STAGE(G_SB(1, 1), b3, vb[1]);
            G_WAIT_V(6); G_BAR; G_MMA(1, 1, At, B1); G_BAR;
        }
        if (FP8) asm volatile("s_nop 15\n\ts_nop 15" ::: "memory");
        { int tz = TIDX; asm volatile("" : "+v"(tz));
          const int wid2 = tz >> 6, lane2 = tz & 63; E(acc, cur, wid2 >> 2, wid2 & 3, lane2 & 15, lane2 >> 4); }
        if (!has_next) break;
#pragma unroll
        for (int a = 0; a < 2; ++a)
#pragma unroll
            for (int b = 0; b < 2; ++b)
#pragma unroll
                for (int m = 0; m < 4; ++m)
#pragma unroll
                    for (int n = 0; n < 2; ++n) acc[a][b][m][n] = (f32x4){0.f, 0.f, 0.f, 0.f};
        cur = nxt; cA = nA; cB = nB; ++ui;
        if (GATHER) { va[0][0] = van[0][0]; va[0][1] = van[0][1]; va[1][0] = van[1][0]; va[1][1] = van[1][1]; }
    }
    G_WAIT_V(0);
    if (wr == 0) G_BAR;
    G_BAR;
#undef G_SA
#undef G_SB
#undef G_STAGE
#undef G_LDA
#undef G_LDB
#undef G_MMA
#undef G_LD8
#undef G_HALF
#undef G_WAIT_V
#undef G_WAIT_L
#undef G_BAR
#undef G_SCHED
}

__device__ __forceinline__ void offs_direct(unsigned (&v)[2][2], int ld, bool perm) {
    int R0, C0; stage_pos(TIDX, R0, C0);
#pragma unroll
    for (int i = 0; i < 2; ++i) { const int R = R0 + 64 * i, Rr = perm ? perm_row(R) : R;
        v[0][i] = (unsigned)(Rr * ld + C0) * 2u; v[1][i] = (unsigned)((Rr + HALF) * ld + C0) * 2u; }
}

struct SrcGrid {
    const char* A; const char* B; size_t astep, bstep; int nM, total, lda, ldb;
    __device__ __forceinline__ bool next(int i, UnitD& u) const { const int id = BID_ + i * NBLK_; if (id >= total) return false; u.t0 = id % nM; u.t1 = id / nM; u.t2 = 0;
        u.gA = A + (size_t)u.t0 * astep; u.gB = B + (size_t)u.t1 * bstep; return true; }
    __device__ __forceinline__ void va(const UnitD&, unsigned (&v)[2][2]) const { offs_direct(v, lda, false); }
    __device__ __forceinline__ void vb(unsigned (&v)[2][2]) const { offs_direct(v, ldb, true); }
};

__device__ __forceinline__ void store_bf16_tile(const Acc& acc, bf16_t* O, int ld, int wr, int wc, int fr, int fq, const float sc = 1.0f) {
#pragma unroll
    for (int ai = 0; ai < 2; ++ai)
#pragma unroll
        for (int m = 0; m < 4; ++m) { bf16_t* rowp = O + (size_t)(ai * HALF + wr * 64 + m * 16 + fr) * ld + wc * 32 + 8 * fq;
#pragma unroll
            for (int bj = 0; bj < 2; ++bj) { const f32x4 v0 = acc[ai][bj][m][0] * sc, v1 = acc[ai][bj][m][1] * sc;
                u32x4 w; w.x = cvt_pk_bf16(v0[0], v0[1]); w.y = cvt_pk_bf16(v0[2], v0[3]); w.z = cvt_pk_bf16(v1[0], v1[1]); w.w = cvt_pk_bf16(v1[2], v1[3]);
                *(u32x4*)(rowp + bj * HALF) = w; } }
}
__device__ __forceinline__ void store_f32_tile(const Acc& acc, float* O, const float* R, int ld, int ncol, int wr, int wc, int fr, int fq, const float sc = 1.0f) {
#pragma unroll
    for (int ai = 0; ai < 2; ++ai)
#pragma unroll
        for (int m = 0; m < 4; ++m) { const size_t ro = (size_t)(ai * HALF + wr * 64 + m * 16 + fr) * ld;
#pragma unroll
            for (int bj = 0; bj < 2; ++bj)
#pragma unroll
                for (int n = 0; n < 2; ++n) { const int c = bj * HALF + wc * 32 + 8 * fq + 4 * n; if (c >= ncol) continue;
                    f32x4 v = acc[ai][bj][m][n] * sc; if (R) v += *(const f32x4*)(R + ro + c); *(f32x4*)(O + ro + c) = v; } }
}
struct EpiProj {
    bf16_t* O; int ld; float* F; int fld, fp0, fp1, ncol; float sc;
    __device__ __forceinline__ void operator()(const Acc& acc, const UnitD& u, int wr, int wc, int fr, int fq) const {
        if (u.t1 >= fp0 && u.t1 < fp1) store_f32_tile(acc, F + (size_t)u.t0 * BM * fld + (u.t1 - fp0) * BM, nullptr, fld, ncol, wr, wc, fr, fq, sc);
        else store_bf16_tile(acc, O + (size_t)u.t0 * BM * ld + u.t1 * BM, ld, wr, wc, fr, fq, sc);
    }
};
struct EpiResid {
    unsigned char* ws; const float* Rf; float sc;
    __device__ __forceinline__ void row_done(float ss, const UnitD& u, int row, int wc, int fq) const {
        ss += __shfl_xor(ss, 16); ss += __shfl_xor(ss, 32);
        if (fq == 0) ((float*)(ws + WS_RSP))[(size_t)(u.t0 * BM + row) * 32 + u.t1 * 4 + wc] = ss; }
    __device__ __forceinline__ void operator()(const Acc& acc, const UnitD& u, int wr, int wc, int fr, int fq) const {
        const size_t o = (size_t)u.t0 * BM * D_ + u.t1 * BM;
        bf16_t* O = (bf16_t*)(ws + WS_X); const bf16_t* Rb = O;
        if (Rf) {
#pragma unroll
            for (int am = 0; am < 8; ++am) { const int ai = am >> 2, m = am & 3; f32x4 r0[2], r1[2];
                const size_t ro = o + (size_t)(ai * HALF + wr * 64 + m * 16 + fr) * D_ + wc * 32 + 8 * fq; float ss = 0.f;
#pragma unroll
                for (int bj = 0; bj < 2; ++bj) { r0[bj] = *(const f32x4*)(Rf + ro + bj * HALF); r1[bj] = *(const f32x4*)(Rf + ro + bj * HALF + 4); }
#pragma unroll
                for (int bj = 0; bj < 2; ++bj) { const f32x4 v0 = acc[ai][bj][m][0] * sc + r0[bj], v1 = acc[ai][bj][m][1] * sc + r1[bj];
                    u32x4 w; w.x = cvt_pk_bf16(v0[0], v0[1]); w.y = cvt_pk_bf16(v0[2], v0[3]); w.z = cvt_pk_bf16(v1[0], v1[1]); w.w = cvt_pk_bf16(v1[2], v1[3]);
                    *(u32x4*)(O + ro + bj * HALF) = w;
                    ss += v0[0] * v0[0] + v0[1] * v0[1] + v0[2] * v0[2] + v0[3] * v0[3] + v1[0] * v1[0] + v1[1] * v1[1] + v1[2] * v1[2] + v1[3] * v1[3]; }
                row_done(ss, u, ai * HALF + wr * 64 + m * 16 + fr, wc, fq); }
        } else {
#pragma unroll
            for (int am = 0; am < 4; ++am) { const int ai = am >> 1; u32x4 rr[2][2];
#pragma unroll
                for (int mm = 0; mm < 2; ++mm) { const int m = (am & 1) * 2 + mm; const size_t ro = o + (size_t)(ai * HALF + wr * 64 + m * 16 + fr) * D_ + wc * 32 + 8 * fq;
#pragma unroll
                    for (int bj = 0; bj < 2; ++bj) rr[mm][bj] = *(const u32x4*)(Rb + ro + bj * HALF); }
#pragma unroll
                for (int mm = 0; mm < 2; ++mm) { const int m = (am & 1) * 2 + mm; const size_t ro = o + (size_t)(ai * HALF + wr * 64 + m * 16 + fr) * D_ + wc * 32 + 8 * fq; float ss = 0.f;
#pragma unroll
                    for (int bj = 0; bj < 2; ++bj) { f32x4 v0 = acc[ai][bj][m][0] * sc, v1 = acc[ai][bj][m][1] * sc; const u32x4 r = rr[mm][bj];
                        v0[0] += bf_lo(r.x); v0[1] += bf_hi(r.x); v0[2] += bf_lo(r.y); v0[3] += bf_hi(r.y); v1[0] += bf_lo(r.z); v1[1] += bf_hi(r.z); v1[2] += bf_lo(r.w); v1[3] += bf_hi(r.w);
                        u32x4 w; w.x = cvt_pk_bf16(v0[0], v0[1]); w.y = cvt_pk_bf16(v0[2], v0[3]); w.z = cvt_pk_bf16(v1[0], v1[1]); w.w = cvt_pk_bf16(v1[2], v1[3]);
                        *(u32x4*)(O + ro + bj * HALF) = w;
                            ss += v0[0] * v0[0] + v0[1] * v0[1] + v0[2] * v0[2] + v0[3] * v0[3] + v1[0] * v1[0] + v1[1] * v1[1] + v1[2] * v1[2] + v1[3] * v1[3]; }
                    row_done(ss, u, ai * HALF + wr * 64 + m * 16 + fr, wc, fq); } }
        }
    }
};
struct EpiLogits {
    float* O;
    __device__ __forceinline__ void operator()(const Acc& acc, const UnitD& u, int wr, int wc, int fr, int fq) const { store_f32_tile(acc, O + (size_t)u.t0 * BM * 128, nullptr, 128, 128, wr, wc, fr, fq); }
};
struct EpiSwiGLU {
    unsigned char* O;
    __device__ __forceinline__ void operator()(const Acc& acc, const UnitD& u, int wr, int wc, int fr, int fq) const {
        unsigned char* o = O + (size_t)u.t0 * BM * DEXP + u.t1 * 128;
#pragma unroll
        for (int ai = 0; ai < 2; ++ai)
#pragma unroll
            for (int m = 0; m < 4; ++m) { unsigned char* rowp = o + (size_t)(ai * HALF + wr * 64 + m * 16 + fr) * DEXP + wc * 32 + 8 * fq;
                float r[8];
#pragma unroll
                for (int n = 0; n < 2; ++n)
#pragma unroll
                    for (int j = 0; j < 4; ++j) r[n * 4 + j] = (ACT8_SCALE / W8_SCALE) * siluf_(acc[ai][0][m][n][j] * (1.0f / W8_SCALE)) * acc[ai][1][m][n][j];
                u32x2 w; w.x = pk_fp8x4(r[0], r[1], r[2], r[3]); w.y = pk_fp8x4(r[4], r[5], r[6], r[7]);
                *(u32x2*)rowp = w; }
    }
};
struct EpiDown {
    unsigned char* O;
    __device__ __forceinline__ void operator()(const Acc& acc, const UnitD& u, int wr, int wc, int fr, int fq) const {
        unsigned char* o = O + (size_t)u.t0 * BM * D_ + u.t1 * BM; const float sc = 1.0f / (W8_SCALE * ACT8_SCALE);
#pragma unroll
        for (int ai = 0; ai < 2; ++ai)
#pragma unroll
            for (int m = 0; m < 4; ++m) { unsigned char* rowp = o + (size_t)(ai * HALF + wr * 64 + m * 16 + fr) * D_ + wc * 32 + 8 * fq;
#pragma unroll
                for (int bj = 0; bj < 2; ++bj) { const f32x4 v0 = acc[ai][bj][m][0] * sc, v1 = acc[ai][bj][m][1] * sc;
                    u32x2 w; w.x = pk_fp8x4(v0[0], v0[1], v0[2], v0[3]); w.y = pk_fp8x4(v1[0], v1[1], v1[2], v1[3]); *(u32x2*)(rowp + bj * HALF) = w; } }
    }
};
__device__ __forceinline__ unsigned rg_idx(unsigned tok, int c) { return ((((tok >> 12) * 64u + (unsigned)(c >> 4)) * (unsigned)S_ + (tok & (unsigned)(S_ - 1))) << 4) + (unsigned)(c & 15); }
struct EpiRgGates {
    bf16_t* LAo; bf16_t* Uo; const bf16_t* xc;
    const float* ba; const float* bx; const float* lam;
    __device__ __forceinline__ void operator()(const Acc& acc, const UnitD& u, int wr, int wc, int fr, int fq) const {
#pragma unroll
        for (int n = 0; n < 2; ++n) { const int c = u.t1 * 128 + wc * 32 + 8 * fq + 4 * n;
            u32x2 xq[2][4];
#pragma unroll
            for (int ai = 0; ai < 2; ++ai)
#pragma unroll
                for (int m = 0; m < 4; ++m) xq[ai][m] = *(const u32x2*)(xc + ((unsigned)(u.t0 * BM + ai * HALF + wr * 64 + m * 16 + fr) * 1024u + (unsigned)c));
            const f32x4 vba = *(const f32x4*)(ba + c), vbx = *(const f32x4*)(bx + c), vl = *(const f32x4*)(lam + c);
            f32x4 c8; for (int j = 0; j < 4; ++j) c8[j] = -8.0f * softplusf_(-vl[j]);
#pragma unroll
            for (int ai = 0; ai < 2; ++ai)
#pragma unroll
                for (int m = 0; m < 4; ++m) { const unsigned tok = (unsigned)(u.t0 * BM + ai * HALF + wr * 64 + m * 16 + fr);
                    const u32x2 xw = xq[ai][m]; const float xv[4] = {bf_lo(xw.x), bf_hi(xw.x), bf_lo(xw.y), bf_hi(xw.y)};
                    f32x4 lv, uv;
#pragma unroll
                    for (int j = 0; j < 4; ++j) { const float r = sigmoidf_(acc[ai][0][m][n][j] + vba[j]), ig = sigmoidf_(acc[ai][1][m][n][j] + vbx[j]);
                        const float la = c8[j] * r, av = __expf(la); lv[j] = la; uv[j] = __builtin_amdgcn_sqrtf(fmaxf(0.f, 1.0f - av * av)) * ig * xv[j]; }
                    const unsigned o = rg_idx(tok, c);
                    u32x2 w0; w0.x = cvt_pk_bf16(lv[0], lv[1]); w0.y = cvt_pk_bf16(lv[2], lv[3]); *(u32x2*)(LAo + o) = w0;
                    u32x2 w1; w1.x = cvt_pk_bf16(uv[0], uv[1]); w1.y = cvt_pk_bf16(uv[2], uv[3]); *(u32x2*)(Uo + o) = w1; } }
    }
};


__device__ __forceinline__ void transpose_job8(const float* src, unsigned char* dst, int K, int N, int ldd, size_t sb, size_t db, int nbatch, LAS unsigned char* lds, const float* kscale = nullptr) {
    const int tid = TIDX, tk = K / 128, tn = N / 64, per = tk * tn, total = per * nbatch;
    const int rr0 = tid >> 4, c4 = (tid & 15) * 4, n = tid >> 3, kg = (tid & 7) * 16;
    f32x4 va[4], vb[4];
#define T8_LD(v, t) { const int u_ = (t), ub_ = u_ / per, ur_ = u_ % per, uik_ = ur_ / tn, uin_ = ur_ % tn; const float* usp_ = src + (size_t)ub_ * sb + (size_t)(uik_ * 128 + rr0) * N + uin_ * 64 + c4; \
        _Pragma("unroll") for (int i = 0; i < 4; ++i) v[i] = *(const f32x4*)(usp_ + (size_t)(i * 32) * N); }
#define T8_ST(v, t, buf) { const int t_ = (t), b_ = t_ / per, r_ = t_ % per, ik_ = r_ / tn, in_ = r_ % tn; LAS float* tile = (LAS float*)(lds + (buf) * (128 * 65 * 4)); \
        _Pragma("unroll") for (int i = 0; i < 4; ++i) { const int rr = rr0 + i * 32; tile[rr * 65 + c4 + 0] = v[i][0]; tile[rr * 65 + c4 + 1] = v[i][1]; tile[rr * 65 + c4 + 2] = v[i][2]; tile[rr * 65 + c4 + 3] = v[i][3]; } \
        if (t_ + 2 * NBLK < total) T8_LD(v, t_ + 2 * NBLK) \
        LDS_BARRIER(); \
        float f[16]; \
        _Pragma("unroll") for (int j = 0; j < 16; ++j) f[j] = tile[(kg + j) * 65 + n] * W8_SCALE; \
        if (kscale) { _Pragma("unroll") for (int j4 = 0; j4 < 4; ++j4) { const f32x4 g4 = *(const f32x4*)(kscale + ik_ * 128 + kg + 4 * j4); f[4 * j4] *= g4[0]; f[4 * j4 + 1] *= g4[1]; f[4 * j4 + 2] *= g4[2]; f[4 * j4 + 3] *= g4[3]; } } \
        u32x4 w; w.x = pk_fp8x4(f[0], f[1], f[2], f[3]); w.y = pk_fp8x4(f[4], f[5], f[6], f[7]); w.z = pk_fp8x4(f[8], f[9], f[10], f[11]); w.w = pk_fp8x4(f[12], f[13], f[14], f[15]); \
        *(u32x4*)(dst + (size_t)b_ * db + (size_t)(in_ * 64 + n) * ldd + ik_ * 128 + kg) = w; }
    int t = BID;
    if (t < total) T8_LD(va, t)
    if (t + NBLK < total) T8_LD(vb, t + NBLK)
    for (; t < total; t += 2 * NBLK) {
        T8_ST(va, t, 0)
        if (t + NBLK < total) T8_ST(vb, t + NBLK, 1)
    }
#undef T8_LD
#undef T8_ST
    LDS_BARRIER();
}
__device__ __forceinline__ void transpose_job(const float* src, bf16_t* dst, int K, int N, int ldd, size_t sb, size_t db, int dalt, int nbatch, LAS unsigned char* lds) {
    const int tid = TIDX, tk = K / 64, tn = N / 64, per = tk * tn, total = per * nbatch;
    const int rr0 = tid >> 4, c4 = (tid & 15) * 4, n = tid >> 3, kg = (tid & 7) * 8;
    f32x4 va[2], vb[2];
#define T16_LD(v, t) { const int u_ = (t), ub_ = u_ / per, ur_ = u_ % per, uik_ = ur_ / tn, uin_ = ur_ % tn; const float* usp_ = src + (size_t)ub_ * sb + (size_t)(uik_ * 64 + rr0) * N + uin_ * 64 + c4; \
        _Pragma("unroll") for (int i = 0; i < 2; ++i) v[i] = *(const f32x4*)(usp_ + (size_t)(i * 32) * N); }
#define T16_ST(v, t, buf) { const int t_ = (t), b_ = t_ / per, r_ = t_ % per, ik_ = r_ / tn, in_ = r_ % tn; LAS float* tile = (LAS float*)(lds + (buf) * (64 * 65 * 4)); \
        _Pragma("unroll") for (int i = 0; i < 2; ++i) { const int rr = rr0 + i * 32; tile[rr * 65 + c4 + 0] = v[i][0]; tile[rr * 65 + c4 + 1] = v[i][1]; tile[rr * 65 + c4 + 2] = v[i][2]; tile[rr * 65 + c4 + 3] = v[i][3]; } \
        if (t_ + 2 * NBLK < total) T16_LD(v, t_ + 2 * NBLK) \
        LDS_BARRIER(); \
        float f[8]; \
        _Pragma("unroll") for (int j = 0; j < 8; ++j) f[j] = tile[(kg + j) * 65 + n]; \
        u32x4 w; w.x = cvt_pk_bf16(f[0], f[1]); w.y = cvt_pk_bf16(f[2], f[3]); w.z = cvt_pk_bf16(f[4], f[5]); w.w = cvt_pk_bf16(f[6], f[7]); \
        *(u32x4*)(dst + (size_t)b_ * db + (size_t)(b_ & 1) * dalt + (size_t)(in_ * 64 + n) * ldd + ik_ * 64 + kg) = w; }
    int t = BID;
    if (t < total) T16_LD(va, t)
    if (t + NBLK < total) T16_LD(vb, t + NBLK)
    for (; t < total; t += 2 * NBLK) {
        T16_ST(va, t, 0)
        if (t + NBLK < total) T16_ST(vb, t + NBLK, 1)
    }
#undef T16_LD
#undef T16_ST
    LDS_BARRIER();
}

__device__ __forceinline__ void moe_weight_jobs(const Args& a, int layer, LAS unsigned char* lds) {
    const size_t lo = (size_t)layer * NEXP * D_ * DEXP;
    transpose_job8(a.in[25] + lo, a.ws + WS_WG, D_, DEXP, D_, (size_t)D_ * DEXP, (size_t)DEXP * D_, NEXP, lds);
    transpose_job8(a.in[26] + lo, a.ws + WS_WU, D_, DEXP, D_, (size_t)D_ * DEXP, (size_t)DEXP * D_, NEXP, lds);
    transpose_job8(a.in[27] + lo, a.ws + WS_WD, DEXP, D_, DEXP, (size_t)D_ * DEXP, (size_t)DEXP * D_, NEXP, lds);
}

__device__ __forceinline__ void phase_prologue(const Args& a, LAS unsigned char* lds) {
    const int gtid = BID * NTHREADS + TIDX, gsz = NBLK * NTHREADS;
    for (int i = gtid; i < 1024; i += gsz) { const float l0 = a.in[12][i], l1 = a.in[12][1024 + i], mx = fmaxf(l0, l1), e0 = __expf(l0 - mx), e1 = __expf(l1 - mx);
        ((float*)(a.ws + WS_LB))[i] = e0 / (e0 + e1); }
    for (int it = gtid; it < 2 * 256 * 256; it += gsz) { const int l = it >> 16, n = (it >> 8) & 255, k8 = (it & 255) * 8; float f[8];
#pragma unroll
        for (int j = 0; j < 8; ++j) { const int k = k8 + j; f[j] = a.in[2][(size_t)l * D_ + k] * (n < 8 ? a.in[21][((size_t)l * D_ + k) * 8 + n] : (n < 72 ? a.in[23][((size_t)l * D_ + k) * 64 + (n - 8)] : 0.f)); }
        u32x4 w; w.x = cvt_pk_bf16(f[0], f[1]); w.y = cvt_pk_bf16(f[2], f[3]); w.z = cvt_pk_bf16(f[4], f[5]); w.w = cvt_pk_bf16(f[6], f[7]);
        *(u32x4*)((bf16_t*)(a.ws + WS_WRT) + ((size_t)l * 256 + n) * D_ + k8) = w; }
    for (int it = gtid; it < 192 * 128; it += gsz) *(u32x4*)(a.ws + WS_WIN1T + (size_t)N_IN1 * D_ + (size_t)it * 16) = (u32x4){0u, 0u, 0u, 0u};
    transpose_job(a.in[4], (bf16_t*)(a.ws + WS_WIN0T), D_, N_IN0, D_, 0, 0, 0, 1, lds);
    transpose_job(a.in[14], (bf16_t*)(a.ws + WS_WOUT0T), D_, D_, D_, 0, 0, 0, 1, lds);
    transpose_job8(a.in[15], a.ws + WS_WIN1T, D_, N_IN1, D_, 0, 0, 1, lds);
    transpose_job8(a.in[20], a.ws + WS_WOUT1T, 4096, D_, 4096, 0, 0, 1, lds);
    transpose_job(a.in[7], (bf16_t*)(a.ws + WS_WGATES), 128, 128, 128, 128 * 128, 256 * 128, 0, 8, lds);
    transpose_job(a.in[9], (bf16_t*)(a.ws + WS_WGATES) + 128 * 128, 128, 128, 128, 128 * 128, 256 * 128, 0, 8, lds);
    moe_weight_jobs(a, 0, lds);
}

#define NORM_PH(M, F) phase_norm<M, F>
template <int MODE, bool F32>
__device__ __forceinline__ void phase_norm(const Args& a, const float* src, const float* gain, int layer) {
    const int wid = TIDX >> 6, lane = TIDX & 63;
    bf16_t* xw = (bf16_t*)(a.ws + WS_X); bf16_t* hw = (bf16_t*)(a.ws + WS_H);
    const unsigned char* ym = a.ws + WS_YMOE; const int* posof = (const int*)(a.ws + WS_POSOF); const float* gate = (const float*)(a.ws + WS_GATE);
    const int stride = NBLK * 16;
    f32x4 rf[2][8]; u32x2 rb[2][8]; int pp[2][2] = {{0, 0}, {0, 0}}; float pg[2][2] = {{0.f, 0.f}, {0.f, 0.f}};
#define NORM_LD(r) { _Pragma("unroll") for (int u = 0; u < 2; ++u) { _Pragma("unroll") for (int i = 0; i < 8; ++i) { \
            if (F32) rf[u][i] = *(const f32x4*)(src + (size_t)((r) + u) * D_ + (i * 64 + lane) * 4); else rb[u][i] = *(const u32x2*)(xw + (size_t)((r) + u) * D_ + (i * 64 + lane) * 4); } \
            if (MODE >= 1) { pp[u][0] = posof[((r) + u) * 2]; pp[u][1] = posof[((r) + u) * 2 + 1]; pg[u][0] = gate[((r) + u) * 2]; pg[u][1] = gate[((r) + u) * 2 + 1]; } } }
    int row = (BID * 8 + wid) * 2;
    if (row < T_) NORM_LD(row)
    for (; row < T_; row += stride) {
        f32x4 v[2][8]; int p[2][2]; float g[2][2];
#pragma unroll
        for (int u = 0; u < 2; ++u) { p[u][0] = pp[u][0]; p[u][1] = pp[u][1]; g[u][0] = pg[u][0]; g[u][1] = pg[u][1];
#pragma unroll
            for (int i = 0; i < 8; ++i) v[u][i] = F32 ? rf[u][i] : (f32x4){bf_lo(rb[u][i].x), bf_hi(rb[u][i].x), bf_lo(rb[u][i].y), bf_hi(rb[u][i].y)}; }
        if (row + stride < T_) NORM_LD(row + stride)
        if (MODE >= 1) {
            int y[2][8][2];
#pragma unroll
            for (int u = 0; u < 2; ++u) {
#pragma unroll
                for (int i = 0; i < 8; ++i) { const int c = (i * 64 + lane) * 4; y[u][i][0] = *(const int*)(ym + (size_t)p[u][0] * D_ + c); y[u][i][1] = *(const int*)(ym + (size_t)p[u][1] * D_ + c); } }
#pragma unroll
            for (int u = 0; u < 2; ++u) { const float g0 = g[u][0], g1 = g[u][1];
#pragma unroll
                for (int i = 0; i < 8; ++i) { const int y0 = y[u][i][0], y1 = y[u][i][1];
                    const f32x2 a0 = __builtin_amdgcn_cvt_pk_f32_fp8(y0, false), a1 = __builtin_amdgcn_cvt_pk_f32_fp8(y0, true), b0 = __builtin_amdgcn_cvt_pk_f32_fp8(y1, false), b1 = __builtin_amdgcn_cvt_pk_f32_fp8(y1, true);
                    v[u][i][0] += g0 * a0[0] + g1 * b0[0]; v[u][i][1] += g0 * a0[1] + g1 * b0[1]; v[u][i][2] += g0 * a1[0] + g1 * b1[0]; v[u][i][3] += g0 * a1[1] + g1 * b1[1]; }
                if (MODE == 1) {
#pragma unroll
                    for (int i = 0; i < 8; ++i) { u32x2 w; w.x = cvt_pk_bf16(v[u][i][0], v[u][i][1]); w.y = cvt_pk_bf16(v[u][i][2], v[u][i][3]); *(u32x2*)(xw + (size_t)(row + u) * D_ + (i * 64 + lane) * 4) = w; } } }
        }
#pragma unroll
        for (int u = 0; u < 2; ++u) {
            float ss = 0.f;
#pragma unroll
            for (int i = 0; i < 8; ++i) ss += v[u][i][0] * v[u][i][0] + v[u][i][1] * v[u][i][1] + v[u][i][2] * v[u][i][2] + v[u][i][3] * v[u][i][3];
            ss = wave_sum(ss);
            const float rstd = rsqrtf(ss * (1.0f / D_) + 1e-6f);
#pragma unroll
            for (int i = 0; i < 8; ++i) { const int c = (i * 64 + lane) * 4; const f32x4 gn = *(const f32x4*)(gain + c);
                const f32x4 o = v[u][i] * rstd * gn;
                if (MODE == 2) *(f32x4*)(a.out + (size_t)(row + u) * D_ + c) = o;
                else { if (MODE != 1) { u32x2 w; w.x = cvt_pk_bf16(o[0], o[1]); w.y = cvt_pk_bf16(o[2], o[3]); *(u32x2*)(hw + (size_t)(row + u) * D_ + c) = w; }
                       if (layer >= 0) *(unsigned*)(a.ws + WS_H8 + (size_t)(row + u) * D_ + c) = pk_fp8x4(o[0], o[1], o[2], o[3]); } } }
    }
#undef NORM_LD
    (void)layer;
}

__device__ __forceinline__ void phase_gemm_in0(const Args& a, LAS unsigned char* lds) {
    SrcGrid S{(const char*)(a.ws + WS_H), (const char*)(a.ws + WS_WIN0T), (size_t)BM * D_ * 2, (size_t)BM * D_ * 2, 64, 64 * 24, D_, D_};
    EpiProj E{(bf16_t*)(a.ws + WS_PROJ), N_IN0, (float*)(a.ws + WS_FLOG), 1024, 12, 16, 256, 1.0f};
    gemm_stream<false, false>(lds, S, D_ / BK, E);
}

__device__ __forceinline__ void phase_rg_conv(const Args& a) {
    const bf16_t* p0 = (const bf16_t*)(a.ws + WS_PROJ); bf16_t* xc = (bf16_t*)(a.ws + WS_XC);
    const float* cw = a.in[5]; const float* cb = a.in[6];
    for (int it = BID * NTHREADS + TIDX; it < 128 * (T_ / 16); it += NBLK * NTHREADS) { const int c = (it & 127) * 8; const size_t t0 = (size_t)(it >> 7) * 16;
        float w[4][8], bias[8];
#pragma unroll
        for (int k = 0; k < 4; ++k) { const f32x4 w0 = *(const f32x4*)(cw + k * 1024 + c), w1 = *(const f32x4*)(cw + k * 1024 + c + 4);
            w[k][0] = w0[0]; w[k][1] = w0[1]; w[k][2] = w0[2]; w[k][3] = w0[3]; w[k][4] = w1[0]; w[k][5] = w1[1]; w[k][6] = w1[2]; w[k][7] = w1[3]; }
        { const f32x4 b0 = *(const f32x4*)(cb + c), b1 = *(const f32x4*)(cb + c + 4); bias[0] = b0[0]; bias[1] = b0[1]; bias[2] = b0[2]; bias[3] = b0[3]; bias[4] = b1[0]; bias[5] = b1[1]; bias[6] = b1[2]; bias[7] = b1[3]; }
        u32x4 x0 = (u32x4){0u, 0u, 0u, 0u}, x1 = x0, x2 = x0;
        if ((t0 & (S_ - 1)) != 0) { x0 = *(const u32x4*)(p0 + (t0 - 3) * N_IN0 + c); x1 = *(const u32x4*)(p0 + (t0 - 2) * N_IN0 + c); x2 = *(const u32x4*)(p0 + (t0 - 1) * N_IN0 + c); }
        u32x4 xr[16];
#pragma unroll
        for (int r = 0; r < 16; ++r) xr[r] = *(const u32x4*)(p0 + (t0 + r) * N_IN0 + c);
#pragma unroll
        for (int r = 0; r < 16; ++r) { const u32x4 x3 = xr[r];
            float acc[8];
#define TAPS(j, f, m) (bias[j] + w[0][j] * f(x0.m) + w[1][j] * f(x1.m) + w[2][j] * f(x2.m) + w[3][j] * f(x3.m))
            acc[0] = TAPS(0, bf_lo, x); acc[1] = TAPS(1, bf_hi, x); acc[2] = TAPS(2, bf_lo, y); acc[3] = TAPS(3, bf_hi, y);
            acc[4] = TAPS(4, bf_lo, z); acc[5] = TAPS(5, bf_hi, z); acc[6] = TAPS(6, bf_lo, w); acc[7] = TAPS(7, bf_hi, w);
#undef TAPS
            u32x4 o; o.x = cvt_pk_bf16(acc[0], acc[1]); o.y = cvt_pk_bf16(acc[2], acc[3]); o.z = cvt_pk_bf16(acc[4], acc[5]); o.w = cvt_pk_bf16(acc[6], acc[7]);
            *(u32x4*)(xc + (t0 + r) * 1024 + c) = o;
            x0 = x1; x1 = x2; x2 = x3; } }
}

struct SrcRgGates {
    const char* xc; const char* w; int total;
    __device__ __forceinline__ bool next(int i, UnitD& u) const { const int id = BID + i * NBLK; if (id >= total) return false; u.t0 = id & 63; u.t1 = id >> 6; u.t2 = 0;
        u.gA = xc + ((size_t)u.t0 * BM * 1024 + u.t1 * 128) * 2; u.gB = w + (size_t)u.t1 * 256 * 128 * 2; return true; }
    __device__ __forceinline__ void va(const UnitD&, unsigned (&v)[2][2]) const { offs_direct(v, 1024, false); }
    __device__ __forceinline__ void vb(unsigned (&v)[2][2]) const { offs_direct(v, 128, true); }
};
__device__ __forceinline__ void phase_rg_gates(const Args& a, LAS unsigned char* lds) {
    SrcRgGates S{(const char*)(a.ws + WS_XC), (const char*)(a.ws + WS_WGATES), 64 * 8};
    EpiRgGates E{(bf16_t*)(a.ws + WS_A), (bf16_t*)(a.ws + WS_U), (const bf16_t*)(a.ws + WS_XC), a.in[8], a.in[10], a.in[11]};
    int nt = 2; asm volatile("" : "+s"(nt));
    gemm_stream<false, false>(lds, S, nt, E);
}

__device__ __forceinline__ void phase_rg_scan(const Args& a, LAS unsigned char* lds) {
    const bf16_t* LA = (const bf16_t*)(a.ws + WS_A); const bf16_t* U = (const bf16_t*)(a.ws + WS_U);
    const bf16_t* p0 = (const bf16_t*)(a.ws + WS_PROJ); bf16_t* Y = (bf16_t*)(a.ws + WS_Y);
    LAS float* sP = (LAS float*)lds; LAS float* sH = sP + 4096; LAS float* gP = sH + 4096; LAS float* gH = gP + 512; LAS float* gC = gH + 512;
    const int tid = TIDX, seg = tid >> 1, c8 = (tid & 1) * 8;
    for (int blk = BID; blk < NB_ * 64; blk += NBLK) { const int b = blk >> 6, c = (blk & 63) * 16 + c8;
        const size_t base = (((size_t)blk * S_ + seg * 16) << 4) + c8;
        float P[8], H[8];
#pragma unroll
        for (int j = 0; j < 8; ++j) { P[j] = 1.f; H[j] = 0.f; }
#pragma unroll 4
        for (int s = 0; s < 16; ++s) { const u32x4 lw = *(const u32x4*)(LA + base + (size_t)s * 16), uw = *(const u32x4*)(U + base + (size_t)s * 16);
            const float la[8] = {bf_lo(lw.x), bf_hi(lw.x), bf_lo(lw.y), bf_hi(lw.y), bf_lo(lw.z), bf_hi(lw.z), bf_lo(lw.w), bf_hi(lw.w)};
            const float uu[8] = {bf_lo(uw.x), bf_hi(uw.x), bf_lo(uw.y), bf_hi(uw.y), bf_lo(uw.z), bf_hi(uw.z), bf_lo(uw.w), bf_hi(uw.w)};
#pragma unroll
            for (int j = 0; j < 8; ++j) { const float av = __expf(la[j]); H[j] = av * H[j] + uu[j]; P[j] *= av; } }
        __syncthreads();
#pragma unroll
        for (int j = 0; j < 8; ++j) { sP[seg * 16 + c8 + j] = P[j]; sH[seg * 16 + c8 + j] = H[j]; }
        __syncthreads();
        { const int ch = tid & 15, grp = tid >> 4; float p = 1.f, h = 0.f;
#pragma unroll
          for (int q = 0; q < 8; ++q) { const int sgi = grp * 8 + q; h = sP[sgi * 16 + ch] * h + sH[sgi * 16 + ch]; p *= sP[sgi * 16 + ch]; }
          gP[grp * 16 + ch] = p; gH[grp * 16 + ch] = h; }
        __syncthreads();
        if (tid < 16) { float carry = 0.f; for (int g = 0; g < 32; ++g) { gC[g * 16 + tid] = carry; carry = gP[g * 16 + tid] * carry + gH[g * 16 + tid]; } }
        __syncthreads();
        { const int ch = tid & 15, grp = tid >> 4; float h = gC[grp * 16 + ch];
#pragma unroll
          for (int q = 0; q < 8; ++q) { const int sgi = grp * 8 + q; const float pin = sP[sgi * 16 + ch], hin = sH[sgi * 16 + ch]; sH[sgi * 16 + ch] = h; h = pin * h + hin; } }
        __syncthreads();
#pragma unroll
        for (int j = 0; j < 8; ++j) H[j] = sH[seg * 16 + c8 + j];
        {
            u32x4 l_a[4], u_a[4], g_a[4];
#define RS_LD(Lv, Uv, Gv, s0) { _Pragma("unroll") for (int j = 0; j < 4; ++j) { const int s_ = (s0) + j; Lv[j] = *(const u32x4*)(LA + base + (size_t)s_ * 16); Uv[j] = *(const u32x4*)(U + base + (size_t)s_ * 16); \
                Gv[j] = *(const u32x4*)(p0 + ((size_t)b * S_ + seg * 16 + s_) * N_IN0 + 1024 + c); } }
            RS_LD(l_a, u_a, g_a, 0)
#pragma unroll
            for (int s0 = 0; s0 < 16; s0 += 4) { u32x4 l_b[4], u_b[4], g_b[4];
#pragma unroll
                for (int j = 0; j < 4; ++j) { l_b[j] = l_a[j]; u_b[j] = u_a[j]; g_b[j] = g_a[j]; }
                if (s0 + 4 < 16) RS_LD(l_b, u_b, g_b, s0 + 4)
#pragma unroll
                for (int j = 0; j < 4; ++j) { const u32x4 lw = l_a[j], uw = u_a[j], gw = g_a[j]; const size_t t = (size_t)b * S_ + seg * 16 + s0 + j;
                    const float la[8] = {bf_lo(lw.x), bf_hi(lw.x), bf_lo(lw.y), bf_hi(lw.y), bf_lo(lw.z), bf_hi(lw.z), bf_lo(lw.w), bf_hi(lw.w)};
                    const float uu[8] = {bf_lo(uw.x), bf_hi(uw.x), bf_lo(uw.y), bf_hi(uw.y), bf_lo(uw.z), bf_hi(uw.z), bf_lo(uw.w), bf_hi(uw.w)};
                    const float gg[8] = {bf_lo(gw.x), bf_hi(gw.x), bf_lo(gw.y), bf_hi(gw.y), bf_lo(gw.z), bf_hi(gw.z), bf_lo(gw.w), bf_hi(gw.w)};
                    float y[8];
#pragma unroll
                    for (int q = 0; q < 8; ++q) { H[q] = __expf(la[q]) * H[q] + uu[q]; y[q] = H[q] * gelu_tanh(gg[q]); }
                    u32x4 o; o.x = cvt_pk_bf16(y[0], y[1]); o.y = cvt_pk_bf16(y[2], y[3]); o.z = cvt_pk_bf16(y[4], y[5]); o.w = cvt_pk_bf16(y[6], y[7]);
                    *(u32x4*)(Y + t * D_ + c) = o; }
#pragma unroll
                for (int j = 0; j < 4; ++j) { l_a[j] = l_b[j]; u_a[j] = u_b[j]; g_a[j] = g_b[j]; } }
#undef RS_LD
        }
    }
}

typedef short s16x4 __attribute__((ext_vector_type(4)));
__device__ __forceinline__ f32x4 mfma32(bf16x8 a, bf16x8 b, f32x4 c) { return __builtin_amdgcn_mfma_f32_16x16x32_bf16(a, b, c, 0, 0, 0); }
__device__ __forceinline__ bf16x8 lds_frag(LAS const unsigned char* p) { return *(const LAS bf16x8*)p; }
__device__ __forceinline__ s16x4 lds_tr4(LAS const unsigned char* p) { return __builtin_amdgcn_ds_read_tr16_b64_v4i16((LAS s16x4*)p); }
__device__ __forceinline__ bf16x8 lds_tr8(LAS const unsigned char* p, int rowskip_bytes) {
    const s16x4 lo = lds_tr4(p), hi = lds_tr4(p + rowskip_bytes); return __builtin_shufflevector(lo, hi, 0, 1, 2, 3, 4, 5, 6, 7); }
__device__ __forceinline__ bf16x8 pack8(const f32x4& lo, const f32x4& hi) { u32x4 w; w.x = cvt_pk_bf16(lo[0], lo[1]); w.y = cvt_pk_bf16(lo[2], lo[3]); w.z = cvt_pk_bf16(hi[0], hi[1]); w.w = cvt_pk_bf16(hi[2], hi[3]); return __builtin_bit_cast(bf16x8, w); }
constexpr int RSB = 272;

constexpr size_t WS_HQ = WS_O;
constexpr size_t WS_HA = WS_HQ + (size_t)2048 * 64 * 128 * 2;
constexpr size_t WS_HG = WS_HA + (size_t)2048 * 8 * 512 * 2;
constexpr size_t WS_HS = WS_HG + (size_t)2048 * 128 * 128 * 2;
constexpr size_t WS_HD = WS_HS + (size_t)2048 * 128 * 128 * 2;
static_assert(WS_HD + (size_t)2048 * 128 * 4 <= WS_TAIL, "hgrn overlay");

__device__ __forceinline__ void phase_hg1(const Args& a, LAS unsigned char* lds) {
    const bf16_t* p0 = (const bf16_t*)(a.ws + WS_PROJ); const float* flog = (const float*)(a.ws + WS_FLOG); const float* lb = (const float*)(a.ws + WS_LB);
    bf16_t* QG = (bf16_t*)(a.ws + WS_HQ); bf16_t* AG = (bf16_t*)(a.ws + WS_HA); bf16_t* GG = (bf16_t*)(a.ws + WS_HG); float* DG = (float*)(a.ws + WS_HD);
    constexpr int SEG = 0, QT = 4096, KT = QT + 64 * RSB, KH = KT + 64 * RSB, VS = KH + 64 * RSB;
    const int tid = TIDX, wid = tid >> 6, lane = tid & 63, I = lane & 15, G = lane >> 4, k2 = 2 * lane, sg = wid;
    LAS float* seg = (LAS float*)(lds + SEG);
    u32x4 pvv[2]; f32x2 pz[8]; unsigned pqw[8];
#define HG1_LOAD(it_) do { const int bh_ = (it_) >> 6, ck_ = (it_) & 63, h_ = bh_ & 7; const size_t t0_ = (size_t)(bh_ >> 3) * S_ + ck_ * 64; \
        _Pragma("unroll") for (int i = 0; i < 2; ++i) { const int c = tid + i * 512, s_ = c >> 4, v8 = (c & 15) * 8; pvv[i] = *(const u32x4*)(p0 + (t0_ + s_) * N_IN0 + 4096 + h_ * 128 + v8); } \
        _Pragma("unroll") for (int i = 0; i < 8; ++i) { const size_t t_ = t0_ + sg * 8 + i; pz[i] = *(const f32x2*)(flog + t_ * 1024 + h_ * 128 + k2); pqw[i] = *(const unsigned*)(p0 + t_ * N_IN0 + 2048 + h_ * 128 + k2); } } while (0)
    if (BID < 2048) HG1_LOAD(BID);
    for (int item = BID; item < 2048; item += NBLK) { const int bh = item >> 6, h = bh & 7;
        LDS_BARRIER();
#pragma unroll
        for (int i = 0; i < 2; ++i) { const int c = tid + i * 512, s = c >> 4, v8 = (c & 15) * 8; *(LAS u32x4*)(lds + VS + s * RSB + v8 * 2) = pvv[i]; }
        const f32x2 l2 = *(const f32x2*)(lb + h * 128 + k2);
        float f[8][2], cb[8][2]; unsigned qw[8]; float c0 = 0.f, c1 = 0.f;
#pragma unroll
        for (int i = 0; i < 8; ++i) { const f32x2 z = pz[i]; qw[i] = pqw[i];
            f[i][0] = l2[0] + (1.0f - l2[0]) * sigmoidf_(z[0]); f[i][1] = l2[1] + (1.0f - l2[1]) * sigmoidf_(z[1]);
            c0 += __logf(f[i][0]); c1 += __logf(f[i][1]); cb[i][0] = c0; cb[i][1] = c1; }
        *(LAS f32x2*)(seg + sg * 128 + k2) = (f32x2){c0, c1};
        if (item + NBLK < 2048) HG1_LOAD(item + NBLK);
        LDS_BARRIER();
        float off0 = 0.f, off1 = 0.f, tot0 = 0.f, tot1 = 0.f;
#pragma unroll
        for (int s2 = 0; s2 < 8; ++s2) { const f32x2 v = *(const LAS f32x2*)(seg + s2 * 128 + k2); tot0 += v[0]; tot1 += v[1]; if (s2 < sg) { off0 += v[0]; off1 += v[1]; } }
        const float et0 = __expf(tot0), et1 = __expf(tot1);
#pragma unroll
        for (int i = 0; i < 8; ++i) { const int t = sg * 8 + i;
            const float e0 = __expf(cb[i][0] + off0), e1 = __expf(cb[i][1] + off1), r0 = __builtin_amdgcn_rcpf(e0), r1 = __builtin_amdgcn_rcpf(e1), km0 = 1.0f - f[i][0], km1 = 1.0f - f[i][1];
            const unsigned qt = cvt_pk_bf16(siluf_(bf_lo(qw[i])) * e0, siluf_(bf_hi(qw[i])) * e1);
            *(LAS unsigned*)(lds + QT + t * RSB + k2 * 2) = qt; *(unsigned*)(QG + ((size_t)item * 64 + t) * 128 + k2) = qt;
            *(LAS unsigned*)(lds + KT + t * RSB + k2 * 2) = cvt_pk_bf16(km0 * r0, km1 * r1);
            *(LAS unsigned*)(lds + KH + t * RSB + k2 * 2) = cvt_pk_bf16(km0 * r0 * et0, km1 * r1 * et1); }
        if (sg == 0) *(f32x2*)(DG + (size_t)item * 128 + k2) = (f32x2){et0, et1};
        LDS_BARRIER();
        { const int tt = wid & 3, sp = wid >> 2;
          bf16x8 qf[4];
#pragma unroll
          for (int ks = 0; ks < 4; ++ks) qf[ks] = lds_frag(lds + QT + (16 * tt + I) * RSB + (32 * ks + 8 * G) * 2);
          f32x4 acc[2];
#pragma unroll
          for (int hh = 0; hh < 2; ++hh) { const int st = 2 * sp + hh; acc[hh] = (f32x4){0.f, 0.f, 0.f, 0.f};
              if (st <= tt) {
#pragma unroll
                  for (int ks = 0; ks < 4; ++ks) acc[hh] = mfma32(lds_frag(lds + KT + (16 * st + I) * RSB + (32 * ks + 8 * G) * 2), qf[ks], acc[hh]);
#pragma unroll
                  for (int r = 0; r < 4; ++r) if (16 * st + 4 * G + r > 16 * tt + I) acc[hh][r] = 0.f; } }
          *(bf16x8*)(AG + (((size_t)item * 4 + tt) * 2 + sp) * 512 + lane * 8) = pack8(acc[0], acc[1]); }
        { const int kt = wid, q = I >> 2, p = I & 3;
          bf16x8 ka[2];
#pragma unroll
          for (int ks = 0; ks < 2; ++ks) ka[ks] = lds_tr8(lds + KH + (32 * ks + 8 * G + q) * RSB + (16 * kt + 4 * p) * 2, 4 * RSB);
#pragma unroll
          for (int vt = 0; vt < 8; ++vt) { f32x4 acc = (f32x4){0.f, 0.f, 0.f, 0.f};
#pragma unroll
              for (int ks = 0; ks < 2; ++ks) acc = mfma32(ka[ks], lds_tr8(lds + VS + (32 * ks + 8 * G + q) * RSB + (16 * vt + 4 * p) * 2, 4 * RSB), acc);
              u32x2 w; w.x = cvt_pk_bf16(acc[0], acc[1]); w.y = cvt_pk_bf16(acc[2], acc[3]);
              *(u32x2*)(GG + ((size_t)item * 128 + 16 * vt + I) * 128 + 16 * kt + 4 * G) = w; } }
    }
#undef HG1_LOAD
}

__device__ __forceinline__ void phase_hg2(const Args& a) {
    const bf16_t* GG = (const bf16_t*)(a.ws + WS_HG); const float* DG = (const float*)(a.ws + WS_HD); bf16_t* SG = (bf16_t*)(a.ws + WS_HS);
    for (int gid = BID * NTHREADS + TIDX; gid < 32 * 4096; gid += NBLK * NTHREADS) { const int bh = gid >> 12, e = gid & 4095, v = e >> 5, k4 = (e & 31) * 4;
        f32x4 S = (f32x4){0.f, 0.f, 0.f, 0.f};
        const size_t o0 = (((size_t)bh * 64) * 128 + v) * 128 + k4; const float* dg = DG + (size_t)bh * 64 * 128 + k4;
        f32x4 da[8]; u32x2 ga[8];
#pragma unroll
        for (int j = 0; j < 8; ++j) { da[j] = *(const f32x4*)(dg + j * 128); ga[j] = *(const u32x2*)(GG + o0 + (size_t)j * 16384); }
#pragma unroll 1
        for (int n0 = 0; n0 < 64; n0 += 8) { f32x4 db[8]; u32x2 gb[8];
#pragma unroll
            for (int j = 0; j < 8; ++j) { db[j] = da[j]; gb[j] = ga[j]; }
            if (n0 + 8 < 64) {
#pragma unroll
                for (int j = 0; j < 8; ++j) { db[j] = *(const f32x4*)(dg + (n0 + 8 + j) * 128); gb[j] = *(const u32x2*)(GG + o0 + (size_t)(n0 + 8 + j) * 16384); } }
#pragma unroll
            for (int j = 0; j < 8; ++j) { u32x2 w; w.x = cvt_pk_bf16(S[0], S[1]); w.y = cvt_pk_bf16(S[2], S[3]); *(u32x2*)(SG + o0 + (size_t)(n0 + j) * 16384) = w;
                const f32x4 d = da[j]; const u32x2 g = ga[j];
                S[0] = d[0] * S[0] + bf_lo(g.x); S[1] = d[1] * S[1] + bf_hi(g.x); S[2] = d[2] * S[2] + bf_lo(g.y); S[3] = d[3] * S[3] + bf_hi(g.y); }
#pragma unroll
            for (int j = 0; j < 8; ++j) { da[j] = db[j]; ga[j] = gb[j]; } } }
}

__device__ __forceinline__ void phase_hg3(const Args& a, LAS unsigned char* lds) {
    const bf16_t* p0 = (const bf16_t*)(a.ws + WS_PROJ); const bf16_t* QG = (const bf16_t*)(a.ws + WS_HQ); const bf16_t* AG = (const bf16_t*)(a.ws + WS_HA); const bf16_t* SG = (const bf16_t*)(a.ws + WS_HS);
    bf16_t* Y = (bf16_t*)(a.ws + WS_Y); const float* gain = a.in[13];
    constexpr int ST = 0, QT = 128 * RSB, VS = QT + 64 * RSB, PART = VS + 64 * RSB;
    const int tid = TIDX, wid = tid >> 6, lane = tid & 63, I = lane & 15, G = lane >> 4, q = I >> 2, p = I & 3;
    LAS float* part = (LAS float*)(lds + PART);
    const int tt = wid & 3, vh = wid >> 2;
    u32x4 ps[4], pq2[2], pv2[2]; bf16x8 paf[2];
#define HG3_LOAD(it_) do { const int bh_ = (it_) >> 6, ck_ = (it_) & 63; const size_t t0_ = (size_t)(bh_ >> 3) * S_ + ck_ * 64; const int h_ = bh_ & 7; \
        _Pragma("unroll") for (int i = 0; i < 4; ++i) { const int c = tid + i * 512, v = c >> 4, k8 = (c & 15) * 8; ps[i] = *(const u32x4*)(SG + ((size_t)(it_) * 128 + v) * 128 + k8); } \
        _Pragma("unroll") for (int i = 0; i < 2; ++i) { const int c = tid + i * 512, s_ = c >> 4, c8 = (c & 15) * 8; pq2[i] = *(const u32x4*)(QG + ((size_t)(it_) * 64 + s_) * 128 + c8); pv2[i] = *(const u32x4*)(p0 + (t0_ + s_) * N_IN0 + 4096 + h_ * 128 + c8); } \
        _Pragma("unroll") for (int sp = 0; sp < 2; ++sp) paf[sp] = *(const bf16x8*)(AG + (((size_t)(it_) * 4 + tt) * 2 + sp) * 512 + lane * 8); } while (0)
    if (BID < 2048) HG3_LOAD(BID);
    for (int item = BID; item < 2048; item += NBLK) { const int bh = item >> 6, ck = item & 63, b = bh >> 3, h = bh & 7; const size_t t0 = (size_t)b * S_ + ck * 64;
        LDS_BARRIER();
#pragma unroll
        for (int i = 0; i < 4; ++i) { const int c = tid + i * 512, v = c >> 4, k8 = (c & 15) * 8; *(LAS u32x4*)(lds + ST + v * RSB + k8 * 2) = ps[i]; }
#pragma unroll
        for (int i = 0; i < 2; ++i) { const int c = tid + i * 512, s2 = c >> 4, c8 = (c & 15) * 8; *(LAS u32x4*)(lds + QT + s2 * RSB + c8 * 2) = pq2[i]; *(LAS u32x4*)(lds + VS + s2 * RSB + c8 * 2) = pv2[i]; }
        bf16x8 af[2]; af[0] = paf[0]; af[1] = paf[1];
        if (item + NBLK < 2048) HG3_LOAD(item + NBLK);
        u32x2 zwp[4];
#pragma unroll
        for (int vi = 0; vi < 4; ++vi) zwp[vi] = *(const u32x2*)(p0 + (t0 + 16 * tt + I) * N_IN0 + 5120 + h * 128 + 16 * (4 * vh + vi) + 4 * G);
        LDS_BARRIER();
        bf16x8 qf[4];
#pragma unroll
        for (int ks = 0; ks < 4; ++ks) qf[ks] = lds_frag(lds + QT + (16 * tt + I) * RSB + (32 * ks + 8 * G) * 2);
        f32x4 acc[4]; float ss = 0.f;
#pragma unroll
        for (int vi = 0; vi < 4; ++vi) { const int vt = 4 * vh + vi; acc[vi] = (f32x4){0.f, 0.f, 0.f, 0.f};
#pragma unroll
            for (int ks = 0; ks < 4; ++ks) acc[vi] = mfma32(lds_frag(lds + ST + (16 * vt + I) * RSB + (32 * ks + 8 * G) * 2), qf[ks], acc[vi]);
#pragma unroll
            for (int sp = 0; sp < 2; ++sp) acc[vi] = mfma32(lds_tr8(lds + VS + (32 * sp + 4 * G + q) * RSB + (16 * vt + 4 * p) * 2, 16 * RSB), af[sp], acc[vi]);
            ss += acc[vi][0] * acc[vi][0] + acc[vi][1] * acc[vi][1] + acc[vi][2] * acc[vi][2] + acc[vi][3] * acc[vi][3]; }
        ss += __shfl_xor(ss, 16); ss += __shfl_xor(ss, 32);
        if (G == 0) part[wid * 16 + I] = ss;
        LDS_BARRIER();
        const float rstd = rsqrtf((part[wid * 16 + I] + part[(wid ^ 4) * 16 + I]) * (1.0f / 128.0f) + 1e-6f);
        const size_t t = t0 + 16 * tt + I;
#pragma unroll
        for (int vi = 0; vi < 4; ++vi) { const int c = h * 128 + 16 * (4 * vh + vi) + 4 * G;
            const f32x4 gn = *(const f32x4*)(gain + c); const u32x2 zw = zwp[vi];
            const float o0 = acc[vi][0] * rstd * gn[0] * siluf_(bf_lo(zw.x)), o1 = acc[vi][1] * rstd * gn[1] * siluf_(bf_hi(zw.x)), o2 = acc[vi][2] * rstd * gn[2] * siluf_(bf_lo(zw.y)), o3 = acc[vi][3] * rstd * gn[3] * siluf_(bf_hi(zw.y));
            u32x2 w; w.x = cvt_pk_bf16(o0, o1); w.y = cvt_pk_bf16(o2, o3); *(u32x2*)(Y + t * D_ + 1024 + c) = w; }
    }
#undef HG3_LOAD
}

__device__ __forceinline__ void phase_gdn_norm(const Args& a) {
    const bf16_t* O = (const bf16_t*)(a.ws + WS_O); const bf16_t* pj = (const bf16_t*)(a.ws + WS_PROJ); unsigned char* Y = a.ws + WS_Y; const float* gain = a.in[19];
    const int lane = TIDX & 63, wid = TIDX >> 6, gc = (lane & 15) * 8;
    const f32x4 g0 = *(const f32x4*)(gain + gc), g1 = *(const f32x4*)(gain + gc + 4);
    u32x4 oa[8], za[8];
    int row = BID * 8 + wid; const int stride = NBLK * 8;
#define GN_LD(ov, zv, r) { _Pragma("unroll") for (int i = 0; i < 8; ++i) { const int c = (i * 64 + lane) * 8; ov[i] = *(const u32x4*)(O + (size_t)(r) * 4096 + c); zv[i] = *(const u32x4*)(pj + (size_t)(r) * N_IN1P + 8192 + c); } }
    if (row < T_) GN_LD(oa, za, row)
    for (; row < T_; row += stride) { u32x4 ob[8], zb[8];
#pragma unroll
        for (int i = 0; i < 8; ++i) { ob[i] = oa[i]; zb[i] = za[i]; }
        if (row + stride < T_) GN_LD(ob, zb, row + stride)
#pragma unroll
        for (int i = 0; i < 8; ++i) { const int c = (i * 64 + lane) * 8;
            const u32x4 ow = oa[i], zw = za[i];
            const float o[8] = {bf_lo(ow.x), bf_hi(ow.x), bf_lo(ow.y), bf_hi(ow.y), bf_lo(ow.z), bf_hi(ow.z), bf_lo(ow.w), bf_hi(ow.w)};
            const float z[8] = {bf_lo(zw.x), bf_hi(zw.x), bf_lo(zw.y), bf_hi(zw.y), bf_lo(zw.z), bf_hi(zw.z), bf_lo(zw.w), bf_hi(zw.w)};
            float ss = 0.f;
#pragma unroll
            for (int q = 0; q < 8; ++q) ss += o[q] * o[q];
            ss = row16_sum(ss);
            const float rstd = rsqrtf(ss * (1.0f / 128.0f) + 1e-6f);
            float y[8];
#pragma unroll
            for (int q = 0; q < 8; ++q) y[q] = o[q] * rstd * (q < 4 ? g0[q & 3] : g1[q & 3]) * siluf_(z[q]);
            u32x2 w; w.x = pk_fp8x4(y[0], y[1], y[2], y[3]); w.y = pk_fp8x4(y[4], y[5], y[6], y[7]);
            *(u32x2*)(Y + (size_t)row * 4096 + c) = w; }
#pragma unroll
        for (int i = 0; i < 8; ++i) { oa[i] = ob[i]; za[i] = zb[i]; }
    }
#undef GN_LD
}

template <bool FP8>
__device__ __forceinline__ void phase_gemm_out(const Args& a, LAS unsigned char* lds, int K, const void* w, const float* xin) {
    const int eb = FP8 ? 1 : 2;
    SrcGrid S{(const char*)(a.ws + WS_Y), (const char*)w, (size_t)BM * K * eb, (size_t)BM * K * eb, 64, 64 * 8, K * eb / 2, K * eb / 2};
    EpiResid E{a.ws, xin, FP8 ? 1.0f / W8_SCALE : 1.0f};
    gemm_stream<false, FP8>(lds, S, K * eb / 128, E);
}

struct SrcRouter {
    const char* h; const char* w;
    __device__ __forceinline__ bool next(int i, UnitD& u) const { const int id = BID + i * NBLK; if (id >= 256) return false; u.t0 = id & 63; u.t1 = id >> 6; u.t2 = 0;
        u.gA = h + ((size_t)u.t0 * BM * D_ + u.t1 * 512) * 2; u.gB = w + (size_t)u.t1 * 512 * 2; return true; }
    __device__ __forceinline__ void va(const UnitD&, unsigned (&v)[2][2]) const { offs_direct(v, D_, false); }
    __device__ __forceinline__ void vb(unsigned (&v)[2][2]) const { offs_direct(v, D_, true); }
};
struct EpiLogitsQ {
    float* O;
    __device__ __forceinline__ void operator()(const Acc& acc, const UnitD& u, int wr, int wc, int fr, int fq) const { store_f32_tile(acc, O + ((size_t)u.t1 * T_ + (size_t)u.t0 * BM) * 128, nullptr, 128, 128, wr, wc, fr, fq); }
};
__device__ __forceinline__ void phase_gemm_router(const Args& a, LAS unsigned char* lds, int layer) {
    SrcRouter S{(const char*)(a.ws + WS_X), (const char*)(a.ws + WS_WRT) + (size_t)layer * 256 * D_ * 2};
    EpiLogitsQ E{(float*)(a.ws + WS_O)};
    gemm_stream<false, false>(lds, S, 512 / BK, E);
}

__device__ __forceinline__ void phase_route(const Args& a, int layer) {
    const float* lg = (const float*)(a.ws + WS_O); const float* bg = a.in[22] + layer * 8; const float* be = a.in[24] + layer * 64;
    int* cnt = (int*)(a.ws + WS_CTL + CTL_CNT) + layer * 64;
    int* eid = (int*)(a.ws + WS_EID); int* slot = (int*)(a.ws + WS_SLOT); float* gate = (float*)(a.ws + WS_GATE); int* rowmap = (int*)(a.ws + WS_ROWMAP);
    const float* rsp = (const float*)(a.ws + WS_RSP); float* rstdo = (float*)(a.ws + WS_RSTD);
    {
        const bf16_t* xw = (const bf16_t*)(a.ws + WS_X); const float* gain = a.in[2] + (size_t)layer * D_; const int wid = TIDX >> 6, lane = TIDX & 63, stride = NBLK * 16;
        u32x2 rb[2][8]; float ps[2];
#define RT_LD(r) { _Pragma("unroll") for (int u = 0; u < 2; ++u) { _Pragma("unroll") for (int i = 0; i < 8; ++i) rb[u][i] = *(const u32x2*)(xw + (size_t)((r) + u) * D_ + (i * 64 + lane) * 4); ps[u] = rsp[(size_t)((r) + u) * 32 + (lane & 31)]; } }
        int row = (BID * 8 + wid) * 2;
        if (row < T_) RT_LD(row)
        for (; row < T_; row += stride) { u32x2 rc[2][8]; float pc[2];
#pragma unroll
            for (int u = 0; u < 2; ++u) { pc[u] = ps[u];
#pragma unroll
                for (int i = 0; i < 8; ++i) rc[u][i] = rb[u][i]; }
            if (row + stride < T_) RT_LD(row + stride)
#pragma unroll
            for (int u = 0; u < 2; ++u) { const float rstd = rsqrtf(wave_sum(pc[u]) * (0.5f / D_) + 1e-6f);
#pragma unroll
                for (int i = 0; i < 8; ++i) { const int c = (i * 64 + lane) * 4; const f32x4 gn = *(const f32x4*)(gain + c);
                    *(unsigned*)(a.ws + WS_H8 + (size_t)(row + u) * D_ + c) = pk_fp8x4(bf_lo(rc[u][i].x) * rstd * gn[0], bf_hi(rc[u][i].x) * rstd * gn[1], bf_lo(rc[u][i].y) * rstd * gn[2], bf_hi(rc[u][i].y) * rstd * gn[3]); } } }
#undef RT_LD
    }
    const int gtid = BID * NTHREADS + TIDX, gsz = NBLK * NTHREADS;
    for (int i = gtid; i < MPAD; i += gsz) rowmap[i] = 0;
    for (int t = gtid; t < T_; t += gsz) {
        f32x4 ga = (f32x4){0.f, 0.f, 0.f, 0.f}, gb = ga, sq = ga;
#pragma unroll
        for (int kq = 0; kq < 4; ++kq) { ga += *(const f32x4*)(lg + ((size_t)kq * T_ + t) * 128); gb += *(const f32x4*)(lg + ((size_t)kq * T_ + t) * 128 + 4); }
#pragma unroll
        for (int i = 0; i < 8; ++i) sq += *(const f32x4*)(rsp + (size_t)t * 32 + i * 4);
        const float rstd = rsqrtf((sq[0] + sq[1] + sq[2] + sq[3]) * (1.0f / D_) + 1e-6f); rstdo[t] = rstd;
        ga *= rstd; gb *= rstd;
        const float gl[8] = {ga[0] + bg[0], ga[1] + bg[1], ga[2] + bg[2], ga[3] + bg[3], gb[0] + bg[4], gb[1] + bg[5], gb[2] + bg[6], gb[3] + bg[7]};
        float mx = -3.0e38f; int gi = 0;
#pragma unroll
        for (int j = 0; j < 8; ++j) if (gl[j] > mx) { mx = gl[j]; gi = j; }
        float se = 0.f;
#pragma unroll
        for (int j = 0; j < 8; ++j) se += __expf(gl[j] - mx);
        const float gp = 1.0f / se;
        f32x4 ea = (f32x4){0.f, 0.f, 0.f, 0.f}, eb = ea;
#pragma unroll
        for (int kq = 0; kq < 4; ++kq) { ea += *(const f32x4*)(lg + ((size_t)kq * T_ + t) * 128 + 8 + gi * 8); eb += *(const f32x4*)(lg + ((size_t)kq * T_ + t) * 128 + 12 + gi * 8); }
        ea = ea * rstd + *(const f32x4*)(be + gi * 8); eb = eb * rstd + *(const f32x4*)(be + gi * 8 + 4);
        const float el[8] = {ea[0], ea[1], ea[2], ea[3], eb[0], eb[1], eb[2], eb[3]};
        float l1 = -3.0e38f, l2 = -3.0e38f; int i1 = 0, i2 = 0;
#pragma unroll
        for (int j = 0; j < 8; ++j) { const float v = el[j];
            if (v > l1) { l2 = l1; i2 = i1; l1 = v; i1 = j; } else if (v > l2) { l2 = v; i2 = j; } }
        const float e2 = __expf(l2 - l1), inv = 1.0f / (1.0f + e2);
        const int e0 = gi * 8 + i1, e1 = gi * 8 + i2;
        eid[t * 2] = e0; eid[t * 2 + 1] = e1; gate[t * 2] = inv * gp; gate[t * 2 + 1] = e2 * inv * gp;
        slot[t * 2] = atomicAdd(&cnt[e0], 1); slot[t * 2 + 1] = atomicAdd(&cnt[e1], 1); }
}

__device__ __forceinline__ void phase_rowmap(const Args& a, LAS unsigned char* lds, int layer) {
    const int* cnt = (const int*)(a.ws + WS_CTL + CTL_CNT) + layer * 64; LAS int* ps = (LAS int*)lds;
    int* tinfo = (int*)(a.ws + WS_TINFO) + layer * 512;
    const int* eid = (const int*)(a.ws + WS_EID); const int* slot = (const int*)(a.ws + WS_SLOT); int* posof = (int*)(a.ws + WS_POSOF); int* rowmap = (int*)(a.ws + WS_ROWMAP);
    __syncthreads();
    if (TIDX == 0) { int acc = 0; for (int e = 0; e < 64; ++e) { ps[e] = acc; acc += (cnt[e] + 255) & ~255; } ps[64] = acc; }
    __syncthreads();
    if (BID == 0) { if (TIDX <= 64) tinfo[TIDX] = ps[TIDX]; if (TIDX == 65) tinfo[65] = ps[64] >> 8;
        if (TIDX < 192) { const int p = TIDX * 256; int e = 0; for (int j = 0; j < 64; ++j) if (ps[j + 1] <= p) e = j + 1; tinfo[128 + TIDX] = e < 64 ? e : 63; } }
    for (int i = BID * NTHREADS + TIDX; i < T_ * 2; i += NBLK * NTHREADS) { const int p = ps[eid[i]] + slot[i]; posof[i] = p; rowmap[p] = i >> 1; }
    __syncthreads();
}

struct SrcMoeUp {
    const char* h; const char* wg; const int* tinfo; const int* rowmap; int total;
    __device__ __forceinline__ bool next(int i, UnitD& u) const { const int id = BID + i * NBLK; if (id >= total) return false; u.t0 = id >> 2; u.t1 = id & 3;
        u.t2 = __builtin_amdgcn_readfirstlane(tinfo[128 + u.t0]); u.gA = h; u.gB = wg + ((size_t)u.t2 * DEXP + u.t1 * 128) * D_; return true; }
    __device__ __forceinline__ void va(const UnitD& u, unsigned (&v)[2][2]) const { int R0, C0; stage_pos(TIDX, R0, C0);
#pragma unroll
        for (int hh = 0; hh < 2; ++hh)
#pragma unroll
            for (int i = 0; i < 2; ++i) v[hh][i] = (unsigned)(rowmap[u.t0 * 256 + hh * 128 + R0 + 64 * i] * D_ + C0 * 2); }
    __device__ __forceinline__ void vb(unsigned (&v)[2][2]) const { int R0, C0; stage_pos(TIDX, R0, C0);
#pragma unroll
        for (int i = 0; i < 2; ++i) { const int Rr = perm_row(R0 + 64 * i); v[0][i] = (unsigned)(Rr * D_ + C0 * 2); v[1][i] = (unsigned)(WS_WU - WS_WG) + (unsigned)(Rr * D_ + C0 * 2); } }
};
__device__ __forceinline__ void phase_moe_up(const Args& a, LAS unsigned char* lds, int layer) {
    const int* tinfo = (const int*)(a.ws + WS_TINFO) + layer * 512;
    const int ntm = __builtin_amdgcn_readfirstlane(tinfo[65]);
    SrcMoeUp S{(const char*)(a.ws + WS_H8), (const char*)(a.ws + WS_WG), tinfo, (const int*)(a.ws + WS_ROWMAP), ntm * 4};
    EpiSwiGLU E{a.ws + WS_ACT};
    gemm_stream<true, true>(lds, S, D_ / 128, E);
}

struct SrcMoeDown {
    const char* act; const char* wd; const int* tinfo; int total;
    __device__ __forceinline__ bool next(int i, UnitD& u) const { const int id = BID + i * NBLK; if (id >= total) return false; u.t0 = id >> 3; u.t1 = id & 7;
        u.t2 = __builtin_amdgcn_readfirstlane(tinfo[128 + u.t0]); u.gA = act + (size_t)u.t0 * BM * DEXP; u.gB = wd + ((size_t)u.t2 * D_ + u.t1 * BM) * DEXP; return true; }
    __device__ __forceinline__ void va(const UnitD&, unsigned (&v)[2][2]) const { offs_direct(v, DEXP / 2, false); }
    __device__ __forceinline__ void vb(unsigned (&v)[2][2]) const { offs_direct(v, DEXP / 2, true); }
};
__device__ __forceinline__ void phase_moe_down(const Args& a, LAS unsigned char* lds, int layer) {
    const int* tinfo = (const int*)(a.ws + WS_TINFO) + layer * 512; const int ntm = __builtin_amdgcn_readfirstlane(tinfo[65]);
    SrcMoeDown S{(const char*)(a.ws + WS_ACT), (const char*)(a.ws + WS_WD), tinfo, ntm * 8};
    EpiDown E{a.ws + WS_YMOE};
    gemm_stream<false, true>(lds, S, DEXP / 128, E);
}

struct SrcIn1Tail {
    const char* h; const char* w;
    __device__ __forceinline__ bool next(int i, UnitD& u) const { const int id = BID + i * NBLK; if (id >= 256) return false; u.t0 = id & 63; u.t1 = id >> 6; u.t2 = 0;
        u.gA = h + (size_t)u.t0 * BM * D_ + u.t1 * 512; u.gB = w + (size_t)48 * BM * D_ + u.t1 * 512; return true; }
    __device__ __forceinline__ void va(const UnitD&, unsigned (&v)[2][2]) const { offs_direct(v, D_ / 2, false); }
    __device__ __forceinline__ void vb(unsigned (&v)[2][2]) const { offs_direct(v, D_ / 2, true); }
};
struct EpiTailQ {
    float* O;
    __device__ __forceinline__ void operator()(const Acc& acc, const UnitD& u, int wr, int wc, int fr, int fq) const { store_f32_tile(acc, O + ((size_t)u.t1 * T_ + (size_t)u.t0 * BM) * 64, nullptr, 64, 64, wr, wc, fr, fq, 1.0f / W8_SCALE); }
};
__device__ __forceinline__ void phase_gemm_in1(const Args& a, LAS unsigned char* lds) {
    SrcGrid S{(const char*)(a.ws + WS_H8), (const char*)(a.ws + WS_WIN1T), (size_t)BM * D_, (size_t)BM * D_, 64, 64 * 48, D_ / 2, D_ / 2};
    EpiProj E{(bf16_t*)(a.ws + WS_PROJ), N_IN1P, nullptr, 64, 48, 48, 64, 1.0f / W8_SCALE};
    gemm_stream<false, true>(lds, S, D_ / 128, E);
}
__device__ __forceinline__ void phase_gemm_in1_tail(const Args& a, LAS unsigned char* lds) {
    SrcIn1Tail S{(const char*)(a.ws + WS_H8), (const char*)(a.ws + WS_WIN1T)};
    EpiTailQ E{(float*)(a.ws + WS_O)};
    int nt = 4; asm volatile("" : "+s"(nt));
    gemm_stream<false, true>(lds, S, nt, E);
}

__device__ __forceinline__ void phase_gdn_conv(const Args& a) {
    const bf16_t* p1 = (const bf16_t*)(a.ws + WS_PROJ); bf16_t* qc = (bf16_t*)(a.ws + WS_QKVC); const float* cw = a.in[16];
    const int gtid = BID * NTHREADS + TIDX, gsz = NBLK * NTHREADS;
    for (int it = gtid; it < 1024 * (T_ / 128); it += gsz) { const int c = (it & 1023) * 8, seg = it >> 10; const size_t t0 = (size_t)seg * 128;
        float w[4][8];
#pragma unroll
        for (int k = 0; k < 4; ++k) { const f32x4 w0 = *(const f32x4*)(cw + k * 8192 + c), w1 = *(const f32x4*)(cw + k * 8192 + c + 4);
            w[k][0] = w0[0]; w[k][1] = w0[1]; w[k][2] = w0[2]; w[k][3] = w0[3]; w[k][4] = w1[0]; w[k][5] = w1[1]; w[k][6] = w1[2]; w[k][7] = w1[3]; }
        u32x4 x0 = (u32x4){0u, 0u, 0u, 0u}, x1 = x0, x2 = x0;
        if ((t0 & (S_ - 1)) != 0) { x0 = *(const u32x4*)(p1 + (t0 - 3) * N_IN1P + c); x1 = *(const u32x4*)(p1 + (t0 - 2) * N_IN1P + c); x2 = *(const u32x4*)(p1 + (t0 - 1) * N_IN1P + c); }
        const float qsc = c < 2048 ? 0.08838834764831845f : 1.0f;
        u32x4 xa[8];
#pragma unroll
        for (int j = 0; j < 8; ++j) xa[j] = *(const u32x4*)(p1 + (t0 + j) * N_IN1P + c);
#pragma unroll 1
        for (int r0 = 0; r0 < 128; r0 += 8) { u32x4 xb[8];
#pragma unroll
            for (int j = 0; j < 8; ++j) xb[j] = xa[j];
            if (r0 + 8 < 128) {
#pragma unroll
                for (int j = 0; j < 8; ++j) xb[j] = *(const u32x4*)(p1 + (t0 + r0 + 8 + j) * N_IN1P + c); }
#pragma unroll
          for (int j8 = 0; j8 < 8; ++j8) { const u32x4 x3 = xa[j8]; const int r = r0 + j8;
            float acc[8];
#define TAPS(j, f, m) (w[0][j] * f(x0.m) + w[1][j] * f(x1.m) + w[2][j] * f(x2.m) + w[3][j] * f(x3.m))
            acc[0] = TAPS(0, bf_lo, x); acc[1] = TAPS(1, bf_hi, x); acc[2] = TAPS(2, bf_lo, y); acc[3] = TAPS(3, bf_hi, y);
            acc[4] = TAPS(4, bf_lo, z); acc[5] = TAPS(5, bf_hi, z); acc[6] = TAPS(6, bf_lo, w); acc[7] = TAPS(7, bf_hi, w);
#undef TAPS
            float ss = 0.f;
#pragma unroll
            for (int j = 0; j < 8; ++j) { acc[j] = siluf_(acc[j]); ss += acc[j] * acc[j]; }
            ss = row16_sum(ss);
            const float sc = c < 4096 ? rsqrtf(ss + 1e-6f) * qsc : 1.0f;
            u32x4 o; o.x = cvt_pk_bf16(acc[0] * sc, acc[1] * sc); o.y = cvt_pk_bf16(acc[2] * sc, acc[3] * sc); o.z = cvt_pk_bf16(acc[4] * sc, acc[5] * sc); o.w = cvt_pk_bf16(acc[6] * sc, acc[7] * sc);
            *(u32x4*)(qc + (t0 + r) * 8192 + c) = o;
            x0 = x1; x1 = x2; x2 = x3; }
#pragma unroll
            for (int j = 0; j < 8; ++j) xa[j] = xb[j]; } }
    const float* tail = (const float*)(a.ws + WS_O); float* bgo = (float*)(a.ws + WS_BG);
    for (int it = gtid; it < T_ * 32; it += gsz) { const int t = it >> 5, hv = it & 31; float tb = 0.f, ta = 0.f;
#pragma unroll
        for (int kq = 0; kq < 4; ++kq) { tb += tail[((size_t)kq * T_ + t) * 64 + hv]; ta += tail[((size_t)kq * T_ + t) * 64 + 32 + hv]; }
        bgo[t * 64 + hv] = sigmoidf_(tb);
        bgo[t * 64 + 32 + hv] = -__expf(a.in[17][hv]) * softplusf_(ta + a.in[18][hv]); }
}

struct MoeTile { const float* src; unsigned char* dst; int lds_, ldd; };
__device__ __forceinline__ MoeTile moe_tile(const Args& a, int g) {
    const int job = g >> 14, r = g & 16383, e = r >> 8, rr = r & 255; MoeTile t;
    typedef __attribute__((address_space(1))) const float* gcf; gcf s25 = (gcf)a.in[25], s26 = (gcf)a.in[26]; asm volatile("" : "+s"(s25), "+s"(s26));
    if (job < 2) { const int ik = rr >> 3, in = rr & 7; t.lds_ = DEXP; t.ldd = D_;
        t.src = (const float*)(job ? s26 : s25) + ((size_t)(NEXP + e) * D_ + ik * 64) * DEXP + in * 64; t.dst = a.ws + (job ? WS_WU : WS_WG) + ((size_t)e * DEXP + in * 64) * D_ + ik * 64; }
    else { const int ik = rr >> 5, in = rr & 31; t.lds_ = D_; t.ldd = DEXP;
        t.src = a.in[27] + ((size_t)(NEXP + e) * DEXP + ik * 64) * D_ + in * 64; t.dst = a.ws + WS_WD + ((size_t)e * D_ + in * 64) * DEXP + ik * 64; }
    return t;
}
__device__ __forceinline__ void moe_tile_load(const MoeTile& t, int tid, f32x4 (&v)[2]) {
#pragma unroll
    for (int i = 0; i < 2; ++i) { const int idx = tid + i * 512, rr = idx >> 4, c4 = (idx & 15) * 4; v[i] = *(const f32x4*)(t.src + (size_t)rr * t.lds_ + c4); }
}
__device__ __forceinline__ void moe_tile_store(const MoeTile& t, int tid, const f32x4 (&v)[2], LAS float* tile) {
#pragma unroll
    for (int i = 0; i < 2; ++i) { const int idx = tid + i * 512, rr = idx >> 4, c4 = (idx & 15) * 4;
        tile[rr * 65 + c4 + 0] = v[i][0]; tile[rr * 65 + c4 + 1] = v[i][1]; tile[rr * 65 + c4 + 2] = v[i][2]; tile[rr * 65 + c4 + 3] = v[i][3]; }
    LDS_BARRIER();
    { const int n = tid >> 3, kg = (tid & 7) * 8; float f[8];
#pragma unroll
      for (int jj = 0; jj < 8; ++jj) f[jj] = tile[(kg + jj) * 65 + n] * W8_SCALE;
      u32x2 w; w.x = pk_fp8x4(f[0], f[1], f[2], f[3]); w.y = pk_fp8x4(f[4], f[5], f[6], f[7]);
      *(u32x2*)(t.dst + (size_t)n * t.ldd + kg) = w; }
    LDS_BARRIER();
}
constexpr int MOE_TILES = 3 * NEXP * 256;

__device__ __forceinline__ f32x4 mfma16(s16x4 a, s16x4 b, f32x4 c) { return __builtin_amdgcn_mfma_f32_16x16x16bf16_1k(a, b, c, 0, 0, 0); }
__device__ __forceinline__ s16x4 pack4(const f32x4& v) { u32x2 w; w.x = cvt_pk_bf16(v[0], v[1]); w.y = cvt_pk_bf16(v[2], v[3]); return __builtin_bit_cast(s16x4, w); }
__device__ __forceinline__ void phase_gdn_chunk(const Args& a, LAS unsigned char* lds) {
    const bf16_t* qc = (const bf16_t*)(a.ws + WS_QKVC); const float* bgi = (const float*)(a.ws + WS_BG); bf16_t* O = (bf16_t*)(a.ws + WS_O);
    constexpr int VRS = 144, KTRS = 136;
    constexpr int KT = 0, QS = KT + 128 * KTRS, WSL = QS + 64 * RSB, QKS = WSL + 64 * RSB, EE = QKS + 2048, EDD = EE + 256, SET = EDD + 256;
    constexpr int STL = 2 * SET, KS = STL + 64 * RSB, VS = KS + 64 * RSB, X2 = VS + 64 * VRS, LS = X2 + 2048, X1 = LS + 4096, GAM = X1 + 2048, BET = GAM + 256, LEND = BET + 256;
    static_assert(LEND <= LDS_XBW, "gdn lds");
    const int wid = __builtin_amdgcn_readfirstlane(TIDX >> 6);
    const int NCK = S_ / 64;
    for (int blk = BID; blk < NB_ * 32 * 2; blk += NBLK) {
        const int grp = (blk & 7) * 8 + (blk >> 5), mem = (blk >> 3) & 3, b = grp >> 4, hk = grp & 15, hv = 2 * hk + (mem >> 1), vhalf = mem & 1;
        __syncthreads();
        if (wid < 4) {
            const int vt = wid;
            f32x4 Sacc[8];
#pragma unroll
            for (int n = 0; n < 8; ++n) Sacc[n] = (f32x4){0.f, 0.f, 0.f, 0.f};
            { const int lane = TIDX & 63;
              for (int i = lane; i < 16 * RSB / 16; i += 64) *(LAS u32x4*)(lds + STL + 16 * vt * RSB + i * 16) = (u32x4){0u, 0u, 0u, 0u}; }
            int lz = TIDX & 63; asm volatile("" : "+v"(lz));
            const int lane = lz, I = lane & 15, G = lane >> 4, q4 = I >> 2, p4 = I & 3;
            for (int it = 0; it <= NCK; ++it) {
                const int set = ((it - 1) & 1) * SET; const size_t t0 = (size_t)b * S_ + (size_t)(it - 1) * 64;
                f32x4 U[4];
                if (it >= 1) {
#pragma unroll
                    for (int sa = 0; sa < 4; ++sa) U[sa] = mfma16(*(const LAS s16x4*)(lds + X2 + ((sa * 16 + I) * 16 + 4 * G) * 2), lds_tr4(lds + VS + (16 * sa + 4 * G + q4) * VRS + (16 * vt + 4 * p4) * 2), (f32x4){0.f, 0.f, 0.f, 0.f});
                    asm volatile("" : "+v"(U[0]), "+v"(U[1]), "+v"(U[2]), "+v"(U[3]) :: "memory");
                }
                LDS_BARRIER();
#pragma unroll
                for (int sa = 0; sa < 4; ++sa) {
                    if (it >= 1) {
                        bf16x8 sf[4];
#pragma unroll
                        for (int ks = 0; ks < 4; ++ks) sf[ks] = lds_frag(lds + STL + (16 * vt + I) * RSB + (32 * ks + 8 * G) * 2);
                        s16x4 kt[8];
#pragma unroll
                        for (int dt = 0; dt < 8; ++dt) kt[dt] = *(const LAS s16x4*)(lds + set + KT + (16 * dt + I) * KTRS + (16 * sa + 4 * G) * 2);
                        f32x4 dl = U[sa], oq = (f32x4){0.f, 0.f, 0.f, 0.f}, dl2 = oq, oq2 = oq;
#pragma unroll
                        for (int ks = 0; ks < 2; ++ks) { dl = mfma32(lds_frag(lds + set + WSL + (16 * sa + I) * RSB + (32 * ks + 8 * G) * 2), sf[ks], dl);
                            dl2 = mfma32(lds_frag(lds + set + WSL + (16 * sa + I) * RSB + (32 * (ks + 2) + 8 * G) * 2), sf[ks + 2], dl2);
                            oq = mfma32(lds_frag(lds + set + QS + (16 * sa + I) * RSB + (32 * ks + 8 * G) * 2), sf[ks], oq);
                            oq2 = mfma32(lds_frag(lds + set + QS + (16 * sa + I) * RSB + (32 * (ks + 2) + 8 * G) * 2), sf[ks + 2], oq2); }
                        dl += dl2; oq += oq2;
                        const s16x4 dfrag = pack4(dl);
                        const f32x4 e4 = *(const LAS f32x4*)(lds + set + EE + (16 * sa + 4 * G) * 4);
                        oq = mfma16(*(const LAS s16x4*)(lds + set + QKS + ((sa * 16 + I) * 16 + 4 * G) * 2), dfrag, oq * e4);
#pragma unroll
                        for (int r = 0; r < 4; ++r) O[(t0 + 16 * sa + 4 * G + r) * 4096 + hv * 128 + vhalf * 64 + 16 * vt + I] = f2bf(oq[r]);
                        const f32x4 ed4 = *(const LAS f32x4*)(lds + set + EDD + (16 * sa + 4 * G) * 4); const float e15 = *(const LAS float*)(lds + set + EE + (16 * sa + 15) * 4);
                        const s16x4 dsc = pack4(dl * ed4);
#pragma unroll
                        for (int dt = 0; dt < 8; ++dt) {
                            Sacc[dt] = mfma16(kt[dt], dsc, Sacc[dt] * e15);
                            *(LAS s16x4*)(lds + STL + (16 * vt + I) * RSB + (16 * dt + 4 * G) * 2) = pack4(Sacc[dt]); }
                    }
                    if (sa & 1) LDS_BARRIER();
                }
            }
        } else {
            const int pw = wid - 4;
            u32x4 pq[4], pk[4], pv[2]; float pb = 0.f, pg = 0.f;
            { const int ptid = TIDX - 256; const size_t t0 = (size_t)b * S_;
#pragma unroll
              for (int i = 0; i < 4; ++i) { const int c = ptid + i * 256, s2 = c >> 4, c8 = (c & 15) * 8; pq[i] = *(const u32x4*)(qc + (t0 + s2) * 8192 + hk * 128 + c8); pk[i] = *(const u32x4*)(qc + (t0 + s2) * 8192 + 2048 + hk * 128 + c8); }
#pragma unroll
              for (int i = 0; i < 2; ++i) { const int c = ptid + i * 256, s2 = c >> 3, c8 = (c & 7) * 8; pv[i] = *(const u32x4*)(qc + (t0 + s2) * 8192 + 4096 + hv * 128 + vhalf * 64 + c8); }
              if (pw == 1) { pb = bgi[(t0 + ptid - 64) * 64 + hv]; pg = bgi[(t0 + ptid - 64) * 64 + 32 + hv]; } }
            int lz = TIDX & 63; asm volatile("" : "+v"(lz));
            const int lane = lz, ptid = pw * 64 + lane, I = lane & 15, G = lane >> 4, q4 = I >> 2, p4 = I & 3;
            for (int it = 0; it <= NCK; ++it) {
                const int set = (it & 1) * SET; const bool act = it < NCK;
                if (act) {
#pragma unroll
                    for (int i = 0; i < 4; ++i) { const int c = ptid + i * 256, s2 = c >> 4, c8 = (c & 15) * 8; *(LAS u32x4*)(lds + set + QS + s2 * RSB + c8 * 2) = pq[i]; *(LAS u32x4*)(lds + KS + s2 * RSB + c8 * 2) = pk[i]; }
                    if (pw == 1) { float x = pg;
                        x += __builtin_bit_cast(float, __builtin_amdgcn_update_dpp(0, __builtin_bit_cast(int, x), 0x111, 0xf, 0xf, true));
                        x += __builtin_bit_cast(float, __builtin_amdgcn_update_dpp(0, __builtin_bit_cast(int, x), 0x112, 0xf, 0xf, true));
                        x += __builtin_bit_cast(float, __builtin_amdgcn_update_dpp(0, __builtin_bit_cast(int, x), 0x114, 0xf, 0xf, true));
                        x += __builtin_bit_cast(float, __builtin_amdgcn_update_dpp(0, __builtin_bit_cast(int, x), 0x118, 0xf, 0xf, true));
                        const float g15 = __shfl(x, 15, 16);
                        *(LAS float*)(lds + GAM + lane * 4) = x; *(LAS float*)(lds + set + EE + lane * 4) = __expf(x); *(LAS float*)(lds + set + EDD + lane * 4) = __expf(g15 - x); *(LAS float*)(lds + BET + lane * 4) = pb; }
                    if (it + 1 < NCK) { const size_t t1 = (size_t)b * S_ + (size_t)(it + 1) * 64;
#pragma unroll
                        for (int i = 0; i < 4; ++i) { const int c = ptid + i * 256, s2 = c >> 4, c8 = (c & 15) * 8; pq[i] = *(const u32x4*)(qc + (t1 + s2) * 8192 + hk * 128 + c8); pk[i] = *(const u32x4*)(qc + (t1 + s2) * 8192 + 2048 + hk * 128 + c8); }
                        if (pw == 1) { pb = bgi[(t1 + ptid - 64) * 64 + hv]; pg = bgi[(t1 + ptid - 64) * 64 + 32 + hv]; } }
                }
                LDS_BARRIER();
                if (act) { const int sa = pw;
#pragma unroll
                    for (int i = 0; i < 2; ++i) { const int c = ptid + i * 256, s2 = c >> 3, c8 = (c & 7) * 8; *(LAS u32x4*)(lds + VS + s2 * VRS + c8 * 2) = pv[i]; }
                    if (it + 1 < NCK) { const size_t t1 = (size_t)b * S_ + (size_t)(it + 1) * 64;
#pragma unroll
                        for (int i = 0; i < 2; ++i) { const int c = ptid + i * 256, s2 = c >> 3, c8 = (c & 7) * 8; pv[i] = *(const u32x4*)(qc + (t1 + s2) * 8192 + 4096 + hv * 128 + vhalf * 64 + c8); } }
#pragma unroll
                    for (int ty = 0; ty < 2; ++ty) { f32x4 acc = (f32x4){0.f, 0.f, 0.f, 0.f};
#pragma unroll
                        for (int ks = 0; ks < 4; ++ks) { const bf16x8 ka = lds_frag(lds + KS + (16 * sa + I) * RSB + (32 * ks + 8 * G) * 2);
                            const bf16x8 bo = ty ? lds_frag(lds + set + QS + (16 * sa + I) * RSB + (32 * ks + 8 * G) * 2) : ka; acc = mfma32(ka, bo, acc); }
                        const f32x4 gr = *(const LAS f32x4*)(lds + GAM + (16 * sa + 4 * G) * 4); const float gc = *(const LAS float*)(lds + GAM + (16 * sa + I) * 4);
                        if (ty == 0) { const f32x4 br = *(const LAS f32x4*)(lds + BET + (16 * sa + 4 * G) * 4);
#pragma unroll
                            for (int r = 0; r < 4; ++r) { const float val = br[r] * acc[r] * __expf(gr[r] - gc); *(LAS float*)(lds + LS + ((sa * 16 + 4 * G + r) * 16 + I) * 4) = (I < 4 * G + r) ? val : 0.f; } }
                        else { f32x4 o;
#pragma unroll
                            for (int r = 0; r < 4; ++r) { const float val = acc[r] * __expf(gc - gr[r]); o[r] = (4 * G + r <= I) ? val : 0.f; }
                            *(LAS s16x4*)(lds + set + QKS + ((sa * 16 + I) * 16 + 4 * G) * 2) = pack4(o); } } }
                LDS_BARRIER();
                if (act) { const int sa = pw, c = lane >> 2, q = lane & 3;
                    f32x4 lv[16];
#pragma unroll
                    for (int i = 0; i < 16; ++i) lv[i] = *(const LAS f32x4*)(lds + LS + ((sa * 16 + i) * 16 + 4 * q) * 4);
                    float xo[4] = {0.f, 0.f, 0.f, 0.f}, xw[4] = {0.f, 0.f, 0.f, 0.f};
#pragma unroll
                    for (int i = 0; i < 16; ++i) {
                        float p = lv[i][0] * xo[0] + lv[i][1] * xo[1] + lv[i][2] * xo[2] + lv[i][3] * xo[3];
                        p += dpp_f<0xB1>(p); p += dpp_f<0x4E>(p);
                        const float xi = ((i == c) ? 1.0f : 0.0f) - p;
                        xo[i & 3] = (q == (i >> 2)) ? xi : xo[i & 3];
                        xw[i >> 2] = (q == (i & 3)) ? xi : xw[i >> 2]; }
                    const float bc = *(const LAS float*)(lds + BET + (sa * 16 + c) * 4), sc1 = -bc * *(const LAS float*)(lds + set + EE + (sa * 16 + c) * 4);
#pragma unroll
                    for (int k = 0; k < 4; ++k) { const int i = 4 * k + q; *(LAS bf16_t*)(lds + X1 + ((sa * 16 + i) * 16 + c) * 2) = f2bf(xw[k] * sc1); *(LAS bf16_t*)(lds + X2 + ((sa * 16 + i) * 16 + c) * 2) = f2bf(xw[k] * bc); } }
                asm volatile("" ::: "memory");
                if (act) { const int sa = pw;
                    const s16x4 xb = *(const LAS s16x4*)(lds + X1 + ((sa * 16 + I) * 16 + 4 * G) * 2); s16x4 kt[8]; f32x4 w[8];
#pragma unroll
                    for (int dt = 0; dt < 8; ++dt) kt[dt] = lds_tr4(lds + KS + (16 * sa + 4 * G + q4) * RSB + (16 * dt + 4 * p4) * 2);
#pragma unroll
                    for (int dt = 0; dt < 8; ++dt) { w[dt] = mfma16(kt[dt], xb, (f32x4){0.f, 0.f, 0.f, 0.f}); *(LAS s16x4*)(lds + set + KT + (16 * dt + I) * KTRS + (16 * sa + 4 * G) * 2) = kt[dt]; }
#pragma unroll
                    for (int dt = 0; dt < 8; ++dt) *(LAS s16x4*)(lds + set + WSL + (16 * sa + I) * RSB + (16 * dt + 4 * G) * 2) = pack4(w[dt]); }
                LDS_BARRIER();
            }
        }
    }
}

constexpr int N_PHASES = 30;
__global__ void __launch_bounds__(NTHREADS, 2) fwd(Args a0) {
    extern __shared__ __attribute__((aligned(16))) unsigned char smem_raw[];
    LAS unsigned char* lds = (LAS unsigned char*)smem_raw;
    volatile LAS unsigned* xbw = (volatile LAS unsigned*)(lds + LDS_XBW);
    if (TIDX == 0) { xbw[0] = 0u; xbw[1] = 0u; xbw[2] = 0u; xbw[3] = 0u; }
    __syncthreads();
    XcdBarrier bar = xcd_barrier_post((unsigned*)(a0.ws + WS_CTL), xbw);
#ifndef PHMASK
#define PHMASK 0xFFFFFFFFull
#endif
#ifndef DUPMASK
#define DUPMASK 0ull
#endif
#define PH(i, body) do { if (((PHMASK >> (i)) & 1ull) && a0.ph_lo <= (i) && (i) < a0.ph_hi) { __attribute__((address_space(1))) unsigned char* wsp_ = (__attribute__((address_space(1))) unsigned char*)a0.ws; asm volatile("" : "+s"(wsp_)); Args a = a0; a.ws = (unsigned char*)wsp_; const float* xin = a.in[0]; const float* xw = (const float*)(a.ws + WS_X); (void)xin; (void)xw; \
        if ((DUPMASK >> (i)) & 1ull) { body; xcd_barrier(bar); } body; if ((i) + 1 < a0.ph_hi) xcd_barrier(bar); } } while (0)
    PH(0, { phase_prologue(a, lds); __syncthreads(); NORM_PH(0, true)(a, xin, a.in[1], -1); });
    PH(2, phase_gemm_in0(a, lds));
    PH(3, { phase_rg_conv(a); __syncthreads(); phase_hg1(a, lds); });
    PH(4, { phase_rg_gates(a, lds); __syncthreads(); phase_hg2(a); });
    PH(5, { phase_rg_scan(a, lds); __syncthreads(); phase_hg3(a, lds); });
    PH(9, phase_gemm_out<false>(a, lds, D_, a.ws + WS_WOUT0T, xin));
    PH(11, phase_gemm_router(a, lds, 0));
    PH(12, phase_route(a, 0));
    PH(13, phase_rowmap(a, lds, 0));
    PH(14, phase_moe_up(a, lds, 0));
    PH(15, phase_moe_down(a, lds, 0));
    PH(16, { NORM_PH(1, false)(a, nullptr, a.in[1] + D_, 0); __syncthreads(); moe_weight_jobs(a, 1, lds); });
    PH(18, { phase_gemm_in1(a, lds); phase_gemm_in1_tail(a, lds); });
    PH(19, phase_gdn_conv(a));
    PH(20, phase_gdn_chunk(a, lds));
    PH(21, phase_gdn_norm(a));
    PH(22, phase_gemm_out<true>(a, lds, 4096, a.ws + WS_WOUT1T, nullptr));
    PH(24, phase_gemm_router(a, lds, 1));
    PH(25, phase_route(a, 1));
    PH(26, phase_rowmap(a, lds, 1));
    PH(27, phase_moe_up(a, lds, 1));
    PH(28, phase_moe_down(a, lds, 1));
    PH(29, NORM_PH(2, false)(a, nullptr, a.in[3], 1));
#undef PH
}

extern "C" void kernel_launch(void* const* d_in, const int* in_sizes, int n_in, void* d_out, int out_size, void* d_ws, size_t ws_size, hipStream_t stream) {
    static int grid = 0;
    if (grid == 0) {
        if (n_in != 28 || ws_size < WS_END) { fprintf(stderr, "kernel_launch: need 28 inputs and %zu bytes of workspace, got %d / %zu\n", (size_t)WS_END, n_in, ws_size); grid = -1; return; }
        int dev = 0, cus = 0, per_cu = 0;
        if (hipGetDevice(&dev) != hipSuccess || hipDeviceGetAttribute(&cus, hipDeviceAttributeMultiprocessorCount, dev) != hipSuccess) { grid = -1; return; }
        if (hipFuncSetAttribute((const void*)fwd, hipFuncAttributeMaxDynamicSharedMemorySize, LDS_BYTES) != hipSuccess) { fprintf(stderr, "kernel_launch: hipFuncSetAttribute failed\n"); grid = -1; return; }
        if (hipOccupancyMaxActiveBlocksPerMultiprocessor(&per_cu, (const void*)fwd, NTHREADS, LDS_BYTES) != hipSuccess || per_cu < 1) { fprintf(stderr, "kernel_launch: occupancy query says %d\n", per_cu); }
        (void)hipGetLastError();
        grid = cus;
    }
    if (grid < 0) return;
    (void)in_sizes; (void)out_size;
    hipMemsetAsync((char*)d_ws + WS_CTL, 0, CTL_BYTES, stream);
    Args a; memset(&a, 0, sizeof(a));
    for (int i = 0; i < 28; ++i) a.in[i] = (const float*)d_in[i];
    a.out = (float*)d_out; a.ws = (unsigned char*)d_ws;
#if N_LAUNCH_MODE == 1
    a.ph_lo = 0; a.ph_hi = N_PHASES;
    hipLaunchKernelGGL(fwd, dim3(grid), dim3(NTHREADS), LDS_BYTES, stream, a);
#if EXTRA_PH >= 0
    a.ph_lo = EXTRA_PH; a.ph_hi = EXTRA_PH + 1;
    hipLaunchKernelGGL(fwd, dim3(grid), dim3(NTHREADS), LDS_BYTES, stream, a);
#endif
#else
    for (int p = 0; p < N_PHASES; ++p) { a.ph_lo = p; a.ph_hi = p + 1; hipLaunchKernelGGL(fwd, dim3(grid), dim3(NTHREADS), LDS_BYTES, stream, a); }
#endif
}
```

```cpp
#include <hip/hip_runtime.h>
#include <stdint.h>
#include <stdio.h>
#include <string.h>

#ifndef EXTRA_PH
#define EXTRA_PH -1
#endif
#ifndef N_LAUNCH_MODE
#define N_LAUNCH_MODE 1
#endif

#define LAS __attribute__((address_space(3)))
typedef unsigned short bf16_t;
typedef short bf16x8 __attribute__((ext_vector_type(8)));
typedef float f32x4 __attribute__((ext_vector_type(4)));
typedef float f32x2 __attribute__((ext_vector_type(2)));
typedef unsigned u32x4 __attribute__((ext_vector_type(4)));
typedef unsigned u32x2 __attribute__((ext_vector_type(2)));

constexpr int T_ = 16384, D_ = 2048, S_ = 4096, NB_ = 4;
constexpr int N_IN0 = 6144, N_IN1 = 12352, N_IN1P = 12544;
constexpr int NEXP = 64, DEXP = 512, MPAD = 49152;
constexpr int NTHREADS = 512;
constexpr int LDS_MAIN = 131072;
constexpr int LDS_BYTES = 163840;
constexpr int LDS_XBW = LDS_BYTES - 16;

constexpr size_t al256(size_t x) { return (x + 255) & ~(size_t)255; }
constexpr size_t WS_CTL = 0;
constexpr size_t CTL_BYTES = 65536;
constexpr size_t CTL_CNT = 16384;
constexpr size_t WS_LB = WS_CTL + CTL_BYTES;
constexpr size_t WS_TINFO = WS_LB + 4096;
constexpr size_t WS_WIN0T = WS_TINFO + 4096;
constexpr size_t WS_WOUT0T = WS_WIN0T + (size_t)N_IN0 * D_ * 2;
constexpr size_t WS_WIN1T = WS_WOUT0T + (size_t)D_ * D_ * 2;
constexpr size_t WS_WOUT1T = WS_WIN1T + (size_t)N_IN1P * D_ * 2;
constexpr size_t WS_WGATES = WS_WOUT1T + (size_t)D_ * 4096 * 2;
constexpr size_t WS_WRT = WS_WGATES + (size_t)8 * 256 * 256 * 2;
constexpr size_t WS_WG = WS_WRT + (size_t)2 * 256 * D_ * 2;
constexpr size_t WS_WU = WS_WG + (size_t)NEXP * DEXP * D_ * 2;
constexpr size_t WS_WD = WS_WU + (size_t)NEXP * DEXP * D_ * 2;
constexpr size_t WS_X = WS_WD + (size_t)NEXP * DEXP * D_ * 2;
constexpr size_t WS_H = WS_X + (size_t)T_ * D_ * 4;
constexpr size_t WS_PROJ = WS_H + (size_t)T_ * D_ * 2;
constexpr size_t PROJ_BYTES = (size_t)T_ * N_IN1P * 2;
constexpr size_t WS_FLOG = WS_PROJ + (size_t)T_ * N_IN0 * 2;
constexpr size_t WS_XC = WS_FLOG + (size_t)T_ * 1024 * 4;
constexpr size_t WS_ACT = WS_PROJ;
constexpr size_t WS_YMOE = WS_ACT + (size_t)MPAD * DEXP * 2;
constexpr size_t WS_R1 = WS_PROJ + PROJ_BYTES;
constexpr size_t WS_A = WS_R1;
constexpr size_t WS_U = WS_R1 + (size_t)T_ * 1024 * 4;
constexpr size_t WS_QKVC = WS_R1;
constexpr size_t WS_Y = WS_R1 + (size_t)T_ * 8192 * 2;
constexpr size_t WS_O = WS_Y + (size_t)T_ * 4096 * 2;
constexpr size_t WS_TAIL = WS_O + (size_t)T_ * 4096 * 4;
constexpr size_t WS_BG = WS_TAIL + (size_t)T_ * 64 * 4;
constexpr size_t WS_LOGITS = WS_BG + (size_t)T_ * 64 * 4;
constexpr size_t WS_EID = WS_LOGITS + (size_t)T_ * 128 * 4;
constexpr size_t WS_SLOT = WS_EID + (size_t)T_ * 2 * 4;
constexpr size_t WS_GATE = WS_SLOT + (size_t)T_ * 2 * 4;
constexpr size_t WS_POSOF = WS_GATE + (size_t)T_ * 2 * 4;
constexpr size_t WS_ROWMAP = WS_POSOF + (size_t)T_ * 2 * 4;
constexpr size_t WS_H8 = WS_ROWMAP + (size_t)MPAD * 4;
constexpr size_t WS_RSP = WS_H8 + (size_t)T_ * D_;
constexpr size_t WS_END = WS_RSP + (size_t)T_ * 32 * 4;
static_assert(WS_YMOE + (size_t)MPAD * D_ * 2 <= WS_R1, "moe overlay");
static_assert(WS_XC + (size_t)T_ * 1024 * 2 <= WS_R1, "layer0 overlay");

struct Args {
    const float* in[28];
    float* out;
    unsigned char* ws;
    int ph_lo, ph_hi;
};

__device__ __forceinline__ int tidx_() { int t = (int)threadIdx.x; asm volatile("" : "+v"(t)); return t; }
#define TIDX tidx_()
typedef __bf16 bf16x2n __attribute__((ext_vector_type(2)));
__device__ __forceinline__ unsigned cvt_pk_bf16(float lo, float hi) { const f32x2 v = {lo, hi}; return __builtin_bit_cast(unsigned, __builtin_convertvector(v, bf16x2n)); }
__device__ __forceinline__ unsigned pk_fp8x4(float a, float b, float c, float d) { int v = __builtin_amdgcn_cvt_pk_fp8_f32(a, b, 0, false); v = __builtin_amdgcn_cvt_pk_fp8_f32(c, d, v, true); return (unsigned)v; }
constexpr float W8_SCALE = 64.0f, ACT8_SCALE = 8.0f;
__device__ __forceinline__ bf16_t f2bf(float x) { return (bf16_t)(cvt_pk_bf16(x, 0.f) & 0xffffu); }
__device__ __forceinline__ float bf_lo(unsigned w) { return __uint_as_float(w << 16); }
__device__ __forceinline__ float bf_hi(unsigned w) { return __uint_as_float(w & 0xffff0000u); }
__device__ __forceinline__ float bf1(bf16_t v) { return __uint_as_float(((unsigned)v) << 16); }
__device__ __forceinline__ float sigmoidf_(float x) { return __builtin_amdgcn_rcpf(1.0f + __expf(-x)); }
__device__ __forceinline__ float siluf_(float x) { return x * __builtin_amdgcn_rcpf(1.0f + __expf(-x)); }
__device__ __forceinline__ float softplusf_(float x) { return x > 20.f ? x : log1pf(__expf(x)); }
__device__ __forceinline__ float gelu_tanh(float x) { const float u = 0.7978845608028654f * (x + 0.044715f * x * x * x); return x * __builtin_amdgcn_rcpf(1.0f + __expf(-2.0f * u)); }
template <int CTRL> __device__ __forceinline__ float dpp_f(float v) { return __builtin_bit_cast(float, __builtin_amdgcn_update_dpp(0, __builtin_bit_cast(int, v), CTRL, 0xf, 0xf, false)); }
__device__ __forceinline__ float row16_sum(float s) { s += dpp_f<0x140>(s); s += dpp_f<0x141>(s); s += dpp_f<0xB1>(s); s += dpp_f<0x4E>(s); return s; }
__device__ __forceinline__ float wave_sum(float v) { v = row16_sum(v); v += __shfl_xor(v, 16); v += __shfl_xor(v, 32); return v; }

#define LDS_BARRIER() do { asm volatile("s_waitcnt lgkmcnt(0)" ::: "memory"); __builtin_amdgcn_s_barrier(); asm volatile("" ::: "memory"); } while (0)
#define XB_TMO      128
#define XB_XCNT(j)  (256  + 64 * (j))
#define XB_XSUB(j)  (1280 + 64 * (j))
#define XB_XGEN(j)  (2304 + 64 * (j))
#define XB_TOP      3328
#define XB_TOPGEN   3392
#define XCD_BAR_WORDS 3456
#define XB_SPIN_CAP (1u << 18)

__device__ __forceinline__ unsigned xb_ld(unsigned* p)              { return __hip_atomic_load(p, __ATOMIC_RELAXED, __HIP_MEMORY_SCOPE_AGENT); }
__device__ __forceinline__ unsigned xb_add(unsigned* p, unsigned v) { return __hip_atomic_fetch_add(p, v, __ATOMIC_RELAXED, __HIP_MEMORY_SCOPE_AGENT); }
__device__ __forceinline__ unsigned xb_xcc_id() { return (unsigned)__builtin_amdgcn_s_getreg((3 << 11) | 20) & 0xFu; }
#define XB_SPIN(cond, bar) do { unsigned _sp = 0; while (cond) { __builtin_amdgcn_s_sleep(1); \
    if ((++_sp & 255u) == 0u) { if (xb_ld(&(bar)[XB_TMO])) break; if (_sp > XB_SPIN_CAP) { atomicAdd(&(bar)[XB_TMO], 1u); break; } } } } while (0)

struct XcdBarrier { unsigned* bar; unsigned x; volatile LAS unsigned* st; };

__device__ __forceinline__ XcdBarrier xcd_barrier_post(unsigned* bar, volatile LAS unsigned* st) {
    XcdBarrier b; b.bar = bar; b.x = xb_xcc_id(); b.st = st;
    if (TIDX == 0) (void)xb_add(&bar[XB_XCNT(b.x)], 1u);
    return b;
}
__device__ __forceinline__ void xcd_barrier_complete(unsigned* bar, unsigned x, unsigned& nloc, unsigned& nx) {
    const unsigned G = gridDim.x * gridDim.y * gridDim.z;
    unsigned sum, cnt, mine, sp = 0u;
    for (;;) {
        sum = 0u; cnt = 0u; mine = 0u;
#pragma unroll
        for (unsigned j = 0; j < 16; ++j) { const unsigned c = xb_ld(&bar[XB_XCNT(j)]); sum += c; cnt += (c > 0u) ? 1u : 0u; mine = (j == x) ? c : mine; }
        if (sum == G) break;
        __builtin_amdgcn_s_sleep(1);
        if ((++sp & 255u) == 0u) { if (xb_ld(&bar[XB_TMO])) break; if (sp > XB_SPIN_CAP) { atomicAdd(&bar[XB_TMO], 1u); break; } }
    }
    nloc = mine > 0u ? mine : 1u; nx = cnt > 0u ? cnt : 1u;
}
__device__ __forceinline__ void xcd_barrier(const XcdBarrier& b) {
    asm volatile("s_waitcnt vmcnt(0)" ::: "memory");
    __syncthreads();
    if (TIDX == 0) {
        unsigned* bar = b.bar;
        __builtin_amdgcn_s_waitcnt(0);
        unsigned nloc = b.st[0], nx = b.st[1];
        if (nloc == 0u) { xcd_barrier_complete(bar, b.x, nloc, nx); b.st[0] = nloc; b.st[1] = nx; }
        const unsigned old = xb_add(&bar[XB_XSUB(b.x)], 1u);
        const unsigned gen = old / nloc;
        if (old + 1u == (gen + 1u) * nloc) {
            __builtin_amdgcn_fence(__ATOMIC_RELEASE, "agent");
            asm volatile("s_waitcnt vmcnt(0)" ::: "memory");
            const unsigned og = xb_add(&bar[XB_TOP], 1u);
            const unsigned tg = og / nx;
            if (og + 1u == (tg + 1u) * nx) xb_add(&bar[XB_TOPGEN], 1u);
            else XB_SPIN(xb_ld(&bar[XB_TOPGEN]) == tg, bar);
            __builtin_amdgcn_fence(__ATOMIC_ACQUIRE, "agent");
            xb_add(&bar[XB_XGEN(b.x)], 1u);
            asm volatile("s_waitcnt vmcnt(0)" ::: "memory");
        } else {
            XB_SPIN(xb_ld(&bar[XB_XGEN(b.x)]) == gen, bar);
            __builtin_amdgcn_fence(__ATOMIC_ACQUIRE, "agent");
            asm volatile("s_waitcnt vmcnt(0)" ::: "memory");
        }
    }
    __syncthreads();
}

constexpr int BM = 256, BK = 64, HALF = 128, HTB = HALF * BK * 2;
__device__ __forceinline__ int lds_byte(int r, int c) { const int st = (r >> 4) * 2 + (c >> 5), rr = r & 15, cc = c & 31, ob = rr * 64 + cc * 2; return st * 1024 + (ob ^ (((ob >> 9) & 1) << 5)); }
__device__ __forceinline__ void stage_rc(int b, int& R, int& C) { const int st = b / 1024, sb = b % 1024, swz = sb ^ (((sb >> 9) & 1) << 5); R = (st >> 1) * 16 + swz / 64; C = (st & 1) * 32 + (swz % 64) / 2; }
__device__ __forceinline__ int perm32(int rho) { const int n = rho >> 4, i = rho & 15; return 8 * (i >> 2) + 4 * n + (i & 3); }

__device__ __forceinline__ void stage_pos(int tid, int& R0, int& C0) { stage_rc(tid * 16, R0, C0); }
__device__ __forceinline__ int perm_row(int R) { return (R & ~31) + perm32(R & 31); }

#define BID ((int)blockIdx.x)
#define NBLK ((int)gridDim.x)
#define BID_ BID
#define NBLK_ NBLK
typedef f32x4 Acc[2][2][4][2];
struct UnitD { const char* gA; const char* gB; int t0, t1, t2; };

typedef int i32x8 __attribute__((ext_vector_type(8)));
typedef int i32x4 __attribute__((ext_vector_type(4)));
template <bool GATHER, bool FP8, class Src, class Epi>
__device__ __forceinline__ void gemm_stream(LAS unsigned char* lds, const Src& S, const int nt, const Epi& E) {
    const int tid = TIDX, wid = tid >> 6, lane = tid & 63, wr = wid >> 2, wc = wid & 3, fr = lane & 15, fq = lane >> 4;
    const unsigned ldsw = (unsigned)wid * 1024u;
    const int aoff = lds_byte(wr * 64 + fr, fq * 8), boff = lds_byte(wc * 32 + fr, fq * 8);
    const size_t kstep = (size_t)(BK * 2);
#define G_SA(b, h) (((b) * 2 + (h)) * HTB)
#define G_SB(b, h) ((4 + (b) * 2 + (h)) * HTB)
#define G_STAGE(bufoff, gbase, v) do { _Pragma("unroll") for (int _i = 0; _i < 2; ++_i) \
        __builtin_amdgcn_global_load_lds((const unsigned*)((gbase) + (v)[_i]), (LAS unsigned*)(lds + (bufoff) + ldsw + _i * 8192), 16, 0, 0); } while (0)
#define G_LD8(p) __builtin_shufflevector(*(const LAS i32x4*)(p), *(const LAS i32x4*)((p) + 1024), 0, 1, 2, 3, 4, 5, 6, 7)
#define G_LDA(dst, b, h) do { _Pragma("unroll") for (int m = 0; m < 4; ++m) dst[m] = G_LD8(lds + G_SA(b, h) + aoff + m * 2048); } while (0)
#define G_LDB(dst, b, h) do { _Pragma("unroll") for (int n = 0; n < 2; ++n) dst[n] = G_LD8(lds + G_SB(b, h) + boff + n * 2048); } while (0)
#define G_HALF(x, k) __builtin_bit_cast(bf16x8, __builtin_shufflevector((x), (x), 4 * (k), 4 * (k) + 1, 4 * (k) + 2, 4 * (k) + 3))
#define G_MMA(ai, bj, At, Bt) do { __builtin_amdgcn_s_setprio(1); _Pragma("unroll") for (int m = 0; m < 4; ++m) _Pragma("unroll") for (int n = 0; n < 2; ++n) { \
        if (FP8) asm volatile("v_mfma_f32_16x16x128_f8f6f4 %0, %1, %2, %0" : "+v"(acc[ai][bj][m][n]) : "v"(Bt[n]), "v"(At[m]));   \
        else { acc[ai][bj][m][n] = __builtin_amdgcn_mfma_f32_16x16x32_bf16(G_HALF(Bt[n], 0), G_HALF(At[m], 0), acc[ai][bj][m][n], 0, 0, 0); \
               acc[ai][bj][m][n] = __builtin_amdgcn_mfma_f32_16x16x32_bf16(G_HALF(Bt[n], 1), G_HALF(At[m], 1), acc[ai][bj][m][n], 0, 0, 0); } } \
        __builtin_amdgcn_s_setprio(0); } while (0)
#define G_WAIT_V(n) asm volatile("s_waitcnt vmcnt(" #n ")" ::: "memory")
#define G_WAIT_L(n) asm volatile("s_waitcnt lgkmcnt(" #n ")" ::: "memory")
#define G_BAR __builtin_amdgcn_s_barrier()
#define G_SCHED __builtin_amdgcn_sched_barrier(0)
    UnitD cur, nxt; int ui = 0;
    if (!S.next(0, cur)) return;
    unsigned va[2][2], vb[2][2], van[2][2];
    S.vb(vb); S.va(cur, va);
    Acc acc;
#pragma unroll
    for (int a = 0; a < 2; ++a)
#pragma unroll
        for (int b = 0; b < 2; ++b)
#pragma unroll
            for (int m = 0; m < 4; ++m)
#pragma unroll
                for (int n = 0; n < 2; ++n) acc[a][b][m][n] = (f32x4){0.f, 0.f, 0.f, 0.f};
    i32x8 At[4], B0[2], B1[2];
    const char* cA = cur.gA; const char* cB = cur.gB;
    G_WAIT_V(0);
    __syncthreads();
    G_STAGE(G_SB(0, 0), cB, vb[0]); G_STAGE(G_SA(0, 0), cA, va[0]); G_STAGE(G_SB(0, 1), cB, vb[1]); G_STAGE(G_SA(0, 1), cA, va[1]);
    if (wr == 1) G_BAR;
    G_WAIT_V(4); G_BAR;
    G_STAGE(G_SB(1, 0), cB + kstep, vb[0]); G_STAGE(G_SA(1, 0), cA + kstep, va[0]); G_STAGE(G_SB(1, 1), cB + kstep, vb[1]);
    G_WAIT_V(6); G_BAR;
    for (;;) {
        const bool has_next = S.next(ui + 1, nxt);
        const char* nA = has_next ? nxt.gA : cA; const char* nB = has_next ? nxt.gB : cB;
        if (GATHER) { if (has_next) S.va(nxt, van); else { van[0][0] = va[0][0]; van[0][1] = va[0][1]; van[1][0] = va[1][0]; van[1][1] = va[1][1]; } }
#pragma unroll 1
        for (int t = 0; t < nt; t += 2) {
            const bool last = (t == nt - 2);
            const char* a1 = cA + (size_t)(t + 1) * kstep;
            const char* a2 = last ? nA : cA + (size_t)(t + 2) * kstep; const char* b2 = last ? nB : cB + (size_t)(t + 2) * kstep;
            const char* a3 = a2 + kstep; const char* b3 = b2 + kstep;
            unsigned v2[2][2];
#pragma unroll
            for (int hh = 0; hh < 2; ++hh)
#pragma unroll
                for (int i = 0; i < 2; ++i) v2[hh][i] = (GATHER && last) ? van[hh][i] : va[hh][i];
            G_LDB(B0, 0, 0); G_SCHED; G_LDA(At, 0, 0); G_STAGE(G_SA(1, 1), a1, va[1]);
            G_WAIT_L(8); G_BAR; G_WAIT_L(0); G_MMA(0, 0, At, B0); G_BAR; G_SCHED;
            G_LDB(B1, 0, 1); G_STAGE(G_SB(0, 0), b2, vb[0]);
            G_BAR; G_WAIT_L(0); G_MMA(0, 1, At, B1); G_BAR;
            G_LDA(At, 0, 1); G_STAGE(G_SA(0, 0), a2, v2[0]);
            G_BAR; G_WAIT_L(0); G_MMA(1, 0, At, B0); G_BAR; G_SCHED;
            G_STAGE(G_SB(0, 1), b2, vb[1]);
            G_WAIT_V(6); G_BAR; G_MMA(1, 1, At, B1); G_BAR;
            G_LDB(B0, 1, 0); G_SCHED; G_LDA(At, 1, 0); G_STAGE(G_SA(0, 1), a2, v2[1]);
            G_WAIT_L(8); G_BAR; G_WAIT_L(0); G_MMA(0, 0, At, B0); G_BAR; G_SCHED;
            G_LDB(B1, 1, 1); G_STAGE(G_SB(1, 0), b3, vb[0]);
            G_BAR; G_WAIT_L(0); G_MMA(0, 1, At, B1); G_BAR;
            G_LDA(At, 1, 1); G_STAGE(G_SA(1, 0), a3, v2[0]);
            G_BAR; G_WAIT_L(0); G_MMA(1, 0, At, B0); G_BAR; G_SCHED;
            G_STAGE(G_SB(1, 1), b3, vb[1]);
            G_WAIT_V(6); G_BAR; G_MMA(1, 1, At, B1); G_BAR;
        }
        if (FP8) asm volatile("s_nop 15\n\ts_nop 15" ::: "memory");
        { int tz = TIDX; asm volatile("" : "+v"(tz));
          const int wid2 = tz >> 6, lane2 = tz & 63; E(acc, cur, wid2 >> 2, wid2 & 3, lane2 & 15, lane2 >> 4); }
        if (!has_next) break;
#pragma unroll
        for (int a = 0; a < 2; ++a)
#pragma unroll
            for (int b = 0; b < 2; ++b)
#pragma unroll
                for (int m = 0; m < 4; ++m)
#pragma unroll
                    for (int n = 0; n < 2; ++n) acc[a][b][m][n] = (f32x4){0.f, 0.f, 0.f, 0.f};
        cur = nxt; cA = nA; cB = nB; ++ui;
        if (GATHER) { va[0][0] = van[0][0]; va[0][1] = van[0][1]; va[1][0] = van[1][0]; va[1][1] = van[1][1]; }
    }
    G_WAIT_V(0);
    if (wr == 0) G_BAR;
    G_BAR;
#undef G_SA
#undef G_SB
#undef G_STAGE
#undef G_LDA
#undef G_LDB
#undef G_MMA
#undef G_LD8
#undef G_HALF
#undef G_WAIT_V
#undef G_WAIT_L
#undef G_BAR
#undef G_SCHED
}

__device__ __forceinline__ void offs_direct(unsigned (&v)[2][2], int ld, bool perm) {
    int R0, C0; stage_pos(TIDX, R0, C0);
#pragma unroll
    for (int i = 0; i < 2; ++i) { const int R = R0 + 64 * i, Rr = perm ? perm_row(R) : R;
        v[0][i] = (unsigned)(Rr * ld + C0) * 2u; v[1][i] = (unsigned)((Rr + HALF) * ld + C0) * 2u; }
}

struct SrcGrid {
    const char* A; const char* B; size_t astep, bstep; int nM, total, lda, ldb;
    __device__ __forceinline__ bool next(int i, UnitD& u) const { const int id = BID_ + i * NBLK_; if (id >= total) return false; u.t0 = id % nM; u.t1 = id / nM; u.t2 = 0;
        u.gA = A + (size_t)u.t0 * astep; u.gB = B + (size_t)u.t1 * bstep; return true; }
    __device__ __forceinline__ void va(const UnitD&, unsigned (&v)[2][2]) const { offs_direct(v, lda, false); }
    __device__ __forceinline__ void vb(unsigned (&v)[2][2]) const { offs_direct(v, ldb, true); }
};

__device__ __forceinline__ void store_bf16_tile(const Acc& acc, bf16_t* O, int ld, int wr, int wc, int fr, int fq, const float sc = 1.0f) {
#pragma unroll
    for (int ai = 0; ai < 2; ++ai)
#pragma unroll
        for (int m = 0; m < 4; ++m) { bf16_t* rowp = O + (size_t)(ai * HALF + wr * 64 + m * 16 + fr) * ld + wc * 32 + 8 * fq;
#pragma unroll
            for (int bj = 0; bj < 2; ++bj) { const f32x4 v0 = acc[ai][bj][m][0] * sc, v1 = acc[ai][bj][m][1] * sc;
                u32x4 w; w.x = cvt_pk_bf16(v0[0], v0[1]); w.y = cvt_pk_bf16(v0[2], v0[3]); w.z = cvt_pk_bf16(v1[0], v1[1]); w.w = cvt_pk_bf16(v1[2], v1[3]);
                *(u32x4*)(rowp + bj * HALF) = w; } }
}
__device__ __forceinline__ void store_f32_tile(const Acc& acc, float* O, const float* R, int ld, int ncol, int wr, int wc, int fr, int fq, const float sc = 1.0f) {
#pragma unroll
    for (int ai = 0; ai < 2; ++ai)
#pragma unroll
        for (int m = 0; m < 4; ++m) { const size_t ro = (size_t)(ai * HALF + wr * 64 + m * 16 + fr) * ld;
#pragma unroll
            for (int bj = 0; bj < 2; ++bj)
#pragma unroll
                for (int n = 0; n < 2; ++n) { const int c = bj * HALF + wc * 32 + 8 * fq + 4 * n; if (c >= ncol) continue;
                    f32x4 v = acc[ai][bj][m][n] * sc; if (R) v += *(const f32x4*)(R + ro + c); *(f32x4*)(O + ro + c) = v; } }
}
struct EpiProj {
    bf16_t* O; int ld; float* F; int fld, fp0, fp1, ncol; float sc;
    __device__ __forceinline__ void operator()(const Acc& acc, const UnitD& u, int wr, int wc, int fr, int fq) const {
        if (u.t1 >= fp0 && u.t1 < fp1) store_f32_tile(acc, F + (size_t)u.t0 * BM * fld + (u.t1 - fp0) * BM, nullptr, fld, ncol, wr, wc, fr, fq, sc);
        else store_bf16_tile(acc, O + (size_t)u.t0 * BM * ld + u.t1 * BM, ld, wr, wc, fr, fq, sc);
    }
};
struct EpiResid {
    unsigned char* ws; const float* Rf; float sc;
    __device__ __forceinline__ void row_done(float ss, const UnitD& u, int row, int wc, int fq) const {
        ss += __shfl_xor(ss, 16); ss += __shfl_xor(ss, 32);
        if (fq == 0) ((float*)(ws + WS_RSP))[(size_t)(u.t0 * BM + row) * 32 + u.t1 * 4 + wc] = ss; }
    __device__ __forceinline__ void operator()(const Acc& acc, const UnitD& u, int wr, int wc, int fr, int fq) const {
        const size_t o = (size_t)u.t0 * BM * D_ + u.t1 * BM;
        bf16_t* O = (bf16_t*)(ws + WS_X); const bf16_t* Rb = O;
        if (Rf) {
#pragma unroll
            for (int am = 0; am < 8; ++am) { const int ai = am >> 2, m = am & 3; f32x4 r0[2], r1[2];
                const size_t ro = o + (size_t)(ai * HALF + wr * 64 + m * 16 + fr) * D_ + wc * 32 + 8 * fq; float ss = 0.f;
#pragma unroll
                for (int bj = 0; bj < 2; ++bj) { r0[bj] = *(const f32x4*)(Rf + ro + bj * HALF); r1[bj] = *(const f32x4*)(Rf + ro + bj * HALF + 4); }
#pragma unroll
                for (int bj = 0; bj < 2; ++bj) { const f32x4 v0 = acc[ai][bj][m][0] * sc + r0[bj], v1 = acc[ai][bj][m][1] * sc + r1[bj];
                    u32x4 w; w.x = cvt_pk_bf16(v0[0], v0[1]); w.y = cvt_pk_bf16(v0[2], v0[3]); w.z = cvt_pk_bf16(v1[0], v1[1]); w.w = cvt_pk_bf16(v1[2], v1[3]);
                    *(u32x4*)(O + ro + bj * HALF) = w;
                    ss += v0[0] * v0[0] + v0[1] * v0[1] + v0[2] * v0[2] + v0[3] * v0[3] + v1[0] * v1[0] + v1[1] * v1[1] + v1[2] * v1[2] + v1[3] * v1[3]; }
                row_done(ss, u, ai * HALF + wr * 64 + m * 16 + fr, wc, fq); }
        } else {
#pragma unroll
            for (int am = 0; am < 4; ++am) { const int ai = am >> 1; u32x4 rr[2][2];
#pragma unroll
                for (int mm = 0; mm < 2; ++mm) { const int m = (am & 1) * 2 + mm; const size_t ro = o + (size_t)(ai * HALF + wr * 64 + m * 16 + fr) * D_ + wc * 32 + 8 * fq;
#pragma unroll
                    for (int bj = 0; bj < 2; ++bj) rr[mm][bj] = *(const u32x4*)(Rb + ro + bj * HALF); }
#pragma unroll
                for (int mm = 0; mm < 2; ++mm) { const int m = (am & 1) * 2 + mm; const size_t ro = o + (size_t)(ai * HALF + wr * 64 + m * 16 + fr) * D_ + wc * 32 + 8 * fq; float ss = 0.f;
#pragma unroll
                    for (int bj = 0; bj < 2; ++bj) { f32x4 v0 = acc[ai][bj][m][0] * sc, v1 = acc[ai][bj][m][1] * sc; const u32x4 r = rr[mm][bj];
                        v0[0] += bf_lo(r.x); v0[1] += bf_hi(r.x); v0[2] += bf_lo(r.y); v0[3] += bf_hi(r.y); v1[0] += bf_lo(r.z); v1[1] += bf_hi(r.z); v1[2] += bf_lo(r.w); v1[3] += bf_hi(r.w);
                        u32x4 w; w.x = cvt_pk_bf16(v0[0], v0[1]); w.y = cvt_pk_bf16(v0[2], v0[3]); w.z = cvt_pk_bf16(v1[0], v1[1]); w.w = cvt_pk_bf16(v1[2], v1[3]);
                        *(u32x4*)(O + ro + bj * HALF) = w;
                            ss += v0[0] * v0[0] + v0[1] * v0[1] + v0[2] * v0[2] + v0[3] * v0[3] + v1[0] * v1[0] + v1[1] * v1[1] + v1[2] * v1[2] + v1[3] * v1[3]; }
                    row_done(ss, u, ai * HALF + wr * 64 + m * 16 + fr, wc, fq); } }
        }
    }
};
struct EpiLogits {
    float* O;
    __device__ __forceinline__ void operator()(const Acc& acc, const UnitD& u, int wr, int wc, int fr, int fq) const { store_f32_tile(acc, O + (size_t)u.t0 * BM * 128, nullptr, 128, 128, wr, wc, fr, fq); }
};
struct EpiSwiGLU {
    unsigned char* O;
    __device__ __forceinline__ void operator()(const Acc& acc, const UnitD& u, int wr, int wc, int fr, int fq) const {
        unsigned char* o = O + (size_t)u.t0 * BM * DEXP + u.t1 * 128;
#pragma unroll
        for (int ai = 0; ai < 2; ++ai)
#pragma unroll
            for (int m = 0; m < 4; ++m) { unsigned char* rowp = o + (size_t)(ai * HALF + wr * 64 + m * 16 + fr) * DEXP + wc * 32 + 8 * fq;
                float r[8];
#pragma unroll
                for (int n = 0; n < 2; ++n)
#pragma unroll
                    for (int j = 0; j < 4; ++j) r[n * 4 + j] = (ACT8_SCALE / W8_SCALE) * siluf_(acc[ai][0][m][n][j] * (1.0f / W8_SCALE)) * acc[ai][1][m][n][j];
                u32x2 w; w.x = pk_fp8x4(r[0], r[1], r[2], r[3]); w.y = pk_fp8x4(r[4], r[5], r[6], r[7]);
                *(u32x2*)rowp = w; }
    }
};
struct EpiDown {
    unsigned char* O;
    __device__ __forceinline__ void operator()(const Acc& acc, const UnitD& u, int wr, int wc, int fr, int fq) const {
        unsigned char* o = O + (size_t)u.t0 * BM * D_ + u.t1 * BM; const float sc = 1.0f / (W8_SCALE * ACT8_SCALE);
#pragma unroll
        for (int ai = 0; ai < 2; ++ai)
#pragma unroll
            for (int m = 0; m < 4; ++m) { unsigned char* rowp = o + (size_t)(ai * HALF + wr * 64 + m * 16 + fr) * D_ + wc * 32 + 8 * fq;
#pragma unroll
                for (int bj = 0; bj < 2; ++bj) { const f32x4 v0 = acc[ai][bj][m][0] * sc, v1 = acc[ai][bj][m][1] * sc;
                    u32x2 w; w.x = pk_fp8x4(v0[0], v0[1], v0[2], v0[3]); w.y = pk_fp8x4(v1[0], v1[1], v1[2], v1[3]); *(u32x2*)(rowp + bj * HALF) = w; } }
    }
};
__device__ __forceinline__ unsigned rg_idx(unsigned tok, int c) { return ((((tok >> 12) * 64u + (unsigned)(c >> 4)) * (unsigned)S_ + (tok & (unsigned)(S_ - 1))) << 4) + (unsigned)(c & 15); }
struct EpiRgGates {
    bf16_t* LAo; bf16_t* Uo; const bf16_t* xc;
    const float* ba; const float* bx; const float* lam;
    __device__ __forceinline__ void operator()(const Acc& acc, const UnitD& u, int wr, int wc, int fr, int fq) const {
#pragma unroll
        for (int n = 0; n < 2; ++n) { const int c = u.t1 * 128 + wc * 32 + 8 * fq + 4 * n;
            u32x2 xq[2][4];
#pragma unroll
            for (int ai = 0; ai < 2; ++ai)
#pragma unroll
                for (int m = 0; m < 4; ++m) xq[ai][m] = *(const u32x2*)(xc + ((unsigned)(u.t0 * BM + ai * HALF + wr * 64 + m * 16 + fr) * 1024u + (unsigned)c));
            const f32x4 vba = *(const f32x4*)(ba + c), vbx = *(const f32x4*)(bx + c), vl = *(const f32x4*)(lam + c);
            f32x4 c8; for (int j = 0; j < 4; ++j) c8[j] = -8.0f * softplusf_(-vl[j]);
#pragma unroll
            for (int ai = 0; ai < 2; ++ai)
#pragma unroll
                for (int m = 0; m < 4; ++m) { const unsigned tok = (unsigned)(u.t0 * BM + ai * HALF + wr * 64 + m * 16 + fr);
                    const u32x2 xw = xq[ai][m]; const float xv[4] = {bf_lo(xw.x), bf_hi(xw.x), bf_lo(xw.y), bf_hi(xw.y)};
                    f32x4 lv, uv;
#pragma unroll
                    for (int j = 0; j < 4; ++j) { const float r = sigmoidf_(acc[ai][0][m][n][j] + vba[j]), ig = sigmoidf_(acc[ai][1][m][n][j] + vbx[j]);
                        const float la = c8[j] * r, av = __expf(la); lv[j] = la; uv[j] = __builtin_amdgcn_sqrtf(fmaxf(0.f, 1.0f - av * av)) * ig * xv[j]; }
                    const unsigned o = rg_idx(tok, c);
                    u32x2 w0; w0.x = cvt_pk_bf16(lv[0], lv[1]); w0.y = cvt_pk_bf16(lv[2], lv[3]); *(u32x2*)(LAo + o) = w0;
                    u32x2 w1; w1.x = cvt_pk_bf16(uv[0], uv[1]); w1.y = cvt_pk_bf16(uv[2], uv[3]); *(u32x2*)(Uo + o) = w1; } }
    }
};


__device__ __forceinline__ void transpose_job8(const float* src, unsigned char* dst, int K, int N, int ldd, size_t sb, size_t db, int nbatch, LAS unsigned char* lds) {
    const int tid = TIDX, tk = K / 128, tn = N / 64, per = tk * tn, total = per * nbatch;
    const int rr0 = tid >> 4, c4 = (tid & 15) * 4, n = tid >> 3, kg = (tid & 7) * 16;
    f32x4 va[4], vb[4];
#define T8_LD(v, t) { const int u_ = (t), ub_ = u_ / per, ur_ = u_ % per, uik_ = ur_ / tn, uin_ = ur_ % tn; const float* usp_ = src + (size_t)ub_ * sb + (size_t)(uik_ * 128 + rr0) * N + uin_ * 64 + c4; \
        _Pragma("unroll") for (int i = 0; i < 4; ++i) v[i] = *(const f32x4*)(usp_ + (size_t)(i * 32) * N); }
#define T8_ST(v, t, buf) { const int t_ = (t), b_ = t_ / per, r_ = t_ % per, ik_ = r_ / tn, in_ = r_ % tn; LAS float* tile = (LAS float*)(lds + (buf) * (128 * 65 * 4)); \
        _Pragma("unroll") for (int i = 0; i < 4; ++i) { const int rr = rr0 + i * 32; tile[rr * 65 + c4 + 0] = v[i][0]; tile[rr * 65 + c4 + 1] = v[i][1]; tile[rr * 65 + c4 + 2] = v[i][2]; tile[rr * 65 + c4 + 3] = v[i][3]; } \
        if (t_ + 2 * NBLK < total) T8_LD(v, t_ + 2 * NBLK) \
        LDS_BARRIER(); \
        float f[16]; \
        _Pragma("unroll") for (int j = 0; j < 16; ++j) f[j] = tile[(kg + j) * 65 + n] * W8_SCALE; \
        u32x4 w; w.x = pk_fp8x4(f[0], f[1], f[2], f[3]); w.y = pk_fp8x4(f[4], f[5], f[6], f[7]); w.z = pk_fp8x4(f[8], f[9], f[10], f[11]); w.w = pk_fp8x4(f[12], f[13], f[14], f[15]); \
        *(u32x4*)(dst + (size_t)b_ * db + (size_t)(in_ * 64 + n) * ldd + ik_ * 128 + kg) = w; }
    int t = BID;
    if (t < total) T8_LD(va, t)
    if (t + NBLK < total) T8_LD(vb, t + NBLK)
    for (; t < total; t += 2 * NBLK) {
        T8_ST(va, t, 0)
        if (t + NBLK < total) T8_ST(vb, t + NBLK, 1)
    }
#undef T8_LD
#undef T8_ST
    LDS_BARRIER();
}
__device__ __forceinline__ void transpose_job(const float* src, bf16_t* dst, int K, int N, int ldd, size_t sb, size_t db, int dalt, int nbatch, LAS unsigned char* lds) {
    const int tid = TIDX, tk = K / 64, tn = N / 64, per = tk * tn, total = per * nbatch;
    const int rr0 = tid >> 4, c4 = (tid & 15) * 4, n = tid >> 3, kg = (tid & 7) * 8;
    f32x4 va[2], vb[2];
#define T16_LD(v, t) { const int u_ = (t), ub_ = u_ / per, ur_ = u_ % per, uik_ = ur_ / tn, uin_ = ur_ % tn; const float* usp_ = src + (size_t)ub_ * sb + (size_t)(uik_ * 64 + rr0) * N + uin_ * 64 + c4; \
        _Pragma("unroll") for (int i = 0; i < 2; ++i) v[i] = *(const f32x4*)(usp_ + (size_t)(i * 32) * N); }
#define T16_ST(v, t, buf) { const int t_ = (t), b_ = t_ / per, r_ = t_ % per, ik_ = r_ / tn, in_ = r_ % tn; LAS float* tile = (LAS float*)(lds + (buf) * (64 * 65 * 4)); \
        _Pragma("unroll") for (int i = 0; i < 2; ++i) { const int rr = rr0 + i * 32; tile[rr * 65 + c4 + 0] = v[i][0]; tile[rr * 65 + c4 + 1] = v[i][1]; tile[rr * 65 + c4 + 2] = v[i][2]; tile[rr * 65 + c4 + 3] = v[i][3]; } \
        if (t_ + 2 * NBLK < total) T16_LD(v, t_ + 2 * NBLK) \
        LDS_BARRIER(); \
        float f[8]; \
        _Pragma("unroll") for (int j = 0; j < 8; ++j) f[j] = tile[(kg + j) * 65 + n]; \
        u32x4 w; w.x = cvt_pk_bf16(f[0], f[1]); w.y = cvt_pk_bf16(f[2], f[3]); w.z = cvt_pk_bf16(f[4], f[5]); w.w = cvt_pk_bf16(f[6], f[7]); \
        *(u32x4*)(dst + (size_t)b_ * db + (size_t)(b_ & 1) * dalt + (size_t)(in_ * 64 + n) * ldd + ik_ * 64 + kg) = w; }
    int t = BID;
    if (t < total) T16_LD(va, t)
    if (t + NBLK < total) T16_LD(vb, t + NBLK)
    for (; t < total; t += 2 * NBLK) {
        T16_ST(va, t, 0)
        if (t + NBLK < total) T16_ST(vb, t + NBLK, 1)
    }
#undef T16_LD
#undef T16_ST
    LDS_BARRIER();
}

__device__ __forceinline__ void moe_weight_jobs(const Args& a, int layer, LAS unsigned char* lds) {
    const size_t lo = (size_t)layer * NEXP * D_ * DEXP;
    transpose_job8(a.in[25] + lo, a.ws + WS_WG, D_, DEXP, D_, (size_t)D_ * DEXP, (size_t)DEXP * D_, NEXP, lds);
    transpose_job8(a.in[26] + lo, a.ws + WS_WU, D_, DEXP, D_, (size_t)D_ * DEXP, (size_t)DEXP * D_, NEXP, lds);
    transpose_job8(a.in[27] + lo, a.ws + WS_WD, DEXP, D_, DEXP, (size_t)D_ * DEXP, (size_t)DEXP * D_, NEXP, lds);
}

__device__ __forceinline__ void phase_prologue(const Args& a, LAS unsigned char* lds) {
    const int gtid = BID * NTHREADS + TIDX, gsz = NBLK * NTHREADS;
    for (int i = gtid; i < 1024; i += gsz) { const float l0 = a.in[12][i], l1 = a.in[12][1024 + i], mx = fmaxf(l0, l1), e0 = __expf(l0 - mx), e1 = __expf(l1 - mx);
        ((float*)(a.ws + WS_LB))[i] = e0 / (e0 + e1); }
    for (int it = gtid; it < 2 * 256 * 256; it += gsz) { const int l = it >> 16, n = (it >> 8) & 255, k8 = (it & 255) * 8; float f[8];
#pragma unroll
        for (int j = 0; j < 8; ++j) { const int k = k8 + j; f[j] = a.in[2][(size_t)l * D_ + k] * (n < 8 ? a.in[21][((size_t)l * D_ + k) * 8 + n] : (n < 72 ? a.in[23][((size_t)l * D_ + k) * 64 + (n - 8)] : 0.f)); }
        u32x4 w; w.x = cvt_pk_bf16(f[0], f[1]); w.y = cvt_pk_bf16(f[2], f[3]); w.z = cvt_pk_bf16(f[4], f[5]); w.w = cvt_pk_bf16(f[6], f[7]);
        *(u32x4*)((bf16_t*)(a.ws + WS_WRT) + ((size_t)l * 256 + n) * D_ + k8) = w; }
    for (int it = gtid; it < 192 * 128; it += gsz) *(u32x4*)(a.ws + WS_WIN1T + (size_t)N_IN1 * D_ + (size_t)it * 16) = (u32x4){0u, 0u, 0u, 0u};
    transpose_job(a.in[4], (bf16_t*)(a.ws + WS_WIN0T), D_, N_IN0, D_, 0, 0, 0, 1, lds);
    transpose_job(a.in[14], (bf16_t*)(a.ws + WS_WOUT0T), D_, D_, D_, 0, 0, 0, 1, lds);
    transpose_job8(a.in[15], a.ws + WS_WIN1T, D_, N_IN1, D_, 0, 0, 1, lds);
    transpose_job8(a.in[20], a.ws + WS_WOUT1T, 4096, D_, 4096, 0, 0, 1, lds);
    transpose_job(a.in[7], (bf16_t*)(a.ws + WS_WGATES), 128, 128, 128, 128 * 128, 256 * 128, 0, 8, lds);
    transpose_job(a.in[9], (bf16_t*)(a.ws + WS_WGATES) + 128 * 128, 128, 128, 128, 128 * 128, 256 * 128, 0, 8, lds);
    moe_weight_jobs(a, 0, lds);
}

#define NORM_PH(M, F) phase_norm<M, F>
template <int MODE, bool F32>
__device__ __forceinline__ void phase_norm(const Args& a, const float* src, const float* gain, int layer) {
    const int wid = TIDX >> 6, lane = TIDX & 63;
    bf16_t* xw = (bf16_t*)(a.ws + WS_X); bf16_t* hw = (bf16_t*)(a.ws + WS_H);
    const unsigned char* ym = a.ws + WS_YMOE; const int* posof = (const int*)(a.ws + WS_POSOF); const float* gate = (const float*)(a.ws + WS_GATE);
    const int stride = NBLK * 16;
    f32x4 rf[2][8]; u32x2 rb[2][8]; int pp[2][2] = {{0, 0}, {0, 0}}; float pg[2][2] = {{0.f, 0.f}, {0.f, 0.f}};
#define NORM_LD(r) { _Pragma("unroll") for (int u = 0; u < 2; ++u) { _Pragma("unroll") for (int i = 0; i < 8; ++i) { \
            if (F32) rf[u][i] = *(const f32x4*)(src + (size_t)((r) + u) * D_ + (i * 64 + lane) * 4); else rb[u][i] = *(const u32x2*)(xw + (size_t)((r) + u) * D_ + (i * 64 + lane) * 4); } \
            if (MODE >= 1) { pp[u][0] = posof[((r) + u) * 2]; pp[u][1] = posof[((r) + u) * 2 + 1]; pg[u][0] = gate[((r) + u) * 2]; pg[u][1] = gate[((r) + u) * 2 + 1]; } } }
    int row = (BID * 8 + wid) * 2;
    if (row < T_) NORM_LD(row)
    for (; row < T_; row += stride) {
        f32x4 v[2][8]; int p[2][2]; float g[2][2];
#pragma unroll
        for (int u = 0; u < 2; ++u) { p[u][0] = pp[u][0]; p[u][1] = pp[u][1]; g[u][0] = pg[u][0]; g[u][1] = pg[u][1];
#pragma unroll
            for (int i = 0; i < 8; ++i) v[u][i] = F32 ? rf[u][i] : (f32x4){bf_lo(rb[u][i].x), bf_hi(rb[u][i].x), bf_lo(rb[u][i].y), bf_hi(rb[u][i].y)}; }
        if (row + stride < T_) NORM_LD(row + stride)
        if (MODE >= 1) {
            int y[2][8][2];
#pragma unroll
            for (int u = 0; u < 2; ++u) {
#pragma unroll
                for (int i = 0; i < 8; ++i) { const int c = (i * 64 + lane) * 4; y[u][i][0] = *(const int*)(ym + (size_t)p[u][0] * D_ + c); y[u][i][1] = *(const int*)(ym + (size_t)p[u][1] * D_ + c); } }
#pragma unroll
            for (int u = 0; u < 2; ++u) { const float g0 = g[u][0], g1 = g[u][1];
#pragma unroll
                for (int i = 0; i < 8; ++i) { const int y0 = y[u][i][0], y1 = y[u][i][1];
                    const f32x2 a0 = __builtin_amdgcn_cvt_pk_f32_fp8(y0, false), a1 = __builtin_amdgcn_cvt_pk_f32_fp8(y0, true), b0 = __builtin_amdgcn_cvt_pk_f32_fp8(y1, false), b1 = __builtin_amdgcn_cvt_pk_f32_fp8(y1, true);
                    v[u][i][0] += g0 * a0[0] + g1 * b0[0]; v[u][i][1] += g0 * a0[1] + g1 * b0[1]; v[u][i][2] += g0 * a1[0] + g1 * b1[0]; v[u][i][3] += g0 * a1[1] + g1 * b1[1]; }
                if (MODE == 1) {
#pragma unroll
                    for (int i = 0; i < 8; ++i) { u32x2 w; w.x = cvt_pk_bf16(v[u][i][0], v[u][i][1]); w.y = cvt_pk_bf16(v[u][i][2], v[u][i][3]); *(u32x2*)(xw + (size_t)(row + u) * D_ + (i * 64 + lane) * 4) = w; } } }
        }
#pragma unroll
        for (int u = 0; u < 2; ++u) {
            float ss = 0.f;
#pragma unroll
            for (int i = 0; i < 8; ++i) ss += v[u][i][0] * v[u][i][0] + v[u][i][1] * v[u][i][1] + v[u][i][2] * v[u][i][2] + v[u][i][3] * v[u][i][3];
            ss = wave_sum(ss);
            const float rstd = rsqrtf(ss * (1.0f / D_) + 1e-6f);
#pragma unroll
            for (int i = 0; i < 8; ++i) { const int c = (i * 64 + lane) * 4; const f32x4 gn = *(const f32x4*)(gain + c);
                const f32x4 o = v[u][i] * rstd * gn;
                if (MODE == 2) *(f32x4*)(a.out + (size_t)(row + u) * D_ + c) = o;
                else { if (MODE != 1) { u32x2 w; w.x = cvt_pk_bf16(o[0], o[1]); w.y = cvt_pk_bf16(o[2], o[3]); *(u32x2*)(hw + (size_t)(row + u) * D_ + c) = w; }
                       if (layer >= 0) *(unsigned*)(a.ws + WS_H8 + (size_t)(row + u) * D_ + c) = pk_fp8x4(o[0], o[1], o[2], o[3]); } } }
    }
#undef NORM_LD
    (void)layer;
}

__device__ __forceinline__ void phase_gemm_in0(const Args& a, LAS unsigned char* lds) {
    SrcGrid S{(const char*)(a.ws + WS_H), (const char*)(a.ws + WS_WIN0T), (size_t)BM * D_ * 2, (size_t)BM * D_ * 2, 64, 64 * 24, D_, D_};
    EpiProj E{(bf16_t*)(a.ws + WS_PROJ), N_IN0, (float*)(a.ws + WS_FLOG), 1024, 12, 16, 256, 1.0f};
    gemm_stream<false, false>(lds, S, D_ / BK, E);
}

__device__ __forceinline__ void phase_rg_conv(const Args& a) {
    const bf16_t* p0 = (const bf16_t*)(a.ws + WS_PROJ); bf16_t* xc = (bf16_t*)(a.ws + WS_XC);
    const float* cw = a.in[5]; const float* cb = a.in[6];
    for (int it = BID * NTHREADS + TIDX; it < 128 * (T_ / 16); it += NBLK * NTHREADS) { const int c = (it & 127) * 8; const size_t t0 = (size_t)(it >> 7) * 16;
        float w[4][8], bias[8];
#pragma unroll
        for (int k = 0; k < 4; ++k) { const f32x4 w0 = *(const f32x4*)(cw + k * 1024 + c), w1 = *(const f32x4*)(cw + k * 1024 + c + 4);
            w[k][0] = w0[0]; w[k][1] = w0[1]; w[k][2] = w0[2]; w[k][3] = w0[3]; w[k][4] = w1[0]; w[k][5] = w1[1]; w[k][6] = w1[2]; w[k][7] = w1[3]; }
        { const f32x4 b0 = *(const f32x4*)(cb + c), b1 = *(const f32x4*)(cb + c + 4); bias[0] = b0[0]; bias[1] = b0[1]; bias[2] = b0[2]; bias[3] = b0[3]; bias[4] = b1[0]; bias[5] = b1[1]; bias[6] = b1[2]; bias[7] = b1[3]; }
        u32x4 x0 = (u32x4){0u, 0u, 0u, 0u}, x1 = x0, x2 = x0;
        if ((t0 & (S_ - 1)) != 0) { x0 = *(const u32x4*)(p0 + (t0 - 3) * N_IN0 + c); x1 = *(const u32x4*)(p0 + (t0 - 2) * N_IN0 + c); x2 = *(const u32x4*)(p0 + (t0 - 1) * N_IN0 + c); }
        u32x4 xr[16];
#pragma unroll
        for (int r = 0; r < 16; ++r) xr[r] = *(const u32x4*)(p0 + (t0 + r) * N_IN0 + c);
#pragma unroll
        for (int r = 0; r < 16; ++r) { const u32x4 x3 = xr[r];
            float acc[8];
#define TAPS(j, f, m) (bias[j] + w[0][j] * f(x0.m) + w[1][j] * f(x1.m) + w[2][j] * f(x2.m) + w[3][j] * f(x3.m))
            acc[0] = TAPS(0, bf_lo, x); acc[1] = TAPS(1, bf_hi, x); acc[2] = TAPS(2, bf_lo, y); acc[3] = TAPS(3, bf_hi, y);
            acc[4] = TAPS(4, bf_lo, z); acc[5] = TAPS(5, bf_hi, z); acc[6] = TAPS(6, bf_lo, w); acc[7] = TAPS(7, bf_hi, w);
#undef TAPS
            u32x4 o; o.x = cvt_pk_bf16(acc[0], acc[1]); o.y = cvt_pk_bf16(acc[2], acc[3]); o.z = cvt_pk_bf16(acc[4], acc[5]); o.w = cvt_pk_bf16(acc[6], acc[7]);
            *(u32x4*)(xc + (t0 + r) * 1024 + c) = o;
            x0 = x1; x1 = x2; x2 = x3; } }
}

struct SrcRgGates {
    const char* xc; const char* w; int total;
    __device__ __forceinline__ bool next(int i, UnitD& u) const { const int id = BID + i * NBLK; if (id >= total) return false; u.t0 = id & 63; u.t1 = id >> 6; u.t2 = 0;
        u.gA = xc + ((size_t)u.t0 * BM * 1024 + u.t1 * 128) * 2; u.gB = w + (size_t)u.t1 * 256 * 128 * 2; return true; }
    __device__ __forceinline__ void va(const UnitD&, unsigned (&v)[2][2]) const { offs_direct(v, 1024, false); }
    __device__ __forceinline__ void vb(unsigned (&v)[2][2]) const { offs_direct(v, 128, true); }
};
__device__ __forceinline__ void phase_rg_gates(const Args& a, LAS unsigned char* lds) {
    SrcRgGates S{(const char*)(a.ws + WS_XC), (const char*)(a.ws + WS_WGATES), 64 * 8};
    EpiRgGates E{(bf16_t*)(a.ws + WS_A), (bf16_t*)(a.ws + WS_U), (const bf16_t*)(a.ws + WS_XC), a.in[8], a.in[10], a.in[11]};
    int nt = 2; asm volatile("" : "+s"(nt));
    gemm_stream<false, false>(lds, S, nt, E);
}

__device__ __forceinline__ void phase_rg_scan(const Args& a, LAS unsigned char* lds) {
    const bf16_t* LA = (const bf16_t*)(a.ws + WS_A); const bf16_t* U = (const bf16_t*)(a.ws + WS_U);
    const bf16_t* p0 = (const bf16_t*)(a.ws + WS_PROJ); bf16_t* Y = (bf16_t*)(a.ws + WS_Y);
    LAS float* sP = (LAS float*)lds; LAS float* sH = sP + 4096; LAS float* gP = sH + 4096; LAS float* gH = gP + 512; LAS float* gC = gH + 512;
    const int tid = TIDX, seg = tid >> 1, c8 = (tid & 1) * 8;
    for (int blk = BID; blk < NB_ * 64; blk += NBLK) { const int b = blk >> 6, c = (blk & 63) * 16 + c8;
        const size_t base = (((size_t)blk * S_ + seg * 16) << 4) + c8;
        float P[8], H[8];
#pragma unroll
        for (int j = 0; j < 8; ++j) { P[j] = 1.f; H[j] = 0.f; }
#pragma unroll 4
        for (int s = 0; s < 16; ++s) { const u32x4 lw = *(const u32x4*)(LA + base + (size_t)s * 16), uw = *(const u32x4*)(U + base + (size_t)s * 16);
            const float la[8] = {bf_lo(lw.x), bf_hi(lw.x), bf_lo(lw.y), bf_hi(lw.y), bf_lo(lw.z), bf_hi(lw.z), bf_lo(lw.w), bf_hi(lw.w)};
            const float uu[8] = {bf_lo(uw.x), bf_hi(uw.x), bf_lo(uw.y), bf_hi(uw.y), bf_lo(uw.z), bf_hi(uw.z), bf_lo(uw.w), bf_hi(uw.w)};
#pragma unroll
            for (int j = 0; j < 8; ++j) { const float av = __expf(la[j]); H[j] = av * H[j] + uu[j]; P[j] *= av; } }
        __syncthreads();
#pragma unroll
        for (int j = 0; j < 8; ++j) { sP[seg * 16 + c8 + j] = P[j]; sH[seg * 16 + c8 + j] = H[j]; }
        __syncthreads();
        { const int ch = tid & 15, grp = tid >> 4; float p = 1.f, h = 0.f;
#pragma unroll
          for (int q = 0; q < 8; ++q) { const int sgi = grp * 8 + q; h = sP[sgi * 16 + ch] * h + sH[sgi * 16 + ch]; p *= sP[sgi * 16 + ch]; }
          gP[grp * 16 + ch] = p; gH[grp * 16 + ch] = h; }
        __syncthreads();
        if (tid < 16) { float carry = 0.f; for (int g = 0; g < 32; ++g) { gC[g * 16 + tid] = carry; carry = gP[g * 16 + tid] * carry + gH[g * 16 + tid]; } }
        __syncthreads();
        { const int ch = tid & 15, grp = tid >> 4; float h = gC[grp * 16 + ch];
#pragma unroll
          for (int q = 0; q < 8; ++q) { const int sgi = grp * 8 + q; const float pin = sP[sgi * 16 + ch], hin = sH[sgi * 16 + ch]; sH[sgi * 16 + ch] = h; h = pin * h + hin; } }
        __syncthreads();
#pragma unroll
        for (int j = 0; j < 8; ++j) H[j] = sH[seg * 16 + c8 + j];
        {
            u32x4 l_a[4], u_a[4], g_a[4];
#define RS_LD(Lv, Uv, Gv, s0) { _Pragma("unroll") for (int j = 0; j < 4; ++j) { const int s_ = (s0) + j; Lv[j] = *(const u32x4*)(LA + base + (size_t)s_ * 16); Uv[j] = *(const u32x4*)(U + base + (size_t)s_ * 16); \
                Gv[j] = *(const u32x4*)(p0 + ((size_t)b * S_ + seg * 16 + s_) * N_IN0 + 1024 + c); } }
            RS_LD(l_a, u_a, g_a, 0)
#pragma unroll
            for (int s0 = 0; s0 < 16; s0 += 4) { u32x4 l_b[4], u_b[4], g_b[4];
#pragma unroll
                for (int j = 0; j < 4; ++j) { l_b[j] = l_a[j]; u_b[j] = u_a[j]; g_b[j] = g_a[j]; }
                if (s0 + 4 < 16) RS_LD(l_b, u_b, g_b, s0 + 4)
#pragma unroll
                for (int j = 0; j < 4; ++j) { const u32x4 lw = l_a[j], uw = u_a[j], gw = g_a[j]; const size_t t = (size_t)b * S_ + seg * 16 + s0 + j;
                    const float la[8] = {bf_lo(lw.x), bf_hi(lw.x), bf_lo(lw.y), bf_hi(lw.y), bf_lo(lw.z), bf_hi(lw.z), bf_lo(lw.w), bf_hi(lw.w)};
                    const float uu[8] = {bf_lo(uw.x), bf_hi(uw.x), bf_lo(uw.y), bf_hi(uw.y), bf_lo(uw.z), bf_hi(uw.z), bf_lo(uw.w), bf_hi(uw.w)};
                    const float gg[8] = {bf_lo(gw.x), bf_hi(gw.x), bf_lo(gw.y), bf_hi(gw.y), bf_lo(gw.z), bf_hi(gw.z), bf_lo(gw.w), bf_hi(gw.w)};
                    float y[8];
#pragma unroll
                    for (int q = 0; q < 8; ++q) { H[q] = __expf(la[q]) * H[q] + uu[q]; y[q] = H[q] * gelu_tanh(gg[q]); }
                    u32x4 o; o.x = cvt_pk_bf16(y[0], y[1]); o.y = cvt_pk_bf16(y[2], y[3]); o.z = cvt_pk_bf16(y[4], y[5]); o.w = cvt_pk_bf16(y[6], y[7]);
                    *(u32x4*)(Y + t * D_ + c) = o; }
#pragma unroll
                for (int j = 0; j < 4; ++j) { l_a[j] = l_b[j]; u_a[j] = u_b[j]; g_a[j] = g_b[j]; } }
#undef RS_LD
        }
    }
}

typedef short s16x4 __attribute__((ext_vector_type(4)));
__device__ __forceinline__ f32x4 mfma32(bf16x8 a, bf16x8 b, f32x4 c) { return __builtin_amdgcn_mfma_f32_16x16x32_bf16(a, b, c, 0, 0, 0); }
__device__ __forceinline__ bf16x8 lds_frag(LAS const unsigned char* p) { return *(const LAS bf16x8*)p; }
__device__ __forceinline__ s16x4 lds_tr4(LAS const unsigned char* p) { return __builtin_amdgcn_ds_read_tr16_b64_v4i16((LAS s16x4*)p); }
__device__ __forceinline__ bf16x8 lds_tr8(LAS const unsigned char* p, int rowskip_bytes) {
    const s16x4 lo = lds_tr4(p), hi = lds_tr4(p + rowskip_bytes); return __builtin_shufflevector(lo, hi, 0, 1, 2, 3, 4, 5, 6, 7); }
__device__ __forceinline__ bf16x8 pack8(const f32x4& lo, const f32x4& hi) { u32x4 w; w.x = cvt_pk_bf16(lo[0], lo[1]); w.y = cvt_pk_bf16(lo[2], lo[3]); w.z = cvt_pk_bf16(hi[0], hi[1]); w.w = cvt_pk_bf16(hi[2], hi[3]); return __builtin_bit_cast(bf16x8, w); }
constexpr int RSB = 272;

constexpr size_t WS_HQ = WS_O;
constexpr size_t WS_HA = WS_HQ + (size_t)2048 * 64 * 128 * 2;
constexpr size_t WS_HG = WS_HA + (size_t)2048 * 8 * 512 * 2;
constexpr size_t WS_HS = WS_HG + (size_t)2048 * 128 * 128 * 2;
constexpr size_t WS_HD = WS_HS + (size_t)2048 * 128 * 128 * 2;
static_assert(WS_HD + (size_t)2048 * 128 * 4 <= WS_TAIL, "hgrn overlay");

__device__ __forceinline__ void phase_hg1(const Args& a, LAS unsigned char* lds) {
    const bf16_t* p0 = (const bf16_t*)(a.ws + WS_PROJ); const float* flog = (const float*)(a.ws + WS_FLOG); const float* lb = (const float*)(a.ws + WS_LB);
    bf16_t* QG = (bf16_t*)(a.ws + WS_HQ); bf16_t* AG = (bf16_t*)(a.ws + WS_HA); bf16_t* GG = (bf16_t*)(a.ws + WS_HG); float* DG = (float*)(a.ws + WS_HD);
    constexpr int SEG = 0, QT = 4096, KT = QT + 64 * RSB, KH = KT + 64 * RSB, VS = KH + 64 * RSB;
    const int tid = TIDX, wid = tid >> 6, lane = tid & 63, I = lane & 15, G = lane >> 4, k2 = 2 * lane, sg = wid;
    LAS float* seg = (LAS float*)(lds + SEG);
    u32x4 pvv[2]; f32x2 pz[8]; unsigned pqw[8];
#define HG1_LOAD(it_) do { const int bh_ = (it_) >> 6, ck_ = (it_) & 63, h_ = bh_ & 7; const size_t t0_ = (size_t)(bh_ >> 3) * S_ + ck_ * 64; \
        _Pragma("unroll") for (int i = 0; i < 2; ++i) { const int c = tid + i * 512, s_ = c >> 4, v8 = (c & 15) * 8; pvv[i] = *(const u32x4*)(p0 + (t0_ + s_) * N_IN0 + 4096 + h_ * 128 + v8); } \
        _Pragma("unroll") for (int i = 0; i < 8; ++i) { const size_t t_ = t0_ + sg * 8 + i; pz[i] = *(const f32x2*)(flog + t_ * 1024 + h_ * 128 + k2); pqw[i] = *(const unsigned*)(p0 + t_ * N_IN0 + 2048 + h_ * 128 + k2); } } while (0)
    if (BID < 2048) HG1_LOAD(BID);
    for (int item = BID; item < 2048; item += NBLK) { const int bh = item >> 6, h = bh & 7;
        LDS_BARRIER();
#pragma unroll
        for (int i = 0; i < 2; ++i) { const int c = tid + i * 512, s = c >> 4, v8 = (c & 15) * 8; *(LAS u32x4*)(lds + VS + s * RSB + v8 * 2) = pvv[i]; }
        const f32x2 l2 = *(const f32x2*)(lb + h * 128 + k2);
        float f[8][2], cb[8][2]; unsigned qw[8]; float c0 = 0.f, c1 = 0.f;
#pragma unroll
        for (int i = 0; i < 8; ++i) { const f32x2 z = pz[i]; qw[i] = pqw[i];
            f[i][0] = l2[0] + (1.0f - l2[0]) * sigmoidf_(z[0]); f[i][1] = l2[1] + (1.0f - l2[1]) * sigmoidf_(z[1]);
            c0 += __logf(f[i][0]); c1 += __logf(f[i][1]); cb[i][0] = c0; cb[i][1] = c1; }
        *(LAS f32x2*)(seg + sg * 128 + k2) = (f32x2){c0, c1};
        if (item + NBLK < 2048) HG1_LOAD(item + NBLK);
        LDS_BARRIER();
        float off0 = 0.f, off1 = 0.f, tot0 = 0.f, tot1 = 0.f;
#pragma unroll
        for (int s2 = 0; s2 < 8; ++s2) { const f32x2 v = *(const LAS f32x2*)(seg + s2 * 128 + k2); tot0 += v[0]; tot1 += v[1]; if (s2 < sg) { off0 += v[0]; off1 += v[1]; } }
        const float et0 = __expf(tot0), et1 = __expf(tot1);
#pragma unroll
        for (int i = 0; i < 8; ++i) { const int t = sg * 8 + i;
            const float e0 = __expf(cb[i][0] + off0), e1 = __expf(cb[i][1] + off1), r0 = __builtin_amdgcn_rcpf(e0), r1 = __builtin_amdgcn_rcpf(e1), km0 = 1.0f - f[i][0], km1 = 1.0f - f[i][1];
            const unsigned qt = cvt_pk_bf16(siluf_(bf_lo(qw[i])) * e0, siluf_(bf_hi(qw[i])) * e1);
            *(LAS unsigned*)(lds + QT + t * RSB + k2 * 2) = qt; *(unsigned*)(QG + ((size_t)item * 64 + t) * 128 + k2) = qt;
            *(LAS unsigned*)(lds + KT + t * RSB + k2 * 2) = cvt_pk_bf16(km0 * r0, km1 * r1);
            *(LAS unsigned*)(lds + KH + t * RSB + k2 * 2) = cvt_pk_bf16(km0 * r0 * et0, km1 * r1 * et1); }
        if (sg == 0) *(f32x2*)(DG + (size_t)item * 128 + k2) = (f32x2){et0, et1};
        LDS_BARRIER();
        { const int tt = wid & 3, sp = wid >> 2;
          bf16x8 qf[4];
#pragma unroll
          for (int ks = 0; ks < 4; ++ks) qf[ks] = lds_frag(lds + QT + (16 * tt + I) * RSB + (32 * ks + 8 * G) * 2);
          f32x4 acc[2];
#pragma unroll
          for (int hh = 0; hh < 2; ++hh) { const int st = 2 * sp + hh; acc[hh] = (f32x4){0.f, 0.f, 0.f, 0.f};
              if (st <= tt) {
#pragma unroll
                  for (int ks = 0; ks < 4; ++ks) acc[hh] = mfma32(lds_frag(lds + KT + (16 * st + I) * RSB + (32 * ks + 8 * G) * 2), qf[ks], acc[hh]);
#pragma unroll
                  for (int r = 0; r < 4; ++r) if (16 * st + 4 * G + r > 16 * tt + I) acc[hh][r] = 0.f; } }
          *(bf16x8*)(AG + (((size_t)item * 4 + tt) * 2 + sp) * 512 + lane * 8) = pack8(acc[0], acc[1]); }
        { const int kt = wid, q = I >> 2, p = I & 3;
          bf16x8 ka[2];
#pragma unroll
          for (int ks = 0; ks < 2; ++ks) ka[ks] = lds_tr8(lds + KH + (32 * ks + 8 * G + q) * RSB + (16 * kt + 4 * p) * 2, 4 * RSB);
#pragma unroll
          for (int vt = 0; vt < 8; ++vt) { f32x4 acc = (f32x4){0.f, 0.f, 0.f, 0.f};
#pragma unroll
              for (int ks = 0; ks < 2; ++ks) acc = mfma32(ka[ks], lds_tr8(lds + VS + (32 * ks + 8 * G + q) * RSB + (16 * vt + 4 * p) * 2, 4 * RSB), acc);
              u32x2 w; w.x = cvt_pk_bf16(acc[0], acc[1]); w.y = cvt_pk_bf16(acc[2], acc[3]);
              *(u32x2*)(GG + ((size_t)item * 128 + 16 * vt + I) * 128 + 16 * kt + 4 * G) = w; } }
    }
#undef HG1_LOAD
}

__device__ __forceinline__ void phase_hg2(const Args& a) {
    const bf16_t* GG = (const bf16_t*)(a.ws + WS_HG); const float* DG = (const float*)(a.ws + WS_HD); bf16_t* SG = (bf16_t*)(a.ws + WS_HS);
    for (int gid = BID * NTHREADS + TIDX; gid < 32 * 4096; gid += NBLK * NTHREADS) { const int bh = gid >> 12, e = gid & 4095, v = e >> 5, k4 = (e & 31) * 4;
        f32x4 S = (f32x4){0.f, 0.f, 0.f, 0.f};
        const size_t o0 = (((size_t)bh * 64) * 128 + v) * 128 + k4; const float* dg = DG + (size_t)bh * 64 * 128 + k4;
        f32x4 da[8]; u32x2 ga[8];
#pragma unroll
        for (int j = 0; j < 8; ++j) { da[j] = *(const f32x4*)(dg + j * 128); ga[j] = *(const u32x2*)(GG + o0 + (size_t)j * 16384); }
#pragma unroll 1
        for (int n0 = 0; n0 < 64; n0 += 8) { f32x4 db[8]; u32x2 gb[8];
#pragma unroll
            for (int j = 0; j < 8; ++j) { db[j] = da[j]; gb[j] = ga[j]; }
            if (n0 + 8 < 64) {
#pragma unroll
                for (int j = 0; j < 8; ++j) { db[j] = *(const f32x4*)(dg + (n0 + 8 + j) * 128); gb[j] = *(const u32x2*)(GG + o0 + (size_t)(n0 + 8 + j) * 16384); } }
#pragma unroll
            for (int j = 0; j < 8; ++j) { u32x2 w; w.x = cvt_pk_bf16(S[0], S[1]); w.y = cvt_pk_bf16(S[2], S[3]); *(u32x2*)(SG + o0 + (size_t)(n0 + j) * 16384) = w;
                const f32x4 d = da[j]; const u32x2 g = ga[j];
                S[0] = d[0] * S[0] + bf_lo(g.x); S[1] = d[1] * S[1] + bf_hi(g.x); S[2] = d[2] * S[2] + bf_lo(g.y); S[3] = d[3] * S[3] + bf_hi(g.y); }
#pragma unroll
            for (int j = 0; j < 8; ++j) { da[j] = db[j]; ga[j] = gb[j]; } } }
}

__device__ __forceinline__ void phase_hg3(const Args& a, LAS unsigned char* lds) {
    const bf16_t* p0 = (const bf16_t*)(a.ws + WS_PROJ); const bf16_t* QG = (const bf16_t*)(a.ws + WS_HQ); const bf16_t* AG = (const bf16_t*)(a.ws + WS_HA); const bf16_t* SG = (const bf16_t*)(a.ws + WS_HS);
    bf16_t* Y = (bf16_t*)(a.ws + WS_Y); const float* gain = a.in[13];
    constexpr int ST = 0, QT = 128 * RSB, VS = QT + 64 * RSB, PART = VS + 64 * RSB;
    const int tid = TIDX, wid = tid >> 6, lane = tid & 63, I = lane & 15, G = lane >> 4, q = I >> 2, p = I & 3;
    LAS float* part = (LAS float*)(lds + PART);
    const int tt = wid & 3, vh = wid >> 2;
    u32x4 ps[4], pq2[2], pv2[2]; bf16x8 paf[2];
#define HG3_LOAD(it_) do { const int bh_ = (it_) >> 6, ck_ = (it_) & 63; const size_t t0_ = (size_t)(bh_ >> 3) * S_ + ck_ * 64; const int h_ = bh_ & 7; \
        _Pragma("unroll") for (int i = 0; i < 4; ++i) { const int c = tid + i * 512, v = c >> 4, k8 = (c & 15) * 8; ps[i] = *(const u32x4*)(SG + ((size_t)(it_) * 128 + v) * 128 + k8); } \
        _Pragma("unroll") for (int i = 0; i < 2; ++i) { const int c = tid + i * 512, s_ = c >> 4, c8 = (c & 15) * 8; pq2[i] = *(const u32x4*)(QG + ((size_t)(it_) * 64 + s_) * 128 + c8); pv2[i] = *(const u32x4*)(p0 + (t0_ + s_) * N_IN0 + 4096 + h_ * 128 + c8); } \
        _Pragma("unroll") for (int sp = 0; sp < 2; ++sp) paf[sp] = *(const bf16x8*)(AG + (((size_t)(it_) * 4 + tt) * 2 + sp) * 512 + lane * 8); } while (0)
    if (BID < 2048) HG3_LOAD(BID);
    for (int item = BID; item < 2048; item += NBLK) { const int bh = item >> 6, ck = item & 63, b = bh >> 3, h = bh & 7; const size_t t0 = (size_t)b * S_ + ck * 64;
        LDS_BARRIER();
#pragma unroll
        for (int i = 0; i < 4; ++i) { const int c = tid + i * 512, v = c >> 4, k8 = (c & 15) * 8; *(LAS u32x4*)(lds + ST + v * RSB + k8 * 2) = ps[i]; }
#pragma unroll
        for (int i = 0; i < 2; ++i) { const int c = tid + i * 512, s2 = c >> 4, c8 = (c & 15) * 8; *(LAS u32x4*)(lds + QT + s2 * RSB + c8 * 2) = pq2[i]; *(LAS u32x4*)(lds + VS + s2 * RSB + c8 * 2) = pv2[i]; }
        bf16x8 af[2]; af[0] = paf[0]; af[1] = paf[1];
        if (item + NBLK < 2048) HG3_LOAD(item + NBLK);
        u32x2 zwp[4];
#pragma unroll
        for (int vi = 0; vi < 4; ++vi) zwp[vi] = *(const u32x2*)(p0 + (t0 + 16 * tt + I) * N_IN0 + 5120 + h * 128 + 16 * (4 * vh + vi) + 4 * G);
        LDS_BARRIER();
        bf16x8 qf[4];
#pragma unroll
        for (int ks = 0; ks < 4; ++ks) qf[ks] = lds_frag(lds + QT + (16 * tt + I) * RSB + (32 * ks + 8 * G) * 2);
        f32x4 acc[4]; float ss = 0.f;
#pragma unroll
        for (int vi = 0; vi < 4; ++vi) { const int vt = 4 * vh + vi; acc[vi] = (f32x4){0.f, 0.f, 0.f, 0.f};
#pragma unroll
            for (int ks = 0; ks < 4; ++ks) acc[vi] = mfma32(lds_frag(lds + ST + (16 * vt + I) * RSB + (32 * ks + 8 * G) * 2), qf[ks], acc[vi]);
#pragma unroll
            for (int sp = 0; sp < 2; ++sp) acc[vi] = mfma32(lds_tr8(lds + VS + (32 * sp + 4 * G + q) * RSB + (16 * vt + 4 * p) * 2, 16 * RSB), af[sp], acc[vi]);
            ss += acc[vi][0] * acc[vi][0] + acc[vi][1] * acc[vi][1] + acc[vi][2] * acc[vi][2] + acc[vi][3] * acc[vi][3]; }
        ss += __shfl_xor(ss, 16); ss += __shfl_xor(ss, 32);
        if (G == 0) part[wid * 16 + I] = ss;
        LDS_BARRIER();
        const float rstd = rsqrtf((part[wid * 16 + I] + part[(wid ^ 4) * 16 + I]) * (1.0f / 128.0f) + 1e-6f);
        const size_t t = t0 + 16 * tt + I;
#pragma unroll
        for (int vi = 0; vi < 4; ++vi) { const int c = h * 128 + 16 * (4 * vh + vi) + 4 * G;
            const f32x4 gn = *(const f32x4*)(gain + c); const u32x2 zw = zwp[vi];
            const float o0 = acc[vi][0] * rstd * gn[0] * siluf_(bf_lo(zw.x)), o1 = acc[vi][1] * rstd * gn[1] * siluf_(bf_hi(zw.x)), o2 = acc[vi][2] * rstd * gn[2] * siluf_(bf_lo(zw.y)), o3 = acc[vi][3] * rstd * gn[3] * siluf_(bf_hi(zw.y));
            u32x2 w; w.x = cvt_pk_bf16(o0, o1); w.y = cvt_pk_bf16(o2, o3); *(u32x2*)(Y + t * D_ + 1024 + c) = w; }
    }
#undef HG3_LOAD
}

__device__ __forceinline__ void phase_gdn_norm(const Args& a) {
    const bf16_t* O = (const bf16_t*)(a.ws + WS_O); const bf16_t* pj = (const bf16_t*)(a.ws + WS_PROJ); unsigned char* Y = a.ws + WS_Y; const float* gain = a.in[19];
    const int lane = TIDX & 63, wid = TIDX >> 6, gc = (lane & 15) * 8;
    const f32x4 g0 = *(const f32x4*)(gain + gc), g1 = *(const f32x4*)(gain + gc + 4);
    u32x4 oa[8], za[8];
    int row = BID * 8 + wid; const int stride = NBLK * 8;
#define GN_LD(ov, zv, r) { _Pragma("unroll") for (int i = 0; i < 8; ++i) { const int c = (i * 64 + lane) * 8; ov[i] = *(const u32x4*)(O + (size_t)(r) * 4096 + c); zv[i] = *(const u32x4*)(pj + (size_t)(r) * N_IN1P + 8192 + c); } }
    if (row < T_) GN_LD(oa, za, row)
    for (; row < T_; row += stride) { u32x4 ob[8], zb[8];
#pragma unroll
        for (int i = 0; i < 8; ++i) { ob[i] = oa[i]; zb[i] = za[i]; }
        if (row + stride < T_) GN_LD(ob, zb, row + stride)
#pragma unroll
        for (int i = 0; i < 8; ++i) { const int c = (i * 64 + lane) * 8;
            const u32x4 ow = oa[i], zw = za[i];
            const float o[8] = {bf_lo(ow.x), bf_hi(ow.x), bf_lo(ow.y), bf_hi(ow.y), bf_lo(ow.z), bf_hi(ow.z), bf_lo(ow.w), bf_hi(ow.w)};
            const float z[8] = {bf_lo(zw.x), bf_hi(zw.x), bf_lo(zw.y), bf_hi(zw.y), bf_lo(zw.z), bf_hi(zw.z), bf_lo(zw.w), bf_hi(zw.w)};
            float ss = 0.f;
#pragma unroll
            for (int q = 0; q < 8; ++q) ss += o[q] * o[q];
            ss = row16_sum(ss);
            const float rstd = rsqrtf(ss * (1.0f / 128.0f) + 1e-6f);
            float y[8];
#pragma unroll
            for (int q = 0; q < 8; ++q) y[q] = o[q] * rstd * (q < 4 ? g0[q & 3] : g1[q & 3]) * siluf_(z[q]);
            u32x2 w; w.x = pk_fp8x4(y[0], y[1], y[2], y[3]); w.y = pk_fp8x4(y[4], y[5], y[6], y[7]);
            *(u32x2*)(Y + (size_t)row * 4096 + c) = w; }
#pragma unroll
        for (int i = 0; i < 8; ++i) { oa[i] = ob[i]; za[i] = zb[i]; }
    }
#undef GN_LD
}

template <bool FP8>
__device__ __forceinline__ void phase_gemm_out(const Args& a, LAS unsigned char* lds, int K, const void* w, const float* xin) {
    const int eb = FP8 ? 1 : 2;
    SrcGrid S{(const char*)(a.ws + WS_Y), (const char*)w, (size_t)BM * K * eb, (size_t)BM * K * eb, 64, 64 * 8, K * eb / 2, K * eb / 2};
    EpiResid E{a.ws, xin, FP8 ? 1.0f / W8_SCALE : 1.0f};
    gemm_stream<false, FP8>(lds, S, K * eb / 128, E);
}

struct SrcRouter {
    const char* h; const char* w;
    __device__ __forceinline__ bool next(int i, UnitD& u) const { const int id = BID + i * NBLK; if (id >= 256) return false; u.t0 = id & 63; u.t1 = id >> 6; u.t2 = 0;
        u.gA = h + ((size_t)u.t0 * BM * D_ + u.t1 * 512) * 2; u.gB = w + (size_t)u.t1 * 512 * 2; return true; }
    __device__ __forceinline__ void va(const UnitD&, unsigned (&v)[2][2]) const { offs_direct(v, D_, false); }
    __device__ __forceinline__ void vb(unsigned (&v)[2][2]) const { offs_direct(v, D_, true); }
};
struct EpiLogitsQ {
    float* O;
    __device__ __forceinline__ void operator()(const Acc& acc, const UnitD& u, int wr, int wc, int fr, int fq) const { store_f32_tile(acc, O + ((size_t)u.t1 * T_ + (size_t)u.t0 * BM) * 128, nullptr, 128, 128, wr, wc, fr, fq); }
};
__device__ __forceinline__ void phase_gemm_router(const Args& a, LAS unsigned char* lds, int layer) {
    SrcRouter S{(const char*)(a.ws + WS_X), (const char*)(a.ws + WS_WRT) + (size_t)layer * 256 * D_ * 2};
    EpiLogitsQ E{(float*)(a.ws + WS_O)};
    gemm_stream<false, false>(lds, S, 512 / BK, E);
}

__device__ __forceinline__ void phase_route(const Args& a, int layer) {
    const float* lg = (const float*)(a.ws + WS_O); const float* bg = a.in[22] + layer * 8; const float* be = a.in[24] + layer * 64;
    int* cnt = (int*)(a.ws + WS_CTL + CTL_CNT) + layer * 64;
    int* eid = (int*)(a.ws + WS_EID); int* slot = (int*)(a.ws + WS_SLOT); float* gate = (float*)(a.ws + WS_GATE); int* rowmap = (int*)(a.ws + WS_ROWMAP);
    const float* rsp = (const float*)(a.ws + WS_RSP);
    {
        const bf16_t* xw = (const bf16_t*)(a.ws + WS_X); const float* gain = a.in[2] + (size_t)layer * D_; const int wid = TIDX >> 6, lane = TIDX & 63, stride = NBLK * 16;
        u32x2 rb[2][8]; float ps[2];
#define RT_LD(r) { _Pragma("unroll") for (int u = 0; u < 2; ++u) { _Pragma("unroll") for (int i = 0; i < 8; ++i) rb[u][i] = *(const u32x2*)(xw + (size_t)((r) + u) * D_ + (i * 64 + lane) * 4); ps[u] = rsp[(size_t)((r) + u) * 32 + (lane & 31)]; } }
        int row = (BID * 8 + wid) * 2;
        if (row < T_) RT_LD(row)
        for (; row < T_; row += stride) { u32x2 rc[2][8]; float pc[2];
#pragma unroll
            for (int u = 0; u < 2; ++u) { pc[u] = ps[u];
#pragma unroll
                for (int i = 0; i < 8; ++i) rc[u][i] = rb[u][i]; }
            if (row + stride < T_) RT_LD(row + stride)
#pragma unroll
            for (int u = 0; u < 2; ++u) { const float rstd = rsqrtf(wave_sum(pc[u]) * (0.5f / D_) + 1e-6f);
#pragma unroll
                for (int i = 0; i < 8; ++i) { const int c = (i * 64 + lane) * 4; const f32x4 gn = *(const f32x4*)(gain + c);
                    *(unsigned*)(a.ws + WS_H8 + (size_t)(row + u) * D_ + c) = pk_fp8x4(bf_lo(rc[u][i].x) * rstd * gn[0], bf_hi(rc[u][i].x) * rstd * gn[1], bf_lo(rc[u][i].y) * rstd * gn[2], bf_hi(rc[u][i].y) * rstd * gn[3]); } } }
#undef RT_LD
    }
    const int gtid = BID * NTHREADS + TIDX, gsz = NBLK * NTHREADS;
    for (int i = gtid; i < MPAD; i += gsz) rowmap[i] = 0;
    for (int t = gtid; t < T_; t += gsz) {
        f32x4 ga = (f32x4){0.f, 0.f, 0.f, 0.f}, gb = ga, sq = ga;
#pragma unroll
        for (int kq = 0; kq < 4; ++kq) { ga += *(const f32x4*)(lg + ((size_t)kq * T_ + t) * 128); gb += *(const f32x4*)(lg + ((size_t)kq * T_ + t) * 128 + 4); }
#pragma unroll
        for (int i = 0; i < 8; ++i) sq += *(const f32x4*)(rsp + (size_t)t * 32 + i * 4);
        const float rstd = rsqrtf((sq[0] + sq[1] + sq[2] + sq[3]) * (1.0f / D_) + 1e-6f);
        ga *= rstd; gb *= rstd;
        const float gl[8] = {ga[0] + bg[0], ga[1] + bg[1], ga[2] + bg[2], ga[3] + bg[3], gb[0] + bg[4], gb[1] + bg[5], gb[2] + bg[6], gb[3] + bg[7]};
        float mx = -3.0e38f; int gi = 0;
#pragma unroll
        for (int j = 0; j < 8; ++j) if (gl[j] > mx) { mx = gl[j]; gi = j; }
        float se = 0.f;
#pragma unroll
        for (int j = 0; j < 8; ++j) se += __expf(gl[j] - mx);
        const float gp = 1.0f / se;
        f32x4 ea = (f32x4){0.f, 0.f, 0.f, 0.f}, eb = ea;
#pragma unroll
        for (int kq = 0; kq < 4; ++kq) { ea += *(const f32x4*)(lg + ((size_t)kq * T_ + t) * 128 + 8 + gi * 8); eb += *(const f32x4*)(lg + ((size_t)kq * T_ + t) * 128 + 12 + gi * 8); }
        ea = ea * rstd + *(const f32x4*)(be + gi * 8); eb = eb * rstd + *(const f32x4*)(be + gi * 8 + 4);
        const float el[8] = {ea[0], ea[1], ea[2], ea[3], eb[0], eb[1], eb[2], eb[3]};
        float l1 = -3.0e38f, l2 = -3.0e38f; int i1 = 0, i2 = 0;
#pragma unroll
        for (int j = 0; j < 8; ++j) { const float v = el[j];
            if (v > l1) { l2 = l1; i2 = i1; l1 = v; i1 = j; } else if (v > l2) { l2 = v; i2 = j; } }
        const float e2 = __expf(l2 - l1), inv = 1.0f / (1.0f + e2);
        const int e0 = gi * 8 + i1, e1 = gi * 8 + i2;
        eid[t * 2] = e0; eid[t * 2 + 1] = e1; gate[t * 2] = inv * gp; gate[t * 2 + 1] = e2 * inv * gp;
        slot[t * 2] = atomicAdd(&cnt[e0], 1); slot[t * 2 + 1] = atomicAdd(&cnt[e1], 1); }
}

__device__ __forceinline__ void phase_rowmap(const Args& a, LAS unsigned char* lds, int layer) {
    const int* cnt = (const int*)(a.ws + WS_CTL + CTL_CNT) + layer * 64; LAS int* ps = (LAS int*)lds;
    int* tinfo = (int*)(a.ws + WS_TINFO) + layer * 512;
    const int* eid = (const int*)(a.ws + WS_EID); const int* slot = (const int*)(a.ws + WS_SLOT); int* posof = (int*)(a.ws + WS_POSOF); int* rowmap = (int*)(a.ws + WS_ROWMAP);
    __syncthreads();
    if (TIDX == 0) { int acc = 0; for (int e = 0; e < 64; ++e) { ps[e] = acc; acc += (cnt[e] + 255) & ~255; } ps[64] = acc; }
    __syncthreads();
    if (BID == 0) { if (TIDX <= 64) tinfo[TIDX] = ps[TIDX]; if (TIDX == 65) tinfo[65] = ps[64] >> 8;
        if (TIDX < 192) { const int p = TIDX * 256; int e = 0; for (int j = 0; j < 64; ++j) if (ps[j + 1] <= p) e = j + 1; tinfo[128 + TIDX] = e < 64 ? e : 63; } }
    for (int i = BID * NTHREADS + TIDX; i < T_ * 2; i += NBLK * NTHREADS) { const int p = ps[eid[i]] + slot[i]; posof[i] = p; rowmap[p] = i >> 1; }
    __syncthreads();
}

struct SrcMoeUp {
    const char* h; const char* wg; const int* tinfo; const int* rowmap; int total;
    __device__ __forceinline__ bool next(int i, UnitD& u) const { const int id = BID + i * NBLK; if (id >= total) return false; u.t0 = id >> 2; u.t1 = id & 3;
        u.t2 = __builtin_amdgcn_readfirstlane(tinfo[128 + u.t0]); u.gA = h; u.gB = wg + ((size_t)u.t2 * DEXP + u.t1 * 128) * D_; return true; }
    __device__ __forceinline__ void va(const UnitD& u, unsigned (&v)[2][2]) const { int R0, C0; stage_pos(TIDX, R0, C0);
#pragma unroll
        for (int hh = 0; hh < 2; ++hh)
#pragma unroll
            for (int i = 0; i < 2; ++i) v[hh][i] = (unsigned)(rowmap[u.t0 * 256 + hh * 128 + R0 + 64 * i] * D_ + C0 * 2); }
    __device__ __forceinline__ void vb(unsigned (&v)[2][2]) const { int R0, C0; stage_pos(TIDX, R0, C0);
#pragma unroll
        for (int i = 0; i < 2; ++i) { const int Rr = perm_row(R0 + 64 * i); v[0][i] = (unsigned)(Rr * D_ + C0 * 2); v[1][i] = (unsigned)(WS_WU - WS_WG) + (unsigned)(Rr * D_ + C0 * 2); } }
};
__device__ __forceinline__ void phase_moe_up(const Args& a, LAS unsigned char* lds, int layer) {
    const int* tinfo = (const int*)(a.ws + WS_TINFO) + layer * 512;
    const int ntm = __builtin_amdgcn_readfirstlane(tinfo[65]);
    SrcMoeUp S{(const char*)(a.ws + WS_H8), (const char*)(a.ws + WS_WG), tinfo, (const int*)(a.ws + WS_ROWMAP), ntm * 4};
    EpiSwiGLU E{a.ws + WS_ACT};
    gemm_stream<true, true>(lds, S, D_ / 128, E);
}

struct SrcMoeDown {
    const char* act; const char* wd; const int* tinfo; int total;
    __device__ __forceinline__ bool next(int i, UnitD& u) const { const int id = BID + i * NBLK; if (id >= total) return false; u.t0 = id >> 3; u.t1 = id & 7;
        u.t2 = __builtin_amdgcn_readfirstlane(tinfo[128 + u.t0]); u.gA = act + (size_t)u.t0 * BM * DEXP; u.gB = wd + ((size_t)u.t2 * D_ + u.t1 * BM) * DEXP; return true; }
    __device__ __forceinline__ void va(const UnitD&, unsigned (&v)[2][2]) const { offs_direct(v, DEXP / 2, false); }
    __device__ __forceinline__ void vb(unsigned (&v)[2][2]) const { offs_direct(v, DEXP / 2, true); }
};
__device__ __forceinline__ void phase_moe_down(const Args& a, LAS unsigned char* lds, int layer) {
    const int* tinfo = (const int*)(a.ws + WS_TINFO) + layer * 512; const int ntm = __builtin_amdgcn_readfirstlane(tinfo[65]);
    SrcMoeDown S{(const char*)(a.ws + WS_ACT), (const char*)(a.ws + WS_WD), tinfo, ntm * 8};
    EpiDown E{a.ws + WS_YMOE};
    gemm_stream<false, true>(lds, S, DEXP / 128, E);
}

struct SrcIn1Tail {
    const char* h; const char* w;
    __device__ __forceinline__ bool next(int i, UnitD& u) const { const int id = BID + i * NBLK; if (id >= 256) return false; u.t0 = id & 63; u.t1 = id >> 6; u.t2 = 0;
        u.gA = h + (size_t)u.t0 * BM * D_ + u.t1 * 512; u.gB = w + (size_t)48 * BM * D_ + u.t1 * 512; return true; }
    __device__ __forceinline__ void va(const UnitD&, unsigned (&v)[2][2]) const { offs_direct(v, D_ / 2, false); }
    __device__ __forceinline__ void vb(unsigned (&v)[2][2]) const { offs_direct(v, D_ / 2, true); }
};
struct EpiTailQ {
    float* O;
    __device__ __forceinline__ void operator()(const Acc& acc, const UnitD& u, int wr, int wc, int fr, int fq) const { store_f32_tile(acc, O + ((size_t)u.t1 * T_ + (size_t)u.t0 * BM) * 64, nullptr, 64, 64, wr, wc, fr, fq, 1.0f / W8_SCALE); }
};
__device__ __forceinline__ void phase_gemm_in1(const Args& a, LAS unsigned char* lds) {
    SrcGrid S{(const char*)(a.ws + WS_H8), (const char*)(a.ws + WS_WIN1T), (size_t)BM * D_, (size_t)BM * D_, 64, 64 * 48, D_ / 2, D_ / 2};
    EpiProj E{(bf16_t*)(a.ws + WS_PROJ), N_IN1P, nullptr, 64, 48, 48, 64, 1.0f / W8_SCALE};
    gemm_stream<false, true>(lds, S, D_ / 128, E);
}
__device__ __forceinline__ void phase_gemm_in1_tail(const Args& a, LAS unsigned char* lds) {
    SrcIn1Tail S{(const char*)(a.ws + WS_H8), (const char*)(a.ws + WS_WIN1T)};
    EpiTailQ E{(float*)(a.ws + WS_O)};
    int nt = 4; asm volatile("" : "+s"(nt));
    gemm_stream<false, true>(lds, S, nt, E);
}

__device__ __forceinline__ void phase_gdn_conv(const Args& a) {
    const bf16_t* p1 = (const bf16_t*)(a.ws + WS_PROJ); bf16_t* qc = (bf16_t*)(a.ws + WS_QKVC); const float* cw = a.in[16];
    const int gtid = BID * NTHREADS + TIDX, gsz = NBLK * NTHREADS;
    for (int it = gtid; it < 1024 * (T_ / 128); it += gsz) { const int c = (it & 1023) * 8, seg = it >> 10; const size_t t0 = (size_t)seg * 128;
        float w[4][8];
#pragma unroll
        for (int k = 0; k < 4; ++k) { const f32x4 w0 = *(const f32x4*)(cw + k * 8192 + c), w1 = *(const f32x4*)(cw + k * 8192 + c + 4);
            w[k][0] = w0[0]; w[k][1] = w0[1]; w[k][2] = w0[2]; w[k][3] = w0[3]; w[k][4] = w1[0]; w[k][5] = w1[1]; w[k][6] = w1[2]; w[k][7] = w1[3]; }
        u32x4 x0 = (u32x4){0u, 0u, 0u, 0u}, x1 = x0, x2 = x0;
        if ((t0 & (S_ - 1)) != 0) { x0 = *(const u32x4*)(p1 + (t0 - 3) * N_IN1P + c); x1 = *(const u32x4*)(p1 + (t0 - 2) * N_IN1P + c); x2 = *(const u32x4*)(p1 + (t0 - 1) * N_IN1P + c); }
        const float qsc = c < 2048 ? 0.08838834764831845f : 1.0f;
        u32x4 xa[8];
#pragma unroll
        for (int j = 0; j < 8; ++j) xa[j] = *(const u32x4*)(p1 + (t0 + j) * N_IN1P + c);
#pragma unroll 1
        for (int r0 = 0; r0 < 128; r0 += 8) { u32x4 xb[8];
#pragma unroll
            for (int j = 0; j < 8; ++j) xb[j] = xa[j];
            if (r0 + 8 < 128) {
#pragma unroll
                for (int j = 0; j < 8; ++j) xb[j] = *(const u32x4*)(p1 + (t0 + r0 + 8 + j) * N_IN1P + c); }
#pragma unroll
          for (int j8 = 0; j8 < 8; ++j8) { const u32x4 x3 = xa[j8]; const int r = r0 + j8;
            float acc[8];
#define TAPS(j, f, m) (w[0][j] * f(x0.m) + w[1][j] * f(x1.m) + w[2][j] * f(x2.m) + w[3][j] * f(x3.m))
            acc[0] = TAPS(0, bf_lo, x); acc[1] = TAPS(1, bf_hi, x); acc[2] = TAPS(2, bf_lo, y); acc[3] = TAPS(3, bf_hi, y);
            acc[4] = TAPS(4, bf_lo, z); acc[5] = TAPS(5, bf_hi, z); acc[6] = TAPS(6, bf_lo, w); acc[7] = TAPS(7, bf_hi, w);
#undef TAPS
            float ss = 0.f;
#pragma unroll
            for (int j = 0; j < 8; ++j) { acc[j] = siluf_(acc[j]); ss += acc[j] * acc[j]; }
            ss = row16_sum(ss);
            const float sc = c < 4096 ? rsqrtf(ss + 1e-6f) * qsc : 1.0f;
            u32x4 o; o.x = cvt_pk_bf16(acc[0] * sc, acc[1] * sc); o.y = cvt_pk_bf16(acc[2] * sc, acc[3] * sc); o.z = cvt_pk_bf16(acc[4] * sc, acc[5] * sc); o.w = cvt_pk_bf16(acc[6] * sc, acc[7] * sc);
            *(u32x4*)(qc + (t0 + r) * 8192 + c) = o;
            x0 = x1; x1 = x2; x2 = x3; }
#pragma unroll
            for (int j = 0; j < 8; ++j) xa[j] = xb[j]; } }
    const float* tail = (const float*)(a.ws + WS_O); float* bgo = (float*)(a.ws + WS_BG);
    for (int it = gtid; it < T_ * 32; it += gsz) { const int t = it >> 5, hv = it & 31; float tb = 0.f, ta = 0.f;
#pragma unroll
        for (int kq = 0; kq < 4; ++kq) { tb += tail[((size_t)kq * T_ + t) * 64 + hv]; ta += tail[((size_t)kq * T_ + t) * 64 + 32 + hv]; }
        bgo[t * 64 + hv] = sigmoidf_(tb);
        bgo[t * 64 + 32 + hv] = -__expf(a.in[17][hv]) * softplusf_(ta + a.in[18][hv]); }
}

struct MoeTile { const float* src; unsigned char* dst; int lds_, ldd; };
__device__ __forceinline__ MoeTile moe_tile(const Args& a, int g) {
    const int job = g >> 14, r = g & 16383, e = r >> 8, rr = r & 255; MoeTile t;
    typedef __attribute__((address_space(1))) const float* gcf; gcf s25 = (gcf)a.in[25], s26 = (gcf)a.in[26]; asm volatile("" : "+s"(s25), "+s"(s26));
    if (job < 2) { const int ik = rr >> 3, in = rr & 7; t.lds_ = DEXP; t.ldd = D_;
        t.src = (const float*)(job ? s26 : s25) + ((size_t)(NEXP + e) * D_ + ik * 64) * DEXP + in * 64; t.dst = a.ws + (job ? WS_WU : WS_WG) + ((size_t)e * DEXP + in * 64) * D_ + ik * 64; }
    else { const int ik = rr >> 5, in = rr & 31; t.lds_ = D_; t.ldd = DEXP;
        t.src = a.in[27] + ((size_t)(NEXP + e) * DEXP + ik * 64) * D_ + in * 64; t.dst = a.ws + WS_WD + ((size_t)e * D_ + in * 64) * DEXP + ik * 64; }
    return t;
}
__device__ __forceinline__ void moe_tile_load(const MoeTile& t, int tid, f32x4 (&v)[2]) {
#pragma unroll
    for (int i = 0; i < 2; ++i) { const int idx = tid + i * 512, rr = idx >> 4, c4 = (idx & 15) * 4; v[i] = *(const f32x4*)(t.src + (size_t)rr * t.lds_ + c4); }
}
__device__ __forceinline__ void moe_tile_store(const MoeTile& t, int tid, const f32x4 (&v)[2], LAS float* tile) {
#pragma unroll
    for (int i = 0; i < 2; ++i) { const int idx = tid + i * 512, rr = idx >> 4, c4 = (idx & 15) * 4;
        tile[rr * 65 + c4 + 0] = v[i][0]; tile[rr * 65 + c4 + 1] = v[i][1]; tile[rr * 65 + c4 + 2] = v[i][2]; tile[rr * 65 + c4 + 3] = v[i][3]; }
    LDS_BARRIER();
    { const int n = tid >> 3, kg = (tid & 7) * 8; float f[8];
#pragma unroll
      for (int jj = 0; jj < 8; ++jj) f[jj] = tile[(kg + jj) * 65 + n] * W8_SCALE;
      u32x2 w; w.x = pk_fp8x4(f[0], f[1], f[2], f[3]); w.y = pk_fp8x4(f[4], f[5], f[6], f[7]);
      *(u32x2*)(t.dst + (size_t)n * t.ldd + kg) = w; }
    LDS_BARRIER();
}
constexpr int MOE_TILES = 3 * NEXP * 256;

__device__ __forceinline__ f32x4 mfma16(s16x4 a, s16x4 b, f32x4 c) { return __builtin_amdgcn_mfma_f32_16x16x16bf16_1k(a, b, c, 0, 0, 0); }
__device__ __forceinline__ s16x4 pack4(const f32x4& v) { u32x2 w; w.x = cvt_pk_bf16(v[0], v[1]); w.y = cvt_pk_bf16(v[2], v[3]); return __builtin_bit_cast(s16x4, w); }
__device__ __forceinline__ void phase_gdn_chunk(const Args& a, LAS unsigned char* lds) {
    const bf16_t* qc = (const bf16_t*)(a.ws + WS_QKVC); const float* bgi = (const float*)(a.ws + WS_BG); bf16_t* O = (bf16_t*)(a.ws + WS_O);
    constexpr int VRS = 144, KTRS = 136;
    constexpr int KT = 0, QS = KT + 128 * KTRS, WSL = QS + 64 * RSB, QKS = WSL + 64 * RSB, EE = QKS + 2048, EDD = EE + 256, SET = EDD + 256;
    constexpr int STL = 2 * SET, KS = STL + 64 * RSB, VS = KS + 64 * RSB, X2 = VS + 64 * VRS, LS = X2 + 2048, X1 = LS + 4096, GAM = X1 + 2048, BET = GAM + 256, LEND = BET + 256;
    static_assert(LEND <= LDS_XBW, "gdn lds");
    const int wid = __builtin_amdgcn_readfirstlane(TIDX >> 6);
    const int NCK = S_ / 64;
    for (int blk = BID; blk < NB_ * 32 * 2; blk += NBLK) {
        const int grp = (blk & 7) * 8 + (blk >> 5), mem = (blk >> 3) & 3, b = grp >> 4, hk = grp & 15, hv = 2 * hk + (mem >> 1), vhalf = mem & 1;
        __syncthreads();
        if (wid < 4) {
            const int vt = wid;
            f32x4 Sacc[8];
#pragma unroll
            for (int n = 0; n < 8; ++n) Sacc[n] = (f32x4){0.f, 0.f, 0.f, 0.f};
            { const int lane = TIDX & 63;
              for (int i = lane; i < 16 * RSB / 16; i += 64) *(LAS u32x4*)(lds + STL + 16 * vt * RSB + i * 16) = (u32x4){0u, 0u, 0u, 0u}; }
            int lz = TIDX & 63; asm volatile("" : "+v"(lz));
            const int lane = lz, I = lane & 15, G = lane >> 4, q4 = I >> 2, p4 = I & 3;
            for (int it = 0; it <= NCK; ++it) {
                const int set = ((it - 1) & 1) * SET; const size_t t0 = (size_t)b * S_ + (size_t)(it - 1) * 64;
                f32x4 U[4];
                if (it >= 1) {
#pragma unroll
                    for (int sa = 0; sa < 4; ++sa) U[sa] = mfma16(*(const LAS s16x4*)(lds + X2 + ((sa * 16 + I) * 16 + 4 * G) * 2), lds_tr4(lds + VS + (16 * sa + 4 * G + q4) * VRS + (16 * vt + 4 * p4) * 2), (f32x4){0.f, 0.f, 0.f, 0.f});
                    asm volatile("" : "+v"(U[0]), "+v"(U[1]), "+v"(U[2]), "+v"(U[3]) :: "memory");
                }
                LDS_BARRIER();
#pragma unroll
                for (int sa = 0; sa < 4; ++sa) {
                    if (it >= 1) {
                        bf16x8 sf[4];
#pragma unroll
                        for (int ks = 0; ks < 4; ++ks) sf[ks] = lds_frag(lds + STL + (16 * vt + I) * RSB + (32 * ks + 8 * G) * 2);
                        s16x4 kt[8];
#pragma unroll
                        for (int dt = 0; dt < 8; ++dt) kt[dt] = *(const LAS s16x4*)(lds + set + KT + (16 * dt + I) * KTRS + (16 * sa + 4 * G) * 2);
                        f32x4 dl = U[sa], oq = (f32x4){0.f, 0.f, 0.f, 0.f}, dl2 = oq, oq2 = oq;
#pragma unroll
                        for (int ks = 0; ks < 2; ++ks) { dl = mfma32(lds_frag(lds + set + WSL + (16 * sa + I) * RSB + (32 * ks + 8 * G) * 2), sf[ks], dl);
                            dl2 = mfma32(lds_frag(lds + set + WSL + (16 * sa + I) * RSB + (32 * (ks + 2) + 8 * G) * 2), sf[ks + 2], dl2);
                            oq = mfma32(lds_frag(lds + set + QS + (16 * sa + I) * RSB + (32 * ks + 8 * G) * 2), sf[ks], oq);
                            oq2 = mfma32(lds_frag(lds + set + QS + (16 * sa + I) * RSB + (32 * (ks + 2) + 8 * G) * 2), sf[ks + 2], oq2); }
                        dl += dl2; oq += oq2;
                        const s16x4 dfrag = pack4(dl);
                        const f32x4 e4 = *(const LAS f32x4*)(lds + set + EE + (16 * sa + 4 * G) * 4);
                        oq = mfma16(*(const LAS s16x4*)(lds + set + QKS + ((sa * 16 + I) * 16 + 4 * G) * 2), dfrag, oq * e4);
#pragma unroll
                        for (int r = 0; r < 4; ++r) O[(t0 + 16 * sa + 4 * G + r) * 4096 + hv * 128 + vhalf * 64 + 16 * vt + I] = f2bf(oq[r]);
                        const f32x4 ed4 = *(const LAS f32x4*)(lds + set + EDD + (16 * sa + 4 * G) * 4); const float e15 = *(const LAS float*)(lds + set + EE + (16 * sa + 15) * 4);
                        const s16x4 dsc = pack4(dl * ed4);
#pragma unroll
                        for (int dt = 0; dt < 8; ++dt) {
                            Sacc[dt] = mfma16(kt[dt], dsc, Sacc[dt] * e15);
                            *(LAS s16x4*)(lds + STL + (16 * vt + I) * RSB + (16 * dt + 4 * G) * 2) = pack4(Sacc[dt]); }
                    }
                    if (sa & 1) LDS_BARRIER();
                }
            }
        } else {
            const int pw = wid - 4;
            u32x4 pq[4], pk[4], pv[2]; float pb = 0.f, pg = 0.f;
            { const int ptid = TIDX - 256; const size_t t0 = (size_t)b * S_;
#pragma unroll
              for (int i = 0; i < 4; ++i) { const int c = ptid + i * 256, s2 = c >> 4, c8 = (c & 15) * 8; pq[i] = *(const u32x4*)(qc + (t0 + s2) * 8192 + hk * 128 + c8); pk[i] = *(const u32x4*)(qc + (t0 + s2) * 8192 + 2048 + hk * 128 + c8); }
#pragma unroll
              for (int i = 0; i < 2; ++i) { const int c = ptid + i * 256, s2 = c >> 3, c8 = (c & 7) * 8; pv[i] = *(const u32x4*)(qc + (t0 + s2) * 8192 + 4096 + hv * 128 + vhalf * 64 + c8); }
              if (pw == 1) { pb = bgi[(t0 + ptid - 64) * 64 + hv]; pg = bgi[(t0 + ptid - 64) * 64 + 32 + hv]; } }
            int lz = TIDX & 63; asm volatile("" : "+v"(lz));
            const int lane = lz, ptid = pw * 64 + lane, I = lane & 15, G = lane >> 4, q4 = I >> 2, p4 = I & 3;
            for (int it = 0; it <= NCK; ++it) {
                const int set = (it & 1) * SET; const bool act = it < NCK;
                if (act) {
#pragma unroll
                    for (int i = 0; i < 4; ++i) { const int c = ptid + i * 256, s2 = c >> 4, c8 = (c & 15) * 8; *(LAS u32x4*)(lds + set + QS + s2 * RSB + c8 * 2) = pq[i]; *(LAS u32x4*)(lds + KS + s2 * RSB + c8 * 2) = pk[i]; }
                    if (pw == 1) { float x = pg;
                        x += __builtin_bit_cast(float, __builtin_amdgcn_update_dpp(0, __builtin_bit_cast(int, x), 0x111, 0xf, 0xf, true));
                        x += __builtin_bit_cast(float, __builtin_amdgcn_update_dpp(0, __builtin_bit_cast(int, x), 0x112, 0xf, 0xf, true));
                        x += __builtin_bit_cast(float, __builtin_amdgcn_update_dpp(0, __builtin_bit_cast(int, x), 0x114, 0xf, 0xf, true));
                        x += __builtin_bit_cast(float, __builtin_amdgcn_update_dpp(0, __builtin_bit_cast(int, x), 0x118, 0xf, 0xf, true));
                        const float g15 = __shfl(x, 15, 16);
                        *(LAS float*)(lds + GAM + lane * 4) = x; *(LAS float*)(lds + set + EE + lane * 4) = __expf(x); *(LAS float*)(lds + set + EDD + lane * 4) = __expf(g15 - x); *(LAS float*)(lds + BET + lane * 4) = pb; }
                    if (it + 1 < NCK) { const size_t t1 = (size_t)b * S_ + (size_t)(it + 1) * 64;
#pragma unroll
                        for (int i = 0; i < 4; ++i) { const int c = ptid + i * 256, s2 = c >> 4, c8 = (c & 15) * 8; pq[i] = *(const u32x4*)(qc + (t1 + s2) * 8192 + hk * 128 + c8); pk[i] = *(const u32x4*)(qc + (t1 + s2) * 8192 + 2048 + hk * 128 + c8); }
                        if (pw == 1) { pb = bgi[(t1 + ptid - 64) * 64 + hv]; pg = bgi[(t1 + ptid - 64) * 64 + 32 + hv]; } }
                }
                LDS_BARRIER();
                if (act) { const int sa = pw;
#pragma unroll
                    for (int i = 0; i < 2; ++i) { const int c = ptid + i * 256, s2 = c >> 3, c8 = (c & 7) * 8; *(LAS u32x4*)(lds + VS + s2 * VRS + c8 * 2) = pv[i]; }
                    if (it + 1 < NCK) { const size_t t1 = (size_t)b * S_ + (size_t)(it + 1) * 64;
#pragma unroll
                        for (int i = 0; i < 2; ++i) { const int c = ptid + i * 256, s2 = c >> 3, c8 = (c & 7) * 8; pv[i] = *(const u32x4*)(qc + (t1 + s2) * 8192 + 4096 + hv * 128 + vhalf * 64 + c8); } }
#pragma unroll
                    for (int ty = 0; ty < 2; ++ty) { f32x4 acc = (f32x4){0.f, 0.f, 0.f, 0.f};
#pragma unroll
                        for (int ks = 0; ks < 4; ++ks) { const bf16x8 ka = lds_frag(lds + KS + (16 * sa + I) * RSB + (32 * ks + 8 * G) * 2);
                            const bf16x8 bo = ty ? lds_frag(lds + set + QS + (16 * sa + I) * RSB + (32 * ks + 8 * G) * 2) : ka; acc = mfma32(ka, bo, acc); }
                        const f32x4 gr = *(const LAS f32x4*)(lds + GAM + (16 * sa + 4 * G) * 4); const float gc = *(const LAS float*)(lds + GAM + (16 * sa + I) * 4);
                        if (ty == 0) { const f32x4 br = *(const LAS f32x4*)(lds + BET + (16 * sa + 4 * G) * 4);
#pragma unroll
                            for (int r = 0; r < 4; ++r) { const float val = br[r] * acc[r] * __expf(gr[r] - gc); *(LAS float*)(lds + LS + ((sa * 16 + 4 * G + r) * 16 + I) * 4) = (I < 4 * G + r) ? val : 0.f; } }
                        else { f32x4 o;
#pragma unroll
                            for (int r = 0; r < 4; ++r) { const float val = acc[r] * __expf(gc - gr[r]); o[r] = (4 * G + r <= I) ? val : 0.f; }
                            *(LAS s16x4*)(lds + set + QKS + ((sa * 16 + I) * 16 + 4 * G) * 2) = pack4(o); } } }
                LDS_BARRIER();
                if (act) { const int sa = pw, c = lane >> 2, q = lane & 3;
                    f32x4 lv[16];
#pragma unroll
                    for (int i = 0; i < 16; ++i) lv[i] = *(const LAS f32x4*)(lds + LS + ((sa * 16 + i) * 16 + 4 * q) * 4);
                    float xo[4] = {0.f, 0.f, 0.f, 0.f}, xw[4] = {0.f, 0.f, 0.f, 0.f};
#pragma unroll
                    for (int i = 0; i < 16; ++i) {
                        float p = lv[i][0] * xo[0] + lv[i][1] * xo[1] + lv[i][2] * xo[2] + lv[i][3] * xo[3];
                        p += dpp_f<0xB1>(p); p += dpp_f<0x4E>(p);
                        const float xi = ((i == c) ? 1.0f : 0.0f) - p;
                        xo[i & 3] = (q == (i >> 2)) ? xi : xo[i & 3];
                        xw[i >> 2] = (q == (i & 3)) ? xi : xw[i >> 2]; }
                    const float bc = *(const LAS float*)(lds + BET + (sa * 16 + c) * 4), sc1 = -bc * *(const LAS float*)(lds + set + EE + (sa * 16 + c) * 4);
#pragma unroll
                    for (int k = 0; k < 4; ++k) { const int i = 4 * k + q; *(LAS bf16_t*)(lds + X1 + ((sa * 16 + i) * 16 + c) * 2) = f2bf(xw[k] * sc1); *(LAS bf16_t*)(lds + X2 + ((sa * 16 + i) * 16 + c) * 2) = f2bf(xw[k] * bc); } }
                asm volatile("" ::: "memory");
                if (act) { const int sa = pw;
                    const s16x4 xb = *(const LAS s16x4*)(lds + X1 + ((sa * 16 + I) * 16 + 4 * G) * 2); s16x4 kt[8]; f32x4 w[8];
#pragma unroll
                    for (int dt = 0; dt < 8; ++dt) kt[dt] = lds_tr4(lds + KS + (16 * sa + 4 * G + q4) * RSB + (16 * dt + 4 * p4) * 2);
#pragma unroll
                    for (int dt = 0; dt < 8; ++dt) { w[dt] = mfma16(kt[dt], xb, (f32x4){0.f, 0.f, 0.f, 0.f}); *(LAS s16x4*)(lds + set + KT + (16 * dt + I) * KTRS + (16 * sa + 4 * G) * 2) = kt[dt]; }
#pragma unroll
                    for (int dt = 0; dt < 8; ++dt) *(LAS s16x4*)(lds + set + WSL + (16 * sa + I) * RSB + (16 * dt + 4 * G) * 2) = pack4(w[dt]); }
                LDS_BARRIER();
            }
        }
    }
}

constexpr int N_PHASES = 30;
__global__ void __launch_bounds__(NTHREADS, 2) fwd(Args a0) {
    extern __shared__ __attribute__((aligned(16))) unsigned char smem_raw[];
    LAS unsigned char* lds = (LAS unsigned char*)smem_raw;
    volatile LAS unsigned* xbw = (volatile LAS unsigned*)(lds + LDS_XBW);
    if (TIDX == 0) { xbw[0] = 0u; xbw[1] = 0u; xbw[2] = 0u; xbw[3] = 0u; }
    __syncthreads();
    XcdBarrier bar = xcd_barrier_post((unsigned*)(a0.ws + WS_CTL), xbw);
#ifndef PHMASK
#define PHMASK 0xFFFFFFFFull
#endif
#ifndef DUPMASK
#define DUPMASK 0ull
#endif
#define PH(i, body) do { if (((PHMASK >> (i)) & 1ull) && a0.ph_lo <= (i) && (i) < a0.ph_hi) { __attribute__((address_space(1))) unsigned char* wsp_ = (__attribute__((address_space(1))) unsigned char*)a0.ws; asm volatile("" : "+s"(wsp_)); Args a = a0; a.ws = (unsigned char*)wsp_; const float* xin = a.in[0]; const float* xw = (const float*)(a.ws + WS_X); (void)xin; (void)xw; \
        if ((DUPMASK >> (i)) & 1ull) { body; xcd_barrier(bar); } body; if ((i) + 1 < a0.ph_hi) xcd_barrier(bar); } } while (0)
    PH(0, { phase_prologue(a, lds); __syncthreads(); NORM_PH(0, true)(a, xin, a.in[1], -1); });
    PH(2, phase_gemm_in0(a, lds));
    PH(3, { phase_rg_conv(a); __syncthreads(); phase_hg1(a, lds); });
    PH(4, { phase_rg_gates(a, lds); __syncthreads(); phase_hg2(a); });
    PH(5, { phase_rg_scan(a, lds); __syncthreads(); phase_hg3(a, lds); });
    PH(9, phase_gemm_out<false>(a, lds, D_, a.ws + WS_WOUT0T, xin));
    PH(11, phase_gemm_router(a, lds, 0));
    PH(12, phase_route(a, 0));
    PH(13, phase_rowmap(a, lds, 0));
    PH(14, phase_moe_up(a, lds, 0));
    PH(15, phase_moe_down(a, lds, 0));
    PH(16, { NORM_PH(1, false)(a, nullptr, a.in[1] + D_, 0); __syncthreads(); moe_weight_jobs(a, 1, lds); });
    PH(18, { phase_gemm_in1(a, lds); phase_gemm_in1_tail(a, lds); });
    PH(19, phase_gdn_conv(a));
    PH(20, phase_gdn_chunk(a, lds));
    PH(21, phase_gdn_norm(a));
    PH(22, phase_gemm_out<true>(a, lds, 4096, a.ws + WS_WOUT1T, nullptr));
    PH(24, phase_gemm_router(a, lds, 1));
    PH(25, phase_route(a, 1));
    PH(26, phase_rowmap(a, lds, 1));
    PH(27, phase_moe_up(a, lds, 1));
    PH(28, phase_moe_down(a, lds, 1));
    PH(29, NORM_PH(2, false)(a, nullptr, a.in[3], 1));
#undef PH
}

extern "C" void kernel_launch(void* const* d_in, const int* in_sizes, int n_in, void* d_out, int out_size, void* d_ws, size_t ws_size, hipStream_t stream) {
    static int grid = 0;
    if (grid == 0) {
        if (n_in != 28 || ws_size < WS_END) { fprintf(stderr, "kernel_launch: need 28 inputs and %zu bytes of workspace, got %d / %zu\n", (size_t)WS_END, n_in, ws_size); grid = -1; return; }
        int dev = 0, cus = 0, per_cu = 0;
        if (hipGetDevice(&dev) != hipSuccess || hipDeviceGetAttribute(&cus, hipDeviceAttributeMultiprocessorCount, dev) != hipSuccess) { grid = -1; return; }
        if (hipFuncSetAttribute((const void*)fwd, hipFuncAttributeMaxDynamicSharedMemorySize, LDS_BYTES) != hipSuccess) { fprintf(stderr, "kernel_launch: hipFuncSetAttribute failed\n"); grid = -1; return; }
        if (hipOccupancyMaxActiveBlocksPerMultiprocessor(&per_cu, (const void*)fwd, NTHREADS, LDS_BYTES) != hipSuccess || per_cu < 1) { fprintf(stderr, "kernel_launch: occupancy query says %d\n", per_cu); }
        (void)hipGetLastError();
        grid = cus;
    }
    if (grid < 0) return;
    (void)in_sizes; (void)out_size;
    hipMemsetAsync((char*)d_ws + WS_CTL, 0, CTL_BYTES, stream);
    Args a; memset(&a, 0, sizeof(a));
    for (int i = 0; i < 28; ++i) a.in[i] = (const float*)d_in[i];
    a.out = (float*)d_out; a.ws = (unsigned char*)d_ws;
#if N_LAUNCH_MODE == 1
    a.ph_lo = 0; a.ph_hi = N_PHASES;
    hipLaunchKernelGGL(fwd, dim3(grid), dim3(NTHREADS), LDS_BYTES, stream, a);
#if EXTRA_PH >= 0
    a.ph_lo = EXTRA_PH; a.ph_hi = EXTRA_PH + 1;
    hipLaunchKernelGGL(fwd, dim3(grid), dim3(NTHREADS), LDS_BYTES, stream, a);
#endif
#else
    for (int p = 0; p < N_PHASES; ++p) { a.ph_lo = p; a.ph_hi = p + 1; hipLaunchKernelGGL(fwd, dim3(grid), dim3(NTHREADS), LDS_BYTES, stream, a); }
#endif
}
```

```cpp
#include <hip/hip_runtime.h>
#include <stdint.h>
#include <stdio.h>
#include <string.h>

#ifndef EXTRA_PH
#define EXTRA_PH -1
#endif
#ifndef N_LAUNCH_MODE
#define N_LAUNCH_MODE 1
#endif

#define LAS __attribute__((address_space(3)))
typedef unsigned short bf16_t;
typedef short bf16x8 __attribute__((ext_vector_type(8)));
typedef float f32x4 __attribute__((ext_vector_type(4)));
typedef float f32x2 __attribute__((ext_vector_type(2)));
typedef unsigned u32x4 __attribute__((ext_vector_type(4)));
typedef unsigned u32x2 __attribute__((ext_vector_type(2)));

constexpr int T_ = 16384, D_ = 2048, S_ = 4096, NB_ = 4;
constexpr int N_IN0 = 6144, N_IN1 = 12352, N_IN1P = 12544;
constexpr int NEXP = 64, DEXP = 512, MPAD = 49152;
constexpr int NTHREADS = 512;
constexpr int LDS_MAIN = 131072;
constexpr int LDS_BYTES = 163840;
constexpr int LDS_XBW = LDS_BYTES - 16;

constexpr size_t al256(size_t x) { return (x + 255) & ~(size_t)255; }
constexpr size_t WS_CTL = 0;
constexpr size_t CTL_BYTES = 65536;
constexpr size_t CTL_CNT = 16384;
constexpr size_t WS_LB = WS_CTL + CTL_BYTES;
constexpr size_t WS_TINFO = WS_LB + 4096;
constexpr size_t WS_WIN0T = WS_TINFO + 4096;
constexpr size_t WS_WOUT0T = WS_WIN0T + (size_t)N_IN0 * D_ * 2;
constexpr size_t WS_WIN1T = WS_WOUT0T + (size_t)D_ * D_ * 2;
constexpr size_t WS_WOUT1T = WS_WIN1T + (size_t)N_IN1P * D_ * 2;
constexpr size_t WS_WGATES = WS_WOUT1T + (size_t)D_ * 4096 * 2;
constexpr size_t WS_WRT = WS_WGATES + (size_t)8 * 256 * 256 * 2;
constexpr size_t WS_WG = WS_WRT + (size_t)2 * 256 * D_ * 2;
constexpr size_t WS_WU = WS_WG + (size_t)NEXP * DEXP * D_ * 2;
constexpr size_t WS_WD = WS_WU + (size_t)NEXP * DEXP * D_ * 2;
constexpr size_t WS_X = WS_WD + (size_t)NEXP * DEXP * D_ * 2;
constexpr size_t WS_H = WS_X + (size_t)T_ * D_ * 4;
constexpr size_t WS_PROJ = WS_H + (size_t)T_ * D_ * 2;
constexpr size_t PROJ_BYTES = (size_t)T_ * N_IN1P * 2;
constexpr size_t WS_FLOG = WS_PROJ + (size_t)T_ * N_IN0 * 2;
constexpr size_t WS_XC = WS_FLOG + (size_t)T_ * 1024 * 4;
constexpr size_t WS_ACT = WS_PROJ;
constexpr size_t WS_YMOE = WS_ACT + (size_t)MPAD * DEXP * 2;
constexpr size_t WS_R1 = WS_PROJ + PROJ_BYTES;
constexpr size_t WS_A = WS_R1;
constexpr size_t WS_U = WS_R1 + (size_t)T_ * 1024 * 4;
constexpr size_t WS_QKVC = WS_R1;
constexpr size_t WS_Y = WS_R1 + (size_t)T_ * 8192 * 2;
constexpr size_t WS_O = WS_Y + (size_t)T_ * 4096 * 2;
constexpr size_t WS_TAIL = WS_O + (size_t)T_ * 4096 * 4;
constexpr size_t WS_BG = WS_TAIL + (size_t)T_ * 64 * 4;
constexpr size_t WS_LOGITS = WS_BG + (size_t)T_ * 64 * 4;
constexpr size_t WS_EID = WS_LOGITS + (size_t)T_ * 128 * 4;
constexpr size_t WS_SLOT = WS_EID + (size_t)T_ * 2 * 4;
constexpr size_t WS_GATE = WS_SLOT + (size_t)T_ * 2 * 4;
constexpr size_t WS_POSOF = WS_GATE + (size_t)T_ * 2 * 4;
constexpr size_t WS_ROWMAP = WS_POSOF + (size_t)T_ * 2 * 4;
constexpr size_t WS_H8 = WS_ROWMAP + (size_t)MPAD * 4;
constexpr size_t WS_RSP = WS_H8 + (size_t)T_ * D_;
constexpr size_t WS_END = WS_RSP + (size_t)T_ * 32 * 4;
static_assert(WS_YMOE + (size_t)MPAD * D_ * 2 <= WS_R1, "moe overlay");
static_assert(WS_XC + (size_t)T_ * 1024 * 2 <= WS_R1, "layer0 overlay");

struct Args {
    const float* in[28];
    float* out;
    unsigned char* ws;
    int ph_lo, ph_hi;
};

__device__ __forceinline__ int tidx_() { int t = (int)threadIdx.x; asm volatile("" : "+v"(t)); return t; }
#define TIDX tidx_()
typedef __bf16 bf16x2n __attribute__((ext_vector_type(2)));
__device__ __forceinline__ unsigned cvt_pk_bf16(float lo, float hi) { const f32x2 v = {lo, hi}; return __builtin_bit_cast(unsigned, __builtin_convertvector(v, bf16x2n)); }
__device__ __forceinline__ unsigned pk_fp8x4(float a, float b, float c, float d) { int v = __builtin_amdgcn_cvt_pk_fp8_f32(a, b, 0, false); v = __builtin_amdgcn_cvt_pk_fp8_f32(c, d, v, true); return (unsigned)v; }
constexpr float W8_SCALE = 64.0f, ACT8_SCALE = 8.0f;
__device__ __forceinline__ bf16_t f2bf(float x) { return (bf16_t)(cvt_pk_bf16(x, 0.f) & 0xffffu); }
__device__ __forceinline__ float bf_lo(unsigned w) { return __uint_as_float(w << 16); }
__device__ __forceinline__ float bf_hi(unsigned w) { return __uint_as_float(w & 0xffff0000u); }
__device__ __forceinline__ float bf1(bf16_t v) { return __uint_as_float(((unsigned)v) << 16); }
__device__ __forceinline__ float sigmoidf_(float x) { return __builtin_amdgcn_rcpf(1.0f + __expf(-x)); }
__device__ __forceinline__ float siluf_(float x) { return x * __builtin_amdgcn_rcpf(1.0f + __expf(-x)); }
__device__ __forceinline__ float softplusf_(float x) { return x > 20.f ? x : log1pf(__expf(x)); }
__device__ __forceinline__ float gelu_tanh(float x) { const float u = 0.7978845608028654f * (x + 0.044715f * x * x * x); return x * __builtin_amdgcn_rcpf(1.0f + __expf(-2.0f * u)); }
template <int CTRL> __device__ __forceinline__ float dpp_f(float v) { return __builtin_bit_cast(float, __builtin_amdgcn_update_dpp(0, __builtin_bit_cast(int, v), CTRL, 0xf, 0xf, false)); }
__device__ __forceinline__ float row16_sum(float s) { s += dpp_f<0x140>(s); s += dpp_f<0x141>(s); s += dpp_f<0xB1>(s); s += dpp_f<0x4E>(s); return s; }
__device__ __forceinline__ float wave_sum(float v) { v = row16_sum(v); v += __shfl_xor(v, 16); v += __shfl_xor(v, 32); return v; }

#define LDS_BARRIER() do { asm volatile("s_waitcnt lgkmcnt(0)" ::: "memory"); __builtin_amdgcn_s_barrier(); asm volatile("" ::: "memory"); } while (0)
#define XB_TMO      128
#define XB_XCNT(j)  (256  + 64 * (j))
#define XB_XSUB(j)  (1280 + 64 * (j))
#define XB_XGEN(j)  (2304 + 64 * (j))
#define XB_TOP      3328
#define XB_TOPGEN   3392
#define XCD_BAR_WORDS 3456
#define XB_SPIN_CAP (1u << 18)

__device__ __forceinline__ unsigned xb_ld(unsigned* p)              { return __hip_atomic_load(p, __ATOMIC_RELAXED, __HIP_MEMORY_SCOPE_AGENT); }
__device__ __forceinline__ unsigned xb_add(unsigned* p, unsigned v) { return __hip_atomic_fetch_add(p, v, __ATOMIC_RELAXED, __HIP_MEMORY_SCOPE_AGENT); }
__device__ __forceinline__ unsigned xb_xcc_id() { return (unsigned)__builtin_amdgcn_s_getreg((3 << 11) | 20) & 0xFu; }
#define XB_SPIN(cond, bar) do { unsigned _sp = 0; while (cond) { __builtin_amdgcn_s_sleep(1); \
    if ((++_sp & 255u) == 0u) { if (xb_ld(&(bar)[XB_TMO])) break; if (_sp > XB_SPIN_CAP) { atomicAdd(&(bar)[XB_TMO], 1u); break; } } } } while (0)

struct XcdBarrier { unsigned* bar; unsigned x; volatile LAS unsigned* st; };

__device__ __forceinline__ XcdBarrier xcd_barrier_post(unsigned* bar, volatile LAS unsigned* st) {
    XcdBarrier b; b.bar = bar; b.x = xb_xcc_id(); b.st = st;
    if (TIDX == 0) (void)xb_add(&bar[XB_XCNT(b.x)], 1u);
    return b;
}
__device__ __forceinline__ void xcd_barrier_complete(unsigned* bar, unsigned x, unsigned& nloc, unsigned& nx) {
    const unsigned G = gridDim.x * gridDim.y * gridDim.z;
    unsigned sum, cnt, mine, sp = 0u;
    for (;;) {
        sum = 0u; cnt = 0u; mine = 0u;
#pragma unroll
        for (unsigned j = 0; j < 16; ++j) { const unsigned c = xb_ld(&bar[XB_XCNT(j)]); sum += c; cnt += (c > 0u) ? 1u : 0u; mine = (j == x) ? c : mine; }
        if (sum == G) break;
        __builtin_amdgcn_s_sleep(1);
        if ((++sp & 255u) == 0u) { if (xb_ld(&bar[XB_TMO])) break; if (sp > XB_SPIN_CAP) { atomicAdd(&bar[XB_TMO], 1u); break; } }
    }
    nloc = mine > 0u ? mine : 1u; nx = cnt > 0u ? cnt : 1u;
}
__device__ __forceinline__ void xcd_barrier(const XcdBarrier& b) {
    asm volatile("s_waitcnt vmcnt(0)" ::: "memory");
    __syncthreads();
    if (TIDX == 0) {
        unsigned* bar = b.bar;
        __builtin_amdgcn_s_waitcnt(0);
        unsigned nloc = b.st[0], nx = b.st[1];
        if (nloc == 0u) { xcd_barrier_complete(bar, b.x, nloc, nx); b.st[0] = nloc; b.st[1] = nx; }
        const unsigned old = xb_add(&bar[XB_XSUB(b.x)], 1u);
        const unsigned gen = old / nloc;
        if (old + 1u == (gen + 1u) * nloc) {
            __builtin_amdgcn_fence(__ATOMIC_RELEASE, "agent");
            asm volatile("s_waitcnt vmcnt(0)" ::: "memory");
            const unsigned og = xb_add(&bar[XB_TOP], 1u);
            const unsigned tg = og / nx;
            if (og + 1u == (tg + 1u) * nx) xb_add(&bar[XB_TOPGEN], 1u);
            else XB_SPIN(xb_ld(&bar[XB_TOPGEN]) == tg, bar);
            __builtin_amdgcn_fence(__ATOMIC_ACQUIRE, "agent");
            xb_add(&bar[XB_XGEN(b.x)], 1u);
            asm volatile("s_waitcnt vmcnt(0)" ::: "memory");
        } else {
            XB_SPIN(xb_ld(&bar[XB_XGEN(b.x)]) == gen, bar);
            __builtin_amdgcn_fence(__ATOMIC_ACQUIRE, "agent");
            asm volatile("s_waitcnt vmcnt(0)" ::: "memory");
        }
    }
    __syncthreads();
}

constexpr int BM = 256, BK = 64, HALF = 128, HTB = HALF * BK * 2;
__device__ __forceinline__ int lds_byte(int r, int c) { const int st = (r >> 4) * 2 + (c >> 5), rr = r & 15, cc = c & 31, ob = rr * 64 + cc * 2; return st * 1024 + (ob ^ (((ob >> 9) & 1) << 5)); }
__device__ __forceinline__ void stage_rc(int b, int& R, int& C) { const int st = b / 1024, sb = b % 1024, swz = sb ^ (((sb >> 9) & 1) << 5); R = (st >> 1) * 16 + swz / 64; C = (st & 1) * 32 + (swz % 64) / 2; }
__device__ __forceinline__ int perm32(int rho) { const int n = rho >> 4, i = rho & 15; return 8 * (i >> 2) + 4 * n + (i & 3); }

__device__ __forceinline__ void stage_pos(int tid, int& R0, int& C0) { stage_rc(tid * 16, R0, C0); }
__device__ __forceinline__ int perm_row(int R) { return (R & ~31) + perm32(R & 31); }

#define BID ((int)blockIdx.x)
#define NBLK ((int)gridDim.x)
#define BID_ BID
#define NBLK_ NBLK
typedef f32x4 Acc[2][2][4][2];
struct UnitD { const char* gA; const char* gB; int t0, t1, t2; };

typedef int i32x8 __attribute__((ext_vector_type(8)));
typedef int i32x4 __attribute__((ext_vector_type(4)));
template <bool GATHER, bool FP8, class Src, class Epi>
__device__ __forceinline__ void gemm_stream(LAS unsigned char* lds, const Src& S, const int nt, const Epi& E) {
    const int tid = TIDX, wid = tid >> 6, lane = tid & 63, wr = wid >> 2, wc = wid & 3, fr = lane & 15, fq = lane >> 4;
    const unsigned ldsw = (unsigned)wid * 1024u;
    const int aoff = lds_byte(wr * 64 + fr, fq * 8), boff = lds_byte(wc * 32 + fr, fq * 8);
    const size_t kstep = (size_t)(BK * 2);
#define G_SA(b, h) (((b) * 2 + (h)) * HTB)
#define G_SB(b, h) ((4 + (b) * 2 + (h)) * HTB)
#define G_STAGE(bufoff, gbase, v) do { _Pragma("unroll") for (int _i = 0; _i < 2; ++_i) \
        __builtin_amdgcn_global_load_lds((const unsigned*)((gbase) + (v)[_i]), (LAS unsigned*)(lds + (bufoff) + ldsw + _i * 8192), 16, 0, 0); } while (0)
#define G_LD8(p) __builtin_shufflevector(*(const LAS i32x4*)(p), *(const LAS i32x4*)((p) + 1024), 0, 1, 2, 3, 4, 5, 6, 7)
#define G_LDA(dst, b, h) do { _Pragma("unroll") for (int m = 0; m < 4; ++m) dst[m] = G_LD8(lds + G_SA(b, h) + aoff + m * 2048); } while (0)
#define G_LDB(dst, b, h) do { _Pragma("unroll") for (int n = 0; n < 2; ++n) dst[n] = G_LD8(lds + G_SB(b, h) + boff + n * 2048); } while (0)
#define G_HALF(x, k) __builtin_bit_cast(bf16x8, __builtin_shufflevector((x), (x), 4 * (k), 4 * (k) + 1, 4 * (k) + 2, 4 * (k) + 3))
#define G_MMA(ai, bj, At, Bt) do { __builtin_amdgcn_s_setprio(1); _Pragma("unroll") for (int m = 0; m < 4; ++m) _Pragma("unroll") for (int n = 0; n < 2; ++n) { \
        if (FP8) asm volatile("v_mfma_f32_16x16x128_f8f6f4 %0, %1, %2, %0" : "+v"(acc[ai][bj][m][n]) : "v"(Bt[n]), "v"(At[m]));   \
        else { acc[ai][bj][m][n] = __builtin_amdgcn_mfma_f32_16x16x32_bf16(G_HALF(Bt[n], 0), G_HALF(At[m], 0), acc[ai][bj][m][n], 0, 0, 0); \
               acc[ai][bj][m][n] = __builtin_amdgcn_mfma_f32_16x16x32_bf16(G_HALF(Bt[n], 1), G_HALF(At[m], 1), acc[ai][bj][m][n], 0, 0, 0); } } \
        __builtin_amdgcn_s_setprio(0); } while (0)
#define G_WAIT_V(n) asm volatile("s_waitcnt vmcnt(" #n ")" ::: "memory")
#define G_WAIT_L(n) asm volatile("s_waitcnt lgkmcnt(" #n ")" ::: "memory")
#define G_BAR __builtin_amdgcn_s_barrier()
#define G_SCHED __builtin_amdgcn_sched_barrier(0)
    UnitD cur, nxt; int ui = 0;
    if (!S.next(0, cur)) return;
    unsigned va[2][2], vb[2][2], van[2][2];
    S.vb(vb); S.va(cur, va);
    Acc acc;
#pragma unroll
    for (int a = 0; a < 2; ++a)
#pragma unroll
        for (int b = 0; b < 2; ++b)
#pragma unroll
            for (int m = 0; m < 4; ++m)
#pragma unroll
                for (int n = 0; n < 2; ++n) acc[a][b][m][n] = (f32x4){0.f, 0.f, 0.f, 0.f};
    i32x8 At[4], B0[2], B1[2];
    const char* cA = cur.gA; const char* cB = cur.gB;
    G_WAIT_V(0);
    __syncthreads();
    G_STAGE(G_SB(0, 0), cB, vb[0]); G_STAGE(G_SA(0, 0), cA, va[0]); G_STAGE(G_SB(0, 1), cB, vb[1]); G_STAGE(G_SA(0, 1), cA, va[1]);
    if (wr == 1) G_BAR;
    G_WAIT_V(4); G_BAR;
    G_STAGE(G_SB(1, 0), cB + kstep, vb[0]); G_STAGE(G_SA(1, 0), cA + kstep, va[0]); G_STAGE(G_SB(1, 1), cB + kstep, vb[1]);
    G_WAIT_V(6); G_BAR;
    for (;;) {
        const bool has_next = S.next(ui + 1, nxt);
        const char* nA = has_next ? nxt.gA : cA; const char* nB = has_next ? nxt.gB : cB;
        if (GATHER) { if (has_next) S.va(nxt, van); else { van[0][0] = va[0][0]; van[0][1] = va[0][1]; van[1][0] = va[1][0]; van[1][1] = va[1][1]; } }
#pragma unroll 1
        for (int t = 0; t < nt; t += 2) {
            const bool last = (t == nt - 2);
            const char* a1 = cA + (size_t)(t + 1) * kstep;
            const char* a2 = last ? nA : cA + (size_t)(t + 2) * kstep; const char* b2 = last ? nB : cB + (size_t)(t + 2) * kstep;
            const char* a3 = a2 + kstep; const char* b3 = b2 + kstep;
            unsigned v2[2][2];
#pragma unroll
            for (int hh = 0; hh < 2; ++hh)
#pragma unroll
                for (int i = 0; i < 2; ++i) v2[hh][i] = (GATHER && last) ? van[hh][i] : va[hh][i];
            G_LDB(B0, 0, 0); G_SCHED; G_LDA(At, 0, 0); G_STAGE(G_SA(1, 1), a1, va[1]);
            G_WAIT_L(8); G_BAR; G_WAIT_L(0); G_MMA(0, 0, At, B0); G_BAR; G_SCHED;
            G_LDB(B1, 0, 1); G_STAGE(G_SB(0, 0), b2, vb[0]);
            G_BAR; G_WAIT_L(0); G_MMA(0, 1, At, B1); G_BAR;
            G_LDA(At, 0, 1); G_STAGE(G_SA(0, 0), a2, v2[0]);
            G_BAR; G_WAIT_L(0); G_MMA(1, 0, At, B0); G_BAR; G_SCHED;
            G_STAGE(G_SB(0, 1), b2, vb[1]);
            G_WAIT_V(6); G_BAR; G_MMA(1, 1, At, B1); G_BAR;
            G_LDB(B0, 1, 0); G_SCHED; G_LDA(At, 1, 0); G_STAGE(G_SA(0, 1), a2, v2[1]);
            G_WAIT_L(8); G_BAR; G_WAIT_L(0); G_MMA(0, 0, At, B0); G_BAR; G_SCHED;
            G_LDB(B1, 1, 1); G_STAGE(G_SB(1, 0), b3, vb[0]);
            G_BAR; G_WAIT_L(0); G_MMA(0, 1, At, B1); G_BAR;
            G_LDA(At, 1, 1); G_STAGE(G_SA(1, 0), a3, v2[0]);
            G_BAR; G_WAIT_L(0); G_MMA(1, 0, At, B0); G_BAR; G_SCHED;
            G_STAGE(G_SB(1, 1), b3, vb[1]);
            G_WAIT_V(6); G_BAR; G_MMA(1, 1, At, B1); G_BAR;
        }
        if (FP8) asm volatile("s_nop 15\n\ts_nop 15" ::: "memory");
        { int tz = TIDX; asm volatile("" : "+v"(tz));
          const int wid2 = tz >> 6, lane2 = tz & 63; E(acc, cur, wid2 >> 2, wid2 & 3, lane2 & 15, lane2 >> 4); }
        if (!has_next) break;
#pragma unroll
        for (int a = 0; a < 2; ++a)
#pragma unroll
            for (int b = 0; b < 2; ++b)
#pragma unroll
                for (int m = 0; m < 4; ++m)
#pragma unroll
                    for (int n = 0; n < 2; ++n) acc[a][b][m][n] = (f32x4){0.f, 0.f, 0.f, 0.f};
        cur = nxt; cA = nA; cB = nB; ++ui;
        if (GATHER) { va[0][0] = van[0][0]; va[0][1] = van[0][1]; va[1][0] = van[1][0]; va[1][1] = van[1][1]; }
    }
    G_WAIT_V(0);
    if (wr == 0) G_BAR;
    G_BAR;
#undef G_SA
#undef G_SB
#undef G_STAGE
#undef G_LDA
#undef G_LDB
#undef G_MMA
#undef G_LD8
#undef G_HALF
#undef G_WAIT_V
#undef G_WAIT_L
#undef G_BAR
#undef G_SCHED
}

__device__ __forceinline__ void offs_direct(unsigned (&v)[2][2], int ld, bool perm) {
    int R0, C0; stage_pos(TIDX, R0, C0);
#pragma unroll
    for (int i = 0; i < 2; ++i) { const int R = R0 + 64 * i, Rr = perm ? perm_row(R) : R;
        v[0][i] = (unsigned)(Rr * ld + C0) * 2u; v[1][i] = (unsigned)((Rr + HALF) * ld + C0) * 2u; }
}

struct SrcGrid {
    const char* A; const char* B; size_t astep, bstep; int nM, total, lda, ldb;
    __device__ __forceinline__ bool next(int i, UnitD& u) const { const int id = BID_ + i * NBLK_; if (id >= total) return false; u.t0 = id % nM; u.t1 = id / nM; u.t2 = 0;
        u.gA = A + (size_t)u.t0 * astep; u.gB = B + (size_t)u.t1 * bstep; return true; }
    __device__ __forceinline__ void va(const UnitD&, unsigned (&v)[2][2]) const { offs_direct(v, lda, false); }
    __device__ __forceinline__ void vb(unsigned (&v)[2][2]) const { offs_direct(v, ldb, true); }
};

struct SrcGridSplit {
    const char* A; const char* B; size_t astep, bstep; int nM, total, lda, ldb;
    __device__ __forceinline__ bool next(int i, UnitD& u) const { int id;
        if (NBLK_ == 256 && total == 3072) { if (BID_ < 128) { if (i >= 16) return false; id = BID_ + 128 * i; } else { if (i >= 8) return false; id = 2048 + (BID_ - 128) + 128 * i; } }
        else { id = BID_ + i * NBLK_; if (id >= total) return false; }
        u.t0 = id % nM; u.t1 = id / nM; u.t2 = 0; u.gA = A + (size_t)u.t0 * astep; u.gB = B + (size_t)u.t1 * bstep; return true; }
    __device__ __forceinline__ void va(const UnitD&, unsigned (&v)[2][2]) const { offs_direct(v, lda, false); }
    __device__ __forceinline__ void vb(unsigned (&v)[2][2]) const { offs_direct(v, ldb, true); }
};

__device__ __forceinline__ void store_bf16_tile(const Acc& acc, bf16_t* O, int ld, int wr, int wc, int fr, int fq, const float sc = 1.0f) {
#pragma unroll
    for (int ai = 0; ai < 2; ++ai)
#pragma unroll
        for (int m = 0; m < 4; ++m) { bf16_t* rowp = O + (size_t)(ai * HALF + wr * 64 + m * 16 + fr) * ld + wc * 32 + 8 * fq;
#pragma unroll
            for (int bj = 0; bj < 2; ++bj) { const f32x4 v0 = acc[ai][bj][m][0] * sc, v1 = acc[ai][bj][m][1] * sc;
                u32x4 w; w.x = cvt_pk_bf16(v0[0], v0[1]); w.y = cvt_pk_bf16(v0[2], v0[3]); w.z = cvt_pk_bf16(v1[0], v1[1]); w.w = cvt_pk_bf16(v1[2], v1[3]);
                *(u32x4*)(rowp + bj * HALF) = w; } }
}
__device__ __forceinline__ void store_f32_tile(const Acc& acc, float* O, const float* R, int ld, int ncol, int wr, int wc, int fr, int fq, const float sc = 1.0f) {
#pragma unroll
    for (int ai = 0; ai < 2; ++ai)
#pragma unroll
        for (int m = 0; m < 4; ++m) { const size_t ro = (size_t)(ai * HALF + wr * 64 + m * 16 + fr) * ld;
#pragma unroll
            for (int bj = 0; bj < 2; ++bj)
#pragma unroll
                for (int n = 0; n < 2; ++n) { const int c = bj * HALF + wc * 32 + 8 * fq + 4 * n; if (c >= ncol) continue;
                    f32x4 v = acc[ai][bj][m][n] * sc; if (R) v += *(const f32x4*)(R + ro + c); *(f32x4*)(O + ro + c) = v; } }
}
struct EpiProj {
    bf16_t* O; int ld; float* F; int fld, fp0, fp1, ncol; float sc;
    __device__ __forceinline__ void operator()(const Acc& acc, const UnitD& u, int wr, int wc, int fr, int fq) const {
        if (u.t1 >= fp0 && u.t1 < fp1) store_f32_tile(acc, F + (size_t)u.t0 * BM * fld + (u.t1 - fp0) * BM, nullptr, fld, ncol, wr, wc, fr, fq, sc);
        else store_bf16_tile(acc, O + (size_t)u.t0 * BM * ld + u.t1 * BM, ld, wr, wc, fr, fq, sc);
    }
};
struct EpiResid {
    unsigned char* ws; const float* Rf; float sc;
    __device__ __forceinline__ void row_done(float ss, const UnitD& u, int row, int wc, int fq) const {
        ss += __shfl_xor(ss, 16); ss += __shfl_xor(ss, 32);
        if (fq == 0) ((float*)(ws + WS_RSP))[(size_t)(u.t0 * BM + row) * 32 + u.t1 * 4 + wc] = ss; }
    __device__ __forceinline__ void operator()(const Acc& acc, const UnitD& u, int wr, int wc, int fr, int fq) const {
        const size_t o = (size_t)u.t0 * BM * D_ + u.t1 * BM;
        bf16_t* O = (bf16_t*)(ws + WS_X); const bf16_t* Rb = O;
        if (Rf) {
#pragma unroll
            for (int am = 0; am < 8; ++am) { const int ai = am >> 2, m = am & 3; f32x4 r0[2], r1[2];
                const size_t ro = o + (size_t)(ai * HALF + wr * 64 + m * 16 + fr) * D_ + wc * 32 + 8 * fq; float ss = 0.f;
#pragma unroll
                for (int bj = 0; bj < 2; ++bj) { r0[bj] = *(const f32x4*)(Rf + ro + bj * HALF); r1[bj] = *(const f32x4*)(Rf + ro + bj * HALF + 4); }
#pragma unroll
                for (int bj = 0; bj < 2; ++bj) { const f32x4 v0 = acc[ai][bj][m][0] * sc + r0[bj], v1 = acc[ai][bj][m][1] * sc + r1[bj];
                    u32x4 w; w.x = cvt_pk_bf16(v0[0], v0[1]); w.y = cvt_pk_bf16(v0[2], v0[3]); w.z = cvt_pk_bf16(v1[0], v1[1]); w.w = cvt_pk_bf16(v1[2], v1[3]);
                    *(u32x4*)(O + ro + bj * HALF) = w;
                    ss += v0[0] * v0[0] + v0[1] * v0[1] + v0[2] * v0[2] + v0[3] * v0[3] + v1[0] * v1[0] + v1[1] * v1[1] + v1[2] * v1[2] + v1[3] * v1[3]; }
                row_done(ss, u, ai * HALF + wr * 64 + m * 16 + fr, wc, fq); }
        } else {
#pragma unroll
            for (int am = 0; am < 4; ++am) { const int ai = am >> 1; u32x4 rr[2][2];
#pragma unroll
                for (int mm = 0; mm < 2; ++mm) { const int m = (am & 1) * 2 + mm; const size_t ro = o + (size_t)(ai * HALF + wr * 64 + m * 16 + fr) * D_ + wc * 32 + 8 * fq;
#pragma unroll
                    for (int bj = 0; bj < 2; ++bj) rr[mm][bj] = *(const u32x4*)(Rb + ro + bj * HALF); }
#pragma unroll
                for (int mm = 0; mm < 2; ++mm) { const int m = (am & 1) * 2 + mm; const size_t ro = o + (size_t)(ai * HALF + wr * 64 + m * 16 + fr) * D_ + wc * 32 + 8 * fq; float ss = 0.f;
#pragma unroll
                    for (int bj = 0; bj < 2; ++bj) { f32x4 v0 = acc[ai][bj][m][0] * sc, v1 = acc[ai][bj][m][1] * sc; const u32x4 r = rr[mm][bj];
                        v0[0] += bf_lo(r.x); v0[1] += bf_hi(r.x); v0[2] += bf_lo(r.y); v0[3] += bf_hi(r.y); v1[0] += bf_lo(r.z); v1[1] += bf_hi(r.z); v1[2] += bf_lo(r.w); v1[3] += bf_hi(r.w);
                        u32x4 w; w.x = cvt_pk_bf16(v0[0], v0[1]); w.y = cvt_pk_bf16(v0[2], v0[3]); w.z = cvt_pk_bf16(v1[0], v1[1]); w.w = cvt_pk_bf16(v1[2], v1[3]);
                        *(u32x4*)(O + ro + bj * HALF) = w;
                            ss += v0[0] * v0[0] + v0[1] * v0[1] + v0[2] * v0[2] + v0[3] * v0[3] + v1[0] * v1[0] + v1[1] * v1[1] + v1[2] * v1[2] + v1[3] * v1[3]; }
                    row_done(ss, u, ai * HALF + wr * 64 + m * 16 + fr, wc, fq); } }
        }
    }
};
struct EpiLogits {
    float* O;
    __device__ __forceinline__ void operator()(const Acc& acc, const UnitD& u, int wr, int wc, int fr, int fq) const { store_f32_tile(acc, O + (size_t)u.t0 * BM * 128, nullptr, 128, 128, wr, wc, fr, fq); }
};
struct EpiSwiGLU {
    unsigned char* O;
    __device__ __forceinline__ void operator()(const Acc& acc, const UnitD& u, int wr, int wc, int fr, int fq) const {
        unsigned char* o = O + (size_t)u.t0 * BM * DEXP + u.t1 * 128;
#pragma unroll
        for (int ai = 0; ai < 2; ++ai)
#pragma unroll
            for (int m = 0; m < 4; ++m) { unsigned char* rowp = o + (size_t)(ai * HALF + wr * 64 + m * 16 + fr) * DEXP + wc * 32 + 8 * fq;
                float r[8];
#pragma unroll
                for (int n = 0; n < 2; ++n)
#pragma unroll
                    for (int j = 0; j < 4; ++j) r[n * 4 + j] = (ACT8_SCALE / W8_SCALE) * siluf_(acc[ai][0][m][n][j] * (1.0f / W8_SCALE)) * acc[ai][1][m][n][j];
                u32x2 w; w.x = pk_fp8x4(r[0], r[1], r[2], r[3]); w.y = pk_fp8x4(r[4], r[5], r[6], r[7]);
                *(u32x2*)rowp = w; }
    }
};
struct EpiDown {
    unsigned char* O;
    __device__ __forceinline__ void operator()(const Acc& acc, const UnitD& u, int wr, int wc, int fr, int fq) const {
        unsigned char* o = O + (size_t)u.t0 * BM * D_ + u.t1 * BM; const float sc = 1.0f / (W8_SCALE * ACT8_SCALE);
#pragma unroll
        for (int ai = 0; ai < 2; ++ai)
#pragma unroll
            for (int m = 0; m < 4; ++m) { unsigned char* rowp = o + (size_t)(ai * HALF + wr * 64 + m * 16 + fr) * D_ + wc * 32 + 8 * fq;
#pragma unroll
                for (int bj = 0; bj < 2; ++bj) { const f32x4 v0 = acc[ai][bj][m][0] * sc, v1 = acc[ai][bj][m][1] * sc;
                    u32x2 w; w.x = pk_fp8x4(v0[0], v0[1], v0[2], v0[3]); w.y = pk_fp8x4(v1[0], v1[1], v1[2], v1[3]); *(u32x2*)(rowp + bj * HALF) = w; } }
    }
};
__device__ __forceinline__ unsigned rg_idx(unsigned tok, int c) { return ((((tok >> 12) * 64u + (unsigned)(c >> 4)) * (unsigned)S_ + (tok & (unsigned)(S_ - 1))) << 4) + (unsigned)(c & 15); }
struct EpiRgGates {
    bf16_t* LAo; bf16_t* Uo; const bf16_t* xc;
    const float* ba; const float* bx; const float* lam;
    __device__ __forceinline__ void operator()(const Acc& acc, const UnitD& u, int wr, int wc, int fr, int fq) const {
#pragma unroll
        for (int n = 0; n < 2; ++n) { const int c = u.t1 * 128 + wc * 32 + 8 * fq + 4 * n;
            u32x2 xq[2][4];
#pragma unroll
            for (int ai = 0; ai < 2; ++ai)
#pragma unroll
                for (int m = 0; m < 4; ++m) xq[ai][m] = *(const u32x2*)(xc + ((unsigned)(u.t0 * BM + ai * HALF + wr * 64 + m * 16 + fr) * 1024u + (unsigned)c));
            const f32x4 vba = *(const f32x4*)(ba + c), vbx = *(const f32x4*)(bx + c), vl = *(const f32x4*)(lam + c);
            f32x4 c8; for (int j = 0; j < 4; ++j) c8[j] = -8.0f * softplusf_(-vl[j]);
#pragma unroll
            for (int ai = 0; ai < 2; ++ai)
#pragma unroll
                for (int m = 0; m < 4; ++m) { const unsigned tok = (unsigned)(u.t0 * BM + ai * HALF + wr * 64 + m * 16 + fr);
                    const u32x2 xw = xq[ai][m]; const float xv[4] = {bf_lo(xw.x), bf_hi(xw.x), bf_lo(xw.y), bf_hi(xw.y)};
                    f32x4 lv, uv;
#pragma unroll
                    for (int j = 0; j < 4; ++j) { const float r = sigmoidf_(acc[ai][0][m][n][j] + vba[j]), ig = sigmoidf_(acc[ai][1][m][n][j] + vbx[j]);
                        const float la = c8[j] * r, av = __expf(la); lv[j] = la; uv[j] = __builtin_amdgcn_sqrtf(fmaxf(0.f, 1.0f - av * av)) * ig * xv[j]; }
                    const unsigned o = rg_idx(tok, c);
                    u32x2 w0; w0.x = cvt_pk_bf16(lv[0], lv[1]); w0.y = cvt_pk_bf16(lv[2], lv[3]); *(u32x2*)(LAo + o) = w0;
                    u32x2 w1; w1.x = cvt_pk_bf16(uv[0], uv[1]); w1.y = cvt_pk_bf16(uv[2], uv[3]); *(u32x2*)(Uo + o) = w1; } }
    }
};


__device__ __forceinline__ void transpose_job8(const float* src, unsigned char* dst, int K, int N, int ldd, size_t sb, size_t db, int nbatch, LAS unsigned char* lds) {
    const int tid = TIDX, tk = K / 128, tn = N / 64, per = tk * tn, total = per * nbatch;
    const int rr0 = tid >> 4, c4 = (tid & 15) * 4, n = tid >> 3, kg = (tid & 7) * 16;
    f32x4 va[4], vb[4];
#define T8_LD(v, t) { const int u_ = (t), ub_ = u_ / per, ur_ = u_ % per, uik_ = ur_ / tn, uin_ = ur_ % tn; const float* usp_ = src + (size_t)ub_ * sb + (size_t)(uik_ * 128 + rr0) * N + uin_ * 64 + c4; \
        _Pragma("unroll") for (int i = 0; i < 4; ++i) v[i] = *(const f32x4*)(usp_ + (size_t)(i * 32) * N); }
#define T8_ST(v, t, buf) { const int t_ = (t), b_ = t_ / per, r_ = t_ % per, ik_ = r_ / tn, in_ = r_ % tn; LAS float* tile = (LAS float*)(lds + (buf) * (128 * 65 * 4)); \
        _Pragma("unroll") for (int i = 0; i < 4; ++i) { const int rr = rr0 + i * 32; tile[rr * 65 + c4 + 0] = v[i][0]; tile[rr * 65 + c4 + 1] = v[i][1]; tile[rr * 65 + c4 + 2] = v[i][2]; tile[rr * 65 + c4 + 3] = v[i][3]; } \
        if (t_ + 2 * NBLK < total) T8_LD(v, t_ + 2 * NBLK) \
        LDS_BARRIER(); \
        float f[16]; \
        _Pragma("unroll") for (int j = 0; j < 16; ++j) f[j] = tile[(kg + j) * 65 + n] * W8_SCALE; \
        u32x4 w; w.x = pk_fp8x4(f[0], f[1], f[2], f[3]); w.y = pk_fp8x4(f[4], f[5], f[6], f[7]); w.z = pk_fp8x4(f[8], f[9], f[10], f[11]); w.w = pk_fp8x4(f[12], f[13], f[14], f[15]); \
        *(u32x4*)(dst + (size_t)b_ * db + (size_t)(in_ * 64 + n) * ldd + ik_ * 128 + kg) = w; }
    int t = BID;
    if (t < total) T8_LD(va, t)
    if (t + NBLK < total) T8_LD(vb, t + NBLK)
    for (; t < total; t += 2 * NBLK) {
        T8_ST(va, t, 0)
        if (t + NBLK < total) T8_ST(vb, t + NBLK, 1)
    }
#undef T8_LD
#undef T8_ST
    LDS_BARRIER();
}
__device__ __forceinline__ void transpose_job8_deep(const float* src, unsigned char* dst, int K, int N, int ldd, size_t sb, size_t db, int nbatch, LAS unsigned char* lds, int first, int stride) {
    const int tid = TIDX, tk = K / 128, tn = N / 64, per = tk * tn, total = per * nbatch;
    const int rr0 = tid >> 4, c4 = (tid & 15) * 4, n = tid >> 3, kg = (tid & 7) * 16;
    f32x4 va[4], vb[4], vc[4], vd[4];
#define T8_LD(v, t) { const int u_ = (t), ub_ = u_ / per, ur_ = u_ % per, uik_ = ur_ / tn, uin_ = ur_ % tn; const float* usp_ = src + (size_t)ub_ * sb + (size_t)(uik_ * 128 + rr0) * N + uin_ * 64 + c4; \
        _Pragma("unroll") for (int i = 0; i < 4; ++i) v[i] = *(const f32x4*)(usp_ + (size_t)(i * 32) * N); }
#define T8_ST(v, t, buf) { const int t_ = (t), b_ = t_ / per, r_ = t_ % per, ik_ = r_ / tn, in_ = r_ % tn; LAS float* tile = (LAS float*)(lds + (buf) * (128 * 65 * 4)); \
        _Pragma("unroll") for (int i = 0; i < 4; ++i) { const int rr = rr0 + i * 32; tile[rr * 65 + c4 + 0] = v[i][0]; tile[rr * 65 + c4 + 1] = v[i][1]; tile[rr * 65 + c4 + 2] = v[i][2]; tile[rr * 65 + c4 + 3] = v[i][3]; } \
        if (t_ + 4 * stride < total) T8_LD(v, t_ + 4 * stride) \
        LDS_BARRIER(); \
        float f[16]; \
        _Pragma("unroll") for (int j = 0; j < 16; ++j) f[j] = tile[(kg + j) * 65 + n] * W8_SCALE; \
        u32x4 w; w.x = pk_fp8x4(f[0], f[1], f[2], f[3]); w.y = pk_fp8x4(f[4], f[5], f[6], f[7]); w.z = pk_fp8x4(f[8], f[9], f[10], f[11]); w.w = pk_fp8x4(f[12], f[13], f[14], f[15]); \
        *(u32x4*)(dst + (size_t)b_ * db + (size_t)(in_ * 64 + n) * ldd + ik_ * 128 + kg) = w; }
    int t = first;
    if (t < total) T8_LD(va, t)
    if (t + stride < total) T8_LD(vb, t + stride)
    if (t + 2 * stride < total) T8_LD(vc, t + 2 * stride)
    if (t + 3 * stride < total) T8_LD(vd, t + 3 * stride)
    for (; t < total; t += 4 * stride) {
        T8_ST(va, t, 0)
        if (t + stride < total) T8_ST(vb, t + stride, 1)
        if (t + 2 * stride < total) T8_ST(vc, t + 2 * stride, 0)
        if (t + 3 * stride < total) T8_ST(vd, t + 3 * stride, 1)
    }
#undef T8_LD
#undef T8_ST
    LDS_BARRIER();
}
__device__ __forceinline__ void transpose_job(const float* src, bf16_t* dst, int K, int N, int ldd, size_t sb, size_t db, int dalt, int nbatch, LAS unsigned char* lds) {
    const int tid = TIDX, tk = K / 64, tn = N / 64, per = tk * tn, total = per * nbatch;
    const int rr0 = tid >> 4, c4 = (tid & 15) * 4, n = tid >> 3, kg = (tid & 7) * 8;
    f32x4 va[2], vb[2];
#define T16_LD(v, t) { const int u_ = (t), ub_ = u_ / per, ur_ = u_ % per, uik_ = ur_ / tn, uin_ = ur_ % tn; const float* usp_ = src + (size_t)ub_ * sb + (size_t)(uik_ * 64 + rr0) * N + uin_ * 64 + c4; \
        _Pragma("unroll") for (int i = 0; i < 2; ++i) v[i] = *(const f32x4*)(usp_ + (size_t)(i * 32) * N); }
#define T16_ST(v, t, buf) { const int t_ = (t), b_ = t_ / per, r_ = t_ % per, ik_ = r_ / tn, in_ = r_ % tn; LAS float* tile = (LAS float*)(lds + (buf) * (64 * 65 * 4)); \
        _Pragma("unroll") for (int i = 0; i < 2; ++i) { const int rr = rr0 + i * 32; tile[rr * 65 + c4 + 0] = v[i][0]; tile[rr * 65 + c4 + 1] = v[i][1]; tile[rr * 65 + c4 + 2] = v[i][2]; tile[rr * 65 + c4 + 3] = v[i][3]; } \
        if (t_ + 2 * NBLK < total) T16_LD(v, t_ + 2 * NBLK) \
        LDS_BARRIER(); \
        float f[8]; \
        _Pragma("unroll") for (int j = 0; j < 8; ++j) f[j] = tile[(kg + j) * 65 + n]; \
        u32x4 w; w.x = cvt_pk_bf16(f[0], f[1]); w.y = cvt_pk_bf16(f[2], f[3]); w.z = cvt_pk_bf16(f[4], f[5]); w.w = cvt_pk_bf16(f[6], f[7]); \
        *(u32x4*)(dst + (size_t)b_ * db + (size_t)(b_ & 1) * dalt + (size_t)(in_ * 64 + n) * ldd + ik_ * 64 + kg) = w; }
    int t = BID;
    if (t < total) T16_LD(va, t)
    if (t + NBLK < total) T16_LD(vb, t + NBLK)
    for (; t < total; t += 2 * NBLK) {
        T16_ST(va, t, 0)
        if (t + NBLK < total) T16_ST(vb, t + NBLK, 1)
    }
#undef T16_LD
#undef T16_ST
    LDS_BARRIER();
}

__device__ __forceinline__ void moe_weight_jobs(const Args& a, int layer, LAS unsigned char* lds) {
    const size_t lo = (size_t)layer * NEXP * D_ * DEXP;
    transpose_job8(a.in[25] + lo, a.ws + WS_WG, D_, DEXP, D_, (size_t)D_ * DEXP, (size_t)DEXP * D_, NEXP, lds);
    transpose_job8(a.in[26] + lo, a.ws + WS_WU, D_, DEXP, D_, (size_t)D_ * DEXP, (size_t)DEXP * D_, NEXP, lds);
    transpose_job8(a.in[27] + lo, a.ws + WS_WD, DEXP, D_, DEXP, (size_t)D_ * DEXP, (size_t)DEXP * D_, NEXP, lds);
}

__device__ __forceinline__ void moe_weight_jobs_part(const Args& a, int layer, LAS unsigned char* lds, int first, int stride) {
    const size_t lo = (size_t)layer * NEXP * D_ * DEXP;
    transpose_job8_deep(a.in[25] + lo, a.ws + WS_WG, D_, DEXP, D_, (size_t)D_ * DEXP, (size_t)DEXP * D_, NEXP, lds, first, stride);
    transpose_job8_deep(a.in[26] + lo, a.ws + WS_WU, D_, DEXP, D_, (size_t)D_ * DEXP, (size_t)DEXP * D_, NEXP, lds, first, stride);
    transpose_job8_deep(a.in[27] + lo, a.ws + WS_WD, DEXP, D_, DEXP, (size_t)D_ * DEXP, (size_t)DEXP * D_, NEXP, lds, first, stride);
}

__device__ __forceinline__ void phase_prologue(const Args& a, LAS unsigned char* lds) {
    const int gtid = BID * NTHREADS + TIDX, gsz = NBLK * NTHREADS;
    for (int i = gtid; i < 1024; i += gsz) { const float l0 = a.in[12][i], l1 = a.in[12][1024 + i], mx = fmaxf(l0, l1), e0 = __expf(l0 - mx), e1 = __expf(l1 - mx);
        ((float*)(a.ws + WS_LB))[i] = e0 / (e0 + e1); }
    for (int it = gtid; it < 2 * 256 * 256; it += gsz) { const int l = it >> 16, n = (it >> 8) & 255, k8 = (it & 255) * 8; float f[8];
#pragma unroll
        for (int j = 0; j < 8; ++j) { const int k = k8 + j; f[j] = a.in[2][(size_t)l * D_ + k] * (n < 8 ? a.in[21][((size_t)l * D_ + k) * 8 + n] : (n < 72 ? a.in[23][((size_t)l * D_ + k) * 64 + (n - 8)] : 0.f)); }
        u32x4 w; w.x = cvt_pk_bf16(f[0], f[1]); w.y = cvt_pk_bf16(f[2], f[3]); w.z = cvt_pk_bf16(f[4], f[5]); w.w = cvt_pk_bf16(f[6], f[7]);
        *(u32x4*)((bf16_t*)(a.ws + WS_WRT) + ((size_t)l * 256 + n) * D_ + k8) = w; }
    for (int it = gtid; it < 192 * 128; it += gsz) *(u32x4*)(a.ws + WS_WIN1T + (size_t)N_IN1 * D_ + (size_t)it * 16) = (u32x4){0u, 0u, 0u, 0u};
    transpose_job(a.in[4], (bf16_t*)(a.ws + WS_WIN0T), D_, N_IN0, D_, 0, 0, 0, 1, lds);
    transpose_job(a.in[14], (bf16_t*)(a.ws + WS_WOUT0T), D_, D_, D_, 0, 0, 0, 1, lds);
    transpose_job8(a.in[15], a.ws + WS_WIN1T, D_, N_IN1, D_, 0, 0, 1, lds);
    transpose_job8(a.in[20], a.ws + WS_WOUT1T, 4096, D_, 4096, 0, 0, 1, lds);
    transpose_job(a.in[7], (bf16_t*)(a.ws + WS_WGATES), 128, 128, 128, 128 * 128, 256 * 128, 0, 8, lds);
    transpose_job(a.in[9], (bf16_t*)(a.ws + WS_WGATES) + 128 * 128, 128, 128, 128, 128 * 128, 256 * 128, 0, 8, lds);
    moe_weight_jobs(a, 0, lds);
}

#define NORM_PH(M, F) phase_norm<M, F>
template <int MODE, bool F32>
__device__ __forceinline__ void phase_norm(const Args& a, const float* src, const float* gain, int layer) {
    const int wid = TIDX >> 6, lane = TIDX & 63;
    bf16_t* xw = (bf16_t*)(a.ws + WS_X); bf16_t* hw = (bf16_t*)(a.ws + WS_H);
    const unsigned char* ym = a.ws + WS_YMOE; const int* posof = (const int*)(a.ws + WS_POSOF); const float* gate = (const float*)(a.ws + WS_GATE);
    const int stride = NBLK * 16;
    f32x4 rf[2][8]; u32x2 rb[2][8]; int pp[2][2] = {{0, 0}, {0, 0}}; float pg[2][2] = {{0.f, 0.f}, {0.f, 0.f}};
#define NORM_LD(r) { _Pragma("unroll") for (int u = 0; u < 2; ++u) { _Pragma("unroll") for (int i = 0; i < 8; ++i) { \
            if (F32) rf[u][i] = *(const f32x4*)(src + (size_t)((r) + u) * D_ + (i * 64 + lane) * 4); else rb[u][i] = *(const u32x2*)(xw + (size_t)((r) + u) * D_ + (i * 64 + lane) * 4); } \
            if (MODE >= 1) { pp[u][0] = posof[((r) + u) * 2]; pp[u][1] = posof[((r) + u) * 2 + 1]; pg[u][0] = gate[((r) + u) * 2]; pg[u][1] = gate[((r) + u) * 2 + 1]; } } }
    int row = (BID * 8 + wid) * 2;
    if (row < T_) NORM_LD(row)
    for (; row < T_; row += stride) {
        f32x4 v[2][8]; int p[2][2]; float g[2][2];
#pragma unroll
        for (int u = 0; u < 2; ++u) { p[u][0] = pp[u][0]; p[u][1] = pp[u][1]; g[u][0] = pg[u][0]; g[u][1] = pg[u][1];
#pragma unroll
            for (int i = 0; i < 8; ++i) v[u][i] = F32 ? rf[u][i] : (f32x4){bf_lo(rb[u][i].x), bf_hi(rb[u][i].x), bf_lo(rb[u][i].y), bf_hi(rb[u][i].y)}; }
        if (row + stride < T_) NORM_LD(row + stride)
        if (MODE >= 1) {
            int y[2][8][2];
#pragma unroll
            for (int u = 0; u < 2; ++u) {
#pragma unroll
                for (int i = 0; i < 8; ++i) { const int c = (i * 64 + lane) * 4; y[u][i][0] = *(const int*)(ym + (size_t)p[u][0] * D_ + c); y[u][i][1] = *(const int*)(ym + (size_t)p[u][1] * D_ + c); } }
#pragma unroll
            for (int u = 0; u < 2; ++u) { const float g0 = g[u][0], g1 = g[u][1];
#pragma unroll
                for (int i = 0; i < 8; ++i) { const int y0 = y[u][i][0], y1 = y[u][i][1];
                    const f32x2 a0 = __builtin_amdgcn_cvt_pk_f32_fp8(y0, false), a1 = __builtin_amdgcn_cvt_pk_f32_fp8(y0, true), b0 = __builtin_amdgcn_cvt_pk_f32_fp8(y1, false), b1 = __builtin_amdgcn_cvt_pk_f32_fp8(y1, true);
                    v[u][i][0] += g0 * a0[0] + g1 * b0[0]; v[u][i][1] += g0 * a0[1] + g1 * b0[1]; v[u][i][2] += g0 * a1[0] + g1 * b1[0]; v[u][i][3] += g0 * a1[1] + g1 * b1[1]; }
                if (MODE == 1) {
#pragma unroll
                    for (int i = 0; i < 8; ++i) { u32x2 w; w.x = cvt_pk_bf16(v[u][i][0], v[u][i][1]); w.y = cvt_pk_bf16(v[u][i][2], v[u][i][3]); *(u32x2*)(xw + (size_t)(row + u) * D_ + (i * 64 + lane) * 4) = w; } } }
        }
#pragma unroll
        for (int u = 0; u < 2; ++u) {
            float ss = 0.f;
#pragma unroll
            for (int i = 0; i < 8; ++i) ss += v[u][i][0] * v[u][i][0] + v[u][i][1] * v[u][i][1] + v[u][i][2] * v[u][i][2] + v[u][i][3] * v[u][i][3];
            ss = wave_sum(ss);
            const float rstd = rsqrtf(ss * (1.0f / D_) + 1e-6f);
#pragma unroll
            for (int i = 0; i < 8; ++i) { const int c = (i * 64 + lane) * 4; const f32x4 gn = *(const f32x4*)(gain + c);
                const f32x4 o = v[u][i] * rstd * gn;
                if (MODE == 2) *(f32x4*)(a.out + (size_t)(row + u) * D_ + c) = o;
                else { if (MODE != 1) { u32x2 w; w.x = cvt_pk_bf16(o[0], o[1]); w.y = cvt_pk_bf16(o[2], o[3]); *(u32x2*)(hw + (size_t)(row + u) * D_ + c) = w; }
                       if (layer >= 0) *(unsigned*)(a.ws + WS_H8 + (size_t)(row + u) * D_ + c) = pk_fp8x4(o[0], o[1], o[2], o[3]); } } }
    }
#undef NORM_LD
    (void)layer;
}

__device__ __forceinline__ void phase_gemm_in0(const Args& a, LAS unsigned char* lds) {
    SrcGrid S{(const char*)(a.ws + WS_H), (const char*)(a.ws + WS_WIN0T), (size_t)BM * D_ * 2, (size_t)BM * D_ * 2, 64, 64 * 24, D_, D_};
    EpiProj E{(bf16_t*)(a.ws + WS_PROJ), N_IN0, (float*)(a.ws + WS_FLOG), 1024, 12, 16, 256, 1.0f};
    gemm_stream<false, false>(lds, S, D_ / BK, E);
}

__device__ __forceinline__ void phase_rg_conv(const Args& a) {
    const bf16_t* p0 = (const bf16_t*)(a.ws + WS_PROJ); bf16_t* xc = (bf16_t*)(a.ws + WS_XC);
    const float* cw = a.in[5]; const float* cb = a.in[6];
    for (int it = BID * NTHREADS + TIDX; it < 128 * (T_ / 16); it += NBLK * NTHREADS) { const int c = (it & 127) * 8; const size_t t0 = (size_t)(it >> 7) * 16;
        float w[4][8], bias[8];
#pragma unroll
        for (int k = 0; k < 4; ++k) { const f32x4 w0 = *(const f32x4*)(cw + k * 1024 + c), w1 = *(const f32x4*)(cw + k * 1024 + c + 4);
            w[k][0] = w0[0]; w[k][1] = w0[1]; w[k][2] = w0[2]; w[k][3] = w0[3]; w[k][4] = w1[0]; w[k][5] = w1[1]; w[k][6] = w1[2]; w[k][7] = w1[3]; }
        { const f32x4 b0 = *(const f32x4*)(cb + c), b1 = *(const f32x4*)(cb + c + 4); bias[0] = b0[0]; bias[1] = b0[1]; bias[2] = b0[2]; bias[3] = b0[3]; bias[4] = b1[0]; bias[5] = b1[1]; bias[6] = b1[2]; bias[7] = b1[3]; }
        u32x4 x0 = (u32x4){0u, 0u, 0u, 0u}, x1 = x0, x2 = x0;
        if ((t0 & (S_ - 1)) != 0) { x0 = *(const u32x4*)(p0 + (t0 - 3) * N_IN0 + c); x1 = *(const u32x4*)(p0 + (t0 - 2) * N_IN0 + c); x2 = *(const u32x4*)(p0 + (t0 - 1) * N_IN0 + c); }
        u32x4 xr[16];
#pragma unroll
        for (int r = 0; r < 16; ++r) xr[r] = *(const u32x4*)(p0 + (t0 + r) * N_IN0 + c);
#pragma unroll
        for (int r = 0; r < 16; ++r) { const u32x4 x3 = xr[r];
            float acc[8];
#define TAPS(j, f, m) (bias[j] + w[0][j] * f(x0.m) + w[1][j] * f(x1.m) + w[2][j] * f(x2.m) + w[3][j] * f(x3.m))
            acc[0] = TAPS(0, bf_lo, x); acc[1] = TAPS(1, bf_hi, x); acc[2] = TAPS(2, bf_lo, y); acc[3] = TAPS(3, bf_hi, y);
            acc[4] = TAPS(4, bf_lo, z); acc[5] = TAPS(5, bf_hi, z); acc[6] = TAPS(6, bf_lo, w); acc[7] = TAPS(7, bf_hi, w);
#undef TAPS
            u32x4 o; o.x = cvt_pk_bf16(acc[0], acc[1]); o.y = cvt_pk_bf16(acc[2], acc[3]); o.z = cvt_pk_bf16(acc[4], acc[5]); o.w = cvt_pk_bf16(acc[6], acc[7]);
            *(u32x4*)(xc + (t0 + r) * 1024 + c) = o;
            x0 = x1; x1 = x2; x2 = x3; } }
}

struct SrcRgGates {
    const char* xc; const char* w; int total;
    __device__ __forceinline__ bool next(int i, UnitD& u) const { const int id = BID + i * NBLK; if (id >= total) return false; u.t0 = id & 63; u.t1 = id >> 6; u.t2 = 0;
        u.gA = xc + ((size_t)u.t0 * BM * 1024 + u.t1 * 128) * 2; u.gB = w + (size_t)u.t1 * 256 * 128 * 2; return true; }
    __device__ __forceinline__ void va(const UnitD&, unsigned (&v)[2][2]) const { offs_direct(v, 1024, false); }
    __device__ __forceinline__ void vb(unsigned (&v)[2][2]) const { offs_direct(v, 128, true); }
};
__device__ __forceinline__ void phase_rg_gates(const Args& a, LAS unsigned char* lds) {
    SrcRgGates S{(const char*)(a.ws + WS_XC), (const char*)(a.ws + WS_WGATES), 64 * 8};
    EpiRgGates E{(bf16_t*)(a.ws + WS_A), (bf16_t*)(a.ws + WS_U), (const bf16_t*)(a.ws + WS_XC), a.in[8], a.in[10], a.in[11]};
    int nt = 2; asm volatile("" : "+s"(nt));
    gemm_stream<false, false>(lds, S, nt, E);
}

__device__ __forceinline__ void phase_rg_scan(const Args& a, LAS unsigned char* lds) {
    const bf16_t* LA = (const bf16_t*)(a.ws + WS_A); const bf16_t* U = (const bf16_t*)(a.ws + WS_U);
    const bf16_t* p0 = (const bf16_t*)(a.ws + WS_PROJ); bf16_t* Y = (bf16_t*)(a.ws + WS_Y);
    LAS float* sP = (LAS float*)lds; LAS float* sH = sP + 4096; LAS float* gP = sH + 4096; LAS float* gH = gP + 512; LAS float* gC = gH + 512;
    const int tid = TIDX, seg = tid >> 1, c8 = (tid & 1) * 8;
    for (int blk = BID; blk < NB_ * 64; blk += NBLK) { const int b = blk >> 6, c = (blk & 63) * 16 + c8;
        const size_t base = (((size_t)blk * S_ + seg * 16) << 4) + c8;
        float P[8], H[8];
#pragma unroll
        for (int j = 0; j < 8; ++j) { P[j] = 1.f; H[j] = 0.f; }
#pragma unroll 4
        for (int s = 0; s < 16; ++s) { const u32x4 lw = *(const u32x4*)(LA + base + (size_t)s * 16), uw = *(const u32x4*)(U + base + (size_t)s * 16);
            const float la[8] = {bf_lo(lw.x), bf_hi(lw.x), bf_lo(lw.y), bf_hi(lw.y), bf_lo(lw.z), bf_hi(lw.z), bf_lo(lw.w), bf_hi(lw.w)};
            const float uu[8] = {bf_lo(uw.x), bf_hi(uw.x), bf_lo(uw.y), bf_hi(uw.y), bf_lo(uw.z), bf_hi(uw.z), bf_lo(uw.w), bf_hi(uw.w)};
#pragma unroll
            for (int j = 0; j < 8; ++j) { const float av = __expf(la[j]); H[j] = av * H[j] + uu[j]; P[j] *= av; } }
        __syncthreads();
#pragma unroll
        for (int j = 0; j < 8; ++j) { sP[seg * 16 + c8 + j] = P[j]; sH[seg * 16 + c8 + j] = H[j]; }
        __syncthreads();
        { const int ch = tid & 15, grp = tid >> 4; float p = 1.f, h = 0.f;
#pragma unroll
          for (int q = 0; q < 8; ++q) { const int sgi = grp * 8 + q; h = sP[sgi * 16 + ch] * h + sH[sgi * 16 + ch]; p *= sP[sgi * 16 + ch]; }
          gP[grp * 16 + ch] = p; gH[grp * 16 + ch] = h; }
        __syncthreads();
        if (tid < 16) { float carry = 0.f; for (int g = 0; g < 32; ++g) { gC[g * 16 + tid] = carry; carry = gP[g * 16 + tid] * carry + gH[g * 16 + tid]; } }
        __syncthreads();
        { const int ch = tid & 15, grp = tid >> 4; float h = gC[grp * 16 + ch];
#pragma unroll
          for (int q = 0; q < 8; ++q) { const int sgi = grp * 8 + q; const float pin = sP[sgi * 16 + ch], hin = sH[sgi * 16 + ch]; sH[sgi * 16 + ch] = h; h = pin * h + hin; } }
        __syncthreads();
#pragma unroll
        for (int j = 0; j < 8; ++j) H[j] = sH[seg * 16 + c8 + j];
        {
            u32x4 l_a[4], u_a[4], g_a[4];
#define RS_LD(Lv, Uv, Gv, s0) { _Pragma("unroll") for (int j = 0; j < 4; ++j) { const int s_ = (s0) + j; Lv[j] = *(const u32x4*)(LA + base + (size_t)s_ * 16); Uv[j] = *(const u32x4*)(U + base + (size_t)s_ * 16); \
                Gv[j] = *(const u32x4*)(p0 + ((size_t)b * S_ + seg * 16 + s_) * N_IN0 + 1024 + c); } }
            RS_LD(l_a, u_a, g_a, 0)
#pragma unroll
            for (int s0 = 0; s0 < 16; s0 += 4) { u32x4 l_b[4], u_b[4], g_b[4];
#pragma unroll
                for (int j = 0; j < 4; ++j) { l_b[j] = l_a[j]; u_b[j] = u_a[j]; g_b[j] = g_a[j]; }
                if (s0 + 4 < 16) RS_LD(l_b, u_b, g_b, s0 + 4)
#pragma unroll
                for (int j = 0; j < 4; ++j) { const u32x4 lw = l_a[j], uw = u_a[j], gw = g_a[j]; const size_t t = (size_t)b * S_ + seg * 16 + s0 + j;
                    const float la[8] = {bf_lo(lw.x), bf_hi(lw.x), bf_lo(lw.y), bf_hi(lw.y), bf_lo(lw.z), bf_hi(lw.z), bf_lo(lw.w), bf_hi(lw.w)};
                    const float uu[8] = {bf_lo(uw.x), bf_hi(uw.x), bf_lo(uw.y), bf_hi(uw.y), bf_lo(uw.z), bf_hi(uw.z), bf_lo(uw.w), bf_hi(uw.w)};
                    const float gg[8] = {bf_lo(gw.x), bf_hi(gw.x), bf_lo(gw.y), bf_hi(gw.y), bf_lo(gw.z), bf_hi(gw.z), bf_lo(gw.w), bf_hi(gw.w)};
                    float y[8];
#pragma unroll
                    for (int q = 0; q < 8; ++q) { H[q] = __expf(la[q]) * H[q] + uu[q]; y[q] = H[q] * gelu_tanh(gg[q]); }
                    u32x4 o; o.x = cvt_pk_bf16(y[0], y[1]); o.y = cvt_pk_bf16(y[2], y[3]); o.z = cvt_pk_bf16(y[4], y[5]); o.w = cvt_pk_bf16(y[6], y[7]);
                    *(u32x4*)(Y + t * D_ + c) = o; }
#pragma unroll
                for (int j = 0; j < 4; ++j) { l_a[j] = l_b[j]; u_a[j] = u_b[j]; g_a[j] = g_b[j]; } }
#undef RS_LD
        }
    }
}

typedef short s16x4 __attribute__((ext_vector_type(4)));
__device__ __forceinline__ f32x4 mfma32(bf16x8 a, bf16x8 b, f32x4 c) { return __builtin_amdgcn_mfma_f32_16x16x32_bf16(a, b, c, 0, 0, 0); }
__device__ __forceinline__ bf16x8 lds_frag(LAS const unsigned char* p) { return *(const LAS bf16x8*)p; }
__device__ __forceinline__ s16x4 lds_tr4(LAS const unsigned char* p) { return __builtin_amdgcn_ds_read_tr16_b64_v4i16((LAS s16x4*)p); }
__device__ __forceinline__ bf16x8 lds_tr8(LAS const unsigned char* p, int rowskip_bytes) {
    const s16x4 lo = lds_tr4(p), hi = lds_tr4(p + rowskip_bytes); return __builtin_shufflevector(lo, hi, 0, 1, 2, 3, 4, 5, 6, 7); }
__device__ __forceinline__ bf16x8 pack8(const f32x4& lo, const f32x4& hi) { u32x4 w; w.x = cvt_pk_bf16(lo[0], lo[1]); w.y = cvt_pk_bf16(lo[2], lo[3]); w.z = cvt_pk_bf16(hi[0], hi[1]); w.w = cvt_pk_bf16(hi[2], hi[3]); return __builtin_bit_cast(bf16x8, w); }
constexpr int RSB = 272;

constexpr size_t WS_HQ = WS_O;
constexpr size_t WS_HA = WS_HQ + (size_t)2048 * 64 * 128 * 2;
constexpr size_t WS_HG = WS_HA + (size_t)2048 * 8 * 512 * 2;
constexpr size_t WS_HS = WS_HG + (size_t)2048 * 128 * 128 * 2;
constexpr size_t WS_HD = WS_HS + (size_t)2048 * 128 * 128 * 2;
static_assert(WS_HD + (size_t)2048 * 128 * 4 <= WS_TAIL, "hgrn overlay");

__device__ __forceinline__ void phase_hg1(const Args& a, LAS unsigned char* lds) {
    const bf16_t* p0 = (const bf16_t*)(a.ws + WS_PROJ); const float* flog = (const float*)(a.ws + WS_FLOG); const float* lb = (const float*)(a.ws + WS_LB);
    bf16_t* QG = (bf16_t*)(a.ws + WS_HQ); bf16_t* AG = (bf16_t*)(a.ws + WS_HA); bf16_t* GG = (bf16_t*)(a.ws + WS_HG); float* DG = (float*)(a.ws + WS_HD);
    constexpr int SEG = 0, QT = 4096, KT = QT + 64 * RSB, KH = KT + 64 * RSB, VS = KH + 64 * RSB;
    const int tid = TIDX, wid = tid >> 6, lane = tid & 63, I = lane & 15, G = lane >> 4, k2 = 2 * lane, sg = wid;
    LAS float* seg = (LAS float*)(lds + SEG);
    u32x4 pvv[2]; f32x2 pz[8]; unsigned pqw[8];
#define HG1_LOAD(it_) do { const int bh_ = (it_) >> 6, ck_ = (it_) & 63, h_ = bh_ & 7; const size_t t0_ = (size_t)(bh_ >> 3) * S_ + ck_ * 64; \
        _Pragma("unroll") for (int i = 0; i < 2; ++i) { const int c = tid + i * 512, s_ = c >> 4, v8 = (c & 15) * 8; pvv[i] = *(const u32x4*)(p0 + (t0_ + s_) * N_IN0 + 4096 + h_ * 128 + v8); } \
        _Pragma("unroll") for (int i = 0; i < 8; ++i) { const size_t t_ = t0_ + sg * 8 + i; pz[i] = *(const f32x2*)(flog + t_ * 1024 + h_ * 128 + k2); pqw[i] = *(const unsigned*)(p0 + t_ * N_IN0 + 2048 + h_ * 128 + k2); } } while (0)
    if (BID < 2048) HG1_LOAD(BID);
    for (int item = BID; item < 2048; item += NBLK) { const int bh = item >> 6, h = bh & 7;
        LDS_BARRIER();
#pragma unroll
        for (int i = 0; i < 2; ++i) { const int c = tid + i * 512, s = c >> 4, v8 = (c & 15) * 8; *(LAS u32x4*)(lds + VS + s * RSB + v8 * 2) = pvv[i]; }
        const f32x2 l2 = *(const f32x2*)(lb + h * 128 + k2);
        float f[8][2], cb[8][2]; unsigned qw[8]; float c0 = 0.f, c1 = 0.f;
#pragma unroll
        for (int i = 0; i < 8; ++i) { const f32x2 z = pz[i]; qw[i] = pqw[i];
            f[i][0] = l2[0] + (1.0f - l2[0]) * sigmoidf_(z[0]); f[i][1] = l2[1] + (1.0f - l2[1]) * sigmoidf_(z[1]);
            c0 += __logf(f[i][0]); c1 += __logf(f[i][1]); cb[i][0] = c0; cb[i][1] = c1; }
        *(LAS f32x2*)(seg + sg * 128 + k2) = (f32x2){c0, c1};
        if (item + NBLK < 2048) HG1_LOAD(item + NBLK);
        LDS_BARRIER();
        float off0 = 0.f, off1 = 0.f, tot0 = 0.f, tot1 = 0.f;
#pragma unroll
        for (int s2 = 0; s2 < 8; ++s2) { const f32x2 v = *(const LAS f32x2*)(seg + s2 * 128 + k2); tot0 += v[0]; tot1 += v[1]; if (s2 < sg) { off0 += v[0]; off1 += v[1]; } }
        const float et0 = __expf(tot0), et1 = __expf(tot1);
#pragma unroll
        for (int i = 0; i < 8; ++i) { const int t = sg * 8 + i;
            const float e0 = __expf(cb[i][0] + off0), e1 = __expf(cb[i][1] + off1), r0 = __builtin_amdgcn_rcpf(e0), r1 = __builtin_amdgcn_rcpf(e1), km0 = 1.0f - f[i][0], km1 = 1.0f - f[i][1];
            const unsigned qt = cvt_pk_bf16(siluf_(bf_lo(qw[i])) * e0, siluf_(bf_hi(qw[i])) * e1);
            *(LAS unsigned*)(lds + QT + t * RSB + k2 * 2) = qt; *(unsigned*)(QG + ((size_t)item * 64 + t) * 128 + k2) = qt;
            *(LAS unsigned*)(lds + KT + t * RSB + k2 * 2) = cvt_pk_bf16(km0 * r0, km1 * r1);
            *(LAS unsigned*)(lds + KH + t * RSB + k2 * 2) = cvt_pk_bf16(km0 * r0 * et0, km1 * r1 * et1); }
        if (sg == 0) *(f32x2*)(DG + (size_t)item * 128 + k2) = (f32x2){et0, et1};
        LDS_BARRIER();
        { const int tt = wid & 3, sp = wid >> 2;
          bf16x8 qf[4];
#pragma unroll
          for (int ks = 0; ks < 4; ++ks) qf[ks] = lds_frag(lds + QT + (16 * tt + I) * RSB + (32 * ks + 8 * G) * 2);
          f32x4 acc[2];
#pragma unroll
          for (int hh = 0; hh < 2; ++hh) { const int st = 2 * sp + hh; acc[hh] = (f32x4){0.f, 0.f, 0.f, 0.f};
              if (st <= tt) {
#pragma unroll
                  for (int ks = 0; ks < 4; ++ks) acc[hh] = mfma32(lds_frag(lds + KT + (16 * st + I) * RSB + (32 * ks + 8 * G) * 2), qf[ks], acc[hh]);
#pragma unroll
                  for (int r = 0; r < 4; ++r) if (16 * st + 4 * G + r > 16 * tt + I) acc[hh][r] = 0.f; } }
          *(bf16x8*)(AG + (((size_t)item * 4 + tt) * 2 + sp) * 512 + lane * 8) = pack8(acc[0], acc[1]); }
        { const int kt = wid, q = I >> 2, p = I & 3;
          bf16x8 ka[2];
#pragma unroll
          for (int ks = 0; ks < 2; ++ks) ka[ks] = lds_tr8(lds + KH + (32 * ks + 8 * G + q) * RSB + (16 * kt + 4 * p) * 2, 4 * RSB);
#pragma unroll
          for (int vt = 0; vt < 8; ++vt) { f32x4 acc = (f32x4){0.f, 0.f, 0.f, 0.f};
#pragma unroll
              for (int ks = 0; ks < 2; ++ks) acc = mfma32(ka[ks], lds_tr8(lds + VS + (32 * ks + 8 * G + q) * RSB + (16 * vt + 4 * p) * 2, 4 * RSB), acc);
              u32x2 w; w.x = cvt_pk_bf16(acc[0], acc[1]); w.y = cvt_pk_bf16(acc[2], acc[3]);
              *(u32x2*)(GG + ((size_t)item * 128 + 16 * vt + I) * 128 + 16 * kt + 4 * G) = w; } }
    }
#undef HG1_LOAD
}

__device__ __forceinline__ void phase_hg2(const Args& a) {
    const bf16_t* GG = (const bf16_t*)(a.ws + WS_HG); const float* DG = (const float*)(a.ws + WS_HD); bf16_t* SG = (bf16_t*)(a.ws + WS_HS);
    for (int gid = BID * NTHREADS + TIDX; gid < 32 * 4096; gid += NBLK * NTHREADS) { const int bh = gid >> 12, e = gid & 4095, v = e >> 5, k4 = (e & 31) * 4;
        f32x4 S = (f32x4){0.f, 0.f, 0.f, 0.f};
        const size_t o0 = (((size_t)bh * 64) * 128 + v) * 128 + k4; const float* dg = DG + (size_t)bh * 64 * 128 + k4;
        f32x4 da[8]; u32x2 ga[8];
#pragma unroll
        for (int j = 0; j < 8; ++j) { da[j] = *(const f32x4*)(dg + j * 128); ga[j] = *(const u32x2*)(GG + o0 + (size_t)j * 16384); }
#pragma unroll 1
        for (int n0 = 0; n0 < 64; n0 += 8) { f32x4 db[8]; u32x2 gb[8];
#pragma unroll
            for (int j = 0; j < 8; ++j) { db[j] = da[j]; gb[j] = ga[j]; }
            if (n0 + 8 < 64) {
#pragma unroll
                for (int j = 0; j < 8; ++j) { db[j] = *(const f32x4*)(dg + (n0 + 8 + j) * 128); gb[j] = *(const u32x2*)(GG + o0 + (size_t)(n0 + 8 + j) * 16384); } }
#pragma unroll
            for (int j = 0; j < 8; ++j) { u32x2 w; w.x = cvt_pk_bf16(S[0], S[1]); w.y = cvt_pk_bf16(S[2], S[3]); *(u32x2*)(SG + o0 + (size_t)(n0 + j) * 16384) = w;
                const f32x4 d = da[j]; const u32x2 g = ga[j];
                S[0] = d[0] * S[0] + bf_lo(g.x); S[1] = d[1] * S[1] + bf_hi(g.x); S[2] = d[2] * S[2] + bf_lo(g.y); S[3] = d[3] * S[3] + bf_hi(g.y); }
#pragma unroll
            for (int j = 0; j < 8; ++j) { da[j] = db[j]; ga[j] = gb[j]; } } }
}

__device__ __forceinline__ void phase_hg3(const Args& a, LAS unsigned char* lds) {
    const bf16_t* p0 = (const bf16_t*)(a.ws + WS_PROJ); const bf16_t* QG = (const bf16_t*)(a.ws + WS_HQ); const bf16_t* AG = (const bf16_t*)(a.ws + WS_HA); const bf16_t* SG = (const bf16_t*)(a.ws + WS_HS);
    bf16_t* Y = (bf16_t*)(a.ws + WS_Y); const float* gain = a.in[13];
    constexpr int ST = 0, QT = 128 * RSB, VS = QT + 64 * RSB, PART = VS + 64 * RSB;
    const int tid = TIDX, wid = tid >> 6, lane = tid & 63, I = lane & 15, G = lane >> 4, q = I >> 2, p = I & 3;
    LAS float* part = (LAS float*)(lds + PART);
    const int tt = wid & 3, vh = wid >> 2;
    u32x4 ps[4], pq2[2], pv2[2]; bf16x8 paf[2];
#define HG3_LOAD(it_) do { const int bh_ = (it_) >> 6, ck_ = (it_) & 63; const size_t t0_ = (size_t)(bh_ >> 3) * S_ + ck_ * 64; const int h_ = bh_ & 7; \
        _Pragma("unroll") for (int i = 0; i < 4; ++i) { const int c = tid + i * 512, v = c >> 4, k8 = (c & 15) * 8; ps[i] = *(const u32x4*)(SG + ((size_t)(it_) * 128 + v) * 128 + k8); } \
        _Pragma("unroll") for (int i = 0; i < 2; ++i) { const int c = tid + i * 512, s_ = c >> 4, c8 = (c & 15) * 8; pq2[i] = *(const u32x4*)(QG + ((size_t)(it_) * 64 + s_) * 128 + c8); pv2[i] = *(const u32x4*)(p0 + (t0_ + s_) * N_IN0 + 4096 + h_ * 128 + c8); } \
        _Pragma("unroll") for (int sp = 0; sp < 2; ++sp) paf[sp] = *(const bf16x8*)(AG + (((size_t)(it_) * 4 + tt) * 2 + sp) * 512 + lane * 8); } while (0)
    if (BID < 2048) HG3_LOAD(BID);
    for (int item = BID; item < 2048; item += NBLK) { const int bh = item >> 6, ck = item & 63, b = bh >> 3, h = bh & 7; const size_t t0 = (size_t)b * S_ + ck * 64;
        LDS_BARRIER();
#pragma unroll
        for (int i = 0; i < 4; ++i) { const int c = tid + i * 512, v = c >> 4, k8 = (c & 15) * 8; *(LAS u32x4*)(lds + ST + v * RSB + k8 * 2) = ps[i]; }
#pragma unroll
        for (int i = 0; i < 2; ++i) { const int c = tid + i * 512, s2 = c >> 4, c8 = (c & 15) * 8; *(LAS u32x4*)(lds + QT + s2 * RSB + c8 * 2) = pq2[i]; *(LAS u32x4*)(lds + VS + s2 * RSB + c8 * 2) = pv2[i]; }
        bf16x8 af[2]; af[0] = paf[0]; af[1] = paf[1];
        if (item + NBLK < 2048) HG3_LOAD(item + NBLK);
        u32x2 zwp[4];
#pragma unroll
        for (int vi = 0; vi < 4; ++vi) zwp[vi] = *(const u32x2*)(p0 + (t0 + 16 * tt + I) * N_IN0 + 5120 + h * 128 + 16 * (4 * vh + vi) + 4 * G);
        LDS_BARRIER();
        bf16x8 qf[4];
#pragma unroll
        for (int ks = 0; ks < 4; ++ks) qf[ks] = lds_frag(lds + QT + (16 * tt + I) * RSB + (32 * ks + 8 * G) * 2);
        f32x4 acc[4]; float ss = 0.f;
#pragma unroll
        for (int vi = 0; vi < 4; ++vi) { const int vt = 4 * vh + vi; acc[vi] = (f32x4){0.f, 0.f, 0.f, 0.f};
#pragma unroll
            for (int ks = 0; ks < 4; ++ks) acc[vi] = mfma32(lds_frag(lds + ST + (16 * vt + I) * RSB + (32 * ks + 8 * G) * 2), qf[ks], acc[vi]);
#pragma unroll
            for (int sp = 0; sp < 2; ++sp) acc[vi] = mfma32(lds_tr8(lds + VS + (32 * sp + 4 * G + q) * RSB + (16 * vt + 4 * p) * 2, 16 * RSB), af[sp], acc[vi]);
            ss += acc[vi][0] * acc[vi][0] + acc[vi][1] * acc[vi][1] + acc[vi][2] * acc[vi][2] + acc[vi][3] * acc[vi][3]; }
        ss += __shfl_xor(ss, 16); ss += __shfl_xor(ss, 32);
        if (G == 0) part[wid * 16 + I] = ss;
        LDS_BARRIER();
        const float rstd = rsqrtf((part[wid * 16 + I] + part[(wid ^ 4) * 16 + I]) * (1.0f / 128.0f) + 1e-6f);
        const size_t t = t0 + 16 * tt + I;
#pragma unroll
        for (int vi = 0; vi < 4; ++vi) { const int c = h * 128 + 16 * (4 * vh + vi) + 4 * G;
            const f32x4 gn = *(const f32x4*)(gain + c); const u32x2 zw = zwp[vi];
            const float o0 = acc[vi][0] * rstd * gn[0] * siluf_(bf_lo(zw.x)), o1 = acc[vi][1] * rstd * gn[1] * siluf_(bf_hi(zw.x)), o2 = acc[vi][2] * rstd * gn[2] * siluf_(bf_lo(zw.y)), o3 = acc[vi][3] * rstd * gn[3] * siluf_(bf_hi(zw.y));
            u32x2 w; w.x = cvt_pk_bf16(o0, o1); w.y = cvt_pk_bf16(o2, o3); *(u32x2*)(Y + t * D_ + 1024 + c) = w; }
    }
#undef HG3_LOAD
}

__device__ __forceinline__ void phase_gdn_norm(const Args& a) {
    const bf16_t* O = (const bf16_t*)(a.ws + WS_O); const bf16_t* pj = (const bf16_t*)(a.ws + WS_PROJ); unsigned char* Y = a.ws + WS_Y; const float* gain = a.in[19];
    const int lane = TIDX & 63, wid = TIDX >> 6, gc = (lane & 15) * 8;
    const f32x4 g0 = *(const f32x4*)(gain + gc), g1 = *(const f32x4*)(gain + gc + 4);
    u32x4 oa[8], za[8];
    int row = BID * 8 + wid; const int stride = NBLK * 8;
#define GN_LD(ov, zv, r) { _Pragma("unroll") for (int i = 0; i < 8; ++i) { const int c = (i * 64 + lane) * 8; ov[i] = *(const u32x4*)(O + (size_t)(r) * 4096 + c); zv[i] = *(const u32x4*)(pj + (size_t)(r) * N_IN1P + 8192 + c); } }
    if (row < T_) GN_LD(oa, za, row)
    for (; row < T_; row += stride) { u32x4 ob[8], zb[8];
#pragma unroll
        for (int i = 0; i < 8; ++i) { ob[i] = oa[i]; zb[i] = za[i]; }
        if (row + stride < T_) GN_LD(ob, zb, row + stride)
#pragma unroll
        for (int i = 0; i < 8; ++i) { const int c = (i * 64 + lane) * 8;
            const u32x4 ow = oa[i], zw = za[i];
            const float o[8] = {bf_lo(ow.x), bf_hi(ow.x), bf_lo(ow.y), bf_hi(ow.y), bf_lo(ow.z), bf_hi(ow.z), bf_lo(ow.w), bf_hi(ow.w)};
            const float z[8] = {bf_lo(zw.x), bf_hi(zw.x), bf_lo(zw.y), bf_hi(zw.y), bf_lo(zw.z), bf_hi(zw.z), bf_lo(zw.w), bf_hi(zw.w)};
            float ss = 0.f;
#pragma unroll
            for (int q = 0; q < 8; ++q) ss += o[q] * o[q];
            ss = row16_sum(ss);
            const float rstd = rsqrtf(ss * (1.0f / 128.0f) + 1e-6f);
            float y[8];
#pragma unroll
            for (int q = 0; q < 8; ++q) y[q] = o[q] * rstd * (q < 4 ? g0[q & 3] : g1[q & 3]) * siluf_(z[q]);
            u32x2 w; w.x = pk_fp8x4(y[0], y[1], y[2], y[3]); w.y = pk_fp8x4(y[4], y[5], y[6], y[7]);
            *(u32x2*)(Y + (size_t)row * 4096 + c) = w; }
#pragma unroll
        for (int i = 0; i < 8; ++i) { oa[i] = ob[i]; za[i] = zb[i]; }
    }
#undef GN_LD
}

template <bool FP8>
__device__ __forceinline__ void phase_gemm_out(const Args& a, LAS unsigned char* lds, int K, const void* w, const float* xin) {
    const int eb = FP8 ? 1 : 2;
    SrcGrid S{(const char*)(a.ws + WS_Y), (const char*)w, (size_t)BM * K * eb, (size_t)BM * K * eb, 64, 64 * 8, K * eb / 2, K * eb / 2};
    EpiResid E{a.ws, xin, FP8 ? 1.0f / W8_SCALE : 1.0f};
    gemm_stream<false, FP8>(lds, S, K * eb / 128, E);
}

struct SrcRouter {
    const char* h; const char* w;
    __device__ __forceinline__ bool next(int i, UnitD& u) const { const int id = BID + i * NBLK; if (id >= 256) return false; u.t0 = id & 63; u.t1 = id >> 6; u.t2 = 0;
        u.gA = h + ((size_t)u.t0 * BM * D_ + u.t1 * 512) * 2; u.gB = w + (size_t)u.t1 * 512 * 2; return true; }
    __device__ __forceinline__ void va(const UnitD&, unsigned (&v)[2][2]) const { offs_direct(v, D_, false); }
    __device__ __forceinline__ void vb(unsigned (&v)[2][2]) const { offs_direct(v, D_, true); }
};
struct EpiLogitsQ {
    float* O;
    __device__ __forceinline__ void operator()(const Acc& acc, const UnitD& u, int wr, int wc, int fr, int fq) const { store_f32_tile(acc, O + ((size_t)u.t1 * T_ + (size_t)u.t0 * BM) * 128, nullptr, 128, 128, wr, wc, fr, fq); }
};
__device__ __forceinline__ void phase_gemm_router(const Args& a, LAS unsigned char* lds, int layer) {
    SrcRouter S{(const char*)(a.ws + WS_X), (const char*)(a.ws + WS_WRT) + (size_t)layer * 256 * D_ * 2};
    EpiLogitsQ E{(float*)(a.ws + WS_O)};
    gemm_stream<false, false>(lds, S, 512 / BK, E);
}

__device__ __forceinline__ void phase_route(const Args& a, int layer) {
    const float* lg = (const float*)(a.ws + WS_O); const float* bg = a.in[22] + layer * 8; const float* be = a.in[24] + layer * 64;
    int* cnt = (int*)(a.ws + WS_CTL + CTL_CNT) + layer * 64;
    int* eid = (int*)(a.ws + WS_EID); int* slot = (int*)(a.ws + WS_SLOT); float* gate = (float*)(a.ws + WS_GATE); int* rowmap = (int*)(a.ws + WS_ROWMAP);
    const float* rsp = (const float*)(a.ws + WS_RSP);
    {
        const bf16_t* xw = (const bf16_t*)(a.ws + WS_X); const float* gain = a.in[2] + (size_t)layer * D_; const int wid = TIDX >> 6, lane = TIDX & 63, stride = NBLK * 16;
        u32x2 rb[2][8]; float ps[2];
#define RT_LD(r) { _Pragma("unroll") for (int u = 0; u < 2; ++u) { _Pragma("unroll") for (int i = 0; i < 8; ++i) rb[u][i] = *(const u32x2*)(xw + (size_t)((r) + u) * D_ + (i * 64 + lane) * 4); ps[u] = rsp[(size_t)((r) + u) * 32 + (lane & 31)]; } }
        int row = (BID * 8 + wid) * 2;
        if (row < T_) RT_LD(row)
        for (; row < T_; row += stride) { u32x2 rc[2][8]; float pc[2];
#pragma unroll
            for (int u = 0; u < 2; ++u) { pc[u] = ps[u];
#pragma unroll
                for (int i = 0; i < 8; ++i) rc[u][i] = rb[u][i]; }
            if (row + stride < T_) RT_LD(row + stride)
#pragma unroll
            for (int u = 0; u < 2; ++u) { const float rstd = rsqrtf(wave_sum(pc[u]) * (0.5f / D_) + 1e-6f);
#pragma unroll
                for (int i = 0; i < 8; ++i) { const int c = (i * 64 + lane) * 4; const f32x4 gn = *(const f32x4*)(gain + c);
                    *(unsigned*)(a.ws + WS_H8 + (size_t)(row + u) * D_ + c) = pk_fp8x4(bf_lo(rc[u][i].x) * rstd * gn[0], bf_hi(rc[u][i].x) * rstd * gn[1], bf_lo(rc[u][i].y) * rstd * gn[2], bf_hi(rc[u][i].y) * rstd * gn[3]); } } }
#undef RT_LD
    }
    const int gtid = BID * NTHREADS + TIDX, gsz = NBLK * NTHREADS;
    for (int i = gtid; i < MPAD; i += gsz) rowmap[i] = 0;
    for (int t = gtid; t < T_; t += gsz) {
        f32x4 ga = (f32x4){0.f, 0.f, 0.f, 0.f}, gb = ga, sq = ga;
#pragma unroll
        for (int kq = 0; kq < 4; ++kq) { ga += *(const f32x4*)(lg + ((size_t)kq * T_ + t) * 128); gb += *(const f32x4*)(lg + ((size_t)kq * T_ + t) * 128 + 4); }
#pragma unroll
        for (int i = 0; i < 8; ++i) sq += *(const f32x4*)(rsp + (size_t)t * 32 + i * 4);
        const float rstd = rsqrtf((sq[0] + sq[1] + sq[2] + sq[3]) * (1.0f / D_) + 1e-6f);
        ga *= rstd; gb *= rstd;
        const float gl[8] = {ga[0] + bg[0], ga[1] + bg[1], ga[2] + bg[2], ga[3] + bg[3], gb[0] + bg[4], gb[1] + bg[5], gb[2] + bg[6], gb[3] + bg[7]};
        float mx = -3.0e38f; int gi = 0;
#pragma unroll
        for (int j = 0; j < 8; ++j) if (gl[j] > mx) { mx = gl[j]; gi = j; }
        float se = 0.f;
#pragma unroll
        for (int j = 0; j < 8; ++j) se += __expf(gl[j] - mx);
        const float gp = 1.0f / se;
        f32x4 ea = (f32x4){0.f, 0.f, 0.f, 0.f}, eb = ea;
#pragma unroll
        for (int kq = 0; kq < 4; ++kq) { ea += *(const f32x4*)(lg + ((size_t)kq * T_ + t) * 128 + 8 + gi * 8); eb += *(const f32x4*)(lg + ((size_t)kq * T_ + t) * 128 + 12 + gi * 8); }
        ea = ea * rstd + *(const f32x4*)(be + gi * 8); eb = eb * rstd + *(const f32x4*)(be + gi * 8 + 4);
        const float el[8] = {ea[0], ea[1], ea[2], ea[3], eb[0], eb[1], eb[2], eb[3]};
        float l1 = -3.0e38f, l2 = -3.0e38f; int i1 = 0, i2 = 0;
#pragma unroll
        for (int j = 0; j < 8; ++j) { const float v = el[j];
            if (v > l1) { l2 = l1; i2 = i1; l1 = v; i1 = j; } else if (v > l2) { l2 = v; i2 = j; } }
        const float e2 = __expf(l2 - l1), inv = 1.0f / (1.0f + e2);
        const int e0 = gi * 8 + i1, e1 = gi * 8 + i2;
        eid[t * 2] = e0; eid[t * 2 + 1] = e1; gate[t * 2] = inv * gp; gate[t * 2 + 1] = e2 * inv * gp;
        slot[t * 2] = atomicAdd(&cnt[e0], 1); slot[t * 2 + 1] = atomicAdd(&cnt[e1], 1); }
}

__device__ __forceinline__ void phase_rowmap(const Args& a, LAS unsigned char* lds, int layer) {
    const int* cnt = (const int*)(a.ws + WS_CTL + CTL_CNT) + layer * 64; LAS int* ps = (LAS int*)lds;
    int* tinfo = (int*)(a.ws + WS_TINFO) + layer * 512;
    const int* eid = (const int*)(a.ws + WS_EID); const int* slot = (const int*)(a.ws + WS_SLOT); int* posof = (int*)(a.ws + WS_POSOF); int* rowmap = (int*)(a.ws + WS_ROWMAP);
    __syncthreads();
    if (TIDX == 0) { int acc = 0; for (int e = 0; e < 64; ++e) { ps[e] = acc; acc += (cnt[e] + 255) & ~255; } ps[64] = acc; }
    __syncthreads();
    if (BID == 0) { if (TIDX <= 64) tinfo[TIDX] = ps[TIDX]; if (TIDX == 65) tinfo[65] = ps[64] >> 8;
        if (TIDX < 192) { const int p = TIDX * 256; int e = 0; for (int j = 0; j < 64; ++j) if (ps[j + 1] <= p) e = j + 1; tinfo[128 + TIDX] = e < 64 ? e : 63; } }
    for (int i = BID * NTHREADS + TIDX; i < T_ * 2; i += NBLK * NTHREADS) { const int p = ps[eid[i]] + slot[i]; posof[i] = p; rowmap[p] = i >> 1; }
    __syncthreads();
}

struct SrcMoeUp {
    const char* h; const char* wg; const int* tinfo; const int* rowmap; int total;
    __device__ __forceinline__ bool next(int i, UnitD& u) const { const int id = BID + i * NBLK; if (id >= total) return false; u.t0 = id >> 2; u.t1 = id & 3;
        u.t2 = __builtin_amdgcn_readfirstlane(tinfo[128 + u.t0]); u.gA = h; u.gB = wg + ((size_t)u.t2 * DEXP + u.t1 * 128) * D_; return true; }
    __device__ __forceinline__ void va(const UnitD& u, unsigned (&v)[2][2]) const { int R0, C0; stage_pos(TIDX, R0, C0);
#pragma unroll
        for (int hh = 0; hh < 2; ++hh)
#pragma unroll
            for (int i = 0; i < 2; ++i) v[hh][i] = (unsigned)(rowmap[u.t0 * 256 + hh * 128 + R0 + 64 * i] * D_ + C0 * 2); }
    __device__ __forceinline__ void vb(unsigned (&v)[2][2]) const { int R0, C0; stage_pos(TIDX, R0, C0);
#pragma unroll
        for (int i = 0; i < 2; ++i) { const int Rr = perm_row(R0 + 64 * i); v[0][i] = (unsigned)(Rr * D_ + C0 * 2); v[1][i] = (unsigned)(WS_WU - WS_WG) + (unsigned)(Rr * D_ + C0 * 2); } }
};
__device__ __forceinline__ void phase_moe_up(const Args& a, LAS unsigned char* lds, int layer) {
    const int* tinfo = (const int*)(a.ws + WS_TINFO) + layer * 512;
    const int ntm = __builtin_amdgcn_readfirstlane(tinfo[65]);
    SrcMoeUp S{(const char*)(a.ws + WS_H8), (const char*)(a.ws + WS_WG), tinfo, (const int*)(a.ws + WS_ROWMAP), ntm * 4};
    EpiSwiGLU E{a.ws + WS_ACT};
    gemm_stream<true, true>(lds, S, D_ / 128, E);
}

struct SrcMoeDown {
    const char* act; const char* wd; const int* tinfo; int total;
    __device__ __forceinline__ bool next(int i, UnitD& u) const { const int id = BID + i * NBLK; if (id >= total) return false; u.t0 = id >> 3; u.t1 = id & 7;
        u.t2 = __builtin_amdgcn_readfirstlane(tinfo[128 + u.t0]); u.gA = act + (size_t)u.t0 * BM * DEXP; u.gB = wd + ((size_t)u.t2 * D_ + u.t1 * BM) * DEXP; return true; }
    __device__ __forceinline__ void va(const UnitD&, unsigned (&v)[2][2]) const { offs_direct(v, DEXP / 2, false); }
    __device__ __forceinline__ void vb(unsigned (&v)[2][2]) const { offs_direct(v, DEXP / 2, true); }
};
__device__ __forceinline__ void phase_moe_down(const Args& a, LAS unsigned char* lds, int layer) {
    const int* tinfo = (const int*)(a.ws + WS_TINFO) + layer * 512; const int ntm = __builtin_amdgcn_readfirstlane(tinfo[65]);
    SrcMoeDown S{(const char*)(a.ws + WS_ACT), (const char*)(a.ws + WS_WD), tinfo, ntm * 8};
    EpiDown E{a.ws + WS_YMOE};
    gemm_stream<false, true>(lds, S, DEXP / 128, E);
}

struct SrcIn1Tail {
    const char* h; const char* w;
    __device__ __forceinline__ bool next(int i, UnitD& u) const { const int id = BID + i * NBLK; if (id >= 256) return false; u.t0 = id & 63; u.t1 = id >> 6; u.t2 = 0;
        u.gA = h + (size_t)u.t0 * BM * D_ + u.t1 * 512; u.gB = w + (size_t)48 * BM * D_ + u.t1 * 512; return true; }
    __device__ __forceinline__ void va(const UnitD&, unsigned (&v)[2][2]) const { offs_direct(v, D_ / 2, false); }
    __device__ __forceinline__ void vb(unsigned (&v)[2][2]) const { offs_direct(v, D_ / 2, true); }
};
struct EpiTailQ {
    float* O;
    __device__ __forceinline__ void operator()(const Acc& acc, const UnitD& u, int wr, int wc, int fr, int fq) const { store_f32_tile(acc, O + ((size_t)u.t1 * T_ + (size_t)u.t0 * BM) * 64, nullptr, 64, 64, wr, wc, fr, fq, 1.0f / W8_SCALE); }
};
__device__ __forceinline__ void phase_gemm_in1(const Args& a, LAS unsigned char* lds) {
    SrcGridSplit S{(const char*)(a.ws + WS_H8), (const char*)(a.ws + WS_WIN1T), (size_t)BM * D_, (size_t)BM * D_, 64, 64 * 48, D_ / 2, D_ / 2};
    EpiProj E{(bf16_t*)(a.ws + WS_PROJ), N_IN1P, nullptr, 64, 48, 48, 64, 1.0f / W8_SCALE};
    gemm_stream<false, true>(lds, S, D_ / 128, E);
}
__device__ __forceinline__ void phase_gemm_in1_tail(const Args& a, LAS unsigned char* lds) {
    SrcIn1Tail S{(const char*)(a.ws + WS_H8), (const char*)(a.ws + WS_WIN1T)};
    EpiTailQ E{(float*)(a.ws + WS_O)};
    int nt = 4; asm volatile("" : "+s"(nt));
    gemm_stream<false, true>(lds, S, nt, E);
}

__device__ __forceinline__ void phase_gdn_conv(const Args& a) {
    const bf16_t* p1 = (const bf16_t*)(a.ws + WS_PROJ); bf16_t* qc = (bf16_t*)(a.ws + WS_QKVC); const float* cw = a.in[16];
    const int gtid = BID * NTHREADS + TIDX, gsz = NBLK * NTHREADS;
    for (int it = gtid; it < 1024 * (T_ / 128); it += gsz) { const int c = (it & 1023) * 8, seg = it >> 10; const size_t t0 = (size_t)seg * 128;
        float w[4][8];
#pragma unroll
        for (int k = 0; k < 4; ++k) { const f32x4 w0 = *(const f32x4*)(cw + k * 8192 + c), w1 = *(const f32x4*)(cw + k * 8192 + c + 4);
            w[k][0] = w0[0]; w[k][1] = w0[1]; w[k][2] = w0[2]; w[k][3] = w0[3]; w[k][4] = w1[0]; w[k][5] = w1[1]; w[k][6] = w1[2]; w[k][7] = w1[3]; }
        u32x4 x0 = (u32x4){0u, 0u, 0u, 0u}, x1 = x0, x2 = x0;
        if ((t0 & (S_ - 1)) != 0) { x0 = *(const u32x4*)(p1 + (t0 - 3) * N_IN1P + c); x1 = *(const u32x4*)(p1 + (t0 - 2) * N_IN1P + c); x2 = *(const u32x4*)(p1 + (t0 - 1) * N_IN1P + c); }
        const float qsc = c < 2048 ? 0.08838834764831845f : 1.0f;
        u32x4 xa[8];
#pragma unroll
        for (int j = 0; j < 8; ++j) xa[j] = *(const u32x4*)(p1 + (t0 + j) * N_IN1P + c);
#pragma unroll 1
        for (int r0 = 0; r0 < 128; r0 += 8) { u32x4 xb[8];
#pragma unroll
            for (int j = 0; j < 8; ++j) xb[j] = xa[j];
            if (r0 + 8 < 128) {
#pragma unroll
                for (int j = 0; j < 8; ++j) xb[j] = *(const u32x4*)(p1 + (t0 + r0 + 8 + j) * N_IN1P + c); }
#pragma unroll
          for (int j8 = 0; j8 < 8; ++j8) { const u32x4 x3 = xa[j8]; const int r = r0 + j8;
            float acc[8];
#define TAPS(j, f, m) (w[0][j] * f(x0.m) + w[1][j] * f(x1.m) + w[2][j] * f(x2.m) + w[3][j] * f(x3.m))
            acc[0] = TAPS(0, bf_lo, x); acc[1] = TAPS(1, bf_hi, x); acc[2] = TAPS(2, bf_lo, y); acc[3] = TAPS(3, bf_hi, y);
            acc[4] = TAPS(4, bf_lo, z); acc[5] = TAPS(5, bf_hi, z); acc[6] = TAPS(6, bf_lo, w); acc[7] = TAPS(7, bf_hi, w);
#undef TAPS
            float ss = 0.f;
#pragma unroll
            for (int j = 0; j < 8; ++j) { acc[j] = siluf_(acc[j]); ss += acc[j] * acc[j]; }
            ss = row16_sum(ss);
            const float sc = c < 4096 ? rsqrtf(ss + 1e-6f) * qsc : 1.0f;
            u32x4 o; o.x = cvt_pk_bf16(acc[0] * sc, acc[1] * sc); o.y = cvt_pk_bf16(acc[2] * sc, acc[3] * sc); o.z = cvt_pk_bf16(acc[4] * sc, acc[5] * sc); o.w = cvt_pk_bf16(acc[6] * sc, acc[7] * sc);
            *(u32x4*)(qc + (t0 + r) * 8192 + c) = o;
            x0 = x1; x1 = x2; x2 = x3; }
#pragma unroll
            for (int j = 0; j < 8; ++j) xa[j] = xb[j]; } }
    const float* tail = (const float*)(a.ws + WS_O); float* bgo = (float*)(a.ws + WS_BG);
    for (int it = gtid; it < T_ * 32; it += gsz) { const int t = it >> 5, hv = it & 31; float tb = 0.f, ta = 0.f;
#pragma unroll
        for (int kq = 0; kq < 4; ++kq) { tb += tail[((size_t)kq * T_ + t) * 64 + hv]; ta += tail[((size_t)kq * T_ + t) * 64 + 32 + hv]; }
        bgo[t * 64 + hv] = sigmoidf_(tb);
        bgo[t * 64 + 32 + hv] = -__expf(a.in[17][hv]) * softplusf_(ta + a.in[18][hv]); }
}

struct MoeTile { const float* src; unsigned char* dst; int lds_, ldd; };
__device__ __forceinline__ MoeTile moe_tile(const Args& a, int g) {
    const int job = g >> 14, r = g & 16383, e = r >> 8, rr = r & 255; MoeTile t;
    typedef __attribute__((address_space(1))) const float* gcf; gcf s25 = (gcf)a.in[25], s26 = (gcf)a.in[26]; asm volatile("" : "+s"(s25), "+s"(s26));
    if (job < 2) { const int ik = rr >> 3, in = rr & 7; t.lds_ = DEXP; t.ldd = D_;
        t.src = (const float*)(job ? s26 : s25) + ((size_t)(NEXP + e) * D_ + ik * 64) * DEXP + in * 64; t.dst = a.ws + (job ? WS_WU : WS_WG) + ((size_t)e * DEXP + in * 64) * D_ + ik * 64; }
    else { const int ik = rr >> 5, in = rr & 31; t.lds_ = D_; t.ldd = DEXP;
        t.src = a.in[27] + ((size_t)(NEXP + e) * DEXP + ik * 64) * D_ + in * 64; t.dst = a.ws + WS_WD + ((size_t)e * D_ + in * 64) * DEXP + ik * 64; }
    return t;
}
__device__ __forceinline__ void moe_tile_load(const MoeTile& t, int tid, f32x4 (&v)[2]) {
#pragma unroll
    for (int i = 0; i < 2; ++i) { const int idx = tid + i * 512, rr = idx >> 4, c4 = (idx & 15) * 4; v[i] = *(const f32x4*)(t.src + (size_t)rr * t.lds_ + c4); }
}
__device__ __forceinline__ void moe_tile_store(const MoeTile& t, int tid, const f32x4 (&v)[2], LAS float* tile) {
#pragma unroll
    for (int i = 0; i < 2; ++i) { const int idx = tid + i * 512, rr = idx >> 4, c4 = (idx & 15) * 4;
        tile[rr * 65 + c4 + 0] = v[i][0]; tile[rr * 65 + c4 + 1] = v[i][1]; tile[rr * 65 + c4 + 2] = v[i][2]; tile[rr * 65 + c4 + 3] = v[i][3]; }
    LDS_BARRIER();
    { const int n = tid >> 3, kg = (tid & 7) * 8; float f[8];
#pragma unroll
      for (int jj = 0; jj < 8; ++jj) f[jj] = tile[(kg + jj) * 65 + n] * W8_SCALE;
      u32x2 w; w.x = pk_fp8x4(f[0], f[1], f[2], f[3]); w.y = pk_fp8x4(f[4], f[5], f[6], f[7]);
      *(u32x2*)(t.dst + (size_t)n * t.ldd + kg) = w; }
    LDS_BARRIER();
}
constexpr int MOE_TILES = 3 * NEXP * 256;

__device__ __forceinline__ f32x4 mfma16(s16x4 a, s16x4 b, f32x4 c) { return __builtin_amdgcn_mfma_f32_16x16x16bf16_1k(a, b, c, 0, 0, 0); }
__device__ __forceinline__ s16x4 pack4(const f32x4& v) { u32x2 w; w.x = cvt_pk_bf16(v[0], v[1]); w.y = cvt_pk_bf16(v[2], v[3]); return __builtin_bit_cast(s16x4, w); }
__device__ __forceinline__ void phase_gdn_chunk(const Args& a, LAS unsigned char* lds) {
    const bf16_t* qc = (const bf16_t*)(a.ws + WS_QKVC); const float* bgi = (const float*)(a.ws + WS_BG); bf16_t* O = (bf16_t*)(a.ws + WS_O);
    constexpr int VRS = 144, KTRS = 136;
    constexpr int KT = 0, QS = KT + 128 * KTRS, WSL = QS + 64 * RSB, QKS = WSL + 64 * RSB, EE = QKS + 2048, EDD = EE + 256, SET = EDD + 256;
    constexpr int STL = 2 * SET, KS = STL + 64 * RSB, VS = KS + 64 * RSB, X2 = VS + 64 * VRS, LS = X2 + 2048, X1 = LS + 4096, GAM = X1 + 2048, BET = GAM + 256, LEND = BET + 256;
    static_assert(LEND <= LDS_XBW, "gdn lds");
    const int wid = __builtin_amdgcn_readfirstlane(TIDX >> 6);
    const int NCK = S_ / 64;
    for (int blk = BID; blk < NB_ * 32 * 2; blk += NBLK) {
        const int grp = (blk & 7) * 8 + (blk >> 5), mem = (blk >> 3) & 3, b = grp >> 4, hk = grp & 15, hv = 2 * hk + (mem >> 1), vhalf = mem & 1;
        __syncthreads();
        if (wid < 4) {
            const int vt = wid;
            f32x4 Sacc[8];
#pragma unroll
            for (int n = 0; n < 8; ++n) Sacc[n] = (f32x4){0.f, 0.f, 0.f, 0.f};
            { const int lane = TIDX & 63;
              for (int i = lane; i < 16 * RSB / 16; i += 64) *(LAS u32x4*)(lds + STL + 16 * vt * RSB + i * 16) = (u32x4){0u, 0u, 0u, 0u}; }
            int lz = TIDX & 63; asm volatile("" : "+v"(lz));
            const int lane = lz, I = lane & 15, G = lane >> 4, q4 = I >> 2, p4 = I & 3;
            for (int it = 0; it <= NCK; ++it) {
                const int set = ((it - 1) & 1) * SET; const size_t t0 = (size_t)b * S_ + (size_t)(it - 1) * 64;
                f32x4 U[4];
                if (it >= 1) {
#pragma unroll
                    for (int sa = 0; sa < 4; ++sa) U[sa] = mfma16(*(const LAS s16x4*)(lds + X2 + ((sa * 16 + I) * 16 + 4 * G) * 2), lds_tr4(lds + VS + (16 * sa + 4 * G + q4) * VRS + (16 * vt + 4 * p4) * 2), (f32x4){0.f, 0.f, 0.f, 0.f});
                    asm volatile("" : "+v"(U[0]), "+v"(U[1]), "+v"(U[2]), "+v"(U[3]) :: "memory");
                }
                LDS_BARRIER();
#pragma unroll
                for (int sa = 0; sa < 4; ++sa) {
                    if (it >= 1) {
                        bf16x8 sf[4];
#pragma unroll
                        for (int ks = 0; ks < 4; ++ks) sf[ks] = lds_frag(lds + STL + (16 * vt + I) * RSB + (32 * ks + 8 * G) * 2);
                        s16x4 kt[8];
#pragma unroll
                        for (int dt = 0; dt < 8; ++dt) kt[dt] = *(const LAS s16x4*)(lds + set + KT + (16 * dt + I) * KTRS + (16 * sa + 4 * G) * 2);
                        f32x4 dl = U[sa], oq = (f32x4){0.f, 0.f, 0.f, 0.f}, dl2 = oq, oq2 = oq;
#pragma unroll
                        for (int ks = 0; ks < 2; ++ks) { dl = mfma32(lds_frag(lds + set + WSL + (16 * sa + I) * RSB + (32 * ks + 8 * G) * 2), sf[ks], dl);
                            dl2 = mfma32(lds_frag(lds + set + WSL + (16 * sa + I) * RSB + (32 * (ks + 2) + 8 * G) * 2), sf[ks + 2], dl2);
                            oq = mfma32(lds_frag(lds + set + QS + (16 * sa + I) * RSB + (32 * ks + 8 * G) * 2), sf[ks], oq);
                            oq2 = mfma32(lds_frag(lds + set + QS + (16 * sa + I) * RSB + (32 * (ks + 2) + 8 * G) * 2), sf[ks + 2], oq2); }
                        dl += dl2; oq += oq2;
                        const s16x4 dfrag = pack4(dl);
                        const f32x4 e4 = *(const LAS f32x4*)(lds + set + EE + (16 * sa + 4 * G) * 4);
                        oq = mfma16(*(const LAS s16x4*)(lds + set + QKS + ((sa * 16 + I) * 16 + 4 * G) * 2), dfrag, oq * e4);
#pragma unroll
                        for (int r = 0; r < 4; ++r) O[(t0 + 16 * sa + 4 * G + r) * 4096 + hv * 128 + vhalf * 64 + 16 * vt + I] = f2bf(oq[r]);
                        const f32x4 ed4 = *(const LAS f32x4*)(lds + set + EDD + (16 * sa + 4 * G) * 4); const float e15 = *(const LAS float*)(lds + set + EE + (16 * sa + 15) * 4);
                        const s16x4 dsc = pack4(dl * ed4);
#pragma unroll
                        for (int dt = 0; dt < 8; ++dt) {
                            Sacc[dt] = mfma16(kt[dt], dsc, Sacc[dt] * e15);
                            *(LAS s16x4*)(lds + STL + (16 * vt + I) * RSB + (16 * dt + 4 * G) * 2) = pack4(Sacc[dt]); }
                    }
                    if (sa & 1) LDS_BARRIER();
                }
            }
        } else {
            const int pw = wid - 4;
            u32x4 pq[4], pk[4], pv[2]; float pb = 0.f, pg = 0.f;
            { const int ptid = TIDX - 256; const size_t t0 = (size_t)b * S_;
#pragma unroll
              for (int i = 0; i < 4; ++i) { const int c = ptid + i * 256, s2 = c >> 4, c8 = (c & 15) * 8; pq[i] = *(const u32x4*)(qc + (t0 + s2) * 8192 + hk * 128 + c8); pk[i] = *(const u32x4*)(qc + (t0 + s2) * 8192 + 2048 + hk * 128 + c8); }
#pragma unroll
              for (int i = 0; i < 2; ++i) { const int c = ptid + i * 256, s2 = c >> 3, c8 = (c & 7) * 8; pv[i] = *(const u32x4*)(qc + (t0 + s2) * 8192 + 4096 + hv * 128 + vhalf * 64 + c8); }
              if (pw == 1) { pb = bgi[(t0 + ptid - 64) * 64 + hv]; pg = bgi[(t0 + ptid - 64) * 64 + 32 + hv]; } }
            int lz = TIDX & 63; asm volatile("" : "+v"(lz));
            const int lane = lz, ptid = pw * 64 + lane, I = lane & 15, G = lane >> 4, q4 = I >> 2, p4 = I & 3;
            for (int it = 0; it <= NCK; ++it) {
                const int set = (it & 1) * SET; const bool act = it < NCK;
                if (act) {
#pragma unroll
                    for (int i = 0; i < 4; ++i) { const int c = ptid + i * 256, s2 = c >> 4, c8 = (c & 15) * 8; *(LAS u32x4*)(lds + set + QS + s2 * RSB + c8 * 2) = pq[i]; *(LAS u32x4*)(lds + KS + s2 * RSB + c8 * 2) = pk[i]; }
                    if (pw == 1) { float x = pg;
                        x += __builtin_bit_cast(float, __builtin_amdgcn_update_dpp(0, __builtin_bit_cast(int, x), 0x111, 0xf, 0xf, true));
                        x += __builtin_bit_cast(float, __builtin_amdgcn_update_dpp(0, __builtin_bit_cast(int, x), 0x112, 0xf, 0xf, true));
                        x += __builtin_bit_cast(float, __builtin_amdgcn_update_dpp(0, __builtin_bit_cast(int, x), 0x114, 0xf, 0xf, true));
                        x += __builtin_bit_cast(float, __builtin_amdgcn_update_dpp(0, __builtin_bit_cast(int, x), 0x118, 0xf, 0xf, true));
                        const float g15 = __shfl(x, 15, 16);
                        *(LAS float*)(lds + GAM + lane * 4) = x; *(LAS float*)(lds + set + EE + lane * 4) = __expf(x); *(LAS float*)(lds + set + EDD + lane * 4) = __expf(g15 - x); *(LAS float*)(lds + BET + lane * 4) = pb; }
                    if (it + 1 < NCK) { const size_t t1 = (size_t)b * S_ + (size_t)(it + 1) * 64;
#pragma unroll
                        for (int i = 0; i < 4; ++i) { const int c = ptid + i * 256, s2 = c >> 4, c8 = (c & 15) * 8; pq[i] = *(const u32x4*)(qc + (t1 + s2) * 8192 + hk * 128 + c8); pk[i] = *(const u32x4*)(qc + (t1 + s2) * 8192 + 2048 + hk * 128 + c8); }
                        if (pw == 1) { pb = bgi[(t1 + ptid - 64) * 64 + hv]; pg = bgi[(t1 + ptid - 64) * 64 + 32 + hv]; } }
                }
                LDS_BARRIER();
                if (act) { const int sa = pw;
#pragma unroll
                    for (int i = 0; i < 2; ++i) { const int c = ptid + i * 256, s2 = c >> 3, c8 = (c & 7) * 8; *(LAS u32x4*)(lds + VS + s2 * VRS + c8 * 2) = pv[i]; }
                    if (it + 1 < NCK) { const size_t t1 = (size_t)b * S_ + (size_t)(it + 1) * 64;
#pragma unroll
                        for (int i = 0; i < 2; ++i) { const int c = ptid + i * 256, s2 = c >> 3, c8 = (c & 7) * 8; pv[i] = *(const u32x4*)(qc + (t1 + s2) * 8192 + 4096 + hv * 128 + vhalf * 64 + c8); } }
#pragma unroll
                    for (int ty = 0; ty < 2; ++ty) { f32x4 acc = (f32x4){0.f, 0.f, 0.f, 0.f};
#pragma unroll
                        for (int ks = 0; ks < 4; ++ks) { const bf16x8 ka = lds_frag(lds + KS + (16 * sa + I) * RSB + (32 * ks + 8 * G) * 2);
                            const bf16x8 bo = ty ? lds_frag(lds + set + QS + (16 * sa + I) * RSB + (32 * ks + 8 * G) * 2) : ka; acc = mfma32(ka, bo, acc); }
                        const f32x4 gr = *(const LAS f32x4*)(lds + GAM + (16 * sa + 4 * G) * 4); const float gc = *(const LAS float*)(lds + GAM + (16 * sa + I) * 4);
                        if (ty == 0) { const f32x4 br = *(const LAS f32x4*)(lds + BET + (16 * sa + 4 * G) * 4);
#pragma unroll
                            for (int r = 0; r < 4; ++r) { const float val = br[r] * acc[r] * __expf(gr[r] - gc); *(LAS float*)(lds + LS + ((sa * 16 + 4 * G + r) * 16 + I) * 4) = (I < 4 * G + r) ? val : 0.f; } }
                        else { f32x4 o;
#pragma unroll
                            for (int r = 0; r < 4; ++r) { const float val = acc[r] * __expf(gc - gr[r]); o[r] = (4 * G + r <= I) ? val : 0.f; }
                            *(LAS s16x4*)(lds + set + QKS + ((sa * 16 + I) * 16 + 4 * G) * 2) = pack4(o); } } }
                LDS_BARRIER();
                if (act) { const int sa = pw, c = lane >> 2, q = lane & 3;
                    f32x4 lv[16];
#pragma unroll
                    for (int i = 0; i < 16; ++i) lv[i] = *(const LAS f32x4*)(lds + LS + ((sa * 16 + i) * 16 + 4 * q) * 4);
                    float xo[4] = {0.f, 0.f, 0.f, 0.f}, xw[4] = {0.f, 0.f, 0.f, 0.f};
#pragma unroll
                    for (int i = 0; i < 16; ++i) {
                        float p = lv[i][0] * xo[0] + lv[i][1] * xo[1] + lv[i][2] * xo[2] + lv[i][3] * xo[3];
                        p += dpp_f<0xB1>(p); p += dpp_f<0x4E>(p);
                        const float xi = ((i == c) ? 1.0f : 0.0f) - p;
                        xo[i & 3] = (q == (i >> 2)) ? xi : xo[i & 3];
                        xw[i >> 2] = (q == (i & 3)) ? xi : xw[i >> 2]; }
                    const float bc = *(const LAS float*)(lds + BET + (sa * 16 + c) * 4), sc1 = -bc * *(const LAS float*)(lds + set + EE + (sa * 16 + c) * 4);
#pragma unroll
                    for (int k = 0; k < 4; ++k) { const int i = 4 * k + q; *(LAS bf16_t*)(lds + X1 + ((sa * 16 + i) * 16 + c) * 2) = f2bf(xw[k] * sc1); *(LAS bf16_t*)(lds + X2 + ((sa * 16 + i) * 16 + c) * 2) = f2bf(xw[k] * bc); } }
                asm volatile("" ::: "memory");
                if (act) { const int sa = pw;
                    const s16x4 xb = *(const LAS s16x4*)(lds + X1 + ((sa * 16 + I) * 16 + 4 * G) * 2); s16x4 kt[8]; f32x4 w[8];
#pragma unroll
                    for (int dt = 0; dt < 8; ++dt) kt[dt] = lds_tr4(lds + KS + (16 * sa + 4 * G + q4) * RSB + (16 * dt + 4 * p4) * 2);
#pragma unroll
                    for (int dt = 0; dt < 8; ++dt) { w[dt] = mfma16(kt[dt], xb, (f32x4){0.f, 0.f, 0.f, 0.f}); *(LAS s16x4*)(lds + set + KT + (16 * dt + I) * KTRS + (16 * sa + 4 * G) * 2) = kt[dt]; }
#pragma unroll
                    for (int dt = 0; dt < 8; ++dt) *(LAS s16x4*)(lds + set + WSL + (16 * sa + I) * RSB + (16 * dt + 4 * G) * 2) = pack4(w[dt]); }
                LDS_BARRIER();
            }
        }
    }
}

constexpr int N_PHASES = 30;
__global__ void __launch_bounds__(NTHREADS, 2) fwd(Args a0) {
    extern __shared__ __attribute__((aligned(16))) unsigned char smem_raw[];
    LAS unsigned char* lds = (LAS unsigned char*)smem_raw;
    volatile LAS unsigned* xbw = (volatile LAS unsigned*)(lds + LDS_XBW);
    if (TIDX == 0) { xbw[0] = 0u; xbw[1] = 0u; xbw[2] = 0u; xbw[3] = 0u; }
    __syncthreads();
    XcdBarrier bar = xcd_barrier_post((unsigned*)(a0.ws + WS_CTL), xbw);
#ifndef PHMASK
#define PHMASK 0xFFFFFFFFull
#endif
#ifndef DUPMASK
#define DUPMASK 0ull
#endif
#define PH(i, body) do { if (((PHMASK >> (i)) & 1ull) && a0.ph_lo <= (i) && (i) < a0.ph_hi) { __attribute__((address_space(1))) unsigned char* wsp_ = (__attribute__((address_space(1))) unsigned char*)a0.ws; asm volatile("" : "+s"(wsp_)); Args a = a0; a.ws = (unsigned char*)wsp_; const float* xin = a.in[0]; const float* xw = (const float*)(a.ws + WS_X); (void)xin; (void)xw; \
        if ((DUPMASK >> (i)) & 1ull) { body; xcd_barrier(bar); } body; if ((i) + 1 < a0.ph_hi) xcd_barrier(bar); } } while (0)
    PH(0, { phase_prologue(a, lds); __syncthreads(); NORM_PH(0, true)(a, xin, a.in[1], -1); });
    PH(2, phase_gemm_in0(a, lds));
    PH(3, { phase_rg_conv(a); __syncthreads(); phase_hg1(a, lds); });
    PH(4, { phase_rg_gates(a, lds); __syncthreads(); phase_hg2(a); });
    PH(5, { phase_rg_scan(a, lds); __syncthreads(); phase_hg3(a, lds); });
    PH(9, phase_gemm_out<false>(a, lds, D_, a.ws + WS_WOUT0T, xin));
    PH(11, phase_gemm_router(a, lds, 0));
    PH(12, phase_route(a, 0));
    PH(13, phase_rowmap(a, lds, 0));
    PH(14, phase_moe_up(a, lds, 0));
    PH(15, phase_moe_down(a, lds, 0));
    PH(16, { NORM_PH(1, false)(a, nullptr, a.in[1] + D_, 0); if (NBLK != 256) { __syncthreads(); moe_weight_jobs(a, 1, lds); } });
    PH(18, { if (NBLK == 256 && BID >= 128) { moe_weight_jobs_part(a, 1, lds, BID - 128, 128); __syncthreads(); }
             phase_gemm_in1(a, lds); phase_gemm_in1_tail(a, lds); });
    PH(19, phase_gdn_conv(a));
    PH(20, phase_gdn_chunk(a, lds));
    PH(21, phase_gdn_norm(a));
    PH(22, phase_gemm_out<true>(a, lds, 4096, a.ws + WS_WOUT1T, nullptr));
    PH(24, phase_gemm_router(a, lds, 1));
    PH(25, phase_route(a, 1));
    PH(26, phase_rowmap(a, lds, 1));
    PH(27, phase_moe_up(a, lds, 1));
    PH(28, phase_moe_down(a, lds, 1));
    PH(29, NORM_PH(2, false)(a, nullptr, a.in[3], 1));
#undef PH
}

extern "C" void kernel_launch(void* const* d_in, const int* in_sizes, int n_in, void* d_out, int out_size, void* d_ws, size_t ws_size, hipStream_t stream) {
    static int grid = 0;
    if (grid == 0) {
        if (n_in != 28 || ws_size < WS_END) { fprintf(stderr, "kernel_launch: need 28 inputs and %zu bytes of workspace, got %d / %zu\n", (size_t)WS_END, n_in, ws_size); grid = -1; return; }
        int dev = 0, cus = 0, per_cu = 0;
        if (hipGetDevice(&dev) != hipSuccess || hipDeviceGetAttribute(&cus, hipDeviceAttributeMultiprocessorCount, dev) != hipSuccess) { grid = -1; return; }
        if (hipFuncSetAttribute((const void*)fwd, hipFuncAttributeMaxDynamicSharedMemorySize, LDS_BYTES) != hipSuccess) { fprintf(stderr, "kernel_launch: hipFuncSetAttribute failed\n"); grid = -1; return; }
        if (hipOccupancyMaxActiveBlocksPerMultiprocessor(&per_cu, (const void*)fwd, NTHREADS, LDS_BYTES) != hipSuccess || per_cu < 1) { fprintf(stderr, "kernel_launch: occupancy query says %d\n", per_cu); }
        (void)hipGetLastError();
        grid = cus;
    }
    if (grid < 0) return;
    (void)in_sizes; (void)out_size;
    hipMemsetAsync((char*)d_ws + WS_CTL, 0, CTL_BYTES, stream);
    Args a; memset(&a, 0, sizeof(a));
    for (int i = 0; i < 28; ++i) a.in[i] = (const float*)d_in[i];
    a.out = (float*)d_out; a.ws = (unsigned char*)d_ws;
#if N_LAUNCH_MODE == 1
    a.ph_lo = 0; a.ph_hi = N_PHASES;
    hipLaunchKernelGGL(fwd, dim3(grid), dim3(NTHREADS), LDS_BYTES, stream, a);
#if EXTRA_PH >= 0
    a.ph_lo = EXTRA_PH; a.ph_hi = EXTRA_PH + 1;
    hipLaunchKernelGGL(fwd, dim3(grid), dim3(NTHREADS), LDS_BYTES, stream, a);
#endif
#else
    for (int p = 0; p < N_PHASES; ++p) { a.ph_lo = p; a.ph_hi = p + 1; hipLaunchKernelGGL(fwd, dim3(grid), dim3(NTHREADS), LDS_BYTES, stream, a); }
#endif
}
```

```cpp
#include <hip/hip_runtime.h>
#include <stdint.h>
#include <stdio.h>
#include <string.h>

#ifndef EXTRA_PH
#define EXTRA_PH -1
#endif
#ifndef N_LAUNCH_MODE
#define N_LAUNCH_MODE 1
#endif

#define LAS __attribute__((address_space(3)))
typedef unsigned short bf16_t;
typedef short bf16x8 __attribute__((ext_vector_type(8)));
typedef float f32x4 __attribute__((ext_vector_type(4)));
typedef float f32x2 __attribute__((ext_vector_type(2)));
typedef unsigned u32x4 __attribute__((ext_vector_type(4)));
typedef unsigned u32x2 __attribute__((ext_vector_type(2)));

constexpr int T_ = 16384, D_ = 2048, S_ = 4096, NB_ = 4;
constexpr int N_IN0 = 6144, N_IN1 = 12352, N_IN1P = 12544;
constexpr int NEXP = 64, DEXP = 512, MPAD = 49152;
constexpr int NTHREADS = 512;
constexpr int LDS_MAIN = 131072;
constexpr int LDS_BYTES = 163840;
constexpr int LDS_XBW = LDS_BYTES - 16;

constexpr size_t al256(size_t x) { return (x + 255) & ~(size_t)255; }
constexpr size_t WS_CTL = 0;
constexpr size_t CTL_BYTES = 65536;
constexpr size_t CTL_CNT = 16384;
constexpr size_t WS_LB = WS_CTL + CTL_BYTES;
constexpr size_t WS_TINFO = WS_LB + 4096;
constexpr size_t WS_WIN0T = WS_TINFO + 4096;
constexpr size_t WS_WOUT0T = WS_WIN0T + (size_t)N_IN0 * D_ * 2;
constexpr size_t WS_WIN1T = WS_WOUT0T + (size_t)D_ * D_ * 2;
constexpr size_t WS_WOUT1T = WS_WIN1T + (size_t)N_IN1P * D_ * 2;
constexpr size_t WS_WGATES = WS_WOUT1T + (size_t)D_ * 4096 * 2;
constexpr size_t WS_WRT = WS_WGATES + (size_t)8 * 256 * 256 * 2;
constexpr size_t WS_WG = WS_WRT + (size_t)2 * 256 * D_ * 2;
constexpr size_t WS_WU = WS_WG + (size_t)NEXP * DEXP * D_ * 2;
constexpr size_t WS_WD = WS_WU + (size_t)NEXP * DEXP * D_ * 2;
constexpr size_t WS_X = WS_WD + (size_t)NEXP * DEXP * D_ * 2;
constexpr size_t WS_H = WS_X + (size_t)T_ * D_ * 4;
constexpr size_t WS_PROJ = WS_H + (size_t)T_ * D_ * 2;
constexpr size_t PROJ_BYTES = (size_t)T_ * N_IN1P * 2;
constexpr size_t WS_FLOG = WS_PROJ + (size_t)T_ * N_IN0 * 2;
constexpr size_t WS_XC = WS_FLOG + (size_t)T_ * 1024 * 4;
constexpr size_t WS_ACT = WS_PROJ;
constexpr size_t WS_YMOE = WS_ACT + (size_t)MPAD * DEXP * 2;
constexpr size_t WS_R1 = WS_PROJ + PROJ_BYTES;
constexpr size_t WS_A = WS_R1;
constexpr size_t WS_U = WS_R1 + (size_t)T_ * 1024 * 4;
constexpr size_t WS_QKVC = WS_R1;
constexpr size_t WS_Y = WS_R1 + (size_t)T_ * 8192 * 2;
constexpr size_t WS_O = WS_Y + (size_t)T_ * 4096 * 2;
constexpr size_t WS_TAIL = WS_O + (size_t)T_ * 4096 * 4;
constexpr size_t WS_BG = WS_TAIL + (size_t)T_ * 64 * 4;
constexpr size_t WS_LOGITS = WS_BG + (size_t)T_ * 64 * 4;
constexpr size_t WS_EID = WS_LOGITS + (size_t)T_ * 128 * 4;
constexpr size_t WS_SLOT = WS_EID + (size_t)T_ * 2 * 4;
constexpr size_t WS_GATE = WS_SLOT + (size_t)T_ * 2 * 4;
constexpr size_t WS_POSOF = WS_GATE + (size_t)T_ * 2 * 4;
constexpr size_t WS_ROWMAP = WS_POSOF + (size_t)T_ * 2 * 4;
constexpr size_t WS_H8 = WS_ROWMAP + (size_t)MPAD * 4;
constexpr size_t WS_RSP = WS_H8 + (size_t)T_ * D_;
constexpr size_t WS_END = WS_RSP + (size_t)T_ * 32 * 4;
static_assert(WS_YMOE + (size_t)MPAD * D_ * 2 <= WS_R1, "moe overlay");
static_assert(WS_XC + (size_t)T_ * 1024 * 2 <= WS_R1, "layer0 overlay");

struct Args {
    const float* in[28];
    float* out;
    unsigned char* ws;
    int ph_lo, ph_hi;
};

__device__ __forceinline__ int tidx_() { int t = (int)threadIdx.x; asm volatile("" : "+v"(t)); return t; }
#define TIDX tidx_()
typedef __bf16 bf16x2n __attribute__((ext_vector_type(2)));
__device__ __forceinline__ unsigned cvt_pk_bf16(float lo, float hi) { const f32x2 v = {lo, hi}; return __builtin_bit_cast(unsigned, __builtin_convertvector(v, bf16x2n)); }
__device__ __forceinline__ unsigned pk_fp8x4(float a, float b, float c, float d) { int v = __builtin_amdgcn_cvt_pk_fp8_f32(a, b, 0, false); v = __builtin_amdgcn_cvt_pk_fp8_f32(c, d, v, true); return (unsigned)v; }
constexpr float W8_SCALE = 64.0f, ACT8_SCALE = 8.0f;
__device__ __forceinline__ bf16_t f2bf(float x) { return (bf16_t)(cvt_pk_bf16(x, 0.f) & 0xffffu); }
__device__ __forceinline__ float bf_lo(unsigned w) { return __uint_as_float(w << 16); }
__device__ __forceinline__ float bf_hi(unsigned w) { return __uint_as_float(w & 0xffff0000u); }
__device__ __forceinline__ float bf1(bf16_t v) { return __uint_as_float(((unsigned)v) << 16); }
__device__ __forceinline__ float sigmoidf_(float x) { return __builtin_amdgcn_rcpf(1.0f + __expf(-x)); }
__device__ __forceinline__ float siluf_(float x) { return x * __builtin_amdgcn_rcpf(1.0f + __expf(-x)); }
__device__ __forceinline__ float softplusf_(float x) { return x > 20.f ? x : log1pf(__expf(x)); }
__device__ __forceinline__ float gelu_tanh(float x) { const float u = 0.7978845608028654f * (x + 0.044715f * x * x * x); return x * __builtin_amdgcn_rcpf(1.0f + __expf(-2.0f * u)); }
template <int CTRL> __device__ __forceinline__ float dpp_f(float v) { return __builtin_bit_cast(float, __builtin_amdgcn_update_dpp(0, __builtin_bit_cast(int, v), CTRL, 0xf, 0xf, false)); }
__device__ __forceinline__ float row16_sum(float s) { s += dpp_f<0x140>(s); s += dpp_f<0x141>(s); s += dpp_f<0xB1>(s); s += dpp_f<0x4E>(s); return s; }
__device__ __forceinline__ float wave_sum(float v) { v = row16_sum(v); v += __shfl_xor(v, 16); v += __shfl_xor(v, 32); return v; }

#define LDS_BARRIER() do { asm volatile("s_waitcnt lgkmcnt(0)" ::: "memory"); __builtin_amdgcn_s_barrier(); asm volatile("" ::: "memory"); } while (0)
#define XB_TMO      128
#define XB_XCNT(j)  (256  + 64 * (j))
#define XB_XSUB(j)  (1280 + 64 * (j))
#define XB_XGEN(j)  (2304 + 64 * (j))
#define XB_TOP      3328
#define XB_TOPGEN   3392
#define XCD_BAR_WORDS 3456
#define XB_SPIN_CAP (1u << 18)

__device__ __forceinline__ unsigned xb_ld(unsigned* p)              { return __hip_atomic_load(p, __ATOMIC_RELAXED, __HIP_MEMORY_SCOPE_AGENT); }
__device__ __forceinline__ unsigned xb_add(unsigned* p, unsigned v) { return __hip_atomic_fetch_add(p, v, __ATOMIC_RELAXED, __HIP_MEMORY_SCOPE_AGENT); }
__device__ __forceinline__ unsigned xb_xcc_id() { return (unsigned)__builtin_amdgcn_s_getreg((3 << 11) | 20) & 0xFu; }
#define XB_SPIN(cond, bar) do { unsigned _sp = 0; while (cond) { __builtin_amdgcn_s_sleep(1); \
    if ((++_sp & 255u) == 0u) { if (xb_ld(&(bar)[XB_TMO])) break; if (_sp > XB_SPIN_CAP) { atomicAdd(&(bar)[XB_TMO], 1u); break; } } } } while (0)

struct XcdBarrier { unsigned* bar; unsigned x; volatile LAS unsigned* st; };

__device__ __forceinline__ XcdBarrier xcd_barrier_post(unsigned* bar, volatile LAS unsigned* st) {
    XcdBarrier b; b.bar = bar; b.x = xb_xcc_id(); b.st = st;
    if (TIDX == 0) (void)xb_add(&bar[XB_XCNT(b.x)], 1u);
    return b;
}
__device__ __forceinline__ void xcd_barrier_complete(unsigned* bar, unsigned x, unsigned& nloc, unsigned& nx) {
    const unsigned G = gridDim.x * gridDim.y * gridDim.z;
    unsigned sum, cnt, mine, sp = 0u;
    for (;;) {
        sum = 0u; cnt = 0u; mine = 0u;
#pragma unroll
        for (unsigned j = 0; j < 16; ++j) { const unsigned c = xb_ld(&bar[XB_XCNT(j)]); sum += c; cnt += (c > 0u) ? 1u : 0u; mine = (j == x) ? c : mine; }
        if (sum == G) break;
        __builtin_amdgcn_s_sleep(1);
        if ((++sp & 255u) == 0u) { if (xb_ld(&bar[XB_TMO])) break; if (sp > XB_SPIN_CAP) { atomicAdd(&bar[XB_TMO], 1u); break; } }
    }
    nloc = mine > 0u ? mine : 1u; nx = cnt > 0u ? cnt : 1u;
}
__device__ __forceinline__ void xcd_barrier(const XcdBarrier& b) {
    asm volatile("s_waitcnt vmcnt(0)" ::: "memory");
    __syncthreads();
    if (TIDX == 0) {
        unsigned* bar = b.bar;
        __builtin_amdgcn_s_waitcnt(0);
        unsigned nloc = b.st[0], nx = b.st[1];
        if (nloc == 0u) { xcd_barrier_complete(bar, b.x, nloc, nx); b.st[0] = nloc; b.st[1] = nx; }
        const unsigned old = xb_add(&bar[XB_XSUB(b.x)], 1u);
        const unsigned gen = old / nloc;
        if (old + 1u == (gen + 1u) * nloc) {
            __builtin_amdgcn_fence(__ATOMIC_RELEASE, "agent");
            asm volatile("s_waitcnt vmcnt(0)" ::: "memory");
            const unsigned og = xb_add(&bar[XB_TOP], 1u);
            const unsigned tg = og / nx;
            if (og + 1u == (tg + 1u) * nx) xb_add(&bar[XB_TOPGEN], 1u);
            else XB_SPIN(xb_ld(&bar[XB_TOPGEN]) == tg, bar);
            __builtin_amdgcn_fence(__ATOMIC_ACQUIRE, "agent");
            xb_add(&bar[XB_XGEN(b.x)], 1u);
            asm volatile("s_waitcnt vmcnt(0)" ::: "memory");
        } else {
            XB_SPIN(xb_ld(&bar[XB_XGEN(b.x)]) == gen, bar);
            __builtin_amdgcn_fence(__ATOMIC_ACQUIRE, "agent");
            asm volatile("s_waitcnt vmcnt(0)" ::: "memory");
        }
    }
    __syncthreads();
}

constexpr int BM = 256, BK = 64, HALF = 128, HTB = HALF * BK * 2;
__device__ __forceinline__ int lds_byte(int r, int c) { const int st = (r >> 4) * 2 + (c >> 5), rr = r & 15, cc = c & 31, ob = rr * 64 + cc * 2; return st * 1024 + (ob ^ (((ob >> 9) & 1) << 5)); }
__device__ __forceinline__ void stage_rc(int b, int& R, int& C) { const int st = b / 1024, sb = b % 1024, swz = sb ^ (((sb >> 9) & 1) << 5); R = (st >> 1) * 16 + swz / 64; C = (st & 1) * 32 + (swz % 64) / 2; }
__device__ __forceinline__ int perm32(int rho) { const int n = rho >> 4, i = rho & 15; return 8 * (i >> 2) + 4 * n + (i & 3); }

__device__ __forceinline__ void stage_pos(int tid, int& R0, int& C0) { stage_rc(tid * 16, R0, C0); }
__device__ __forceinline__ int perm_row(int R) { return (R & ~31) + perm32(R & 31); }

#define BID ((int)blockIdx.x)
#define NBLK ((int)gridDim.x)
#define BID_ BID
#define NBLK_ NBLK
typedef f32x4 Acc[2][2][4][2];
struct UnitD { const char* gA; const char* gB; int t0, t1, t2; };

typedef int i32x8 __attribute__((ext_vector_type(8)));
typedef int i32x4 __attribute__((ext_vector_type(4)));
template <bool GATHER, bool FP8, class Src, class Epi>
__device__ __forceinline__ void gemm_stream(LAS unsigned char* lds, const Src& S, const int nt, const Epi& E) {
    const int tid = TIDX, wid = tid >> 6, lane = tid & 63, wr = wid >> 2, wc = wid & 3, fr = lane & 15, fq = lane >> 4;
    const unsigned ldsw = (unsigned)wid * 1024u;
    const int aoff = lds_byte(wr * 64 + fr, fq * 8), boff = lds_byte(wc * 32 + fr, fq * 8);
    const size_t kstep = (size_t)(BK * 2);
#define G_SA(b, h) (((b) * 2 + (h)) * HTB)
#define G_SB(b, h) ((4 + (b) * 2 + (h)) * HTB)
#define G_STAGE(bufoff, gbase, v) do { _Pragma("unroll") for (int _i = 0; _i < 2; ++_i) \
        __builtin_amdgcn_global_load_lds((const unsigned*)((gbase) + (v)[_i]), (LAS unsigned*)(lds + (bufoff) + ldsw + _i * 8192), 16, 0, 0); } while (0)
#define G_LD8(p) __builtin_shufflevector(*(const LAS i32x4*)(p), *(const LAS i32x4*)((p) + 1024), 0, 1, 2, 3, 4, 5, 6, 7)
#define G_LDA(dst, b, h) do { _Pragma("unroll") for (int m = 0; m < 4; ++m) dst[m] = G_LD8(lds + G_SA(b, h) + aoff + m * 2048); } while (0)
#define G_LDB(dst, b, h) do { _Pragma("unroll") for (int n = 0; n < 2; ++n) dst[n] = G_LD8(lds + G_SB(b, h) + boff + n * 2048); } while (0)
#define G_HALF(x, k) __builtin_bit_cast(bf16x8, __builtin_shufflevector((x), (x), 4 * (k), 4 * (k) + 1, 4 * (k) + 2, 4 * (k) + 3))
#define G_MMA(ai, bj, At, Bt) do { __builtin_amdgcn_s_setprio(1); _Pragma("unroll") for (int m = 0; m < 4; ++m) _Pragma("unroll") for (int n = 0; n < 2; ++n) { \
        if (FP8) asm volatile("v_mfma_f32_16x16x128_f8f6f4 %0, %1, %2, %0" : "+v"(acc[ai][bj][m][n]) : "v"(Bt[n]), "v"(At[m]));   \
        else { acc[ai][bj][m][n] = __builtin_amdgcn_mfma_f32_16x16x32_bf16(G_HALF(Bt[n], 0), G_HALF(At[m], 0), acc[ai][bj][m][n], 0, 0, 0); \
               acc[ai][bj][m][n] = __builtin_amdgcn_mfma_f32_16x16x32_bf16(G_HALF(Bt[n], 1), G_HALF(At[m], 1), acc[ai][bj][m][n], 0, 0, 0); } } \
        __builtin_amdgcn_s_setprio(0); } while (0)
#define G_WAIT_V(n) asm volatile("s_waitcnt vmcnt(" #n ")" ::: "memory")
#define G_WAIT_L(n) asm volatile("s_waitcnt lgkmcnt(" #n ")" ::: "memory")
#define G_BAR __builtin_amdgcn_s_barrier()
#define G_SCHED __builtin_amdgcn_sched_barrier(0)
    UnitD cur, nxt; int ui = 0;
    if (!S.next(0, cur)) return;
    unsigned va[2][2], vb[2][2], van[2][2];
    S.vb(vb); S.va(cur, va);
    Acc acc;
#pragma unroll
    for (int a = 0; a < 2; ++a)
#pragma unroll
        for (int b = 0; b < 2; ++b)
#pragma unroll
            for (int m = 0; m < 4; ++m)
#pragma unroll
                for (int n = 0; n < 2; ++n) acc[a][b][m][n] = (f32x4){0.f, 0.f, 0.f, 0.f};
    i32x8 At[4], B0[2], B1[2];
    const char* cA = cur.gA; const char* cB = cur.gB;
    G_WAIT_V(0);
    __syncthreads();
    G_STAGE(G_SB(0, 0), cB, vb[0]); G_STAGE(G_SA(0, 0), cA, va[0]); G_STAGE(G_SB(0, 1), cB, vb[1]); G_STAGE(G_SA(0, 1), cA, va[1]);
    if (wr == 1) G_BAR;
    G_WAIT_V(4); G_BAR;
    G_STAGE(G_SB(1, 0), cB + kstep, vb[0]); G_STAGE(G_SA(1, 0), cA + kstep, va[0]); G_STAGE(G_SB(1, 1), cB + kstep, vb[1]);
    G_WAIT_V(6); G_BAR;
    for (;;) {
        const bool has_next = S.next(ui + 1, nxt);
        const char* nA = has_next ? nxt.gA : cA; const char* nB = has_next ? nxt.gB : cB;
        if (GATHER) { if (has_next) S.va(nxt, van); else { van[0][0] = va[0][0]; van[0][1] = va[0][1]; van[1][0] = va[1][0]; van[1][1] = va[1][1]; } }
#pragma unroll 1
        for (int t = 0; t < nt; t += 2) {
            const bool last = (t == nt - 2);
            const char* a1 = cA + (size_t)(t + 1) * kstep;
            const char* a2 = last ? nA : cA + (size_t)(t + 2) * kstep; const char* b2 = last ? nB : cB + (size_t)(t + 2) * kstep;
            const char* a3 = a2 + kstep; const char* b3 = b2 + kstep;
            unsigned v2[2][2];
#pragma unroll
            for (int hh = 0; hh < 2; ++hh)
#pragma unroll
                for (int i = 0; i < 2; ++i) v2[hh][i] = (GATHER && last) ? van[hh][i] : va[hh][i];
            G_LDB(B0, 0, 0); G_SCHED; G_LDA(At, 0, 0); G_STAGE(G_SA(1, 1), a1, va[1]);
            G_WAIT_L(8); G_BAR; G_WAIT_L(0); G_MMA(0, 0, At, B0); G_BAR; G_SCHED;
            G_LDB(B1, 0, 1); G_STAGE(G_SB(0, 0), b2, vb[0]);
            G_BAR; G_WAIT_L(0); G_MMA(0, 1, At, B1); G_BAR;
            G_LDA(At, 0, 1); G_STAGE(G_SA(0, 0), a2, v2[0]);
            G_BAR; G_WAIT_L(0); G_MMA(1, 0, At, B0); G_BAR; G_SCHED;
            G_STAGE(G_SB(0, 1), b2, vb[1]);
            G_WAIT_V(6); G_BAR; G_MMA(1, 1, At, B1); G_BAR;
            G_LDB(B0, 1, 0); G_SCHED; G_LDA(At, 1, 0); G_STAGE(G_SA(0, 1), a2, v2[1]);
            G_WAIT_L(8); G_BAR; G_WAIT_L(0); G_MMA(0, 0, At, B0); G_BAR; G_SCHED;
            G_LDB(B1, 1, 1); G_STAGE(G_SB(1, 0), b3, vb[0]);
            G_BAR; G_WAIT_L(0); G_MMA(0, 1, At, B1); G_BAR;
            G_LDA(At, 1, 1); G_STAGE(G_SA(1, 0), a3, v2[0]);
            G_BAR; G_WAIT_L(0); G_MMA(1, 0, At, B0); G_BAR; G_SCHED;
            G_STAGE(G_SB(1, 1), b3, vb[1]);
            G_WAIT_V(6); G_BAR; G_MMA(1, 1, At, B1); G_BAR;
        }
        if (FP8) asm volatile("s_nop 15\n\ts_nop 15" ::: "memory");
        { int tz = TIDX; asm volatile("" : "+v"(tz));
          const int wid2 = tz >> 6, lane2 = tz & 63; E(acc, cur, wid2 >> 2, wid2 & 3, lane2 & 15, lane2 >> 4); }
        if (!has_next) break;
#pragma unroll
        for (int a = 0; a < 2; ++a)
#pragma unroll
            for (int b = 0; b < 2; ++b)
#pragma unroll
                for (int m = 0; m < 4; ++m)
#pragma unroll
                    for (int n = 0; n < 2; ++n) acc[a][b][m][n] = (f32x4){0.f, 0.f, 0.f, 0.f};
        cur = nxt; cA = nA; cB = nB; ++ui;
        if (GATHER) { va[0][0] = van[0][0]; va[0][1] = van[0][1]; va[1][0] = van[1][0]; va[1][1] = van[1][1]; }
    }
    G_WAIT_V(0);
    if (wr == 0) G_BAR;
    G_BAR;
#undef G_SA
#undef G_SB
#undef G_STAGE
#undef G_LDA
#undef G_LDB
#undef G_MMA
#undef G_LD8
#undef G_HALF
#undef G_WAIT_V
#undef G_WAIT_L
#undef G_BAR
#undef G_SCHED
}

__device__ __forceinline__ void offs_direct(unsigned (&v)[2][2], int ld, bool perm) {
    int R0, C0; stage_pos(TIDX, R0, C0);
#pragma unroll
    for (int i = 0; i < 2; ++i) { const int R = R0 + 64 * i, Rr = perm ? perm_row(R) : R;
        v[0][i] = (unsigned)(Rr * ld + C0) * 2u; v[1][i] = (unsigned)((Rr + HALF) * ld + C0) * 2u; }
}

struct SrcGrid {
    const char* A; const char* B; size_t astep, bstep; int nM, total, lda, ldb;
    __device__ __forceinline__ bool next(int i, UnitD& u) const { const int id = BID_ + i * NBLK_; if (id >= total) return false; u.t0 = id % nM; u.t1 = id / nM; u.t2 = 0;
        u.gA = A + (size_t)u.t0 * astep; u.gB = B + (size_t)u.t1 * bstep; return true; }
    __device__ __forceinline__ void va(const UnitD&, unsigned (&v)[2][2]) const { offs_direct(v, lda, false); }
    __device__ __forceinline__ void vb(unsigned (&v)[2][2]) const { offs_direct(v, ldb, true); }
};

struct SrcGridSplit {
    const char* A; const char* B; size_t astep, bstep; int nM, total, lda, ldb, na, nb;
    __device__ __forceinline__ bool next(int i, UnitD& u) const { int id;
        if (NBLK_ == 256 && total == 128 * (na + nb)) { if (BID_ < 128) { if (i >= na) return false; id = BID_ + 128 * i; } else { if (i >= nb) return false; id = 128 * na + (BID_ - 128) + 128 * i; } }
        else { id = BID_ + i * NBLK_; if (id >= total) return false; }
        u.t0 = id % nM; u.t1 = id / nM; u.t2 = 0; u.gA = A + (size_t)u.t0 * astep; u.gB = B + (size_t)u.t1 * bstep; return true; }
    __device__ __forceinline__ void va(const UnitD&, unsigned (&v)[2][2]) const { offs_direct(v, lda, false); }
    __device__ __forceinline__ void vb(unsigned (&v)[2][2]) const { offs_direct(v, ldb, true); }
};

__device__ __forceinline__ void store_bf16_tile(const Acc& acc, bf16_t* O, int ld, int wr, int wc, int fr, int fq, const float sc = 1.0f) {
#pragma unroll
    for (int ai = 0; ai < 2; ++ai)
#pragma unroll
        for (int m = 0; m < 4; ++m) { bf16_t* rowp = O + (size_t)(ai * HALF + wr * 64 + m * 16 + fr) * ld + wc * 32 + 8 * fq;
#pragma unroll
            for (int bj = 0; bj < 2; ++bj) { const f32x4 v0 = acc[ai][bj][m][0] * sc, v1 = acc[ai][bj][m][1] * sc;
                u32x4 w; w.x = cvt_pk_bf16(v0[0], v0[1]); w.y = cvt_pk_bf16(v0[2], v0[3]); w.z = cvt_pk_bf16(v1[0], v1[1]); w.w = cvt_pk_bf16(v1[2], v1[3]);
                *(u32x4*)(rowp + bj * HALF) = w; } }
}
__device__ __forceinline__ void store_f32_tile(const Acc& acc, float* O, const float* R, int ld, int ncol, int wr, int wc, int fr, int fq, const float sc = 1.0f) {
#pragma unroll
    for (int ai = 0; ai < 2; ++ai)
#pragma unroll
        for (int m = 0; m < 4; ++m) { const size_t ro = (size_t)(ai * HALF + wr * 64 + m * 16 + fr) * ld;
#pragma unroll
            for (int bj = 0; bj < 2; ++bj)
#pragma unroll
                for (int n = 0; n < 2; ++n) { const int c = bj * HALF + wc * 32 + 8 * fq + 4 * n; if (c >= ncol) continue;
                    f32x4 v = acc[ai][bj][m][n] * sc; if (R) v += *(const f32x4*)(R + ro + c); *(f32x4*)(O + ro + c) = v; } }
}
struct EpiProj {
    bf16_t* O; int ld; float* F; int fld, fp0, fp1, ncol; float sc;
    __device__ __forceinline__ void operator()(const Acc& acc, const UnitD& u, int wr, int wc, int fr, int fq) const {
        if (u.t1 >= fp0 && u.t1 < fp1) store_f32_tile(acc, F + (size_t)u.t0 * BM * fld + (u.t1 - fp0) * BM, nullptr, fld, ncol, wr, wc, fr, fq, sc);
        else store_bf16_tile(acc, O + (size_t)u.t0 * BM * ld + u.t1 * BM, ld, wr, wc, fr, fq, sc);
    }
};
struct EpiResid {
    unsigned char* ws; const float* Rf; float sc;
    __device__ __forceinline__ void row_done(float ss, const UnitD& u, int row, int wc, int fq) const {
        ss += __shfl_xor(ss, 16); ss += __shfl_xor(ss, 32);
        if (fq == 0) ((float*)(ws + WS_RSP))[(size_t)(u.t0 * BM + row) * 32 + u.t1 * 4 + wc] = ss; }
    __device__ __forceinline__ void operator()(const Acc& acc, const UnitD& u, int wr, int wc, int fr, int fq) const {
        const size_t o = (size_t)u.t0 * BM * D_ + u.t1 * BM;
        bf16_t* O = (bf16_t*)(ws + WS_X); const bf16_t* Rb = O;
        if (Rf) {
#pragma unroll
            for (int am = 0; am < 8; ++am) { const int ai = am >> 2, m = am & 3; f32x4 r0[2], r1[2];
                const size_t ro = o + (size_t)(ai * HALF + wr * 64 + m * 16 + fr) * D_ + wc * 32 + 8 * fq; float ss = 0.f;
#pragma unroll
                for (int bj = 0; bj < 2; ++bj) { r0[bj] = *(const f32x4*)(Rf + ro + bj * HALF); r1[bj] = *(const f32x4*)(Rf + ro + bj * HALF + 4); }
#pragma unroll
                for (int bj = 0; bj < 2; ++bj) { const f32x4 v0 = acc[ai][bj][m][0] * sc + r0[bj], v1 = acc[ai][bj][m][1] * sc + r1[bj];
                    u32x4 w; w.x = cvt_pk_bf16(v0[0], v0[1]); w.y = cvt_pk_bf16(v0[2], v0[3]); w.z = cvt_pk_bf16(v1[0], v1[1]); w.w = cvt_pk_bf16(v1[2], v1[3]);
                    *(u32x4*)(O + ro + bj * HALF) = w;
                    ss += v0[0] * v0[0] + v0[1] * v0[1] + v0[2] * v0[2] + v0[3] * v0[3] + v1[0] * v1[0] + v1[1] * v1[1] + v1[2] * v1[2] + v1[3] * v1[3]; }
                row_done(ss, u, ai * HALF + wr * 64 + m * 16 + fr, wc, fq); }
        } else {
#pragma unroll
            for (int am = 0; am < 4; ++am) { const int ai = am >> 1; u32x4 rr[2][2];
#pragma unroll
                for (int mm = 0; mm < 2; ++mm) { const int m = (am & 1) * 2 + mm; const size_t ro = o + (size_t)(ai * HALF + wr * 64 + m * 16 + fr) * D_ + wc * 32 + 8 * fq;
#pragma unroll
                    for (int bj = 0; bj < 2; ++bj) rr[mm][bj] = *(const u32x4*)(Rb + ro + bj * HALF); }
#pragma unroll
                for (int mm = 0; mm < 2; ++mm) { const int m = (am & 1) * 2 + mm; const size_t ro = o + (size_t)(ai * HALF + wr * 64 + m * 16 + fr) * D_ + wc * 32 + 8 * fq; float ss = 0.f;
#pragma unroll
                    for (int bj = 0; bj < 2; ++bj) { f32x4 v0 = acc[ai][bj][m][0] * sc, v1 = acc[ai][bj][m][1] * sc; const u32x4 r = rr[mm][bj];
                        v0[0] += bf_lo(r.x); v0[1] += bf_hi(r.x); v0[2] += bf_lo(r.y); v0[3] += bf_hi(r.y); v1[0] += bf_lo(r.z); v1[1] += bf_hi(r.z); v1[2] += bf_lo(r.w); v1[3] += bf_hi(r.w);
                        u32x4 w; w.x = cvt_pk_bf16(v0[0], v0[1]); w.y = cvt_pk_bf16(v0[2], v0[3]); w.z = cvt_pk_bf16(v1[0], v1[1]); w.w = cvt_pk_bf16(v1[2], v1[3]);
                        *(u32x4*)(O + ro + bj * HALF) = w;
                            ss += v0[0] * v0[0] + v0[1] * v0[1] + v0[2] * v0[2] + v0[3] * v0[3] + v1[0] * v1[0] + v1[1] * v1[1] + v1[2] * v1[2] + v1[3] * v1[3]; }
                    row_done(ss, u, ai * HALF + wr * 64 + m * 16 + fr, wc, fq); } }
        }
    }
};
struct EpiLogits {
    float* O;
    __device__ __forceinline__ void operator()(const Acc& acc, const UnitD& u, int wr, int wc, int fr, int fq) const { store_f32_tile(acc, O + (size_t)u.t0 * BM * 128, nullptr, 128, 128, wr, wc, fr, fq); }
};
struct EpiSwiGLU {
    unsigned char* O;
    __device__ __forceinline__ void operator()(const Acc& acc, const UnitD& u, int wr, int wc, int fr, int fq) const {
        unsigned char* o = O + (size_t)u.t0 * BM * DEXP + u.t1 * 128;
#pragma unroll
        for (int ai = 0; ai < 2; ++ai)
#pragma unroll
            for (int m = 0; m < 4; ++m) { unsigned char* rowp = o + (size_t)(ai * HALF + wr * 64 + m * 16 + fr) * DEXP + wc * 32 + 8 * fq;
                float r[8];
#pragma unroll
                for (int n = 0; n < 2; ++n)
#pragma unroll
                    for (int j = 0; j < 4; ++j) r[n * 4 + j] = (ACT8_SCALE / W8_SCALE) * siluf_(acc[ai][0][m][n][j] * (1.0f / W8_SCALE)) * acc[ai][1][m][n][j];
                u32x2 w; w.x = pk_fp8x4(r[0], r[1], r[2], r[3]); w.y = pk_fp8x4(r[4], r[5], r[6], r[7]);
                *(u32x2*)rowp = w; }
    }
};
struct EpiDown {
    unsigned char* O;
    __device__ __forceinline__ void operator()(const Acc& acc, const UnitD& u, int wr, int wc, int fr, int fq) const {
        unsigned char* o = O + (size_t)u.t0 * BM * D_ + u.t1 * BM; const float sc = 1.0f / (W8_SCALE * ACT8_SCALE);
#pragma unroll
        for (int ai = 0; ai < 2; ++ai)
#pragma unroll
            for (int m = 0; m < 4; ++m) { unsigned char* rowp = o + (size_t)(ai * HALF + wr * 64 + m * 16 + fr) * D_ + wc * 32 + 8 * fq;
#pragma unroll
                for (int bj = 0; bj < 2; ++bj) { const f32x4 v0 = acc[ai][bj][m][0] * sc, v1 = acc[ai][bj][m][1] * sc;
                    u32x2 w; w.x = pk_fp8x4(v0[0], v0[1], v0[2], v0[3]); w.y = pk_fp8x4(v1[0], v1[1], v1[2], v1[3]); *(u32x2*)(rowp + bj * HALF) = w; } }
    }
};
__device__ __forceinline__ unsigned rg_idx(unsigned tok, int c) { return ((((tok >> 12) * 64u + (unsigned)(c >> 4)) * (unsigned)S_ + (tok & (unsigned)(S_ - 1))) << 4) + (unsigned)(c & 15); }
struct EpiRgGates {
    bf16_t* LAo; bf16_t* Uo; const bf16_t* xc;
    const float* ba; const float* bx; const float* lam;
    __device__ __forceinline__ void operator()(const Acc& acc, const UnitD& u, int wr, int wc, int fr, int fq) const {
#pragma unroll
        for (int n = 0; n < 2; ++n) { const int c = u.t1 * 128 + wc * 32 + 8 * fq + 4 * n;
            u32x2 xq[2][4];
#pragma unroll
            for (int ai = 0; ai < 2; ++ai)
#pragma unroll
                for (int m = 0; m < 4; ++m) xq[ai][m] = *(const u32x2*)(xc + ((unsigned)(u.t0 * BM + ai * HALF + wr * 64 + m * 16 + fr) * 1024u + (unsigned)c));
            const f32x4 vba = *(const f32x4*)(ba + c), vbx = *(const f32x4*)(bx + c), vl = *(const f32x4*)(lam + c);
            f32x4 c8; for (int j = 0; j < 4; ++j) c8[j] = -8.0f * softplusf_(-vl[j]);
#pragma unroll
            for (int ai = 0; ai < 2; ++ai)
#pragma unroll
                for (int m = 0; m < 4; ++m) { const unsigned tok = (unsigned)(u.t0 * BM + ai * HALF + wr * 64 + m * 16 + fr);
                    const u32x2 xw = xq[ai][m]; const float xv[4] = {bf_lo(xw.x), bf_hi(xw.x), bf_lo(xw.y), bf_hi(xw.y)};
                    f32x4 lv, uv;
#pragma unroll
                    for (int j = 0; j < 4; ++j) { const float r = sigmoidf_(acc[ai][0][m][n][j] + vba[j]), ig = sigmoidf_(acc[ai][1][m][n][j] + vbx[j]);
                        const float la = c8[j] * r, av = __expf(la); lv[j] = la; uv[j] = __builtin_amdgcn_sqrtf(fmaxf(0.f, 1.0f - av * av)) * ig * xv[j]; }
                    const unsigned o = rg_idx(tok, c);
                    u32x2 w0; w0.x = cvt_pk_bf16(lv[0], lv[1]); w0.y = cvt_pk_bf16(lv[2], lv[3]); *(u32x2*)(LAo + o) = w0;
                    u32x2 w1; w1.x = cvt_pk_bf16(uv[0], uv[1]); w1.y = cvt_pk_bf16(uv[2], uv[3]); *(u32x2*)(Uo + o) = w1; } }
    }
};


__device__ __forceinline__ void transpose_job8(const float* src, unsigned char* dst, int K, int N, int ldd, size_t sb, size_t db, int nbatch, LAS unsigned char* lds) {
    const int tid = TIDX, tk = K / 128, tn = N / 64, per = tk * tn, total = per * nbatch;
    const int rr0 = tid >> 4, c4 = (tid & 15) * 4, n = tid >> 3, kg = (tid & 7) * 16;
    f32x4 va[4], vb[4];
#define T8_LD(v, t) { const int u_ = (t), ub_ = u_ / per, ur_ = u_ % per, uik_ = ur_ / tn, uin_ = ur_ % tn; const float* usp_ = src + (size_t)ub_ * sb + (size_t)(uik_ * 128 + rr0) * N + uin_ * 64 + c4; \
        _Pragma("unroll") for (int i = 0; i < 4; ++i) v[i] = *(const f32x4*)(usp_ + (size_t)(i * 32) * N); }
#define T8_ST(v, t, buf) { const int t_ = (t), b_ = t_ / per, r_ = t_ % per, ik_ = r_ / tn, in_ = r_ % tn; LAS float* tile = (LAS float*)(lds + (buf) * (128 * 65 * 4)); \
        _Pragma("unroll") for (int i = 0; i < 4; ++i) { const int rr = rr0 + i * 32; tile[rr * 65 + c4 + 0] = v[i][0]; tile[rr * 65 + c4 + 1] = v[i][1]; tile[rr * 65 + c4 + 2] = v[i][2]; tile[rr * 65 + c4 + 3] = v[i][3]; } \
        if (t_ + 2 * NBLK < total) T8_LD(v, t_ + 2 * NBLK) \
        LDS_BARRIER(); \
        float f[16]; \
        _Pragma("unroll") for (int j = 0; j < 16; ++j) f[j] = tile[(kg + j) * 65 + n] * W8_SCALE; \
        u32x4 w; w.x = pk_fp8x4(f[0], f[1], f[2], f[3]); w.y = pk_fp8x4(f[4], f[5], f[6], f[7]); w.z = pk_fp8x4(f[8], f[9], f[10], f[11]); w.w = pk_fp8x4(f[12], f[13], f[14], f[15]); \
        *(u32x4*)(dst + (size_t)b_ * db + (size_t)(in_ * 64 + n) * ldd + ik_ * 128 + kg) = w; }
    int t = BID;
    if (t < total) T8_LD(va, t)
    if (t + NBLK < total) T8_LD(vb, t + NBLK)
    for (; t < total; t += 2 * NBLK) {
        T8_ST(va, t, 0)
        if (t + NBLK < total) T8_ST(vb, t + NBLK, 1)
    }
#undef T8_LD
#undef T8_ST
    LDS_BARRIER();
}
__device__ __forceinline__ void transpose_job8_deep(const float* src, unsigned char* dst, int K, int N, int ldd, size_t sb, size_t db, int nbatch, LAS unsigned char* lds, int first, int stride) {
    const int tid = TIDX, tk = K / 128, tn = N / 64, per = tk * tn, total = per * nbatch;
    const int rr0 = tid >> 4, c4 = (tid & 15) * 4, n = tid >> 3, kg = (tid & 7) * 16;
    f32x4 va[4], vb[4], vc[4], vd[4];
#define T8_LD(v, t) { const int u_ = (t), ub_ = u_ / per, ur_ = u_ % per, uik_ = ur_ / tn, uin_ = ur_ % tn; const float* usp_ = src + (size_t)ub_ * sb + (size_t)(uik_ * 128 + rr0) * N + uin_ * 64 + c4; \
        _Pragma("unroll") for (int i = 0; i < 4; ++i) v[i] = *(const f32x4*)(usp_ + (size_t)(i * 32) * N); }
#define T8_ST(v, t, buf) { const int t_ = (t), b_ = t_ / per, r_ = t_ % per, ik_ = r_ / tn, in_ = r_ % tn; LAS float* tile = (LAS float*)(lds + (buf) * (128 * 65 * 4)); \
        _Pragma("unroll") for (int i = 0; i < 4; ++i) { const int rr = rr0 + i * 32; tile[rr * 65 + c4 + 0] = v[i][0]; tile[rr * 65 + c4 + 1] = v[i][1]; tile[rr * 65 + c4 + 2] = v[i][2]; tile[rr * 65 + c4 + 3] = v[i][3]; } \
        if (t_ + 4 * stride < total) T8_LD(v, t_ + 4 * stride) \
        LDS_BARRIER(); \
        float f[16]; \
        _Pragma("unroll") for (int j = 0; j < 16; ++j) f[j] = tile[(kg + j) * 65 + n] * W8_SCALE; \
        u32x4 w; w.x = pk_fp8x4(f[0], f[1], f[2], f[3]); w.y = pk_fp8x4(f[4], f[5], f[6], f[7]); w.z = pk_fp8x4(f[8], f[9], f[10], f[11]); w.w = pk_fp8x4(f[12], f[13], f[14], f[15]); \
        *(u32x4*)(dst + (size_t)b_ * db + (size_t)(in_ * 64 + n) * ldd + ik_ * 128 + kg) = w; }
    int t = first;
    if (t < total) T8_LD(va, t)
    if (t + stride < total) T8_LD(vb, t + stride)
    if (t + 2 * stride < total) T8_LD(vc, t + 2 * stride)
    if (t + 3 * stride < total) T8_LD(vd, t + 3 * stride)
    for (; t < total; t += 4 * stride) {
        T8_ST(va, t, 0)
        if (t + stride < total) T8_ST(vb, t + stride, 1)
        if (t + 2 * stride < total) T8_ST(vc, t + 2 * stride, 0)
        if (t + 3 * stride < total) T8_ST(vd, t + 3 * stride, 1)
    }
#undef T8_LD
#undef T8_ST
    LDS_BARRIER();
}
__device__ __forceinline__ void transpose_job(const float* src, bf16_t* dst, int K, int N, int ldd, size_t sb, size_t db, int dalt, int nbatch, LAS unsigned char* lds) {
    const int tid = TIDX, tk = K / 64, tn = N / 64, per = tk * tn, total = per * nbatch;
    const int rr0 = tid >> 4, c4 = (tid & 15) * 4, n = tid >> 3, kg = (tid & 7) * 8;
    f32x4 va[2], vb[2];
#define T16_LD(v, t) { const int u_ = (t), ub_ = u_ / per, ur_ = u_ % per, uik_ = ur_ / tn, uin_ = ur_ % tn; const float* usp_ = src + (size_t)ub_ * sb + (size_t)(uik_ * 64 + rr0) * N + uin_ * 64 + c4; \
        _Pragma("unroll") for (int i = 0; i < 2; ++i) v[i] = *(const f32x4*)(usp_ + (size_t)(i * 32) * N); }
#define T16_ST(v, t, buf) { const int t_ = (t), b_ = t_ / per, r_ = t_ % per, ik_ = r_ / tn, in_ = r_ % tn; LAS float* tile = (LAS float*)(lds + (buf) * (64 * 65 * 4)); \
        _Pragma("unroll") for (int i = 0; i < 2; ++i) { const int rr = rr0 + i * 32; tile[rr * 65 + c4 + 0] = v[i][0]; tile[rr * 65 + c4 + 1] = v[i][1]; tile[rr * 65 + c4 + 2] = v[i][2]; tile[rr * 65 + c4 + 3] = v[i][3]; } \
        if (t_ + 2 * NBLK < total) T16_LD(v, t_ + 2 * NBLK) \
        LDS_BARRIER(); \
        float f[8]; \
        _Pragma("unroll") for (int j = 0; j < 8; ++j) f[j] = tile[(kg + j) * 65 + n]; \
        u32x4 w; w.x = cvt_pk_bf16(f[0], f[1]); w.y = cvt_pk_bf16(f[2], f[3]); w.z = cvt_pk_bf16(f[4], f[5]); w.w = cvt_pk_bf16(f[6], f[7]); \
        *(u32x4*)(dst + (size_t)b_ * db + (size_t)(b_ & 1) * dalt + (size_t)(in_ * 64 + n) * ldd + ik_ * 64 + kg) = w; }
    int t = BID;
    if (t < total) T16_LD(va, t)
    if (t + NBLK < total) T16_LD(vb, t + NBLK)
    for (; t < total; t += 2 * NBLK) {
        T16_ST(va, t, 0)
        if (t + NBLK < total) T16_ST(vb, t + NBLK, 1)
    }
#undef T16_LD
#undef T16_ST
    LDS_BARRIER();
}

__device__ __forceinline__ void moe_weight_jobs(const Args& a, int layer, LAS unsigned char* lds) {
    const size_t lo = (size_t)layer * NEXP * D_ * DEXP;
    transpose_job8(a.in[25] + lo, a.ws + WS_WG, D_, DEXP, D_, (size_t)D_ * DEXP, (size_t)DEXP * D_, NEXP, lds);
    transpose_job8(a.in[26] + lo, a.ws + WS_WU, D_, DEXP, D_, (size_t)D_ * DEXP, (size_t)DEXP * D_, NEXP, lds);
    transpose_job8(a.in[27] + lo, a.ws + WS_WD, DEXP, D_, DEXP, (size_t)D_ * DEXP, (size_t)DEXP * D_, NEXP, lds);
}

__device__ __forceinline__ void moe_weight_jobs_part(const Args& a, int layer, LAS unsigned char* lds, int first, int stride) {
    const size_t lo = (size_t)layer * NEXP * D_ * DEXP;
    transpose_job8_deep(a.in[25] + lo, a.ws + WS_WG, D_, DEXP, D_, (size_t)D_ * DEXP, (size_t)DEXP * D_, NEXP, lds, first, stride);
    transpose_job8_deep(a.in[26] + lo, a.ws + WS_WU, D_, DEXP, D_, (size_t)D_ * DEXP, (size_t)DEXP * D_, NEXP, lds, first, stride);
    transpose_job8_deep(a.in[27] + lo, a.ws + WS_WD, DEXP, D_, DEXP, (size_t)D_ * DEXP, (size_t)DEXP * D_, NEXP, lds, first, stride);
}

__device__ __forceinline__ void phase_prologue(const Args& a, LAS unsigned char* lds) {
    const int gtid = BID * NTHREADS + TIDX, gsz = NBLK * NTHREADS;
    for (int i = gtid; i < 1024; i += gsz) { const float l0 = a.in[12][i], l1 = a.in[12][1024 + i], mx = fmaxf(l0, l1), e0 = __expf(l0 - mx), e1 = __expf(l1 - mx);
        ((float*)(a.ws + WS_LB))[i] = e0 / (e0 + e1); }
    for (int it = gtid; it < 2 * 256 * 256; it += gsz) { const int l = it >> 16, n = (it >> 8) & 255, k8 = (it & 255) * 8; float f[8];
#pragma unroll
        for (int j = 0; j < 8; ++j) { const int k = k8 + j; f[j] = a.in[2][(size_t)l * D_ + k] * (n < 8 ? a.in[21][((size_t)l * D_ + k) * 8 + n] : (n < 72 ? a.in[23][((size_t)l * D_ + k) * 64 + (n - 8)] : 0.f)); }
        u32x4 w; w.x = cvt_pk_bf16(f[0], f[1]); w.y = cvt_pk_bf16(f[2], f[3]); w.z = cvt_pk_bf16(f[4], f[5]); w.w = cvt_pk_bf16(f[6], f[7]);
        *(u32x4*)((bf16_t*)(a.ws + WS_WRT) + ((size_t)l * 256 + n) * D_ + k8) = w; }
    for (int it = gtid; it < 192 * 128; it += gsz) *(u32x4*)(a.ws + WS_WIN1T + (size_t)N_IN1 * D_ + (size_t)it * 16) = (u32x4){0u, 0u, 0u, 0u};
    transpose_job(a.in[4], (bf16_t*)(a.ws + WS_WIN0T), D_, N_IN0, D_, 0, 0, 0, 1, lds);
    transpose_job(a.in[14], (bf16_t*)(a.ws + WS_WOUT0T), D_, D_, D_, 0, 0, 0, 1, lds);
    transpose_job8(a.in[15], a.ws + WS_WIN1T, D_, N_IN1, D_, 0, 0, 1, lds);
    transpose_job8(a.in[20], a.ws + WS_WOUT1T, 4096, D_, 4096, 0, 0, 1, lds);
    transpose_job(a.in[7], (bf16_t*)(a.ws + WS_WGATES), 128, 128, 128, 128 * 128, 256 * 128, 0, 8, lds);
    transpose_job(a.in[9], (bf16_t*)(a.ws + WS_WGATES) + 128 * 128, 128, 128, 128, 128 * 128, 256 * 128, 0, 8, lds);
    if (NBLK != 256) moe_weight_jobs(a, 0, lds);
}

#define NORM_PH(M, F) phase_norm<M, F>
template <int MODE, bool F32>
__device__ __forceinline__ void phase_norm(const Args& a, const float* src, const float* gain, int layer) {
    const int wid = TIDX >> 6, lane = TIDX & 63;
    bf16_t* xw = (bf16_t*)(a.ws + WS_X); bf16_t* hw = (bf16_t*)(a.ws + WS_H);
    const unsigned char* ym = a.ws + WS_YMOE; const int* posof = (const int*)(a.ws + WS_POSOF); const float* gate = (const float*)(a.ws + WS_GATE);
    const int stride = NBLK * 16;
    f32x4 rf[2][8]; u32x2 rb[2][8]; int pp[2][2] = {{0, 0}, {0, 0}}; float pg[2][2] = {{0.f, 0.f}, {0.f, 0.f}};
#define NORM_LD(r) { _Pragma("unroll") for (int u = 0; u < 2; ++u) { _Pragma("unroll") for (int i = 0; i < 8; ++i) { \
            if (F32) rf[u][i] = *(const f32x4*)(src + (size_t)((r) + u) * D_ + (i * 64 + lane) * 4); else rb[u][i] = *(const u32x2*)(xw + (size_t)((r) + u) * D_ + (i * 64 + lane) * 4); } \
            if (MODE >= 1) { pp[u][0] = posof[((r) + u) * 2]; pp[u][1] = posof[((r) + u) * 2 + 1]; pg[u][0] = gate[((r) + u) * 2]; pg[u][1] = gate[((r) + u) * 2 + 1]; } } }
    int row = (BID * 8 + wid) * 2;
    if (row < T_) NORM_LD(row)
    for (; row < T_; row += stride) {
        f32x4 v[2][8]; int p[2][2]; float g[2][2];
#pragma unroll
        for (int u = 0; u < 2; ++u) { p[u][0] = pp[u][0]; p[u][1] = pp[u][1]; g[u][0] = pg[u][0]; g[u][1] = pg[u][1];
#pragma unroll
            for (int i = 0; i < 8; ++i) v[u][i] = F32 ? rf[u][i] : (f32x4){bf_lo(rb[u][i].x), bf_hi(rb[u][i].x), bf_lo(rb[u][i].y), bf_hi(rb[u][i].y)}; }
        if (row + stride < T_) NORM_LD(row + stride)
        if (MODE >= 1) {
            int y[2][8][2];
#pragma unroll
            for (int u = 0; u < 2; ++u) {
#pragma unroll
                for (int i = 0; i < 8; ++i) { const int c = (i * 64 + lane) * 4; y[u][i][0] = *(const int*)(ym + (size_t)p[u][0] * D_ + c); y[u][i][1] = *(const int*)(ym + (size_t)p[u][1] * D_ + c); } }
#pragma unroll
            for (int u = 0; u < 2; ++u) { const float g0 = g[u][0], g1 = g[u][1];
#pragma unroll
                for (int i = 0; i < 8; ++i) { const int y0 = y[u][i][0], y1 = y[u][i][1];
                    const f32x2 a0 = __builtin_amdgcn_cvt_pk_f32_fp8(y0, false), a1 = __builtin_amdgcn_cvt_pk_f32_fp8(y0, true), b0 = __builtin_amdgcn_cvt_pk_f32_fp8(y1, false), b1 = __builtin_amdgcn_cvt_pk_f32_fp8(y1, true);
                    v[u][i][0] += g0 * a0[0] + g1 * b0[0]; v[u][i][1] += g0 * a0[1] + g1 * b0[1]; v[u][i][2] += g0 * a1[0] + g1 * b1[0]; v[u][i][3] += g0 * a1[1] + g1 * b1[1]; }
                if (MODE == 1) {
#pragma unroll
                    for (int i = 0; i < 8; ++i) { u32x2 w; w.x = cvt_pk_bf16(v[u][i][0], v[u][i][1]); w.y = cvt_pk_bf16(v[u][i][2], v[u][i][3]); *(u32x2*)(xw + (size_t)(row + u) * D_ + (i * 64 + lane) * 4) = w; } } }
        }
#pragma unroll
        for (int u = 0; u < 2; ++u) {
            float ss = 0.f;
#pragma unroll
            for (int i = 0; i < 8; ++i) ss += v[u][i][0] * v[u][i][0] + v[u][i][1] * v[u][i][1] + v[u][i][2] * v[u][i][2] + v[u][i][3] * v[u][i][3];
            ss = wave_sum(ss);
            const float rstd = rsqrtf(ss * (1.0f / D_) + 1e-6f);
#pragma unroll
            for (int i = 0; i < 8; ++i) { const int c = (i * 64 + lane) * 4; const f32x4 gn = *(const f32x4*)(gain + c);
                const f32x4 o = v[u][i] * rstd * gn;
                if (MODE == 2) *(f32x4*)(a.out + (size_t)(row + u) * D_ + c) = o;
                else { if (MODE != 1) { u32x2 w; w.x = cvt_pk_bf16(o[0], o[1]); w.y = cvt_pk_bf16(o[2], o[3]); *(u32x2*)(hw + (size_t)(row + u) * D_ + c) = w; }
                       if (layer >= 0) *(unsigned*)(a.ws + WS_H8 + (size_t)(row + u) * D_ + c) = pk_fp8x4(o[0], o[1], o[2], o[3]); } } }
    }
#undef NORM_LD
    (void)layer;
}

__device__ __forceinline__ void phase_gemm_in0(const Args& a, LAS unsigned char* lds) {
    SrcGridSplit S{(const char*)(a.ws + WS_H), (const char*)(a.ws + WS_WIN0T), (size_t)BM * D_ * 2, (size_t)BM * D_ * 2, 64, 64 * 24, D_, D_, 8, 4};
    EpiProj E{(bf16_t*)(a.ws + WS_PROJ), N_IN0, (float*)(a.ws + WS_FLOG), 1024, 12, 16, 256, 1.0f};
    gemm_stream<false, false>(lds, S, D_ / BK, E);
}

__device__ __forceinline__ void phase_rg_conv(const Args& a) {
    const bf16_t* p0 = (const bf16_t*)(a.ws + WS_PROJ); bf16_t* xc = (bf16_t*)(a.ws + WS_XC);
    const float* cw = a.in[5]; const float* cb = a.in[6];
    for (int it = BID * NTHREADS + TIDX; it < 128 * (T_ / 16); it += NBLK * NTHREADS) { const int c = (it & 127) * 8; const size_t t0 = (size_t)(it >> 7) * 16;
        float w[4][8], bias[8];
#pragma unroll
        for (int k = 0; k < 4; ++k) { const f32x4 w0 = *(const f32x4*)(cw + k * 1024 + c), w1 = *(const f32x4*)(cw + k * 1024 + c + 4);
            w[k][0] = w0[0]; w[k][1] = w0[1]; w[k][2] = w0[2]; w[k][3] = w0[3]; w[k][4] = w1[0]; w[k][5] = w1[1]; w[k][6] = w1[2]; w[k][7] = w1[3]; }
        { const f32x4 b0 = *(const f32x4*)(cb + c), b1 = *(const f32x4*)(cb + c + 4); bias[0] = b0[0]; bias[1] = b0[1]; bias[2] = b0[2]; bias[3] = b0[3]; bias[4] = b1[0]; bias[5] = b1[1]; bias[6] = b1[2]; bias[7] = b1[3]; }
        u32x4 x0 = (u32x4){0u, 0u, 0u, 0u}, x1 = x0, x2 = x0;
        if ((t0 & (S_ - 1)) != 0) { x0 = *(const u32x4*)(p0 + (t0 - 3) * N_IN0 + c); x1 = *(const u32x4*)(p0 + (t0 - 2) * N_IN0 + c); x2 = *(const u32x4*)(p0 + (t0 - 1) * N_IN0 + c); }
        u32x4 xr[16];
#pragma unroll
        for (int r = 0; r < 16; ++r) xr[r] = *(const u32x4*)(p0 + (t0 + r) * N_IN0 + c);
#pragma unroll
        for (int r = 0; r < 16; ++r) { const u32x4 x3 = xr[r];
            float acc[8];
#define TAPS(j, f, m) (bias[j] + w[0][j] * f(x0.m) + w[1][j] * f(x1.m) + w[2][j] * f(x2.m) + w[3][j] * f(x3.m))
            acc[0] = TAPS(0, bf_lo, x); acc[1] = TAPS(1, bf_hi, x); acc[2] = TAPS(2, bf_lo, y); acc[3] = TAPS(3, bf_hi, y);
            acc[4] = TAPS(4, bf_lo, z); acc[5] = TAPS(5, bf_hi, z); acc[6] = TAPS(6, bf_lo, w); acc[7] = TAPS(7, bf_hi, w);
#undef TAPS
            u32x4 o; o.x = cvt_pk_bf16(acc[0], acc[1]); o.y = cvt_pk_bf16(acc[2], acc[3]); o.z = cvt_pk_bf16(acc[4], acc[5]); o.w = cvt_pk_bf16(acc[6], acc[7]);
            *(u32x4*)(xc + (t0 + r) * 1024 + c) = o;
            x0 = x1; x1 = x2; x2 = x3; } }
}

struct SrcRgGates {
    const char* xc; const char* w; int total;
    __device__ __forceinline__ bool next(int i, UnitD& u) const { const int id = BID + i * NBLK; if (id >= total) return false; u.t0 = id & 63; u.t1 = id >> 6; u.t2 = 0;
        u.gA = xc + ((size_t)u.t0 * BM * 1024 + u.t1 * 128) * 2; u.gB = w + (size_t)u.t1 * 256 * 128 * 2; return true; }
    __device__ __forceinline__ void va(const UnitD&, unsigned (&v)[2][2]) const { offs_direct(v, 1024, false); }
    __device__ __forceinline__ void vb(unsigned (&v)[2][2]) const { offs_direct(v, 128, true); }
};
__device__ __forceinline__ void phase_rg_gates(const Args& a, LAS unsigned char* lds) {
    SrcRgGates S{(const char*)(a.ws + WS_XC), (const char*)(a.ws + WS_WGATES), 64 * 8};
    EpiRgGates E{(bf16_t*)(a.ws + WS_A), (bf16_t*)(a.ws + WS_U), (const bf16_t*)(a.ws + WS_XC), a.in[8], a.in[10], a.in[11]};
    int nt = 2; asm volatile("" : "+s"(nt));
    gemm_stream<false, false>(lds, S, nt, E);
}

__device__ __forceinline__ void phase_rg_scan(const Args& a, LAS unsigned char* lds) {
    const bf16_t* LA = (const bf16_t*)(a.ws + WS_A); const bf16_t* U = (const bf16_t*)(a.ws + WS_U);
    const bf16_t* p0 = (const bf16_t*)(a.ws + WS_PROJ); bf16_t* Y = (bf16_t*)(a.ws + WS_Y);
    LAS float* sP = (LAS float*)lds; LAS float* sH = sP + 4096; LAS float* gP = sH + 4096; LAS float* gH = gP + 512; LAS float* gC = gH + 512;
    const int tid = TIDX, seg = tid >> 1, c8 = (tid & 1) * 8;
    for (int blk = BID; blk < NB_ * 64; blk += NBLK) { const int b = blk >> 6, c = (blk & 63) * 16 + c8;
        const size_t base = (((size_t)blk * S_ + seg * 16) << 4) + c8;
        float P[8], H[8];
#pragma unroll
        for (int j = 0; j < 8; ++j) { P[j] = 1.f; H[j] = 0.f; }
#pragma unroll 4
        for (int s = 0; s < 16; ++s) { const u32x4 lw = *(const u32x4*)(LA + base + (size_t)s * 16), uw = *(const u32x4*)(U + base + (size_t)s * 16);
            const float la[8] = {bf_lo(lw.x), bf_hi(lw.x), bf_lo(lw.y), bf_hi(lw.y), bf_lo(lw.z), bf_hi(lw.z), bf_lo(lw.w), bf_hi(lw.w)};
            const float uu[8] = {bf_lo(uw.x), bf_hi(uw.x), bf_lo(uw.y), bf_hi(uw.y), bf_lo(uw.z), bf_hi(uw.z), bf_lo(uw.w), bf_hi(uw.w)};
#pragma unroll
            for (int j = 0; j < 8; ++j) { const float av = __expf(la[j]); H[j] = av * H[j] + uu[j]; P[j] *= av; } }
        __syncthreads();
#pragma unroll
        for (int j = 0; j < 8; ++j) { sP[seg * 16 + c8 + j] = P[j]; sH[seg * 16 + c8 + j] = H[j]; }
        __syncthreads();
        { const int ch = tid & 15, grp = tid >> 4; float p = 1.f, h = 0.f;
#pragma unroll
          for (int q = 0; q < 8; ++q) { const int sgi = grp * 8 + q; h = sP[sgi * 16 + ch] * h + sH[sgi * 16 + ch]; p *= sP[sgi * 16 + ch]; }
          gP[grp * 16 + ch] = p; gH[grp * 16 + ch] = h; }
        __syncthreads();
        if (tid < 16) { float carry = 0.f; for (int g = 0; g < 32; ++g) { gC[g * 16 + tid] = carry; carry = gP[g * 16 + tid] * carry + gH[g * 16 + tid]; } }
        __syncthreads();
        { const int ch = tid & 15, grp = tid >> 4; float h = gC[grp * 16 + ch];
#pragma unroll
          for (int q = 0; q < 8; ++q) { const int sgi = grp * 8 + q; const float pin = sP[sgi * 16 + ch], hin = sH[sgi * 16 + ch]; sH[sgi * 16 + ch] = h; h = pin * h + hin; } }
        __syncthreads();
#pragma unroll
        for (int j = 0; j < 8; ++j) H[j] = sH[seg * 16 + c8 + j];
        {
            u32x4 l_a[4], u_a[4], g_a[4];
#define RS_LD(Lv, Uv, Gv, s0) { _Pragma("unroll") for (int j = 0; j < 4; ++j) { const int s_ = (s0) + j; Lv[j] = *(const u32x4*)(LA + base + (size_t)s_ * 16); Uv[j] = *(const u32x4*)(U + base + (size_t)s_ * 16); \
                Gv[j] = *(const u32x4*)(p0 + ((size_t)b * S_ + seg * 16 + s_) * N_IN0 + 1024 + c); } }
            RS_LD(l_a, u_a, g_a, 0)
#pragma unroll
            for (int s0 = 0; s0 < 16; s0 += 4) { u32x4 l_b[4], u_b[4], g_b[4];
#pragma unroll
                for (int j = 0; j < 4; ++j) { l_b[j] = l_a[j]; u_b[j] = u_a[j]; g_b[j] = g_a[j]; }
                if (s0 + 4 < 16) RS_LD(l_b, u_b, g_b, s0 + 4)
#pragma unroll
                for (int j = 0; j < 4; ++j) { const u32x4 lw = l_a[j], uw = u_a[j], gw = g_a[j]; const size_t t = (size_t)b * S_ + seg * 16 + s0 + j;
                    const float la[8] = {bf_lo(lw.x), bf_hi(lw.x), bf_lo(lw.y), bf_hi(lw.y), bf_lo(lw.z), bf_hi(lw.z), bf_lo(lw.w), bf_hi(lw.w)};
                    const float uu[8] = {bf_lo(uw.x), bf_hi(uw.x), bf_lo(uw.y), bf_hi(uw.y), bf_lo(uw.z), bf_hi(uw.z), bf_lo(uw.w), bf_hi(uw.w)};
                    const float gg[8] = {bf_lo(gw.x), bf_hi(gw.x), bf_lo(gw.y), bf_hi(gw.y), bf_lo(gw.z), bf_hi(gw.z), bf_lo(gw.w), bf_hi(gw.w)};
                    float y[8];
#pragma unroll
                    for (int q = 0; q < 8; ++q) { H[q] = __expf(la[q]) * H[q] + uu[q]; y[q] = H[q] * gelu_tanh(gg[q]); }
                    u32x4 o; o.x = cvt_pk_bf16(y[0], y[1]); o.y = cvt_pk_bf16(y[2], y[3]); o.z = cvt_pk_bf16(y[4], y[5]); o.w = cvt_pk_bf16(y[6], y[7]);
                    *(u32x4*)(Y + t * D_ + c) = o; }
#pragma unroll
                for (int j = 0; j < 4; ++j) { l_a[j] = l_b[j]; u_a[j] = u_b[j]; g_a[j] = g_b[j]; } }
#undef RS_LD
        }
    }
}

typedef short s16x4 __attribute__((ext_vector_type(4)));
__device__ __forceinline__ f32x4 mfma32(bf16x8 a, bf16x8 b, f32x4 c) { return __builtin_amdgcn_mfma_f32_16x16x32_bf16(a, b, c, 0, 0, 0); }
__device__ __forceinline__ bf16x8 lds_frag(LAS const unsigned char* p) { return *(const LAS bf16x8*)p; }
__device__ __forceinline__ s16x4 lds_tr4(LAS const unsigned char* p) { return __builtin_amdgcn_ds_read_tr16_b64_v4i16((LAS s16x4*)p); }
__device__ __forceinline__ bf16x8 lds_tr8(LAS const unsigned char* p, int rowskip_bytes) {
    const s16x4 lo = lds_tr4(p), hi = lds_tr4(p + rowskip_bytes); return __builtin_shufflevector(lo, hi, 0, 1, 2, 3, 4, 5, 6, 7); }
__device__ __forceinline__ bf16x8 pack8(const f32x4& lo, const f32x4& hi) { u32x4 w; w.x = cvt_pk_bf16(lo[0], lo[1]); w.y = cvt_pk_bf16(lo[2], lo[3]); w.z = cvt_pk_bf16(hi[0], hi[1]); w.w = cvt_pk_bf16(hi[2], hi[3]); return __builtin_bit_cast(bf16x8, w); }
constexpr int RSB = 272;

constexpr size_t WS_HQ = WS_O;
constexpr size_t WS_HA = WS_HQ + (size_t)2048 * 64 * 128 * 2;
constexpr size_t WS_HG = WS_HA + (size_t)2048 * 8 * 512 * 2;
constexpr size_t WS_HS = WS_HG + (size_t)2048 * 128 * 128 * 2;
constexpr size_t WS_HD = WS_HS + (size_t)2048 * 128 * 128 * 2;
static_assert(WS_HD + (size_t)2048 * 128 * 4 <= WS_TAIL, "hgrn overlay");

__device__ __forceinline__ void phase_hg1(const Args& a, LAS unsigned char* lds) {
    const bf16_t* p0 = (const bf16_t*)(a.ws + WS_PROJ); const float* flog = (const float*)(a.ws + WS_FLOG); const float* lb = (const float*)(a.ws + WS_LB);
    bf16_t* QG = (bf16_t*)(a.ws + WS_HQ); bf16_t* AG = (bf16_t*)(a.ws + WS_HA); bf16_t* GG = (bf16_t*)(a.ws + WS_HG); float* DG = (float*)(a.ws + WS_HD);
    constexpr int SEG = 0, QT = 4096, KT = QT + 64 * RSB, KH = KT + 64 * RSB, VS = KH + 64 * RSB;
    const int tid = TIDX, wid = tid >> 6, lane = tid & 63, I = lane & 15, G = lane >> 4, k2 = 2 * lane, sg = wid;
    LAS float* seg = (LAS float*)(lds + SEG);
    u32x4 pvv[2]; f32x2 pz[8]; unsigned pqw[8];
#define HG1_LOAD(it_) do { const int bh_ = (it_) >> 6, ck_ = (it_) & 63, h_ = bh_ & 7; const size_t t0_ = (size_t)(bh_ >> 3) * S_ + ck_ * 64; \
        _Pragma("unroll") for (int i = 0; i < 2; ++i) { const int c = tid + i * 512, s_ = c >> 4, v8 = (c & 15) * 8; pvv[i] = *(const u32x4*)(p0 + (t0_ + s_) * N_IN0 + 4096 + h_ * 128 + v8); } \
        _Pragma("unroll") for (int i = 0; i < 8; ++i) { const size_t t_ = t0_ + sg * 8 + i; pz[i] = *(const f32x2*)(flog + t_ * 1024 + h_ * 128 + k2); pqw[i] = *(const unsigned*)(p0 + t_ * N_IN0 + 2048 + h_ * 128 + k2); } } while (0)
    if (BID < 2048) HG1_LOAD(BID);
    for (int item = BID; item < 2048; item += NBLK) { const int bh = item >> 6, h = bh & 7;
        LDS_BARRIER();
#pragma unroll
        for (int i = 0; i < 2; ++i) { const int c = tid + i * 512, s = c >> 4, v8 = (c & 15) * 8; *(LAS u32x4*)(lds + VS + s * RSB + v8 * 2) = pvv[i]; }
        const f32x2 l2 = *(const f32x2*)(lb + h * 128 + k2);
        float f[8][2], cb[8][2]; unsigned qw[8]; float c0 = 0.f, c1 = 0.f;
#pragma unroll
        for (int i = 0; i < 8; ++i) { const f32x2 z = pz[i]; qw[i] = pqw[i];
            f[i][0] = l2[0] + (1.0f - l2[0]) * sigmoidf_(z[0]); f[i][1] = l2[1] + (1.0f - l2[1]) * sigmoidf_(z[1]);
            c0 += __logf(f[i][0]); c1 += __logf(f[i][1]); cb[i][0] = c0; cb[i][1] = c1; }
        *(LAS f32x2*)(seg + sg * 128 + k2) = (f32x2){c0, c1};
        if (item + NBLK < 2048) HG1_LOAD(item + NBLK);
        LDS_BARRIER();
        float off0 = 0.f, off1 = 0.f, tot0 = 0.f, tot1 = 0.f;
#pragma unroll
        for (int s2 = 0; s2 < 8; ++s2) { const f32x2 v = *(const LAS f32x2*)(seg + s2 * 128 + k2); tot0 += v[0]; tot1 += v[1]; if (s2 < sg) { off0 += v[0]; off1 += v[1]; } }
        const float et0 = __expf(tot0), et1 = __expf(tot1);
#pragma unroll
        for (int i = 0; i < 8; ++i) { const int t = sg * 8 + i;
            const float e0 = __expf(cb[i][0] + off0), e1 = __expf(cb[i][1] + off1), r0 = __builtin_amdgcn_rcpf(e0), r1 = __builtin_amdgcn_rcpf(e1), km0 = 1.0f - f[i][0], km1 = 1.0f - f[i][1];
            const unsigned qt = cvt_pk_bf16(siluf_(bf_lo(qw[i])) * e0, siluf_(bf_hi(qw[i])) * e1);
            *(LAS unsigned*)(lds + QT + t * RSB + k2 * 2) = qt; *(unsigned*)(QG + ((size_t)item * 64 + t) * 128 + k2) = qt;
            *(LAS unsigned*)(lds + KT + t * RSB + k2 * 2) = cvt_pk_bf16(km0 * r0, km1 * r1);
            *(LAS unsigned*)(lds + KH + t * RSB + k2 * 2) = cvt_pk_bf16(km0 * r0 * et0, km1 * r1 * et1); }
        if (sg == 0) *(f32x2*)(DG + (size_t)item * 128 + k2) = (f32x2){et0, et1};
        LDS_BARRIER();
        { const int tt = wid & 3, sp = wid >> 2;
          bf16x8 qf[4];
#pragma unroll
          for (int ks = 0; ks < 4; ++ks) qf[ks] = lds_frag(lds + QT + (16 * tt + I) * RSB + (32 * ks + 8 * G) * 2);
          f32x4 acc[2];
#pragma unroll
          for (int hh = 0; hh < 2; ++hh) { const int st = 2 * sp + hh; acc[hh] = (f32x4){0.f, 0.f, 0.f, 0.f};
              if (st <= tt) {
#pragma unroll
                  for (int ks = 0; ks < 4; ++ks) acc[hh] = mfma32(lds_frag(lds + KT + (16 * st + I) * RSB + (32 * ks + 8 * G) * 2), qf[ks], acc[hh]);
#pragma unroll
                  for (int r = 0; r < 4; ++r) if (16 * st + 4 * G + r > 16 * tt + I) acc[hh][r] = 0.f; } }
          *(bf16x8*)(AG + (((size_t)item * 4 + tt) * 2 + sp) * 512 + lane * 8) = pack8(acc[0], acc[1]); }
        { const int kt = wid, q = I >> 2, p = I & 3;
          bf16x8 ka[2];
#pragma unroll
          for (int ks = 0; ks < 2; ++ks) ka[ks] = lds_tr8(lds + KH + (32 * ks + 8 * G + q) * RSB + (16 * kt + 4 * p) * 2, 4 * RSB);
#pragma unroll
          for (int vt = 0; vt < 8; ++vt) { f32x4 acc = (f32x4){0.f, 0.f, 0.f, 0.f};
#pragma unroll
              for (int ks = 0; ks < 2; ++ks) acc = mfma32(ka[ks], lds_tr8(lds + VS + (32 * ks + 8 * G + q) * RSB + (16 * vt + 4 * p) * 2, 4 * RSB), acc);
              u32x2 w; w.x = cvt_pk_bf16(acc[0], acc[1]); w.y = cvt_pk_bf16(acc[2], acc[3]);
              *(u32x2*)(GG + ((size_t)item * 128 + 16 * vt + I) * 128 + 16 * kt + 4 * G) = w; } }
    }
#undef HG1_LOAD
}

__device__ __forceinline__ void phase_hg2(const Args& a) {
    const bf16_t* GG = (const bf16_t*)(a.ws + WS_HG); const float* DG = (const float*)(a.ws + WS_HD); bf16_t* SG = (bf16_t*)(a.ws + WS_HS);
    for (int gid = BID * NTHREADS + TIDX; gid < 32 * 4096; gid += NBLK * NTHREADS) { const int bh = gid >> 12, e = gid & 4095, v = e >> 5, k4 = (e & 31) * 4;
        f32x4 S = (f32x4){0.f, 0.f, 0.f, 0.f};
        const size_t o0 = (((size_t)bh * 64) * 128 + v) * 128 + k4; const float* dg = DG + (size_t)bh * 64 * 128 + k4;
        f32x4 da[8]; u32x2 ga[8];
#pragma unroll
        for (int j = 0; j < 8; ++j) { da[j] = *(const f32x4*)(dg + j * 128); ga[j] = *(const u32x2*)(GG + o0 + (size_t)j * 16384); }
#pragma unroll 1
        for (int n0 = 0; n0 < 64; n0 += 8) { f32x4 db[8]; u32x2 gb[8];
#pragma unroll
            for (int j = 0; j < 8; ++j) { db[j] = da[j]; gb[j] = ga[j]; }
            if (n0 + 8 < 64) {
#pragma unroll
                for (int j = 0; j < 8; ++j) { db[j] = *(const f32x4*)(dg + (n0 + 8 + j) * 128); gb[j] = *(const u32x2*)(GG + o0 + (size_t)(n0 + 8 + j) * 16384); } }
#pragma unroll
            for (int j = 0; j < 8; ++j) { u32x2 w; w.x = cvt_pk_bf16(S[0], S[1]); w.y = cvt_pk_bf16(S[2], S[3]); *(u32x2*)(SG + o0 + (size_t)(n0 + j) * 16384) = w;
                const f32x4 d = da[j]; const u32x2 g = ga[j];
                S[0] = d[0] * S[0] + bf_lo(g.x); S[1] = d[1] * S[1] + bf_hi(g.x); S[2] = d[2] * S[2] + bf_lo(g.y); S[3] = d[3] * S[3] + bf_hi(g.y); }
#pragma unroll
            for (int j = 0; j < 8; ++j) { da[j] = db[j]; ga[j] = gb[j]; } } }
}

__device__ __forceinline__ void phase_hg3(const Args& a, LAS unsigned char* lds) {
    const bf16_t* p0 = (const bf16_t*)(a.ws + WS_PROJ); const bf16_t* QG = (const bf16_t*)(a.ws + WS_HQ); const bf16_t* AG = (const bf16_t*)(a.ws + WS_HA); const bf16_t* SG = (const bf16_t*)(a.ws + WS_HS);
    bf16_t* Y = (bf16_t*)(a.ws + WS_Y); const float* gain = a.in[13];
    constexpr int ST = 0, QT = 128 * RSB, VS = QT + 64 * RSB, PART = VS + 64 * RSB;
    const int tid = TIDX, wid = tid >> 6, lane = tid & 63, I = lane & 15, G = lane >> 4, q = I >> 2, p = I & 3;
    LAS float* part = (LAS float*)(lds + PART);
    const int tt = wid & 3, vh = wid >> 2;
    u32x4 ps[4], pq2[2], pv2[2]; bf16x8 paf[2];
#define HG3_LOAD(it_) do { const int bh_ = (it_) >> 6, ck_ = (it_) & 63; const size_t t0_ = (size_t)(bh_ >> 3) * S_ + ck_ * 64; const int h_ = bh_ & 7; \
        _Pragma("unroll") for (int i = 0; i < 4; ++i) { const int c = tid + i * 512, v = c >> 4, k8 = (c & 15) * 8; ps[i] = *(const u32x4*)(SG + ((size_t)(it_) * 128 + v) * 128 + k8); } \
        _Pragma("unroll") for (int i = 0; i < 2; ++i) { const int c = tid + i * 512, s_ = c >> 4, c8 = (c & 15) * 8; pq2[i] = *(const u32x4*)(QG + ((size_t)(it_) * 64 + s_) * 128 + c8); pv2[i] = *(const u32x4*)(p0 + (t0_ + s_) * N_IN0 + 4096 + h_ * 128 + c8); } \
        _Pragma("unroll") for (int sp = 0; sp < 2; ++sp) paf[sp] = *(const bf16x8*)(AG + (((size_t)(it_) * 4 + tt) * 2 + sp) * 512 + lane * 8); } while (0)
    if (BID < 2048) HG3_LOAD(BID);
    for (int item = BID; item < 2048; item += NBLK) { const int bh = item >> 6, ck = item & 63, b = bh >> 3, h = bh & 7; const size_t t0 = (size_t)b * S_ + ck * 64;
        LDS_BARRIER();
#pragma unroll
        for (int i = 0; i < 4; ++i) { const int c = tid + i * 512, v = c >> 4, k8 = (c & 15) * 8; *(LAS u32x4*)(lds + ST + v * RSB + k8 * 2) = ps[i]; }
#pragma unroll
        for (int i = 0; i < 2; ++i) { const int c = tid + i * 512, s2 = c >> 4, c8 = (c & 15) * 8; *(LAS u32x4*)(lds + QT + s2 * RSB + c8 * 2) = pq2[i]; *(LAS u32x4*)(lds + VS + s2 * RSB + c8 * 2) = pv2[i]; }
        bf16x8 af[2]; af[0] = paf[0]; af[1] = paf[1];
        if (item + NBLK < 2048) HG3_LOAD(item + NBLK);
        u32x2 zwp[4];
#pragma unroll
        for (int vi = 0; vi < 4; ++vi) zwp[vi] = *(const u32x2*)(p0 + (t0 + 16 * tt + I) * N_IN0 + 5120 + h * 128 + 16 * (4 * vh + vi) + 4 * G);
        LDS_BARRIER();
        bf16x8 qf[4];
#pragma unroll
        for (int ks = 0; ks < 4; ++ks) qf[ks] = lds_frag(lds + QT + (16 * tt + I) * RSB + (32 * ks + 8 * G) * 2);
        f32x4 acc[4]; float ss = 0.f;
#pragma unroll
        for (int vi = 0; vi < 4; ++vi) { const int vt = 4 * vh + vi; acc[vi] = (f32x4){0.f, 0.f, 0.f, 0.f};
#pragma unroll
            for (int ks = 0; ks < 4; ++ks) acc[vi] = mfma32(lds_frag(lds + ST + (16 * vt + I) * RSB + (32 * ks + 8 * G) * 2), qf[ks], acc[vi]);
#pragma unroll
            for (int sp = 0; sp < 2; ++sp) acc[vi] = mfma32(lds_tr8(lds + VS + (32 * sp + 4 * G + q) * RSB + (16 * vt + 4 * p) * 2, 16 * RSB), af[sp], acc[vi]);
            ss += acc[vi][0] * acc[vi][0] + acc[vi][1] * acc[vi][1] + acc[vi][2] * acc[vi][2] + acc[vi][3] * acc[vi][3]; }
        ss += __shfl_xor(ss, 16); ss += __shfl_xor(ss, 32);
        if (G == 0) part[wid * 16 + I] = ss;
        LDS_BARRIER();
        const float rstd = rsqrtf((part[wid * 16 + I] + part[(wid ^ 4) * 16 + I]) * (1.0f / 128.0f) + 1e-6f);
        const size_t t = t0 + 16 * tt + I;
#pragma unroll
        for (int vi = 0; vi < 4; ++vi) { const int c = h * 128 + 16 * (4 * vh + vi) + 4 * G;
            const f32x4 gn = *(const f32x4*)(gain + c); const u32x2 zw = zwp[vi];
            const float o0 = acc[vi][0] * rstd * gn[0] * siluf_(bf_lo(zw.x)), o1 = acc[vi][1] * rstd * gn[1] * siluf_(bf_hi(zw.x)), o2 = acc[vi][2] * rstd * gn[2] * siluf_(bf_lo(zw.y)), o3 = acc[vi][3] * rstd * gn[3] * siluf_(bf_hi(zw.y));
            u32x2 w; w.x = cvt_pk_bf16(o0, o1); w.y = cvt_pk_bf16(o2, o3); *(u32x2*)(Y + t * D_ + 1024 + c) = w; }
    }
#undef HG3_LOAD
}

__device__ __forceinline__ void phase_gdn_norm(const Args& a) {
    const bf16_t* O = (const bf16_t*)(a.ws + WS_O); const bf16_t* pj = (const bf16_t*)(a.ws + WS_PROJ); unsigned char* Y = a.ws + WS_Y; const float* gain = a.in[19];
    const int lane = TIDX & 63, wid = TIDX >> 6, gc = (lane & 15) * 8;
    const f32x4 g0 = *(const f32x4*)(gain + gc), g1 = *(const f32x4*)(gain + gc + 4);
    u32x4 oa[8], za[8];
    int row = BID * 8 + wid; const int stride = NBLK * 8;
#define GN_LD(ov, zv, r) { _Pragma("unroll") for (int i = 0; i < 8; ++i) { const int c = (i * 64 + lane) * 8; ov[i] = *(const u32x4*)(O + (size_t)(r) * 4096 + c); zv[i] = *(const u32x4*)(pj + (size_t)(r) * N_IN1P + 8192 + c); } }
    if (row < T_) GN_LD(oa, za, row)
    for (; row < T_; row += stride) { u32x4 ob[8], zb[8];
#pragma unroll
        for (int i = 0; i < 8; ++i) { ob[i] = oa[i]; zb[i] = za[i]; }
        if (row + stride < T_) GN_LD(ob, zb, row + stride)
#pragma unroll
        for (int i = 0; i < 8; ++i) { const int c = (i * 64 + lane) * 8;
            const u32x4 ow = oa[i], zw = za[i];
            const float o[8] = {bf_lo(ow.x), bf_hi(ow.x), bf_lo(ow.y), bf_hi(ow.y), bf_lo(ow.z), bf_hi(ow.z), bf_lo(ow.w), bf_hi(ow.w)};
            const float z[8] = {bf_lo(zw.x), bf_hi(zw.x), bf_lo(zw.y), bf_hi(zw.y), bf_lo(zw.z), bf_hi(zw.z), bf_lo(zw.w), bf_hi(zw.w)};
            float ss = 0.f;
#pragma unroll
            for (int q = 0; q < 8; ++q) ss += o[q] * o[q];
            ss = row16_sum(ss);
            const float rstd = rsqrtf(ss * (1.0f / 128.0f) + 1e-6f);
            float y[8];
#pragma unroll
            for (int q = 0; q < 8; ++q) y[q] = o[q] * rstd * (q < 4 ? g0[q & 3] : g1[q & 3]) * siluf_(z[q]);
            u32x2 w; w.x = pk_fp8x4(y[0], y[1], y[2], y[3]); w.y = pk_fp8x4(y[4], y[5], y[6], y[7]);
            *(u32x2*)(Y + (size_t)row * 4096 + c) = w; }
#pragma unroll
        for (int i = 0; i < 8; ++i) { oa[i] = ob[i]; za[i] = zb[i]; }
    }
#undef GN_LD
}

template <bool FP8>
__device__ __forceinline__ void phase_gemm_out(const Args& a, LAS unsigned char* lds, int K, const void* w, const float* xin) {
    const int eb = FP8 ? 1 : 2;
    SrcGrid S{(const char*)(a.ws + WS_Y), (const char*)w, (size_t)BM * K * eb, (size_t)BM * K * eb, 64, 64 * 8, K * eb / 2, K * eb / 2};
    EpiResid E{a.ws, xin, FP8 ? 1.0f / W8_SCALE : 1.0f};
    gemm_stream<false, FP8>(lds, S, K * eb / 128, E);
}

struct SrcRouter {
    const char* h; const char* w;
    __device__ __forceinline__ bool next(int i, UnitD& u) const { const int id = BID + i * NBLK; if (id >= 256) return false; u.t0 = id & 63; u.t1 = id >> 6; u.t2 = 0;
        u.gA = h + ((size_t)u.t0 * BM * D_ + u.t1 * 512) * 2; u.gB = w + (size_t)u.t1 * 512 * 2; return true; }
    __device__ __forceinline__ void va(const UnitD&, unsigned (&v)[2][2]) const { offs_direct(v, D_, false); }
    __device__ __forceinline__ void vb(unsigned (&v)[2][2]) const { offs_direct(v, D_, true); }
};
struct EpiLogitsQ {
    float* O;
    __device__ __forceinline__ void operator()(const Acc& acc, const UnitD& u, int wr, int wc, int fr, int fq) const { store_f32_tile(acc, O + ((size_t)u.t1 * T_ + (size_t)u.t0 * BM) * 128, nullptr, 128, 128, wr, wc, fr, fq); }
};
__device__ __forceinline__ void phase_gemm_router(const Args& a, LAS unsigned char* lds, int layer) {
    SrcRouter S{(const char*)(a.ws + WS_X), (const char*)(a.ws + WS_WRT) + (size_t)layer * 256 * D_ * 2};
    EpiLogitsQ E{(float*)(a.ws + WS_O)};
    gemm_stream<false, false>(lds, S, 512 / BK, E);
}

__device__ __forceinline__ void phase_route(const Args& a, int layer) {
    const float* lg = (const float*)(a.ws + WS_O); const float* bg = a.in[22] + layer * 8; const float* be = a.in[24] + layer * 64;
    int* cnt = (int*)(a.ws + WS_CTL + CTL_CNT) + layer * 64;
    int* eid = (int*)(a.ws + WS_EID); int* slot = (int*)(a.ws + WS_SLOT); float* gate = (float*)(a.ws + WS_GATE); int* rowmap = (int*)(a.ws + WS_ROWMAP);
    const float* rsp = (const float*)(a.ws + WS_RSP);
    {
        const bf16_t* xw = (const bf16_t*)(a.ws + WS_X); const float* gain = a.in[2] + (size_t)layer * D_; const int wid = TIDX >> 6, lane = TIDX & 63, stride = NBLK * 16;
        u32x2 rb[2][8]; float ps[2];
#define RT_LD(r) { _Pragma("unroll") for (int u = 0; u < 2; ++u) { _Pragma("unroll") for (int i = 0; i < 8; ++i) rb[u][i] = *(const u32x2*)(xw + (size_t)((r) + u) * D_ + (i * 64 + lane) * 4); ps[u] = rsp[(size_t)((r) + u) * 32 + (lane & 31)]; } }
        int row = (BID * 8 + wid) * 2;
        if (row < T_) RT_LD(row)
        for (; row < T_; row += stride) { u32x2 rc[2][8]; float pc[2];
#pragma unroll
            for (int u = 0; u < 2; ++u) { pc[u] = ps[u];
#pragma unroll
                for (int i = 0; i < 8; ++i) rc[u][i] = rb[u][i]; }
            if (row + stride < T_) RT_LD(row + stride)
#pragma unroll
            for (int u = 0; u < 2; ++u) { const float rstd = rsqrtf(wave_sum(pc[u]) * (0.5f / D_) + 1e-6f);
#pragma unroll
                for (int i = 0; i < 8; ++i) { const int c = (i * 64 + lane) * 4; const f32x4 gn = *(const f32x4*)(gain + c);
                    *(unsigned*)(a.ws + WS_H8 + (size_t)(row + u) * D_ + c) = pk_fp8x4(bf_lo(rc[u][i].x) * rstd * gn[0], bf_hi(rc[u][i].x) * rstd * gn[1], bf_lo(rc[u][i].y) * rstd * gn[2], bf_hi(rc[u][i].y) * rstd * gn[3]); } } }
#undef RT_LD
    }
    const int gtid = BID * NTHREADS + TIDX, gsz = NBLK * NTHREADS;
    for (int i = gtid; i < MPAD; i += gsz) rowmap[i] = 0;
    for (int t = gtid; t < T_; t += gsz) {
        f32x4 ga = (f32x4){0.f, 0.f, 0.f, 0.f}, gb = ga, sq = ga;
#pragma unroll
        for (int kq = 0; kq < 4; ++kq) { ga += *(const f32x4*)(lg + ((size_t)kq * T_ + t) * 128); gb += *(const f32x4*)(lg + ((size_t)kq * T_ + t) * 128 + 4); }
#pragma unroll
        for (int i = 0; i < 8; ++i) sq += *(const f32x4*)(rsp + (size_t)t * 32 + i * 4);
        const float rstd = rsqrtf((sq[0] + sq[1] + sq[2] + sq[3]) * (1.0f / D_) + 1e-6f);
        ga *= rstd; gb *= rstd;
        const float gl[8] = {ga[0] + bg[0], ga[1] + bg[1], ga[2] + bg[2], ga[3] + bg[3], gb[0] + bg[4], gb[1] + bg[5], gb[2] + bg[6], gb[3] + bg[7]};
        float mx = -3.0e38f; int gi = 0;
#pragma unroll
        for (int j = 0; j < 8; ++j) if (gl[j] > mx) { mx = gl[j]; gi = j; }
        float se = 0.f;
#pragma unroll
        for (int j = 0; j < 8; ++j) se += __expf(gl[j] - mx);
        const float gp = 1.0f / se;
        f32x4 ea = (f32x4){0.f, 0.f, 0.f, 0.f}, eb = ea;
#pragma unroll
        for (int kq = 0; kq < 4; ++kq) { ea += *(const f32x4*)(lg + ((size_t)kq * T_ + t) * 128 + 8 + gi * 8); eb += *(const f32x4*)(lg + ((size_t)kq * T_ + t) * 128 + 12 + gi * 8); }
        ea = ea * rstd + *(const f32x4*)(be + gi * 8); eb = eb * rstd + *(const f32x4*)(be + gi * 8 + 4);
        const float el[8] = {ea[0], ea[1], ea[2], ea[3], eb[0], eb[1], eb[2], eb[3]};
        float l1 = -3.0e38f, l2 = -3.0e38f; int i1 = 0, i2 = 0;
#pragma unroll
        for (int j = 0; j < 8; ++j) { const float v = el[j];
            if (v > l1) { l2 = l1; i2 = i1; l1 = v; i1 = j; } else if (v > l2) { l2 = v; i2 = j; } }
        const float e2 = __expf(l2 - l1), inv = 1.0f / (1.0f + e2);
        const int e0 = gi * 8 + i1, e1 = gi * 8 + i2;
        eid[t * 2] = e0; eid[t * 2 + 1] = e1; gate[t * 2] = inv * gp; gate[t * 2 + 1] = e2 * inv * gp;
        slot[t * 2] = atomicAdd(&cnt[e0], 1); slot[t * 2 + 1] = atomicAdd(&cnt[e1], 1); }
}

__device__ __forceinline__ void phase_rowmap(const Args& a, LAS unsigned char* lds, int layer) {
    const int* cnt = (const int*)(a.ws + WS_CTL + CTL_CNT) + layer * 64; LAS int* ps = (LAS int*)lds;
    int* tinfo = (int*)(a.ws + WS_TINFO) + layer * 512;
    const int* eid = (const int*)(a.ws + WS_EID); const int* slot = (const int*)(a.ws + WS_SLOT); int* posof = (int*)(a.ws + WS_POSOF); int* rowmap = (int*)(a.ws + WS_ROWMAP);
    __syncthreads();
    if (TIDX == 0) { int acc = 0; for (int e = 0; e < 64; ++e) { ps[e] = acc; acc += (cnt[e] + 255) & ~255; } ps[64] = acc; }
    __syncthreads();
    if (BID == 0) { if (TIDX <= 64) tinfo[TIDX] = ps[TIDX]; if (TIDX == 65) tinfo[65] = ps[64] >> 8;
        if (TIDX < 192) { const int p = TIDX * 256; int e = 0; for (int j = 0; j < 64; ++j) if (ps[j + 1] <= p) e = j + 1; tinfo[128 + TIDX] = e < 64 ? e : 63; } }
    for (int i = BID * NTHREADS + TIDX; i < T_ * 2; i += NBLK * NTHREADS) { const int p = ps[eid[i]] + slot[i]; posof[i] = p; rowmap[p] = i >> 1; }
    __syncthreads();
}

struct SrcMoeUp {
    const char* h; const char* wg; const int* tinfo; const int* rowmap; int total;
    __device__ __forceinline__ bool next(int i, UnitD& u) const { const int id = BID + i * NBLK; if (id >= total) return false; u.t0 = id >> 2; u.t1 = id & 3;
        u.t2 = __builtin_amdgcn_readfirstlane(tinfo[128 + u.t0]); u.gA = h; u.gB = wg + ((size_t)u.t2 * DEXP + u.t1 * 128) * D_; return true; }
    __device__ __forceinline__ void va(const UnitD& u, unsigned (&v)[2][2]) const { int R0, C0; stage_pos(TIDX, R0, C0);
#pragma unroll
        for (int hh = 0; hh < 2; ++hh)
#pragma unroll
            for (int i = 0; i < 2; ++i) v[hh][i] = (unsigned)(rowmap[u.t0 * 256 + hh * 128 + R0 + 64 * i] * D_ + C0 * 2); }
    __device__ __forceinline__ void vb(unsigned (&v)[2][2]) const { int R0, C0; stage_pos(TIDX, R0, C0);
#pragma unroll
        for (int i = 0; i < 2; ++i) { const int Rr = perm_row(R0 + 64 * i); v[0][i] = (unsigned)(Rr * D_ + C0 * 2); v[1][i] = (unsigned)(WS_WU - WS_WG) + (unsigned)(Rr * D_ + C0 * 2); } }
};
__device__ __forceinline__ void phase_moe_up(const Args& a, LAS unsigned char* lds, int layer) {
    const int* tinfo = (const int*)(a.ws + WS_TINFO) + layer * 512;
    const int ntm = __builtin_amdgcn_readfirstlane(tinfo[65]);
    SrcMoeUp S{(const char*)(a.ws + WS_H8), (const char*)(a.ws + WS_WG), tinfo, (const int*)(a.ws + WS_ROWMAP), ntm * 4};
    EpiSwiGLU E{a.ws + WS_ACT};
    gemm_stream<true, true>(lds, S, D_ / 128, E);
}

struct SrcMoeDown {
    const char* act; const char* wd; const int* tinfo; int total;
    __device__ __forceinline__ bool next(int i, UnitD& u) const { const int id = BID + i * NBLK; if (id >= total) return false; u.t0 = id >> 3; u.t1 = id & 7;
        u.t2 = __builtin_amdgcn_readfirstlane(tinfo[128 + u.t0]); u.gA = act + (size_t)u.t0 * BM * DEXP; u.gB = wd + ((size_t)u.t2 * D_ + u.t1 * BM) * DEXP; return true; }
    __device__ __forceinline__ void va(const UnitD&, unsigned (&v)[2][2]) const { offs_direct(v, DEXP / 2, false); }
    __device__ __forceinline__ void vb(unsigned (&v)[2][2]) const { offs_direct(v, DEXP / 2, true); }
};
__device__ __forceinline__ void phase_moe_down(const Args& a, LAS unsigned char* lds, int layer) {
    const int* tinfo = (const int*)(a.ws + WS_TINFO) + layer * 512; const int ntm = __builtin_amdgcn_readfirstlane(tinfo[65]);
    SrcMoeDown S{(const char*)(a.ws + WS_ACT), (const char*)(a.ws + WS_WD), tinfo, ntm * 8};
    EpiDown E{a.ws + WS_YMOE};
    gemm_stream<false, true>(lds, S, DEXP / 128, E);
}

struct SrcIn1Tail {
    const char* h; const char* w;
    __device__ __forceinline__ bool next(int i, UnitD& u) const { const int id = BID + i * NBLK; if (id >= 256) return false; u.t0 = id & 63; u.t1 = id >> 6; u.t2 = 0;
        u.gA = h + (size_t)u.t0 * BM * D_ + u.t1 * 512; u.gB = w + (size_t)48 * BM * D_ + u.t1 * 512; return true; }
    __device__ __forceinline__ void va(const UnitD&, unsigned (&v)[2][2]) const { offs_direct(v, D_ / 2, false); }
    __device__ __forceinline__ void vb(unsigned (&v)[2][2]) const { offs_direct(v, D_ / 2, true); }
};
struct EpiTailQ {
    float* O;
    __device__ __forceinline__ void operator()(const Acc& acc, const UnitD& u, int wr, int wc, int fr, int fq) const { store_f32_tile(acc, O + ((size_t)u.t1 * T_ + (size_t)u.t0 * BM) * 64, nullptr, 64, 64, wr, wc, fr, fq, 1.0f / W8_SCALE); }
};
__device__ __forceinline__ void phase_gemm_in1(const Args& a, LAS unsigned char* lds) {
    SrcGridSplit S{(const char*)(a.ws + WS_H8), (const char*)(a.ws + WS_WIN1T), (size_t)BM * D_, (size_t)BM * D_, 64, 64 * 48, D_ / 2, D_ / 2, 16, 8};
    EpiProj E{(bf16_t*)(a.ws + WS_PROJ), N_IN1P, nullptr, 64, 48, 48, 64, 1.0f / W8_SCALE};
    gemm_stream<false, true>(lds, S, D_ / 128, E);
}
__device__ __forceinline__ void phase_gemm_in1_tail(const Args& a, LAS unsigned char* lds) {
    SrcIn1Tail S{(const char*)(a.ws + WS_H8), (const char*)(a.ws + WS_WIN1T)};
    EpiTailQ E{(float*)(a.ws + WS_O)};
    int nt = 4; asm volatile("" : "+s"(nt));
    gemm_stream<false, true>(lds, S, nt, E);
}

__device__ __forceinline__ void phase_gdn_conv(const Args& a) {
    const bf16_t* p1 = (const bf16_t*)(a.ws + WS_PROJ); bf16_t* qc = (bf16_t*)(a.ws + WS_QKVC); const float* cw = a.in[16];
    const int gtid = BID * NTHREADS + TIDX, gsz = NBLK * NTHREADS;
    for (int it = gtid; it < 1024 * (T_ / 128); it += gsz) { const int c = (it & 1023) * 8, seg = it >> 10; const size_t t0 = (size_t)seg * 128;
        float w[4][8];
#pragma unroll
        for (int k = 0; k < 4; ++k) { const f32x4 w0 = *(const f32x4*)(cw + k * 8192 + c), w1 = *(const f32x4*)(cw + k * 8192 + c + 4);
            w[k][0] = w0[0]; w[k][1] = w0[1]; w[k][2] = w0[2]; w[k][3] = w0[3]; w[k][4] = w1[0]; w[k][5] = w1[1]; w[k][6] = w1[2]; w[k][7] = w1[3]; }
        u32x4 x0 = (u32x4){0u, 0u, 0u, 0u}, x1 = x0, x2 = x0;
        if ((t0 & (S_ - 1)) != 0) { x0 = *(const u32x4*)(p1 + (t0 - 3) * N_IN1P + c); x1 = *(const u32x4*)(p1 + (t0 - 2) * N_IN1P + c); x2 = *(const u32x4*)(p1 + (t0 - 1) * N_IN1P + c); }
        const float qsc = c < 2048 ? 0.08838834764831845f : 1.0f;
        u32x4 xa[8];
#pragma unroll
        for (int j = 0; j < 8; ++j) xa[j] = *(const u32x4*)(p1 + (t0 + j) * N_IN1P + c);
#pragma unroll 1
        for (int r0 = 0; r0 < 128; r0 += 8) { u32x4 xb[8];
#pragma unroll
            for (int j = 0; j < 8; ++j) xb[j] = xa[j];
            if (r0 + 8 < 128) {
#pragma unroll
                for (int j = 0; j < 8; ++j) xb[j] = *(const u32x4*)(p1 + (t0 + r0 + 8 + j) * N_IN1P + c); }
#pragma unroll
          for (int j8 = 0; j8 < 8; ++j8) { const u32x4 x3 = xa[j8]; const int r = r0 + j8;
            float acc[8];
#define TAPS(j, f, m) (w[0][j] * f(x0.m) + w[1][j] * f(x1.m) + w[2][j] * f(x2.m) + w[3][j] * f(x3.m))
            acc[0] = TAPS(0, bf_lo, x); acc[1] = TAPS(1, bf_hi, x); acc[2] = TAPS(2, bf_lo, y); acc[3] = TAPS(3, bf_hi, y);
            acc[4] = TAPS(4, bf_lo, z); acc[5] = TAPS(5, bf_hi, z); acc[6] = TAPS(6, bf_lo, w); acc[7] = TAPS(7, bf_hi, w);
#undef TAPS
            float ss = 0.f;
#pragma unroll
            for (int j = 0; j < 8; ++j) { acc[j] = siluf_(acc[j]); ss += acc[j] * acc[j]; }
            ss = row16_sum(ss);
            const float sc = c < 4096 ? rsqrtf(ss + 1e-6f) * qsc : 1.0f;
            u32x4 o; o.x = cvt_pk_bf16(acc[0] * sc, acc[1] * sc); o.y = cvt_pk_bf16(acc[2] * sc, acc[3] * sc); o.z = cvt_pk_bf16(acc[4] * sc, acc[5] * sc); o.w = cvt_pk_bf16(acc[6] * sc, acc[7] * sc);
            *(u32x4*)(qc + (t0 + r) * 8192 + c) = o;
            x0 = x1; x1 = x2; x2 = x3; }
#pragma unroll
            for (int j = 0; j < 8; ++j) xa[j] = xb[j]; } }
    const float* tail = (const float*)(a.ws + WS_O); float* bgo = (float*)(a.ws + WS_BG);
    for (int it = gtid; it < T_ * 32; it += gsz) { const int t = it >> 5, hv = it & 31; float tb = 0.f, ta = 0.f;
#pragma unroll
        for (int kq = 0; kq < 4; ++kq) { tb += tail[((size_t)kq * T_ + t) * 64 + hv]; ta += tail[((size_t)kq * T_ + t) * 64 + 32 + hv]; }
        bgo[t * 64 + hv] = sigmoidf_(tb);
        bgo[t * 64 + 32 + hv] = -__expf(a.in[17][hv]) * softplusf_(ta + a.in[18][hv]); }
}

struct MoeTile { const float* src; unsigned char* dst; int lds_, ldd; };
__device__ __forceinline__ MoeTile moe_tile(const Args& a, int g) {
    const int job = g >> 14, r = g & 16383, e = r >> 8, rr = r & 255; MoeTile t;
    typedef __attribute__((address_space(1))) const float* gcf; gcf s25 = (gcf)a.in[25], s26 = (gcf)a.in[26]; asm volatile("" : "+s"(s25), "+s"(s26));
    if (job < 2) { const int ik = rr >> 3, in = rr & 7; t.lds_ = DEXP; t.ldd = D_;
        t.src = (const float*)(job ? s26 : s25) + ((size_t)(NEXP + e) * D_ + ik * 64) * DEXP + in * 64; t.dst = a.ws + (job ? WS_WU : WS_WG) + ((size_t)e * DEXP + in * 64) * D_ + ik * 64; }
    else { const int ik = rr >> 5, in = rr & 31; t.lds_ = D_; t.ldd = DEXP;
        t.src = a.in[27] + ((size_t)(NEXP + e) * DEXP + ik * 64) * D_ + in * 64; t.dst = a.ws + WS_WD + ((size_t)e * D_ + in * 64) * DEXP + ik * 64; }
    return t;
}
__device__ __forceinline__ void moe_tile_load(const MoeTile& t, int tid, f32x4 (&v)[2]) {
#pragma unroll
    for (int i = 0; i < 2; ++i) { const int idx = tid + i * 512, rr = idx >> 4, c4 = (idx & 15) * 4; v[i] = *(const f32x4*)(t.src + (size_t)rr * t.lds_ + c4); }
}
__device__ __forceinline__ void moe_tile_store(const MoeTile& t, int tid, const f32x4 (&v)[2], LAS float* tile) {
#pragma unroll
    for (int i = 0; i < 2; ++i) { const int idx = tid + i * 512, rr = idx >> 4, c4 = (idx & 15) * 4;
        tile[rr * 65 + c4 + 0] = v[i][0]; tile[rr * 65 + c4 + 1] = v[i][1]; tile[rr * 65 + c4 + 2] = v[i][2]; tile[rr * 65 + c4 + 3] = v[i][3]; }
    LDS_BARRIER();
    { const int n = tid >> 3, kg = (tid & 7) * 8; float f[8];
#pragma unroll
      for (int jj = 0; jj < 8; ++jj) f[jj] = tile[(kg + jj) * 65 + n] * W8_SCALE;
      u32x2 w; w.x = pk_fp8x4(f[0], f[1], f[2], f[3]); w.y = pk_fp8x4(f[4], f[5], f[6], f[7]);
      *(u32x2*)(t.dst + (size_t)n * t.ldd + kg) = w; }
    LDS_BARRIER();
}
constexpr int MOE_TILES = 3 * NEXP * 256;

__device__ __forceinline__ f32x4 mfma16(s16x4 a, s16x4 b, f32x4 c) { return __builtin_amdgcn_mfma_f32_16x16x16bf16_1k(a, b, c, 0, 0, 0); }
__device__ __forceinline__ s16x4 pack4(const f32x4& v) { u32x2 w; w.x = cvt_pk_bf16(v[0], v[1]); w.y = cvt_pk_bf16(v[2], v[3]); return __builtin_bit_cast(s16x4, w); }
__device__ __forceinline__ void phase_gdn_chunk(const Args& a, LAS unsigned char* lds) {
    const bf16_t* qc = (const bf16_t*)(a.ws + WS_QKVC); const float* bgi = (const float*)(a.ws + WS_BG); bf16_t* O = (bf16_t*)(a.ws + WS_O);
    constexpr int VRS = 144, KTRS = 136;
    constexpr int KT = 0, QS = KT + 128 * KTRS, WSL = QS + 64 * RSB, QKS = WSL + 64 * RSB, EE = QKS + 2048, EDD = EE + 256, SET = EDD + 256;
    constexpr int STL = 2 * SET, KS = STL + 64 * RSB, VS = KS + 64 * RSB, X2 = VS + 64 * VRS, LS = X2 + 2048, X1 = LS + 4096, GAM = X1 + 2048, BET = GAM + 256, LEND = BET + 256;
    static_assert(LEND <= LDS_XBW, "gdn lds");
    const int wid = __builtin_amdgcn_readfirstlane(TIDX >> 6);
    const int NCK = S_ / 64;
    for (int blk = BID; blk < NB_ * 32 * 2; blk += NBLK) {
        const int grp = (blk & 7) * 8 + (blk >> 5), mem = (blk >> 3) & 3, b = grp >> 4, hk = grp & 15, hv = 2 * hk + (mem >> 1), vhalf = mem & 1;
        __syncthreads();
        if (wid < 4) {
            const int vt = wid;
            f32x4 Sacc[8];
#pragma unroll
            for (int n = 0; n < 8; ++n) Sacc[n] = (f32x4){0.f, 0.f, 0.f, 0.f};
            { const int lane = TIDX & 63;
              for (int i = lane; i < 16 * RSB / 16; i += 64) *(LAS u32x4*)(lds + STL + 16 * vt * RSB + i * 16) = (u32x4){0u, 0u, 0u, 0u}; }
            int lz = TIDX & 63; asm volatile("" : "+v"(lz));
            const int lane = lz, I = lane & 15, G = lane >> 4, q4 = I >> 2, p4 = I & 3;
            for (int it = 0; it <= NCK; ++it) {
                const int set = ((it - 1) & 1) * SET; const size_t t0 = (size_t)b * S_ + (size_t)(it - 1) * 64;
                f32x4 U[4];
                if (it >= 1) {
#pragma unroll
                    for (int sa = 0; sa < 4; ++sa) U[sa] = mfma16(*(const LAS s16x4*)(lds + X2 + ((sa * 16 + I) * 16 + 4 * G) * 2), lds_tr4(lds + VS + (16 * sa + 4 * G + q4) * VRS + (16 * vt + 4 * p4) * 2), (f32x4){0.f, 0.f, 0.f, 0.f});
                    asm volatile("" : "+v"(U[0]), "+v"(U[1]), "+v"(U[2]), "+v"(U[3]) :: "memory");
                }
                LDS_BARRIER();
#pragma unroll
                for (int sa = 0; sa < 4; ++sa) {
                    if (it >= 1) {
                        bf16x8 sf[4];
#pragma unroll
                        for (int ks = 0; ks < 4; ++ks) sf[ks] = lds_frag(lds + STL + (16 * vt + I) * RSB + (32 * ks + 8 * G) * 2);
                        s16x4 kt[8];
#pragma unroll
                        for (int dt = 0; dt < 8; ++dt) kt[dt] = *(const LAS s16x4*)(lds + set + KT + (16 * dt + I) * KTRS + (16 * sa + 4 * G) * 2);
                        f32x4 dl = U[sa], oq = (f32x4){0.f, 0.f, 0.f, 0.f}, dl2 = oq, oq2 = oq;
#pragma unroll
                        for (int ks = 0; ks < 2; ++ks) { dl = mfma32(lds_frag(lds + set + WSL + (16 * sa + I) * RSB + (32 * ks + 8 * G) * 2), sf[ks], dl);
                            dl2 = mfma32(lds_frag(lds + set + WSL + (16 * sa + I) * RSB + (32 * (ks + 2) + 8 * G) * 2), sf[ks + 2], dl2);
                            oq = mfma32(lds_frag(lds + set + QS + (16 * sa + I) * RSB + (32 * ks + 8 * G) * 2), sf[ks], oq);
                            oq2 = mfma32(lds_frag(lds + set + QS + (16 * sa + I) * RSB + (32 * (ks + 2) + 8 * G) * 2), sf[ks + 2], oq2); }
                        dl += dl2; oq += oq2;
                        const s16x4 dfrag = pack4(dl);
                        const f32x4 e4 = *(const LAS f32x4*)(lds + set + EE + (16 * sa + 4 * G) * 4);
                        oq = mfma16(*(const LAS s16x4*)(lds + set + QKS + ((sa * 16 + I) * 16 + 4 * G) * 2), dfrag, oq * e4);
#pragma unroll
                        for (int r = 0; r < 4; ++r) O[(t0 + 16 * sa + 4 * G + r) * 4096 + hv * 128 + vhalf * 64 + 16 * vt + I] = f2bf(oq[r]);
                        const f32x4 ed4 = *(const LAS f32x4*)(lds + set + EDD + (16 * sa + 4 * G) * 4); const float e15 = *(const LAS float*)(lds + set + EE + (16 * sa + 15) * 4);
                        const s16x4 dsc = pack4(dl * ed4);
#pragma unroll
                        for (int dt = 0; dt < 8; ++dt) {
                            Sacc[dt] = mfma16(kt[dt], dsc, Sacc[dt] * e15);
                            *(LAS s16x4*)(lds + STL + (16 * vt + I) * RSB + (16 * dt + 4 * G) * 2) = pack4(Sacc[dt]); }
                    }
                    if (sa & 1) LDS_BARRIER();
                }
            }
        } else {
            const int pw = wid - 4;
            u32x4 pq[4], pk[4], pv[2]; float pb = 0.f, pg = 0.f;
            { const int ptid = TIDX - 256; const size_t t0 = (size_t)b * S_;
#pragma unroll
              for (int i = 0; i < 4; ++i) { const int c = ptid + i * 256, s2 = c >> 4, c8 = (c & 15) * 8; pq[i] = *(const u32x4*)(qc + (t0 + s2) * 8192 + hk * 128 + c8); pk[i] = *(const u32x4*)(qc + (t0 + s2) * 8192 + 2048 + hk * 128 + c8); }
#pragma unroll
              for (int i = 0; i < 2; ++i) { const int c = ptid + i * 256, s2 = c >> 3, c8 = (c & 7) * 8; pv[i] = *(const u32x4*)(qc + (t0 + s2) * 8192 + 4096 + hv * 128 + vhalf * 64 + c8); }
              if (pw == 1) { pb = bgi[(t0 + ptid - 64) * 64 + hv]; pg = bgi[(t0 + ptid - 64) * 64 + 32 + hv]; } }
            int lz = TIDX & 63; asm volatile("" : "+v"(lz));
            const int lane = lz, ptid = pw * 64 + lane, I = lane & 15, G = lane >> 4, q4 = I >> 2, p4 = I & 3;
            for (int it = 0; it <= NCK; ++it) {
                const int set = (it & 1) * SET; const bool act = it < NCK;
                if (act) {
#pragma unroll
                    for (int i = 0; i < 4; ++i) { const int c = ptid + i * 256, s2 = c >> 4, c8 = (c & 15) * 8; *(LAS u32x4*)(lds + set + QS + s2 * RSB + c8 * 2) = pq[i]; *(LAS u32x4*)(lds + KS + s2 * RSB + c8 * 2) = pk[i]; }
                    if (pw == 1) { float x = pg;
                        x += __builtin_bit_cast(float, __builtin_amdgcn_update_dpp(0, __builtin_bit_cast(int, x), 0x111, 0xf, 0xf, true));
                        x += __builtin_bit_cast(float, __builtin_amdgcn_update_dpp(0, __builtin_bit_cast(int, x), 0x112, 0xf, 0xf, true));
                        x += __builtin_bit_cast(float, __builtin_amdgcn_update_dpp(0, __builtin_bit_cast(int, x), 0x114, 0xf, 0xf, true));
                        x += __builtin_bit_cast(float, __builtin_amdgcn_update_dpp(0, __builtin_bit_cast(int, x), 0x118, 0xf, 0xf, true));
                        const float g15 = __shfl(x, 15, 16);
                        *(LAS float*)(lds + GAM + lane * 4) = x; *(LAS float*)(lds + set + EE + lane * 4) = __expf(x); *(LAS float*)(lds + set + EDD + lane * 4) = __expf(g15 - x); *(LAS float*)(lds + BET + lane * 4) = pb; }
                    if (it + 1 < NCK) { const size_t t1 = (size_t)b * S_ + (size_t)(it + 1) * 64;
#pragma unroll
                        for (int i = 0; i < 4; ++i) { const int c = ptid + i * 256, s2 = c >> 4, c8 = (c & 15) * 8; pq[i] = *(const u32x4*)(qc + (t1 + s2) * 8192 + hk * 128 + c8); pk[i] = *(const u32x4*)(qc + (t1 + s2) * 8192 + 2048 + hk * 128 + c8); }
                        if (pw == 1) { pb = bgi[(t1 + ptid - 64) * 64 + hv]; pg = bgi[(t1 + ptid - 64) * 64 + 32 + hv]; } }
                }
                LDS_BARRIER();
                if (act) { const int sa = pw;
#pragma unroll
                    for (int i = 0; i < 2; ++i) { const int c = ptid + i * 256, s2 = c >> 3, c8 = (c & 7) * 8; *(LAS u32x4*)(lds + VS + s2 * VRS + c8 * 2) = pv[i]; }
                    if (it + 1 < NCK) { const size_t t1 = (size_t)b * S_ + (size_t)(it + 1) * 64;
#pragma unroll
                        for (int i = 0; i < 2; ++i) { const int c = ptid + i * 256, s2 = c >> 3, c8 = (c & 7) * 8; pv[i] = *(const u32x4*)(qc + (t1 + s2) * 8192 + 4096 + hv * 128 + vhalf * 64 + c8); } }
#pragma unroll
                    for (int ty = 0; ty < 2; ++ty) { f32x4 acc = (f32x4){0.f, 0.f, 0.f, 0.f};
#pragma unroll
                        for (int ks = 0; ks < 4; ++ks) { const bf16x8 ka = lds_frag(lds + KS + (16 * sa + I) * RSB + (32 * ks + 8 * G) * 2);
                            const bf16x8 bo = ty ? lds_frag(lds + set + QS + (16 * sa + I) * RSB + (32 * ks + 8 * G) * 2) : ka; acc = mfma32(ka, bo, acc); }
                        const f32x4 gr = *(const LAS f32x4*)(lds + GAM + (16 * sa + 4 * G) * 4); const float gc = *(const LAS float*)(lds + GAM + (16 * sa + I) * 4);
                        if (ty == 0) { const f32x4 br = *(const LAS f32x4*)(lds + BET + (16 * sa + 4 * G) * 4);
#pragma unroll
                            for (int r = 0; r < 4; ++r) { const float val = br[r] * acc[r] * __expf(gr[r] - gc); *(LAS float*)(lds + LS + ((sa * 16 + 4 * G + r) * 16 + I) * 4) = (I < 4 * G + r) ? val : 0.f; } }
                        else { f32x4 o;
#pragma unroll
                            for (int r = 0; r < 4; ++r) { const float val = acc[r] * __expf(gc - gr[r]); o[r] = (4 * G + r <= I) ? val : 0.f; }
                            *(LAS s16x4*)(lds + set + QKS + ((sa * 16 + I) * 16 + 4 * G) * 2) = pack4(o); } } }
                LDS_BARRIER();
                if (act) { const int sa = pw, c = lane >> 2, q = lane & 3;
                    f32x4 lv[16];
#pragma unroll
                    for (int i = 0; i < 16; ++i) lv[i] = *(const LAS f32x4*)(lds + LS + ((sa * 16 + i) * 16 + 4 * q) * 4);
                    float xo[4] = {0.f, 0.f, 0.f, 0.f}, xw[4] = {0.f, 0.f, 0.f, 0.f};
#pragma unroll
                    for (int i = 0; i < 16; ++i) {
                        float p = lv[i][0] * xo[0] + lv[i][1] * xo[1] + lv[i][2] * xo[2] + lv[i][3] * xo[3];
                        p += dpp_f<0xB1>(p); p += dpp_f<0x4E>(p);
                        const float xi = ((i == c) ? 1.0f : 0.0f) - p;
                        xo[i & 3] = (q == (i >> 2)) ? xi : xo[i & 3];
                        xw[i >> 2] = (q == (i & 3)) ? xi : xw[i >> 2]; }
                    const float bc = *(const LAS float*)(lds + BET + (sa * 16 + c) * 4), sc1 = -bc * *(const LAS float*)(lds + set + EE + (sa * 16 + c) * 4);
#pragma unroll
                    for (int k = 0; k < 4; ++k) { const int i = 4 * k + q; *(LAS bf16_t*)(lds + X1 + ((sa * 16 + i) * 16 + c) * 2) = f2bf(xw[k] * sc1); *(LAS bf16_t*)(lds + X2 + ((sa * 16 + i) * 16 + c) * 2) = f2bf(xw[k] * bc); } }
                asm volatile("" ::: "memory");
                if (act) { const int sa = pw;
                    const s16x4 xb = *(const LAS s16x4*)(lds + X1 + ((sa * 16 + I) * 16 + 4 * G) * 2); s16x4 kt[8]; f32x4 w[8];
#pragma unroll
                    for (int dt = 0; dt < 8; ++dt) kt[dt] = lds_tr4(lds + KS + (16 * sa + 4 * G + q4) * RSB + (16 * dt + 4 * p4) * 2);
#pragma unroll
                    for (int dt = 0; dt < 8; ++dt) { w[dt] = mfma16(kt[dt], xb, (f32x4){0.f, 0.f, 0.f, 0.f}); *(LAS s16x4*)(lds + set + KT + (16 * dt + I) * KTRS + (16 * sa + 4 * G) * 2) = kt[dt]; }
#pragma unroll
                    for (int dt = 0; dt < 8; ++dt) *(LAS s16x4*)(lds + set + WSL + (16 * sa + I) * RSB + (16 * dt + 4 * G) * 2) = pack4(w[dt]); }
                LDS_BARRIER();
            }
        }
    }
}

constexpr int N_PHASES = 30;
__global__ void __launch_bounds__(NTHREADS, 2) fwd(Args a0) {
    extern __shared__ __attribute__((aligned(16))) unsigned char smem_raw[];
    LAS unsigned char* lds = (LAS unsigned char*)smem_raw;
    volatile LAS unsigned* xbw = (volatile LAS unsigned*)(lds + LDS_XBW);
    if (TIDX == 0) { xbw[0] = 0u; xbw[1] = 0u; xbw[2] = 0u; xbw[3] = 0u; }
    __syncthreads();
    XcdBarrier bar = xcd_barrier_post((unsigned*)(a0.ws + WS_CTL), xbw);
#ifndef PHMASK
#define PHMASK 0xFFFFFFFFull
#endif
#ifndef DUPMASK
#define DUPMASK 0ull
#endif
#define PH(i, body) do { if (((PHMASK >> (i)) & 1ull) && a0.ph_lo <= (i) && (i) < a0.ph_hi) { __attribute__((address_space(1))) unsigned char* wsp_ = (__attribute__((address_space(1))) unsigned char*)a0.ws; asm volatile("" : "+s"(wsp_)); Args a = a0; a.ws = (unsigned char*)wsp_; const float* xin = a.in[0]; const float* xw = (const float*)(a.ws + WS_X); (void)xin; (void)xw; \
        if ((DUPMASK >> (i)) & 1ull) { body; xcd_barrier(bar); } body; if ((i) + 1 < a0.ph_hi) xcd_barrier(bar); } } while (0)
    PH(0, { phase_prologue(a, lds); __syncthreads(); NORM_PH(0, true)(a, xin, a.in[1], -1); });
    PH(2, { if (NBLK == 256 && BID >= 128) { moe_weight_jobs_part(a, 0, lds, BID - 128, 128); __syncthreads(); }
            phase_gemm_in0(a, lds); });
    PH(3, { phase_rg_conv(a); __syncthreads(); phase_hg1(a, lds); });
    PH(4, { phase_rg_gates(a, lds); __syncthreads(); phase_hg2(a); });
    PH(5, { phase_rg_scan(a, lds); __syncthreads(); phase_hg3(a, lds); });
    PH(9, phase_gemm_out<false>(a, lds, D_, a.ws + WS_WOUT0T, xin));
    PH(11, phase_gemm_router(a, lds, 0));
    PH(12, phase_route(a, 0));
    PH(13, phase_rowmap(a, lds, 0));
    PH(14, phase_moe_up(a, lds, 0));
    PH(15, phase_moe_down(a, lds, 0));
    PH(16, { NORM_PH(1, false)(a, nullptr, a.in[1] + D_, 0); if (NBLK != 256) { __syncthreads(); moe_weight_jobs(a, 1, lds); } });
    PH(18, { if (NBLK == 256 && BID >= 128) { moe_weight_jobs_part(a, 1, lds, BID - 128, 128); __syncthreads(); }
             phase_gemm_in1(a, lds); phase_gemm_in1_tail(a, lds); });
    PH(19, phase_gdn_conv(a));
    PH(20, phase_gdn_chunk(a, lds));
    PH(21, phase_gdn_norm(a));
    PH(22, phase_gemm_out<true>(a, lds, 4096, a.ws + WS_WOUT1T, nullptr));
    PH(24, phase_gemm_router(a, lds, 1));
    PH(25, phase_route(a, 1));
    PH(26, phase_rowmap(a, lds, 1));
    PH(27, phase_moe_up(a, lds, 1));
    PH(28, phase_moe_down(a, lds, 1));
    PH(29, NORM_PH(2, false)(a, nullptr, a.in[3], 1));
#undef PH
}

extern "C" void kernel_launch(void* const* d_in, const int* in_sizes, int n_in, void* d_out, int out_size, void* d_ws, size_t ws_size, hipStream_t stream) {
    static int grid = 0;
    if (grid == 0) {
        if (n_in != 28 || ws_size < WS_END) { fprintf(stderr, "kernel_launch: need 28 inputs and %zu bytes of workspace, got %d / %zu\n", (size_t)WS_END, n_in, ws_size); grid = -1; return; }
        int dev = 0, cus = 0, per_cu = 0;
        if (hipGetDevice(&dev) != hipSuccess || hipDeviceGetAttribute(&cus, hipDeviceAttributeMultiprocessorCount, dev) != hipSuccess) { grid = -1; return; }
        if (hipFuncSetAttribute((const void*)fwd, hipFuncAttributeMaxDynamicSharedMemorySize, LDS_BYTES) != hipSuccess) { fprintf(stderr, "kernel_launch: hipFuncSetAttribute failed\n"); grid = -1; return; }
        if (hipOccupancyMaxActiveBlocksPerMultiprocessor(&per_cu, (const void*)fwd, NTHREADS, LDS_BYTES) != hipSuccess || per_cu < 1) { fprintf(stderr, "kernel_launch: occupancy query says %d\n", per_cu); }
        (void)hipGetLastError();
        grid = cus;
    }
    if (grid < 0) return;
    (void)in_sizes; (void)out_size;
    hipMemsetAsync((char*)d_ws + WS_CTL, 0, CTL_BYTES, stream);
    Args a; memset(&a, 0, sizeof(a));
    for (int i = 0; i < 28; ++i) a.in[i] = (const float*)d_in[i];
    a.out = (float*)d_out; a.ws = (unsigned char*)d_ws;
#if N_LAUNCH_MODE == 1
    a.ph_lo = 0; a.ph_hi = N_PHASES;
    hipLaunchKernelGGL(fwd, dim3(grid), dim3(NTHREADS), LDS_BYTES, stream, a);
#if EXTRA_PH >= 0
    a.ph_lo = EXTRA_PH; a.ph_hi = EXTRA_PH + 1;
    hipLaunchKernelGGL(fwd, dim3(grid), dim3(NTHREADS), LDS_BYTES, stream, a);
#endif
#else
    for (int p = 0; p < N_PHASES; ++p) { a.ph_lo = p; a.ph_hi = p + 1; hipLaunchKernelGGL(fwd, dim3(grid), dim3(NTHREADS), LDS_BYTES, stream, a); }
#endif
}
```

```cpp
#include <hip/hip_runtime.h>
#include <stdint.h>
#include <stdio.h>
#include <string.h>

#ifndef EXTRA_PH
#define EXTRA_PH -1
#endif
#ifndef N_LAUNCH_MODE
#define N_LAUNCH_MODE 1
#endif

#define LAS __attribute__((address_space(3)))
typedef unsigned short bf16_t;
typedef short bf16x8 __attribute__((ext_vector_type(8)));
typedef float f32x4 __attribute__((ext_vector_type(4)));
typedef float f32x2 __attribute__((ext_vector_type(2)));
typedef unsigned u32x4 __attribute__((ext_vector_type(4)));
typedef unsigned u32x2 __attribute__((ext_vector_type(2)));

constexpr int T_ = 16384, D_ = 2048, S_ = 4096, NB_ = 4;
constexpr int N_IN0 = 6144, N_IN1 = 12352, N_IN1P = 12544;
constexpr int NEXP = 64, DEXP = 512, MPAD = 49152;
constexpr int NTHREADS = 512;
constexpr int LDS_MAIN = 131072;
constexpr int LDS_BYTES = 163840;
constexpr int LDS_XBW = LDS_BYTES - 16;

constexpr size_t al256(size_t x) { return (x + 255) & ~(size_t)255; }
constexpr size_t WS_CTL = 0;
constexpr size_t CTL_BYTES = 65536;
constexpr size_t CTL_CNT = 16384;
constexpr size_t WS_LB = WS_CTL + CTL_BYTES;
constexpr size_t WS_TINFO = WS_LB + 4096;
constexpr size_t WS_WIN0T = WS_TINFO + 4096;
constexpr size_t WS_WOUT0T = WS_WIN0T + (size_t)N_IN0 * D_ * 2;
constexpr size_t WS_WIN1T = WS_WOUT0T + (size_t)D_ * D_ * 2;
constexpr size_t WS_WOUT1T = WS_WIN1T + (size_t)N_IN1P * D_ * 2;
constexpr size_t WS_WGATES = WS_WOUT1T + (size_t)D_ * 4096 * 2;
constexpr size_t WS_WRT = WS_WGATES + (size_t)8 * 256 * 256 * 2;
constexpr size_t WS_WG = WS_WRT + (size_t)2 * 256 * D_ * 2;
constexpr size_t WS_WU = WS_WG + (size_t)NEXP * DEXP * D_ * 2;
constexpr size_t WS_WD = WS_WU + (size_t)NEXP * DEXP * D_ * 2;
constexpr size_t WS_X = WS_WD + (size_t)NEXP * DEXP * D_ * 2;
constexpr size_t WS_H = WS_X + (size_t)T_ * D_ * 4;
constexpr size_t WS_PROJ = WS_H + (size_t)T_ * D_ * 2;
constexpr size_t PROJ_BYTES = (size_t)T_ * N_IN1P * 2;
constexpr size_t WS_FLOG = WS_PROJ + (size_t)T_ * N_IN0 * 2;
constexpr size_t WS_XC = WS_FLOG + (size_t)T_ * 1024 * 4;
constexpr size_t WS_ACT = WS_PROJ;
constexpr size_t WS_YMOE = WS_ACT + (size_t)MPAD * DEXP * 2;
constexpr size_t WS_R1 = WS_PROJ + PROJ_BYTES;
constexpr size_t WS_A = WS_R1;
constexpr size_t WS_U = WS_R1 + (size_t)T_ * 1024 * 4;
constexpr size_t WS_QKVC = WS_R1;
constexpr size_t WS_Y = WS_R1 + (size_t)T_ * 8192 * 2;
constexpr size_t WS_O = WS_Y + (size_t)T_ * 4096 * 2;
constexpr size_t WS_TAIL = WS_O + (size_t)T_ * 4096 * 4;
constexpr size_t WS_BG = WS_TAIL + (size_t)T_ * 64 * 4;
constexpr size_t WS_LOGITS = WS_BG + (size_t)T_ * 64 * 4;
constexpr size_t WS_EID = WS_LOGITS + (size_t)T_ * 128 * 4;
constexpr size_t WS_SLOT = WS_EID + (size_t)T_ * 2 * 4;
constexpr size_t WS_GATE = WS_SLOT + (size_t)T_ * 2 * 4;
constexpr size_t WS_POSOF = WS_GATE + (size_t)T_ * 2 * 4;
constexpr size_t WS_ROWMAP = WS_POSOF + (size_t)T_ * 2 * 4;
constexpr size_t WS_H8 = WS_ROWMAP + (size_t)MPAD * 4;
constexpr size_t WS_RSP = WS_H8 + (size_t)T_ * D_;
constexpr size_t WS_END = WS_RSP + (size_t)T_ * 32 * 4;
static_assert(WS_YMOE + (size_t)MPAD * D_ * 2 <= WS_R1, "moe overlay");
static_assert(WS_XC + (size_t)T_ * 1024 * 2 <= WS_R1, "layer0 overlay");

struct Args {
    const float* in[28];
    float* out;
    unsigned char* ws;
    int ph_lo, ph_hi;
};

__device__ __forceinline__ int tidx_() { int t = (int)threadIdx.x; asm volatile("" : "+v"(t)); return t; }
#define TIDX tidx_()
typedef __bf16 bf16x2n __attribute__((ext_vector_type(2)));
__device__ __forceinline__ unsigned cvt_pk_bf16(float lo, float hi) { const f32x2 v = {lo, hi}; return __builtin_bit_cast(unsigned, __builtin_convertvector(v, bf16x2n)); }
__device__ __forceinline__ unsigned pk_fp8x4(float a, float b, float c, float d) { int v = __builtin_amdgcn_cvt_pk_fp8_f32(a, b, 0, false); v = __builtin_amdgcn_cvt_pk_fp8_f32(c, d, v, true); return (unsigned)v; }
constexpr float W8_SCALE = 64.0f, ACT8_SCALE = 8.0f;
__device__ __forceinline__ bf16_t f2bf(float x) { return (bf16_t)(cvt_pk_bf16(x, 0.f) & 0xffffu); }
__device__ __forceinline__ float bf_lo(unsigned w) { return __uint_as_float(w << 16); }
__device__ __forceinline__ float bf_hi(unsigned w) { return __uint_as_float(w & 0xffff0000u); }
__device__ __forceinline__ float bf1(bf16_t v) { return __uint_as_float(((unsigned)v) << 16); }
__device__ __forceinline__ float sigmoidf_(float x) { return __builtin_amdgcn_rcpf(1.0f + __expf(-x)); }
__device__ __forceinline__ float siluf_(float x) { return x * __builtin_amdgcn_rcpf(1.0f + __expf(-x)); }
__device__ __forceinline__ float softplusf_(float x) { return x > 20.f ? x : log1pf(__expf(x)); }
__device__ __forceinline__ float gelu_tanh(float x) { const float u = 0.7978845608028654f * (x + 0.044715f * x * x * x); return x * __builtin_amdgcn_rcpf(1.0f + __expf(-2.0f * u)); }
template <int CTRL> __device__ __forceinline__ float dpp_f(float v) { return __builtin_bit_cast(float, __builtin_amdgcn_update_dpp(0, __builtin_bit_cast(int, v), CTRL, 0xf, 0xf, false)); }
__device__ __forceinline__ float row16_sum(float s) { s += dpp_f<0x140>(s); s += dpp_f<0x141>(s); s += dpp_f<0xB1>(s); s += dpp_f<0x4E>(s); return s; }
__device__ __forceinline__ float wave_sum(float v) { v = row16_sum(v); v += __shfl_xor(v, 16); v += __shfl_xor(v, 32); return v; }

#define LDS_BARRIER() do { asm volatile("s_waitcnt lgkmcnt(0)" ::: "memory"); __builtin_amdgcn_s_barrier(); asm volatile("" ::: "memory"); } while (0)
#define XB_TMO      128
#define XB_XCNT(j)  (256  + 64 * (j))
#define XB_XSUB(j)  (1280 + 64 * (j))
#define XB_XGEN(j)  (2304 + 64 * (j))
#define XB_TOP      3328
#define XB_TOPGEN   3392
#define XCD_BAR_WORDS 3456
#define XB_SPIN_CAP (1u << 18)

__device__ __forceinline__ unsigned xb_ld(unsigned* p)              { return __hip_atomic_load(p, __ATOMIC_RELAXED, __HIP_MEMORY_SCOPE_AGENT); }
__device__ __forceinline__ unsigned xb_add(unsigned* p, unsigned v) { return __hip_atomic_fetch_add(p, v, __ATOMIC_RELAXED, __HIP_MEMORY_SCOPE_AGENT); }
__device__ __forceinline__ unsigned xb_xcc_id() { return (unsigned)__builtin_amdgcn_s_getreg((3 << 11) | 20) & 0xFu; }
#define XB_SPIN(cond, bar) do { unsigned _sp = 0; while (cond) { __builtin_amdgcn_s_sleep(1); \
    if ((++_sp & 255u) == 0u) { if (xb_ld(&(bar)[XB_TMO])) break; if (_sp > XB_SPIN_CAP) { atomicAdd(&(bar)[XB_TMO], 1u); break; } } } } while (0)

struct XcdBarrier { unsigned* bar; unsigned x; volatile LAS unsigned* st; };

__device__ __forceinline__ XcdBarrier xcd_barrier_post(unsigned* bar, volatile LAS unsigned* st) {
    XcdBarrier b; b.bar = bar; b.x = xb_xcc_id(); b.st = st;
    if (TIDX == 0) (void)xb_add(&bar[XB_XCNT(b.x)], 1u);
    return b;
}
__device__ __forceinline__ void xcd_barrier_complete(unsigned* bar, unsigned x, unsigned& nloc, unsigned& nx) {
    const unsigned G = gridDim.x * gridDim.y * gridDim.z;
    unsigned sum, cnt, mine, sp = 0u;
    for (;;) {
        sum = 0u; cnt = 0u; mine = 0u;
#pragma unroll
        for (unsigned j = 0; j < 16; ++j) { const unsigned c = xb_ld(&bar[XB_XCNT(j)]); sum += c; cnt += (c > 0u) ? 1u : 0u; mine = (j == x) ? c : mine; }
        if (sum == G) break;
        __builtin_amdgcn_s_sleep(1);
        if ((++sp & 255u) == 0u) { if (xb_ld(&bar[XB_TMO])) break; if (sp > XB_SPIN_CAP) { atomicAdd(&bar[XB_TMO], 1u); break; } }
    }
    nloc = mine > 0u ? mine : 1u; nx = cnt > 0u ? cnt : 1u;
}
__device__ __forceinline__ void xcd_barrier(const XcdBarrier& b) {
    asm volatile("s_waitcnt vmcnt(0)" ::: "memory");
    __syncthreads();
    if (TIDX == 0) {
        unsigned* bar = b.bar;
        __builtin_amdgcn_s_waitcnt(0);
        unsigned nloc = b.st[0], nx = b.st[1];
        if (nloc == 0u) { xcd_barrier_complete(bar, b.x, nloc, nx); b.st[0] = nloc; b.st[1] = nx; }
        const unsigned old = xb_add(&bar[XB_XSUB(b.x)], 1u);
        const unsigned gen = old / nloc;
        if (old + 1u == (gen + 1u) * nloc) {
            __builtin_amdgcn_fence(__ATOMIC_RELEASE, "agent");
            asm volatile("s_waitcnt vmcnt(0)" ::: "memory");
            const unsigned og = xb_add(&bar[XB_TOP], 1u);
            const unsigned tg = og / nx;
            if (og + 1u == (tg + 1u) * nx) xb_add(&bar[XB_TOPGEN], 1u);
            else XB_SPIN(xb_ld(&bar[XB_TOPGEN]) == tg, bar);
            __builtin_amdgcn_fence(__ATOMIC_ACQUIRE, "agent");
            xb_add(&bar[XB_XGEN(b.x)], 1u);
            asm volatile("s_waitcnt vmcnt(0)" ::: "memory");
        } else {
            XB_SPIN(xb_ld(&bar[XB_XGEN(b.x)]) == gen, bar);
            __builtin_amdgcn_fence(__ATOMIC_ACQUIRE, "agent");
            asm volatile("s_waitcnt vmcnt(0)" ::: "memory");
        }
    }
    __syncthreads();
}

constexpr int BM = 256, BK = 64, HALF = 128, HTB = HALF * BK * 2;
__device__ __forceinline__ int lds_byte(int r, int c) { const int st = (r >> 4) * 2 + (c >> 5), rr = r & 15, cc = c & 31, ob = rr * 64 + cc * 2; return st * 1024 + (ob ^ (((ob >> 9) & 1) << 5)); }
__device__ __forceinline__ void stage_rc(int b, int& R, int& C) { const int st = b / 1024, sb = b % 1024, swz = sb ^ (((sb >> 9) & 1) << 5); R = (st >> 1) * 16 + swz / 64; C = (st & 1) * 32 + (swz % 64) / 2; }
__device__ __forceinline__ int perm32(int rho) { const int n = rho >> 4, i = rho & 15; return 8 * (i >> 2) + 4 * n + (i & 3); }

__device__ __forceinline__ void stage_pos(int tid, int& R0, int& C0) { stage_rc(tid * 16, R0, C0); }
__device__ __forceinline__ int perm_row(int R) { return (R & ~31) + perm32(R & 31); }

#define BID ((int)blockIdx.x)
#define NBLK ((int)gridDim.x)
#define BID_ BID
#define NBLK_ NBLK
typedef f32x4 Acc[2][2][4][2];
struct UnitD { const char* gA; const char* gB; int t0, t1, t2; };

typedef int i32x8 __attribute__((ext_vector_type(8)));
typedef int i32x4 __attribute__((ext_vector_type(4)));
template <bool GATHER, bool FP8, class Src, class Epi>
__device__ __forceinline__ void gemm_stream(LAS unsigned char* lds, const Src& S, const int nt, const Epi& E) {
    const int tid = TIDX, wid = tid >> 6, lane = tid & 63, wr = wid >> 2, wc = wid & 3, fr = lane & 15, fq = lane >> 4;
    const unsigned ldsw = (unsigned)wid * 1024u;
    const int aoff = lds_byte(wr * 64 + fr, fq * 8), boff = lds_byte(wc * 32 + fr, fq * 8);
    const size_t kstep = (size_t)(BK * 2);
#define G_SA(b, h) (((b) * 2 + (h)) * HTB)
#define G_SB(b, h) ((4 + (b) * 2 + (h)) * HTB)
#define G_STAGE(bufoff, gbase, v) do { _Pragma("unroll") for (int _i = 0; _i < 2; ++_i) \
        __builtin_amdgcn_global_load_lds((const unsigned*)((gbase) + (v)[_i]), (LAS unsigned*)(lds + (bufoff) + ldsw + _i * 8192), 16, 0, 0); } while (0)
#define G_LD8(p) __builtin_shufflevector(*(const LAS i32x4*)(p), *(const LAS i32x4*)((p) + 1024), 0, 1, 2, 3, 4, 5, 6, 7)
#define G_LDA(dst, b, h) do { _Pragma("unroll") for (int m = 0; m < 4; ++m) dst[m] = G_LD8(lds + G_SA(b, h) + aoff + m * 2048); } while (0)
#define G_LDB(dst, b, h) do { _Pragma("unroll") for (int n = 0; n < 2; ++n) dst[n] = G_LD8(lds + G_SB(b, h) + boff + n * 2048); } while (0)
#define G_HALF(x, k) __builtin_bit_cast(bf16x8, __builtin_shufflevector((x), (x), 4 * (k), 4 * (k) + 1, 4 * (k) + 2, 4 * (k) + 3))
#define G_MMA(ai, bj, At, Bt) do { __builtin_amdgcn_s_setprio(1); _Pragma("unroll") for (int m = 0; m < 4; ++m) _Pragma("unroll") for (int n = 0; n < 2; ++n) { \
        if (FP8) asm volatile("v_mfma_f32_16x16x128_f8f6f4 %0, %1, %2, %0" : "+v"(acc[ai][bj][m][n]) : "v"(Bt[n]), "v"(At[m]));   \
        else { acc[ai][bj][m][n] = __builtin_amdgcn_mfma_f32_16x16x32_bf16(G_HALF(Bt[n], 0), G_HALF(At[m], 0), acc[ai][bj][m][n], 0, 0, 0); \
               acc[ai][bj][m][n] = __builtin_amdgcn_mfma_f32_16x16x32_bf16(G_HALF(Bt[n], 1), G_HALF(At[m], 1), acc[ai][bj][m][n], 0, 0, 0); } } \
        __builtin_amdgcn_s_setprio(0); } while (0)
#define G_WAIT_V(n) asm volatile("s_waitcnt vmcnt(" #n ")" ::: "memory")
#define G_WAIT_L(n) asm volatile("s_waitcnt lgkmcnt(" #n ")" ::: "memory")
#define G_BAR __builtin_amdgcn_s_barrier()
#define G_SCHED __builtin_amdgcn_sched_barrier(0)
    UnitD cur, nxt; int ui = 0;
    if (!S.next(0, cur)) return;
    unsigned va[2][2], vb[2][2], van[2][2];
    S.vb(vb); S.va(cur, va);
    Acc acc;
#pragma unroll
    for (int a = 0; a < 2; ++a)
#pragma unroll
        for (int b = 0; b < 2; ++b)
#pragma unroll
            for (int m = 0; m < 4; ++m)
#pragma unroll
                for (int n = 0; n < 2; ++n) acc[a][b][m][n] = (f32x4){0.f, 0.f, 0.f, 0.f};
    i32x8 At[4], B0[2], B1[2];
    const char* cA = cur.gA; const char* cB = cur.gB;
    G_WAIT_V(0);
    __syncthreads();
    G_STAGE(G_SB(0, 0), cB, vb[0]); G_STAGE(G_SA(0, 0), cA, va[0]); G_STAGE(G_SB(0, 1), cB, vb[1]); G_STAGE(G_SA(0, 1), cA, va[1]);
    if (wr == 1) G_BAR;
    G_WAIT_V(4); G_BAR;
    G_STAGE(G_SB(1, 0), cB + kstep, vb[0]); G_STAGE(G_SA(1, 0), cA + kstep, va[0]); G_STAGE(G_SB(1, 1), cB + kstep, vb[1]);
    G_WAIT_V(6); G_BAR;
    for (;;) {
        const bool has_next = S.next(ui + 1, nxt);
        const char* nA = has_next ? nxt.gA : cA; const char* nB = has_next ? nxt.gB : cB;
        if (GATHER) { if (has_next) S.va(nxt, van); else { van[0][0] = va[0][0]; van[0][1] = va[0][1]; van[1][0] = va[1][0]; van[1][1] = va[1][1]; } }
#pragma unroll 1
        for (int t = 0; t < nt; t += 2) {
            const bool last = (t == nt - 2);
            const char* a1 = cA + (size_t)(t + 1) * kstep;
            const char* a2 = last ? nA : cA + (size_t)(t + 2) * kstep; const char* b2 = last ? nB : cB + (size_t)(t + 2) * kstep;
            const char* a3 = a2 + kstep; const char* b3 = b2 + kstep;
            unsigned v2[2][2];
#pragma unroll
            for (int hh = 0; hh < 2; ++hh)
#pragma unroll
                for (int i = 0; i < 2; ++i) v2[hh][i] = (GATHER && last) ? van[hh][i] : va[hh][i];
            G_LDB(B0, 0, 0); G_SCHED; G_LDA(At, 0, 0); G_STAGE(G_SA(1, 1), a1, va[1]);
            G_WAIT_L(8); G_BAR; G_WAIT_L(0); G_MMA(0, 0, At, B0); G_BAR; G_SCHED;
            G_LDB(B1, 0, 1); G_STAGE(G_SB(0, 0), b2, vb[0]);
            G_BAR; G_WAIT_L(0); G_MMA(0, 1, At, B1); G_BAR;
            G_LDA(At, 0, 1); G_STAGE(G_SA(0, 0), a2, v2[0]);
            G_BAR; G_WAIT_L(0); G_MMA(1, 0, At, B0); G_BAR; G_SCHED;
            G_STAGE(G_SB(0, 1), b2, vb[1]);
            G_WAIT_V(6); G_BAR; G_MMA(1, 1, At, B1); G_BAR;
            G_LDB(B0, 1, 0); G_SCHED; G_LDA(At, 1, 0); G_STAGE(G_SA(0, 1), a2, v2[1]);
            G_WAIT_L(8); G_BAR; G_WAIT_L(0); G_MMA(0, 0, At, B0); G_BAR; G_SCHED;
            G_LDB(B1, 1, 1); G_STAGE(G_SB(1, 0), b3, vb[0]);
            G_BAR; G_WAIT_L(0); G_MMA(0, 1, At, B1); G_BAR;
            G_LDA(At, 1, 1); G_STAGE(G_SA(1, 0), a3, v2[0]);
            G_BAR; G_WAIT_L(0); G_MMA(1, 0, At, B0); G_BAR; G_SCHED;
            G_STAGE(G_SB(1, 1), b3, vb[1]);
            G_WAIT_V(6); G_BAR; G_MMA(1, 1, At, B1); G_BAR;
        }
        if (FP8) asm volatile("s_nop 15\n\ts_nop 15" ::: "memory");
        { int tz = TIDX; asm volatile("" : "+v"(tz));
          const int wid2 = tz >> 6, lane2 = tz & 63; E(acc, cur, wid2 >> 2, wid2 & 3, lane2 & 15, lane2 >> 4); }
        if (!has_next) break;
#pragma unroll
        for (int a = 0; a < 2; ++a)
#pragma unroll
            for (int b = 0; b < 2; ++b)
#pragma unroll
                for (int m = 0; m < 4; ++m)
#pragma unroll
                    for (int n = 0; n < 2; ++n) acc[a][b][m][n] = (f32x4){0.f, 0.f, 0.f, 0.f};
        cur = nxt; cA = nA; cB = nB; ++ui;
        if (GATHER) { va[0][0] = van[0][0]; va[0][1] = van[0][1]; va[1][0] = van[1][0]; va[1][1] = van[1][1]; }
    }
    G_WAIT_V(0);
    if (wr == 0) G_BAR;
    G_BAR;
#undef G_SA
#undef G_SB
#undef G_STAGE
#undef G_LDA
#undef G_LDB
#undef G_MMA
#undef G_LD8
#undef G_HALF
#undef G_WAIT_V
#undef G_WAIT_L
#undef G_BAR
#undef G_SCHED
}

__device__ __forceinline__ void offs_direct(unsigned (&v)[2][2], int ld, bool perm) {
    int R0, C0; stage_pos(TIDX, R0, C0);
#pragma unroll
    for (int i = 0; i < 2; ++i) { const int R = R0 + 64 * i, Rr = perm ? perm_row(R) : R;
        v[0][i] = (unsigned)(Rr * ld + C0) * 2u; v[1][i] = (unsigned)((Rr + HALF) * ld + C0) * 2u; }
}

struct SrcGrid {
    const char* A; const char* B; size_t astep, bstep; int nM, total, lda, ldb;
    __device__ __forceinline__ bool next(int i, UnitD& u) const { const int id = BID_ + i * NBLK_; if (id >= total) return false; u.t0 = id % nM; u.t1 = id / nM; u.t2 = 0;
        u.gA = A + (size_t)u.t0 * astep; u.gB = B + (size_t)u.t1 * bstep; return true; }
    __device__ __forceinline__ void va(const UnitD&, unsigned (&v)[2][2]) const { offs_direct(v, lda, false); }
    __device__ __forceinline__ void vb(unsigned (&v)[2][2]) const { offs_direct(v, ldb, true); }
};

struct SrcGridSplit {
    const char* A; const char* B; size_t astep, bstep; int nM, total, lda, ldb, na, nb;
    __device__ __forceinline__ bool next(int i, UnitD& u) const { int id;
        if (NBLK_ == 256 && total == 128 * (na + nb)) { if (BID_ < 128) { if (i >= na) return false; id = BID_ + 128 * i; } else { if (i >= nb) return false; id = 128 * na + (BID_ - 128) + 128 * i; } }
        else { id = BID_ + i * NBLK_; if (id >= total) return false; }
        u.t0 = id % nM; u.t1 = id / nM; u.t2 = 0; u.gA = A + (size_t)u.t0 * astep; u.gB = B + (size_t)u.t1 * bstep; return true; }
    __device__ __forceinline__ void va(const UnitD&, unsigned (&v)[2][2]) const { offs_direct(v, lda, false); }
    __device__ __forceinline__ void vb(unsigned (&v)[2][2]) const { offs_direct(v, ldb, true); }
};

__device__ __forceinline__ void store_bf16_tile(const Acc& acc, bf16_t* O, int ld, int wr, int wc, int fr, int fq, const float sc = 1.0f) {
#pragma unroll
    for (int ai = 0; ai < 2; ++ai)
#pragma unroll
        for (int m = 0; m < 4; ++m) { bf16_t* rowp = O + (size_t)(ai * HALF + wr * 64 + m * 16 + fr) * ld + wc * 32 + 8 * fq;
#pragma unroll
            for (int bj = 0; bj < 2; ++bj) { const f32x4 v0 = acc[ai][bj][m][0] * sc, v1 = acc[ai][bj][m][1] * sc;
                u32x4 w; w.x = cvt_pk_bf16(v0[0], v0[1]); w.y = cvt_pk_bf16(v0[2], v0[3]); w.z = cvt_pk_bf16(v1[0], v1[1]); w.w = cvt_pk_bf16(v1[2], v1[3]);
                *(u32x4*)(rowp + bj * HALF) = w; } }
}
__device__ __forceinline__ void store_f32_tile(const Acc& acc, float* O, const float* R, int ld, int ncol, int wr, int wc, int fr, int fq, const float sc = 1.0f) {
#pragma unroll
    for (int ai = 0; ai < 2; ++ai)
#pragma unroll
        for (int m = 0; m < 4; ++m) { const size_t ro = (size_t)(ai * HALF + wr * 64 + m * 16 + fr) * ld;
#pragma unroll
            for (int bj = 0; bj < 2; ++bj)
#pragma unroll
                for (int n = 0; n < 2; ++n) { const int c = bj * HALF + wc * 32 + 8 * fq + 4 * n; if (c >= ncol) continue;
                    f32x4 v = acc[ai][bj][m][n] * sc; if (R) v += *(const f32x4*)(R + ro + c); *(f32x4*)(O + ro + c) = v; } }
}
struct EpiProj {
    bf16_t* O; int ld; float* F; int fld, fp0, fp1, ncol; float sc;
    __device__ __forceinline__ void operator()(const Acc& acc, const UnitD& u, int wr, int wc, int fr, int fq) const {
        if (u.t1 >= fp0 && u.t1 < fp1) store_f32_tile(acc, F + (size_t)u.t0 * BM * fld + (u.t1 - fp0) * BM, nullptr, fld, ncol, wr, wc, fr, fq, sc);
        else store_bf16_tile(acc, O + (size_t)u.t0 * BM * ld + u.t1 * BM, ld, wr, wc, fr, fq, sc);
    }
};
struct EpiResid {
    unsigned char* ws; const float* Rf; float sc;
    __device__ __forceinline__ void row_done(float ss, const UnitD& u, int row, int wc, int fq) const {
        ss += __shfl_xor(ss, 16); ss += __shfl_xor(ss, 32);
        if (fq == 0) ((float*)(ws + WS_RSP))[(size_t)(u.t0 * BM + row) * 32 + u.t1 * 4 + wc] = ss; }
    __device__ __forceinline__ void operator()(const Acc& acc, const UnitD& u, int wr, int wc, int fr, int fq) const {
        const size_t o = (size_t)u.t0 * BM * D_ + u.t1 * BM;
        bf16_t* O = (bf16_t*)(ws + WS_X); const bf16_t* Rb = O;
        if (Rf) {
#pragma unroll
            for (int am = 0; am < 8; ++am) { const int ai = am >> 2, m = am & 3; f32x4 r0[2], r1[2];
                const size_t ro = o + (size_t)(ai * HALF + wr * 64 + m * 16 + fr) * D_ + wc * 32 + 8 * fq; float ss = 0.f;
#pragma unroll
                for (int bj = 0; bj < 2; ++bj) { r0[bj] = *(const f32x4*)(Rf + ro + bj * HALF); r1[bj] = *(const f32x4*)(Rf + ro + bj * HALF + 4); }
#pragma unroll
                for (int bj = 0; bj < 2; ++bj) { const f32x4 v0 = acc[ai][bj][m][0] * sc + r0[bj], v1 = acc[ai][bj][m][1] * sc + r1[bj];
                    u32x4 w; w.x = cvt_pk_bf16(v0[0], v0[1]); w.y = cvt_pk_bf16(v0[2], v0[3]); w.z = cvt_pk_bf16(v1[0], v1[1]); w.w = cvt_pk_bf16(v1[2], v1[3]);
                    *(u32x4*)(O + ro + bj * HALF) = w;
                    ss += v0[0] * v0[0] + v0[1] * v0[1] + v0[2] * v0[2] + v0[3] * v0[3] + v1[0] * v1[0] + v1[1] * v1[1] + v1[2] * v1[2] + v1[3] * v1[3]; }
                row_done(ss, u, ai * HALF + wr * 64 + m * 16 + fr, wc, fq); }
        } else {
#pragma unroll
            for (int am = 0; am < 4; ++am) { const int ai = am >> 1; u32x4 rr[2][2];
#pragma unroll
                for (int mm = 0; mm < 2; ++mm) { const int m = (am & 1) * 2 + mm; const size_t ro = o + (size_t)(ai * HALF + wr * 64 + m * 16 + fr) * D_ + wc * 32 + 8 * fq;
#pragma unroll
                    for (int bj = 0; bj < 2; ++bj) rr[mm][bj] = *(const u32x4*)(Rb + ro + bj * HALF); }
#pragma unroll
                for (int mm = 0; mm < 2; ++mm) { const int m = (am & 1) * 2 + mm; const size_t ro = o + (size_t)(ai * HALF + wr * 64 + m * 16 + fr) * D_ + wc * 32 + 8 * fq; float ss = 0.f;
#pragma unroll
                    for (int bj = 0; bj < 2; ++bj) { f32x4 v0 = acc[ai][bj][m][0] * sc, v1 = acc[ai][bj][m][1] * sc; const u32x4 r = rr[mm][bj];
                        v0[0] += bf_lo(r.x); v0[1] += bf_hi(r.x); v0[2] += bf_lo(r.y); v0[3] += bf_hi(r.y); v1[0] += bf_lo(r.z); v1[1] += bf_hi(r.z); v1[2] += bf_lo(r.w); v1[3] += bf_hi(r.w);
                        u32x4 w; w.x = cvt_pk_bf16(v0[0], v0[1]); w.y = cvt_pk_bf16(v0[2], v0[3]); w.z = cvt_pk_bf16(v1[0], v1[1]); w.w = cvt_pk_bf16(v1[2], v1[3]);
                        *(u32x4*)(O + ro + bj * HALF) = w;
                            ss += v0[0] * v0[0] + v0[1] * v0[1] + v0[2] * v0[2] + v0[3] * v0[3] + v1[0] * v1[0] + v1[1] * v1[1] + v1[2] * v1[2] + v1[3] * v1[3]; }
                    row_done(ss, u, ai * HALF + wr * 64 + m * 16 + fr, wc, fq); } }
        }
    }
};
struct EpiLogits {
    float* O;
    __device__ __forceinline__ void operator()(const Acc& acc, const UnitD& u, int wr, int wc, int fr, int fq) const { store_f32_tile(acc, O + (size_t)u.t0 * BM * 128, nullptr, 128, 128, wr, wc, fr, fq); }
};
struct EpiSwiGLU {
    unsigned char* O;
    __device__ __forceinline__ void operator()(const Acc& acc, const UnitD& u, int wr, int wc, int fr, int fq) const {
        unsigned char* o = O + (size_t)u.t0 * BM * DEXP + u.t1 * 128;
#pragma unroll
        for (int ai = 0; ai < 2; ++ai)
#pragma unroll
            for (int m = 0; m < 4; ++m) { unsigned char* rowp = o + (size_t)(ai * HALF + wr * 64 + m * 16 + fr) * DEXP + wc * 32 + 8 * fq;
                float r[8];
#pragma unroll
                for (int n = 0; n < 2; ++n)
#pragma unroll
                    for (int j = 0; j < 4; ++j) r[n * 4 + j] = (ACT8_SCALE / W8_SCALE) * siluf_(acc[ai][0][m][n][j] * (1.0f / W8_SCALE)) * acc[ai][1][m][n][j];
                u32x2 w; w.x = pk_fp8x4(r[0], r[1], r[2], r[3]); w.y = pk_fp8x4(r[4], r[5], r[6], r[7]);
                *(u32x2*)rowp = w; }
    }
};
struct EpiDown {
    unsigned char* O;
    __device__ __forceinline__ void operator()(const Acc& acc, const UnitD& u, int wr, int wc, int fr, int fq) const {
        unsigned char* o = O + (size_t)u.t0 * BM * D_ + u.t1 * BM; const float sc = 1.0f / (W8_SCALE * ACT8_SCALE);
#pragma unroll
        for (int ai = 0; ai < 2; ++ai)
#pragma unroll
            for (int m = 0; m < 4; ++m) { unsigned char* rowp = o + (size_t)(ai * HALF + wr * 64 + m * 16 + fr) * D_ + wc * 32 + 8 * fq;
#pragma unroll
                for (int bj = 0; bj < 2; ++bj) { const f32x4 v0 = acc[ai][bj][m][0] * sc, v1 = acc[ai][bj][m][1] * sc;
                    u32x2 w; w.x = pk_fp8x4(v0[0], v0[1], v0[2], v0[3]); w.y = pk_fp8x4(v1[0], v1[1], v1[2], v1[3]); *(u32x2*)(rowp + bj * HALF) = w; } }
    }
};
__device__ __forceinline__ unsigned rg_idx(unsigned tok, int c) { return ((((tok >> 12) * 64u + (unsigned)(c >> 4)) * (unsigned)S_ + (tok & (unsigned)(S_ - 1))) << 4) + (unsigned)(c & 15); }
struct EpiRgGates {
    bf16_t* LAo; bf16_t* Uo; const bf16_t* xc;
    const float* ba; const float* bx; const float* lam;
    __device__ __forceinline__ void operator()(const Acc& acc, const UnitD& u, int wr, int wc, int fr, int fq) const {
#pragma unroll
        for (int n = 0; n < 2; ++n) { const int c = u.t1 * 128 + wc * 32 + 8 * fq + 4 * n;
            u32x2 xq[2][4];
#pragma unroll
            for (int ai = 0; ai < 2; ++ai)
#pragma unroll
                for (int m = 0; m < 4; ++m) xq[ai][m] = *(const u32x2*)(xc + ((unsigned)(u.t0 * BM + ai * HALF + wr * 64 + m * 16 + fr) * 1024u + (unsigned)c));
            const f32x4 vba = *(const f32x4*)(ba + c), vbx = *(const f32x4*)(bx + c), vl = *(const f32x4*)(lam + c);
            f32x4 c8; for (int j = 0; j < 4; ++j) c8[j] = -8.0f * softplusf_(-vl[j]);
#pragma unroll
            for (int ai = 0; ai < 2; ++ai)
#pragma unroll
                for (int m = 0; m < 4; ++m) { const unsigned tok = (unsigned)(u.t0 * BM + ai * HALF + wr * 64 + m * 16 + fr);
                    const u32x2 xw = xq[ai][m]; const float xv[4] = {bf_lo(xw.x), bf_hi(xw.x), bf_lo(xw.y), bf_hi(xw.y)};
                    f32x4 lv, uv;
#pragma unroll
                    for (int j = 0; j < 4; ++j) { const float r = sigmoidf_(acc[ai][0][m][n][j] + vba[j]), ig = sigmoidf_(acc[ai][1][m][n][j] + vbx[j]);
                        const float la = c8[j] * r, av = __expf(la); lv[j] = la; uv[j] = __builtin_amdgcn_sqrtf(fmaxf(0.f, 1.0f - av * av)) * ig * xv[j]; }
                    const unsigned o = rg_idx(tok, c);
                    u32x2 w0; w0.x = cvt_pk_bf16(lv[0], lv[1]); w0.y = cvt_pk_bf16(lv[2], lv[3]); *(u32x2*)(LAo + o) = w0;
                    u32x2 w1; w1.x = cvt_pk_bf16(uv[0], uv[1]); w1.y = cvt_pk_bf16(uv[2], uv[3]); *(u32x2*)(Uo + o) = w1; } }
    }
};


__device__ __forceinline__ void transpose_job8(const float* src, unsigned char* dst, int K, int N, int ldd, size_t sb, size_t db, int nbatch, LAS unsigned char* lds) {
    const int tid = TIDX, tk = K / 128, tn = N / 64, per = tk * tn, total = per * nbatch;
    const int rr0 = tid >> 4, c4 = (tid & 15) * 4, n = tid >> 3, kg = (tid & 7) * 16;
    f32x4 va[4], vb[4];
#define T8_LD(v, t) { const int u_ = (t), ub_ = u_ / per, ur_ = u_ % per, uik_ = ur_ / tn, uin_ = ur_ % tn; const float* usp_ = src + (size_t)ub_ * sb + (size_t)(uik_ * 128 + rr0) * N + uin_ * 64 + c4; \
        _Pragma("unroll") for (int i = 0; i < 4; ++i) v[i] = *(const f32x4*)(usp_ + (size_t)(i * 32) * N); }
#define T8_ST(v, t, buf) { const int t_ = (t), b_ = t_ / per, r_ = t_ % per, ik_ = r_ / tn, in_ = r_ % tn; LAS float* tile = (LAS float*)(lds + (buf) * (128 * 65 * 4)); \
        _Pragma("unroll") for (int i = 0; i < 4; ++i) { const int rr = rr0 + i * 32; tile[rr * 65 + c4 + 0] = v[i][0]; tile[rr * 65 + c4 + 1] = v[i][1]; tile[rr * 65 + c4 + 2] = v[i][2]; tile[rr * 65 + c4 + 3] = v[i][3]; } \
        if (t_ + 2 * NBLK < total) T8_LD(v, t_ + 2 * NBLK) \
        LDS_BARRIER(); \
        float f[16]; \
        _Pragma("unroll") for (int j = 0; j < 16; ++j) f[j] = tile[(kg + j) * 65 + n] * W8_SCALE; \
        u32x4 w; w.x = pk_fp8x4(f[0], f[1], f[2], f[3]); w.y = pk_fp8x4(f[4], f[5], f[6], f[7]); w.z = pk_fp8x4(f[8], f[9], f[10], f[11]); w.w = pk_fp8x4(f[12], f[13], f[14], f[15]); \
        *(u32x4*)(dst + (size_t)b_ * db + (size_t)(in_ * 64 + n) * ldd + ik_ * 128 + kg) = w; }
    int t = BID;
    if (t < total) T8_LD(va, t)
    if (t + NBLK < total) T8_LD(vb, t + NBLK)
    for (; t < total; t += 2 * NBLK) {
        T8_ST(va, t, 0)
        if (t + NBLK < total) T8_ST(vb, t + NBLK, 1)
    }
#undef T8_LD
#undef T8_ST
    LDS_BARRIER();
}
__device__ __forceinline__ void transpose_job8_deep(const float* src, unsigned char* dst, int K, int N, int ldd, size_t sb, size_t db, int nbatch, LAS unsigned char* lds, int first, int stride) {
    const int tid = TIDX, tk = K / 128, tn = N / 64, per = tk * tn, total = per * nbatch;
    const int rr0 = tid >> 4, c4 = (tid & 15) * 4, n = tid >> 3, kg = (tid & 7) * 16;
    f32x4 va[4], vb[4], vc[4], vd[4];
#define T8_LD(v, t) { const int u_ = (t), ub_ = u_ / per, ur_ = u_ % per, uik_ = ur_ / tn, uin_ = ur_ % tn; const float* usp_ = src + (size_t)ub_ * sb + (size_t)(uik_ * 128 + rr0) * N + uin_ * 64 + c4; \
        _Pragma("unroll") for (int i = 0; i < 4; ++i) v[i] = *(const f32x4*)(usp_ + (size_t)(i * 32) * N); }
#define T8_ST(v, t, buf) { const int t_ = (t), b_ = t_ / per, r_ = t_ % per, ik_ = r_ / tn, in_ = r_ % tn; LAS float* tile = (LAS float*)(lds + (buf) * (128 * 65 * 4)); \
        _Pragma("unroll") for (int i = 0; i < 4; ++i) { const int rr = rr0 + i * 32; tile[rr * 65 + c4 + 0] = v[i][0]; tile[rr * 65 + c4 + 1] = v[i][1]; tile[rr * 65 + c4 + 2] = v[i][2]; tile[rr * 65 + c4 + 3] = v[i][3]; } \
        if (t_ + 4 * stride < total) T8_LD(v, t_ + 4 * stride) \
        LDS_BARRIER(); \
        float f[16]; \
        _Pragma("unroll") for (int j = 0; j < 16; ++j) f[j] = tile[(kg + j) * 65 + n] * W8_SCALE; \
        u32x4 w; w.x = pk_fp8x4(f[0], f[1], f[2], f[3]); w.y = pk_fp8x4(f[4], f[5], f[6], f[7]); w.z = pk_fp8x4(f[8], f[9], f[10], f[11]); w.w = pk_fp8x4(f[12], f[13], f[14], f[15]); \
        *(u32x4*)(dst + (size_t)b_ * db + (size_t)(in_ * 64 + n) * ldd + ik_ * 128 + kg) = w; }
    int t = first;
    if (t < total) T8_LD(va, t)
    if (t + stride < total) T8_LD(vb, t + stride)
    if (t + 2 * stride < total) T8_LD(vc, t + 2 * stride)
    if (t + 3 * stride < total) T8_LD(vd, t + 3 * stride)
    for (; t < total; t += 4 * stride) {
        T8_ST(va, t, 0)
        if (t + stride < total) T8_ST(vb, t + stride, 1)
        if (t + 2 * stride < total) T8_ST(vc, t + 2 * stride, 0)
        if (t + 3 * stride < total) T8_ST(vd, t + 3 * stride, 1)
    }
#undef T8_LD
#undef T8_ST
    LDS_BARRIER();
}
__device__ __forceinline__ void transpose_job(const float* src, bf16_t* dst, int K, int N, int ldd, size_t sb, size_t db, int dalt, int nbatch, LAS unsigned char* lds) {
    const int tid = TIDX, tk = K / 64, tn = N / 64, per = tk * tn, total = per * nbatch;
    const int rr0 = tid >> 4, c4 = (tid & 15) * 4, n = tid >> 3, kg = (tid & 7) * 8;
    f32x4 va[2], vb[2];
#define T16_LD(v, t) { const int u_ = (t), ub_ = u_ / per, ur_ = u_ % per, uik_ = ur_ / tn, uin_ = ur_ % tn; const float* usp_ = src + (size_t)ub_ * sb + (size_t)(uik_ * 64 + rr0) * N + uin_ * 64 + c4; \
        _Pragma("unroll") for (int i = 0; i < 2; ++i) v[i] = *(const f32x4*)(usp_ + (size_t)(i * 32) * N); }
#define T16_ST(v, t, buf) { const int t_ = (t), b_ = t_ / per, r_ = t_ % per, ik_ = r_ / tn, in_ = r_ % tn; LAS float* tile = (LAS float*)(lds + (buf) * (64 * 65 * 4)); \
        _Pragma("unroll") for (int i = 0; i < 2; ++i) { const int rr = rr0 + i * 32; tile[rr * 65 + c4 + 0] = v[i][0]; tile[rr * 65 + c4 + 1] = v[i][1]; tile[rr * 65 + c4 + 2] = v[i][2]; tile[rr * 65 + c4 + 3] = v[i][3]; } \
        if (t_ + 2 * NBLK < total) T16_LD(v, t_ + 2 * NBLK) \
        LDS_BARRIER(); \
        float f[8]; \
        _Pragma("unroll") for (int j = 0; j < 8; ++j) f[j] = tile[(kg + j) * 65 + n]; \
        u32x4 w; w.x = cvt_pk_bf16(f[0], f[1]); w.y = cvt_pk_bf16(f[2], f[3]); w.z = cvt_pk_bf16(f[4], f[5]); w.w = cvt_pk_bf16(f[6], f[7]); \
        *(u32x4*)(dst + (size_t)b_ * db + (size_t)(b_ & 1) * dalt + (size_t)(in_ * 64 + n) * ldd + ik_ * 64 + kg) = w; }
    int t = BID;
    if (t < total) T16_LD(va, t)
    if (t + NBLK < total) T16_LD(vb, t + NBLK)
    for (; t < total; t += 2 * NBLK) {
        T16_ST(va, t, 0)
        if (t + NBLK < total) T16_ST(vb, t + NBLK, 1)
    }
#undef T16_LD
#undef T16_ST
    LDS_BARRIER();
}

__device__ __forceinline__ void moe_weight_jobs(const Args& a, int layer, LAS unsigned char* lds) {
    const size_t lo = (size_t)layer * NEXP * D_ * DEXP;
    transpose_job8(a.in[25] + lo, a.ws + WS_WG, D_, DEXP, D_, (size_t)D_ * DEXP, (size_t)DEXP * D_, NEXP, lds);
    transpose_job8(a.in[26] + lo, a.ws + WS_WU, D_, DEXP, D_, (size_t)D_ * DEXP, (size_t)DEXP * D_, NEXP, lds);
    transpose_job8(a.in[27] + lo, a.ws + WS_WD, DEXP, D_, DEXP, (size_t)D_ * DEXP, (size_t)DEXP * D_, NEXP, lds);
}

__device__ __forceinline__ void moe_weight_jobs_part(const Args& a, int layer, LAS unsigned char* lds, int first, int stride) {
    const size_t lo = (size_t)layer * NEXP * D_ * DEXP;
    transpose_job8_deep(a.in[25] + lo, a.ws + WS_WG, D_, DEXP, D_, (size_t)D_ * DEXP, (size_t)DEXP * D_, NEXP, lds, first, stride);
    transpose_job8_deep(a.in[26] + lo, a.ws + WS_WU, D_, DEXP, D_, (size_t)D_ * DEXP, (size_t)DEXP * D_, NEXP, lds, first, stride);
    transpose_job8_deep(a.in[27] + lo, a.ws + WS_WD, DEXP, D_, DEXP, (size_t)D_ * DEXP, (size_t)DEXP * D_, NEXP, lds, first, stride);
}

__device__ __forceinline__ void phase_prologue(const Args& a, LAS unsigned char* lds) {
    const int gtid = BID * NTHREADS + TIDX, gsz = NBLK * NTHREADS;
    for (int i = gtid; i < 1024; i += gsz) { const float l0 = a.in[12][i], l1 = a.in[12][1024 + i], mx = fmaxf(l0, l1), e0 = __expf(l0 - mx), e1 = __expf(l1 - mx);
        ((float*)(a.ws + WS_LB))[i] = e0 / (e0 + e1); }
    for (int it = gtid; it < 2 * 256 * 256; it += gsz) { const int l = it >> 16, n = (it >> 8) & 255, k8 = (it & 255) * 8; float f[8];
#pragma unroll
        for (int j = 0; j < 8; ++j) { const int k = k8 + j; f[j] = a.in[2][(size_t)l * D_ + k] * (n < 8 ? a.in[21][((size_t)l * D_ + k) * 8 + n] : (n < 72 ? a.in[23][((size_t)l * D_ + k) * 64 + (n - 8)] : 0.f)); }
        u32x4 w; w.x = cvt_pk_bf16(f[0], f[1]); w.y = cvt_pk_bf16(f[2], f[3]); w.z = cvt_pk_bf16(f[4], f[5]); w.w = cvt_pk_bf16(f[6], f[7]);
        *(u32x4*)((bf16_t*)(a.ws + WS_WRT) + ((size_t)l * 256 + n) * D_ + k8) = w; }
    for (int it = gtid; it < 192 * 128; it += gsz) *(u32x4*)(a.ws + WS_WIN1T + (size_t)N_IN1 * D_ + (size_t)it * 16) = (u32x4){0u, 0u, 0u, 0u};
    transpose_job(a.in[4], (bf16_t*)(a.ws + WS_WIN0T), D_, N_IN0, D_, 0, 0, 0, 1, lds);
    transpose_job(a.in[14], (bf16_t*)(a.ws + WS_WOUT0T), D_, D_, D_, 0, 0, 0, 1, lds);
    transpose_job8(a.in[15], a.ws + WS_WIN1T, D_, N_IN1, D_, 0, 0, 1, lds);
    transpose_job8(a.in[20], a.ws + WS_WOUT1T, 4096, D_, 4096, 0, 0, 1, lds);
    transpose_job(a.in[7], (bf16_t*)(a.ws + WS_WGATES), 128, 128, 128, 128 * 128, 256 * 128, 0, 8, lds);
    transpose_job(a.in[9], (bf16_t*)(a.ws + WS_WGATES) + 128 * 128, 128, 128, 128, 128 * 128, 256 * 128, 0, 8, lds);
    if (NBLK != 256) moe_weight_jobs(a, 0, lds);
}

#define NORM_PH(M, F) phase_norm<M, F>
template <int MODE, bool F32>
__device__ __forceinline__ void phase_norm(const Args& a, const float* src, const float* gain, int layer) {
    const int wid = TIDX >> 6, lane = TIDX & 63;
    bf16_t* xw = (bf16_t*)(a.ws + WS_X); bf16_t* hw = (bf16_t*)(a.ws + WS_H);
    const unsigned char* ym = a.ws + WS_YMOE; const int* posof = (const int*)(a.ws + WS_POSOF); const float* gate = (const float*)(a.ws + WS_GATE);
    const int stride = NBLK * 16;
    f32x4 rf[2][8]; u32x2 rb[2][8]; int pp[2][2] = {{0, 0}, {0, 0}}; float pg[2][2] = {{0.f, 0.f}, {0.f, 0.f}};
#define NORM_LD(r) { _Pragma("unroll") for (int u = 0; u < 2; ++u) { _Pragma("unroll") for (int i = 0; i < 8; ++i) { \
            if (F32) rf[u][i] = *(const f32x4*)(src + (size_t)((r) + u) * D_ + (i * 64 + lane) * 4); else rb[u][i] = *(const u32x2*)(xw + (size_t)((r) + u) * D_ + (i * 64 + lane) * 4); } \
            if (MODE >= 1) { pp[u][0] = posof[((r) + u) * 2]; pp[u][1] = posof[((r) + u) * 2 + 1]; pg[u][0] = gate[((r) + u) * 2]; pg[u][1] = gate[((r) + u) * 2 + 1]; } } }
    int row = (BID * 8 + wid) * 2;
    if (row < T_) NORM_LD(row)
    for (; row < T_; row += stride) {
        f32x4 v[2][8]; int p[2][2]; float g[2][2];
#pragma unroll
        for (int u = 0; u < 2; ++u) { p[u][0] = pp[u][0]; p[u][1] = pp[u][1]; g[u][0] = pg[u][0]; g[u][1] = pg[u][1];
#pragma unroll
            for (int i = 0; i < 8; ++i) v[u][i] = F32 ? rf[u][i] : (f32x4){bf_lo(rb[u][i].x), bf_hi(rb[u][i].x), bf_lo(rb[u][i].y), bf_hi(rb[u][i].y)}; }
        if (row + stride < T_) NORM_LD(row + stride)
        if (MODE >= 1) {
            int y[2][8][2];
#pragma unroll
            for (int u = 0; u < 2; ++u) {
#pragma unroll
                for (int i = 0; i < 8; ++i) { const int c = (i * 64 + lane) * 4; y[u][i][0] = *(const int*)(ym + (size_t)p[u][0] * D_ + c); y[u][i][1] = *(const int*)(ym + (size_t)p[u][1] * D_ + c); } }
#pragma unroll
            for (int u = 0; u < 2; ++u) { const float g0 = g[u][0], g1 = g[u][1];
#pragma unroll
                for (int i = 0; i < 8; ++i) { const int y0 = y[u][i][0], y1 = y[u][i][1];
                    const f32x2 a0 = __builtin_amdgcn_cvt_pk_f32_fp8(y0, false), a1 = __builtin_amdgcn_cvt_pk_f32_fp8(y0, true), b0 = __builtin_amdgcn_cvt_pk_f32_fp8(y1, false), b1 = __builtin_amdgcn_cvt_pk_f32_fp8(y1, true);
                    v[u][i][0] += g0 * a0[0] + g1 * b0[0]; v[u][i][1] += g0 * a0[1] + g1 * b0[1]; v[u][i][2] += g0 * a1[0] + g1 * b1[0]; v[u][i][3] += g0 * a1[1] + g1 * b1[1]; }
                if (MODE == 1) {
#pragma unroll
                    for (int i = 0; i < 8; ++i) { u32x2 w; w.x = cvt_pk_bf16(v[u][i][0], v[u][i][1]); w.y = cvt_pk_bf16(v[u][i][2], v[u][i][3]); *(u32x2*)(xw + (size_t)(row + u) * D_ + (i * 64 + lane) * 4) = w; } } }
        }
#pragma unroll
        for (int u = 0; u < 2; ++u) {
            float ss = 0.f;
#pragma unroll
            for (int i = 0; i < 8; ++i) ss += v[u][i][0] * v[u][i][0] + v[u][i][1] * v[u][i][1] + v[u][i][2] * v[u][i][2] + v[u][i][3] * v[u][i][3];
            ss = wave_sum(ss);
            const float rstd = rsqrtf(ss * (1.0f / D_) + 1e-6f);
#pragma unroll
            for (int i = 0; i < 8; ++i) { const int c = (i * 64 + lane) * 4; const f32x4 gn = *(const f32x4*)(gain + c);
                const f32x4 o = v[u][i] * rstd * gn;
                if (MODE == 2) *(f32x4*)(a.out + (size_t)(row + u) * D_ + c) = o;
                else { if (MODE != 1) { u32x2 w; w.x = cvt_pk_bf16(o[0], o[1]); w.y = cvt_pk_bf16(o[2], o[3]); *(u32x2*)(hw + (size_t)(row + u) * D_ + c) = w; }
                       if (layer >= 0) *(unsigned*)(a.ws + WS_H8 + (size_t)(row + u) * D_ + c) = pk_fp8x4(o[0], o[1], o[2], o[3]); } } }
    }
#undef NORM_LD
    (void)layer;
}

__device__ __forceinline__ void phase_gemm_in0(const Args& a, LAS unsigned char* lds) {
    SrcGridSplit S{(const char*)(a.ws + WS_H), (const char*)(a.ws + WS_WIN0T), (size_t)BM * D_ * 2, (size_t)BM * D_ * 2, 64, 64 * 24, D_, D_, 8, 4};
    EpiProj E{(bf16_t*)(a.ws + WS_PROJ), N_IN0, (float*)(a.ws + WS_FLOG), 1024, 12, 16, 256, 1.0f};
    gemm_stream<false, false>(lds, S, D_ / BK, E);
}

__device__ __forceinline__ void phase_rg_conv(const Args& a) {
    const bf16_t* p0 = (const bf16_t*)(a.ws + WS_PROJ); bf16_t* xc = (bf16_t*)(a.ws + WS_XC);
    const float* cw = a.in[5]; const float* cb = a.in[6];
    for (int it = BID * NTHREADS + TIDX; it < 128 * (T_ / 16); it += NBLK * NTHREADS) { const int c = (it & 127) * 8; const size_t t0 = (size_t)(it >> 7) * 16;
        float w[4][8], bias[8];
#pragma unroll
        for (int k = 0; k < 4; ++k) { const f32x4 w0 = *(const f32x4*)(cw + k * 1024 + c), w1 = *(const f32x4*)(cw + k * 1024 + c + 4);
            w[k][0] = w0[0]; w[k][1] = w0[1]; w[k][2] = w0[2]; w[k][3] = w0[3]; w[k][4] = w1[0]; w[k][5] = w1[1]; w[k][6] = w1[2]; w[k][7] = w1[3]; }
        { const f32x4 b0 = *(const f32x4*)(cb + c), b1 = *(const f32x4*)(cb + c + 4); bias[0] = b0[0]; bias[1] = b0[1]; bias[2] = b0[2]; bias[3] = b0[3]; bias[4] = b1[0]; bias[5] = b1[1]; bias[6] = b1[2]; bias[7] = b1[3]; }
        u32x4 x0 = (u32x4){0u, 0u, 0u, 0u}, x1 = x0, x2 = x0;
        if ((t0 & (S_ - 1)) != 0) { x0 = *(const u32x4*)(p0 + (t0 - 3) * N_IN0 + c); x1 = *(const u32x4*)(p0 + (t0 - 2) * N_IN0 + c); x2 = *(const u32x4*)(p0 + (t0 - 1) * N_IN0 + c); }
        u32x4 xr[16];
#pragma unroll
        for (int r = 0; r < 16; ++r) xr[r] = *(const u32x4*)(p0 + (t0 + r) * N_IN0 + c);
#pragma unroll
        for (int r = 0; r < 16; ++r) { const u32x4 x3 = xr[r];
            float acc[8];
#define TAPS(j, f, m) (bias[j] + w[0][j] * f(x0.m) + w[1][j] * f(x1.m) + w[2][j] * f(x2.m) + w[3][j] * f(x3.m))
            acc[0] = TAPS(0, bf_lo, x); acc[1] = TAPS(1, bf_hi, x); acc[2] = TAPS(2, bf_lo, y); acc[3] = TAPS(3, bf_hi, y);
            acc[4] = TAPS(4, bf_lo, z); acc[5] = TAPS(5, bf_hi, z); acc[6] = TAPS(6, bf_lo, w); acc[7] = TAPS(7, bf_hi, w);
#undef TAPS
            u32x4 o; o.x = cvt_pk_bf16(acc[0], acc[1]); o.y = cvt_pk_bf16(acc[2], acc[3]); o.z = cvt_pk_bf16(acc[4], acc[5]); o.w = cvt_pk_bf16(acc[6], acc[7]);
            *(u32x4*)(xc + (t0 + r) * 1024 + c) = o;
            x0 = x1; x1 = x2; x2 = x3; } }
}

struct SrcRgGates {
    const char* xc; const char* w; int total;
    __device__ __forceinline__ bool next(int i, UnitD& u) const { const int id = BID + i * NBLK; if (id >= total) return false; u.t0 = id & 63; u.t1 = id >> 6; u.t2 = 0;
        u.gA = xc + ((size_t)u.t0 * BM * 1024 + u.t1 * 128) * 2; u.gB = w + (size_t)u.t1 * 256 * 128 * 2; return true; }
    __device__ __forceinline__ void va(const UnitD&, unsigned (&v)[2][2]) const { offs_direct(v, 1024, false); }
    __device__ __forceinline__ void vb(unsigned (&v)[2][2]) const { offs_direct(v, 128, true); }
};
__device__ __forceinline__ void phase_rg_gates(const Args& a, LAS unsigned char* lds) {
    SrcRgGates S{(const char*)(a.ws + WS_XC), (const char*)(a.ws + WS_WGATES), 64 * 8};
    EpiRgGates E{(bf16_t*)(a.ws + WS_A), (bf16_t*)(a.ws + WS_U), (const bf16_t*)(a.ws + WS_XC), a.in[8], a.in[10], a.in[11]};
    int nt = 2; asm volatile("" : "+s"(nt));
    gemm_stream<false, false>(lds, S, nt, E);
}

__device__ __forceinline__ void phase_rg_scan(const Args& a, LAS unsigned char* lds) {
    const bf16_t* LA = (const bf16_t*)(a.ws + WS_A); const bf16_t* U = (const bf16_t*)(a.ws + WS_U);
    const bf16_t* p0 = (const bf16_t*)(a.ws + WS_PROJ); bf16_t* Y = (bf16_t*)(a.ws + WS_Y);
    LAS float* sP = (LAS float*)lds; LAS float* sH = sP + 4096; LAS float* gP = sH + 4096; LAS float* gH = gP + 512; LAS float* gC = gH + 512;
    const int tid = TIDX, seg = tid >> 1, c8 = (tid & 1) * 8;
    for (int blk = BID; blk < NB_ * 64; blk += NBLK) { const int b = blk >> 6, c = (blk & 63) * 16 + c8;
        const size_t base = (((size_t)blk * S_ + seg * 16) << 4) + c8;
        float P[8], H[8];
#pragma unroll
        for (int j = 0; j < 8; ++j) { P[j] = 1.f; H[j] = 0.f; }
#pragma unroll 4
        for (int s = 0; s < 16; ++s) { const u32x4 lw = *(const u32x4*)(LA + base + (size_t)s * 16), uw = *(const u32x4*)(U + base + (size_t)s * 16);
            const float la[8] = {bf_lo(lw.x), bf_hi(lw.x), bf_lo(lw.y), bf_hi(lw.y), bf_lo(lw.z), bf_hi(lw.z), bf_lo(lw.w), bf_hi(lw.w)};
            const float uu[8] = {bf_lo(uw.x), bf_hi(uw.x), bf_lo(uw.y), bf_hi(uw.y), bf_lo(uw.z), bf_hi(uw.z), bf_lo(uw.w), bf_hi(uw.w)};
#pragma unroll
            for (int j = 0; j < 8; ++j) { const float av = __expf(la[j]); H[j] = av * H[j] + uu[j]; P[j] *= av; } }
        __syncthreads();
#pragma unroll
        for (int j = 0; j < 8; ++j) { sP[seg * 16 + c8 + j] = P[j]; sH[seg * 16 + c8 + j] = H[j]; }
        __syncthreads();
        { const int ch = tid & 15, grp = tid >> 4; float p = 1.f, h = 0.f;
#pragma unroll
          for (int q = 0; q < 8; ++q) { const int sgi = grp * 8 + q; h = sP[sgi * 16 + ch] * h + sH[sgi * 16 + ch]; p *= sP[sgi * 16 + ch]; }
          gP[grp * 16 + ch] = p; gH[grp * 16 + ch] = h; }
        __syncthreads();
        if (tid < 16) { float carry = 0.f; for (int g = 0; g < 32; ++g) { gC[g * 16 + tid] = carry; carry = gP[g * 16 + tid] * carry + gH[g * 16 + tid]; } }
        __syncthreads();
        { const int ch = tid & 15, grp = tid >> 4; float h = gC[grp * 16 + ch];
#pragma unroll
          for (int q = 0; q < 8; ++q) { const int sgi = grp * 8 + q; const float pin = sP[sgi * 16 + ch], hin = sH[sgi * 16 + ch]; sH[sgi * 16 + ch] = h; h = pin * h + hin; } }
        __syncthreads();
#pragma unroll
        for (int j = 0; j < 8; ++j) H[j] = sH[seg * 16 + c8 + j];
        {
            u32x4 l_a[4], u_a[4], g_a[4];
#define RS_LD(Lv, Uv, Gv, s0) { _Pragma("unroll") for (int j = 0; j < 4; ++j) { const int s_ = (s0) + j; Lv[j] = *(const u32x4*)(LA + base + (size_t)s_ * 16); Uv[j] = *(const u32x4*)(U + base + (size_t)s_ * 16); \
                Gv[j] = *(const u32x4*)(p0 + ((size_t)b * S_ + seg * 16 + s_) * N_IN0 + 1024 + c); } }
            RS_LD(l_a, u_a, g_a, 0)
#pragma unroll
            for (int s0 = 0; s0 < 16; s0 += 4) { u32x4 l_b[4], u_b[4], g_b[4];
#pragma unroll
                for (int j = 0; j < 4; ++j) { l_b[j] = l_a[j]; u_b[j] = u_a[j]; g_b[j] = g_a[j]; }
                if (s0 + 4 < 16) RS_LD(l_b, u_b, g_b, s0 + 4)
#pragma unroll
                for (int j = 0; j < 4; ++j) { const u32x4 lw = l_a[j], uw = u_a[j], gw = g_a[j]; const size_t t = (size_t)b * S_ + seg * 16 + s0 + j;
                    const float la[8] = {bf_lo(lw.x), bf_hi(lw.x), bf_lo(lw.y), bf_hi(lw.y), bf_lo(lw.z), bf_hi(lw.z), bf_lo(lw.w), bf_hi(lw.w)};
                    const float uu[8] = {bf_lo(uw.x), bf_hi(uw.x), bf_lo(uw.y), bf_hi(uw.y), bf_lo(uw.z), bf_hi(uw.z), bf_lo(uw.w), bf_hi(uw.w)};
                    const float gg[8] = {bf_lo(gw.x), bf_hi(gw.x), bf_lo(gw.y), bf_hi(gw.y), bf_lo(gw.z), bf_hi(gw.z), bf_lo(gw.w), bf_hi(gw.w)};
                    float y[8];
#pragma unroll
                    for (int q = 0; q < 8; ++q) { H[q] = __expf(la[q]) * H[q] + uu[q]; y[q] = H[q] * gelu_tanh(gg[q]); }
                    u32x4 o; o.x = cvt_pk_bf16(y[0], y[1]); o.y = cvt_pk_bf16(y[2], y[3]); o.z = cvt_pk_bf16(y[4], y[5]); o.w = cvt_pk_bf16(y[6], y[7]);
                    *(u32x4*)(Y + t * D_ + c) = o; }
#pragma unroll
                for (int j = 0; j < 4; ++j) { l_a[j] = l_b[j]; u_a[j] = u_b[j]; g_a[j] = g_b[j]; } }
#undef RS_LD
        }
    }
}

typedef short s16x4 __attribute__((ext_vector_type(4)));
__device__ __forceinline__ f32x4 mfma32(bf16x8 a, bf16x8 b, f32x4 c) { return __builtin_amdgcn_mfma_f32_16x16x32_bf16(a, b, c, 0, 0, 0); }
__device__ __forceinline__ bf16x8 lds_frag(LAS const unsigned char* p) { return *(const LAS bf16x8*)p; }
__device__ __forceinline__ s16x4 lds_tr4(LAS const unsigned char* p) { return __builtin_amdgcn_ds_read_tr16_b64_v4i16((LAS s16x4*)p); }
__device__ __forceinline__ bf16x8 lds_tr8(LAS const unsigned char* p, int rowskip_bytes) {
    const s16x4 lo = lds_tr4(p), hi = lds_tr4(p + rowskip_bytes); return __builtin_shufflevector(lo, hi, 0, 1, 2, 3, 4, 5, 6, 7); }
__device__ __forceinline__ bf16x8 pack8(const f32x4& lo, const f32x4& hi) { u32x4 w; w.x = cvt_pk_bf16(lo[0], lo[1]); w.y = cvt_pk_bf16(lo[2], lo[3]); w.z = cvt_pk_bf16(hi[0], hi[1]); w.w = cvt_pk_bf16(hi[2], hi[3]); return __builtin_bit_cast(bf16x8, w); }
constexpr int RSB = 272;

constexpr size_t WS_HQ = WS_O;
constexpr size_t WS_HA = WS_HQ + (size_t)2048 * 64 * 128 * 2;
constexpr size_t WS_HG = WS_HA + (size_t)2048 * 8 * 512 * 2;
constexpr size_t WS_HS = WS_HG + (size_t)2048 * 128 * 128 * 2;
constexpr size_t WS_HD = WS_HS + (size_t)2048 * 128 * 128 * 2;
static_assert(WS_HD + (size_t)2048 * 128 * 4 <= WS_TAIL, "hgrn overlay");

__device__ __forceinline__ void phase_hg1(const Args& a, LAS unsigned char* lds) {
    const bf16_t* p0 = (const bf16_t*)(a.ws + WS_PROJ); const float* flog = (const float*)(a.ws + WS_FLOG); const float* lb = (const float*)(a.ws + WS_LB);
    bf16_t* QG = (bf16_t*)(a.ws + WS_HQ); bf16_t* AG = (bf16_t*)(a.ws + WS_HA); bf16_t* GG = (bf16_t*)(a.ws + WS_HG); float* DG = (float*)(a.ws + WS_HD);
    constexpr int SEG = 0, QT = 4096, KT = QT + 64 * RSB, KH = KT + 64 * RSB, VS = KH + 64 * RSB;
    const int tid = TIDX, wid = tid >> 6, lane = tid & 63, I = lane & 15, G = lane >> 4, k2 = 2 * lane, sg = wid;
    LAS float* seg = (LAS float*)(lds + SEG);
    u32x4 pvv[2]; f32x2 pz[8]; unsigned pqw[8];
#define HG1_LOAD(it_) do { const int bh_ = (it_) >> 6, ck_ = (it_) & 63, h_ = bh_ & 7; const size_t t0_ = (size_t)(bh_ >> 3) * S_ + ck_ * 64; \
        _Pragma("unroll") for (int i = 0; i < 2; ++i) { const int c = tid + i * 512, s_ = c >> 4, v8 = (c & 15) * 8; pvv[i] = *(const u32x4*)(p0 + (t0_ + s_) * N_IN0 + 4096 + h_ * 128 + v8); } \
        _Pragma("unroll") for (int i = 0; i < 8; ++i) { const size_t t_ = t0_ + sg * 8 + i; pz[i] = *(const f32x2*)(flog + t_ * 1024 + h_ * 128 + k2); pqw[i] = *(const unsigned*)(p0 + t_ * N_IN0 + 2048 + h_ * 128 + k2); } } while (0)
    if (BID < 2048) HG1_LOAD(BID);
    for (int item = BID; item < 2048; item += NBLK) { const int bh = item >> 6, h = bh & 7;
        LDS_BARRIER();
#pragma unroll
        for (int i = 0; i < 2; ++i) { const int c = tid + i * 512, s = c >> 4, v8 = (c & 15) * 8; *(LAS u32x4*)(lds + VS + s * RSB + v8 * 2) = pvv[i]; }
        const f32x2 l2 = *(const f32x2*)(lb + h * 128 + k2);
        float f[8][2], cb[8][2]; unsigned qw[8]; float c0 = 0.f, c1 = 0.f;
#pragma unroll
        for (int i = 0; i < 8; ++i) { const f32x2 z = pz[i]; qw[i] = pqw[i];
            f[i][0] = l2[0] + (1.0f - l2[0]) * sigmoidf_(z[0]); f[i][1] = l2[1] + (1.0f - l2[1]) * sigmoidf_(z[1]);
            c0 += __logf(f[i][0]); c1 += __logf(f[i][1]); cb[i][0] = c0; cb[i][1] = c1; }
        *(LAS f32x2*)(seg + sg * 128 + k2) = (f32x2){c0, c1};
        if (item + NBLK < 2048) HG1_LOAD(item + NBLK);
        LDS_BARRIER();
        float off0 = 0.f, off1 = 0.f, tot0 = 0.f, tot1 = 0.f;
#pragma unroll
        for (int s2 = 0; s2 < 8; ++s2) { const f32x2 v = *(const LAS f32x2*)(seg + s2 * 128 + k2); tot0 += v[0]; tot1 += v[1]; if (s2 < sg) { off0 += v[0]; off1 += v[1]; } }
        const float et0 = __expf(tot0), et1 = __expf(tot1);
#pragma unroll
        for (int i = 0; i < 8; ++i) { const int t = sg * 8 + i;
            const float e0 = __expf(cb[i][0] + off0), e1 = __expf(cb[i][1] + off1), r0 = __builtin_amdgcn_rcpf(e0), r1 = __builtin_amdgcn_rcpf(e1), km0 = 1.0f - f[i][0], km1 = 1.0f - f[i][1];
            const unsigned qt = cvt_pk_bf16(siluf_(bf_lo(qw[i])) * e0, siluf_(bf_hi(qw[i])) * e1);
            *(LAS unsigned*)(lds + QT + t * RSB + k2 * 2) = qt; *(unsigned*)(QG + ((size_t)item * 64 + t) * 128 + k2) = qt;
            *(LAS unsigned*)(lds + KT + t * RSB + k2 * 2) = cvt_pk_bf16(km0 * r0, km1 * r1);
            *(LAS unsigned*)(lds + KH + t * RSB + k2 * 2) = cvt_pk_bf16(km0 * r0 * et0, km1 * r1 * et1); }
        if (sg == 0) *(f32x2*)(DG + (size_t)item * 128 + k2) = (f32x2){et0, et1};
        LDS_BARRIER();
        { const int tt = wid & 3, sp = wid >> 2;
          bf16x8 qf[4];
#pragma unroll
          for (int ks = 0; ks < 4; ++ks) qf[ks] = lds_frag(lds + QT + (16 * tt + I) * RSB + (32 * ks + 8 * G) * 2);
          f32x4 acc[2];
#pragma unroll
          for (int hh = 0; hh < 2; ++hh) { const int st = 2 * sp + hh; acc[hh] = (f32x4){0.f, 0.f, 0.f, 0.f};
              if (st <= tt) {
#pragma unroll
                  for (int ks = 0; ks < 4; ++ks) acc[hh] = mfma32(lds_frag(lds + KT + (16 * st + I) * RSB + (32 * ks + 8 * G) * 2), qf[ks], acc[hh]);
#pragma unroll
                  for (int r = 0; r < 4; ++r) if (16 * st + 4 * G + r > 16 * tt + I) acc[hh][r] = 0.f; } }
          *(bf16x8*)(AG + (((size_t)item * 4 + tt) * 2 + sp) * 512 + lane * 8) = pack8(acc[0], acc[1]); }
        { const int kt = wid, q = I >> 2, p = I & 3;
          bf16x8 ka[2];
#pragma unroll
          for (int ks = 0; ks < 2; ++ks) ka[ks] = lds_tr8(lds + KH + (32 * ks + 8 * G + q) * RSB + (16 * kt + 4 * p) * 2, 4 * RSB);
#pragma unroll
          for (int vt = 0; vt < 8; ++vt) { f32x4 acc = (f32x4){0.f, 0.f, 0.f, 0.f};
#pragma unroll
              for (int ks = 0; ks < 2; ++ks) acc = mfma32(ka[ks], lds_tr8(lds + VS + (32 * ks + 8 * G + q) * RSB + (16 * vt + 4 * p) * 2, 4 * RSB), acc);
              u32x2 w; w.x = cvt_pk_bf16(acc[0], acc[1]); w.y = cvt_pk_bf16(acc[2], acc[3]);
              *(u32x2*)(GG + ((size_t)item * 128 + 16 * vt + I) * 128 + 16 * kt + 4 * G) = w; } }
    }
#undef HG1_LOAD
}

__device__ __forceinline__ void phase_hg2(const Args& a) {
    const bf16_t* GG = (const bf16_t*)(a.ws + WS_HG); const float* DG = (const float*)(a.ws + WS_HD); bf16_t* SG = (bf16_t*)(a.ws + WS_HS);
    for (int gid = BID * NTHREADS + TIDX; gid < 32 * 4096; gid += NBLK * NTHREADS) { const int bh = gid >> 12, e = gid & 4095, v = e >> 5, k4 = (e & 31) * 4;
        f32x4 S = (f32x4){0.f, 0.f, 0.f, 0.f};
        const size_t o0 = (((size_t)bh * 64) * 128 + v) * 128 + k4; const float* dg = DG + (size_t)bh * 64 * 128 + k4;
        f32x4 da[8]; u32x2 ga[8];
#pragma unroll
        for (int j = 0; j < 8; ++j) { da[j] = *(const f32x4*)(dg + j * 128); ga[j] = *(const u32x2*)(GG + o0 + (size_t)j * 16384); }
#pragma unroll 1
        for (int n0 = 0; n0 < 64; n0 += 8) { f32x4 db[8]; u32x2 gb[8];
#pragma unroll
            for (int j = 0; j < 8; ++j) { db[j] = da[j]; gb[j] = ga[j]; }
            if (n0 + 8 < 64) {
#pragma unroll
                for (int j = 0; j < 8; ++j) { db[j] = *(const f32x4*)(dg + (n0 + 8 + j) * 128); gb[j] = *(const u32x2*)(GG + o0 + (size_t)(n0 + 8 + j) * 16384); } }
#pragma unroll
            for (int j = 0; j < 8; ++j) { u32x2 w; w.x = cvt_pk_bf16(S[0], S[1]); w.y = cvt_pk_bf16(S[2], S[3]); *(u32x2*)(SG + o0 + (size_t)(n0 + j) * 16384) = w;
                const f32x4 d = da[j]; const u32x2 g = ga[j];
                S[0] = d[0] * S[0] + bf_lo(g.x); S[1] = d[1] * S[1] + bf_hi(g.x); S[2] = d[2] * S[2] + bf_lo(g.y); S[3] = d[3] * S[3] + bf_hi(g.y); }
#pragma unroll
            for (int j = 0; j < 8; ++j) { da[j] = db[j]; ga[j] = gb[j]; } } }
}

__device__ __forceinline__ void phase_hg3(const Args& a, LAS unsigned char* lds) {
    const bf16_t* p0 = (const bf16_t*)(a.ws + WS_PROJ); const bf16_t* QG = (const bf16_t*)(a.ws + WS_HQ); const bf16_t* AG = (const bf16_t*)(a.ws + WS_HA); const bf16_t* SG = (const bf16_t*)(a.ws + WS_HS);
    bf16_t* Y = (bf16_t*)(a.ws + WS_Y); const float* gain = a.in[13];
    constexpr int ST = 0, QT = 128 * RSB, VS = QT + 64 * RSB, PART = VS + 64 * RSB;
    const int tid = TIDX, wid = tid >> 6, lane = tid & 63, I = lane & 15, G = lane >> 4, q = I >> 2, p = I & 3;
    LAS float* part = (LAS float*)(lds + PART);
    const int tt = wid & 3, vh = wid >> 2;
    u32x4 ps[4], pq2[2], pv2[2]; bf16x8 paf[2];
#define HG3_LOAD(it_) do { const int bh_ = (it_) >> 6, ck_ = (it_) & 63; const size_t t0_ = (size_t)(bh_ >> 3) * S_ + ck_ * 64; const int h_ = bh_ & 7; \
        _Pragma("unroll") for (int i = 0; i < 4; ++i) { const int c = tid + i * 512, v = c >> 4, k8 = (c & 15) * 8; ps[i] = *(const u32x4*)(SG + ((size_t)(it_) * 128 + v) * 128 + k8); } \
        _Pragma("unroll") for (int i = 0; i < 2; ++i) { const int c = tid + i * 512, s_ = c >> 4, c8 = (c & 15) * 8; pq2[i] = *(const u32x4*)(QG + ((size_t)(it_) * 64 + s_) * 128 + c8); pv2[i] = *(const u32x4*)(p0 + (t0_ + s_) * N_IN0 + 4096 + h_ * 128 + c8); } \
        _Pragma("unroll") for (int sp = 0; sp < 2; ++sp) paf[sp] = *(const bf16x8*)(AG + (((size_t)(it_) * 4 + tt) * 2 + sp) * 512 + lane * 8); } while (0)
    if (BID < 2048) HG3_LOAD(BID);
    for (int item = BID; item < 2048; item += NBLK) { const int bh = item >> 6, ck = item & 63, b = bh >> 3, h = bh & 7; const size_t t0 = (size_t)b * S_ + ck * 64;
        LDS_BARRIER();
#pragma unroll
        for (int i = 0; i < 4; ++i) { const int c = tid + i * 512, v = c >> 4, k8 = (c & 15) * 8; *(LAS u32x4*)(lds + ST + v * RSB + k8 * 2) = ps[i]; }
#pragma unroll
        for (int i = 0; i < 2; ++i) { const int c = tid + i * 512, s2 = c >> 4, c8 = (c & 15) * 8; *(LAS u32x4*)(lds + QT + s2 * RSB + c8 * 2) = pq2[i]; *(LAS u32x4*)(lds + VS + s2 * RSB + c8 * 2) = pv2[i]; }
        bf16x8 af[2]; af[0] = paf[0]; af[1] = paf[1];
        if (item + NBLK < 2048) HG3_LOAD(item + NBLK);
        u32x2 zwp[4];
#pragma unroll
        for (int vi = 0; vi < 4; ++vi) zwp[vi] = *(const u32x2*)(p0 + (t0 + 16 * tt + I) * N_IN0 + 5120 + h * 128 + 16 * (4 * vh + vi) + 4 * G);
        LDS_BARRIER();
        bf16x8 qf[4];
#pragma unroll
        for (int ks = 0; ks < 4; ++ks) qf[ks] = lds_frag(lds + QT + (16 * tt + I) * RSB + (32 * ks + 8 * G) * 2);
        f32x4 acc[4]; float ss = 0.f;
#pragma unroll
        for (int vi = 0; vi < 4; ++vi) { const int vt = 4 * vh + vi; acc[vi] = (f32x4){0.f, 0.f, 0.f, 0.f};
#pragma unroll
            for (int ks = 0; ks < 4; ++ks) acc[vi] = mfma32(lds_frag(lds + ST + (16 * vt + I) * RSB + (32 * ks + 8 * G) * 2), qf[ks], acc[vi]);
#pragma unroll
            for (int sp = 0; sp < 2; ++sp) acc[vi] = mfma32(lds_tr8(lds + VS + (32 * sp + 4 * G + q) * RSB + (16 * vt + 4 * p) * 2, 16 * RSB), af[sp], acc[vi]);
            ss += acc[vi][0] * acc[vi][0] + acc[vi][1] * acc[vi][1] + acc[vi][2] * acc[vi][2] + acc[vi][3] * acc[vi][3]; }
        ss += __shfl_xor(ss, 16); ss += __shfl_xor(ss, 32);
        if (G == 0) part[wid * 16 + I] = ss;
        LDS_BARRIER();
        const float rstd = rsqrtf((part[wid * 16 + I] + part[(wid ^ 4) * 16 + I]) * (1.0f / 128.0f) + 1e-6f);
        const size_t t = t0 + 16 * tt + I;
#pragma unroll
        for (int vi = 0; vi < 4; ++vi) { const int c = h * 128 + 16 * (4 * vh + vi) + 4 * G;
            const f32x4 gn = *(const f32x4*)(gain + c); const u32x2 zw = zwp[vi];
            const float o0 = acc[vi][0] * rstd * gn[0] * siluf_(bf_lo(zw.x)), o1 = acc[vi][1] * rstd * gn[1] * siluf_(bf_hi(zw.x)), o2 = acc[vi][2] * rstd * gn[2] * siluf_(bf_lo(zw.y)), o3 = acc[vi][3] * rstd * gn[3] * siluf_(bf_hi(zw.y));
            u32x2 w; w.x = cvt_pk_bf16(o0, o1); w.y = cvt_pk_bf16(o2, o3); *(u32x2*)(Y + t * D_ + 1024 + c) = w; }
    }
#undef HG3_LOAD
}

__device__ __forceinline__ void phase_gdn_norm(const Args& a) {
    const bf16_t* O = (const bf16_t*)(a.ws + WS_O); const bf16_t* pj = (const bf16_t*)(a.ws + WS_PROJ); unsigned char* Y = a.ws + WS_Y; const float* gain = a.in[19];
    const int lane = TIDX & 63, wid = TIDX >> 6, gc = (lane & 15) * 8;
    const f32x4 g0 = *(const f32x4*)(gain + gc), g1 = *(const f32x4*)(gain + gc + 4);
    u32x4 oa[8], za[8];
    int row = BID * 8 + wid; const int stride = NBLK * 8;
#define GN_LD(ov, zv, r) { _Pragma("unroll") for (int i = 0; i < 8; ++i) { const int c = (i * 64 + lane) * 8; ov[i] = *(const u32x4*)(O + (size_t)(r) * 4096 + c); zv[i] = *(const u32x4*)(pj + (size_t)(r) * N_IN1P + 8192 + c); } }
    if (row < T_) GN_LD(oa, za, row)
    for (; row < T_; row += stride) { u32x4 ob[8], zb[8];
#pragma unroll
        for (int i = 0; i < 8; ++i) { ob[i] = oa[i]; zb[i] = za[i]; }
        if (row + stride < T_) GN_LD(ob, zb, row + stride)
#pragma unroll
        for (int i = 0; i < 8; ++i) { const int c = (i * 64 + lane) * 8;
            const u32x4 ow = oa[i], zw = za[i];
            const float o[8] = {bf_lo(ow.x), bf_hi(ow.x), bf_lo(ow.y), bf_hi(ow.y), bf_lo(ow.z), bf_hi(ow.z), bf_lo(ow.w), bf_hi(ow.w)};
            const float z[8] = {bf_lo(zw.x), bf_hi(zw.x), bf_lo(zw.y), bf_hi(zw.y), bf_lo(zw.z), bf_hi(zw.z), bf_lo(zw.w), bf_hi(zw.w)};
            float ss = 0.f;
#pragma unroll
            for (int q = 0; q < 8; ++q) ss += o[q] * o[q];
            ss = row16_sum(ss);
            const float rstd = rsqrtf(ss * (1.0f / 128.0f) + 1e-6f);
            float y[8];
#pragma unroll
            for (int q = 0; q < 8; ++q) y[q] = o[q] * rstd * (q < 4 ? g0[q & 3] : g1[q & 3]) * siluf_(z[q]);
            u32x2 w; w.x = pk_fp8x4(y[0], y[1], y[2], y[3]); w.y = pk_fp8x4(y[4], y[5], y[6], y[7]);
            *(u32x2*)(Y + (size_t)row * 4096 + c) = w; }
#pragma unroll
        for (int i = 0; i < 8; ++i) { oa[i] = ob[i]; za[i] = zb[i]; }
    }
#undef GN_LD
}

template <bool FP8>
__device__ __forceinline__ void phase_gemm_out(const Args& a, LAS unsigned char* lds, int K, const void* w, const float* xin) {
    const int eb = FP8 ? 1 : 2;
    SrcGrid S{(const char*)(a.ws + WS_Y), (const char*)w, (size_t)BM * K * eb, (size_t)BM * K * eb, 64, 64 * 8, K * eb / 2, K * eb / 2};
    EpiResid E{a.ws, xin, FP8 ? 1.0f / W8_SCALE : 1.0f};
    gemm_stream<false, FP8>(lds, S, K * eb / 128, E);
}

struct SrcRouter {
    const char* h; const char* w;
    __device__ __forceinline__ bool next(int i, UnitD& u) const { const int id = BID + i * NBLK; if (id >= 256) return false; u.t0 = id & 63; u.t1 = id >> 6; u.t2 = 0;
        u.gA = h + ((size_t)u.t0 * BM * D_ + u.t1 * 512) * 2; u.gB = w + (size_t)u.t1 * 512 * 2; return true; }
    __device__ __forceinline__ void va(const UnitD&, unsigned (&v)[2][2]) const { offs_direct(v, D_, false); }
    __device__ __forceinline__ void vb(unsigned (&v)[2][2]) const { offs_direct(v, D_, true); }
};
struct EpiLogitsQ {
    float* O;
    __device__ __forceinline__ void operator()(const Acc& acc, const UnitD& u, int wr, int wc, int fr, int fq) const { store_f32_tile(acc, O + ((size_t)u.t1 * T_ + (size_t)u.t0 * BM) * 128, nullptr, 128, 128, wr, wc, fr, fq); }
};
__device__ __forceinline__ void phase_gemm_router(const Args& a, LAS unsigned char* lds, int layer) {
    SrcRouter S{(const char*)(a.ws + WS_X), (const char*)(a.ws + WS_WRT) + (size_t)layer * 256 * D_ * 2};
    EpiLogitsQ E{(float*)(a.ws + WS_O)};
    gemm_stream<false, false>(lds, S, 512 / BK, E);
}

__device__ __forceinline__ void phase_route(const Args& a, int layer) {
    const float* lg = (const float*)(a.ws + WS_O); const float* bg = a.in[22] + layer * 8; const float* be = a.in[24] + layer * 64;
    int* cnt = (int*)(a.ws + WS_CTL + CTL_CNT) + layer * 64;
    int* eid = (int*)(a.ws + WS_EID); int* slot = (int*)(a.ws + WS_SLOT); float* gate = (float*)(a.ws + WS_GATE); int* rowmap = (int*)(a.ws + WS_ROWMAP);
    const float* rsp = (const float*)(a.ws + WS_RSP);
    {
        const bf16_t* xw = (const bf16_t*)(a.ws + WS_X); const float* gain = a.in[2] + (size_t)layer * D_; const int wid = TIDX >> 6, lane = TIDX & 63, stride = NBLK * 16;
        u32x2 rb[2][8]; float ps[2];
#define RT_LD(r) { _Pragma("unroll") for (int u = 0; u < 2; ++u) { _Pragma("unroll") for (int i = 0; i < 8; ++i) rb[u][i] = *(const u32x2*)(xw + (size_t)((r) + u) * D_ + (i * 64 + lane) * 4); ps[u] = rsp[(size_t)((r) + u) * 32 + (lane & 31)]; } }
        int row = (BID * 8 + wid) * 2;
        if (row < T_) RT_LD(row)
        for (; row < T_; row += stride) { u32x2 rc[2][8]; float pc[2];
#pragma unroll
            for (int u = 0; u < 2; ++u) { pc[u] = ps[u];
#pragma unroll
                for (int i = 0; i < 8; ++i) rc[u][i] = rb[u][i]; }
            if (row + stride < T_) RT_LD(row + stride)
#pragma unroll
            for (int u = 0; u < 2; ++u) { const float rstd = rsqrtf(wave_sum(pc[u]) * (0.5f / D_) + 1e-6f);
#pragma unroll
                for (int i = 0; i < 8; ++i) { const int c = (i * 64 + lane) * 4; const f32x4 gn = *(const f32x4*)(gain + c);
                    *(unsigned*)(a.ws + WS_H8 + (size_t)(row + u) * D_ + c) = pk_fp8x4(bf_lo(rc[u][i].x) * rstd * gn[0], bf_hi(rc[u][i].x) * rstd * gn[1], bf_lo(rc[u][i].y) * rstd * gn[2], bf_hi(rc[u][i].y) * rstd * gn[3]); } } }
#undef RT_LD
    }
    const int gtid = BID * NTHREADS + TIDX, gsz = NBLK * NTHREADS;
    for (int i = gtid; i < MPAD; i += gsz) rowmap[i] = 0;
    for (int t = gtid; t < T_; t += gsz) {
        f32x4 ga = (f32x4){0.f, 0.f, 0.f, 0.f}, gb = ga, sq = ga;
#pragma unroll
        for (int kq = 0; kq < 4; ++kq) { ga += *(const f32x4*)(lg + ((size_t)kq * T_ + t) * 128); gb += *(const f32x4*)(lg + ((size_t)kq * T_ + t) * 128 + 4); }
#pragma unroll
        for (int i = 0; i < 8; ++i) sq += *(const f32x4*)(rsp + (size_t)t * 32 + i * 4);
        const float rstd = rsqrtf((sq[0] + sq[1] + sq[2] + sq[3]) * (1.0f / D_) + 1e-6f);
        ga *= rstd; gb *= rstd;
        const float gl[8] = {ga[0] + bg[0], ga[1] + bg[1], ga[2] + bg[2], ga[3] + bg[3], gb[0] + bg[4], gb[1] + bg[5], gb[2] + bg[6], gb[3] + bg[7]};
        float mx = -3.0e38f; int gi = 0;
#pragma unroll
        for (int j = 0; j < 8; ++j) if (gl[j] > mx) { mx = gl[j]; gi = j; }
        float se = 0.f;
#pragma unroll
        for (int j = 0; j < 8; ++j) se += __expf(gl[j] - mx);
        const float gp = 1.0f / se;
        f32x4 ea = (f32x4){0.f, 0.f, 0.f, 0.f}, eb = ea;
#pragma unroll
        for (int kq = 0; kq < 4; ++kq) { ea += *(const f32x4*)(lg + ((size_t)kq * T_ + t) * 128 + 8 + gi * 8); eb += *(const f32x4*)(lg + ((size_t)kq * T_ + t) * 128 + 12 + gi * 8); }
        ea = ea * rstd + *(const f32x4*)(be + gi * 8); eb = eb * rstd + *(const f32x4*)(be + gi * 8 + 4);
        const float el[8] = {ea[0], ea[1], ea[2], ea[3], eb[0], eb[1], eb[2], eb[3]};
        float l1 = -3.0e38f, l2 = -3.0e38f; int i1 = 0, i2 = 0;
#pragma unroll
        for (int j = 0; j < 8; ++j) { const float v = el[j];
            if (v > l1) { l2 = l1; i2 = i1; l1 = v; i1 = j; } else if (v > l2) { l2 = v; i2 = j; } }
        const float e2 = __expf(l2 - l1), inv = 1.0f / (1.0f + e2);
        const int e0 = gi * 8 + i1, e1 = gi * 8 + i2;
        eid[t * 2] = e0; eid[t * 2 + 1] = e1; gate[t * 2] = inv * gp; gate[t * 2 + 1] = e2 * inv * gp;
        slot[t * 2] = atomicAdd(&cnt[e0], 1); slot[t * 2 + 1] = atomicAdd(&cnt[e1], 1); }
}

__device__ __forceinline__ void phase_rowmap(const Args& a, LAS unsigned char* lds, int layer) {
    const int* cnt = (const int*)(a.ws + WS_CTL + CTL_CNT) + layer * 64; LAS int* ps = (LAS int*)lds;
    int* tinfo = (int*)(a.ws + WS_TINFO) + layer * 512;
    const int* eid = (const int*)(a.ws + WS_EID); const int* slot = (const int*)(a.ws + WS_SLOT); int* posof = (int*)(a.ws + WS_POSOF); int* rowmap = (int*)(a.ws + WS_ROWMAP);
    __syncthreads();
    if (TIDX == 0) { int acc = 0; for (int e = 0; e < 64; ++e) { ps[e] = acc; acc += (cnt[e] + 255) & ~255; } ps[64] = acc; }
    __syncthreads();
    if (BID == 0) { if (TIDX <= 64) tinfo[TIDX] = ps[TIDX]; if (TIDX == 65) tinfo[65] = ps[64] >> 8;
        if (TIDX < 192) { const int p = TIDX * 256; int e = 0; for (int j = 0; j < 64; ++j) if (ps[j + 1] <= p) e = j + 1; tinfo[128 + TIDX] = e < 64 ? e : 63; } }
    for (int i = BID * NTHREADS + TIDX; i < T_ * 2; i += NBLK * NTHREADS) { const int p = ps[eid[i]] + slot[i]; posof[i] = p; rowmap[p] = i >> 1; }
    __syncthreads();
}

struct SrcMoeUp {
    const char* h; const char* wg; const int* tinfo; const int* rowmap; int total;
    __device__ __forceinline__ bool next(int i, UnitD& u) const { const int id = BID + i * NBLK; if (id >= total) return false; u.t0 = id >> 2; u.t1 = id & 3;
        u.t2 = __builtin_amdgcn_readfirstlane(tinfo[128 + u.t0]); u.gA = h; u.gB = wg + ((size_t)u.t2 * DEXP + u.t1 * 128) * D_; return true; }
    __device__ __forceinline__ void va(const UnitD& u, unsigned (&v)[2][2]) const { int R0, C0; stage_pos(TIDX, R0, C0);
#pragma unroll
        for (int hh = 0; hh < 2; ++hh)
#pragma unroll
            for (int i = 0; i < 2; ++i) v[hh][i] = (unsigned)(rowmap[u.t0 * 256 + hh * 128 + R0 + 64 * i] * D_ + C0 * 2); }
    __device__ __forceinline__ void vb(unsigned (&v)[2][2]) const { int R0, C0; stage_pos(TIDX, R0, C0);
#pragma unroll
        for (int i = 0; i < 2; ++i) { const int Rr = perm_row(R0 + 64 * i); v[0][i] = (unsigned)(Rr * D_ + C0 * 2); v[1][i] = (unsigned)(WS_WU - WS_WG) + (unsigned)(Rr * D_ + C0 * 2); } }
};
__device__ __forceinline__ void phase_moe_up(const Args& a, LAS unsigned char* lds, int layer) {
    const int* tinfo = (const int*)(a.ws + WS_TINFO) + layer * 512;
    const int ntm = __builtin_amdgcn_readfirstlane(tinfo[65]);
    SrcMoeUp S{(const char*)(a.ws + WS_H8), (const char*)(a.ws + WS_WG), tinfo, (const int*)(a.ws + WS_ROWMAP), ntm * 4};
    EpiSwiGLU E{a.ws + WS_ACT};
    gemm_stream<true, true>(lds, S, D_ / 128, E);
}

struct SrcMoeDown {
    const char* act; const char* wd; const int* tinfo; int total;
    __device__ __forceinline__ bool next(int i, UnitD& u) const { const int id = BID + i * NBLK; if (id >= total) return false; u.t0 = id >> 3; u.t1 = id & 7;
        u.t2 = __builtin_amdgcn_readfirstlane(tinfo[128 + u.t0]); u.gA = act + (size_t)u.t0 * BM * DEXP; u.gB = wd + ((size_t)u.t2 * D_ + u.t1 * BM) * DEXP; return true; }
    __device__ __forceinline__ void va(const UnitD&, unsigned (&v)[2][2]) const { offs_direct(v, DEXP / 2, false); }
    __device__ __forceinline__ void vb(unsigned (&v)[2][2]) const { offs_direct(v, DEXP / 2, true); }
};
__device__ __forceinline__ void phase_moe_down(const Args& a, LAS unsigned char* lds, int layer) {
    const int* tinfo = (const int*)(a.ws + WS_TINFO) + layer * 512; const int ntm = __builtin_amdgcn_readfirstlane(tinfo[65]);
    SrcMoeDown S{(const char*)(a.ws + WS_ACT), (const char*)(a.ws + WS_WD), tinfo, ntm * 8};
    EpiDown E{a.ws + WS_YMOE};
    gemm_stream<false, true>(lds, S, DEXP / 128, E);
}

struct SrcIn1Tail {
    const char* h; const char* w;
    __device__ __forceinline__ bool next(int i, UnitD& u) const { const int id = BID + i * NBLK; if (id >= 256) return false; u.t0 = id & 63; u.t1 = id >> 6; u.t2 = 0;
        u.gA = h + (size_t)u.t0 * BM * D_ + u.t1 * 512; u.gB = w + (size_t)48 * BM * D_ + u.t1 * 512; return true; }
    __device__ __forceinline__ void va(const UnitD&, unsigned (&v)[2][2]) const { offs_direct(v, D_ / 2, false); }
    __device__ __forceinline__ void vb(unsigned (&v)[2][2]) const { offs_direct(v, D_ / 2, true); }
};
struct EpiTailQ {
    float* O;
    __device__ __forceinline__ void operator()(const Acc& acc, const UnitD& u, int wr, int wc, int fr, int fq) const { store_f32_tile(acc, O + ((size_t)u.t1 * T_ + (size_t)u.t0 * BM) * 64, nullptr, 64, 64, wr, wc, fr, fq, 1.0f / W8_SCALE); }
};
__device__ __forceinline__ void phase_gemm_in1(const Args& a, LAS unsigned char* lds) {
    SrcGridSplit S{(const char*)(a.ws + WS_H8), (const char*)(a.ws + WS_WIN1T), (size_t)BM * D_, (size_t)BM * D_, 64, 64 * 48, D_ / 2, D_ / 2, 16, 8};
    EpiProj E{(bf16_t*)(a.ws + WS_PROJ), N_IN1P, nullptr, 64, 48, 48, 64, 1.0f / W8_SCALE};
    gemm_stream<false, true>(lds, S, D_ / 128, E);
}
__device__ __forceinline__ void phase_gemm_in1_tail(const Args& a, LAS unsigned char* lds) {
    SrcIn1Tail S{(const char*)(a.ws + WS_H8), (const char*)(a.ws + WS_WIN1T)};
    EpiTailQ E{(float*)(a.ws + WS_O)};
    int nt = 4; asm volatile("" : "+s"(nt));
    gemm_stream<false, true>(lds, S, nt, E);
}

__device__ __forceinline__ void phase_gdn_conv(const Args& a) {
    const bf16_t* p1 = (const bf16_t*)(a.ws + WS_PROJ); bf16_t* qc = (bf16_t*)(a.ws + WS_QKVC); const float* cw = a.in[16];
    const int gtid = BID * NTHREADS + TIDX, gsz = NBLK * NTHREADS;
    for (int it = gtid; it < 1024 * (T_ / 128); it += gsz) { const int c = (it & 1023) * 8, seg = it >> 10; const size_t t0 = (size_t)seg * 128;
        float w[4][8];
#pragma unroll
        for (int k = 0; k < 4; ++k) { const f32x4 w0 = *(const f32x4*)(cw + k * 8192 + c), w1 = *(const f32x4*)(cw + k * 8192 + c + 4);
            w[k][0] = w0[0]; w[k][1] = w0[1]; w[k][2] = w0[2]; w[k][3] = w0[3]; w[k][4] = w1[0]; w[k][5] = w1[1]; w[k][6] = w1[2]; w[k][7] = w1[3]; }
        u32x4 x0 = (u32x4){0u, 0u, 0u, 0u}, x1 = x0, x2 = x0;
        if ((t0 & (S_ - 1)) != 0) { x0 = *(const u32x4*)(p1 + (t0 - 3) * N_IN1P + c); x1 = *(const u32x4*)(p1 + (t0 - 2) * N_IN1P + c); x2 = *(const u32x4*)(p1 + (t0 - 1) * N_IN1P + c); }
        const float qsc = c < 2048 ? 0.08838834764831845f : 1.0f;
        u32x4 xa[8];
#pragma unroll
        for (int j = 0; j < 8; ++j) xa[j] = *(const u32x4*)(p1 + (t0 + j) * N_IN1P + c);
#pragma unroll 1
        for (int r0 = 0; r0 < 128; r0 += 8) { u32x4 xb[8];
#pragma unroll
            for (int j = 0; j < 8; ++j) xb[j] = xa[j];
            if (r0 + 8 < 128) {
#pragma unroll
                for (int j = 0; j < 8; ++j) xb[j] = *(const u32x4*)(p1 + (t0 + r0 + 8 + j) * N_IN1P + c); }
#pragma unroll
          for (int j8 = 0; j8 < 8; ++j8) { const u32x4 x3 = xa[j8]; const int r = r0 + j8;
            float acc[8];
#define TAPS(j, f, m) (w[0][j] * f(x0.m) + w[1][j] * f(x1.m) + w[2][j] * f(x2.m) + w[3][j] * f(x3.m))
            acc[0] = TAPS(0, bf_lo, x); acc[1] = TAPS(1, bf_hi, x); acc[2] = TAPS(2, bf_lo, y); acc[3] = TAPS(3, bf_hi, y);
            acc[4] = TAPS(4, bf_lo, z); acc[5] = TAPS(5, bf_hi, z); acc[6] = TAPS(6, bf_lo, w); acc[7] = TAPS(7, bf_hi, w);
#undef TAPS
            float ss = 0.f;
#pragma unroll
            for (int j = 0; j < 8; ++j) { acc[j] = siluf_(acc[j]); ss += acc[j] * acc[j]; }
            ss = row16_sum(ss);
            const float sc = c < 4096 ? rsqrtf(ss + 1e-6f) * qsc : 1.0f;
            u32x4 o; o.x = cvt_pk_bf16(acc[0] * sc, acc[1] * sc); o.y = cvt_pk_bf16(acc[2] * sc, acc[3] * sc); o.z = cvt_pk_bf16(acc[4] * sc, acc[5] * sc); o.w = cvt_pk_bf16(acc[6] * sc, acc[7] * sc);
            *(u32x4*)(qc + (t0 + r) * 8192 + c) = o;
            x0 = x1; x1 = x2; x2 = x3; }
#pragma unroll
            for (int j = 0; j < 8; ++j) xa[j] = xb[j]; } }
    const float* tail = (const float*)(a.ws + WS_O); float* bgo = (float*)(a.ws + WS_BG);
    for (int it = gtid; it < T_ * 32; it += gsz) { const int t = it >> 5, hv = it & 31; float tb = 0.f, ta = 0.f;
#pragma unroll
        for (int kq = 0; kq < 4; ++kq) { tb += tail[((size_t)kq * T_ + t) * 64 + hv]; ta += tail[((size_t)kq * T_ + t) * 64 + 32 + hv]; }
        bgo[t * 64 + hv] = sigmoidf_(tb);
        bgo[t * 64 + 32 + hv] = -__expf(a.in[17][hv]) * softplusf_(ta + a.in[18][hv]); }
}

struct MoeTile { const float* src; unsigned char* dst; int lds_, ldd; };
__device__ __forceinline__ MoeTile moe_tile(const Args& a, int g) {
    const int job = g >> 14, r = g & 16383, e = r >> 8, rr = r & 255; MoeTile t;
    typedef __attribute__((address_space(1))) const float* gcf; gcf s25 = (gcf)a.in[25], s26 = (gcf)a.in[26]; asm volatile("" : "+s"(s25), "+s"(s26));
    if (job < 2) { const int ik = rr >> 3, in = rr & 7; t.lds_ = DEXP; t.ldd = D_;
        t.src = (const float*)(job ? s26 : s25) + ((size_t)(NEXP + e) * D_ + ik * 64) * DEXP + in * 64; t.dst = a.ws + (job ? WS_WU : WS_WG) + ((size_t)e * DEXP + in * 64) * D_ + ik * 64; }
    else { const int ik = rr >> 5, in = rr & 31; t.lds_ = D_; t.ldd = DEXP;
        t.src = a.in[27] + ((size_t)(NEXP + e) * DEXP + ik * 64) * D_ + in * 64; t.dst = a.ws + WS_WD + ((size_t)e * D_ + in * 64) * DEXP + ik * 64; }
    return t;
}
__device__ __forceinline__ void moe_tile_load(const MoeTile& t, int tid, f32x4 (&v)[2]) {
#pragma unroll
    for (int i = 0; i < 2; ++i) { const int idx = tid + i * 512, rr = idx >> 4, c4 = (idx & 15) * 4; v[i] = *(const f32x4*)(t.src + (size_t)rr * t.lds_ + c4); }
}
__device__ __forceinline__ void moe_tile_store(const MoeTile& t, int tid, const f32x4 (&v)[2], LAS float* tile) {
#pragma unroll
    for (int i = 0; i < 2; ++i) { const int idx = tid + i * 512, rr = idx >> 4, c4 = (idx & 15) * 4;
        tile[rr * 65 + c4 + 0] = v[i][0]; tile[rr * 65 + c4 + 1] = v[i][1]; tile[rr * 65 + c4 + 2] = v[i][2]; tile[rr * 65 + c4 + 3] = v[i][3]; }
    LDS_BARRIER();
    { const int n = tid >> 3, kg = (tid & 7) * 8; float f[8];
#pragma unroll
      for (int jj = 0; jj < 8; ++jj) f[jj] = tile[(kg + jj) * 65 + n] * W8_SCALE;
      u32x2 w; w.x = pk_fp8x4(f[0], f[1], f[2], f[3]); w.y = pk_fp8x4(f[4], f[5], f[6], f[7]);
      *(u32x2*)(t.dst + (size_t)n * t.ldd + kg) = w; }
    LDS_BARRIER();
}
constexpr int MOE_TILES = 3 * NEXP * 256;

__device__ __forceinline__ f32x4 mfma16(s16x4 a, s16x4 b, f32x4 c) { return __builtin_amdgcn_mfma_f32_16x16x16bf16_1k(a, b, c, 0, 0, 0); }
__device__ __forceinline__ s16x4 pack4(const f32x4& v) { u32x2 w; w.x = cvt_pk_bf16(v[0], v[1]); w.y = cvt_pk_bf16(v[2], v[3]); return __builtin_bit_cast(s16x4, w); }
__device__ __forceinline__ void phase_gdn_chunk(const Args& a, LAS unsigned char* lds) {
    const bf16_t* qc = (const bf16_t*)(a.ws + WS_QKVC); const float* bgi = (const float*)(a.ws + WS_BG); bf16_t* O = (bf16_t*)(a.ws + WS_O);
    constexpr int VRS = 144, KTRS = 136;
    constexpr int KT = 0, QS = KT + 128 * KTRS, WSL = QS + 64 * RSB, QKS = WSL + 64 * RSB, EE = QKS + 2048, EDD = EE + 256, SET = EDD + 256;
    constexpr int STL = 2 * SET, KS = STL + 64 * RSB, VS = KS + 64 * RSB, X2 = VS + 64 * VRS, LS = X2 + 2048, X1 = LS + 4096, GAM = X1 + 2048, BET = GAM + 256, LEND = BET + 256;
    static_assert(LEND <= LDS_XBW, "gdn lds");
    const int wid = __builtin_amdgcn_readfirstlane(TIDX >> 6);
    const int NCK = S_ / 64;
    for (int blk = BID; blk < NB_ * 32 * 2; blk += NBLK) {
        const int grp = (blk & 7) * 8 + (blk >> 5), mem = (blk >> 3) & 3, b = grp >> 4, hk = grp & 15, hv = 2 * hk + (mem >> 1), vhalf = mem & 1;
        __syncthreads();
        if (wid < 4) {
            const int vt = wid;
            f32x4 Sacc[8];
#pragma unroll
            for (int n = 0; n < 8; ++n) Sacc[n] = (f32x4){0.f, 0.f, 0.f, 0.f};
            { const int lane = TIDX & 63;
              for (int i = lane; i < 16 * RSB / 16; i += 64) *(LAS u32x4*)(lds + STL + 16 * vt * RSB + i * 16) = (u32x4){0u, 0u, 0u, 0u}; }
            int lz = TIDX & 63; asm volatile("" : "+v"(lz));
            const int lane = lz, I = lane & 15, G = lane >> 4, q4 = I >> 2, p4 = I & 3;
            for (int it = 0; it <= NCK; ++it) {
                const int set = ((it - 1) & 1) * SET; const size_t t0 = (size_t)b * S_ + (size_t)(it - 1) * 64;
                f32x4 U[4];
                if (it >= 1) {
#pragma unroll
                    for (int sa = 0; sa < 4; ++sa) U[sa] = mfma16(*(const LAS s16x4*)(lds + X2 + ((sa * 16 + I) * 16 + 4 * G) * 2), lds_tr4(lds + VS + (16 * sa + 4 * G + q4) * VRS + (16 * vt + 4 * p4) * 2), (f32x4){0.f, 0.f, 0.f, 0.f});
                    asm volatile("" : "+v"(U[0]), "+v"(U[1]), "+v"(U[2]), "+v"(U[3]) :: "memory");
                }
                LDS_BARRIER();
#pragma unroll
                for (int sa = 0; sa < 4; ++sa) {
                    if (it >= 1) {
                        bf16x8 sf[4];
#pragma unroll
                        for (int ks = 0; ks < 4; ++ks) sf[ks] = lds_frag(lds + STL + (16 * vt + I) * RSB + (32 * ks + 8 * G) * 2);
                        s16x4 kt[8];
#pragma unroll
                        for (int dt = 0; dt < 8; ++dt) kt[dt] = *(const LAS s16x4*)(lds + set + KT + (16 * dt + I) * KTRS + (16 * sa + 4 * G) * 2);
                        f32x4 dl = U[sa], oq = (f32x4){0.f, 0.f, 0.f, 0.f}, dl2 = oq, oq2 = oq;
#pragma unroll
                        for (int ks = 0; ks < 2; ++ks) { dl = mfma32(lds_frag(lds + set + WSL + (16 * sa + I) * RSB + (32 * ks + 8 * G) * 2), sf[ks], dl);
                            dl2 = mfma32(lds_frag(lds + set + WSL + (16 * sa + I) * RSB + (32 * (ks + 2) + 8 * G) * 2), sf[ks + 2], dl2);
                            oq = mfma32(lds_frag(lds + set + QS + (16 * sa + I) * RSB + (32 * ks + 8 * G) * 2), sf[ks], oq);
                            oq2 = mfma32(lds_frag(lds + set + QS + (16 * sa + I) * RSB + (32 * (ks + 2) + 8 * G) * 2), sf[ks + 2], oq2); }
                        dl += dl2; oq += oq2;
                        const s16x4 dfrag = pack4(dl);
                        const f32x4 e4 = *(const LAS f32x4*)(lds + set + EE + (16 * sa + 4 * G) * 4);
                        oq = mfma16(*(const LAS s16x4*)(lds + set + QKS + ((sa * 16 + I) * 16 + 4 * G) * 2), dfrag, oq * e4);
#pragma unroll
                        for (int r = 0; r < 4; ++r) O[(t0 + 16 * sa + 4 * G + r) * 4096 + hv * 128 + vhalf * 64 + 16 * vt + I] = f2bf(oq[r]);
                        const f32x4 ed4 = *(const LAS f32x4*)(lds + set + EDD + (16 * sa + 4 * G) * 4); const float e15 = *(const LAS float*)(lds + set + EE + (16 * sa + 15) * 4);
                        const s16x4 dsc = pack4(dl * ed4);
#pragma unroll
                        for (int dt = 0; dt < 8; ++dt) {
                            Sacc[dt] = mfma16(kt[dt], dsc, Sacc[dt] * e15);
                            *(LAS s16x4*)(lds + STL + (16 * vt + I) * RSB + (16 * dt + 4 * G) * 2) = pack4(Sacc[dt]); }
                    }
                    if (sa == 0 || sa == 3) LDS_BARRIER();
                }
            }
        } else {
            const int pw = wid - 4;
            u32x4 pq[4], pk[4], pv[2]; float pb = 0.f, pg = 0.f;
            { const int ptid = TIDX - 256; const size_t t0 = (size_t)b * S_;
#pragma unroll
              for (int i = 0; i < 4; ++i) { const int c = ptid + i * 256, s2 = c >> 4, c8 = (c & 15) * 8; pq[i] = *(const u32x4*)(qc + (t0 + s2) * 8192 + hk * 128 + c8); pk[i] = *(const u32x4*)(qc + (t0 + s2) * 8192 + 2048 + hk * 128 + c8); }
#pragma unroll
              for (int i = 0; i < 2; ++i) { const int c = ptid + i * 256, s2 = c >> 3, c8 = (c & 7) * 8; pv[i] = *(const u32x4*)(qc + (t0 + s2) * 8192 + 4096 + hv * 128 + vhalf * 64 + c8); }
              if (pw == 1) { pb = bgi[(t0 + ptid - 64) * 64 + hv]; pg = bgi[(t0 + ptid - 64) * 64 + 32 + hv]; } }
            int lz = TIDX & 63; asm volatile("" : "+v"(lz));
            const int lane = lz, ptid = pw * 64 + lane, I = lane & 15, G = lane >> 4, q4 = I >> 2, p4 = I & 3;
            for (int it = 0; it <= NCK; ++it) {
                const int set = (it & 1) * SET; const bool act = it < NCK;
                if (act) {
#pragma unroll
                    for (int i = 0; i < 4; ++i) { const int c = ptid + i * 256, s2 = c >> 4, c8 = (c & 15) * 8; *(LAS u32x4*)(lds + set + QS + s2 * RSB + c8 * 2) = pq[i]; *(LAS u32x4*)(lds + KS + s2 * RSB + c8 * 2) = pk[i]; }
                    if (pw == 1) { float x = pg;
                        x += __builtin_bit_cast(float, __builtin_amdgcn_update_dpp(0, __builtin_bit_cast(int, x), 0x111, 0xf, 0xf, true));
                        x += __builtin_bit_cast(float, __builtin_amdgcn_update_dpp(0, __builtin_bit_cast(int, x), 0x112, 0xf, 0xf, true));
                        x += __builtin_bit_cast(float, __builtin_amdgcn_update_dpp(0, __builtin_bit_cast(int, x), 0x114, 0xf, 0xf, true));
                        x += __builtin_bit_cast(float, __builtin_amdgcn_update_dpp(0, __builtin_bit_cast(int, x), 0x118, 0xf, 0xf, true));
                        const float g15 = __shfl(x, 15, 16);
                        *(LAS float*)(lds + GAM + lane * 4) = x; *(LAS float*)(lds + set + EE + lane * 4) = __expf(x); *(LAS float*)(lds + set + EDD + lane * 4) = __expf(g15 - x); *(LAS float*)(lds + BET + lane * 4) = pb; }
                    if (it + 1 < NCK) { const size_t t1 = (size_t)b * S_ + (size_t)(it + 1) * 64;
#pragma unroll
                        for (int i = 0; i < 4; ++i) { const int c = ptid + i * 256, s2 = c >> 4, c8 = (c & 15) * 8; pq[i] = *(const u32x4*)(qc + (t1 + s2) * 8192 + hk * 128 + c8); pk[i] = *(const u32x4*)(qc + (t1 + s2) * 8192 + 2048 + hk * 128 + c8); }
                        if (pw == 1) { pb = bgi[(t1 + ptid - 64) * 64 + hv]; pg = bgi[(t1 + ptid - 64) * 64 + 32 + hv]; } }
                }
                LDS_BARRIER();
                if (act) { const int sa = pw;
#pragma unroll
                    for (int i = 0; i < 2; ++i) { const int c = ptid + i * 256, s2 = c >> 3, c8 = (c & 7) * 8; *(LAS u32x4*)(lds + VS + s2 * VRS + c8 * 2) = pv[i]; }
                    if (it + 1 < NCK) { const size_t t1 = (size_t)b * S_ + (size_t)(it + 1) * 64;
#pragma unroll
                        for (int i = 0; i < 2; ++i) { const int c = ptid + i * 256, s2 = c >> 3, c8 = (c & 7) * 8; pv[i] = *(const u32x4*)(qc + (t1 + s2) * 8192 + 4096 + hv * 128 + vhalf * 64 + c8); } }
#pragma unroll
                    for (int ty = 0; ty < 2; ++ty) { f32x4 acc = (f32x4){0.f, 0.f, 0.f, 0.f};
#pragma unroll
                        for (int ks = 0; ks < 4; ++ks) { const bf16x8 ka = lds_frag(lds + KS + (16 * sa + I) * RSB + (32 * ks + 8 * G) * 2);
                            const bf16x8 bo = ty ? lds_frag(lds + set + QS + (16 * sa + I) * RSB + (32 * ks + 8 * G) * 2) : ka; acc = mfma32(ka, bo, acc); }
                        const f32x4 gr = *(const LAS f32x4*)(lds + GAM + (16 * sa + 4 * G) * 4); const float gc = *(const LAS float*)(lds + GAM + (16 * sa + I) * 4);
                        if (ty == 0) { const f32x4 br = *(const LAS f32x4*)(lds + BET + (16 * sa + 4 * G) * 4);
#pragma unroll
                            for (int r = 0; r < 4; ++r) { const float val = br[r] * acc[r] * __expf(gr[r] - gc); *(LAS float*)(lds + LS + ((sa * 16 + 4 * G + r) * 16 + I) * 4) = (I < 4 * G + r) ? val : 0.f; } }
                        else { f32x4 o;
#pragma unroll
                            for (int r = 0; r < 4; ++r) { const float val = acc[r] * __expf(gc - gr[r]); o[r] = (4 * G + r <= I) ? val : 0.f; }
                            *(LAS s16x4*)(lds + set + QKS + ((sa * 16 + I) * 16 + 4 * G) * 2) = pack4(o); } } }
                LDS_BARRIER();
                if (act) { const int sa = pw, c = lane >> 2, q = lane & 3;
                    f32x4 lv[16];
#pragma unroll
                    for (int i = 0; i < 16; ++i) lv[i] = *(const LAS f32x4*)(lds + LS + ((sa * 16 + i) * 16 + 4 * q) * 4);
                    float xo[4] = {0.f, 0.f, 0.f, 0.f}, xw[4] = {0.f, 0.f, 0.f, 0.f};
#pragma unroll
                    for (int i = 0; i < 16; ++i) {
                        float p = lv[i][0] * xo[0] + lv[i][1] * xo[1] + lv[i][2] * xo[2] + lv[i][3] * xo[3];
                        p += dpp_f<0xB1>(p); p += dpp_f<0x4E>(p);
                        const float xi = ((i == c) ? 1.0f : 0.0f) - p;
                        xo[i & 3] = (q == (i >> 2)) ? xi : xo[i & 3];
                        xw[i >> 2] = (q == (i & 3)) ? xi : xw[i >> 2]; }
                    const float bc = *(const LAS float*)(lds + BET + (sa * 16 + c) * 4), sc1 = -bc * *(const LAS float*)(lds + set + EE + (sa * 16 + c) * 4);
#pragma unroll
                    for (int k = 0; k < 4; ++k) { const int i = 4 * k + q; *(LAS bf16_t*)(lds + X1 + ((sa * 16 + i) * 16 + c) * 2) = f2bf(xw[k] * sc1); *(LAS bf16_t*)(lds + X2 + ((sa * 16 + i) * 16 + c) * 2) = f2bf(xw[k] * bc); } }
                asm volatile("" ::: "memory");
                if (act) { const int sa = pw;
                    const s16x4 xb = *(const LAS s16x4*)(lds + X1 + ((sa * 16 + I) * 16 + 4 * G) * 2); s16x4 kt[8]; f32x4 w[8];
#pragma unroll
                    for (int dt = 0; dt < 8; ++dt) kt[dt] = lds_tr4(lds + KS + (16 * sa + 4 * G + q4) * RSB + (16 * dt + 4 * p4) * 2);
#pragma unroll
                    for (int dt = 0; dt < 8; ++dt) { w[dt] = mfma16(kt[dt], xb, (f32x4){0.f, 0.f, 0.f, 0.f}); *(LAS s16x4*)(lds + set + KT + (16 * dt + I) * KTRS + (16 * sa + 4 * G) * 2) = kt[dt]; }
#pragma unroll
                    for (int dt = 0; dt < 8; ++dt) *(LAS s16x4*)(lds + set + WSL + (16 * sa + I) * RSB + (16 * dt + 4 * G) * 2) = pack4(w[dt]); }
                LDS_BARRIER();
            }
        }
    }
}

constexpr int N_PHASES = 30;
__global__ void __launch_bounds__(NTHREADS, 2) fwd(Args a0) {
    extern __shared__ __attribute__((aligned(16))) unsigned char smem_raw[];
    LAS unsigned char* lds = (LAS unsigned char*)smem_raw;
    volatile LAS unsigned* xbw = (volatile LAS unsigned*)(lds + LDS_XBW);
    if (TIDX == 0) { xbw[0] = 0u; xbw[1] = 0u; xbw[2] = 0u; xbw[3] = 0u; }
    __syncthreads();
    XcdBarrier bar = xcd_barrier_post((unsigned*)(a0.ws + WS_CTL), xbw);
#ifndef PHMASK
#define PHMASK 0xFFFFFFFFull
#endif
#ifndef DUPMASK
#define DUPMASK 0ull
#endif
#define PH(i, body) do { if (((PHMASK >> (i)) & 1ull) && a0.ph_lo <= (i) && (i) < a0.ph_hi) { __attribute__((address_space(1))) unsigned char* wsp_ = (__attribute__((address_space(1))) unsigned char*)a0.ws; asm volatile("" : "+s"(wsp_)); Args a = a0; a.ws = (unsigned char*)wsp_; const float* xin = a.in[0]; const float* xw = (const float*)(a.ws + WS_X); (void)xin; (void)xw; \
        if ((DUPMASK >> (i)) & 1ull) { body; xcd_barrier(bar); } body; if ((i) + 1 < a0.ph_hi) xcd_barrier(bar); } } while (0)
    PH(0, { phase_prologue(a, lds); __syncthreads(); NORM_PH(0, true)(a, xin, a.in[1], -1); });
    PH(2, { if (NBLK == 256 && BID >= 128) { moe_weight_jobs_part(a, 0, lds, BID - 128, 128); __syncthreads(); }
            phase_gemm_in0(a, lds); });
    PH(3, { phase_rg_conv(a); __syncthreads(); phase_hg1(a, lds); });
    PH(4, { phase_rg_gates(a, lds); __syncthreads(); phase_hg2(a); });
    PH(5, { phase_rg_scan(a, lds); __syncthreads(); phase_hg3(a, lds); });
    PH(9, phase_gemm_out<false>(a, lds, D_, a.ws + WS_WOUT0T, xin));
    PH(11, phase_gemm_router(a, lds, 0));
    PH(12, phase_route(a, 0));
    PH(13, phase_rowmap(a, lds, 0));
    PH(14, phase_moe_up(a, lds, 0));
    PH(15, phase_moe_down(a, lds, 0));
    PH(16, { NORM_PH(1, false)(a, nullptr, a.in[1] + D_, 0); if (NBLK != 256) { __syncthreads(); moe_weight_jobs(a, 1, lds); } });
    PH(18, { if (NBLK == 256 && BID >= 128) { moe_weight_jobs_part(a, 1, lds, BID - 128, 128); __syncthreads(); }
             phase_gemm_in1(a, lds); phase_gemm_in1_tail(a, lds); });
    PH(19, phase_gdn_conv(a));
    PH(20, phase_gdn_chunk(a, lds));
    PH(21, phase_gdn_norm(a));
    PH(22, phase_gemm_out<true>(a, lds, 4096, a.ws + WS_WOUT1T, nullptr));
    PH(24, phase_gemm_router(a, lds, 1));
    PH(25, phase_route(a, 1));
    PH(26, phase_rowmap(a, lds, 1));
    PH(27, phase_moe_up(a, lds, 1));
    PH(28, phase_moe_down(a, lds, 1));
    PH(29, NORM_PH(2, false)(a, nullptr, a.in[3], 1));
#undef PH
}

extern "C" void kernel_launch(void* const* d_in, const int* in_sizes, int n_in, void* d_out, int out_size, void* d_ws, size_t ws_size, hipStream_t stream) {
    static int grid = 0;
    if (grid == 0) {
        if (n_in != 28 || ws_size < WS_END) { fprintf(stderr, "kernel_launch: need 28 inputs and %zu bytes of workspace, got %d / %zu\n", (size_t)WS_END, n_in, ws_size); grid = -1; return; }
        int dev = 0, cus = 0, per_cu = 0;
        if (hipGetDevice(&dev) != hipSuccess || hipDeviceGetAttribute(&cus, hipDeviceAttributeMultiprocessorCount, dev) != hipSuccess) { grid = -1; return; }
        if (hipFuncSetAttribute((const void*)fwd, hipFuncAttributeMaxDynamicSharedMemorySize, LDS_BYTES) != hipSuccess) { fprintf(stderr, "kernel_launch: hipFuncSetAttribute failed\n"); grid = -1; return; }
        if (hipOccupancyMaxActiveBlocksPerMultiprocessor(&per_cu, (const void*)fwd, NTHREADS, LDS_BYTES) != hipSuccess || per_cu < 1) { fprintf(stderr, "kernel_launch: occupancy query says %d\n", per_cu); }
        (void)hipGetLastError();
        grid = cus;
    }
    if (grid < 0) return;
    (void)in_sizes; (void)out_size;
    hipMemsetAsync((char*)d_ws + WS_CTL, 0, CTL_BYTES, stream);
    Args a; memset(&a, 0, sizeof(a));
    for (int i = 0; i < 28; ++i) a.in[i] = (const float*)d_in[i];
    a.out = (float*)d_out; a.ws = (unsigned char*)d_ws;
#if N_LAUNCH_MODE == 1
    a.ph_lo = 0; a.ph_hi = N_PHASES;
    hipLaunchKernelGGL(fwd, dim3(grid), dim3(NTHREADS), LDS_BYTES, stream, a);
#if EXTRA_PH >= 0
    a.ph_lo = EXTRA_PH; a.ph_hi = EXTRA_PH + 1;
    hipLaunchKernelGGL(fwd, dim3(grid), dim3(NTHREADS), LDS_BYTES, stream, a);
#endif
#else
    for (int p = 0; p < N_PHASES; ++p) { a.ph_lo = p; a.ph_hi = p + 1; hipLaunchKernelGGL(fwd, dim3(grid), dim3(NTHREADS), LDS_BYTES, stream, a); }
#endif
}
```

```cpp
#include <hip/hip_runtime.h>
#include <stdint.h>
#include <stdio.h>
#include <string.h>

#ifndef EXTRA_PH
#define EXTRA_PH -1
#endif
#ifndef N_LAUNCH_MODE
#define N_LAUNCH_MODE 1
#endif

#define LAS __attribute__((address_space(3)))
typedef unsigned short bf16_t;
typedef short bf16x8 __attribute__((ext_vector_type(8)));
typedef float f32x4 __attribute__((ext_vector_type(4)));
typedef float f32x2 __attribute__((ext_vector_type(2)));
typedef unsigned u32x4 __attribute__((ext_vector_type(4)));
typedef unsigned u32x2 __attribute__((ext_vector_type(2)));

constexpr int T_ = 16384, D_ = 2048, S_ = 4096, NB_ = 4;
constexpr int N_IN0 = 6144, N_IN1 = 12352, N_IN1P = 12544;
constexpr int NEXP = 64, DEXP = 512, MPAD = 49152;
constexpr int NTHREADS = 512;
constexpr int LDS_MAIN = 131072;
constexpr int LDS_BYTES = 163840;
constexpr int LDS_XBW = LDS_BYTES - 16;

constexpr size_t al256(size_t x) { return (x + 255) & ~(size_t)255; }
constexpr size_t WS_CTL = 0;
constexpr size_t CTL_BYTES = 65536;
constexpr size_t CTL_CNT = 16384;
constexpr size_t WS_LB = WS_CTL + CTL_BYTES;
constexpr size_t WS_TINFO = WS_LB + 4096;
constexpr size_t WS_WIN0T = WS_TINFO + 4096;
constexpr size_t WS_WOUT0T = WS_WIN0T + (size_t)N_IN0 * D_ * 2;
constexpr size_t WS_WIN1T = WS_WOUT0T + (size_t)D_ * D_ * 2;
constexpr size_t WS_WOUT1T = WS_WIN1T + (size_t)N_IN1P * D_ * 2;
constexpr size_t WS_WGATES = WS_WOUT1T + (size_t)D_ * 4096 * 2;
constexpr size_t WS_WRT = WS_WGATES + (size_t)8 * 256 * 256 * 2;
constexpr size_t WS_WG = WS_WRT + (size_t)2 * 256 * D_ * 2;
constexpr size_t WS_WU = WS_WG + (size_t)NEXP * DEXP * D_ * 2;
constexpr size_t WS_WD = WS_WU + (size_t)NEXP * DEXP * D_ * 2;
constexpr size_t WS_X = WS_WD + (size_t)NEXP * DEXP * D_ * 2;
constexpr size_t WS_H = WS_X + (size_t)T_ * D_ * 4;
constexpr size_t WS_PROJ = WS_H + (size_t)T_ * D_ * 2;
constexpr size_t PROJ_BYTES = (size_t)T_ * N_IN1P * 2;
constexpr size_t WS_FLOG = WS_PROJ + (size_t)T_ * N_IN0 * 2;
constexpr size_t WS_XC = WS_FLOG + (size_t)T_ * 1024 * 4;
constexpr size_t WS_ACT = WS_PROJ;
constexpr size_t WS_YMOE = WS_ACT + (size_t)MPAD * DEXP * 2;
constexpr size_t WS_R1 = WS_PROJ + PROJ_BYTES;
constexpr size_t WS_A = WS_R1;
constexpr size_t WS_U = WS_R1 + (size_t)T_ * 1024 * 4;
constexpr size_t WS_QKVC = WS_R1;
constexpr size_t WS_Y = WS_R1 + (size_t)T_ * 8192 * 2;
constexpr size_t WS_O = WS_Y + (size_t)T_ * 4096 * 2;
constexpr size_t WS_TAIL = WS_O + (size_t)T_ * 4096 * 4;
constexpr size_t WS_BG = WS_TAIL + (size_t)T_ * 64 * 4;
constexpr size_t WS_LOGITS = WS_BG + (size_t)T_ * 64 * 4;
constexpr size_t WS_EID = WS_LOGITS + (size_t)T_ * 128 * 4;
constexpr size_t WS_SLOT = WS_EID + (size_t)T_ * 2 * 4;
constexpr size_t WS_GATE = WS_SLOT + (size_t)T_ * 2 * 4;
constexpr size_t WS_POSOF = WS_GATE + (size_t)T_ * 2 * 4;
constexpr size_t WS_ROWMAP = WS_POSOF + (size_t)T_ * 2 * 4;
constexpr size_t WS_H8 = WS_ROWMAP + (size_t)MPAD * 4;
constexpr size_t WS_RSP = WS_H8 + (size_t)T_ * D_;
constexpr size_t WS_END = WS_RSP + (size_t)T_ * 32 * 4;
static_assert(WS_YMOE + (size_t)MPAD * D_ * 2 <= WS_R1, "moe overlay");
static_assert(WS_XC + (size_t)T_ * 1024 * 2 <= WS_R1, "layer0 overlay");

struct Args {
    const float* in[28];
    float* out;
    unsigned char* ws;
    int ph_lo, ph_hi;
};

__device__ __forceinline__ int tidx_() { int t = (int)threadIdx.x; asm volatile("" : "+v"(t)); return t; }
#define TIDX tidx_()
typedef __bf16 bf16x2n __attribute__((ext_vector_type(2)));
__device__ __forceinline__ unsigned cvt_pk_bf16(float lo, float hi) { const f32x2 v = {lo, hi}; return __builtin_bit_cast(unsigned, __builtin_convertvector(v, bf16x2n)); }
__device__ __forceinline__ unsigned pk_fp8x4(float a, float b, float c, float d) { int v = __builtin_amdgcn_cvt_pk_fp8_f32(a, b, 0, false); v = __builtin_amdgcn_cvt_pk_fp8_f32(c, d, v, true); return (unsigned)v; }
constexpr float W8_SCALE = 64.0f, ACT8_SCALE = 8.0f;
__device__ __forceinline__ bf16_t f2bf(float x) { return (bf16_t)(cvt_pk_bf16(x, 0.f) & 0xffffu); }
__device__ __forceinline__ float bf_lo(unsigned w) { return __uint_as_float(w << 16); }
__device__ __forceinline__ float bf_hi(unsigned w) { return __uint_as_float(w & 0xffff0000u); }
__device__ __forceinline__ float bf1(bf16_t v) { return __uint_as_float(((unsigned)v) << 16); }
__device__ __forceinline__ float sigmoidf_(float x) { return __builtin_amdgcn_rcpf(1.0f + __expf(-x)); }
__device__ __forceinline__ float siluf_(float x) { return x * __builtin_amdgcn_rcpf(1.0f + __expf(-x)); }
__device__ __forceinline__ float softplusf_(float x) { return x > 20.f ? x : log1pf(__expf(x)); }
__device__ __forceinline__ float gelu_tanh(float x) { const float u = 0.7978845608028654f * (x + 0.044715f * x * x * x); return x * __builtin_amdgcn_rcpf(1.0f + __expf(-2.0f * u)); }
template <int CTRL> __device__ __forceinline__ float dpp_f(float v) { return __builtin_bit_cast(float, __builtin_amdgcn_update_dpp(0, __builtin_bit_cast(int, v), CTRL, 0xf, 0xf, false)); }
__device__ __forceinline__ float row16_sum(float s) { s += dpp_f<0x140>(s); s += dpp_f<0x141>(s); s += dpp_f<0xB1>(s); s += dpp_f<0x4E>(s); return s; }
__device__ __forceinline__ float wave_sum(float v) { v = row16_sum(v); v += __shfl_xor(v, 16); v += __shfl_xor(v, 32); return v; }

#define LDS_BARRIER() do { asm volatile("s_waitcnt lgkmcnt(0)" ::: "memory"); __builtin_amdgcn_s_barrier(); asm volatile("" ::: "memory"); } while (0)
#define XB_TMO      128
#define XB_XCNT(j)  (256  + 64 * (j))
#define XB_XSUB(j)  (1280 + 64 * (j))
#define XB_XGEN(j)  (2304 + 64 * (j))
#define XB_TOP      3328
#define XB_TOPGEN   3392
#define XCD_BAR_WORDS 3456
#define XB_SPIN_CAP (1u << 18)

__device__ __forceinline__ unsigned xb_ld(unsigned* p)              { return __hip_atomic_load(p, __ATOMIC_RELAXED, __HIP_MEMORY_SCOPE_AGENT); }
__device__ __forceinline__ unsigned xb_add(unsigned* p, unsigned v) { return __hip_atomic_fetch_add(p, v, __ATOMIC_RELAXED, __HIP_MEMORY_SCOPE_AGENT); }
__device__ __forceinline__ unsigned xb_xcc_id() { return (unsigned)__builtin_amdgcn_s_getreg((3 << 11) | 20) & 0xFu; }
#define XB_SPIN(cond, bar) do { unsigned _sp = 0; while (cond) { __builtin_amdgcn_s_sleep(1); \
    if ((++_sp & 255u) == 0u) { if (xb_ld(&(bar)[XB_TMO])) break; if (_sp > XB_SPIN_CAP) { atomicAdd(&(bar)[XB_TMO], 1u); break; } } } } while (0)

struct XcdBarrier { unsigned* bar; unsigned x; volatile LAS unsigned* st; };

__device__ __forceinline__ XcdBarrier xcd_barrier_post(unsigned* bar, volatile LAS unsigned* st) {
    XcdBarrier b; b.bar = bar; b.x = xb_xcc_id(); b.st = st;
    if (TIDX == 0) (void)xb_add(&bar[XB_XCNT(b.x)], 1u);
    return b;
}
__device__ __forceinline__ void xcd_barrier_complete(unsigned* bar, unsigned x, unsigned& nloc, unsigned& nx) {
    const unsigned G = gridDim.x * gridDim.y * gridDim.z;
    unsigned sum, cnt, mine, sp = 0u;
    for (;;) {
        sum = 0u; cnt = 0u; mine = 0u;
#pragma unroll
        for (unsigned j = 0; j < 16; ++j) { const unsigned c = xb_ld(&bar[XB_XCNT(j)]); sum += c; cnt += (c > 0u) ? 1u : 0u; mine = (j == x) ? c : mine; }
        if (sum == G) break;
        __builtin_amdgcn_s_sleep(1);
        if ((++sp & 255u) == 0u) { if (xb_ld(&bar[XB_TMO])) break; if (sp > XB_SPIN_CAP) { atomicAdd(&bar[XB_TMO], 1u); break; } }
    }
    nloc = mine > 0u ? mine : 1u; nx = cnt > 0u ? cnt : 1u;
}
__device__ __forceinline__ void xcd_barrier(const XcdBarrier& b) {
    asm volatile("s_waitcnt vmcnt(0)" ::: "memory");
    __syncthreads();
    if (TIDX == 0) {
        unsigned* bar = b.bar;
        __builtin_amdgcn_s_waitcnt(0);
        unsigned nloc = b.st[0], nx = b.st[1];
        if (nloc == 0u) { xcd_barrier_complete(bar, b.x, nloc, nx); b.st[0] = nloc; b.st[1] = nx; }
        const unsigned old = xb_add(&bar[XB_XSUB(b.x)], 1u);
        const unsigned gen = old / nloc;
        if (old + 1u == (gen + 1u) * nloc) {
            __builtin_amdgcn_fence(__ATOMIC_RELEASE, "agent");
            asm volatile("s_waitcnt vmcnt(0)" ::: "memory");
            const unsigned og = xb_add(&bar[XB_TOP], 1u);
            const unsigned tg = og / nx;
            if (og + 1u == (tg + 1u) * nx) xb_add(&bar[XB_TOPGEN], 1u);
            else XB_SPIN(xb_ld(&bar[XB_TOPGEN]) == tg, bar);
            __builtin_amdgcn_fence(__ATOMIC_ACQUIRE, "agent");
            xb_add(&bar[XB_XGEN(b.x)], 1u);
            asm volatile("s_waitcnt vmcnt(0)" ::: "memory");
        } else {
            XB_SPIN(xb_ld(&bar[XB_XGEN(b.x)]) == gen, bar);
            __builtin_amdgcn_fence(__ATOMIC_ACQUIRE, "agent");
            asm volatile("s_waitcnt vmcnt(0)" ::: "memory");
        }
    }
    __syncthreads();
}

constexpr int BM = 256, BK = 64, HALF = 128, HTB = HALF * BK * 2;
__device__ __forceinline__ int lds_byte(int r, int c) { const int st = (r >> 4) * 2 + (c >> 5), rr = r & 15, cc = c & 31, ob = rr * 64 + cc * 2; return st * 1024 + (ob ^ (((ob >> 9) & 1) << 5)); }
__device__ __forceinline__ void stage_rc(int b, int& R, int& C) { const int st = b / 1024, sb = b % 1024, swz = sb ^ (((sb >> 9) & 1) << 5); R = (st >> 1) * 16 + swz / 64; C = (st & 1) * 32 + (swz % 64) / 2; }
__device__ __forceinline__ int perm32(int rho) { const int n = rho >> 4, i = rho & 15; return 8 * (i >> 2) + 4 * n + (i & 3); }

__device__ __forceinline__ void stage_pos(int tid, int& R0, int& C0) { stage_rc(tid * 16, R0, C0); }
__device__ __forceinline__ int perm_row(int R) { return (R & ~31) + perm32(R & 31); }

#define BID ((int)blockIdx.x)
#define NBLK ((int)gridDim.x)
#define BID_ BID
#define NBLK_ NBLK
typedef f32x4 Acc[2][2][4][2];
struct UnitD { const char* gA; const char* gB; int t0, t1, t2; };

typedef int i32x8 __attribute__((ext_vector_type(8)));
typedef int i32x4 __attribute__((ext_vector_type(4)));
template <bool GATHER, bool FP8, class Src, class Epi>
__device__ __forceinline__ void gemm_stream(LAS unsigned char* lds, const Src& S, const int nt, const Epi& E) {
    const int tid = TIDX, wid = tid >> 6, lane = tid & 63, wr = wid >> 2, wc = wid & 3, fr = lane & 15, fq = lane >> 4;
    const unsigned ldsw = (unsigned)wid * 1024u;
    const int aoff = lds_byte(wr * 64 + fr, fq * 8), boff = lds_byte(wc * 32 + fr, fq * 8);
    const size_t kstep = (size_t)(BK * 2);
#define G_SA(b, h) (((b) * 2 + (h)) * HTB)
#define G_SB(b, h) ((4 + (b) * 2 + (h)) * HTB)
#define G_STAGE(bufoff, gbase, v) do { _Pragma("unroll") for (int _i = 0; _i < 2; ++_i) \
        __builtin_amdgcn_global_load_lds((const unsigned*)((gbase) + (v)[_i]), (LAS unsigned*)(lds + (bufoff) + ldsw + _i * 8192), 16, 0, 0); } while (0)
#define G_LD8(p) __builtin_shufflevector(*(const LAS i32x4*)(p), *(const LAS i32x4*)((p) + 1024), 0, 1, 2, 3, 4, 5, 6, 7)
#define G_LDA(dst, b, h) do { _Pragma("unroll") for (int m = 0; m < 4; ++m) dst[m] = G_LD8(lds + G_SA(b, h) + aoff + m * 2048); } while (0)
#define G_LDB(dst, b, h) do { _Pragma("unroll") for (int n = 0; n < 2; ++n) dst[n] = G_LD8(lds + G_SB(b, h) + boff + n * 2048); } while (0)
#define G_HALF(x, k) __builtin_bit_cast(bf16x8, __builtin_shufflevector((x), (x), 4 * (k), 4 * (k) + 1, 4 * (k) + 2, 4 * (k) + 3))
#define G_MMA(ai, bj, At, Bt) do { __builtin_amdgcn_s_setprio(1); _Pragma("unroll") for (int m = 0; m < 4; ++m) _Pragma("unroll") for (int n = 0; n < 2; ++n) { \
        if (FP8) asm volatile("v_mfma_f32_16x16x128_f8f6f4 %0, %1, %2, %0" : "+v"(acc[ai][bj][m][n]) : "v"(Bt[n]), "v"(At[m]));   \
        else { acc[ai][bj][m][n] = __builtin_amdgcn_mfma_f32_16x16x32_bf16(G_HALF(Bt[n], 0), G_HALF(At[m], 0), acc[ai][bj][m][n], 0, 0, 0); \
               acc[ai][bj][m][n] = __builtin_amdgcn_mfma_f32_16x16x32_bf16(G_HALF(Bt[n], 1), G_HALF(At[m], 1), acc[ai][bj][m][n], 0, 0, 0); } } \
        __builtin_amdgcn_s_setprio(0); } while (0)
#define G_WAIT_V(n) asm volatile("s_waitcnt vmcnt(" #n ")" ::: "memory")
#define G_WAIT_L(n) asm volatile("s_waitcnt lgkmcnt(" #n ")" ::: "memory")
#define G_BAR __builtin_amdgcn_s_barrier()
#define G_SCHED __builtin_amdgcn_sched_barrier(0)
    UnitD cur, nxt; int ui = 0;
    if (!S.next(0, cur)) return;
    unsigned va[2][2], vb[2][2], van[2][2];
    S.vb(vb); S.va(cur, va);
    Acc acc;
#pragma unroll
    for (int a = 0; a < 2; ++a)
#pragma unroll
        for (int b = 0; b < 2; ++b)
#pragma unroll
            for (int m = 0; m < 4; ++m)
#pragma unroll
                for (int n = 0; n < 2; ++n) acc[a][b][m][n] = (f32x4){0.f, 0.f, 0.f, 0.f};
    i32x8 At[4], B0[2], B1[2];
    const char* cA = cur.gA; const char* cB = cur.gB;
    G_WAIT_V(0);
    __syncthreads();
    G_STAGE(G_SB(0, 0), cB, vb[0]); G_STAGE(G_SA(0, 0), cA, va[0]); G_STAGE(G_SB(0, 1), cB, vb[1]); G_STAGE(G_SA(0, 1), cA, va[1]);
    if (wr == 1) G_BAR;
    G_WAIT_V(4); G_BAR;
    G_STAGE(G_SB(1, 0), cB + kstep, vb[0]); G_STAGE(G_SA(1, 0), cA + kstep, va[0]); G_STAGE(G_SB(1, 1), cB + kstep, vb[1]);
    G_WAIT_V(6); G_BAR;
    for (;;) {
        const bool has_next = S.next(ui + 1, nxt);
        const char* nA = has_next ? nxt.gA : cA; const char* nB = has_next ? nxt.gB : cB;
        if (GATHER) { if (has_next) S.va(nxt, van); else { van[0][0] = va[0][0]; van[0][1] = va[0][1]; van[1][0] = va[1][0]; van[1][1] = va[1][1]; } }
#pragma unroll 1
        for (int t = 0; t < nt; t += 2) {
            const bool last = (t == nt - 2);
            const char* a1 = cA + (size_t)(t + 1) * kstep;
            const char* a2 = last ? nA : cA + (size_t)(t + 2) * kstep; const char* b2 = last ? nB : cB + (size_t)(t + 2) * kstep;
            const char* a3 = a2 + kstep; const char* b3 = b2 + kstep;
            unsigned v2[2][2];
#pragma unroll
            for (int hh = 0; hh < 2; ++hh)
#pragma unroll
                for (int i = 0; i < 2; ++i) v2[hh][i] = (GATHER && last) ? van[hh][i] : va[hh][i];
            G_LDB(B0, 0, 0); G_SCHED; G_LDA(At, 0, 0); G_STAGE(G_SA(1, 1), a1, va[1]);
            G_WAIT_L(8); G_BAR; G_WAIT_L(0); G_MMA(0, 0, At, B0); G_BAR; G_SCHED;
            G_LDB(B1, 0, 1); G_STAGE(G_SB(0, 0), b2, vb[0]);
            G_BAR; G_WAIT_L(0); G_MMA(0, 1, At, B1); G_BAR;
            G_LDA(At, 0, 1); G_STAGE(G_SA(0, 0), a2, v2[0]);
            G_BAR; G_WAIT_L(0); G_MMA(1, 0, At, B0); G_BAR; G_SCHED;
            G_STAGE(G_SB(0, 1), b2, vb[1]);
            G_WAIT_V(6); G_BAR; G_MMA(1, 1, At, B1); G_BAR;
            G_LDB(B0, 1, 0); G_SCHED; G_LDA(At, 1, 0); G_STAGE(G_SA(0, 1), a2, v2[1]);
            G_WAIT_L(8); G_BAR; G_WAIT_L(0); G_MMA(0, 0, At, B0); G_BAR; G_SCHED;
            G_LDB(B1, 1, 1); G_STAGE(G_SB(1, 0), b3, vb[0]);
            G_BAR; G_WAIT_L(0); G_MMA(0, 1, At, B1); G_BAR;
            G_LDA(At, 1, 1); G_STAGE(G_SA(1, 0), a3, v2[0]);
            G_BAR; G_WAIT_L(0); G_MMA(1, 0, At, B0); G_BAR; G_SCHED;
            G_STAGE(G_SB(1, 1), b3, vb[1]);
            G_WAIT_V(6); G_BAR; G_MMA(1, 1, At, B1); G_BAR;
        }
        if (FP8) asm volatile("s_nop 15\n\ts_nop 15" ::: "memory");
        { int tz = TIDX; asm volatile("" : "+v"(tz));
          const int wid2 = tz >> 6, lane2 = tz & 63; E(acc, cur, wid2 >> 2, wid2 & 3, lane2 & 15, lane2 >> 4); }
        if (!has_next) break;
#pragma unroll
        for (int a = 0; a < 2; ++a)
#pragma unroll
            for (int b = 0; b < 2; ++b)
#pragma unroll
                for (int m = 0; m < 4; ++m)
#pragma unroll
                    for (int n = 0; n < 2; ++n) acc[a][b][m][n] = (f32x4){0.f, 0.f, 0.f, 0.f};
        cur = nxt; cA = nA; cB = nB; ++ui;
        if (GATHER) { va[0][0] = van[0][0]; va[0][1] = van[0][1]; va[1][0] = van[1][0]; va[1][1] = van[1][1]; }
    }
    G_WAIT_V(0);
    if (wr == 0) G_BAR;
    G_BAR;
#undef G_SA
#undef G_SB
#undef G_STAGE
#undef G_LDA
#undef G_LDB
#undef G_MMA
#undef G_LD8
#undef G_HALF
#undef G_WAIT_V
#undef G_WAIT_L
#undef G_BAR
#undef G_SCHED
}

__device__ __forceinline__ void offs_direct(unsigned (&v)[2][2], int ld, bool perm) {
    int R0, C0; stage_pos(TIDX, R0, C0);
#pragma unroll
    for (int i = 0; i < 2; ++i) { const int R = R0 + 64 * i, Rr = perm ? perm_row(R) : R;
        v[0][i] = (unsigned)(Rr * ld + C0) * 2u; v[1][i] = (unsigned)((Rr + HALF) * ld + C0) * 2u; }
}

struct SrcGrid {
    const char* A; const char* B; size_t astep, bstep; int nM, total, lda, ldb;
    __device__ __forceinline__ bool next(int i, UnitD& u) const { const int id = BID_ + i * NBLK_; if (id >= total) return false; u.t0 = id % nM; u.t1 = id / nM; u.t2 = 0;
        u.gA = A + (size_t)u.t0 * astep; u.gB = B + (size_t)u.t1 * bstep; return true; }
    __device__ __forceinline__ void va(const UnitD&, unsigned (&v)[2][2]) const { offs_direct(v, lda, false); }
    __device__ __forceinline__ void vb(unsigned (&v)[2][2]) const { offs_direct(v, ldb, true); }
};

struct SrcGridSplit {
    const char* A; const char* B; size_t astep, bstep; int nM, total, lda, ldb, na, nb;
    __device__ __forceinline__ bool next(int i, UnitD& u) const { int id;
        if (NBLK_ == 256 && total == 128 * (na + nb)) { if (BID_ < 128) { if (i >= na) return false; id = BID_ + 128 * i; } else { if (i >= nb) return false; id = 128 * na + (BID_ - 128) + 128 * i; } }
        else { id = BID_ + i * NBLK_; if (id >= total) return false; }
        u.t0 = id % nM; u.t1 = id / nM; u.t2 = 0; u.gA = A + (size_t)u.t0 * astep; u.gB = B + (size_t)u.t1 * bstep; return true; }
    __device__ __forceinline__ void va(const UnitD&, unsigned (&v)[2][2]) const { offs_direct(v, lda, false); }
    __device__ __forceinline__ void vb(unsigned (&v)[2][2]) const { offs_direct(v, ldb, true); }
};

__device__ __forceinline__ void store_bf16_tile(const Acc& acc, bf16_t* O, int ld, int wr, int wc, int fr, int fq, const float sc = 1.0f) {
#pragma unroll
    for (int ai = 0; ai < 2; ++ai)
#pragma unroll
        for (int m = 0; m < 4; ++m) { bf16_t* rowp = O + (size_t)(ai * HALF + wr * 64 + m * 16 + fr) * ld + wc * 32 + 8 * fq;
#pragma unroll
            for (int bj = 0; bj < 2; ++bj) { const f32x4 v0 = acc[ai][bj][m][0] * sc, v1 = acc[ai][bj][m][1] * sc;
                u32x4 w; w.x = cvt_pk_bf16(v0[0], v0[1]); w.y = cvt_pk_bf16(v0[2], v0[3]); w.z = cvt_pk_bf16(v1[0], v1[1]); w.w = cvt_pk_bf16(v1[2], v1[3]);
                *(u32x4*)(rowp + bj * HALF) = w; } }
}
__device__ __forceinline__ void store_f32_tile(const Acc& acc, float* O, const float* R, int ld, int ncol, int wr, int wc, int fr, int fq, const float sc = 1.0f) {
#pragma unroll
    for (int ai = 0; ai < 2; ++ai)
#pragma unroll
        for (int m = 0; m < 4; ++m) { const size_t ro = (size_t)(ai * HALF + wr * 64 + m * 16 + fr) * ld;
#pragma unroll
            for (int bj = 0; bj < 2; ++bj)
#pragma unroll
                for (int n = 0; n < 2; ++n) { const int c = bj * HALF + wc * 32 + 8 * fq + 4 * n; if (c >= ncol) continue;
                    f32x4 v = acc[ai][bj][m][n] * sc; if (R) v += *(const f32x4*)(R + ro + c); *(f32x4*)(O + ro + c) = v; } }
}
struct EpiProj {
    bf16_t* O; int ld; float* F; int fld, fp0, fp1, ncol; float sc;
    __device__ __forceinline__ void operator()(const Acc& acc, const UnitD& u, int wr, int wc, int fr, int fq) const {
        if (u.t1 >= fp0 && u.t1 < fp1) store_f32_tile(acc, F + (size_t)u.t0 * BM * fld + (u.t1 - fp0) * BM, nullptr, fld, ncol, wr, wc, fr, fq, sc);
        else store_bf16_tile(acc, O + (size_t)u.t0 * BM * ld + u.t1 * BM, ld, wr, wc, fr, fq, sc);
    }
};
struct EpiResid {
    unsigned char* ws; const float* Rf; float sc;
    __device__ __forceinline__ void row_done(float ss, const UnitD& u, int row, int wc, int fq) const {
        ss += __shfl_xor(ss, 16); ss += __shfl_xor(ss, 32);
        if (fq == 0) ((float*)(ws + WS_RSP))[(size_t)(u.t0 * BM + row) * 32 + u.t1 * 4 + wc] = ss; }
    __device__ __forceinline__ void operator()(const Acc& acc, const UnitD& u, int wr, int wc, int fr, int fq) const {
        const size_t o = (size_t)u.t0 * BM * D_ + u.t1 * BM;
        bf16_t* O = (bf16_t*)(ws + WS_X); const bf16_t* Rb = O;
        if (Rf) {
#pragma unroll
            for (int am = 0; am < 8; ++am) { const int ai = am >> 2, m = am & 3; f32x4 r0[2], r1[2];
                const size_t ro = o + (size_t)(ai * HALF + wr * 64 + m * 16 + fr) * D_ + wc * 32 + 8 * fq; float ss = 0.f;
#pragma unroll
                for (int bj = 0; bj < 2; ++bj) { r0[bj] = *(const f32x4*)(Rf + ro + bj * HALF); r1[bj] = *(const f32x4*)(Rf + ro + bj * HALF + 4); }
#pragma unroll
                for (int bj = 0; bj < 2; ++bj) { const f32x4 v0 = acc[ai][bj][m][0] * sc + r0[bj], v1 = acc[ai][bj][m][1] * sc + r1[bj];
                    u32x4 w; w.x = cvt_pk_bf16(v0[0], v0[1]); w.y = cvt_pk_bf16(v0[2], v0[3]); w.z = cvt_pk_bf16(v1[0], v1[1]); w.w = cvt_pk_bf16(v1[2], v1[3]);
                    *(u32x4*)(O + ro + bj * HALF) = w;
                    ss += v0[0] * v0[0] + v0[1] * v0[1] + v0[2] * v0[2] + v0[3] * v0[3] + v1[0] * v1[0] + v1[1] * v1[1] + v1[2] * v1[2] + v1[3] * v1[3]; }
                row_done(ss, u, ai * HALF + wr * 64 + m * 16 + fr, wc, fq); }
        } else {
#pragma unroll
            for (int am = 0; am < 4; ++am) { const int ai = am >> 1; u32x4 rr[2][2];
#pragma unroll
                for (int mm = 0; mm < 2; ++mm) { const int m = (am & 1) * 2 + mm; const size_t ro = o + (size_t)(ai * HALF + wr * 64 + m * 16 + fr) * D_ + wc * 32 + 8 * fq;
#pragma unroll
                    for (int bj = 0; bj < 2; ++bj) rr[mm][bj] = *(const u32x4*)(Rb + ro + bj * HALF); }
#pragma unroll
                for (int mm = 0; mm < 2; ++mm) { const int m = (am & 1) * 2 + mm; const size_t ro = o + (size_t)(ai * HALF + wr * 64 + m * 16 + fr) * D_ + wc * 32 + 8 * fq; float ss = 0.f;
#pragma unroll
                    for (int bj = 0; bj < 2; ++bj) { f32x4 v0 = acc[ai][bj][m][0] * sc, v1 = acc[ai][bj][m][1] * sc; const u32x4 r = rr[mm][bj];
                        v0[0] += bf_lo(r.x); v0[1] += bf_hi(r.x); v0[2] += bf_lo(r.y); v0[3] += bf_hi(r.y); v1[0] += bf_lo(r.z); v1[1] += bf_hi(r.z); v1[2] += bf_lo(r.w); v1[3] += bf_hi(r.w);
                        u32x4 w; w.x = cvt_pk_bf16(v0[0], v0[1]); w.y = cvt_pk_bf16(v0[2], v0[3]); w.z = cvt_pk_bf16(v1[0], v1[1]); w.w = cvt_pk_bf16(v1[2], v1[3]);
                        *(u32x4*)(O + ro + bj * HALF) = w;
                            ss += v0[0] * v0[0] + v0[1] * v0[1] + v0[2] * v0[2] + v0[3] * v0[3] + v1[0] * v1[0] + v1[1] * v1[1] + v1[2] * v1[2] + v1[3] * v1[3]; }
                    row_done(ss, u, ai * HALF + wr * 64 + m * 16 + fr, wc, fq); } }
        }
    }
};
struct EpiLogits {
    float* O;
    __device__ __forceinline__ void operator()(const Acc& acc, const UnitD& u, int wr, int wc, int fr, int fq) const { store_f32_tile(acc, O + (size_t)u.t0 * BM * 128, nullptr, 128, 128, wr, wc, fr, fq); }
};
struct EpiSwiGLU {
    unsigned char* O;
    __device__ __forceinline__ void operator()(const Acc& acc, const UnitD& u, int wr, int wc, int fr, int fq) const {
        unsigned char* o = O + (size_t)u.t0 * BM * DEXP + u.t1 * 128;
#pragma unroll
        for (int ai = 0; ai < 2; ++ai)
#pragma unroll
            for (int m = 0; m < 4; ++m) { unsigned char* rowp = o + (size_t)(ai * HALF + wr * 64 + m * 16 + fr) * DEXP + wc * 32 + 8 * fq;
                float r[8];
#pragma unroll
                for (int n = 0; n < 2; ++n)
#pragma unroll
                    for (int j = 0; j < 4; ++j) r[n * 4 + j] = (ACT8_SCALE / W8_SCALE) * siluf_(acc[ai][0][m][n][j] * (1.0f / W8_SCALE)) * acc[ai][1][m][n][j];
                u32x2 w; w.x = pk_fp8x4(r[0], r[1], r[2], r[3]); w.y = pk_fp8x4(r[4], r[5], r[6], r[7]);
                *(u32x2*)rowp = w; }
    }
};
struct EpiDown {
    unsigned char* O;
    __device__ __forceinline__ void operator()(const Acc& acc, const UnitD& u, int wr, int wc, int fr, int fq) const {
        unsigned char* o = O + (size_t)u.t0 * BM * D_ + u.t1 * BM; const float sc = 1.0f / (W8_SCALE * ACT8_SCALE);
#pragma unroll
        for (int ai = 0; ai < 2; ++ai)
#pragma unroll
            for (int m = 0; m < 4; ++m) { unsigned char* rowp = o + (size_t)(ai * HALF + wr * 64 + m * 16 + fr) * D_ + wc * 32 + 8 * fq;
#pragma unroll
                for (int bj = 0; bj < 2; ++bj) { const f32x4 v0 = acc[ai][bj][m][0] * sc, v1 = acc[ai][bj][m][1] * sc;
                    u32x2 w; w.x = pk_fp8x4(v0[0], v0[1], v0[2], v0[3]); w.y = pk_fp8x4(v1[0], v1[1], v1[2], v1[3]); *(u32x2*)(rowp + bj * HALF) = w; } }
    }
};
__device__ __forceinline__ unsigned rg_idx(unsigned tok, int c) { return ((((tok >> 12) * 64u + (unsigned)(c >> 4)) * (unsigned)S_ + (tok & (unsigned)(S_ - 1))) << 4) + (unsigned)(c & 15); }
struct EpiRgGates {
    bf16_t* LAo; bf16_t* Uo; const bf16_t* xc;
    const float* ba; const float* bx; const float* lam;
    __device__ __forceinline__ void operator()(const Acc& acc, const UnitD& u, int wr, int wc, int fr, int fq) const {
#pragma unroll
        for (int n = 0; n < 2; ++n) { const int c = u.t1 * 128 + wc * 32 + 8 * fq + 4 * n;
            u32x2 xq[2][4];
#pragma unroll
            for (int ai = 0; ai < 2; ++ai)
#pragma unroll
                for (int m = 0; m < 4; ++m) xq[ai][m] = *(const u32x2*)(xc + ((unsigned)(u.t0 * BM + ai * HALF + wr * 64 + m * 16 + fr) * 1024u + (unsigned)c));
            const f32x4 vba = *(const f32x4*)(ba + c), vbx = *(const f32x4*)(bx + c), vl = *(const f32x4*)(lam + c);
            f32x4 c8; for (int j = 0; j < 4; ++j) c8[j] = -8.0f * softplusf_(-vl[j]);
#pragma unroll
            for (int ai = 0; ai < 2; ++ai)
#pragma unroll
                for (int m = 0; m < 4; ++m) { const unsigned tok = (unsigned)(u.t0 * BM + ai * HALF + wr * 64 + m * 16 + fr);
                    const u32x2 xw = xq[ai][m]; const float xv[4] = {bf_lo(xw.x), bf_hi(xw.x), bf_lo(xw.y), bf_hi(xw.y)};
                    f32x4 lv, uv;
#pragma unroll
                    for (int j = 0; j < 4; ++j) { const float r = sigmoidf_(acc[ai][0][m][n][j] + vba[j]), ig = sigmoidf_(acc[ai][1][m][n][j] + vbx[j]);
                        const float la = c8[j] * r, av = __expf(la); lv[j] = la; uv[j] = __builtin_amdgcn_sqrtf(fmaxf(0.f, 1.0f - av * av)) * ig * xv[j]; }
                    const unsigned o = rg_idx(tok, c);
                    u32x2 w0; w0.x = cvt_pk_bf16(lv[0], lv[1]); w0.y = cvt_pk_bf16(lv[2], lv[3]); *(u32x2*)(LAo + o) = w0;
                    u32x2 w1; w1.x = cvt_pk_bf16(uv[0], uv[1]); w1.y = cvt_pk_bf16(uv[2], uv[3]); *(u32x2*)(Uo + o) = w1; } }
    }
};


__device__ __forceinline__ void transpose_job8(const float* src, unsigned char* dst, int K, int N, int ldd, size_t sb, size_t db, int nbatch, LAS unsigned char* lds) {
    const int tid = TIDX, tk = K / 128, tn = N / 64, per = tk * tn, total = per * nbatch;
    const int rr0 = tid >> 4, c4 = (tid & 15) * 4, n = tid >> 3, kg = (tid & 7) * 16;
    f32x4 va[4], vb[4];
#define T8_LD(v, t) { const int u_ = (t), ub_ = u_ / per, ur_ = u_ % per, uik_ = ur_ / tn, uin_ = ur_ % tn; const float* usp_ = src + (size_t)ub_ * sb + (size_t)(uik_ * 128 + rr0) * N + uin_ * 64 + c4; \
        _Pragma("unroll") for (int i = 0; i < 4; ++i) v[i] = *(const f32x4*)(usp_ + (size_t)(i * 32) * N); }
#define T8_ST(v, t, buf) { const int t_ = (t), b_ = t_ / per, r_ = t_ % per, ik_ = r_ / tn, in_ = r_ % tn; LAS float* tile = (LAS float*)(lds + (buf) * (128 * 65 * 4)); \
        _Pragma("unroll") for (int i = 0; i < 4; ++i) { const int rr = rr0 + i * 32; tile[rr * 65 + c4 + 0] = v[i][0]; tile[rr * 65 + c4 + 1] = v[i][1]; tile[rr * 65 + c4 + 2] = v[i][2]; tile[rr * 65 + c4 + 3] = v[i][3]; } \
        if (t_ + 2 * NBLK < total) T8_LD(v, t_ + 2 * NBLK) \
        LDS_BARRIER(); \
        float f[16]; \
        _Pragma("unroll") for (int j = 0; j < 16; ++j) f[j] = tile[(kg + j) * 65 + n] * W8_SCALE; \
        u32x4 w; w.x = pk_fp8x4(f[0], f[1], f[2], f[3]); w.y = pk_fp8x4(f[4], f[5], f[6], f[7]); w.z = pk_fp8x4(f[8], f[9], f[10], f[11]); w.w = pk_fp8x4(f[12], f[13], f[14], f[15]); \
        *(u32x4*)(dst + (size_t)b_ * db + (size_t)(in_ * 64 + n) * ldd + ik_ * 128 + kg) = w; }
    int t = BID;
    if (t < total) T8_LD(va, t)
    if (t + NBLK < total) T8_LD(vb, t + NBLK)
    for (; t < total; t += 2 * NBLK) {
        T8_ST(va, t, 0)
        if (t + NBLK < total) T8_ST(vb, t + NBLK, 1)
    }
#undef T8_LD
#undef T8_ST
    LDS_BARRIER();
}
__device__ __forceinline__ void transpose_job8_deep(const float* src, unsigned char* dst, int K, int N, int ldd, size_t sb, size_t db, int nbatch, LAS unsigned char* lds, int first, int stride) {
    const int tid = TIDX, tk = K / 128, tn = N / 64, per = tk * tn, total = per * nbatch;
    const int rr0 = tid >> 4, c4 = (tid & 15) * 4, n = tid >> 3, kg = (tid & 7) * 16;
    f32x4 va[4], vb[4], vc[4], vd[4];
#define T8_LD(v, t) { const int u_ = (t), ub_ = u_ / per, ur_ = u_ % per, uik_ = ur_ / tn, uin_ = ur_ % tn; const float* usp_ = src + (size_t)ub_ * sb + (size_t)(uik_ * 128 + rr0) * N + uin_ * 64 + c4; \
        _Pragma("unroll") for (int i = 0; i < 4; ++i) v[i] = *(const f32x4*)(usp_ + (size_t)(i * 32) * N); }
#define T8_ST(v, t, buf) { const int t_ = (t), b_ = t_ / per, r_ = t_ % per, ik_ = r_ / tn, in_ = r_ % tn; LAS float* tile = (LAS float*)(lds + (buf) * (128 * 65 * 4)); \
        _Pragma("unroll") for (int i = 0; i < 4; ++i) { const int rr = rr0 + i * 32; tile[rr * 65 + c4 + 0] = v[i][0]; tile[rr * 65 + c4 + 1] = v[i][1]; tile[rr * 65 + c4 + 2] = v[i][2]; tile[rr * 65 + c4 + 3] = v[i][3]; } \
        if (t_ + 4 * stride < total) T8_LD(v, t_ + 4 * stride) \
        LDS_BARRIER(); \
        float f[16]; \
        _Pragma("unroll") for (int j = 0; j < 16; ++j) f[j] = tile[(kg + j) * 65 + n] * W8_SCALE; \
        u32x4 w; w.x = pk_fp8x4(f[0], f[1], f[2], f[3]); w.y = pk_fp8x4(f[4], f[5], f[6], f[7]); w.z = pk_fp8x4(f[8], f[9], f[10], f[11]); w.w = pk_fp8x4(f[12], f[13], f[14], f[15]); \
        *(u32x4*)(dst + (size_t)b_ * db + (size_t)(in_ * 64 + n) * ldd + ik_ * 128 + kg) = w; }
    int t = first;
    if (t < total) T8_LD(va, t)
    if (t + stride < total) T8_LD(vb, t + stride)
    if (t + 2 * stride < total) T8_LD(vc, t + 2 * stride)
    if (t + 3 * stride < total) T8_LD(vd, t + 3 * stride)
    for (; t < total; t += 4 * stride) {
        T8_ST(va, t, 0)
        if (t + stride < total) T8_ST(vb, t + stride, 1)
        if (t + 2 * stride < total) T8_ST(vc, t + 2 * stride, 0)
        if (t + 3 * stride < total) T8_ST(vd, t + 3 * stride, 1)
    }
#undef T8_LD
#undef T8_ST
    LDS_BARRIER();
}
__device__ __forceinline__ void transpose_job(const float* src, bf16_t* dst, int K, int N, int ldd, size_t sb, size_t db, int dalt, int nbatch, LAS unsigned char* lds) {
    const int tid = TIDX, tk = K / 64, tn = N / 64, per = tk * tn, total = per * nbatch;
    const int rr0 = tid >> 4, c4 = (tid & 15) * 4, n = tid >> 3, kg = (tid & 7) * 8;
    f32x4 va[2], vb[2];
#define T16_LD(v, t) { const int u_ = (t), ub_ = u_ / per, ur_ = u_ % per, uik_ = ur_ / tn, uin_ = ur_ % tn; const float* usp_ = src + (size_t)ub_ * sb + (size_t)(uik_ * 64 + rr0) * N + uin_ * 64 + c4; \
        _Pragma("unroll") for (int i = 0; i < 2; ++i) v[i] = *(const f32x4*)(usp_ + (size_t)(i * 32) * N); }
#define T16_ST(v, t, buf) { const int t_ = (t), b_ = t_ / per, r_ = t_ % per, ik_ = r_ / tn, in_ = r_ % tn; LAS float* tile = (LAS float*)(lds + (buf) * (64 * 65 * 4)); \
        _Pragma("unroll") for (int i = 0; i < 2; ++i) { const int rr = rr0 + i * 32; tile[rr * 65 + c4 + 0] = v[i][0]; tile[rr * 65 + c4 + 1] = v[i][1]; tile[rr * 65 + c4 + 2] = v[i][2]; tile[rr * 65 + c4 + 3] = v[i][3]; } \
        if (t_ + 2 * NBLK < total) T16_LD(v, t_ + 2 * NBLK) \
        LDS_BARRIER(); \
        float f[8]; \
        _Pragma("unroll") for (int j = 0; j < 8; ++j) f[j] = tile[(kg + j) * 65 + n]; \
        u32x4 w; w.x = cvt_pk_bf16(f[0], f[1]); w.y = cvt_pk_bf16(f[2], f[3]); w.z = cvt_pk_bf16(f[4], f[5]); w.w = cvt_pk_bf16(f[6], f[7]); \
        *(u32x4*)(dst + (size_t)b_ * db + (size_t)(b_ & 1) * dalt + (size_t)(in_ * 64 + n) * ldd + ik_ * 64 + kg) = w; }
    int t = BID;
    if (t < total) T16_LD(va, t)
    if (t + NBLK < total) T16_LD(vb, t + NBLK)
    for (; t < total; t += 2 * NBLK) {
        T16_ST(va, t, 0)
        if (t + NBLK < total) T16_ST(vb, t + NBLK, 1)
    }
#undef T16_LD
#undef T16_ST
    LDS_BARRIER();
}

__device__ __forceinline__ void moe_weight_jobs(const Args& a, int layer, LAS unsigned char* lds) {
    const size_t lo = (size_t)layer * NEXP * D_ * DEXP;
    transpose_job8(a.in[25] + lo, a.ws + WS_WG, D_, DEXP, D_, (size_t)D_ * DEXP, (size_t)DEXP * D_, NEXP, lds);
    transpose_job8(a.in[26] + lo, a.ws + WS_WU, D_, DEXP, D_, (size_t)D_ * DEXP, (size_t)DEXP * D_, NEXP, lds);
    transpose_job8(a.in[27] + lo, a.ws + WS_WD, DEXP, D_, DEXP, (size_t)D_ * DEXP, (size_t)DEXP * D_, NEXP, lds);
}

__device__ __forceinline__ void moe_weight_jobs_part(const Args& a, int layer, LAS unsigned char* lds, int first, int stride) {
    const size_t lo = (size_t)layer * NEXP * D_ * DEXP;
    transpose_job8_deep(a.in[25] + lo, a.ws + WS_WG, D_, DEXP, D_, (size_t)D_ * DEXP, (size_t)DEXP * D_, NEXP, lds, first, stride);
    transpose_job8_deep(a.in[26] + lo, a.ws + WS_WU, D_, DEXP, D_, (size_t)D_ * DEXP, (size_t)DEXP * D_, NEXP, lds, first, stride);
    transpose_job8_deep(a.in[27] + lo, a.ws + WS_WD, DEXP, D_, DEXP, (size_t)D_ * DEXP, (size_t)DEXP * D_, NEXP, lds, first, stride);
}

__device__ __forceinline__ void phase_prologue(const Args& a, LAS unsigned char* lds) {
    const int gtid = BID * NTHREADS + TIDX, gsz = NBLK * NTHREADS;
    for (int i = gtid; i < 1024; i += gsz) { const float l0 = a.in[12][i], l1 = a.in[12][1024 + i], mx = fmaxf(l0, l1), e0 = __expf(l0 - mx), e1 = __expf(l1 - mx);
        ((float*)(a.ws + WS_LB))[i] = e0 / (e0 + e1); }
    for (int it = gtid; it < 2 * 256 * 256; it += gsz) { const int l = it >> 16, n = (it >> 8) & 255, k8 = (it & 255) * 8; float f[8];
#pragma unroll
        for (int j = 0; j < 8; ++j) { const int k = k8 + j; f[j] = a.in[2][(size_t)l * D_ + k] * (n < 8 ? a.in[21][((size_t)l * D_ + k) * 8 + n] : (n < 72 ? a.in[23][((size_t)l * D_ + k) * 64 + (n - 8)] : 0.f)); }
        u32x4 w; w.x = cvt_pk_bf16(f[0], f[1]); w.y = cvt_pk_bf16(f[2], f[3]); w.z = cvt_pk_bf16(f[4], f[5]); w.w = cvt_pk_bf16(f[6], f[7]);
        *(u32x4*)((bf16_t*)(a.ws + WS_WRT) + ((size_t)l * 256 + n) * D_ + k8) = w; }
    for (int it = gtid; it < 192 * 128; it += gsz) *(u32x4*)(a.ws + WS_WIN1T + (size_t)N_IN1 * D_ + (size_t)it * 16) = (u32x4){0u, 0u, 0u, 0u};
    transpose_job(a.in[4], (bf16_t*)(a.ws + WS_WIN0T), D_, N_IN0, D_, 0, 0, 0, 1, lds);
    transpose_job(a.in[14], (bf16_t*)(a.ws + WS_WOUT0T), D_, D_, D_, 0, 0, 0, 1, lds);
    transpose_job8(a.in[15], a.ws + WS_WIN1T, D_, N_IN1, D_, 0, 0, 1, lds);
    transpose_job8(a.in[20], a.ws + WS_WOUT1T, 4096, D_, 4096, 0, 0, 1, lds);
    transpose_job(a.in[7], (bf16_t*)(a.ws + WS_WGATES), 128, 128, 128, 128 * 128, 256 * 128, 0, 8, lds);
    transpose_job(a.in[9], (bf16_t*)(a.ws + WS_WGATES) + 128 * 128, 128, 128, 128, 128 * 128, 256 * 128, 0, 8, lds);
    if (NBLK != 256) moe_weight_jobs(a, 0, lds);
}

#define NORM_PH(M, F) phase_norm<M, F>
template <int MODE, bool F32>
__device__ __forceinline__ void phase_norm(const Args& a, const float* src, const float* gain, int layer) {
    const int wid = TIDX >> 6, lane = TIDX & 63;
    bf16_t* xw = (bf16_t*)(a.ws + WS_X); bf16_t* hw = (bf16_t*)(a.ws + WS_H);
    const unsigned char* ym = a.ws + WS_YMOE; const int* posof = (const int*)(a.ws + WS_POSOF); const float* gate = (const float*)(a.ws + WS_GATE);
    const int stride = NBLK * 16;
    f32x4 rf[2][8]; u32x2 rb[2][8]; int pp[2][2] = {{0, 0}, {0, 0}}; float pg[2][2] = {{0.f, 0.f}, {0.f, 0.f}};
#define NORM_LD(r) { _Pragma("unroll") for (int u = 0; u < 2; ++u) { _Pragma("unroll") for (int i = 0; i < 8; ++i) { \
            if (F32) rf[u][i] = *(const f32x4*)(src + (size_t)((r) + u) * D_ + (i * 64 + lane) * 4); else rb[u][i] = *(const u32x2*)(xw + (size_t)((r) + u) * D_ + (i * 64 + lane) * 4); } \
            if (MODE >= 1) { pp[u][0] = posof[((r) + u) * 2]; pp[u][1] = posof[((r) + u) * 2 + 1]; pg[u][0] = gate[((r) + u) * 2]; pg[u][1] = gate[((r) + u) * 2 + 1]; } } }
    int row = (BID * 8 + wid) * 2;
    if (row < T_) NORM_LD(row)
    for (; row < T_; row += stride) {
        f32x4 v[2][8]; int p[2][2]; float g[2][2];
#pragma unroll
        for (int u = 0; u < 2; ++u) { p[u][0] = pp[u][0]; p[u][1] = pp[u][1]; g[u][0] = pg[u][0]; g[u][1] = pg[u][1];
#pragma unroll
            for (int i = 0; i < 8; ++i) v[u][i] = F32 ? rf[u][i] : (f32x4){bf_lo(rb[u][i].x), bf_hi(rb[u][i].x), bf_lo(rb[u][i].y), bf_hi(rb[u][i].y)}; }
        if (row + stride < T_) NORM_LD(row + stride)
        if (MODE >= 1) {
            int y[2][8][2];
#pragma unroll
            for (int u = 0; u < 2; ++u) {
#pragma unroll
                for (int i = 0; i < 8; ++i) { const int c = (i * 64 + lane) * 4; y[u][i][0] = *(const int*)(ym + (size_t)p[u][0] * D_ + c); y[u][i][1] = *(const int*)(ym + (size_t)p[u][1] * D_ + c); } }
#pragma unroll
            for (int u = 0; u < 2; ++u) { const float g0 = g[u][0], g1 = g[u][1];
#pragma unroll
                for (int i = 0; i < 8; ++i) { const int y0 = y[u][i][0], y1 = y[u][i][1];
                    const f32x2 a0 = __builtin_amdgcn_cvt_pk_f32_fp8(y0, false), a1 = __builtin_amdgcn_cvt_pk_f32_fp8(y0, true), b0 = __builtin_amdgcn_cvt_pk_f32_fp8(y1, false), b1 = __builtin_amdgcn_cvt_pk_f32_fp8(y1, true);
                    v[u][i][0] += g0 * a0[0] + g1 * b0[0]; v[u][i][1] += g0 * a0[1] + g1 * b0[1]; v[u][i][2] += g0 * a1[0] + g1 * b1[0]; v[u][i][3] += g0 * a1[1] + g1 * b1[1]; }
                if (MODE == 1) {
#pragma unroll
                    for (int i = 0; i < 8; ++i) { u32x2 w; w.x = cvt_pk_bf16(v[u][i][0], v[u][i][1]); w.y = cvt_pk_bf16(v[u][i][2], v[u][i][3]); *(u32x2*)(xw + (size_t)(row + u) * D_ + (i * 64 + lane) * 4) = w; } } }
        }
#pragma unroll
        for (int u = 0; u < 2; ++u) {
            float ss = 0.f;
#pragma unroll
            for (int i = 0; i < 8; ++i) ss += v[u][i][0] * v[u][i][0] + v[u][i][1] * v[u][i][1] + v[u][i][2] * v[u][i][2] + v[u][i][3] * v[u][i][3];
            ss = wave_sum(ss);
            const float rstd = rsqrtf(ss * (1.0f / D_) + 1e-6f);
#pragma unroll
            for (int i = 0; i < 8; ++i) { const int c = (i * 64 + lane) * 4; const f32x4 gn = *(const f32x4*)(gain + c);
                const f32x4 o = v[u][i] * rstd * gn;
                if (MODE == 2) *(f32x4*)(a.out + (size_t)(row + u) * D_ + c) = o;
                else { if (MODE != 1) { u32x2 w; w.x = cvt_pk_bf16(o[0], o[1]); w.y = cvt_pk_bf16(o[2], o[3]); *(u32x2*)(hw + (size_t)(row + u) * D_ + c) = w; }
                       if (layer >= 0) *(unsigned*)(a.ws + WS_H8 + (size_t)(row + u) * D_ + c) = pk_fp8x4(o[0], o[1], o[2], o[3]); } } }
    }
#undef NORM_LD
    (void)layer;
}

__device__ __forceinline__ void phase_gemm_in0(const Args& a, LAS unsigned char* lds) {
    SrcGridSplit S{(const char*)(a.ws + WS_H), (const char*)(a.ws + WS_WIN0T), (size_t)BM * D_ * 2, (size_t)BM * D_ * 2, 64, 64 * 24, D_, D_, 8, 4};
    EpiProj E{(bf16_t*)(a.ws + WS_PROJ), N_IN0, (float*)(a.ws + WS_FLOG), 1024, 12, 16, 256, 1.0f};
    gemm_stream<false, false>(lds, S, D_ / BK, E);
}

__device__ __forceinline__ void phase_rg_conv(const Args& a) {
    const bf16_t* p0 = (const bf16_t*)(a.ws + WS_PROJ); bf16_t* xc = (bf16_t*)(a.ws + WS_XC);
    const float* cw = a.in[5]; const float* cb = a.in[6];
    for (int it = BID * NTHREADS + TIDX; it < 128 * (T_ / 16); it += NBLK * NTHREADS) { const int c = (it & 127) * 8; const size_t t0 = (size_t)(it >> 7) * 16;
        float w[4][8], bias[8];
#pragma unroll
        for (int k = 0; k < 4; ++k) { const f32x4 w0 = *(const f32x4*)(cw + k * 1024 + c), w1 = *(const f32x4*)(cw + k * 1024 + c + 4);
            w[k][0] = w0[0]; w[k][1] = w0[1]; w[k][2] = w0[2]; w[k][3] = w0[3]; w[k][4] = w1[0]; w[k][5] = w1[1]; w[k][6] = w1[2]; w[k][7] = w1[3]; }
        { const f32x4 b0 = *(const f32x4*)(cb + c), b1 = *(const f32x4*)(cb + c + 4); bias[0] = b0[0]; bias[1] = b0[1]; bias[2] = b0[2]; bias[3] = b0[3]; bias[4] = b1[0]; bias[5] = b1[1]; bias[6] = b1[2]; bias[7] = b1[3]; }
        u32x4 x0 = (u32x4){0u, 0u, 0u, 0u}, x1 = x0, x2 = x0;
        if ((t0 & (S_ - 1)) != 0) { x0 = *(const u32x4*)(p0 + (t0 - 3) * N_IN0 + c); x1 = *(const u32x4*)(p0 + (t0 - 2) * N_IN0 + c); x2 = *(const u32x4*)(p0 + (t0 - 1) * N_IN0 + c); }
        u32x4 xr[16];
#pragma unroll
        for (int r = 0; r < 16; ++r) xr[r] = *(const u32x4*)(p0 + (t0 + r) * N_IN0 + c);
#pragma unroll
        for (int r = 0; r < 16; ++r) { const u32x4 x3 = xr[r];
            float acc[8];
#define TAPS(j, f, m) (bias[j] + w[0][j] * f(x0.m) + w[1][j] * f(x1.m) + w[2][j] * f(x2.m) + w[3][j] * f(x3.m))
            acc[0] = TAPS(0, bf_lo, x); acc[1] = TAPS(1, bf_hi, x); acc[2] = TAPS(2, bf_lo, y); acc[3] = TAPS(3, bf_hi, y);
            acc[4] = TAPS(4, bf_lo, z); acc[5] = TAPS(5, bf_hi, z); acc[6] = TAPS(6, bf_lo, w); acc[7] = TAPS(7, bf_hi, w);
#undef TAPS
            u32x4 o; o.x = cvt_pk_bf16(acc[0], acc[1]); o.y = cvt_pk_bf16(acc[2], acc[3]); o.z = cvt_pk_bf16(acc[4], acc[5]); o.w = cvt_pk_bf16(acc[6], acc[7]);
            *(u32x4*)(xc + (t0 + r) * 1024 + c) = o;
            x0 = x1; x1 = x2; x2 = x3; } }
}

struct SrcRgGates {
    const char* xc; const char* w; int total;
    __device__ __forceinline__ bool next(int i, UnitD& u) const { const int id = BID + i * NBLK; if (id >= total) return false; u.t0 = id & 63; u.t1 = id >> 6; u.t2 = 0;
        u.gA = xc + ((size_t)u.t0 * BM * 1024 + u.t1 * 128) * 2; u.gB = w + (size_t)u.t1 * 256 * 128 * 2; return true; }
    __device__ __forceinline__ void va(const UnitD&, unsigned (&v)[2][2]) const { offs_direct(v, 1024, false); }
    __device__ __forceinline__ void vb(unsigned (&v)[2][2]) const { offs_direct(v, 128, true); }
};
__device__ __forceinline__ void phase_rg_gates(const Args& a, LAS unsigned char* lds) {
    SrcRgGates S{(const char*)(a.ws + WS_XC), (const char*)(a.ws + WS_WGATES), 64 * 8};
    EpiRgGates E{(bf16_t*)(a.ws + WS_A), (bf16_t*)(a.ws + WS_U), (const bf16_t*)(a.ws + WS_XC), a.in[8], a.in[10], a.in[11]};
    int nt = 2; asm volatile("" : "+s"(nt));
    gemm_stream<false, false>(lds, S, nt, E);
}

__device__ __forceinline__ void phase_rg_scan(const Args& a, LAS unsigned char* lds) {
    const bf16_t* LA = (const bf16_t*)(a.ws + WS_A); const bf16_t* U = (const bf16_t*)(a.ws + WS_U);
    const bf16_t* p0 = (const bf16_t*)(a.ws + WS_PROJ); bf16_t* Y = (bf16_t*)(a.ws + WS_Y);
    LAS float* sP = (LAS float*)lds; LAS float* sH = sP + 4096; LAS float* gP = sH + 4096; LAS float* gH = gP + 512; LAS float* gC = gH + 512;
    const int tid = TIDX, seg = tid >> 1, c8 = (tid & 1) * 8;
    for (int blk = BID; blk < NB_ * 64; blk += NBLK) { const int b = blk >> 6, c = (blk & 63) * 16 + c8;
        const size_t base = (((size_t)blk * S_ + seg * 16) << 4) + c8;
        float P[8], H[8];
#pragma unroll
        for (int j = 0; j < 8; ++j) { P[j] = 1.f; H[j] = 0.f; }
#pragma unroll 4
        for (int s = 0; s < 16; ++s) { const u32x4 lw = *(const u32x4*)(LA + base + (size_t)s * 16), uw = *(const u32x4*)(U + base + (size_t)s * 16);
            const float la[8] = {bf_lo(lw.x), bf_hi(lw.x), bf_lo(lw.y), bf_hi(lw.y), bf_lo(lw.z), bf_hi(lw.z), bf_lo(lw.w), bf_hi(lw.w)};
            const float uu[8] = {bf_lo(uw.x), bf_hi(uw.x), bf_lo(uw.y), bf_hi(uw.y), bf_lo(uw.z), bf_hi(uw.z), bf_lo(uw.w), bf_hi(uw.w)};
#pragma unroll
            for (int j = 0; j < 8; ++j) { const float av = __expf(la[j]); H[j] = av * H[j] + uu[j]; P[j] *= av; } }
        __syncthreads();
#pragma unroll
        for (int j = 0; j < 8; ++j) { sP[seg * 16 + c8 + j] = P[j]; sH[seg * 16 + c8 + j] = H[j]; }
        __syncthreads();
        { const int ch = tid & 15, grp = tid >> 4; float p = 1.f, h = 0.f;
#pragma unroll
          for (int q = 0; q < 8; ++q) { const int sgi = grp * 8 + q; h = sP[sgi * 16 + ch] * h + sH[sgi * 16 + ch]; p *= sP[sgi * 16 + ch]; }
          gP[grp * 16 + ch] = p; gH[grp * 16 + ch] = h; }
        __syncthreads();
        if (tid < 16) { float carry = 0.f; for (int g = 0; g < 32; ++g) { gC[g * 16 + tid] = carry; carry = gP[g * 16 + tid] * carry + gH[g * 16 + tid]; } }
        __syncthreads();
        { const int ch = tid & 15, grp = tid >> 4; float h = gC[grp * 16 + ch];
#pragma unroll
          for (int q = 0; q < 8; ++q) { const int sgi = grp * 8 + q; const float pin = sP[sgi * 16 + ch], hin = sH[sgi * 16 + ch]; sH[sgi * 16 + ch] = h; h = pin * h + hin; } }
        __syncthreads();
#pragma unroll
        for (int j = 0; j < 8; ++j) H[j] = sH[seg * 16 + c8 + j];
        {
            u32x4 l_a[4], u_a[4], g_a[4];
#define RS_LD(Lv, Uv, Gv, s0) { _Pragma("unroll") for (int j = 0; j < 4; ++j) { const int s_ = (s0) + j; Lv[j] = *(const u32x4*)(LA + base + (size_t)s_ * 16); Uv[j] = *(const u32x4*)(U + base + (size_t)s_ * 16); \
                Gv[j] = *(const u32x4*)(p0 + ((size_t)b * S_ + seg * 16 + s_) * N_IN0 + 1024 + c); } }
            RS_LD(l_a, u_a, g_a, 0)
#pragma unroll
            for (int s0 = 0; s0 < 16; s0 += 4) { u32x4 l_b[4], u_b[4], g_b[4];
#pragma unroll
                for (int j = 0; j < 4; ++j) { l_b[j] = l_a[j]; u_b[j] = u_a[j]; g_b[j] = g_a[j]; }
                if (s0 + 4 < 16) RS_LD(l_b, u_b, g_b, s0 + 4)
#pragma unroll
                for (int j = 0; j < 4; ++j) { const u32x4 lw = l_a[j], uw = u_a[j], gw = g_a[j]; const size_t t = (size_t)b * S_ + seg * 16 + s0 + j;
                    const float la[8] = {bf_lo(lw.x), bf_hi(lw.x), bf_lo(lw.y), bf_hi(lw.y), bf_lo(lw.z), bf_hi(lw.z), bf_lo(lw.w), bf_hi(lw.w)};
                    const float uu[8] = {bf_lo(uw.x), bf_hi(uw.x), bf_lo(uw.y), bf_hi(uw.y), bf_lo(uw.z), bf_hi(uw.z), bf_lo(uw.w), bf_hi(uw.w)};
                    const float gg[8] = {bf_lo(gw.x), bf_hi(gw.x), bf_lo(gw.y), bf_hi(gw.y), bf_lo(gw.z), bf_hi(gw.z), bf_lo(gw.w), bf_hi(gw.w)};
                    float y[8];
#pragma unroll
                    for (int q = 0; q < 8; ++q) { H[q] = __expf(la[q]) * H[q] + uu[q]; y[q] = H[q] * gelu_tanh(gg[q]); }
                    u32x4 o; o.x = cvt_pk_bf16(y[0], y[1]); o.y = cvt_pk_bf16(y[2], y[3]); o.z = cvt_pk_bf16(y[4], y[5]); o.w = cvt_pk_bf16(y[6], y[7]);
                    *(u32x4*)(Y + t * D_ + c) = o; }
#pragma unroll
                for (int j = 0; j < 4; ++j) { l_a[j] = l_b[j]; u_a[j] = u_b[j]; g_a[j] = g_b[j]; } }
#undef RS_LD
        }
    }
}

typedef short s16x4 __attribute__((ext_vector_type(4)));
__device__ __forceinline__ f32x4 mfma32(bf16x8 a, bf16x8 b, f32x4 c) { return __builtin_amdgcn_mfma_f32_16x16x32_bf16(a, b, c, 0, 0, 0); }
__device__ __forceinline__ bf16x8 lds_frag(LAS const unsigned char* p) { return *(const LAS bf16x8*)p; }
__device__ __forceinline__ s16x4 lds_tr4(LAS const unsigned char* p) { return __builtin_amdgcn_ds_read_tr16_b64_v4i16((LAS s16x4*)p); }
__device__ __forceinline__ bf16x8 lds_tr8(LAS const unsigned char* p, int rowskip_bytes) {
    const s16x4 lo = lds_tr4(p), hi = lds_tr4(p + rowskip_bytes); return __builtin_shufflevector(lo, hi, 0, 1, 2, 3, 4, 5, 6, 7); }
__device__ __forceinline__ bf16x8 pack8(const f32x4& lo, const f32x4& hi) { u32x4 w; w.x = cvt_pk_bf16(lo[0], lo[1]); w.y = cvt_pk_bf16(lo[2], lo[3]); w.z = cvt_pk_bf16(hi[0], hi[1]); w.w = cvt_pk_bf16(hi[2], hi[3]); return __builtin_bit_cast(bf16x8, w); }
constexpr int RSB = 272;

constexpr size_t WS_HQ = WS_O;
constexpr size_t WS_HA = WS_HQ + (size_t)2048 * 64 * 128 * 2;
constexpr size_t WS_HG = WS_HA + (size_t)2048 * 8 * 512 * 2;
constexpr size_t WS_HS = WS_HG + (size_t)2048 * 128 * 128 * 2;
constexpr size_t WS_HD = WS_HS + (size_t)2048 * 128 * 128 * 2;
static_assert(WS_HD + (size_t)2048 * 128 * 4 <= WS_TAIL, "hgrn overlay");

__device__ __forceinline__ void phase_hg1(const Args& a, LAS unsigned char* lds) {
    const bf16_t* p0 = (const bf16_t*)(a.ws + WS_PROJ); const float* flog = (const float*)(a.ws + WS_FLOG); const float* lb = (const float*)(a.ws + WS_LB);
    bf16_t* QG = (bf16_t*)(a.ws + WS_HQ); bf16_t* AG = (bf16_t*)(a.ws + WS_HA); bf16_t* GG = (bf16_t*)(a.ws + WS_HG); float* DG = (float*)(a.ws + WS_HD);
    constexpr int SEG = 0, QT = 4096, KT = QT + 64 * RSB, KH = KT + 64 * RSB, VS = KH + 64 * RSB;
    const int tid = TIDX, wid = tid >> 6, lane = tid & 63, I = lane & 15, G = lane >> 4, k2 = 2 * lane, sg = wid;
    LAS float* seg = (LAS float*)(lds + SEG);
    u32x4 pvv[2]; f32x2 pz[8]; unsigned pqw[8];
#define HG1_LOAD(it_) do { const int bh_ = (it_) >> 6, ck_ = (it_) & 63, h_ = bh_ & 7; const size_t t0_ = (size_t)(bh_ >> 3) * S_ + ck_ * 64; \
        _Pragma("unroll") for (int i = 0; i < 2; ++i) { const int c = tid + i * 512, s_ = c >> 4, v8 = (c & 15) * 8; pvv[i] = *(const u32x4*)(p0 + (t0_ + s_) * N_IN0 + 4096 + h_ * 128 + v8); } \
        _Pragma("unroll") for (int i = 0; i < 8; ++i) { const size_t t_ = t0_ + sg * 8 + i; pz[i] = *(const f32x2*)(flog + t_ * 1024 + h_ * 128 + k2); pqw[i] = *(const unsigned*)(p0 + t_ * N_IN0 + 2048 + h_ * 128 + k2); } } while (0)
    if (BID < 2048) HG1_LOAD(BID);
    for (int item = BID; item < 2048; item += NBLK) { const int bh = item >> 6, h = bh & 7;
        LDS_BARRIER();
#pragma unroll
        for (int i = 0; i < 2; ++i) { const int c = tid + i * 512, s = c >> 4, v8 = (c & 15) * 8; *(LAS u32x4*)(lds + VS + s * RSB + v8 * 2) = pvv[i]; }
        const f32x2 l2 = *(const f32x2*)(lb + h * 128 + k2);
        float f[8][2], cb[8][2]; unsigned qw[8]; float c0 = 0.f, c1 = 0.f;
#pragma unroll
        for (int i = 0; i < 8; ++i) { const f32x2 z = pz[i]; qw[i] = pqw[i];
            f[i][0] = l2[0] + (1.0f - l2[0]) * sigmoidf_(z[0]); f[i][1] = l2[1] + (1.0f - l2[1]) * sigmoidf_(z[1]);
            c0 += __logf(f[i][0]); c1 += __logf(f[i][1]); cb[i][0] = c0; cb[i][1] = c1; }
        *(LAS f32x2*)(seg + sg * 128 + k2) = (f32x2){c0, c1};
        if (item + NBLK < 2048) HG1_LOAD(item + NBLK);
        LDS_BARRIER();
        float off0 = 0.f, off1 = 0.f, tot0 = 0.f, tot1 = 0.f;
#pragma unroll
        for (int s2 = 0; s2 < 8; ++s2) { const f32x2 v = *(const LAS f32x2*)(seg + s2 * 128 + k2); tot0 += v[0]; tot1 += v[1]; if (s2 < sg) { off0 += v[0]; off1 += v[1]; } }
        const float et0 = __expf(tot0), et1 = __expf(tot1);
#pragma unroll
        for (int i = 0; i < 8; ++i) { const int t = sg * 8 + i;
            const float e0 = __expf(cb[i][0] + off0), e1 = __expf(cb[i][1] + off1), r0 = __builtin_amdgcn_rcpf(e0), r1 = __builtin_amdgcn_rcpf(e1), km0 = 1.0f - f[i][0], km1 = 1.0f - f[i][1];
            const unsigned qt = cvt_pk_bf16(siluf_(bf_lo(qw[i])) * e0, siluf_(bf_hi(qw[i])) * e1);
            *(LAS unsigned*)(lds + QT + t * RSB + k2 * 2) = qt; *(unsigned*)(QG + ((size_t)item * 64 + t) * 128 + k2) = qt;
            *(LAS unsigned*)(lds + KT + t * RSB + k2 * 2) = cvt_pk_bf16(km0 * r0, km1 * r1);
            *(LAS unsigned*)(lds + KH + t * RSB + k2 * 2) = cvt_pk_bf16(km0 * r0 * et0, km1 * r1 * et1); }
        if (sg == 0) *(f32x2*)(DG + (size_t)item * 128 + k2) = (f32x2){et0, et1};
        LDS_BARRIER();
        { const int tt = wid & 3, sp = wid >> 2;
          bf16x8 qf[4];
#pragma unroll
          for (int ks = 0; ks < 4; ++ks) qf[ks] = lds_frag(lds + QT + (16 * tt + I) * RSB + (32 * ks + 8 * G) * 2);
          f32x4 acc[2];
#pragma unroll
          for (int hh = 0; hh < 2; ++hh) { const int st = 2 * sp + hh; acc[hh] = (f32x4){0.f, 0.f, 0.f, 0.f};
              if (st <= tt) {
#pragma unroll
                  for (int ks = 0; ks < 4; ++ks) acc[hh] = mfma32(lds_frag(lds + KT + (16 * st + I) * RSB + (32 * ks + 8 * G) * 2), qf[ks], acc[hh]);
#pragma unroll
                  for (int r = 0; r < 4; ++r) if (16 * st + 4 * G + r > 16 * tt + I) acc[hh][r] = 0.f; } }
          *(bf16x8*)(AG + (((size_t)item * 4 + tt) * 2 + sp) * 512 + lane * 8) = pack8(acc[0], acc[1]); }
        { const int kt = wid, q = I >> 2, p = I & 3;
          bf16x8 ka[2];
#pragma unroll
          for (int ks = 0; ks < 2; ++ks) ka[ks] = lds_tr8(lds + KH + (32 * ks + 8 * G + q) * RSB + (16 * kt + 4 * p) * 2, 4 * RSB);
#pragma unroll
          for (int vt = 0; vt < 8; ++vt) { f32x4 acc = (f32x4){0.f, 0.f, 0.f, 0.f};
#pragma unroll
              for (int ks = 0; ks < 2; ++ks) acc = mfma32(ka[ks], lds_tr8(lds + VS + (32 * ks + 8 * G + q) * RSB + (16 * vt + 4 * p) * 2, 4 * RSB), acc);
              u32x2 w; w.x = cvt_pk_bf16(acc[0], acc[1]); w.y = cvt_pk_bf16(acc[2], acc[3]);
              *(u32x2*)(GG + ((size_t)item * 128 + 16 * vt + I) * 128 + 16 * kt + 4 * G) = w; } }
    }
#undef HG1_LOAD
}

__device__ __forceinline__ void phase_hg2(const Args& a) {
    const bf16_t* GG = (const bf16_t*)(a.ws + WS_HG); const float* DG = (const float*)(a.ws + WS_HD); bf16_t* SG = (bf16_t*)(a.ws + WS_HS);
    for (int gid = BID * NTHREADS + TIDX; gid < 32 * 4096; gid += NBLK * NTHREADS) { const int bh = gid >> 12, e = gid & 4095, v = e >> 5, k4 = (e & 31) * 4;
        f32x4 S = (f32x4){0.f, 0.f, 0.f, 0.f};
        const size_t o0 = (((size_t)bh * 64) * 128 + v) * 128 + k4; const float* dg = DG + (size_t)bh * 64 * 128 + k4;
        f32x4 da[8]; u32x2 ga[8];
#pragma unroll
        for (int j = 0; j < 8; ++j) { da[j] = *(const f32x4*)(dg + j * 128); ga[j] = *(const u32x2*)(GG + o0 + (size_t)j * 16384); }
#pragma unroll 1
        for (int n0 = 0; n0 < 64; n0 += 8) { f32x4 db[8]; u32x2 gb[8];
#pragma unroll
            for (int j = 0; j < 8; ++j) { db[j] = da[j]; gb[j] = ga[j]; }
            if (n0 + 8 < 64) {
#pragma unroll
                for (int j = 0; j < 8; ++j) { db[j] = *(const f32x4*)(dg + (n0 + 8 + j) * 128); gb[j] = *(const u32x2*)(GG + o0 + (size_t)(n0 + 8 + j) * 16384); } }
#pragma unroll
            for (int j = 0; j < 8; ++j) { u32x2 w; w.x = cvt_pk_bf16(S[0], S[1]); w.y = cvt_pk_bf16(S[2], S[3]); *(u32x2*)(SG + o0 + (size_t)(n0 + j) * 16384) = w;
                const f32x4 d = da[j]; const u32x2 g = ga[j];
                S[0] = d[0] * S[0] + bf_lo(g.x); S[1] = d[1] * S[1] + bf_hi(g.x); S[2] = d[2] * S[2] + bf_lo(g.y); S[3] = d[3] * S[3] + bf_hi(g.y); }
#pragma unroll
            for (int j = 0; j < 8; ++j) { da[j] = db[j]; ga[j] = gb[j]; } } }
}

__device__ __forceinline__ void phase_hg3(const Args& a, LAS unsigned char* lds) {
    const bf16_t* p0 = (const bf16_t*)(a.ws + WS_PROJ); const bf16_t* QG = (const bf16_t*)(a.ws + WS_HQ); const bf16_t* AG = (const bf16_t*)(a.ws + WS_HA); const bf16_t* SG = (const bf16_t*)(a.ws + WS_HS);
    bf16_t* Y = (bf16_t*)(a.ws + WS_Y); const float* gain = a.in[13];
    constexpr int ST = 0, QT = 128 * RSB, VS = QT + 64 * RSB, PART = VS + 64 * RSB;
    const int tid = TIDX, wid = tid >> 6, lane = tid & 63, I = lane & 15, G = lane >> 4, q = I >> 2, p = I & 3;
    LAS float* part = (LAS float*)(lds + PART);
    const int tt = wid & 3, vh = wid >> 2;
    u32x4 ps[4], pq2[2], pv2[2]; bf16x8 paf[2];
#define HG3_LOAD(it_) do { const int bh_ = (it_) >> 6, ck_ = (it_) & 63; const size_t t0_ = (size_t)(bh_ >> 3) * S_ + ck_ * 64; const int h_ = bh_ & 7; \
        _Pragma("unroll") for (int i = 0; i < 4; ++i) { const int c = tid + i * 512, v = c >> 4, k8 = (c & 15) * 8; ps[i] = *(const u32x4*)(SG + ((size_t)(it_) * 128 + v) * 128 + k8); } \
        _Pragma("unroll") for (int i = 0; i < 2; ++i) { const int c = tid + i * 512, s_ = c >> 4, c8 = (c & 15) * 8; pq2[i] = *(const u32x4*)(QG + ((size_t)(it_) * 64 + s_) * 128 + c8); pv2[i] = *(const u32x4*)(p0 + (t0_ + s_) * N_IN0 + 4096 + h_ * 128 + c8); } \
        _Pragma("unroll") for (int sp = 0; sp < 2; ++sp) paf[sp] = *(const bf16x8*)(AG + (((size_t)(it_) * 4 + tt) * 2 + sp) * 512 + lane * 8); } while (0)
    if (BID < 2048) HG3_LOAD(BID);
    for (int item = BID; item < 2048; item += NBLK) { const int bh = item >> 6, ck = item & 63, b = bh >> 3, h = bh & 7; const size_t t0 = (size_t)b * S_ + ck * 64;
        LDS_BARRIER();
#pragma unroll
        for (int i = 0; i < 4; ++i) { const int c = tid + i * 512, v = c >> 4, k8 = (c & 15) * 8; *(LAS u32x4*)(lds + ST + v * RSB + k8 * 2) = ps[i]; }
#pragma unroll
        for (int i = 0; i < 2; ++i) { const int c = tid + i * 512, s2 = c >> 4, c8 = (c & 15) * 8; *(LAS u32x4*)(lds + QT + s2 * RSB + c8 * 2) = pq2[i]; *(LAS u32x4*)(lds + VS + s2 * RSB + c8 * 2) = pv2[i]; }
        bf16x8 af[2]; af[0] = paf[0]; af[1] = paf[1];
        if (item + NBLK < 2048) HG3_LOAD(item + NBLK);
        u32x2 zwp[4];
#pragma unroll
        for (int vi = 0; vi < 4; ++vi) zwp[vi] = *(const u32x2*)(p0 + (t0 + 16 * tt + I) * N_IN0 + 5120 + h * 128 + 16 * (4 * vh + vi) + 4 * G);
        LDS_BARRIER();
        bf16x8 qf[4];
#pragma unroll
        for (int ks = 0; ks < 4; ++ks) qf[ks] = lds_frag(lds + QT + (16 * tt + I) * RSB + (32 * ks + 8 * G) * 2);
        f32x4 acc[4]; float ss = 0.f;
#pragma unroll
        for (int vi = 0; vi < 4; ++vi) { const int vt = 4 * vh + vi; acc[vi] = (f32x4){0.f, 0.f, 0.f, 0.f};
#pragma unroll
            for (int ks = 0; ks < 4; ++ks) acc[vi] = mfma32(lds_frag(lds + ST + (16 * vt + I) * RSB + (32 * ks + 8 * G) * 2), qf[ks], acc[vi]);
#pragma unroll
            for (int sp = 0; sp < 2; ++sp) acc[vi] = mfma32(lds_tr8(lds + VS + (32 * sp + 4 * G + q) * RSB + (16 * vt + 4 * p) * 2, 16 * RSB), af[sp], acc[vi]);
            ss += acc[vi][0] * acc[vi][0] + acc[vi][1] * acc[vi][1] + acc[vi][2] * acc[vi][2] + acc[vi][3] * acc[vi][3]; }
        ss += __shfl_xor(ss, 16); ss += __shfl_xor(ss, 32);
        if (G == 0) part[wid * 16 + I] = ss;
        LDS_BARRIER();
        const float rstd = rsqrtf((part[wid * 16 + I] + part[(wid ^ 4) * 16 + I]) * (1.0f / 128.0f) + 1e-6f);
        const size_t t = t0 + 16 * tt + I;
#pragma unroll
        for (int vi = 0; vi < 4; ++vi) { const int c = h * 128 + 16 * (4 * vh + vi) + 4 * G;
            const f32x4 gn = *(const f32x4*)(gain + c); const u32x2 zw = zwp[vi];
            const float o0 = acc[vi][0] * rstd * gn[0] * siluf_(bf_lo(zw.x)), o1 = acc[vi][1] * rstd * gn[1] * siluf_(bf_hi(zw.x)), o2 = acc[vi][2] * rstd * gn[2] * siluf_(bf_lo(zw.y)), o3 = acc[vi][3] * rstd * gn[3] * siluf_(bf_hi(zw.y));
            u32x2 w; w.x = cvt_pk_bf16(o0, o1); w.y = cvt_pk_bf16(o2, o3); *(u32x2*)(Y + t * D_ + 1024 + c) = w; }
    }
#undef HG3_LOAD
}

__device__ __forceinline__ void phase_gdn_norm(const Args& a) {
    const bf16_t* O = (const bf16_t*)(a.ws + WS_O); const bf16_t* pj = (const bf16_t*)(a.ws + WS_PROJ); unsigned char* Y = a.ws + WS_Y; const float* gain = a.in[19];
    const int lane = TIDX & 63, wid = TIDX >> 6, gc = (lane & 15) * 8;
    const f32x4 g0 = *(const f32x4*)(gain + gc), g1 = *(const f32x4*)(gain + gc + 4);
    u32x4 oa[8], za[8];
    int row = BID * 8 + wid; const int stride = NBLK * 8;
#define GN_LD(ov, zv, r) { _Pragma("unroll") for (int i = 0; i < 8; ++i) { const int c = (i * 64 + lane) * 8; ov[i] = *(const u32x4*)(O + (size_t)(r) * 4096 + c); zv[i] = *(const u32x4*)(pj + (size_t)(r) * N_IN1P + 8192 + c); } }
    if (row < T_) GN_LD(oa, za, row)
    for (; row < T_; row += stride) { u32x4 ob[8], zb[8];
#pragma unroll
        for (int i = 0; i < 8; ++i) { ob[i] = oa[i]; zb[i] = za[i]; }
        if (row + stride < T_) GN_LD(ob, zb, row + stride)
#pragma unroll
        for (int i = 0; i < 8; ++i) { const int c = (i * 64 + lane) * 8;
            const u32x4 ow = oa[i], zw = za[i];
            const float o[8] = {bf_lo(ow.x), bf_hi(ow.x), bf_lo(ow.y), bf_hi(ow.y), bf_lo(ow.z), bf_hi(ow.z), bf_lo(ow.w), bf_hi(ow.w)};
            const float z[8] = {bf_lo(zw.x), bf_hi(zw.x), bf_lo(zw.y), bf_hi(zw.y), bf_lo(zw.z), bf_hi(zw.z), bf_lo(zw.w), bf_hi(zw.w)};
            float ss = 0.f;
#pragma unroll
            for (int q = 0; q < 8; ++q) ss += o[q] * o[q];
            ss = row16_sum(ss);
            const float rstd = rsqrtf(ss * (1.0f / 128.0f) + 1e-6f);
            float y[8];
#pragma unroll
            for (int q = 0; q < 8; ++q) y[q] = o[q] * rstd * (q < 4 ? g0[q & 3] : g1[q & 3]) * siluf_(z[q]);
            u32x2 w; w.x = pk_fp8x4(y[0], y[1], y[2], y[3]); w.y = pk_fp8x4(y[4], y[5], y[6], y[7]);
            *(u32x2*)(Y + (size_t)row * 4096 + c) = w; }
#pragma unroll
        for (int i = 0; i < 8; ++i) { oa[i] = ob[i]; za[i] = zb[i]; }
    }
#undef GN_LD
}

template <bool FP8>
__device__ __forceinline__ void phase_gemm_out(const Args& a, LAS unsigned char* lds, int K, const void* w, const float* xin) {
    const int eb = FP8 ? 1 : 2;
    SrcGrid S{(const char*)(a.ws + WS_Y), (const char*)w, (size_t)BM * K * eb, (size_t)BM * K * eb, 64, 64 * 8, K * eb / 2, K * eb / 2};
    EpiResid E{a.ws, xin, FP8 ? 1.0f / W8_SCALE : 1.0f};
    gemm_stream<false, FP8>(lds, S, K * eb / 128, E);
}

struct SrcRouter {
    const char* h; const char* w;
    __device__ __forceinline__ bool next(int i, UnitD& u) const { const int id = BID + i * NBLK; if (id >= 256) return false; u.t0 = id & 63; u.t1 = id >> 6; u.t2 = 0;
        u.gA = h + ((size_t)u.t0 * BM * D_ + u.t1 * 512) * 2; u.gB = w + (size_t)u.t1 * 512 * 2; return true; }
    __device__ __forceinline__ void va(const UnitD&, unsigned (&v)[2][2]) const { offs_direct(v, D_, false); }
    __device__ __forceinline__ void vb(unsigned (&v)[2][2]) const { offs_direct(v, D_, true); }
};
struct EpiLogitsQ {
    float* O;
    __device__ __forceinline__ void operator()(const Acc& acc, const UnitD& u, int wr, int wc, int fr, int fq) const { store_f32_tile(acc, O + ((size_t)u.t1 * T_ + (size_t)u.t0 * BM) * 128, nullptr, 128, 128, wr, wc, fr, fq); }
};
__device__ __forceinline__ void phase_gemm_router(const Args& a, LAS unsigned char* lds, int layer) {
    SrcRouter S{(const char*)(a.ws + WS_X), (const char*)(a.ws + WS_WRT) + (size_t)layer * 256 * D_ * 2};
    EpiLogitsQ E{(float*)(a.ws + WS_O)};
    gemm_stream<false, false>(lds, S, 512 / BK, E);
}

__device__ __forceinline__ void phase_route(const Args& a, int layer) {
    const float* lg = (const float*)(a.ws + WS_O); const float* bg = a.in[22] + layer * 8; const float* be = a.in[24] + layer * 64;
    int* cnt = (int*)(a.ws + WS_CTL + CTL_CNT) + layer * 64;
    int* eid = (int*)(a.ws + WS_EID); int* slot = (int*)(a.ws + WS_SLOT); float* gate = (float*)(a.ws + WS_GATE); int* rowmap = (int*)(a.ws + WS_ROWMAP);
    const float* rsp = (const float*)(a.ws + WS_RSP);
    {
        const bf16_t* xw = (const bf16_t*)(a.ws + WS_X); const float* gain = a.in[2] + (size_t)layer * D_; const int wid = TIDX >> 6, lane = TIDX & 63, stride = NBLK * 16;
        u32x2 rb[2][8]; float ps[2];
#define RT_LD(r) { _Pragma("unroll") for (int u = 0; u < 2; ++u) { _Pragma("unroll") for (int i = 0; i < 8; ++i) rb[u][i] = *(const u32x2*)(xw + (size_t)((r) + u) * D_ + (i * 64 + lane) * 4); ps[u] = rsp[(size_t)((r) + u) * 32 + (lane & 31)]; } }
        int row = (BID * 8 + wid) * 2;
        if (row < T_) RT_LD(row)
        for (; row < T_; row += stride) { u32x2 rc[2][8]; float pc[2];
#pragma unroll
            for (int u = 0; u < 2; ++u) { pc[u] = ps[u];
#pragma unroll
                for (int i = 0; i < 8; ++i) rc[u][i] = rb[u][i]; }
            if (row + stride < T_) RT_LD(row + stride)
#pragma unroll
            for (int u = 0; u < 2; ++u) { const float rstd = rsqrtf(wave_sum(pc[u]) * (0.5f / D_) + 1e-6f);
#pragma unroll
                for (int i = 0; i < 8; ++i) { const int c = (i * 64 + lane) * 4; const f32x4 gn = *(const f32x4*)(gain + c);
                    *(unsigned*)(a.ws + WS_H8 + (size_t)(row + u) * D_ + c) = pk_fp8x4(bf_lo(rc[u][i].x) * rstd * gn[0], bf_hi(rc[u][i].x) * rstd * gn[1], bf_lo(rc[u][i].y) * rstd * gn[2], bf_hi(rc[u][i].y) * rstd * gn[3]); } } }
#undef RT_LD
    }
    const int gtid = BID * NTHREADS + TIDX, gsz = NBLK * NTHREADS;
    for (int i = gtid; i < MPAD; i += gsz) rowmap[i] = 0;
    for (int t = gtid; t < T_; t += gsz) {
        f32x4 ga = (f32x4){0.f, 0.f, 0.f, 0.f}, gb = ga, sq = ga;
#pragma unroll
        for (int kq = 0; kq < 4; ++kq) { ga += *(const f32x4*)(lg + ((size_t)kq * T_ + t) * 128); gb += *(const f32x4*)(lg + ((size_t)kq * T_ + t) * 128 + 4); }
#pragma unroll
        for (int i = 0; i < 8; ++i) sq += *(const f32x4*)(rsp + (size_t)t * 32 + i * 4);
        const float rstd = rsqrtf((sq[0] + sq[1] + sq[2] + sq[3]) * (1.0f / D_) + 1e-6f);
        ga *= rstd; gb *= rstd;
        const float gl[8] = {ga[0] + bg[0], ga[1] + bg[1], ga[2] + bg[2], ga[3] + bg[3], gb[0] + bg[4], gb[1] + bg[5], gb[2] + bg[6], gb[3] + bg[7]};
        float mx = -3.0e38f; int gi = 0;
#pragma unroll
        for (int j = 0; j < 8; ++j) if (gl[j] > mx) { mx = gl[j]; gi = j; }
        float se = 0.f;
#pragma unroll
        for (int j = 0; j < 8; ++j) se += __expf(gl[j] - mx);
        const float gp = 1.0f / se;
        f32x4 ea = (f32x4){0.f, 0.f, 0.f, 0.f}, eb = ea;
#pragma unroll
        for (int kq = 0; kq < 4; ++kq) { ea += *(const f32x4*)(lg + ((size_t)kq * T_ + t) * 128 + 8 + gi * 8); eb += *(const f32x4*)(lg + ((size_t)kq * T_ + t) * 128 + 12 + gi * 8); }
        ea = ea * rstd + *(const f32x4*)(be + gi * 8); eb = eb * rstd + *(const f32x4*)(be + gi * 8 + 4);
        const float el[8] = {ea[0], ea[1], ea[2], ea[3], eb[0], eb[1], eb[2], eb[3]};
        float l1 = -3.0e38f, l2 = -3.0e38f; int i1 = 0, i2 = 0;
#pragma unroll
        for (int j = 0; j < 8; ++j) { const float v = el[j];
            if (v > l1) { l2 = l1; i2 = i1; l1 = v; i1 = j; } else if (v > l2) { l2 = v; i2 = j; } }
        const float e2 = __expf(l2 - l1), inv = 1.0f / (1.0f + e2);
        const int e0 = gi * 8 + i1, e1 = gi * 8 + i2;
        eid[t * 2] = e0; eid[t * 2 + 1] = e1; gate[t * 2] = inv * gp; gate[t * 2 + 1] = e2 * inv * gp;
        slot[t * 2] = atomicAdd(&cnt[e0], 1); slot[t * 2 + 1] = atomicAdd(&cnt[e1], 1); }
}

__device__ __forceinline__ void phase_rowmap(const Args& a, LAS unsigned char* lds, int layer) {
    const int* cnt = (const int*)(a.ws + WS_CTL + CTL_CNT) + layer * 64; LAS int* ps = (LAS int*)lds;
    int* tinfo = (int*)(a.ws + WS_TINFO) + layer * 512;
    const int* eid = (const int*)(a.ws + WS_EID); const int* slot = (const int*)(a.ws + WS_SLOT); int* posof = (int*)(a.ws + WS_POSOF); int* rowmap = (int*)(a.ws + WS_ROWMAP);
    __syncthreads();
    if (TIDX == 0) { int acc = 0; for (int e = 0; e < 64; ++e) { ps[e] = acc; acc += (cnt[e] + 255) & ~255; } ps[64] = acc; }
    __syncthreads();
    if (BID == 0) { if (TIDX <= 64) tinfo[TIDX] = ps[TIDX]; if (TIDX == 65) tinfo[65] = ps[64] >> 8;
        if (TIDX < 192) { const int p = TIDX * 256; int e = 0; for (int j = 0; j < 64; ++j) if (ps[j + 1] <= p) e = j + 1; tinfo[128 + TIDX] = e < 64 ? e : 63; } }
    for (int i = BID * NTHREADS + TIDX; i < T_ * 2; i += NBLK * NTHREADS) { const int p = ps[eid[i]] + slot[i]; posof[i] = p; rowmap[p] = i >> 1; }
    __syncthreads();
}

struct SrcMoeUp {
    const char* h; const char* wg; const int* tinfo; const int* rowmap; int total;
    __device__ __forceinline__ bool next(int i, UnitD& u) const { const int id = BID + i * NBLK; if (id >= total) return false; u.t0 = id >> 2; u.t1 = id & 3;
        u.t2 = __builtin_amdgcn_readfirstlane(tinfo[128 + u.t0]); u.gA = h; u.gB = wg + ((size_t)u.t2 * DEXP + u.t1 * 128) * D_; return true; }
    __device__ __forceinline__ void va(const UnitD& u, unsigned (&v)[2][2]) const { int R0, C0; stage_pos(TIDX, R0, C0);
#pragma unroll
        for (int hh = 0; hh < 2; ++hh)
#pragma unroll
            for (int i = 0; i < 2; ++i) v[hh][i] = (unsigned)(rowmap[u.t0 * 256 + hh * 128 + R0 + 64 * i] * D_ + C0 * 2); }
    __device__ __forceinline__ void vb(unsigned (&v)[2][2]) const { int R0, C0; stage_pos(TIDX, R0, C0);
#pragma unroll
        for (int i = 0; i < 2; ++i) { const int Rr = perm_row(R0 + 64 * i); v[0][i] = (unsigned)(Rr * D_ + C0 * 2); v[1][i] = (unsigned)(WS_WU - WS_WG) + (unsigned)(Rr * D_ + C0 * 2); } }
};
__device__ __forceinline__ void phase_moe_up(const Args& a, LAS unsigned char* lds, int layer) {
    const int* tinfo = (const int*)(a.ws + WS_TINFO) + layer * 512;
    const int ntm = __builtin_amdgcn_readfirstlane(tinfo[65]);
    SrcMoeUp S{(const char*)(a.ws + WS_H8), (const char*)(a.ws + WS_WG), tinfo, (const int*)(a.ws + WS_ROWMAP), ntm * 4};
    EpiSwiGLU E{a.ws + WS_ACT};
    gemm_stream<true, true>(lds, S, D_ / 128, E);
}

struct SrcMoeDown {
    const char* act; const char* wd; const int* tinfo; int total;
    __device__ __forceinline__ bool next(int i, UnitD& u) const { const int id = BID + i * NBLK; if (id >= total) return false; u.t0 = id >> 3; u.t1 = id & 7;
        u.t2 = __builtin_amdgcn_readfirstlane(tinfo[128 + u.t0]); u.gA = act + (size_t)u.t0 * BM * DEXP; u.gB = wd + ((size_t)u.t2 * D_ + u.t1 * BM) * DEXP; return true; }
    __device__ __forceinline__ void va(const UnitD&, unsigned (&v)[2][2]) const { offs_direct(v, DEXP / 2, false); }
    __device__ __forceinline__ void vb(unsigned (&v)[2][2]) const { offs_direct(v, DEXP / 2, true); }
};
__device__ __forceinline__ void phase_moe_down(const Args& a, LAS unsigned char* lds, int layer) {
    const int* tinfo = (const int*)(a.ws + WS_TINFO) + layer * 512; const int ntm = __builtin_amdgcn_readfirstlane(tinfo[65]);
    SrcMoeDown S{(const char*)(a.ws + WS_ACT), (const char*)(a.ws + WS_WD), tinfo, ntm * 8};
    EpiDown E{a.ws + WS_YMOE};
    gemm_stream<false, true>(lds, S, DEXP / 128, E);
}

struct SrcIn1Tail {
    const char* h; const char* w;
    __device__ __forceinline__ bool next(int i, UnitD& u) const { const int id = BID + i * NBLK; if (id >= 256) return false; u.t0 = id & 63; u.t1 = id >> 6; u.t2 = 0;
        u.gA = h + (size_t)u.t0 * BM * D_ + u.t1 * 512; u.gB = w + (size_t)48 * BM * D_ + u.t1 * 512; return true; }
    __device__ __forceinline__ void va(const UnitD&, unsigned (&v)[2][2]) const { offs_direct(v, D_ / 2, false); }
    __device__ __forceinline__ void vb(unsigned (&v)[2][2]) const { offs_direct(v, D_ / 2, true); }
};
struct EpiTailQ {
    float* O;
    __device__ __forceinline__ void operator()(const Acc& acc, const UnitD& u, int wr, int wc, int fr, int fq) const { store_f32_tile(acc, O + ((size_t)u.t1 * T_ + (size_t)u.t0 * BM) * 64, nullptr, 64, 64, wr, wc, fr, fq, 1.0f / W8_SCALE); }
};
__device__ __forceinline__ void phase_gemm_in1(const Args& a, LAS unsigned char* lds) {
    SrcGridSplit S{(const char*)(a.ws + WS_H8), (const char*)(a.ws + WS_WIN1T), (size_t)BM * D_, (size_t)BM * D_, 64, 64 * 48, D_ / 2, D_ / 2, 16, 8};
    EpiProj E{(bf16_t*)(a.ws + WS_PROJ), N_IN1P, nullptr, 64, 48, 48, 64, 1.0f / W8_SCALE};
    gemm_stream<false, true>(lds, S, D_ / 128, E);
}
__device__ __forceinline__ void phase_gemm_in1_tail(const Args& a, LAS unsigned char* lds) {
    SrcIn1Tail S{(const char*)(a.ws + WS_H8), (const char*)(a.ws + WS_WIN1T)};
    EpiTailQ E{(float*)(a.ws + WS_O)};
    int nt = 4; asm volatile("" : "+s"(nt));
    gemm_stream<false, true>(lds, S, nt, E);
}

__device__ __forceinline__ void phase_gdn_conv(const Args& a) {
    const bf16_t* p1 = (const bf16_t*)(a.ws + WS_PROJ); bf16_t* qc = (bf16_t*)(a.ws + WS_QKVC); const float* cw = a.in[16];
    const int gtid = BID * NTHREADS + TIDX, gsz = NBLK * NTHREADS;
    for (int it = gtid; it < 1024 * (T_ / 128); it += gsz) { const int c = (it & 1023) * 8, seg = it >> 10; const size_t t0 = (size_t)seg * 128;
        float w[4][8];
#pragma unroll
        for (int k = 0; k < 4; ++k) { const f32x4 w0 = *(const f32x4*)(cw + k * 8192 + c), w1 = *(const f32x4*)(cw + k * 8192 + c + 4);
            w[k][0] = w0[0]; w[k][1] = w0[1]; w[k][2] = w0[2]; w[k][3] = w0[3]; w[k][4] = w1[0]; w[k][5] = w1[1]; w[k][6] = w1[2]; w[k][7] = w1[3]; }
        u32x4 x0 = (u32x4){0u, 0u, 0u, 0u}, x1 = x0, x2 = x0;
        if ((t0 & (S_ - 1)) != 0) { x0 = *(const u32x4*)(p1 + (t0 - 3) * N_IN1P + c); x1 = *(const u32x4*)(p1 + (t0 - 2) * N_IN1P + c); x2 = *(const u32x4*)(p1 + (t0 - 1) * N_IN1P + c); }
        const float qsc = c < 2048 ? 0.08838834764831845f : 1.0f;
        u32x4 xa[8];
#pragma unroll
        for (int j = 0; j < 8; ++j) xa[j] = *(const u32x4*)(p1 + (t0 + j) * N_IN1P + c);
#pragma unroll 1
        for (int r0 = 0; r0 < 128; r0 += 8) { u32x4 xb[8];
#pragma unroll
            for (int j = 0; j < 8; ++j) xb[j] = xa[j];
            if (r0 + 8 < 128) {
#pragma unroll
                for (int j = 0; j < 8; ++j) xb[j] = *(const u32x4*)(p1 + (t0 + r0 + 8 + j) * N_IN1P + c); }
#pragma unroll
          for (int j8 = 0; j8 < 8; ++j8) { const u32x4 x3 = xa[j8]; const int r = r0 + j8;
            float acc[8];
#define TAPS(j, f, m) (w[0][j] * f(x0.m) + w[1][j] * f(x1.m) + w[2][j] * f(x2.m) + w[3][j] * f(x3.m))
            acc[0] = TAPS(0, bf_lo, x); acc[1] = TAPS(1, bf_hi, x); acc[2] = TAPS(2, bf_lo, y); acc[3] = TAPS(3, bf_hi, y);
            acc[4] = TAPS(4, bf_lo, z); acc[5] = TAPS(5, bf_hi, z); acc[6] = TAPS(6, bf_lo, w); acc[7] = TAPS(7, bf_hi, w);
#undef TAPS
            float ss = 0.f;
#pragma unroll
            for (int j = 0; j < 8; ++j) { acc[j] = siluf_(acc[j]); ss += acc[j] * acc[j]; }
            ss = row16_sum(ss);
            const float sc = c < 4096 ? rsqrtf(ss + 1e-6f) * qsc : 1.0f;
            u32x4 o; o.x = cvt_pk_bf16(acc[0] * sc, acc[1] * sc); o.y = cvt_pk_bf16(acc[2] * sc, acc[3] * sc); o.z = cvt_pk_bf16(acc[4] * sc, acc[5] * sc); o.w = cvt_pk_bf16(acc[6] * sc, acc[7] * sc);
            *(u32x4*)(qc + (t0 + r) * 8192 + c) = o;
            x0 = x1; x1 = x2; x2 = x3; }
#pragma unroll
            for (int j = 0; j < 8; ++j) xa[j] = xb[j]; } }
    const float* tail = (const float*)(a.ws + WS_O); float* bgo = (float*)(a.ws + WS_BG);
    for (int it = gtid; it < T_ * 32; it += gsz) { const int t = it >> 5, hv = it & 31; float tb = 0.f, ta = 0.f;
#pragma unroll
        for (int kq = 0; kq < 4; ++kq) { tb += tail[((size_t)kq * T_ + t) * 64 + hv]; ta += tail[((size_t)kq * T_ + t) * 64 + 32 + hv]; }
        bgo[t * 64 + hv] = sigmoidf_(tb);
        bgo[t * 64 + 32 + hv] = -__expf(a.in[17][hv]) * softplusf_(ta + a.in[18][hv]); }
}

struct MoeTile { const float* src; unsigned char* dst; int lds_, ldd; };
__device__ __forceinline__ MoeTile moe_tile(const Args& a, int g) {
    const int job = g >> 14, r = g & 16383, e = r >> 8, rr = r & 255; MoeTile t;
    typedef __attribute__((address_space(1))) const float* gcf; gcf s25 = (gcf)a.in[25], s26 = (gcf)a.in[26]; asm volatile("" : "+s"(s25), "+s"(s26));
    if (job < 2) { const int ik = rr >> 3, in = rr & 7; t.lds_ = DEXP; t.ldd = D_;
        t.src = (const float*)(job ? s26 : s25) + ((size_t)(NEXP + e) * D_ + ik * 64) * DEXP + in * 64; t.dst = a.ws + (job ? WS_WU : WS_WG) + ((size_t)e * DEXP + in * 64) * D_ + ik * 64; }
    else { const int ik = rr >> 5, in = rr & 31; t.lds_ = D_; t.ldd = DEXP;
        t.src = a.in[27] + ((size_t)(NEXP + e) * DEXP + ik * 64) * D_ + in * 64; t.dst = a.ws + WS_WD + ((size_t)e * D_ + in * 64) * DEXP + ik * 64; }
    return t;
}
__device__ __forceinline__ void moe_tile_load(const MoeTile& t, int tid, f32x4 (&v)[2]) {
#pragma unroll
    for (int i = 0; i < 2; ++i) { const int idx = tid + i * 512, rr = idx >> 4, c4 = (idx & 15) * 4; v[i] = *(const f32x4*)(t.src + (size_t)rr * t.lds_ + c4); }
}
__device__ __forceinline__ void moe_tile_store(const MoeTile& t, int tid, const f32x4 (&v)[2], LAS float* tile) {
#pragma unroll
    for (int i = 0; i < 2; ++i) { const int idx = tid + i * 512, rr = idx >> 4, c4 = (idx & 15) * 4;
        tile[rr * 65 + c4 + 0] = v[i][0]; tile[rr * 65 + c4 + 1] = v[i][1]; tile[rr * 65 + c4 + 2] = v[i][2]; tile[rr * 65 + c4 + 3] = v[i][3]; }
    LDS_BARRIER();
    { const int n = tid >> 3, kg = (tid & 7) * 8; float f[8];
#pragma unroll
      for (int jj = 0; jj < 8; ++jj) f[jj] = tile[(kg + jj) * 65 + n] * W8_SCALE;
      u32x2 w; w.x = pk_fp8x4(f[0], f[1], f[2], f[3]); w.y = pk_fp8x4(f[4], f[5], f[6], f[7]);
      *(u32x2*)(t.dst + (size_t)n * t.ldd + kg) = w; }
    LDS_BARRIER();
}
constexpr int MOE_TILES = 3 * NEXP * 256;

__device__ __forceinline__ f32x4 mfma16(s16x4 a, s16x4 b, f32x4 c) { return __builtin_amdgcn_mfma_f32_16x16x16bf16_1k(a, b, c, 0, 0, 0); }
__device__ __forceinline__ s16x4 pack4(const f32x4& v) { u32x2 w; w.x = cvt_pk_bf16(v[0], v[1]); w.y = cvt_pk_bf16(v[2], v[3]); return __builtin_bit_cast(s16x4, w); }
__device__ __forceinline__ void phase_gdn_chunk(const Args& a, LAS unsigned char* lds) {
    const bf16_t* qc = (const bf16_t*)(a.ws + WS_QKVC); const float* bgi = (const float*)(a.ws + WS_BG); bf16_t* O = (bf16_t*)(a.ws + WS_O);
    constexpr int VRS = 144, KTRS = 136;
    constexpr int KT = 0, QS = KT + 128 * KTRS, WSL = QS + 64 * RSB, QKS = WSL + 64 * RSB, EE = QKS + 2048, EDD = EE + 256, SET = EDD + 256;
    constexpr int STL = 2 * SET, KS = STL + 64 * RSB, VS = KS + 64 * RSB, X2 = VS + 64 * VRS, LS = X2 + 2048, X1 = LS + 4096, GAM = X1 + 2048, BET = GAM + 256, LEND = BET + 256;
    static_assert(LEND <= LDS_XBW, "gdn lds");
    const int wid = __builtin_amdgcn_readfirstlane(TIDX >> 6);
    const int NCK = S_ / 64;
    for (int blk = BID; blk < NB_ * 32 * 2; blk += NBLK) {
        const int grp = (blk & 7) * 8 + (blk >> 5), mem = (blk >> 3) & 3, b = grp >> 4, hk = grp & 15, hv = 2 * hk + (mem >> 1), vhalf = mem & 1;
        __syncthreads();
        if (wid < 4) {
            const int vt = wid;
            f32x4 Sacc[8];
#pragma unroll
            for (int n = 0; n < 8; ++n) Sacc[n] = (f32x4){0.f, 0.f, 0.f, 0.f};
            { const int lane = TIDX & 63;
              for (int i = lane; i < 16 * RSB / 16; i += 64) *(LAS u32x4*)(lds + STL + 16 * vt * RSB + i * 16) = (u32x4){0u, 0u, 0u, 0u}; }
            int lz = TIDX & 63; asm volatile("" : "+v"(lz));
            const int lane = lz, I = lane & 15, G = lane >> 4, q4 = I >> 2, p4 = I & 3;
            for (int it = 0; it <= NCK; ++it) {
                const int set = ((it - 1) & 1) * SET; const size_t t0 = (size_t)b * S_ + (size_t)(it - 1) * 64;
                f32x4 U[4];
                if (it >= 1) {
#pragma unroll
                    for (int sa = 0; sa < 4; ++sa) U[sa] = mfma16(*(const LAS s16x4*)(lds + X2 + ((sa * 16 + I) * 16 + 4 * G) * 2), lds_tr4(lds + VS + (16 * sa + 4 * G + q4) * VRS + (16 * vt + 4 * p4) * 2), (f32x4){0.f, 0.f, 0.f, 0.f});
                    asm volatile("" : "+v"(U[0]), "+v"(U[1]), "+v"(U[2]), "+v"(U[3]) :: "memory");
                }
                LDS_BARRIER();
#pragma unroll
                for (int sa = 0; sa < 4; ++sa) {
                    if (it >= 1) {
                        bf16x8 sf[4];
#pragma unroll
                        for (int ks = 0; ks < 4; ++ks) sf[ks] = lds_frag(lds + STL + (16 * vt + I) * RSB + (32 * ks + 8 * G) * 2);
                        s16x4 kt[8];
#pragma unroll
                        for (int dt = 0; dt < 8; ++dt) kt[dt] = *(const LAS s16x4*)(lds + set + KT + (16 * dt + I) * KTRS + (16 * sa + 4 * G) * 2);
                        f32x4 dl = U[sa], oq = (f32x4){0.f, 0.f, 0.f, 0.f}, dl2 = oq, oq2 = oq;
#pragma unroll
                        for (int ks = 0; ks < 2; ++ks) { dl = mfma32(lds_frag(lds + set + WSL + (16 * sa + I) * RSB + (32 * ks + 8 * G) * 2), sf[ks], dl);
                            dl2 = mfma32(lds_frag(lds + set + WSL + (16 * sa + I) * RSB + (32 * (ks + 2) + 8 * G) * 2), sf[ks + 2], dl2);
                            oq = mfma32(lds_frag(lds + set + QS + (16 * sa + I) * RSB + (32 * ks + 8 * G) * 2), sf[ks], oq);
                            oq2 = mfma32(lds_frag(lds + set + QS + (16 * sa + I) * RSB + (32 * (ks + 2) + 8 * G) * 2), sf[ks + 2], oq2); }
                        dl += dl2; oq += oq2;
                        const s16x4 dfrag = pack4(dl);
                        const f32x4 e4 = *(const LAS f32x4*)(lds + set + EE + (16 * sa + 4 * G) * 4);
                        oq = mfma16(*(const LAS s16x4*)(lds + set + QKS + ((sa * 16 + I) * 16 + 4 * G) * 2), dfrag, oq * e4);
#pragma unroll
                        for (int r = 0; r < 4; ++r) O[(t0 + 16 * sa + 4 * G + r) * 4096 + hv * 128 + vhalf * 64 + 16 * vt + I] = f2bf(oq[r]);
                        const f32x4 ed4 = *(const LAS f32x4*)(lds + set + EDD + (16 * sa + 4 * G) * 4); const float e15 = *(const LAS float*)(lds + set + EE + (16 * sa + 15) * 4);
                        const s16x4 dsc = pack4(dl * ed4);
#pragma unroll
                        for (int dt = 0; dt < 8; ++dt) {
                            Sacc[dt] = mfma16(kt[dt], dsc, Sacc[dt] * e15);
                            *(LAS s16x4*)(lds + STL + (16 * vt + I) * RSB + (16 * dt + 4 * G) * 2) = pack4(Sacc[dt]); }
                    }
                    if (sa == 3) LDS_BARRIER();
                }
            }
        } else {
            const int pw = wid - 4;
            u32x4 pq[4], pk[4], pv[2]; float pb = 0.f, pg = 0.f;
            { const int ptid = TIDX - 256; const size_t t0 = (size_t)b * S_;
#pragma unroll
              for (int i = 0; i < 4; ++i) { const int c = ptid + i * 256, s2 = c >> 4, c8 = (c & 15) * 8; pq[i] = *(const u32x4*)(qc + (t0 + s2) * 8192 + hk * 128 + c8); pk[i] = *(const u32x4*)(qc + (t0 + s2) * 8192 + 2048 + hk * 128 + c8); }
#pragma unroll
              for (int i = 0; i < 2; ++i) { const int c = ptid + i * 256, s2 = c >> 3, c8 = (c & 7) * 8; pv[i] = *(const u32x4*)(qc + (t0 + s2) * 8192 + 4096 + hv * 128 + vhalf * 64 + c8); }
              if (pw == 1) { pb = bgi[(t0 + ptid - 64) * 64 + hv]; pg = bgi[(t0 + ptid - 64) * 64 + 32 + hv]; } }
            int lz = TIDX & 63; asm volatile("" : "+v"(lz));
            const int lane = lz, ptid = pw * 64 + lane, I = lane & 15, G = lane >> 4, q4 = I >> 2, p4 = I & 3;
            for (int it = 0; it <= NCK; ++it) {
                const int set = (it & 1) * SET; const bool act = it < NCK;
                if (act) {
#pragma unroll
                    for (int i = 0; i < 4; ++i) { const int c = ptid + i * 256, s2 = c >> 4, c8 = (c & 15) * 8; *(LAS u32x4*)(lds + set + QS + s2 * RSB + c8 * 2) = pq[i]; *(LAS u32x4*)(lds + KS + s2 * RSB + c8 * 2) = pk[i]; }
                    if (pw == 1) { float x = pg;
                        x += __builtin_bit_cast(float, __builtin_amdgcn_update_dpp(0, __builtin_bit_cast(int, x), 0x111, 0xf, 0xf, true));
                        x += __builtin_bit_cast(float, __builtin_amdgcn_update_dpp(0, __builtin_bit_cast(int, x), 0x112, 0xf, 0xf, true));
                        x += __builtin_bit_cast(float, __builtin_amdgcn_update_dpp(0, __builtin_bit_cast(int, x), 0x114, 0xf, 0xf, true));
                        x += __builtin_bit_cast(float, __builtin_amdgcn_update_dpp(0, __builtin_bit_cast(int, x), 0x118, 0xf, 0xf, true));
                        const float g15 = __shfl(x, 15, 16);
                        *(LAS float*)(lds + GAM + lane * 4) = x; *(LAS float*)(lds + set + EE + lane * 4) = __expf(x); *(LAS float*)(lds + set + EDD + lane * 4) = __expf(g15 - x); *(LAS float*)(lds + BET + lane * 4) = pb; }
                    if (it + 1 < NCK) { const size_t t1 = (size_t)b * S_ + (size_t)(it + 1) * 64;
#pragma unroll
                        for (int i = 0; i < 4; ++i) { const int c = ptid + i * 256, s2 = c >> 4, c8 = (c & 15) * 8; pq[i] = *(const u32x4*)(qc + (t1 + s2) * 8192 + hk * 128 + c8); pk[i] = *(const u32x4*)(qc + (t1 + s2) * 8192 + 2048 + hk * 128 + c8); }
                        if (pw == 1) { pb = bgi[(t1 + ptid - 64) * 64 + hv]; pg = bgi[(t1 + ptid - 64) * 64 + 32 + hv]; } }
                }
                LDS_BARRIER();
                if (act) { const int sa = pw;
#pragma unroll
                    for (int i = 0; i < 2; ++i) { const int c = ptid + i * 256, s2 = c >> 3, c8 = (c & 7) * 8; *(LAS u32x4*)(lds + VS + s2 * VRS + c8 * 2) = pv[i]; }
                    if (it + 1 < NCK) { const size_t t1 = (size_t)b * S_ + (size_t)(it + 1) * 64;
#pragma unroll
                        for (int i = 0; i < 2; ++i) { const int c = ptid + i * 256, s2 = c >> 3, c8 = (c & 7) * 8; pv[i] = *(const u32x4*)(qc + (t1 + s2) * 8192 + 4096 + hv * 128 + vhalf * 64 + c8); } }
#pragma unroll
                    for (int ty = 0; ty < 2; ++ty) { f32x4 acc = (f32x4){0.f, 0.f, 0.f, 0.f};
#pragma unroll
                        for (int ks = 0; ks < 4; ++ks) { const bf16x8 ka = lds_frag(lds + KS + (16 * sa + I) * RSB + (32 * ks + 8 * G) * 2);
                            const bf16x8 bo = ty ? lds_frag(lds + set + QS + (16 * sa + I) * RSB + (32 * ks + 8 * G) * 2) : ka; acc = mfma32(ka, bo, acc); }
                        const f32x4 gr = *(const LAS f32x4*)(lds + GAM + (16 * sa + 4 * G) * 4); const float gc = *(const LAS float*)(lds + GAM + (16 * sa + I) * 4);
                        if (ty == 0) { const f32x4 br = *(const LAS f32x4*)(lds + BET + (16 * sa + 4 * G) * 4);
#pragma unroll
                            for (int r = 0; r < 4; ++r) { const float val = br[r] * acc[r] * __expf(gr[r] - gc); *(LAS float*)(lds + LS + ((sa * 16 + 4 * G + r) * 16 + I) * 4) = (I < 4 * G + r) ? val : 0.f; } }
                        else { f32x4 o;
#pragma unroll
                            for (int r = 0; r < 4; ++r) { const float val = acc[r] * __expf(gc - gr[r]); o[r] = (4 * G + r <= I) ? val : 0.f; }
                            *(LAS s16x4*)(lds + set + QKS + ((sa * 16 + I) * 16 + 4 * G) * 2) = pack4(o); } } }
                asm volatile("" ::: "memory");
                if (act) { const int sa = pw, c = lane >> 2, q = lane & 3;
                    f32x4 lv[16];
#pragma unroll
                    for (int i = 0; i < 16; ++i) lv[i] = *(const LAS f32x4*)(lds + LS + ((sa * 16 + i) * 16 + 4 * q) * 4);
                    float xo[4] = {0.f, 0.f, 0.f, 0.f}, xw[4] = {0.f, 0.f, 0.f, 0.f};
#pragma unroll
                    for (int i = 0; i < 16; ++i) {
                        float p = lv[i][0] * xo[0] + lv[i][1] * xo[1] + lv[i][2] * xo[2] + lv[i][3] * xo[3];
                        p += dpp_f<0xB1>(p); p += dpp_f<0x4E>(p);
                        const float xi = ((i == c) ? 1.0f : 0.0f) - p;
                        xo[i & 3] = (q == (i >> 2)) ? xi : xo[i & 3];
                        xw[i >> 2] = (q == (i & 3)) ? xi : xw[i >> 2]; }
                    const float bc = *(const LAS float*)(lds + BET + (sa * 16 + c) * 4), sc1 = -bc * *(const LAS float*)(lds + set + EE + (sa * 16 + c) * 4);
#pragma unroll
                    for (int k = 0; k < 4; ++k) { const int i = 4 * k + q; *(LAS bf16_t*)(lds + X1 + ((sa * 16 + i) * 16 + c) * 2) = f2bf(xw[k] * sc1); *(LAS bf16_t*)(lds + X2 + ((sa * 16 + i) * 16 + c) * 2) = f2bf(xw[k] * bc); } }
                asm volatile("" ::: "memory");
                if (act) { const int sa = pw;
                    const s16x4 xb = *(const LAS s16x4*)(lds + X1 + ((sa * 16 + I) * 16 + 4 * G) * 2); s16x4 kt[8]; f32x4 w[8];
#pragma unroll
                    for (int dt = 0; dt < 8; ++dt) kt[dt] = lds_tr4(lds + KS + (16 * sa + 4 * G + q4) * RSB + (16 * dt + 4 * p4) * 2);
#pragma unroll
                    for (int dt = 0; dt < 8; ++dt) { w[dt] = mfma16(kt[dt], xb, (f32x4){0.f, 0.f, 0.f, 0.f}); *(LAS s16x4*)(lds + set + KT + (16 * dt + I) * KTRS + (16 * sa + 4 * G) * 2) = kt[dt]; }
#pragma unroll
                    for (int dt = 0; dt < 8; ++dt) *(LAS s16x4*)(lds + set + WSL + (16 * sa + I) * RSB + (16 * dt + 4 * G) * 2) = pack4(w[dt]); }
                LDS_BARRIER();
            }
        }
    }
}

constexpr int N_PHASES = 30;
__global__ void __launch_bounds__(NTHREADS, 2) fwd(Args a0) {
    extern __shared__ __attribute__((aligned(16))) unsigned char smem_raw[];
    LAS unsigned char* lds = (LAS unsigned char*)smem_raw;
    volatile LAS unsigned* xbw = (volatile LAS unsigned*)(lds + LDS_XBW);
    if (TIDX == 0) { xbw[0] = 0u; xbw[1] = 0u; xbw[2] = 0u; xbw[3] = 0u; }
    __syncthreads();
    XcdBarrier bar = xcd_barrier_post((unsigned*)(a0.ws + WS_CTL), xbw);
#ifndef PHMASK
#define PHMASK 0xFFFFFFFFull
#endif
#ifndef DUPMASK
#define DUPMASK 0ull
#endif
#define PH(i, body) do { if (((PHMASK >> (i)) & 1ull) && a0.ph_lo <= (i) && (i) < a0.ph_hi) { __attribute__((address_space(1))) unsigned char* wsp_ = (__attribute__((address_space(1))) unsigned char*)a0.ws; asm volatile("" : "+s"(wsp_)); Args a = a0; a.ws = (unsigned char*)wsp_; const float* xin = a.in[0]; const float* xw = (const float*)(a.ws + WS_X); (void)xin; (void)xw; \
        if ((DUPMASK >> (i)) & 1ull) { body; xcd_barrier(bar); } body; if ((i) + 1 < a0.ph_hi) xcd_barrier(bar); } } while (0)
    PH(0, { phase_prologue(a, lds); __syncthreads(); NORM_PH(0, true)(a, xin, a.in[1], -1); });
    PH(2, { if (NBLK == 256 && BID >= 128) { moe_weight_jobs_part(a, 0, lds, BID - 128, 128); __syncthreads(); }
            phase_gemm_in0(a, lds); });
    PH(3, { phase_rg_conv(a); __syncthreads(); phase_hg1(a, lds); });
    PH(4, { phase_rg_gates(a, lds); __syncthreads(); phase_hg2(a); });
    PH(5, { phase_rg_scan(a, lds); __syncthreads(); phase_hg3(a, lds); });
    PH(9, phase_gemm_out<false>(a, lds, D_, a.ws + WS_WOUT0T, xin));
    PH(11, phase_gemm_router(a, lds, 0));
    PH(12, phase_route(a, 0));
    PH(13, phase_rowmap(a, lds, 0));
    PH(14, phase_moe_up(a, lds, 0));
    PH(15, phase_moe_down(a, lds, 0));
    PH(16, { NORM_PH(1, false)(a, nullptr, a.in[1] + D_, 0); if (NBLK != 256) { __syncthreads(); moe_weight_jobs(a, 1, lds); } });
    PH(18, { if (NBLK == 256 && BID >= 128) { moe_weight_jobs_part(a, 1, lds, BID - 128, 128); __syncthreads(); }
             phase_gemm_in1(a, lds); phase_gemm_in1_tail(a, lds); });
    PH(19, phase_gdn_conv(a));
    PH(20, phase_gdn_chunk(a, lds));
    PH(21, phase_gdn_norm(a));
    PH(22, phase_gemm_out<true>(a, lds, 4096, a.ws + WS_WOUT1T, nullptr));
    PH(24, phase_gemm_router(a, lds, 1));
    PH(25, phase_route(a, 1));
    PH(26, phase_rowmap(a, lds, 1));
    PH(27, phase_moe_up(a, lds, 1));
    PH(28, phase_moe_down(a, lds, 1));
    PH(29, NORM_PH(2, false)(a, nullptr, a.in[3], 1));
#undef PH
}

extern "C" void kernel_launch(void* const* d_in, const int* in_sizes, int n_in, void* d_out, int out_size, void* d_ws, size_t ws_size, hipStream_t stream) {
    static int grid = 0;
    if (grid == 0) {
        if (n_in != 28 || ws_size < WS_END) { fprintf(stderr, "kernel_launch: need 28 inputs and %zu bytes of workspace, got %d / %zu\n", (size_t)WS_END, n_in, ws_size); grid = -1; return; }
        int dev = 0, cus = 0, per_cu = 0;
        if (hipGetDevice(&dev) != hipSuccess || hipDeviceGetAttribute(&cus, hipDeviceAttributeMultiprocessorCount, dev) != hipSuccess) { grid = -1; return; }
        if (hipFuncSetAttribute((const void*)fwd, hipFuncAttributeMaxDynamicSharedMemorySize, LDS_BYTES) != hipSuccess) { fprintf(stderr, "kernel_launch: hipFuncSetAttribute failed\n"); grid = -1; return; }
        if (hipOccupancyMaxActiveBlocksPerMultiprocessor(&per_cu, (const void*)fwd, NTHREADS, LDS_BYTES) != hipSuccess || per_cu < 1) { fprintf(stderr, "kernel_launch: occupancy query says %d\n", per_cu); }
        (void)hipGetLastError();
        grid = cus;
    }
    if (grid < 0) return;
    (void)in_sizes; (void)out_size;
    hipMemsetAsync((char*)d_ws + WS_CTL, 0, CTL_BYTES, stream);
    Args a; memset(&a, 0, sizeof(a));
    for (int i = 0; i < 28; ++i) a.in[i] = (const float*)d_in[i];
    a.out = (float*)d_out; a.ws = (unsigned char*)d_ws;
#if N_LAUNCH_MODE == 1
    a.ph_lo = 0; a.ph_hi = N_PHASES;
    hipLaunchKernelGGL(fwd, dim3(grid), dim3(NTHREADS), LDS_BYTES, stream, a);
#if EXTRA_PH >= 0
    a.ph_lo = EXTRA_PH; a.ph_hi = EXTRA_PH + 1;
    hipLaunchKernelGGL(fwd, dim3(grid), dim3(NTHREADS), LDS_BYTES, stream, a);
#endif
#else
    for (int p = 0; p < N_PHASES; ++p) { a.ph_lo = p; a.ph_hi = p + 1; hipLaunchKernelGGL(fwd, dim3(grid), dim3(NTHREADS), LDS_BYTES, stream, a); }
#endif
}
```
